# Optimizing an MI355X kernel written in HIP

```python
import math
import jax, jax.numpy as jnp
from jax import lax
import numpy as np

D_MODEL = 1024
BATCH = 8
SEQ = 4096
DEPTH = 1

PLE_DIM = 256
N_HEADS = 4
QK_NOPE_DIM = 128
QK_ROPE_DIM = 64
V_HEAD_DIM = 128
Q_LORA_RANK = 256
KV_LORA_RANK = 128
ROPE_THETA = 10000.0
ATTN_WIDTH = N_HEADS * V_HEAD_DIM
Q_BLOCK = 128
CONV_GROUPS = 4
CONV_WIDTH = 512
CONV_K = 3
MIX_WIDTH = ATTN_WIDTH + CONV_WIDTH
IN_PROJ_WIDTH = Q_LORA_RANK + KV_LORA_RANK + QK_ROPE_DIM + 3 * CONV_WIDTH
N_EXPERTS = 32
TOP_K = 4
D_EXPERT = 1024
SWIGLU_ALPHA = 1.702
SWIGLU_LIMIT = 7.0
EXPERT_BLOCK = 128
EPS = 1e-6

kernel_name = "hymba_mla_shortconv_moe_ple"


def rmsnorm(x, g):
    xf = x.astype(jnp.float32)
    y = xf * lax.rsqrt(jnp.mean(xf * xf, axis=-1, keepdims=True) + EPS)
    return (y * g.astype(jnp.float32)).astype(x.dtype)


def apply_rope(x, positions):
    half = QK_ROPE_DIM // 2
    inv_freq = ROPE_THETA ** (-jnp.arange(half, dtype=jnp.float32) / half)
    ang = positions.astype(jnp.float32)[..., None] * inv_freq
    cos = jnp.cos(ang)[:, :, None, :]
    sin = jnp.sin(ang)[:, :, None, :]
    xf = x.astype(jnp.float32)
    x1, x2 = xf[..., :half], xf[..., half:]
    return jnp.concatenate([x1 * cos - x2 * sin, x1 * sin + x2 * cos], axis=-1).astype(x.dtype)


def mla(c_q, c_kv, k_pe, positions, q_norm, w_uq, kv_norm, w_ukv):
    B, S, _ = c_q.shape
    q = (rmsnorm(c_q, q_norm) @ w_uq).reshape(B, S, N_HEADS, QK_NOPE_DIM + QK_ROPE_DIM)
    q_nope, q_pe = q[..., :QK_NOPE_DIM], q[..., QK_NOPE_DIM:]
    q_pe = apply_rope(q_pe, positions)
    kv = (rmsnorm(c_kv, kv_norm) @ w_ukv).reshape(B, S, N_HEADS, QK_NOPE_DIM + V_HEAD_DIM)
    k_nope, v = kv[..., :QK_NOPE_DIM], kv[..., QK_NOPE_DIM:]
    k_pe = apply_rope(k_pe[:, :, None, :], positions)[:, :, 0, :]
    scale = (QK_NOPE_DIM + QK_ROPE_DIM) ** -0.5
    nqb = S // Q_BLOCK
    q_nope_b = q_nope.reshape(B, nqb, Q_BLOCK, N_HEADS, QK_NOPE_DIM).transpose(1, 0, 2, 3, 4)
    q_pe_b = q_pe.reshape(B, nqb, Q_BLOCK, N_HEADS, QK_ROPE_DIM).transpose(1, 0, 2, 3, 4)
    k_pos = jnp.arange(S)

    def q_block(args):
        qn, qp, i = args
        s = (jnp.einsum('bqhd,bkhd->bhqk', qn, k_nope)
             + jnp.einsum('bqhr,bkr->bhqk', qp, k_pe)).astype(jnp.float32) * scale
        q_pos = i * Q_BLOCK + jnp.arange(Q_BLOCK)
        causal = k_pos[None, :] <= q_pos[:, None]
        s = jnp.where(causal, s, -jnp.inf)
        prob = jax.nn.softmax(s, axis=-1).astype(v.dtype)
        return jnp.einsum('bhqk,bkhd->bqhd', prob, v)

    out = lax.map(q_block, (q_nope_b, q_pe_b, jnp.arange(nqb)))
    return out.transpose(1, 0, 2, 3, 4).reshape(B, S, ATTN_WIDTH)


def short_conv(b_gate, c_gate, val, conv_w):
    S = val.shape[1]
    u = c_gate * val
    u_pad = jnp.pad(u, ((0, 0), (CONV_K - 1, 0), (0, 0)))
    y = conv_w[0] * u_pad[:, 0:S]
    for k in range(1, CONV_K):
        y = y + conv_w[k] * u_pad[:, k:k + S]
    return b_gate * y


def clamped_swiglu(h):
    gate, up = h[..., :D_EXPERT], h[..., D_EXPERT:]
    gate = jnp.minimum(gate, SWIGLU_LIMIT)
    up = jnp.clip(up, -SWIGLU_LIMIT, SWIGLU_LIMIT)
    return gate * jax.nn.sigmoid(SWIGLU_ALPHA * gate) * (up + 1)


def moe(x, w_router, b_router, w1, b1, w2, b2):
    B, S, D = x.shape
    N = B * S
    xt = x.reshape(N, D)
    logits = (xt @ w_router + b_router).astype(jnp.float32)
    top_v, top_i = lax.top_k(logits, TOP_K)
    gates = jax.nn.softmax(top_v, axis=-1)
    M = N * TOP_K
    e = top_i.reshape(M)
    tok = jnp.repeat(jnp.arange(N, dtype=jnp.int32), TOP_K)
    g = gates.reshape(M)
    order = jnp.argsort(e)
    e_s, tok_s, g_s = e[order], tok[order], g[order]
    counts = jnp.bincount(e, length=N_EXPERTS)
    starts = jnp.cumsum(counts) - counts
    padded = ((counts + EXPERT_BLOCK - 1) // EXPERT_BLOCK) * EXPERT_BLOCK
    pad_ends = jnp.cumsum(padded)
    pad_starts = pad_ends - padded
    dest = pad_starts[e_s] + jnp.arange(M) - starts[e_s]
    n_blocks = -(-M // EXPERT_BLOCK) + N_EXPERTS
    P = n_blocks * EXPERT_BLOCK
    row_tok = jnp.full((P,), N, dtype=jnp.int32).at[dest].set(tok_s)
    row_gate = jnp.zeros((P,), dtype=jnp.float32).at[dest].set(g_s)
    blk_expert = jnp.clip(jnp.searchsorted(pad_ends, jnp.arange(n_blocks) * EXPERT_BLOCK, side='right'),
                          0, N_EXPERTS - 1)
    x_pad = jnp.concatenate([xt, jnp.zeros((1, D), xt.dtype)], axis=0)

    def expert_block(args):
        rows, eid = args
        xb = x_pad[rows]
        hb = clamped_swiglu(xb @ w1[eid] + b1[eid])
        return hb @ w2[eid] + b2[eid]

    y = lax.map(expert_block, (row_tok.reshape(n_blocks, EXPERT_BLOCK), blk_expert))
    y = y.reshape(P, D) * row_gate[:, None].astype(y.dtype)
    out = jax.ops.segment_sum(y, row_tok, num_segments=N + 1)[:N]
    return out.reshape(B, S, D)


def setup_inputs(seed: int = 0) -> dict:
    key = jax.random.key(seed)
    ks = jax.random.split(key, 32)
    f32 = jnp.float32

    def nrm(k, shape, fan_in):
        return jax.random.normal(k, shape, f32) * (fan_in ** -0.5)

    def gain(k, shape):
        return 1.0 + 0.01 * jax.random.normal(k, shape, f32)

    L = DEPTH
    return {
        "x": jax.random.normal(ks[0], (BATCH, SEQ, D_MODEL), f32),
        "p": jax.random.normal(ks[1], (DEPTH, BATCH, SEQ, PLE_DIM), f32),
        "positions": jnp.broadcast_to(jnp.arange(SEQ, dtype=jnp.int32), (BATCH, SEQ)),
        "mix_norm": gain(ks[2], (L, D_MODEL)),
        "w_in": nrm(ks[3], (L, D_MODEL, IN_PROJ_WIDTH), D_MODEL),
        "q_norm": gain(ks[4], (L, Q_LORA_RANK)),
        "w_uq": nrm(ks[5], (L, Q_LORA_RANK, N_HEADS * (QK_NOPE_DIM + QK_ROPE_DIM)), Q_LORA_RANK),
        "kv_norm": gain(ks[6], (L, KV_LORA_RANK)),
        "w_ukv": nrm(ks[7], (L, KV_LORA_RANK, N_HEADS * (QK_NOPE_DIM + V_HEAD_DIM)), KV_LORA_RANK),
        "conv_w": nrm(ks[8], (L, CONV_K, CONV_WIDTH), CONV_K),
        "attn_out_norm": gain(ks[9], (L, ATTN_WIDTH)),
        "conv_out_norm": gain(ks[10], (L, CONV_WIDTH)),
        "w_o": nrm(ks[11], (L, MIX_WIDTH, D_MODEL), MIX_WIDTH),
        "moe_norm": gain(ks[12], (L, D_MODEL)),
        "w_router": nrm(ks[13], (L, D_MODEL, N_EXPERTS), D_MODEL),
        "b_router": 0.01 * jax.random.normal(ks[14], (L, N_EXPERTS), f32),
        "w1": nrm(ks[15], (L, N_EXPERTS, D_MODEL, 2 * D_EXPERT), D_MODEL),
        "b1": 0.01 * jax.random.normal(ks[16], (L, N_EXPERTS, 2 * D_EXPERT), f32),
        "w2": nrm(ks[17], (L, N_EXPERTS, D_EXPERT, D_MODEL), D_EXPERT),
        "b2": 0.01 * jax.random.normal(ks[18], (L, N_EXPERTS, D_MODEL), f32),
        "ple_norm": gain(ks[19], (L, D_MODEL)),
        "w_ple_gate": nrm(ks[20], (L, D_MODEL, D_MODEL), D_MODEL),
        "w_ple_proj": nrm(ks[21], (L, PLE_DIM, D_MODEL), PLE_DIM),
        "ple_post_norm": gain(ks[22], (L, D_MODEL)),
        "final_norm": gain(ks[23], (D_MODEL,)),
    }


def reference(x, p, positions, mix_norm, w_in, q_norm, w_uq, kv_norm, w_ukv, conv_w,
              attn_out_norm, conv_out_norm, w_o, moe_norm, w_router, b_router, w1, b1, w2, b2,
              ple_norm, w_ple_gate, w_ple_proj, ple_post_norm, final_norm):
    split_pts = list(np.cumsum([Q_LORA_RANK, KV_LORA_RANK, QK_ROPE_DIM, CONV_WIDTH, CONV_WIDTH]))
    h = x
    for i in range(DEPTH):
        z = rmsnorm(h, mix_norm[i]) @ w_in[i]
        c_q, c_kv, k_pe, b_gate, c_gate, val = jnp.split(z, split_pts, axis=-1)
        attn = mla(c_q, c_kv, k_pe, positions, q_norm[i], w_uq[i], kv_norm[i], w_ukv[i])
        conv = short_conv(b_gate, c_gate, val, conv_w[i])
        mixed = jnp.concatenate([rmsnorm(attn, attn_out_norm[i]),
                                 rmsnorm(conv, conv_out_norm[i])], axis=-1)
        h = h + mixed @ w_o[i]
        h = h + moe(rmsnorm(h, moe_norm[i]), w_router[i], b_router[i], w1[i], b1[i], w2[i], b2[i])
        gate = jax.nn.sigmoid(rmsnorm(h, ple_norm[i]) @ w_ple_gate[i])
        ple = rmsnorm(p[i] @ w_ple_proj[i], ple_post_norm[i])
        h = h + gate * ple
    return rmsnorm(h, final_norm)
```

```cpp
#include <hip/hip_runtime.h>
#include <cstdint>
#include <cstdio>
#include <cmath>

typedef unsigned short bf16_t;

constexpr int NB = 8, SEQ = 4096, DM = 1024, NTOK = NB * SEQ;
constexpr int PLE = 256, NH = 4, DN = 128, DR = 64, DV = 128, QL = 256, KVL = 128, DQK = DN + DR;
constexpr int INW = 1984, INWP = 2048;
constexpr int NE = 32, TOPK = 4, DE = 1024;
constexpr int MROWS = NTOK * TOPK;
constexpr int MAXTILES = MROWS / 256 + NE;
constexpr int PROWS = MAXTILES * 256;
constexpr float EPS = 1e-6f;
constexpr float QSCALE = 0.07216878364870322f * 1.4426950408889634f;

constexpr size_t MiB = 1u << 20;
constexpr size_t WS_CTL = 0;
constexpr size_t WS_WIN = 1 * MiB, WS_WUQ = 5 * MiB, WS_WUKV = 5 * MiB + 512 * 1024, WS_WO = 6 * MiB, WS_WG = 8 * MiB, WS_WP = 10 * MiB;
constexpr size_t WS_WR = 10 * MiB + 512 * 1024;
constexpr size_t WS_CS = 11 * MiB;
constexpr size_t WS_SSQ = 19 * MiB, WS_ASSQ = 20 * MiB, WS_PSSQ = 21 * MiB, WS_FSSQ = 23 * MiB;
constexpr size_t WS_TOPI = 25 * MiB, WS_TOPG = 25 * MiB + 512 * 1024;
constexpr size_t WS_ROWTOK = 26 * MiB, WS_ROWSLOT = 27 * MiB, WS_ROWGATE = 28 * MiB;
constexpr size_t WS_P16 = 29 * MiB;
constexpr size_t WS_W1 = 48 * MiB, WS_W2 = 176 * MiB, WS_XN = 240 * MiB, WS_MIX = 304 * MiB, WS_PLER = 368 * MiB;
constexpr size_t WS_Z = 432 * MiB, WS_Q = 560 * MiB, WS_K = 608 * MiB, WS_V = 656 * MiB;
constexpr size_t WS_HB = 432 * MiB;
constexpr size_t WS_Y = 704 * MiB;
constexpr size_t WS_END = WS_Y + (size_t)(MROWS + 256) * DM * 2;
constexpr int CW_CNT = 0, CW_CURSOR = 64, CW_PADSTART = 128, CW_NTILES = 192, CW_TILE_E = 256;

__device__ __forceinline__ float bf2f(bf16_t v) { return __uint_as_float((unsigned)v << 16); }
__device__ __forceinline__ float blo(unsigned u) { return __uint_as_float(u << 16); }
__device__ __forceinline__ float bhi(unsigned u) { return __uint_as_float(u & 0xffff0000u); }
__device__ __forceinline__ bf16_t f2bf(float f) { unsigned u = __float_as_uint(f); return (bf16_t)((u + 0x7fffu + ((u >> 16) & 1u)) >> 16); }
__device__ __forceinline__ unsigned pk2(float lo, float hi) { return (unsigned)f2bf(lo) | ((unsigned)f2bf(hi) << 16); }
__device__ __forceinline__ float wave_sum(float v) {
#pragma unroll
    for (int o = 1; o < 64; o <<= 1) v += __shfl_xor(v, o);
    return v;
}
__device__ __forceinline__ float wave_max(float v) {
#pragma unroll
    for (int o = 1; o < 64; o <<= 1) v = fmaxf(v, __shfl_xor(v, o));
    return v;
}
__device__ __forceinline__ float dot8(uint4 x, uint4 y) {
    return blo(x.x) * blo(y.x) + bhi(x.x) * bhi(y.x) + blo(x.y) * blo(y.y) + bhi(x.y) * bhi(y.y) +
           blo(x.z) * blo(y.z) + bhi(x.z) * bhi(y.z) + blo(x.w) * blo(y.w) + bhi(x.w) * bhi(y.w);
}
__device__ __forceinline__ float dot_bf16(const bf16_t* a, const bf16_t* b, int K) {
    const uint4* a4 = (const uint4*)a; const uint4* b4 = (const uint4*)b; float acc = 0.f;
    for (int i = 0; i < K / 8; ++i) acc += dot8(a4[i], b4[i]);
    return acc;
}

template <int MODE>
__global__ void k_prep_wt(const float* __restrict__ src, bf16_t* __restrict__ dst, int K, int Nrows, int ldsrc, int nvalid,
                          const float* __restrict__ gain, const float* __restrict__ gain2, float scale) {
    const size_t idx = (size_t)blockIdx.x * 256 + threadIdx.x; if (idx >= (size_t)Nrows * K) return;
    const int n = (int)(idx / K), k = (int)(idx % K);
    src += (size_t)blockIdx.y * K * ldsrc; dst += (size_t)blockIdx.y * Nrows * K;
    int c = n;
    if (MODE == 1) { const int pn = n >> 8, half = (n >> 7) & 1, jj = n & 127; c = half * 1024 + pn * 128 + jj; }
    float v = 0.f;
    if (c < nvalid) { float g = 1.f; if (gain) g = (gain2 && k >= 512) ? gain2[k - 512] : gain[k]; v = src[(size_t)k * ldsrc + c] * g * scale; }
    dst[idx] = f2bf(v);
}
__global__ void k_prep_wr(const float* __restrict__ wr, const float* __restrict__ g, float* __restrict__ dst) {
    const int idx = blockIdx.x * 256 + threadIdx.x; if (idx >= DM * NE) return; dst[idx] = wr[idx] * g[idx / NE];
}
__global__ void k_prep_cs(const int* __restrict__ pos, float* __restrict__ cs) {
    const int idx = blockIdx.x * 256 + threadIdx.x; if (idx >= NTOK * 32) return; const int t = idx >> 5, i = idx & 31;
    const float inv = powf(10000.f, -(float)i / 32.f); const float a = (float)pos[t] * inv; float s, c; sincosf(a, &s, &c);
    cs[(size_t)t * 64 + i] = c; cs[(size_t)t * 64 + 32 + i] = s;
}
__global__ void k_cvt_bf16(const float* __restrict__ src, bf16_t* __restrict__ dst, size_t n) {
    const size_t idx = (size_t)blockIdx.x * 256 + threadIdx.x; if (idx < n) dst[idx] = f2bf(src[idx]);
}
__global__ void k_rmsnorm_bf16(const float* __restrict__ src, bf16_t* __restrict__ dst) {
    const int row = blockIdx.x * 4 + (threadIdx.x >> 6), lane = threadIdx.x & 63;
    const float4* s = (const float4*)(src + (size_t)row * DM); float4 v[4]; float ss = 0.f;
#pragma unroll
    for (int j = 0; j < 4; ++j) { v[j] = s[lane + 64 * j]; ss += v[j].x * v[j].x + v[j].y * v[j].y + v[j].z * v[j].z + v[j].w * v[j].w; }
    const float rstd = rsqrtf(wave_sum(ss) * (1.f / DM) + EPS);
    uint2* d = (uint2*)(dst + (size_t)row * DM);
#pragma unroll
    for (int j = 0; j < 4; ++j) d[lane + 64 * j] = make_uint2(pk2(v[j].x * rstd, v[j].y * rstd), pk2(v[j].z * rstd, v[j].w * rstd));
}

__global__ void k_inproj(const bf16_t* __restrict__ XN, const bf16_t* __restrict__ WT, bf16_t* __restrict__ Z) {
    const size_t idx = (size_t)blockIdx.x * 256 + threadIdx.x; const int row = (int)(idx / INWP), col = (int)(idx % INWP);
    Z[idx] = f2bf(dot_bf16(XN + (size_t)row * DM, WT + (size_t)col * DM, DM));
}
__global__ void k_zstats(const bf16_t* __restrict__ Z, float* __restrict__ SSQ) {
    const int row = blockIdx.x * 4 + (threadIdx.x >> 6), lane = threadIdx.x & 63; const bf16_t* z = Z + (size_t)row * INWP;
    float q = 0.f, kv = 0.f;
    for (int c = lane; c < 256; c += 64) { const float v = bf2f(z[c]); q += v * v; }
    for (int c = 256 + lane; c < 384; c += 64) { const float v = bf2f(z[c]); kv += v * v; }
    q = wave_sum(q); kv = wave_sum(kv);
    if (lane < 8) SSQ[(size_t)row * 8 + lane] = lane == 0 ? q : (lane == 4 ? kv : 0.f);
}
__global__ void k_pleraw(const bf16_t* __restrict__ P16, const bf16_t* __restrict__ WT, bf16_t* __restrict__ PLER) {
    const size_t idx = (size_t)blockIdx.x * 256 + threadIdx.x; const int row = (int)(idx / DM), col = (int)(idx % DM);
    PLER[idx] = f2bf(dot_bf16(P16 + (size_t)row * PLE, WT + (size_t)col * PLE, PLE));
}
__global__ void k_rowssq16(const bf16_t* __restrict__ X, float* __restrict__ out) {
    const int row = blockIdx.x * 4 + (threadIdx.x >> 6), lane = threadIdx.x & 63; float s = 0.f;
    for (int c = lane; c < DM; c += 64) { const float v = bf2f(X[(size_t)row * DM + c]); s += v * v; }
    s = wave_sum(s); if (lane < 16) out[(size_t)row * 16 + lane] = lane == 0 ? s : 0.f;
}
__device__ __forceinline__ float rstd4(const float* p, float n) { return rsqrtf((p[0] + p[1] + p[2] + p[3]) / n + EPS); }
__global__ void k_qup(const bf16_t* __restrict__ Z, const bf16_t* __restrict__ WT, const float* __restrict__ SSQ, const float* __restrict__ CS, bf16_t* __restrict__ Q) {
    const size_t idx = (size_t)blockIdx.x * 256 + threadIdx.x; const int row = (int)(idx / (NH * 160)), r = (int)(idx % (NH * 160)), h = r / 160, j = r % 160;
    const float rs = rstd4(SSQ + (size_t)row * 8, (float)QL); const bf16_t* a = Z + (size_t)row * INWP;
    const int b = row / SEQ, s = row % SEQ; bf16_t* q = Q + ((size_t)(b * NH + h) * SEQ + s) * DQK;
    if (j < 128) { q[j] = f2bf(rs * dot_bf16(a, WT + (size_t)(h * DQK + j) * QL, QL)); }
    else { const int i = j - 128; const float x1 = rs * dot_bf16(a, WT + (size_t)(h * DQK + 128 + i) * QL, QL), x2 = rs * dot_bf16(a, WT + (size_t)(h * DQK + 160 + i) * QL, QL);
        const float c = CS[(size_t)row * 64 + i], sn = CS[(size_t)row * 64 + 32 + i];
        q[128 + i] = f2bf(x1 * c - x2 * sn); q[160 + i] = f2bf(x1 * sn + x2 * c); }
}
__global__ void k_kvup(const bf16_t* __restrict__ Z, const bf16_t* __restrict__ WT, const float* __restrict__ SSQ, bf16_t* __restrict__ K, bf16_t* __restrict__ V) {
    const size_t idx = (size_t)blockIdx.x * 256 + threadIdx.x; const int row = (int)(idx / 1024), col = (int)(idx % 1024), h = col >> 8, d = col & 255;
    const float rs = rstd4(SSQ + (size_t)row * 8 + 4, (float)KVL);
    const float v = rs * dot_bf16(Z + (size_t)row * INWP + 256, WT + (size_t)col * KVL, KVL);
    const int b = row / SEQ, s = row % SEQ; const size_t t = (size_t)(b * NH + h) * SEQ + s;
    if (d < 128) K[t * DQK + d] = f2bf(v); else V[t * DV + d - 128] = f2bf(v);
}
__global__ void k_kpe(const bf16_t* __restrict__ Z, const float* __restrict__ CS, bf16_t* __restrict__ K) {
    const int idx = blockIdx.x * 256 + threadIdx.x; const int row = idx >> 5, i = idx & 31;
    const float x1 = bf2f(Z[(size_t)row * INWP + 384 + i]), x2 = bf2f(Z[(size_t)row * INWP + 416 + i]);
    const float c = CS[(size_t)row * 64 + i], sn = CS[(size_t)row * 64 + 32 + i];
    const bf16_t o1 = f2bf(x1 * c - x2 * sn), o2 = f2bf(x1 * sn + x2 * c); const int b = row / SEQ, s = row % SEQ;
    for (int h = 0; h < NH; ++h) { bf16_t* k = K + ((size_t)(b * NH + h) * SEQ + s) * DQK; k[128 + i] = o1; k[160 + i] = o2; }
}
__global__ void k_conv(const bf16_t* __restrict__ Z, const float* __restrict__ cw, bf16_t* __restrict__ MIX) {
    const int row = blockIdx.x * 4 + (threadIdx.x >> 6), lane = threadIdx.x & 63, s = row % SEQ; const bf16_t* z = Z + (size_t)row * INWP;
    float y[8]; float ss = 0.f;
#pragma unroll
    for (int j = 0; j < 8; ++j) { const int c = lane + 64 * j;
        const float u0 = bf2f(z[960 + c]) * bf2f(z[1472 + c]);
        const float u1 = s >= 1 ? bf2f(z[960 + c - INWP]) * bf2f(z[1472 + c - INWP]) : 0.f;
        const float u2 = s >= 2 ? bf2f(z[960 + c - 2 * INWP]) * bf2f(z[1472 + c - 2 * INWP]) : 0.f;
        const float v = bf2f(z[448 + c]) * (cw[c] * u2 + cw[512 + c] * u1 + cw[1024 + c] * u0);
        y[j] = v; ss += v * v; }
    const float rstd = rsqrtf(wave_sum(ss) * (1.f / 512.f) + EPS);
#pragma unroll
    for (int j = 0; j < 8; ++j) MIX[(size_t)row * DM + 512 + lane + 64 * j] = f2bf(y[j] * rstd);
}
__global__ void k_attn_naive(const bf16_t* __restrict__ Q, const bf16_t* __restrict__ K, const bf16_t* __restrict__ V, bf16_t* __restrict__ MIX, float* __restrict__ ASSQ) {
    __shared__ float qs[4][DQK];
    const int wid = threadIdx.x >> 6, lane = threadIdx.x & 63; const int gw = blockIdx.x * 4 + wid; const int i = gw % SEQ, bh = gw / SEQ;
    const bf16_t* q = Q + (size_t)gw * DQK;
    for (int d = lane; d < DQK; d += 64) qs[wid][d] = bf2f(q[d]);
    __syncthreads();
    const bf16_t* Kb = K + (size_t)bh * SEQ * DQK; const bf16_t* Vb = V + (size_t)bh * SEQ * DV;
    float m = -1e30f, l = 0.f, o0 = 0.f, o1 = 0.f;
    for (int j0 = 0; j0 <= i; j0 += 64) {
        const int j = j0 + lane; const bool valid = j <= i; float sc = -INFINITY;
        if (valid) { const uint4* kr = (const uint4*)(Kb + (size_t)j * DQK); float acc = 0.f;
            for (int c = 0; c < 24; ++c) { const uint4 kv = kr[c]; const float* qq = &qs[wid][c * 8];
                acc += blo(kv.x) * qq[0] + bhi(kv.x) * qq[1] + blo(kv.y) * qq[2] + bhi(kv.y) * qq[3] + blo(kv.z) * qq[4] + bhi(kv.z) * qq[5] + blo(kv.w) * qq[6] + bhi(kv.w) * qq[7]; }
            sc = acc; }
        const float mnew = fmaxf(m, wave_max(sc)); const float alpha = exp2f(m - mnew); const float p = valid ? exp2f(sc - mnew) : 0.f;
        l = l * alpha + wave_sum(p); o0 *= alpha; o1 *= alpha; m = mnew;
        const int nj = (i - j0 + 1) < 64 ? (i - j0 + 1) : 64;
        for (int jj = 0; jj < nj; ++jj) { const float pj = __shfl(p, jj); const unsigned vv = *(const unsigned*)(Vb + (size_t)(j0 + jj) * DV + 2 * lane); o0 += pj * blo(vv); o1 += pj * bhi(vv); }
    }
    const float inv = 1.f / l; o0 *= inv; o1 *= inv;
    const int b = bh / NH, h = bh % NH; const size_t row = (size_t)b * SEQ + i;
    *(unsigned*)(MIX + row * DM + h * DV + 2 * lane) = pk2(o0, o1);
    const float ss = wave_sum(o0 * o0 + o1 * o1); if (lane == 0) ASSQ[row * 4 + h] = ss;
}
__global__ void k_wo(const bf16_t* __restrict__ MIX, const bf16_t* __restrict__ WT, const float* __restrict__ ASSQ, const float* __restrict__ x, float* __restrict__ H) {
    const size_t idx = (size_t)blockIdx.x * 256 + threadIdx.x; const int row = (int)(idx / DM), col = (int)(idx % DM);
    const float ra = rstd4(ASSQ + (size_t)row * 4, 512.f);
    const float a = dot_bf16(MIX + (size_t)row * DM, WT + (size_t)col * DM, 512) * ra + dot_bf16(MIX + (size_t)row * DM + 512, WT + (size_t)col * DM + 512, 512);
    H[idx] = x[idx] + a;
}
__global__ void k_router(const float* __restrict__ H, const float* __restrict__ WR, const float* __restrict__ br, bf16_t* __restrict__ XN, int* __restrict__ TOPI, float* __restrict__ TOPG, int* __restrict__ CNT) {
    __shared__ float lg[4][NE];
    const int wid = threadIdx.x >> 6, lane = threadIdx.x & 63, row = blockIdx.x * 4 + wid; const float* h = H + (size_t)row * DM;
    const float4* s = (const float4*)h; float4 v[4]; float ss = 0.f;
#pragma unroll
    for (int j = 0; j < 4; ++j) { v[j] = s[lane + 64 * j]; ss += v[j].x * v[j].x + v[j].y * v[j].y + v[j].z * v[j].z + v[j].w * v[j].w; }
    const float rstd = rsqrtf(wave_sum(ss) * (1.f / DM) + EPS);
    uint2* d = (uint2*)(XN + (size_t)row * DM);
#pragma unroll
    for (int j = 0; j < 4; ++j) d[lane + 64 * j] = make_uint2(pk2(v[j].x * rstd, v[j].y * rstd), pk2(v[j].z * rstd, v[j].w * rstd));
    const int e = lane & 31, half = lane >> 5; float acc = 0.f;
    for (int k = half * 512; k < half * 512 + 512; ++k) acc += h[k] * WR[k * NE + e];
    acc += __shfl_xor(acc, 32); acc = acc * rstd + br[e];
    if (lane < 32) lg[wid][lane] = acc;
    __syncthreads();
    if (lane == 0) { float lv[4]; int li[4]; unsigned used = 0u;
        for (int t = 0; t < 4; ++t) { float best = -INFINITY; int bi = 0; for (int q = 0; q < NE; ++q) { const float x = lg[wid][q]; if (!((used >> q) & 1u) && x > best) { best = x; bi = q; } } used |= 1u << bi; lv[t] = best; li[t] = bi; }
        float den = 0.f, ex[4]; for (int t = 0; t < 4; ++t) { ex[t] = expf(lv[t] - lv[0]); den += ex[t]; }
        for (int t = 0; t < 4; ++t) { TOPI[row * 4 + t] = li[t]; TOPG[row * 4 + t] = ex[t] / den; atomicAdd(&CNT[li[t]], 1); } }
}
__global__ void k_route_plan(int* __restrict__ ctl) {
    if (threadIdx.x != 0 || blockIdx.x != 0) return; int ps = 0, nt = 0;
    for (int e = 0; e < NE; ++e) { ctl[CW_PADSTART + e] = ps; const int t = (ctl[CW_CNT + e] + 255) / 256; for (int q = 0; q < t; ++q) ctl[CW_TILE_E + nt + q] = e; nt += t; ps += t * 256; }
    ctl[CW_PADSTART + NE] = ps; ctl[CW_NTILES] = nt;
}
__global__ void k_route_assign(const int* __restrict__ TOPI, const float* __restrict__ TOPG, int* __restrict__ ctl, int* __restrict__ ROWTOK, int* __restrict__ ROWSLOT, float* __restrict__ ROWGATE) {
    const int idx = blockIdx.x * 256 + threadIdx.x; if (idx >= MROWS) return; const int e = TOPI[idx];
    const int dest = ctl[CW_PADSTART + e] + atomicAdd(&ctl[CW_CURSOR + e], 1);
    ROWTOK[dest] = idx >> 2; ROWSLOT[dest] = idx; ROWGATE[dest] = TOPG[idx];
}
__global__ void k_route_fill(const int* __restrict__ ctl, int* __restrict__ ROWTOK, int* __restrict__ ROWSLOT, float* __restrict__ ROWGATE) {
    const int e = blockIdx.x; const int lo = ctl[CW_PADSTART + e] + ctl[CW_CNT + e], hi = ctl[CW_PADSTART + e + 1];
    for (int r = lo + threadIdx.x; r < hi; r += 256) { ROWTOK[r] = 0; ROWSLOT[r] = MROWS; ROWGATE[r] = 0.f; }
}
__device__ __forceinline__ float swiglu(float g, float u) { g = fminf(g, 7.f); u = fminf(fmaxf(u, -7.f), 7.f); return g / (1.f + expf(-1.702f * g)) * (u + 1.f); }
__global__ void k_moe1(const bf16_t* __restrict__ XN, const bf16_t* __restrict__ W1T, const float* __restrict__ b1, const int* __restrict__ ctl, const int* __restrict__ ROWTOK, bf16_t* __restrict__ HB) {
    const size_t idx = (size_t)blockIdx.x * 256 + threadIdx.x; const int r = (int)(idx / DE), j = (int)(idx % DE);
    if (r >= ctl[CW_NTILES] * 256) return; const int e = ctl[CW_TILE_E + (r >> 8)];
    const bf16_t* a = XN + (size_t)ROWTOK[r] * DM; const bf16_t* w = W1T + (size_t)e * 2048 * DM; const int rg = (j >> 7) * 256 + (j & 127);
    const float g = dot_bf16(a, w + (size_t)rg * DM, DM) + b1[e * 2048 + j], u = dot_bf16(a, w + (size_t)(rg + 128) * DM, DM) + b1[e * 2048 + 1024 + j];
    HB[idx] = f2bf(swiglu(g, u));
}
__global__ void k_moe2(const bf16_t* __restrict__ HB, const bf16_t* __restrict__ W2T, const float* __restrict__ b2, const int* __restrict__ ctl, const int* __restrict__ ROWSLOT, const float* __restrict__ ROWGATE, bf16_t* __restrict__ Y) {
    const size_t idx = (size_t)blockIdx.x * 256 + threadIdx.x; const int r = (int)(idx / DM), c = (int)(idx % DM);
    if (r >= ctl[CW_NTILES] * 256) return; const int e = ctl[CW_TILE_E + (r >> 8)];
    const float v = (dot_bf16(HB + (size_t)r * DE, W2T + ((size_t)e * DM + c) * DE, DE) + b2[e * DM + c]) * ROWGATE[r];
    Y[(size_t)ROWSLOT[r] * DM + c] = f2bf(v);
}
__global__ void k_combine(float* __restrict__ H, const bf16_t* __restrict__ Y, bf16_t* __restrict__ XN) {
    const int row = blockIdx.x * 4 + (threadIdx.x >> 6), lane = threadIdx.x & 63; float4* hp = (float4*)(H + (size_t)row * DM); float4 v[4]; float ss = 0.f;
#pragma unroll
    for (int j = 0; j < 4; ++j) { v[j] = hp[lane + 64 * j];
        for (int k = 0; k < 4; ++k) { const uint2 y = *(const uint2*)(Y + ((size_t)row * 4 + k) * DM + 4 * (lane + 64 * j)); v[j].x += blo(y.x); v[j].y += bhi(y.x); v[j].z += blo(y.y); v[j].w += bhi(y.y); }
        hp[lane + 64 * j] = v[j]; ss += v[j].x * v[j].x + v[j].y * v[j].y + v[j].z * v[j].z + v[j].w * v[j].w; }
    const float rstd = rsqrtf(wave_sum(ss) * (1.f / DM) + EPS);
    uint2* d = (uint2*)(XN + (size_t)row * DM);
#pragma unroll
    for (int j = 0; j < 4; ++j) d[lane + 64 * j] = make_uint2(pk2(v[j].x * rstd, v[j].y * rstd), pk2(v[j].z * rstd, v[j].w * rstd));
}
__global__ void k_plegate(const bf16_t* __restrict__ XN, const bf16_t* __restrict__ WGT, const bf16_t* __restrict__ PLER, const float* __restrict__ PSSQ, const float* __restrict__ pg, float* __restrict__ H) {
    const size_t idx = (size_t)blockIdx.x * 256 + threadIdx.x; const int row = (int)(idx / DM), col = (int)(idx % DM);
    const float a = dot_bf16(XN + (size_t)row * DM, WGT + (size_t)col * DM, DM); const float g = 1.f / (1.f + expf(-a));
    float s = 0.f; for (int t = 0; t < 16; ++t) s += PSSQ[(size_t)row * 16 + t]; const float rp = rsqrtf(s * (1.f / DM) + EPS);
    H[idx] = H[idx] + g * bf2f(PLER[idx]) * rp * pg[col];
}
__global__ void k_final(float* __restrict__ H, const float* __restrict__ g) {
    const int row = blockIdx.x * 4 + (threadIdx.x >> 6), lane = threadIdx.x & 63; float4* hp = (float4*)(H + (size_t)row * DM); const float4* gp = (const float4*)g; float4 v[4]; float ss = 0.f;
#pragma unroll
    for (int j = 0; j < 4; ++j) { v[j] = hp[lane + 64 * j]; ss += v[j].x * v[j].x + v[j].y * v[j].y + v[j].z * v[j].z + v[j].w * v[j].w; }
    const float rstd = rsqrtf(wave_sum(ss) * (1.f / DM) + EPS);
#pragma unroll
    for (int j = 0; j < 4; ++j) { const float4 gg = gp[lane + 64 * j]; hp[lane + 64 * j] = make_float4(v[j].x * rstd * gg.x, v[j].y * rstd * gg.y, v[j].z * rstd * gg.z, v[j].w * rstd * gg.w); }
}

extern "C" void kernel_launch(void* const* d_in, const int* in_sizes, int n_in, void* d_out, int out_size, void* d_ws, size_t ws_size, hipStream_t stream) {
    if (n_in != 25 || in_sizes[0] != NTOK * DM || out_size != NTOK * DM || ws_size < WS_END) {
        fprintf(stderr, "kernel_launch: unexpected shapes (n_in %d, in0 %d, out %d, ws %zu need %zu)\n", n_in, n_in > 0 ? in_sizes[0] : -1, out_size, ws_size, (size_t)WS_END); return; }
    const float* x = (const float*)d_in[0]; const float* p = (const float*)d_in[1]; const int* pos = (const int*)d_in[2];
    const float *mix_norm = (const float*)d_in[3], *w_in = (const float*)d_in[4], *q_norm = (const float*)d_in[5], *w_uq = (const float*)d_in[6], *kv_norm = (const float*)d_in[7],
                *w_ukv = (const float*)d_in[8], *conv_w = (const float*)d_in[9], *attn_out_norm = (const float*)d_in[10], *conv_out_norm = (const float*)d_in[11], *w_o = (const float*)d_in[12],
                *moe_norm = (const float*)d_in[13], *w_router = (const float*)d_in[14], *b_router = (const float*)d_in[15], *w1 = (const float*)d_in[16], *b1 = (const float*)d_in[17],
                *w2 = (const float*)d_in[18], *b2 = (const float*)d_in[19], *ple_norm = (const float*)d_in[20], *w_ple_gate = (const float*)d_in[21], *w_ple_proj = (const float*)d_in[22],
                *ple_post_norm = (const float*)d_in[23], *final_norm = (const float*)d_in[24];
    unsigned char* ws = (unsigned char*)d_ws; float* H = (float*)d_out;
    int* ctl = (int*)(ws + WS_CTL);
    bf16_t *WIN = (bf16_t*)(ws + WS_WIN), *WUQ = (bf16_t*)(ws + WS_WUQ), *WUKV = (bf16_t*)(ws + WS_WUKV), *WO = (bf16_t*)(ws + WS_WO), *WG = (bf16_t*)(ws + WS_WG), *WP = (bf16_t*)(ws + WS_WP);
    bf16_t *W1T = (bf16_t*)(ws + WS_W1), *W2T = (bf16_t*)(ws + WS_W2), *XN = (bf16_t*)(ws + WS_XN), *MIX = (bf16_t*)(ws + WS_MIX), *PLER = (bf16_t*)(ws + WS_PLER);
    bf16_t *Z = (bf16_t*)(ws + WS_Z), *Q = (bf16_t*)(ws + WS_Q), *K = (bf16_t*)(ws + WS_K), *V = (bf16_t*)(ws + WS_V), *HB = (bf16_t*)(ws + WS_HB), *Y = (bf16_t*)(ws + WS_Y), *P16 = (bf16_t*)(ws + WS_P16);
    float *WR = (float*)(ws + WS_WR), *CS = (float*)(ws + WS_CS), *SSQ = (float*)(ws + WS_SSQ), *ASSQ = (float*)(ws + WS_ASSQ), *PSSQ = (float*)(ws + WS_PSSQ);
    int *TOPI = (int*)(ws + WS_TOPI), *ROWTOK = (int*)(ws + WS_ROWTOK), *ROWSLOT = (int*)(ws + WS_ROWSLOT); float *TOPG = (float*)(ws + WS_TOPG), *ROWGATE = (float*)(ws + WS_ROWGATE);
    (void)hipMemsetAsync(ws + WS_CTL, 0, 1 * MiB, stream);
#define GRID1(n) dim3((unsigned)(((size_t)(n) + 255) / 256))
    k_prep_wt<0><<<GRID1((size_t)INWP * DM), 256, 0, stream>>>(w_in, WIN, DM, INWP, INW, INW, mix_norm, nullptr, 1.f);
    k_prep_wt<0><<<GRID1((size_t)768 * QL), 256, 0, stream>>>(w_uq, WUQ, QL, 768, 768, 768, q_norm, nullptr, QSCALE);
    k_prep_wt<0><<<GRID1((size_t)1024 * KVL), 256, 0, stream>>>(w_ukv, WUKV, KVL, 1024, 1024, 1024, kv_norm, nullptr, 1.f);
    k_prep_wt<0><<<GRID1((size_t)DM * DM), 256, 0, stream>>>(w_o, WO, DM, DM, DM, DM, attn_out_norm, conv_out_norm, 1.f);
    k_prep_wt<0><<<GRID1((size_t)DM * DM), 256, 0, stream>>>(w_ple_gate, WG, DM, DM, DM, DM, ple_norm, nullptr, 1.f);
    k_prep_wt<0><<<GRID1((size_t)DM * PLE), 256, 0, stream>>>(w_ple_proj, WP, PLE, DM, DM, DM, nullptr, nullptr, 1.f);
    { dim3 g = GRID1((size_t)2048 * DM); g.y = NE; k_prep_wt<1><<<g, 256, 0, stream>>>(w1, W1T, DM, 2048, 2048, 2048, moe_norm, nullptr, 1.f); }
    { dim3 g = GRID1((size_t)DM * DE); g.y = NE; k_prep_wt<0><<<g, 256, 0, stream>>>(w2, W2T, DE, DM, DM, DM, nullptr, nullptr, 1.f); }
    k_prep_wr<<<GRID1(DM * NE), 256, 0, stream>>>(w_router, moe_norm, WR);
    k_prep_cs<<<GRID1(NTOK * 32), 256, 0, stream>>>(pos, CS);
    k_cvt_bf16<<<GRID1((size_t)NTOK * PLE), 256, 0, stream>>>(p, P16, (size_t)NTOK * PLE);
    k_rmsnorm_bf16<<<NTOK / 4, 256, 0, stream>>>(x, XN);
    k_inproj<<<GRID1((size_t)NTOK * INWP), 256, 0, stream>>>(XN, WIN, Z);
    k_zstats<<<NTOK / 4, 256, 0, stream>>>(Z, SSQ);
    k_pleraw<<<GRID1((size_t)NTOK * DM), 256, 0, stream>>>(P16, WP, PLER);
    k_rowssq16<<<NTOK / 4, 256, 0, stream>>>(PLER, PSSQ);
    k_qup<<<GRID1((size_t)NTOK * NH * 160), 256, 0, stream>>>(Z, WUQ, SSQ, CS, Q);
    k_kvup<<<GRID1((size_t)NTOK * 1024), 256, 0, stream>>>(Z, WUKV, SSQ, K, V);
    k_kpe<<<GRID1(NTOK * 32), 256, 0, stream>>>(Z, CS, K);
    k_conv<<<NTOK / 4, 256, 0, stream>>>(Z, conv_w, MIX);
    k_attn_naive<<<NB * NH * SEQ / 4, 256, 0, stream>>>(Q, K, V, MIX, ASSQ);
    k_wo<<<GRID1((size_t)NTOK * DM), 256, 0, stream>>>(MIX, WO, ASSQ, x, H);
    k_router<<<NTOK / 4, 256, 0, stream>>>(H, WR, b_router, XN, TOPI, TOPG, ctl + CW_CNT);
    k_route_plan<<<1, 64, 0, stream>>>(ctl);
    k_route_assign<<<GRID1(MROWS), 256, 0, stream>>>(TOPI, TOPG, ctl, ROWTOK, ROWSLOT, ROWGATE);
    k_route_fill<<<NE, 256, 0, stream>>>(ctl, ROWTOK, ROWSLOT, ROWGATE);
    k_moe1<<<GRID1((size_t)PROWS * DE), 256, 0, stream>>>(XN, W1T, b1, ctl, ROWTOK, HB);
    k_moe2<<<GRID1((size_t)PROWS * DM), 256, 0, stream>>>(HB, W2T, b2, ctl, ROWSLOT, ROWGATE, Y);
    k_combine<<<NTOK / 4, 256, 0, stream>>>(H, Y, XN);
    k_plegate<<<GRID1((size_t)NTOK * DM), 256, 0, stream>>>(XN, WG, PLER, PSSQ, ple_post_norm, H);
    k_final<<<NTOK / 4, 256, 0, stream>>>(H, final_norm);
#undef GRID1
}
```

```cpp
#include <hip/hip_runtime.h>
#include <cstdint>
#include <cstdio>
#include <cmath>

typedef unsigned short bf16_t;

constexpr int NB = 8, SEQ = 4096, DM = 1024, NTOK = NB * SEQ;
constexpr int PLE = 256, NH = 4, DN = 128, DR = 64, DV = 128, QL = 256, KVL = 128, DQK = DN + DR;
constexpr int INW = 1984, INWP = 2048;
constexpr int NE = 32, TOPK = 4, DE = 1024;
constexpr int MROWS = NTOK * TOPK;
constexpr int MAXTILES = MROWS / 256 + NE;
constexpr int PROWS = MAXTILES * 256;
constexpr float EPS = 1e-6f;
constexpr float QSCALE = 0.07216878364870322f * 1.4426950408889634f;

constexpr size_t MiB = 1u << 20;
constexpr size_t WS_CTL = 0;
constexpr size_t WS_WIN = 1 * MiB, WS_WUQ = 5 * MiB, WS_WUKV = 5 * MiB + 512 * 1024, WS_WO = 6 * MiB, WS_WG = 8 * MiB, WS_WP = 10 * MiB;
constexpr size_t WS_WR = 10 * MiB + 512 * 1024;
constexpr size_t WS_CS = 11 * MiB;
constexpr size_t WS_SSQ = 19 * MiB, WS_ASSQ = 20 * MiB, WS_PSSQ = 21 * MiB, WS_FSSQ = 23 * MiB;
constexpr size_t WS_TOPI = 25 * MiB, WS_TOPG = 25 * MiB + 512 * 1024;
constexpr size_t WS_ROWTOK = 26 * MiB, WS_ROWSLOT = 27 * MiB, WS_ROWGATE = 28 * MiB;
constexpr size_t WS_P16 = 29 * MiB;
constexpr size_t WS_W1 = 48 * MiB, WS_W2 = 176 * MiB, WS_XN = 240 * MiB, WS_MIX = 304 * MiB, WS_PLER = 368 * MiB;
constexpr size_t WS_Z = 432 * MiB, WS_Q = 560 * MiB, WS_K = 608 * MiB, WS_V = 656 * MiB;
constexpr size_t WS_HB = 432 * MiB;
constexpr size_t WS_Y = 704 * MiB;
constexpr size_t WS_END = WS_Y + (size_t)(MROWS + 256) * DM * 2;
constexpr int CW_CNT = 0, CW_CURSOR = 64, CW_PADSTART = 128, CW_NTILES = 192, CW_TILE_E = 256;

__device__ __forceinline__ float bf2f(bf16_t v) { return __uint_as_float((unsigned)v << 16); }
__device__ __forceinline__ float blo(unsigned u) { return __uint_as_float(u << 16); }
__device__ __forceinline__ float bhi(unsigned u) { return __uint_as_float(u & 0xffff0000u); }
__device__ __forceinline__ bf16_t f2bf(float f) { unsigned u = __float_as_uint(f); return (bf16_t)((u + 0x7fffu + ((u >> 16) & 1u)) >> 16); }
__device__ __forceinline__ unsigned pk2(float lo, float hi) { return (unsigned)f2bf(lo) | ((unsigned)f2bf(hi) << 16); }
__device__ __forceinline__ float wave_sum(float v) {
#pragma unroll
    for (int o = 1; o < 64; o <<= 1) v += __shfl_xor(v, o);
    return v;
}
__device__ __forceinline__ float wave_max(float v) {
#pragma unroll
    for (int o = 1; o < 64; o <<= 1) v = fmaxf(v, __shfl_xor(v, o));
    return v;
}
__device__ __forceinline__ float dot8(uint4 x, uint4 y) {
    return blo(x.x) * blo(y.x) + bhi(x.x) * bhi(y.x) + blo(x.y) * blo(y.y) + bhi(x.y) * bhi(y.y) +
           blo(x.z) * blo(y.z) + bhi(x.z) * bhi(y.z) + blo(x.w) * blo(y.w) + bhi(x.w) * bhi(y.w);
}
__device__ __forceinline__ float dot_bf16(const bf16_t* a, const bf16_t* b, int K) {
    const uint4* a4 = (const uint4*)a; const uint4* b4 = (const uint4*)b; float acc = 0.f;
    for (int i = 0; i < K / 8; ++i) acc += dot8(a4[i], b4[i]);
    return acc;
}

template <int MODE>
__global__ void k_prep_wt(const float* __restrict__ src, bf16_t* __restrict__ dst, int K, int Nrows, int ldsrc, int nvalid,
                          const float* __restrict__ gain, const float* __restrict__ gain2, float scale) {
    const size_t idx = (size_t)blockIdx.x * 256 + threadIdx.x; if (idx >= (size_t)Nrows * K) return;
    const int n = (int)(idx / K), k = (int)(idx % K);
    src += (size_t)blockIdx.y * K * ldsrc; dst += (size_t)blockIdx.y * Nrows * K;
    int c = n;
    if (MODE == 1) { const int pn = n >> 8, half = (n >> 7) & 1, jj = n & 127; c = half * 1024 + pn * 128 + jj; }
    float v = 0.f;
    if (c < nvalid) { float g = 1.f; if (gain) g = (gain2 && k >= 512) ? gain2[k - 512] : gain[k]; v = src[(size_t)k * ldsrc + c] * g * scale; }
    dst[idx] = f2bf(v);
}
__global__ void k_prep_wr(const float* __restrict__ wr, const float* __restrict__ g, float* __restrict__ dst) {
    const int idx = blockIdx.x * 256 + threadIdx.x; if (idx >= DM * NE) return; dst[idx] = wr[idx] * g[idx / NE];
}
__global__ void k_prep_cs(const int* __restrict__ pos, float* __restrict__ cs) {
    const int idx = blockIdx.x * 256 + threadIdx.x; if (idx >= NTOK * 32) return; const int t = idx >> 5, i = idx & 31;
    const float inv = powf(10000.f, -(float)i / 32.f); const float a = (float)pos[t] * inv; float s, c; sincosf(a, &s, &c);
    cs[(size_t)t * 64 + i] = c; cs[(size_t)t * 64 + 32 + i] = s;
}
__global__ void k_cvt_bf16(const float* __restrict__ src, bf16_t* __restrict__ dst, size_t n) {
    const size_t idx = (size_t)blockIdx.x * 256 + threadIdx.x; if (idx < n) dst[idx] = f2bf(src[idx]);
}
__global__ void k_rmsnorm_bf16(const float* __restrict__ src, bf16_t* __restrict__ dst) {
    const int row = blockIdx.x * 4 + (threadIdx.x >> 6), lane = threadIdx.x & 63;
    const float4* s = (const float4*)(src + (size_t)row * DM); float4 v[4]; float ss = 0.f;
#pragma unroll
    for (int j = 0; j < 4; ++j) { v[j] = s[lane + 64 * j]; ss += v[j].x * v[j].x + v[j].y * v[j].y + v[j].z * v[j].z + v[j].w * v[j].w; }
    const float rstd = rsqrtf(wave_sum(ss) * (1.f / DM) + EPS);
    uint2* d = (uint2*)(dst + (size_t)row * DM);
#pragma unroll
    for (int j = 0; j < 4; ++j) d[lane + 64 * j] = make_uint2(pk2(v[j].x * rstd, v[j].y * rstd), pk2(v[j].z * rstd, v[j].w * rstd));
}

__global__ void k_inproj(const bf16_t* __restrict__ XN, const bf16_t* __restrict__ WT, bf16_t* __restrict__ Z) {
    const size_t idx = (size_t)blockIdx.x * 256 + threadIdx.x; const int row = (int)(idx / INWP), col = (int)(idx % INWP);
    Z[idx] = f2bf(dot_bf16(XN + (size_t)row * DM, WT + (size_t)col * DM, DM));
}
__global__ void k_zstats(const bf16_t* __restrict__ Z, float* __restrict__ SSQ) {
    const int row = blockIdx.x * 4 + (threadIdx.x >> 6), lane = threadIdx.x & 63; const bf16_t* z = Z + (size_t)row * INWP;
    float q = 0.f, kv = 0.f;
    for (int c = lane; c < 256; c += 64) { const float v = bf2f(z[c]); q += v * v; }
    for (int c = 256 + lane; c < 384; c += 64) { const float v = bf2f(z[c]); kv += v * v; }
    q = wave_sum(q); kv = wave_sum(kv);
    if (lane < 8) SSQ[(size_t)row * 8 + lane] = lane == 0 ? q : (lane == 4 ? kv : 0.f);
}
__global__ void k_pleraw(const bf16_t* __restrict__ P16, const bf16_t* __restrict__ WT, bf16_t* __restrict__ PLER) {
    const size_t idx = (size_t)blockIdx.x * 256 + threadIdx.x; const int row = (int)(idx / DM), col = (int)(idx % DM);
    PLER[idx] = f2bf(dot_bf16(P16 + (size_t)row * PLE, WT + (size_t)col * PLE, PLE));
}
__global__ void k_rowssq16(const bf16_t* __restrict__ X, float* __restrict__ out) {
    const int row = blockIdx.x * 4 + (threadIdx.x >> 6), lane = threadIdx.x & 63; float s = 0.f;
    for (int c = lane; c < DM; c += 64) { const float v = bf2f(X[(size_t)row * DM + c]); s += v * v; }
    s = wave_sum(s); if (lane < 16) out[(size_t)row * 16 + lane] = lane == 0 ? s : 0.f;
}
__device__ __forceinline__ float rstd4(const float* p, float n) { return rsqrtf((p[0] + p[1] + p[2] + p[3]) / n + EPS); }
__global__ void k_qup(const bf16_t* __restrict__ Z, const bf16_t* __restrict__ WT, const float* __restrict__ SSQ, const float* __restrict__ CS, bf16_t* __restrict__ Q) {
    const size_t idx = (size_t)blockIdx.x * 256 + threadIdx.x; const int row = (int)(idx / (NH * 160)), r = (int)(idx % (NH * 160)), h = r / 160, j = r % 160;
    const float rs = rstd4(SSQ + (size_t)row * 8, (float)QL); const bf16_t* a = Z + (size_t)row * INWP;
    const int b = row / SEQ, s = row % SEQ; bf16_t* q = Q + ((size_t)(b * NH + h) * SEQ + s) * DQK;
    if (j < 128) { q[j] = f2bf(rs * dot_bf16(a, WT + (size_t)(h * DQK + j) * QL, QL)); }
    else { const int i = j - 128; const float x1 = rs * dot_bf16(a, WT + (size_t)(h * DQK + 128 + 2 * i) * QL, QL), x2 = rs * dot_bf16(a, WT + (size_t)(h * DQK + 129 + 2 * i) * QL, QL);
        const float c = CS[(size_t)row * 64 + i], sn = CS[(size_t)row * 64 + 32 + i];
        q[128 + 2 * i] = f2bf(x1 * c - x2 * sn); q[129 + 2 * i] = f2bf(x1 * sn + x2 * c); }
}
__global__ void k_kvup(const bf16_t* __restrict__ Z, const bf16_t* __restrict__ WT, const float* __restrict__ SSQ, bf16_t* __restrict__ K, bf16_t* __restrict__ V) {
    const size_t idx = (size_t)blockIdx.x * 256 + threadIdx.x; const int row = (int)(idx / 1024), col = (int)(idx % 1024), h = col >> 8, d = col & 255;
    const float rs = rstd4(SSQ + (size_t)row * 8 + 4, (float)KVL);
    const float v = rs * dot_bf16(Z + (size_t)row * INWP + 256, WT + (size_t)col * 256, KVL);
    const int b = row / SEQ, s = row % SEQ; const size_t t = (size_t)(b * NH + h) * SEQ + s;
    if (d < 128) K[t * DQK + d] = f2bf(v); else V[t * DV + d - 128] = f2bf(v);
}
__global__ void k_kpe(const bf16_t* __restrict__ Z, const float* __restrict__ CS, bf16_t* __restrict__ K) {
    const int idx = blockIdx.x * 256 + threadIdx.x; const int row = idx >> 5, i = idx & 31;
    const float x1 = bf2f(Z[(size_t)row * INWP + 384 + i]), x2 = bf2f(Z[(size_t)row * INWP + 416 + i]);
    const float c = CS[(size_t)row * 64 + i], sn = CS[(size_t)row * 64 + 32 + i];
    const bf16_t o1 = f2bf(x1 * c - x2 * sn), o2 = f2bf(x1 * sn + x2 * c); const int b = row / SEQ, s = row % SEQ;
    for (int h = 0; h < NH; ++h) { bf16_t* k = K + ((size_t)(b * NH + h) * SEQ + s) * DQK; k[128 + 2 * i] = o1; k[129 + 2 * i] = o2; }
}
__global__ void k_conv(const bf16_t* __restrict__ Z, const float* __restrict__ cw, bf16_t* __restrict__ MIX) {
    const int row = blockIdx.x * 4 + (threadIdx.x >> 6), lane = threadIdx.x & 63, s = row % SEQ; const bf16_t* z = Z + (size_t)row * INWP;
    float y[8]; float ss = 0.f;
#pragma unroll
    for (int j = 0; j < 8; ++j) { const int c = lane + 64 * j;
        const float u0 = bf2f(z[960 + c]) * bf2f(z[1472 + c]);
        const float u1 = s >= 1 ? bf2f(z[960 + c - INWP]) * bf2f(z[1472 + c - INWP]) : 0.f;
        const float u2 = s >= 2 ? bf2f(z[960 + c - 2 * INWP]) * bf2f(z[1472 + c - 2 * INWP]) : 0.f;
        const float v = bf2f(z[448 + c]) * (cw[c] * u2 + cw[512 + c] * u1 + cw[1024 + c] * u0);
        y[j] = v; ss += v * v; }
    const float rstd = rsqrtf(wave_sum(ss) * (1.f / 512.f) + EPS);
#pragma unroll
    for (int j = 0; j < 8; ++j) MIX[(size_t)row * DM + 512 + lane + 64 * j] = f2bf(y[j] * rstd);
}
__global__ void k_attn_naive(const bf16_t* __restrict__ Q, const bf16_t* __restrict__ K, const bf16_t* __restrict__ V, bf16_t* __restrict__ MIX, float* __restrict__ ASSQ) {
    __shared__ float qs[4][DQK];
    const int wid = threadIdx.x >> 6, lane = threadIdx.x & 63; const int gw = blockIdx.x * 4 + wid; const int i = gw % SEQ, bh = gw / SEQ;
    const bf16_t* q = Q + (size_t)gw * DQK;
    for (int d = lane; d < DQK; d += 64) qs[wid][d] = bf2f(q[d]);
    __syncthreads();
    const bf16_t* Kb = K + (size_t)bh * SEQ * DQK; const bf16_t* Vb = V + (size_t)bh * SEQ * DV;
    float m = -1e30f, l = 0.f, o0 = 0.f, o1 = 0.f;
    for (int j0 = 0; j0 <= i; j0 += 64) {
        const int j = j0 + lane; const bool valid = j <= i; float sc = -INFINITY;
        if (valid) { const uint4* kr = (const uint4*)(Kb + (size_t)j * DQK); float acc = 0.f;
            for (int c = 0; c < 24; ++c) { const uint4 kv = kr[c]; const float* qq = &qs[wid][c * 8];
                acc += blo(kv.x) * qq[0] + bhi(kv.x) * qq[1] + blo(kv.y) * qq[2] + bhi(kv.y) * qq[3] + blo(kv.z) * qq[4] + bhi(kv.z) * qq[5] + blo(kv.w) * qq[6] + bhi(kv.w) * qq[7]; }
            sc = acc; }
        const float mnew = fmaxf(m, wave_max(sc)); const float alpha = exp2f(m - mnew); const float p = valid ? exp2f(sc - mnew) : 0.f;
        l = l * alpha + wave_sum(p); o0 *= alpha; o1 *= alpha; m = mnew;
        const int nj = (i - j0 + 1) < 64 ? (i - j0 + 1) : 64;
        for (int jj = 0; jj < nj; ++jj) { const float pj = __shfl(p, jj); const unsigned vv = *(const unsigned*)(Vb + (size_t)(j0 + jj) * DV + 2 * lane); o0 += pj * blo(vv); o1 += pj * bhi(vv); }
    }
    const float inv = 1.f / l; o0 *= inv; o1 *= inv;
    const int b = bh / NH, h = bh % NH; const size_t row = (size_t)b * SEQ + i;
    *(unsigned*)(MIX + row * DM + h * DV + 2 * lane) = pk2(o0, o1);
    const float ss = wave_sum(o0 * o0 + o1 * o1); if (lane == 0) ASSQ[row * 4 + h] = ss;
}
__global__ void k_wo(const bf16_t* __restrict__ MIX, const bf16_t* __restrict__ WT, const float* __restrict__ ASSQ, const float* __restrict__ x, float* __restrict__ H) {
    const size_t idx = (size_t)blockIdx.x * 256 + threadIdx.x; const int row = (int)(idx / DM), col = (int)(idx % DM);
    const float ra = rstd4(ASSQ + (size_t)row * 4, 512.f);
    const float a = dot_bf16(MIX + (size_t)row * DM, WT + (size_t)col * DM, 512) * ra + dot_bf16(MIX + (size_t)row * DM + 512, WT + (size_t)col * DM + 512, 512);
    H[idx] = x[idx] + a;
}
__global__ void k_router(const float* __restrict__ H, const float* __restrict__ WR, const float* __restrict__ br, bf16_t* __restrict__ XN, int* __restrict__ TOPI, float* __restrict__ TOPG, int* __restrict__ CNT) {
    __shared__ float lg[4][NE];
    const int wid = threadIdx.x >> 6, lane = threadIdx.x & 63, row = blockIdx.x * 4 + wid; const float* h = H + (size_t)row * DM;
    const float4* s = (const float4*)h; float4 v[4]; float ss = 0.f;
#pragma unroll
    for (int j = 0; j < 4; ++j) { v[j] = s[lane + 64 * j]; ss += v[j].x * v[j].x + v[j].y * v[j].y + v[j].z * v[j].z + v[j].w * v[j].w; }
    const float rstd = rsqrtf(wave_sum(ss) * (1.f / DM) + EPS);
    uint2* d = (uint2*)(XN + (size_t)row * DM);
#pragma unroll
    for (int j = 0; j < 4; ++j) d[lane + 64 * j] = make_uint2(pk2(v[j].x * rstd, v[j].y * rstd), pk2(v[j].z * rstd, v[j].w * rstd));
    const int e = lane & 31, half = lane >> 5; float acc = 0.f;
    for (int k = half * 512; k < half * 512 + 512; ++k) acc += h[k] * WR[e * DM + k];
    acc += __shfl_xor(acc, 32); acc = acc * rstd + br[e];
    if (lane < 32) lg[wid][lane] = acc;
    __syncthreads();
    if (lane == 0) { float lv[4]; int li[4]; unsigned used = 0u;
        for (int t = 0; t < 4; ++t) { float best = -INFINITY; int bi = 0; for (int q = 0; q < NE; ++q) { const float x = lg[wid][q]; if (!((used >> q) & 1u) && x > best) { best = x; bi = q; } } used |= 1u << bi; lv[t] = best; li[t] = bi; }
        float den = 0.f, ex[4]; for (int t = 0; t < 4; ++t) { ex[t] = expf(lv[t] - lv[0]); den += ex[t]; }
        for (int t = 0; t < 4; ++t) { TOPI[row * 4 + t] = li[t]; TOPG[row * 4 + t] = ex[t] / den; atomicAdd(&CNT[li[t]], 1); } }
}
__global__ void k_route_plan(int* __restrict__ ctl) {
    if (threadIdx.x != 0 || blockIdx.x != 0) return; int ps = 0, nt = 0;
    for (int e = 0; e < NE; ++e) { ctl[CW_PADSTART + e] = ps; const int t = (ctl[CW_CNT + e] + 255) / 256; for (int q = 0; q < t; ++q) ctl[CW_TILE_E + nt + q] = e; nt += t; ps += t * 256; }
    ctl[CW_PADSTART + NE] = ps; ctl[CW_NTILES] = nt;
}
__global__ void k_route_assign(const int* __restrict__ TOPI, const float* __restrict__ TOPG, int* __restrict__ ctl, int* __restrict__ ROWTOK, int* __restrict__ ROWSLOT, float* __restrict__ ROWGATE) {
    const int idx = blockIdx.x * 256 + threadIdx.x; if (idx >= MROWS) return; const int e = TOPI[idx];
    const int dest = ctl[CW_PADSTART + e] + atomicAdd(&ctl[CW_CURSOR + e], 1);
    ROWTOK[dest] = idx >> 2; ROWSLOT[dest] = idx; ROWGATE[dest] = TOPG[idx];
}
__global__ void k_route_fill(const int* __restrict__ ctl, int* __restrict__ ROWTOK, int* __restrict__ ROWSLOT, float* __restrict__ ROWGATE) {
    const int e = blockIdx.x; const int lo = ctl[CW_PADSTART + e] + ctl[CW_CNT + e], hi = ctl[CW_PADSTART + e + 1];
    for (int r = lo + threadIdx.x; r < hi; r += 256) { ROWTOK[r] = 0; ROWSLOT[r] = MROWS; ROWGATE[r] = 0.f; }
}
__device__ __forceinline__ float swiglu(float g, float u) { g = fminf(g, 7.f); u = fminf(fmaxf(u, -7.f), 7.f); return g / (1.f + expf(-1.702f * g)) * (u + 1.f); }
__global__ void k_moe1(const bf16_t* __restrict__ XN, const bf16_t* __restrict__ W1T, const float* __restrict__ b1, const int* __restrict__ ctl, const int* __restrict__ ROWTOK, bf16_t* __restrict__ HB) {
    const size_t idx = (size_t)blockIdx.x * 256 + threadIdx.x; const int r = (int)(idx / DE), j = (int)(idx % DE);
    if (r >= ctl[CW_NTILES] * 256) return; const int e = ctl[CW_TILE_E + (r >> 8)];
    const bf16_t* a = XN + (size_t)ROWTOK[r] * DM; const bf16_t* w = W1T + (size_t)e * 2048 * DM; const int rg = (j >> 7) * 256 + (j & 127);
    const float g = dot_bf16(a, w + (size_t)rg * DM, DM) + b1[e * 2048 + j], u = dot_bf16(a, w + (size_t)(rg + 128) * DM, DM) + b1[e * 2048 + 1024 + j];
    HB[idx] = f2bf(swiglu(g, u));
}
__global__ void k_moe2(const bf16_t* __restrict__ HB, const bf16_t* __restrict__ W2T, const float* __restrict__ b2, const int* __restrict__ ctl, const int* __restrict__ ROWSLOT, const float* __restrict__ ROWGATE, bf16_t* __restrict__ Y) {
    const size_t idx = (size_t)blockIdx.x * 256 + threadIdx.x; const int r = (int)(idx / DM), c = (int)(idx % DM);
    if (r >= ctl[CW_NTILES] * 256) return; const int e = ctl[CW_TILE_E + (r >> 8)];
    const float v = (dot_bf16(HB + (size_t)r * DE, W2T + ((size_t)e * DM + c) * DE, DE) + b2[e * DM + c]) * ROWGATE[r];
    Y[(size_t)ROWSLOT[r] * DM + c] = f2bf(v);
}
__global__ void k_combine(float* __restrict__ H, const bf16_t* __restrict__ Y, bf16_t* __restrict__ XN) {
    const int row = blockIdx.x * 4 + (threadIdx.x >> 6), lane = threadIdx.x & 63; float4* hp = (float4*)(H + (size_t)row * DM); float4 v[4]; float ss = 0.f;
#pragma unroll
    for (int j = 0; j < 4; ++j) { v[j] = hp[lane + 64 * j];
        for (int k = 0; k < 4; ++k) { const uint2 y = *(const uint2*)(Y + ((size_t)row * 4 + k) * DM + 4 * (lane + 64 * j)); v[j].x += blo(y.x); v[j].y += bhi(y.x); v[j].z += blo(y.y); v[j].w += bhi(y.y); }
        hp[lane + 64 * j] = v[j]; ss += v[j].x * v[j].x + v[j].y * v[j].y + v[j].z * v[j].z + v[j].w * v[j].w; }
    const float rstd = rsqrtf(wave_sum(ss) * (1.f / DM) + EPS);
    uint2* d = (uint2*)(XN + (size_t)row * DM);
#pragma unroll
    for (int j = 0; j < 4; ++j) d[lane + 64 * j] = make_uint2(pk2(v[j].x * rstd, v[j].y * rstd), pk2(v[j].z * rstd, v[j].w * rstd));
}
__global__ void k_plegate(const bf16_t* __restrict__ XN, const bf16_t* __restrict__ WGT, const bf16_t* __restrict__ PLER, const float* __restrict__ PSSQ, const float* __restrict__ pg, float* __restrict__ H) {
    const size_t idx = (size_t)blockIdx.x * 256 + threadIdx.x; const int row = (int)(idx / DM), col = (int)(idx % DM);
    const float a = dot_bf16(XN + (size_t)row * DM, WGT + (size_t)col * DM, DM); const float g = 1.f / (1.f + expf(-a));
    float s = 0.f; for (int t = 0; t < 16; ++t) s += PSSQ[(size_t)row * 16 + t]; const float rp = rsqrtf(s * (1.f / DM) + EPS);
    H[idx] = H[idx] + g * bf2f(PLER[idx]) * rp * pg[col];
}
__global__ void k_final(float* __restrict__ H, const float* __restrict__ g) {
    const int row = blockIdx.x * 4 + (threadIdx.x >> 6), lane = threadIdx.x & 63; float4* hp = (float4*)(H + (size_t)row * DM); const float4* gp = (const float4*)g; float4 v[4]; float ss = 0.f;
#pragma unroll
    for (int j = 0; j < 4; ++j) { v[j] = hp[lane + 64 * j]; ss += v[j].x * v[j].x + v[j].y * v[j].y + v[j].z * v[j].z + v[j].w * v[j].w; }
    const float rstd = rsqrtf(wave_sum(ss) * (1.f / DM) + EPS);
#pragma unroll
    for (int j = 0; j < 4; ++j) { const float4 gg = gp[lane + 64 * j]; hp[lane + 64 * j] = make_float4(v[j].x * rstd * gg.x, v[j].y * rstd * gg.y, v[j].z * rstd * gg.z, v[j].w * rstd * gg.w); }
}

#define LAS __attribute__((address_space(3)))
#define GAS __attribute__((address_space(1)))
typedef short bf16x8 __attribute__((ext_vector_type(8)));
typedef float f32x4 __attribute__((ext_vector_type(4)));
typedef float f32x2 __attribute__((ext_vector_type(2)));
typedef unsigned u32x4 __attribute__((ext_vector_type(4)));
typedef unsigned u32x2 __attribute__((ext_vector_type(2)));
constexpr int NWAVES = 8, NTHREADS = 512;
constexpr int RING_BYTES = 131072, MISC_OFF = RING_BYTES, HIST_OFF = MISC_OFF + 256, LDS_BYTES = 163840;
constexpr int CW_BAR = 4096;
__device__ __forceinline__ unsigned cvt_pk_bf16(float lo, float hi) { unsigned r; asm volatile("v_cvt_pk_bf16_f32 %0, %1, %2" : "=v"(r) : "v"(lo), "v"(hi)); return r; }
__device__ __forceinline__ int lane_id() { int l = (int)__builtin_amdgcn_mbcnt_hi(~0u, __builtin_amdgcn_mbcnt_lo(~0u, 0u)); asm volatile("" : "+v"(l)); return l; }
__device__ __forceinline__ float fast_sigmoid(float a) { return __builtin_amdgcn_rcpf(1.f + __expf(-a)); }

#define XB_TMO      128
#define XB_XCNT(j)  (256  + 64 * (j))
#define XB_XSUB(j)  (1280 + 64 * (j))
#define XB_XGEN(j)  (2304 + 64 * (j))
#define XB_TOP      3328
#define XB_TOPGEN   3392
#define XCD_BAR_WORDS 3456
#define XB_SPIN_CAP (1u << 20)
__device__ __forceinline__ unsigned xb_ld(unsigned* p)              { return __hip_atomic_load(p, __ATOMIC_RELAXED, __HIP_MEMORY_SCOPE_AGENT); }
__device__ __forceinline__ unsigned xb_add(unsigned* p, unsigned v) { return __hip_atomic_fetch_add(p, v, __ATOMIC_RELAXED, __HIP_MEMORY_SCOPE_AGENT); }
__device__ __forceinline__ unsigned xb_xcc_id() { return (unsigned)__builtin_amdgcn_s_getreg((3 << 11) | 20) & 0xFu; }
#define XB_SPIN(cond, bar) do { unsigned _sp = 0; while (cond) { __builtin_amdgcn_s_sleep(1); \
    if ((++_sp & 255u) == 0u) { if (xb_ld(&(bar)[XB_TMO])) break; if (_sp > XB_SPIN_CAP) { atomicAdd(&(bar)[XB_TMO], 1u); break; } } } } while (0)
struct XcdBarrier { unsigned* bar; unsigned x; volatile LAS unsigned* st; };
__device__ __forceinline__ XcdBarrier xcd_barrier_post(unsigned* bar, volatile LAS unsigned* st, int wave) {
    XcdBarrier b; b.bar = bar; b.x = xb_xcc_id(); b.st = st;
    if (wave == 0 && lane_id() == 0) (void)xb_add(&bar[XB_XCNT(b.x)], 1u);
    return b;
}
__device__ __forceinline__ void xcd_barrier_complete(unsigned* bar, unsigned x, unsigned& nloc, unsigned& nx) {
    const unsigned G = gridDim.x * gridDim.y * gridDim.z;
    unsigned sum, cnt, mine, sp = 0u;
    for (;;) {
        sum = 0u; cnt = 0u; mine = 0u;
#pragma unroll
        for (unsigned j = 0; j < 16; ++j) { const unsigned c = xb_ld(&bar[XB_XCNT(j)]); sum += c; cnt += (c > 0u) ? 1u : 0u; mine = (j == x) ? c : mine; }
        if (sum == G) break;
        __builtin_amdgcn_s_sleep(1);
        if ((++sp & 255u) == 0u) { if (xb_ld(&bar[XB_TMO])) break; if (sp > XB_SPIN_CAP) { atomicAdd(&bar[XB_TMO], 1u); break; } }
    }
    nloc = mine > 0u ? mine : 1u; nx = cnt > 0u ? cnt : 1u;
}
__device__ __forceinline__ void xcd_barrier(const XcdBarrier& b, int wave) {
    asm volatile("s_waitcnt vmcnt(0)" ::: "memory");
    __syncthreads();
    if (wave == 0 && lane_id() == 0) {
        unsigned* bar = b.bar;
        __builtin_amdgcn_s_waitcnt(0);
        unsigned nloc = b.st[0], nx = b.st[1];
        if (nloc == 0u) { xcd_barrier_complete(bar, b.x, nloc, nx); b.st[0] = nloc; b.st[1] = nx; }
        const unsigned old = xb_add(&bar[XB_XSUB(b.x)], 1u);
        const unsigned gen = old / nloc;
        if (old + 1u == (gen + 1u) * nloc) {
            __builtin_amdgcn_fence(__ATOMIC_RELEASE, "agent");
            asm volatile("s_waitcnt vmcnt(0)" ::: "memory");
            const unsigned og = xb_add(&bar[XB_TOP], 1u);
            const unsigned tg = og / nx;
            if (og + 1u == (tg + 1u) * nx) xb_add(&bar[XB_TOPGEN], 1u);
            else XB_SPIN(xb_ld(&bar[XB_TOPGEN]) == tg, bar);
            __builtin_amdgcn_fence(__ATOMIC_ACQUIRE, "agent");
            xb_add(&bar[XB_XGEN(b.x)], 1u);
            asm volatile("s_waitcnt vmcnt(0)" ::: "memory");
        } else {
            XB_SPIN(xb_ld(&bar[XB_XGEN(b.x)]) == gen, bar);
            __builtin_amdgcn_fence(__ATOMIC_ACQUIRE, "agent");
            asm volatile("s_waitcnt vmcnt(0)" ::: "memory");
        }
    }
    __syncthreads();
}

namespace pg8 {
constexpr int BM = 256, BK = 64, HALF = 128, HTB = HALF * BK * 2, STAGE_BYTES = 8 * HTB, NXCD = 8, WGM = 8;
__host__ __device__ __forceinline__ int lds_byte(int r, int c) { const int st = (r >> 4) * 2 + (c >> 5), rr = r & 15, cc = c & 31, ob = rr * 64 + cc * 2; return st * 1024 + (ob ^ (((ob >> 9) & 1) << 5)); }
__host__ __device__ __forceinline__ void stage_rc(int b, int& R, int& C) { const int st = b / 1024, sb = b % 1024, swz = sb ^ (((sb >> 9) & 1) << 5); R = (st >> 1) * 16 + swz / 64; C = (st & 1) * 32 + (swz % 64) / 2; }
__host__ __device__ __forceinline__ int perm32(int rho) { const int n = rho >> 4, i = rho & 15; return 8 * (i >> 2) + 4 * n + (i & 3); }
struct Unit { int pm, pn, e; };
struct Gemm { const bf16_t* A; const bf16_t* Bt; int K, lda, ldb; const int* rowidx; size_t bstride; };
struct StaticOrder {
    int nM, nN, nwg, G, c; const int* tile_e;
    __device__ void init(int nM_, int nN_, int G_, int c_, const int* te) { nM = nM_; nN = nN_; nwg = nM * nN; G = G_; c = c_; tile_e = te; }
    __device__ bool next(int i, Unit& u) const {
        const long L = (long)i * G + c; if (L >= nwg) return false;
        int wgid = (int)L; { const int q = nwg / NXCD, r = nwg % NXCD, xcd = wgid % NXCD, off = wgid / NXCD; wgid = (xcd < r ? xcd * (q + 1) : r * (q + 1) + (xcd - r) * q) + off; }
        const int nig = WGM * nN, gid = wgid / nig, fm = gid * WGM, gsz = (nM - fm) < WGM ? (nM - fm) : WGM;
        u.pm = fm + ((wgid % nig) % gsz); u.pn = (wgid % nig) / gsz; u.e = tile_e ? tile_e[u.pm] : 0; return true;
    }
};
typedef f32x4 Acc[2][2][4][2];
template <class Epi, bool GATHER>
__device__ __forceinline__ void gemm_phase(LAS unsigned char* lds, const Gemm g, const StaticOrder& S, const Epi& E, const int wid) {
    const int lane = lane_id(), tid = wid * 64 + lane, wr = wid >> 2, wc = wid & 3, fr = lane & 15, fq = lane >> 4;
    const int K = g.K, nt = K / BK;
    int RA[2], CA[2]; unsigned voffB[2], voffA[2];
#pragma unroll
    for (int i = 0; i < 2; ++i) { int R, C; stage_rc(tid * 16 + i * 8192, R, C); const int Rb = Epi::PERM ? ((R & ~31) + perm32(R & 31)) : R;
        RA[i] = R; CA[i] = C; voffB[i] = (unsigned)(Rb * g.ldb + C) * 2u; voffA[i] = (unsigned)(R * g.lda + C) * 2u; }
    const size_t hstepA = GATHER ? 0 : (size_t)HALF * g.lda * 2;
    const size_t kstep = (size_t)(BK * 2);
    const size_t hstepB = (size_t)HALF * g.ldb * 2;
    const unsigned ldsw = (unsigned)wid * 1024u;
    const int aoff = lds_byte(wr * 64 + fr, fq * 8), boff = lds_byte(wc * 32 + fr, fq * 8);
#define PG8_SA(b, h) (((b) * 2 + (h)) * HTB)
#define PG8_SB(b, h) ((4 + (b) * 2 + (h)) * HTB)
#define PG8_STAGE(bufoff, gbase, voff) do { _Pragma("unroll") for (int _i = 0; _i < 2; ++_i) \
        __builtin_amdgcn_global_load_lds((const unsigned*)((const char*)(gbase) + (voff)[_i]), (LAS unsigned*)(lds + (bufoff) + ldsw + _i * 8192), 16, 0, 0); } while (0)
#define PG8_LDA(dst, b, h) do { _Pragma("unroll") for (int m = 0; m < 4; ++m) _Pragma("unroll") for (int k = 0; k < 2; ++k) dst[m][k] = *(const LAS bf16x8*)(lds + PG8_SA(b, h) + aoff + m * 2048 + k * 1024); } while (0)
#define PG8_LDB(dst, b, h) do { _Pragma("unroll") for (int n = 0; n < 2; ++n) _Pragma("unroll") for (int k = 0; k < 2; ++k) dst[n][k] = *(const LAS bf16x8*)(lds + PG8_SB(b, h) + boff + n * 2048 + k * 1024); } while (0)
#define PG8_MMA(ai, bj, At, Bt) do { __builtin_amdgcn_s_setprio(1); _Pragma("unroll") for (int m = 0; m < 4; ++m) _Pragma("unroll") for (int n = 0; n < 2; ++n) _Pragma("unroll") for (int k = 0; k < 2; ++k) \
        acc[ai][bj][m][n] = __builtin_amdgcn_mfma_f32_16x16x32_bf16(Bt[n][k], At[m][k], acc[ai][bj][m][n], 0, 0, 0); __builtin_amdgcn_s_setprio(0); } while (0)
#define PG8_WAIT_V(n) asm volatile("s_waitcnt vmcnt(" #n ")" ::: "memory")
#define PG8_WAIT_L(n) asm volatile("s_waitcnt lgkmcnt(" #n ")" ::: "memory")
#define PG8_BAR __builtin_amdgcn_s_barrier()
#define PG8_SCHED __builtin_amdgcn_sched_barrier(0)
#define PG8_SETVO(vo, u) do { if constexpr (GATHER) { _Pragma("unroll") for (int _h = 0; _h < 2; ++_h) _Pragma("unroll") for (int _i = 0; _i < 2; ++_i) { \
        const int _row = g.rowidx[(u).pm * BM + _h * HALF + RA[_i]]; (vo)[_h][_i] = ((unsigned)_row * (unsigned)g.lda + (unsigned)CA[_i]) * 2u; } } } while (0)
#define PG8_STAGE_A(bufoff, base, h, vog) do { if constexpr (GATHER) { PG8_STAGE(bufoff, base, (vog)[h]); } else { PG8_STAGE(bufoff, (base) + (h) * hstepA, voffA); } } while (0)
    Unit cur, nxt; int ui = 0;
    if (!S.next(0, cur)) return;
    Acc acc;
#pragma unroll
    for (int a = 0; a < 2; ++a)
#pragma unroll
        for (int b = 0; b < 2; ++b)
#pragma unroll
            for (int m = 0; m < 4; ++m)
#pragma unroll
                for (int n = 0; n < 2; ++n) acc[a][b][m][n] = (f32x4){0.f, 0.f, 0.f, 0.f};
    bf16x8 At[4][2], B0[2][2], B1[2][2];
    unsigned voC[2][2], voN[2][2];
    PG8_SETVO(voC, cur);
    const char* const Ab = (const char*)g.A;
    const char* cA = GATHER ? Ab : Ab + (size_t)cur.pm * 2 * hstepA;
    const char* cB = (const char*)g.Bt + (size_t)cur.e * g.bstride + (size_t)cur.pn * 2 * hstepB;
    PG8_STAGE(PG8_SB(0, 0), cB, voffB); PG8_STAGE(PG8_SB(0, 1), cB + hstepB, voffB); PG8_STAGE_A(PG8_SA(0, 0), cA, 0, voC); PG8_STAGE_A(PG8_SA(0, 1), cA, 1, voC);
    if (wr == 1) PG8_BAR;
    PG8_WAIT_V(2); PG8_BAR;
    PG8_STAGE(PG8_SB(1, 0), cB + kstep, voffB); PG8_STAGE_A(PG8_SA(1, 0), cA + kstep, 0, voC); PG8_STAGE(PG8_SB(1, 1), cB + hstepB + kstep, voffB);
    PG8_WAIT_V(6); PG8_BAR;
    for (;;) {
        const bool has_next = S.next(ui + 1, nxt);
        const char* nB = has_next ? (const char*)g.Bt + (size_t)nxt.e * g.bstride + (size_t)nxt.pn * 2 * hstepB : cB;
        const char* nA = (has_next && !GATHER) ? Ab + (size_t)nxt.pm * 2 * hstepA : cA;
        if constexpr (GATHER) { if (has_next) { PG8_SETVO(voN, nxt); } else {
#pragma unroll
            for (int h = 0; h < 2; ++h)
#pragma unroll
                for (int i = 0; i < 2; ++i) voN[h][i] = voC[h][i]; } }
        for (int t = 0; t < nt; t += 2) {
            const bool last = (t == nt - 2);
            if constexpr (Epi::MIDK > 0) { if (t == Epi::MIDK) { const int l2 = lane_id(); E.mid(acc, cur, wr, wc, l2 & 15, l2 >> 4); } }
            const char* a1 = cA + (size_t)(t + 1) * kstep;
            const char* a2 = last ? nA : cA + (size_t)(t + 2) * kstep; const char* b2 = last ? nB : cB + (size_t)(t + 2) * kstep;
            const char* a3 = a2 + kstep; const char* b3 = b2 + kstep;
            unsigned o2[2][2];
            if constexpr (GATHER) {
#pragma unroll
            for (int h = 0; h < 2; ++h)
#pragma unroll
                for (int i = 0; i < 2; ++i) o2[h][i] = last ? voN[h][i] : voC[h][i]; }
            PG8_LDB(B0, 0, 0); PG8_LDB(B1, 0, 1); PG8_SCHED; PG8_LDA(At, 0, 0); PG8_STAGE_A(PG8_SA(1, 1), a1, 1, voC);
            PG8_WAIT_V(8); PG8_WAIT_L(0); PG8_BAR; PG8_MMA(0, 0, At, B0); PG8_MMA(0, 1, At, B1); PG8_BAR; PG8_SCHED;
            PG8_LDA(At, 0, 1); PG8_STAGE(PG8_SB(0, 0), b2, voffB); PG8_STAGE(PG8_SB(0, 1), b2 + hstepB, voffB); PG8_STAGE_A(PG8_SA(0, 0), a2, 0, o2);
            PG8_WAIT_V(8); PG8_WAIT_L(0); PG8_BAR; PG8_MMA(1, 0, At, B0); PG8_MMA(1, 1, At, B1); PG8_BAR; PG8_SCHED;
            PG8_LDB(B0, 1, 0); PG8_LDB(B1, 1, 1); PG8_SCHED; PG8_LDA(At, 1, 0); PG8_STAGE_A(PG8_SA(0, 1), a2, 1, o2);
            PG8_WAIT_V(8); PG8_WAIT_L(0); PG8_BAR; PG8_MMA(0, 0, At, B0); PG8_MMA(0, 1, At, B1); PG8_BAR; PG8_SCHED;
            PG8_LDA(At, 1, 1); PG8_STAGE(PG8_SB(1, 0), b3, voffB); PG8_STAGE(PG8_SB(1, 1), b3 + hstepB, voffB); PG8_STAGE_A(PG8_SA(1, 0), a3, 0, o2);
            PG8_WAIT_V(8); PG8_WAIT_L(0); PG8_BAR; PG8_MMA(1, 0, At, B0); PG8_MMA(1, 1, At, B1); PG8_BAR; PG8_SCHED;
        }
        if (wr == 0) PG8_BAR;
        { const int l2 = lane_id(); E(acc, cur, wr, wc, l2 & 15, l2 >> 4); }
        if (!has_next) break;
#pragma unroll
        for (int a = 0; a < 2; ++a)
#pragma unroll
            for (int b = 0; b < 2; ++b)
#pragma unroll
                for (int m = 0; m < 4; ++m)
#pragma unroll
                    for (int n = 0; n < 2; ++n) acc[a][b][m][n] = (f32x4){0.f, 0.f, 0.f, 0.f};
        cur = nxt; cB = nB; cA = nA; ++ui;
        if constexpr (GATHER) {
#pragma unroll
        for (int h = 0; h < 2; ++h)
#pragma unroll
            for (int i = 0; i < 2; ++i) voC[h][i] = voN[h][i]; }
        if (wr == 1) PG8_BAR;
    }
    PG8_WAIT_V(0);
    PG8_BAR;
#undef PG8_SA
#undef PG8_SB
#undef PG8_STAGE
#undef PG8_LDA
#undef PG8_LDB
#undef PG8_MMA
#undef PG8_WAIT_V
#undef PG8_WAIT_L
#undef PG8_BAR
#undef PG8_SCHED
#undef PG8_SETVO
#undef PG8_STAGE_A
}

__device__ __forceinline__ float sq4(f32x4 v) { return (v[0] * v[0] + v[1] * v[1]) + (v[2] * v[2] + v[3] * v[3]); }
__device__ __forceinline__ float red_fq(float s) { s += __shfl_xor(s, 16); s += __shfl_xor(s, 32); return s; }
__device__ __forceinline__ u32x4 pack8(f32x4 a, f32x4 b) { u32x4 w; w.x = cvt_pk_bf16(a[0], a[1]); w.y = cvt_pk_bf16(a[2], a[3]); w.z = cvt_pk_bf16(b[0], b[1]); w.w = cvt_pk_bf16(b[2], b[3]); return w; }
template <int MODE> struct EpiBf16Stats {
    static constexpr bool PERM = true; static constexpr int MIDK = 0;
    bf16_t* O; int ldc; float* ssq;
    __device__ __forceinline__ void operator()(const Acc& acc, const Unit& u, int wr, int wc, int fr, int fq) const {
        const int row0 = u.pm * BM + wr * 64 + fr, col0 = u.pn * BM + wc * 32 + 8 * fq;
#pragma unroll
        for (int ai = 0; ai < 2; ++ai)
#pragma unroll
            for (int m = 0; m < 4; ++m) { const int row = row0 + ai * HALF + m * 16; bf16_t* rowp = O + (size_t)row * ldc + col0;
#pragma unroll
                for (int bj = 0; bj < 2; ++bj) *(u32x4*)(rowp + bj * HALF) = pack8(acc[ai][bj][m][0], acc[ai][bj][m][1]);
                if (MODE == 1) { float s = (sq4(acc[ai][0][m][0]) + sq4(acc[ai][0][m][1])) + (sq4(acc[ai][1][m][0]) + sq4(acc[ai][1][m][1])); s = red_fq(s); if (fq == 0) ssq[(size_t)row * 16 + u.pn * 4 + wc] = s; }
                else if (u.pn == 0) { float s = (sq4(acc[ai][0][m][0]) + sq4(acc[ai][0][m][1])) + (sq4(acc[ai][1][m][0]) + sq4(acc[ai][1][m][1])); s = red_fq(s); if (fq == 0) ssq[(size_t)row * 8 + wc] = s; }
                else if (u.pn == 1) { float s = sq4(acc[ai][0][m][0]) + sq4(acc[ai][0][m][1]); s = red_fq(s); if (fq == 0) ssq[(size_t)row * 8 + 4 + wc] = s; } }
    }
};
struct EpiQ {
    static constexpr bool PERM = true; static constexpr int MIDK = 0;
    bf16_t* Q; const float* ssq; const float* cs;
    __device__ __forceinline__ void operator()(const Acc& acc, const Unit& u, int wr, int wc, int fr, int fq) const {
        const int row0 = u.pm * BM + wr * 64 + fr;
#pragma unroll
        for (int ai = 0; ai < 2; ++ai)
#pragma unroll
            for (int m = 0; m < 4; ++m) { const int row = row0 + ai * HALF + m * 16; const f32x4 sv = *(const f32x4*)(ssq + (size_t)row * 8);
                const float rs = rsqrtf(((sv[0] + sv[1]) + (sv[2] + sv[3])) * (1.f / QL) + EPS); const int b = row / SEQ, s = row % SEQ;
#pragma unroll
                for (int bj = 0; bj < 2; ++bj) { const int cv = u.pn * BM + bj * HALF + wc * 32 + 8 * fq; const int h = cv / DQK, d = cv % DQK;
                    f32x4 v0 = acc[ai][bj][m][0] * rs, v1 = acc[ai][bj][m][1] * rs;
                    if (d >= DN) { const int i0 = (d - DN) >> 1; const f32x4 c = *(const f32x4*)(cs + (size_t)row * 64 + i0), sn = *(const f32x4*)(cs + (size_t)row * 64 + 32 + i0);
                        const f32x4 r0 = {v0[0] * c[0] - v0[1] * sn[0], v0[0] * sn[0] + v0[1] * c[0], v0[2] * c[1] - v0[3] * sn[1], v0[2] * sn[1] + v0[3] * c[1]};
                        const f32x4 r1 = {v1[0] * c[2] - v1[1] * sn[2], v1[0] * sn[2] + v1[1] * c[2], v1[2] * c[3] - v1[3] * sn[3], v1[2] * sn[3] + v1[3] * c[3]};
                        v0 = r0; v1 = r1; }
                    *(u32x4*)(Q + ((size_t)(b * NH + h) * SEQ + s) * DQK + d) = pack8(v0, v1); } }
    }
};
struct EpiKV {
    static constexpr bool PERM = true; static constexpr int MIDK = 0;
    bf16_t* Kc; bf16_t* Vc; const float* ssq;
    __device__ __forceinline__ void operator()(const Acc& acc, const Unit& u, int wr, int wc, int fr, int fq) const {
        const int row0 = u.pm * BM + wr * 64 + fr, d = wc * 32 + 8 * fq, h = u.pn;
#pragma unroll
        for (int ai = 0; ai < 2; ++ai)
#pragma unroll
            for (int m = 0; m < 4; ++m) { const int row = row0 + ai * HALF + m * 16; const f32x4 sv = *(const f32x4*)(ssq + (size_t)row * 8 + 4);
                const float rs = rsqrtf(((sv[0] + sv[1]) + (sv[2] + sv[3])) * (1.f / KVL) + EPS); const int b = row / SEQ, s = row % SEQ; const size_t t = (size_t)(b * NH + h) * SEQ + s;
                *(u32x4*)(Kc + t * DQK + d) = pack8(acc[ai][0][m][0] * rs, acc[ai][0][m][1] * rs);
                *(u32x4*)(Vc + t * DV + d) = pack8(acc[ai][1][m][0] * rs, acc[ai][1][m][1] * rs); }
    }
};
struct EpiWo {
    static constexpr bool PERM = false; static constexpr int MIDK = 8;
    const float* x; float* H; const float* assq;
    __device__ __forceinline__ void mid(Acc& acc, const Unit& u, int wr, int wc, int fr, int fq) const {
        const int row0 = u.pm * BM + wr * 64 + fr;
#pragma unroll
        for (int ai = 0; ai < 2; ++ai)
#pragma unroll
            for (int m = 0; m < 4; ++m) { const f32x4 sv = *(const f32x4*)(assq + (size_t)(row0 + ai * HALF + m * 16) * 4);
                const float rs = rsqrtf(((sv[0] + sv[1]) + (sv[2] + sv[3])) * (1.f / 512.f) + EPS);
#pragma unroll
                for (int bj = 0; bj < 2; ++bj)
#pragma unroll
                    for (int n = 0; n < 2; ++n) acc[ai][bj][m][n] = acc[ai][bj][m][n] * rs; }
    }
    __device__ __forceinline__ void operator()(const Acc& acc, const Unit& u, int wr, int wc, int fr, int fq) const {
        const int row0 = u.pm * BM + wr * 64 + fr, col0 = u.pn * BM + wc * 32 + 4 * fq;
#pragma unroll
        for (int ai = 0; ai < 2; ++ai)
#pragma unroll
            for (int m = 0; m < 4; ++m) { const size_t off = (size_t)(row0 + ai * HALF + m * 16) * DM + col0;
#pragma unroll
                for (int bj = 0; bj < 2; ++bj)
#pragma unroll
                    for (int n = 0; n < 2; ++n) *(f32x4*)(H + off + bj * HALF + n * 16) = *(const f32x4*)(x + off + bj * HALF + n * 16) + acc[ai][bj][m][n]; }
    }
};
__device__ __forceinline__ float swiglu_f(float g, float u) { g = fminf(g, 7.f); u = fminf(fmaxf(u, -7.f), 7.f); return g * fast_sigmoid(1.702f * g) * (u + 1.f); }
struct EpiMoe1 {
    static constexpr bool PERM = true; static constexpr int MIDK = 0;
    bf16_t* HB; const float* b1;
    __device__ __forceinline__ void operator()(const Acc& acc, const Unit& u, int wr, int wc, int fr, int fq) const {
        const int row0 = u.pm * BM + wr * 64 + fr, j0 = u.pn * HALF + wc * 32 + 8 * fq; const float* bg = b1 + (size_t)u.e * 2048 + j0;
        const f32x4 g0 = *(const f32x4*)bg, g1 = *(const f32x4*)(bg + 4), u0 = *(const f32x4*)(bg + 1024), u1 = *(const f32x4*)(bg + 1028);
#pragma unroll
        for (int ai = 0; ai < 2; ++ai)
#pragma unroll
            for (int m = 0; m < 4; ++m) { const f32x4 a0 = acc[ai][0][m][0] + g0, a1 = acc[ai][0][m][1] + g1, c0 = acc[ai][1][m][0] + u0, c1 = acc[ai][1][m][1] + u1; f32x4 r0, r1;
#pragma unroll
                for (int j = 0; j < 4; ++j) { r0[j] = swiglu_f(a0[j], c0[j]); r1[j] = swiglu_f(a1[j], c1[j]); }
                *(u32x4*)(HB + (size_t)(row0 + ai * HALF + m * 16) * DE + j0) = pack8(r0, r1); }
    }
};
struct EpiMoe2 {
    static constexpr bool PERM = true; static constexpr int MIDK = 0;
    bf16_t* Y; const float* b2; const int* rowslot; const float* rowgate;
    __device__ __forceinline__ void operator()(const Acc& acc, const Unit& u, int wr, int wc, int fr, int fq) const {
        const int row0 = u.pm * BM + wr * 64 + fr, col0 = u.pn * BM + wc * 32 + 8 * fq; const float* bb = b2 + (size_t)u.e * DM + col0;
        f32x4 bv[2][2];
#pragma unroll
        for (int bj = 0; bj < 2; ++bj)
#pragma unroll
            for (int n = 0; n < 2; ++n) bv[bj][n] = *(const f32x4*)(bb + bj * HALF + 4 * n);
#pragma unroll
        for (int ai = 0; ai < 2; ++ai)
#pragma unroll
            for (int m = 0; m < 4; ++m) { const int r = row0 + ai * HALF + m * 16; const float gt = rowgate[r]; bf16_t* yp = Y + (size_t)rowslot[r] * DM + col0;
#pragma unroll
                for (int bj = 0; bj < 2; ++bj) *(u32x4*)(yp + bj * HALF) = pack8((acc[ai][bj][m][0] + bv[bj][0]) * gt, (acc[ai][bj][m][1] + bv[bj][1]) * gt); }
    }
};
struct EpiPle {
    static constexpr bool PERM = false; static constexpr int MIDK = 0;
    float* H; const bf16_t* pler; const float* pssq; const float* pg; float* fssq;
    __device__ __forceinline__ void operator()(const Acc& acc, const Unit& u, int wr, int wc, int fr, int fq) const {
        const int row0 = u.pm * BM + wr * 64 + fr, col0 = u.pn * BM + wc * 32 + 4 * fq;
        f32x4 gv[2][2];
#pragma unroll
        for (int bj = 0; bj < 2; ++bj)
#pragma unroll
            for (int n = 0; n < 2; ++n) gv[bj][n] = *(const f32x4*)(pg + col0 + bj * HALF + n * 16);
#pragma unroll
        for (int ai = 0; ai < 2; ++ai)
#pragma unroll
            for (int m = 0; m < 4; ++m) { const int row = row0 + ai * HALF + m * 16; const size_t off = (size_t)row * DM + col0; const f32x4* pp = (const f32x4*)(pssq + (size_t)row * 16);
                const f32x4 p0 = pp[0], p1 = pp[1], p2 = pp[2], p3 = pp[3];
                const float rp = rsqrtf((((p0[0] + p0[1]) + (p0[2] + p0[3])) + ((p1[0] + p1[1]) + (p1[2] + p1[3])) + ((p2[0] + p2[1]) + (p2[2] + p2[3])) + ((p3[0] + p3[1]) + (p3[2] + p3[3]))) * (1.f / DM) + EPS);
                float ss = 0.f;
#pragma unroll
                for (int bj = 0; bj < 2; ++bj)
#pragma unroll
                    for (int n = 0; n < 2; ++n) { const size_t o = off + bj * HALF + n * 16; const u32x2 pr = *(const u32x2*)(pler + o); const f32x4 a = acc[ai][bj][m][n]; const f32x4 hv = *(const f32x4*)(H + o);
                        const f32x4 pl = {blo(pr.x), bhi(pr.x), blo(pr.y), bhi(pr.y)}; f32x4 r;
#pragma unroll
                        for (int j = 0; j < 4; ++j) r[j] = hv[j] + fast_sigmoid(a[j]) * (pl[j] * rp * gv[bj][n][j]);
                        *(f32x4*)(H + o) = r; ss += sq4(r); }
                ss = red_fq(ss); if (fq == 0) fssq[(size_t)row * 16 + u.pn * 4 + wc] = ss; }
    }
};
}

namespace att {
typedef float f32x16 __attribute__((ext_vector_type(16)));
typedef short s16x4 __attribute__((ext_vector_type(4)));
constexpr int QBLK = 32, KVBLK = 64, QB = 256;
constexpr int SHM_K = KVBLK * DQK * 2, SHM_V = KVBLK * DV * 2;
constexpr int L_V = 0, L_K = 2 * SHM_V, L_WS = L_K + 2 * SHM_K, L_END = L_WS + NWAVES * 256;
constexpr float THR = 8.f;
#define KSWZ(row, colB) ((row) * 384 + ((colB) ^ (((row) & 7) << 4)))
#define SBAR() __builtin_amdgcn_sched_barrier(0)
__device__ __forceinline__ int v_st(int k, int c) { const int kk = (k & ~0xC) | ((k & 4) << 1) | ((k & 8) >> 1); return ((kk >> 3) * 4 + (c >> 5)) * 512 + ((kk & 7) * 32 + (c & 31)) * 2; }
__device__ __forceinline__ int v_rd_base(int lane) { return ((lane & 3) << 3) | (((lane >> 2) & 3) << 6) | (((lane >> 4) & 1) << 5) | (((lane >> 5) & 1) << 8); }
constexpr int v_rd_off(int d0, int ks, int half) { return d0 * 512 + ks * 4096 + half * 2048; }
__device__ __forceinline__ int crow(int r, int hi) { return (r & 3) + 8 * (r >> 2) + 4 * hi; }
typedef __bf16 bf16x2_t __attribute__((ext_vector_type(2)));
__device__ __forceinline__ unsigned cvtpk(float lo, float hi) { f32x2 v = {lo, hi}; bf16x2_t b = __builtin_convertvector(v, bf16x2_t); return __builtin_bit_cast(unsigned, b); }

__device__ __forceinline__ void qkt(f32x16& p0, f32x16& p1, const LAS unsigned char* Kbuf, int r32, int hi, const bf16x8* qr) {
    p0 = f32x16{}; p1 = f32x16{};
    const LAS unsigned char* kb[4];
#pragma unroll
    for (int dd = 0; dd < 4; ++dd) kb[dd] = Kbuf + KSWZ(r32, (dd * 16 + hi * 8) * 2);
#pragma unroll
    for (int d0 = 0; d0 < 12; ++d0) { const LAS unsigned char* a = kb[d0 & 3] + (d0 >> 2) * 128;
        const bf16x8 b0 = *(const LAS bf16x8*)a; const bf16x8 b1 = *(const LAS bf16x8*)(a + 32 * 384);
        p0 = __builtin_amdgcn_mfma_f32_32x32x16_bf16(b0, qr[d0], p0, 0, 0, 0);
        p1 = __builtin_amdgcn_mfma_f32_32x32x16_bf16(b1, qr[d0], p1, 0, 0, 0); }
}
template <int VB>
__device__ __forceinline__ void pv_tile(f32x16* o, int vb0, bf16x8 pa0, bf16x8 pa1, bf16x8 pa2, bf16x8 pa3) {
#define TRRD(dst, off) asm volatile("ds_read_b64_tr_b16 %0, %1 offset:%2" : "=&v"(dst) : "v"(vb0), "i"(off) : "memory")
#define PV_D0(d0) do { s16x4 l0, l1, l2, l3, h0, h1, h2, h3; constexpr int b_ = VB * SHM_V + v_rd_off(d0, 0, 0); \
        TRRD(l0, b_); TRRD(h0, b_ + 2048); TRRD(l1, b_ + 4096); TRRD(h1, b_ + 6144); TRRD(l2, b_ + 8192); TRRD(h2, b_ + 10240); TRRD(l3, b_ + 12288); TRRD(h3, b_ + 14336); \
        asm volatile("s_waitcnt lgkmcnt(0)" ::: "memory"); SBAR(); \
        o[d0] = __builtin_amdgcn_mfma_f32_32x32x16_bf16(pa0, (bf16x8){l0[0], l0[1], l0[2], l0[3], h0[0], h0[1], h0[2], h0[3]}, o[d0], 0, 0, 0); \
        o[d0] = __builtin_amdgcn_mfma_f32_32x32x16_bf16(pa1, (bf16x8){l1[0], l1[1], l1[2], l1[3], h1[0], h1[1], h1[2], h1[3]}, o[d0], 0, 0, 0); \
        o[d0] = __builtin_amdgcn_mfma_f32_32x32x16_bf16(pa2, (bf16x8){l2[0], l2[1], l2[2], l2[3], h2[0], h2[1], h2[2], h2[3]}, o[d0], 0, 0, 0); \
        o[d0] = __builtin_amdgcn_mfma_f32_32x32x16_bf16(pa3, (bf16x8){l3[0], l3[1], l3[2], l3[3], h3[0], h3[1], h3[2], h3[3]}, o[d0], 0, 0, 0); } while (0)
    PV_D0(0); PV_D0(1); PV_D0(2); PV_D0(3);
#undef PV_D0
#undef TRRD
}
__device__ __forceinline__ void attn_block(int bh, int qb, const bf16_t* __restrict__ Q, const bf16_t* __restrict__ K, const bf16_t* __restrict__ V, bf16_t* __restrict__ MIX, float* __restrict__ ASSQ, LAS unsigned char* lds, const int wid) {
    const int lane = lane_id(), r32 = lane & 31, hi = lane >> 5;
    const int b = bh / NH, h = bh % NH;
    const bf16_t* Qw = Q + ((size_t)bh * SEQ + qb * QB + wid * QBLK + r32) * DQK;
    const bf16_t* Kh = K + (size_t)bh * SEQ * DQK; const bf16_t* Vh = V + (size_t)bh * SEQ * DV;
    bf16x8 qr[12];
#pragma unroll
    for (int d0 = 0; d0 < 12; ++d0) qr[d0] = *(const bf16x8*)(Qw + d0 * 16 + hi * 8);
    const int NT = 4 * qb + 4, qlo = qb * QB + wid * QBLK, qm = qlo + r32 - 4 * hi;
    LAS unsigned char* V_lds = lds + L_V; LAS unsigned char* K_lds = lds + L_K;
    LAS float* wsf = (LAS float*)(lds + L_WS) + wid * 64; LAS float* li_l = wsf; LAS float* al_l = wsf + 32;
    unsigned ksrc[3], vsrc[2];
#pragma unroll
    for (int i = 0; i < 3; ++i) { const int off = ((wid + 8 * i) * 64 + lane) * 16, row = off / 384, wb = off % 384, seg = wb >> 7, cpos = (wb & 127) >> 4; ksrc[i] = (unsigned)(row * 384 + seg * 128 + ((cpos ^ (row & 7)) << 4)); }
#pragma unroll
    for (int i = 0; i < 2; ++i) { const int off = ((wid + 8 * i) * 64 + lane) * 16, st = off >> 9, o_ = off & 511, kk = (st >> 2) * 8 + (o_ >> 6), c = (st & 3) * 32 + ((o_ & 63) >> 1);
        const int k = (kk & ~0xC) | ((kk & 4) << 1) | ((kk & 8) >> 1); vsrc[i] = (unsigned)(k * 256 + c * 2); }
    const int vb0 = (int)(unsigned)(uintptr_t)V_lds + v_rd_base(lane);
#define ADMA(t, bf) do { const char* kp = (const char*)(Kh + (size_t)(t) * KVBLK * DQK); const char* vp = (const char*)(Vh + (size_t)(t) * KVBLK * DV); \
        _Pragma("unroll") for (int i = 0; i < 3; ++i) __builtin_amdgcn_global_load_lds((const unsigned*)(kp + ksrc[i]), (LAS unsigned*)(K_lds + (bf) * SHM_K + (wid + 8 * i) * 1024), 16, 0, 0); \
        _Pragma("unroll") for (int i = 0; i < 2; ++i) __builtin_amdgcn_global_load_lds((const unsigned*)(vp + vsrc[i]), (LAS unsigned*)(V_lds + (bf) * SHM_V + (wid + 8 * i) * 1024), 16, 0, 0); } while (0)
    float m_reg = -1e30f, l_reg = 0.f; f32x16 o[4] = {};
    ADMA(0, 0);
#define TILE(t, BF) do { \
        asm volatile("s_waitcnt vmcnt(0)" ::: "memory"); __syncthreads(); \
        if ((t) + 1 < NT) ADMA((t) + 1, (BF) ^ 1); \
        const int kb_ = (t) * KVBLK; \
        if (kb_ <= qlo + QBLK - 1) { \
            f32x16 p0, p1; SBAR(); qkt(p0, p1, K_lds + (BF) * SHM_K, r32, hi, qr); \
            if (kb_ + KVBLK - 1 > qlo) { const int dq = qm - kb_; const float NEG = -__builtin_inff(); \
                _Pragma("unroll") for (int r = 0; r < 16; ++r) { const int c = (r & 3) + 8 * (r >> 2); if (c > dq) p0[r] = NEG; if (c + 32 > dq) p1[r] = NEG; } } \
            float pmax = p0[0]; _Pragma("unroll") for (int r = 1; r < 16; ++r) pmax = fmaxf(pmax, p0[r]); _Pragma("unroll") for (int r = 0; r < 16; ++r) pmax = fmaxf(pmax, p1[r]); \
            { auto rr = __builtin_amdgcn_permlane32_swap(__float_as_uint(pmax), __float_as_uint(pmax), false, false); pmax = fmaxf(__uint_as_float(rr[0]), __uint_as_float(rr[1])); } \
            if (!__all(pmax - m_reg <= THR)) { const float mn = fmaxf(m_reg, pmax); const float alpha = __builtin_amdgcn_exp2f(m_reg - mn); m_reg = mn; l_reg *= alpha; \
                if (hi == 0) al_l[r32] = alpha; asm volatile("s_waitcnt lgkmcnt(0)" ::: "memory"); \
                _Pragma("unroll") for (int d_ = 0; d_ < 4; ++d_) _Pragma("unroll") for (int r = 0; r < 16; ++r) o[d_][r] *= al_l[crow(r, hi)]; } \
            float ps = 0.f; \
            _Pragma("unroll") for (int r = 0; r < 16; ++r) { p0[r] = __builtin_amdgcn_exp2f(p0[r] - m_reg); p1[r] = __builtin_amdgcn_exp2f(p1[r] - m_reg); } \
            _Pragma("unroll") for (int r = 0; r < 16; ++r) ps += p0[r] + p1[r]; \
            { auto rr = __builtin_amdgcn_permlane32_swap(__float_as_uint(ps), __float_as_uint(ps), false, false); ps = __uint_as_float(rr[0]) + __uint_as_float(rr[1]); } \
            l_reg += ps; \
            bf16x8 pa0, pa1, pa2, pa3; \
            PK4(p0, 0, pa0); PK4(p0, 8, pa1); PK4(p1, 0, pa2); PK4(p1, 8, pa3); \
            SBAR(); pv_tile<BF>(o, vb0, pa0, pa1, pa2, pa3); } } while (0)
#define PK4(P, B_, OUT) do { unsigned a0 = cvtpk(P[B_ + 0], P[B_ + 1]), a1 = cvtpk(P[B_ + 2], P[B_ + 3]); \
        unsigned b0 = cvtpk(P[B_ + 4], P[B_ + 5]), b1 = cvtpk(P[B_ + 6], P[B_ + 7]); \
        auto r0 = __builtin_amdgcn_permlane32_swap(a0, b0, false, false); auto r1 = __builtin_amdgcn_permlane32_swap(a1, b1, false, false); \
        u32x4 w = {r0[0], r1[0], r0[1], r1[1]}; OUT = __builtin_bit_cast(bf16x8, w); } while (0)
    for (int t = 0; t < NT; t += 2) { TILE(t, 0); TILE(t + 1, 1); }
#undef PK4
#undef TILE
#undef ADMA
    if (hi == 0) li_l[r32] = l_reg;
    asm volatile("s_waitcnt vmcnt(0) lgkmcnt(0)" ::: "memory");
    float rli[16];
#pragma unroll
    for (int r = 0; r < 16; ++r) rli[r] = __builtin_amdgcn_rcpf(li_l[crow(r, hi)]);
    __syncthreads();
    LAS bf16_t* stg = (LAS bf16_t*)(lds + wid * 8192);
#pragma unroll
    for (int r = 0; r < 16; ++r) { const int orow = crow(r, hi);
#pragma unroll
        for (int d0 = 0; d0 < 4; ++d0) stg[orow * 128 + d0 * 32 + r32] = f2bf(o[d0][r] * rli[r]); }
    asm volatile("s_waitcnt lgkmcnt(0)" ::: "memory");
    const size_t row0 = (size_t)b * SEQ + qb * QB + wid * QBLK;
#pragma unroll
    for (int i = 0; i < 8; ++i) { const int row = i * 4 + (lane >> 4), ch = lane & 15; const u32x4 v = *(const LAS u32x4*)(stg + row * 128 + ch * 8);
        float ss = (blo(v.x) * blo(v.x) + bhi(v.x) * bhi(v.x)) + (blo(v.y) * blo(v.y) + bhi(v.y) * bhi(v.y)) + (blo(v.z) * blo(v.z) + bhi(v.z) * bhi(v.z)) + (blo(v.w) * blo(v.w) + bhi(v.w) * bhi(v.w));
        ss += __shfl_xor(ss, 1); ss += __shfl_xor(ss, 2); ss += __shfl_xor(ss, 4); ss += __shfl_xor(ss, 8);
        *(u32x4*)(MIX + (row0 + row) * DM + h * DV + ch * 8) = v;
        if (ch == 0) ASSQ[(row0 + row) * 4 + h] = ss; }
    __syncthreads();
}
#undef KSWZ
#undef SBAR
}

struct Args { const void* in[25]; float* out; unsigned char* ws; int ph_lo, ph_hi, li, skip; };
enum { PH_PREP = 0, PH_INPROJ, PH_TOKLOCAL, PH_ATTN, PH_WO, PH_ROUTER, PH_ROUTE, PH_MOE1, PH_MOE2, PH_COMBINE, PH_PLE, PH_FINAL, PH_COUNT };

template <int MODE> __device__ __forceinline__ int cmap_col(int n) {
    if (MODE == 1) { const int pn = n >> 8, half = (n >> 7) & 1, jj = n & 127; return half * 1024 + pn * 128 + jj; }
    if (MODE == 2) { const int h = n / DQK, d = n % DQK; if (d < DN) return n; const int t = d - DN; return h * DQK + DN + (t & 1) * 32 + (t >> 1); }
    return n;
}
template <int MODE> __device__ __forceinline__ void transpose_item(const float* __restrict__ W, int ldsrc, int nblk, bf16_t* __restrict__ WT, int ldd, const float* __restrict__ gain, const float* __restrict__ gain2, float scale,
                                                                  LAS float* scr, int item, int lane) {
    const int kb = item / nblk, nb = item % nblk, k0 = 64 * kb, n0 = 32 * nb; const int c = cmap_col<MODE>(n0 + (lane & 31));
#pragma unroll 8
    for (int i = 0; i < 32; ++i) { const int kk = 2 * i + (lane >> 5), k = k0 + kk; float gk = scale; if (gain) gk *= (gain2 && k >= 512) ? gain2[k - 512] : gain[k];
        scr[kk * 33 + (lane & 31)] = W[(size_t)k * ldsrc + c] * gk; }
    asm volatile("s_waitcnt lgkmcnt(0)" ::: "memory");
    const int cc = lane & 7;
#pragma unroll
    for (int j = 0; j < 4; ++j) { const int n = (lane >> 3) + 8 * j; const LAS float* s = scr + (8 * cc) * 33 + n;
        u32x4 o; o.x = pk2(s[0 * 33], s[1 * 33]); o.y = pk2(s[2 * 33], s[3 * 33]); o.z = pk2(s[4 * 33], s[5 * 33]); o.w = pk2(s[6 * 33], s[7 * 33]);
        *(u32x4*)(WT + (size_t)(n0 + n) * ldd + k0 + 8 * cc) = o; }
    asm volatile("s_waitcnt lgkmcnt(0)" ::: "memory");
}

__global__ void __launch_bounds__(NTHREADS, 2) fwd(Args args) {
    extern __shared__ __attribute__((aligned(16))) unsigned char lds_raw[];
    LAS unsigned char* lds = (LAS unsigned char*)lds_raw;
    volatile LAS unsigned* MISC = (volatile LAS unsigned*)(lds + MISC_OFF);
    const int wave = __builtin_amdgcn_readfirstlane(threadIdx.x >> 6);
    const int G = gridDim.x, bx = blockIdx.x;
#define PHASE_LANE const int lane = lane_id(); const int tid = wave * 64 + lane; (void)tid
    const int gw = bx * NWAVES + wave, NGW = G * NWAVES;
    unsigned char* ws = args.ws; int* ctl = (int*)(ws + WS_CTL); float* H = args.out;
    const float* x = (const float*)args.in[0]; const float* p = (const float*)args.in[1]; const int* pos = (const int*)args.in[2];
    const float *mix_norm = (const float*)args.in[3], *w_in = (const float*)args.in[4], *q_norm = (const float*)args.in[5], *w_uq = (const float*)args.in[6], *kv_norm = (const float*)args.in[7],
                *w_ukv = (const float*)args.in[8], *attn_out_norm = (const float*)args.in[10], *conv_out_norm = (const float*)args.in[11], *w_o = (const float*)args.in[12],
                *moe_norm = (const float*)args.in[13], *w_router = (const float*)args.in[14], *w1 = (const float*)args.in[16], *b1 = (const float*)args.in[17],
                *w2 = (const float*)args.in[18], *b2 = (const float*)args.in[19], *ple_norm = (const float*)args.in[20], *w_ple_gate = (const float*)args.in[21], *w_ple_proj = (const float*)args.in[22],
                *ple_post_norm = (const float*)args.in[23], *conv_w = (const float*)args.in[9], *b_router = (const float*)args.in[15], *final_norm = (const float*)args.in[24];
    int* TOPI = (int*)(ws + WS_TOPI); float* TOPG = (float*)(ws + WS_TOPG);
    bf16_t *WIN = (bf16_t*)(ws + WS_WIN), *WUQ = (bf16_t*)(ws + WS_WUQ), *WUKV = (bf16_t*)(ws + WS_WUKV), *WO = (bf16_t*)(ws + WS_WO), *WG = (bf16_t*)(ws + WS_WG), *WP = (bf16_t*)(ws + WS_WP);
    bf16_t *W1T = (bf16_t*)(ws + WS_W1), *W2T = (bf16_t*)(ws + WS_W2), *XN = (bf16_t*)(ws + WS_XN), *MIX = (bf16_t*)(ws + WS_MIX), *PLER = (bf16_t*)(ws + WS_PLER);
    bf16_t *Z = (bf16_t*)(ws + WS_Z), *Qb = (bf16_t*)(ws + WS_Q), *Kb = (bf16_t*)(ws + WS_K), *Vb = (bf16_t*)(ws + WS_V), *HB = (bf16_t*)(ws + WS_HB), *Y = (bf16_t*)(ws + WS_Y), *P16 = (bf16_t*)(ws + WS_P16);
    float *WR = (float*)(ws + WS_WR), *CS = (float*)(ws + WS_CS), *SSQ = (float*)(ws + WS_SSQ), *ASSQ = (float*)(ws + WS_ASSQ), *PSSQ = (float*)(ws + WS_PSSQ), *FSSQ = (float*)(ws + WS_FSSQ);
    int *ROWTOK = (int*)(ws + WS_ROWTOK), *ROWSLOT = (int*)(ws + WS_ROWSLOT); float* ROWGATE = (float*)(ws + WS_ROWGATE);

    { PHASE_LANE; for (int u = tid; u < (LDS_BYTES - MISC_OFF) / 4; u += NTHREADS) ((LAS unsigned*)(lds + MISC_OFF))[u] = 0u; }
    __syncthreads();
    const int lo = args.ph_lo, hi = args.ph_hi;
    XcdBarrier bar; bar.bar = (unsigned*)ctl + CW_BAR + args.li * XCD_BAR_WORDS; bar.x = 0; bar.st = MISC + 8;
    if (hi - lo > 1) bar = xcd_barrier_post((unsigned*)ctl + CW_BAR + args.li * XCD_BAR_WORDS, MISC + 8, wave);
#define IN(k) (lo <= (k) && (k) < hi)
#define SEAM(k) do { if (IN(k) && IN((k) + 1)) xcd_barrier(bar, wave); } while (0)

    if (IN(PH_PREP)) {
        PHASE_LANE;
        LAS float* scr = (LAS float*)(lds + wave * 16384);
        constexpr int I_IN = (DM / 64) * (INW / 32), I_UQ = (QL / 64) * (768 / 32), I_UKV = (KVL / 64) * (1024 / 32), I_O = (DM / 64) * (DM / 32), I_G = I_O, I_P = (PLE / 64) * (DM / 32);
        constexpr int I_1 = (DM / 64) * (2048 / 32), I_2 = (DE / 64) * (DM / 32);
        constexpr int NITEMS = I_IN + I_UQ + I_UKV + I_O + I_G + I_P + NE * I_1 + NE * I_2;
        for (int it = gw; it < NITEMS; it += NGW) {
            int r = it;
            if (r < I_IN) { transpose_item<0>(w_in, INW, INW / 32, WIN, DM, mix_norm, nullptr, 1.f, scr, r, lane); continue; } r -= I_IN;
            if (r < I_UQ) { transpose_item<2>(w_uq, 768, 768 / 32, WUQ, QL, q_norm, nullptr, QSCALE, scr, r, lane); continue; } r -= I_UQ;
            if (r < I_UKV) { transpose_item<0>(w_ukv, 1024, 1024 / 32, WUKV, 256, kv_norm, nullptr, 1.f, scr, r, lane); continue; } r -= I_UKV;
            if (r < I_O) { transpose_item<0>(w_o, DM, DM / 32, WO, DM, attn_out_norm, conv_out_norm, 1.f, scr, r, lane); continue; } r -= I_O;
            if (r < I_G) { transpose_item<0>(w_ple_gate, DM, DM / 32, WG, DM, ple_norm, nullptr, 1.f, scr, r, lane); continue; } r -= I_G;
            if (r < I_P) { transpose_item<0>(w_ple_proj, DM, DM / 32, WP, PLE, nullptr, nullptr, 1.f, scr, r, lane); continue; } r -= I_P;
            if (r < NE * I_1) { const int e = r / I_1; transpose_item<1>(w1 + (size_t)e * DM * 2048, 2048, 2048 / 32, W1T + (size_t)e * 2048 * DM, DM, moe_norm, nullptr, 1.f, scr, r % I_1, lane); continue; } r -= NE * I_1;
            { const int e = r / I_2; transpose_item<0>(w2 + (size_t)e * DE * DM, DM, DM / 32, W2T + (size_t)e * DM * DE, DE, nullptr, nullptr, 1.f, scr, r % I_2, lane); }
        }
        for (int i = bx * NTHREADS + tid; i < 1024 * 16; i += G * NTHREADS) *(u32x4*)(WUKV + (size_t)(i >> 4) * 256 + 128 + (i & 15) * 8) = (u32x4){0u, 0u, 0u, 0u};
        for (int i = bx * NTHREADS + tid; i < DM * NE; i += G * NTHREADS) { const int e = i >> 10, k = i & 1023; WR[i] = w_router[k * NE + e] * moe_norm[k]; }
        for (int i = bx * NTHREADS + tid; i < NTOK * 32; i += G * NTHREADS) { const int t = i >> 5, j = i & 31; const float inv = powf(10000.f, -(float)j / 32.f); const float a = (float)pos[t] * inv; float sn, c; sincosf(a, &sn, &c);
            CS[(size_t)t * 64 + j] = c; CS[(size_t)t * 64 + 32 + j] = sn; }
        for (int i = bx * NTHREADS + tid; i < NTOK * PLE / 4; i += G * NTHREADS) { const f32x4 v = ((const f32x4*)p)[i]; ((u32x2*)P16)[i] = (u32x2){pk2(v[0], v[1]), pk2(v[2], v[3])}; }
        for (int row = gw; row < NTOK; row += NGW) {
            const f32x4* s = (const f32x4*)(x + (size_t)row * DM); f32x4 v[4]; float ss = 0.f;
#pragma unroll
            for (int j = 0; j < 4; ++j) { v[j] = s[lane + 64 * j]; ss += pg8::sq4(v[j]); }
            const float rstd = rsqrtf(wave_sum(ss) * (1.f / DM) + EPS);
            u32x2* d = (u32x2*)(XN + (size_t)row * DM);
#pragma unroll
            for (int j = 0; j < 4; ++j) d[lane + 64 * j] = (u32x2){pk2(v[j][0] * rstd, v[j][1] * rstd), pk2(v[j][2] * rstd, v[j][3] * rstd)};
        }
    }
    SEAM(PH_PREP);
    if (IN(PH_INPROJ)) {
        { pg8::Gemm g{XN, WIN, DM, DM, DM, nullptr, 0}; pg8::StaticOrder S; S.init(NTOK / 256, INWP / 256, G, bx, nullptr);
          pg8::EpiBf16Stats<0> E{Z, INWP, SSQ}; pg8::gemm_phase<pg8::EpiBf16Stats<0>, false>(lds, g, S, E, wave); }
        { pg8::Gemm g{P16, WP, PLE, PLE, PLE, nullptr, 0}; pg8::StaticOrder S; S.init(NTOK / 256, DM / 256, G, bx, nullptr);
          pg8::EpiBf16Stats<1> E{PLER, DM, PSSQ}; pg8::gemm_phase<pg8::EpiBf16Stats<1>, false>(lds, g, S, E, wave); }
    }
    SEAM(PH_INPROJ);
    if (IN(PH_TOKLOCAL)) {
        PHASE_LANE;
        if (!(args.skip & 1)) for (int row = gw; row < NTOK; row += NGW) {
            const bf16_t* z = Z + (size_t)row * INWP; const int s = row % SEQ, b = row / SEQ;
            if (lane < 32) { const float x1 = bf2f(z[384 + lane]), x2 = bf2f(z[416 + lane]); const float c = CS[(size_t)row * 64 + lane], sn = CS[(size_t)row * 64 + 32 + lane];
                const unsigned o = pk2(x1 * c - x2 * sn, x1 * sn + x2 * c);
#pragma unroll
                for (int h = 0; h < NH; ++h) *(unsigned*)(Kb + ((size_t)(b * NH + h) * SEQ + s) * DQK + DN + 2 * lane) = o; }
            float y[8]; float ss = 0.f;
#pragma unroll
            for (int j = 0; j < 8; ++j) { const int c = lane + 64 * j;
                const float u0 = bf2f(z[960 + c]) * bf2f(z[1472 + c]);
                const float u1 = s >= 1 ? bf2f(z[960 + c - INWP]) * bf2f(z[1472 + c - INWP]) : 0.f;
                const float u2 = s >= 2 ? bf2f(z[960 + c - 2 * INWP]) * bf2f(z[1472 + c - 2 * INWP]) : 0.f;
                const float v = bf2f(z[448 + c]) * (conv_w[c] * u2 + conv_w[512 + c] * u1 + conv_w[1024 + c] * u0);
                y[j] = v; ss += v * v; }
            const float rstd = rsqrtf(wave_sum(ss) * (1.f / 512.f) + EPS);
#pragma unroll
            for (int j = 0; j < 8; ++j) MIX[(size_t)row * DM + 512 + lane + 64 * j] = f2bf(y[j] * rstd);
        }
        { pg8::Gemm g{Z, WUQ, QL, INWP, QL, nullptr, 0}; pg8::StaticOrder S; S.init(NTOK / 256, 768 / 256, G, bx, nullptr);
          pg8::EpiQ E{Qb, SSQ, CS}; pg8::gemm_phase<pg8::EpiQ, false>(lds, g, S, E, wave); }
        { pg8::Gemm g{Z + 256, WUKV, 256, INWP, 256, nullptr, 0}; pg8::StaticOrder S; S.init(NTOK / 256, 1024 / 256, G, bx, nullptr);
          pg8::EpiKV E{Kb, Vb, SSQ}; pg8::gemm_phase<pg8::EpiKV, false>(lds, g, S, E, wave); }
    }
    SEAM(PH_TOKLOCAL);
    if (IN(PH_ATTN)) {
        const int vcu = (G % 8 == 0) ? (bx % 8) * (G / 8) + bx / 8 : bx;
        for (int it = vcu; it < NB * NH * 8; it += G) { const int bh = it >> 3, pr = it & 7;
            for (int pass = 0; pass < 2; ++pass) att::attn_block(bh, pass ? pr : 15 - pr, Qb, Kb, Vb, MIX, ASSQ, lds, wave); }
    }
    SEAM(PH_ATTN);
    if (IN(PH_WO)) {
        pg8::Gemm g{MIX, WO, DM, DM, DM, nullptr, 0}; pg8::StaticOrder S; S.init(NTOK / 256, DM / 256, G, bx, nullptr);
        pg8::EpiWo E{x, H, ASSQ}; pg8::gemm_phase<pg8::EpiWo, false>(lds, g, S, E, wave);
    }
    SEAM(PH_WO);
    if (IN(PH_ROUTER)) {
        PHASE_LANE;
        typedef float f32x16 __attribute__((ext_vector_type(16)));
        LAS int* hist = (LAS int*)(lds + HIST_OFF);
        for (int i = tid; i < NE * 256; i += NTHREADS) { const int e = i >> 8, kc = i & 255; *(LAS f32x4*)(lds + e * 4096 + ((kc ^ (e & 15)) << 4)) = ((const f32x4*)WR)[i]; }
        if (tid < NE) hist[tid] = 0;
        __syncthreads();
        for (int chunk = bx; chunk < NTOK / 128; chunk += G) {
            const int base = chunk * 128;
            if (wave < 4) {
                const int j = lane & 31, half = lane >> 5, tok = base + wave * 32 + j;
                const f32x4* xr = (const f32x4*)(H + (size_t)tok * DM) + 2 * half; const LAS unsigned char* wrow = lds + j * 4096;
                f32x16 acc = {}; float ss = 0.f;
#pragma unroll 2
                for (int c = 0; c < 64; ++c) { const f32x4 x0 = xr[4 * c], x1 = xr[4 * c + 1];
                    const f32x4 w0 = *(const LAS f32x4*)(wrow + (((4 * c + 2 * half) ^ (j & 15)) << 4)), w1 = *(const LAS f32x4*)(wrow + (((4 * c + 2 * half + 1) ^ (j & 15)) << 4));
                    ss += pg8::sq4(x0) + pg8::sq4(x1);
#pragma unroll
                    for (int q = 0; q < 4; ++q) acc = __builtin_amdgcn_mfma_f32_32x32x2f32(w0[q], x0[q], acc, 0, 0, 0);
#pragma unroll
                    for (int q = 0; q < 4; ++q) acc = __builtin_amdgcn_mfma_f32_32x32x2f32(w1[q], x1[q], acc, 0, 0, 0); }
                ss += __shfl_xor(ss, 32); const float rstd = rsqrtf(ss * (1.f / DM) + EPS);
                float v[16];
#pragma unroll
                for (int r = 0; r < 16; ++r) v[r] = acc[r] * rstd + b_router[(r & 3) + 8 * (r >> 2) + 4 * half];
                float lv[4]; int li[4];
#pragma unroll
                for (int t = 0; t < 4; ++t) { float best = -__builtin_inff(); int bi = 0;
#pragma unroll
                    for (int r = 0; r < 16; ++r) if (v[r] > best) { best = v[r]; bi = (r & 3) + 8 * (r >> 2) + 4 * half; }
                    const auto rv = __builtin_amdgcn_permlane32_swap(__float_as_uint(best), __float_as_uint(best), false, false); const auto ri = __builtin_amdgcn_permlane32_swap((unsigned)bi, (unsigned)bi, false, false);
                    const float b0 = __uint_as_float(rv[0]), b1 = __uint_as_float(rv[1]); const int i0 = (int)ri[0], i1 = (int)ri[1];
                    const bool t0 = (b0 > b1) || (b0 == b1 && i0 < i1); const float gb = t0 ? b0 : b1; const int gi = t0 ? i0 : i1; lv[t] = gb; li[t] = gi;
#pragma unroll
                    for (int r = 0; r < 16; ++r) if ((r & 3) + 8 * (r >> 2) + 4 * half == gi) v[r] = -__builtin_inff(); }
                if (half == 0) { const float e1 = __expf(lv[1] - lv[0]), e2 = __expf(lv[2] - lv[0]), e3 = __expf(lv[3] - lv[0]); const float inv = 1.f / (1.f + e1 + e2 + e3);
                    *(int4*)(TOPI + (size_t)tok * 4) = make_int4(li[0], li[1], li[2], li[3]); *(f32x4*)(TOPG + (size_t)tok * 4) = (f32x4){inv, e1 * inv, e2 * inv, e3 * inv};
#pragma unroll
                    for (int t = 0; t < 4; ++t) (void)__hip_atomic_fetch_add(hist + li[t], 1, __ATOMIC_RELAXED, __HIP_MEMORY_SCOPE_WORKGROUP); }
            } else {
                for (int rr = 0; rr < 32; ++rr) { const int row = base + (wave - 4) * 32 + rr;
                    const f32x4* s4 = (const f32x4*)(H + (size_t)row * DM); f32x4 v[4]; float ss = 0.f;
#pragma unroll
                    for (int j = 0; j < 4; ++j) { v[j] = s4[lane + 64 * j]; ss += pg8::sq4(v[j]); }
                    const float rstd = rsqrtf(wave_sum(ss) * (1.f / DM) + EPS);
                    u32x2* d = (u32x2*)(XN + (size_t)row * DM);
#pragma unroll
                    for (int j = 0; j < 4; ++j) d[lane + 64 * j] = (u32x2){pk2(v[j][0] * rstd, v[j][1] * rstd), pk2(v[j][2] * rstd, v[j][3] * rstd)}; }
            }
        }
        __syncthreads();
        if (tid < NE) atomicAdd(ctl + CW_CNT + tid, hist[tid]);
    }
    SEAM(PH_ROUTER);
    if (IN(PH_ROUTE)) {
        PHASE_LANE;
        LAS int* sh = (LAS int*)lds;
        if (tid == 0) { int ps = 0, nt = 0;
            for (int e = 0; e < NE; ++e) { sh[e] = ps; const int t = (ctl[CW_CNT + e] + 255) >> 8; if (bx == 0) for (int q = 0; q < t; ++q) ctl[CW_TILE_E + nt + q] = e; nt += t; ps += t * 256; }
            sh[NE] = ps; if (bx == 0) ctl[CW_NTILES] = nt; }
        __syncthreads();
        for (int chunk = bx; chunk < MROWS / NTHREADS; chunk += G) {
            if (tid < NE) sh[64 + tid] = 0;
            __syncthreads();
            const int idx = chunk * NTHREADS + tid, e = TOPI[idx]; const int r = __hip_atomic_fetch_add(sh + 64 + e, 1, __ATOMIC_RELAXED, __HIP_MEMORY_SCOPE_WORKGROUP);
            __syncthreads();
            if (tid < NE) sh[128 + tid] = atomicAdd(ctl + CW_CURSOR + tid, sh[64 + tid]);
            __syncthreads();
            const int dest = sh[e] + sh[128 + e] + r; ROWTOK[dest] = idx >> 2; ROWSLOT[dest] = idx; ROWGATE[dest] = TOPG[idx];
            __syncthreads();
        }
        for (int e = bx; e < NE; e += G) { const int plo = sh[e] + ctl[CW_CNT + e], phi = sh[e + 1];
            for (int r = plo + tid; r < phi; r += NTHREADS) { ROWTOK[r] = 0; ROWSLOT[r] = MROWS; ROWGATE[r] = 0.f; } }
        __syncthreads();
    }
    SEAM(PH_ROUTE);
    if (IN(PH_MOE1)) {
        pg8::Gemm g{XN, W1T, DM, DM, DM, ROWTOK, (size_t)2048 * DM * 2}; pg8::StaticOrder S; S.init(ctl[CW_NTILES], 2048 / 256, G, bx, ctl + CW_TILE_E);
        pg8::EpiMoe1 E{HB, b1}; pg8::gemm_phase<pg8::EpiMoe1, true>(lds, g, S, E, wave);
    }
    SEAM(PH_MOE1);
    if (IN(PH_MOE2)) {
        pg8::Gemm g{HB, W2T, DE, DE, DE, nullptr, (size_t)DM * DE * 2}; pg8::StaticOrder S; S.init(ctl[CW_NTILES], DM / 256, G, bx, ctl + CW_TILE_E);
        pg8::EpiMoe2 E{Y, b2, ROWSLOT, ROWGATE}; pg8::gemm_phase<pg8::EpiMoe2, false>(lds, g, S, E, wave);
    }
    SEAM(PH_MOE2);
    if (IN(PH_COMBINE)) {
        PHASE_LANE;
        for (int row = gw; row < NTOK; row += NGW) {
            f32x4* hp = (f32x4*)(H + (size_t)row * DM); f32x4 v[4]; float ss = 0.f;
#pragma unroll
            for (int j = 0; j < 4; ++j) { v[j] = hp[lane + 64 * j];
#pragma unroll
                for (int k = 0; k < 4; ++k) { const u32x2 y = *(const u32x2*)(Y + ((size_t)row * 4 + k) * DM + 4 * (lane + 64 * j)); v[j][0] += blo(y.x); v[j][1] += bhi(y.x); v[j][2] += blo(y.y); v[j][3] += bhi(y.y); }
                hp[lane + 64 * j] = v[j]; ss += pg8::sq4(v[j]); }
            const float rstd = rsqrtf(wave_sum(ss) * (1.f / DM) + EPS);
            u32x2* d = (u32x2*)(XN + (size_t)row * DM);
#pragma unroll
            for (int j = 0; j < 4; ++j) d[lane + 64 * j] = (u32x2){pk2(v[j][0] * rstd, v[j][1] * rstd), pk2(v[j][2] * rstd, v[j][3] * rstd)};
        }
    }
    SEAM(PH_COMBINE);
    if (IN(PH_PLE)) {
        pg8::Gemm g{XN, WG, DM, DM, DM, nullptr, 0}; pg8::StaticOrder S; S.init(NTOK / 256, DM / 256, G, bx, nullptr);
        pg8::EpiPle E{H, PLER, PSSQ, ple_post_norm, FSSQ}; pg8::gemm_phase<pg8::EpiPle, false>(lds, g, S, E, wave);
    }
    SEAM(PH_PLE);
    if (IN(PH_FINAL)) {
        PHASE_LANE;
        for (int row = gw; row < NTOK; row += NGW) {
            f32x4* hp = (f32x4*)(H + (size_t)row * DM); const f32x4* gp = (const f32x4*)final_norm;
            float s = lane < 16 ? FSSQ[(size_t)row * 16 + lane] : 0.f; s += __shfl_xor(s, 1); s += __shfl_xor(s, 2); s += __shfl_xor(s, 4); s += __shfl_xor(s, 8);
            const float rstd = rsqrtf(__shfl(s, 0) * (1.f / DM) + EPS);
#pragma unroll
            for (int j = 0; j < 4; ++j) { const f32x4 v = hp[lane + 64 * j], gg = gp[lane + 64 * j]; hp[lane + 64 * j] = v * rstd * gg; }
        }
    }
#undef IN
#undef SEAM
}
#ifndef NAIVE_MASK
#define NAIVE_MASK 0u
#endif
static int g_grid = 0;
static void launch_fwd(Args a, int lo, int hi, int li, hipStream_t st) {
    a.ph_lo = lo; a.ph_hi = hi; a.li = li;
    if (hi - lo > 1) { void* p[] = {&a}; hipError_t e = hipLaunchCooperativeKernel((const void*)fwd, dim3(g_grid), dim3(NTHREADS), p, LDS_BYTES, st);
        if (e != hipSuccess) fprintf(stderr, "cooperative launch failed: %s (grid %d)\n", hipGetErrorString(e), g_grid); }
    else hipLaunchKernelGGL(fwd, dim3(g_grid), dim3(NTHREADS), LDS_BYTES, st, a);
}
extern "C" void kernel_launch(void* const* d_in, const int* in_sizes, int n_in, void* d_out, int out_size, void* d_ws, size_t ws_size, hipStream_t stream) {
    if (n_in != 25 || in_sizes[0] != NTOK * DM || out_size != NTOK * DM || ws_size < WS_END) {
        fprintf(stderr, "kernel_launch: unexpected shapes (n_in %d, in0 %d, out %d, ws %zu need %zu)\n", n_in, n_in > 0 ? in_sizes[0] : -1, out_size, ws_size, (size_t)WS_END); return; }
    if (g_grid == 0) {
        int dev = 0, cus = 0, per_cu = 0; (void)hipGetDevice(&dev); (void)hipDeviceGetAttribute(&cus, hipDeviceAttributeMultiprocessorCount, dev);
        if (hipFuncSetAttribute((const void*)fwd, hipFuncAttributeMaxDynamicSharedMemorySize, LDS_BYTES) != hipSuccess) fprintf(stderr, "hipFuncSetAttribute failed\n");
        if (hipOccupancyMaxActiveBlocksPerMultiprocessor(&per_cu, (const void*)fwd, NTHREADS, LDS_BYTES) != hipSuccess || per_cu < 1) { fprintf(stderr, "occupancy query: %d\n", per_cu); per_cu = 1; }
        (void)hipGetLastError();
        g_grid = cus > 0 ? cus : 256;
    }
    const float* x = (const float*)d_in[0];
    const float *conv_w = (const float*)d_in[9], *b_router = (const float*)d_in[15], *final_norm = (const float*)d_in[24];
    unsigned char* ws = (unsigned char*)d_ws; float* H = (float*)d_out;
    int* ctl = (int*)(ws + WS_CTL);
    bf16_t *XN = (bf16_t*)(ws + WS_XN), *MIX = (bf16_t*)(ws + WS_MIX);
    bf16_t *Z = (bf16_t*)(ws + WS_Z), *Q = (bf16_t*)(ws + WS_Q), *K = (bf16_t*)(ws + WS_K), *V = (bf16_t*)(ws + WS_V), *Y = (bf16_t*)(ws + WS_Y);
    float *WR = (float*)(ws + WS_WR), *CS = (float*)(ws + WS_CS), *ASSQ = (float*)(ws + WS_ASSQ);
    int *TOPI = (int*)(ws + WS_TOPI), *ROWTOK = (int*)(ws + WS_ROWTOK), *ROWSLOT = (int*)(ws + WS_ROWSLOT); float *TOPG = (float*)(ws + WS_TOPG), *ROWGATE = (float*)(ws + WS_ROWGATE);
    (void)hipMemsetAsync(ws + WS_CTL, 0, 1 * MiB, stream);
    Args a{}; for (int i = 0; i < 25; ++i) a.in[i] = d_in[i]; a.out = H; a.ws = ws;
#define GRID1(n) dim3((unsigned)(((size_t)(n) + 255) / 256))
    const unsigned NAIVE = NAIVE_MASK;
    a.skip = (NAIVE & 1u) ? 1 : 0;
    int li = 0, lo = 0;
    for (int k = 0; k <= PH_COUNT; ++k) {
        const bool nv = k < PH_COUNT && ((k == PH_ATTN && (NAIVE & 2u)) || (k == PH_ROUTER && (NAIVE & 4u)) || (k == PH_ROUTE && (NAIVE & 8u)) || (k == PH_COMBINE && (NAIVE & 16u)) || (k == PH_FINAL && (NAIVE & 32u)));
        const bool pre = (k == PH_TOKLOCAL && (NAIVE & 1u));
        if (k == PH_COUNT || nv || pre) { if (k > lo) launch_fwd(a, lo, k, li++, stream); lo = nv ? k + 1 : k; }
        if (pre) { k_kpe<<<GRID1(NTOK * 32), 256, 0, stream>>>(Z, CS, K); k_conv<<<NTOK / 4, 256, 0, stream>>>(Z, conv_w, MIX); }
        if (!nv) continue;
        if (k == PH_ATTN) k_attn_naive<<<NB * NH * SEQ / 4, 256, 0, stream>>>(Q, K, V, MIX, ASSQ);
        if (k == PH_ROUTER) k_router<<<NTOK / 4, 256, 0, stream>>>(H, WR, b_router, XN, TOPI, TOPG, ctl + CW_CNT);
        if (k == PH_ROUTE) { k_route_plan<<<1, 64, 0, stream>>>(ctl); k_route_assign<<<GRID1(MROWS), 256, 0, stream>>>(TOPI, TOPG, ctl, ROWTOK, ROWSLOT, ROWGATE); k_route_fill<<<NE, 256, 0, stream>>>(ctl, ROWTOK, ROWSLOT, ROWGATE); }
        if (k == PH_COMBINE) k_combine<<<NTOK / 4, 256, 0, stream>>>(H, Y, XN);
        if (k == PH_FINAL) k_final<<<NTOK / 4, 256, 0, stream>>>(H, final_norm);
    }
#undef GRID1
}
```

```cpp
#include <hip/hip_runtime.h>
#include <cstdint>
#include <cstdio>
#include <cmath>

typedef unsigned short bf16_t;

constexpr int NB = 8, SEQ = 4096, DM = 1024, NTOK = NB * SEQ;
constexpr int PLE = 256, NH = 4, DN = 128, DR = 64, DV = 128, QL = 256, KVL = 128, DQK = DN + DR;
constexpr int INW = 1984, INWP = 2048;
constexpr int NE = 32, TOPK = 4, DE = 1024;
constexpr int MROWS = NTOK * TOPK;
constexpr int MAXTILES = MROWS / 256 + NE;
constexpr int PROWS = MAXTILES * 256;
constexpr float EPS = 1e-6f;
constexpr float QSCALE = 0.07216878364870322f * 1.4426950408889634f;

constexpr size_t MiB = 1u << 20;
constexpr size_t WS_CTL = 0;
constexpr size_t WS_WIN = 1 * MiB, WS_WUQ = 5 * MiB, WS_WUKV = 5 * MiB + 512 * 1024, WS_WO = 6 * MiB, WS_WG = 8 * MiB, WS_WP = 10 * MiB;
constexpr size_t WS_WR = 10 * MiB + 512 * 1024;
constexpr size_t WS_CS = 11 * MiB;
constexpr size_t WS_SSQ = 19 * MiB, WS_ASSQ = 20 * MiB, WS_PSSQ = 21 * MiB, WS_FSSQ = 23 * MiB;
constexpr size_t WS_TOPI = 25 * MiB, WS_TOPG = 25 * MiB + 512 * 1024;
constexpr size_t WS_ROWTOK = 26 * MiB, WS_ROWSLOT = 27 * MiB, WS_ROWGATE = 28 * MiB;
constexpr size_t WS_P16 = 29 * MiB;
constexpr size_t WS_W1 = 48 * MiB, WS_W2 = 176 * MiB, WS_XN = 240 * MiB, WS_MIX = 304 * MiB, WS_PLER = 368 * MiB;
constexpr size_t WS_Z = 432 * MiB, WS_Q = 560 * MiB, WS_K = 608 * MiB, WS_V = 656 * MiB;
constexpr size_t WS_HB = 432 * MiB;
constexpr size_t WS_Y = 704 * MiB;
constexpr size_t WS_END = WS_Y + (size_t)(MROWS + 256) * DM * 2;
constexpr int CW_CNT = 0, CW_CURSOR = 64, CW_PADSTART = 128, CW_NTILES = 192, CW_TILE_E = 256;

__device__ __forceinline__ float bf2f(bf16_t v) { return __uint_as_float((unsigned)v << 16); }
__device__ __forceinline__ float blo(unsigned u) { return __uint_as_float(u << 16); }
__device__ __forceinline__ float bhi(unsigned u) { return __uint_as_float(u & 0xffff0000u); }
__device__ __forceinline__ bf16_t f2bf(float f) { unsigned u = __float_as_uint(f); return (bf16_t)((u + 0x7fffu + ((u >> 16) & 1u)) >> 16); }
__device__ __forceinline__ unsigned pk2(float lo, float hi) { return (unsigned)f2bf(lo) | ((unsigned)f2bf(hi) << 16); }
__device__ __forceinline__ float wave_sum(float v) {
#pragma unroll
    for (int o = 1; o < 64; o <<= 1) v += __shfl_xor(v, o);
    return v;
}
__device__ __forceinline__ float wave_max(float v) {
#pragma unroll
    for (int o = 1; o < 64; o <<= 1) v = fmaxf(v, __shfl_xor(v, o));
    return v;
}
__device__ __forceinline__ float dot8(uint4 x, uint4 y) {
    return blo(x.x) * blo(y.x) + bhi(x.x) * bhi(y.x) + blo(x.y) * blo(y.y) + bhi(x.y) * bhi(y.y) +
           blo(x.z) * blo(y.z) + bhi(x.z) * bhi(y.z) + blo(x.w) * blo(y.w) + bhi(x.w) * bhi(y.w);
}
__device__ __forceinline__ float dot_bf16(const bf16_t* a, const bf16_t* b, int K) {
    const uint4* a4 = (const uint4*)a; const uint4* b4 = (const uint4*)b; float acc = 0.f;
    for (int i = 0; i < K / 8; ++i) acc += dot8(a4[i], b4[i]);
    return acc;
}

template <int MODE>
__global__ void k_prep_wt(const float* __restrict__ src, bf16_t* __restrict__ dst, int K, int Nrows, int ldsrc, int nvalid,
                          const float* __restrict__ gain, const float* __restrict__ gain2, float scale) {
    const size_t idx = (size_t)blockIdx.x * 256 + threadIdx.x; if (idx >= (size_t)Nrows * K) return;
    const int n = (int)(idx / K), k = (int)(idx % K);
    src += (size_t)blockIdx.y * K * ldsrc; dst += (size_t)blockIdx.y * Nrows * K;
    int c = n;
    if (MODE == 1) { const int pn = n >> 8, half = (n >> 7) & 1, jj = n & 127; c = half * 1024 + pn * 128 + jj; }
    float v = 0.f;
    if (c < nvalid) { float g = 1.f; if (gain) g = (gain2 && k >= 512) ? gain2[k - 512] : gain[k]; v = src[(size_t)k * ldsrc + c] * g * scale; }
    dst[idx] = f2bf(v);
}
__global__ void k_prep_wr(const float* __restrict__ wr, const float* __restrict__ g, float* __restrict__ dst) {
    const int idx = blockIdx.x * 256 + threadIdx.x; if (idx >= DM * NE) return; dst[idx] = wr[idx] * g[idx / NE];
}
__global__ void k_prep_cs(const int* __restrict__ pos, float* __restrict__ cs) {
    const int idx = blockIdx.x * 256 + threadIdx.x; if (idx >= NTOK * 32) return; const int t = idx >> 5, i = idx & 31;
    const float inv = powf(10000.f, -(float)i / 32.f); const float a = (float)pos[t] * inv; float s, c; sincosf(a, &s, &c);
    cs[(size_t)t * 64 + i] = c; cs[(size_t)t * 64 + 32 + i] = s;
}
__global__ void k_cvt_bf16(const float* __restrict__ src, bf16_t* __restrict__ dst, size_t n) {
    const size_t idx = (size_t)blockIdx.x * 256 + threadIdx.x; if (idx < n) dst[idx] = f2bf(src[idx]);
}
__global__ void k_rmsnorm_bf16(const float* __restrict__ src, bf16_t* __restrict__ dst) {
    const int row = blockIdx.x * 4 + (threadIdx.x >> 6), lane = threadIdx.x & 63;
    const float4* s = (const float4*)(src + (size_t)row * DM); float4 v[4]; float ss = 0.f;
#pragma unroll
    for (int j = 0; j < 4; ++j) { v[j] = s[lane + 64 * j]; ss += v[j].x * v[j].x + v[j].y * v[j].y + v[j].z * v[j].z + v[j].w * v[j].w; }
    const float rstd = rsqrtf(wave_sum(ss) * (1.f / DM) + EPS);
    uint2* d = (uint2*)(dst + (size_t)row * DM);
#pragma unroll
    for (int j = 0; j < 4; ++j) d[lane + 64 * j] = make_uint2(pk2(v[j].x * rstd, v[j].y * rstd), pk2(v[j].z * rstd, v[j].w * rstd));
}

__global__ void k_inproj(const bf16_t* __restrict__ XN, const bf16_t* __restrict__ WT, bf16_t* __restrict__ Z) {
    const size_t idx = (size_t)blockIdx.x * 256 + threadIdx.x; const int row = (int)(idx / INWP), col = (int)(idx % INWP);
    Z[idx] = f2bf(dot_bf16(XN + (size_t)row * DM, WT + (size_t)col * DM, DM));
}
__global__ void k_zstats(const bf16_t* __restrict__ Z, float* __restrict__ SSQ) {
    const int row = blockIdx.x * 4 + (threadIdx.x >> 6), lane = threadIdx.x & 63; const bf16_t* z = Z + (size_t)row * INWP;
    float q = 0.f, kv = 0.f;
    for (int c = lane; c < 256; c += 64) { const float v = bf2f(z[c]); q += v * v; }
    for (int c = 256 + lane; c < 384; c += 64) { const float v = bf2f(z[c]); kv += v * v; }
    q = wave_sum(q); kv = wave_sum(kv);
    if (lane < 8) SSQ[(size_t)row * 8 + lane] = lane == 0 ? q : (lane == 4 ? kv : 0.f);
}
__global__ void k_pleraw(const bf16_t* __restrict__ P16, const bf16_t* __restrict__ WT, bf16_t* __restrict__ PLER) {
    const size_t idx = (size_t)blockIdx.x * 256 + threadIdx.x; const int row = (int)(idx / DM), col = (int)(idx % DM);
    PLER[idx] = f2bf(dot_bf16(P16 + (size_t)row * PLE, WT + (size_t)col * PLE, PLE));
}
__global__ void k_rowssq16(const bf16_t* __restrict__ X, float* __restrict__ out) {
    const int row = blockIdx.x * 4 + (threadIdx.x >> 6), lane = threadIdx.x & 63; float s = 0.f;
    for (int c = lane; c < DM; c += 64) { const float v = bf2f(X[(size_t)row * DM + c]); s += v * v; }
    s = wave_sum(s); if (lane < 16) out[(size_t)row * 16 + lane] = lane == 0 ? s : 0.f;
}
__device__ __forceinline__ float rstd4(const float* p, float n) { return rsqrtf((p[0] + p[1] + p[2] + p[3]) / n + EPS); }
__global__ void k_qup(const bf16_t* __restrict__ Z, const bf16_t* __restrict__ WT, const float* __restrict__ SSQ, const float* __restrict__ CS, bf16_t* __restrict__ Q) {
    const size_t idx = (size_t)blockIdx.x * 256 + threadIdx.x; const int row = (int)(idx / (NH * 160)), r = (int)(idx % (NH * 160)), h = r / 160, j = r % 160;
    const float rs = rstd4(SSQ + (size_t)row * 8, (float)QL); const bf16_t* a = Z + (size_t)row * INWP;
    const int b = row / SEQ, s = row % SEQ; bf16_t* q = Q + ((size_t)(b * NH + h) * SEQ + s) * DQK;
    if (j < 128) { q[j] = f2bf(rs * dot_bf16(a, WT + (size_t)(h * DQK + j) * QL, QL)); }
    else { const int i = j - 128; const float x1 = rs * dot_bf16(a, WT + (size_t)(h * DQK + 128 + 2 * i) * QL, QL), x2 = rs * dot_bf16(a, WT + (size_t)(h * DQK + 129 + 2 * i) * QL, QL);
        const float c = CS[(size_t)row * 64 + i], sn = CS[(size_t)row * 64 + 32 + i];
        q[128 + 2 * i] = f2bf(x1 * c - x2 * sn); q[129 + 2 * i] = f2bf(x1 * sn + x2 * c); }
}
__global__ void k_kvup(const bf16_t* __restrict__ Z, const bf16_t* __restrict__ WT, const float* __restrict__ SSQ, bf16_t* __restrict__ K, bf16_t* __restrict__ V) {
    const size_t idx = (size_t)blockIdx.x * 256 + threadIdx.x; const int row = (int)(idx / 1024), col = (int)(idx % 1024), h = col >> 8, d = col & 255;
    const float rs = rstd4(SSQ + (size_t)row * 8 + 4, (float)KVL);
    const float v = rs * dot_bf16(Z + (size_t)row * INWP + 256, WT + (size_t)col * 256, KVL);
    const int b = row / SEQ, s = row % SEQ; const size_t t = (size_t)(b * NH + h) * SEQ + s;
    if (d < 128) K[t * DQK + d] = f2bf(v); else V[t * DV + d - 128] = f2bf(v);
}
__global__ void k_kpe(const bf16_t* __restrict__ Z, const float* __restrict__ CS, bf16_t* __restrict__ K) {
    const int idx = blockIdx.x * 256 + threadIdx.x; const int row = idx >> 5, i = idx & 31;
    const float x1 = bf2f(Z[(size_t)row * INWP + 384 + i]), x2 = bf2f(Z[(size_t)row * INWP + 416 + i]);
    const float c = CS[(size_t)row * 64 + i], sn = CS[(size_t)row * 64 + 32 + i];
    const bf16_t o1 = f2bf(x1 * c - x2 * sn), o2 = f2bf(x1 * sn + x2 * c); const int b = row / SEQ, s = row % SEQ;
    for (int h = 0; h < NH; ++h) { bf16_t* k = K + ((size_t)(b * NH + h) * SEQ + s) * DQK; k[128 + 2 * i] = o1; k[129 + 2 * i] = o2; }
}
__global__ void k_conv(const bf16_t* __restrict__ Z, const float* __restrict__ cw, bf16_t* __restrict__ MIX) {
    const int row = blockIdx.x * 4 + (threadIdx.x >> 6), lane = threadIdx.x & 63, s = row % SEQ; const bf16_t* z = Z + (size_t)row * INWP;
    float y[8]; float ss = 0.f;
#pragma unroll
    for (int j = 0; j < 8; ++j) { const int c = lane + 64 * j;
        const float u0 = bf2f(z[960 + c]) * bf2f(z[1472 + c]);
        const float u1 = s >= 1 ? bf2f(z[960 + c - INWP]) * bf2f(z[1472 + c - INWP]) : 0.f;
        const float u2 = s >= 2 ? bf2f(z[960 + c - 2 * INWP]) * bf2f(z[1472 + c - 2 * INWP]) : 0.f;
        const float v = bf2f(z[448 + c]) * (cw[c] * u2 + cw[512 + c] * u1 + cw[1024 + c] * u0);
        y[j] = v; ss += v * v; }
    const float rstd = rsqrtf(wave_sum(ss) * (1.f / 512.f) + EPS);
#pragma unroll
    for (int j = 0; j < 8; ++j) MIX[(size_t)row * DM + 512 + lane + 64 * j] = f2bf(y[j] * rstd);
}
__global__ void k_attn_naive(const bf16_t* __restrict__ Q, const bf16_t* __restrict__ K, const bf16_t* __restrict__ V, bf16_t* __restrict__ MIX, float* __restrict__ ASSQ) {
    __shared__ float qs[4][DQK];
    const int wid = threadIdx.x >> 6, lane = threadIdx.x & 63; const int gw = blockIdx.x * 4 + wid; const int i = gw % SEQ, bh = gw / SEQ;
    const bf16_t* q = Q + (size_t)gw * DQK;
    for (int d = lane; d < DQK; d += 64) qs[wid][d] = bf2f(q[d]);
    __syncthreads();
    const bf16_t* Kb = K + (size_t)bh * SEQ * DQK; const bf16_t* Vb = V + (size_t)bh * SEQ * DV;
    float m = -1e30f, l = 0.f, o0 = 0.f, o1 = 0.f;
    for (int j0 = 0; j0 <= i; j0 += 64) {
        const int j = j0 + lane; const bool valid = j <= i; float sc = -INFINITY;
        if (valid) { const uint4* kr = (const uint4*)(Kb + (size_t)j * DQK); float acc = 0.f;
            for (int c = 0; c < 24; ++c) { const uint4 kv = kr[c]; const float* qq = &qs[wid][c * 8];
                acc += blo(kv.x) * qq[0] + bhi(kv.x) * qq[1] + blo(kv.y) * qq[2] + bhi(kv.y) * qq[3] + blo(kv.z) * qq[4] + bhi(kv.z) * qq[5] + blo(kv.w) * qq[6] + bhi(kv.w) * qq[7]; }
            sc = acc; }
        const float mnew = fmaxf(m, wave_max(sc)); const float alpha = exp2f(m - mnew); const float p = valid ? exp2f(sc - mnew) : 0.f;
        l = l * alpha + wave_sum(p); o0 *= alpha; o1 *= alpha; m = mnew;
        const int nj = (i - j0 + 1) < 64 ? (i - j0 + 1) : 64;
        for (int jj = 0; jj < nj; ++jj) { const float pj = __shfl(p, jj); const unsigned vv = *(const unsigned*)(Vb + (size_t)(j0 + jj) * DV + 2 * lane); o0 += pj * blo(vv); o1 += pj * bhi(vv); }
    }
    const float inv = 1.f / l; o0 *= inv; o1 *= inv;
    const int b = bh / NH, h = bh % NH; const size_t row = (size_t)b * SEQ + i;
    *(unsigned*)(MIX + row * DM + h * DV + 2 * lane) = pk2(o0, o1);
    const float ss = wave_sum(o0 * o0 + o1 * o1); if (lane == 0) ASSQ[row * 4 + h] = ss;
}
__global__ void k_wo(const bf16_t* __restrict__ MIX, const bf16_t* __restrict__ WT, const float* __restrict__ ASSQ, const float* __restrict__ x, float* __restrict__ H) {
    const size_t idx = (size_t)blockIdx.x * 256 + threadIdx.x; const int row = (int)(idx / DM), col = (int)(idx % DM);
    const float ra = rstd4(ASSQ + (size_t)row * 4, 512.f);
    const float a = dot_bf16(MIX + (size_t)row * DM, WT + (size_t)col * DM, 512) * ra + dot_bf16(MIX + (size_t)row * DM + 512, WT + (size_t)col * DM + 512, 512);
    H[idx] = x[idx] + a;
}
__global__ void k_router(const float* __restrict__ H, const float* __restrict__ WR, const float* __restrict__ br, bf16_t* __restrict__ XN, int* __restrict__ TOPI, float* __restrict__ TOPG, int* __restrict__ CNT) {
    __shared__ float lg[4][NE];
    const int wid = threadIdx.x >> 6, lane = threadIdx.x & 63, row = blockIdx.x * 4 + wid; const float* h = H + (size_t)row * DM;
    const float4* s = (const float4*)h; float4 v[4]; float ss = 0.f;
#pragma unroll
    for (int j = 0; j < 4; ++j) { v[j] = s[lane + 64 * j]; ss += v[j].x * v[j].x + v[j].y * v[j].y + v[j].z * v[j].z + v[j].w * v[j].w; }
    const float rstd = rsqrtf(wave_sum(ss) * (1.f / DM) + EPS);
    uint2* d = (uint2*)(XN + (size_t)row * DM);
#pragma unroll
    for (int j = 0; j < 4; ++j) d[lane + 64 * j] = make_uint2(pk2(v[j].x * rstd, v[j].y * rstd), pk2(v[j].z * rstd, v[j].w * rstd));
    const int e = lane & 31, half = lane >> 5; float acc = 0.f;
    for (int k = half * 512; k < half * 512 + 512; ++k) acc += h[k] * WR[e * DM + k];
    acc += __shfl_xor(acc, 32); acc = acc * rstd + br[e];
    if (lane < 32) lg[wid][lane] = acc;
    __syncthreads();
    if (lane == 0) { float lv[4]; int li[4]; unsigned used = 0u;
        for (int t = 0; t < 4; ++t) { float best = -INFINITY; int bi = 0; for (int q = 0; q < NE; ++q) { const float x = lg[wid][q]; if (!((used >> q) & 1u) && x > best) { best = x; bi = q; } } used |= 1u << bi; lv[t] = best; li[t] = bi; }
        float den = 0.f, ex[4]; for (int t = 0; t < 4; ++t) { ex[t] = expf(lv[t] - lv[0]); den += ex[t]; }
        for (int t = 0; t < 4; ++t) { TOPI[row * 4 + t] = li[t]; TOPG[row * 4 + t] = ex[t] / den; atomicAdd(&CNT[li[t]], 1); } }
}
__global__ void k_route_plan(int* __restrict__ ctl) {
    if (threadIdx.x != 0 || blockIdx.x != 0) return; int ps = 0, nt = 0;
    for (int e = 0; e < NE; ++e) { ctl[CW_PADSTART + e] = ps; const int t = (ctl[CW_CNT + e] + 255) / 256; for (int q = 0; q < t; ++q) ctl[CW_TILE_E + nt + q] = e; nt += t; ps += t * 256; }
    ctl[CW_PADSTART + NE] = ps; ctl[CW_NTILES] = nt;
}
__global__ void k_route_assign(const int* __restrict__ TOPI, const float* __restrict__ TOPG, int* __restrict__ ctl, int* __restrict__ ROWTOK, int* __restrict__ ROWSLOT, float* __restrict__ ROWGATE) {
    const int idx = blockIdx.x * 256 + threadIdx.x; if (idx >= MROWS) return; const int e = TOPI[idx];
    const int dest = ctl[CW_PADSTART + e] + atomicAdd(&ctl[CW_CURSOR + e], 1);
    ROWTOK[dest] = idx >> 2; ROWSLOT[dest] = idx; ROWGATE[dest] = TOPG[idx];
}
__global__ void k_route_fill(const int* __restrict__ ctl, int* __restrict__ ROWTOK, int* __restrict__ ROWSLOT, float* __restrict__ ROWGATE) {
    const int e = blockIdx.x; const int lo = ctl[CW_PADSTART + e] + ctl[CW_CNT + e], hi = ctl[CW_PADSTART + e + 1];
    for (int r = lo + threadIdx.x; r < hi; r += 256) { ROWTOK[r] = 0; ROWSLOT[r] = MROWS; ROWGATE[r] = 0.f; }
}
__device__ __forceinline__ float swiglu(float g, float u) { g = fminf(g, 7.f); u = fminf(fmaxf(u, -7.f), 7.f); return g / (1.f + expf(-1.702f * g)) * (u + 1.f); }
__global__ void k_moe1(const bf16_t* __restrict__ XN, const bf16_t* __restrict__ W1T, const float* __restrict__ b1, const int* __restrict__ ctl, const int* __restrict__ ROWTOK, bf16_t* __restrict__ HB) {
    const size_t idx = (size_t)blockIdx.x * 256 + threadIdx.x; const int r = (int)(idx / DE), j = (int)(idx % DE);
    if (r >= ctl[CW_NTILES] * 256) return; const int e = ctl[CW_TILE_E + (r >> 8)];
    const bf16_t* a = XN + (size_t)ROWTOK[r] * DM; const bf16_t* w = W1T + (size_t)e * 2048 * DM; const int rg = (j >> 7) * 256 + (j & 127);
    const float g = dot_bf16(a, w + (size_t)rg * DM, DM) + b1[e * 2048 + j], u = dot_bf16(a, w + (size_t)(rg + 128) * DM, DM) + b1[e * 2048 + 1024 + j];
    HB[idx] = f2bf(swiglu(g, u));
}
__global__ void k_moe2(const bf16_t* __restrict__ HB, const bf16_t* __restrict__ W2T, const float* __restrict__ b2, const int* __restrict__ ctl, const int* __restrict__ ROWSLOT, const float* __restrict__ ROWGATE, bf16_t* __restrict__ Y) {
    const size_t idx = (size_t)blockIdx.x * 256 + threadIdx.x; const int r = (int)(idx / DM), c = (int)(idx % DM);
    if (r >= ctl[CW_NTILES] * 256) return; const int e = ctl[CW_TILE_E + (r >> 8)];
    const float v = (dot_bf16(HB + (size_t)r * DE, W2T + ((size_t)e * DM + c) * DE, DE) + b2[e * DM + c]) * ROWGATE[r];
    Y[(size_t)ROWSLOT[r] * DM + c] = f2bf(v);
}
__global__ void k_combine(float* __restrict__ H, const bf16_t* __restrict__ Y, bf16_t* __restrict__ XN) {
    const int row = blockIdx.x * 4 + (threadIdx.x >> 6), lane = threadIdx.x & 63; float4* hp = (float4*)(H + (size_t)row * DM); float4 v[4]; float ss = 0.f;
#pragma unroll
    for (int j = 0; j < 4; ++j) { v[j] = hp[lane + 64 * j];
        for (int k = 0; k < 4; ++k) { const uint2 y = *(const uint2*)(Y + ((size_t)row * 4 + k) * DM + 4 * (lane + 64 * j)); v[j].x += blo(y.x); v[j].y += bhi(y.x); v[j].z += blo(y.y); v[j].w += bhi(y.y); }
        hp[lane + 64 * j] = v[j]; ss += v[j].x * v[j].x + v[j].y * v[j].y + v[j].z * v[j].z + v[j].w * v[j].w; }
    const float rstd = rsqrtf(wave_sum(ss) * (1.f / DM) + EPS);
    uint2* d = (uint2*)(XN + (size_t)row * DM);
#pragma unroll
    for (int j = 0; j < 4; ++j) d[lane + 64 * j] = make_uint2(pk2(v[j].x * rstd, v[j].y * rstd), pk2(v[j].z * rstd, v[j].w * rstd));
}
__global__ void k_plegate(const bf16_t* __restrict__ XN, const bf16_t* __restrict__ WGT, const bf16_t* __restrict__ PLER, const float* __restrict__ PSSQ, const float* __restrict__ pg, float* __restrict__ H) {
    const size_t idx = (size_t)blockIdx.x * 256 + threadIdx.x; const int row = (int)(idx / DM), col = (int)(idx % DM);
    const float a = dot_bf16(XN + (size_t)row * DM, WGT + (size_t)col * DM, DM); const float g = 1.f / (1.f + expf(-a));
    float s = 0.f; for (int t = 0; t < 16; ++t) s += PSSQ[(size_t)row * 16 + t]; const float rp = rsqrtf(s * (1.f / DM) + EPS);
    H[idx] = H[idx] + g * bf2f(PLER[idx]) * rp * pg[col];
}
__global__ void k_final(float* __restrict__ H, const float* __restrict__ g) {
    const int row = blockIdx.x * 4 + (threadIdx.x >> 6), lane = threadIdx.x & 63; float4* hp = (float4*)(H + (size_t)row * DM); const float4* gp = (const float4*)g; float4 v[4]; float ss = 0.f;
#pragma unroll
    for (int j = 0; j < 4; ++j) { v[j] = hp[lane + 64 * j]; ss += v[j].x * v[j].x + v[j].y * v[j].y + v[j].z * v[j].z + v[j].w * v[j].w; }
    const float rstd = rsqrtf(wave_sum(ss) * (1.f / DM) + EPS);
#pragma unroll
    for (int j = 0; j < 4; ++j) { const float4 gg = gp[lane + 64 * j]; hp[lane + 64 * j] = make_float4(v[j].x * rstd * gg.x, v[j].y * rstd * gg.y, v[j].z * rstd * gg.z, v[j].w * rstd * gg.w); }
}

#define LAS __attribute__((address_space(3)))
#define GAS __attribute__((address_space(1)))
typedef short bf16x8 __attribute__((ext_vector_type(8)));
typedef float f32x4 __attribute__((ext_vector_type(4)));
typedef float f32x2 __attribute__((ext_vector_type(2)));
typedef unsigned u32x4 __attribute__((ext_vector_type(4)));
typedef unsigned u32x2 __attribute__((ext_vector_type(2)));
#ifndef PROBE_PH
#define PROBE_PH (-1)
#define PROBE_REP 1
#endif
constexpr int NWAVES = 8, NTHREADS = 512;
constexpr int RING_BYTES = 131072, MISC_OFF = RING_BYTES, HIST_OFF = MISC_OFF + 256, LDS_BYTES = 163840;
constexpr int CW_BAR = 4096;
__device__ __forceinline__ unsigned cvt_pk_bf16(float lo, float hi) { unsigned r; asm volatile("v_cvt_pk_bf16_f32 %0, %1, %2" : "=v"(r) : "v"(lo), "v"(hi)); return r; }
__device__ __forceinline__ int lane_id() { int l = (int)__builtin_amdgcn_mbcnt_hi(~0u, __builtin_amdgcn_mbcnt_lo(~0u, 0u)); asm volatile("" : "+v"(l)); return l; }
__device__ __forceinline__ float fast_sigmoid(float a) { return __builtin_amdgcn_rcpf(1.f + __expf(-a)); }

#define XB_TMO      128
#define XB_XCNT(j)  (256  + 64 * (j))
#define XB_XSUB(j)  (1280 + 64 * (j))
#define XB_XGEN(j)  (2304 + 64 * (j))
#define XB_TOP      3328
#define XB_TOPGEN   3392
#define XCD_BAR_WORDS 3456
#define XB_SPIN_CAP (1u << 20)
__device__ __forceinline__ unsigned xb_ld(unsigned* p)              { return __hip_atomic_load(p, __ATOMIC_RELAXED, __HIP_MEMORY_SCOPE_AGENT); }
__device__ __forceinline__ unsigned xb_add(unsigned* p, unsigned v) { return __hip_atomic_fetch_add(p, v, __ATOMIC_RELAXED, __HIP_MEMORY_SCOPE_AGENT); }
__device__ __forceinline__ unsigned xb_xcc_id() { return (unsigned)__builtin_amdgcn_s_getreg((3 << 11) | 20) & 0xFu; }
#define XB_SPIN(cond, bar) do { unsigned _sp = 0; while (cond) { __builtin_amdgcn_s_sleep(1); \
    if ((++_sp & 255u) == 0u) { if (xb_ld(&(bar)[XB_TMO])) break; if (_sp > XB_SPIN_CAP) { atomicAdd(&(bar)[XB_TMO], 1u); break; } } } } while (0)
struct XcdBarrier { unsigned* bar; unsigned x; volatile LAS unsigned* st; };
__device__ __forceinline__ XcdBarrier xcd_barrier_post(unsigned* bar, volatile LAS unsigned* st, int wave) {
    XcdBarrier b; b.bar = bar; b.x = xb_xcc_id(); b.st = st;
    if (wave == 0 && lane_id() == 0) (void)xb_add(&bar[XB_XCNT(b.x)], 1u);
    return b;
}
__device__ __forceinline__ void xcd_barrier_complete(unsigned* bar, unsigned x, unsigned& nloc, unsigned& nx) {
    const unsigned G = gridDim.x * gridDim.y * gridDim.z;
    unsigned sum, cnt, mine, sp = 0u;
    for (;;) {
        sum = 0u; cnt = 0u; mine = 0u;
#pragma unroll
        for (unsigned j = 0; j < 16; ++j) { const unsigned c = xb_ld(&bar[XB_XCNT(j)]); sum += c; cnt += (c > 0u) ? 1u : 0u; mine = (j == x) ? c : mine; }
        if (sum == G) break;
        __builtin_amdgcn_s_sleep(1);
        if ((++sp & 255u) == 0u) { if (xb_ld(&bar[XB_TMO])) break; if (sp > XB_SPIN_CAP) { atomicAdd(&bar[XB_TMO], 1u); break; } }
    }
    nloc = mine > 0u ? mine : 1u; nx = cnt > 0u ? cnt : 1u;
}
__device__ __forceinline__ void xcd_barrier(const XcdBarrier& b, int wave) {
    asm volatile("s_waitcnt vmcnt(0)" ::: "memory");
    __syncthreads();
    if (wave == 0 && lane_id() == 0) {
        unsigned* bar = b.bar;
        __builtin_amdgcn_s_waitcnt(0);
        unsigned nloc = b.st[0], nx = b.st[1];
        if (nloc == 0u) { xcd_barrier_complete(bar, b.x, nloc, nx); b.st[0] = nloc; b.st[1] = nx; }
        const unsigned old = xb_add(&bar[XB_XSUB(b.x)], 1u);
        const unsigned gen = old / nloc;
        if (old + 1u == (gen + 1u) * nloc) {
            __builtin_amdgcn_fence(__ATOMIC_RELEASE, "agent");
            asm volatile("s_waitcnt vmcnt(0)" ::: "memory");
            const unsigned og = xb_add(&bar[XB_TOP], 1u);
            const unsigned tg = og / nx;
            if (og + 1u == (tg + 1u) * nx) xb_add(&bar[XB_TOPGEN], 1u);
            else XB_SPIN(xb_ld(&bar[XB_TOPGEN]) == tg, bar);
            __builtin_amdgcn_fence(__ATOMIC_ACQUIRE, "agent");
            xb_add(&bar[XB_XGEN(b.x)], 1u);
            asm volatile("s_waitcnt vmcnt(0)" ::: "memory");
        } else {
            XB_SPIN(xb_ld(&bar[XB_XGEN(b.x)]) == gen, bar);
            __builtin_amdgcn_fence(__ATOMIC_ACQUIRE, "agent");
            asm volatile("s_waitcnt vmcnt(0)" ::: "memory");
        }
    }
    __syncthreads();
}

namespace pg8 {
constexpr int BM = 256, BK = 64, HALF = 128, HTB = HALF * BK * 2, STAGE_BYTES = 8 * HTB, NXCD = 8, WGM = 8;
__host__ __device__ __forceinline__ int lds_byte(int r, int c) { const int st = (r >> 4) * 2 + (c >> 5), rr = r & 15, cc = c & 31, ob = rr * 64 + cc * 2; return st * 1024 + (ob ^ (((ob >> 9) & 1) << 5)); }
__host__ __device__ __forceinline__ void stage_rc(int b, int& R, int& C) { const int st = b / 1024, sb = b % 1024, swz = sb ^ (((sb >> 9) & 1) << 5); R = (st >> 1) * 16 + swz / 64; C = (st & 1) * 32 + (swz % 64) / 2; }
__host__ __device__ __forceinline__ int perm32(int rho) { const int n = rho >> 4, i = rho & 15; return 8 * (i >> 2) + 4 * n + (i & 3); }
struct Unit { int pm, pn, e; };
struct Gemm { const void* A; const void* Bt; int K, lda, ldb; const int* rowidx; size_t bstride; };
struct StaticOrder {
    int nM, nN, nwg, G, c; const int* tile_e;
    __device__ void init(int nM_, int nN_, int G_, int c_, const int* te) { nM = nM_; nN = nN_; nwg = nM * nN; G = G_; c = c_; tile_e = te; }
    __device__ bool next(int i, Unit& u) const {
        const long L = (long)i * G + c; if (L >= nwg) return false;
        int wgid = (int)L; { const int q = nwg / NXCD, r = nwg % NXCD, xcd = wgid % NXCD, off = wgid / NXCD; wgid = (xcd < r ? xcd * (q + 1) : r * (q + 1) + (xcd - r) * q) + off; }
        const int nig = WGM * nN, gid = wgid / nig, fm = gid * WGM, gsz = (nM - fm) < WGM ? (nM - fm) : WGM;
        u.pm = fm + ((wgid % nig) % gsz); u.pn = (wgid % nig) / gsz; u.e = tile_e ? tile_e[u.pm] : 0; return true;
    }
};
typedef f32x4 Acc[2][2][4][2];
typedef int v8i_t __attribute__((ext_vector_type(8)));
typedef int v4i_t __attribute__((ext_vector_type(4)));
template <class Epi, bool GATHER, bool FP8 = false>
__device__ __forceinline__ void gemm_phase(LAS unsigned char* lds, const Gemm g, const StaticOrder& S, const Epi& E, const int wid) {
    const int lane = lane_id(), tid = wid * 64 + lane, wr = wid >> 2, wc = wid & 3, fr = lane & 15, fq = lane >> 4;
    constexpr int ES = FP8 ? 1 : 2;
    const int K = g.K, nt = K * ES / 128;
    int RA[2], CA[2]; unsigned voffB[2], voffA[2];
#pragma unroll
    for (int i = 0; i < 2; ++i) { int R, C; stage_rc(tid * 16 + i * 8192, R, C); const int Rb = Epi::PERM ? ((R & ~31) + perm32(R & 31)) : R;
        RA[i] = R; CA[i] = C; voffB[i] = (unsigned)(Rb * g.ldb * ES + C * 2); voffA[i] = (unsigned)(R * g.lda * ES + C * 2); }
    const size_t hstepA = GATHER ? 0 : (size_t)HALF * g.lda * ES;
    const size_t kstep = (size_t)(BK * 2);
    const size_t hstepB = (size_t)HALF * g.ldb * ES;
    const unsigned ldsw = (unsigned)wid * 1024u;
    const int aoff = lds_byte(wr * 64 + fr, fq * 8), boff = lds_byte(wc * 32 + fr, fq * 8);
#define PG8_SA(b, h) (((b) * 2 + (h)) * HTB)
#define PG8_SB(b, h) ((4 + (b) * 2 + (h)) * HTB)
#define PG8_STAGE(bufoff, gbase, voff) do { _Pragma("unroll") for (int _i = 0; _i < 2; ++_i) \
        __builtin_amdgcn_global_load_lds((const unsigned*)((const char*)(gbase) + (voff)[_i]), (LAS unsigned*)(lds + (bufoff) + ldsw + _i * 8192), 16, 0, 0); } while (0)
#define PG8_LDA(dst, b, h) do { _Pragma("unroll") for (int m = 0; m < 4; ++m) _Pragma("unroll") for (int k = 0; k < 2; ++k) dst[m][k] = *(const LAS bf16x8*)(lds + PG8_SA(b, h) + aoff + m * 2048 + k * 1024); } while (0)
#define PG8_LDB(dst, b, h) do { _Pragma("unroll") for (int n = 0; n < 2; ++n) _Pragma("unroll") for (int k = 0; k < 2; ++k) dst[n][k] = *(const LAS bf16x8*)(lds + PG8_SB(b, h) + boff + n * 2048 + k * 1024); } while (0)
#define PG8_CAT8(x) __builtin_shufflevector(__builtin_bit_cast(v4i_t, (x)[0]), __builtin_bit_cast(v4i_t, (x)[1]), 0, 1, 2, 3, 4, 5, 6, 7)
#define PG8_MMA(ai, bj, At, Bt) do { __builtin_amdgcn_s_setprio(1); if constexpr (FP8) { _Pragma("unroll") for (int m = 0; m < 4; ++m) _Pragma("unroll") for (int n = 0; n < 2; ++n) \
        acc[ai][bj][m][n] = __builtin_amdgcn_mfma_scale_f32_16x16x128_f8f6f4(PG8_CAT8(Bt[n]), PG8_CAT8(At[m]), acc[ai][bj][m][n], 0, 0, 0, 0x7f7f7f7f, 0, 0x7f7f7f7f); \
        _Pragma("unroll") for (int m = 0; m < 4; ++m) _Pragma("unroll") for (int n = 0; n < 2; ++n) asm volatile("" : "+v"(acc[ai][bj][m][n]));   } else { \
        _Pragma("unroll") for (int m = 0; m < 4; ++m) _Pragma("unroll") for (int n = 0; n < 2; ++n) _Pragma("unroll") for (int k = 0; k < 2; ++k) \
        acc[ai][bj][m][n] = __builtin_amdgcn_mfma_f32_16x16x32_bf16(Bt[n][k], At[m][k], acc[ai][bj][m][n], 0, 0, 0); } __builtin_amdgcn_s_setprio(0); } while (0)
#define PG8_WAIT_V(n) asm volatile("s_waitcnt vmcnt(" #n ")" ::: "memory")
#define PG8_WAIT_L(n) asm volatile("s_waitcnt lgkmcnt(" #n ")" ::: "memory")
#define PG8_BAR __builtin_amdgcn_s_barrier()
#define PG8_SCHED __builtin_amdgcn_sched_barrier(0)
#define PG8_SETVO(vo, u) do { if constexpr (GATHER) { _Pragma("unroll") for (int _h = 0; _h < 2; ++_h) _Pragma("unroll") for (int _i = 0; _i < 2; ++_i) { \
        const int _row = g.rowidx[(u).pm * BM + _h * HALF + RA[_i]]; (vo)[_h][_i] = (unsigned)_row * (unsigned)(g.lda * ES) + (unsigned)CA[_i] * 2u; } } } while (0)
#define PG8_STAGE_A(bufoff, base, h, vog) do { if constexpr (GATHER) { PG8_STAGE(bufoff, base, (vog)[h]); } else { PG8_STAGE(bufoff, (base) + (h) * hstepA, voffA); } } while (0)
    Unit cur, nxt; int ui = 0;
    if (!S.next(0, cur)) return;
    Acc acc;
#pragma unroll
    for (int a = 0; a < 2; ++a)
#pragma unroll
        for (int b = 0; b < 2; ++b)
#pragma unroll
            for (int m = 0; m < 4; ++m)
#pragma unroll
                for (int n = 0; n < 2; ++n) acc[a][b][m][n] = (f32x4){0.f, 0.f, 0.f, 0.f};
    bf16x8 At[4][2], B0[2][2], B1[2][2];
    unsigned voC[2][2], voN[2][2];
    PG8_SETVO(voC, cur);
    const char* const Ab = (const char*)g.A;
    const char* cA = GATHER ? Ab : Ab + (size_t)cur.pm * 2 * hstepA;
    const char* cB = (const char*)g.Bt + (size_t)cur.e * g.bstride + (size_t)cur.pn * 2 * hstepB;
    PG8_STAGE(PG8_SB(0, 0), cB, voffB); PG8_STAGE(PG8_SB(0, 1), cB + hstepB, voffB); PG8_STAGE_A(PG8_SA(0, 0), cA, 0, voC); PG8_STAGE_A(PG8_SA(0, 1), cA, 1, voC);
    if (wr == 1) PG8_BAR;
    PG8_WAIT_V(2); PG8_BAR;
    PG8_STAGE(PG8_SB(1, 0), cB + kstep, voffB); PG8_STAGE_A(PG8_SA(1, 0), cA + kstep, 0, voC); PG8_STAGE(PG8_SB(1, 1), cB + hstepB + kstep, voffB);
    PG8_WAIT_V(6); PG8_BAR;
    for (;;) {
        const bool has_next = S.next(ui + 1, nxt);
        const char* nB = has_next ? (const char*)g.Bt + (size_t)nxt.e * g.bstride + (size_t)nxt.pn * 2 * hstepB : cB;
        const char* nA = (has_next && !GATHER) ? Ab + (size_t)nxt.pm * 2 * hstepA : cA;
        if constexpr (GATHER) { if (has_next) { PG8_SETVO(voN, nxt); } else {
#pragma unroll
            for (int h = 0; h < 2; ++h)
#pragma unroll
                for (int i = 0; i < 2; ++i) voN[h][i] = voC[h][i]; } }
        for (int t = 0; t < nt; t += 2) {
            const bool last = (t == nt - 2);
            if constexpr (Epi::MIDK > 0) { if (t == Epi::MIDK) { const int l2 = lane_id(); E.mid(acc, cur, wr, wc, l2 & 15, l2 >> 4); } }
            const char* a1 = cA + (size_t)(t + 1) * kstep;
            const char* a2 = last ? nA : cA + (size_t)(t + 2) * kstep; const char* b2 = last ? nB : cB + (size_t)(t + 2) * kstep;
            const char* a3 = a2 + kstep; const char* b3 = b2 + kstep;
            unsigned o2[2][2];
            if constexpr (GATHER) {
#pragma unroll
            for (int h = 0; h < 2; ++h)
#pragma unroll
                for (int i = 0; i < 2; ++i) o2[h][i] = last ? voN[h][i] : voC[h][i]; }
            PG8_LDB(B0, 0, 0); PG8_LDB(B1, 0, 1); PG8_SCHED; PG8_LDA(At, 0, 0); PG8_STAGE_A(PG8_SA(1, 1), a1, 1, voC);
            PG8_WAIT_V(8); PG8_WAIT_L(0); PG8_BAR; PG8_MMA(0, 0, At, B0); PG8_MMA(0, 1, At, B1); PG8_BAR; PG8_SCHED;
            PG8_LDA(At, 0, 1); PG8_STAGE(PG8_SB(0, 0), b2, voffB); PG8_STAGE(PG8_SB(0, 1), b2 + hstepB, voffB); PG8_STAGE_A(PG8_SA(0, 0), a2, 0, o2);
            PG8_WAIT_V(8); PG8_WAIT_L(0); PG8_BAR; PG8_MMA(1, 0, At, B0); PG8_MMA(1, 1, At, B1); PG8_BAR; PG8_SCHED;
            PG8_LDB(B0, 1, 0); PG8_LDB(B1, 1, 1); PG8_SCHED; PG8_LDA(At, 1, 0); PG8_STAGE_A(PG8_SA(0, 1), a2, 1, o2);
            PG8_WAIT_V(8); PG8_WAIT_L(0); PG8_BAR; PG8_MMA(0, 0, At, B0); PG8_MMA(0, 1, At, B1); PG8_BAR; PG8_SCHED;
            PG8_LDA(At, 1, 1); PG8_STAGE(PG8_SB(1, 0), b3, voffB); PG8_STAGE(PG8_SB(1, 1), b3 + hstepB, voffB); PG8_STAGE_A(PG8_SA(1, 0), a3, 0, o2);
            PG8_WAIT_V(8); PG8_WAIT_L(0); PG8_BAR; PG8_MMA(1, 0, At, B0); PG8_MMA(1, 1, At, B1); PG8_BAR; PG8_SCHED;
        }
        if (wr == 0) PG8_BAR;
        { const int l2 = lane_id(); E(acc, cur, wr, wc, l2 & 15, l2 >> 4); }
        if (!has_next) break;
#pragma unroll
        for (int a = 0; a < 2; ++a)
#pragma unroll
            for (int b = 0; b < 2; ++b)
#pragma unroll
                for (int m = 0; m < 4; ++m)
#pragma unroll
                    for (int n = 0; n < 2; ++n) acc[a][b][m][n] = (f32x4){0.f, 0.f, 0.f, 0.f};
        cur = nxt; cB = nB; cA = nA; ++ui;
        if constexpr (GATHER) {
#pragma unroll
        for (int h = 0; h < 2; ++h)
#pragma unroll
            for (int i = 0; i < 2; ++i) voC[h][i] = voN[h][i]; }
        if (wr == 1) PG8_BAR;
    }
    PG8_WAIT_V(0);
    PG8_BAR;
#undef PG8_SA
#undef PG8_SB
#undef PG8_STAGE
#undef PG8_LDA
#undef PG8_LDB
#undef PG8_MMA
#undef PG8_CAT8
#undef PG8_WAIT_V
#undef PG8_WAIT_L
#undef PG8_BAR
#undef PG8_SCHED
#undef PG8_SETVO
#undef PG8_STAGE_A
}

__device__ __forceinline__ float sq4(f32x4 v) { return (v[0] * v[0] + v[1] * v[1]) + (v[2] * v[2] + v[3] * v[3]); }
__device__ __forceinline__ float red_fq(float s) { s += __shfl_xor(s, 16); s += __shfl_xor(s, 32); return s; }
__device__ __forceinline__ u32x4 pack8(f32x4 a, f32x4 b) { u32x4 w; w.x = cvt_pk_bf16(a[0], a[1]); w.y = cvt_pk_bf16(a[2], a[3]); w.z = cvt_pk_bf16(b[0], b[1]); w.w = cvt_pk_bf16(b[2], b[3]); return w; }
template <int MODE> struct EpiBf16Stats {
    static constexpr bool PERM = true; static constexpr int MIDK = 0;
    bf16_t* O; int ldc; float* ssq;
    __device__ __forceinline__ void operator()(const Acc& acc, const Unit& u, int wr, int wc, int fr, int fq) const {
        const int row0 = u.pm * BM + wr * 64 + fr, col0 = u.pn * BM + wc * 32 + 8 * fq;
#pragma unroll
        for (int ai = 0; ai < 2; ++ai)
#pragma unroll
            for (int m = 0; m < 4; ++m) { const int row = row0 + ai * HALF + m * 16; bf16_t* rowp = O + (size_t)row * ldc + col0;
#pragma unroll
                for (int bj = 0; bj < 2; ++bj) *(u32x4*)(rowp + bj * HALF) = pack8(acc[ai][bj][m][0], acc[ai][bj][m][1]);
                if (MODE == 1) { float s = (sq4(acc[ai][0][m][0]) + sq4(acc[ai][0][m][1])) + (sq4(acc[ai][1][m][0]) + sq4(acc[ai][1][m][1])); s = red_fq(s); if (fq == 0) ssq[(size_t)row * 16 + u.pn * 4 + wc] = s; }
                else if (u.pn == 0) { float s = (sq4(acc[ai][0][m][0]) + sq4(acc[ai][0][m][1])) + (sq4(acc[ai][1][m][0]) + sq4(acc[ai][1][m][1])); s = red_fq(s); if (fq == 0) ssq[(size_t)row * 8 + wc] = s; }
                else if (u.pn == 1) { float s = sq4(acc[ai][0][m][0]) + sq4(acc[ai][0][m][1]); s = red_fq(s); if (fq == 0) ssq[(size_t)row * 8 + 4 + wc] = s; } }
    }
};
struct EpiQ {
    static constexpr bool PERM = true; static constexpr int MIDK = 0;
    bf16_t* Q; const float* ssq; const float* cs;
    __device__ __forceinline__ void operator()(const Acc& acc, const Unit& u, int wr, int wc, int fr, int fq) const {
        const int row0 = u.pm * BM + wr * 64 + fr;
#pragma unroll
        for (int ai = 0; ai < 2; ++ai)
#pragma unroll
            for (int m = 0; m < 4; ++m) { const int row = row0 + ai * HALF + m * 16; const f32x4 sv = *(const f32x4*)(ssq + (size_t)row * 8);
                const float rs = rsqrtf(((sv[0] + sv[1]) + (sv[2] + sv[3])) * (1.f / QL) + EPS); const int b = row / SEQ, s = row % SEQ;
#pragma unroll
                for (int bj = 0; bj < 2; ++bj) { const int cv = u.pn * BM + bj * HALF + wc * 32 + 8 * fq; const int h = cv / DQK, d = cv % DQK;
                    f32x4 v0 = acc[ai][bj][m][0] * rs, v1 = acc[ai][bj][m][1] * rs;
                    if (d >= DN) { const int i0 = (d - DN) >> 1; const f32x4 c = *(const f32x4*)(cs + (size_t)row * 64 + i0), sn = *(const f32x4*)(cs + (size_t)row * 64 + 32 + i0);
                        const f32x4 r0 = {v0[0] * c[0] - v0[1] * sn[0], v0[0] * sn[0] + v0[1] * c[0], v0[2] * c[1] - v0[3] * sn[1], v0[2] * sn[1] + v0[3] * c[1]};
                        const f32x4 r1 = {v1[0] * c[2] - v1[1] * sn[2], v1[0] * sn[2] + v1[1] * c[2], v1[2] * c[3] - v1[3] * sn[3], v1[2] * sn[3] + v1[3] * c[3]};
                        v0 = r0; v1 = r1; }
                    *(u32x4*)(Q + ((size_t)(b * NH + h) * SEQ + s) * DQK + d) = pack8(v0, v1); } }
    }
};
struct EpiKV {
    static constexpr bool PERM = true; static constexpr int MIDK = 0;
    bf16_t* Kc; bf16_t* Vc; const float* ssq;
    __device__ __forceinline__ void operator()(const Acc& acc, const Unit& u, int wr, int wc, int fr, int fq) const {
        const int row0 = u.pm * BM + wr * 64 + fr, d = wc * 32 + 8 * fq, h = u.pn;
#pragma unroll
        for (int ai = 0; ai < 2; ++ai)
#pragma unroll
            for (int m = 0; m < 4; ++m) { const int row = row0 + ai * HALF + m * 16; const f32x4 sv = *(const f32x4*)(ssq + (size_t)row * 8 + 4);
                const float rs = rsqrtf(((sv[0] + sv[1]) + (sv[2] + sv[3])) * (1.f / KVL) + EPS); const int b = row / SEQ, s = row % SEQ; const size_t t = (size_t)(b * NH + h) * SEQ + s;
                *(u32x4*)(Kc + t * DQK + d) = pack8(acc[ai][0][m][0] * rs, acc[ai][0][m][1] * rs);
                *(u32x4*)(Vc + t * DV + d) = pack8(acc[ai][1][m][0] * rs, acc[ai][1][m][1] * rs); }
    }
};
struct EpiWo {
    static constexpr bool PERM = false; static constexpr int MIDK = 8;
    const float* x; float* H; const float* assq;
    __device__ __forceinline__ void mid(Acc& acc, const Unit& u, int wr, int wc, int fr, int fq) const {
        const int row0 = u.pm * BM + wr * 64 + fr;
#pragma unroll
        for (int ai = 0; ai < 2; ++ai)
#pragma unroll
            for (int m = 0; m < 4; ++m) { const f32x4 sv = *(const f32x4*)(assq + (size_t)(row0 + ai * HALF + m * 16) * 4);
                const float rs = rsqrtf(((sv[0] + sv[1]) + (sv[2] + sv[3])) * (1.f / 512.f) + EPS);
#pragma unroll
                for (int bj = 0; bj < 2; ++bj)
#pragma unroll
                    for (int n = 0; n < 2; ++n) acc[ai][bj][m][n] = acc[ai][bj][m][n] * rs; }
    }
    __device__ __forceinline__ void operator()(const Acc& acc, const Unit& u, int wr, int wc, int fr, int fq) const {
        const int row0 = u.pm * BM + wr * 64 + fr, col0 = u.pn * BM + wc * 32 + 4 * fq;
#pragma unroll
        for (int ai = 0; ai < 2; ++ai)
#pragma unroll
            for (int m = 0; m < 4; ++m) { const size_t off = (size_t)(row0 + ai * HALF + m * 16) * DM + col0;
#pragma unroll
                for (int bj = 0; bj < 2; ++bj)
#pragma unroll
                    for (int n = 0; n < 2; ++n) *(f32x4*)(H + off + bj * HALF + n * 16) = *(const f32x4*)(x + off + bj * HALF + n * 16) + acc[ai][bj][m][n]; }
    }
};
__device__ __forceinline__ float swiglu_f(float g, float u) { g = fminf(g, 7.f); u = fminf(fmaxf(u, -7.f), 7.f); return g * fast_sigmoid(1.702f * g) * (u + 1.f); }
__device__ __forceinline__ unsigned pk4_fp8(f32x4 v) { unsigned w = 0; w = __builtin_amdgcn_cvt_pk_fp8_f32(v[0], v[1], w, false); w = __builtin_amdgcn_cvt_pk_fp8_f32(v[2], v[3], w, true); return w; }
constexpr float WSCALE = 64.f, WINV = 1.f / 64.f;
struct EpiMoe1 {
    static constexpr bool PERM = true; static constexpr int MIDK = 0;
    unsigned char* HB; const float* b1;
    __device__ __forceinline__ void operator()(const Acc& acc, const Unit& u, int wr, int wc, int fr, int fq) const {
        const int row0 = u.pm * BM + wr * 64 + fr, j0 = u.pn * HALF + wc * 32 + 8 * fq; const float* bg = b1 + (size_t)u.e * 2048 + j0;
        const f32x4 g0 = *(const f32x4*)bg, g1 = *(const f32x4*)(bg + 4), u0 = *(const f32x4*)(bg + 1024), u1 = *(const f32x4*)(bg + 1028);
#pragma unroll
        for (int ai = 0; ai < 2; ++ai)
#pragma unroll
            for (int m = 0; m < 4; ++m) { const f32x4 a0 = acc[ai][0][m][0] * WINV + g0, a1 = acc[ai][0][m][1] * WINV + g1, c0 = acc[ai][1][m][0] * WINV + u0, c1 = acc[ai][1][m][1] * WINV + u1; f32x4 r0, r1;
#pragma unroll
                for (int j = 0; j < 4; ++j) { r0[j] = swiglu_f(a0[j], c0[j]); r1[j] = swiglu_f(a1[j], c1[j]); }
                *(u32x2*)(HB + (size_t)(row0 + ai * HALF + m * 16) * DE + j0) = (u32x2){pk4_fp8(r0), pk4_fp8(r1)}; }
    }
};
struct EpiMoe2 {
    static constexpr bool PERM = true; static constexpr int MIDK = 0;
    bf16_t* Y; const float* b2; const int* rowslot; const float* rowgate;
    __device__ __forceinline__ void operator()(const Acc& acc, const Unit& u, int wr, int wc, int fr, int fq) const {
        const int row0 = u.pm * BM + wr * 64 + fr, col0 = u.pn * BM + wc * 32 + 8 * fq; const float* bb = b2 + (size_t)u.e * DM + col0;
        f32x4 bv[2][2];
#pragma unroll
        for (int bj = 0; bj < 2; ++bj)
#pragma unroll
            for (int n = 0; n < 2; ++n) bv[bj][n] = *(const f32x4*)(bb + bj * HALF + 4 * n);
#pragma unroll
        for (int ai = 0; ai < 2; ++ai)
#pragma unroll
            for (int m = 0; m < 4; ++m) { const int r = row0 + ai * HALF + m * 16; const float gt = rowgate[r]; bf16_t* yp = Y + (size_t)rowslot[r] * DM + col0;
#pragma unroll
                for (int bj = 0; bj < 2; ++bj) *(u32x4*)(yp + bj * HALF) = pack8((acc[ai][bj][m][0] * WINV + bv[bj][0]) * gt, (acc[ai][bj][m][1] * WINV + bv[bj][1]) * gt); }
    }
};
struct EpiPle {
    static constexpr bool PERM = false; static constexpr int MIDK = 0;
    float* H; float* Ho; const bf16_t* pler; const float* pssq; const float* pg; float* fssq;
    __device__ __forceinline__ void operator()(const Acc& acc, const Unit& u, int wr, int wc, int fr, int fq) const {
        const int row0 = u.pm * BM + wr * 64 + fr, col0 = u.pn * BM + wc * 32 + 4 * fq;
        f32x4 gv[2][2];
#pragma unroll
        for (int bj = 0; bj < 2; ++bj)
#pragma unroll
            for (int n = 0; n < 2; ++n) gv[bj][n] = *(const f32x4*)(pg + col0 + bj * HALF + n * 16);
#pragma unroll
        for (int ai = 0; ai < 2; ++ai)
#pragma unroll
            for (int m = 0; m < 4; ++m) { const int row = row0 + ai * HALF + m * 16; const size_t off = (size_t)row * DM + col0; const f32x4* pp = (const f32x4*)(pssq + (size_t)row * 16);
                const f32x4 p0 = pp[0], p1 = pp[1], p2 = pp[2], p3 = pp[3];
                const float rp = rsqrtf((((p0[0] + p0[1]) + (p0[2] + p0[3])) + ((p1[0] + p1[1]) + (p1[2] + p1[3])) + ((p2[0] + p2[1]) + (p2[2] + p2[3])) + ((p3[0] + p3[1]) + (p3[2] + p3[3]))) * (1.f / DM) + EPS);
                float ss = 0.f;
#pragma unroll
                for (int bj = 0; bj < 2; ++bj)
#pragma unroll
                    for (int n = 0; n < 2; ++n) { const size_t o = off + bj * HALF + n * 16; const u32x2 pr = *(const u32x2*)(pler + o); const f32x4 a = acc[ai][bj][m][n]; const f32x4 hv = *(const f32x4*)(H + o);
                        const f32x4 pl = {blo(pr.x), bhi(pr.x), blo(pr.y), bhi(pr.y)}; f32x4 r;
#pragma unroll
                        for (int j = 0; j < 4; ++j) r[j] = hv[j] + fast_sigmoid(a[j]) * (pl[j] * rp * gv[bj][n][j]);
                        *(f32x4*)(Ho + o) = r; ss += sq4(r); }
                ss = red_fq(ss); if (fq == 0) fssq[(size_t)row * 16 + u.pn * 4 + wc] = ss; }
    }
};
}

namespace att {
typedef float f32x16 __attribute__((ext_vector_type(16)));
typedef short s16x4 __attribute__((ext_vector_type(4)));
constexpr int QBLK = 32, KVBLK = 64, QB = 256;
constexpr int SHM_K = KVBLK * DQK * 2, SHM_V = KVBLK * DV * 2;
constexpr int L_V = 0, L_K = 2 * SHM_V, L_WS = L_K + 2 * SHM_K, L_END = L_WS + NWAVES * 256;
constexpr float THR = 8.f;
#define KSWZ(row, colB) ((row) * 384 + ((colB) ^ (((row) & 7) << 4)))
#define SBAR() __builtin_amdgcn_sched_barrier(0)
__device__ __forceinline__ int v_st(int k, int c) { const int kk = (k & ~0xC) | ((k & 4) << 1) | ((k & 8) >> 1); return ((kk >> 3) * 4 + (c >> 5)) * 512 + ((kk & 7) * 32 + (c & 31)) * 2; }
__device__ __forceinline__ int v_rd_base(int lane) { return ((lane & 3) << 3) | (((lane >> 2) & 3) << 6) | (((lane >> 4) & 1) << 5) | (((lane >> 5) & 1) << 8); }
constexpr int v_rd_off(int d0, int ks, int half) { return d0 * 512 + ks * 4096 + half * 2048; }
__device__ __forceinline__ int crow(int r, int hi) { return (r & 3) + 8 * (r >> 2) + 4 * hi; }
typedef __bf16 bf16x2_t __attribute__((ext_vector_type(2)));
__device__ __forceinline__ unsigned cvtpk(float lo, float hi) { f32x2 v = {lo, hi}; bf16x2_t b = __builtin_convertvector(v, bf16x2_t); return __builtin_bit_cast(unsigned, b); }

__device__ __forceinline__ void qkt(f32x16& p0, f32x16& p1, const LAS unsigned char* Kbuf, int r32, int hi, const bf16x8* qr) {
    p0 = f32x16{}; p1 = f32x16{};
    const LAS unsigned char* kb[4];
#pragma unroll
    for (int dd = 0; dd < 4; ++dd) kb[dd] = Kbuf + KSWZ(r32, (dd * 16 + hi * 8) * 2);
#pragma unroll
    for (int d0 = 0; d0 < 12; ++d0) { const LAS unsigned char* a = kb[d0 & 3] + (d0 >> 2) * 128;
        const bf16x8 b0 = *(const LAS bf16x8*)a; const bf16x8 b1 = *(const LAS bf16x8*)(a + 32 * 384);
        p0 = __builtin_amdgcn_mfma_f32_32x32x16_bf16(b0, qr[d0], p0, 0, 0, 0);
        p1 = __builtin_amdgcn_mfma_f32_32x32x16_bf16(b1, qr[d0], p1, 0, 0, 0); }
}
template <int VB>
__device__ __forceinline__ void pv_tile(f32x16* o, int vb0, bf16x8 pa0, bf16x8 pa1, bf16x8 pa2, bf16x8 pa3) {
#define TRRD(dst, off) asm volatile("ds_read_b64_tr_b16 %0, %1 offset:%2" : "=&v"(dst) : "v"(vb0), "i"(off) : "memory")
#define PV_D0(d0) do { s16x4 l0, l1, l2, l3, h0, h1, h2, h3; constexpr int b_ = VB * SHM_V + v_rd_off(d0, 0, 0); \
        TRRD(l0, b_); TRRD(h0, b_ + 2048); TRRD(l1, b_ + 4096); TRRD(h1, b_ + 6144); TRRD(l2, b_ + 8192); TRRD(h2, b_ + 10240); TRRD(l3, b_ + 12288); TRRD(h3, b_ + 14336); \
        asm volatile("s_waitcnt lgkmcnt(0)" ::: "memory"); SBAR(); \
        o[d0] = __builtin_amdgcn_mfma_f32_32x32x16_bf16(pa0, (bf16x8){l0[0], l0[1], l0[2], l0[3], h0[0], h0[1], h0[2], h0[3]}, o[d0], 0, 0, 0); \
        o[d0] = __builtin_amdgcn_mfma_f32_32x32x16_bf16(pa1, (bf16x8){l1[0], l1[1], l1[2], l1[3], h1[0], h1[1], h1[2], h1[3]}, o[d0], 0, 0, 0); \
        o[d0] = __builtin_amdgcn_mfma_f32_32x32x16_bf16(pa2, (bf16x8){l2[0], l2[1], l2[2], l2[3], h2[0], h2[1], h2[2], h2[3]}, o[d0], 0, 0, 0); \
        o[d0] = __builtin_amdgcn_mfma_f32_32x32x16_bf16(pa3, (bf16x8){l3[0], l3[1], l3[2], l3[3], h3[0], h3[1], h3[2], h3[3]}, o[d0], 0, 0, 0); } while (0)
    PV_D0(0); PV_D0(1); PV_D0(2); PV_D0(3);
#undef PV_D0
#undef TRRD
}
__device__ __forceinline__ void attn_block(int bh, int qb, const bf16_t* __restrict__ Q, const bf16_t* __restrict__ K, const bf16_t* __restrict__ V, bf16_t* __restrict__ MIX, float* __restrict__ ASSQ, LAS unsigned char* lds, const int wid) {
    const int lane = lane_id(), r32 = lane & 31, hi = lane >> 5;
    const int b = bh / NH, h = bh % NH;
    const bf16_t* Qw = Q + ((size_t)bh * SEQ + qb * QB + wid * QBLK + r32) * DQK;
    const bf16_t* Kh = K + (size_t)bh * SEQ * DQK; const bf16_t* Vh = V + (size_t)bh * SEQ * DV;
    bf16x8 qr[12];
#pragma unroll
    for (int d0 = 0; d0 < 12; ++d0) qr[d0] = *(const bf16x8*)(Qw + d0 * 16 + hi * 8);
    const int NT = 4 * qb + 4, qlo = qb * QB + wid * QBLK, qm = qlo + r32 - 4 * hi;
    LAS unsigned char* V_lds = lds + L_V; LAS unsigned char* K_lds = lds + L_K;
    LAS float* wsf = (LAS float*)(lds + L_WS) + wid * 64; LAS float* li_l = wsf; LAS float* al_l = wsf + 32;
    unsigned ksrc[3], vsrc[2];
#pragma unroll
    for (int i = 0; i < 3; ++i) { const int off = ((wid + 8 * i) * 64 + lane) * 16, row = off / 384, wb = off % 384, seg = wb >> 7, cpos = (wb & 127) >> 4; ksrc[i] = (unsigned)(row * 384 + seg * 128 + ((cpos ^ (row & 7)) << 4)); }
#pragma unroll
    for (int i = 0; i < 2; ++i) { const int off = ((wid + 8 * i) * 64 + lane) * 16, st = off >> 9, o_ = off & 511, kk = (st >> 2) * 8 + (o_ >> 6), c = (st & 3) * 32 + ((o_ & 63) >> 1);
        const int k = (kk & ~0xC) | ((kk & 4) << 1) | ((kk & 8) >> 1); vsrc[i] = (unsigned)(k * 256 + c * 2); }
    const int vb0 = (int)(unsigned)(uintptr_t)V_lds + v_rd_base(lane);
#define ADMA(t, bf) do { const char* kp = (const char*)(Kh + (size_t)(t) * KVBLK * DQK); const char* vp = (const char*)(Vh + (size_t)(t) * KVBLK * DV); \
        _Pragma("unroll") for (int i = 0; i < 3; ++i) __builtin_amdgcn_global_load_lds((const unsigned*)(kp + ksrc[i]), (LAS unsigned*)(K_lds + (bf) * SHM_K + (wid + 8 * i) * 1024), 16, 0, 0); \
        _Pragma("unroll") for (int i = 0; i < 2; ++i) __builtin_amdgcn_global_load_lds((const unsigned*)(vp + vsrc[i]), (LAS unsigned*)(V_lds + (bf) * SHM_V + (wid + 8 * i) * 1024), 16, 0, 0); } while (0)
    float m_reg = -1e30f, l_reg = 0.f; f32x16 o[4] = {};
    ADMA(0, 0);
#define TILE(t, BF) do { \
        asm volatile("s_waitcnt vmcnt(0)" ::: "memory"); __syncthreads(); \
        if ((t) + 1 < NT) ADMA((t) + 1, (BF) ^ 1); \
        const int kb_ = (t) * KVBLK; \
        if (kb_ <= qlo + QBLK - 1) { \
            f32x16 p0, p1; SBAR(); qkt(p0, p1, K_lds + (BF) * SHM_K, r32, hi, qr); \
            if (kb_ + KVBLK - 1 > qlo) { const int dq = qm - kb_; const float NEG = -__builtin_inff(); \
                _Pragma("unroll") for (int r = 0; r < 16; ++r) { const int c = (r & 3) + 8 * (r >> 2); if (c > dq) p0[r] = NEG; if (c + 32 > dq) p1[r] = NEG; } } \
            float pmax = p0[0]; _Pragma("unroll") for (int r = 1; r < 16; ++r) pmax = fmaxf(pmax, p0[r]); _Pragma("unroll") for (int r = 0; r < 16; ++r) pmax = fmaxf(pmax, p1[r]); \
            { auto rr = __builtin_amdgcn_permlane32_swap(__float_as_uint(pmax), __float_as_uint(pmax), false, false); pmax = fmaxf(__uint_as_float(rr[0]), __uint_as_float(rr[1])); } \
            if (!__all(pmax - m_reg <= THR)) { const float mn = fmaxf(m_reg, pmax); const float alpha = __builtin_amdgcn_exp2f(m_reg - mn); m_reg = mn; l_reg *= alpha; \
                if (hi == 0) al_l[r32] = alpha; asm volatile("s_waitcnt lgkmcnt(0)" ::: "memory"); \
                _Pragma("unroll") for (int d_ = 0; d_ < 4; ++d_) _Pragma("unroll") for (int r = 0; r < 16; ++r) o[d_][r] *= al_l[crow(r, hi)]; } \
            float ps = 0.f; \
            _Pragma("unroll") for (int r = 0; r < 16; ++r) { p0[r] = __builtin_amdgcn_exp2f(p0[r] - m_reg); p1[r] = __builtin_amdgcn_exp2f(p1[r] - m_reg); } \
            _Pragma("unroll") for (int r = 0; r < 16; ++r) ps += p0[r] + p1[r]; \
            { auto rr = __builtin_amdgcn_permlane32_swap(__float_as_uint(ps), __float_as_uint(ps), false, false); ps = __uint_as_float(rr[0]) + __uint_as_float(rr[1]); } \
            l_reg += ps; \
            bf16x8 pa0, pa1, pa2, pa3; \
            PK4(p0, 0, pa0); PK4(p0, 8, pa1); PK4(p1, 0, pa2); PK4(p1, 8, pa3); \
            SBAR(); pv_tile<BF>(o, vb0, pa0, pa1, pa2, pa3); } } while (0)
#define PK4(P, B_, OUT) do { unsigned a0 = cvtpk(P[B_ + 0], P[B_ + 1]), a1 = cvtpk(P[B_ + 2], P[B_ + 3]); \
        unsigned b0 = cvtpk(P[B_ + 4], P[B_ + 5]), b1 = cvtpk(P[B_ + 6], P[B_ + 7]); \
        auto r0 = __builtin_amdgcn_permlane32_swap(a0, b0, false, false); auto r1 = __builtin_amdgcn_permlane32_swap(a1, b1, false, false); \
        u32x4 w = {r0[0], r1[0], r0[1], r1[1]}; OUT = __builtin_bit_cast(bf16x8, w); } while (0)
    for (int t = 0; t < NT; t += 2) { TILE(t, 0); TILE(t + 1, 1); }
#undef PK4
#undef TILE
#undef ADMA
    if (hi == 0) li_l[r32] = l_reg;
    asm volatile("s_waitcnt vmcnt(0) lgkmcnt(0)" ::: "memory");
    float rli[16];
#pragma unroll
    for (int r = 0; r < 16; ++r) rli[r] = __builtin_amdgcn_rcpf(li_l[crow(r, hi)]);
    __syncthreads();
    LAS bf16_t* stg = (LAS bf16_t*)(lds + wid * 8192);
#pragma unroll
    for (int r = 0; r < 16; ++r) { const int orow = crow(r, hi);
#pragma unroll
        for (int d0 = 0; d0 < 4; ++d0) stg[orow * 128 + d0 * 32 + r32] = f2bf(o[d0][r] * rli[r]); }
    asm volatile("s_waitcnt lgkmcnt(0)" ::: "memory");
    const size_t row0 = (size_t)b * SEQ + qb * QB + wid * QBLK;
#pragma unroll
    for (int i = 0; i < 8; ++i) { const int row = i * 4 + (lane >> 4), ch = lane & 15; const u32x4 v = *(const LAS u32x4*)(stg + row * 128 + ch * 8);
        float ss = (blo(v.x) * blo(v.x) + bhi(v.x) * bhi(v.x)) + (blo(v.y) * blo(v.y) + bhi(v.y) * bhi(v.y)) + (blo(v.z) * blo(v.z) + bhi(v.z) * bhi(v.z)) + (blo(v.w) * blo(v.w) + bhi(v.w) * bhi(v.w));
        ss += __shfl_xor(ss, 1); ss += __shfl_xor(ss, 2); ss += __shfl_xor(ss, 4); ss += __shfl_xor(ss, 8);
        *(u32x4*)(MIX + (row0 + row) * DM + h * DV + ch * 8) = v;
        if (ch == 0) ASSQ[(row0 + row) * 4 + h] = ss; }
    __syncthreads();
}
#undef KSWZ
#undef SBAR
}

struct Args { const void* in[25]; float* out; unsigned char* ws; int ph_lo, ph_hi, li, skip; };
enum { PH_PREP = 0, PH_INPROJ, PH_TOKLOCAL, PH_ATTN, PH_WO, PH_ROUTER, PH_ROUTE, PH_MOE1, PH_MOE2, PH_COMBINE, PH_PLE, PH_FINAL, PH_COUNT };

template <int MODE> __device__ __forceinline__ int cmap_col(int n) {
    if (MODE == 1) { const int pn = n >> 8, half = (n >> 7) & 1, jj = n & 127; return half * 1024 + pn * 128 + jj; }
    if (MODE == 2) { const int h = n / DQK, d = n % DQK; if (d < DN) return n; const int t = d - DN; return h * DQK + DN + (t & 1) * 32 + (t >> 1); }
    return n;
}
template <int MODE> __device__ __forceinline__ void transpose_item_fp8(const float* __restrict__ W, int ldsrc, int nblk, unsigned char* __restrict__ WT, int ldd, const float* __restrict__ gain, float scale,
                                                                      LAS float* scr, int item, int lane) {
    const int kb = item / nblk, nb = item % nblk, k0 = 64 * kb, n0 = 32 * nb; const int c = cmap_col<MODE>(n0 + (lane & 31));
    float wv[32];
#pragma unroll
    for (int i = 0; i < 32; ++i) wv[i] = W[(size_t)(k0 + 2 * i + (lane >> 5)) * ldsrc + c];
#pragma unroll
    for (int i = 0; i < 32; ++i) { const int kk = 2 * i + (lane >> 5), k = k0 + kk; float gk = scale; if (gain) gk *= gain[k]; scr[kk * 33 + (lane & 31)] = wv[i] * gk; }
    asm volatile("s_waitcnt lgkmcnt(0)" ::: "memory");
    const int cc = lane & 3;
#pragma unroll
    for (int j = 0; j < 2; ++j) { const int n = (lane >> 2) + 16 * j; const LAS float* s = scr + (16 * cc) * 33 + n; u32x4 o;
        o.x = pg8::pk4_fp8((f32x4){s[0 * 33], s[1 * 33], s[2 * 33], s[3 * 33]}); o.y = pg8::pk4_fp8((f32x4){s[4 * 33], s[5 * 33], s[6 * 33], s[7 * 33]});
        o.z = pg8::pk4_fp8((f32x4){s[8 * 33], s[9 * 33], s[10 * 33], s[11 * 33]}); o.w = pg8::pk4_fp8((f32x4){s[12 * 33], s[13 * 33], s[14 * 33], s[15 * 33]});
        *(u32x4*)(WT + (size_t)(n0 + n) * ldd + k0 + 16 * cc) = o; }
    asm volatile("s_waitcnt lgkmcnt(0)" ::: "memory");
}
template <int MODE> __device__ __forceinline__ void transpose_item(const float* __restrict__ W, int ldsrc, int nblk, bf16_t* __restrict__ WT, int ldd, const float* __restrict__ gain, const float* __restrict__ gain2, float scale,
                                                                  LAS float* scr, int item, int lane) {
    const int kb = item / nblk, nb = item % nblk, k0 = 64 * kb, n0 = 32 * nb; const int c = cmap_col<MODE>(n0 + (lane & 31));
    float wv[32];
#pragma unroll
    for (int i = 0; i < 32; ++i) wv[i] = W[(size_t)(k0 + 2 * i + (lane >> 5)) * ldsrc + c];
#pragma unroll
    for (int i = 0; i < 32; ++i) { const int kk = 2 * i + (lane >> 5), k = k0 + kk; float gk = scale; if (gain) gk *= (gain2 && k >= 512) ? gain2[k - 512] : gain[k];
        scr[kk * 33 + (lane & 31)] = wv[i] * gk; }
    asm volatile("s_waitcnt lgkmcnt(0)" ::: "memory");
    const int cc = lane & 7;
#pragma unroll
    for (int j = 0; j < 4; ++j) { const int n = (lane >> 3) + 8 * j; const LAS float* s = scr + (8 * cc) * 33 + n;
        u32x4 o; o.x = pk2(s[0 * 33], s[1 * 33]); o.y = pk2(s[2 * 33], s[3 * 33]); o.z = pk2(s[4 * 33], s[5 * 33]); o.w = pk2(s[6 * 33], s[7 * 33]);
        *(u32x4*)(WT + (size_t)(n0 + n) * ldd + k0 + 8 * cc) = o; }
    asm volatile("s_waitcnt lgkmcnt(0)" ::: "memory");
}

__global__ void __launch_bounds__(NTHREADS, 2) fwd(Args args) {
    extern __shared__ __attribute__((aligned(16))) unsigned char lds_raw[];
    LAS unsigned char* lds = (LAS unsigned char*)lds_raw;
    volatile LAS unsigned* MISC = (volatile LAS unsigned*)(lds + MISC_OFF);
    const int wave = __builtin_amdgcn_readfirstlane(threadIdx.x >> 6);
    const int G = gridDim.x, bx = blockIdx.x;
#define PHASE_LANE const int lane = lane_id(); const int tid = wave * 64 + lane; (void)tid
    const int gw = bx * NWAVES + wave, NGW = G * NWAVES;
    unsigned char* ws = args.ws; int* ctl = (int*)(ws + WS_CTL); float* H = args.out;
    const float* x = (const float*)args.in[0]; const float* p = (const float*)args.in[1]; const int* pos = (const int*)args.in[2];
    const float *mix_norm = (const float*)args.in[3], *w_in = (const float*)args.in[4], *q_norm = (const float*)args.in[5], *w_uq = (const float*)args.in[6], *kv_norm = (const float*)args.in[7],
                *w_ukv = (const float*)args.in[8], *attn_out_norm = (const float*)args.in[10], *conv_out_norm = (const float*)args.in[11], *w_o = (const float*)args.in[12],
                *moe_norm = (const float*)args.in[13], *w_router = (const float*)args.in[14], *w1 = (const float*)args.in[16], *b1 = (const float*)args.in[17],
                *w2 = (const float*)args.in[18], *b2 = (const float*)args.in[19], *ple_norm = (const float*)args.in[20], *w_ple_gate = (const float*)args.in[21], *w_ple_proj = (const float*)args.in[22],
                *ple_post_norm = (const float*)args.in[23], *conv_w = (const float*)args.in[9], *b_router = (const float*)args.in[15], *final_norm = (const float*)args.in[24];
    int* TOPI = (int*)(ws + WS_TOPI); float* TOPG = (float*)(ws + WS_TOPG);
    bf16_t *WIN = (bf16_t*)(ws + WS_WIN), *WUQ = (bf16_t*)(ws + WS_WUQ), *WUKV = (bf16_t*)(ws + WS_WUKV), *WO = (bf16_t*)(ws + WS_WO), *WG = (bf16_t*)(ws + WS_WG), *WP = (bf16_t*)(ws + WS_WP);
    bf16_t *W1T = (bf16_t*)(ws + WS_W1), *W2T = (bf16_t*)(ws + WS_W2), *XN = (bf16_t*)(ws + WS_XN), *MIX = (bf16_t*)(ws + WS_MIX), *PLER = (bf16_t*)(ws + WS_PLER);
    bf16_t *Z = (bf16_t*)(ws + WS_Z), *Qb = (bf16_t*)(ws + WS_Q), *Kb = (bf16_t*)(ws + WS_K), *Vb = (bf16_t*)(ws + WS_V), *HB = (bf16_t*)(ws + WS_HB), *Y = (bf16_t*)(ws + WS_Y), *P16 = (bf16_t*)(ws + WS_P16);
    float *WR = (float*)(ws + WS_WR), *CS = (float*)(ws + WS_CS), *SSQ = (float*)(ws + WS_SSQ), *ASSQ = (float*)(ws + WS_ASSQ), *PSSQ = (float*)(ws + WS_PSSQ), *FSSQ = (float*)(ws + WS_FSSQ);
    int *ROWTOK = (int*)(ws + WS_ROWTOK), *ROWSLOT = (int*)(ws + WS_ROWSLOT); float* ROWGATE = (float*)(ws + WS_ROWGATE);

    { PHASE_LANE; for (int u = tid; u < (LDS_BYTES - MISC_OFF) / 4; u += NTHREADS) ((LAS unsigned*)(lds + MISC_OFF))[u] = 0u; }
    __syncthreads();
    const int lo = args.ph_lo, hi = args.ph_hi;
    XcdBarrier bar; bar.bar = (unsigned*)ctl + CW_BAR + args.li * XCD_BAR_WORDS; bar.x = 0; bar.st = MISC + 8;
    if (hi - lo > 1) bar = xcd_barrier_post((unsigned*)ctl + CW_BAR + args.li * XCD_BAR_WORDS, MISC + 8, wave);
#define IN(k) (lo <= (k) && (k) < hi)
#define NREP(k) ((PROBE_PH == (k)) ? PROBE_REP : 1)
#define REPLOOP(k) for (int rep = 0; rep < NREP(k); ++rep)
#define LASTREP(k) (rep == NREP(k) - 1)
#define SEAM(k) do { if (IN(k) && IN((k) + 1)) xcd_barrier(bar, wave); } while (0)

    if (IN(PH_PREP)) REPLOOP(PH_PREP) {
        PHASE_LANE;
        LAS float* scr = (LAS float*)(lds + wave * 16384);
        constexpr int I_IN = (DM / 64) * (INW / 32), I_UQ = (QL / 64) * (768 / 32), I_UKV = (KVL / 64) * (1024 / 32), I_O = (DM / 64) * (DM / 32), I_G = I_O, I_P = (PLE / 64) * (DM / 32);
        constexpr int I_1 = (DM / 64) * (2048 / 32), I_2 = (DE / 64) * (DM / 32);
        constexpr int NITEMS = I_IN + I_UQ + I_UKV + I_O + I_G + I_P + NE * I_1 + NE * I_2;
        for (int it = gw; it < NITEMS; it += NGW) {
            int r = it;
            if (r < I_IN) { transpose_item<0>(w_in, INW, INW / 32, WIN, DM, mix_norm, nullptr, 1.f, scr, r, lane); continue; } r -= I_IN;
            if (r < I_UQ) { transpose_item<2>(w_uq, 768, 768 / 32, WUQ, QL, q_norm, nullptr, QSCALE, scr, r, lane); continue; } r -= I_UQ;
            if (r < I_UKV) { transpose_item<0>(w_ukv, 1024, 1024 / 32, WUKV, 256, kv_norm, nullptr, 1.f, scr, r, lane); continue; } r -= I_UKV;
            if (r < I_O) { transpose_item<0>(w_o, DM, DM / 32, WO, DM, attn_out_norm, conv_out_norm, 1.f, scr, r, lane); continue; } r -= I_O;
            if (r < I_G) { transpose_item<0>(w_ple_gate, DM, DM / 32, WG, DM, ple_norm, nullptr, 1.f, scr, r, lane); continue; } r -= I_G;
            if (r < I_P) { transpose_item<0>(w_ple_proj, DM, DM / 32, WP, PLE, nullptr, nullptr, 1.f, scr, r, lane); continue; } r -= I_P;
            if (r < NE * I_1) { const int e = r / I_1; transpose_item_fp8<1>(w1 + (size_t)e * DM * 2048, 2048, 2048 / 32, (unsigned char*)W1T + (size_t)e * 2048 * DM, DM, moe_norm, pg8::WSCALE, scr, r % I_1, lane); continue; } r -= NE * I_1;
            { const int e = r / I_2; transpose_item_fp8<0>(w2 + (size_t)e * DE * DM, DM, DM / 32, (unsigned char*)W2T + (size_t)e * DM * DE, DE, nullptr, pg8::WSCALE, scr, r % I_2, lane); }
        }
        for (int i = bx * NTHREADS + tid; i < 1024 * 16; i += G * NTHREADS) *(u32x4*)(WUKV + (size_t)(i >> 4) * 256 + 128 + (i & 15) * 8) = (u32x4){0u, 0u, 0u, 0u};
        for (int i = bx * NTHREADS + tid; i < DM * NE; i += G * NTHREADS) { const int e = i >> 10, k = i & 1023; WR[i] = w_router[k * NE + e] * moe_norm[k]; }
        for (int i = bx * NTHREADS + tid; i < NTOK * 32; i += G * NTHREADS) { const int t = i >> 5, j = i & 31; const float inv = powf(10000.f, -(float)j / 32.f); const float a = (float)pos[t] * inv; float sn, c; sincosf(a, &sn, &c);
            CS[(size_t)t * 64 + j] = c; CS[(size_t)t * 64 + 32 + j] = sn; }
        for (int i = bx * NTHREADS + tid; i < NTOK * PLE / 4; i += G * NTHREADS) { const f32x4 v = ((const f32x4*)p)[i]; ((u32x2*)P16)[i] = (u32x2){pk2(v[0], v[1]), pk2(v[2], v[3])}; }
        for (int row = gw * 4; row < NTOK; row += NGW * 4) {
            f32x4 v[4][4]; float ss[4];
#pragma unroll
            for (int q = 0; q < 4; ++q) { const f32x4* s = (const f32x4*)(x + (size_t)(row + q) * DM);
#pragma unroll
                for (int j = 0; j < 4; ++j) v[q][j] = s[lane + 64 * j]; }
#pragma unroll
            for (int q = 0; q < 4; ++q) { ss[q] = 0.f;
#pragma unroll
                for (int j = 0; j < 4; ++j) ss[q] += pg8::sq4(v[q][j]); }
#pragma unroll
            for (int q = 0; q < 4; ++q) { const float rstd = rsqrtf(wave_sum(ss[q]) * (1.f / DM) + EPS); u32x2* d = (u32x2*)(XN + (size_t)(row + q) * DM);
#pragma unroll
                for (int j = 0; j < 4; ++j) d[lane + 64 * j] = (u32x2){pk2(v[q][j][0] * rstd, v[q][j][1] * rstd), pk2(v[q][j][2] * rstd, v[q][j][3] * rstd)}; }
        }
    }
    SEAM(PH_PREP);
    if (IN(PH_INPROJ)) REPLOOP(PH_INPROJ) {
        { pg8::Gemm g{XN, WIN, DM, DM, DM, nullptr, 0}; pg8::StaticOrder S; S.init(NTOK / 256, INWP / 256, G, bx, nullptr);
          pg8::EpiBf16Stats<0> E{Z, INWP, SSQ}; pg8::gemm_phase<pg8::EpiBf16Stats<0>, false>(lds, g, S, E, wave); }
        { pg8::Gemm g{P16, WP, PLE, PLE, PLE, nullptr, 0}; pg8::StaticOrder S; S.init(NTOK / 256, DM / 256, G, bx, nullptr);
          pg8::EpiBf16Stats<1> E{PLER, DM, PSSQ}; pg8::gemm_phase<pg8::EpiBf16Stats<1>, false>(lds, g, S, E, wave); }
    }
    SEAM(PH_INPROJ);
    if (IN(PH_TOKLOCAL)) REPLOOP(PH_TOKLOCAL) {
        PHASE_LANE;
        if (!(args.skip & 1)) for (int row = gw; row < NTOK; row += NGW) {
            const bf16_t* z = Z + (size_t)row * INWP; const int s = row % SEQ, b = row / SEQ;
            if (lane < 32) { const float x1 = bf2f(z[384 + lane]), x2 = bf2f(z[416 + lane]); const float c = CS[(size_t)row * 64 + lane], sn = CS[(size_t)row * 64 + 32 + lane];
                const unsigned o = pk2(x1 * c - x2 * sn, x1 * sn + x2 * c);
#pragma unroll
                for (int h = 0; h < NH; ++h) *(unsigned*)(Kb + ((size_t)(b * NH + h) * SEQ + s) * DQK + DN + 2 * lane) = o; }
            float y[8]; float ss = 0.f;
#pragma unroll
            for (int j = 0; j < 8; ++j) { const int c = lane + 64 * j;
                const float u0 = bf2f(z[960 + c]) * bf2f(z[1472 + c]);
                const float u1 = s >= 1 ? bf2f(z[960 + c - INWP]) * bf2f(z[1472 + c - INWP]) : 0.f;
                const float u2 = s >= 2 ? bf2f(z[960 + c - 2 * INWP]) * bf2f(z[1472 + c - 2 * INWP]) : 0.f;
                const float v = bf2f(z[448 + c]) * (conv_w[c] * u2 + conv_w[512 + c] * u1 + conv_w[1024 + c] * u0);
                y[j] = v; ss += v * v; }
            const float rstd = rsqrtf(wave_sum(ss) * (1.f / 512.f) + EPS);
#pragma unroll
            for (int j = 0; j < 8; ++j) MIX[(size_t)row * DM + 512 + lane + 64 * j] = f2bf(y[j] * rstd);
        }
        { pg8::Gemm g{Z, WUQ, QL, INWP, QL, nullptr, 0}; pg8::StaticOrder S; S.init(NTOK / 256, 768 / 256, G, bx, nullptr);
          pg8::EpiQ E{Qb, SSQ, CS}; pg8::gemm_phase<pg8::EpiQ, false>(lds, g, S, E, wave); }
        { pg8::Gemm g{Z + 256, WUKV, 256, INWP, 256, nullptr, 0}; pg8::StaticOrder S; S.init(NTOK / 256, 1024 / 256, G, bx, nullptr);
          pg8::EpiKV E{Kb, Vb, SSQ}; pg8::gemm_phase<pg8::EpiKV, false>(lds, g, S, E, wave); }
    }
    SEAM(PH_TOKLOCAL);
    if (IN(PH_ATTN)) REPLOOP(PH_ATTN) {
        const int vcu = (G % 8 == 0) ? (bx % 8) * (G / 8) + bx / 8 : bx;
        for (int it = vcu; it < NB * NH * 8; it += G) { const int bh = it >> 3, pr = it & 7;
            for (int pass = 0; pass < 2; ++pass) att::attn_block(bh, pass ? pr : 15 - pr, Qb, Kb, Vb, MIX, ASSQ, lds, wave); }
    }
    SEAM(PH_ATTN);
    if (IN(PH_WO)) REPLOOP(PH_WO) {
        pg8::Gemm g{MIX, WO, DM, DM, DM, nullptr, 0}; pg8::StaticOrder S; S.init(NTOK / 256, DM / 256, G, bx, nullptr);
        pg8::EpiWo E{x, H, ASSQ}; pg8::gemm_phase<pg8::EpiWo, false>(lds, g, S, E, wave);
    }
    SEAM(PH_WO);
    if (IN(PH_ROUTER)) REPLOOP(PH_ROUTER) {
        PHASE_LANE;
        typedef float f32x16 __attribute__((ext_vector_type(16)));
        LAS int* hist = (LAS int*)(lds + HIST_OFF);
        for (int i = tid; i < NE * 256; i += NTHREADS) { const int e = i >> 8, kc = i & 255; *(LAS f32x4*)(lds + e * 4096 + ((kc ^ (e & 15)) << 4)) = ((const f32x4*)WR)[i]; }
        if (tid < NE) hist[tid] = 0;
        __syncthreads();
        for (int chunk = bx; chunk < NTOK / 128; chunk += G) {
            const int base = chunk * 128;
            if (wave < 4) {
                const int j = lane & 31, half = lane >> 5, tok = base + wave * 32 + j;
                const f32x4* xr = (const f32x4*)(H + (size_t)tok * DM) + 2 * half; const LAS unsigned char* wrow = lds + j * 4096;
                f32x16 acc = {}; float ss = 0.f;
#pragma unroll 2
                for (int c = 0; c < 64; ++c) { const f32x4 x0 = xr[4 * c], x1 = xr[4 * c + 1];
                    const f32x4 w0 = *(const LAS f32x4*)(wrow + (((4 * c + 2 * half) ^ (j & 15)) << 4)), w1 = *(const LAS f32x4*)(wrow + (((4 * c + 2 * half + 1) ^ (j & 15)) << 4));
                    ss += pg8::sq4(x0) + pg8::sq4(x1);
#pragma unroll
                    for (int q = 0; q < 4; ++q) acc = __builtin_amdgcn_mfma_f32_32x32x2f32(w0[q], x0[q], acc, 0, 0, 0);
#pragma unroll
                    for (int q = 0; q < 4; ++q) acc = __builtin_amdgcn_mfma_f32_32x32x2f32(w1[q], x1[q], acc, 0, 0, 0); }
                ss += __shfl_xor(ss, 32); const float rstd = rsqrtf(ss * (1.f / DM) + EPS);
                float v[16];
#pragma unroll
                for (int r = 0; r < 16; ++r) v[r] = acc[r] * rstd + b_router[(r & 3) + 8 * (r >> 2) + 4 * half];
                float lv[4]; int li[4];
#pragma unroll
                for (int t = 0; t < 4; ++t) { float best = -__builtin_inff(); int bi = 0;
#pragma unroll
                    for (int r = 0; r < 16; ++r) if (v[r] > best) { best = v[r]; bi = (r & 3) + 8 * (r >> 2) + 4 * half; }
                    const auto rv = __builtin_amdgcn_permlane32_swap(__float_as_uint(best), __float_as_uint(best), false, false); const auto ri = __builtin_amdgcn_permlane32_swap((unsigned)bi, (unsigned)bi, false, false);
                    const float b0 = __uint_as_float(rv[0]), b1 = __uint_as_float(rv[1]); const int i0 = (int)ri[0], i1 = (int)ri[1];
                    const bool t0 = (b0 > b1) || (b0 == b1 && i0 < i1); const float gb = t0 ? b0 : b1; const int gi = t0 ? i0 : i1; lv[t] = gb; li[t] = gi;
#pragma unroll
                    for (int r = 0; r < 16; ++r) if ((r & 3) + 8 * (r >> 2) + 4 * half == gi) v[r] = -__builtin_inff(); }
                if (half == 0) { const float e1 = __expf(lv[1] - lv[0]), e2 = __expf(lv[2] - lv[0]), e3 = __expf(lv[3] - lv[0]); const float inv = 1.f / (1.f + e1 + e2 + e3);
                    *(int4*)(TOPI + (size_t)tok * 4) = make_int4(li[0], li[1], li[2], li[3]); *(f32x4*)(TOPG + (size_t)tok * 4) = (f32x4){inv, e1 * inv, e2 * inv, e3 * inv};
#pragma unroll
                    for (int t = 0; t < 4; ++t) (void)__hip_atomic_fetch_add(hist + li[t], 1, __ATOMIC_RELAXED, __HIP_MEMORY_SCOPE_WORKGROUP); }
            } else {
                for (int rr = 0; rr < 32; ++rr) { const int row = base + (wave - 4) * 32 + rr;
                    const f32x4* s4 = (const f32x4*)(H + (size_t)row * DM); f32x4 v[4]; float ss = 0.f;
#pragma unroll
                    for (int j = 0; j < 4; ++j) { v[j] = s4[lane + 64 * j]; ss += pg8::sq4(v[j]); }
                    const float rstd = rsqrtf(wave_sum(ss) * (1.f / DM) + EPS);
                    unsigned* d = (unsigned*)((unsigned char*)XN + (size_t)row * DM);
#pragma unroll
                    for (int j = 0; j < 4; ++j) d[lane + 64 * j] = pg8::pk4_fp8(v[j] * rstd); }
            }
        }
        __syncthreads();
        if (tid < NE && LASTREP(PH_ROUTER)) atomicAdd(ctl + CW_CNT + tid, hist[tid]);
        __syncthreads();
    }
    SEAM(PH_ROUTER);
    if (IN(PH_ROUTE)) {
        PHASE_LANE;
        LAS int* sh = (LAS int*)lds;
        if (tid == 0) { int ps = 0, nt = 0;
            for (int e = 0; e < NE; ++e) { sh[e] = ps; const int t = (ctl[CW_CNT + e] + 255) >> 8; if (bx == 0) for (int q = 0; q < t; ++q) ctl[CW_TILE_E + nt + q] = e; nt += t; ps += t * 256; }
            sh[NE] = ps; if (bx == 0) ctl[CW_NTILES] = nt; }
        __syncthreads();
        for (int chunk = bx; chunk < MROWS / NTHREADS; chunk += G) {
            if (tid < NE) sh[64 + tid] = 0;
            __syncthreads();
            const int idx = chunk * NTHREADS + tid, e = TOPI[idx]; const int r = __hip_atomic_fetch_add(sh + 64 + e, 1, __ATOMIC_RELAXED, __HIP_MEMORY_SCOPE_WORKGROUP);
            __syncthreads();
            if (tid < NE) sh[128 + tid] = atomicAdd(ctl + CW_CURSOR + tid, sh[64 + tid]);
            __syncthreads();
            const int dest = sh[e] + sh[128 + e] + r; ROWTOK[dest] = idx >> 2; ROWSLOT[dest] = idx; ROWGATE[dest] = TOPG[idx];
            __syncthreads();
        }
        for (int e = bx; e < NE; e += G) { const int plo = sh[e] + ctl[CW_CNT + e], phi = sh[e + 1];
            for (int r = plo + tid; r < phi; r += NTHREADS) { ROWTOK[r] = 0; ROWSLOT[r] = MROWS; ROWGATE[r] = 0.f; } }
        __syncthreads();
    }
    SEAM(PH_ROUTE);
    if (IN(PH_MOE1)) REPLOOP(PH_MOE1) {
        pg8::Gemm g{XN, W1T, DM, DM, DM, ROWTOK, (size_t)2048 * DM}; pg8::StaticOrder S; S.init(ctl[CW_NTILES], 2048 / 256, G, bx, ctl + CW_TILE_E);
        pg8::EpiMoe1 E{(unsigned char*)HB, b1}; pg8::gemm_phase<pg8::EpiMoe1, true, true>(lds, g, S, E, wave);
    }
    SEAM(PH_MOE1);
    if (IN(PH_MOE2)) REPLOOP(PH_MOE2) {
        pg8::Gemm g{HB, W2T, DE, DE, DE, nullptr, (size_t)DM * DE}; pg8::StaticOrder S; S.init(ctl[CW_NTILES], DM / 256, G, bx, ctl + CW_TILE_E);
        pg8::EpiMoe2 E{Y, b2, ROWSLOT, ROWGATE}; pg8::gemm_phase<pg8::EpiMoe2, false, true>(lds, g, S, E, wave);
    }
    SEAM(PH_MOE2);
    if (IN(PH_COMBINE)) REPLOOP(PH_COMBINE) {
        PHASE_LANE;
        for (int row = gw; row < NTOK; row += NGW) {
            f32x4* hp = (f32x4*)(H + (size_t)row * DM); f32x4* hq = LASTREP(PH_COMBINE) ? hp : (f32x4*)((float*)(ws + WS_HB) + (size_t)row * DM); f32x4 v[4]; float ss = 0.f;
#pragma unroll
            for (int j = 0; j < 4; ++j) { v[j] = hp[lane + 64 * j];
#pragma unroll
                for (int k = 0; k < 4; ++k) { const u32x2 y = *(const u32x2*)(Y + ((size_t)row * 4 + k) * DM + 4 * (lane + 64 * j)); v[j][0] += blo(y.x); v[j][1] += bhi(y.x); v[j][2] += blo(y.y); v[j][3] += bhi(y.y); }
                hq[lane + 64 * j] = v[j]; ss += pg8::sq4(v[j]); }
            const float rstd = rsqrtf(wave_sum(ss) * (1.f / DM) + EPS);
            u32x2* d = (u32x2*)(XN + (size_t)row * DM);
#pragma unroll
            for (int j = 0; j < 4; ++j) d[lane + 64 * j] = (u32x2){pk2(v[j][0] * rstd, v[j][1] * rstd), pk2(v[j][2] * rstd, v[j][3] * rstd)};
        }
    }
    SEAM(PH_COMBINE);
    if (IN(PH_PLE)) REPLOOP(PH_PLE) {
        pg8::Gemm g{XN, WG, DM, DM, DM, nullptr, 0}; pg8::StaticOrder S; S.init(NTOK / 256, DM / 256, G, bx, nullptr);
        pg8::EpiPle E{H, LASTREP(PH_PLE) ? H : (float*)(ws + WS_HB), PLER, PSSQ, ple_post_norm, FSSQ}; pg8::gemm_phase<pg8::EpiPle, false>(lds, g, S, E, wave);
    }
    SEAM(PH_PLE);
    if (IN(PH_FINAL)) REPLOOP(PH_FINAL) {
        PHASE_LANE;
        for (int row = gw; row < NTOK; row += NGW) {
            f32x4* hp = (f32x4*)(H + (size_t)row * DM); f32x4* hq = LASTREP(PH_FINAL) ? hp : (f32x4*)((float*)(ws + WS_HB) + (size_t)row * DM); const f32x4* gp = (const f32x4*)final_norm;
            float s = lane < 16 ? FSSQ[(size_t)row * 16 + lane] : 0.f; s += __shfl_xor(s, 1); s += __shfl_xor(s, 2); s += __shfl_xor(s, 4); s += __shfl_xor(s, 8);
            const float rstd = rsqrtf(__shfl(s, 0) * (1.f / DM) + EPS);
#pragma unroll
            for (int j = 0; j < 4; ++j) { const f32x4 v = hp[lane + 64 * j], gg = gp[lane + 64 * j]; hq[lane + 64 * j] = v * rstd * gg; }
        }
    }
#undef IN
#undef NREP
#undef REPLOOP
#undef LASTREP
#undef SEAM
}
#ifndef NAIVE_MASK
#define NAIVE_MASK 0u
#endif
static int g_grid = 0;
static void launch_fwd(Args a, int lo, int hi, int li, hipStream_t st) {
    a.ph_lo = lo; a.ph_hi = hi; a.li = li;
    if (hi - lo > 1) { void* p[] = {&a}; hipError_t e = hipLaunchCooperativeKernel((const void*)fwd, dim3(g_grid), dim3(NTHREADS), p, LDS_BYTES, st);
        if (e != hipSuccess) fprintf(stderr, "cooperative launch failed: %s (grid %d)\n", hipGetErrorString(e), g_grid); }
    else hipLaunchKernelGGL(fwd, dim3(g_grid), dim3(NTHREADS), LDS_BYTES, st, a);
}
extern "C" void kernel_launch(void* const* d_in, const int* in_sizes, int n_in, void* d_out, int out_size, void* d_ws, size_t ws_size, hipStream_t stream) {
    if (n_in != 25 || in_sizes[0] != NTOK * DM || out_size != NTOK * DM || ws_size < WS_END) {
        fprintf(stderr, "kernel_launch: unexpected shapes (n_in %d, in0 %d, out %d, ws %zu need %zu)\n", n_in, n_in > 0 ? in_sizes[0] : -1, out_size, ws_size, (size_t)WS_END); return; }
    if (g_grid == 0) {
        int dev = 0, cus = 0, per_cu = 0; (void)hipGetDevice(&dev); (void)hipDeviceGetAttribute(&cus, hipDeviceAttributeMultiprocessorCount, dev);
        if (hipFuncSetAttribute((const void*)fwd, hipFuncAttributeMaxDynamicSharedMemorySize, LDS_BYTES) != hipSuccess) fprintf(stderr, "hipFuncSetAttribute failed\n");
        if (hipOccupancyMaxActiveBlocksPerMultiprocessor(&per_cu, (const void*)fwd, NTHREADS, LDS_BYTES) != hipSuccess || per_cu < 1) { fprintf(stderr, "occupancy query: %d\n", per_cu); per_cu = 1; }
        (void)hipGetLastError();
        g_grid = cus > 0 ? cus : 256;
    }
    const float* x = (const float*)d_in[0];
    const float *conv_w = (const float*)d_in[9], *b_router = (const float*)d_in[15], *final_norm = (const float*)d_in[24];
    unsigned char* ws = (unsigned char*)d_ws; float* H = (float*)d_out;
    int* ctl = (int*)(ws + WS_CTL);
    bf16_t *XN = (bf16_t*)(ws + WS_XN), *MIX = (bf16_t*)(ws + WS_MIX);
    bf16_t *Z = (bf16_t*)(ws + WS_Z), *Q = (bf16_t*)(ws + WS_Q), *K = (bf16_t*)(ws + WS_K), *V = (bf16_t*)(ws + WS_V), *Y = (bf16_t*)(ws + WS_Y);
    float *WR = (float*)(ws + WS_WR), *CS = (float*)(ws + WS_CS), *ASSQ = (float*)(ws + WS_ASSQ);
    int *TOPI = (int*)(ws + WS_TOPI), *ROWTOK = (int*)(ws + WS_ROWTOK), *ROWSLOT = (int*)(ws + WS_ROWSLOT); float *TOPG = (float*)(ws + WS_TOPG), *ROWGATE = (float*)(ws + WS_ROWGATE);
    (void)hipMemsetAsync(ws + WS_CTL, 0, 1 * MiB, stream);
    Args a{}; for (int i = 0; i < 25; ++i) a.in[i] = d_in[i]; a.out = H; a.ws = ws;
#define GRID1(n) dim3((unsigned)(((size_t)(n) + 255) / 256))
    const unsigned NAIVE = NAIVE_MASK;
    a.skip = (NAIVE & 1u) ? 1 : 0;
    int li = 0, lo = 0;
    for (int k = 0; k <= PH_COUNT; ++k) {
        const bool nv = k < PH_COUNT && ((k == PH_ATTN && (NAIVE & 2u)) || (k == PH_ROUTER && (NAIVE & 4u)) || (k == PH_ROUTE && (NAIVE & 8u)) || (k == PH_COMBINE && (NAIVE & 16u)) || (k == PH_FINAL && (NAIVE & 32u)));
        const bool pre = (k == PH_TOKLOCAL && (NAIVE & 1u));
        if (k == PH_COUNT || nv || pre) { if (k > lo) launch_fwd(a, lo, k, li++, stream); lo = nv ? k + 1 : k; }
        if (pre) { k_kpe<<<GRID1(NTOK * 32), 256, 0, stream>>>(Z, CS, K); k_conv<<<NTOK / 4, 256, 0, stream>>>(Z, conv_w, MIX); }
        if (!nv) continue;
        if (k == PH_ATTN) k_attn_naive<<<NB * NH * SEQ / 4, 256, 0, stream>>>(Q, K, V, MIX, ASSQ);
        if (k == PH_ROUTER) k_router<<<NTOK / 4, 256, 0, stream>>>(H, WR, b_router, XN, TOPI, TOPG, ctl + CW_CNT);
        if (k == PH_ROUTE) { k_route_plan<<<1, 64, 0, stream>>>(ctl); k_route_assign<<<GRID1(MROWS), 256, 0, stream>>>(TOPI, TOPG, ctl, ROWTOK, ROWSLOT, ROWGATE); k_route_fill<<<NE, 256, 0, stream>>>(ctl, ROWTOK, ROWSLOT, ROWGATE); }
        if (k == PH_COMBINE) k_combine<<<NTOK / 4, 256, 0, stream>>>(H, Y, XN);
        if (k == PH_FINAL) k_final<<<NTOK / 4, 256, 0, stream>>>(H, final_norm);
    }
#undef GRID1
}
```

```cpp
#include <hip/hip_runtime.h>
#include <cstdint>
#include <cstdio>
#include <cmath>

typedef unsigned short bf16_t;

constexpr int NB = 8, SEQ = 4096, DM = 1024, NTOK = NB * SEQ;
constexpr int PLE = 256, NH = 4, DN = 128, DR = 64, DV = 128, QL = 256, KVL = 128, DQK = DN + DR;
constexpr int INW = 1984, INWP = 2048;
constexpr int NE = 32, TOPK = 4, DE = 1024;
constexpr int MROWS = NTOK * TOPK;
constexpr int MAXTILES = MROWS / 256 + NE;
constexpr int PROWS = MAXTILES * 256;
constexpr float EPS = 1e-6f;
constexpr float QSCALE = 0.07216878364870322f * 1.4426950408889634f;

constexpr size_t MiB = 1u << 20;
constexpr size_t WS_CTL = 0;
constexpr size_t WS_WIN = 1 * MiB, WS_WUQ = 5 * MiB, WS_WUKV = 5 * MiB + 512 * 1024, WS_WO = 6 * MiB, WS_WG = 8 * MiB, WS_WP = 10 * MiB;
constexpr size_t WS_WR = 10 * MiB + 512 * 1024;
constexpr size_t WS_CS = 11 * MiB;
constexpr size_t WS_SSQ = 19 * MiB, WS_ASSQ = 20 * MiB, WS_PSSQ = 21 * MiB, WS_FSSQ = 23 * MiB;
constexpr size_t WS_TOPI = 25 * MiB, WS_TOPG = 25 * MiB + 512 * 1024;
constexpr size_t WS_ROWTOK = 26 * MiB, WS_ROWSLOT = 27 * MiB, WS_ROWGATE = 28 * MiB;
constexpr size_t WS_P16 = 29 * MiB;
constexpr size_t WS_SSQ1 = 45 * MiB, WS_RS1 = 47 * MiB, WS_RS2 = 47 * MiB + 128 * 1024, WS_ROWRS = 47 * MiB + 256 * 1024;
constexpr size_t WS_WRHL = 10 * MiB + 768 * 1024;
constexpr size_t WS_HBF = 112 * MiB;
constexpr size_t WS_H3 = 304 * MiB;
constexpr size_t WS_W1 = 48 * MiB, WS_W2 = 176 * MiB, WS_XN = 240 * MiB, WS_MIX = 304 * MiB, WS_PLER = 368 * MiB;
constexpr size_t WS_Z = 432 * MiB, WS_Q = 560 * MiB, WS_K = 608 * MiB, WS_V = 656 * MiB;
constexpr size_t WS_HB = 432 * MiB;
constexpr size_t WS_Y = 704 * MiB;
constexpr size_t WS_END = WS_Y + (size_t)(MROWS + 256) * DM * 2;
constexpr int CW_CNT = 0, CW_CURSOR = 64, CW_PADSTART = 128, CW_NTILES = 192, CW_TILE_E = 256;

__device__ __forceinline__ float bf2f(bf16_t v) { return __uint_as_float((unsigned)v << 16); }
__device__ __forceinline__ float blo(unsigned u) { return __uint_as_float(u << 16); }
__device__ __forceinline__ float bhi(unsigned u) { return __uint_as_float(u & 0xffff0000u); }
__device__ __forceinline__ bf16_t f2bf(float f) { unsigned u = __float_as_uint(f); return (bf16_t)((u + 0x7fffu + ((u >> 16) & 1u)) >> 16); }
__device__ __forceinline__ unsigned pk2(float lo, float hi) { return (unsigned)f2bf(lo) | ((unsigned)f2bf(hi) << 16); }
__device__ __forceinline__ float wave_sum(float v) {
#pragma unroll
    for (int o = 1; o < 64; o <<= 1) v += __shfl_xor(v, o);
    return v;
}
__device__ __forceinline__ float wave_max(float v) {
#pragma unroll
    for (int o = 1; o < 64; o <<= 1) v = fmaxf(v, __shfl_xor(v, o));
    return v;
}
__device__ __forceinline__ float dot8(uint4 x, uint4 y) {
    return blo(x.x) * blo(y.x) + bhi(x.x) * bhi(y.x) + blo(x.y) * blo(y.y) + bhi(x.y) * bhi(y.y) +
           blo(x.z) * blo(y.z) + bhi(x.z) * bhi(y.z) + blo(x.w) * blo(y.w) + bhi(x.w) * bhi(y.w);
}
__device__ __forceinline__ float dot_bf16(const bf16_t* a, const bf16_t* b, int K) {
    const uint4* a4 = (const uint4*)a; const uint4* b4 = (const uint4*)b; float acc = 0.f;
    for (int i = 0; i < K / 8; ++i) acc += dot8(a4[i], b4[i]);
    return acc;
}

template <int MODE>
__global__ void k_prep_wt(const float* __restrict__ src, bf16_t* __restrict__ dst, int K, int Nrows, int ldsrc, int nvalid,
                          const float* __restrict__ gain, const float* __restrict__ gain2, float scale) {
    const size_t idx = (size_t)blockIdx.x * 256 + threadIdx.x; if (idx >= (size_t)Nrows * K) return;
    const int n = (int)(idx / K), k = (int)(idx % K);
    src += (size_t)blockIdx.y * K * ldsrc; dst += (size_t)blockIdx.y * Nrows * K;
    int c = n;
    if (MODE == 1) { const int pn = n >> 8, half = (n >> 7) & 1, jj = n & 127; c = half * 1024 + pn * 128 + jj; }
    float v = 0.f;
    if (c < nvalid) { float g = 1.f; if (gain) g = (gain2 && k >= 512) ? gain2[k - 512] : gain[k]; v = src[(size_t)k * ldsrc + c] * g * scale; }
    dst[idx] = f2bf(v);
}
__global__ void k_prep_wr(const float* __restrict__ wr, const float* __restrict__ g, float* __restrict__ dst) {
    const int idx = blockIdx.x * 256 + threadIdx.x; if (idx >= DM * NE) return; dst[idx] = wr[idx] * g[idx / NE];
}
__global__ void k_prep_cs(const int* __restrict__ pos, float* __restrict__ cs) {
    const int idx = blockIdx.x * 256 + threadIdx.x; if (idx >= NTOK * 32) return; const int t = idx >> 5, i = idx & 31;
    const float inv = powf(10000.f, -(float)i / 32.f); const float a = (float)pos[t] * inv; float s, c; sincosf(a, &s, &c);
    cs[(size_t)t * 64 + i] = c; cs[(size_t)t * 64 + 32 + i] = s;
}
__global__ void k_cvt_bf16(const float* __restrict__ src, bf16_t* __restrict__ dst, size_t n) {
    const size_t idx = (size_t)blockIdx.x * 256 + threadIdx.x; if (idx < n) dst[idx] = f2bf(src[idx]);
}
__global__ void k_rmsnorm_bf16(const float* __restrict__ src, bf16_t* __restrict__ dst) {
    const int row = blockIdx.x * 4 + (threadIdx.x >> 6), lane = threadIdx.x & 63;
    const float4* s = (const float4*)(src + (size_t)row * DM); float4 v[4]; float ss = 0.f;
#pragma unroll
    for (int j = 0; j < 4; ++j) { v[j] = s[lane + 64 * j]; ss += v[j].x * v[j].x + v[j].y * v[j].y + v[j].z * v[j].z + v[j].w * v[j].w; }
    const float rstd = rsqrtf(wave_sum(ss) * (1.f / DM) + EPS);
    uint2* d = (uint2*)(dst + (size_t)row * DM);
#pragma unroll
    for (int j = 0; j < 4; ++j) d[lane + 64 * j] = make_uint2(pk2(v[j].x * rstd, v[j].y * rstd), pk2(v[j].z * rstd, v[j].w * rstd));
}

__global__ void k_inproj(const bf16_t* __restrict__ XN, const bf16_t* __restrict__ WT, bf16_t* __restrict__ Z) {
    const size_t idx = (size_t)blockIdx.x * 256 + threadIdx.x; const int row = (int)(idx / INWP), col = (int)(idx % INWP);
    Z[idx] = f2bf(dot_bf16(XN + (size_t)row * DM, WT + (size_t)col * DM, DM));
}
__global__ void k_zstats(const bf16_t* __restrict__ Z, float* __restrict__ SSQ) {
    const int row = blockIdx.x * 4 + (threadIdx.x >> 6), lane = threadIdx.x & 63; const bf16_t* z = Z + (size_t)row * INWP;
    float q = 0.f, kv = 0.f;
    for (int c = lane; c < 256; c += 64) { const float v = bf2f(z[c]); q += v * v; }
    for (int c = 256 + lane; c < 384; c += 64) { const float v = bf2f(z[c]); kv += v * v; }
    q = wave_sum(q); kv = wave_sum(kv);
    if (lane < 8) SSQ[(size_t)row * 8 + lane] = lane == 0 ? q : (lane == 4 ? kv : 0.f);
}
__global__ void k_pleraw(const bf16_t* __restrict__ P16, const bf16_t* __restrict__ WT, bf16_t* __restrict__ PLER) {
    const size_t idx = (size_t)blockIdx.x * 256 + threadIdx.x; const int row = (int)(idx / DM), col = (int)(idx % DM);
    PLER[idx] = f2bf(dot_bf16(P16 + (size_t)row * PLE, WT + (size_t)col * PLE, PLE));
}
__global__ void k_rowssq16(const bf16_t* __restrict__ X, float* __restrict__ out) {
    const int row = blockIdx.x * 4 + (threadIdx.x >> 6), lane = threadIdx.x & 63; float s = 0.f;
    for (int c = lane; c < DM; c += 64) { const float v = bf2f(X[(size_t)row * DM + c]); s += v * v; }
    s = wave_sum(s); if (lane < 16) out[(size_t)row * 16 + lane] = lane == 0 ? s : 0.f;
}
__device__ __forceinline__ float rstd4(const float* p, float n) { return rsqrtf((p[0] + p[1] + p[2] + p[3]) / n + EPS); }
__global__ void k_qup(const bf16_t* __restrict__ Z, const bf16_t* __restrict__ WT, const float* __restrict__ SSQ, const float* __restrict__ CS, bf16_t* __restrict__ Q) {
    const size_t idx = (size_t)blockIdx.x * 256 + threadIdx.x; const int row = (int)(idx / (NH * 160)), r = (int)(idx % (NH * 160)), h = r / 160, j = r % 160;
    const float rs = rstd4(SSQ + (size_t)row * 8, (float)QL); const bf16_t* a = Z + (size_t)row * INWP;
    const int b = row / SEQ, s = row % SEQ; bf16_t* q = Q + ((size_t)(b * NH + h) * SEQ + s) * DQK;
    if (j < 128) { q[j] = f2bf(rs * dot_bf16(a, WT + (size_t)(h * DQK + j) * QL, QL)); }
    else { const int i = j - 128; const float x1 = rs * dot_bf16(a, WT + (size_t)(h * DQK + 128 + 2 * i) * QL, QL), x2 = rs * dot_bf16(a, WT + (size_t)(h * DQK + 129 + 2 * i) * QL, QL);
        const float c = CS[(size_t)row * 64 + i], sn = CS[(size_t)row * 64 + 32 + i];
        q[128 + 2 * i] = f2bf(x1 * c - x2 * sn); q[129 + 2 * i] = f2bf(x1 * sn + x2 * c); }
}
__global__ void k_kvup(const bf16_t* __restrict__ Z, const bf16_t* __restrict__ WT, const float* __restrict__ SSQ, bf16_t* __restrict__ K, bf16_t* __restrict__ V) {
    const size_t idx = (size_t)blockIdx.x * 256 + threadIdx.x; const int row = (int)(idx / 1024), col = (int)(idx % 1024), h = col >> 8, d = col & 255;
    const float rs = rstd4(SSQ + (size_t)row * 8 + 4, (float)KVL);
    const float v = rs * dot_bf16(Z + (size_t)row * INWP + 256, WT + (size_t)col * 256, KVL);
    const int b = row / SEQ, s = row % SEQ; const size_t t = (size_t)(b * NH + h) * SEQ + s;
    if (d < 128) K[t * DQK + d] = f2bf(v); else V[t * DV + d - 128] = f2bf(v);
}
__global__ void k_kpe(const bf16_t* __restrict__ Z, const float* __restrict__ CS, bf16_t* __restrict__ K) {
    const int idx = blockIdx.x * 256 + threadIdx.x; const int row = idx >> 5, i = idx & 31;
    const float x1 = bf2f(Z[(size_t)row * INWP + 384 + i]), x2 = bf2f(Z[(size_t)row * INWP + 416 + i]);
    const float c = CS[(size_t)row * 64 + i], sn = CS[(size_t)row * 64 + 32 + i];
    const bf16_t o1 = f2bf(x1 * c - x2 * sn), o2 = f2bf(x1 * sn + x2 * c); const int b = row / SEQ, s = row % SEQ;
    for (int h = 0; h < NH; ++h) { bf16_t* k = K + ((size_t)(b * NH + h) * SEQ + s) * DQK; k[128 + 2 * i] = o1; k[129 + 2 * i] = o2; }
}
__global__ void k_conv(const bf16_t* __restrict__ Z, const float* __restrict__ cw, bf16_t* __restrict__ MIX) {
    const int row = blockIdx.x * 4 + (threadIdx.x >> 6), lane = threadIdx.x & 63, s = row % SEQ; const bf16_t* z = Z + (size_t)row * INWP;
    float y[8]; float ss = 0.f;
#pragma unroll
    for (int j = 0; j < 8; ++j) { const int c = lane + 64 * j;
        const float u0 = bf2f(z[960 + c]) * bf2f(z[1472 + c]);
        const float u1 = s >= 1 ? bf2f(z[960 + c - INWP]) * bf2f(z[1472 + c - INWP]) : 0.f;
        const float u2 = s >= 2 ? bf2f(z[960 + c - 2 * INWP]) * bf2f(z[1472 + c - 2 * INWP]) : 0.f;
        const float v = bf2f(z[448 + c]) * (cw[c] * u2 + cw[512 + c] * u1 + cw[1024 + c] * u0);
        y[j] = v; ss += v * v; }
    const float rstd = rsqrtf(wave_sum(ss) * (1.f / 512.f) + EPS);
#pragma unroll
    for (int j = 0; j < 8; ++j) MIX[(size_t)row * DM + 512 + lane + 64 * j] = f2bf(y[j] * rstd);
}
__global__ void k_attn_naive(const bf16_t* __restrict__ Q, const bf16_t* __restrict__ K, const bf16_t* __restrict__ V, bf16_t* __restrict__ MIX, float* __restrict__ ASSQ) {
    __shared__ float qs[4][DQK];
    const int wid = threadIdx.x >> 6, lane = threadIdx.x & 63; const int gw = blockIdx.x * 4 + wid; const int i = gw % SEQ, bh = gw / SEQ;
    const bf16_t* q = Q + (size_t)gw * DQK;
    for (int d = lane; d < DQK; d += 64) qs[wid][d] = bf2f(q[d]);
    __syncthreads();
    const bf16_t* Kb = K + (size_t)bh * SEQ * DQK; const bf16_t* Vb = V + (size_t)bh * SEQ * DV;
    float m = -1e30f, l = 0.f, o0 = 0.f, o1 = 0.f;
    for (int j0 = 0; j0 <= i; j0 += 64) {
        const int j = j0 + lane; const bool valid = j <= i; float sc = -INFINITY;
        if (valid) { const uint4* kr = (const uint4*)(Kb + (size_t)j * DQK); float acc = 0.f;
            for (int c = 0; c < 24; ++c) { const uint4 kv = kr[c]; const float* qq = &qs[wid][c * 8];
                acc += blo(kv.x) * qq[0] + bhi(kv.x) * qq[1] + blo(kv.y) * qq[2] + bhi(kv.y) * qq[3] + blo(kv.z) * qq[4] + bhi(kv.z) * qq[5] + blo(kv.w) * qq[6] + bhi(kv.w) * qq[7]; }
            sc = acc; }
        const float mnew = fmaxf(m, wave_max(sc)); const float alpha = exp2f(m - mnew); const float p = valid ? exp2f(sc - mnew) : 0.f;
        l = l * alpha + wave_sum(p); o0 *= alpha; o1 *= alpha; m = mnew;
        const int nj = (i - j0 + 1) < 64 ? (i - j0 + 1) : 64;
        for (int jj = 0; jj < nj; ++jj) { const float pj = __shfl(p, jj); const unsigned vv = *(const unsigned*)(Vb + (size_t)(j0 + jj) * DV + 2 * lane); o0 += pj * blo(vv); o1 += pj * bhi(vv); }
    }
    const float inv = 1.f / l; o0 *= inv; o1 *= inv;
    const int b = bh / NH, h = bh % NH; const size_t row = (size_t)b * SEQ + i;
    *(unsigned*)(MIX + row * DM + h * DV + 2 * lane) = pk2(o0, o1);
    const float ss = wave_sum(o0 * o0 + o1 * o1); if (lane == 0) ASSQ[row * 4 + h] = ss;
}
__global__ void k_wo(const bf16_t* __restrict__ MIX, const bf16_t* __restrict__ WT, const float* __restrict__ ASSQ, const float* __restrict__ x, float* __restrict__ H) {
    const size_t idx = (size_t)blockIdx.x * 256 + threadIdx.x; const int row = (int)(idx / DM), col = (int)(idx % DM);
    const float ra = rstd4(ASSQ + (size_t)row * 4, 512.f);
    const float a = dot_bf16(MIX + (size_t)row * DM, WT + (size_t)col * DM, 512) * ra + dot_bf16(MIX + (size_t)row * DM + 512, WT + (size_t)col * DM + 512, 512);
    H[idx] = x[idx] + a;
}
__global__ void k_router(const float* __restrict__ H, const float* __restrict__ WR, const float* __restrict__ br, bf16_t* __restrict__ XN, int* __restrict__ TOPI, float* __restrict__ TOPG, int* __restrict__ CNT) {
    __shared__ float lg[4][NE];
    const int wid = threadIdx.x >> 6, lane = threadIdx.x & 63, row = blockIdx.x * 4 + wid; const float* h = H + (size_t)row * DM;
    const float4* s = (const float4*)h; float4 v[4]; float ss = 0.f;
#pragma unroll
    for (int j = 0; j < 4; ++j) { v[j] = s[lane + 64 * j]; ss += v[j].x * v[j].x + v[j].y * v[j].y + v[j].z * v[j].z + v[j].w * v[j].w; }
    const float rstd = rsqrtf(wave_sum(ss) * (1.f / DM) + EPS);
    uint2* d = (uint2*)(XN + (size_t)row * DM);
#pragma unroll
    for (int j = 0; j < 4; ++j) d[lane + 64 * j] = make_uint2(pk2(v[j].x * rstd, v[j].y * rstd), pk2(v[j].z * rstd, v[j].w * rstd));
    const int e = lane & 31, half = lane >> 5; float acc = 0.f;
    for (int k = half * 512; k < half * 512 + 512; ++k) acc += h[k] * WR[e * DM + k];
    acc += __shfl_xor(acc, 32); acc = acc * rstd + br[e];
    if (lane < 32) lg[wid][lane] = acc;
    __syncthreads();
    if (lane == 0) { float lv[4]; int li[4]; unsigned used = 0u;
        for (int t = 0; t < 4; ++t) { float best = -INFINITY; int bi = 0; for (int q = 0; q < NE; ++q) { const float x = lg[wid][q]; if (!((used >> q) & 1u) && x > best) { best = x; bi = q; } } used |= 1u << bi; lv[t] = best; li[t] = bi; }
        float den = 0.f, ex[4]; for (int t = 0; t < 4; ++t) { ex[t] = expf(lv[t] - lv[0]); den += ex[t]; }
        for (int t = 0; t < 4; ++t) { TOPI[row * 4 + t] = li[t]; TOPG[row * 4 + t] = ex[t] / den; atomicAdd(&CNT[li[t]], 1); } }
}
__global__ void k_route_plan(int* __restrict__ ctl) {
    if (threadIdx.x != 0 || blockIdx.x != 0) return; int ps = 0, nt = 0;
    for (int e = 0; e < NE; ++e) { ctl[CW_PADSTART + e] = ps; const int t = (ctl[CW_CNT + e] + 255) / 256; for (int q = 0; q < t; ++q) ctl[CW_TILE_E + nt + q] = e; nt += t; ps += t * 256; }
    ctl[CW_PADSTART + NE] = ps; ctl[CW_NTILES] = nt;
}
__global__ void k_route_assign(const int* __restrict__ TOPI, const float* __restrict__ TOPG, int* __restrict__ ctl, int* __restrict__ ROWTOK, int* __restrict__ ROWSLOT, float* __restrict__ ROWGATE) {
    const int idx = blockIdx.x * 256 + threadIdx.x; if (idx >= MROWS) return; const int e = TOPI[idx];
    const int dest = ctl[CW_PADSTART + e] + atomicAdd(&ctl[CW_CURSOR + e], 1);
    ROWTOK[dest] = idx >> 2; ROWSLOT[dest] = idx; ROWGATE[dest] = TOPG[idx];
}
__global__ void k_route_fill(const int* __restrict__ ctl, int* __restrict__ ROWTOK, int* __restrict__ ROWSLOT, float* __restrict__ ROWGATE) {
    const int e = blockIdx.x; const int lo = ctl[CW_PADSTART + e] + ctl[CW_CNT + e], hi = ctl[CW_PADSTART + e + 1];
    for (int r = lo + threadIdx.x; r < hi; r += 256) { ROWTOK[r] = 0; ROWSLOT[r] = MROWS; ROWGATE[r] = 0.f; }
}
__device__ __forceinline__ float swiglu(float g, float u) { g = fminf(g, 7.f); u = fminf(fmaxf(u, -7.f), 7.f); return g / (1.f + expf(-1.702f * g)) * (u + 1.f); }
__global__ void k_moe1(const bf16_t* __restrict__ XN, const bf16_t* __restrict__ W1T, const float* __restrict__ b1, const int* __restrict__ ctl, const int* __restrict__ ROWTOK, bf16_t* __restrict__ HB) {
    const size_t idx = (size_t)blockIdx.x * 256 + threadIdx.x; const int r = (int)(idx / DE), j = (int)(idx % DE);
    if (r >= ctl[CW_NTILES] * 256) return; const int e = ctl[CW_TILE_E + (r >> 8)];
    const bf16_t* a = XN + (size_t)ROWTOK[r] * DM; const bf16_t* w = W1T + (size_t)e * 2048 * DM; const int rg = (j >> 7) * 256 + (j & 127);
    const float g = dot_bf16(a, w + (size_t)rg * DM, DM) + b1[e * 2048 + j], u = dot_bf16(a, w + (size_t)(rg + 128) * DM, DM) + b1[e * 2048 + 1024 + j];
    HB[idx] = f2bf(swiglu(g, u));
}
__global__ void k_moe2(const bf16_t* __restrict__ HB, const bf16_t* __restrict__ W2T, const float* __restrict__ b2, const int* __restrict__ ctl, const int* __restrict__ ROWSLOT, const float* __restrict__ ROWGATE, bf16_t* __restrict__ Y) {
    const size_t idx = (size_t)blockIdx.x * 256 + threadIdx.x; const int r = (int)(idx / DM), c = (int)(idx % DM);
    if (r >= ctl[CW_NTILES] * 256) return; const int e = ctl[CW_TILE_E + (r >> 8)];
    const float v = (dot_bf16(HB + (size_t)r * DE, W2T + ((size_t)e * DM + c) * DE, DE) + b2[e * DM + c]) * ROWGATE[r];
    Y[(size_t)ROWSLOT[r] * DM + c] = f2bf(v);
}
__global__ void k_combine(float* __restrict__ H, const bf16_t* __restrict__ Y, bf16_t* __restrict__ XN) {
    const int row = blockIdx.x * 4 + (threadIdx.x >> 6), lane = threadIdx.x & 63; float4* hp = (float4*)(H + (size_t)row * DM); float4 v[4]; float ss = 0.f;
#pragma unroll
    for (int j = 0; j < 4; ++j) { v[j] = hp[lane + 64 * j];
        for (int k = 0; k < 4; ++k) { const uint2 y = *(const uint2*)(Y + ((size_t)row * 4 + k) * DM + 4 * (lane + 64 * j)); v[j].x += blo(y.x); v[j].y += bhi(y.x); v[j].z += blo(y.y); v[j].w += bhi(y.y); }
        hp[lane + 64 * j] = v[j]; ss += v[j].x * v[j].x + v[j].y * v[j].y + v[j].z * v[j].z + v[j].w * v[j].w; }
    const float rstd = rsqrtf(wave_sum(ss) * (1.f / DM) + EPS);
    uint2* d = (uint2*)(XN + (size_t)row * DM);
#pragma unroll
    for (int j = 0; j < 4; ++j) d[lane + 64 * j] = make_uint2(pk2(v[j].x * rstd, v[j].y * rstd), pk2(v[j].z * rstd, v[j].w * rstd));
}
__global__ void k_plegate(const bf16_t* __restrict__ XN, const bf16_t* __restrict__ WGT, const bf16_t* __restrict__ PLER, const float* __restrict__ PSSQ, const float* __restrict__ pg, float* __restrict__ H) {
    const size_t idx = (size_t)blockIdx.x * 256 + threadIdx.x; const int row = (int)(idx / DM), col = (int)(idx % DM);
    const float a = dot_bf16(XN + (size_t)row * DM, WGT + (size_t)col * DM, DM); const float g = 1.f / (1.f + expf(-a));
    float s = 0.f; for (int t = 0; t < 16; ++t) s += PSSQ[(size_t)row * 16 + t]; const float rp = rsqrtf(s * (1.f / DM) + EPS);
    H[idx] = H[idx] + g * bf2f(PLER[idx]) * rp * pg[col];
}
__global__ void k_final(float* __restrict__ H, const float* __restrict__ g) {
    const int row = blockIdx.x * 4 + (threadIdx.x >> 6), lane = threadIdx.x & 63; float4* hp = (float4*)(H + (size_t)row * DM); const float4* gp = (const float4*)g; float4 v[4]; float ss = 0.f;
#pragma unroll
    for (int j = 0; j < 4; ++j) { v[j] = hp[lane + 64 * j]; ss += v[j].x * v[j].x + v[j].y * v[j].y + v[j].z * v[j].z + v[j].w * v[j].w; }
    const float rstd = rsqrtf(wave_sum(ss) * (1.f / DM) + EPS);
#pragma unroll
    for (int j = 0; j < 4; ++j) { const float4 gg = gp[lane + 64 * j]; hp[lane + 64 * j] = make_float4(v[j].x * rstd * gg.x, v[j].y * rstd * gg.y, v[j].z * rstd * gg.z, v[j].w * rstd * gg.w); }
}

#define LAS __attribute__((address_space(3)))
#define GAS __attribute__((address_space(1)))
typedef short bf16x8 __attribute__((ext_vector_type(8)));
typedef float f32x4 __attribute__((ext_vector_type(4)));
typedef float f32x2 __attribute__((ext_vector_type(2)));
typedef unsigned u32x4 __attribute__((ext_vector_type(4)));
typedef unsigned u32x2 __attribute__((ext_vector_type(2)));
#ifndef PROBE_PH
#define PROBE_PH (-1)
#define PROBE_REP 1
#endif
constexpr int NWAVES = 8, NTHREADS = 512;
constexpr int RING_BYTES = 131072, MISC_OFF = RING_BYTES, HIST_OFF = MISC_OFF + 256, LDS_BYTES = 163840;
constexpr int CW_BAR = 4096;
__device__ __forceinline__ unsigned cvt_pk_bf16(float lo, float hi) { unsigned r; asm volatile("v_cvt_pk_bf16_f32 %0, %1, %2" : "=v"(r) : "v"(lo), "v"(hi)); return r; }
__device__ __forceinline__ int lane_id() { int l = (int)__builtin_amdgcn_mbcnt_hi(~0u, __builtin_amdgcn_mbcnt_lo(~0u, 0u)); asm volatile("" : "+v"(l)); return l; }
__device__ __forceinline__ float fast_sigmoid(float a) { return __builtin_amdgcn_rcpf(1.f + __expf(-a)); }

#define XB_TMO      128
#define XB_XCNT(j)  (256  + 64 * (j))
#define XB_XSUB(j)  (1280 + 64 * (j))
#define XB_XGEN(j)  (2304 + 64 * (j))
#define XB_TOP      3328
#define XB_TOPGEN   3392
#define XCD_BAR_WORDS 3456
#define XB_SPIN_CAP (1u << 20)
__device__ __forceinline__ unsigned xb_ld(unsigned* p)              { return __hip_atomic_load(p, __ATOMIC_RELAXED, __HIP_MEMORY_SCOPE_AGENT); }
__device__ __forceinline__ unsigned xb_add(unsigned* p, unsigned v) { return __hip_atomic_fetch_add(p, v, __ATOMIC_RELAXED, __HIP_MEMORY_SCOPE_AGENT); }
__device__ __forceinline__ unsigned xb_xcc_id() { return (unsigned)__builtin_amdgcn_s_getreg((3 << 11) | 20) & 0xFu; }
#define XB_SPIN(cond, bar) do { unsigned _sp = 0; while (cond) { __builtin_amdgcn_s_sleep(1); \
    if ((++_sp & 255u) == 0u) { if (xb_ld(&(bar)[XB_TMO])) break; if (_sp > XB_SPIN_CAP) { atomicAdd(&(bar)[XB_TMO], 1u); break; } } } } while (0)
struct XcdBarrier { unsigned* bar; unsigned x; volatile LAS unsigned* st; };
__device__ __forceinline__ XcdBarrier xcd_barrier_post(unsigned* bar, volatile LAS unsigned* st, int wave) {
    XcdBarrier b; b.bar = bar; b.x = xb_xcc_id(); b.st = st;
    if (wave == 0 && lane_id() == 0) (void)xb_add(&bar[XB_XCNT(b.x)], 1u);
    return b;
}
__device__ __forceinline__ void xcd_barrier_complete(unsigned* bar, unsigned x, unsigned& nloc, unsigned& nx) {
    const unsigned G = gridDim.x * gridDim.y * gridDim.z;
    unsigned sum, cnt, mine, sp = 0u;
    for (;;) {
        sum = 0u; cnt = 0u; mine = 0u;
#pragma unroll
        for (unsigned j = 0; j < 16; ++j) { const unsigned c = xb_ld(&bar[XB_XCNT(j)]); sum += c; cnt += (c > 0u) ? 1u : 0u; mine = (j == x) ? c : mine; }
        if (sum == G) break;
        __builtin_amdgcn_s_sleep(1);
        if ((++sp & 255u) == 0u) { if (xb_ld(&bar[XB_TMO])) break; if (sp > XB_SPIN_CAP) { atomicAdd(&bar[XB_TMO], 1u); break; } }
    }
    nloc = mine > 0u ? mine : 1u; nx = cnt > 0u ? cnt : 1u;
}
__device__ __forceinline__ void xcd_barrier(const XcdBarrier& b, int wave) {
    asm volatile("s_waitcnt vmcnt(0)" ::: "memory");
    __syncthreads();
    if (wave == 0 && lane_id() == 0) {
        unsigned* bar = b.bar;
        __builtin_amdgcn_s_waitcnt(0);
        unsigned nloc = b.st[0], nx = b.st[1];
        if (nloc == 0u) { xcd_barrier_complete(bar, b.x, nloc, nx); b.st[0] = nloc; b.st[1] = nx; }
        const unsigned old = xb_add(&bar[XB_XSUB(b.x)], 1u);
        const unsigned gen = old / nloc;
        if (old + 1u == (gen + 1u) * nloc) {
            __builtin_amdgcn_fence(__ATOMIC_RELEASE, "agent");
            asm volatile("s_waitcnt vmcnt(0)" ::: "memory");
            const unsigned og = xb_add(&bar[XB_TOP], 1u);
            const unsigned tg = og / nx;
            if (og + 1u == (tg + 1u) * nx) xb_add(&bar[XB_TOPGEN], 1u);
            else XB_SPIN(xb_ld(&bar[XB_TOPGEN]) == tg, bar);
            __builtin_amdgcn_fence(__ATOMIC_ACQUIRE, "agent");
            xb_add(&bar[XB_XGEN(b.x)], 1u);
            asm volatile("s_waitcnt vmcnt(0)" ::: "memory");
        } else {
            XB_SPIN(xb_ld(&bar[XB_XGEN(b.x)]) == gen, bar);
            __builtin_amdgcn_fence(__ATOMIC_ACQUIRE, "agent");
            asm volatile("s_waitcnt vmcnt(0)" ::: "memory");
        }
    }
    __syncthreads();
}

namespace pg8 {
constexpr int BM = 256, BK = 64, HALF = 128, HTB = HALF * BK * 2, STAGE_BYTES = 8 * HTB, NXCD = 8, WGM = 8;
__host__ __device__ __forceinline__ int lds_byte(int r, int c) { const int st = (r >> 4) * 2 + (c >> 5), rr = r & 15, cc = c & 31, ob = rr * 64 + cc * 2; return st * 1024 + (ob ^ (((ob >> 9) & 1) << 5)); }
__host__ __device__ __forceinline__ void stage_rc(int b, int& R, int& C) { const int st = b / 1024, sb = b % 1024, swz = sb ^ (((sb >> 9) & 1) << 5); R = (st >> 1) * 16 + swz / 64; C = (st & 1) * 32 + (swz % 64) / 2; }
__host__ __device__ __forceinline__ int perm32(int rho) { const int n = rho >> 4, i = rho & 15; return 8 * (i >> 2) + 4 * n + (i & 3); }
struct Unit { int pm, pn, e; };
struct Gemm { const void* A; const void* Bt; int K, lda, ldb; const int* rowidx; size_t bstride; };
struct StaticOrder {
    int nM, nN, nwg, G, c; const int* tile_e;
    __device__ void init(int nM_, int nN_, int G_, int c_, const int* te) { nM = nM_; nN = nN_; nwg = nM * nN; G = G_; c = c_; tile_e = te; }
    __device__ bool next(int i, Unit& u) const {
        const long L = (long)i * G + c; if (L >= nwg) return false;
        int wgid = (int)L; { const int q = nwg / NXCD, r = nwg % NXCD, xcd = wgid % NXCD, off = wgid / NXCD; wgid = (xcd < r ? xcd * (q + 1) : r * (q + 1) + (xcd - r) * q) + off; }
        const int nig = WGM * nN, gid = wgid / nig, fm = gid * WGM, gsz = (nM - fm) < WGM ? (nM - fm) : WGM;
        u.pm = fm + ((wgid % nig) % gsz); u.pn = (wgid % nig) / gsz; u.e = tile_e ? tile_e[u.pm] : 0; return true;
    }
};
typedef f32x4 Acc[2][2][4][2];
typedef int v8i_t __attribute__((ext_vector_type(8)));
typedef int v4i_t __attribute__((ext_vector_type(4)));
template <class Epi, bool GATHER, bool FP8 = false>
__device__ __forceinline__ void gemm_phase(LAS unsigned char* lds, const Gemm g, const StaticOrder& S, const Epi& E, const int wid, const bool do_epi = true) {
    const int lane = lane_id(), tid = wid * 64 + lane, wr = wid >> 2, wc = wid & 3, fr = lane & 15, fq = lane >> 4;
    constexpr int ES = FP8 ? 1 : 2;
    const int K = g.K, nt = K * ES / 128;
    int RA[2], CA[2]; unsigned voffB[2], voffA[2];
#pragma unroll
    for (int i = 0; i < 2; ++i) { int R, C; stage_rc(tid * 16 + i * 8192, R, C); const int Rb = Epi::PERM ? ((R & ~31) + perm32(R & 31)) : R;
        RA[i] = R; CA[i] = C; voffB[i] = (unsigned)(Rb * g.ldb * ES + C * 2); voffA[i] = (unsigned)(R * g.lda * ES + C * 2); }
    const size_t hstepA = GATHER ? 0 : (size_t)HALF * g.lda * ES;
    const size_t kstep = (size_t)(BK * 2);
    const size_t hstepB = (size_t)HALF * g.ldb * ES;
    const unsigned ldsw = (unsigned)wid * 1024u;
    const int aoff = lds_byte(wr * 64 + fr, fq * 8), boff = lds_byte(wc * 32 + fr, fq * 8);
#define PG8_SA(b, h) (((b) * 2 + (h)) * HTB)
#define PG8_SB(b, h) ((4 + (b) * 2 + (h)) * HTB)
#define PG8_STAGE(bufoff, gbase, voff) do { _Pragma("unroll") for (int _i = 0; _i < 2; ++_i) \
        __builtin_amdgcn_global_load_lds((const unsigned*)((const char*)(gbase) + (voff)[_i]), (LAS unsigned*)(lds + (bufoff) + ldsw + _i * 8192), 16, 0, 0); } while (0)
#define PG8_LDA(dst, b, h) do { _Pragma("unroll") for (int m = 0; m < 4; ++m) _Pragma("unroll") for (int k = 0; k < 2; ++k) dst[m][k] = *(const LAS bf16x8*)(lds + PG8_SA(b, h) + aoff + m * 2048 + k * 1024); } while (0)
#define PG8_LDB(dst, b, h) do { _Pragma("unroll") for (int n = 0; n < 2; ++n) _Pragma("unroll") for (int k = 0; k < 2; ++k) dst[n][k] = *(const LAS bf16x8*)(lds + PG8_SB(b, h) + boff + n * 2048 + k * 1024); } while (0)
#define PG8_CAT8(x) __builtin_shufflevector(__builtin_bit_cast(v4i_t, (x)[0]), __builtin_bit_cast(v4i_t, (x)[1]), 0, 1, 2, 3, 4, 5, 6, 7)
#define PG8_MMA(ai, bj, At, Bt) do { __builtin_amdgcn_s_setprio(1); if constexpr (FP8) { _Pragma("unroll") for (int m = 0; m < 4; ++m) _Pragma("unroll") for (int n = 0; n < 2; ++n) \
        acc[ai][bj][m][n] = __builtin_amdgcn_mfma_scale_f32_16x16x128_f8f6f4(PG8_CAT8(Bt[n]), PG8_CAT8(At[m]), acc[ai][bj][m][n], 0, 0, 0, 0x7f7f7f7f, 0, 0x7f7f7f7f); \
        _Pragma("unroll") for (int m = 0; m < 4; ++m) _Pragma("unroll") for (int n = 0; n < 2; ++n) asm volatile("" : "+v"(acc[ai][bj][m][n]));   } else { \
        _Pragma("unroll") for (int m = 0; m < 4; ++m) _Pragma("unroll") for (int n = 0; n < 2; ++n) _Pragma("unroll") for (int k = 0; k < 2; ++k) \
        acc[ai][bj][m][n] = __builtin_amdgcn_mfma_f32_16x16x32_bf16(Bt[n][k], At[m][k], acc[ai][bj][m][n], 0, 0, 0); } __builtin_amdgcn_s_setprio(0); } while (0)
#define PG8_WAIT_V(n) asm volatile("s_waitcnt vmcnt(" #n ")" ::: "memory")
#define PG8_WAIT_L(n) asm volatile("s_waitcnt lgkmcnt(" #n ")" ::: "memory")
#define PG8_BAR __builtin_amdgcn_s_barrier()
#define PG8_SCHED __builtin_amdgcn_sched_barrier(0)
#define PG8_SETVO(vo, u) do { if constexpr (GATHER) { _Pragma("unroll") for (int _h = 0; _h < 2; ++_h) _Pragma("unroll") for (int _i = 0; _i < 2; ++_i) { \
        const int _row = g.rowidx[(u).pm * BM + _h * HALF + RA[_i]]; (vo)[_h][_i] = (unsigned)_row * (unsigned)(g.lda * ES) + (unsigned)CA[_i] * 2u; } } } while (0)
#define PG8_STAGE_A(bufoff, base, h, vog) do { if constexpr (GATHER) { PG8_STAGE(bufoff, base, (vog)[h]); } else { PG8_STAGE(bufoff, (base) + (h) * hstepA, voffA); } } while (0)
    Unit cur, nxt; int ui = 0;
    if (!S.next(0, cur)) return;
    Acc acc;
#pragma unroll
    for (int a = 0; a < 2; ++a)
#pragma unroll
        for (int b = 0; b < 2; ++b)
#pragma unroll
            for (int m = 0; m < 4; ++m)
#pragma unroll
                for (int n = 0; n < 2; ++n) acc[a][b][m][n] = (f32x4){0.f, 0.f, 0.f, 0.f};
    bf16x8 At[4][2], B0[2][2], B1[2][2];
    unsigned voC[2][2], voN[2][2];
    PG8_SETVO(voC, cur);
    const char* const Ab = (const char*)g.A;
    const char* cA = GATHER ? Ab : Ab + (size_t)cur.pm * 2 * hstepA;
    const char* cB = (const char*)g.Bt + (size_t)cur.e * g.bstride + (size_t)cur.pn * 2 * hstepB;
    PG8_STAGE(PG8_SB(0, 0), cB, voffB); PG8_STAGE(PG8_SB(0, 1), cB + hstepB, voffB); PG8_STAGE_A(PG8_SA(0, 0), cA, 0, voC); PG8_STAGE_A(PG8_SA(0, 1), cA, 1, voC);
    if (wr == 1) PG8_BAR;
    PG8_WAIT_V(2); PG8_BAR;
    PG8_STAGE(PG8_SB(1, 0), cB + kstep, voffB); PG8_STAGE_A(PG8_SA(1, 0), cA + kstep, 0, voC); PG8_STAGE(PG8_SB(1, 1), cB + hstepB + kstep, voffB);
    PG8_WAIT_V(6); PG8_BAR;
    for (;;) {
        const bool has_next = S.next(ui + 1, nxt);
        const char* nB = has_next ? (const char*)g.Bt + (size_t)nxt.e * g.bstride + (size_t)nxt.pn * 2 * hstepB : cB;
        const char* nA = (has_next && !GATHER) ? Ab + (size_t)nxt.pm * 2 * hstepA : cA;
        if constexpr (GATHER) { if (has_next) { PG8_SETVO(voN, nxt); } else {
#pragma unroll
            for (int h = 0; h < 2; ++h)
#pragma unroll
                for (int i = 0; i < 2; ++i) voN[h][i] = voC[h][i]; } }
        for (int t = 0; t < nt; t += 2) {
            const bool last = (t == nt - 2);
            if constexpr (Epi::MIDK > 0) { if (t == Epi::MIDK) { const int l2 = lane_id(); E.mid(acc, cur, wr, wc, l2 & 15, l2 >> 4); } }
            const char* a1 = cA + (size_t)(t + 1) * kstep;
            const char* a2 = last ? nA : cA + (size_t)(t + 2) * kstep; const char* b2 = last ? nB : cB + (size_t)(t + 2) * kstep;
            const char* a3 = a2 + kstep; const char* b3 = b2 + kstep;
            unsigned o2[2][2];
            if constexpr (GATHER) {
#pragma unroll
            for (int h = 0; h < 2; ++h)
#pragma unroll
                for (int i = 0; i < 2; ++i) o2[h][i] = last ? voN[h][i] : voC[h][i]; }
            PG8_LDB(B0, 0, 0); PG8_LDB(B1, 0, 1); PG8_SCHED; PG8_LDA(At, 0, 0); PG8_STAGE_A(PG8_SA(1, 1), a1, 1, voC);
            PG8_WAIT_V(8); PG8_WAIT_L(0); PG8_BAR; PG8_MMA(0, 0, At, B0); PG8_MMA(0, 1, At, B1); PG8_BAR; PG8_SCHED;
            PG8_LDA(At, 0, 1); PG8_STAGE(PG8_SB(0, 0), b2, voffB); PG8_STAGE(PG8_SB(0, 1), b2 + hstepB, voffB); PG8_STAGE_A(PG8_SA(0, 0), a2, 0, o2);
            PG8_WAIT_V(8); PG8_WAIT_L(0); PG8_BAR; PG8_MMA(1, 0, At, B0); PG8_MMA(1, 1, At, B1); PG8_BAR; PG8_SCHED;
            PG8_LDB(B0, 1, 0); PG8_LDB(B1, 1, 1); PG8_SCHED; PG8_LDA(At, 1, 0); PG8_STAGE_A(PG8_SA(0, 1), a2, 1, o2);
            PG8_WAIT_V(8); PG8_WAIT_L(0); PG8_BAR; PG8_MMA(0, 0, At, B0); PG8_MMA(0, 1, At, B1); PG8_BAR; PG8_SCHED;
            PG8_LDA(At, 1, 1); PG8_STAGE(PG8_SB(1, 0), b3, voffB); PG8_STAGE(PG8_SB(1, 1), b3 + hstepB, voffB); PG8_STAGE_A(PG8_SA(1, 0), a3, 0, o2);
            PG8_WAIT_V(8); PG8_WAIT_L(0); PG8_BAR; PG8_MMA(1, 0, At, B0); PG8_MMA(1, 1, At, B1); PG8_BAR; PG8_SCHED;
        }
        if (wr == 0) PG8_BAR;
        if (do_epi) { const int l2 = lane_id(); E(acc, cur, wr, wc, l2 & 15, l2 >> 4); }
        if (!has_next) break;
#pragma unroll
        for (int a = 0; a < 2; ++a)
#pragma unroll
            for (int b = 0; b < 2; ++b)
#pragma unroll
                for (int m = 0; m < 4; ++m)
#pragma unroll
                    for (int n = 0; n < 2; ++n) acc[a][b][m][n] = (f32x4){0.f, 0.f, 0.f, 0.f};
        cur = nxt; cB = nB; cA = nA; ++ui;
        if constexpr (GATHER) {
#pragma unroll
        for (int h = 0; h < 2; ++h)
#pragma unroll
            for (int i = 0; i < 2; ++i) voC[h][i] = voN[h][i]; }
        if (wr == 1) PG8_BAR;
    }
    PG8_WAIT_V(0);
    PG8_BAR;
#undef PG8_SA
#undef PG8_SB
#undef PG8_STAGE
#undef PG8_LDA
#undef PG8_LDB
#undef PG8_MMA
#undef PG8_CAT8
#undef PG8_WAIT_V
#undef PG8_WAIT_L
#undef PG8_BAR
#undef PG8_SCHED
#undef PG8_SETVO
#undef PG8_STAGE_A
}

__device__ __forceinline__ unsigned pk4_fp8(f32x4 v) { unsigned w = 0; w = __builtin_amdgcn_cvt_pk_fp8_f32(v[0], v[1], w, false); w = __builtin_amdgcn_cvt_pk_fp8_f32(v[2], v[3], w, true); return w; }
__device__ __forceinline__ float sq4(f32x4 v) { return (v[0] * v[0] + v[1] * v[1]) + (v[2] * v[2] + v[3] * v[3]); }
__device__ __forceinline__ float red_fq(float s) { s += __shfl_xor(s, 16); s += __shfl_xor(s, 32); return s; }
__device__ __forceinline__ u32x4 pack8(f32x4 a, f32x4 b) { u32x4 w; w.x = cvt_pk_bf16(a[0], a[1]); w.y = cvt_pk_bf16(a[2], a[3]); w.z = cvt_pk_bf16(b[0], b[1]); w.w = cvt_pk_bf16(b[2], b[3]); return w; }
template <int MODE> struct EpiBf16Stats {
    static constexpr bool PERM = true; static constexpr int MIDK = 0;
    bf16_t* O; int ldc; float* ssq;
    __device__ __forceinline__ void operator()(const Acc& acc, const Unit& u, int wr, int wc, int fr, int fq) const {
        const int row0 = u.pm * BM + wr * 64 + fr, col0 = u.pn * BM + wc * 32 + 8 * fq;
#pragma unroll
        for (int ai = 0; ai < 2; ++ai)
#pragma unroll
            for (int m = 0; m < 4; ++m) { const int row = row0 + ai * HALF + m * 16; bf16_t* rowp = O + (size_t)row * ldc + col0;
#pragma unroll
                for (int bj = 0; bj < 2; ++bj) *(u32x4*)(rowp + bj * HALF) = pack8(acc[ai][bj][m][0], acc[ai][bj][m][1]);
                if (MODE == 1) { float s = (sq4(acc[ai][0][m][0]) + sq4(acc[ai][0][m][1])) + (sq4(acc[ai][1][m][0]) + sq4(acc[ai][1][m][1])); s = red_fq(s); if (fq == 0) ssq[(size_t)row * 16 + u.pn * 4 + wc] = s; }
                else if (u.pn == 0) { float s = (sq4(acc[ai][0][m][0]) + sq4(acc[ai][0][m][1])) + (sq4(acc[ai][1][m][0]) + sq4(acc[ai][1][m][1])); s = red_fq(s); if (fq == 0) ssq[(size_t)row * 8 + wc] = s; }
                else if (u.pn == 1) { float s = sq4(acc[ai][0][m][0]) + sq4(acc[ai][0][m][1]); s = red_fq(s); if (fq == 0) ssq[(size_t)row * 8 + 4 + wc] = s; } }
    }
};
struct EpiQ {
    static constexpr bool PERM = true; static constexpr int MIDK = 0;
    bf16_t* Q; const float* ssq; const float* cs;
    __device__ __forceinline__ void operator()(const Acc& acc, const Unit& u, int wr, int wc, int fr, int fq) const {
        const int row0 = u.pm * BM + wr * 64 + fr;
#pragma unroll
        for (int ai = 0; ai < 2; ++ai)
#pragma unroll
            for (int m = 0; m < 4; ++m) { const int row = row0 + ai * HALF + m * 16; const f32x4 sv = *(const f32x4*)(ssq + (size_t)row * 8);
                const float rs = rsqrtf(((sv[0] + sv[1]) + (sv[2] + sv[3])) * (1.f / QL) + EPS); const int b = row / SEQ, s = row % SEQ;
#pragma unroll
                for (int bj = 0; bj < 2; ++bj) { const int cv = u.pn * BM + bj * HALF + wc * 32 + 8 * fq; const int h = cv / DQK, d = cv % DQK;
                    f32x4 v0 = acc[ai][bj][m][0] * rs, v1 = acc[ai][bj][m][1] * rs;
                    if (d >= DN) { const int i0 = (d - DN) >> 1; const f32x4 c = *(const f32x4*)(cs + (size_t)row * 64 + i0), sn = *(const f32x4*)(cs + (size_t)row * 64 + 32 + i0);
                        const f32x4 r0 = {v0[0] * c[0] - v0[1] * sn[0], v0[0] * sn[0] + v0[1] * c[0], v0[2] * c[1] - v0[3] * sn[1], v0[2] * sn[1] + v0[3] * c[1]};
                        const f32x4 r1 = {v1[0] * c[2] - v1[1] * sn[2], v1[0] * sn[2] + v1[1] * c[2], v1[2] * c[3] - v1[3] * sn[3], v1[2] * sn[3] + v1[3] * c[3]};
                        v0 = r0; v1 = r1; }
                    *(u32x4*)(Q + ((size_t)(b * NH + h) * SEQ + s) * DQK + d) = pack8(v0, v1); } }
    }
};
struct EpiKV {
    static constexpr bool PERM = true; static constexpr int MIDK = 0;
    bf16_t* Kc; bf16_t* Vc; const float* ssq;
    __device__ __forceinline__ void operator()(const Acc& acc, const Unit& u, int wr, int wc, int fr, int fq) const {
        const int row0 = u.pm * BM + wr * 64 + fr, d = wc * 32 + 8 * fq, h = u.pn;
#pragma unroll
        for (int ai = 0; ai < 2; ++ai)
#pragma unroll
            for (int m = 0; m < 4; ++m) { const int row = row0 + ai * HALF + m * 16; const f32x4 sv = *(const f32x4*)(ssq + (size_t)row * 8 + 4);
                const float rs = rsqrtf(((sv[0] + sv[1]) + (sv[2] + sv[3])) * (1.f / KVL) + EPS); const int b = row / SEQ, s = row % SEQ; const size_t t = (size_t)(b * NH + h) * SEQ + s;
                *(u32x4*)(Kc + t * DQK + d) = pack8(acc[ai][0][m][0] * rs, acc[ai][0][m][1] * rs);
                *(u32x4*)(Vc + t * DV + d) = pack8(acc[ai][1][m][0] * rs, acc[ai][1][m][1] * rs); }
    }
};
struct EpiWo {
    static constexpr bool PERM = true; static constexpr int MIDK = 8;
    const float* x; bf16_t* HBF; unsigned char* X8; const float* assq; float* ssq1;
    __device__ __forceinline__ void mid(Acc& acc, const Unit& u, int wr, int wc, int fr, int fq) const {
        const int row0 = u.pm * BM + wr * 64 + fr;
#pragma unroll
        for (int ai = 0; ai < 2; ++ai)
#pragma unroll
            for (int m = 0; m < 4; ++m) { const f32x4 sv = *(const f32x4*)(assq + (size_t)(row0 + ai * HALF + m * 16) * 4);
                const float rs = rsqrtf(((sv[0] + sv[1]) + (sv[2] + sv[3])) * (1.f / 512.f) + EPS);
#pragma unroll
                for (int bj = 0; bj < 2; ++bj)
#pragma unroll
                    for (int n = 0; n < 2; ++n) acc[ai][bj][m][n] = acc[ai][bj][m][n] * rs; }
    }
    __device__ __forceinline__ void operator()(const Acc& acc, const Unit& u, int wr, int wc, int fr, int fq) const {
        const int row0 = u.pm * BM + wr * 64 + fr, col0 = u.pn * BM + wc * 32 + 8 * fq;
#pragma unroll
        for (int ai = 0; ai < 2; ++ai)
#pragma unroll
            for (int m = 0; m < 4; ++m) { const int row = row0 + ai * HALF + m * 16; const size_t off = (size_t)row * DM + col0; float ss = 0.f;
#pragma unroll
                for (int bj = 0; bj < 2; ++bj) { const f32x4 h0 = *(const f32x4*)(x + off + bj * HALF) + acc[ai][bj][m][0], h1 = *(const f32x4*)(x + off + bj * HALF + 4) + acc[ai][bj][m][1];
                    *(u32x4*)(HBF + off + bj * HALF) = pack8(h0, h1); *(u32x2*)(X8 + off + bj * HALF) = (u32x2){pk4_fp8(h0), pk4_fp8(h1)}; ss += sq4(h0) + sq4(h1); }
                ss = red_fq(ss); if (fq == 0) ssq1[(size_t)row * 16 + u.pn * 4 + wc] = ss; }
    }
};
__device__ __forceinline__ float swiglu_f(float g, float u) { g = fminf(g, 7.f); u = fminf(fmaxf(u, -7.f), 7.f); return g * fast_sigmoid(1.702f * g) * (u + 1.f); }
constexpr float WSCALE = 64.f, WINV = 1.f / 64.f;
struct EpiMoe1 {
    static constexpr bool PERM = true; static constexpr int MIDK = 0;
    unsigned char* HB; const float* b1; const float* rowrs;
    __device__ __forceinline__ void operator()(const Acc& acc, const Unit& u, int wr, int wc, int fr, int fq) const {
        const int row0 = u.pm * BM + wr * 64 + fr, j0 = u.pn * HALF + wc * 32 + 8 * fq; const float* bg = b1 + (size_t)u.e * 2048 + j0;
        const f32x4 g0 = *(const f32x4*)bg, g1 = *(const f32x4*)(bg + 4), u0 = *(const f32x4*)(bg + 1024), u1 = *(const f32x4*)(bg + 1028);
#pragma unroll
        for (int ai = 0; ai < 2; ++ai)
#pragma unroll
            for (int m = 0; m < 4; ++m) { const float rs = rowrs[row0 + ai * HALF + m * 16] * WINV;
                const f32x4 a0 = acc[ai][0][m][0] * rs + g0, a1 = acc[ai][0][m][1] * rs + g1, c0 = acc[ai][1][m][0] * rs + u0, c1 = acc[ai][1][m][1] * rs + u1; f32x4 r0, r1;
#pragma unroll
                for (int j = 0; j < 4; ++j) { r0[j] = swiglu_f(a0[j], c0[j]); r1[j] = swiglu_f(a1[j], c1[j]); }
                *(u32x2*)(HB + (size_t)(row0 + ai * HALF + m * 16) * DE + j0) = (u32x2){pk4_fp8(r0), pk4_fp8(r1)}; }
    }
};
struct EpiMoe2 {
    static constexpr bool PERM = true; static constexpr int MIDK = 0;
    bf16_t* Y; const float* b2; const int* rowslot; const float* rowgate;
    __device__ __forceinline__ void operator()(const Acc& acc, const Unit& u, int wr, int wc, int fr, int fq) const {
        const int row0 = u.pm * BM + wr * 64 + fr, col0 = u.pn * BM + wc * 32 + 8 * fq; const float* bb = b2 + (size_t)u.e * DM + col0;
        f32x4 bv[2][2];
#pragma unroll
        for (int bj = 0; bj < 2; ++bj)
#pragma unroll
            for (int n = 0; n < 2; ++n) bv[bj][n] = *(const f32x4*)(bb + bj * HALF + 4 * n);
#pragma unroll
        for (int ai = 0; ai < 2; ++ai)
#pragma unroll
            for (int m = 0; m < 4; ++m) { const int r = row0 + ai * HALF + m * 16; const float gt = rowgate[r]; bf16_t* yp = Y + (size_t)rowslot[r] * DM + col0;
#pragma unroll
                for (int bj = 0; bj < 2; ++bj) *(u32x4*)(yp + bj * HALF) = pack8((acc[ai][bj][m][0] * WINV + bv[bj][0]) * gt, (acc[ai][bj][m][1] * WINV + bv[bj][1]) * gt); }
    }
};
struct EpiPle {
    static constexpr bool PERM = true; static constexpr int MIDK = 0;
    const bf16_t* H2; bf16_t* H3; const bf16_t* pler; const float* pssq; const float* rs2; const float* pg; float* fssq;
    __device__ __forceinline__ void operator()(const Acc& acc, const Unit& u, int wr, int wc, int fr, int fq) const {
        const int row0 = u.pm * BM + wr * 64 + fr, col0 = u.pn * BM + wc * 32 + 8 * fq;
        f32x4 gv[2][2];
#pragma unroll
        for (int bj = 0; bj < 2; ++bj)
#pragma unroll
            for (int n = 0; n < 2; ++n) gv[bj][n] = *(const f32x4*)(pg + col0 + bj * HALF + n * 4);
#pragma unroll
        for (int ai = 0; ai < 2; ++ai)
#pragma unroll
            for (int m = 0; m < 4; ++m) { const int row = row0 + ai * HALF + m * 16; const size_t off = (size_t)row * DM + col0; const f32x4* pp = (const f32x4*)(pssq + (size_t)row * 16);
                const f32x4 p0 = pp[0], p1 = pp[1], p2 = pp[2], p3 = pp[3]; const float r2 = rs2[row];
                const float rp = rsqrtf((((p0[0] + p0[1]) + (p0[2] + p0[3])) + ((p1[0] + p1[1]) + (p1[2] + p1[3])) + ((p2[0] + p2[1]) + (p2[2] + p2[3])) + ((p3[0] + p3[1]) + (p3[2] + p3[3]))) * (1.f / DM) + EPS);
                float ss = 0.f;
#pragma unroll
                for (int bj = 0; bj < 2; ++bj) { const size_t o = off + bj * HALF; const u32x4 hv = *(const u32x4*)(H2 + o), pr = *(const u32x4*)(pler + o);
                    const f32x4 h0 = {blo(hv.x), bhi(hv.x), blo(hv.y), bhi(hv.y)}, h1 = {blo(hv.z), bhi(hv.z), blo(hv.w), bhi(hv.w)};
                    const f32x4 q0 = {blo(pr.x), bhi(pr.x), blo(pr.y), bhi(pr.y)}, q1 = {blo(pr.z), bhi(pr.z), blo(pr.w), bhi(pr.w)}; const f32x4 a0 = acc[ai][bj][m][0] * r2, a1 = acc[ai][bj][m][1] * r2; f32x4 r0, r1;
#pragma unroll
                    for (int j = 0; j < 4; ++j) { r0[j] = h0[j] + fast_sigmoid(a0[j]) * (q0[j] * rp * gv[bj][0][j]); r1[j] = h1[j] + fast_sigmoid(a1[j]) * (q1[j] * rp * gv[bj][1][j]); }
                    *(u32x4*)(H3 + o) = pack8(r0, r1); ss += sq4(r0) + sq4(r1); }
                ss = red_fq(ss); if (fq == 0) fssq[(size_t)row * 16 + u.pn * 4 + wc] = ss; }
    }
};
}

namespace att {
typedef float f32x16 __attribute__((ext_vector_type(16)));
typedef short s16x4 __attribute__((ext_vector_type(4)));
constexpr int QBLK = 32, KVBLK = 64, QB = 256;
constexpr int SHM_K = KVBLK * DQK * 2, SHM_V = KVBLK * DV * 2;
constexpr int L_V = 0, L_K = 2 * SHM_V, L_WS = L_K + 2 * SHM_K, L_END = L_WS + NWAVES * 256;
constexpr float THR = 8.f;
#define KSWZ(row, colB) ((row) * 384 + ((colB) ^ (((row) & 7) << 4)))
#define SBAR() __builtin_amdgcn_sched_barrier(0)
__device__ __forceinline__ int v_st(int k, int c) { const int kk = (k & ~0xC) | ((k & 4) << 1) | ((k & 8) >> 1); return ((kk >> 3) * 4 + (c >> 5)) * 512 + ((kk & 7) * 32 + (c & 31)) * 2; }
__device__ __forceinline__ int v_rd_base(int lane) { return ((lane & 3) << 3) | (((lane >> 2) & 3) << 6) | (((lane >> 4) & 1) << 5) | (((lane >> 5) & 1) << 8); }
constexpr int v_rd_off(int d0, int ks, int half) { return d0 * 512 + ks * 4096 + half * 2048; }
__device__ __forceinline__ int crow(int r, int hi) { return (r & 3) + 8 * (r >> 2) + 4 * hi; }
typedef __bf16 bf16x2_t __attribute__((ext_vector_type(2)));
__device__ __forceinline__ unsigned cvtpk(float lo, float hi) { f32x2 v = {lo, hi}; bf16x2_t b = __builtin_convertvector(v, bf16x2_t); return __builtin_bit_cast(unsigned, b); }

__device__ __forceinline__ void qkt(f32x16& p0, f32x16& p1, const LAS unsigned char* Kbuf, int r32, int hi, const bf16x8* qr) {
    p0 = f32x16{}; p1 = f32x16{};
    const LAS unsigned char* kb[4];
#pragma unroll
    for (int dd = 0; dd < 4; ++dd) kb[dd] = Kbuf + KSWZ(r32, (dd * 16 + hi * 8) * 2);
#pragma unroll
    for (int d0 = 0; d0 < 12; ++d0) { const LAS unsigned char* a = kb[d0 & 3] + (d0 >> 2) * 128;
        const bf16x8 b0 = *(const LAS bf16x8*)a; const bf16x8 b1 = *(const LAS bf16x8*)(a + 32 * 384);
        p0 = __builtin_amdgcn_mfma_f32_32x32x16_bf16(b0, qr[d0], p0, 0, 0, 0);
        p1 = __builtin_amdgcn_mfma_f32_32x32x16_bf16(b1, qr[d0], p1, 0, 0, 0); }
}
template <int VB>
__device__ __forceinline__ void pv_tile(f32x16* o, int vb0, bf16x8 pa0, bf16x8 pa1, bf16x8 pa2, bf16x8 pa3) {
#define TRRD(dst, off) asm volatile("ds_read_b64_tr_b16 %0, %1 offset:%2" : "=&v"(dst) : "v"(vb0), "i"(off) : "memory")
#define PV_D0(d0) do { s16x4 l0, l1, l2, l3, h0, h1, h2, h3; constexpr int b_ = VB * SHM_V + v_rd_off(d0, 0, 0); \
        TRRD(l0, b_); TRRD(h0, b_ + 2048); TRRD(l1, b_ + 4096); TRRD(h1, b_ + 6144); TRRD(l2, b_ + 8192); TRRD(h2, b_ + 10240); TRRD(l3, b_ + 12288); TRRD(h3, b_ + 14336); \
        asm volatile("s_waitcnt lgkmcnt(0)" ::: "memory"); SBAR(); \
        o[d0] = __builtin_amdgcn_mfma_f32_32x32x16_bf16(pa0, (bf16x8){l0[0], l0[1], l0[2], l0[3], h0[0], h0[1], h0[2], h0[3]}, o[d0], 0, 0, 0); \
        o[d0] = __builtin_amdgcn_mfma_f32_32x32x16_bf16(pa1, (bf16x8){l1[0], l1[1], l1[2], l1[3], h1[0], h1[1], h1[2], h1[3]}, o[d0], 0, 0, 0); \
        o[d0] = __builtin_amdgcn_mfma_f32_32x32x16_bf16(pa2, (bf16x8){l2[0], l2[1], l2[2], l2[3], h2[0], h2[1], h2[2], h2[3]}, o[d0], 0, 0, 0); \
        o[d0] = __builtin_amdgcn_mfma_f32_32x32x16_bf16(pa3, (bf16x8){l3[0], l3[1], l3[2], l3[3], h3[0], h3[1], h3[2], h3[3]}, o[d0], 0, 0, 0); } while (0)
    PV_D0(0); PV_D0(1); PV_D0(2); PV_D0(3);
#undef PV_D0
#undef TRRD
}
__device__ __forceinline__ void attn_block(int bh, int qb, const bf16_t* __restrict__ Q, const bf16_t* __restrict__ K, const bf16_t* __restrict__ V, bf16_t* __restrict__ MIX, float* __restrict__ ASSQ, LAS unsigned char* lds, const int wid) {
    const int lane = lane_id(), r32 = lane & 31, hi = lane >> 5;
    const int b = bh / NH, h = bh % NH;
    const bf16_t* Qw = Q + ((size_t)bh * SEQ + qb * QB + wid * QBLK + r32) * DQK;
    const bf16_t* Kh = K + (size_t)bh * SEQ * DQK; const bf16_t* Vh = V + (size_t)bh * SEQ * DV;
    bf16x8 qr[12];
#pragma unroll
    for (int d0 = 0; d0 < 12; ++d0) qr[d0] = *(const bf16x8*)(Qw + d0 * 16 + hi * 8);
    const int NT = 4 * qb + 4, qlo = qb * QB + wid * QBLK, qm = qlo + r32 - 4 * hi;
    LAS unsigned char* V_lds = lds + L_V; LAS unsigned char* K_lds = lds + L_K;
    LAS float* wsf = (LAS float*)(lds + L_WS) + wid * 64; LAS float* li_l = wsf; LAS float* al_l = wsf + 32;
    unsigned ksrc[3], vsrc[2];
#pragma unroll
    for (int i = 0; i < 3; ++i) { const int off = ((wid + 8 * i) * 64 + lane) * 16, row = off / 384, wb = off % 384, seg = wb >> 7, cpos = (wb & 127) >> 4; ksrc[i] = (unsigned)(row * 384 + seg * 128 + ((cpos ^ (row & 7)) << 4)); }
#pragma unroll
    for (int i = 0; i < 2; ++i) { const int off = ((wid + 8 * i) * 64 + lane) * 16, st = off >> 9, o_ = off & 511, kk = (st >> 2) * 8 + (o_ >> 6), c = (st & 3) * 32 + ((o_ & 63) >> 1);
        const int k = (kk & ~0xC) | ((kk & 4) << 1) | ((kk & 8) >> 1); vsrc[i] = (unsigned)(k * 256 + c * 2); }
    const int vb0 = (int)(unsigned)(uintptr_t)V_lds + v_rd_base(lane);
#define ADMA(t, bf) do { const char* kp = (const char*)(Kh + (size_t)(t) * KVBLK * DQK); const char* vp = (const char*)(Vh + (size_t)(t) * KVBLK * DV); \
        _Pragma("unroll") for (int i = 0; i < 3; ++i) __builtin_amdgcn_global_load_lds((const unsigned*)(kp + ksrc[i]), (LAS unsigned*)(K_lds + (bf) * SHM_K + (wid + 8 * i) * 1024), 16, 0, 0); \
        _Pragma("unroll") for (int i = 0; i < 2; ++i) __builtin_amdgcn_global_load_lds((const unsigned*)(vp + vsrc[i]), (LAS unsigned*)(V_lds + (bf) * SHM_V + (wid + 8 * i) * 1024), 16, 0, 0); } while (0)
    float m_reg = -1e30f, l_reg = 0.f; f32x16 o[4] = {};
    ADMA(0, 0);
#define TILE(t, BF) do { \
        asm volatile("s_waitcnt vmcnt(0)" ::: "memory"); __syncthreads(); \
        if ((t) + 1 < NT) ADMA((t) + 1, (BF) ^ 1); \
        const int kb_ = (t) * KVBLK; \
        if (kb_ <= qlo + QBLK - 1) { \
            f32x16 p0, p1; SBAR(); qkt(p0, p1, K_lds + (BF) * SHM_K, r32, hi, qr); \
            if (kb_ + KVBLK - 1 > qlo) { const int dq = qm - kb_; const float NEG = -__builtin_inff(); \
                _Pragma("unroll") for (int r = 0; r < 16; ++r) { const int c = (r & 3) + 8 * (r >> 2); if (c > dq) p0[r] = NEG; if (c + 32 > dq) p1[r] = NEG; } } \
            float pmax = p0[0]; _Pragma("unroll") for (int r = 1; r < 16; ++r) pmax = fmaxf(pmax, p0[r]); _Pragma("unroll") for (int r = 0; r < 16; ++r) pmax = fmaxf(pmax, p1[r]); \
            { auto rr = __builtin_amdgcn_permlane32_swap(__float_as_uint(pmax), __float_as_uint(pmax), false, false); pmax = fmaxf(__uint_as_float(rr[0]), __uint_as_float(rr[1])); } \
            if (!__all(pmax - m_reg <= THR)) { const float mn = fmaxf(m_reg, pmax); const float alpha = __builtin_amdgcn_exp2f(m_reg - mn); m_reg = mn; l_reg *= alpha; \
                if (hi == 0) al_l[r32] = alpha; asm volatile("s_waitcnt lgkmcnt(0)" ::: "memory"); \
                _Pragma("unroll") for (int d_ = 0; d_ < 4; ++d_) _Pragma("unroll") for (int r = 0; r < 16; ++r) o[d_][r] *= al_l[crow(r, hi)]; } \
            float ps = 0.f; \
            _Pragma("unroll") for (int r = 0; r < 16; ++r) { p0[r] = __builtin_amdgcn_exp2f(p0[r] - m_reg); p1[r] = __builtin_amdgcn_exp2f(p1[r] - m_reg); } \
            _Pragma("unroll") for (int r = 0; r < 16; ++r) ps += p0[r] + p1[r]; \
            { auto rr = __builtin_amdgcn_permlane32_swap(__float_as_uint(ps), __float_as_uint(ps), false, false); ps = __uint_as_float(rr[0]) + __uint_as_float(rr[1]); } \
            l_reg += ps; \
            bf16x8 pa0, pa1, pa2, pa3; \
            PK4(p0, 0, pa0); PK4(p0, 8, pa1); PK4(p1, 0, pa2); PK4(p1, 8, pa3); \
            SBAR(); pv_tile<BF>(o, vb0, pa0, pa1, pa2, pa3); } } while (0)
#define PK4(P, B_, OUT) do { unsigned a0 = cvtpk(P[B_ + 0], P[B_ + 1]), a1 = cvtpk(P[B_ + 2], P[B_ + 3]); \
        unsigned b0 = cvtpk(P[B_ + 4], P[B_ + 5]), b1 = cvtpk(P[B_ + 6], P[B_ + 7]); \
        auto r0 = __builtin_amdgcn_permlane32_swap(a0, b0, false, false); auto r1 = __builtin_amdgcn_permlane32_swap(a1, b1, false, false); \
        u32x4 w = {r0[0], r1[0], r0[1], r1[1]}; OUT = __builtin_bit_cast(bf16x8, w); } while (0)
    for (int t = 0; t < NT; t += 2) { TILE(t, 0); TILE(t + 1, 1); }
#undef PK4
#undef TILE
#undef ADMA
    if (hi == 0) li_l[r32] = l_reg;
    asm volatile("s_waitcnt vmcnt(0) lgkmcnt(0)" ::: "memory");
    float rli[16];
#pragma unroll
    for (int r = 0; r < 16; ++r) rli[r] = __builtin_amdgcn_rcpf(li_l[crow(r, hi)]);
    __syncthreads();
    LAS bf16_t* stg = (LAS bf16_t*)(lds + wid * 8192);
#pragma unroll
    for (int r = 0; r < 16; ++r) { const int orow = crow(r, hi);
#pragma unroll
        for (int d0 = 0; d0 < 4; ++d0) stg[orow * 128 + d0 * 32 + r32] = f2bf(o[d0][r] * rli[r]); }
    asm volatile("s_waitcnt lgkmcnt(0)" ::: "memory");
    const size_t row0 = (size_t)b * SEQ + qb * QB + wid * QBLK;
#pragma unroll
    for (int i = 0; i < 8; ++i) { const int row = i * 4 + (lane >> 4), ch = lane & 15; const u32x4 v = *(const LAS u32x4*)(stg + row * 128 + ch * 8);
        float ss = (blo(v.x) * blo(v.x) + bhi(v.x) * bhi(v.x)) + (blo(v.y) * blo(v.y) + bhi(v.y) * bhi(v.y)) + (blo(v.z) * blo(v.z) + bhi(v.z) * bhi(v.z)) + (blo(v.w) * blo(v.w) + bhi(v.w) * bhi(v.w));
        ss += __shfl_xor(ss, 1); ss += __shfl_xor(ss, 2); ss += __shfl_xor(ss, 4); ss += __shfl_xor(ss, 8);
        *(u32x4*)(MIX + (row0 + row) * DM + h * DV + ch * 8) = v;
        if (ch == 0) ASSQ[(row0 + row) * 4 + h] = ss; }
    __syncthreads();
}
#undef KSWZ
#undef SBAR
}

struct Args { const void* in[25]; float* out; unsigned char* ws; int ph_lo, ph_hi, li, skip; };
enum { PH_PREP = 0, PH_INPROJ, PH_TOKLOCAL, PH_ATTN, PH_WO, PH_ROUTER, PH_ROUTE, PH_MOE1, PH_MOE2, PH_COMBINE, PH_PLE, PH_FINAL, PH_COUNT };

template <int MODE> __device__ __forceinline__ int cmap_col(int n) {
    if (MODE == 1) { const int pn = n >> 8, half = (n >> 7) & 1, jj = n & 127; return half * 1024 + pn * 128 + jj; }
    if (MODE == 2) { const int h = n / DQK, d = n % DQK; if (d < DN) return n; const int t = d - DN; return h * DQK + DN + (t & 1) * 32 + (t >> 1); }
    return n;
}
template <int MODE> __device__ __forceinline__ void transpose_item_fp8(const float* __restrict__ W, int ldsrc, int nblk, unsigned char* __restrict__ WT, int ldd, const float* __restrict__ gain, float scale,
                                                                      LAS float* scr, int item, int lane) {
    const int kb = item / nblk, nb = item % nblk, k0 = 64 * kb, n0 = 32 * nb; const int c = cmap_col<MODE>(n0 + (lane & 31));
    float wv[32];
#pragma unroll
    for (int i = 0; i < 32; ++i) wv[i] = W[(size_t)(k0 + 2 * i + (lane >> 5)) * ldsrc + c];
#pragma unroll
    for (int i = 0; i < 32; ++i) { const int kk = 2 * i + (lane >> 5), k = k0 + kk; float gk = scale; if (gain) gk *= gain[k]; scr[kk * 33 + (lane & 31)] = wv[i] * gk; }
    asm volatile("s_waitcnt lgkmcnt(0)" ::: "memory");
    const int cc = lane & 3;
#pragma unroll
    for (int j = 0; j < 2; ++j) { const int n = (lane >> 2) + 16 * j; const LAS float* s = scr + (16 * cc) * 33 + n; u32x4 o;
        o.x = pg8::pk4_fp8((f32x4){s[0 * 33], s[1 * 33], s[2 * 33], s[3 * 33]}); o.y = pg8::pk4_fp8((f32x4){s[4 * 33], s[5 * 33], s[6 * 33], s[7 * 33]});
        o.z = pg8::pk4_fp8((f32x4){s[8 * 33], s[9 * 33], s[10 * 33], s[11 * 33]}); o.w = pg8::pk4_fp8((f32x4){s[12 * 33], s[13 * 33], s[14 * 33], s[15 * 33]});
        *(u32x4*)(WT + (size_t)(n0 + n) * ldd + k0 + 16 * cc) = o; }
    asm volatile("s_waitcnt lgkmcnt(0)" ::: "memory");
}
template <int MODE> __device__ __forceinline__ void transpose_item(const float* __restrict__ W, int ldsrc, int nblk, bf16_t* __restrict__ WT, int ldd, const float* __restrict__ gain, const float* __restrict__ gain2, float scale,
                                                                  LAS float* scr, int item, int lane) {
    const int kb = item / nblk, nb = item % nblk, k0 = 64 * kb, n0 = 32 * nb; const int c = cmap_col<MODE>(n0 + (lane & 31));
    float wv[32];
#pragma unroll
    for (int i = 0; i < 32; ++i) wv[i] = W[(size_t)(k0 + 2 * i + (lane >> 5)) * ldsrc + c];
#pragma unroll
    for (int i = 0; i < 32; ++i) { const int kk = 2 * i + (lane >> 5), k = k0 + kk; float gk = scale; if (gain) gk *= (gain2 && k >= 512) ? gain2[k - 512] : gain[k];
        scr[kk * 33 + (lane & 31)] = wv[i] * gk; }
    asm volatile("s_waitcnt lgkmcnt(0)" ::: "memory");
    const int cc = lane & 7;
#pragma unroll
    for (int j = 0; j < 4; ++j) { const int n = (lane >> 3) + 8 * j; const LAS float* s = scr + (8 * cc) * 33 + n;
        u32x4 o; o.x = pk2(s[0 * 33], s[1 * 33]); o.y = pk2(s[2 * 33], s[3 * 33]); o.z = pk2(s[4 * 33], s[5 * 33]); o.w = pk2(s[6 * 33], s[7 * 33]);
        *(u32x4*)(WT + (size_t)(n0 + n) * ldd + k0 + 8 * cc) = o; }
    asm volatile("s_waitcnt lgkmcnt(0)" ::: "memory");
}

__global__ void __launch_bounds__(NTHREADS, 2) fwd(Args args) {
    extern __shared__ __attribute__((aligned(16))) unsigned char lds_raw[];
    LAS unsigned char* lds = (LAS unsigned char*)lds_raw;
    volatile LAS unsigned* MISC = (volatile LAS unsigned*)(lds + MISC_OFF);
    const int wave = __builtin_amdgcn_readfirstlane(threadIdx.x >> 6);
    const int G = gridDim.x, bx = blockIdx.x;
#define PHASE_LANE const int lane = lane_id(); const int tid = wave * 64 + lane; (void)tid
    const int gw = bx * NWAVES + wave, NGW = G * NWAVES;
    unsigned char* ws = args.ws; int* ctl = (int*)(ws + WS_CTL); float* H = args.out;
    const float* x = (const float*)args.in[0]; const float* p = (const float*)args.in[1]; const int* pos = (const int*)args.in[2];
    const float *mix_norm = (const float*)args.in[3], *w_in = (const float*)args.in[4], *q_norm = (const float*)args.in[5], *w_uq = (const float*)args.in[6], *kv_norm = (const float*)args.in[7],
                *w_ukv = (const float*)args.in[8], *attn_out_norm = (const float*)args.in[10], *conv_out_norm = (const float*)args.in[11], *w_o = (const float*)args.in[12],
                *moe_norm = (const float*)args.in[13], *w_router = (const float*)args.in[14], *w1 = (const float*)args.in[16], *b1 = (const float*)args.in[17],
                *w2 = (const float*)args.in[18], *b2 = (const float*)args.in[19], *ple_norm = (const float*)args.in[20], *w_ple_gate = (const float*)args.in[21], *w_ple_proj = (const float*)args.in[22],
                *ple_post_norm = (const float*)args.in[23], *conv_w = (const float*)args.in[9], *b_router = (const float*)args.in[15], *final_norm = (const float*)args.in[24];
    int* TOPI = (int*)(ws + WS_TOPI); float* TOPG = (float*)(ws + WS_TOPG);
    bf16_t *HBF = (bf16_t*)(ws + WS_HBF), *H3 = (bf16_t*)(ws + WS_H3), *WRHL = (bf16_t*)(ws + WS_WRHL); unsigned char* X8 = (unsigned char*)(ws + WS_XN);
    float *SSQ1 = (float*)(ws + WS_SSQ1), *RS1 = (float*)(ws + WS_RS1), *RS2 = (float*)(ws + WS_RS2), *ROWRS = (float*)(ws + WS_ROWRS);
    bf16_t *WIN = (bf16_t*)(ws + WS_WIN), *WUQ = (bf16_t*)(ws + WS_WUQ), *WUKV = (bf16_t*)(ws + WS_WUKV), *WO = (bf16_t*)(ws + WS_WO), *WG = (bf16_t*)(ws + WS_WG), *WP = (bf16_t*)(ws + WS_WP);
    bf16_t *W1T = (bf16_t*)(ws + WS_W1), *W2T = (bf16_t*)(ws + WS_W2), *XN = (bf16_t*)(ws + WS_XN), *MIX = (bf16_t*)(ws + WS_MIX), *PLER = (bf16_t*)(ws + WS_PLER);
    bf16_t *Z = (bf16_t*)(ws + WS_Z), *Qb = (bf16_t*)(ws + WS_Q), *Kb = (bf16_t*)(ws + WS_K), *Vb = (bf16_t*)(ws + WS_V), *HB = (bf16_t*)(ws + WS_HB), *Y = (bf16_t*)(ws + WS_Y), *P16 = (bf16_t*)(ws + WS_P16);
    float *WR = (float*)(ws + WS_WR), *CS = (float*)(ws + WS_CS), *SSQ = (float*)(ws + WS_SSQ), *ASSQ = (float*)(ws + WS_ASSQ), *PSSQ = (float*)(ws + WS_PSSQ), *FSSQ = (float*)(ws + WS_FSSQ);
    int *ROWTOK = (int*)(ws + WS_ROWTOK), *ROWSLOT = (int*)(ws + WS_ROWSLOT); float* ROWGATE = (float*)(ws + WS_ROWGATE);

    { PHASE_LANE; for (int u = tid; u < (LDS_BYTES - MISC_OFF) / 4; u += NTHREADS) ((LAS unsigned*)(lds + MISC_OFF))[u] = 0u; }
    __syncthreads();
    const int lo = args.ph_lo, hi = args.ph_hi;
    XcdBarrier bar; bar.bar = (unsigned*)ctl + CW_BAR + args.li * XCD_BAR_WORDS; bar.x = 0; bar.st = MISC + 8;
    if (hi - lo > 1) bar = xcd_barrier_post((unsigned*)ctl + CW_BAR + args.li * XCD_BAR_WORDS, MISC + 8, wave);
#define IN(k) (lo <= (k) && (k) < hi)
#define NREP(k) ((PROBE_PH == (k)) ? PROBE_REP : 1)
#define REPLOOP(k) for (int rep = 0; rep < NREP(k); ++rep)
#define LASTREP(k) (rep == NREP(k) - 1)
#define SEAM(k) do { if (IN(k) && IN((k) + 1)) xcd_barrier(bar, wave); } while (0)

    if (IN(PH_PREP)) REPLOOP(PH_PREP) {
        PHASE_LANE;
        LAS float* scr = (LAS float*)(lds + wave * 16384);
        constexpr int I_IN = (DM / 64) * (INW / 32), I_UQ = (QL / 64) * (768 / 32), I_UKV = (KVL / 64) * (1024 / 32), I_O = (DM / 64) * (DM / 32), I_G = I_O, I_P = (PLE / 64) * (DM / 32);
        constexpr int I_1 = (DM / 64) * (2048 / 32), I_2 = (DE / 64) * (DM / 32);
        constexpr int NITEMS = I_IN + I_UQ + I_UKV + I_O + I_G + I_P + NE * I_1 + NE * I_2;
        for (int it = gw; it < NITEMS; it += NGW) {
            int r = it;
            if (r < I_IN) { transpose_item<0>(w_in, INW, INW / 32, WIN, DM, mix_norm, nullptr, 1.f, scr, r, lane); continue; } r -= I_IN;
            if (r < I_UQ) { transpose_item<2>(w_uq, 768, 768 / 32, WUQ, QL, q_norm, nullptr, QSCALE, scr, r, lane); continue; } r -= I_UQ;
            if (r < I_UKV) { transpose_item<0>(w_ukv, 1024, 1024 / 32, WUKV, 256, kv_norm, nullptr, 1.f, scr, r, lane); continue; } r -= I_UKV;
            if (r < I_O) { transpose_item<0>(w_o, DM, DM / 32, WO, DM, attn_out_norm, conv_out_norm, 1.f, scr, r, lane); continue; } r -= I_O;
            if (r < I_G) { transpose_item<0>(w_ple_gate, DM, DM / 32, WG, DM, ple_norm, nullptr, 1.f, scr, r, lane); continue; } r -= I_G;
            if (r < I_P) { transpose_item<0>(w_ple_proj, DM, DM / 32, WP, PLE, nullptr, nullptr, 1.f, scr, r, lane); continue; } r -= I_P;
            if (r < NE * I_1) { const int e = r / I_1; transpose_item_fp8<1>(w1 + (size_t)e * DM * 2048, 2048, 2048 / 32, (unsigned char*)W1T + (size_t)e * 2048 * DM, DM, moe_norm, pg8::WSCALE, scr, r % I_1, lane); continue; } r -= NE * I_1;
            { const int e = r / I_2; transpose_item_fp8<0>(w2 + (size_t)e * DE * DM, DM, DM / 32, (unsigned char*)W2T + (size_t)e * DM * DE, DE, nullptr, pg8::WSCALE, scr, r % I_2, lane); }
        }
        for (int i = bx * NTHREADS + tid; i < 1024 * 16; i += G * NTHREADS) *(u32x4*)(WUKV + (size_t)(i >> 4) * 256 + 128 + (i & 15) * 8) = (u32x4){0u, 0u, 0u, 0u};
        for (int i = bx * NTHREADS + tid; i < DM * NE; i += G * NTHREADS) { const int e = i >> 10, k = i & 1023; const float w = w_router[k * NE + e] * moe_norm[k]; const bf16_t whi = f2bf(w);
            WRHL[i] = whi; WRHL[DM * NE + i] = f2bf(w - bf2f(whi)); }
        for (int i = bx * NTHREADS + tid; i < NTOK * 32; i += G * NTHREADS) { const int t = i >> 5, j = i & 31; const float inv = powf(10000.f, -(float)j / 32.f); const float a = (float)pos[t] * inv; float sn, c; sincosf(a, &sn, &c);
            CS[(size_t)t * 64 + j] = c; CS[(size_t)t * 64 + 32 + j] = sn; }
        for (int i = bx * NTHREADS + tid; i < NTOK * PLE / 4; i += G * NTHREADS) { const f32x4 v = ((const f32x4*)p)[i]; ((u32x2*)P16)[i] = (u32x2){pk2(v[0], v[1]), pk2(v[2], v[3])}; }
        for (int row = gw * 4; row < NTOK; row += NGW * 4) {
            f32x4 v[4][4]; float ss[4];
#pragma unroll
            for (int q = 0; q < 4; ++q) { const f32x4* s = (const f32x4*)(x + (size_t)(row + q) * DM);
#pragma unroll
                for (int j = 0; j < 4; ++j) v[q][j] = s[lane + 64 * j]; }
#pragma unroll
            for (int q = 0; q < 4; ++q) { ss[q] = 0.f;
#pragma unroll
                for (int j = 0; j < 4; ++j) ss[q] += pg8::sq4(v[q][j]); }
#pragma unroll
            for (int q = 0; q < 4; ++q) { const float rstd = rsqrtf(wave_sum(ss[q]) * (1.f / DM) + EPS); u32x2* d = (u32x2*)(XN + (size_t)(row + q) * DM);
#pragma unroll
                for (int j = 0; j < 4; ++j) d[lane + 64 * j] = (u32x2){pk2(v[q][j][0] * rstd, v[q][j][1] * rstd), pk2(v[q][j][2] * rstd, v[q][j][3] * rstd)}; }
        }
    }
    SEAM(PH_PREP);
    if (IN(PH_INPROJ)) REPLOOP(PH_INPROJ) {
        { pg8::Gemm g{XN, WIN, DM, DM, DM, nullptr, 0}; pg8::StaticOrder S; S.init(NTOK / 256, INWP / 256, G, bx, nullptr);
          pg8::EpiBf16Stats<0> E{Z, INWP, SSQ}; pg8::gemm_phase<pg8::EpiBf16Stats<0>, false>(lds, g, S, E, wave); }
        { pg8::Gemm g{P16, WP, PLE, PLE, PLE, nullptr, 0}; pg8::StaticOrder S; S.init(NTOK / 256, DM / 256, G, bx, nullptr);
          pg8::EpiBf16Stats<1> E{PLER, DM, PSSQ}; pg8::gemm_phase<pg8::EpiBf16Stats<1>, false>(lds, g, S, E, wave); }
    }
    SEAM(PH_INPROJ);
    if (IN(PH_TOKLOCAL)) REPLOOP(PH_TOKLOCAL) {
        PHASE_LANE;
        if (!(args.skip & 1)) for (int r0 = gw * 16; r0 < NTOK; r0 += NGW * 16) {
            const int c8 = lane * 8; f32x4 w0[2], w1[2], w2[2];
#pragma unroll
            for (int q = 0; q < 2; ++q) { w0[q] = *(const f32x4*)(conv_w + c8 + 4 * q); w1[q] = *(const f32x4*)(conv_w + 512 + c8 + 4 * q); w2[q] = *(const f32x4*)(conv_w + 1024 + c8 + 4 * q); }
            f32x4 u1[2] = {}, u2[2] = {};
            if ((r0 % SEQ) != 0) {
#pragma unroll
                for (int p = 1; p <= 2; ++p) { const bf16_t* zp = Z + (size_t)(r0 - p) * INWP; const u32x4 cg = *(const u32x4*)(zp + 960 + c8), vv = *(const u32x4*)(zp + 1472 + c8);
                    const f32x4 a = (f32x4){blo(cg.x), bhi(cg.x), blo(cg.y), bhi(cg.y)} * (f32x4){blo(vv.x), bhi(vv.x), blo(vv.y), bhi(vv.y)}, b = (f32x4){blo(cg.z), bhi(cg.z), blo(cg.w), bhi(cg.w)} * (f32x4){blo(vv.z), bhi(vv.z), blo(vv.w), bhi(vv.w)};
                    if (p == 1) { u1[0] = a; u1[1] = b; } else { u2[0] = a; u2[1] = b; } } }
#pragma unroll 4
            for (int rr = 0; rr < 16; ++rr) { const int row = r0 + rr; const bf16_t* z = Z + (size_t)row * INWP; const int s = row % SEQ, b = row / SEQ;
                const u32x4 bg = *(const u32x4*)(z + 448 + c8), cg = *(const u32x4*)(z + 960 + c8), vv = *(const u32x4*)(z + 1472 + c8);
                if (lane < 32) { const float x1 = bf2f(z[384 + lane]), x2 = bf2f(z[416 + lane]); const float c = CS[(size_t)row * 64 + lane], sn = CS[(size_t)row * 64 + 32 + lane];
                    const unsigned o = pk2(x1 * c - x2 * sn, x1 * sn + x2 * c);
#pragma unroll
                    for (int h = 0; h < NH; ++h) *(unsigned*)(Kb + ((size_t)(b * NH + h) * SEQ + s) * DQK + DN + 2 * lane) = o; }
                f32x4 u0[2]; u0[0] = (f32x4){blo(cg.x), bhi(cg.x), blo(cg.y), bhi(cg.y)} * (f32x4){blo(vv.x), bhi(vv.x), blo(vv.y), bhi(vv.y)}; u0[1] = (f32x4){blo(cg.z), bhi(cg.z), blo(cg.w), bhi(cg.w)} * (f32x4){blo(vv.z), bhi(vv.z), blo(vv.w), bhi(vv.w)};
                f32x4 y[2]; y[0] = (f32x4){blo(bg.x), bhi(bg.x), blo(bg.y), bhi(bg.y)} * (w0[0] * u2[0] + w1[0] * u1[0] + w2[0] * u0[0]); y[1] = (f32x4){blo(bg.z), bhi(bg.z), blo(bg.w), bhi(bg.w)} * (w0[1] * u2[1] + w1[1] * u1[1] + w2[1] * u0[1]);
                const float rstd = rsqrtf(wave_sum(pg8::sq4(y[0]) + pg8::sq4(y[1])) * (1.f / 512.f) + EPS);
                *(u32x4*)(MIX + (size_t)row * DM + 512 + c8) = pg8::pack8(y[0] * rstd, y[1] * rstd);
                u2[0] = u1[0]; u2[1] = u1[1]; u1[0] = u0[0]; u1[1] = u0[1]; }
        }
        { pg8::Gemm g{Z, WUQ, QL, INWP, QL, nullptr, 0}; pg8::StaticOrder S; S.init(NTOK / 256, 768 / 256, G, bx, nullptr);
          pg8::EpiQ E{Qb, SSQ, CS}; pg8::gemm_phase<pg8::EpiQ, false>(lds, g, S, E, wave); }
        { pg8::Gemm g{Z + 256, WUKV, 256, INWP, 256, nullptr, 0}; pg8::StaticOrder S; S.init(NTOK / 256, 1024 / 256, G, bx, nullptr);
          pg8::EpiKV E{Kb, Vb, SSQ}; pg8::gemm_phase<pg8::EpiKV, false>(lds, g, S, E, wave); }
    }
    SEAM(PH_TOKLOCAL);
    if (IN(PH_ATTN)) REPLOOP(PH_ATTN) {
        const int vcu = (G % 8 == 0) ? (bx % 8) * (G / 8) + bx / 8 : bx;
        for (int it = vcu; it < NB * NH * 8; it += G) { const int bh = it >> 3, pr = it & 7;
            for (int pass = 0; pass < 2; ++pass) att::attn_block(bh, pass ? pr : 15 - pr, Qb, Kb, Vb, MIX, ASSQ, lds, wave); }
    }
    SEAM(PH_ATTN);
    if (IN(PH_WO)) REPLOOP(PH_WO) {
        pg8::Gemm g{MIX, WO, DM, DM, DM, nullptr, 0}; pg8::StaticOrder S; S.init(NTOK / 256, DM / 256, G, bx, nullptr);
        pg8::EpiWo E{x, HBF, X8, ASSQ, SSQ1}; pg8::gemm_phase<pg8::EpiWo, false>(lds, g, S, E, wave);
    }
    SEAM(PH_WO);
    if (IN(PH_ROUTER)) REPLOOP(PH_ROUTER) {
        PHASE_LANE;
        typedef float f32x16 __attribute__((ext_vector_type(16)));
        LAS int* hist = (LAS int*)(lds + HIST_OFF); LAS f32x16* xch = (LAS f32x16*)(lds + HIST_OFF + 256);
        for (int i = tid; i < 2 * NE * 128; i += NTHREADS) { const int pe = i >> 7, kc = i & 127, e = pe & 31; *(LAS u32x4*)(lds + pe * 2048 + ((kc ^ (e & 15)) << 4)) = ((const u32x4*)WRHL)[i]; }
        if (tid < NE) hist[tid] = 0;
        __syncthreads();
        for (int chunk = bx; chunk < NTOK / 128; chunk += G) {
            const int base = chunk * 128, wq = wave & 3, kh = wave >> 2;
            const int j = lane & 31, half = lane >> 5, tok = base + wq * 32 + j;
            const bf16_t* xr = HBF + (size_t)tok * DM + kh * 512 + 8 * half; const LAS unsigned char* wrow = lds + j * 2048;
            f32x16 acc = {};
#pragma unroll 8
            for (int s = 0; s < 32; ++s) { const bf16x8 xb = *(const bf16x8*)(xr + 16 * s); const int kc = ((kh * 64 + 2 * s + half) ^ (j & 15)) << 4;
                const bf16x8 ah = *(const LAS bf16x8*)(wrow + kc), al = *(const LAS bf16x8*)(wrow + 65536 + kc);
                acc = __builtin_amdgcn_mfma_f32_32x32x16_bf16(ah, xb, acc, 0, 0, 0); acc = __builtin_amdgcn_mfma_f32_32x32x16_bf16(al, xb, acc, 0, 0, 0); }
            if (kh == 1) xch[wq * 64 + lane] = acc;
            __syncthreads();
            if (kh == 0) {
                const f32x16 other = xch[wq * 64 + lane];
                const f32x4 s0 = *(const f32x4*)(SSQ1 + (size_t)tok * 16 + 8 * half), s1 = *(const f32x4*)(SSQ1 + (size_t)tok * 16 + 8 * half + 4);
                float ss = ((s0[0] + s0[1]) + (s0[2] + s0[3])) + ((s1[0] + s1[1]) + (s1[2] + s1[3])); ss += __shfl_xor(ss, 32); const float rstd = rsqrtf(ss * (1.f / DM) + EPS);
                float v[16];
#pragma unroll
                for (int r = 0; r < 16; ++r) v[r] = (acc[r] + other[r]) * rstd + b_router[(r & 3) + 8 * (r >> 2) + 4 * half];
                float lv[4]; int li[4];
#pragma unroll
                for (int t = 0; t < 4; ++t) { float best = -__builtin_inff(); int bi = 0;
#pragma unroll
                    for (int r = 0; r < 16; ++r) if (v[r] > best) { best = v[r]; bi = (r & 3) + 8 * (r >> 2) + 4 * half; }
                    const auto rv = __builtin_amdgcn_permlane32_swap(__float_as_uint(best), __float_as_uint(best), false, false); const auto ri = __builtin_amdgcn_permlane32_swap((unsigned)bi, (unsigned)bi, false, false);
                    const float b0 = __uint_as_float(rv[0]), b1 = __uint_as_float(rv[1]); const int i0 = (int)ri[0], i1 = (int)ri[1];
                    const bool t0 = (b0 > b1) || (b0 == b1 && i0 < i1); const float gb = t0 ? b0 : b1; const int gi = t0 ? i0 : i1; lv[t] = gb; li[t] = gi;
#pragma unroll
                    for (int r = 0; r < 16; ++r) if ((r & 3) + 8 * (r >> 2) + 4 * half == gi) v[r] = -__builtin_inff(); }
                if (half == 0) { const float e1 = __expf(lv[1] - lv[0]), e2 = __expf(lv[2] - lv[0]), e3 = __expf(lv[3] - lv[0]); const float inv = 1.f / (1.f + e1 + e2 + e3);
                    *(int4*)(TOPI + (size_t)tok * 4) = make_int4(li[0], li[1], li[2], li[3]); *(f32x4*)(TOPG + (size_t)tok * 4) = (f32x4){inv, e1 * inv, e2 * inv, e3 * inv}; RS1[tok] = rstd;
#pragma unroll
                    for (int t = 0; t < 4; ++t) (void)__hip_atomic_fetch_add(hist + li[t], 1, __ATOMIC_RELAXED, __HIP_MEMORY_SCOPE_WORKGROUP); }
            }
            __syncthreads();
        }
        if (tid < NE && LASTREP(PH_ROUTER)) atomicAdd(ctl + CW_CNT + tid, hist[tid]);
        __syncthreads();
    }
    SEAM(PH_ROUTER);
    if (IN(PH_ROUTE)) {
        PHASE_LANE;
        LAS int* sh = (LAS int*)lds;
        if (tid == 0) { int ps = 0, nt = 0;
            for (int e = 0; e < NE; ++e) { sh[e] = ps; const int t = (ctl[CW_CNT + e] + 255) >> 8; if (bx == 0) for (int q = 0; q < t; ++q) ctl[CW_TILE_E + nt + q] = e; nt += t; ps += t * 256; }
            sh[NE] = ps; if (bx == 0) ctl[CW_NTILES] = nt; }
        __syncthreads();
        for (int chunk = bx; chunk < MROWS / NTHREADS; chunk += G) {
            if (tid < NE) sh[64 + tid] = 0;
            __syncthreads();
            const int idx = chunk * NTHREADS + tid, e = TOPI[idx]; const int r = __hip_atomic_fetch_add(sh + 64 + e, 1, __ATOMIC_RELAXED, __HIP_MEMORY_SCOPE_WORKGROUP);
            __syncthreads();
            if (tid < NE) sh[128 + tid] = atomicAdd(ctl + CW_CURSOR + tid, sh[64 + tid]);
            __syncthreads();
            const int dest = sh[e] + sh[128 + e] + r; ROWTOK[dest] = idx >> 2; ROWSLOT[dest] = idx; ROWGATE[dest] = TOPG[idx]; ROWRS[dest] = RS1[idx >> 2];
            __syncthreads();
        }
        for (int e = bx; e < NE; e += G) { const int plo = sh[e] + ctl[CW_CNT + e], phi = sh[e + 1];
            for (int r = plo + tid; r < phi; r += NTHREADS) { ROWTOK[r] = 0; ROWSLOT[r] = MROWS; ROWGATE[r] = 0.f; ROWRS[r] = 0.f; } }
        __syncthreads();
    }
    SEAM(PH_ROUTE);
    if (IN(PH_MOE1)) REPLOOP(PH_MOE1) {
        pg8::Gemm g{X8, W1T, DM, DM, DM, ROWTOK, (size_t)2048 * DM}; pg8::StaticOrder S; S.init(ctl[CW_NTILES], 2048 / 256, G, bx, ctl + CW_TILE_E);
        pg8::EpiMoe1 E{(unsigned char*)HB, b1, ROWRS}; pg8::gemm_phase<pg8::EpiMoe1, true, true>(lds, g, S, E, wave, LASTREP(PH_MOE1));
    }
    SEAM(PH_MOE1);
    if (IN(PH_MOE2)) REPLOOP(PH_MOE2) {
        pg8::Gemm g{HB, W2T, DE, DE, DE, nullptr, (size_t)DM * DE}; pg8::StaticOrder S; S.init(ctl[CW_NTILES], DM / 256, G, bx, ctl + CW_TILE_E);
        pg8::EpiMoe2 E{Y, b2, ROWSLOT, ROWGATE}; pg8::gemm_phase<pg8::EpiMoe2, false, true>(lds, g, S, E, wave);
    }
    SEAM(PH_MOE2);
    if (IN(PH_COMBINE)) REPLOOP(PH_COMBINE) {
        PHASE_LANE;
        for (int row = gw * 2; row < NTOK; row += NGW * 2) {
            u32x4 hv[2][2], yv[2][4][2];
#pragma unroll
            for (int q = 0; q < 2; ++q)
#pragma unroll
                for (int j = 0; j < 2; ++j) { hv[q][j] = *(const u32x4*)(HBF + (size_t)(row + q) * DM + (lane + 64 * j) * 8);
#pragma unroll
                    for (int k = 0; k < 4; ++k) yv[q][k][j] = *(const u32x4*)(Y + ((size_t)(row + q) * 4 + k) * DM + (lane + 64 * j) * 8); }
#pragma unroll
            for (int q = 0; q < 2; ++q) { float ss = 0.f; u32x4 ov[2];
#pragma unroll
                for (int j = 0; j < 2; ++j) { f32x4 a = {blo(hv[q][j].x), bhi(hv[q][j].x), blo(hv[q][j].y), bhi(hv[q][j].y)}, b = {blo(hv[q][j].z), bhi(hv[q][j].z), blo(hv[q][j].w), bhi(hv[q][j].w)};
#pragma unroll
                    for (int k = 0; k < 4; ++k) { const u32x4 y = yv[q][k][j]; a += (f32x4){blo(y.x), bhi(y.x), blo(y.y), bhi(y.y)}; b += (f32x4){blo(y.z), bhi(y.z), blo(y.w), bhi(y.w)}; }
                    ss += pg8::sq4(a) + pg8::sq4(b); ov[j] = pg8::pack8(a, b); }
                ss = wave_sum(ss);
                bf16_t* ho = LASTREP(PH_COMBINE) ? HBF : (bf16_t*)(ws + WS_HB);
#pragma unroll
                for (int j = 0; j < 2; ++j) *(u32x4*)(ho + (size_t)(row + q) * DM + (lane + 64 * j) * 8) = ov[j];
                if (lane == 0) RS2[row + q] = rsqrtf(ss * (1.f / DM) + EPS); }
        }
    }
    SEAM(PH_COMBINE);
    if (IN(PH_PLE)) REPLOOP(PH_PLE) {
        pg8::Gemm g{HBF, WG, DM, DM, DM, nullptr, 0}; pg8::StaticOrder S; S.init(NTOK / 256, DM / 256, G, bx, nullptr);
        pg8::EpiPle E{HBF, H3, PLER, PSSQ, RS2, ple_post_norm, FSSQ}; pg8::gemm_phase<pg8::EpiPle, false>(lds, g, S, E, wave);
    }
    SEAM(PH_PLE);
    if (IN(PH_FINAL)) REPLOOP(PH_FINAL) {
        PHASE_LANE;
        for (int row = gw * 2; row < NTOK; row += NGW * 2) {
            u32x4 hv[2][2]; float sp[2];
#pragma unroll
            for (int q = 0; q < 2; ++q) { sp[q] = lane < 16 ? FSSQ[(size_t)(row + q) * 16 + lane] : 0.f;
#pragma unroll
                for (int j = 0; j < 2; ++j) hv[q][j] = *(const u32x4*)(H3 + (size_t)(row + q) * DM + (lane + 64 * j) * 8); }
#pragma unroll
            for (int q = 0; q < 2; ++q) { float s = sp[q]; s += __shfl_xor(s, 1); s += __shfl_xor(s, 2); s += __shfl_xor(s, 4); s += __shfl_xor(s, 8);
                const float rstd = rsqrtf(__shfl(s, 0) * (1.f / DM) + EPS); float* ho = (LASTREP(PH_FINAL) ? H : (float*)(ws + WS_HB)) + (size_t)(row + q) * DM;
#pragma unroll
                for (int j = 0; j < 2; ++j) { const int c = (lane + 64 * j) * 8; const f32x4 g0 = *(const f32x4*)(final_norm + c), g1 = *(const f32x4*)(final_norm + c + 4); const u32x4 v = hv[q][j];
                    *(f32x4*)(ho + c) = (f32x4){blo(v.x), bhi(v.x), blo(v.y), bhi(v.y)} * rstd * g0; *(f32x4*)(ho + c + 4) = (f32x4){blo(v.z), bhi(v.z), blo(v.w), bhi(v.w)} * rstd * g1; } }
        }
    }
#undef IN
#undef NREP
#undef REPLOOP
#undef LASTREP
#undef SEAM
}
#ifndef NAIVE_MASK
#define NAIVE_MASK 0u
#endif
static int g_grid = 0;
static void launch_fwd(Args a, int lo, int hi, int li, hipStream_t st) {
    a.ph_lo = lo; a.ph_hi = hi; a.li = li;
    if (hi - lo > 1) { void* p[] = {&a}; hipError_t e = hipLaunchCooperativeKernel((const void*)fwd, dim3(g_grid), dim3(NTHREADS), p, LDS_BYTES, st);
        if (e != hipSuccess) fprintf(stderr, "cooperative launch failed: %s (grid %d)\n", hipGetErrorString(e), g_grid); }
    else hipLaunchKernelGGL(fwd, dim3(g_grid), dim3(NTHREADS), LDS_BYTES, st, a);
}
extern "C" void kernel_launch(void* const* d_in, const int* in_sizes, int n_in, void* d_out, int out_size, void* d_ws, size_t ws_size, hipStream_t stream) {
    if (n_in != 25 || in_sizes[0] != NTOK * DM || out_size != NTOK * DM || ws_size < WS_END) {
        fprintf(stderr, "kernel_launch: unexpected shapes (n_in %d, in0 %d, out %d, ws %zu need %zu)\n", n_in, n_in > 0 ? in_sizes[0] : -1, out_size, ws_size, (size_t)WS_END); return; }
    if (g_grid == 0) {
        int dev = 0, cus = 0, per_cu = 0; (void)hipGetDevice(&dev); (void)hipDeviceGetAttribute(&cus, hipDeviceAttributeMultiprocessorCount, dev);
        if (hipFuncSetAttribute((const void*)fwd, hipFuncAttributeMaxDynamicSharedMemorySize, LDS_BYTES) != hipSuccess) fprintf(stderr, "hipFuncSetAttribute failed\n");
        if (hipOccupancyMaxActiveBlocksPerMultiprocessor(&per_cu, (const void*)fwd, NTHREADS, LDS_BYTES) != hipSuccess || per_cu < 1) { fprintf(stderr, "occupancy query: %d\n", per_cu); per_cu = 1; }
        (void)hipGetLastError();
        g_grid = cus > 0 ? cus : 256;
    }
    const float* x = (const float*)d_in[0];
    const float *conv_w = (const float*)d_in[9], *b_router = (const float*)d_in[15], *final_norm = (const float*)d_in[24];
    unsigned char* ws = (unsigned char*)d_ws; float* H = (float*)d_out;
    int* ctl = (int*)(ws + WS_CTL);
    bf16_t *XN = (bf16_t*)(ws + WS_XN), *MIX = (bf16_t*)(ws + WS_MIX);
    bf16_t *Z = (bf16_t*)(ws + WS_Z), *Q = (bf16_t*)(ws + WS_Q), *K = (bf16_t*)(ws + WS_K), *V = (bf16_t*)(ws + WS_V), *Y = (bf16_t*)(ws + WS_Y);
    float *WR = (float*)(ws + WS_WR), *CS = (float*)(ws + WS_CS), *ASSQ = (float*)(ws + WS_ASSQ);
    int *TOPI = (int*)(ws + WS_TOPI), *ROWTOK = (int*)(ws + WS_ROWTOK), *ROWSLOT = (int*)(ws + WS_ROWSLOT); float *TOPG = (float*)(ws + WS_TOPG), *ROWGATE = (float*)(ws + WS_ROWGATE);
    (void)hipMemsetAsync(ws + WS_CTL, 0, 1 * MiB, stream);
    Args a{}; for (int i = 0; i < 25; ++i) a.in[i] = d_in[i]; a.out = H; a.ws = ws;
#define GRID1(n) dim3((unsigned)(((size_t)(n) + 255) / 256))
    const unsigned NAIVE = NAIVE_MASK;
    a.skip = (NAIVE & 1u) ? 1 : 0;
    int li = 0, lo = 0;
    for (int k = 0; k <= PH_COUNT; ++k) {
        const bool nv = k < PH_COUNT && ((k == PH_ATTN && (NAIVE & 2u)) || (k == PH_ROUTER && (NAIVE & 4u)) || (k == PH_ROUTE && (NAIVE & 8u)) || (k == PH_COMBINE && (NAIVE & 16u)) || (k == PH_FINAL && (NAIVE & 32u)));
        const bool pre = (k == PH_TOKLOCAL && (NAIVE & 1u));
        if (k == PH_COUNT || nv || pre) { if (k > lo) launch_fwd(a, lo, k, li++, stream); lo = nv ? k + 1 : k; }
        if (pre) { k_kpe<<<GRID1(NTOK * 32), 256, 0, stream>>>(Z, CS, K); k_conv<<<NTOK / 4, 256, 0, stream>>>(Z, conv_w, MIX); }
        if (!nv) continue;
        if (k == PH_ATTN) k_attn_naive<<<NB * NH * SEQ / 4, 256, 0, stream>>>(Q, K, V, MIX, ASSQ);
        if (k == PH_ROUTER) k_router<<<NTOK / 4, 256, 0, stream>>>(H, WR, b_router, XN, TOPI, TOPG, ctl + CW_CNT);
        if (k == PH_ROUTE) { k_route_plan<<<1, 64, 0, stream>>>(ctl); k_route_assign<<<GRID1(MROWS), 256, 0, stream>>>(TOPI, TOPG, ctl, ROWTOK, ROWSLOT, ROWGATE); k_route_fill<<<NE, 256, 0, stream>>>(ctl, ROWTOK, ROWSLOT, ROWGATE); }
        if (k == PH_COMBINE) k_combine<<<NTOK / 4, 256, 0, stream>>>(H, Y, XN);
        if (k == PH_FINAL) k_final<<<NTOK / 4, 256, 0, stream>>>(H, final_norm);
    }
#undef GRID1
}
```

```cpp
#include <hip/hip_runtime.h>
#include <cstdint>
#include <cstdio>
#include <cmath>

typedef unsigned short bf16_t;

constexpr int NB = 8, SEQ = 4096, DM = 1024, NTOK = NB * SEQ;
constexpr int PLE = 256, NH = 4, DN = 128, DR = 64, DV = 128, QL = 256, KVL = 128, DQK = DN + DR;
constexpr int INW = 1984, INWP = 2048;
constexpr int NE = 32, TOPK = 4, DE = 1024;
constexpr int MROWS = NTOK * TOPK;
constexpr int MAXTILES = MROWS / 256 + NE;
constexpr int PROWS = MAXTILES * 256;
constexpr float EPS = 1e-6f;
constexpr float QSCALE = 0.07216878364870322f * 1.4426950408889634f;

constexpr size_t MiB = 1u << 20;
constexpr size_t WS_CTL = 0;
constexpr size_t WS_WIN = 1 * MiB, WS_WUQ = 5 * MiB, WS_WUKV = 5 * MiB + 512 * 1024, WS_WO = 6 * MiB, WS_WG = 8 * MiB, WS_WP = 10 * MiB;
constexpr size_t WS_WR = 10 * MiB + 512 * 1024;
constexpr size_t WS_CS = 11 * MiB;
constexpr size_t WS_SSQ = 19 * MiB, WS_ASSQ = 20 * MiB, WS_PSSQ = 21 * MiB, WS_FSSQ = 23 * MiB;
constexpr size_t WS_TOPI = 25 * MiB, WS_TOPG = 25 * MiB + 512 * 1024;
constexpr size_t WS_ROWTOK = 26 * MiB, WS_ROWSLOT = 27 * MiB, WS_ROWGATE = 28 * MiB;
constexpr size_t WS_P16 = 29 * MiB;
constexpr size_t WS_SSQ1 = 45 * MiB, WS_RS1 = 47 * MiB, WS_RS2 = 47 * MiB + 128 * 1024, WS_ROWRS = 47 * MiB + 384 * 1024;
constexpr size_t WS_WRHL = 10 * MiB + 768 * 1024;
constexpr size_t WS_HBF = 112 * MiB;
constexpr size_t WS_H3 = 304 * MiB;
constexpr size_t WS_W1 = 48 * MiB, WS_W2 = 176 * MiB, WS_XN = 240 * MiB, WS_MIX = 304 * MiB, WS_PLER = 368 * MiB;
constexpr size_t WS_Z = 432 * MiB, WS_Q = 560 * MiB, WS_K = 608 * MiB, WS_V = 656 * MiB;
constexpr size_t WS_HB = 432 * MiB;
constexpr size_t WS_Y = 704 * MiB;
constexpr size_t WS_END = WS_Y + (size_t)(MROWS + 256) * DM * 2;
constexpr int CW_CNT = 0, CW_CURSOR = 64, CW_PADSTART = 128, CW_NTILES = 192, CW_TILE_E = 256;

__device__ __forceinline__ float bf2f(bf16_t v) { return __uint_as_float((unsigned)v << 16); }
__device__ __forceinline__ float blo(unsigned u) { return __uint_as_float(u << 16); }
__device__ __forceinline__ float bhi(unsigned u) { return __uint_as_float(u & 0xffff0000u); }
__device__ __forceinline__ bf16_t f2bf(float f) { unsigned u = __float_as_uint(f); return (bf16_t)((u + 0x7fffu + ((u >> 16) & 1u)) >> 16); }
__device__ __forceinline__ unsigned pk2(float lo, float hi) { return (unsigned)f2bf(lo) | ((unsigned)f2bf(hi) << 16); }
__device__ __forceinline__ float wave_sum(float v) {
#pragma unroll
    for (int o = 1; o < 64; o <<= 1) v += __shfl_xor(v, o);
    return v;
}
__device__ __forceinline__ float wave_max(float v) {
#pragma unroll
    for (int o = 1; o < 64; o <<= 1) v = fmaxf(v, __shfl_xor(v, o));
    return v;
}
__device__ __forceinline__ float dot8(uint4 x, uint4 y) {
    return blo(x.x) * blo(y.x) + bhi(x.x) * bhi(y.x) + blo(x.y) * blo(y.y) + bhi(x.y) * bhi(y.y) +
           blo(x.z) * blo(y.z) + bhi(x.z) * bhi(y.z) + blo(x.w) * blo(y.w) + bhi(x.w) * bhi(y.w);
}
__device__ __forceinline__ float dot_bf16(const bf16_t* a, const bf16_t* b, int K) {
    const uint4* a4 = (const uint4*)a; const uint4* b4 = (const uint4*)b; float acc = 0.f;
    for (int i = 0; i < K / 8; ++i) acc += dot8(a4[i], b4[i]);
    return acc;
}

#define LAS __attribute__((address_space(3)))
#define GAS __attribute__((address_space(1)))
typedef short bf16x8 __attribute__((ext_vector_type(8)));
typedef float f32x4 __attribute__((ext_vector_type(4)));
typedef float f32x2 __attribute__((ext_vector_type(2)));
typedef unsigned u32x4 __attribute__((ext_vector_type(4)));
typedef unsigned u32x2 __attribute__((ext_vector_type(2)));
#ifndef PROBE_PH
#define PROBE_PH (-1)
#define PROBE_REP 1
#endif
#ifndef MOE2_DELAY_TICKS
#define MOE2_DELAY_TICKS 700ull
#endif
constexpr int NWAVES = 8, NTHREADS = 512;
constexpr int RING_BYTES = 131072, MISC_OFF = RING_BYTES, HIST_OFF = MISC_OFF + 256, LDS_BYTES = 163840;
constexpr int CW_BAR = 4096;
__device__ __forceinline__ unsigned cvt_pk_bf16(float lo, float hi) { unsigned r; asm volatile("v_cvt_pk_bf16_f32 %0, %1, %2" : "=v"(r) : "v"(lo), "v"(hi)); return r; }
__device__ __forceinline__ int lane_id() { int l = (int)__builtin_amdgcn_mbcnt_hi(~0u, __builtin_amdgcn_mbcnt_lo(~0u, 0u)); asm volatile("" : "+v"(l)); return l; }
__device__ __forceinline__ float fast_sigmoid(float a) { return __builtin_amdgcn_rcpf(1.f + __expf(-a)); }

#define XB_TMO      128
#define XB_XCNT(j)  (256  + 64 * (j))
#define XB_XSUB(j)  (1280 + 64 * (j))
#define XB_XGEN(j)  (2304 + 64 * (j))
#define XB_TOP      3328
#define XB_TOPGEN   3392
#define XCD_BAR_WORDS 3456
#define XB_SPIN_CAP (1u << 20)
__device__ __forceinline__ unsigned xb_ld(unsigned* p)              { return __hip_atomic_load(p, __ATOMIC_RELAXED, __HIP_MEMORY_SCOPE_AGENT); }
__device__ __forceinline__ unsigned xb_add(unsigned* p, unsigned v) { return __hip_atomic_fetch_add(p, v, __ATOMIC_RELAXED, __HIP_MEMORY_SCOPE_AGENT); }
__device__ __forceinline__ unsigned xb_xcc_id() { return (unsigned)__builtin_amdgcn_s_getreg((3 << 11) | 20) & 0xFu; }
#define XB_SPIN(cond, bar) do { unsigned _sp = 0; while (cond) { __builtin_amdgcn_s_sleep(1); \
    if ((++_sp & 255u) == 0u) { if (xb_ld(&(bar)[XB_TMO])) break; if (_sp > XB_SPIN_CAP) { atomicAdd(&(bar)[XB_TMO], 1u); break; } } } } while (0)
struct XcdBarrier { unsigned* bar; unsigned x; volatile LAS unsigned* st; };
__device__ __forceinline__ XcdBarrier xcd_barrier_post(unsigned* bar, volatile LAS unsigned* st, int wave) {
    XcdBarrier b; b.bar = bar; b.x = xb_xcc_id(); b.st = st;
    if (wave == 0 && lane_id() == 0) (void)xb_add(&bar[XB_XCNT(b.x)], 1u);
    return b;
}
__device__ __forceinline__ void xcd_barrier_complete(unsigned* bar, unsigned x, unsigned& nloc, unsigned& nx) {
    const unsigned G = gridDim.x * gridDim.y * gridDim.z;
    unsigned sum, cnt, mine, sp = 0u;
    for (;;) {
        sum = 0u; cnt = 0u; mine = 0u;
#pragma unroll
        for (unsigned j = 0; j < 16; ++j) { const unsigned c = xb_ld(&bar[XB_XCNT(j)]); sum += c; cnt += (c > 0u) ? 1u : 0u; mine = (j == x) ? c : mine; }
        if (sum == G) break;
        __builtin_amdgcn_s_sleep(1);
        if ((++sp & 255u) == 0u) { if (xb_ld(&bar[XB_TMO])) break; if (sp > XB_SPIN_CAP) { atomicAdd(&bar[XB_TMO], 1u); break; } }
    }
    nloc = mine > 0u ? mine : 1u; nx = cnt > 0u ? cnt : 1u;
}
__device__ __forceinline__ void xcd_barrier(const XcdBarrier& b, int wave) {
    asm volatile("s_waitcnt vmcnt(0)" ::: "memory");
    __syncthreads();
    if (wave == 0 && lane_id() == 0) {
        unsigned* bar = b.bar;
        __builtin_amdgcn_s_waitcnt(0);
        unsigned nloc = b.st[0], nx = b.st[1];
        if (nloc == 0u) { xcd_barrier_complete(bar, b.x, nloc, nx); b.st[0] = nloc; b.st[1] = nx; }
        const unsigned old = xb_add(&bar[XB_XSUB(b.x)], 1u);
        const unsigned gen = old / nloc;
        if (old + 1u == (gen + 1u) * nloc) {
            __builtin_amdgcn_fence(__ATOMIC_RELEASE, "agent");
            asm volatile("s_waitcnt vmcnt(0)" ::: "memory");
            const unsigned og = xb_add(&bar[XB_TOP], 1u);
            const unsigned tg = og / nx;
            if (og + 1u == (tg + 1u) * nx) xb_add(&bar[XB_TOPGEN], 1u);
            else XB_SPIN(xb_ld(&bar[XB_TOPGEN]) == tg, bar);
            __builtin_amdgcn_fence(__ATOMIC_ACQUIRE, "agent");
            xb_add(&bar[XB_XGEN(b.x)], 1u);
            asm volatile("s_waitcnt vmcnt(0)" ::: "memory");
        } else {
            XB_SPIN(xb_ld(&bar[XB_XGEN(b.x)]) == gen, bar);
            __builtin_amdgcn_fence(__ATOMIC_ACQUIRE, "agent");
            asm volatile("s_waitcnt vmcnt(0)" ::: "memory");
        }
    }
    __syncthreads();
}

namespace pg8 {
constexpr int BM = 256, BK = 64, HALF = 128, HTB = HALF * BK * 2, STAGE_BYTES = 8 * HTB, NXCD = 8, WGM = 8;
__host__ __device__ __forceinline__ int lds_byte(int r, int c) { const int st = (r >> 4) * 2 + (c >> 5), rr = r & 15, cc = c & 31, ob = rr * 64 + cc * 2; return st * 1024 + (ob ^ (((ob >> 9) & 1) << 5)); }
__host__ __device__ __forceinline__ void stage_rc(int b, int& R, int& C) { const int st = b / 1024, sb = b % 1024, swz = sb ^ (((sb >> 9) & 1) << 5); R = (st >> 1) * 16 + swz / 64; C = (st & 1) * 32 + (swz % 64) / 2; }
__host__ __device__ __forceinline__ int perm32(int rho) { const int n = rho >> 4, i = rho & 15; return 8 * (i >> 2) + 4 * n + (i & 3); }
struct Unit { int pm, pn, e; };
struct Gemm { const void* A; const void* Bt; int K, lda, ldb; const int* rowidx; size_t bstride; };
struct StaticOrder {
    int nM, nN, nwg, G, c; const int* tile_e;
    __device__ void init(int nM_, int nN_, int G_, int c_, const int* te) { nM = nM_; nN = nN_; nwg = nM * nN; G = G_; c = c_; tile_e = te; }
    __device__ bool next(int i, Unit& u) const {
        const long L = (long)i * G + c; if (L >= nwg) return false;
        int wgid = (int)L; { const int q = nwg / NXCD, r = nwg % NXCD, xcd = wgid % NXCD, off = wgid / NXCD; wgid = (xcd < r ? xcd * (q + 1) : r * (q + 1) + (xcd - r) * q) + off; }
        const int nig = WGM * nN, gid = wgid / nig, fm = gid * WGM, gsz = (nM - fm) < WGM ? (nM - fm) : WGM;
        u.pm = fm + ((wgid % nig) % gsz); u.pn = (wgid % nig) / gsz; u.e = tile_e ? tile_e[u.pm] : 0; return true;
    }
};
typedef f32x4 Acc[2][2][4][2];
typedef int v8i_t __attribute__((ext_vector_type(8)));
typedef int v4i_t __attribute__((ext_vector_type(4)));
template <class Epi, bool GATHER, bool FP8 = false>
__device__ __forceinline__ void gemm_phase(LAS unsigned char* lds, const Gemm g, const StaticOrder& S, const Epi& E, const int wid, const bool do_epi = true) {
    const int lane = lane_id(), tid = wid * 64 + lane, wr = wid >> 2, wc = wid & 3, fr = lane & 15, fq = lane >> 4;
    constexpr int ES = FP8 ? 1 : 2;
    const int K = g.K, nt = K * ES / 128;
    int RA[2], CA[2]; unsigned voffB[2], voffA[2];
#pragma unroll
    for (int i = 0; i < 2; ++i) { int R, C; stage_rc(tid * 16 + i * 8192, R, C); const int Rb = Epi::PERM ? ((R & ~31) + perm32(R & 31)) : R;
        RA[i] = R; CA[i] = C; voffB[i] = (unsigned)(Rb * g.ldb * ES + C * 2); voffA[i] = (unsigned)(R * g.lda * ES + C * 2); }
    const size_t hstepA = GATHER ? 0 : (size_t)HALF * g.lda * ES;
    const size_t kstep = (size_t)(BK * 2);
    const size_t hstepB = (size_t)HALF * g.ldb * ES;
    const unsigned ldsw = (unsigned)wid * 1024u;
    const int aoff = lds_byte(wr * 64 + fr, fq * 8), boff = lds_byte(wc * 32 + fr, fq * 8);
#define PG8_SA(b, h) (((b) * 2 + (h)) * HTB)
#define PG8_SB(b, h) ((4 + (b) * 2 + (h)) * HTB)
#define PG8_STAGE(bufoff, gbase, voff) do { _Pragma("unroll") for (int _i = 0; _i < 2; ++_i) \
        __builtin_amdgcn_global_load_lds((const unsigned*)((const char*)(gbase) + (voff)[_i]), (LAS unsigned*)(lds + (bufoff) + ldsw + _i * 8192), 16, 0, 0); } while (0)
#define PG8_LDA(dst, b, h) do { _Pragma("unroll") for (int m = 0; m < 4; ++m) _Pragma("unroll") for (int k = 0; k < 2; ++k) dst[m][k] = *(const LAS bf16x8*)(lds + PG8_SA(b, h) + aoff + m * 2048 + k * 1024); } while (0)
#define PG8_LDB(dst, b, h) do { _Pragma("unroll") for (int n = 0; n < 2; ++n) _Pragma("unroll") for (int k = 0; k < 2; ++k) dst[n][k] = *(const LAS bf16x8*)(lds + PG8_SB(b, h) + boff + n * 2048 + k * 1024); } while (0)
#define PG8_CAT8(x) __builtin_shufflevector(__builtin_bit_cast(v4i_t, (x)[0]), __builtin_bit_cast(v4i_t, (x)[1]), 0, 1, 2, 3, 4, 5, 6, 7)
#define PG8_MMA(ai, bj, At, Bt) do { __builtin_amdgcn_s_setprio(1); if constexpr (FP8) { _Pragma("unroll") for (int m = 0; m < 4; ++m) _Pragma("unroll") for (int n = 0; n < 2; ++n) \
        acc[ai][bj][m][n] = __builtin_amdgcn_mfma_scale_f32_16x16x128_f8f6f4(PG8_CAT8(Bt[n]), PG8_CAT8(At[m]), acc[ai][bj][m][n], 0, 0, 0, 0x7f7f7f7f, 0, 0x7f7f7f7f); \
        _Pragma("unroll") for (int m = 0; m < 4; ++m) _Pragma("unroll") for (int n = 0; n < 2; ++n) asm volatile("" : "+v"(acc[ai][bj][m][n]));   } else { \
        _Pragma("unroll") for (int m = 0; m < 4; ++m) _Pragma("unroll") for (int n = 0; n < 2; ++n) _Pragma("unroll") for (int k = 0; k < 2; ++k) \
        acc[ai][bj][m][n] = __builtin_amdgcn_mfma_f32_16x16x32_bf16(Bt[n][k], At[m][k], acc[ai][bj][m][n], 0, 0, 0); } __builtin_amdgcn_s_setprio(0); } while (0)
#define PG8_WAIT_V(n) asm volatile("s_waitcnt vmcnt(" #n ")" ::: "memory")
#define PG8_WAIT_L(n) asm volatile("s_waitcnt lgkmcnt(" #n ")" ::: "memory")
#define PG8_BAR __builtin_amdgcn_s_barrier()
#define PG8_SCHED __builtin_amdgcn_sched_barrier(0)
#define PG8_SETVO(vo, u) do { if constexpr (GATHER) { _Pragma("unroll") for (int _h = 0; _h < 2; ++_h) _Pragma("unroll") for (int _i = 0; _i < 2; ++_i) { \
        const int _row = g.rowidx[(u).pm * BM + _h * HALF + RA[_i]]; (vo)[_h][_i] = (unsigned)_row * (unsigned)(g.lda * ES) + (unsigned)CA[_i] * 2u; } } } while (0)
#define PG8_STAGE_A(bufoff, base, h, vog) do { if constexpr (GATHER) { PG8_STAGE(bufoff, base, (vog)[h]); } else { PG8_STAGE(bufoff, (base) + (h) * hstepA, voffA); } } while (0)
    Unit cur, nxt; int ui = 0;
    if (!S.next(0, cur)) return;
    Acc acc;
#pragma unroll
    for (int a = 0; a < 2; ++a)
#pragma unroll
        for (int b = 0; b < 2; ++b)
#pragma unroll
            for (int m = 0; m < 4; ++m)
#pragma unroll
                for (int n = 0; n < 2; ++n) acc[a][b][m][n] = (f32x4){0.f, 0.f, 0.f, 0.f};
    bf16x8 At[4][2], B0[2][2], B1[2][2];
    unsigned voC[2][2], voN[2][2];
    PG8_SETVO(voC, cur);
    const char* const Ab = (const char*)g.A;
    const char* cA = GATHER ? Ab : Ab + (size_t)cur.pm * 2 * hstepA;
    const char* cB = (const char*)g.Bt + (size_t)cur.e * g.bstride + (size_t)cur.pn * 2 * hstepB;
    PG8_STAGE(PG8_SB(0, 0), cB, voffB); PG8_STAGE(PG8_SB(0, 1), cB + hstepB, voffB); PG8_STAGE_A(PG8_SA(0, 0), cA, 0, voC); PG8_STAGE_A(PG8_SA(0, 1), cA, 1, voC);
    if (wr == 1) PG8_BAR;
    PG8_WAIT_V(2); PG8_BAR;
    PG8_STAGE(PG8_SB(1, 0), cB + kstep, voffB); PG8_STAGE_A(PG8_SA(1, 0), cA + kstep, 0, voC); PG8_STAGE(PG8_SB(1, 1), cB + hstepB + kstep, voffB);
    PG8_WAIT_V(6); PG8_BAR;
    for (;;) {
        const bool has_next = S.next(ui + 1, nxt);
        const char* nB = has_next ? (const char*)g.Bt + (size_t)nxt.e * g.bstride + (size_t)nxt.pn * 2 * hstepB : cB;
        const char* nA = (has_next && !GATHER) ? Ab + (size_t)nxt.pm * 2 * hstepA : cA;
        if constexpr (GATHER) { if (has_next) { PG8_SETVO(voN, nxt); } else {
#pragma unroll
            for (int h = 0; h < 2; ++h)
#pragma unroll
                for (int i = 0; i < 2; ++i) voN[h][i] = voC[h][i]; } }
        for (int t = 0; t < nt; t += 2) {
            const bool last = (t == nt - 2);
            if constexpr (Epi::MIDK > 0) { if (t == Epi::MIDK) { const int l2 = lane_id(); E.mid(acc, cur, wr, wc, l2 & 15, l2 >> 4); } }
            const char* a1 = cA + (size_t)(t + 1) * kstep;
            const char* a2 = last ? nA : cA + (size_t)(t + 2) * kstep; const char* b2 = last ? nB : cB + (size_t)(t + 2) * kstep;
            const char* a3 = a2 + kstep; const char* b3 = b2 + kstep;
            unsigned o2[2][2];
            if constexpr (GATHER) {
#pragma unroll
            for (int h = 0; h < 2; ++h)
#pragma unroll
                for (int i = 0; i < 2; ++i) o2[h][i] = last ? voN[h][i] : voC[h][i]; }
            PG8_LDB(B0, 0, 0); PG8_LDB(B1, 0, 1); PG8_SCHED; PG8_LDA(At, 0, 0); PG8_STAGE_A(PG8_SA(1, 1), a1, 1, voC);
            PG8_WAIT_V(8); PG8_WAIT_L(0); PG8_BAR; PG8_MMA(0, 0, At, B0); PG8_MMA(0, 1, At, B1); PG8_BAR; PG8_SCHED;
            PG8_LDA(At, 0, 1); PG8_STAGE(PG8_SB(0, 0), b2, voffB); PG8_STAGE(PG8_SB(0, 1), b2 + hstepB, voffB); PG8_STAGE_A(PG8_SA(0, 0), a2, 0, o2);
            PG8_WAIT_V(8); PG8_WAIT_L(0); PG8_BAR; PG8_MMA(1, 0, At, B0); PG8_MMA(1, 1, At, B1); PG8_BAR; PG8_SCHED;
            PG8_LDB(B0, 1, 0); PG8_LDB(B1, 1, 1); PG8_SCHED; PG8_LDA(At, 1, 0); PG8_STAGE_A(PG8_SA(0, 1), a2, 1, o2);
            PG8_WAIT_V(8); PG8_WAIT_L(0); PG8_BAR; PG8_MMA(0, 0, At, B0); PG8_MMA(0, 1, At, B1); PG8_BAR; PG8_SCHED;
            PG8_LDA(At, 1, 1); PG8_STAGE(PG8_SB(1, 0), b3, voffB); PG8_STAGE(PG8_SB(1, 1), b3 + hstepB, voffB); PG8_STAGE_A(PG8_SA(1, 0), a3, 0, o2);
            PG8_WAIT_V(8); PG8_WAIT_L(0); PG8_BAR; PG8_MMA(1, 0, At, B0); PG8_MMA(1, 1, At, B1); PG8_BAR; PG8_SCHED;
        }
        if (wr == 0) PG8_BAR;
        if (do_epi) { const int l2 = lane_id(); E(acc, cur, wr, wc, l2 & 15, l2 >> 4); }
        if (!has_next) break;
#pragma unroll
        for (int a = 0; a < 2; ++a)
#pragma unroll
            for (int b = 0; b < 2; ++b)
#pragma unroll
                for (int m = 0; m < 4; ++m)
#pragma unroll
                    for (int n = 0; n < 2; ++n) acc[a][b][m][n] = (f32x4){0.f, 0.f, 0.f, 0.f};
        cur = nxt; cB = nB; cA = nA; ++ui;
        if constexpr (GATHER) {
#pragma unroll
        for (int h = 0; h < 2; ++h)
#pragma unroll
            for (int i = 0; i < 2; ++i) voC[h][i] = voN[h][i]; }
        if (wr == 1) PG8_BAR;
    }
    PG8_WAIT_V(0);
    PG8_BAR;
#undef PG8_SA
#undef PG8_SB
#undef PG8_STAGE
#undef PG8_LDA
#undef PG8_LDB
#undef PG8_MMA
#undef PG8_CAT8
#undef PG8_WAIT_V
#undef PG8_WAIT_L
#undef PG8_BAR
#undef PG8_SCHED
#undef PG8_SETVO
#undef PG8_STAGE_A
}

__device__ __forceinline__ unsigned pk4_fp8(f32x4 v) { unsigned w = 0; w = __builtin_amdgcn_cvt_pk_fp8_f32(v[0], v[1], w, false); w = __builtin_amdgcn_cvt_pk_fp8_f32(v[2], v[3], w, true); return w; }
__device__ __forceinline__ float sq4(f32x4 v) { return (v[0] * v[0] + v[1] * v[1]) + (v[2] * v[2] + v[3] * v[3]); }
__device__ __forceinline__ float red_fq(float s) { s += __shfl_xor(s, 16); s += __shfl_xor(s, 32); return s; }
__device__ __forceinline__ u32x4 pack8(f32x4 a, f32x4 b) { u32x4 w; w.x = cvt_pk_bf16(a[0], a[1]); w.y = cvt_pk_bf16(a[2], a[3]); w.z = cvt_pk_bf16(b[0], b[1]); w.w = cvt_pk_bf16(b[2], b[3]); return w; }
template <int MODE> struct EpiBf16Stats {
    static constexpr bool PERM = true; static constexpr int MIDK = 0;
    bf16_t* O; int ldc; float* ssq;
    __device__ __forceinline__ void operator()(const Acc& acc, const Unit& u, int wr, int wc, int fr, int fq) const {
        const int row0 = u.pm * BM + wr * 64 + fr, col0 = u.pn * BM + wc * 32 + 8 * fq;
#pragma unroll
        for (int ai = 0; ai < 2; ++ai)
#pragma unroll
            for (int m = 0; m < 4; ++m) { const int row = row0 + ai * HALF + m * 16; bf16_t* rowp = O + (size_t)row * ldc + col0;
#pragma unroll
                for (int bj = 0; bj < 2; ++bj) *(u32x4*)(rowp + bj * HALF) = pack8(acc[ai][bj][m][0], acc[ai][bj][m][1]);
                if (MODE == 1) { float s = (sq4(acc[ai][0][m][0]) + sq4(acc[ai][0][m][1])) + (sq4(acc[ai][1][m][0]) + sq4(acc[ai][1][m][1])); s = red_fq(s); if (fq == 0) ssq[(size_t)row * 16 + u.pn * 4 + wc] = s; }
                else if (u.pn == 0) { float s = (sq4(acc[ai][0][m][0]) + sq4(acc[ai][0][m][1])) + (sq4(acc[ai][1][m][0]) + sq4(acc[ai][1][m][1])); s = red_fq(s); if (fq == 0) ssq[(size_t)row * 8 + wc] = s; }
                else if (u.pn == 1) { float s = sq4(acc[ai][0][m][0]) + sq4(acc[ai][0][m][1]); s = red_fq(s); if (fq == 0) ssq[(size_t)row * 8 + 4 + wc] = s; } }
    }
};
struct EpiQ {
    static constexpr bool PERM = true; static constexpr int MIDK = 0;
    bf16_t* Q; const float* ssq; const float* cs;
    __device__ __forceinline__ void operator()(const Acc& acc, const Unit& u, int wr, int wc, int fr, int fq) const {
        const int row0 = u.pm * BM + wr * 64 + fr;
#pragma unroll
        for (int ai = 0; ai < 2; ++ai)
#pragma unroll
            for (int m = 0; m < 4; ++m) { const int row = row0 + ai * HALF + m * 16; const f32x4 sv = *(const f32x4*)(ssq + (size_t)row * 8);
                const float rs = rsqrtf(((sv[0] + sv[1]) + (sv[2] + sv[3])) * (1.f / QL) + EPS); const int b = row / SEQ, s = row % SEQ;
#pragma unroll
                for (int bj = 0; bj < 2; ++bj) { const int cv = u.pn * BM + bj * HALF + wc * 32 + 8 * fq; const int h = cv / DQK, d = cv % DQK;
                    f32x4 v0 = acc[ai][bj][m][0] * rs, v1 = acc[ai][bj][m][1] * rs;
                    if (d >= DN) { const int i0 = (d - DN) >> 1; const f32x4 c = *(const f32x4*)(cs + (size_t)row * 64 + i0), sn = *(const f32x4*)(cs + (size_t)row * 64 + 32 + i0);
                        const f32x4 r0 = {v0[0] * c[0] - v0[1] * sn[0], v0[0] * sn[0] + v0[1] * c[0], v0[2] * c[1] - v0[3] * sn[1], v0[2] * sn[1] + v0[3] * c[1]};
                        const f32x4 r1 = {v1[0] * c[2] - v1[1] * sn[2], v1[0] * sn[2] + v1[1] * c[2], v1[2] * c[3] - v1[3] * sn[3], v1[2] * sn[3] + v1[3] * c[3]};
                        v0 = r0; v1 = r1; }
                    *(u32x4*)(Q + ((size_t)(b * NH + h) * SEQ + s) * DQK + d) = pack8(v0, v1); } }
    }
};
struct EpiKV {
    static constexpr bool PERM = true; static constexpr int MIDK = 0;
    bf16_t* Kc; bf16_t* Vc; const float* ssq;
    __device__ __forceinline__ void operator()(const Acc& acc, const Unit& u, int wr, int wc, int fr, int fq) const {
        const int row0 = u.pm * BM + wr * 64 + fr, d = wc * 32 + 8 * fq, h = u.pn;
#pragma unroll
        for (int ai = 0; ai < 2; ++ai)
#pragma unroll
            for (int m = 0; m < 4; ++m) { const int row = row0 + ai * HALF + m * 16; const f32x4 sv = *(const f32x4*)(ssq + (size_t)row * 8 + 4);
                const float rs = rsqrtf(((sv[0] + sv[1]) + (sv[2] + sv[3])) * (1.f / KVL) + EPS); const int b = row / SEQ, s = row % SEQ; const size_t t = (size_t)(b * NH + h) * SEQ + s;
                *(u32x4*)(Kc + t * DQK + d) = pack8(acc[ai][0][m][0] * rs, acc[ai][0][m][1] * rs);
                *(u32x4*)(Vc + t * DV + d) = pack8(acc[ai][1][m][0] * rs, acc[ai][1][m][1] * rs); }
    }
};
struct EpiWo {
    static constexpr bool PERM = true; static constexpr int MIDK = 8;
    const float* x; bf16_t* HBF; unsigned char* X8; const float* assq; float* ssq1; const float* gmoe;
    __device__ __forceinline__ void mid(Acc& acc, const Unit& u, int wr, int wc, int fr, int fq) const {
        const int row0 = u.pm * BM + wr * 64 + fr;
#pragma unroll
        for (int ai = 0; ai < 2; ++ai)
#pragma unroll
            for (int m = 0; m < 4; ++m) { const f32x4 sv = *(const f32x4*)(assq + (size_t)(row0 + ai * HALF + m * 16) * 4);
                const float rs = rsqrtf(((sv[0] + sv[1]) + (sv[2] + sv[3])) * (1.f / 512.f) + EPS);
#pragma unroll
                for (int bj = 0; bj < 2; ++bj)
#pragma unroll
                    for (int n = 0; n < 2; ++n) acc[ai][bj][m][n] = acc[ai][bj][m][n] * rs; }
    }
    __device__ __forceinline__ void operator()(const Acc& acc, const Unit& u, int wr, int wc, int fr, int fq) const {
        const int row0 = u.pm * BM + wr * 64 + fr, col0 = u.pn * BM + wc * 32 + 8 * fq;
        f32x4 gn[2][2];
#pragma unroll
        for (int bj = 0; bj < 2; ++bj) { gn[bj][0] = *(const f32x4*)(gmoe + col0 + bj * HALF); gn[bj][1] = *(const f32x4*)(gmoe + col0 + bj * HALF + 4); }
#pragma unroll
        for (int ai = 0; ai < 2; ++ai) { f32x4 xv[4][2][2];
#pragma unroll
            for (int m = 0; m < 4; ++m) { const size_t off = (size_t)(row0 + ai * HALF + m * 16) * DM + col0;
#pragma unroll
                for (int bj = 0; bj < 2; ++bj) { xv[m][bj][0] = *(const f32x4*)(x + off + bj * HALF); xv[m][bj][1] = *(const f32x4*)(x + off + bj * HALF + 4); } }
            asm volatile("" ::: "memory");
#pragma unroll
            for (int m = 0; m < 4; ++m) { const int row = row0 + ai * HALF + m * 16; const size_t off = (size_t)row * DM + col0; float ss = 0.f;
#pragma unroll
                for (int bj = 0; bj < 2; ++bj) { const f32x4 h0 = xv[m][bj][0] + acc[ai][bj][m][0], h1 = xv[m][bj][1] + acc[ai][bj][m][1];
                    *(u32x4*)(HBF + off + bj * HALF) = pack8(h0, h1); *(u32x2*)(X8 + off + bj * HALF) = (u32x2){pk4_fp8(h0 * gn[bj][0]), pk4_fp8(h1 * gn[bj][1])}; ss += sq4(h0) + sq4(h1); }
                ss = red_fq(ss); if (fq == 0) ssq1[(size_t)row * 16 + u.pn * 4 + wc] = ss; }
            asm volatile("" ::: "memory"); }
    }
};
__device__ __forceinline__ f32x4 sigmoid4(f32x4 a) { const f32x4 t = a * -1.44269504f; f32x4 e; e[0] = __builtin_amdgcn_exp2f(t[0]); e[1] = __builtin_amdgcn_exp2f(t[1]); e[2] = __builtin_amdgcn_exp2f(t[2]); e[3] = __builtin_amdgcn_exp2f(t[3]);
    const f32x4 d = e + 1.0f; f32x4 r; r[0] = __builtin_amdgcn_rcpf(d[0]); r[1] = __builtin_amdgcn_rcpf(d[1]); r[2] = __builtin_amdgcn_rcpf(d[2]); r[3] = __builtin_amdgcn_rcpf(d[3]); return r; }
__device__ __forceinline__ f32x2 swiglu2(f32x2 g, f32x2 u) {
    g.x = fminf(g.x, 7.f); g.y = fminf(g.y, 7.f); u.x = __builtin_amdgcn_fmed3f(u.x, -7.f, 7.f); u.y = __builtin_amdgcn_fmed3f(u.y, -7.f, 7.f);
    const f32x2 t = g * -2.45546696f; f32x2 e; e.x = __builtin_amdgcn_exp2f(t.x); e.y = __builtin_amdgcn_exp2f(t.y); const f32x2 d = e + 1.0f; f32x2 r; r.x = __builtin_amdgcn_rcpf(d.x); r.y = __builtin_amdgcn_rcpf(d.y);
    const f32x2 gs = g * r; return u * gs + gs; }
__device__ __forceinline__ float swiglu_f(float g, float u) { g = fminf(g, 7.f); u = __builtin_amdgcn_fmed3f(u, -7.f, 7.f); const float gs = g * __builtin_amdgcn_rcpf(1.f + __builtin_amdgcn_exp2f(g * -2.45546696f)); return fmaf(u, gs, gs); }
constexpr float WSCALE = 64.f, WINV = 1.f / 64.f;
struct EpiMoe1 {
    static constexpr bool PERM = true; static constexpr int MIDK = 0;
    unsigned char* HB; const float* b1; const float* rowrs;
    __device__ __forceinline__ void operator()(const Acc& acc, const Unit& u, int wr, int wc, int fr, int fq) const {
        const int row0 = u.pm * BM + wr * 64 + fr, j0 = u.pn * HALF + wc * 32 + 8 * fq; const float* bg = b1 + (size_t)u.e * 2048 + j0;
        const f32x4 g0 = *(const f32x4*)bg, g1 = *(const f32x4*)(bg + 4), u0 = *(const f32x4*)(bg + 1024), u1 = *(const f32x4*)(bg + 1028);
        float rsv[2][4];
#pragma unroll
        for (int ai = 0; ai < 2; ++ai)
#pragma unroll
            for (int m = 0; m < 4; ++m) rsv[ai][m] = rowrs[row0 + ai * HALF + m * 16];
        asm volatile("" ::: "memory");
#pragma unroll
        for (int ai = 0; ai < 2; ++ai)
#pragma unroll
            for (int m = 0; m < 4; ++m) { const float rs = rsv[ai][m] * WINV;
                const f32x4 a0 = acc[ai][0][m][0] * rs + g0, a1 = acc[ai][0][m][1] * rs + g1, c0 = acc[ai][1][m][0] * rs + u0, c1 = acc[ai][1][m][1] * rs + u1; f32x4 r0, r1;
#pragma unroll
                for (int j = 0; j < 4; j += 2) { const f32x2 s0 = swiglu2((f32x2){a0[j], a0[j + 1]}, (f32x2){c0[j], c0[j + 1]}), s1 = swiglu2((f32x2){a1[j], a1[j + 1]}, (f32x2){c1[j], c1[j + 1]}); r0[j] = s0.x; r0[j + 1] = s0.y; r1[j] = s1.x; r1[j + 1] = s1.y; }
                *(u32x2*)(HB + (size_t)(row0 + ai * HALF + m * 16) * DE + j0) = (u32x2){pk4_fp8(r0), pk4_fp8(r1)}; }
    }
};
struct EpiMoe2 {
    static constexpr bool PERM = true; static constexpr int MIDK = 0;
    unsigned char* Y; const float* b2; const int* rowslot; const float* rowgate;
    __device__ __forceinline__ void operator()(const Acc& acc, const Unit& u, int wr, int wc, int fr, int fq) const {
        const int row0 = u.pm * BM + wr * 64 + fr, col0 = u.pn * BM + wc * 32 + 8 * fq; const float* bb = b2 + (size_t)u.e * DM + col0;
        f32x4 bv[2][2];
#pragma unroll
        for (int bj = 0; bj < 2; ++bj)
#pragma unroll
            for (int n = 0; n < 2; ++n) bv[bj][n] = *(const f32x4*)(bb + bj * HALF + 4 * n);
        float gtv[2][4]; int slv[2][4];
#pragma unroll
        for (int ai = 0; ai < 2; ++ai)
#pragma unroll
            for (int m = 0; m < 4; ++m) { const int r = row0 + ai * HALF + m * 16; gtv[ai][m] = rowgate[r]; slv[ai][m] = rowslot[r]; }
        asm volatile("" ::: "memory");
#pragma unroll
        for (int ai = 0; ai < 2; ++ai)
#pragma unroll
            for (int m = 0; m < 4; ++m) { const float gt = gtv[ai][m]; unsigned char* yp = Y + (size_t)slv[ai][m] * DM + col0;
#pragma unroll
                for (int bj = 0; bj < 2; ++bj) *(u32x2*)(yp + bj * HALF) = (u32x2){pk4_fp8((acc[ai][bj][m][0] * WINV + bv[bj][0]) * gt), pk4_fp8((acc[ai][bj][m][1] * WINV + bv[bj][1]) * gt)}; }
    }
};
struct EpiPle {
    static constexpr bool PERM = true; static constexpr int MIDK = 0;
    const bf16_t* H2; bf16_t* H3; const bf16_t* pler; const float* rpv; const float* rs2; const float* pg; float* fssq;
    __device__ __forceinline__ void operator()(const Acc& acc, const Unit& u, int wr, int wc, int fr, int fq) const {
        const int row0 = u.pm * BM + wr * 64 + fr, col0 = u.pn * BM + wc * 32 + 8 * fq;
        f32x4 gv[2][2];
#pragma unroll
        for (int bj = 0; bj < 2; ++bj)
#pragma unroll
            for (int n = 0; n < 2; ++n) gv[bj][n] = *(const f32x4*)(pg + col0 + bj * HALF + n * 4);
#pragma unroll
        for (int am = 0; am < 4; ++am) { const int ai = am >> 1; u32x4 hq[2][2], pq[2][2]; float r2v[2], rpq[2];
#pragma unroll
            for (int mm = 0; mm < 2; ++mm) { const int row = row0 + ai * HALF + ((am & 1) * 2 + mm) * 16; const size_t off = (size_t)row * DM + col0; r2v[mm] = rs2[row]; rpq[mm] = rpv[row];
#pragma unroll
                for (int bj = 0; bj < 2; ++bj) { hq[mm][bj] = *(const u32x4*)(H2 + off + bj * HALF); pq[mm][bj] = *(const u32x4*)(pler + off + bj * HALF); } }
            asm volatile("" ::: "memory");
#pragma unroll
            for (int mm = 0; mm < 2; ++mm) { const int m = (am & 1) * 2 + mm; const int row = row0 + ai * HALF + m * 16; const size_t off = (size_t)row * DM + col0; const float r2 = r2v[mm], rp = rpq[mm]; float ss = 0.f;
#pragma unroll
                for (int bj = 0; bj < 2; ++bj) { const size_t o = off + bj * HALF; const u32x4 hv = hq[mm][bj], pr = pq[mm][bj];
                    const f32x4 h0 = {blo(hv.x), bhi(hv.x), blo(hv.y), bhi(hv.y)}, h1 = {blo(hv.z), bhi(hv.z), blo(hv.w), bhi(hv.w)};
                    const f32x4 q0 = {blo(pr.x), bhi(pr.x), blo(pr.y), bhi(pr.y)}, q1 = {blo(pr.z), bhi(pr.z), blo(pr.w), bhi(pr.w)};
                    const f32x4 r0 = h0 + sigmoid4(acc[ai][bj][m][0] * r2) * (q0 * (gv[bj][0] * rp)), r1 = h1 + sigmoid4(acc[ai][bj][m][1] * r2) * (q1 * (gv[bj][1] * rp));
                    *(u32x4*)(H3 + o) = pack8(r0, r1); ss += sq4(r0) + sq4(r1); }
                ss = red_fq(ss); if (fq == 0) fssq[(size_t)row * 16 + u.pn * 4 + wc] = ss; }
            asm volatile("" ::: "memory"); }
    }
};
}

namespace att {
typedef float f32x16 __attribute__((ext_vector_type(16)));
typedef short s16x4 __attribute__((ext_vector_type(4)));
constexpr int QBLK = 32, KVBLK = 64, QB = 256;
constexpr int SHM_K = KVBLK * DQK * 2, SHM_V = KVBLK * DV * 2;
constexpr int L_V = 0, L_K = 2 * SHM_V, L_WS = L_K + 2 * SHM_K, L_END = L_WS + NWAVES * 256;
constexpr float THR = 8.f;
#define KSWZ(row, colB) ((row) * 384 + ((colB) ^ (((row) & 7) << 4)))
#define SBAR() __builtin_amdgcn_sched_barrier(0)
__device__ __forceinline__ int v_st(int k, int c) { const int kk = (k & ~0xC) | ((k & 4) << 1) | ((k & 8) >> 1); return ((kk >> 3) * 4 + (c >> 5)) * 512 + ((kk & 7) * 32 + (c & 31)) * 2; }
__device__ __forceinline__ int v_rd_base(int lane) { return ((lane & 3) << 3) | (((lane >> 2) & 3) << 6) | (((lane >> 4) & 1) << 5) | (((lane >> 5) & 1) << 8); }
constexpr int v_rd_off(int d0, int ks, int half) { return d0 * 512 + ks * 4096 + half * 2048; }
__device__ __forceinline__ int crow(int r, int hi) { return (r & 3) + 8 * (r >> 2) + 4 * hi; }
typedef __bf16 bf16x2_t __attribute__((ext_vector_type(2)));
__device__ __forceinline__ unsigned cvtpk(float lo, float hi) { f32x2 v = {lo, hi}; bf16x2_t b = __builtin_convertvector(v, bf16x2_t); return __builtin_bit_cast(unsigned, b); }

__device__ __forceinline__ void qkt(f32x16& p0, f32x16& p1, const LAS unsigned char* Kbuf, int r32, int hi, const bf16x8* qr) {
    p0 = f32x16{}; p1 = f32x16{};
    const LAS unsigned char* kb[4];
#pragma unroll
    for (int dd = 0; dd < 4; ++dd) kb[dd] = Kbuf + KSWZ(r32, (dd * 16 + hi * 8) * 2);
#pragma unroll
    for (int d0 = 0; d0 < 12; ++d0) { const LAS unsigned char* a = kb[d0 & 3] + (d0 >> 2) * 128;
        const bf16x8 b0 = *(const LAS bf16x8*)a; const bf16x8 b1 = *(const LAS bf16x8*)(a + 32 * 384);
        p0 = __builtin_amdgcn_mfma_f32_32x32x16_bf16(b0, qr[d0], p0, 0, 0, 0);
        p1 = __builtin_amdgcn_mfma_f32_32x32x16_bf16(b1, qr[d0], p1, 0, 0, 0); }
}
template <int VB>
__device__ __forceinline__ void pv_tile(f32x16* o, int vb0, bf16x8 pa0, bf16x8 pa1, bf16x8 pa2, bf16x8 pa3) {
#define TRRD(dst, off) asm volatile("ds_read_b64_tr_b16 %0, %1 offset:%2" : "=&v"(dst) : "v"(vb0), "i"(off) : "memory")
#define PV_D0(d0) do { s16x4 l0, l1, l2, l3, h0, h1, h2, h3; constexpr int b_ = VB * SHM_V + v_rd_off(d0, 0, 0); \
        TRRD(l0, b_); TRRD(h0, b_ + 2048); TRRD(l1, b_ + 4096); TRRD(h1, b_ + 6144); TRRD(l2, b_ + 8192); TRRD(h2, b_ + 10240); TRRD(l3, b_ + 12288); TRRD(h3, b_ + 14336); \
        asm volatile("s_waitcnt lgkmcnt(0)" ::: "memory"); SBAR(); \
        o[d0] = __builtin_amdgcn_mfma_f32_32x32x16_bf16(pa0, (bf16x8){l0[0], l0[1], l0[2], l0[3], h0[0], h0[1], h0[2], h0[3]}, o[d0], 0, 0, 0); \
        o[d0] = __builtin_amdgcn_mfma_f32_32x32x16_bf16(pa1, (bf16x8){l1[0], l1[1], l1[2], l1[3], h1[0], h1[1], h1[2], h1[3]}, o[d0], 0, 0, 0); \
        o[d0] = __builtin_amdgcn_mfma_f32_32x32x16_bf16(pa2, (bf16x8){l2[0], l2[1], l2[2], l2[3], h2[0], h2[1], h2[2], h2[3]}, o[d0], 0, 0, 0); \
        o[d0] = __builtin_amdgcn_mfma_f32_32x32x16_bf16(pa3, (bf16x8){l3[0], l3[1], l3[2], l3[3], h3[0], h3[1], h3[2], h3[3]}, o[d0], 0, 0, 0); } while (0)
    PV_D0(0); PV_D0(1); PV_D0(2); PV_D0(3);
#undef PV_D0
#undef TRRD
}
struct ConvJob { const float* w1; const float* w2; const float* gain; unsigned char* W1T; unsigned char* W2T; int gw, ngw; };
constexpr int CV_N1 = NE * 32 * 64, CV_N2 = NE * 32 * 32, CV_TOTAL = CV_N1 + CV_N2;
__device__ __forceinline__ int cv_cmap1(int n) { const int pn = n >> 8, half = (n >> 7) & 1, jj = n & 127; return half * 1024 + pn * 128 + jj; }
#define CV_DECODE(idx) \
    const bool cv_on = (idx) < CV_TOTAL; const bool cv_is1 = (idx) < CV_N1; const int cv_r = cv_is1 ? (idx) : (idx) - CV_N1; \
    const int cv_nblk = cv_is1 ? 64 : 32, cv_ld = cv_is1 ? 2048 : 1024; const int cv_e = cv_r / (32 * cv_nblk), cv_q = cv_r % (32 * cv_nblk), cv_k0 = 32 * (cv_q / cv_nblk), cv_n0 = 32 * (cv_q % cv_nblk); \
    const float* cv_src = (cv_is1 ? cj.w1 + (size_t)cv_e * 1024 * 2048 : cj.w2 + (size_t)cv_e * 1024 * 1024); \
    const int cv_c = cv_is1 ? cv_cmap1(cv_n0 + (lane & 31)) : cv_n0 + (lane & 31);
#define CV_LOAD() do { if (cv_on) { _Pragma("unroll") for (int i = 0; i < 16; ++i) cvw[i] = cv_src[(size_t)(cv_k0 + 2 * i + hi) * cv_ld + cv_c]; } } while (0)
#define CV_STORE() do { if (cv_on) { LAS float* scr = (LAS float*)(lds + L_END) + wid * (32 * 33); \
        _Pragma("unroll") for (int i = 0; i < 16; ++i) { const int kk = 2 * i + hi; scr[kk * 33 + (lane & 31)] = cvw[i] * 64.f; } \
        asm volatile("s_waitcnt lgkmcnt(0)" ::: "memory"); \
        { const int n = lane >> 1, cc = lane & 1; const LAS float* s = scr + (16 * cc) * 33 + n; u32x4 o; \
          o.x = pg8::pk4_fp8((f32x4){s[0 * 33], s[1 * 33], s[2 * 33], s[3 * 33]}); o.y = pg8::pk4_fp8((f32x4){s[4 * 33], s[5 * 33], s[6 * 33], s[7 * 33]}); \
          o.z = pg8::pk4_fp8((f32x4){s[8 * 33], s[9 * 33], s[10 * 33], s[11 * 33]}); o.w = pg8::pk4_fp8((f32x4){s[12 * 33], s[13 * 33], s[14 * 33], s[15 * 33]}); \
          unsigned char* dst = (cv_is1 ? cj.W1T + (size_t)cv_e * 2048 * 1024 : cj.W2T + (size_t)cv_e * 1024 * 1024) + (size_t)(cv_n0 + n) * 1024 + cv_k0 + 16 * cc; *(u32x4*)dst = o; } \
        asm volatile("s_waitcnt lgkmcnt(0)" ::: "memory"); } } while (0)
__device__ __forceinline__ void attn_block(int bh, int qb, const bf16_t* __restrict__ Q, const bf16_t* __restrict__ K, const bf16_t* __restrict__ V, bf16_t* __restrict__ MIX, float* __restrict__ ASSQ, LAS unsigned char* lds, const int wid, const ConvJob& cj, int& tseq) {
    const int lane = lane_id(), r32 = lane & 31, hi = lane >> 5;
    const int b = bh / NH, h = bh % NH;
    const bf16_t* Qw = Q + ((size_t)bh * SEQ + qb * QB + wid * QBLK + r32) * DQK;
    const bf16_t* Kh = K + (size_t)bh * SEQ * DQK; const bf16_t* Vh = V + (size_t)bh * SEQ * DV;
    bf16x8 qr[12];
#pragma unroll
    for (int d0 = 0; d0 < 12; ++d0) qr[d0] = *(const bf16x8*)(Qw + d0 * 16 + hi * 8);
    const int NT = 4 * qb + 4, qlo = qb * QB + wid * QBLK, qm = qlo + r32 - 4 * hi;
    LAS unsigned char* V_lds = lds + L_V; LAS unsigned char* K_lds = lds + L_K;
    LAS float* wsf = (LAS float*)(lds + L_WS) + wid * 64; LAS float* li_l = wsf; LAS float* al_l = wsf + 32;
    unsigned ksrc[3], vsrc[2];
#pragma unroll
    for (int i = 0; i < 3; ++i) { const int off = ((wid + 8 * i) * 64 + lane) * 16, row = off / 384, wb = off % 384, seg = wb >> 7, cpos = (wb & 127) >> 4; ksrc[i] = (unsigned)(row * 384 + seg * 128 + ((cpos ^ (row & 7)) << 4)); }
#pragma unroll
    for (int i = 0; i < 2; ++i) { const int off = ((wid + 8 * i) * 64 + lane) * 16, st = off >> 9, o_ = off & 511, kk = (st >> 2) * 8 + (o_ >> 6), c = (st & 3) * 32 + ((o_ & 63) >> 1);
        const int k = (kk & ~0xC) | ((kk & 4) << 1) | ((kk & 8) >> 1); vsrc[i] = (unsigned)(k * 256 + c * 2); }
    const int vb0 = (int)(unsigned)(uintptr_t)V_lds + v_rd_base(lane);
#define ADMA(t, bf) do { const char* kp = (const char*)(Kh + (size_t)(t) * KVBLK * DQK); const char* vp = (const char*)(Vh + (size_t)(t) * KVBLK * DV); \
        _Pragma("unroll") for (int i = 0; i < 3; ++i) __builtin_amdgcn_global_load_lds((const unsigned*)(kp + ksrc[i]), (LAS unsigned*)(K_lds + (bf) * SHM_K + (wid + 8 * i) * 1024), 16, 0, 0); \
        _Pragma("unroll") for (int i = 0; i < 2; ++i) __builtin_amdgcn_global_load_lds((const unsigned*)(vp + vsrc[i]), (LAS unsigned*)(V_lds + (bf) * SHM_V + (wid + 8 * i) * 1024), 16, 0, 0); } while (0)
    float m_reg = -1e30f, l_reg = 0.f; f32x16 o[4] = {}; float cvw[16]; int cv_pend = -1;
    ADMA(0, 0);
#define TILE(t, BF) do { \
        asm volatile("s_waitcnt vmcnt(0)" ::: "memory"); __syncthreads(); \
        if ((t) + 1 < NT) ADMA((t) + 1, (BF) ^ 1); \
        if (cv_pend >= 0) { CV_DECODE(cv_pend) CV_STORE(); }     \
        { const int cv_idx = tseq * cj.ngw + cj.gw; ++tseq; CV_DECODE(cv_idx) CV_LOAD(); cv_pend = cv_on ? cv_idx : -1; } SBAR(); \
        const int kb_ = (t) * KVBLK; \
        if (kb_ <= qlo + QBLK - 1) { \
            f32x16 p0, p1; SBAR(); qkt(p0, p1, K_lds + (BF) * SHM_K, r32, hi, qr); \
            if (kb_ + KVBLK - 1 > qlo) { const int dq = qm - kb_; const float NEG = -__builtin_inff(); \
                _Pragma("unroll") for (int r = 0; r < 16; ++r) { const int c = (r & 3) + 8 * (r >> 2); if (c > dq) p0[r] = NEG; if (c + 32 > dq) p1[r] = NEG; } } \
            float pmax = p0[0]; _Pragma("unroll") for (int r = 1; r < 16; ++r) pmax = fmaxf(pmax, p0[r]); _Pragma("unroll") for (int r = 0; r < 16; ++r) pmax = fmaxf(pmax, p1[r]); \
            { auto rr = __builtin_amdgcn_permlane32_swap(__float_as_uint(pmax), __float_as_uint(pmax), false, false); pmax = fmaxf(__uint_as_float(rr[0]), __uint_as_float(rr[1])); } \
            if (!__all(pmax - m_reg <= THR)) { const float mn = fmaxf(m_reg, pmax); const float alpha = __builtin_amdgcn_exp2f(m_reg - mn); m_reg = mn; l_reg *= alpha; \
                if (hi == 0) al_l[r32] = alpha; asm volatile("s_waitcnt lgkmcnt(0)" ::: "memory"); \
                _Pragma("unroll") for (int d_ = 0; d_ < 4; ++d_) _Pragma("unroll") for (int r = 0; r < 16; ++r) o[d_][r] *= al_l[crow(r, hi)]; } \
            float ps = 0.f; \
            _Pragma("unroll") for (int r = 0; r < 16; ++r) { p0[r] = __builtin_amdgcn_exp2f(p0[r] - m_reg); p1[r] = __builtin_amdgcn_exp2f(p1[r] - m_reg); } \
            _Pragma("unroll") for (int r = 0; r < 16; ++r) ps += p0[r] + p1[r]; \
            { auto rr = __builtin_amdgcn_permlane32_swap(__float_as_uint(ps), __float_as_uint(ps), false, false); ps = __uint_as_float(rr[0]) + __uint_as_float(rr[1]); } \
            l_reg += ps; \
            bf16x8 pa0, pa1, pa2, pa3; \
            PK4(p0, 0, pa0); PK4(p0, 8, pa1); PK4(p1, 0, pa2); PK4(p1, 8, pa3); \
            SBAR(); pv_tile<BF>(o, vb0, pa0, pa1, pa2, pa3); } \
        } while (0)
#define PK4(P, B_, OUT) do { unsigned a0 = cvtpk(P[B_ + 0], P[B_ + 1]), a1 = cvtpk(P[B_ + 2], P[B_ + 3]); \
        unsigned b0 = cvtpk(P[B_ + 4], P[B_ + 5]), b1 = cvtpk(P[B_ + 6], P[B_ + 7]); \
        auto r0 = __builtin_amdgcn_permlane32_swap(a0, b0, false, false); auto r1 = __builtin_amdgcn_permlane32_swap(a1, b1, false, false); \
        u32x4 w = {r0[0], r1[0], r0[1], r1[1]}; OUT = __builtin_bit_cast(bf16x8, w); } while (0)
    for (int t = 0; t < NT; t += 2) { TILE(t, 0); TILE(t + 1, 1); }
#undef PK4
#undef TILE
#undef ADMA
    if (cv_pend >= 0) { asm volatile("s_waitcnt vmcnt(0)" ::: "memory"); CV_DECODE(cv_pend) CV_STORE(); }
    if (hi == 0) li_l[r32] = l_reg;
    asm volatile("s_waitcnt vmcnt(0) lgkmcnt(0)" ::: "memory");
    float rli[16];
#pragma unroll
    for (int r = 0; r < 16; ++r) rli[r] = __builtin_amdgcn_rcpf(li_l[crow(r, hi)]);
    __syncthreads();
    LAS bf16_t* stg = (LAS bf16_t*)(lds + wid * 8192);
#pragma unroll
    for (int r = 0; r < 16; ++r) { const int orow = crow(r, hi);
#pragma unroll
        for (int d0 = 0; d0 < 4; ++d0) stg[orow * 128 + d0 * 32 + r32] = f2bf(o[d0][r] * rli[r]); }
    asm volatile("s_waitcnt lgkmcnt(0)" ::: "memory");
    const size_t row0 = (size_t)b * SEQ + qb * QB + wid * QBLK;
#pragma unroll
    for (int i = 0; i < 8; ++i) { const int row = i * 4 + (lane >> 4), ch = lane & 15; const u32x4 v = *(const LAS u32x4*)(stg + row * 128 + ch * 8);
        float ss = (blo(v.x) * blo(v.x) + bhi(v.x) * bhi(v.x)) + (blo(v.y) * blo(v.y) + bhi(v.y) * bhi(v.y)) + (blo(v.z) * blo(v.z) + bhi(v.z) * bhi(v.z)) + (blo(v.w) * blo(v.w) + bhi(v.w) * bhi(v.w));
        ss += __shfl_xor(ss, 1); ss += __shfl_xor(ss, 2); ss += __shfl_xor(ss, 4); ss += __shfl_xor(ss, 8);
        *(u32x4*)(MIX + (row0 + row) * DM + h * DV + ch * 8) = v;
        if (ch == 0) ASSQ[(row0 + row) * 4 + h] = ss; }
    __syncthreads();
}
#undef KSWZ
#undef SBAR
}

struct Args { const void* in[25]; float* out; unsigned char* ws; int ph_lo, ph_hi, li, skip; };
enum { PH_PREP = 0, PH_INPROJ, PH_TOKLOCAL, PH_ATTN, PH_WO, PH_ROUTER, PH_ROUTE, PH_MOE1, PH_MOE2, PH_COMBINE, PH_PLE, PH_FINAL, PH_COUNT };

template <int MODE> __device__ __forceinline__ int cmap_col(int n) {
    if (MODE == 1) { const int pn = n >> 8, half = (n >> 7) & 1, jj = n & 127; return half * 1024 + pn * 128 + jj; }
    if (MODE == 2) { const int h = n / DQK, d = n % DQK; if (d < DN) return n; const int t = d - DN; return h * DQK + DN + (t & 1) * 32 + (t >> 1); }
    return n;
}
template <int MODE> __device__ __forceinline__ void transpose_item_fp8(const float* __restrict__ W, int ldsrc, int nblk, unsigned char* __restrict__ WT, int ldd, const float* __restrict__ gain, float scale,
                                                                      LAS float* scr, int item, int lane) {
    const int kb = item / nblk, nb = item % nblk, k0 = 64 * kb, n0 = 32 * nb; const int c = cmap_col<MODE>(n0 + (lane & 31));
    float wv[32];
#pragma unroll
    for (int i = 0; i < 32; ++i) wv[i] = W[(size_t)(k0 + 2 * i + (lane >> 5)) * ldsrc + c];
#pragma unroll
    for (int i = 0; i < 32; ++i) { const int kk = 2 * i + (lane >> 5), k = k0 + kk; float gk = scale; if (gain) gk *= gain[k]; scr[kk * 33 + (lane & 31)] = wv[i] * gk; }
    asm volatile("s_waitcnt lgkmcnt(0)" ::: "memory");
    const int cc = lane & 3;
#pragma unroll
    for (int j = 0; j < 2; ++j) { const int n = (lane >> 2) + 16 * j; const LAS float* s = scr + (16 * cc) * 33 + n; u32x4 o;
        o.x = pg8::pk4_fp8((f32x4){s[0 * 33], s[1 * 33], s[2 * 33], s[3 * 33]}); o.y = pg8::pk4_fp8((f32x4){s[4 * 33], s[5 * 33], s[6 * 33], s[7 * 33]});
        o.z = pg8::pk4_fp8((f32x4){s[8 * 33], s[9 * 33], s[10 * 33], s[11 * 33]}); o.w = pg8::pk4_fp8((f32x4){s[12 * 33], s[13 * 33], s[14 * 33], s[15 * 33]});
        *(u32x4*)(WT + (size_t)(n0 + n) * ldd + k0 + 16 * cc) = o; }
    asm volatile("s_waitcnt lgkmcnt(0)" ::: "memory");
}
template <int MODE> __device__ __forceinline__ void transpose_item(const float* __restrict__ W, int ldsrc, int nblk, bf16_t* __restrict__ WT, int ldd, const float* __restrict__ gain, const float* __restrict__ gain2, float scale,
                                                                  LAS float* scr, int item, int lane) {
    const int kb = item / nblk, nb = item % nblk, k0 = 64 * kb, n0 = 32 * nb; const int c = cmap_col<MODE>(n0 + (lane & 31));
    float wv[32], gq[32];
#pragma unroll
    for (int i = 0; i < 32; ++i) wv[i] = W[(size_t)(k0 + 2 * i + (lane >> 5)) * ldsrc + c];
#pragma unroll
    for (int i = 0; i < 32; ++i) { const int k = k0 + 2 * i + (lane >> 5); gq[i] = gain ? ((gain2 && k >= 512) ? gain2[k - 512] : gain[k]) : 1.f; }
    asm volatile("" ::: "memory");
#pragma unroll
    for (int i = 0; i < 32; ++i) { const int kk = 2 * i + (lane >> 5); scr[kk * 33 + (lane & 31)] = wv[i] * (gq[i] * scale); }
    asm volatile("s_waitcnt lgkmcnt(0)" ::: "memory");
    const int cc = lane & 7;
#pragma unroll
    for (int j = 0; j < 4; ++j) { const int n = (lane >> 3) + 8 * j; const LAS float* s = scr + (8 * cc) * 33 + n;
        u32x4 o; o.x = pk2(s[0 * 33], s[1 * 33]); o.y = pk2(s[2 * 33], s[3 * 33]); o.z = pk2(s[4 * 33], s[5 * 33]); o.w = pk2(s[6 * 33], s[7 * 33]);
        *(u32x4*)(WT + (size_t)(n0 + n) * ldd + k0 + 8 * cc) = o; }
    asm volatile("s_waitcnt lgkmcnt(0)" ::: "memory");
}

__global__ void __launch_bounds__(NTHREADS, 2) fwd(Args args) {
    extern __shared__ __attribute__((aligned(16))) unsigned char lds_raw[];
    LAS unsigned char* lds = (LAS unsigned char*)lds_raw;
    volatile LAS unsigned* MISC = (volatile LAS unsigned*)(lds + MISC_OFF);
    const int wave = __builtin_amdgcn_readfirstlane(threadIdx.x >> 6);
    const int G = gridDim.x, bx = blockIdx.x;
#define PHASE_LANE const int lane = lane_id(); const int tid = wave * 64 + lane; (void)tid
    const int gw = bx * NWAVES + wave, NGW = G * NWAVES;
    unsigned char* ws = args.ws; int* ctl = (int*)(ws + WS_CTL); float* H = args.out;
    const float* x = (const float*)args.in[0]; const float* p = (const float*)args.in[1]; const int* pos = (const int*)args.in[2];
    const float *mix_norm = (const float*)args.in[3], *w_in = (const float*)args.in[4], *q_norm = (const float*)args.in[5], *w_uq = (const float*)args.in[6], *kv_norm = (const float*)args.in[7],
                *w_ukv = (const float*)args.in[8], *attn_out_norm = (const float*)args.in[10], *conv_out_norm = (const float*)args.in[11], *w_o = (const float*)args.in[12],
                *moe_norm = (const float*)args.in[13], *w_router = (const float*)args.in[14], *w1 = (const float*)args.in[16], *b1 = (const float*)args.in[17],
                *w2 = (const float*)args.in[18], *b2 = (const float*)args.in[19], *ple_norm = (const float*)args.in[20], *w_ple_gate = (const float*)args.in[21], *w_ple_proj = (const float*)args.in[22],
                *ple_post_norm = (const float*)args.in[23], *conv_w = (const float*)args.in[9], *b_router = (const float*)args.in[15], *final_norm = (const float*)args.in[24];
    int* TOPI = (int*)(ws + WS_TOPI); float* TOPG = (float*)(ws + WS_TOPG);
    bf16_t *HBF = (bf16_t*)(ws + WS_HBF), *H3 = (bf16_t*)(ws + WS_H3), *WRHL = (bf16_t*)(ws + WS_WRHL); unsigned char* X8 = (unsigned char*)(ws + WS_XN);
    float *SSQ1 = (float*)(ws + WS_SSQ1), *RS1 = (float*)(ws + WS_RS1), *RS2 = (float*)(ws + WS_RS2), *ROWRS = (float*)(ws + WS_ROWRS);
    bf16_t *WIN = (bf16_t*)(ws + WS_WIN), *WUQ = (bf16_t*)(ws + WS_WUQ), *WUKV = (bf16_t*)(ws + WS_WUKV), *WO = (bf16_t*)(ws + WS_WO), *WG = (bf16_t*)(ws + WS_WG), *WP = (bf16_t*)(ws + WS_WP);
    bf16_t *W1T = (bf16_t*)(ws + WS_W1), *W2T = (bf16_t*)(ws + WS_W2), *XN = (bf16_t*)(ws + WS_XN), *MIX = (bf16_t*)(ws + WS_MIX), *PLER = (bf16_t*)(ws + WS_PLER);
    bf16_t *Z = (bf16_t*)(ws + WS_Z), *Qb = (bf16_t*)(ws + WS_Q), *Kb = (bf16_t*)(ws + WS_K), *Vb = (bf16_t*)(ws + WS_V), *HB = (bf16_t*)(ws + WS_HB), *Y = (bf16_t*)(ws + WS_Y), *P16 = (bf16_t*)(ws + WS_P16);
    float *WR = (float*)(ws + WS_WR), *CS = (float*)(ws + WS_CS), *SSQ = (float*)(ws + WS_SSQ), *ASSQ = (float*)(ws + WS_ASSQ), *PSSQ = (float*)(ws + WS_PSSQ), *FSSQ = (float*)(ws + WS_FSSQ);
    int *ROWTOK = (int*)(ws + WS_ROWTOK), *ROWSLOT = (int*)(ws + WS_ROWSLOT); float* ROWGATE = (float*)(ws + WS_ROWGATE);

    { PHASE_LANE; for (int u = tid; u < (LDS_BYTES - MISC_OFF) / 4; u += NTHREADS) ((LAS unsigned*)(lds + MISC_OFF))[u] = 0u; }
    __syncthreads();
    const int lo = args.ph_lo, hi = args.ph_hi;
    XcdBarrier bar; bar.bar = (unsigned*)ctl + CW_BAR + args.li * XCD_BAR_WORDS; bar.x = 0; bar.st = MISC + 8;
    if (hi - lo > 1) bar = xcd_barrier_post((unsigned*)ctl + CW_BAR + args.li * XCD_BAR_WORDS, MISC + 8, wave);
#define IN(k) (lo <= (k) && (k) < hi)
#define NREP(k) ((PROBE_PH == (k)) ? PROBE_REP : 1)
#define REPLOOP(k) for (int rep = 0; rep < NREP(k); ++rep)
#define LASTREP(k) (rep == NREP(k) - 1)
#ifdef PROBE_TIME_PH
#define STAMP(k) do { if (bx == 0 && wave == 0) MISC[32 + (k)] = (unsigned)__builtin_amdgcn_s_memrealtime(); } while (0)
#else
#define STAMP(k) do { } while (0)
#endif
#define SEAM(k) do { if (IN(k) && IN((k) + 1)) xcd_barrier(bar, wave); STAMP((k) + 1); } while (0)
    STAMP(0);

    if (IN(PH_PREP)) REPLOOP(PH_PREP) {
        PHASE_LANE;
        LAS float* scr = (LAS float*)(lds + wave * 16384);
        constexpr int I_IN = (DM / 64) * (INW / 32), I_UQ = (QL / 64) * (768 / 32), I_UKV = (KVL / 64) * (1024 / 32), I_O = (DM / 64) * (DM / 32), I_G = I_O, I_P = (PLE / 64) * (DM / 32);
        constexpr int I_1 = (DM / 64) * (2048 / 32), I_2 = (DE / 64) * (DM / 32);
        constexpr int NITEMS = I_IN + I_UQ + I_UKV + I_O + I_G + I_P;
        for (int it = gw; it < NITEMS; it += NGW) {
            int r = it;
            if (r < I_IN) { transpose_item<0>(w_in, INW, INW / 32, WIN, DM, mix_norm, nullptr, 1.f, scr, r, lane); continue; } r -= I_IN;
            if (r < I_UQ) { transpose_item<2>(w_uq, 768, 768 / 32, WUQ, QL, q_norm, nullptr, QSCALE, scr, r, lane); continue; } r -= I_UQ;
            if (r < I_UKV) { transpose_item<0>(w_ukv, 1024, 1024 / 32, WUKV, 256, kv_norm, nullptr, 1.f, scr, r, lane); continue; } r -= I_UKV;
            if (r < I_O) { transpose_item<0>(w_o, DM, DM / 32, WO, DM, attn_out_norm, conv_out_norm, 1.f, scr, r, lane); continue; } r -= I_O;
            if (r < I_G) { transpose_item<0>(w_ple_gate, DM, DM / 32, WG, DM, ple_norm, nullptr, 1.f, scr, r, lane); continue; } r -= I_G;
            transpose_item<0>(w_ple_proj, DM, DM / 32, WP, PLE, nullptr, nullptr, 1.f, scr, r, lane);
        }
        for (int i = bx * NTHREADS + tid; i < 1024 * 16; i += G * NTHREADS) *(u32x4*)(WUKV + (size_t)(i >> 4) * 256 + 128 + (i & 15) * 8) = (u32x4){0u, 0u, 0u, 0u};
        for (int i = bx * NTHREADS + tid; i < DM * NE; i += G * NTHREADS) { const int e = i >> 10, k = i & 1023; const float w = w_router[k * NE + e] * moe_norm[k]; const bf16_t whi = f2bf(w);
            WRHL[i] = whi; WRHL[DM * NE + i] = f2bf(w - bf2f(whi)); }
        for (int i = bx * NTHREADS + tid; i < NTOK * 32; i += G * NTHREADS) { const int t = i >> 5, j = i & 31; const float inv = powf(10000.f, -(float)j / 32.f); const float a = (float)pos[t] * inv; float sn, c; sincosf(a, &sn, &c);
            CS[(size_t)t * 64 + j] = c; CS[(size_t)t * 64 + 32 + j] = sn; }
        for (int i = bx * NTHREADS + tid; i < NTOK * PLE / 4; i += G * NTHREADS) { const f32x4 v = ((const f32x4*)p)[i]; ((u32x2*)P16)[i] = (u32x2){pk2(v[0], v[1]), pk2(v[2], v[3])}; }
        for (int row = gw * 4; row < NTOK; row += NGW * 4) {
            f32x4 v[4][4]; float ss[4];
#pragma unroll
            for (int q = 0; q < 4; ++q) { const f32x4* s = (const f32x4*)(x + (size_t)(row + q) * DM);
#pragma unroll
                for (int j = 0; j < 4; ++j) v[q][j] = s[lane + 64 * j]; }
#pragma unroll
            for (int q = 0; q < 4; ++q) { ss[q] = 0.f;
#pragma unroll
                for (int j = 0; j < 4; ++j) ss[q] += pg8::sq4(v[q][j]); }
#pragma unroll
            for (int q = 0; q < 4; ++q) { const float rstd = rsqrtf(wave_sum(ss[q]) * (1.f / DM) + EPS); u32x2* d = (u32x2*)(XN + (size_t)(row + q) * DM);
#pragma unroll
                for (int j = 0; j < 4; ++j) d[lane + 64 * j] = (u32x2){pk2(v[q][j][0] * rstd, v[q][j][1] * rstd), pk2(v[q][j][2] * rstd, v[q][j][3] * rstd)}; }
        }
    }
    SEAM(PH_PREP);
    if (IN(PH_INPROJ)) REPLOOP(PH_INPROJ) {
        { pg8::Gemm g{XN, WIN, DM, DM, DM, nullptr, 0}; pg8::StaticOrder S; S.init(NTOK / 256, INWP / 256, G, bx, nullptr);
          pg8::EpiBf16Stats<0> E{Z, INWP, SSQ}; pg8::gemm_phase<pg8::EpiBf16Stats<0>, false>(lds, g, S, E, wave); }
        { pg8::Gemm g{P16, WP, PLE, PLE, PLE, nullptr, 0}; pg8::StaticOrder S; S.init(NTOK / 256, DM / 256, G, bx, nullptr);
          pg8::EpiBf16Stats<1> E{PLER, DM, PSSQ}; pg8::gemm_phase<pg8::EpiBf16Stats<1>, false>(lds, g, S, E, wave); }
    }
    SEAM(PH_INPROJ);
    if (IN(PH_TOKLOCAL)) REPLOOP(PH_TOKLOCAL) {
        PHASE_LANE;
        if (!(args.skip & 1)) for (int r0 = gw * 16; r0 < NTOK; r0 += NGW * 16) {
            const int c8 = lane * 8; f32x4 w0[2], w1[2], w2[2];
#pragma unroll
            for (int q = 0; q < 2; ++q) { w0[q] = *(const f32x4*)(conv_w + c8 + 4 * q); w1[q] = *(const f32x4*)(conv_w + 512 + c8 + 4 * q); w2[q] = *(const f32x4*)(conv_w + 1024 + c8 + 4 * q); }
            f32x4 u1[2] = {}, u2[2] = {};
            if ((r0 % SEQ) != 0) {
#pragma unroll
                for (int p = 1; p <= 2; ++p) { const bf16_t* zp = Z + (size_t)(r0 - p) * INWP; const u32x4 cg = *(const u32x4*)(zp + 960 + c8), vv = *(const u32x4*)(zp + 1472 + c8);
                    const f32x4 a = (f32x4){blo(cg.x), bhi(cg.x), blo(cg.y), bhi(cg.y)} * (f32x4){blo(vv.x), bhi(vv.x), blo(vv.y), bhi(vv.y)}, b = (f32x4){blo(cg.z), bhi(cg.z), blo(cg.w), bhi(cg.w)} * (f32x4){blo(vv.z), bhi(vv.z), blo(vv.w), bhi(vv.w)};
                    if (p == 1) { u1[0] = a; u1[1] = b; } else { u2[0] = a; u2[1] = b; } } }
#pragma unroll 4
            for (int rr = 0; rr < 16; ++rr) { const int row = r0 + rr; const bf16_t* z = Z + (size_t)row * INWP; const int s = row % SEQ, b = row / SEQ;
                const u32x4 bg = *(const u32x4*)(z + 448 + c8), cg = *(const u32x4*)(z + 960 + c8), vv = *(const u32x4*)(z + 1472 + c8);
                if (lane < 32) { const float x1 = bf2f(z[384 + lane]), x2 = bf2f(z[416 + lane]); const float c = CS[(size_t)row * 64 + lane], sn = CS[(size_t)row * 64 + 32 + lane];
                    const unsigned o = pk2(x1 * c - x2 * sn, x1 * sn + x2 * c);
#pragma unroll
                    for (int h = 0; h < NH; ++h) *(unsigned*)(Kb + ((size_t)(b * NH + h) * SEQ + s) * DQK + DN + 2 * lane) = o; }
                f32x4 u0[2]; u0[0] = (f32x4){blo(cg.x), bhi(cg.x), blo(cg.y), bhi(cg.y)} * (f32x4){blo(vv.x), bhi(vv.x), blo(vv.y), bhi(vv.y)}; u0[1] = (f32x4){blo(cg.z), bhi(cg.z), blo(cg.w), bhi(cg.w)} * (f32x4){blo(vv.z), bhi(vv.z), blo(vv.w), bhi(vv.w)};
                f32x4 y[2]; y[0] = (f32x4){blo(bg.x), bhi(bg.x), blo(bg.y), bhi(bg.y)} * (w0[0] * u2[0] + w1[0] * u1[0] + w2[0] * u0[0]); y[1] = (f32x4){blo(bg.z), bhi(bg.z), blo(bg.w), bhi(bg.w)} * (w0[1] * u2[1] + w1[1] * u1[1] + w2[1] * u0[1]);
                const float rstd = rsqrtf(wave_sum(pg8::sq4(y[0]) + pg8::sq4(y[1])) * (1.f / 512.f) + EPS);
                *(u32x4*)(MIX + (size_t)row * DM + 512 + c8) = pg8::pack8(y[0] * rstd, y[1] * rstd);
                u2[0] = u1[0]; u2[1] = u1[1]; u1[0] = u0[0]; u1[1] = u0[1]; }
        }
        { pg8::Gemm g{Z, WUQ, QL, INWP, QL, nullptr, 0}; pg8::StaticOrder S; S.init(NTOK / 256, 768 / 256, G, bx, nullptr);
          pg8::EpiQ E{Qb, SSQ, CS}; pg8::gemm_phase<pg8::EpiQ, false>(lds, g, S, E, wave); }
        { pg8::Gemm g{Z + 256, WUKV, 256, INWP, 256, nullptr, 0}; pg8::StaticOrder S; S.init(NTOK / 256, 1024 / 256, G, bx, nullptr);
          pg8::EpiKV E{Kb, Vb, SSQ}; pg8::gemm_phase<pg8::EpiKV, false>(lds, g, S, E, wave); }
    }
    SEAM(PH_TOKLOCAL);
    if (IN(PH_ATTN)) REPLOOP(PH_ATTN) {
        const int vcu = (G % 8 == 0) ? (bx % 8) * (G / 8) + bx / 8 : bx;
        using att::L_END; using att::cv_cmap1; using att::CV_N1; using att::CV_TOTAL;
        const att::ConvJob cj{w1, w2, moe_norm, (unsigned char*)W1T, (unsigned char*)W2T, gw, NGW}; int tseq = LASTREP(PH_ATTN) ? 0 : (1 << 20);
        for (int it = vcu; it < NB * NH * 8; it += G) { const int bh = it >> 3, pr = it & 7;
            for (int pass = 0; pass < 2; ++pass) att::attn_block(bh, pass ? pr : 15 - pr, Qb, Kb, Vb, MIX, ASSQ, lds, wave, cj, tseq); }
        if (LASTREP(PH_ATTN)) { const int lane = lane_id(), hi = lane >> 5, wid = wave; __syncthreads();
            for (int cv_idx = tseq * NGW + gw; cv_idx < att::CV_TOTAL; cv_idx += NGW) { CV_DECODE(cv_idx) float cvw[16]; CV_LOAD(); CV_STORE(); } }
    }
    SEAM(PH_ATTN);
    if (IN(PH_WO)) REPLOOP(PH_WO) {
        pg8::Gemm g{MIX, WO, DM, DM, DM, nullptr, 0}; pg8::StaticOrder S; S.init(NTOK / 256, DM / 256, G, bx, nullptr);
        pg8::EpiWo E{x, HBF, X8, ASSQ, SSQ1, moe_norm}; pg8::gemm_phase<pg8::EpiWo, false>(lds, g, S, E, wave, LASTREP(PH_WO));
    }
    SEAM(PH_WO);
    if (IN(PH_ROUTER)) REPLOOP(PH_ROUTER) {
        PHASE_LANE;
        typedef float f32x16 __attribute__((ext_vector_type(16)));
        LAS int* hist = (LAS int*)(lds + HIST_OFF); LAS f32x16* xch = (LAS f32x16*)(lds + HIST_OFF + 256);
        for (int i = tid; i < 2 * NE * 128; i += NTHREADS) { const int pe = i >> 7, kc = i & 127, e = pe & 31; *(LAS u32x4*)(lds + pe * 2048 + ((kc ^ (e & 15)) << 4)) = ((const u32x4*)WRHL)[i]; }
        if (tid < NE) hist[tid] = 0;
        __syncthreads();
        for (int chunk = bx; chunk < NTOK / 128; chunk += G) {
            const int base = chunk * 128, wq = wave & 3, kh = wave >> 2;
            const int j = lane & 31, half = lane >> 5, tok = base + wq * 32 + j;
            const bf16_t* xr = HBF + (size_t)tok * DM + kh * 512 + 8 * half; const LAS unsigned char* wrow = lds + j * 2048;
            f32x16 acc = {};
#pragma unroll 8
            for (int s = 0; s < 32; ++s) { const bf16x8 xb = *(const bf16x8*)(xr + 16 * s); const int kc = ((kh * 64 + 2 * s + half) ^ (j & 15)) << 4;
                const bf16x8 ah = *(const LAS bf16x8*)(wrow + kc), al = *(const LAS bf16x8*)(wrow + 65536 + kc);
                acc = __builtin_amdgcn_mfma_f32_32x32x16_bf16(ah, xb, acc, 0, 0, 0); acc = __builtin_amdgcn_mfma_f32_32x32x16_bf16(al, xb, acc, 0, 0, 0); }
            if (kh == 1) xch[wq * 64 + lane] = acc;
            __syncthreads();
            if (kh == 0) {
                const f32x16 other = xch[wq * 64 + lane];
                const f32x4 s0 = *(const f32x4*)(SSQ1 + (size_t)tok * 16 + 8 * half), s1 = *(const f32x4*)(SSQ1 + (size_t)tok * 16 + 8 * half + 4);
                float ss = ((s0[0] + s0[1]) + (s0[2] + s0[3])) + ((s1[0] + s1[1]) + (s1[2] + s1[3])); ss += __shfl_xor(ss, 32); const float rstd = rsqrtf(ss * (1.f / DM) + EPS);
                float v[16];
#pragma unroll
                for (int r = 0; r < 16; ++r) v[r] = (acc[r] + other[r]) * rstd + b_router[(r & 3) + 8 * (r >> 2) + 4 * half];
                float lv[4]; int li[4];
#pragma unroll
                for (int t = 0; t < 4; ++t) { float best = -__builtin_inff(); int bi = 0;
#pragma unroll
                    for (int r = 0; r < 16; ++r) if (v[r] > best) { best = v[r]; bi = (r & 3) + 8 * (r >> 2) + 4 * half; }
                    const auto rv = __builtin_amdgcn_permlane32_swap(__float_as_uint(best), __float_as_uint(best), false, false); const auto ri = __builtin_amdgcn_permlane32_swap((unsigned)bi, (unsigned)bi, false, false);
                    const float b0 = __uint_as_float(rv[0]), b1 = __uint_as_float(rv[1]); const int i0 = (int)ri[0], i1 = (int)ri[1];
                    const bool t0 = (b0 > b1) || (b0 == b1 && i0 < i1); const float gb = t0 ? b0 : b1; const int gi = t0 ? i0 : i1; lv[t] = gb; li[t] = gi;
#pragma unroll
                    for (int r = 0; r < 16; ++r) if ((r & 3) + 8 * (r >> 2) + 4 * half == gi) v[r] = -__builtin_inff(); }
                if (half == 0) { const float e1 = __expf(lv[1] - lv[0]), e2 = __expf(lv[2] - lv[0]), e3 = __expf(lv[3] - lv[0]); const float inv = 1.f / (1.f + e1 + e2 + e3);
                    *(int4*)(TOPI + (size_t)tok * 4) = make_int4(li[0], li[1], li[2], li[3]); *(f32x4*)(TOPG + (size_t)tok * 4) = (f32x4){inv, e1 * inv, e2 * inv, e3 * inv}; RS1[tok] = rstd;
#pragma unroll
                    for (int t = 0; t < 4; ++t) (void)__hip_atomic_fetch_add(hist + li[t], 1, __ATOMIC_RELAXED, __HIP_MEMORY_SCOPE_WORKGROUP); }
            }
            __syncthreads();
        }
        if (tid < NE && LASTREP(PH_ROUTER)) atomicAdd(ctl + CW_CNT + tid, hist[tid]);
        __syncthreads();
    }
    SEAM(PH_ROUTER);
    if (IN(PH_ROUTE)) {
        PHASE_LANE;
        LAS int* sh = (LAS int*)lds;
        if (tid == 0) { int ps = 0, nt = 0;
            for (int e = 0; e < NE; ++e) { sh[e] = ps; const int t = (ctl[CW_CNT + e] + 255) >> 8; if (bx == 0) for (int q = 0; q < t; ++q) ctl[CW_TILE_E + nt + q] = e; nt += t; ps += t * 256; }
            sh[NE] = ps; if (bx == 0) ctl[CW_NTILES] = nt; }
        __syncthreads();
        for (int chunk = bx; chunk < MROWS / NTHREADS; chunk += G) {
            if (tid < NE) sh[64 + tid] = 0;
            __syncthreads();
            const int idx = chunk * NTHREADS + tid, e = TOPI[idx]; const int r = __hip_atomic_fetch_add(sh + 64 + e, 1, __ATOMIC_RELAXED, __HIP_MEMORY_SCOPE_WORKGROUP);
            __syncthreads();
            if (tid < NE) sh[128 + tid] = atomicAdd(ctl + CW_CURSOR + tid, sh[64 + tid]);
            __syncthreads();
            const int dest = sh[e] + sh[128 + e] + r; ROWTOK[dest] = idx >> 2; ROWSLOT[dest] = idx; ROWGATE[dest] = TOPG[idx]; ROWRS[dest] = RS1[idx >> 2];
            __syncthreads();
        }
        for (int e = bx; e < NE; e += G) { const int plo = sh[e] + ctl[CW_CNT + e], phi = sh[e + 1];
            for (int r = plo + tid; r < phi; r += NTHREADS) { ROWTOK[r] = 0; ROWSLOT[r] = MROWS; ROWGATE[r] = 0.f; ROWRS[r] = 0.f; } }
        __syncthreads();
    }
    SEAM(PH_ROUTE);
    if (IN(PH_MOE1)) REPLOOP(PH_MOE1) {
        pg8::Gemm g{X8, W1T, DM, DM, DM, ROWTOK, (size_t)2048 * DM}; pg8::StaticOrder S; S.init(ctl[CW_NTILES], 2048 / 256, G, bx, ctl + CW_TILE_E);
        pg8::EpiMoe1 E{(unsigned char*)HB, b1, ROWRS}; pg8::gemm_phase<pg8::EpiMoe1, true, true>(lds, g, S, E, wave, LASTREP(PH_MOE1));
    }
    SEAM(PH_MOE1);
    if (IN(PH_MOE2)) REPLOOP(PH_MOE2) {
        pg8::Gemm g{HB, W2T, DE, DE, DE, nullptr, (size_t)DM * DE}; pg8::StaticOrder S; S.init(ctl[CW_NTILES], DM / 256, G, bx, ctl + CW_TILE_E);
        pg8::EpiMoe2 E{(unsigned char*)Y, b2, ROWSLOT, ROWGATE}; pg8::gemm_phase<pg8::EpiMoe2, false, true>(lds, g, S, E, wave, LASTREP(PH_MOE2));
    }
    SEAM(PH_MOE2);
    if (IN(PH_COMBINE)) REPLOOP(PH_COMBINE) {
        PHASE_LANE;
        for (int row = gw * 2; row < NTOK; row += NGW * 2) {
            u32x4 hv[2][2]; u32x2 yv[2][4][2]; const unsigned char* Y8 = (const unsigned char*)Y;
#pragma unroll
            for (int q = 0; q < 2; ++q)
#pragma unroll
                for (int j = 0; j < 2; ++j) { hv[q][j] = *(const u32x4*)(HBF + (size_t)(row + q) * DM + (lane + 64 * j) * 8);
#pragma unroll
                    for (int k = 0; k < 4; ++k) yv[q][k][j] = *(const u32x2*)(Y8 + ((size_t)(row + q) * 4 + k) * DM + (lane + 64 * j) * 8); }
#pragma unroll
            for (int q = 0; q < 2; ++q) { float ss = 0.f; u32x4 ov[2];
#pragma unroll
                for (int j = 0; j < 2; ++j) { f32x4 a = {blo(hv[q][j].x), bhi(hv[q][j].x), blo(hv[q][j].y), bhi(hv[q][j].y)}, b = {blo(hv[q][j].z), bhi(hv[q][j].z), blo(hv[q][j].w), bhi(hv[q][j].w)};
#pragma unroll
                    for (int k = 0; k < 4; ++k) { const u32x2 y = yv[q][k][j]; const f32x2 y0 = __builtin_amdgcn_cvt_pk_f32_fp8(y.x, false), y1 = __builtin_amdgcn_cvt_pk_f32_fp8(y.x, true), y2 = __builtin_amdgcn_cvt_pk_f32_fp8(y.y, false), y3 = __builtin_amdgcn_cvt_pk_f32_fp8(y.y, true);
                        a += (f32x4){y0[0], y0[1], y1[0], y1[1]}; b += (f32x4){y2[0], y2[1], y3[0], y3[1]}; }
                    ss += pg8::sq4(a) + pg8::sq4(b); ov[j] = pg8::pack8(a, b); }
                ss = wave_sum(ss);
                bf16_t* ho = LASTREP(PH_COMBINE) ? HBF : (bf16_t*)(ws + WS_HB);
#pragma unroll
                for (int j = 0; j < 2; ++j) *(u32x4*)(ho + (size_t)(row + q) * DM + (lane + 64 * j) * 8) = ov[j];
                float ps = lane < 16 ? PSSQ[(size_t)(row + q) * 16 + lane] : 0.f; ps += __shfl_xor(ps, 1); ps += __shfl_xor(ps, 2); ps += __shfl_xor(ps, 4); ps += __shfl_xor(ps, 8);
                if (lane == 0) { RS2[row + q] = rsqrtf(ss * (1.f / DM) + EPS); RS2[NTOK + row + q] = rsqrtf(ps * (1.f / DM) + EPS); } }
        }
    }
    SEAM(PH_COMBINE);
    if (IN(PH_PLE)) REPLOOP(PH_PLE) {
        pg8::Gemm g{HBF, WG, DM, DM, DM, nullptr, 0}; pg8::StaticOrder S; S.init(NTOK / 256, DM / 256, G, bx, nullptr);
        pg8::EpiPle E{HBF, H3, PLER, RS2 + NTOK, RS2, ple_post_norm, FSSQ}; pg8::gemm_phase<pg8::EpiPle, false>(lds, g, S, E, wave);
    }
    SEAM(PH_PLE);
    if (IN(PH_FINAL)) REPLOOP(PH_FINAL) {
        PHASE_LANE;
        for (int row = gw * 2; row < NTOK; row += NGW * 2) {
            u32x4 hv[2][2]; float sp[2];
#pragma unroll
            for (int q = 0; q < 2; ++q) { sp[q] = lane < 16 ? FSSQ[(size_t)(row + q) * 16 + lane] : 0.f;
#pragma unroll
                for (int j = 0; j < 2; ++j) hv[q][j] = *(const u32x4*)(H3 + (size_t)(row + q) * DM + (lane + 64 * j) * 8); }
#pragma unroll
            for (int q = 0; q < 2; ++q) { float s = sp[q]; s += __shfl_xor(s, 1); s += __shfl_xor(s, 2); s += __shfl_xor(s, 4); s += __shfl_xor(s, 8);
                const float rstd = rsqrtf(__shfl(s, 0) * (1.f / DM) + EPS); float* ho = (LASTREP(PH_FINAL) ? H : (float*)(ws + WS_HB)) + (size_t)(row + q) * DM;
#pragma unroll
                for (int j = 0; j < 2; ++j) { const int c = (lane + 64 * j) * 8; const f32x4 g0 = *(const f32x4*)(final_norm + c), g1 = *(const f32x4*)(final_norm + c + 4); const u32x4 v = hv[q][j];
                    *(f32x4*)(ho + c) = (f32x4){blo(v.x), bhi(v.x), blo(v.y), bhi(v.y)} * rstd * g0; *(f32x4*)(ho + c + 4) = (f32x4){blo(v.z), bhi(v.z), blo(v.w), bhi(v.w)} * rstd * g1; } }
        }
    }
#ifdef PROBE_TIME_PH
    STAMP(PH_COUNT);
    if (bx == 0 && wave == 0) { const unsigned dt = MISC[32 + PROBE_TIME_PH + 1] - MISC[32 + PROBE_TIME_PH]; const unsigned long long t0 = __builtin_amdgcn_s_memrealtime(); while (__builtin_amdgcn_s_memrealtime() - t0 < (unsigned long long)dt) __builtin_amdgcn_s_sleep(8); }
#endif
#ifdef PROBE_BARS
    if (hi - lo > 1) for (int i = 0; i < PROBE_BARS; ++i) xcd_barrier(bar, wave);
#endif
#undef IN
#undef NREP
#undef REPLOOP
#undef LASTREP
#undef SEAM
}
static int g_grid = 0;
extern "C" void kernel_launch(void* const* d_in, const int* in_sizes, int n_in, void* d_out, int out_size, void* d_ws, size_t ws_size, hipStream_t stream) {
    if (n_in != 25 || in_sizes[0] != NTOK * DM || out_size != NTOK * DM || ws_size < WS_END) {
        fprintf(stderr, "kernel_launch: unexpected shapes (n_in %d, in0 %d, out %d, ws %zu need %zu)\n", n_in, n_in > 0 ? in_sizes[0] : -1, out_size, ws_size, (size_t)WS_END); return; }
    if (g_grid == 0) {
        int dev = 0, cus = 0, per_cu = 0; (void)hipGetDevice(&dev); (void)hipDeviceGetAttribute(&cus, hipDeviceAttributeMultiprocessorCount, dev);
        if (hipFuncSetAttribute((const void*)fwd, hipFuncAttributeMaxDynamicSharedMemorySize, LDS_BYTES) != hipSuccess) fprintf(stderr, "hipFuncSetAttribute failed\n");
        if (hipOccupancyMaxActiveBlocksPerMultiprocessor(&per_cu, (const void*)fwd, NTHREADS, LDS_BYTES) != hipSuccess || per_cu < 1) { fprintf(stderr, "occupancy query: %d\n", per_cu); per_cu = 1; }
        (void)hipGetLastError();
        g_grid = cus > 0 ? cus : 256;
    }
    (void)hipMemsetAsync((unsigned char*)d_ws + WS_CTL, 0, 64 * 1024, stream);
    Args a{}; for (int i = 0; i < 25; ++i) a.in[i] = d_in[i]; a.out = (float*)d_out; a.ws = (unsigned char*)d_ws;
    a.ph_lo = 0; a.ph_hi = PH_COUNT; a.li = 0; a.skip = 0;
    void* p[] = {&a};
    const hipError_t e = hipLaunchCooperativeKernel((const void*)fwd, dim3(g_grid), dim3(NTHREADS), p, LDS_BYTES, stream);
    if (e != hipSuccess) fprintf(stderr, "cooperative launch failed: %s (grid %d)\n", hipGetErrorString(e), g_grid);
}
```

```cpp
#include <hip/hip_runtime.h>
#include <cstdint>
#include <cstdio>
#include <cmath>

typedef unsigned short bf16_t;

constexpr int NB = 8, SEQ = 4096, DM = 1024, NTOK = NB * SEQ;
constexpr int PLE = 256, NH = 4, DN = 128, DR = 64, DV = 128, QL = 256, KVL = 128, DQK = DN + DR;
constexpr int INW = 1984, INWP = 2048;
constexpr int NE = 32, TOPK = 4, DE = 1024;
constexpr int MROWS = NTOK * TOPK;
constexpr int MAXTILES = MROWS / 256 + NE;
constexpr int PROWS = MAXTILES * 256;
constexpr float EPS = 1e-6f;
constexpr float QSCALE = 0.07216878364870322f * 1.4426950408889634f;

constexpr size_t MiB = 1u << 20;
constexpr size_t WS_CTL = 0;
constexpr size_t WS_WIN = 1 * MiB, WS_WUQ = 5 * MiB, WS_WUKV = 5 * MiB + 512 * 1024, WS_WO = 6 * MiB, WS_WG = 8 * MiB, WS_WP = 10 * MiB;
constexpr size_t WS_WR = 10 * MiB + 512 * 1024;
constexpr size_t WS_CS = 11 * MiB;
constexpr size_t WS_SSQ = 19 * MiB, WS_ASSQ = 20 * MiB, WS_PSSQ = 21 * MiB, WS_FSSQ = 23 * MiB;
constexpr size_t WS_TOPI = 25 * MiB, WS_TOPG = 25 * MiB + 512 * 1024;
constexpr size_t WS_ROWTOK = 26 * MiB, WS_ROWSLOT = 27 * MiB, WS_ROWGATE = 28 * MiB;
constexpr size_t WS_P16 = 29 * MiB;
constexpr size_t WS_SSQ1 = 45 * MiB, WS_RS1 = 47 * MiB, WS_RS2 = 47 * MiB + 128 * 1024, WS_ROWRS = 47 * MiB + 384 * 1024;
constexpr size_t WS_WRHL = 10 * MiB + 768 * 1024;
constexpr size_t WS_HBF = 112 * MiB;
constexpr size_t WS_H3 = 304 * MiB;
constexpr size_t WS_W1 = 48 * MiB, WS_W2 = 176 * MiB, WS_XN = 240 * MiB, WS_MIX = 304 * MiB, WS_PLER = 368 * MiB;
constexpr size_t WS_Z = 432 * MiB, WS_Q = 560 * MiB, WS_K = 608 * MiB, WS_V = 656 * MiB;
constexpr size_t WS_HB = 432 * MiB;
constexpr size_t WS_Y = 704 * MiB;
constexpr size_t WS_END = WS_Y + (size_t)(MROWS + 256) * DM * 2;
constexpr int CW_CNT = 0, CW_CURSOR = 64, CW_PADSTART = 128, CW_NTILES = 192, CW_TILE_E = 256;

__device__ __forceinline__ float bf2f(bf16_t v) { return __uint_as_float((unsigned)v << 16); }
__device__ __forceinline__ float blo(unsigned u) { return __uint_as_float(u << 16); }
__device__ __forceinline__ float bhi(unsigned u) { return __uint_as_float(u & 0xffff0000u); }
__device__ __forceinline__ bf16_t f2bf(float f) { unsigned u = __float_as_uint(f); return (bf16_t)((u + 0x7fffu + ((u >> 16) & 1u)) >> 16); }
__device__ __forceinline__ unsigned pk2(float lo, float hi) { return (unsigned)f2bf(lo) | ((unsigned)f2bf(hi) << 16); }
__device__ __forceinline__ float wave_sum(float v) {
#pragma unroll
    for (int o = 1; o < 64; o <<= 1) v += __shfl_xor(v, o);
    return v;
}
__device__ __forceinline__ float wave_max(float v) {
#pragma unroll
    for (int o = 1; o < 64; o <<= 1) v = fmaxf(v, __shfl_xor(v, o));
    return v;
}
__device__ __forceinline__ float dot8(uint4 x, uint4 y) {
    return blo(x.x) * blo(y.x) + bhi(x.x) * bhi(y.x) + blo(x.y) * blo(y.y) + bhi(x.y) * bhi(y.y) +
           blo(x.z) * blo(y.z) + bhi(x.z) * bhi(y.z) + blo(x.w) * blo(y.w) + bhi(x.w) * bhi(y.w);
}
__device__ __forceinline__ float dot_bf16(const bf16_t* a, const bf16_t* b, int K) {
    const uint4* a4 = (const uint4*)a; const uint4* b4 = (const uint4*)b; float acc = 0.f;
    for (int i = 0; i < K / 8; ++i) acc += dot8(a4[i], b4[i]);
    return acc;
}

#define LAS __attribute__((address_space(3)))
#define GAS __attribute__((address_space(1)))
typedef short bf16x8 __attribute__((ext_vector_type(8)));
typedef float f32x4 __attribute__((ext_vector_type(4)));
typedef float f32x2 __attribute__((ext_vector_type(2)));
typedef unsigned u32x4 __attribute__((ext_vector_type(4)));
typedef unsigned u32x2 __attribute__((ext_vector_type(2)));
#ifndef PROBE_PH
#define PROBE_PH (-1)
#define PROBE_REP 1
#endif
#ifndef MOE2_DELAY_TICKS
#define MOE2_DELAY_TICKS 700ull
#endif
constexpr int NWAVES = 8, NTHREADS = 512;
constexpr int RING_BYTES = 131072, MISC_OFF = RING_BYTES, HIST_OFF = MISC_OFF + 256, LDS_BYTES = 163840;
constexpr int CW_BAR = 4096;
__device__ __forceinline__ unsigned cvt_pk_bf16(float lo, float hi) { unsigned r; asm volatile("v_cvt_pk_bf16_f32 %0, %1, %2" : "=v"(r) : "v"(lo), "v"(hi)); return r; }
__device__ __forceinline__ int lane_id() { int l = (int)__builtin_amdgcn_mbcnt_hi(~0u, __builtin_amdgcn_mbcnt_lo(~0u, 0u)); asm volatile("" : "+v"(l)); return l; }
__device__ __forceinline__ float fast_sigmoid(float a) { return __builtin_amdgcn_rcpf(1.f + __expf(-a)); }

#define XB_TMO      128
#define XB_XCNT(j)  (256  + 64 * (j))
#define XB_XSUB(j)  (1280 + 64 * (j))
#define XB_XGEN(j)  (2304 + 64 * (j))
#define XB_TOP      3328
#define XB_TOPGEN   3392
#define XCD_BAR_WORDS 3456
#define XB_SPIN_CAP (1u << 20)
__device__ __forceinline__ unsigned xb_ld(unsigned* p)              { return __hip_atomic_load(p, __ATOMIC_RELAXED, __HIP_MEMORY_SCOPE_AGENT); }
__device__ __forceinline__ unsigned xb_add(unsigned* p, unsigned v) { return __hip_atomic_fetch_add(p, v, __ATOMIC_RELAXED, __HIP_MEMORY_SCOPE_AGENT); }
__device__ __forceinline__ unsigned xb_xcc_id() { return (unsigned)__builtin_amdgcn_s_getreg((3 << 11) | 20) & 0xFu; }
#define XB_SPIN(cond, bar) do { unsigned _sp = 0; while (cond) { __builtin_amdgcn_s_sleep(1); \
    if ((++_sp & 255u) == 0u) { if (xb_ld(&(bar)[XB_TMO])) break; if (_sp > XB_SPIN_CAP) { atomicAdd(&(bar)[XB_TMO], 1u); break; } } } } while (0)
struct XcdBarrier { unsigned* bar; unsigned x; volatile LAS unsigned* st; };
__device__ __forceinline__ XcdBarrier xcd_barrier_post(unsigned* bar, volatile LAS unsigned* st, int wave) {
    XcdBarrier b; b.bar = bar; b.x = xb_xcc_id(); b.st = st;
    if (wave == 0 && lane_id() == 0) (void)xb_add(&bar[XB_XCNT(b.x)], 1u);
    return b;
}
__device__ __forceinline__ void xcd_barrier_complete(unsigned* bar, unsigned x, unsigned& nloc, unsigned& nx) {
    const unsigned G = gridDim.x * gridDim.y * gridDim.z;
    unsigned sum, cnt, mine, sp = 0u;
    for (;;) {
        sum = 0u; cnt = 0u; mine = 0u;
#pragma unroll
        for (unsigned j = 0; j < 16; ++j) { const unsigned c = xb_ld(&bar[XB_XCNT(j)]); sum += c; cnt += (c > 0u) ? 1u : 0u; mine = (j == x) ? c : mine; }
        if (sum == G) break;
        __builtin_amdgcn_s_sleep(1);
        if ((++sp & 255u) == 0u) { if (xb_ld(&bar[XB_TMO])) break; if (sp > XB_SPIN_CAP) { atomicAdd(&bar[XB_TMO], 1u); break; } }
    }
    nloc = mine > 0u ? mine : 1u; nx = cnt > 0u ? cnt : 1u;
}
__device__ __forceinline__ void xcd_barrier(const XcdBarrier& b, int wave) {
    asm volatile("s_waitcnt vmcnt(0)" ::: "memory");
    __syncthreads();
    if (wave == 0 && lane_id() == 0) {
        unsigned* bar = b.bar;
        __builtin_amdgcn_s_waitcnt(0);
        unsigned nloc = b.st[0], nx = b.st[1];
        if (nloc == 0u) { xcd_barrier_complete(bar, b.x, nloc, nx); b.st[0] = nloc; b.st[1] = nx; }
        const unsigned old = xb_add(&bar[XB_XSUB(b.x)], 1u);
        const unsigned gen = old / nloc;
        if (old + 1u == (gen + 1u) * nloc) {
            __builtin_amdgcn_fence(__ATOMIC_RELEASE, "agent");
            asm volatile("s_waitcnt vmcnt(0)" ::: "memory");
            const unsigned og = xb_add(&bar[XB_TOP], 1u);
            const unsigned tg = og / nx;
            if (og + 1u == (tg + 1u) * nx) xb_add(&bar[XB_TOPGEN], 1u);
            else XB_SPIN(xb_ld(&bar[XB_TOPGEN]) == tg, bar);
            __builtin_amdgcn_fence(__ATOMIC_ACQUIRE, "agent");
            xb_add(&bar[XB_XGEN(b.x)], 1u);
            asm volatile("s_waitcnt vmcnt(0)" ::: "memory");
        } else {
            XB_SPIN(xb_ld(&bar[XB_XGEN(b.x)]) == gen, bar);
            __builtin_amdgcn_fence(__ATOMIC_ACQUIRE, "agent");
            asm volatile("s_waitcnt vmcnt(0)" ::: "memory");
        }
    }
    __syncthreads();
}

namespace pg8 {
constexpr int BM = 256, BK = 64, HALF = 128, HTB = HALF * BK * 2, STAGE_BYTES = 8 * HTB, NXCD = 8, WGM = 8;
__host__ __device__ __forceinline__ int lds_byte(int r, int c) { const int st = (r >> 4) * 2 + (c >> 5), rr = r & 15, cc = c & 31, ob = rr * 64 + cc * 2; return st * 1024 + (ob ^ (((ob >> 9) & 1) << 5)); }
__host__ __device__ __forceinline__ void stage_rc(int b, int& R, int& C) { const int st = b / 1024, sb = b % 1024, swz = sb ^ (((sb >> 9) & 1) << 5); R = (st >> 1) * 16 + swz / 64; C = (st & 1) * 32 + (swz % 64) / 2; }
__host__ __device__ __forceinline__ int perm32(int rho) { const int n = rho >> 4, i = rho & 15; return 8 * (i >> 2) + 4 * n + (i & 3); }
struct Unit { int pm, pn, e; };
struct Gemm { const void* A; const void* Bt; int K, lda, ldb; const int* rowidx; size_t bstride; };
struct StaticOrder {
    int nM, nN, nwg, G, c; const int* tile_e;
    __device__ void init(int nM_, int nN_, int G_, int c_, const int* te) { nM = nM_; nN = nN_; nwg = nM * nN; G = G_; c = c_; tile_e = te; }
    __device__ bool next(int i, Unit& u) const {
        const long L = (long)i * G + c; if (L >= nwg) return false;
        int wgid = (int)L; { const int q = nwg / NXCD, r = nwg % NXCD, xcd = wgid % NXCD, off = wgid / NXCD; wgid = (xcd < r ? xcd * (q + 1) : r * (q + 1) + (xcd - r) * q) + off; }
        const int nig = WGM * nN, gid = wgid / nig, fm = gid * WGM, gsz = (nM - fm) < WGM ? (nM - fm) : WGM;
        u.pm = fm + ((wgid % nig) % gsz); u.pn = (wgid % nig) / gsz; u.e = tile_e ? tile_e[u.pm] : 0; return true;
    }
};
typedef f32x4 Acc[2][2][4][2];
typedef int v8i_t __attribute__((ext_vector_type(8)));
typedef int v4i_t __attribute__((ext_vector_type(4)));
template <class Epi, bool GATHER, bool FP8 = false>
__device__ __forceinline__ void gemm_phase(LAS unsigned char* lds, const Gemm g, const StaticOrder& S, const Epi& E, const int wid, const bool do_epi = true) {
    const int lane = lane_id(), tid = wid * 64 + lane, wr = wid >> 2, wc = wid & 3, fr = lane & 15, fq = lane >> 4;
    constexpr int ES = FP8 ? 1 : 2;
    const int K = g.K, nt = K * ES / 128;
    int RA[2], CA[2]; unsigned voffB[2], voffA[2];
#pragma unroll
    for (int i = 0; i < 2; ++i) { int R, C; stage_rc(tid * 16 + i * 8192, R, C); const int Rb = Epi::PERM ? ((R & ~31) + perm32(R & 31)) : R;
        RA[i] = R; CA[i] = C; voffB[i] = (unsigned)(Rb * g.ldb * ES + C * 2); voffA[i] = (unsigned)(R * g.lda * ES + C * 2); }
    const size_t hstepA = GATHER ? 0 : (size_t)HALF * g.lda * ES;
    const size_t kstep = (size_t)(BK * 2);
    const size_t hstepB = (size_t)HALF * g.ldb * ES;
    const unsigned ldsw = (unsigned)wid * 1024u;
    const int aoff = lds_byte(wr * 64 + fr, fq * 8), boff = lds_byte(wc * 32 + fr, fq * 8);
#define PG8_SA(b, h) (((b) * 2 + (h)) * HTB)
#define PG8_SB(b, h) ((4 + (b) * 2 + (h)) * HTB)
#define PG8_STAGE(bufoff, gbase, voff) do { _Pragma("unroll") for (int _i = 0; _i < 2; ++_i) \
        __builtin_amdgcn_global_load_lds((const unsigned*)((const char*)(gbase) + (voff)[_i]), (LAS unsigned*)(lds + (bufoff) + ldsw + _i * 8192), 16, 0, 0); } while (0)
#define PG8_LDA(dst, b, h) do { _Pragma("unroll") for (int m = 0; m < 4; ++m) _Pragma("unroll") for (int k = 0; k < 2; ++k) dst[m][k] = *(const LAS bf16x8*)(lds + PG8_SA(b, h) + aoff + m * 2048 + k * 1024); } while (0)
#define PG8_LDB(dst, b, h) do { _Pragma("unroll") for (int n = 0; n < 2; ++n) _Pragma("unroll") for (int k = 0; k < 2; ++k) dst[n][k] = *(const LAS bf16x8*)(lds + PG8_SB(b, h) + boff + n * 2048 + k * 1024); } while (0)
#define PG8_CAT8(x) __builtin_shufflevector(__builtin_bit_cast(v4i_t, (x)[0]), __builtin_bit_cast(v4i_t, (x)[1]), 0, 1, 2, 3, 4, 5, 6, 7)
#define PG8_MMA(ai, bj, At, Bt) do { __builtin_amdgcn_s_setprio(1); if constexpr (FP8) { _Pragma("unroll") for (int m = 0; m < 4; ++m) _Pragma("unroll") for (int n = 0; n < 2; ++n) \
        acc[ai][bj][m][n] = __builtin_amdgcn_mfma_scale_f32_16x16x128_f8f6f4(PG8_CAT8(Bt[n]), PG8_CAT8(At[m]), acc[ai][bj][m][n], 0, 0, 0, 0x7f7f7f7f, 0, 0x7f7f7f7f); \
        _Pragma("unroll") for (int m = 0; m < 4; ++m) _Pragma("unroll") for (int n = 0; n < 2; ++n) asm volatile("" : "+v"(acc[ai][bj][m][n]));   } else { \
        _Pragma("unroll") for (int m = 0; m < 4; ++m) _Pragma("unroll") for (int n = 0; n < 2; ++n) _Pragma("unroll") for (int k = 0; k < 2; ++k) \
        acc[ai][bj][m][n] = __builtin_amdgcn_mfma_f32_16x16x32_bf16(Bt[n][k], At[m][k], acc[ai][bj][m][n], 0, 0, 0); } __builtin_amdgcn_s_setprio(0); } while (0)
#define PG8_WAIT_V(n) asm volatile("s_waitcnt vmcnt(" #n ")" ::: "memory")
#define PG8_WAIT_L(n) asm volatile("s_waitcnt lgkmcnt(" #n ")" ::: "memory")
#define PG8_BAR __builtin_amdgcn_s_barrier()
#define PG8_SCHED __builtin_amdgcn_sched_barrier(0)
#define PG8_SETVO(vo, u) do { if constexpr (GATHER) { _Pragma("unroll") for (int _h = 0; _h < 2; ++_h) _Pragma("unroll") for (int _i = 0; _i < 2; ++_i) { \
        const int _row = g.rowidx[(u).pm * BM + _h * HALF + RA[_i]]; (vo)[_h][_i] = (unsigned)_row * (unsigned)(g.lda * ES) + (unsigned)CA[_i] * 2u; } } } while (0)
#define PG8_STAGE_A(bufoff, base, h, vog) do { if constexpr (GATHER) { PG8_STAGE(bufoff, base, (vog)[h]); } else { PG8_STAGE(bufoff, (base) + (h) * hstepA, voffA); } } while (0)
    Unit cur, nxt; int ui = 0;
    if (!S.next(0, cur)) return;
    Acc acc;
#pragma unroll
    for (int a = 0; a < 2; ++a)
#pragma unroll
        for (int b = 0; b < 2; ++b)
#pragma unroll
            for (int m = 0; m < 4; ++m)
#pragma unroll
                for (int n = 0; n < 2; ++n) acc[a][b][m][n] = (f32x4){0.f, 0.f, 0.f, 0.f};
    bf16x8 At[4][2], B0[2][2], B1[2][2];
    unsigned voC[2][2], voN[2][2];
    PG8_SETVO(voC, cur);
    const char* const Ab = (const char*)g.A;
    const char* cA = GATHER ? Ab : Ab + (size_t)cur.pm * 2 * hstepA;
    const char* cB = (const char*)g.Bt + (size_t)cur.e * g.bstride + (size_t)cur.pn * 2 * hstepB;
    PG8_STAGE(PG8_SB(0, 0), cB, voffB); PG8_STAGE(PG8_SB(0, 1), cB + hstepB, voffB); PG8_STAGE_A(PG8_SA(0, 0), cA, 0, voC); PG8_STAGE_A(PG8_SA(0, 1), cA, 1, voC);
    if (wr == 1) PG8_BAR;
    PG8_WAIT_V(2); PG8_BAR;
    PG8_STAGE(PG8_SB(1, 0), cB + kstep, voffB); PG8_STAGE_A(PG8_SA(1, 0), cA + kstep, 0, voC); PG8_STAGE(PG8_SB(1, 1), cB + hstepB + kstep, voffB);
    PG8_WAIT_V(6); PG8_BAR;
    for (;;) {
        const bool has_next = S.next(ui + 1, nxt);
        const char* nB = has_next ? (const char*)g.Bt + (size_t)nxt.e * g.bstride + (size_t)nxt.pn * 2 * hstepB : cB;
        const char* nA = (has_next && !GATHER) ? Ab + (size_t)nxt.pm * 2 * hstepA : cA;
        if constexpr (GATHER) { if (has_next) { PG8_SETVO(voN, nxt); } else {
#pragma unroll
            for (int h = 0; h < 2; ++h)
#pragma unroll
                for (int i = 0; i < 2; ++i) voN[h][i] = voC[h][i]; } }
        for (int t = 0; t < nt; t += 2) {
            const bool last = (t == nt - 2);
            if constexpr (Epi::MIDK > 0) { if (t == Epi::MIDK) { const int l2 = lane_id(); E.mid(acc, cur, wr, wc, l2 & 15, l2 >> 4); } }
            const char* a1 = cA + (size_t)(t + 1) * kstep;
            const char* a2 = last ? nA : cA + (size_t)(t + 2) * kstep; const char* b2 = last ? nB : cB + (size_t)(t + 2) * kstep;
            const char* a3 = a2 + kstep; const char* b3 = b2 + kstep;
            unsigned o2[2][2];
            if constexpr (GATHER) {
#pragma unroll
            for (int h = 0; h < 2; ++h)
#pragma unroll
                for (int i = 0; i < 2; ++i) o2[h][i] = last ? voN[h][i] : voC[h][i]; }
            PG8_LDB(B0, 0, 0); PG8_LDB(B1, 0, 1); PG8_SCHED; PG8_LDA(At, 0, 0); PG8_STAGE_A(PG8_SA(1, 1), a1, 1, voC);
            PG8_WAIT_V(8); PG8_WAIT_L(0); PG8_BAR; PG8_MMA(0, 0, At, B0); PG8_MMA(0, 1, At, B1); PG8_BAR; PG8_SCHED;
            PG8_LDA(At, 0, 1); PG8_STAGE(PG8_SB(0, 0), b2, voffB); PG8_STAGE(PG8_SB(0, 1), b2 + hstepB, voffB); PG8_STAGE_A(PG8_SA(0, 0), a2, 0, o2);
            PG8_WAIT_V(8); PG8_WAIT_L(0); PG8_BAR; PG8_MMA(1, 0, At, B0); PG8_MMA(1, 1, At, B1); PG8_BAR; PG8_SCHED;
            PG8_LDB(B0, 1, 0); PG8_LDB(B1, 1, 1); PG8_SCHED; PG8_LDA(At, 1, 0); PG8_STAGE_A(PG8_SA(0, 1), a2, 1, o2);
            PG8_WAIT_V(8); PG8_WAIT_L(0); PG8_BAR; PG8_MMA(0, 0, At, B0); PG8_MMA(0, 1, At, B1); PG8_BAR; PG8_SCHED;
            PG8_LDA(At, 1, 1); PG8_STAGE(PG8_SB(1, 0), b3, voffB); PG8_STAGE(PG8_SB(1, 1), b3 + hstepB, voffB); PG8_STAGE_A(PG8_SA(1, 0), a3, 0, o2);
            PG8_WAIT_V(8); PG8_WAIT_L(0); PG8_BAR; PG8_MMA(1, 0, At, B0); PG8_MMA(1, 1, At, B1); PG8_BAR; PG8_SCHED;
        }
        if (wr == 0) PG8_BAR;
        if (do_epi) { const int l2 = lane_id(); E(acc, cur, wr, wc, l2 & 15, l2 >> 4); }
        if (!has_next) break;
#pragma unroll
        for (int a = 0; a < 2; ++a)
#pragma unroll
            for (int b = 0; b < 2; ++b)
#pragma unroll
                for (int m = 0; m < 4; ++m)
#pragma unroll
                    for (int n = 0; n < 2; ++n) acc[a][b][m][n] = (f32x4){0.f, 0.f, 0.f, 0.f};
        cur = nxt; cB = nB; cA = nA; ++ui;
        if constexpr (GATHER) {
#pragma unroll
        for (int h = 0; h < 2; ++h)
#pragma unroll
            for (int i = 0; i < 2; ++i) voC[h][i] = voN[h][i]; }
        if (wr == 1) PG8_BAR;
    }
    PG8_WAIT_V(0);
    PG8_BAR;
#undef PG8_SA
#undef PG8_SB
#undef PG8_STAGE
#undef PG8_LDA
#undef PG8_LDB
#undef PG8_MMA
#undef PG8_CAT8
#undef PG8_WAIT_V
#undef PG8_WAIT_L
#undef PG8_BAR
#undef PG8_SCHED
#undef PG8_SETVO
#undef PG8_STAGE_A
}

__device__ __forceinline__ unsigned pk4_fp8(f32x4 v) { unsigned w = 0; w = __builtin_amdgcn_cvt_pk_fp8_f32(v[0], v[1], w, false); w = __builtin_amdgcn_cvt_pk_fp8_f32(v[2], v[3], w, true); return w; }
__device__ __forceinline__ float sq4(f32x4 v) { return (v[0] * v[0] + v[1] * v[1]) + (v[2] * v[2] + v[3] * v[3]); }
__device__ __forceinline__ float red_fq(float s) { s += __shfl_xor(s, 16); s += __shfl_xor(s, 32); return s; }
__device__ __forceinline__ u32x4 pack8(f32x4 a, f32x4 b) { u32x4 w; w.x = cvt_pk_bf16(a[0], a[1]); w.y = cvt_pk_bf16(a[2], a[3]); w.z = cvt_pk_bf16(b[0], b[1]); w.w = cvt_pk_bf16(b[2], b[3]); return w; }
template <int MODE> struct EpiBf16Stats {
    static constexpr bool PERM = true; static constexpr int MIDK = 0;
    bf16_t* O; int ldc; float* ssq;
    __device__ __forceinline__ void operator()(const Acc& acc, const Unit& u, int wr, int wc, int fr, int fq) const {
        const int row0 = u.pm * BM + wr * 64 + fr, col0 = u.pn * BM + wc * 32 + 8 * fq;
#pragma unroll
        for (int ai = 0; ai < 2; ++ai)
#pragma unroll
            for (int m = 0; m < 4; ++m) { const int row = row0 + ai * HALF + m * 16; bf16_t* rowp = O + (size_t)row * ldc + col0;
#pragma unroll
                for (int bj = 0; bj < 2; ++bj) *(u32x4*)(rowp + bj * HALF) = pack8(acc[ai][bj][m][0], acc[ai][bj][m][1]);
                if (MODE == 1) { float s = (sq4(acc[ai][0][m][0]) + sq4(acc[ai][0][m][1])) + (sq4(acc[ai][1][m][0]) + sq4(acc[ai][1][m][1])); s = red_fq(s); if (fq == 0) ssq[(size_t)row * 16 + u.pn * 4 + wc] = s; }
                else if (u.pn == 0) { float s = (sq4(acc[ai][0][m][0]) + sq4(acc[ai][0][m][1])) + (sq4(acc[ai][1][m][0]) + sq4(acc[ai][1][m][1])); s = red_fq(s); if (fq == 0) ssq[(size_t)row * 8 + wc] = s; }
                else if (u.pn == 1) { float s = sq4(acc[ai][0][m][0]) + sq4(acc[ai][0][m][1]); s = red_fq(s); if (fq == 0) ssq[(size_t)row * 8 + 4 + wc] = s; } }
    }
};
struct EpiQ {
    static constexpr bool PERM = true; static constexpr int MIDK = 0;
    bf16_t* Q; const float* ssq; const float* cs;
    __device__ __forceinline__ void operator()(const Acc& acc, const Unit& u, int wr, int wc, int fr, int fq) const {
        const int row0 = u.pm * BM + wr * 64 + fr;
#pragma unroll
        for (int ai = 0; ai < 2; ++ai)
#pragma unroll
            for (int m = 0; m < 4; ++m) { const int row = row0 + ai * HALF + m * 16; const f32x4 sv = *(const f32x4*)(ssq + (size_t)row * 8);
                const float rs = rsqrtf(((sv[0] + sv[1]) + (sv[2] + sv[3])) * (1.f / QL) + EPS); const int b = row / SEQ, s = row % SEQ;
#pragma unroll
                for (int bj = 0; bj < 2; ++bj) { const int cv = u.pn * BM + bj * HALF + wc * 32 + 8 * fq; const int h = cv / DQK, d = cv % DQK;
                    f32x4 v0 = acc[ai][bj][m][0] * rs, v1 = acc[ai][bj][m][1] * rs;
                    if (d >= DN) { const int i0 = (d - DN) >> 1; const f32x4 c = *(const f32x4*)(cs + (size_t)row * 64 + i0), sn = *(const f32x4*)(cs + (size_t)row * 64 + 32 + i0);
                        const f32x4 r0 = {v0[0] * c[0] - v0[1] * sn[0], v0[0] * sn[0] + v0[1] * c[0], v0[2] * c[1] - v0[3] * sn[1], v0[2] * sn[1] + v0[3] * c[1]};
                        const f32x4 r1 = {v1[0] * c[2] - v1[1] * sn[2], v1[0] * sn[2] + v1[1] * c[2], v1[2] * c[3] - v1[3] * sn[3], v1[2] * sn[3] + v1[3] * c[3]};
                        v0 = r0; v1 = r1; }
                    *(u32x4*)(Q + ((size_t)(b * NH + h) * SEQ + s) * DQK + d) = pack8(v0, v1); } }
    }
};
struct EpiKV {
    static constexpr bool PERM = true; static constexpr int MIDK = 0;
    bf16_t* Kc; bf16_t* Vc; const float* ssq;
    __device__ __forceinline__ void operator()(const Acc& acc, const Unit& u, int wr, int wc, int fr, int fq) const {
        const int row0 = u.pm * BM + wr * 64 + fr, d = wc * 32 + 8 * fq, h = u.pn;
#pragma unroll
        for (int ai = 0; ai < 2; ++ai)
#pragma unroll
            for (int m = 0; m < 4; ++m) { const int row = row0 + ai * HALF + m * 16; const f32x4 sv = *(const f32x4*)(ssq + (size_t)row * 8 + 4);
                const float rs = rsqrtf(((sv[0] + sv[1]) + (sv[2] + sv[3])) * (1.f / KVL) + EPS); const int b = row / SEQ, s = row % SEQ; const size_t t = (size_t)(b * NH + h) * SEQ + s;
                *(u32x4*)(Kc + t * DQK + d) = pack8(acc[ai][0][m][0] * rs, acc[ai][0][m][1] * rs);
                *(u32x4*)(Vc + t * DV + d) = pack8(acc[ai][1][m][0] * rs, acc[ai][1][m][1] * rs); }
    }
};
struct EpiWo {
    static constexpr bool PERM = true; static constexpr int MIDK = 8;
    const float* x; bf16_t* HBF; unsigned char* X8; const float* assq; float* ssq1; const float* gmoe;
    __device__ __forceinline__ void mid(Acc& acc, const Unit& u, int wr, int wc, int fr, int fq) const {
        const int row0 = u.pm * BM + wr * 64 + fr;
#pragma unroll
        for (int ai = 0; ai < 2; ++ai)
#pragma unroll
            for (int m = 0; m < 4; ++m) { const f32x4 sv = *(const f32x4*)(assq + (size_t)(row0 + ai * HALF + m * 16) * 4);
                const float rs = rsqrtf(((sv[0] + sv[1]) + (sv[2] + sv[3])) * (1.f / 512.f) + EPS);
#pragma unroll
                for (int bj = 0; bj < 2; ++bj)
#pragma unroll
                    for (int n = 0; n < 2; ++n) acc[ai][bj][m][n] = acc[ai][bj][m][n] * rs; }
    }
    __device__ __forceinline__ void operator()(const Acc& acc, const Unit& u, int wr, int wc, int fr, int fq) const {
        const int row0 = u.pm * BM + wr * 64 + fr, col0 = u.pn * BM + wc * 32 + 8 * fq;
        f32x4 gn[2][2];
#pragma unroll
        for (int bj = 0; bj < 2; ++bj) { gn[bj][0] = *(const f32x4*)(gmoe + col0 + bj * HALF); gn[bj][1] = *(const f32x4*)(gmoe + col0 + bj * HALF + 4); }
#pragma unroll
        for (int ai = 0; ai < 2; ++ai) { f32x4 xv[4][2][2];
#pragma unroll
            for (int m = 0; m < 4; ++m) { const size_t off = (size_t)(row0 + ai * HALF + m * 16) * DM + col0;
#pragma unroll
                for (int bj = 0; bj < 2; ++bj) { xv[m][bj][0] = *(const f32x4*)(x + off + bj * HALF); xv[m][bj][1] = *(const f32x4*)(x + off + bj * HALF + 4); } }
            asm volatile("" ::: "memory");
#pragma unroll
            for (int m = 0; m < 4; ++m) { const int row = row0 + ai * HALF + m * 16; const size_t off = (size_t)row * DM + col0; float ss = 0.f;
#pragma unroll
                for (int bj = 0; bj < 2; ++bj) { const f32x4 h0 = xv[m][bj][0] + acc[ai][bj][m][0], h1 = xv[m][bj][1] + acc[ai][bj][m][1];
                    *(u32x4*)(HBF + off + bj * HALF) = pack8(h0, h1); *(u32x2*)(X8 + off + bj * HALF) = (u32x2){pk4_fp8(h0 * gn[bj][0]), pk4_fp8(h1 * gn[bj][1])}; ss += sq4(h0) + sq4(h1); }
                ss = red_fq(ss); if (fq == 0) ssq1[(size_t)row * 16 + u.pn * 4 + wc] = ss; }
            asm volatile("" ::: "memory"); }
    }
};
__device__ __forceinline__ f32x4 sigmoid4(f32x4 a) { const f32x4 t = a * -1.44269504f; f32x4 e; e[0] = __builtin_amdgcn_exp2f(t[0]); e[1] = __builtin_amdgcn_exp2f(t[1]); e[2] = __builtin_amdgcn_exp2f(t[2]); e[3] = __builtin_amdgcn_exp2f(t[3]);
    const f32x4 d = e + 1.0f; f32x4 r; r[0] = __builtin_amdgcn_rcpf(d[0]); r[1] = __builtin_amdgcn_rcpf(d[1]); r[2] = __builtin_amdgcn_rcpf(d[2]); r[3] = __builtin_amdgcn_rcpf(d[3]); return r; }
__device__ __forceinline__ f32x2 swiglu2(f32x2 g, f32x2 u) {
    g.x = fminf(g.x, 7.f); g.y = fminf(g.y, 7.f); u.x = __builtin_amdgcn_fmed3f(u.x, -7.f, 7.f); u.y = __builtin_amdgcn_fmed3f(u.y, -7.f, 7.f);
    const f32x2 t = g * -2.45546696f; f32x2 e; e.x = __builtin_amdgcn_exp2f(t.x); e.y = __builtin_amdgcn_exp2f(t.y); const f32x2 d = e + 1.0f; f32x2 r; r.x = __builtin_amdgcn_rcpf(d.x); r.y = __builtin_amdgcn_rcpf(d.y);
    const f32x2 gs = g * r; return u * gs + gs; }
__device__ __forceinline__ float swiglu_f(float g, float u) { g = fminf(g, 7.f); u = __builtin_amdgcn_fmed3f(u, -7.f, 7.f); const float gs = g * __builtin_amdgcn_rcpf(1.f + __builtin_amdgcn_exp2f(g * -2.45546696f)); return fmaf(u, gs, gs); }
constexpr float WSCALE = 64.f, WINV = 1.f / 64.f;
struct EpiMoe1 {
    static constexpr bool PERM = true; static constexpr int MIDK = 0;
    unsigned char* HB; const float* b1; const float* rowrs;
    __device__ __forceinline__ void operator()(const Acc& acc, const Unit& u, int wr, int wc, int fr, int fq) const {
        const int row0 = u.pm * BM + wr * 64 + fr, j0 = u.pn * HALF + wc * 32 + 8 * fq; const float* bg = b1 + (size_t)u.e * 2048 + j0;
        const f32x4 g0 = *(const f32x4*)bg, g1 = *(const f32x4*)(bg + 4), u0 = *(const f32x4*)(bg + 1024), u1 = *(const f32x4*)(bg + 1028);
        float rsv[2][4];
#pragma unroll
        for (int ai = 0; ai < 2; ++ai)
#pragma unroll
            for (int m = 0; m < 4; ++m) rsv[ai][m] = rowrs[row0 + ai * HALF + m * 16];
        asm volatile("" ::: "memory");
#pragma unroll
        for (int ai = 0; ai < 2; ++ai)
#pragma unroll
            for (int m = 0; m < 4; ++m) { const float rs = rsv[ai][m] * WINV;
                const f32x4 a0 = acc[ai][0][m][0] * rs + g0, a1 = acc[ai][0][m][1] * rs + g1, c0 = acc[ai][1][m][0] * rs + u0, c1 = acc[ai][1][m][1] * rs + u1; f32x4 r0, r1;
#pragma unroll
                for (int j = 0; j < 4; j += 2) { const f32x2 s0 = swiglu2((f32x2){a0[j], a0[j + 1]}, (f32x2){c0[j], c0[j + 1]}), s1 = swiglu2((f32x2){a1[j], a1[j + 1]}, (f32x2){c1[j], c1[j + 1]}); r0[j] = s0.x; r0[j + 1] = s0.y; r1[j] = s1.x; r1[j + 1] = s1.y; }
                *(u32x2*)(HB + (size_t)(row0 + ai * HALF + m * 16) * DE + j0) = (u32x2){pk4_fp8(r0), pk4_fp8(r1)}; }
    }
};
struct EpiMoe2 {
    static constexpr bool PERM = true; static constexpr int MIDK = 0;
    unsigned char* Y; const float* b2; const int* rowslot; const float* rowgate;
    __device__ __forceinline__ void operator()(const Acc& acc, const Unit& u, int wr, int wc, int fr, int fq) const {
        const int row0 = u.pm * BM + wr * 64 + fr, col0 = u.pn * BM + wc * 64 + 16 * fq; const float* bb = b2 + (size_t)u.e * DM + col0;
        f32x4 bv[2][2];
#pragma unroll
        for (int bj = 0; bj < 2; ++bj)
#pragma unroll
            for (int n = 0; n < 2; ++n) bv[bj][n] = *(const f32x4*)(bb + bj * 8 + 4 * n);
        float gtv[2][4]; int slv[2][4];
#pragma unroll
        for (int ai = 0; ai < 2; ++ai)
#pragma unroll
            for (int m = 0; m < 4; ++m) { const int r = row0 + ai * HALF + m * 16; gtv[ai][m] = rowgate[r]; slv[ai][m] = rowslot[r]; }
        asm volatile("" ::: "memory");
#pragma unroll
        for (int ai = 0; ai < 2; ++ai)
#pragma unroll
            for (int m = 0; m < 4; ++m) { const float gt = gtv[ai][m]; unsigned char* yp = Y + (size_t)slv[ai][m] * DM + col0;
                *(u32x4*)yp = (u32x4){pk4_fp8((acc[ai][0][m][0] * WINV + bv[0][0]) * gt), pk4_fp8((acc[ai][0][m][1] * WINV + bv[0][1]) * gt), pk4_fp8((acc[ai][1][m][0] * WINV + bv[1][0]) * gt), pk4_fp8((acc[ai][1][m][1] * WINV + bv[1][1]) * gt)}; }
    }
};
struct EpiPle {
    static constexpr bool PERM = true; static constexpr int MIDK = 0;
    const bf16_t* H2; bf16_t* H3; const bf16_t* pler; const float* rpv; const float* rs2; const float* pg; float* fssq;
    __device__ __forceinline__ void operator()(const Acc& acc, const Unit& u, int wr, int wc, int fr, int fq) const {
        const int row0 = u.pm * BM + wr * 64 + fr, col0 = u.pn * BM + wc * 32 + 8 * fq;
        f32x4 gv[2][2];
#pragma unroll
        for (int bj = 0; bj < 2; ++bj)
#pragma unroll
            for (int n = 0; n < 2; ++n) gv[bj][n] = *(const f32x4*)(pg + col0 + bj * HALF + n * 4);
#pragma unroll
        for (int am = 0; am < 4; ++am) { const int ai = am >> 1; u32x4 hq[2][2], pq[2][2]; float r2v[2], rpq[2];
#pragma unroll
            for (int mm = 0; mm < 2; ++mm) { const int row = row0 + ai * HALF + ((am & 1) * 2 + mm) * 16; const size_t off = (size_t)row * DM + col0; r2v[mm] = rs2[row]; rpq[mm] = rpv[row];
#pragma unroll
                for (int bj = 0; bj < 2; ++bj) { hq[mm][bj] = *(const u32x4*)(H2 + off + bj * HALF); pq[mm][bj] = *(const u32x4*)(pler + off + bj * HALF); } }
            asm volatile("" ::: "memory");
#pragma unroll
            for (int mm = 0; mm < 2; ++mm) { const int m = (am & 1) * 2 + mm; const int row = row0 + ai * HALF + m * 16; const size_t off = (size_t)row * DM + col0; const float r2 = r2v[mm], rp = rpq[mm]; float ss = 0.f;
#pragma unroll
                for (int bj = 0; bj < 2; ++bj) { const size_t o = off + bj * HALF; const u32x4 hv = hq[mm][bj], pr = pq[mm][bj];
                    const f32x4 h0 = {blo(hv.x), bhi(hv.x), blo(hv.y), bhi(hv.y)}, h1 = {blo(hv.z), bhi(hv.z), blo(hv.w), bhi(hv.w)};
                    const f32x4 q0 = {blo(pr.x), bhi(pr.x), blo(pr.y), bhi(pr.y)}, q1 = {blo(pr.z), bhi(pr.z), blo(pr.w), bhi(pr.w)};
                    const f32x4 r0 = h0 + sigmoid4(acc[ai][bj][m][0] * r2) * (q0 * (gv[bj][0] * rp)), r1 = h1 + sigmoid4(acc[ai][bj][m][1] * r2) * (q1 * (gv[bj][1] * rp));
                    *(u32x4*)(H3 + o) = pack8(r0, r1); ss += sq4(r0) + sq4(r1); }
                ss = red_fq(ss); if (fq == 0) fssq[(size_t)row * 16 + u.pn * 4 + wc] = ss; }
            asm volatile("" ::: "memory"); }
    }
};
}

namespace att {
typedef float f32x16 __attribute__((ext_vector_type(16)));
typedef short s16x4 __attribute__((ext_vector_type(4)));
constexpr int QBLK = 32, KVBLK = 64, QB = 256;
constexpr int SHM_K = KVBLK * DQK * 2, SHM_V = KVBLK * DV * 2;
constexpr int L_V = 0, L_K = 2 * SHM_V, L_WS = L_K + 2 * SHM_K, L_END = L_WS + NWAVES * 256;
constexpr float THR = 8.f;
#define KSWZ(row, colB) ((row) * 384 + ((colB) ^ (((row) & 7) << 4)))
#define SBAR() __builtin_amdgcn_sched_barrier(0)
__device__ __forceinline__ int v_st(int k, int c) { const int kk = (k & ~0xC) | ((k & 4) << 1) | ((k & 8) >> 1); return ((kk >> 3) * 4 + (c >> 5)) * 512 + ((kk & 7) * 32 + (c & 31)) * 2; }
__device__ __forceinline__ int v_rd_base(int lane) { return ((lane & 3) << 3) | (((lane >> 2) & 3) << 6) | (((lane >> 4) & 1) << 5) | (((lane >> 5) & 1) << 8); }
constexpr int v_rd_off(int d0, int ks, int half) { return d0 * 512 + ks * 4096 + half * 2048; }
__device__ __forceinline__ int crow(int r, int hi) { return (r & 3) + 8 * (r >> 2) + 4 * hi; }
typedef __bf16 bf16x2_t __attribute__((ext_vector_type(2)));
__device__ __forceinline__ unsigned cvtpk(float lo, float hi) { f32x2 v = {lo, hi}; bf16x2_t b = __builtin_convertvector(v, bf16x2_t); return __builtin_bit_cast(unsigned, b); }

__device__ __forceinline__ void qkt(f32x16& p0, f32x16& p1, const LAS unsigned char* Kbuf, int r32, int hi, const bf16x8* qr) {
    p0 = f32x16{}; p1 = f32x16{};
    const LAS unsigned char* kb[4];
#pragma unroll
    for (int dd = 0; dd < 4; ++dd) kb[dd] = Kbuf + KSWZ(r32, (dd * 16 + hi * 8) * 2);
#pragma unroll
    for (int d0 = 0; d0 < 12; ++d0) { const LAS unsigned char* a = kb[d0 & 3] + (d0 >> 2) * 128;
        const bf16x8 b0 = *(const LAS bf16x8*)a; const bf16x8 b1 = *(const LAS bf16x8*)(a + 32 * 384);
        p0 = __builtin_amdgcn_mfma_f32_32x32x16_bf16(b0, qr[d0], p0, 0, 0, 0);
        p1 = __builtin_amdgcn_mfma_f32_32x32x16_bf16(b1, qr[d0], p1, 0, 0, 0); }
}
template <int VB>
__device__ __forceinline__ void pv_tile(f32x16* o, int vb0, bf16x8 pa0, bf16x8 pa1, bf16x8 pa2, bf16x8 pa3) {
#define TRRD(dst, off) asm volatile("ds_read_b64_tr_b16 %0, %1 offset:%2" : "=&v"(dst) : "v"(vb0), "i"(off) : "memory")
#define PV_D0(d0) do { s16x4 l0, l1, l2, l3, h0, h1, h2, h3; constexpr int b_ = VB * SHM_V + v_rd_off(d0, 0, 0); \
        TRRD(l0, b_); TRRD(h0, b_ + 2048); TRRD(l1, b_ + 4096); TRRD(h1, b_ + 6144); TRRD(l2, b_ + 8192); TRRD(h2, b_ + 10240); TRRD(l3, b_ + 12288); TRRD(h3, b_ + 14336); \
        asm volatile("s_waitcnt lgkmcnt(0)" ::: "memory"); SBAR(); \
        o[d0] = __builtin_amdgcn_mfma_f32_32x32x16_bf16(pa0, (bf16x8){l0[0], l0[1], l0[2], l0[3], h0[0], h0[1], h0[2], h0[3]}, o[d0], 0, 0, 0); \
        o[d0] = __builtin_amdgcn_mfma_f32_32x32x16_bf16(pa1, (bf16x8){l1[0], l1[1], l1[2], l1[3], h1[0], h1[1], h1[2], h1[3]}, o[d0], 0, 0, 0); \
        o[d0] = __builtin_amdgcn_mfma_f32_32x32x16_bf16(pa2, (bf16x8){l2[0], l2[1], l2[2], l2[3], h2[0], h2[1], h2[2], h2[3]}, o[d0], 0, 0, 0); \
        o[d0] = __builtin_amdgcn_mfma_f32_32x32x16_bf16(pa3, (bf16x8){l3[0], l3[1], l3[2], l3[3], h3[0], h3[1], h3[2], h3[3]}, o[d0], 0, 0, 0); } while (0)
    PV_D0(0); PV_D0(1); PV_D0(2); PV_D0(3);
#undef PV_D0
#undef TRRD
}
struct ConvJob { const float* w1; const float* w2; const float* gain; unsigned char* W1T; unsigned char* W2T; int gw, ngw; };
constexpr int CV_N1 = NE * 32 * 64, CV_N2 = NE * 32 * 32, CV_TOTAL = CV_N1 + CV_N2;
__device__ __forceinline__ int cv_cmap2(int n) { const int t = n & ~255, v = n & 255; return t + 64 * ((v >> 5) & 3) + 16 * ((v >> 3) & 3) + 8 * (v >> 7) + (v & 7); }
__device__ __forceinline__ int cv_cmap1(int n) { const int pn = n >> 8, half = (n >> 7) & 1, jj = n & 127; return half * 1024 + pn * 128 + jj; }
#define CV_DECODE(idx) \
    const bool cv_on = (idx) < CV_TOTAL; const bool cv_is1 = (idx) < CV_N1; const int cv_r = cv_is1 ? (idx) : (idx) - CV_N1; \
    const int cv_nblk = cv_is1 ? 64 : 32, cv_ld = cv_is1 ? 2048 : 1024; const int cv_e = cv_r / (32 * cv_nblk), cv_q = cv_r % (32 * cv_nblk), cv_k0 = 32 * (cv_q / cv_nblk), cv_n0 = 32 * (cv_q % cv_nblk); \
    const float* cv_src = (cv_is1 ? cj.w1 + (size_t)cv_e * 1024 * 2048 : cj.w2 + (size_t)cv_e * 1024 * 1024); \
    const int cv_c = cv_is1 ? cv_cmap1(cv_n0 + (lane & 31)) : cv_cmap2(cv_n0 + (lane & 31));
#define CV_LOAD() do { if (cv_on) { _Pragma("unroll") for (int i = 0; i < 16; ++i) cvw[i] = cv_src[(size_t)(cv_k0 + 2 * i + hi) * cv_ld + cv_c]; } } while (0)
#define CV_STORE() do { if (cv_on) { LAS float* scr = (LAS float*)(lds + L_END) + wid * (32 * 33); \
        _Pragma("unroll") for (int i = 0; i < 16; ++i) { const int kk = 2 * i + hi; scr[kk * 33 + (lane & 31)] = cvw[i] * 64.f; } \
        asm volatile("s_waitcnt lgkmcnt(0)" ::: "memory"); \
        { const int n = lane >> 1, cc = lane & 1; const LAS float* s = scr + (16 * cc) * 33 + n; u32x4 o; \
          o.x = pg8::pk4_fp8((f32x4){s[0 * 33], s[1 * 33], s[2 * 33], s[3 * 33]}); o.y = pg8::pk4_fp8((f32x4){s[4 * 33], s[5 * 33], s[6 * 33], s[7 * 33]}); \
          o.z = pg8::pk4_fp8((f32x4){s[8 * 33], s[9 * 33], s[10 * 33], s[11 * 33]}); o.w = pg8::pk4_fp8((f32x4){s[12 * 33], s[13 * 33], s[14 * 33], s[15 * 33]}); \
          unsigned char* dst = (cv_is1 ? cj.W1T + (size_t)cv_e * 2048 * 1024 : cj.W2T + (size_t)cv_e * 1024 * 1024) + (size_t)(cv_n0 + n) * 1024 + cv_k0 + 16 * cc; *(u32x4*)dst = o; } \
        asm volatile("s_waitcnt lgkmcnt(0)" ::: "memory"); } } while (0)
__device__ __forceinline__ void attn_block(int bh, int qb, const bf16_t* __restrict__ Q, const bf16_t* __restrict__ K, const bf16_t* __restrict__ V, bf16_t* __restrict__ MIX, float* __restrict__ ASSQ, LAS unsigned char* lds, const int wid, const ConvJob& cj, int& tseq) {
    const int lane = lane_id(), r32 = lane & 31, hi = lane >> 5;
    const int b = bh / NH, h = bh % NH;
    const bf16_t* Qw = Q + ((size_t)bh * SEQ + qb * QB + wid * QBLK + r32) * DQK;
    const bf16_t* Kh = K + (size_t)bh * SEQ * DQK; const bf16_t* Vh = V + (size_t)bh * SEQ * DV;
    bf16x8 qr[12];
#pragma unroll
    for (int d0 = 0; d0 < 12; ++d0) qr[d0] = *(const bf16x8*)(Qw + d0 * 16 + hi * 8);
    const int NT = 4 * qb + 4, qlo = qb * QB + wid * QBLK, qm = qlo + r32 - 4 * hi;
    LAS unsigned char* V_lds = lds + L_V; LAS unsigned char* K_lds = lds + L_K;
    LAS float* wsf = (LAS float*)(lds + L_WS) + wid * 64; LAS float* li_l = wsf; LAS float* al_l = wsf + 32;
    unsigned ksrc[3], vsrc[2];
#pragma unroll
    for (int i = 0; i < 3; ++i) { const int off = ((wid + 8 * i) * 64 + lane) * 16, row = off / 384, wb = off % 384, seg = wb >> 7, cpos = (wb & 127) >> 4; ksrc[i] = (unsigned)(row * 384 + seg * 128 + ((cpos ^ (row & 7)) << 4)); }
#pragma unroll
    for (int i = 0; i < 2; ++i) { const int off = ((wid + 8 * i) * 64 + lane) * 16, st = off >> 9, o_ = off & 511, kk = (st >> 2) * 8 + (o_ >> 6), c = (st & 3) * 32 + ((o_ & 63) >> 1);
        const int k = (kk & ~0xC) | ((kk & 4) << 1) | ((kk & 8) >> 1); vsrc[i] = (unsigned)(k * 256 + c * 2); }
    const int vb0 = (int)(unsigned)(uintptr_t)V_lds + v_rd_base(lane);
#define ADMA(t, bf) do { const char* kp = (const char*)(Kh + (size_t)(t) * KVBLK * DQK); const char* vp = (const char*)(Vh + (size_t)(t) * KVBLK * DV); \
        _Pragma("unroll") for (int i = 0; i < 3; ++i) __builtin_amdgcn_global_load_lds((const unsigned*)(kp + ksrc[i]), (LAS unsigned*)(K_lds + (bf) * SHM_K + (wid + 8 * i) * 1024), 16, 0, 0); \
        _Pragma("unroll") for (int i = 0; i < 2; ++i) __builtin_amdgcn_global_load_lds((const unsigned*)(vp + vsrc[i]), (LAS unsigned*)(V_lds + (bf) * SHM_V + (wid + 8 * i) * 1024), 16, 0, 0); } while (0)
    float m_reg = -1e30f, l_reg = 0.f; f32x16 o[4] = {}; float cvw[16]; int cv_pend = -1;
    ADMA(0, 0);
#define TILE(t, BF) do { \
        asm volatile("s_waitcnt vmcnt(0)" ::: "memory"); __syncthreads(); \
        if ((t) + 1 < NT) ADMA((t) + 1, (BF) ^ 1); \
        if (cv_pend >= 0) { CV_DECODE(cv_pend) CV_STORE(); }     \
        { const int cv_idx = tseq * cj.ngw + cj.gw; ++tseq; CV_DECODE(cv_idx) CV_LOAD(); cv_pend = cv_on ? cv_idx : -1; } SBAR(); \
        const int kb_ = (t) * KVBLK; \
        if (kb_ <= qlo + QBLK - 1) { \
            f32x16 p0, p1; SBAR(); qkt(p0, p1, K_lds + (BF) * SHM_K, r32, hi, qr); \
            if (kb_ + KVBLK - 1 > qlo) { const int dq = qm - kb_; const float NEG = -__builtin_inff(); \
                _Pragma("unroll") for (int r = 0; r < 16; ++r) { const int c = (r & 3) + 8 * (r >> 2); if (c > dq) p0[r] = NEG; if (c + 32 > dq) p1[r] = NEG; } } \
            float pmax = p0[0]; _Pragma("unroll") for (int r = 1; r < 16; ++r) pmax = fmaxf(pmax, p0[r]); _Pragma("unroll") for (int r = 0; r < 16; ++r) pmax = fmaxf(pmax, p1[r]); \
            { auto rr = __builtin_amdgcn_permlane32_swap(__float_as_uint(pmax), __float_as_uint(pmax), false, false); pmax = fmaxf(__uint_as_float(rr[0]), __uint_as_float(rr[1])); } \
            if (!__all(pmax - m_reg <= THR)) { const float mn = fmaxf(m_reg, pmax); const float alpha = __builtin_amdgcn_exp2f(m_reg - mn); m_reg = mn; l_reg *= alpha; \
                if (hi == 0) al_l[r32] = alpha; asm volatile("s_waitcnt lgkmcnt(0)" ::: "memory"); \
                _Pragma("unroll") for (int d_ = 0; d_ < 4; ++d_) _Pragma("unroll") for (int r = 0; r < 16; ++r) o[d_][r] *= al_l[crow(r, hi)]; } \
            float ps = 0.f; \
            _Pragma("unroll") for (int r = 0; r < 16; ++r) { p0[r] = __builtin_amdgcn_exp2f(p0[r] - m_reg); p1[r] = __builtin_amdgcn_exp2f(p1[r] - m_reg); } \
            _Pragma("unroll") for (int r = 0; r < 16; ++r) ps += p0[r] + p1[r]; \
            { auto rr = __builtin_amdgcn_permlane32_swap(__float_as_uint(ps), __float_as_uint(ps), false, false); ps = __uint_as_float(rr[0]) + __uint_as_float(rr[1]); } \
            l_reg += ps; \
            bf16x8 pa0, pa1, pa2, pa3; \
            PK4(p0, 0, pa0); PK4(p0, 8, pa1); PK4(p1, 0, pa2); PK4(p1, 8, pa3); \
            SBAR(); pv_tile<BF>(o, vb0, pa0, pa1, pa2, pa3); } \
        } while (0)
#define PK4(P, B_, OUT) do { unsigned a0 = cvtpk(P[B_ + 0], P[B_ + 1]), a1 = cvtpk(P[B_ + 2], P[B_ + 3]); \
        unsigned b0 = cvtpk(P[B_ + 4], P[B_ + 5]), b1 = cvtpk(P[B_ + 6], P[B_ + 7]); \
        auto r0 = __builtin_amdgcn_permlane32_swap(a0, b0, false, false); auto r1 = __builtin_amdgcn_permlane32_swap(a1, b1, false, false); \
        u32x4 w = {r0[0], r1[0], r0[1], r1[1]}; OUT = __builtin_bit_cast(bf16x8, w); } while (0)
    for (int t = 0; t < NT; t += 2) { TILE(t, 0); TILE(t + 1, 1); }
#undef PK4
#undef TILE
#undef ADMA
    if (cv_pend >= 0) { asm volatile("s_waitcnt vmcnt(0)" ::: "memory"); CV_DECODE(cv_pend) CV_STORE(); }
    if (hi == 0) li_l[r32] = l_reg;
    asm volatile("s_waitcnt vmcnt(0) lgkmcnt(0)" ::: "memory");
    float rli[16];
#pragma unroll
    for (int r = 0; r < 16; ++r) rli[r] = __builtin_amdgcn_rcpf(li_l[crow(r, hi)]);
    __syncthreads();
    LAS bf16_t* stg = (LAS bf16_t*)(lds + wid * 8192);
#pragma unroll
    for (int r = 0; r < 16; ++r) { const int orow = crow(r, hi);
#pragma unroll
        for (int d0 = 0; d0 < 4; ++d0) stg[orow * 128 + d0 * 32 + r32] = f2bf(o[d0][r] * rli[r]); }
    asm volatile("s_waitcnt lgkmcnt(0)" ::: "memory");
    const size_t row0 = (size_t)b * SEQ + qb * QB + wid * QBLK;
#pragma unroll
    for (int i = 0; i < 8; ++i) { const int row = i * 4 + (lane >> 4), ch = lane & 15; const u32x4 v = *(const LAS u32x4*)(stg + row * 128 + ch * 8);
        float ss = (blo(v.x) * blo(v.x) + bhi(v.x) * bhi(v.x)) + (blo(v.y) * blo(v.y) + bhi(v.y) * bhi(v.y)) + (blo(v.z) * blo(v.z) + bhi(v.z) * bhi(v.z)) + (blo(v.w) * blo(v.w) + bhi(v.w) * bhi(v.w));
        ss += __shfl_xor(ss, 1); ss += __shfl_xor(ss, 2); ss += __shfl_xor(ss, 4); ss += __shfl_xor(ss, 8);
        *(u32x4*)(MIX + (row0 + row) * DM + h * DV + ch * 8) = v;
        if (ch == 0) ASSQ[(row0 + row) * 4 + h] = ss; }
    __syncthreads();
}
#undef KSWZ
#undef SBAR
}

struct Args { const void* in[25]; float* out; unsigned char* ws; int ph_lo, ph_hi, li, skip; };
enum { PH_PREP = 0, PH_INPROJ, PH_TOKLOCAL, PH_ATTN, PH_WO, PH_ROUTER, PH_ROUTE, PH_MOE1, PH_MOE2, PH_COMBINE, PH_PLE, PH_FINAL, PH_COUNT };

template <int MODE> __device__ __forceinline__ int cmap_col(int n) {
    if (MODE == 1) { const int pn = n >> 8, half = (n >> 7) & 1, jj = n & 127; return half * 1024 + pn * 128 + jj; }
    if (MODE == 2) { const int h = n / DQK, d = n % DQK; if (d < DN) return n; const int t = d - DN; return h * DQK + DN + (t & 1) * 32 + (t >> 1); }
    return n;
}
template <int MODE> __device__ __forceinline__ void transpose_item_fp8(const float* __restrict__ W, int ldsrc, int nblk, unsigned char* __restrict__ WT, int ldd, const float* __restrict__ gain, float scale,
                                                                      LAS float* scr, int item, int lane) {
    const int kb = item / nblk, nb = item % nblk, k0 = 64 * kb, n0 = 32 * nb; const int c = cmap_col<MODE>(n0 + (lane & 31));
    float wv[32];
#pragma unroll
    for (int i = 0; i < 32; ++i) wv[i] = W[(size_t)(k0 + 2 * i + (lane >> 5)) * ldsrc + c];
#pragma unroll
    for (int i = 0; i < 32; ++i) { const int kk = 2 * i + (lane >> 5), k = k0 + kk; float gk = scale; if (gain) gk *= gain[k]; scr[kk * 33 + (lane & 31)] = wv[i] * gk; }
    asm volatile("s_waitcnt lgkmcnt(0)" ::: "memory");
    const int cc = lane & 3;
#pragma unroll
    for (int j = 0; j < 2; ++j) { const int n = (lane >> 2) + 16 * j; const LAS float* s = scr + (16 * cc) * 33 + n; u32x4 o;
        o.x = pg8::pk4_fp8((f32x4){s[0 * 33], s[1 * 33], s[2 * 33], s[3 * 33]}); o.y = pg8::pk4_fp8((f32x4){s[4 * 33], s[5 * 33], s[6 * 33], s[7 * 33]});
        o.z = pg8::pk4_fp8((f32x4){s[8 * 33], s[9 * 33], s[10 * 33], s[11 * 33]}); o.w = pg8::pk4_fp8((f32x4){s[12 * 33], s[13 * 33], s[14 * 33], s[15 * 33]});
        *(u32x4*)(WT + (size_t)(n0 + n) * ldd + k0 + 16 * cc) = o; }
    asm volatile("s_waitcnt lgkmcnt(0)" ::: "memory");
}
template <int MODE> __device__ __forceinline__ void transpose_item(const float* __restrict__ W, int ldsrc, int nblk, bf16_t* __restrict__ WT, int ldd, const float* __restrict__ gain, const float* __restrict__ gain2, float scale,
                                                                  LAS float* scr, int item, int lane) {
    const int kb = item / nblk, nb = item % nblk, k0 = 64 * kb, n0 = 32 * nb; const int c = cmap_col<MODE>(n0 + (lane & 31));
    float wv[32], gq[32];
#pragma unroll
    for (int i = 0; i < 32; ++i) wv[i] = W[(size_t)(k0 + 2 * i + (lane >> 5)) * ldsrc + c];
#pragma unroll
    for (int i = 0; i < 32; ++i) { const int k = k0 + 2 * i + (lane >> 5); gq[i] = gain ? ((gain2 && k >= 512) ? gain2[k - 512] : gain[k]) : 1.f; }
    asm volatile("" ::: "memory");
#pragma unroll
    for (int i = 0; i < 32; ++i) { const int kk = 2 * i + (lane >> 5); scr[kk * 33 + (lane & 31)] = wv[i] * (gq[i] * scale); }
    asm volatile("s_waitcnt lgkmcnt(0)" ::: "memory");
    const int cc = lane & 7;
#pragma unroll
    for (int j = 0; j < 4; ++j) { const int n = (lane >> 3) + 8 * j; const LAS float* s = scr + (8 * cc) * 33 + n;
        u32x4 o; o.x = pk2(s[0 * 33], s[1 * 33]); o.y = pk2(s[2 * 33], s[3 * 33]); o.z = pk2(s[4 * 33], s[5 * 33]); o.w = pk2(s[6 * 33], s[7 * 33]);
        *(u32x4*)(WT + (size_t)(n0 + n) * ldd + k0 + 8 * cc) = o; }
    asm volatile("s_waitcnt lgkmcnt(0)" ::: "memory");
}

__global__ void __launch_bounds__(NTHREADS, 2) fwd(Args args) {
    extern __shared__ __attribute__((aligned(16))) unsigned char lds_raw[];
    LAS unsigned char* lds = (LAS unsigned char*)lds_raw;
    volatile LAS unsigned* MISC = (volatile LAS unsigned*)(lds + MISC_OFF);
    const int wave = __builtin_amdgcn_readfirstlane(threadIdx.x >> 6);
    const int G = gridDim.x, bx = blockIdx.x;
#define PHASE_LANE const int lane = lane_id(); const int tid = wave * 64 + lane; (void)tid
    const int gw = bx * NWAVES + wave, NGW = G * NWAVES;
    unsigned char* ws = args.ws; int* ctl = (int*)(ws + WS_CTL); float* H = args.out;
    const float* x = (const float*)args.in[0]; const float* p = (const float*)args.in[1]; const int* pos = (const int*)args.in[2];
    const float *mix_norm = (const float*)args.in[3], *w_in = (const float*)args.in[4], *q_norm = (const float*)args.in[5], *w_uq = (const float*)args.in[6], *kv_norm = (const float*)args.in[7],
                *w_ukv = (const float*)args.in[8], *attn_out_norm = (const float*)args.in[10], *conv_out_norm = (const float*)args.in[11], *w_o = (const float*)args.in[12],
                *moe_norm = (const float*)args.in[13], *w_router = (const float*)args.in[14], *w1 = (const float*)args.in[16], *b1 = (const float*)args.in[17],
                *w2 = (const float*)args.in[18], *b2 = (const float*)args.in[19], *ple_norm = (const float*)args.in[20], *w_ple_gate = (const float*)args.in[21], *w_ple_proj = (const float*)args.in[22],
                *ple_post_norm = (const float*)args.in[23], *conv_w = (const float*)args.in[9], *b_router = (const float*)args.in[15], *final_norm = (const float*)args.in[24];
    int* TOPI = (int*)(ws + WS_TOPI); float* TOPG = (float*)(ws + WS_TOPG);
    bf16_t *HBF = (bf16_t*)(ws + WS_HBF), *H3 = (bf16_t*)(ws + WS_H3), *WRHL = (bf16_t*)(ws + WS_WRHL); unsigned char* X8 = (unsigned char*)(ws + WS_XN);
    float *SSQ1 = (float*)(ws + WS_SSQ1), *RS1 = (float*)(ws + WS_RS1), *RS2 = (float*)(ws + WS_RS2), *ROWRS = (float*)(ws + WS_ROWRS);
    bf16_t *WIN = (bf16_t*)(ws + WS_WIN), *WUQ = (bf16_t*)(ws + WS_WUQ), *WUKV = (bf16_t*)(ws + WS_WUKV), *WO = (bf16_t*)(ws + WS_WO), *WG = (bf16_t*)(ws + WS_WG), *WP = (bf16_t*)(ws + WS_WP);
    bf16_t *W1T = (bf16_t*)(ws + WS_W1), *W2T = (bf16_t*)(ws + WS_W2), *XN = (bf16_t*)(ws + WS_XN), *MIX = (bf16_t*)(ws + WS_MIX), *PLER = (bf16_t*)(ws + WS_PLER);
    bf16_t *Z = (bf16_t*)(ws + WS_Z), *Qb = (bf16_t*)(ws + WS_Q), *Kb = (bf16_t*)(ws + WS_K), *Vb = (bf16_t*)(ws + WS_V), *HB = (bf16_t*)(ws + WS_HB), *Y = (bf16_t*)(ws + WS_Y), *P16 = (bf16_t*)(ws + WS_P16);
    float *WR = (float*)(ws + WS_WR), *CS = (float*)(ws + WS_CS), *SSQ = (float*)(ws + WS_SSQ), *ASSQ = (float*)(ws + WS_ASSQ), *PSSQ = (float*)(ws + WS_PSSQ), *FSSQ = (float*)(ws + WS_FSSQ);
    int *ROWTOK = (int*)(ws + WS_ROWTOK), *ROWSLOT = (int*)(ws + WS_ROWSLOT); float* ROWGATE = (float*)(ws + WS_ROWGATE);

    { PHASE_LANE; for (int u = tid; u < (LDS_BYTES - MISC_OFF) / 4; u += NTHREADS) ((LAS unsigned*)(lds + MISC_OFF))[u] = 0u; }
    __syncthreads();
    const int lo = args.ph_lo, hi = args.ph_hi;
    XcdBarrier bar; bar.bar = (unsigned*)ctl + CW_BAR + args.li * XCD_BAR_WORDS; bar.x = 0; bar.st = MISC + 8;
    if (hi - lo > 1) bar = xcd_barrier_post((unsigned*)ctl + CW_BAR + args.li * XCD_BAR_WORDS, MISC + 8, wave);
#define IN(k) (lo <= (k) && (k) < hi)
#define NREP(k) ((PROBE_PH == (k)) ? PROBE_REP : 1)
#define REPLOOP(k) for (int rep = 0; rep < NREP(k); ++rep)
#define LASTREP(k) (rep == NREP(k) - 1)
#ifdef PROBE_TIME_PH
#define STAMP(k) do { if (bx == 0 && wave == 0) MISC[32 + (k)] = (unsigned)__builtin_amdgcn_s_memrealtime(); } while (0)
#else
#define STAMP(k) do { } while (0)
#endif
#define SEAM(k) do { if (IN(k) && IN((k) + 1)) xcd_barrier(bar, wave); STAMP((k) + 1); } while (0)
    STAMP(0);

    if (IN(PH_PREP)) REPLOOP(PH_PREP) {
        PHASE_LANE;
        LAS float* scr = (LAS float*)(lds + wave * 16384);
        constexpr int I_IN = (DM / 64) * (INW / 32), I_UQ = (QL / 64) * (768 / 32), I_UKV = (KVL / 64) * (1024 / 32), I_O = (DM / 64) * (DM / 32), I_G = I_O, I_P = (PLE / 64) * (DM / 32);
        constexpr int I_1 = (DM / 64) * (2048 / 32), I_2 = (DE / 64) * (DM / 32);
        constexpr int NITEMS = I_IN + I_UQ + I_UKV + I_O + I_G + I_P;
        for (int it = gw; it < NITEMS; it += NGW) {
            int r = it;
            if (r < I_IN) { transpose_item<0>(w_in, INW, INW / 32, WIN, DM, mix_norm, nullptr, 1.f, scr, r, lane); continue; } r -= I_IN;
            if (r < I_UQ) { transpose_item<2>(w_uq, 768, 768 / 32, WUQ, QL, q_norm, nullptr, QSCALE, scr, r, lane); continue; } r -= I_UQ;
            if (r < I_UKV) { transpose_item<0>(w_ukv, 1024, 1024 / 32, WUKV, 256, kv_norm, nullptr, 1.f, scr, r, lane); continue; } r -= I_UKV;
            if (r < I_O) { transpose_item<0>(w_o, DM, DM / 32, WO, DM, attn_out_norm, conv_out_norm, 1.f, scr, r, lane); continue; } r -= I_O;
            if (r < I_G) { transpose_item<0>(w_ple_gate, DM, DM / 32, WG, DM, ple_norm, nullptr, 1.f, scr, r, lane); continue; } r -= I_G;
            transpose_item<0>(w_ple_proj, DM, DM / 32, WP, PLE, nullptr, nullptr, 1.f, scr, r, lane);
        }
        for (int i = bx * NTHREADS + tid; i < 1024 * 16; i += G * NTHREADS) *(u32x4*)(WUKV + (size_t)(i >> 4) * 256 + 128 + (i & 15) * 8) = (u32x4){0u, 0u, 0u, 0u};
        for (int i = bx * NTHREADS + tid; i < DM * NE; i += G * NTHREADS) { const int e = i >> 10, k = i & 1023; const float w = w_router[k * NE + e] * moe_norm[k]; const bf16_t whi = f2bf(w);
            WRHL[i] = whi; WRHL[DM * NE + i] = f2bf(w - bf2f(whi)); }
        for (int i = bx * NTHREADS + tid; i < NTOK * 32; i += G * NTHREADS) { const int t = i >> 5, j = i & 31; const float inv = powf(10000.f, -(float)j / 32.f); const float a = (float)pos[t] * inv; float sn, c; sincosf(a, &sn, &c);
            CS[(size_t)t * 64 + j] = c; CS[(size_t)t * 64 + 32 + j] = sn; }
        for (int i = bx * NTHREADS + tid; i < NTOK * PLE / 4; i += G * NTHREADS) { const f32x4 v = ((const f32x4*)p)[i]; ((u32x2*)P16)[i] = (u32x2){pk2(v[0], v[1]), pk2(v[2], v[3])}; }
        for (int row = gw * 4; row < NTOK; row += NGW * 4) {
            f32x4 v[4][4]; float ss[4];
#pragma unroll
            for (int q = 0; q < 4; ++q) { const f32x4* s = (const f32x4*)(x + (size_t)(row + q) * DM);
#pragma unroll
                for (int j = 0; j < 4; ++j) v[q][j] = s[lane + 64 * j]; }
#pragma unroll
            for (int q = 0; q < 4; ++q) { ss[q] = 0.f;
#pragma unroll
                for (int j = 0; j < 4; ++j) ss[q] += pg8::sq4(v[q][j]); }
#pragma unroll
            for (int q = 0; q < 4; ++q) { const float rstd = rsqrtf(wave_sum(ss[q]) * (1.f / DM) + EPS); u32x2* d = (u32x2*)(XN + (size_t)(row + q) * DM);
#pragma unroll
                for (int j = 0; j < 4; ++j) d[lane + 64 * j] = (u32x2){pk2(v[q][j][0] * rstd, v[q][j][1] * rstd), pk2(v[q][j][2] * rstd, v[q][j][3] * rstd)}; }
        }
    }
    SEAM(PH_PREP);
    if (IN(PH_INPROJ)) REPLOOP(PH_INPROJ) {
        { pg8::Gemm g{XN, WIN, DM, DM, DM, nullptr, 0}; pg8::StaticOrder S; S.init(NTOK / 256, INWP / 256, G, bx, nullptr);
          pg8::EpiBf16Stats<0> E{Z, INWP, SSQ}; pg8::gemm_phase<pg8::EpiBf16Stats<0>, false>(lds, g, S, E, wave); }
        { pg8::Gemm g{P16, WP, PLE, PLE, PLE, nullptr, 0}; pg8::StaticOrder S; S.init(NTOK / 256, DM / 256, G, bx, nullptr);
          pg8::EpiBf16Stats<1> E{PLER, DM, PSSQ}; pg8::gemm_phase<pg8::EpiBf16Stats<1>, false>(lds, g, S, E, wave); }
    }
    SEAM(PH_INPROJ);
    if (IN(PH_TOKLOCAL)) REPLOOP(PH_TOKLOCAL) {
        PHASE_LANE;
        if (!(args.skip & 1)) for (int r0 = gw * 16; r0 < NTOK; r0 += NGW * 16) {
            const int c8 = lane * 8; f32x4 w0[2], w1[2], w2[2];
#pragma unroll
            for (int q = 0; q < 2; ++q) { w0[q] = *(const f32x4*)(conv_w + c8 + 4 * q); w1[q] = *(const f32x4*)(conv_w + 512 + c8 + 4 * q); w2[q] = *(const f32x4*)(conv_w + 1024 + c8 + 4 * q); }
            f32x4 u1[2] = {}, u2[2] = {};
            if ((r0 % SEQ) != 0) {
#pragma unroll
                for (int p = 1; p <= 2; ++p) { const bf16_t* zp = Z + (size_t)(r0 - p) * INWP; const u32x4 cg = *(const u32x4*)(zp + 960 + c8), vv = *(const u32x4*)(zp + 1472 + c8);
                    const f32x4 a = (f32x4){blo(cg.x), bhi(cg.x), blo(cg.y), bhi(cg.y)} * (f32x4){blo(vv.x), bhi(vv.x), blo(vv.y), bhi(vv.y)}, b = (f32x4){blo(cg.z), bhi(cg.z), blo(cg.w), bhi(cg.w)} * (f32x4){blo(vv.z), bhi(vv.z), blo(vv.w), bhi(vv.w)};
                    if (p == 1) { u1[0] = a; u1[1] = b; } else { u2[0] = a; u2[1] = b; } } }
#pragma unroll 4
            for (int rr = 0; rr < 16; ++rr) { const int row = r0 + rr; const bf16_t* z = Z + (size_t)row * INWP; const int s = row % SEQ, b = row / SEQ;
                const u32x4 bg = *(const u32x4*)(z + 448 + c8), cg = *(const u32x4*)(z + 960 + c8), vv = *(const u32x4*)(z + 1472 + c8);
                if (lane < 32) { const float x1 = bf2f(z[384 + lane]), x2 = bf2f(z[416 + lane]); const float c = CS[(size_t)row * 64 + lane], sn = CS[(size_t)row * 64 + 32 + lane];
                    const unsigned o = pk2(x1 * c - x2 * sn, x1 * sn + x2 * c);
#pragma unroll
                    for (int h = 0; h < NH; ++h) *(unsigned*)(Kb + ((size_t)(b * NH + h) * SEQ + s) * DQK + DN + 2 * lane) = o; }
                f32x4 u0[2]; u0[0] = (f32x4){blo(cg.x), bhi(cg.x), blo(cg.y), bhi(cg.y)} * (f32x4){blo(vv.x), bhi(vv.x), blo(vv.y), bhi(vv.y)}; u0[1] = (f32x4){blo(cg.z), bhi(cg.z), blo(cg.w), bhi(cg.w)} * (f32x4){blo(vv.z), bhi(vv.z), blo(vv.w), bhi(vv.w)};
                f32x4 y[2]; y[0] = (f32x4){blo(bg.x), bhi(bg.x), blo(bg.y), bhi(bg.y)} * (w0[0] * u2[0] + w1[0] * u1[0] + w2[0] * u0[0]); y[1] = (f32x4){blo(bg.z), bhi(bg.z), blo(bg.w), bhi(bg.w)} * (w0[1] * u2[1] + w1[1] * u1[1] + w2[1] * u0[1]);
                const float rstd = rsqrtf(wave_sum(pg8::sq4(y[0]) + pg8::sq4(y[1])) * (1.f / 512.f) + EPS);
                *(u32x4*)(MIX + (size_t)row * DM + 512 + c8) = pg8::pack8(y[0] * rstd, y[1] * rstd);
                u2[0] = u1[0]; u2[1] = u1[1]; u1[0] = u0[0]; u1[1] = u0[1]; }
        }
        { pg8::Gemm g{Z, WUQ, QL, INWP, QL, nullptr, 0}; pg8::StaticOrder S; S.init(NTOK / 256, 768 / 256, G, bx, nullptr);
          pg8::EpiQ E{Qb, SSQ, CS}; pg8::gemm_phase<pg8::EpiQ, false>(lds, g, S, E, wave); }
        { pg8::Gemm g{Z + 256, WUKV, 256, INWP, 256, nullptr, 0}; pg8::StaticOrder S; S.init(NTOK / 256, 1024 / 256, G, bx, nullptr);
          pg8::EpiKV E{Kb, Vb, SSQ}; pg8::gemm_phase<pg8::EpiKV, false>(lds, g, S, E, wave); }
    }
    SEAM(PH_TOKLOCAL);
    if (IN(PH_ATTN)) REPLOOP(PH_ATTN) {
        const int vcu = (G % 8 == 0) ? (bx % 8) * (G / 8) + bx / 8 : bx;
        using att::L_END; using att::cv_cmap1; using att::cv_cmap2; using att::CV_N1; using att::CV_TOTAL;
        const att::ConvJob cj{w1, w2, moe_norm, (unsigned char*)W1T, (unsigned char*)W2T, gw, NGW}; int tseq = LASTREP(PH_ATTN) ? 0 : (1 << 20);
        for (int it = vcu; it < NB * NH * 8; it += G) { const int bh = it >> 3, pr = it & 7;
            for (int pass = 0; pass < 2; ++pass) att::attn_block(bh, pass ? pr : 15 - pr, Qb, Kb, Vb, MIX, ASSQ, lds, wave, cj, tseq); }
        if (LASTREP(PH_ATTN)) { const int lane = lane_id(), hi = lane >> 5, wid = wave; __syncthreads();
            for (int cv_idx = tseq * NGW + gw; cv_idx < att::CV_TOTAL; cv_idx += NGW) { CV_DECODE(cv_idx) float cvw[16]; CV_LOAD(); CV_STORE(); } }
    }
    SEAM(PH_ATTN);
    if (IN(PH_WO)) REPLOOP(PH_WO) {
        pg8::Gemm g{MIX, WO, DM, DM, DM, nullptr, 0}; pg8::StaticOrder S; S.init(NTOK / 256, DM / 256, G, bx, nullptr);
        pg8::EpiWo E{x, HBF, X8, ASSQ, SSQ1, moe_norm}; pg8::gemm_phase<pg8::EpiWo, false>(lds, g, S, E, wave, LASTREP(PH_WO));
    }
    SEAM(PH_WO);
    if (IN(PH_ROUTER)) REPLOOP(PH_ROUTER) {
        PHASE_LANE;
        typedef float f32x16 __attribute__((ext_vector_type(16)));
        LAS int* hist = (LAS int*)(lds + HIST_OFF); LAS f32x16* xch = (LAS f32x16*)(lds + HIST_OFF + 256);
        for (int i = tid; i < 2 * NE * 128; i += NTHREADS) { const int pe = i >> 7, kc = i & 127, e = pe & 31; *(LAS u32x4*)(lds + pe * 2048 + ((kc ^ (e & 15)) << 4)) = ((const u32x4*)WRHL)[i]; }
        if (tid < NE) hist[tid] = 0;
        __syncthreads();
        for (int chunk = bx; chunk < NTOK / 128; chunk += G) {
            const int base = chunk * 128, wq = wave & 3, kh = wave >> 2;
            const int j = lane & 31, half = lane >> 5, tok = base + wq * 32 + j;
            const bf16_t* xr = HBF + (size_t)tok * DM + kh * 512 + 8 * half; const LAS unsigned char* wrow = lds + j * 2048;
            f32x16 acc = {};
#pragma unroll 8
            for (int s = 0; s < 32; ++s) { const bf16x8 xb = *(const bf16x8*)(xr + 16 * s); const int kc = ((kh * 64 + 2 * s + half) ^ (j & 15)) << 4;
                const bf16x8 ah = *(const LAS bf16x8*)(wrow + kc), al = *(const LAS bf16x8*)(wrow + 65536 + kc);
                acc = __builtin_amdgcn_mfma_f32_32x32x16_bf16(ah, xb, acc, 0, 0, 0); acc = __builtin_amdgcn_mfma_f32_32x32x16_bf16(al, xb, acc, 0, 0, 0); }
            if (kh == 1) xch[wq * 64 + lane] = acc;
            __syncthreads();
            if (kh == 0) {
                const f32x16 other = xch[wq * 64 + lane];
                const f32x4 s0 = *(const f32x4*)(SSQ1 + (size_t)tok * 16 + 8 * half), s1 = *(const f32x4*)(SSQ1 + (size_t)tok * 16 + 8 * half + 4);
                float ss = ((s0[0] + s0[1]) + (s0[2] + s0[3])) + ((s1[0] + s1[1]) + (s1[2] + s1[3])); ss += __shfl_xor(ss, 32); const float rstd = rsqrtf(ss * (1.f / DM) + EPS);
                float v[16];
#pragma unroll
                for (int r = 0; r < 16; ++r) v[r] = (acc[r] + other[r]) * rstd + b_router[(r & 3) + 8 * (r >> 2) + 4 * half];
                float lv[4]; int li[4];
#pragma unroll
                for (int t = 0; t < 4; ++t) { float best = -__builtin_inff(); int bi = 0;
#pragma unroll
                    for (int r = 0; r < 16; ++r) if (v[r] > best) { best = v[r]; bi = (r & 3) + 8 * (r >> 2) + 4 * half; }
                    const auto rv = __builtin_amdgcn_permlane32_swap(__float_as_uint(best), __float_as_uint(best), false, false); const auto ri = __builtin_amdgcn_permlane32_swap((unsigned)bi, (unsigned)bi, false, false);
                    const float b0 = __uint_as_float(rv[0]), b1 = __uint_as_float(rv[1]); const int i0 = (int)ri[0], i1 = (int)ri[1];
                    const bool t0 = (b0 > b1) || (b0 == b1 && i0 < i1); const float gb = t0 ? b0 : b1; const int gi = t0 ? i0 : i1; lv[t] = gb; li[t] = gi;
#pragma unroll
                    for (int r = 0; r < 16; ++r) if ((r & 3) + 8 * (r >> 2) + 4 * half == gi) v[r] = -__builtin_inff(); }
                if (half == 0) { const float e1 = __expf(lv[1] - lv[0]), e2 = __expf(lv[2] - lv[0]), e3 = __expf(lv[3] - lv[0]); const float inv = 1.f / (1.f + e1 + e2 + e3);
                    *(int4*)(TOPI + (size_t)tok * 4) = make_int4(li[0], li[1], li[2], li[3]); *(f32x4*)(TOPG + (size_t)tok * 4) = (f32x4){inv, e1 * inv, e2 * inv, e3 * inv}; RS1[tok] = rstd;
#pragma unroll
                    for (int t = 0; t < 4; ++t) (void)__hip_atomic_fetch_add(hist + li[t], 1, __ATOMIC_RELAXED, __HIP_MEMORY_SCOPE_WORKGROUP); }
            }
            __syncthreads();
        }
        if (tid < NE && LASTREP(PH_ROUTER)) atomicAdd(ctl + CW_CNT + tid, hist[tid]);
        __syncthreads();
    }
    SEAM(PH_ROUTER);
    if (IN(PH_ROUTE)) {
        PHASE_LANE;
        LAS int* sh = (LAS int*)lds;
        if (tid == 0) { int ps = 0, nt = 0;
            for (int e = 0; e < NE; ++e) { sh[e] = ps; const int t = (ctl[CW_CNT + e] + 255) >> 8; if (bx == 0) for (int q = 0; q < t; ++q) ctl[CW_TILE_E + nt + q] = e; nt += t; ps += t * 256; }
            sh[NE] = ps; if (bx == 0) ctl[CW_NTILES] = nt; }
        __syncthreads();
        for (int chunk = bx; chunk < MROWS / NTHREADS; chunk += G) {
            if (tid < NE) sh[64 + tid] = 0;
            __syncthreads();
            const int idx = chunk * NTHREADS + tid, e = TOPI[idx]; const int r = __hip_atomic_fetch_add(sh + 64 + e, 1, __ATOMIC_RELAXED, __HIP_MEMORY_SCOPE_WORKGROUP);
            __syncthreads();
            if (tid < NE) sh[128 + tid] = atomicAdd(ctl + CW_CURSOR + tid, sh[64 + tid]);
            __syncthreads();
            const int dest = sh[e] + sh[128 + e] + r; ROWTOK[dest] = idx >> 2; ROWSLOT[dest] = idx; ROWGATE[dest] = TOPG[idx]; ROWRS[dest] = RS1[idx >> 2];
            __syncthreads();
        }
        for (int e = bx; e < NE; e += G) { const int plo = sh[e] + ctl[CW_CNT + e], phi = sh[e + 1];
            for (int r = plo + tid; r < phi; r += NTHREADS) { ROWTOK[r] = 0; ROWSLOT[r] = MROWS; ROWGATE[r] = 0.f; ROWRS[r] = 0.f; } }
        __syncthreads();
    }
    SEAM(PH_ROUTE);
    if (IN(PH_MOE1)) REPLOOP(PH_MOE1) {
        pg8::Gemm g{X8, W1T, DM, DM, DM, ROWTOK, (size_t)2048 * DM}; pg8::StaticOrder S; S.init(ctl[CW_NTILES], 2048 / 256, G, bx, ctl + CW_TILE_E);
        pg8::EpiMoe1 E{(unsigned char*)HB, b1, ROWRS}; pg8::gemm_phase<pg8::EpiMoe1, true, true>(lds, g, S, E, wave, LASTREP(PH_MOE1));
    }
    SEAM(PH_MOE1);
    if (IN(PH_MOE2)) REPLOOP(PH_MOE2) {
        pg8::Gemm g{HB, W2T, DE, DE, DE, nullptr, (size_t)DM * DE}; pg8::StaticOrder S; S.init(ctl[CW_NTILES], DM / 256, G, bx, ctl + CW_TILE_E);
        pg8::EpiMoe2 E{(unsigned char*)Y, b2, ROWSLOT, ROWGATE}; pg8::gemm_phase<pg8::EpiMoe2, false, true>(lds, g, S, E, wave, LASTREP(PH_MOE2));
    }
    SEAM(PH_MOE2);
    if (IN(PH_COMBINE)) REPLOOP(PH_COMBINE) {
        PHASE_LANE;
        for (int row = gw * 2; row < NTOK; row += NGW * 2) {
            u32x4 hv[2][2]; u32x2 yv[2][4][2]; const unsigned char* Y8 = (const unsigned char*)Y;
#pragma unroll
            for (int q = 0; q < 2; ++q)
#pragma unroll
                for (int j = 0; j < 2; ++j) { hv[q][j] = *(const u32x4*)(HBF + (size_t)(row + q) * DM + (lane + 64 * j) * 8);
#pragma unroll
                    for (int k = 0; k < 4; ++k) yv[q][k][j] = *(const u32x2*)(Y8 + ((size_t)(row + q) * 4 + k) * DM + (lane + 64 * j) * 8); }
#pragma unroll
            for (int q = 0; q < 2; ++q) { float ss = 0.f; u32x4 ov[2];
#pragma unroll
                for (int j = 0; j < 2; ++j) { f32x4 a = {blo(hv[q][j].x), bhi(hv[q][j].x), blo(hv[q][j].y), bhi(hv[q][j].y)}, b = {blo(hv[q][j].z), bhi(hv[q][j].z), blo(hv[q][j].w), bhi(hv[q][j].w)};
#pragma unroll
                    for (int k = 0; k < 4; ++k) { const u32x2 y = yv[q][k][j]; const f32x2 y0 = __builtin_amdgcn_cvt_pk_f32_fp8(y.x, false), y1 = __builtin_amdgcn_cvt_pk_f32_fp8(y.x, true), y2 = __builtin_amdgcn_cvt_pk_f32_fp8(y.y, false), y3 = __builtin_amdgcn_cvt_pk_f32_fp8(y.y, true);
                        a += (f32x4){y0[0], y0[1], y1[0], y1[1]}; b += (f32x4){y2[0], y2[1], y3[0], y3[1]}; }
                    ss += pg8::sq4(a) + pg8::sq4(b); ov[j] = pg8::pack8(a, b); }
                ss = wave_sum(ss);
                bf16_t* ho = LASTREP(PH_COMBINE) ? HBF : (bf16_t*)(ws + WS_HB);
#pragma unroll
                for (int j = 0; j < 2; ++j) *(u32x4*)(ho + (size_t)(row + q) * DM + (lane + 64 * j) * 8) = ov[j];
                float ps = lane < 16 ? PSSQ[(size_t)(row + q) * 16 + lane] : 0.f; ps += __shfl_xor(ps, 1); ps += __shfl_xor(ps, 2); ps += __shfl_xor(ps, 4); ps += __shfl_xor(ps, 8);
                if (lane == 0) { RS2[row + q] = rsqrtf(ss * (1.f / DM) + EPS); RS2[NTOK + row + q] = rsqrtf(ps * (1.f / DM) + EPS); } }
        }
    }
    SEAM(PH_COMBINE);
    if (IN(PH_PLE)) REPLOOP(PH_PLE) {
        pg8::Gemm g{HBF, WG, DM, DM, DM, nullptr, 0}; pg8::StaticOrder S; S.init(NTOK / 256, DM / 256, G, bx, nullptr);
        pg8::EpiPle E{HBF, H3, PLER, RS2 + NTOK, RS2, ple_post_norm, FSSQ}; pg8::gemm_phase<pg8::EpiPle, false>(lds, g, S, E, wave);
    }
    SEAM(PH_PLE);
    if (IN(PH_FINAL)) REPLOOP(PH_FINAL) {
        PHASE_LANE;
        for (int row = gw * 2; row < NTOK; row += NGW * 2) {
            u32x4 hv[2][2]; float sp[2];
#pragma unroll
            for (int q = 0; q < 2; ++q) { sp[q] = lane < 16 ? FSSQ[(size_t)(row + q) * 16 + lane] : 0.f;
#pragma unroll
                for (int j = 0; j < 2; ++j) hv[q][j] = *(const u32x4*)(H3 + (size_t)(row + q) * DM + (lane + 64 * j) * 8); }
#pragma unroll
            for (int q = 0; q < 2; ++q) { float s = sp[q]; s += __shfl_xor(s, 1); s += __shfl_xor(s, 2); s += __shfl_xor(s, 4); s += __shfl_xor(s, 8);
                const float rstd = rsqrtf(__shfl(s, 0) * (1.f / DM) + EPS); float* ho = (LASTREP(PH_FINAL) ? H : (float*)(ws + WS_HB)) + (size_t)(row + q) * DM;
#pragma unroll
                for (int j = 0; j < 2; ++j) { const int c = (lane + 64 * j) * 8; const f32x4 g0 = *(const f32x4*)(final_norm + c), g1 = *(const f32x4*)(final_norm + c + 4); const u32x4 v = hv[q][j];
                    *(f32x4*)(ho + c) = (f32x4){blo(v.x), bhi(v.x), blo(v.y), bhi(v.y)} * rstd * g0; *(f32x4*)(ho + c + 4) = (f32x4){blo(v.z), bhi(v.z), blo(v.w), bhi(v.w)} * rstd * g1; } }
        }
    }
#ifdef PROBE_TIME_PH
    STAMP(PH_COUNT);
    if (bx == 0 && wave == 0) { const unsigned dt = MISC[32 + PROBE_TIME_PH + 1] - MISC[32 + PROBE_TIME_PH]; const unsigned long long t0 = __builtin_amdgcn_s_memrealtime(); while (__builtin_amdgcn_s_memrealtime() - t0 < (unsigned long long)dt) __builtin_amdgcn_s_sleep(8); }
#endif
#ifdef PROBE_BARS
    if (hi - lo > 1) for (int i = 0; i < PROBE_BARS; ++i) xcd_barrier(bar, wave);
#endif
#undef IN
#undef NREP
#undef REPLOOP
#undef LASTREP
#undef SEAM
}
static int g_grid = 0;
extern "C" void kernel_launch(void* const* d_in, const int* in_sizes, int n_in, void* d_out, int out_size, void* d_ws, size_t ws_size, hipStream_t stream) {
    if (n_in != 25 || in_sizes[0] != NTOK * DM || out_size != NTOK * DM || ws_size < WS_END) {
        fprintf(stderr, "kernel_launch: unexpected shapes (n_in %d, in0 %d, out %d, ws %zu need %zu)\n", n_in, n_in > 0 ? in_sizes[0] : -1, out_size, ws_size, (size_t)WS_END); return; }
    if (g_grid == 0) {
        int dev = 0, cus = 0, per_cu = 0; (void)hipGetDevice(&dev); (void)hipDeviceGetAttribute(&cus, hipDeviceAttributeMultiprocessorCount, dev);
        if (hipFuncSetAttribute((const void*)fwd, hipFuncAttributeMaxDynamicSharedMemorySize, LDS_BYTES) != hipSuccess) fprintf(stderr, "hipFuncSetAttribute failed\n");
        if (hipOccupancyMaxActiveBlocksPerMultiprocessor(&per_cu, (const void*)fwd, NTHREADS, LDS_BYTES) != hipSuccess || per_cu < 1) { fprintf(stderr, "occupancy query: %d\n", per_cu); per_cu = 1; }
        (void)hipGetLastError();
        g_grid = cus > 0 ? cus : 256;
    }
    (void)hipMemsetAsync((unsigned char*)d_ws + WS_CTL, 0, 64 * 1024, stream);
    Args a{}; for (int i = 0; i < 25; ++i) a.in[i] = d_in[i]; a.out = (float*)d_out; a.ws = (unsigned char*)d_ws;
    a.ph_lo = 0; a.ph_hi = PH_COUNT; a.li = 0; a.skip = 0;
    void* p[] = {&a};
    const hipError_t e = hipLaunchCooperativeKernel((const void*)fwd, dim3(g_grid), dim3(NTHREADS), p, LDS_BYTES, stream);
    if (e != hipSuccess) fprintf(stderr, "cooperative launch failed: %s (grid %d)\n", hipGetErrorString(e), g_grid);
}
```

```cpp
#include <hip/hip_runtime.h>
#include <cstdint>
#include <cstdio>
#include <cmath>

typedef unsigned short bf16_t;

constexpr int NB = 8, SEQ = 4096, DM = 1024, NTOK = NB * SEQ;
constexpr int PLE = 256, NH = 4, DN = 128, DR = 64, DV = 128, QL = 256, KVL = 128, DQK = DN + DR;
constexpr int INW = 1984, INWP = 2048;
constexpr int NE = 32, TOPK = 4, DE = 1024;
constexpr int MROWS = NTOK * TOPK;
constexpr int MAXTILES = MROWS / 256 + NE;
constexpr int PROWS = MAXTILES * 256;
constexpr float EPS = 1e-6f;
constexpr float QSCALE = 0.07216878364870322f * 1.4426950408889634f;

constexpr size_t MiB = 1u << 20;
constexpr size_t WS_CTL = 0;
constexpr size_t WS_WIN = 1 * MiB, WS_WUQ = 5 * MiB, WS_WUKV = 5 * MiB + 512 * 1024, WS_WO = 6 * MiB, WS_WG = 8 * MiB, WS_WP = 10 * MiB;
constexpr size_t WS_WR = 10 * MiB + 512 * 1024;
constexpr size_t WS_CS = 11 * MiB;
constexpr size_t WS_SSQ = 19 * MiB, WS_ASSQ = 20 * MiB, WS_PSSQ = 21 * MiB, WS_FSSQ = 23 * MiB;
constexpr size_t WS_TOPI = 25 * MiB, WS_TOPG = 25 * MiB + 512 * 1024;
constexpr size_t WS_ROWTOK = 26 * MiB, WS_ROWSLOT = 27 * MiB, WS_ROWGATE = 28 * MiB;
constexpr size_t WS_P16 = 29 * MiB;
constexpr size_t WS_SSQ1 = 45 * MiB, WS_RS1 = 47 * MiB, WS_RS2 = 47 * MiB + 128 * 1024, WS_ROWRS = 47 * MiB + 384 * 1024;
constexpr size_t WS_RSX = 10 * MiB + 512 * 1024;
constexpr size_t WS_WRHL = 10 * MiB + 768 * 1024;
constexpr size_t WS_HBF = 112 * MiB;
constexpr size_t WS_H3 = 304 * MiB;
constexpr size_t WS_W1 = 48 * MiB, WS_W2 = 176 * MiB, WS_XN = 240 * MiB, WS_MIX = 304 * MiB, WS_PLER = 368 * MiB;
constexpr size_t WS_Z = 432 * MiB, WS_Q = 560 * MiB, WS_K = 608 * MiB, WS_V = 656 * MiB;
constexpr size_t WS_HB = 432 * MiB;
constexpr size_t WS_Y = 704 * MiB;
constexpr size_t WS_END = WS_Y + (size_t)(MROWS + 256) * DM * 2;
constexpr int CW_CNT = 0, CW_CURSOR = 64, CW_PADSTART = 128, CW_NTILES = 192, CW_TILE_E = 256;

__device__ __forceinline__ float bf2f(bf16_t v) { return __uint_as_float((unsigned)v << 16); }
__device__ __forceinline__ float blo(unsigned u) { return __uint_as_float(u << 16); }
__device__ __forceinline__ float bhi(unsigned u) { return __uint_as_float(u & 0xffff0000u); }
__device__ __forceinline__ bf16_t f2bf(float f) { unsigned u = __float_as_uint(f); return (bf16_t)((u + 0x7fffu + ((u >> 16) & 1u)) >> 16); }
__device__ __forceinline__ unsigned pk2(float lo, float hi) { return (unsigned)f2bf(lo) | ((unsigned)f2bf(hi) << 16); }
__device__ __forceinline__ float wave_sum(float v) {
#pragma unroll
    for (int o = 1; o < 64; o <<= 1) v += __shfl_xor(v, o);
    return v;
}
__device__ __forceinline__ float wave_max(float v) {
#pragma unroll
    for (int o = 1; o < 64; o <<= 1) v = fmaxf(v, __shfl_xor(v, o));
    return v;
}
__device__ __forceinline__ float dot8(uint4 x, uint4 y) {
    return blo(x.x) * blo(y.x) + bhi(x.x) * bhi(y.x) + blo(x.y) * blo(y.y) + bhi(x.y) * bhi(y.y) +
           blo(x.z) * blo(y.z) + bhi(x.z) * bhi(y.z) + blo(x.w) * blo(y.w) + bhi(x.w) * bhi(y.w);
}
__device__ __forceinline__ float dot_bf16(const bf16_t* a, const bf16_t* b, int K) {
    const uint4* a4 = (const uint4*)a; const uint4* b4 = (const uint4*)b; float acc = 0.f;
    for (int i = 0; i < K / 8; ++i) acc += dot8(a4[i], b4[i]);
    return acc;
}

#define LAS __attribute__((address_space(3)))
#define GAS __attribute__((address_space(1)))
typedef short bf16x8 __attribute__((ext_vector_type(8)));
typedef float f32x4 __attribute__((ext_vector_type(4)));
typedef float f32x2 __attribute__((ext_vector_type(2)));
typedef unsigned u32x4 __attribute__((ext_vector_type(4)));
typedef unsigned u32x2 __attribute__((ext_vector_type(2)));
#ifndef PROBE_PH
#define PROBE_PH (-1)
#define PROBE_REP 1
#endif
#ifndef MOE2_DELAY_TICKS
#define MOE2_DELAY_TICKS 700ull
#endif
constexpr int NWAVES = 8, NTHREADS = 512;
constexpr int RING_BYTES = 131072, MISC_OFF = RING_BYTES, HIST_OFF = MISC_OFF + 256, LDS_BYTES = 163840;
constexpr int CW_BAR = 4096;
__device__ __forceinline__ unsigned cvt_pk_bf16(float lo, float hi) { unsigned r; asm volatile("v_cvt_pk_bf16_f32 %0, %1, %2" : "=v"(r) : "v"(lo), "v"(hi)); return r; }
__device__ __forceinline__ int lane_id() { int l = (int)__builtin_amdgcn_mbcnt_hi(~0u, __builtin_amdgcn_mbcnt_lo(~0u, 0u)); asm volatile("" : "+v"(l)); return l; }
__device__ __forceinline__ float fast_sigmoid(float a) { return __builtin_amdgcn_rcpf(1.f + __expf(-a)); }

#define XB_TMO      128
#define XB_XCNT(j)  (256  + 64 * (j))
#define XB_XSUB(j)  (1280 + 64 * (j))
#define XB_XGEN(j)  (2304 + 64 * (j))
#define XB_TOP      3328
#define XB_TOPGEN   3392
#define XCD_BAR_WORDS 3456
#define XB_SPIN_CAP (1u << 20)
__device__ __forceinline__ unsigned xb_ld(unsigned* p)              { return __hip_atomic_load(p, __ATOMIC_RELAXED, __HIP_MEMORY_SCOPE_AGENT); }
__device__ __forceinline__ unsigned xb_add(unsigned* p, unsigned v) { return __hip_atomic_fetch_add(p, v, __ATOMIC_RELAXED, __HIP_MEMORY_SCOPE_AGENT); }
__device__ __forceinline__ unsigned xb_xcc_id() { return (unsigned)__builtin_amdgcn_s_getreg((3 << 11) | 20) & 0xFu; }
#define XB_SPIN(cond, bar) do { unsigned _sp = 0; while (cond) { __builtin_amdgcn_s_sleep(1); \
    if ((++_sp & 255u) == 0u) { if (xb_ld(&(bar)[XB_TMO])) break; if (_sp > XB_SPIN_CAP) { atomicAdd(&(bar)[XB_TMO], 1u); break; } } } } while (0)
struct XcdBarrier { unsigned* bar; unsigned x; volatile LAS unsigned* st; };
__device__ __forceinline__ XcdBarrier xcd_barrier_post(unsigned* bar, volatile LAS unsigned* st, int wave) {
    XcdBarrier b; b.bar = bar; b.x = xb_xcc_id(); b.st = st;
    if (wave == 0 && lane_id() == 0) (void)xb_add(&bar[XB_XCNT(b.x)], 1u);
    return b;
}
__device__ __forceinline__ void xcd_barrier_complete(unsigned* bar, unsigned x, unsigned& nloc, unsigned& nx) {
    const unsigned G = gridDim.x * gridDim.y * gridDim.z;
    unsigned sum, cnt, mine, sp = 0u;
    for (;;) {
        sum = 0u; cnt = 0u; mine = 0u;
#pragma unroll
        for (unsigned j = 0; j < 16; ++j) { const unsigned c = xb_ld(&bar[XB_XCNT(j)]); sum += c; cnt += (c > 0u) ? 1u : 0u; mine = (j == x) ? c : mine; }
        if (sum == G) break;
        __builtin_amdgcn_s_sleep(1);
        if ((++sp & 255u) == 0u) { if (xb_ld(&bar[XB_TMO])) break; if (sp > XB_SPIN_CAP) { atomicAdd(&bar[XB_TMO], 1u); break; } }
    }
    nloc = mine > 0u ? mine : 1u; nx = cnt > 0u ? cnt : 1u;
}
__device__ __forceinline__ void xcd_barrier(const XcdBarrier& b, int wave) {
    asm volatile("s_waitcnt vmcnt(0)" ::: "memory");
    __syncthreads();
    if (wave == 0 && lane_id() == 0) {
        unsigned* bar = b.bar;
        __builtin_amdgcn_s_waitcnt(0);
        unsigned nloc = b.st[0], nx = b.st[1];
        if (nloc == 0u) { xcd_barrier_complete(bar, b.x, nloc, nx); b.st[0] = nloc; b.st[1] = nx; }
        const unsigned old = xb_add(&bar[XB_XSUB(b.x)], 1u);
        const unsigned gen = old / nloc;
        if (old + 1u == (gen + 1u) * nloc) {
            __builtin_amdgcn_fence(__ATOMIC_RELEASE, "agent");
            asm volatile("s_waitcnt vmcnt(0)" ::: "memory");
            const unsigned og = xb_add(&bar[XB_TOP], 1u);
            const unsigned tg = og / nx;
            if (og + 1u == (tg + 1u) * nx) xb_add(&bar[XB_TOPGEN], 1u);
            else XB_SPIN(xb_ld(&bar[XB_TOPGEN]) == tg, bar);
            __builtin_amdgcn_fence(__ATOMIC_ACQUIRE, "agent");
            xb_add(&bar[XB_XGEN(b.x)], 1u);
            asm volatile("s_waitcnt vmcnt(0)" ::: "memory");
        } else {
            XB_SPIN(xb_ld(&bar[XB_XGEN(b.x)]) == gen, bar);
            __builtin_amdgcn_fence(__ATOMIC_ACQUIRE, "agent");
            asm volatile("s_waitcnt vmcnt(0)" ::: "memory");
        }
    }
    __syncthreads();
}

namespace pg8 {
constexpr int BM = 256, BK = 64, HALF = 128, HTB = HALF * BK * 2, STAGE_BYTES = 8 * HTB, NXCD = 8, WGM = 8;
__host__ __device__ __forceinline__ int lds_byte(int r, int c) { const int st = (r >> 4) * 2 + (c >> 5), rr = r & 15, cc = c & 31, ob = rr * 64 + cc * 2; return st * 1024 + (ob ^ (((ob >> 9) & 1) << 5)); }
__host__ __device__ __forceinline__ void stage_rc(int b, int& R, int& C) { const int st = b / 1024, sb = b % 1024, swz = sb ^ (((sb >> 9) & 1) << 5); R = (st >> 1) * 16 + swz / 64; C = (st & 1) * 32 + (swz % 64) / 2; }
__host__ __device__ __forceinline__ int perm32(int rho) { const int n = rho >> 4, i = rho & 15; return 8 * (i >> 2) + 4 * n + (i & 3); }
struct Unit { int pm, pn, e; };
struct Gemm { const void* A; const void* Bt; int K, lda, ldb; const int* rowidx; size_t bstride; };
struct StaticOrder {
    int nM, nN, nwg, G, c; const int* tile_e;
    __device__ void init(int nM_, int nN_, int G_, int c_, const int* te) { nM = nM_; nN = nN_; nwg = nM * nN; G = G_; c = c_; tile_e = te; }
    __device__ bool next(int i, Unit& u) const {
        const long L = (long)i * G + c; if (L >= nwg) return false;
        int wgid = (int)L; { const int q = nwg / NXCD, r = nwg % NXCD, xcd = wgid % NXCD, off = wgid / NXCD; wgid = (xcd < r ? xcd * (q + 1) : r * (q + 1) + (xcd - r) * q) + off; }
        const int nig = WGM * nN, gid = wgid / nig, fm = gid * WGM, gsz = (nM - fm) < WGM ? (nM - fm) : WGM;
        u.pm = fm + ((wgid % nig) % gsz); u.pn = (wgid % nig) / gsz; u.e = tile_e ? tile_e[u.pm] : 0; return true;
    }
};
typedef f32x4 Acc[2][2][4][2];
typedef int v8i_t __attribute__((ext_vector_type(8)));
typedef int v4i_t __attribute__((ext_vector_type(4)));
template <class Epi, bool GATHER, bool FP8 = false>
__device__ __forceinline__ void gemm_phase(LAS unsigned char* lds, const Gemm g, const StaticOrder& S, const Epi& E, const int wid, const bool do_epi = true) {
    const int lane = lane_id(), tid = wid * 64 + lane, wr = wid >> 2, wc = wid & 3, fr = lane & 15, fq = lane >> 4;
    constexpr int ES = FP8 ? 1 : 2;
    const int K = g.K, nt = K * ES / 128;
    int RA[2], CA[2]; unsigned voffB[2], voffA[2];
#pragma unroll
    for (int i = 0; i < 2; ++i) { int R, C; stage_rc(tid * 16 + i * 8192, R, C); const int Rb = Epi::PERM ? ((R & ~31) + perm32(R & 31)) : R;
        RA[i] = R; CA[i] = C; voffB[i] = (unsigned)(Rb * g.ldb * ES + C * 2); voffA[i] = (unsigned)(R * g.lda * ES + C * 2); }
    const size_t hstepA = GATHER ? 0 : (size_t)HALF * g.lda * ES;
    const size_t kstep = (size_t)(BK * 2);
    const size_t hstepB = (size_t)HALF * g.ldb * ES;
    const unsigned ldsw = (unsigned)wid * 1024u;
    const int aoff = lds_byte(wr * 64 + fr, fq * 8), boff = lds_byte(wc * 32 + fr, fq * 8);
#define PG8_SA(b, h) (((b) * 2 + (h)) * HTB)
#define PG8_SB(b, h) ((4 + (b) * 2 + (h)) * HTB)
#define PG8_STAGE(bufoff, gbase, voff) do { _Pragma("unroll") for (int _i = 0; _i < 2; ++_i) \
        __builtin_amdgcn_global_load_lds((const unsigned*)((const char*)(gbase) + (voff)[_i]), (LAS unsigned*)(lds + (bufoff) + ldsw + _i * 8192), 16, 0, 0); } while (0)
#define PG8_LDA(dst, b, h) do { _Pragma("unroll") for (int m = 0; m < 4; ++m) _Pragma("unroll") for (int k = 0; k < 2; ++k) dst[m][k] = *(const LAS bf16x8*)(lds + PG8_SA(b, h) + aoff + m * 2048 + k * 1024); } while (0)
#define PG8_LDB(dst, b, h) do { _Pragma("unroll") for (int n = 0; n < 2; ++n) _Pragma("unroll") for (int k = 0; k < 2; ++k) dst[n][k] = *(const LAS bf16x8*)(lds + PG8_SB(b, h) + boff + n * 2048 + k * 1024); } while (0)
#define PG8_CAT8(x) __builtin_shufflevector(__builtin_bit_cast(v4i_t, (x)[0]), __builtin_bit_cast(v4i_t, (x)[1]), 0, 1, 2, 3, 4, 5, 6, 7)
#define PG8_MMA(ai, bj, At, Bt) do { __builtin_amdgcn_s_setprio(1); if constexpr (FP8) { _Pragma("unroll") for (int m = 0; m < 4; ++m) _Pragma("unroll") for (int n = 0; n < 2; ++n) \
        acc[ai][bj][m][n] = __builtin_amdgcn_mfma_scale_f32_16x16x128_f8f6f4(PG8_CAT8(Bt[n]), PG8_CAT8(At[m]), acc[ai][bj][m][n], 0, 0, 0, 0x7f7f7f7f, 0, 0x7f7f7f7f); \
        _Pragma("unroll") for (int m = 0; m < 4; ++m) _Pragma("unroll") for (int n = 0; n < 2; ++n) asm volatile("" : "+v"(acc[ai][bj][m][n]));   } else { \
        _Pragma("unroll") for (int m = 0; m < 4; ++m) _Pragma("unroll") for (int n = 0; n < 2; ++n) _Pragma("unroll") for (int k = 0; k < 2; ++k) \
        acc[ai][bj][m][n] = __builtin_amdgcn_mfma_f32_16x16x32_bf16(Bt[n][k], At[m][k], acc[ai][bj][m][n], 0, 0, 0); } __builtin_amdgcn_s_setprio(0); } while (0)
#define PG8_WAIT_V(n) asm volatile("s_waitcnt vmcnt(" #n ")" ::: "memory")
#define PG8_WAIT_L(n) asm volatile("s_waitcnt lgkmcnt(" #n ")" ::: "memory")
#define PG8_BAR __builtin_amdgcn_s_barrier()
#define PG8_SCHED __builtin_amdgcn_sched_barrier(0)
#define PG8_SETVO(vo, u) do { if constexpr (GATHER) { _Pragma("unroll") for (int _h = 0; _h < 2; ++_h) _Pragma("unroll") for (int _i = 0; _i < 2; ++_i) { \
        const int _row = g.rowidx[(u).pm * BM + _h * HALF + RA[_i]]; (vo)[_h][_i] = (unsigned)_row * (unsigned)(g.lda * ES) + (unsigned)CA[_i] * 2u; } } } while (0)
#define PG8_STAGE_A(bufoff, base, h, vog) do { if constexpr (GATHER) { PG8_STAGE(bufoff, base, (vog)[h]); } else { PG8_STAGE(bufoff, (base) + (h) * hstepA, voffA); } } while (0)
    Unit cur, nxt; int ui = 0;
    if (!S.next(0, cur)) return;
    Acc acc;
#pragma unroll
    for (int a = 0; a < 2; ++a)
#pragma unroll
        for (int b = 0; b < 2; ++b)
#pragma unroll
            for (int m = 0; m < 4; ++m)
#pragma unroll
                for (int n = 0; n < 2; ++n) acc[a][b][m][n] = (f32x4){0.f, 0.f, 0.f, 0.f};
    bf16x8 At[4][2], B0[2][2], B1[2][2];
    unsigned voC[2][2], voN[2][2];
    PG8_SETVO(voC, cur);
    const char* const Ab = (const char*)g.A;
    const char* cA = GATHER ? Ab : Ab + (size_t)cur.pm * 2 * hstepA;
    const char* cB = (const char*)g.Bt + (size_t)cur.e * g.bstride + (size_t)cur.pn * 2 * hstepB;
    PG8_STAGE(PG8_SB(0, 0), cB, voffB); PG8_STAGE(PG8_SB(0, 1), cB + hstepB, voffB); PG8_STAGE_A(PG8_SA(0, 0), cA, 0, voC); PG8_STAGE_A(PG8_SA(0, 1), cA, 1, voC);
    if (wr == 1) PG8_BAR;
    PG8_WAIT_V(2); PG8_BAR;
    PG8_STAGE(PG8_SB(1, 0), cB + kstep, voffB); PG8_STAGE_A(PG8_SA(1, 0), cA + kstep, 0, voC); PG8_STAGE(PG8_SB(1, 1), cB + hstepB + kstep, voffB);
    PG8_WAIT_V(6); PG8_BAR;
    for (;;) {
        const bool has_next = S.next(ui + 1, nxt);
        const char* nB = has_next ? (const char*)g.Bt + (size_t)nxt.e * g.bstride + (size_t)nxt.pn * 2 * hstepB : cB;
        const char* nA = (has_next && !GATHER) ? Ab + (size_t)nxt.pm * 2 * hstepA : cA;
        if constexpr (GATHER) { if (has_next) { PG8_SETVO(voN, nxt); } else {
#pragma unroll
            for (int h = 0; h < 2; ++h)
#pragma unroll
                for (int i = 0; i < 2; ++i) voN[h][i] = voC[h][i]; } }
        for (int t = 0; t < nt; t += 2) {
            const bool last = (t == nt - 2);
            if constexpr (Epi::MIDK > 0) { if (t == Epi::MIDK) { const int l2 = lane_id(); E.mid(acc, cur, wr, wc, l2 & 15, l2 >> 4); } }
            const char* a1 = cA + (size_t)(t + 1) * kstep;
            const char* a2 = last ? nA : cA + (size_t)(t + 2) * kstep; const char* b2 = last ? nB : cB + (size_t)(t + 2) * kstep;
            const char* a3 = a2 + kstep; const char* b3 = b2 + kstep;
            unsigned o2[2][2];
            if constexpr (GATHER) {
#pragma unroll
            for (int h = 0; h < 2; ++h)
#pragma unroll
                for (int i = 0; i < 2; ++i) o2[h][i] = last ? voN[h][i] : voC[h][i]; }
            PG8_LDB(B0, 0, 0); PG8_LDB(B1, 0, 1); PG8_SCHED; PG8_LDA(At, 0, 0); PG8_STAGE_A(PG8_SA(1, 1), a1, 1, voC);
            PG8_WAIT_V(8); PG8_WAIT_L(0); PG8_BAR; PG8_MMA(0, 0, At, B0); PG8_MMA(0, 1, At, B1); PG8_BAR; PG8_SCHED;
            PG8_LDA(At, 0, 1); PG8_STAGE(PG8_SB(0, 0), b2, voffB); PG8_STAGE(PG8_SB(0, 1), b2 + hstepB, voffB); PG8_STAGE_A(PG8_SA(0, 0), a2, 0, o2);
            PG8_WAIT_V(8); PG8_WAIT_L(0); PG8_BAR; PG8_MMA(1, 0, At, B0); PG8_MMA(1, 1, At, B1); PG8_BAR; PG8_SCHED;
            PG8_LDB(B0, 1, 0); PG8_LDB(B1, 1, 1); PG8_SCHED; PG8_LDA(At, 1, 0); PG8_STAGE_A(PG8_SA(0, 1), a2, 1, o2);
            PG8_WAIT_V(8); PG8_WAIT_L(0); PG8_BAR; PG8_MMA(0, 0, At, B0); PG8_MMA(0, 1, At, B1); PG8_BAR; PG8_SCHED;
            PG8_LDA(At, 1, 1); PG8_STAGE(PG8_SB(1, 0), b3, voffB); PG8_STAGE(PG8_SB(1, 1), b3 + hstepB, voffB); PG8_STAGE_A(PG8_SA(1, 0), a3, 0, o2);
            PG8_WAIT_V(8); PG8_WAIT_L(0); PG8_BAR; PG8_MMA(1, 0, At, B0); PG8_MMA(1, 1, At, B1); PG8_BAR; PG8_SCHED;
        }
        if (wr == 0) PG8_BAR;
        if (do_epi) { const int l2 = lane_id(); E(acc, cur, wr, wc, l2 & 15, l2 >> 4); }
        if (!has_next) break;
#pragma unroll
        for (int a = 0; a < 2; ++a)
#pragma unroll
            for (int b = 0; b < 2; ++b)
#pragma unroll
                for (int m = 0; m < 4; ++m)
#pragma unroll
                    for (int n = 0; n < 2; ++n) acc[a][b][m][n] = (f32x4){0.f, 0.f, 0.f, 0.f};
        cur = nxt; cB = nB; cA = nA; ++ui;
        if constexpr (GATHER) {
#pragma unroll
        for (int h = 0; h < 2; ++h)
#pragma unroll
            for (int i = 0; i < 2; ++i) voC[h][i] = voN[h][i]; }
        if (wr == 1) PG8_BAR;
    }
    PG8_WAIT_V(0);
    PG8_BAR;
#undef PG8_SA
#undef PG8_SB
#undef PG8_STAGE
#undef PG8_LDA
#undef PG8_LDB
#undef PG8_MMA
#undef PG8_CAT8
#undef PG8_WAIT_V
#undef PG8_WAIT_L
#undef PG8_BAR
#undef PG8_SCHED
#undef PG8_SETVO
#undef PG8_STAGE_A
}

__device__ __forceinline__ unsigned pk4_fp8(f32x4 v) { unsigned w = 0; w = __builtin_amdgcn_cvt_pk_fp8_f32(v[0], v[1], w, false); w = __builtin_amdgcn_cvt_pk_fp8_f32(v[2], v[3], w, true); return w; }
__device__ __forceinline__ float sq4(f32x4 v) { return (v[0] * v[0] + v[1] * v[1]) + (v[2] * v[2] + v[3] * v[3]); }
__device__ __forceinline__ float red_fq(float s) { s += __shfl_xor(s, 16); s += __shfl_xor(s, 32); return s; }
__device__ __forceinline__ u32x4 pack8(f32x4 a, f32x4 b) { u32x4 w; w.x = cvt_pk_bf16(a[0], a[1]); w.y = cvt_pk_bf16(a[2], a[3]); w.z = cvt_pk_bf16(b[0], b[1]); w.w = cvt_pk_bf16(b[2], b[3]); return w; }
template <int MODE> struct EpiBf16Stats {
    static constexpr bool PERM = true; static constexpr int MIDK = 0;
    bf16_t* O; int ldc; float* ssq; const float* rsx;
    __device__ __forceinline__ void operator()(const Acc& acc, const Unit& u, int wr, int wc, int fr, int fq) const {
        const int row0 = u.pm * BM + wr * 64 + fr, col0 = u.pn * BM + wc * 32 + 8 * fq;
        float rv[2][4];
#pragma unroll
        for (int ai = 0; ai < 2; ++ai)
#pragma unroll
            for (int m = 0; m < 4; ++m) rv[ai][m] = rsx ? rsx[row0 + ai * HALF + m * 16] : 1.f;
        asm volatile("" ::: "memory");
#pragma unroll
        for (int ai = 0; ai < 2; ++ai)
#pragma unroll
            for (int m = 0; m < 4; ++m) { const int row = row0 + ai * HALF + m * 16; bf16_t* rowp = O + (size_t)row * ldc + col0; const float rs = rv[ai][m];
                const f32x4 a00 = acc[ai][0][m][0] * rs, a01 = acc[ai][0][m][1] * rs, a10 = acc[ai][1][m][0] * rs, a11 = acc[ai][1][m][1] * rs;
                *(u32x4*)(rowp) = pack8(a00, a01); *(u32x4*)(rowp + HALF) = pack8(a10, a11);
                if (MODE == 1) { float s = (sq4(a00) + sq4(a01)) + (sq4(a10) + sq4(a11)); s = red_fq(s); if (fq == 0) ssq[(size_t)row * 16 + u.pn * 4 + wc] = s; }
                else if (u.pn == 0) { float s = (sq4(a00) + sq4(a01)) + (sq4(a10) + sq4(a11)); s = red_fq(s); if (fq == 0) ssq[(size_t)row * 8 + wc] = s; }
                else if (u.pn == 1) { float s = sq4(a00) + sq4(a01); s = red_fq(s); if (fq == 0) ssq[(size_t)row * 8 + 4 + wc] = s; } }
    }
};
struct EpiQ {
    static constexpr bool PERM = true; static constexpr int MIDK = 0;
    bf16_t* Q; const float* ssq; const float* cs;
    __device__ __forceinline__ void operator()(const Acc& acc, const Unit& u, int wr, int wc, int fr, int fq) const {
        const int row0 = u.pm * BM + wr * 64 + fr;
#pragma unroll
        for (int ai = 0; ai < 2; ++ai)
#pragma unroll
            for (int m = 0; m < 4; ++m) { const int row = row0 + ai * HALF + m * 16; const f32x4 sv = *(const f32x4*)(ssq + (size_t)row * 8);
                const float rs = rsqrtf(((sv[0] + sv[1]) + (sv[2] + sv[3])) * (1.f / QL) + EPS); const int b = row / SEQ, s = row % SEQ;
#pragma unroll
                for (int bj = 0; bj < 2; ++bj) { const int cv = u.pn * BM + bj * HALF + wc * 32 + 8 * fq; const int h = cv / DQK, d = cv % DQK;
                    f32x4 v0 = acc[ai][bj][m][0] * rs, v1 = acc[ai][bj][m][1] * rs;
                    if (d >= DN) { const int i0 = (d - DN) >> 1; const f32x4 c = *(const f32x4*)(cs + (size_t)row * 64 + i0), sn = *(const f32x4*)(cs + (size_t)row * 64 + 32 + i0);
                        const f32x4 r0 = {v0[0] * c[0] - v0[1] * sn[0], v0[0] * sn[0] + v0[1] * c[0], v0[2] * c[1] - v0[3] * sn[1], v0[2] * sn[1] + v0[3] * c[1]};
                        const f32x4 r1 = {v1[0] * c[2] - v1[1] * sn[2], v1[0] * sn[2] + v1[1] * c[2], v1[2] * c[3] - v1[3] * sn[3], v1[2] * sn[3] + v1[3] * c[3]};
                        v0 = r0; v1 = r1; }
                    *(u32x4*)(Q + ((size_t)(b * NH + h) * SEQ + s) * DQK + d) = pack8(v0, v1); } }
    }
};
struct EpiKV {
    static constexpr bool PERM = true; static constexpr int MIDK = 0;
    bf16_t* Kc; bf16_t* Vc; const float* ssq;
    __device__ __forceinline__ void operator()(const Acc& acc, const Unit& u, int wr, int wc, int fr, int fq) const {
        const int row0 = u.pm * BM + wr * 64 + fr, d = wc * 32 + 8 * fq, h = u.pn;
#pragma unroll
        for (int ai = 0; ai < 2; ++ai)
#pragma unroll
            for (int m = 0; m < 4; ++m) { const int row = row0 + ai * HALF + m * 16; const f32x4 sv = *(const f32x4*)(ssq + (size_t)row * 8 + 4);
                const float rs = rsqrtf(((sv[0] + sv[1]) + (sv[2] + sv[3])) * (1.f / KVL) + EPS); const int b = row / SEQ, s = row % SEQ; const size_t t = (size_t)(b * NH + h) * SEQ + s;
                *(u32x4*)(Kc + t * DQK + d) = pack8(acc[ai][0][m][0] * rs, acc[ai][0][m][1] * rs);
                *(u32x4*)(Vc + t * DV + d) = pack8(acc[ai][1][m][0] * rs, acc[ai][1][m][1] * rs); }
    }
};
struct EpiWo {
    static constexpr bool PERM = true; static constexpr int MIDK = 8;
    const bf16_t* x; bf16_t* HBF; unsigned char* X8; const float* assq; float* ssq1; const float* gmoe;
    __device__ __forceinline__ void mid(Acc& acc, const Unit& u, int wr, int wc, int fr, int fq) const {
        const int row0 = u.pm * BM + wr * 64 + fr;
#pragma unroll
        for (int ai = 0; ai < 2; ++ai)
#pragma unroll
            for (int m = 0; m < 4; ++m) { const f32x4 sv = *(const f32x4*)(assq + (size_t)(row0 + ai * HALF + m * 16) * 4);
                const float rs = rsqrtf(((sv[0] + sv[1]) + (sv[2] + sv[3])) * (1.f / 512.f) + EPS);
#pragma unroll
                for (int bj = 0; bj < 2; ++bj)
#pragma unroll
                    for (int n = 0; n < 2; ++n) acc[ai][bj][m][n] = acc[ai][bj][m][n] * rs; }
    }
    __device__ __forceinline__ void operator()(const Acc& acc, const Unit& u, int wr, int wc, int fr, int fq) const {
        const int row0 = u.pm * BM + wr * 64 + fr, col0 = u.pn * BM + wc * 32 + 8 * fq;
        f32x4 gn[2][2];
#pragma unroll
        for (int bj = 0; bj < 2; ++bj) { gn[bj][0] = *(const f32x4*)(gmoe + col0 + bj * HALF); gn[bj][1] = *(const f32x4*)(gmoe + col0 + bj * HALF + 4); }
#pragma unroll
        for (int ai = 0; ai < 2; ++ai) { u32x4 xv[4][2];
#pragma unroll
            for (int m = 0; m < 4; ++m) { const size_t off = (size_t)(row0 + ai * HALF + m * 16) * DM + col0;
#pragma unroll
                for (int bj = 0; bj < 2; ++bj) xv[m][bj] = *(const u32x4*)(x + off + bj * HALF); }
            asm volatile("" ::: "memory");
#pragma unroll
            for (int m = 0; m < 4; ++m) { const int row = row0 + ai * HALF + m * 16; const size_t off = (size_t)row * DM + col0; float ss = 0.f;
#pragma unroll
                for (int bj = 0; bj < 2; ++bj) { const u32x4 xq = xv[m][bj]; const f32x4 h0 = (f32x4){blo(xq.x), bhi(xq.x), blo(xq.y), bhi(xq.y)} + acc[ai][bj][m][0], h1 = (f32x4){blo(xq.z), bhi(xq.z), blo(xq.w), bhi(xq.w)} + acc[ai][bj][m][1];
                    *(u32x4*)(HBF + off + bj * HALF) = pack8(h0, h1); *(u32x2*)(X8 + off + bj * HALF) = (u32x2){pk4_fp8(h0 * gn[bj][0]), pk4_fp8(h1 * gn[bj][1])}; ss += sq4(h0) + sq4(h1); }
                ss = red_fq(ss); if (fq == 0) ssq1[(size_t)row * 16 + u.pn * 4 + wc] = ss; }
            asm volatile("" ::: "memory"); }
    }
};
__device__ __forceinline__ f32x4 sigmoid4(f32x4 a) { const f32x4 t = a * -1.44269504f; f32x4 e; e[0] = __builtin_amdgcn_exp2f(t[0]); e[1] = __builtin_amdgcn_exp2f(t[1]); e[2] = __builtin_amdgcn_exp2f(t[2]); e[3] = __builtin_amdgcn_exp2f(t[3]);
    const f32x4 d = e + 1.0f; f32x4 r; r[0] = __builtin_amdgcn_rcpf(d[0]); r[1] = __builtin_amdgcn_rcpf(d[1]); r[2] = __builtin_amdgcn_rcpf(d[2]); r[3] = __builtin_amdgcn_rcpf(d[3]); return r; }
__device__ __forceinline__ f32x2 swiglu2(f32x2 g, f32x2 u) {
    g.x = fminf(g.x, 7.f); g.y = fminf(g.y, 7.f); u.x = __builtin_amdgcn_fmed3f(u.x, -7.f, 7.f); u.y = __builtin_amdgcn_fmed3f(u.y, -7.f, 7.f);
    const f32x2 t = g * -2.45546696f; f32x2 e; e.x = __builtin_amdgcn_exp2f(t.x); e.y = __builtin_amdgcn_exp2f(t.y); const f32x2 d = e + 1.0f; f32x2 r; r.x = __builtin_amdgcn_rcpf(d.x); r.y = __builtin_amdgcn_rcpf(d.y);
    const f32x2 gs = g * r; return u * gs + gs; }
__device__ __forceinline__ float swiglu_f(float g, float u) { g = fminf(g, 7.f); u = __builtin_amdgcn_fmed3f(u, -7.f, 7.f); const float gs = g * __builtin_amdgcn_rcpf(1.f + __builtin_amdgcn_exp2f(g * -2.45546696f)); return fmaf(u, gs, gs); }
constexpr float WSCALE = 64.f, WINV = 1.f / 64.f;
struct EpiMoe1 {
    static constexpr bool PERM = true; static constexpr int MIDK = 0;
    unsigned char* HB; const float* b1; const float* rowrs;
    __device__ __forceinline__ void operator()(const Acc& acc, const Unit& u, int wr, int wc, int fr, int fq) const {
        const int row0 = u.pm * BM + wr * 64 + fr, j0 = u.pn * HALF + wc * 32 + 8 * fq; const float* bg = b1 + (size_t)u.e * 2048 + j0;
        const f32x4 g0 = *(const f32x4*)bg, g1 = *(const f32x4*)(bg + 4), u0 = *(const f32x4*)(bg + 1024), u1 = *(const f32x4*)(bg + 1028);
        float rsv[2][4];
#pragma unroll
        for (int ai = 0; ai < 2; ++ai)
#pragma unroll
            for (int m = 0; m < 4; ++m) rsv[ai][m] = rowrs[row0 + ai * HALF + m * 16];
        asm volatile("" ::: "memory");
#pragma unroll
        for (int ai = 0; ai < 2; ++ai)
#pragma unroll
            for (int m = 0; m < 4; ++m) { const float rs = rsv[ai][m] * WINV;
                const f32x4 a0 = acc[ai][0][m][0] * rs + g0, a1 = acc[ai][0][m][1] * rs + g1, c0 = acc[ai][1][m][0] * rs + u0, c1 = acc[ai][1][m][1] * rs + u1; f32x4 r0, r1;
#pragma unroll
                for (int j = 0; j < 4; j += 2) { const f32x2 s0 = swiglu2((f32x2){a0[j], a0[j + 1]}, (f32x2){c0[j], c0[j + 1]}), s1 = swiglu2((f32x2){a1[j], a1[j + 1]}, (f32x2){c1[j], c1[j + 1]}); r0[j] = s0.x; r0[j + 1] = s0.y; r1[j] = s1.x; r1[j + 1] = s1.y; }
                *(u32x2*)(HB + (size_t)(row0 + ai * HALF + m * 16) * DE + j0) = (u32x2){pk4_fp8(r0), pk4_fp8(r1)}; }
    }
};
struct EpiMoe2 {
    static constexpr bool PERM = true; static constexpr int MIDK = 0;
    unsigned char* Y; const float* b2; const int* rowslot; const float* rowgate;
    __device__ __forceinline__ void operator()(const Acc& acc, const Unit& u, int wr, int wc, int fr, int fq) const {
        const int row0 = u.pm * BM + wr * 64 + fr, col0 = u.pn * BM + wc * 64 + 16 * fq; const float* bb = b2 + (size_t)u.e * DM + col0;
        f32x4 bv[2][2];
#pragma unroll
        for (int bj = 0; bj < 2; ++bj)
#pragma unroll
            for (int n = 0; n < 2; ++n) bv[bj][n] = *(const f32x4*)(bb + bj * 8 + 4 * n);
        float gtv[2][4]; int slv[2][4];
#pragma unroll
        for (int ai = 0; ai < 2; ++ai)
#pragma unroll
            for (int m = 0; m < 4; ++m) { const int r = row0 + ai * HALF + m * 16; gtv[ai][m] = rowgate[r]; slv[ai][m] = rowslot[r]; }
        asm volatile("" ::: "memory");
#pragma unroll
        for (int ai = 0; ai < 2; ++ai)
#pragma unroll
            for (int m = 0; m < 4; ++m) { const float gt = gtv[ai][m]; unsigned char* yp = Y + (size_t)slv[ai][m] * DM + col0;
                *(u32x4*)yp = (u32x4){pk4_fp8((acc[ai][0][m][0] * WINV + bv[0][0]) * gt), pk4_fp8((acc[ai][0][m][1] * WINV + bv[0][1]) * gt), pk4_fp8((acc[ai][1][m][0] * WINV + bv[1][0]) * gt), pk4_fp8((acc[ai][1][m][1] * WINV + bv[1][1]) * gt)}; }
    }
};
struct EpiPle {
    static constexpr bool PERM = true; static constexpr int MIDK = 0;
    const bf16_t* H2; bf16_t* H3; const bf16_t* pler; const float* rpv; const float* rs2; const float* pg; float* fssq;
    __device__ __forceinline__ void operator()(const Acc& acc, const Unit& u, int wr, int wc, int fr, int fq) const {
        const int row0 = u.pm * BM + wr * 64 + fr, col0 = u.pn * BM + wc * 32 + 8 * fq;
        f32x4 gv[2][2];
#pragma unroll
        for (int bj = 0; bj < 2; ++bj)
#pragma unroll
            for (int n = 0; n < 2; ++n) gv[bj][n] = *(const f32x4*)(pg + col0 + bj * HALF + n * 4);
#pragma unroll
        for (int am = 0; am < 4; ++am) { const int ai = am >> 1; u32x4 hq[2][2], pq[2][2]; float r2v[2], rpq[2];
#pragma unroll
            for (int mm = 0; mm < 2; ++mm) { const int row = row0 + ai * HALF + ((am & 1) * 2 + mm) * 16; const size_t off = (size_t)row * DM + col0; r2v[mm] = rs2[row]; rpq[mm] = rpv[row];
#pragma unroll
                for (int bj = 0; bj < 2; ++bj) { hq[mm][bj] = *(const u32x4*)(H2 + off + bj * HALF); pq[mm][bj] = *(const u32x4*)(pler + off + bj * HALF); } }
            asm volatile("" ::: "memory");
#pragma unroll
            for (int mm = 0; mm < 2; ++mm) { const int m = (am & 1) * 2 + mm; const int row = row0 + ai * HALF + m * 16; const size_t off = (size_t)row * DM + col0; const float r2 = r2v[mm], rp = rpq[mm]; float ss = 0.f;
#pragma unroll
                for (int bj = 0; bj < 2; ++bj) { const size_t o = off + bj * HALF; const u32x4 hv = hq[mm][bj], pr = pq[mm][bj];
                    const f32x4 h0 = {blo(hv.x), bhi(hv.x), blo(hv.y), bhi(hv.y)}, h1 = {blo(hv.z), bhi(hv.z), blo(hv.w), bhi(hv.w)};
                    const f32x4 q0 = {blo(pr.x), bhi(pr.x), blo(pr.y), bhi(pr.y)}, q1 = {blo(pr.z), bhi(pr.z), blo(pr.w), bhi(pr.w)};
                    const f32x4 r0 = h0 + sigmoid4(acc[ai][bj][m][0] * r2) * (q0 * (gv[bj][0] * rp)), r1 = h1 + sigmoid4(acc[ai][bj][m][1] * r2) * (q1 * (gv[bj][1] * rp));
                    *(u32x4*)(H3 + o) = pack8(r0, r1); ss += sq4(r0) + sq4(r1); }
                ss = red_fq(ss); if (fq == 0) fssq[(size_t)row * 16 + u.pn * 4 + wc] = ss; }
            asm volatile("" ::: "memory"); }
    }
};
}

namespace att {
typedef float f32x16 __attribute__((ext_vector_type(16)));
typedef short s16x4 __attribute__((ext_vector_type(4)));
constexpr int QBLK = 32, KVBLK = 64, QB = 256;
constexpr int SHM_K = KVBLK * DQK * 2, SHM_V = KVBLK * DV * 2;
constexpr int L_V = 0, L_K = 2 * SHM_V, L_WS = L_K + 2 * SHM_K, L_END = L_WS + NWAVES * 256;
constexpr float THR = 8.f;
#define KSWZ(row, colB) ((row) * 384 + ((colB) ^ (((row) & 7) << 4)))
#define SBAR() __builtin_amdgcn_sched_barrier(0)
__device__ __forceinline__ int v_st(int k, int c) { const int kk = (k & ~0xC) | ((k & 4) << 1) | ((k & 8) >> 1); return ((kk >> 3) * 4 + (c >> 5)) * 512 + ((kk & 7) * 32 + (c & 31)) * 2; }
__device__ __forceinline__ int v_rd_base(int lane) { return ((lane & 3) << 3) | (((lane >> 2) & 3) << 6) | (((lane >> 4) & 1) << 5) | (((lane >> 5) & 1) << 8); }
constexpr int v_rd_off(int d0, int ks, int half) { return d0 * 512 + ks * 4096 + half * 2048; }
__device__ __forceinline__ int crow(int r, int hi) { return (r & 3) + 8 * (r >> 2) + 4 * hi; }
typedef __bf16 bf16x2_t __attribute__((ext_vector_type(2)));
__device__ __forceinline__ unsigned cvtpk(float lo, float hi) { f32x2 v = {lo, hi}; bf16x2_t b = __builtin_convertvector(v, bf16x2_t); return __builtin_bit_cast(unsigned, b); }

__device__ __forceinline__ void qkt(f32x16& p0, f32x16& p1, const LAS unsigned char* Kbuf, int r32, int hi, const bf16x8* qr) {
    p0 = f32x16{}; p1 = f32x16{};
    const LAS unsigned char* kb[4];
#pragma unroll
    for (int dd = 0; dd < 4; ++dd) kb[dd] = Kbuf + KSWZ(r32, (dd * 16 + hi * 8) * 2);
#pragma unroll
    for (int d0 = 0; d0 < 12; ++d0) { const LAS unsigned char* a = kb[d0 & 3] + (d0 >> 2) * 128;
        const bf16x8 b0 = *(const LAS bf16x8*)a; const bf16x8 b1 = *(const LAS bf16x8*)(a + 32 * 384);
        p0 = __builtin_amdgcn_mfma_f32_32x32x16_bf16(b0, qr[d0], p0, 0, 0, 0);
        p1 = __builtin_amdgcn_mfma_f32_32x32x16_bf16(b1, qr[d0], p1, 0, 0, 0); }
}
template <int VB>
__device__ __forceinline__ void pv_tile(f32x16* o, int vb0, bf16x8 pa0, bf16x8 pa1, bf16x8 pa2, bf16x8 pa3) {
#define TRRD(dst, off) asm volatile("ds_read_b64_tr_b16 %0, %1 offset:%2" : "=&v"(dst) : "v"(vb0), "i"(off) : "memory")
#define PV_D0(d0) do { s16x4 l0, l1, l2, l3, h0, h1, h2, h3; constexpr int b_ = VB * SHM_V + v_rd_off(d0, 0, 0); \
        TRRD(l0, b_); TRRD(h0, b_ + 2048); TRRD(l1, b_ + 4096); TRRD(h1, b_ + 6144); TRRD(l2, b_ + 8192); TRRD(h2, b_ + 10240); TRRD(l3, b_ + 12288); TRRD(h3, b_ + 14336); \
        asm volatile("s_waitcnt lgkmcnt(0)" ::: "memory"); SBAR(); \
        o[d0] = __builtin_amdgcn_mfma_f32_32x32x16_bf16(pa0, (bf16x8){l0[0], l0[1], l0[2], l0[3], h0[0], h0[1], h0[2], h0[3]}, o[d0], 0, 0, 0); \
        o[d0] = __builtin_amdgcn_mfma_f32_32x32x16_bf16(pa1, (bf16x8){l1[0], l1[1], l1[2], l1[3], h1[0], h1[1], h1[2], h1[3]}, o[d0], 0, 0, 0); \
        o[d0] = __builtin_amdgcn_mfma_f32_32x32x16_bf16(pa2, (bf16x8){l2[0], l2[1], l2[2], l2[3], h2[0], h2[1], h2[2], h2[3]}, o[d0], 0, 0, 0); \
        o[d0] = __builtin_amdgcn_mfma_f32_32x32x16_bf16(pa3, (bf16x8){l3[0], l3[1], l3[2], l3[3], h3[0], h3[1], h3[2], h3[3]}, o[d0], 0, 0, 0); } while (0)
    PV_D0(0); PV_D0(1); PV_D0(2); PV_D0(3);
#undef PV_D0
#undef TRRD
}
struct ConvJob { const float* w1; const float* w2; const float* gain; unsigned char* W1T; unsigned char* W2T; int gw, ngw; };
constexpr int CV_N1 = NE * 32 * 64, CV_N2 = NE * 32 * 32, CV_TOTAL = CV_N1 + CV_N2;
__device__ __forceinline__ int cv_cmap2(int n) { const int t = n & ~255, v = n & 255; return t + 64 * ((v >> 5) & 3) + 16 * ((v >> 3) & 3) + 8 * (v >> 7) + (v & 7); }
__device__ __forceinline__ int cv_cmap1(int n) { const int pn = n >> 8, half = (n >> 7) & 1, jj = n & 127; return half * 1024 + pn * 128 + jj; }
#define CV_DECODE(idx) \
    const bool cv_on = (idx) < CV_TOTAL; const bool cv_is1 = (idx) < CV_N1; const int cv_r = cv_is1 ? (idx) : (idx) - CV_N1; \
    const int cv_nblk = cv_is1 ? 64 : 32, cv_ld = cv_is1 ? 2048 : 1024; const int cv_e = cv_r / (32 * cv_nblk), cv_q = cv_r % (32 * cv_nblk), cv_k0 = 32 * (cv_q / cv_nblk), cv_n0 = 32 * (cv_q % cv_nblk); \
    const float* cv_src = (cv_is1 ? cj.w1 + (size_t)cv_e * 1024 * 2048 : cj.w2 + (size_t)cv_e * 1024 * 1024); \
    const int cv_c = cv_is1 ? cv_cmap1(cv_n0 + (lane & 31)) : cv_cmap2(cv_n0 + (lane & 31));
#define CV_LOAD() do { if (cv_on) { _Pragma("unroll") for (int i = 0; i < 16; ++i) cvw[i] = cv_src[(size_t)(cv_k0 + 2 * i + hi) * cv_ld + cv_c]; } } while (0)
#define CV_STORE() do { if (cv_on) { LAS float* scr = (LAS float*)(lds + L_END) + wid * (32 * 33); \
        _Pragma("unroll") for (int i = 0; i < 16; ++i) { const int kk = 2 * i + hi; scr[kk * 33 + (lane & 31)] = cvw[i] * 64.f; } \
        asm volatile("s_waitcnt lgkmcnt(0)" ::: "memory"); \
        { const int n = lane >> 1, cc = lane & 1; const LAS float* s = scr + (16 * cc) * 33 + n; u32x4 o; \
          o.x = pg8::pk4_fp8((f32x4){s[0 * 33], s[1 * 33], s[2 * 33], s[3 * 33]}); o.y = pg8::pk4_fp8((f32x4){s[4 * 33], s[5 * 33], s[6 * 33], s[7 * 33]}); \
          o.z = pg8::pk4_fp8((f32x4){s[8 * 33], s[9 * 33], s[10 * 33], s[11 * 33]}); o.w = pg8::pk4_fp8((f32x4){s[12 * 33], s[13 * 33], s[14 * 33], s[15 * 33]}); \
          unsigned char* dst = (cv_is1 ? cj.W1T + (size_t)cv_e * 2048 * 1024 : cj.W2T + (size_t)cv_e * 1024 * 1024) + (size_t)(cv_n0 + n) * 1024 + cv_k0 + 16 * cc; *(u32x4*)dst = o; } \
        asm volatile("s_waitcnt lgkmcnt(0)" ::: "memory"); } } while (0)
__device__ __forceinline__ void attn_block(int bh, int qb, const bf16_t* __restrict__ Q, const bf16_t* __restrict__ K, const bf16_t* __restrict__ V, bf16_t* __restrict__ MIX, float* __restrict__ ASSQ, LAS unsigned char* lds, const int wid, const ConvJob& cj, int& tseq) {
    const int lane = lane_id(), r32 = lane & 31, hi = lane >> 5;
    const int b = bh / NH, h = bh % NH;
    const bf16_t* Qw = Q + ((size_t)bh * SEQ + qb * QB + wid * QBLK + r32) * DQK;
    const bf16_t* Kh = K + (size_t)bh * SEQ * DQK; const bf16_t* Vh = V + (size_t)bh * SEQ * DV;
    bf16x8 qr[12];
#pragma unroll
    for (int d0 = 0; d0 < 12; ++d0) qr[d0] = *(const bf16x8*)(Qw + d0 * 16 + hi * 8);
    const int NT = 4 * qb + 4, qlo = qb * QB + wid * QBLK, qm = qlo + r32 - 4 * hi;
    LAS unsigned char* V_lds = lds + L_V; LAS unsigned char* K_lds = lds + L_K;
    LAS float* wsf = (LAS float*)(lds + L_WS) + wid * 64; LAS float* li_l = wsf; LAS float* al_l = wsf + 32;
    unsigned ksrc[3], vsrc[2];
#pragma unroll
    for (int i = 0; i < 3; ++i) { const int off = ((wid + 8 * i) * 64 + lane) * 16, row = off / 384, wb = off % 384, seg = wb >> 7, cpos = (wb & 127) >> 4; ksrc[i] = (unsigned)(row * 384 + seg * 128 + ((cpos ^ (row & 7)) << 4)); }
#pragma unroll
    for (int i = 0; i < 2; ++i) { const int off = ((wid + 8 * i) * 64 + lane) * 16, st = off >> 9, o_ = off & 511, kk = (st >> 2) * 8 + (o_ >> 6), c = (st & 3) * 32 + ((o_ & 63) >> 1);
        const int k = (kk & ~0xC) | ((kk & 4) << 1) | ((kk & 8) >> 1); vsrc[i] = (unsigned)(k * 256 + c * 2); }
    const int vb0 = (int)(unsigned)(uintptr_t)V_lds + v_rd_base(lane);
#define ADMA(t, bf) do { const char* kp = (const char*)(Kh + (size_t)(t) * KVBLK * DQK); const char* vp = (const char*)(Vh + (size_t)(t) * KVBLK * DV); \
        _Pragma("unroll") for (int i = 0; i < 3; ++i) __builtin_amdgcn_global_load_lds((const unsigned*)(kp + ksrc[i]), (LAS unsigned*)(K_lds + (bf) * SHM_K + (wid + 8 * i) * 1024), 16, 0, 0); \
        _Pragma("unroll") for (int i = 0; i < 2; ++i) __builtin_amdgcn_global_load_lds((const unsigned*)(vp + vsrc[i]), (LAS unsigned*)(V_lds + (bf) * SHM_V + (wid + 8 * i) * 1024), 16, 0, 0); } while (0)
    float m_reg = -1e30f, l_reg = 0.f; f32x16 o[4] = {}; float cvw[16]; int cv_pend = -1;
    ADMA(0, 0);
#define TILE(t, BF) do { \
        asm volatile("s_waitcnt vmcnt(0)" ::: "memory"); __syncthreads(); \
        if ((t) + 1 < NT) ADMA((t) + 1, (BF) ^ 1); \
        if (cv_pend >= 0) { CV_DECODE(cv_pend) CV_STORE(); }     \
        { const int cv_idx = tseq * cj.ngw + cj.gw; ++tseq; CV_DECODE(cv_idx) CV_LOAD(); cv_pend = cv_on ? cv_idx : -1; } SBAR(); \
        const int kb_ = (t) * KVBLK; \
        if (kb_ <= qlo + QBLK - 1) { \
            f32x16 p0, p1; SBAR(); qkt(p0, p1, K_lds + (BF) * SHM_K, r32, hi, qr); \
            if (kb_ + KVBLK - 1 > qlo) { const int dq = qm - kb_; const float NEG = -__builtin_inff(); \
                _Pragma("unroll") for (int r = 0; r < 16; ++r) { const int c = (r & 3) + 8 * (r >> 2); if (c > dq) p0[r] = NEG; if (c + 32 > dq) p1[r] = NEG; } } \
            float pmax = p0[0]; _Pragma("unroll") for (int r = 1; r < 16; ++r) pmax = fmaxf(pmax, p0[r]); _Pragma("unroll") for (int r = 0; r < 16; ++r) pmax = fmaxf(pmax, p1[r]); \
            { auto rr = __builtin_amdgcn_permlane32_swap(__float_as_uint(pmax), __float_as_uint(pmax), false, false); pmax = fmaxf(__uint_as_float(rr[0]), __uint_as_float(rr[1])); } \
            if (!__all(pmax - m_reg <= THR)) { const float mn = fmaxf(m_reg, pmax); const float alpha = __builtin_amdgcn_exp2f(m_reg - mn); m_reg = mn; l_reg *= alpha; \
                if (hi == 0) al_l[r32] = alpha; asm volatile("s_waitcnt lgkmcnt(0)" ::: "memory"); \
                _Pragma("unroll") for (int d_ = 0; d_ < 4; ++d_) _Pragma("unroll") for (int r = 0; r < 16; ++r) o[d_][r] *= al_l[crow(r, hi)]; } \
            float ps = 0.f; \
            _Pragma("unroll") for (int r = 0; r < 16; ++r) { p0[r] = __builtin_amdgcn_exp2f(p0[r] - m_reg); p1[r] = __builtin_amdgcn_exp2f(p1[r] - m_reg); } \
            _Pragma("unroll") for (int r = 0; r < 16; ++r) ps += p0[r] + p1[r]; \
            { auto rr = __builtin_amdgcn_permlane32_swap(__float_as_uint(ps), __float_as_uint(ps), false, false); ps = __uint_as_float(rr[0]) + __uint_as_float(rr[1]); } \
            l_reg += ps; \
            bf16x8 pa0, pa1, pa2, pa3; \
            PK4(p0, 0, pa0); PK4(p0, 8, pa1); PK4(p1, 0, pa2); PK4(p1, 8, pa3); \
            SBAR(); pv_tile<BF>(o, vb0, pa0, pa1, pa2, pa3); } \
        } while (0)
#define PK4(P, B_, OUT) do { unsigned a0 = cvtpk(P[B_ + 0], P[B_ + 1]), a1 = cvtpk(P[B_ + 2], P[B_ + 3]); \
        unsigned b0 = cvtpk(P[B_ + 4], P[B_ + 5]), b1 = cvtpk(P[B_ + 6], P[B_ + 7]); \
        auto r0 = __builtin_amdgcn_permlane32_swap(a0, b0, false, false); auto r1 = __builtin_amdgcn_permlane32_swap(a1, b1, false, false); \
        u32x4 w = {r0[0], r1[0], r0[1], r1[1]}; OUT = __builtin_bit_cast(bf16x8, w); } while (0)
    for (int t = 0; t < NT; t += 2) { TILE(t, 0); TILE(t + 1, 1); }
#undef PK4
#undef TILE
#undef ADMA
    if (cv_pend >= 0) { asm volatile("s_waitcnt vmcnt(0)" ::: "memory"); CV_DECODE(cv_pend) CV_STORE(); }
    if (hi == 0) li_l[r32] = l_reg;
    asm volatile("s_waitcnt vmcnt(0) lgkmcnt(0)" ::: "memory");
    float rli[16];
#pragma unroll
    for (int r = 0; r < 16; ++r) rli[r] = __builtin_amdgcn_rcpf(li_l[crow(r, hi)]);
    __syncthreads();
    LAS bf16_t* stg = (LAS bf16_t*)(lds + wid * 8192);
#pragma unroll
    for (int r = 0; r < 16; ++r) { const int orow = crow(r, hi);
#pragma unroll
        for (int d0 = 0; d0 < 4; ++d0) stg[orow * 128 + d0 * 32 + r32] = f2bf(o[d0][r] * rli[r]); }
    asm volatile("s_waitcnt lgkmcnt(0)" ::: "memory");
    const size_t row0 = (size_t)b * SEQ + qb * QB + wid * QBLK;
#pragma unroll
    for (int i = 0; i < 8; ++i) { const int row = i * 4 + (lane >> 4), ch = lane & 15; const u32x4 v = *(const LAS u32x4*)(stg + row * 128 + ch * 8);
        float ss = (blo(v.x) * blo(v.x) + bhi(v.x) * bhi(v.x)) + (blo(v.y) * blo(v.y) + bhi(v.y) * bhi(v.y)) + (blo(v.z) * blo(v.z) + bhi(v.z) * bhi(v.z)) + (blo(v.w) * blo(v.w) + bhi(v.w) * bhi(v.w));
        ss += __shfl_xor(ss, 1); ss += __shfl_xor(ss, 2); ss += __shfl_xor(ss, 4); ss += __shfl_xor(ss, 8);
        *(u32x4*)(MIX + (row0 + row) * DM + h * DV + ch * 8) = v;
        if (ch == 0) ASSQ[(row0 + row) * 4 + h] = ss; }
    __syncthreads();
}
#undef KSWZ
#undef SBAR
}

struct Args { const void* in[25]; float* out; unsigned char* ws; int ph_lo, ph_hi, li, skip; };
enum { PH_PREP = 0, PH_INPROJ, PH_TOKLOCAL, PH_ATTN, PH_WO, PH_ROUTER, PH_ROUTE, PH_MOE1, PH_MOE2, PH_COMBINE, PH_PLE, PH_FINAL, PH_COUNT };

template <int MODE> __device__ __forceinline__ int cmap_col(int n) {
    if (MODE == 1) { const int pn = n >> 8, half = (n >> 7) & 1, jj = n & 127; return half * 1024 + pn * 128 + jj; }
    if (MODE == 2) { const int h = n / DQK, d = n % DQK; if (d < DN) return n; const int t = d - DN; return h * DQK + DN + (t & 1) * 32 + (t >> 1); }
    return n;
}
template <int MODE> __device__ __forceinline__ void transpose_item_fp8(const float* __restrict__ W, int ldsrc, int nblk, unsigned char* __restrict__ WT, int ldd, const float* __restrict__ gain, float scale,
                                                                      LAS float* scr, int item, int lane) {
    const int kb = item / nblk, nb = item % nblk, k0 = 64 * kb, n0 = 32 * nb; const int c = cmap_col<MODE>(n0 + (lane & 31));
    float wv[32];
#pragma unroll
    for (int i = 0; i < 32; ++i) wv[i] = W[(size_t)(k0 + 2 * i + (lane >> 5)) * ldsrc + c];
#pragma unroll
    for (int i = 0; i < 32; ++i) { const int kk = 2 * i + (lane >> 5), k = k0 + kk; float gk = scale; if (gain) gk *= gain[k]; scr[kk * 33 + (lane & 31)] = wv[i] * gk; }
    asm volatile("s_waitcnt lgkmcnt(0)" ::: "memory");
    const int cc = lane & 3;
#pragma unroll
    for (int j = 0; j < 2; ++j) { const int n = (lane >> 2) + 16 * j; const LAS float* s = scr + (16 * cc) * 33 + n; u32x4 o;
        o.x = pg8::pk4_fp8((f32x4){s[0 * 33], s[1 * 33], s[2 * 33], s[3 * 33]}); o.y = pg8::pk4_fp8((f32x4){s[4 * 33], s[5 * 33], s[6 * 33], s[7 * 33]});
        o.z = pg8::pk4_fp8((f32x4){s[8 * 33], s[9 * 33], s[10 * 33], s[11 * 33]}); o.w = pg8::pk4_fp8((f32x4){s[12 * 33], s[13 * 33], s[14 * 33], s[15 * 33]});
        *(u32x4*)(WT + (size_t)(n0 + n) * ldd + k0 + 16 * cc) = o; }
    asm volatile("s_waitcnt lgkmcnt(0)" ::: "memory");
}
template <int MODE> __device__ __forceinline__ void transpose_item(const float* __restrict__ W, int ldsrc, int nblk, bf16_t* __restrict__ WT, int ldd, const float* __restrict__ gain, const float* __restrict__ gain2, float scale,
                                                                  LAS float* scr, int item, int lane) {
    const int kb = item / nblk, nb = item % nblk, k0 = 64 * kb, n0 = 32 * nb; const int c = cmap_col<MODE>(n0 + (lane & 31));
    float wv[32], gq[32];
#pragma unroll
    for (int i = 0; i < 32; ++i) wv[i] = W[(size_t)(k0 + 2 * i + (lane >> 5)) * ldsrc + c];
#pragma unroll
    for (int i = 0; i < 32; ++i) { const int k = k0 + 2 * i + (lane >> 5); gq[i] = gain ? ((gain2 && k >= 512) ? gain2[k - 512] : gain[k]) : 1.f; }
    asm volatile("" ::: "memory");
#pragma unroll
    for (int i = 0; i < 32; ++i) { const int kk = 2 * i + (lane >> 5); scr[kk * 33 + (lane & 31)] = wv[i] * (gq[i] * scale); }
    asm volatile("s_waitcnt lgkmcnt(0)" ::: "memory");
    const int cc = lane & 7;
#pragma unroll
    for (int j = 0; j < 4; ++j) { const int n = (lane >> 3) + 8 * j; const LAS float* s = scr + (8 * cc) * 33 + n;
        u32x4 o; o.x = pk2(s[0 * 33], s[1 * 33]); o.y = pk2(s[2 * 33], s[3 * 33]); o.z = pk2(s[4 * 33], s[5 * 33]); o.w = pk2(s[6 * 33], s[7 * 33]);
        *(u32x4*)(WT + (size_t)(n0 + n) * ldd + k0 + 8 * cc) = o; }
    asm volatile("s_waitcnt lgkmcnt(0)" ::: "memory");
}

__global__ void __launch_bounds__(NTHREADS, 2) fwd(Args args) {
    extern __shared__ __attribute__((aligned(16))) unsigned char lds_raw[];
    LAS unsigned char* lds = (LAS unsigned char*)lds_raw;
    volatile LAS unsigned* MISC = (volatile LAS unsigned*)(lds + MISC_OFF);
    const int wave = __builtin_amdgcn_readfirstlane(threadIdx.x >> 6);
    const int G = gridDim.x, bx = blockIdx.x;
#define PHASE_LANE const int lane = lane_id(); const int tid = wave * 64 + lane; (void)tid
    const int gw = bx * NWAVES + wave, NGW = G * NWAVES;
    unsigned char* ws = args.ws; int* ctl = (int*)(ws + WS_CTL); float* H = args.out;
    const float* x = (const float*)args.in[0]; const float* p = (const float*)args.in[1]; const int* pos = (const int*)args.in[2];
    const float *mix_norm = (const float*)args.in[3], *w_in = (const float*)args.in[4], *q_norm = (const float*)args.in[5], *w_uq = (const float*)args.in[6], *kv_norm = (const float*)args.in[7],
                *w_ukv = (const float*)args.in[8], *attn_out_norm = (const float*)args.in[10], *conv_out_norm = (const float*)args.in[11], *w_o = (const float*)args.in[12],
                *moe_norm = (const float*)args.in[13], *w_router = (const float*)args.in[14], *w1 = (const float*)args.in[16], *b1 = (const float*)args.in[17],
                *w2 = (const float*)args.in[18], *b2 = (const float*)args.in[19], *ple_norm = (const float*)args.in[20], *w_ple_gate = (const float*)args.in[21], *w_ple_proj = (const float*)args.in[22],
                *ple_post_norm = (const float*)args.in[23], *conv_w = (const float*)args.in[9], *b_router = (const float*)args.in[15], *final_norm = (const float*)args.in[24];
    int* TOPI = (int*)(ws + WS_TOPI); float* TOPG = (float*)(ws + WS_TOPG);
    bf16_t *HBF = (bf16_t*)(ws + WS_HBF), *H3 = (bf16_t*)(ws + WS_H3), *WRHL = (bf16_t*)(ws + WS_WRHL); unsigned char* X8 = (unsigned char*)(ws + WS_K);
    float* RSX = (float*)(ws + WS_RSX);
    float *SSQ1 = (float*)(ws + WS_SSQ1), *RS1 = (float*)(ws + WS_RS1), *RS2 = (float*)(ws + WS_RS2), *ROWRS = (float*)(ws + WS_ROWRS);
    bf16_t *WIN = (bf16_t*)(ws + WS_WIN), *WUQ = (bf16_t*)(ws + WS_WUQ), *WUKV = (bf16_t*)(ws + WS_WUKV), *WO = (bf16_t*)(ws + WS_WO), *WG = (bf16_t*)(ws + WS_WG), *WP = (bf16_t*)(ws + WS_WP);
    bf16_t *W1T = (bf16_t*)(ws + WS_W1), *W2T = (bf16_t*)(ws + WS_W2), *XN = (bf16_t*)(ws + WS_XN), *MIX = (bf16_t*)(ws + WS_MIX), *PLER = (bf16_t*)(ws + WS_PLER);
    bf16_t *Z = (bf16_t*)(ws + WS_Z), *Qb = (bf16_t*)(ws + WS_Q), *Kb = (bf16_t*)(ws + WS_K), *Vb = (bf16_t*)(ws + WS_V), *HB = (bf16_t*)(ws + WS_HB), *Y = (bf16_t*)(ws + WS_Y), *P16 = (bf16_t*)(ws + WS_P16);
    float *WR = (float*)(ws + WS_WR), *CS = (float*)(ws + WS_CS), *SSQ = (float*)(ws + WS_SSQ), *ASSQ = (float*)(ws + WS_ASSQ), *PSSQ = (float*)(ws + WS_PSSQ), *FSSQ = (float*)(ws + WS_FSSQ);
    int *ROWTOK = (int*)(ws + WS_ROWTOK), *ROWSLOT = (int*)(ws + WS_ROWSLOT); float* ROWGATE = (float*)(ws + WS_ROWGATE);

    { PHASE_LANE; for (int u = tid; u < (LDS_BYTES - MISC_OFF) / 4; u += NTHREADS) ((LAS unsigned*)(lds + MISC_OFF))[u] = 0u; }
    __syncthreads();
    const int lo = args.ph_lo, hi = args.ph_hi;
    XcdBarrier bar; bar.bar = (unsigned*)ctl + CW_BAR + args.li * XCD_BAR_WORDS; bar.x = 0; bar.st = MISC + 8;
    if (hi - lo > 1) bar = xcd_barrier_post((unsigned*)ctl + CW_BAR + args.li * XCD_BAR_WORDS, MISC + 8, wave);
#define IN(k) (lo <= (k) && (k) < hi)
#define NREP(k) ((PROBE_PH == (k)) ? PROBE_REP : 1)
#define REPLOOP(k) for (int rep = 0; rep < NREP(k); ++rep)
#define LASTREP(k) (rep == NREP(k) - 1)
#ifdef PROBE_TIME_PH
#define STAMP(k) do { if (bx == 0 && wave == 0) MISC[32 + (k)] = (unsigned)__builtin_amdgcn_s_memrealtime(); } while (0)
#else
#define STAMP(k) do { } while (0)
#endif
#define SEAM(k) do { if (IN(k) && IN((k) + 1)) xcd_barrier(bar, wave); STAMP((k) + 1); } while (0)
    STAMP(0);

    if (IN(PH_PREP)) REPLOOP(PH_PREP) {
        PHASE_LANE;
        LAS float* scr = (LAS float*)(lds + wave * 16384);
        constexpr int I_IN = (DM / 64) * (INW / 32), I_UQ = (QL / 64) * (768 / 32), I_UKV = (KVL / 64) * (1024 / 32), I_O = (DM / 64) * (DM / 32), I_G = I_O, I_P = (PLE / 64) * (DM / 32);
        constexpr int I_1 = (DM / 64) * (2048 / 32), I_2 = (DE / 64) * (DM / 32);
        constexpr int NITEMS = I_IN + I_UQ + I_UKV + I_O + I_G + I_P;
        for (int it = gw; it < NITEMS; it += NGW) {
            int r = it;
            if (r < I_IN) { transpose_item<0>(w_in, INW, INW / 32, WIN, DM, mix_norm, nullptr, 1.f, scr, r, lane); continue; } r -= I_IN;
            if (r < I_UQ) { transpose_item<2>(w_uq, 768, 768 / 32, WUQ, QL, q_norm, nullptr, QSCALE, scr, r, lane); continue; } r -= I_UQ;
            if (r < I_UKV) { transpose_item<0>(w_ukv, 1024, 1024 / 32, WUKV, 256, kv_norm, nullptr, 1.f, scr, r, lane); continue; } r -= I_UKV;
            if (r < I_O) { transpose_item<0>(w_o, DM, DM / 32, WO, DM, attn_out_norm, conv_out_norm, 1.f, scr, r, lane); continue; } r -= I_O;
            if (r < I_G) { transpose_item<0>(w_ple_gate, DM, DM / 32, WG, DM, ple_norm, nullptr, 1.f, scr, r, lane); continue; } r -= I_G;
            transpose_item<0>(w_ple_proj, DM, DM / 32, WP, PLE, nullptr, nullptr, 1.f, scr, r, lane);
        }
        for (int i = bx * NTHREADS + tid; i < 1024 * 16; i += G * NTHREADS) *(u32x4*)(WUKV + (size_t)(i >> 4) * 256 + 128 + (i & 15) * 8) = (u32x4){0u, 0u, 0u, 0u};
        for (int i = bx * NTHREADS + tid; i < DM * NE; i += G * NTHREADS) { const int e = i >> 10, k = i & 1023; const float w = w_router[k * NE + e] * moe_norm[k]; const bf16_t whi = f2bf(w);
            WRHL[i] = whi; WRHL[DM * NE + i] = f2bf(w - bf2f(whi)); }
        for (int i = bx * NTHREADS + tid; i < NTOK * 32; i += G * NTHREADS) { const int t = i >> 5, j = i & 31; const float inv = powf(10000.f, -(float)j / 32.f); const float a = (float)pos[t] * inv; float sn, c; sincosf(a, &sn, &c);
            CS[(size_t)t * 64 + j] = c; CS[(size_t)t * 64 + 32 + j] = sn; }
        for (int i = bx * NTHREADS + tid; i < NTOK * PLE / 4; i += G * NTHREADS) { const f32x4 v = ((const f32x4*)p)[i]; ((u32x2*)P16)[i] = (u32x2){pk2(v[0], v[1]), pk2(v[2], v[3])}; }
        for (int row = gw * 4; row < NTOK; row += NGW * 4) {
            f32x4 v[4][4]; float ss[4];
#pragma unroll
            for (int q = 0; q < 4; ++q) { const f32x4* s = (const f32x4*)(x + (size_t)(row + q) * DM);
#pragma unroll
                for (int j = 0; j < 4; ++j) v[q][j] = s[lane + 64 * j]; }
#pragma unroll
            for (int q = 0; q < 4; ++q) { ss[q] = 0.f;
#pragma unroll
                for (int j = 0; j < 4; ++j) ss[q] += pg8::sq4(v[q][j]); }
#pragma unroll
            for (int q = 0; q < 4; ++q) { const float rstd = rsqrtf(wave_sum(ss[q]) * (1.f / DM) + EPS); u32x2* d = (u32x2*)(XN + (size_t)(row + q) * DM); if (lane == 0) RSX[row + q] = rstd;
#pragma unroll
                for (int j = 0; j < 4; ++j) d[lane + 64 * j] = (u32x2){pk2(v[q][j][0], v[q][j][1]), pk2(v[q][j][2], v[q][j][3])}; }
        }
    }
    SEAM(PH_PREP);
    if (IN(PH_INPROJ)) REPLOOP(PH_INPROJ) {
        { pg8::Gemm g{XN, WIN, DM, DM, DM, nullptr, 0}; pg8::StaticOrder S; S.init(NTOK / 256, INWP / 256, G, bx, nullptr);
          pg8::EpiBf16Stats<0> E{Z, INWP, SSQ, RSX}; pg8::gemm_phase<pg8::EpiBf16Stats<0>, false>(lds, g, S, E, wave); }
        { pg8::Gemm g{P16, WP, PLE, PLE, PLE, nullptr, 0}; pg8::StaticOrder S; S.init(NTOK / 256, DM / 256, G, bx, nullptr);
          pg8::EpiBf16Stats<1> E{PLER, DM, PSSQ, nullptr}; pg8::gemm_phase<pg8::EpiBf16Stats<1>, false>(lds, g, S, E, wave); }
    }
    SEAM(PH_INPROJ);
    if (IN(PH_TOKLOCAL)) REPLOOP(PH_TOKLOCAL) {
        PHASE_LANE;
        if (!(args.skip & 1)) for (int r0 = gw * 16; r0 < NTOK; r0 += NGW * 16) {
            const int c8 = lane * 8; f32x4 w0[2], w1[2], w2[2];
#pragma unroll
            for (int q = 0; q < 2; ++q) { w0[q] = *(const f32x4*)(conv_w + c8 + 4 * q); w1[q] = *(const f32x4*)(conv_w + 512 + c8 + 4 * q); w2[q] = *(const f32x4*)(conv_w + 1024 + c8 + 4 * q); }
            f32x4 u1[2] = {}, u2[2] = {};
            if ((r0 % SEQ) != 0) {
#pragma unroll
                for (int p = 1; p <= 2; ++p) { const bf16_t* zp = Z + (size_t)(r0 - p) * INWP; const u32x4 cg = *(const u32x4*)(zp + 960 + c8), vv = *(const u32x4*)(zp + 1472 + c8);
                    const f32x4 a = (f32x4){blo(cg.x), bhi(cg.x), blo(cg.y), bhi(cg.y)} * (f32x4){blo(vv.x), bhi(vv.x), blo(vv.y), bhi(vv.y)}, b = (f32x4){blo(cg.z), bhi(cg.z), blo(cg.w), bhi(cg.w)} * (f32x4){blo(vv.z), bhi(vv.z), blo(vv.w), bhi(vv.w)};
                    if (p == 1) { u1[0] = a; u1[1] = b; } else { u2[0] = a; u2[1] = b; } } }
#pragma unroll 4
            for (int rr = 0; rr < 16; ++rr) { const int row = r0 + rr; const bf16_t* z = Z + (size_t)row * INWP; const int s = row % SEQ, b = row / SEQ;
                const u32x4 bg = *(const u32x4*)(z + 448 + c8), cg = *(const u32x4*)(z + 960 + c8), vv = *(const u32x4*)(z + 1472 + c8);
                if (lane < 32) { const float x1 = bf2f(z[384 + lane]), x2 = bf2f(z[416 + lane]); const float c = CS[(size_t)row * 64 + lane], sn = CS[(size_t)row * 64 + 32 + lane];
                    const unsigned o = pk2(x1 * c - x2 * sn, x1 * sn + x2 * c);
#pragma unroll
                    for (int h = 0; h < NH; ++h) *(unsigned*)(Kb + ((size_t)(b * NH + h) * SEQ + s) * DQK + DN + 2 * lane) = o; }
                f32x4 u0[2]; u0[0] = (f32x4){blo(cg.x), bhi(cg.x), blo(cg.y), bhi(cg.y)} * (f32x4){blo(vv.x), bhi(vv.x), blo(vv.y), bhi(vv.y)}; u0[1] = (f32x4){blo(cg.z), bhi(cg.z), blo(cg.w), bhi(cg.w)} * (f32x4){blo(vv.z), bhi(vv.z), blo(vv.w), bhi(vv.w)};
                f32x4 y[2]; y[0] = (f32x4){blo(bg.x), bhi(bg.x), blo(bg.y), bhi(bg.y)} * (w0[0] * u2[0] + w1[0] * u1[0] + w2[0] * u0[0]); y[1] = (f32x4){blo(bg.z), bhi(bg.z), blo(bg.w), bhi(bg.w)} * (w0[1] * u2[1] + w1[1] * u1[1] + w2[1] * u0[1]);
                const float rstd = rsqrtf(wave_sum(pg8::sq4(y[0]) + pg8::sq4(y[1])) * (1.f / 512.f) + EPS);
                *(u32x4*)(MIX + (size_t)row * DM + 512 + c8) = pg8::pack8(y[0] * rstd, y[1] * rstd);
                u2[0] = u1[0]; u2[1] = u1[1]; u1[0] = u0[0]; u1[1] = u0[1]; }
        }
        { pg8::Gemm g{Z, WUQ, QL, INWP, QL, nullptr, 0}; pg8::StaticOrder S; S.init(NTOK / 256, 768 / 256, G, bx, nullptr);
          pg8::EpiQ E{Qb, SSQ, CS}; pg8::gemm_phase<pg8::EpiQ, false>(lds, g, S, E, wave); }
        { pg8::Gemm g{Z + 256, WUKV, 256, INWP, 256, nullptr, 0}; pg8::StaticOrder S; S.init(NTOK / 256, 1024 / 256, G, bx, nullptr);
          pg8::EpiKV E{Kb, Vb, SSQ}; pg8::gemm_phase<pg8::EpiKV, false>(lds, g, S, E, wave); }
    }
    SEAM(PH_TOKLOCAL);
    if (IN(PH_ATTN)) REPLOOP(PH_ATTN) {
        const int vcu = (G % 8 == 0) ? (bx % 8) * (G / 8) + bx / 8 : bx;
        using att::L_END; using att::cv_cmap1; using att::cv_cmap2; using att::CV_N1; using att::CV_TOTAL;
        const att::ConvJob cj{w1, w2, moe_norm, (unsigned char*)W1T, (unsigned char*)W2T, gw, NGW}; int tseq = LASTREP(PH_ATTN) ? 0 : (1 << 20);
        for (int it = vcu; it < NB * NH * 8; it += G) { const int bh = it >> 3, pr = it & 7;
            for (int pass = 0; pass < 2; ++pass) att::attn_block(bh, pass ? pr : 15 - pr, Qb, Kb, Vb, MIX, ASSQ, lds, wave, cj, tseq); }
        if (LASTREP(PH_ATTN)) { const int lane = lane_id(), hi = lane >> 5, wid = wave; __syncthreads();
            for (int cv_idx = tseq * NGW + gw; cv_idx < att::CV_TOTAL; cv_idx += NGW) { CV_DECODE(cv_idx) float cvw[16]; CV_LOAD(); CV_STORE(); } }
    }
    SEAM(PH_ATTN);
    if (IN(PH_WO)) REPLOOP(PH_WO) {
        pg8::Gemm g{MIX, WO, DM, DM, DM, nullptr, 0}; pg8::StaticOrder S; S.init(NTOK / 256, DM / 256, G, bx, nullptr);
        pg8::EpiWo E{XN, HBF, X8, ASSQ, SSQ1, moe_norm}; pg8::gemm_phase<pg8::EpiWo, false>(lds, g, S, E, wave, LASTREP(PH_WO));
    }
    SEAM(PH_WO);
    if (IN(PH_ROUTER)) REPLOOP(PH_ROUTER) {
        PHASE_LANE;
        typedef float f32x16 __attribute__((ext_vector_type(16)));
        LAS int* hist = (LAS int*)(lds + HIST_OFF); LAS f32x16* xch = (LAS f32x16*)(lds + HIST_OFF + 256);
        for (int i = tid; i < 2 * NE * 128; i += NTHREADS) { const int pe = i >> 7, kc = i & 127, e = pe & 31; *(LAS u32x4*)(lds + pe * 2048 + ((kc ^ (e & 15)) << 4)) = ((const u32x4*)WRHL)[i]; }
        if (tid < NE) hist[tid] = 0;
        __syncthreads();
        for (int chunk = bx; chunk < NTOK / 128; chunk += G) {
            const int base = chunk * 128, wq = wave & 3, kh = wave >> 2;
            const int j = lane & 31, half = lane >> 5, tok = base + wq * 32 + j;
            const bf16_t* xr = HBF + (size_t)tok * DM + kh * 512 + 8 * half; const LAS unsigned char* wrow = lds + j * 2048;
            f32x16 acc = {};
#pragma unroll 8
            for (int s = 0; s < 32; ++s) { const bf16x8 xb = *(const bf16x8*)(xr + 16 * s); const int kc = ((kh * 64 + 2 * s + half) ^ (j & 15)) << 4;
                const bf16x8 ah = *(const LAS bf16x8*)(wrow + kc), al = *(const LAS bf16x8*)(wrow + 65536 + kc);
                acc = __builtin_amdgcn_mfma_f32_32x32x16_bf16(ah, xb, acc, 0, 0, 0); acc = __builtin_amdgcn_mfma_f32_32x32x16_bf16(al, xb, acc, 0, 0, 0); }
            if (kh == 1) xch[wq * 64 + lane] = acc;
            __syncthreads();
            if (kh == 0) {
                const f32x16 other = xch[wq * 64 + lane];
                const f32x4 s0 = *(const f32x4*)(SSQ1 + (size_t)tok * 16 + 8 * half), s1 = *(const f32x4*)(SSQ1 + (size_t)tok * 16 + 8 * half + 4);
                float ss = ((s0[0] + s0[1]) + (s0[2] + s0[3])) + ((s1[0] + s1[1]) + (s1[2] + s1[3])); ss += __shfl_xor(ss, 32); const float rstd = rsqrtf(ss * (1.f / DM) + EPS);
                float v[16];
#pragma unroll
                for (int r = 0; r < 16; ++r) v[r] = (acc[r] + other[r]) * rstd + b_router[(r & 3) + 8 * (r >> 2) + 4 * half];
                float lv[4]; int li[4];
#pragma unroll
                for (int t = 0; t < 4; ++t) { float best = -__builtin_inff(); int bi = 0;
#pragma unroll
                    for (int r = 0; r < 16; ++r) if (v[r] > best) { best = v[r]; bi = (r & 3) + 8 * (r >> 2) + 4 * half; }
                    const auto rv = __builtin_amdgcn_permlane32_swap(__float_as_uint(best), __float_as_uint(best), false, false); const auto ri = __builtin_amdgcn_permlane32_swap((unsigned)bi, (unsigned)bi, false, false);
                    const float b0 = __uint_as_float(rv[0]), b1 = __uint_as_float(rv[1]); const int i0 = (int)ri[0], i1 = (int)ri[1];
                    const bool t0 = (b0 > b1) || (b0 == b1 && i0 < i1); const float gb = t0 ? b0 : b1; const int gi = t0 ? i0 : i1; lv[t] = gb; li[t] = gi;
#pragma unroll
                    for (int r = 0; r < 16; ++r) if ((r & 3) + 8 * (r >> 2) + 4 * half == gi) v[r] = -__builtin_inff(); }
                if (half == 0) { const float e1 = __expf(lv[1] - lv[0]), e2 = __expf(lv[2] - lv[0]), e3 = __expf(lv[3] - lv[0]); const float inv = 1.f / (1.f + e1 + e2 + e3);
                    *(int4*)(TOPI + (size_t)tok * 4) = make_int4(li[0], li[1], li[2], li[3]); *(f32x4*)(TOPG + (size_t)tok * 4) = (f32x4){inv, e1 * inv, e2 * inv, e3 * inv}; RS1[tok] = rstd;
#pragma unroll
                    for (int t = 0; t < 4; ++t) (void)__hip_atomic_fetch_add(hist + li[t], 1, __ATOMIC_RELAXED, __HIP_MEMORY_SCOPE_WORKGROUP); }
            }
            __syncthreads();
        }
        if (tid < NE && LASTREP(PH_ROUTER)) atomicAdd(ctl + CW_CNT + tid, hist[tid]);
        __syncthreads();
    }
    SEAM(PH_ROUTER);
    if (IN(PH_ROUTE)) {
        PHASE_LANE;
        LAS int* sh = (LAS int*)lds;
        if (tid == 0) { int ps = 0, nt = 0;
            for (int e = 0; e < NE; ++e) { sh[e] = ps; const int t = (ctl[CW_CNT + e] + 255) >> 8; if (bx == 0) for (int q = 0; q < t; ++q) ctl[CW_TILE_E + nt + q] = e; nt += t; ps += t * 256; }
            sh[NE] = ps; if (bx == 0) ctl[CW_NTILES] = nt; }
        __syncthreads();
        for (int chunk = bx; chunk < MROWS / NTHREADS; chunk += G) {
            if (tid < NE) sh[64 + tid] = 0;
            __syncthreads();
            const int idx = chunk * NTHREADS + tid, e = TOPI[idx]; const int r = __hip_atomic_fetch_add(sh + 64 + e, 1, __ATOMIC_RELAXED, __HIP_MEMORY_SCOPE_WORKGROUP);
            __syncthreads();
            if (tid < NE) sh[128 + tid] = atomicAdd(ctl + CW_CURSOR + tid, sh[64 + tid]);
            __syncthreads();
            const int dest = sh[e] + sh[128 + e] + r; ROWTOK[dest] = idx >> 2; ROWSLOT[dest] = idx; ROWGATE[dest] = TOPG[idx]; ROWRS[dest] = RS1[idx >> 2];
            __syncthreads();
        }
        for (int e = bx; e < NE; e += G) { const int plo = sh[e] + ctl[CW_CNT + e], phi = sh[e + 1];
            for (int r = plo + tid; r < phi; r += NTHREADS) { ROWTOK[r] = 0; ROWSLOT[r] = MROWS; ROWGATE[r] = 0.f; ROWRS[r] = 0.f; } }
        __syncthreads();
    }
    SEAM(PH_ROUTE);
    if (IN(PH_MOE1)) REPLOOP(PH_MOE1) {
        pg8::Gemm g{X8, W1T, DM, DM, DM, ROWTOK, (size_t)2048 * DM}; pg8::StaticOrder S; S.init(ctl[CW_NTILES], 2048 / 256, G, bx, ctl + CW_TILE_E);
        pg8::EpiMoe1 E{(unsigned char*)HB, b1, ROWRS}; pg8::gemm_phase<pg8::EpiMoe1, true, true>(lds, g, S, E, wave, LASTREP(PH_MOE1));
    }
    SEAM(PH_MOE1);
    if (IN(PH_MOE2)) REPLOOP(PH_MOE2) {
        pg8::Gemm g{HB, W2T, DE, DE, DE, nullptr, (size_t)DM * DE}; pg8::StaticOrder S; S.init(ctl[CW_NTILES], DM / 256, G, bx, ctl + CW_TILE_E);
        pg8::EpiMoe2 E{(unsigned char*)Y, b2, ROWSLOT, ROWGATE}; pg8::gemm_phase<pg8::EpiMoe2, false, true>(lds, g, S, E, wave, LASTREP(PH_MOE2));
    }
    SEAM(PH_MOE2);
    if (IN(PH_COMBINE)) REPLOOP(PH_COMBINE) {
        PHASE_LANE;
        for (int row = gw * 2; row < NTOK; row += NGW * 2) {
            u32x4 hv[2][2]; u32x2 yv[2][4][2]; const unsigned char* Y8 = (const unsigned char*)Y;
#pragma unroll
            for (int q = 0; q < 2; ++q)
#pragma unroll
                for (int j = 0; j < 2; ++j) { hv[q][j] = *(const u32x4*)(HBF + (size_t)(row + q) * DM + (lane + 64 * j) * 8);
#pragma unroll
                    for (int k = 0; k < 4; ++k) yv[q][k][j] = *(const u32x2*)(Y8 + ((size_t)(row + q) * 4 + k) * DM + (lane + 64 * j) * 8); }
#pragma unroll
            for (int q = 0; q < 2; ++q) { float ss = 0.f; u32x4 ov[2];
#pragma unroll
                for (int j = 0; j < 2; ++j) { f32x4 a = {blo(hv[q][j].x), bhi(hv[q][j].x), blo(hv[q][j].y), bhi(hv[q][j].y)}, b = {blo(hv[q][j].z), bhi(hv[q][j].z), blo(hv[q][j].w), bhi(hv[q][j].w)};
#pragma unroll
                    for (int k = 0; k < 4; ++k) { const u32x2 y = yv[q][k][j]; const f32x2 y0 = __builtin_amdgcn_cvt_pk_f32_fp8(y.x, false), y1 = __builtin_amdgcn_cvt_pk_f32_fp8(y.x, true), y2 = __builtin_amdgcn_cvt_pk_f32_fp8(y.y, false), y3 = __builtin_amdgcn_cvt_pk_f32_fp8(y.y, true);
                        a += (f32x4){y0[0], y0[1], y1[0], y1[1]}; b += (f32x4){y2[0], y2[1], y3[0], y3[1]}; }
                    ss += pg8::sq4(a) + pg8::sq4(b); ov[j] = pg8::pack8(a, b); }
                ss = wave_sum(ss);
                bf16_t* ho = LASTREP(PH_COMBINE) ? HBF : (bf16_t*)(ws + WS_HB);
#pragma unroll
                for (int j = 0; j < 2; ++j) *(u32x4*)(ho + (size_t)(row + q) * DM + (lane + 64 * j) * 8) = ov[j];
                float ps = lane < 16 ? PSSQ[(size_t)(row + q) * 16 + lane] : 0.f; ps += __shfl_xor(ps, 1); ps += __shfl_xor(ps, 2); ps += __shfl_xor(ps, 4); ps += __shfl_xor(ps, 8);
                if (lane == 0) { RS2[row + q] = rsqrtf(ss * (1.f / DM) + EPS); RS2[NTOK + row + q] = rsqrtf(ps * (1.f / DM) + EPS); } }
        }
    }
    SEAM(PH_COMBINE);
    if (IN(PH_PLE)) REPLOOP(PH_PLE) {
        pg8::Gemm g{HBF, WG, DM, DM, DM, nullptr, 0}; pg8::StaticOrder S; S.init(NTOK / 256, DM / 256, G, bx, nullptr);
        pg8::EpiPle E{HBF, H3, PLER, RS2 + NTOK, RS2, ple_post_norm, FSSQ}; pg8::gemm_phase<pg8::EpiPle, false>(lds, g, S, E, wave);
    }
    SEAM(PH_PLE);
    if (IN(PH_FINAL)) REPLOOP(PH_FINAL) {
        PHASE_LANE;
        for (int row = gw * 2; row < NTOK; row += NGW * 2) {
            u32x4 hv[2][2]; float sp[2];
#pragma unroll
            for (int q = 0; q < 2; ++q) { sp[q] = lane < 16 ? FSSQ[(size_t)(row + q) * 16 + lane] : 0.f;
#pragma unroll
                for (int j = 0; j < 2; ++j) hv[q][j] = *(const u32x4*)(H3 + (size_t)(row + q) * DM + (lane + 64 * j) * 8); }
#pragma unroll
            for (int q = 0; q < 2; ++q) { float s = sp[q]; s += __shfl_xor(s, 1); s += __shfl_xor(s, 2); s += __shfl_xor(s, 4); s += __shfl_xor(s, 8);
                const float rstd = rsqrtf(__shfl(s, 0) * (1.f / DM) + EPS); float* ho = (LASTREP(PH_FINAL) ? H : (float*)(ws + WS_HB)) + (size_t)(row + q) * DM;
#pragma unroll
                for (int j = 0; j < 2; ++j) { const int c = (lane + 64 * j) * 8; const f32x4 g0 = *(const f32x4*)(final_norm + c), g1 = *(const f32x4*)(final_norm + c + 4); const u32x4 v = hv[q][j];
                    *(f32x4*)(ho + c) = (f32x4){blo(v.x), bhi(v.x), blo(v.y), bhi(v.y)} * rstd * g0; *(f32x4*)(ho + c + 4) = (f32x4){blo(v.z), bhi(v.z), blo(v.w), bhi(v.w)} * rstd * g1; } }
        }
    }
#ifdef PROBE_TIME_PH
    STAMP(PH_COUNT);
    if (bx == 0 && wave == 0) { const unsigned dt = MISC[32 + PROBE_TIME_PH + 1] - MISC[32 + PROBE_TIME_PH]; const unsigned long long t0 = __builtin_amdgcn_s_memrealtime(); while (__builtin_amdgcn_s_memrealtime() - t0 < (unsigned long long)dt) __builtin_amdgcn_s_sleep(8); }
#endif
#ifdef PROBE_BARS
    if (hi - lo > 1) for (int i = 0; i < PROBE_BARS; ++i) xcd_barrier(bar, wave);
#endif
#undef IN
#undef NREP
#undef REPLOOP
#undef LASTREP
#undef SEAM
}
static int g_grid = 0;
extern "C" void kernel_launch(void* const* d_in, const int* in_sizes, int n_in, void* d_out, int out_size, void* d_ws, size_t ws_size, hipStream_t stream) {
    if (n_in != 25 || in_sizes[0] != NTOK * DM || out_size != NTOK * DM || ws_size < WS_END) {
        fprintf(stderr, "kernel_launch: unexpected shapes (n_in %d, in0 %d, out %d, ws %zu need %zu)\n", n_in, n_in > 0 ? in_sizes[0] : -1, out_size, ws_size, (size_t)WS_END); return; }
    if (g_grid == 0) {
        int dev = 0, cus = 0, per_cu = 0; (void)hipGetDevice(&dev); (void)hipDeviceGetAttribute(&cus, hipDeviceAttributeMultiprocessorCount, dev);
        if (hipFuncSetAttribute((const void*)fwd, hipFuncAttributeMaxDynamicSharedMemorySize, LDS_BYTES) != hipSuccess) fprintf(stderr, "hipFuncSetAttribute failed\n");
        if (hipOccupancyMaxActiveBlocksPerMultiprocessor(&per_cu, (const void*)fwd, NTHREADS, LDS_BYTES) != hipSuccess || per_cu < 1) { fprintf(stderr, "occupancy query: %d\n", per_cu); per_cu = 1; }
        (void)hipGetLastError();
        g_grid = cus > 0 ? cus : 256;
    }
    (void)hipMemsetAsync((unsigned char*)d_ws + WS_CTL, 0, 64 * 1024, stream);
    Args a{}; for (int i = 0; i < 25; ++i) a.in[i] = d_in[i]; a.out = (float*)d_out; a.ws = (unsigned char*)d_ws;
    a.ph_lo = 0; a.ph_hi = PH_COUNT; a.li = 0; a.skip = 0;
    void* p[] = {&a};
    const hipError_t e = hipLaunchCooperativeKernel((const void*)fwd, dim3(g_grid), dim3(NTHREADS), p, LDS_BYTES, stream);
    if (e != hipSuccess) fprintf(stderr, "cooperative launch failed: %s (grid %d)\n", hipGetErrorString(e), g_grid);
}
```

```cpp
#include <hip/hip_runtime.h>
#include <cstdint>
#include <cstdio>
#include <cmath>

typedef unsigned short bf16_t;

constexpr int NB = 8, SEQ = 4096, DM = 1024, NTOK = NB * SEQ;
constexpr int PLE = 256, NH = 4, DN = 128, DR = 64, DV = 128, QL = 256, KVL = 128, DQK = DN + DR;
constexpr int INW = 1984, INWP = 2048;
constexpr int NE = 32, TOPK = 4, DE = 1024;
constexpr int MROWS = NTOK * TOPK;
constexpr int MAXTILES = MROWS / 256 + NE;
constexpr int PROWS = MAXTILES * 256;
constexpr float EPS = 1e-6f;
constexpr float QSCALE = 0.07216878364870322f * 1.4426950408889634f;

constexpr size_t MiB = 1u << 20;
constexpr size_t WS_CTL = 0;
constexpr size_t WS_WIN = 1 * MiB, WS_WUQ = 5 * MiB, WS_WUKV = 5 * MiB + 512 * 1024, WS_WO = 6 * MiB, WS_WG = 8 * MiB, WS_WP = 10 * MiB;
constexpr size_t WS_WR = 10 * MiB + 512 * 1024;
constexpr size_t WS_CS = 11 * MiB;
constexpr size_t WS_SSQ = 19 * MiB, WS_ASSQ = 20 * MiB, WS_PSSQ = 21 * MiB, WS_FSSQ = 23 * MiB;
constexpr size_t WS_TOPI = 25 * MiB, WS_TOPG = 25 * MiB + 512 * 1024;
constexpr size_t WS_ROWTOK = 26 * MiB, WS_ROWSLOT = 27 * MiB, WS_ROWGATE = 28 * MiB;
constexpr size_t WS_P16 = 29 * MiB;
constexpr size_t WS_SSQ1 = 45 * MiB, WS_RS1 = 47 * MiB, WS_RS2 = 47 * MiB + 128 * 1024, WS_ROWRS = 47 * MiB + 384 * 1024;
constexpr size_t WS_RSX = 10 * MiB + 512 * 1024;
constexpr size_t WS_WRHL = 10 * MiB + 768 * 1024;
constexpr size_t WS_HBF = 112 * MiB;
constexpr size_t WS_H3 = 304 * MiB;
constexpr size_t WS_W1 = 48 * MiB, WS_W2 = 176 * MiB, WS_XN = 240 * MiB, WS_MIX = 304 * MiB, WS_PLER = 368 * MiB;
constexpr size_t WS_Z = 432 * MiB, WS_Q = 560 * MiB, WS_K = 608 * MiB, WS_V = 656 * MiB;
constexpr size_t WS_HB = 432 * MiB;
constexpr size_t WS_Y = 704 * MiB;
constexpr size_t WS_END = WS_Y + (size_t)(MROWS + 256) * DM * 2;
constexpr int CW_CNT = 0, CW_CURSOR = 64, CW_PADSTART = 128, CW_NTILES = 192, CW_TILE_E = 256;

__device__ __forceinline__ float bf2f(bf16_t v) { return __uint_as_float((unsigned)v << 16); }
__device__ __forceinline__ float blo(unsigned u) { return __uint_as_float(u << 16); }
__device__ __forceinline__ float bhi(unsigned u) { return __uint_as_float(u & 0xffff0000u); }
__device__ __forceinline__ bf16_t f2bf(float f) { unsigned u = __float_as_uint(f); return (bf16_t)((u + 0x7fffu + ((u >> 16) & 1u)) >> 16); }
__device__ __forceinline__ unsigned pk2(float lo, float hi) { return (unsigned)f2bf(lo) | ((unsigned)f2bf(hi) << 16); }
__device__ __forceinline__ float wave_sum(float v) {
#pragma unroll
    for (int o = 1; o < 64; o <<= 1) v += __shfl_xor(v, o);
    return v;
}
__device__ __forceinline__ float wave_max(float v) {
#pragma unroll
    for (int o = 1; o < 64; o <<= 1) v = fmaxf(v, __shfl_xor(v, o));
    return v;
}
__device__ __forceinline__ float dot8(uint4 x, uint4 y) {
    return blo(x.x) * blo(y.x) + bhi(x.x) * bhi(y.x) + blo(x.y) * blo(y.y) + bhi(x.y) * bhi(y.y) +
           blo(x.z) * blo(y.z) + bhi(x.z) * bhi(y.z) + blo(x.w) * blo(y.w) + bhi(x.w) * bhi(y.w);
}
__device__ __forceinline__ float dot_bf16(const bf16_t* a, const bf16_t* b, int K) {
    const uint4* a4 = (const uint4*)a; const uint4* b4 = (const uint4*)b; float acc = 0.f;
    for (int i = 0; i < K / 8; ++i) acc += dot8(a4[i], b4[i]);
    return acc;
}

#define LAS __attribute__((address_space(3)))
#define GAS __attribute__((address_space(1)))
typedef short bf16x8 __attribute__((ext_vector_type(8)));
typedef float f32x4 __attribute__((ext_vector_type(4)));
typedef float f32x2 __attribute__((ext_vector_type(2)));
typedef unsigned u32x4 __attribute__((ext_vector_type(4)));
typedef unsigned u32x2 __attribute__((ext_vector_type(2)));
#ifndef PROBE_PH
#define PROBE_PH (-1)
#define PROBE_REP 1
#endif
#ifndef MOE2_DELAY_TICKS
#define MOE2_DELAY_TICKS 700ull
#endif
constexpr int NWAVES = 8, NTHREADS = 512;
constexpr int RING_BYTES = 131072, MISC_OFF = RING_BYTES, HIST_OFF = MISC_OFF + 256, LDS_BYTES = 163840;
constexpr int CW_BAR = 4096;
__device__ __forceinline__ unsigned cvt_pk_bf16(float lo, float hi) { unsigned r; asm volatile("v_cvt_pk_bf16_f32 %0, %1, %2" : "=v"(r) : "v"(lo), "v"(hi)); return r; }
__device__ __forceinline__ int lane_id() { int l = (int)__builtin_amdgcn_mbcnt_hi(~0u, __builtin_amdgcn_mbcnt_lo(~0u, 0u)); asm volatile("" : "+v"(l)); return l; }
__device__ __forceinline__ float fast_sigmoid(float a) { return __builtin_amdgcn_rcpf(1.f + __expf(-a)); }

#define XB_TMO      128
#define XB_XCNT(j)  (256  + 64 * (j))
#define XB_XSUB(j)  (1280 + 64 * (j))
#define XB_XGEN(j)  (2304 + 64 * (j))
#define XB_TOP      3328
#define XB_TOPGEN   3392
#define XCD_BAR_WORDS 3456
#define XB_SPIN_CAP (1u << 20)
__device__ __forceinline__ unsigned xb_ld(unsigned* p)              { return __hip_atomic_load(p, __ATOMIC_RELAXED, __HIP_MEMORY_SCOPE_AGENT); }
__device__ __forceinline__ unsigned xb_add(unsigned* p, unsigned v) { return __hip_atomic_fetch_add(p, v, __ATOMIC_RELAXED, __HIP_MEMORY_SCOPE_AGENT); }
__device__ __forceinline__ unsigned xb_xcc_id() { return (unsigned)__builtin_amdgcn_s_getreg((3 << 11) | 20) & 0xFu; }
#define XB_SPIN(cond, bar) do { unsigned _sp = 0; while (cond) { __builtin_amdgcn_s_sleep(1); \
    if ((++_sp & 255u) == 0u) { if (xb_ld(&(bar)[XB_TMO])) break; if (_sp > XB_SPIN_CAP) { atomicAdd(&(bar)[XB_TMO], 1u); break; } } } } while (0)
struct XcdBarrier { unsigned* bar; unsigned x; volatile LAS unsigned* st; };
__device__ __forceinline__ XcdBarrier xcd_barrier_post(unsigned* bar, volatile LAS unsigned* st, int wave) {
    XcdBarrier b; b.bar = bar; b.x = xb_xcc_id(); b.st = st;
    if (wave == 0 && lane_id() == 0) (void)xb_add(&bar[XB_XCNT(b.x)], 1u);
    return b;
}
__device__ __forceinline__ void xcd_barrier_complete(unsigned* bar, unsigned x, unsigned& nloc, unsigned& nx) {
    const unsigned G = gridDim.x * gridDim.y * gridDim.z;
    unsigned sum, cnt, mine, sp = 0u;
    for (;;) {
        sum = 0u; cnt = 0u; mine = 0u;
#pragma unroll
        for (unsigned j = 0; j < 16; ++j) { const unsigned c = xb_ld(&bar[XB_XCNT(j)]); sum += c; cnt += (c > 0u) ? 1u : 0u; mine = (j == x) ? c : mine; }
        if (sum == G) break;
        __builtin_amdgcn_s_sleep(1);
        if ((++sp & 255u) == 0u) { if (xb_ld(&bar[XB_TMO])) break; if (sp > XB_SPIN_CAP) { atomicAdd(&bar[XB_TMO], 1u); break; } }
    }
    nloc = mine > 0u ? mine : 1u; nx = cnt > 0u ? cnt : 1u;
}
__device__ __forceinline__ void xcd_barrier(const XcdBarrier& b, int wave) {
    asm volatile("s_waitcnt vmcnt(0)" ::: "memory");
    __syncthreads();
    if (wave == 0 && lane_id() == 0) {
        unsigned* bar = b.bar;
        __builtin_amdgcn_s_waitcnt(0);
        unsigned nloc = b.st[0], nx = b.st[1];
        if (nloc == 0u) { xcd_barrier_complete(bar, b.x, nloc, nx); b.st[0] = nloc; b.st[1] = nx; }
        const unsigned old = xb_add(&bar[XB_XSUB(b.x)], 1u);
        const unsigned gen = old / nloc;
        if (old + 1u == (gen + 1u) * nloc) {
            __builtin_amdgcn_fence(__ATOMIC_RELEASE, "agent");
            asm volatile("s_waitcnt vmcnt(0)" ::: "memory");
            const unsigned og = xb_add(&bar[XB_TOP], 1u);
            const unsigned tg = og / nx;
            if (og + 1u == (tg + 1u) * nx) xb_add(&bar[XB_TOPGEN], 1u);
            else XB_SPIN(xb_ld(&bar[XB_TOPGEN]) == tg, bar);
            __builtin_amdgcn_fence(__ATOMIC_ACQUIRE, "agent");
            xb_add(&bar[XB_XGEN(b.x)], 1u);
            asm volatile("s_waitcnt vmcnt(0)" ::: "memory");
        } else {
            XB_SPIN(xb_ld(&bar[XB_XGEN(b.x)]) == gen, bar);
            __builtin_amdgcn_fence(__ATOMIC_ACQUIRE, "agent");
            asm volatile("s_waitcnt vmcnt(0)" ::: "memory");
        }
    }
    __syncthreads();
}

namespace pg8 {
constexpr int BM = 256, BK = 64, HALF = 128, HTB = HALF * BK * 2, STAGE_BYTES = 8 * HTB, NXCD = 8, WGM = 8;
__host__ __device__ __forceinline__ int lds_byte(int r, int c) { const int st = (r >> 4) * 2 + (c >> 5), rr = r & 15, cc = c & 31, ob = rr * 64 + cc * 2; return st * 1024 + (ob ^ (((ob >> 9) & 1) << 5)); }
__host__ __device__ __forceinline__ void stage_rc(int b, int& R, int& C) { const int st = b / 1024, sb = b % 1024, swz = sb ^ (((sb >> 9) & 1) << 5); R = (st >> 1) * 16 + swz / 64; C = (st & 1) * 32 + (swz % 64) / 2; }
__host__ __device__ __forceinline__ int perm32(int rho) { const int n = rho >> 4, i = rho & 15; return 8 * (i >> 2) + 4 * n + (i & 3); }
struct Unit { int pm, pn, e; };
struct Gemm { const void* A; const void* Bt; int K, lda, ldb; const int* rowidx; size_t bstride; };
struct StaticOrder {
    int nM, nN, nwg, G, c; const int* tile_e;
    __device__ void init(int nM_, int nN_, int G_, int c_, const int* te) { nM = nM_; nN = nN_; nwg = nM * nN; G = G_; c = c_; tile_e = te; }
    __device__ bool next(int i, Unit& u) const {
        const long L = (long)i * G + c; if (L >= nwg) return false;
        int wgid = (int)L; { const int q = nwg / NXCD, r = nwg % NXCD, xcd = wgid % NXCD, off = wgid / NXCD; wgid = (xcd < r ? xcd * (q + 1) : r * (q + 1) + (xcd - r) * q) + off; }
        const int nig = WGM * nN, gid = wgid / nig, fm = gid * WGM, gsz = (nM - fm) < WGM ? (nM - fm) : WGM;
        u.pm = fm + ((wgid % nig) % gsz); u.pn = (wgid % nig) / gsz; u.e = tile_e ? tile_e[u.pm] : 0; return true;
    }
};
typedef f32x4 Acc[2][2][4][2];
typedef int v8i_t __attribute__((ext_vector_type(8)));
typedef int v4i_t __attribute__((ext_vector_type(4)));
template <class Epi, bool GATHER, bool FP8 = false>
__device__ __forceinline__ void gemm_phase(LAS unsigned char* lds, const Gemm g, const StaticOrder& S, const Epi& E, const int wid, const bool do_epi = true) {
    const int lane = lane_id(), tid = wid * 64 + lane, wr = wid >> 2, wc = wid & 3, fr = lane & 15, fq = lane >> 4;
    constexpr int ES = FP8 ? 1 : 2;
    const int K = g.K, nt = K * ES / 128;
    int RA[2], CA[2]; unsigned voffB[2], voffA[2];
#pragma unroll
    for (int i = 0; i < 2; ++i) { int R, C; stage_rc(tid * 16 + i * 8192, R, C); const int Rb = Epi::PERM ? ((R & ~31) + perm32(R & 31)) : R;
        RA[i] = R; CA[i] = C; voffB[i] = (unsigned)(Rb * g.ldb * ES + C * 2); voffA[i] = (unsigned)(R * g.lda * ES + C * 2); }
    const size_t hstepA = GATHER ? 0 : (size_t)HALF * g.lda * ES;
    const size_t kstep = (size_t)(BK * 2);
    const size_t hstepB = (size_t)HALF * g.ldb * ES;
    const unsigned ldsw = (unsigned)wid * 1024u;
    const int aoff = lds_byte(wr * 64 + fr, fq * 8), boff = lds_byte(wc * 32 + fr, fq * 8);
#define PG8_SA(b, h) (((b) * 2 + (h)) * HTB)
#define PG8_SB(b, h) ((4 + (b) * 2 + (h)) * HTB)
#define PG8_STAGE(bufoff, gbase, voff) do { _Pragma("unroll") for (int _i = 0; _i < 2; ++_i) \
        __builtin_amdgcn_global_load_lds((const unsigned*)((const char*)(gbase) + (voff)[_i]), (LAS unsigned*)(lds + (bufoff) + ldsw + _i * 8192), 16, 0, 0); } while (0)
#define PG8_LDA(dst, b, h) do { _Pragma("unroll") for (int m = 0; m < 4; ++m) _Pragma("unroll") for (int k = 0; k < 2; ++k) dst[m][k] = *(const LAS bf16x8*)(lds + PG8_SA(b, h) + aoff + m * 2048 + k * 1024); } while (0)
#define PG8_LDB(dst, b, h) do { _Pragma("unroll") for (int n = 0; n < 2; ++n) _Pragma("unroll") for (int k = 0; k < 2; ++k) dst[n][k] = *(const LAS bf16x8*)(lds + PG8_SB(b, h) + boff + n * 2048 + k * 1024); } while (0)
#define PG8_CAT8(x) __builtin_shufflevector(__builtin_bit_cast(v4i_t, (x)[0]), __builtin_bit_cast(v4i_t, (x)[1]), 0, 1, 2, 3, 4, 5, 6, 7)
#define PG8_MMA(ai, bj, At, Bt) do { __builtin_amdgcn_s_setprio(1); if constexpr (FP8) { _Pragma("unroll") for (int m = 0; m < 4; ++m) _Pragma("unroll") for (int n = 0; n < 2; ++n) \
        acc[ai][bj][m][n] = __builtin_amdgcn_mfma_scale_f32_16x16x128_f8f6f4(PG8_CAT8(Bt[n]), PG8_CAT8(At[m]), acc[ai][bj][m][n], 0, 0, 0, 0x7f7f7f7f, 0, 0x7f7f7f7f); \
        _Pragma("unroll") for (int m = 0; m < 4; ++m) _Pragma("unroll") for (int n = 0; n < 2; ++n) asm volatile("" : "+v"(acc[ai][bj][m][n]));   } else { \
        _Pragma("unroll") for (int m = 0; m < 4; ++m) _Pragma("unroll") for (int n = 0; n < 2; ++n) _Pragma("unroll") for (int k = 0; k < 2; ++k) \
        acc[ai][bj][m][n] = __builtin_amdgcn_mfma_f32_16x16x32_bf16(Bt[n][k], At[m][k], acc[ai][bj][m][n], 0, 0, 0); } __builtin_amdgcn_s_setprio(0); } while (0)
#define PG8_WAIT_V(n) asm volatile("s_waitcnt vmcnt(" #n ")" ::: "memory")
#define PG8_WAIT_L(n) asm volatile("s_waitcnt lgkmcnt(" #n ")" ::: "memory")
#define PG8_BAR __builtin_amdgcn_s_barrier()
#define PG8_SCHED __builtin_amdgcn_sched_barrier(0)
#define PG8_SETVO(vo, u) do { if constexpr (GATHER) { _Pragma("unroll") for (int _h = 0; _h < 2; ++_h) _Pragma("unroll") for (int _i = 0; _i < 2; ++_i) { \
        const int _row = g.rowidx[(u).pm * BM + _h * HALF + RA[_i]]; (vo)[_h][_i] = (unsigned)_row * (unsigned)(g.lda * ES) + (unsigned)CA[_i] * 2u; } } } while (0)
#define PG8_STAGE_A(bufoff, base, h, vog) do { if constexpr (GATHER) { PG8_STAGE(bufoff, base, (vog)[h]); } else { PG8_STAGE(bufoff, (base) + (h) * hstepA, voffA); } } while (0)
    Unit cur, nxt; int ui = 0;
    if (!S.next(0, cur)) return;
    Acc acc;
#pragma unroll
    for (int a = 0; a < 2; ++a)
#pragma unroll
        for (int b = 0; b < 2; ++b)
#pragma unroll
            for (int m = 0; m < 4; ++m)
#pragma unroll
                for (int n = 0; n < 2; ++n) acc[a][b][m][n] = (f32x4){0.f, 0.f, 0.f, 0.f};
    bf16x8 At[4][2], B0[2][2], B1[2][2];
    unsigned voC[2][2], voN[2][2];
    PG8_SETVO(voC, cur);
    const char* const Ab = (const char*)g.A;
    const char* cA = GATHER ? Ab : Ab + (size_t)cur.pm * 2 * hstepA;
    const char* cB = (const char*)g.Bt + (size_t)cur.e * g.bstride + (size_t)cur.pn * 2 * hstepB;
    PG8_STAGE(PG8_SB(0, 0), cB, voffB); PG8_STAGE(PG8_SB(0, 1), cB + hstepB, voffB); PG8_STAGE_A(PG8_SA(0, 0), cA, 0, voC); PG8_STAGE_A(PG8_SA(0, 1), cA, 1, voC);
    if (wr == 1) PG8_BAR;
    PG8_WAIT_V(2); PG8_BAR;
    PG8_STAGE(PG8_SB(1, 0), cB + kstep, voffB); PG8_STAGE_A(PG8_SA(1, 0), cA + kstep, 0, voC); PG8_STAGE(PG8_SB(1, 1), cB + hstepB + kstep, voffB);
    PG8_WAIT_V(6); PG8_BAR;
    for (;;) {
        const bool has_next = S.next(ui + 1, nxt);
        const char* nB = has_next ? (const char*)g.Bt + (size_t)nxt.e * g.bstride + (size_t)nxt.pn * 2 * hstepB : cB;
        const char* nA = (has_next && !GATHER) ? Ab + (size_t)nxt.pm * 2 * hstepA : cA;
        if constexpr (GATHER) { if (has_next) { PG8_SETVO(voN, nxt); } else {
#pragma unroll
            for (int h = 0; h < 2; ++h)
#pragma unroll
                for (int i = 0; i < 2; ++i) voN[h][i] = voC[h][i]; } }
        for (int t = 0; t < nt; t += 2) {
            const bool last = (t == nt - 2);
            if constexpr (Epi::MIDK > 0) { if (t == Epi::MIDK) { const int l2 = lane_id(); E.mid(acc, cur, wr, wc, l2 & 15, l2 >> 4); } }
            const char* a1 = cA + (size_t)(t + 1) * kstep;
            const char* a2 = last ? nA : cA + (size_t)(t + 2) * kstep; const char* b2 = last ? nB : cB + (size_t)(t + 2) * kstep;
            const char* a3 = a2 + kstep; const char* b3 = b2 + kstep;
            unsigned o2[2][2];
            if constexpr (GATHER) {
#pragma unroll
            for (int h = 0; h < 2; ++h)
#pragma unroll
                for (int i = 0; i < 2; ++i) o2[h][i] = last ? voN[h][i] : voC[h][i]; }
            PG8_LDB(B0, 0, 0); PG8_LDB(B1, 0, 1); PG8_SCHED; PG8_LDA(At, 0, 0); PG8_STAGE_A(PG8_SA(1, 1), a1, 1, voC);
            PG8_WAIT_V(8); PG8_WAIT_L(0); PG8_BAR; PG8_MMA(0, 0, At, B0); PG8_MMA(0, 1, At, B1); PG8_BAR; PG8_SCHED;
            PG8_LDA(At, 0, 1); PG8_STAGE(PG8_SB(0, 0), b2, voffB); PG8_STAGE(PG8_SB(0, 1), b2 + hstepB, voffB); PG8_STAGE_A(PG8_SA(0, 0), a2, 0, o2);
            PG8_WAIT_V(8); PG8_WAIT_L(0); PG8_BAR; PG8_MMA(1, 0, At, B0); PG8_MMA(1, 1, At, B1); PG8_BAR; PG8_SCHED;
            PG8_LDB(B0, 1, 0); PG8_LDB(B1, 1, 1); PG8_SCHED; PG8_LDA(At, 1, 0); PG8_STAGE_A(PG8_SA(0, 1), a2, 1, o2);
            PG8_WAIT_V(8); PG8_WAIT_L(0); PG8_BAR; PG8_MMA(0, 0, At, B0); PG8_MMA(0, 1, At, B1); PG8_BAR; PG8_SCHED;
            PG8_LDA(At, 1, 1); PG8_STAGE(PG8_SB(1, 0), b3, voffB); PG8_STAGE(PG8_SB(1, 1), b3 + hstepB, voffB); PG8_STAGE_A(PG8_SA(1, 0), a3, 0, o2);
            PG8_WAIT_V(8); PG8_WAIT_L(0); PG8_BAR; PG8_MMA(1, 0, At, B0); PG8_MMA(1, 1, At, B1); PG8_BAR; PG8_SCHED;
        }
        if (wr == 0) PG8_BAR;
        if (do_epi) { const int l2 = lane_id(); E(acc, cur, wr, wc, l2 & 15, l2 >> 4); }
        if (!has_next) break;
#pragma unroll
        for (int a = 0; a < 2; ++a)
#pragma unroll
            for (int b = 0; b < 2; ++b)
#pragma unroll
                for (int m = 0; m < 4; ++m)
#pragma unroll
                    for (int n = 0; n < 2; ++n) acc[a][b][m][n] = (f32x4){0.f, 0.f, 0.f, 0.f};
        cur = nxt; cB = nB; cA = nA; ++ui;
        if constexpr (GATHER) {
#pragma unroll
        for (int h = 0; h < 2; ++h)
#pragma unroll
            for (int i = 0; i < 2; ++i) voC[h][i] = voN[h][i]; }
        if (wr == 1) PG8_BAR;
    }
    PG8_WAIT_V(0);
    PG8_BAR;
#undef PG8_SA
#undef PG8_SB
#undef PG8_STAGE
#undef PG8_LDA
#undef PG8_LDB
#undef PG8_MMA
#undef PG8_CAT8
#undef PG8_WAIT_V
#undef PG8_WAIT_L
#undef PG8_BAR
#undef PG8_SCHED
#undef PG8_SETVO
#undef PG8_STAGE_A
}

__device__ __forceinline__ unsigned pk4_fp8(f32x4 v) { unsigned w = 0; w = __builtin_amdgcn_cvt_pk_fp8_f32(v[0], v[1], w, false); w = __builtin_amdgcn_cvt_pk_fp8_f32(v[2], v[3], w, true); return w; }
__device__ __forceinline__ float sq4(f32x4 v) { return (v[0] * v[0] + v[1] * v[1]) + (v[2] * v[2] + v[3] * v[3]); }
__device__ __forceinline__ float red_fq(float s) { s += __shfl_xor(s, 16); s += __shfl_xor(s, 32); return s; }
__device__ __forceinline__ u32x4 pack8(f32x4 a, f32x4 b) { u32x4 w; w.x = cvt_pk_bf16(a[0], a[1]); w.y = cvt_pk_bf16(a[2], a[3]); w.z = cvt_pk_bf16(b[0], b[1]); w.w = cvt_pk_bf16(b[2], b[3]); return w; }
template <int MODE> struct EpiBf16Stats {
    static constexpr bool PERM = true; static constexpr int MIDK = 0;
    bf16_t* O; int ldc; float* ssq; const float* rsx;
    __device__ __forceinline__ void operator()(const Acc& acc, const Unit& u, int wr, int wc, int fr, int fq) const {
        const int row0 = u.pm * BM + wr * 64 + fr, col0 = u.pn * BM + wc * 32 + 8 * fq;
        float rv[2][4];
#pragma unroll
        for (int ai = 0; ai < 2; ++ai)
#pragma unroll
            for (int m = 0; m < 4; ++m) rv[ai][m] = rsx ? rsx[row0 + ai * HALF + m * 16] : 1.f;
        asm volatile("" ::: "memory");
#pragma unroll
        for (int ai = 0; ai < 2; ++ai)
#pragma unroll
            for (int m = 0; m < 4; ++m) { const int row = row0 + ai * HALF + m * 16; bf16_t* rowp = O + (size_t)row * ldc + col0; const float rs = rv[ai][m];
                const f32x4 a00 = acc[ai][0][m][0] * rs, a01 = acc[ai][0][m][1] * rs, a10 = acc[ai][1][m][0] * rs, a11 = acc[ai][1][m][1] * rs;
                *(u32x4*)(rowp) = pack8(a00, a01); *(u32x4*)(rowp + HALF) = pack8(a10, a11);
                if (MODE == 1) { float s = (sq4(a00) + sq4(a01)) + (sq4(a10) + sq4(a11)); s = red_fq(s); if (fq == 0) ssq[(size_t)row * 16 + u.pn * 4 + wc] = s; }
                else if (u.pn == 0) { float s = (sq4(a00) + sq4(a01)) + (sq4(a10) + sq4(a11)); s = red_fq(s); if (fq == 0) ssq[(size_t)row * 8 + wc] = s; }
                else if (u.pn == 1) { float s = sq4(a00) + sq4(a01); s = red_fq(s); if (fq == 0) ssq[(size_t)row * 8 + 4 + wc] = s; } }
    }
};
struct EpiQ {
    static constexpr bool PERM = true; static constexpr int MIDK = 0;
    bf16_t* Q; const float* ssq; const float* cs;
    __device__ __forceinline__ void operator()(const Acc& acc, const Unit& u, int wr, int wc, int fr, int fq) const {
        const int row0 = u.pm * BM + wr * 64 + fr;
#pragma unroll
        for (int ai = 0; ai < 2; ++ai)
#pragma unroll
            for (int m = 0; m < 4; ++m) { const int row = row0 + ai * HALF + m * 16; const f32x4 sv = *(const f32x4*)(ssq + (size_t)row * 8);
                const float rs = rsqrtf(((sv[0] + sv[1]) + (sv[2] + sv[3])) * (1.f / QL) + EPS); const int b = row / SEQ, s = row % SEQ;
#pragma unroll
                for (int bj = 0; bj < 2; ++bj) { const int cv = u.pn * BM + bj * HALF + wc * 32 + 8 * fq; const int h = cv / DQK, d = cv % DQK;
                    f32x4 v0 = acc[ai][bj][m][0] * rs, v1 = acc[ai][bj][m][1] * rs;
                    if (d >= DN) { const int i0 = (d - DN) >> 1; const f32x4 c = *(const f32x4*)(cs + (size_t)row * 64 + i0), sn = *(const f32x4*)(cs + (size_t)row * 64 + 32 + i0);
                        const f32x4 r0 = {v0[0] * c[0] - v0[1] * sn[0], v0[0] * sn[0] + v0[1] * c[0], v0[2] * c[1] - v0[3] * sn[1], v0[2] * sn[1] + v0[3] * c[1]};
                        const f32x4 r1 = {v1[0] * c[2] - v1[1] * sn[2], v1[0] * sn[2] + v1[1] * c[2], v1[2] * c[3] - v1[3] * sn[3], v1[2] * sn[3] + v1[3] * c[3]};
                        v0 = r0; v1 = r1; }
                    *(u32x4*)(Q + ((size_t)(b * NH + h) * SEQ + s) * DQK + d) = pack8(v0, v1); } }
    }
};
struct EpiKV {
    static constexpr bool PERM = true; static constexpr int MIDK = 0;
    bf16_t* Kc; bf16_t* Vc; const float* ssq;
    __device__ __forceinline__ void operator()(const Acc& acc, const Unit& u, int wr, int wc, int fr, int fq) const {
        const int row0 = u.pm * BM + wr * 64 + fr, d = wc * 32 + 8 * fq, h = u.pn;
#pragma unroll
        for (int ai = 0; ai < 2; ++ai)
#pragma unroll
            for (int m = 0; m < 4; ++m) { const int row = row0 + ai * HALF + m * 16; const f32x4 sv = *(const f32x4*)(ssq + (size_t)row * 8 + 4);
                const float rs = rsqrtf(((sv[0] + sv[1]) + (sv[2] + sv[3])) * (1.f / KVL) + EPS); const int b = row / SEQ, s = row % SEQ; const size_t t = (size_t)(b * NH + h) * SEQ + s;
                *(u32x4*)(Kc + t * DQK + d) = pack8(acc[ai][0][m][0] * rs, acc[ai][0][m][1] * rs);
                *(u32x4*)(Vc + t * DV + d) = pack8(acc[ai][1][m][0] * rs, acc[ai][1][m][1] * rs); }
    }
};
struct EpiWo {
    static constexpr bool PERM = true; static constexpr int MIDK = 8;
    const bf16_t* x; bf16_t* HBF; unsigned char* X8; const float* assq; float* ssq1; const float* gmoe;
    __device__ __forceinline__ void mid(Acc& acc, const Unit& u, int wr, int wc, int fr, int fq) const {
        const int row0 = u.pm * BM + wr * 64 + fr;
#pragma unroll
        for (int ai = 0; ai < 2; ++ai)
#pragma unroll
            for (int m = 0; m < 4; ++m) { const f32x4 sv = *(const f32x4*)(assq + (size_t)(row0 + ai * HALF + m * 16) * 4);
                const float rs = rsqrtf(((sv[0] + sv[1]) + (sv[2] + sv[3])) * (1.f / 512.f) + EPS);
#pragma unroll
                for (int bj = 0; bj < 2; ++bj)
#pragma unroll
                    for (int n = 0; n < 2; ++n) acc[ai][bj][m][n] = acc[ai][bj][m][n] * rs; }
    }
    __device__ __forceinline__ void operator()(const Acc& acc, const Unit& u, int wr, int wc, int fr, int fq) const {
        const int row0 = u.pm * BM + wr * 64 + fr, col0 = u.pn * BM + wc * 32 + 8 * fq;
        f32x4 gn[2][2];
#pragma unroll
        for (int bj = 0; bj < 2; ++bj) { gn[bj][0] = *(const f32x4*)(gmoe + col0 + bj * HALF); gn[bj][1] = *(const f32x4*)(gmoe + col0 + bj * HALF + 4); }
#pragma unroll
        for (int ai = 0; ai < 2; ++ai) { u32x4 xv[4][2];
#pragma unroll
            for (int m = 0; m < 4; ++m) { const size_t off = (size_t)(row0 + ai * HALF + m * 16) * DM + col0;
#pragma unroll
                for (int bj = 0; bj < 2; ++bj) xv[m][bj] = *(const u32x4*)(x + off + bj * HALF); }
            asm volatile("" ::: "memory");
#pragma unroll
            for (int m = 0; m < 4; ++m) { const int row = row0 + ai * HALF + m * 16; const size_t off = (size_t)row * DM + col0; float ss = 0.f;
#pragma unroll
                for (int bj = 0; bj < 2; ++bj) { const u32x4 xq = xv[m][bj]; const f32x4 h0 = (f32x4){blo(xq.x), bhi(xq.x), blo(xq.y), bhi(xq.y)} + acc[ai][bj][m][0], h1 = (f32x4){blo(xq.z), bhi(xq.z), blo(xq.w), bhi(xq.w)} + acc[ai][bj][m][1];
                    *(u32x4*)(HBF + off + bj * HALF) = pack8(h0, h1); *(u32x2*)(X8 + off + bj * HALF) = (u32x2){pk4_fp8(h0 * gn[bj][0]), pk4_fp8(h1 * gn[bj][1])}; ss += sq4(h0) + sq4(h1); }
                ss = red_fq(ss); if (fq == 0) ssq1[(size_t)row * 16 + u.pn * 4 + wc] = ss; }
            asm volatile("" ::: "memory"); }
    }
};
__device__ __forceinline__ f32x4 sigmoid4(f32x4 a) { const f32x4 t = a * -1.44269504f; f32x4 e; e[0] = __builtin_amdgcn_exp2f(t[0]); e[1] = __builtin_amdgcn_exp2f(t[1]); e[2] = __builtin_amdgcn_exp2f(t[2]); e[3] = __builtin_amdgcn_exp2f(t[3]);
    const f32x4 d = e + 1.0f; f32x4 r; r[0] = __builtin_amdgcn_rcpf(d[0]); r[1] = __builtin_amdgcn_rcpf(d[1]); r[2] = __builtin_amdgcn_rcpf(d[2]); r[3] = __builtin_amdgcn_rcpf(d[3]); return r; }
__device__ __forceinline__ f32x2 swiglu2(f32x2 g, f32x2 u) {
    g.x = fminf(g.x, 7.f); g.y = fminf(g.y, 7.f); u.x = __builtin_amdgcn_fmed3f(u.x, -7.f, 7.f); u.y = __builtin_amdgcn_fmed3f(u.y, -7.f, 7.f);
    const f32x2 t = g * -2.45546696f; f32x2 e; e.x = __builtin_amdgcn_exp2f(t.x); e.y = __builtin_amdgcn_exp2f(t.y); const f32x2 d = e + 1.0f; f32x2 r; r.x = __builtin_amdgcn_rcpf(d.x); r.y = __builtin_amdgcn_rcpf(d.y);
    const f32x2 gs = g * r; return u * gs + gs; }
__device__ __forceinline__ float swiglu_f(float g, float u) { g = fminf(g, 7.f); u = __builtin_amdgcn_fmed3f(u, -7.f, 7.f); const float gs = g * __builtin_amdgcn_rcpf(1.f + __builtin_amdgcn_exp2f(g * -2.45546696f)); return fmaf(u, gs, gs); }
constexpr float WSCALE = 64.f, WINV = 1.f / 64.f;
struct EpiMoe1 {
    static constexpr bool PERM = true; static constexpr int MIDK = 0;
    unsigned char* HB; const float* b1; const float* rowrs;
    __device__ __forceinline__ void operator()(const Acc& acc, const Unit& u, int wr, int wc, int fr, int fq) const {
        const int row0 = u.pm * BM + wr * 64 + fr, j0 = u.pn * HALF + wc * 32 + 8 * fq; const float* bg = b1 + (size_t)u.e * 2048 + j0;
        const f32x4 g0 = *(const f32x4*)bg, g1 = *(const f32x4*)(bg + 4), u0 = *(const f32x4*)(bg + 1024), u1 = *(const f32x4*)(bg + 1028);
        float rsv[2][4];
#pragma unroll
        for (int ai = 0; ai < 2; ++ai)
#pragma unroll
            for (int m = 0; m < 4; ++m) rsv[ai][m] = rowrs[row0 + ai * HALF + m * 16];
        asm volatile("" ::: "memory");
#pragma unroll
        for (int ai = 0; ai < 2; ++ai)
#pragma unroll
            for (int m = 0; m < 4; ++m) { const float rs = rsv[ai][m] * WINV;
                const f32x4 a0 = acc[ai][0][m][0] * rs + g0, a1 = acc[ai][0][m][1] * rs + g1, c0 = acc[ai][1][m][0] * rs + u0, c1 = acc[ai][1][m][1] * rs + u1; f32x4 r0, r1;
#pragma unroll
                for (int j = 0; j < 4; j += 2) { const f32x2 s0 = swiglu2((f32x2){a0[j], a0[j + 1]}, (f32x2){c0[j], c0[j + 1]}), s1 = swiglu2((f32x2){a1[j], a1[j + 1]}, (f32x2){c1[j], c1[j + 1]}); r0[j] = s0.x; r0[j + 1] = s0.y; r1[j] = s1.x; r1[j + 1] = s1.y; }
                *(u32x2*)(HB + (size_t)(row0 + ai * HALF + m * 16) * DE + j0) = (u32x2){pk4_fp8(r0), pk4_fp8(r1)}; }
    }
};
struct EpiMoe2 {
    static constexpr bool PERM = true; static constexpr int MIDK = 0;
    unsigned char* Y; const float* b2; const int* rowslot; const float* rowgate;
    __device__ __forceinline__ void operator()(const Acc& acc, const Unit& u, int wr, int wc, int fr, int fq) const {
        const int row0 = u.pm * BM + wr * 64 + fr, col0 = u.pn * BM + wc * 64 + 16 * fq; const float* bb = b2 + (size_t)u.e * DM + col0;
        f32x4 bv[2][2];
#pragma unroll
        for (int bj = 0; bj < 2; ++bj)
#pragma unroll
            for (int n = 0; n < 2; ++n) bv[bj][n] = *(const f32x4*)(bb + bj * 8 + 4 * n);
        float gtv[2][4]; int slv[2][4];
#pragma unroll
        for (int ai = 0; ai < 2; ++ai)
#pragma unroll
            for (int m = 0; m < 4; ++m) { const int r = row0 + ai * HALF + m * 16; gtv[ai][m] = rowgate[r]; slv[ai][m] = rowslot[r]; }
        asm volatile("" ::: "memory");
#pragma unroll
        for (int ai = 0; ai < 2; ++ai)
#pragma unroll
            for (int m = 0; m < 4; ++m) { const float gt = gtv[ai][m]; unsigned char* yp = Y + (size_t)slv[ai][m] * DM + col0;
                *(u32x4*)yp = (u32x4){pk4_fp8((acc[ai][0][m][0] * WINV + bv[0][0]) * gt), pk4_fp8((acc[ai][0][m][1] * WINV + bv[0][1]) * gt), pk4_fp8((acc[ai][1][m][0] * WINV + bv[1][0]) * gt), pk4_fp8((acc[ai][1][m][1] * WINV + bv[1][1]) * gt)}; }
    }
};
struct EpiPle {
    static constexpr bool PERM = true; static constexpr int MIDK = 0;
    const bf16_t* H2; bf16_t* H3; const bf16_t* pler; const float* rpv; const float* rs2; const float* pg; float* fssq;
    __device__ __forceinline__ void operator()(const Acc& acc, const Unit& u, int wr, int wc, int fr, int fq) const {
        const int row0 = u.pm * BM + wr * 64 + fr, col0 = u.pn * BM + wc * 32 + 8 * fq;
        f32x4 gv[2][2];
#pragma unroll
        for (int bj = 0; bj < 2; ++bj)
#pragma unroll
            for (int n = 0; n < 2; ++n) gv[bj][n] = *(const f32x4*)(pg + col0 + bj * HALF + n * 4);
#pragma unroll
        for (int am = 0; am < 4; ++am) { const int ai = am >> 1; u32x4 hq[2][2], pq[2][2]; float r2v[2], rpq[2];
#pragma unroll
            for (int mm = 0; mm < 2; ++mm) { const int row = row0 + ai * HALF + ((am & 1) * 2 + mm) * 16; const size_t off = (size_t)row * DM + col0; r2v[mm] = rs2[row]; rpq[mm] = rpv[row];
#pragma unroll
                for (int bj = 0; bj < 2; ++bj) { hq[mm][bj] = *(const u32x4*)(H2 + off + bj * HALF); pq[mm][bj] = *(const u32x4*)(pler + off + bj * HALF); } }
            asm volatile("" ::: "memory");
#pragma unroll
            for (int mm = 0; mm < 2; ++mm) { const int m = (am & 1) * 2 + mm; const int row = row0 + ai * HALF + m * 16; const size_t off = (size_t)row * DM + col0; const float r2 = r2v[mm], rp = rpq[mm]; float ss = 0.f;
#pragma unroll
                for (int bj = 0; bj < 2; ++bj) { const size_t o = off + bj * HALF; const u32x4 hv = hq[mm][bj], pr = pq[mm][bj];
                    const f32x4 h0 = {blo(hv.x), bhi(hv.x), blo(hv.y), bhi(hv.y)}, h1 = {blo(hv.z), bhi(hv.z), blo(hv.w), bhi(hv.w)};
                    const f32x4 q0 = {blo(pr.x), bhi(pr.x), blo(pr.y), bhi(pr.y)}, q1 = {blo(pr.z), bhi(pr.z), blo(pr.w), bhi(pr.w)};
                    const f32x4 r0 = h0 + sigmoid4(acc[ai][bj][m][0] * r2) * (q0 * (gv[bj][0] * rp)), r1 = h1 + sigmoid4(acc[ai][bj][m][1] * r2) * (q1 * (gv[bj][1] * rp));
                    *(u32x4*)(H3 + o) = pack8(r0, r1); ss += sq4(r0) + sq4(r1); }
                ss = red_fq(ss); if (fq == 0) fssq[(size_t)row * 16 + u.pn * 4 + wc] = ss; }
            asm volatile("" ::: "memory"); }
    }
};
}

namespace att {
typedef float f32x16 __attribute__((ext_vector_type(16)));
typedef short s16x4 __attribute__((ext_vector_type(4)));
constexpr int QBLK = 32, KVBLK = 64, QB = 256;
constexpr int SHM_K = KVBLK * DQK * 2, SHM_V = KVBLK * DV * 2;
constexpr int L_V = 0, L_K = 2 * SHM_V, L_WS = L_K + 2 * SHM_K, L_END = L_WS + NWAVES * 256;
constexpr float THR = 8.f;
#define KSWZ(row, colB) ((row) * 384 + ((colB) ^ (((row) & 7) << 4)))
#define SBAR() __builtin_amdgcn_sched_barrier(0)
__device__ __forceinline__ int v_st(int k, int c) { const int kk = (k & ~0xC) | ((k & 4) << 1) | ((k & 8) >> 1); return ((kk >> 3) * 4 + (c >> 5)) * 512 + ((kk & 7) * 32 + (c & 31)) * 2; }
__device__ __forceinline__ int v_rd_base(int lane) { return ((lane & 3) << 3) | (((lane >> 2) & 3) << 6) | (((lane >> 4) & 1) << 5) | (((lane >> 5) & 1) << 8); }
constexpr int v_rd_off(int d0, int ks, int half) { return d0 * 512 + ks * 4096 + half * 2048; }
__device__ __forceinline__ int crow(int r, int hi) { return (r & 3) + 8 * (r >> 2) + 4 * hi; }
typedef __bf16 bf16x2_t __attribute__((ext_vector_type(2)));
__device__ __forceinline__ unsigned cvtpk(float lo, float hi) { f32x2 v = {lo, hi}; bf16x2_t b = __builtin_convertvector(v, bf16x2_t); return __builtin_bit_cast(unsigned, b); }

__device__ __forceinline__ void qkt(f32x16& p0, f32x16& p1, const LAS unsigned char* Kbuf, int r32, int hi, const bf16x8* qr) {
    p0 = f32x16{}; p1 = f32x16{};
    const LAS unsigned char* kb[4];
#pragma unroll
    for (int dd = 0; dd < 4; ++dd) kb[dd] = Kbuf + KSWZ(r32, (dd * 16 + hi * 8) * 2);
#pragma unroll
    for (int d0 = 0; d0 < 12; ++d0) { const LAS unsigned char* a = kb[d0 & 3] + (d0 >> 2) * 128;
        const bf16x8 b0 = *(const LAS bf16x8*)a; const bf16x8 b1 = *(const LAS bf16x8*)(a + 32 * 384);
        p0 = __builtin_amdgcn_mfma_f32_32x32x16_bf16(b0, qr[d0], p0, 0, 0, 0);
        p1 = __builtin_amdgcn_mfma_f32_32x32x16_bf16(b1, qr[d0], p1, 0, 0, 0); }
}
template <int VB>
__device__ __forceinline__ void pv_tile(f32x16* o, int vb0, bf16x8 pa0, bf16x8 pa1, bf16x8 pa2, bf16x8 pa3) {
#define TRRD(dst, off) asm volatile("ds_read_b64_tr_b16 %0, %1 offset:%2" : "=&v"(dst) : "v"(vb0), "i"(off) : "memory")
#define PV_D0(d0) do { s16x4 l0, l1, l2, l3, h0, h1, h2, h3; constexpr int b_ = VB * SHM_V + v_rd_off(d0, 0, 0); \
        TRRD(l0, b_); TRRD(h0, b_ + 2048); TRRD(l1, b_ + 4096); TRRD(h1, b_ + 6144); TRRD(l2, b_ + 8192); TRRD(h2, b_ + 10240); TRRD(l3, b_ + 12288); TRRD(h3, b_ + 14336); \
        asm volatile("s_waitcnt lgkmcnt(0)" ::: "memory"); SBAR(); \
        o[d0] = __builtin_amdgcn_mfma_f32_32x32x16_bf16(pa0, (bf16x8){l0[0], l0[1], l0[2], l0[3], h0[0], h0[1], h0[2], h0[3]}, o[d0], 0, 0, 0); \
        o[d0] = __builtin_amdgcn_mfma_f32_32x32x16_bf16(pa1, (bf16x8){l1[0], l1[1], l1[2], l1[3], h1[0], h1[1], h1[2], h1[3]}, o[d0], 0, 0, 0); \
        o[d0] = __builtin_amdgcn_mfma_f32_32x32x16_bf16(pa2, (bf16x8){l2[0], l2[1], l2[2], l2[3], h2[0], h2[1], h2[2], h2[3]}, o[d0], 0, 0, 0); \
        o[d0] = __builtin_amdgcn_mfma_f32_32x32x16_bf16(pa3, (bf16x8){l3[0], l3[1], l3[2], l3[3], h3[0], h3[1], h3[2], h3[3]}, o[d0], 0, 0, 0); } while (0)
    PV_D0(0); PV_D0(1); PV_D0(2); PV_D0(3);
#undef PV_D0
#undef TRRD
}
struct ConvJob { const float* w1; const float* w2; const float* gain; unsigned char* W1T; unsigned char* W2T; int gw, ngw; };
constexpr int CV_N1 = NE * 32 * 64, CV_N2 = NE * 32 * 32, CV_TOTAL = CV_N1 + CV_N2;
__device__ __forceinline__ int cv_cmap2(int n) { const int t = n & ~255, v = n & 255; return t + 64 * ((v >> 5) & 3) + 16 * ((v >> 3) & 3) + 8 * (v >> 7) + (v & 7); }
__device__ __forceinline__ int cv_cmap1(int n) { const int pn = n >> 8, half = (n >> 7) & 1, jj = n & 127; return half * 1024 + pn * 128 + jj; }
#define CV_DECODE(idx) \
    const bool cv_on = (idx) < CV_TOTAL; const bool cv_is1 = (idx) < CV_N1; const int cv_r = cv_is1 ? (idx) : (idx) - CV_N1; \
    const int cv_nblk = cv_is1 ? 64 : 32, cv_ld = cv_is1 ? 2048 : 1024; const int cv_e = cv_r / (32 * cv_nblk), cv_q = cv_r % (32 * cv_nblk), cv_k0 = 32 * (cv_q / cv_nblk), cv_n0 = 32 * (cv_q % cv_nblk); \
    const float* cv_src = (cv_is1 ? cj.w1 + (size_t)cv_e * 1024 * 2048 : cj.w2 + (size_t)cv_e * 1024 * 1024); \
    const int cv_c = cv_is1 ? cv_cmap1(cv_n0 + (lane & 31)) : cv_cmap2(cv_n0 + (lane & 31));
#define CV_LOAD() do { if (cv_on) { _Pragma("unroll") for (int i = 0; i < 16; ++i) cvw[i] = cv_src[(size_t)(cv_k0 + 2 * i + hi) * cv_ld + cv_c]; } } while (0)
#define CV_STORE() do { if (cv_on) { LAS float* scr = (LAS float*)(lds + L_END) + wid * (32 * 33); \
        _Pragma("unroll") for (int i = 0; i < 16; ++i) { const int kk = 2 * i + hi; scr[kk * 33 + (lane & 31)] = cvw[i] * 64.f; } \
        asm volatile("s_waitcnt lgkmcnt(0)" ::: "memory"); \
        { const int n = lane >> 1, cc = lane & 1; const LAS float* s = scr + (16 * cc) * 33 + n; u32x4 o; \
          o.x = pg8::pk4_fp8((f32x4){s[0 * 33], s[1 * 33], s[2 * 33], s[3 * 33]}); o.y = pg8::pk4_fp8((f32x4){s[4 * 33], s[5 * 33], s[6 * 33], s[7 * 33]}); \
          o.z = pg8::pk4_fp8((f32x4){s[8 * 33], s[9 * 33], s[10 * 33], s[11 * 33]}); o.w = pg8::pk4_fp8((f32x4){s[12 * 33], s[13 * 33], s[14 * 33], s[15 * 33]}); \
          unsigned char* dst = (cv_is1 ? cj.W1T + (size_t)cv_e * 2048 * 1024 : cj.W2T + (size_t)cv_e * 1024 * 1024) + (size_t)(cv_n0 + n) * 1024 + cv_k0 + 16 * cc; *(u32x4*)dst = o; } \
        asm volatile("s_waitcnt lgkmcnt(0)" ::: "memory"); } } while (0)
__device__ __forceinline__ void attn_block(int bh, int qb, const bf16_t* __restrict__ Q, const bf16_t* __restrict__ K, const bf16_t* __restrict__ V, bf16_t* __restrict__ MIX, float* __restrict__ ASSQ, LAS unsigned char* lds, const int wid, const ConvJob& cj, int& tseq) {
    const int lane = lane_id(), r32 = lane & 31, hi = lane >> 5;
    const int b = bh / NH, h = bh % NH;
    const bf16_t* Qw = Q + ((size_t)bh * SEQ + qb * QB + wid * QBLK + r32) * DQK;
    const bf16_t* Kh = K + (size_t)bh * SEQ * DQK; const bf16_t* Vh = V + (size_t)bh * SEQ * DV;
    bf16x8 qr[12];
#pragma unroll
    for (int d0 = 0; d0 < 12; ++d0) qr[d0] = *(const bf16x8*)(Qw + d0 * 16 + hi * 8);
    const int NT = 4 * qb + 4, qlo = qb * QB + wid * QBLK, qm = qlo + r32 - 4 * hi;
    LAS unsigned char* V_lds = lds + L_V; LAS unsigned char* K_lds = lds + L_K;
    LAS float* wsf = (LAS float*)(lds + L_WS) + wid * 64; LAS float* li_l = wsf; LAS float* al_l = wsf + 32;
    unsigned ksrc[3], vsrc[2];
#pragma unroll
    for (int i = 0; i < 3; ++i) { const int off = ((wid + 8 * i) * 64 + lane) * 16, row = off / 384, wb = off % 384, seg = wb >> 7, cpos = (wb & 127) >> 4; ksrc[i] = (unsigned)(row * 384 + seg * 128 + ((cpos ^ (row & 7)) << 4)); }
#pragma unroll
    for (int i = 0; i < 2; ++i) { const int off = ((wid + 8 * i) * 64 + lane) * 16, st = off >> 9, o_ = off & 511, kk = (st >> 2) * 8 + (o_ >> 6), c = (st & 3) * 32 + ((o_ & 63) >> 1);
        const int k = (kk & ~0xC) | ((kk & 4) << 1) | ((kk & 8) >> 1); vsrc[i] = (unsigned)(k * 256 + c * 2); }
    const int vb0 = (int)(unsigned)(uintptr_t)V_lds + v_rd_base(lane);
#define ADMA(t, bf) do { const char* kp = (const char*)(Kh + (size_t)(t) * KVBLK * DQK); const char* vp = (const char*)(Vh + (size_t)(t) * KVBLK * DV); \
        _Pragma("unroll") for (int i = 0; i < 3; ++i) __builtin_amdgcn_global_load_lds((const unsigned*)(kp + ksrc[i]), (LAS unsigned*)(K_lds + (bf) * SHM_K + (wid + 8 * i) * 1024), 16, 0, 0); \
        _Pragma("unroll") for (int i = 0; i < 2; ++i) __builtin_amdgcn_global_load_lds((const unsigned*)(vp + vsrc[i]), (LAS unsigned*)(V_lds + (bf) * SHM_V + (wid + 8 * i) * 1024), 16, 0, 0); } while (0)
    float m_reg = -1e30f, l_reg = 0.f; f32x16 o[4] = {}; float cvw[16]; int cv_pend = -1;
    ADMA(0, 0);
#define TILE(t, BF) do { \
        asm volatile("s_waitcnt vmcnt(0)" ::: "memory"); __syncthreads(); \
        if ((t) + 1 < NT) ADMA((t) + 1, (BF) ^ 1); \
        if (cv_pend >= 0) { CV_DECODE(cv_pend) CV_STORE(); }     \
        { const int cv_idx = tseq * cj.ngw + cj.gw; ++tseq; CV_DECODE(cv_idx) CV_LOAD(); cv_pend = cv_on ? cv_idx : -1; } SBAR(); \
        const int kb_ = (t) * KVBLK; \
        if (kb_ <= qlo + QBLK - 1) { \
            f32x16 p0, p1; SBAR(); qkt(p0, p1, K_lds + (BF) * SHM_K, r32, hi, qr); \
            if (kb_ + KVBLK - 1 > qlo) { const int dq = qm - kb_; const float NEG = -__builtin_inff(); \
                _Pragma("unroll") for (int r = 0; r < 16; ++r) { const int c = (r & 3) + 8 * (r >> 2); if (c > dq) p0[r] = NEG; if (c + 32 > dq) p1[r] = NEG; } } \
            float pmax = p0[0]; _Pragma("unroll") for (int r = 1; r < 16; ++r) pmax = fmaxf(pmax, p0[r]); _Pragma("unroll") for (int r = 0; r < 16; ++r) pmax = fmaxf(pmax, p1[r]); \
            { auto rr = __builtin_amdgcn_permlane32_swap(__float_as_uint(pmax), __float_as_uint(pmax), false, false); pmax = fmaxf(__uint_as_float(rr[0]), __uint_as_float(rr[1])); } \
            if (!__all(pmax - m_reg <= THR)) { const float mn = fmaxf(m_reg, pmax); const float alpha = __builtin_amdgcn_exp2f(m_reg - mn); m_reg = mn; l_reg *= alpha; \
                if (hi == 0) al_l[r32] = alpha; asm volatile("s_waitcnt lgkmcnt(0)" ::: "memory"); \
                _Pragma("unroll") for (int d_ = 0; d_ < 4; ++d_) _Pragma("unroll") for (int r = 0; r < 16; ++r) o[d_][r] *= al_l[crow(r, hi)]; } \
            float ps = 0.f; \
            _Pragma("unroll") for (int r = 0; r < 16; ++r) { p0[r] = __builtin_amdgcn_exp2f(p0[r] - m_reg); p1[r] = __builtin_amdgcn_exp2f(p1[r] - m_reg); } \
            _Pragma("unroll") for (int r = 0; r < 16; ++r) ps += p0[r] + p1[r]; \
            { auto rr = __builtin_amdgcn_permlane32_swap(__float_as_uint(ps), __float_as_uint(ps), false, false); ps = __uint_as_float(rr[0]) + __uint_as_float(rr[1]); } \
            l_reg += ps; \
            bf16x8 pa0, pa1, pa2, pa3; \
            PK4(p0, 0, pa0); PK4(p0, 8, pa1); PK4(p1, 0, pa2); PK4(p1, 8, pa3); \
            SBAR(); pv_tile<BF>(o, vb0, pa0, pa1, pa2, pa3); } \
        } while (0)
#define PK4(P, B_, OUT) do { unsigned a0 = cvtpk(P[B_ + 0], P[B_ + 1]), a1 = cvtpk(P[B_ + 2], P[B_ + 3]); \
        unsigned b0 = cvtpk(P[B_ + 4], P[B_ + 5]), b1 = cvtpk(P[B_ + 6], P[B_ + 7]); \
        auto r0 = __builtin_amdgcn_permlane32_swap(a0, b0, false, false); auto r1 = __builtin_amdgcn_permlane32_swap(a1, b1, false, false); \
        u32x4 w = {r0[0], r1[0], r0[1], r1[1]}; OUT = __builtin_bit_cast(bf16x8, w); } while (0)
    for (int t = 0; t < NT; t += 2) { TILE(t, 0); TILE(t + 1, 1); }
#undef PK4
#undef TILE
#undef ADMA
    if (cv_pend >= 0) { asm volatile("s_waitcnt vmcnt(0)" ::: "memory"); CV_DECODE(cv_pend) CV_STORE(); }
    if (hi == 0) li_l[r32] = l_reg;
    asm volatile("s_waitcnt vmcnt(0) lgkmcnt(0)" ::: "memory");
    float rli[16];
#pragma unroll
    for (int r = 0; r < 16; ++r) rli[r] = __builtin_amdgcn_rcpf(li_l[crow(r, hi)]);
    __syncthreads();
    LAS bf16_t* stg = (LAS bf16_t*)(lds + wid * 8192);
#pragma unroll
    for (int r = 0; r < 16; ++r) { const int orow = crow(r, hi);
#pragma unroll
        for (int d0 = 0; d0 < 4; ++d0) stg[orow * 128 + d0 * 32 + r32] = f2bf(o[d0][r] * rli[r]); }
    asm volatile("s_waitcnt lgkmcnt(0)" ::: "memory");
    const size_t row0 = (size_t)b * SEQ + qb * QB + wid * QBLK;
#pragma unroll
    for (int i = 0; i < 8; ++i) { const int row = i * 4 + (lane >> 4), ch = lane & 15; const u32x4 v = *(const LAS u32x4*)(stg + row * 128 + ch * 8);
        float ss = (blo(v.x) * blo(v.x) + bhi(v.x) * bhi(v.x)) + (blo(v.y) * blo(v.y) + bhi(v.y) * bhi(v.y)) + (blo(v.z) * blo(v.z) + bhi(v.z) * bhi(v.z)) + (blo(v.w) * blo(v.w) + bhi(v.w) * bhi(v.w));
        ss += __shfl_xor(ss, 1); ss += __shfl_xor(ss, 2); ss += __shfl_xor(ss, 4); ss += __shfl_xor(ss, 8);
        *(u32x4*)(MIX + (row0 + row) * DM + h * DV + ch * 8) = v;
        if (ch == 0) ASSQ[(row0 + row) * 4 + h] = ss; }
    __syncthreads();
}
#undef KSWZ
#undef SBAR
}

struct Args { const void* in[25]; float* out; unsigned char* ws; int ph_lo, ph_hi, li, skip; };
enum { PH_PREP = 0, PH_INPROJ, PH_TOKLOCAL, PH_ATTN, PH_WO, PH_ROUTER, PH_ROUTE, PH_MOE1, PH_MOE2, PH_COMBINE, PH_PLE, PH_FINAL, PH_COUNT };

template <int MODE> __device__ __forceinline__ int cmap_col(int n) {
    if (MODE == 1) { const int pn = n >> 8, half = (n >> 7) & 1, jj = n & 127; return half * 1024 + pn * 128 + jj; }
    if (MODE == 2) { const int h = n / DQK, d = n % DQK; if (d < DN) return n; const int t = d - DN; return h * DQK + DN + (t & 1) * 32 + (t >> 1); }
    return n;
}
template <int MODE> __device__ __forceinline__ void transpose_item_fp8(const float* __restrict__ W, int ldsrc, int nblk, unsigned char* __restrict__ WT, int ldd, const float* __restrict__ gain, float scale,
                                                                      LAS float* scr, int item, int lane) {
    const int kb = item / nblk, nb = item % nblk, k0 = 64 * kb, n0 = 32 * nb; const int c = cmap_col<MODE>(n0 + (lane & 31));
    float wv[32];
#pragma unroll
    for (int i = 0; i < 32; ++i) wv[i] = W[(size_t)(k0 + 2 * i + (lane >> 5)) * ldsrc + c];
#pragma unroll
    for (int i = 0; i < 32; ++i) { const int kk = 2 * i + (lane >> 5), k = k0 + kk; float gk = scale; if (gain) gk *= gain[k]; scr[kk * 33 + (lane & 31)] = wv[i] * gk; }
    asm volatile("s_waitcnt lgkmcnt(0)" ::: "memory");
    const int cc = lane & 3;
#pragma unroll
    for (int j = 0; j < 2; ++j) { const int n = (lane >> 2) + 16 * j; const LAS float* s = scr + (16 * cc) * 33 + n; u32x4 o;
        o.x = pg8::pk4_fp8((f32x4){s[0 * 33], s[1 * 33], s[2 * 33], s[3 * 33]}); o.y = pg8::pk4_fp8((f32x4){s[4 * 33], s[5 * 33], s[6 * 33], s[7 * 33]});
        o.z = pg8::pk4_fp8((f32x4){s[8 * 33], s[9 * 33], s[10 * 33], s[11 * 33]}); o.w = pg8::pk4_fp8((f32x4){s[12 * 33], s[13 * 33], s[14 * 33], s[15 * 33]});
        *(u32x4*)(WT + (size_t)(n0 + n) * ldd + k0 + 16 * cc) = o; }
    asm volatile("s_waitcnt lgkmcnt(0)" ::: "memory");
}
template <int MODE> __device__ __forceinline__ void transpose_item(const float* __restrict__ W, int ldsrc, int nblk, bf16_t* __restrict__ WT, int ldd, const float* __restrict__ gain, const float* __restrict__ gain2, float scale,
                                                                  LAS float* scr, int item, int lane) {
    const int kb = item / nblk, nb = item % nblk, k0 = 64 * kb, n0 = 32 * nb; const int c = cmap_col<MODE>(n0 + (lane & 31));
    float wv[32], gq[32];
#pragma unroll
    for (int i = 0; i < 32; ++i) wv[i] = W[(size_t)(k0 + 2 * i + (lane >> 5)) * ldsrc + c];
#pragma unroll
    for (int i = 0; i < 32; ++i) { const int k = k0 + 2 * i + (lane >> 5); gq[i] = gain ? ((gain2 && k >= 512) ? gain2[k - 512] : gain[k]) : 1.f; }
    asm volatile("" ::: "memory");
#pragma unroll
    for (int i = 0; i < 32; ++i) { const int kk = 2 * i + (lane >> 5); scr[kk * 33 + (lane & 31)] = wv[i] * (gq[i] * scale); }
    asm volatile("s_waitcnt lgkmcnt(0)" ::: "memory");
    const int cc = lane & 7;
#pragma unroll
    for (int j = 0; j < 4; ++j) { const int n = (lane >> 3) + 8 * j; const LAS float* s = scr + (8 * cc) * 33 + n;
        u32x4 o; o.x = pk2(s[0 * 33], s[1 * 33]); o.y = pk2(s[2 * 33], s[3 * 33]); o.z = pk2(s[4 * 33], s[5 * 33]); o.w = pk2(s[6 * 33], s[7 * 33]);
        *(u32x4*)(WT + (size_t)(n0 + n) * ldd + k0 + 8 * cc) = o; }
    asm volatile("s_waitcnt lgkmcnt(0)" ::: "memory");
}

__global__ void __launch_bounds__(NTHREADS, 2) fwd(Args args) {
    extern __shared__ __attribute__((aligned(16))) unsigned char lds_raw[];
    LAS unsigned char* lds = (LAS unsigned char*)lds_raw;
    volatile LAS unsigned* MISC = (volatile LAS unsigned*)(lds + MISC_OFF);
    const int wave = __builtin_amdgcn_readfirstlane(threadIdx.x >> 6);
    const int G = gridDim.x, bx = blockIdx.x;
#define PHASE_LANE const int lane = lane_id(); const int tid = wave * 64 + lane; (void)tid
    const int gw = bx * NWAVES + wave, NGW = G * NWAVES;
    unsigned char* ws = args.ws; int* ctl = (int*)(ws + WS_CTL); float* H = args.out;
    const float* x = (const float*)args.in[0]; const float* p = (const float*)args.in[1]; const int* pos = (const int*)args.in[2];
    const float *mix_norm = (const float*)args.in[3], *w_in = (const float*)args.in[4], *q_norm = (const float*)args.in[5], *w_uq = (const float*)args.in[6], *kv_norm = (const float*)args.in[7],
                *w_ukv = (const float*)args.in[8], *attn_out_norm = (const float*)args.in[10], *conv_out_norm = (const float*)args.in[11], *w_o = (const float*)args.in[12],
                *moe_norm = (const float*)args.in[13], *w_router = (const float*)args.in[14], *w1 = (const float*)args.in[16], *b1 = (const float*)args.in[17],
                *w2 = (const float*)args.in[18], *b2 = (const float*)args.in[19], *ple_norm = (const float*)args.in[20], *w_ple_gate = (const float*)args.in[21], *w_ple_proj = (const float*)args.in[22],
                *ple_post_norm = (const float*)args.in[23], *conv_w = (const float*)args.in[9], *b_router = (const float*)args.in[15], *final_norm = (const float*)args.in[24];
    int* TOPI = (int*)(ws + WS_TOPI); float* TOPG = (float*)(ws + WS_TOPG);
    bf16_t *HBF = (bf16_t*)(ws + WS_HBF), *H3 = (bf16_t*)(ws + WS_H3), *WRHL = (bf16_t*)(ws + WS_WRHL); unsigned char* X8 = (unsigned char*)(ws + WS_K);
    float* RSX = (float*)(ws + WS_RSX);
    float *SSQ1 = (float*)(ws + WS_SSQ1), *RS1 = (float*)(ws + WS_RS1), *RS2 = (float*)(ws + WS_RS2), *ROWRS = (float*)(ws + WS_ROWRS);
    bf16_t *WIN = (bf16_t*)(ws + WS_WIN), *WUQ = (bf16_t*)(ws + WS_WUQ), *WUKV = (bf16_t*)(ws + WS_WUKV), *WO = (bf16_t*)(ws + WS_WO), *WG = (bf16_t*)(ws + WS_WG), *WP = (bf16_t*)(ws + WS_WP);
    bf16_t *W1T = (bf16_t*)(ws + WS_W1), *W2T = (bf16_t*)(ws + WS_W2), *XN = (bf16_t*)(ws + WS_XN), *MIX = (bf16_t*)(ws + WS_MIX), *PLER = (bf16_t*)(ws + WS_PLER);
    bf16_t *Z = (bf16_t*)(ws + WS_Z), *Qb = (bf16_t*)(ws + WS_Q), *Kb = (bf16_t*)(ws + WS_K), *Vb = (bf16_t*)(ws + WS_V), *HB = (bf16_t*)(ws + WS_HB), *Y = (bf16_t*)(ws + WS_Y), *P16 = (bf16_t*)(ws + WS_P16);
    float *WR = (float*)(ws + WS_WR), *CS = (float*)(ws + WS_CS), *SSQ = (float*)(ws + WS_SSQ), *ASSQ = (float*)(ws + WS_ASSQ), *PSSQ = (float*)(ws + WS_PSSQ), *FSSQ = (float*)(ws + WS_FSSQ);
    int *ROWTOK = (int*)(ws + WS_ROWTOK), *ROWSLOT = (int*)(ws + WS_ROWSLOT); float* ROWGATE = (float*)(ws + WS_ROWGATE);

    { PHASE_LANE; for (int u = tid; u < (LDS_BYTES - MISC_OFF) / 4; u += NTHREADS) ((LAS unsigned*)(lds + MISC_OFF))[u] = 0u; }
    __syncthreads();
    const int lo = args.ph_lo, hi = args.ph_hi;
    XcdBarrier bar; bar.bar = (unsigned*)ctl + CW_BAR + args.li * XCD_BAR_WORDS; bar.x = 0; bar.st = MISC + 8;
    if (hi - lo > 1) bar = xcd_barrier_post((unsigned*)ctl + CW_BAR + args.li * XCD_BAR_WORDS, MISC + 8, wave);
#define IN(k) (lo <= (k) && (k) < hi)
#define NREP(k) ((PROBE_PH == (k)) ? PROBE_REP : 1)
#define REPLOOP(k) for (int rep = 0; rep < NREP(k); ++rep)
#define LASTREP(k) (rep == NREP(k) - 1)
#ifdef PROBE_TIME_PH
#define STAMP(k) do { if (bx == 0 && wave == 0) MISC[32 + (k)] = (unsigned)__builtin_amdgcn_s_memrealtime(); } while (0)
#else
#define STAMP(k) do { } while (0)
#endif
#define SEAM(k) do { if (IN(k) && IN((k) + 1)) xcd_barrier(bar, wave); STAMP((k) + 1); } while (0)
    STAMP(0);

    if (IN(PH_PREP)) REPLOOP(PH_PREP) {
        PHASE_LANE;
        LAS float* scr = (LAS float*)(lds + wave * 16384);
        constexpr int I_IN = (DM / 64) * (INW / 32), I_UQ = (QL / 64) * (768 / 32), I_UKV = (KVL / 64) * (1024 / 32), I_O = (DM / 64) * (DM / 32), I_G = I_O, I_P = (PLE / 64) * (DM / 32);
        constexpr int I_1 = (DM / 64) * (2048 / 32), I_2 = (DE / 64) * (DM / 32);
        constexpr int NITEMS = I_IN + I_UQ + I_UKV + I_O + I_G + I_P;
        for (int it = gw; it < NITEMS; it += NGW) {
            int r = it;
            if (r < I_IN) { transpose_item<0>(w_in, INW, INW / 32, WIN, DM, mix_norm, nullptr, 1.f, scr, r, lane); continue; } r -= I_IN;
            if (r < I_UQ) { transpose_item<2>(w_uq, 768, 768 / 32, WUQ, QL, q_norm, nullptr, QSCALE, scr, r, lane); continue; } r -= I_UQ;
            if (r < I_UKV) { transpose_item<0>(w_ukv, 1024, 1024 / 32, WUKV, 256, kv_norm, nullptr, 1.f, scr, r, lane); continue; } r -= I_UKV;
            if (r < I_O) { transpose_item<0>(w_o, DM, DM / 32, WO, DM, attn_out_norm, conv_out_norm, 1.f, scr, r, lane); continue; } r -= I_O;
            if (r < I_G) { transpose_item<0>(w_ple_gate, DM, DM / 32, WG, DM, ple_norm, nullptr, 1.f, scr, r, lane); continue; } r -= I_G;
            transpose_item<0>(w_ple_proj, DM, DM / 32, WP, PLE, nullptr, nullptr, 1.f, scr, r, lane);
        }
        for (int i = bx * NTHREADS + tid; i < 1024 * 16; i += G * NTHREADS) *(u32x4*)(WUKV + (size_t)(i >> 4) * 256 + 128 + (i & 15) * 8) = (u32x4){0u, 0u, 0u, 0u};
        for (int i = bx * NTHREADS + tid; i < DM * NE; i += G * NTHREADS) { const int e = i >> 10, k = i & 1023; const float w = w_router[k * NE + e] * moe_norm[k]; const bf16_t whi = f2bf(w);
            WRHL[i] = whi; WRHL[DM * NE + i] = f2bf(w - bf2f(whi)); }
        for (int i = bx * NTHREADS + tid; i < NTOK * 32; i += G * NTHREADS) { const int t = i >> 5, j = i & 31; const float inv = powf(10000.f, -(float)j / 32.f); const float a = (float)pos[t] * inv; float sn, c; sincosf(a, &sn, &c);
            CS[(size_t)t * 64 + j] = c; CS[(size_t)t * 64 + 32 + j] = sn; }
        for (int i = bx * NTHREADS + tid; i < NTOK * PLE / 4; i += 4 * G * NTHREADS) { f32x4 v[4];
#pragma unroll
            for (int q = 0; q < 4; ++q) { const int ii = i + q * G * NTHREADS; v[q] = ii < NTOK * PLE / 4 ? ((const f32x4*)p)[ii] : (f32x4){0.f, 0.f, 0.f, 0.f}; }
#pragma unroll
            for (int q = 0; q < 4; ++q) { const int ii = i + q * G * NTHREADS; if (ii < NTOK * PLE / 4) ((u32x2*)P16)[ii] = (u32x2){pk2(v[q][0], v[q][1]), pk2(v[q][2], v[q][3])}; } }
        for (int row = gw * 4; row < NTOK; row += NGW * 4) {
            f32x4 v[4][4]; float ss[4];
#pragma unroll
            for (int q = 0; q < 4; ++q) { const f32x4* s = (const f32x4*)(x + (size_t)(row + q) * DM);
#pragma unroll
                for (int j = 0; j < 4; ++j) v[q][j] = s[lane + 64 * j]; }
#pragma unroll
            for (int q = 0; q < 4; ++q) { ss[q] = 0.f;
#pragma unroll
                for (int j = 0; j < 4; ++j) ss[q] += pg8::sq4(v[q][j]); }
#pragma unroll
            for (int q = 0; q < 4; ++q) { const float rstd = rsqrtf(wave_sum(ss[q]) * (1.f / DM) + EPS); u32x2* d = (u32x2*)(XN + (size_t)(row + q) * DM); if (lane == 0) RSX[row + q] = rstd;
#pragma unroll
                for (int j = 0; j < 4; ++j) d[lane + 64 * j] = (u32x2){pk2(v[q][j][0], v[q][j][1]), pk2(v[q][j][2], v[q][j][3])}; }
        }
    }
    SEAM(PH_PREP);
    if (IN(PH_INPROJ)) REPLOOP(PH_INPROJ) {
        { pg8::Gemm g{XN, WIN, DM, DM, DM, nullptr, 0}; pg8::StaticOrder S; S.init(NTOK / 256, INWP / 256, G, bx, nullptr);
          pg8::EpiBf16Stats<0> E{Z, INWP, SSQ, RSX}; pg8::gemm_phase<pg8::EpiBf16Stats<0>, false>(lds, g, S, E, wave); }
        { pg8::Gemm g{P16, WP, PLE, PLE, PLE, nullptr, 0}; pg8::StaticOrder S; S.init(NTOK / 256, DM / 256, G, bx, nullptr);
          pg8::EpiBf16Stats<1> E{PLER, DM, PSSQ, nullptr}; pg8::gemm_phase<pg8::EpiBf16Stats<1>, false>(lds, g, S, E, wave); }
    }
    SEAM(PH_INPROJ);
    if (IN(PH_TOKLOCAL)) REPLOOP(PH_TOKLOCAL) {
        PHASE_LANE;
        if (!(args.skip & 1)) for (int r0 = gw * 16; r0 < NTOK; r0 += NGW * 16) {
            const int c8 = lane * 8; f32x4 w0[2], w1[2], w2[2];
#pragma unroll
            for (int q = 0; q < 2; ++q) { w0[q] = *(const f32x4*)(conv_w + c8 + 4 * q); w1[q] = *(const f32x4*)(conv_w + 512 + c8 + 4 * q); w2[q] = *(const f32x4*)(conv_w + 1024 + c8 + 4 * q); }
            f32x4 u1[2] = {}, u2[2] = {};
            if ((r0 % SEQ) != 0) {
#pragma unroll
                for (int p = 1; p <= 2; ++p) { const bf16_t* zp = Z + (size_t)(r0 - p) * INWP; const u32x4 cg = *(const u32x4*)(zp + 960 + c8), vv = *(const u32x4*)(zp + 1472 + c8);
                    const f32x4 a = (f32x4){blo(cg.x), bhi(cg.x), blo(cg.y), bhi(cg.y)} * (f32x4){blo(vv.x), bhi(vv.x), blo(vv.y), bhi(vv.y)}, b = (f32x4){blo(cg.z), bhi(cg.z), blo(cg.w), bhi(cg.w)} * (f32x4){blo(vv.z), bhi(vv.z), blo(vv.w), bhi(vv.w)};
                    if (p == 1) { u1[0] = a; u1[1] = b; } else { u2[0] = a; u2[1] = b; } } }
#pragma unroll 4
            for (int rr = 0; rr < 16; ++rr) { const int row = r0 + rr; const bf16_t* z = Z + (size_t)row * INWP; const int s = row % SEQ, b = row / SEQ;
                const u32x4 bg = *(const u32x4*)(z + 448 + c8), cg = *(const u32x4*)(z + 960 + c8), vv = *(const u32x4*)(z + 1472 + c8);
                if (lane < 32) { const float x1 = bf2f(z[384 + lane]), x2 = bf2f(z[416 + lane]); const float c = CS[(size_t)row * 64 + lane], sn = CS[(size_t)row * 64 + 32 + lane];
                    const unsigned o = pk2(x1 * c - x2 * sn, x1 * sn + x2 * c);
#pragma unroll
                    for (int h = 0; h < NH; ++h) *(unsigned*)(Kb + ((size_t)(b * NH + h) * SEQ + s) * DQK + DN + 2 * lane) = o; }
                f32x4 u0[2]; u0[0] = (f32x4){blo(cg.x), bhi(cg.x), blo(cg.y), bhi(cg.y)} * (f32x4){blo(vv.x), bhi(vv.x), blo(vv.y), bhi(vv.y)}; u0[1] = (f32x4){blo(cg.z), bhi(cg.z), blo(cg.w), bhi(cg.w)} * (f32x4){blo(vv.z), bhi(vv.z), blo(vv.w), bhi(vv.w)};
                f32x4 y[2]; y[0] = (f32x4){blo(bg.x), bhi(bg.x), blo(bg.y), bhi(bg.y)} * (w0[0] * u2[0] + w1[0] * u1[0] + w2[0] * u0[0]); y[1] = (f32x4){blo(bg.z), bhi(bg.z), blo(bg.w), bhi(bg.w)} * (w0[1] * u2[1] + w1[1] * u1[1] + w2[1] * u0[1]);
                const float rstd = rsqrtf(wave_sum(pg8::sq4(y[0]) + pg8::sq4(y[1])) * (1.f / 512.f) + EPS);
                *(u32x4*)(MIX + (size_t)row * DM + 512 + c8) = pg8::pack8(y[0] * rstd, y[1] * rstd);
                u2[0] = u1[0]; u2[1] = u1[1]; u1[0] = u0[0]; u1[1] = u0[1]; }
        }
        { pg8::Gemm g{Z, WUQ, QL, INWP, QL, nullptr, 0}; pg8::StaticOrder S; S.init(NTOK / 256, 768 / 256, G, bx, nullptr);
          pg8::EpiQ E{Qb, SSQ, CS}; pg8::gemm_phase<pg8::EpiQ, false>(lds, g, S, E, wave); }
        { pg8::Gemm g{Z + 256, WUKV, 256, INWP, 256, nullptr, 0}; pg8::StaticOrder S; S.init(NTOK / 256, 1024 / 256, G, bx, nullptr);
          pg8::EpiKV E{Kb, Vb, SSQ}; pg8::gemm_phase<pg8::EpiKV, false>(lds, g, S, E, wave); }
    }
    SEAM(PH_TOKLOCAL);
    if (IN(PH_ATTN)) REPLOOP(PH_ATTN) {
        const int vcu = (G % 8 == 0) ? (bx % 8) * (G / 8) + bx / 8 : bx;
        using att::L_END; using att::cv_cmap1; using att::cv_cmap2; using att::CV_N1; using att::CV_TOTAL;
        const att::ConvJob cj{w1, w2, moe_norm, (unsigned char*)W1T, (unsigned char*)W2T, gw, NGW}; int tseq = LASTREP(PH_ATTN) ? 0 : (1 << 20);
        for (int it = vcu; it < NB * NH * 8; it += G) { const int bh = it >> 3, pr = it & 7;
            for (int pass = 0; pass < 2; ++pass) att::attn_block(bh, pass ? pr : 15 - pr, Qb, Kb, Vb, MIX, ASSQ, lds, wave, cj, tseq); }
        if (LASTREP(PH_ATTN)) { const int lane = lane_id(), hi = lane >> 5, wid = wave; __syncthreads();
            for (int cv_idx = tseq * NGW + gw; cv_idx < att::CV_TOTAL; cv_idx += NGW) { CV_DECODE(cv_idx) float cvw[16]; CV_LOAD(); CV_STORE(); } }
    }
    SEAM(PH_ATTN);
    if (IN(PH_WO)) REPLOOP(PH_WO) {
        pg8::Gemm g{MIX, WO, DM, DM, DM, nullptr, 0}; pg8::StaticOrder S; S.init(NTOK / 256, DM / 256, G, bx, nullptr);
        pg8::EpiWo E{XN, HBF, X8, ASSQ, SSQ1, moe_norm}; pg8::gemm_phase<pg8::EpiWo, false>(lds, g, S, E, wave, LASTREP(PH_WO));
    }
    SEAM(PH_WO);
    if (IN(PH_ROUTER)) REPLOOP(PH_ROUTER) {
        PHASE_LANE;
        typedef float f32x16 __attribute__((ext_vector_type(16)));
        LAS int* hist = (LAS int*)(lds + HIST_OFF); LAS f32x16* xch = (LAS f32x16*)(lds + HIST_OFF + 256);
        for (int i = tid; i < 2 * NE * 128; i += NTHREADS) { const int pe = i >> 7, kc = i & 127, e = pe & 31; *(LAS u32x4*)(lds + pe * 2048 + ((kc ^ (e & 15)) << 4)) = ((const u32x4*)WRHL)[i]; }
        if (tid < NE) hist[tid] = 0;
        __syncthreads();
        for (int chunk = bx; chunk < NTOK / 128; chunk += G) {
            const int base = chunk * 128, wq = wave & 3, kh = wave >> 2;
            const int j = lane & 31, half = lane >> 5, tok = base + wq * 32 + j;
            const bf16_t* xr = HBF + (size_t)tok * DM + kh * 512 + 8 * half; const LAS unsigned char* wrow = lds + j * 2048;
            f32x16 acc = {};
#pragma unroll 8
            for (int s = 0; s < 32; ++s) { const bf16x8 xb = *(const bf16x8*)(xr + 16 * s); const int kc = ((kh * 64 + 2 * s + half) ^ (j & 15)) << 4;
                const bf16x8 ah = *(const LAS bf16x8*)(wrow + kc), al = *(const LAS bf16x8*)(wrow + 65536 + kc);
                acc = __builtin_amdgcn_mfma_f32_32x32x16_bf16(ah, xb, acc, 0, 0, 0); acc = __builtin_amdgcn_mfma_f32_32x32x16_bf16(al, xb, acc, 0, 0, 0); }
            if (kh == 1) xch[wq * 64 + lane] = acc;
            __syncthreads();
            if (kh == 0) {
                const f32x16 other = xch[wq * 64 + lane];
                const f32x4 s0 = *(const f32x4*)(SSQ1 + (size_t)tok * 16 + 8 * half), s1 = *(const f32x4*)(SSQ1 + (size_t)tok * 16 + 8 * half + 4);
                float ss = ((s0[0] + s0[1]) + (s0[2] + s0[3])) + ((s1[0] + s1[1]) + (s1[2] + s1[3])); ss += __shfl_xor(ss, 32); const float rstd = rsqrtf(ss * (1.f / DM) + EPS);
                float v[16];
#pragma unroll
                for (int r = 0; r < 16; ++r) v[r] = (acc[r] + other[r]) * rstd + b_router[(r & 3) + 8 * (r >> 2) + 4 * half];
                float lv[4]; int li[4];
#pragma unroll
                for (int t = 0; t < 4; ++t) { float best = -__builtin_inff(); int bi = 0;
#pragma unroll
                    for (int r = 0; r < 16; ++r) if (v[r] > best) { best = v[r]; bi = (r & 3) + 8 * (r >> 2) + 4 * half; }
                    const auto rv = __builtin_amdgcn_permlane32_swap(__float_as_uint(best), __float_as_uint(best), false, false); const auto ri = __builtin_amdgcn_permlane32_swap((unsigned)bi, (unsigned)bi, false, false);
                    const float b0 = __uint_as_float(rv[0]), b1 = __uint_as_float(rv[1]); const int i0 = (int)ri[0], i1 = (int)ri[1];
                    const bool t0 = (b0 > b1) || (b0 == b1 && i0 < i1); const float gb = t0 ? b0 : b1; const int gi = t0 ? i0 : i1; lv[t] = gb; li[t] = gi;
#pragma unroll
                    for (int r = 0; r < 16; ++r) if ((r & 3) + 8 * (r >> 2) + 4 * half == gi) v[r] = -__builtin_inff(); }
                if (half == 0) { const float e1 = __expf(lv[1] - lv[0]), e2 = __expf(lv[2] - lv[0]), e3 = __expf(lv[3] - lv[0]); const float inv = 1.f / (1.f + e1 + e2 + e3);
                    *(int4*)(TOPI + (size_t)tok * 4) = make_int4(li[0], li[1], li[2], li[3]); *(f32x4*)(TOPG + (size_t)tok * 4) = (f32x4){inv, e1 * inv, e2 * inv, e3 * inv}; RS1[tok] = rstd;
#pragma unroll
                    for (int t = 0; t < 4; ++t) (void)__hip_atomic_fetch_add(hist + li[t], 1, __ATOMIC_RELAXED, __HIP_MEMORY_SCOPE_WORKGROUP); }
            }
            __syncthreads();
        }
        if (tid < NE && LASTREP(PH_ROUTER)) atomicAdd(ctl + CW_CNT + tid, hist[tid]);
        __syncthreads();
    }
    SEAM(PH_ROUTER);
    if (IN(PH_ROUTE)) {
        PHASE_LANE;
        LAS int* sh = (LAS int*)lds;
        if (tid == 0) { int ps = 0, nt = 0;
            for (int e = 0; e < NE; ++e) { sh[e] = ps; const int t = (ctl[CW_CNT + e] + 255) >> 8; if (bx == 0) for (int q = 0; q < t; ++q) ctl[CW_TILE_E + nt + q] = e; nt += t; ps += t * 256; }
            sh[NE] = ps; if (bx == 0) ctl[CW_NTILES] = nt; }
        __syncthreads();
        for (int chunk = bx; chunk < MROWS / NTHREADS; chunk += G) {
            if (tid < NE) sh[64 + tid] = 0;
            __syncthreads();
            const int idx = chunk * NTHREADS + tid, e = TOPI[idx]; const int r = __hip_atomic_fetch_add(sh + 64 + e, 1, __ATOMIC_RELAXED, __HIP_MEMORY_SCOPE_WORKGROUP);
            __syncthreads();
            if (tid < NE) sh[128 + tid] = atomicAdd(ctl + CW_CURSOR + tid, sh[64 + tid]);
            __syncthreads();
            const int dest = sh[e] + sh[128 + e] + r; ROWTOK[dest] = idx >> 2; ROWSLOT[dest] = idx; ROWGATE[dest] = TOPG[idx]; ROWRS[dest] = RS1[idx >> 2];
            __syncthreads();
        }
        for (int e = bx; e < NE; e += G) { const int plo = sh[e] + ctl[CW_CNT + e], phi = sh[e + 1];
            for (int r = plo + tid; r < phi; r += NTHREADS) { ROWTOK[r] = 0; ROWSLOT[r] = MROWS; ROWGATE[r] = 0.f; ROWRS[r] = 0.f; } }
        __syncthreads();
    }
    SEAM(PH_ROUTE);
    if (IN(PH_MOE1)) REPLOOP(PH_MOE1) {
        pg8::Gemm g{X8, W1T, DM, DM, DM, ROWTOK, (size_t)2048 * DM}; pg8::StaticOrder S; S.init(ctl[CW_NTILES], 2048 / 256, G, bx, ctl + CW_TILE_E);
        pg8::EpiMoe1 E{(unsigned char*)HB, b1, ROWRS}; pg8::gemm_phase<pg8::EpiMoe1, true, true>(lds, g, S, E, wave, LASTREP(PH_MOE1));
    }
    SEAM(PH_MOE1);
    if (IN(PH_MOE2)) REPLOOP(PH_MOE2) {
        pg8::Gemm g{HB, W2T, DE, DE, DE, nullptr, (size_t)DM * DE}; pg8::StaticOrder S; S.init(ctl[CW_NTILES], DM / 256, G, bx, ctl + CW_TILE_E);
        pg8::EpiMoe2 E{(unsigned char*)Y, b2, ROWSLOT, ROWGATE}; pg8::gemm_phase<pg8::EpiMoe2, false, true>(lds, g, S, E, wave, LASTREP(PH_MOE2));
    }
    SEAM(PH_MOE2);
    if (IN(PH_COMBINE)) REPLOOP(PH_COMBINE) {
        PHASE_LANE;
        for (int row = gw * 2; row < NTOK; row += NGW * 2) {
            u32x4 hv[2][2]; u32x2 yv[2][4][2]; const unsigned char* Y8 = (const unsigned char*)Y;
#pragma unroll
            for (int q = 0; q < 2; ++q)
#pragma unroll
                for (int j = 0; j < 2; ++j) { hv[q][j] = *(const u32x4*)(HBF + (size_t)(row + q) * DM + (lane + 64 * j) * 8);
#pragma unroll
                    for (int k = 0; k < 4; ++k) yv[q][k][j] = *(const u32x2*)(Y8 + ((size_t)(row + q) * 4 + k) * DM + (lane + 64 * j) * 8); }
#pragma unroll
            for (int q = 0; q < 2; ++q) { float ss = 0.f; u32x4 ov[2];
#pragma unroll
                for (int j = 0; j < 2; ++j) { f32x4 a = {blo(hv[q][j].x), bhi(hv[q][j].x), blo(hv[q][j].y), bhi(hv[q][j].y)}, b = {blo(hv[q][j].z), bhi(hv[q][j].z), blo(hv[q][j].w), bhi(hv[q][j].w)};
#pragma unroll
                    for (int k = 0; k < 4; ++k) { const u32x2 y = yv[q][k][j]; const f32x2 y0 = __builtin_amdgcn_cvt_pk_f32_fp8(y.x, false), y1 = __builtin_amdgcn_cvt_pk_f32_fp8(y.x, true), y2 = __builtin_amdgcn_cvt_pk_f32_fp8(y.y, false), y3 = __builtin_amdgcn_cvt_pk_f32_fp8(y.y, true);
                        a += (f32x4){y0[0], y0[1], y1[0], y1[1]}; b += (f32x4){y2[0], y2[1], y3[0], y3[1]}; }
                    ss += pg8::sq4(a) + pg8::sq4(b); ov[j] = pg8::pack8(a, b); }
                ss = wave_sum(ss);
                bf16_t* ho = LASTREP(PH_COMBINE) ? HBF : (bf16_t*)(ws + WS_HB);
#pragma unroll
                for (int j = 0; j < 2; ++j) *(u32x4*)(ho + (size_t)(row + q) * DM + (lane + 64 * j) * 8) = ov[j];
                float ps = lane < 16 ? PSSQ[(size_t)(row + q) * 16 + lane] : 0.f; ps += __shfl_xor(ps, 1); ps += __shfl_xor(ps, 2); ps += __shfl_xor(ps, 4); ps += __shfl_xor(ps, 8);
                if (lane == 0) { RS2[row + q] = rsqrtf(ss * (1.f / DM) + EPS); RS2[NTOK + row + q] = rsqrtf(ps * (1.f / DM) + EPS); } }
        }
    }
    SEAM(PH_COMBINE);
    if (IN(PH_PLE)) REPLOOP(PH_PLE) {
        pg8::Gemm g{HBF, WG, DM, DM, DM, nullptr, 0}; pg8::StaticOrder S; S.init(NTOK / 256, DM / 256, G, bx, nullptr);
        pg8::EpiPle E{HBF, H3, PLER, RS2 + NTOK, RS2, ple_post_norm, FSSQ}; pg8::gemm_phase<pg8::EpiPle, false>(lds, g, S, E, wave);
    }
    SEAM(PH_PLE);
    if (IN(PH_FINAL)) REPLOOP(PH_FINAL) {
        PHASE_LANE;
        for (int row = gw * 4; row < NTOK; row += NGW * 4) {
            u32x4 hv[4][2]; float sp[4];
#pragma unroll
            for (int q = 0; q < 4; ++q) { sp[q] = lane < 16 ? FSSQ[(size_t)(row + q) * 16 + lane] : 0.f;
#pragma unroll
                for (int j = 0; j < 2; ++j) hv[q][j] = *(const u32x4*)(H3 + (size_t)(row + q) * DM + (lane + 64 * j) * 8); }
#pragma unroll
            for (int q = 0; q < 4; ++q) { float s = sp[q]; s += __shfl_xor(s, 1); s += __shfl_xor(s, 2); s += __shfl_xor(s, 4); s += __shfl_xor(s, 8);
                const float rstd = rsqrtf(__shfl(s, 0) * (1.f / DM) + EPS); float* ho = (LASTREP(PH_FINAL) ? H : (float*)(ws + WS_HB)) + (size_t)(row + q) * DM;
#pragma unroll
                for (int j = 0; j < 2; ++j) { const int c = (lane + 64 * j) * 8; const f32x4 g0 = *(const f32x4*)(final_norm + c), g1 = *(const f32x4*)(final_norm + c + 4); const u32x4 v = hv[q][j];
                    *(f32x4*)(ho + c) = (f32x4){blo(v.x), bhi(v.x), blo(v.y), bhi(v.y)} * rstd * g0; *(f32x4*)(ho + c + 4) = (f32x4){blo(v.z), bhi(v.z), blo(v.w), bhi(v.w)} * rstd * g1; } }
        }
    }
#ifdef PROBE_TIME_PH
    STAMP(PH_COUNT);
    if (bx == 0 && wave == 0) { const unsigned dt = MISC[32 + PROBE_TIME_PH + 1] - MISC[32 + PROBE_TIME_PH]; const unsigned long long t0 = __builtin_amdgcn_s_memrealtime(); while (__builtin_amdgcn_s_memrealtime() - t0 < (unsigned long long)dt) __builtin_amdgcn_s_sleep(8); }
#endif
#ifdef PROBE_BARS
    if (hi - lo > 1) for (int i = 0; i < PROBE_BARS; ++i) xcd_barrier(bar, wave);
#endif
#undef IN
#undef NREP
#undef REPLOOP
#undef LASTREP
#undef SEAM
}
static int g_grid = 0;
extern "C" void kernel_launch(void* const* d_in, const int* in_sizes, int n_in, void* d_out, int out_size, void* d_ws, size_t ws_size, hipStream_t stream) {
    if (n_in != 25 || in_sizes[0] != NTOK * DM || out_size != NTOK * DM || ws_size < WS_END) {
        fprintf(stderr, "kernel_launch: unexpected shapes (n_in %d, in0 %d, out %d, ws %zu need %zu)\n", n_in, n_in > 0 ? in_sizes[0] : -1, out_size, ws_size, (size_t)WS_END); return; }
    if (g_grid == 0) {
        int dev = 0, cus = 0, per_cu = 0; (void)hipGetDevice(&dev); (void)hipDeviceGetAttribute(&cus, hipDeviceAttributeMultiprocessorCount, dev);
        if (hipFuncSetAttribute((const void*)fwd, hipFuncAttributeMaxDynamicSharedMemorySize, LDS_BYTES) != hipSuccess) fprintf(stderr, "hipFuncSetAttribute failed\n");
        if (hipOccupancyMaxActiveBlocksPerMultiprocessor(&per_cu, (const void*)fwd, NTHREADS, LDS_BYTES) != hipSuccess || per_cu < 1) { fprintf(stderr, "occupancy query: %d\n", per_cu); per_cu = 1; }
        (void)hipGetLastError();
        g_grid = cus > 0 ? cus : 256;
    }
    (void)hipMemsetAsync((unsigned char*)d_ws + WS_CTL, 0, 64 * 1024, stream);
    Args a{}; for (int i = 0; i < 25; ++i) a.in[i] = d_in[i]; a.out = (float*)d_out; a.ws = (unsigned char*)d_ws;
    a.ph_lo = 0; a.ph_hi = PH_COUNT; a.li = 0; a.skip = 0;
    void* p[] = {&a};
    const hipError_t e = hipLaunchCooperativeKernel((const void*)fwd, dim3(g_grid), dim3(NTHREADS), p, LDS_BYTES, stream);
    if (e != hipSuccess) fprintf(stderr, "cooperative launch failed: %s (grid %d)\n", hipGetErrorString(e), g_grid);
}
```

```cpp
#include <hip/hip_runtime.h>
#include <cstdint>
#include <cstdio>
#include <cmath>

typedef unsigned short bf16_t;

constexpr int NB = 8, SEQ = 4096, DM = 1024, NTOK = NB * SEQ;
constexpr int PLE = 256, NH = 4, DN = 128, DR = 64, DV = 128, QL = 256, KVL = 128, DQK = DN + DR;
constexpr int INW = 1984, INWP = 2048;
constexpr int NE = 32, TOPK = 4, DE = 1024;
constexpr int MROWS = NTOK * TOPK;
constexpr int MAXTILES = MROWS / 256 + NE;
constexpr int PROWS = MAXTILES * 256;
constexpr float EPS = 1e-6f;
constexpr float QSCALE = 0.07216878364870322f * 1.4426950408889634f;

constexpr size_t MiB = 1u << 20;
constexpr size_t WS_CTL = 0;
constexpr size_t WS_WIN = 1 * MiB, WS_WUQ = 5 * MiB, WS_WUKV = 5 * MiB + 512 * 1024, WS_WO = 6 * MiB, WS_WG = 8 * MiB, WS_WP = 10 * MiB;
constexpr size_t WS_WR = 10 * MiB + 512 * 1024;
constexpr size_t WS_CS = 11 * MiB;
constexpr size_t WS_SSQ = 19 * MiB, WS_ASSQ = 20 * MiB, WS_PSSQ = 21 * MiB, WS_FSSQ = 23 * MiB;
constexpr size_t WS_TOPI = 25 * MiB, WS_TOPG = 25 * MiB + 512 * 1024;
constexpr size_t WS_ROWTOK = 26 * MiB, WS_ROWSLOT = 27 * MiB, WS_ROWGATE = 28 * MiB;
constexpr size_t WS_P16 = 29 * MiB;
constexpr size_t WS_SSQ1 = 45 * MiB, WS_RS1 = 47 * MiB, WS_RS2 = 47 * MiB + 128 * 1024, WS_ROWRS = 47 * MiB + 384 * 1024;
constexpr size_t WS_RSX = 10 * MiB + 512 * 1024;
constexpr size_t WS_WRHL = 10 * MiB + 768 * 1024;
constexpr size_t WS_HBF = 112 * MiB;
constexpr size_t WS_H3 = 304 * MiB;
constexpr size_t WS_W1 = 48 * MiB, WS_W2 = 176 * MiB, WS_XN = 240 * MiB, WS_MIX = 304 * MiB, WS_PLER = 368 * MiB;
constexpr size_t WS_Z = 432 * MiB, WS_Q = 560 * MiB, WS_K = 608 * MiB, WS_V = 656 * MiB;
constexpr size_t WS_HB = 432 * MiB;
constexpr size_t WS_Y = 704 * MiB;
constexpr size_t WS_END = WS_Y + (size_t)(MROWS + 256) * DM * 2;
constexpr int CW_CNT = 0, CW_CURSOR = 64, CW_PADSTART = 128, CW_NTILES = 192, CW_TILE_E = 256;

__device__ __forceinline__ float bf2f(bf16_t v) { return __uint_as_float((unsigned)v << 16); }
__device__ __forceinline__ float blo(unsigned u) { return __uint_as_float(u << 16); }
__device__ __forceinline__ float bhi(unsigned u) { return __uint_as_float(u & 0xffff0000u); }
__device__ __forceinline__ bf16_t f2bf(float f) { unsigned u = __float_as_uint(f); return (bf16_t)((u + 0x7fffu + ((u >> 16) & 1u)) >> 16); }
__device__ __forceinline__ unsigned pk2(float lo, float hi) { return (unsigned)f2bf(lo) | ((unsigned)f2bf(hi) << 16); }
__device__ __forceinline__ float wave_sum(float v) {
#pragma unroll
    for (int o = 1; o < 64; o <<= 1) v += __shfl_xor(v, o);
    return v;
}
__device__ __forceinline__ float wave_max(float v) {
#pragma unroll
    for (int o = 1; o < 64; o <<= 1) v = fmaxf(v, __shfl_xor(v, o));
    return v;
}
__device__ __forceinline__ float dot8(uint4 x, uint4 y) {
    return blo(x.x) * blo(y.x) + bhi(x.x) * bhi(y.x) + blo(x.y) * blo(y.y) + bhi(x.y) * bhi(y.y) +
           blo(x.z) * blo(y.z) + bhi(x.z) * bhi(y.z) + blo(x.w) * blo(y.w) + bhi(x.w) * bhi(y.w);
}
__device__ __forceinline__ float dot_bf16(const bf16_t* a, const bf16_t* b, int K) {
    const uint4* a4 = (const uint4*)a; const uint4* b4 = (const uint4*)b; float acc = 0.f;
    for (int i = 0; i < K / 8; ++i) acc += dot8(a4[i], b4[i]);
    return acc;
}

#define LAS __attribute__((address_space(3)))
#define GAS __attribute__((address_space(1)))
typedef short bf16x8 __attribute__((ext_vector_type(8)));
typedef float f32x4 __attribute__((ext_vector_type(4)));
typedef float f32x2 __attribute__((ext_vector_type(2)));
typedef unsigned u32x4 __attribute__((ext_vector_type(4)));
typedef unsigned u32x2 __attribute__((ext_vector_type(2)));
#ifndef PROBE_PH
#define PROBE_PH (-1)
#define PROBE_REP 1
#endif
#ifndef MOE2_DELAY_TICKS
#define MOE2_DELAY_TICKS 700ull
#endif
constexpr int NWAVES = 8, NTHREADS = 512;
constexpr int RING_BYTES = 131072, MISC_OFF = RING_BYTES, HIST_OFF = MISC_OFF + 256, STG_OFF = RING_BYTES + 1024, LDS_BYTES = 163840;
constexpr int CW_PANEL = 8192;
constexpr int CW_BAR = 4096;
__device__ __forceinline__ unsigned cvt_pk_bf16(float lo, float hi) { unsigned r; asm volatile("v_cvt_pk_bf16_f32 %0, %1, %2" : "=v"(r) : "v"(lo), "v"(hi)); return r; }
__device__ __forceinline__ int lane_id() { int l = (int)__builtin_amdgcn_mbcnt_hi(~0u, __builtin_amdgcn_mbcnt_lo(~0u, 0u)); asm volatile("" : "+v"(l)); return l; }
__device__ __forceinline__ float fast_sigmoid(float a) { return __builtin_amdgcn_rcpf(1.f + __expf(-a)); }

#define XB_TMO      128
#define XB_XCNT(j)  (256  + 64 * (j))
#define XB_XSUB(j)  (1280 + 64 * (j))
#define XB_XGEN(j)  (2304 + 64 * (j))
#define XB_TOP      3328
#define XB_TOPGEN   3392
#define XCD_BAR_WORDS 3456
#define XB_SPIN_CAP (1u << 20)
__device__ __forceinline__ unsigned xb_ld(unsigned* p)              { return __hip_atomic_load(p, __ATOMIC_RELAXED, __HIP_MEMORY_SCOPE_AGENT); }
__device__ __forceinline__ unsigned xb_add(unsigned* p, unsigned v) { return __hip_atomic_fetch_add(p, v, __ATOMIC_RELAXED, __HIP_MEMORY_SCOPE_AGENT); }
__device__ __forceinline__ unsigned xb_xcc_id() { return (unsigned)__builtin_amdgcn_s_getreg((3 << 11) | 20) & 0xFu; }
#define XB_SPIN(cond, bar) do { unsigned _sp = 0; while (cond) { __builtin_amdgcn_s_sleep(1); \
    if ((++_sp & 255u) == 0u) { if (xb_ld(&(bar)[XB_TMO])) break; if (_sp > XB_SPIN_CAP) { atomicAdd(&(bar)[XB_TMO], 1u); break; } } } } while (0)
struct XcdBarrier { unsigned* bar; unsigned x; volatile LAS unsigned* st; };
__device__ __forceinline__ XcdBarrier xcd_barrier_post(unsigned* bar, volatile LAS unsigned* st, int wave) {
    XcdBarrier b; b.bar = bar; b.x = xb_xcc_id(); b.st = st;
    if (wave == 0 && lane_id() == 0) (void)xb_add(&bar[XB_XCNT(b.x)], 1u);
    return b;
}
__device__ __forceinline__ void xcd_barrier_complete(unsigned* bar, unsigned x, unsigned& nloc, unsigned& nx) {
    const unsigned G = gridDim.x * gridDim.y * gridDim.z;
    unsigned sum, cnt, mine, sp = 0u;
    for (;;) {
        sum = 0u; cnt = 0u; mine = 0u;
#pragma unroll
        for (unsigned j = 0; j < 16; ++j) { const unsigned c = xb_ld(&bar[XB_XCNT(j)]); sum += c; cnt += (c > 0u) ? 1u : 0u; mine = (j == x) ? c : mine; }
        if (sum == G) break;
        __builtin_amdgcn_s_sleep(1);
        if ((++sp & 255u) == 0u) { if (xb_ld(&bar[XB_TMO])) break; if (sp > XB_SPIN_CAP) { atomicAdd(&bar[XB_TMO], 1u); break; } }
    }
    nloc = mine > 0u ? mine : 1u; nx = cnt > 0u ? cnt : 1u;
}
__device__ __forceinline__ void xcd_barrier(const XcdBarrier& b, int wave) {
    asm volatile("s_waitcnt vmcnt(0)" ::: "memory");
    __syncthreads();
    if (wave == 0 && lane_id() == 0) {
        unsigned* bar = b.bar;
        __builtin_amdgcn_s_waitcnt(0);
        unsigned nloc = b.st[0], nx = b.st[1];
        if (nloc == 0u) { xcd_barrier_complete(bar, b.x, nloc, nx); b.st[0] = nloc; b.st[1] = nx; }
        const unsigned old = xb_add(&bar[XB_XSUB(b.x)], 1u);
        const unsigned gen = old / nloc;
        if (old + 1u == (gen + 1u) * nloc) {
            __builtin_amdgcn_fence(__ATOMIC_RELEASE, "agent");
            asm volatile("s_waitcnt vmcnt(0)" ::: "memory");
            const unsigned og = xb_add(&bar[XB_TOP], 1u);
            const unsigned tg = og / nx;
            if (og + 1u == (tg + 1u) * nx) xb_add(&bar[XB_TOPGEN], 1u);
            else XB_SPIN(xb_ld(&bar[XB_TOPGEN]) == tg, bar);
            __builtin_amdgcn_fence(__ATOMIC_ACQUIRE, "agent");
            xb_add(&bar[XB_XGEN(b.x)], 1u);
            asm volatile("s_waitcnt vmcnt(0)" ::: "memory");
        } else {
            XB_SPIN(xb_ld(&bar[XB_XGEN(b.x)]) == gen, bar);
            __builtin_amdgcn_fence(__ATOMIC_ACQUIRE, "agent");
            asm volatile("s_waitcnt vmcnt(0)" ::: "memory");
        }
    }
    __syncthreads();
}

namespace pg8 {
constexpr int BM = 256, BK = 64, HALF = 128, HTB = HALF * BK * 2, STAGE_BYTES = 8 * HTB, NXCD = 8, WGM = 8;
__host__ __device__ __forceinline__ int lds_byte(int r, int c) { const int st = (r >> 4) * 2 + (c >> 5), rr = r & 15, cc = c & 31, ob = rr * 64 + cc * 2; return st * 1024 + (ob ^ (((ob >> 9) & 1) << 5)); }
__host__ __device__ __forceinline__ void stage_rc(int b, int& R, int& C) { const int st = b / 1024, sb = b % 1024, swz = sb ^ (((sb >> 9) & 1) << 5); R = (st >> 1) * 16 + swz / 64; C = (st & 1) * 32 + (swz % 64) / 2; }
__host__ __device__ __forceinline__ int perm32(int rho) { const int n = rho >> 4, i = rho & 15; return 8 * (i >> 2) + 4 * n + (i & 3); }
struct Unit { int pm, pn, e; };
struct Gemm { const void* A; const void* Bt; int K, lda, ldb; const int* rowidx; size_t bstride; };
struct StaticOrder {
    int nM, nN, nwg, G, c; const int* tile_e;
    __device__ void init(int nM_, int nN_, int G_, int c_, const int* te) { nM = nM_; nN = nN_; nwg = nM * nN; G = G_; c = c_; tile_e = te; }
    __device__ bool next(int i, Unit& u) const {
        const long L = (long)i * G + c; if (L >= nwg) return false;
        int wgid = (int)L; { const int q = nwg / NXCD, r = nwg % NXCD, xcd = wgid % NXCD, off = wgid / NXCD; wgid = (xcd < r ? xcd * (q + 1) : r * (q + 1) + (xcd - r) * q) + off; }
        const int nig = WGM * nN, gid = wgid / nig, fm = gid * WGM, gsz = (nM - fm) < WGM ? (nM - fm) : WGM;
        u.pm = fm + ((wgid % nig) % gsz); u.pn = (wgid % nig) / gsz; u.e = tile_e ? tile_e[u.pm] : 0; return true;
    }
};
typedef f32x4 Acc[2][2][4][2];
typedef int v8i_t __attribute__((ext_vector_type(8)));
typedef int v4i_t __attribute__((ext_vector_type(4)));
template <class Epi, bool GATHER, bool FP8 = false>
__device__ __forceinline__ void gemm_phase(LAS unsigned char* lds, const Gemm g, const StaticOrder& S, const Epi& E, const int wid, const bool do_epi = true) {
    const int lane = lane_id(), tid = wid * 64 + lane, wr = wid >> 2, wc = wid & 3, fr = lane & 15, fq = lane >> 4;
    constexpr int ES = FP8 ? 1 : 2;
    const int K = g.K, nt = K * ES / 128;
    int RA[2], CA[2]; unsigned voffB[2], voffA[2];
#pragma unroll
    for (int i = 0; i < 2; ++i) { int R, C; stage_rc(tid * 16 + i * 8192, R, C); const int Rb = Epi::PERM ? ((R & ~31) + perm32(R & 31)) : R;
        RA[i] = R; CA[i] = C; voffB[i] = (unsigned)(Rb * g.ldb * ES + C * 2); voffA[i] = (unsigned)(R * g.lda * ES + C * 2); }
    const size_t hstepA = GATHER ? 0 : (size_t)HALF * g.lda * ES;
    const size_t kstep = (size_t)(BK * 2);
    const size_t hstepB = (size_t)HALF * g.ldb * ES;
    const unsigned ldsw = (unsigned)wid * 1024u;
    const int aoff = lds_byte(wr * 64 + fr, fq * 8), boff = lds_byte(wc * 32 + fr, fq * 8);
#define PG8_SA(b, h) (((b) * 2 + (h)) * HTB)
#define PG8_SB(b, h) ((4 + (b) * 2 + (h)) * HTB)
#define PG8_STAGE(bufoff, gbase, voff) do { _Pragma("unroll") for (int _i = 0; _i < 2; ++_i) \
        __builtin_amdgcn_global_load_lds((const unsigned*)((const char*)(gbase) + (voff)[_i]), (LAS unsigned*)(lds + (bufoff) + ldsw + _i * 8192), 16, 0, 0); } while (0)
#define PG8_LDA(dst, b, h) do { _Pragma("unroll") for (int m = 0; m < 4; ++m) _Pragma("unroll") for (int k = 0; k < 2; ++k) dst[m][k] = *(const LAS bf16x8*)(lds + PG8_SA(b, h) + aoff + m * 2048 + k * 1024); } while (0)
#define PG8_LDB(dst, b, h) do { _Pragma("unroll") for (int n = 0; n < 2; ++n) _Pragma("unroll") for (int k = 0; k < 2; ++k) dst[n][k] = *(const LAS bf16x8*)(lds + PG8_SB(b, h) + boff + n * 2048 + k * 1024); } while (0)
#define PG8_CAT8(x) __builtin_shufflevector(__builtin_bit_cast(v4i_t, (x)[0]), __builtin_bit_cast(v4i_t, (x)[1]), 0, 1, 2, 3, 4, 5, 6, 7)
#define PG8_MMA(ai, bj, At, Bt) do { __builtin_amdgcn_s_setprio(1); if constexpr (FP8) { _Pragma("unroll") for (int m = 0; m < 4; ++m) _Pragma("unroll") for (int n = 0; n < 2; ++n) \
        acc[ai][bj][m][n] = __builtin_amdgcn_mfma_scale_f32_16x16x128_f8f6f4(PG8_CAT8(Bt[n]), PG8_CAT8(At[m]), acc[ai][bj][m][n], 0, 0, 0, 0x7f7f7f7f, 0, 0x7f7f7f7f); \
        _Pragma("unroll") for (int m = 0; m < 4; ++m) _Pragma("unroll") for (int n = 0; n < 2; ++n) asm volatile("" : "+v"(acc[ai][bj][m][n]));   } else { \
        _Pragma("unroll") for (int m = 0; m < 4; ++m) _Pragma("unroll") for (int n = 0; n < 2; ++n) _Pragma("unroll") for (int k = 0; k < 2; ++k) \
        acc[ai][bj][m][n] = __builtin_amdgcn_mfma_f32_16x16x32_bf16(Bt[n][k], At[m][k], acc[ai][bj][m][n], 0, 0, 0); } __builtin_amdgcn_s_setprio(0); } while (0)
#define PG8_WAIT_V(n) asm volatile("s_waitcnt vmcnt(" #n ")" ::: "memory")
#define PG8_WAIT_L(n) asm volatile("s_waitcnt lgkmcnt(" #n ")" ::: "memory")
#define PG8_BAR __builtin_amdgcn_s_barrier()
#define PG8_SCHED __builtin_amdgcn_sched_barrier(0)
#define PG8_SETVO(vo, u) do { if constexpr (GATHER) { _Pragma("unroll") for (int _h = 0; _h < 2; ++_h) _Pragma("unroll") for (int _i = 0; _i < 2; ++_i) { \
        const int _row = g.rowidx[(u).pm * BM + _h * HALF + RA[_i]]; (vo)[_h][_i] = (unsigned)_row * (unsigned)(g.lda * ES) + (unsigned)CA[_i] * 2u; } } } while (0)
#define PG8_STAGE_A(bufoff, base, h, vog) do { if constexpr (GATHER) { PG8_STAGE(bufoff, base, (vog)[h]); } else { PG8_STAGE(bufoff, (base) + (h) * hstepA, voffA); } } while (0)
    Unit cur, nxt; int ui = 0;
    if (!S.next(0, cur)) return;
    Acc acc;
#pragma unroll
    for (int a = 0; a < 2; ++a)
#pragma unroll
        for (int b = 0; b < 2; ++b)
#pragma unroll
            for (int m = 0; m < 4; ++m)
#pragma unroll
                for (int n = 0; n < 2; ++n) acc[a][b][m][n] = (f32x4){0.f, 0.f, 0.f, 0.f};
    bf16x8 At[4][2], B0[2][2], B1[2][2];
    unsigned voC[2][2], voN[2][2];
    PG8_SETVO(voC, cur);
    const char* const Ab = (const char*)g.A;
    const char* cA = GATHER ? Ab : Ab + (size_t)cur.pm * 2 * hstepA;
    const char* cB = (const char*)g.Bt + (size_t)cur.e * g.bstride + (size_t)cur.pn * 2 * hstepB;
    PG8_STAGE(PG8_SB(0, 0), cB, voffB); PG8_STAGE(PG8_SB(0, 1), cB + hstepB, voffB); PG8_STAGE_A(PG8_SA(0, 0), cA, 0, voC); PG8_STAGE_A(PG8_SA(0, 1), cA, 1, voC);
    if (wr == 1) PG8_BAR;
    PG8_WAIT_V(2); PG8_BAR;
    PG8_STAGE(PG8_SB(1, 0), cB + kstep, voffB); PG8_STAGE_A(PG8_SA(1, 0), cA + kstep, 0, voC); PG8_STAGE(PG8_SB(1, 1), cB + hstepB + kstep, voffB);
    PG8_WAIT_V(6); PG8_BAR;
    for (;;) {
        const bool has_next = S.next(ui + 1, nxt);
        const char* nB = has_next ? (const char*)g.Bt + (size_t)nxt.e * g.bstride + (size_t)nxt.pn * 2 * hstepB : cB;
        const char* nA = (has_next && !GATHER) ? Ab + (size_t)nxt.pm * 2 * hstepA : cA;
        if constexpr (GATHER) { if (has_next) { PG8_SETVO(voN, nxt); } else {
#pragma unroll
            for (int h = 0; h < 2; ++h)
#pragma unroll
                for (int i = 0; i < 2; ++i) voN[h][i] = voC[h][i]; } }
        for (int t = 0; t < nt; t += 2) {
            const bool last = (t == nt - 2);
            if constexpr (Epi::MIDK > 0) { if (t == Epi::MIDK) { const int l2 = lane_id(); E.mid(acc, cur, wr, wc, l2 & 15, l2 >> 4); } }
            const char* a1 = cA + (size_t)(t + 1) * kstep;
            const char* a2 = last ? nA : cA + (size_t)(t + 2) * kstep; const char* b2 = last ? nB : cB + (size_t)(t + 2) * kstep;
            const char* a3 = a2 + kstep; const char* b3 = b2 + kstep;
            unsigned o2[2][2];
            if constexpr (GATHER) {
#pragma unroll
            for (int h = 0; h < 2; ++h)
#pragma unroll
                for (int i = 0; i < 2; ++i) o2[h][i] = last ? voN[h][i] : voC[h][i]; }
            PG8_LDB(B0, 0, 0); PG8_LDB(B1, 0, 1); PG8_SCHED; PG8_LDA(At, 0, 0); PG8_STAGE_A(PG8_SA(1, 1), a1, 1, voC);
            PG8_WAIT_V(8); PG8_WAIT_L(0); PG8_BAR; PG8_MMA(0, 0, At, B0); PG8_MMA(0, 1, At, B1); PG8_BAR; PG8_SCHED;
            PG8_LDA(At, 0, 1); PG8_STAGE(PG8_SB(0, 0), b2, voffB); PG8_STAGE(PG8_SB(0, 1), b2 + hstepB, voffB); PG8_STAGE_A(PG8_SA(0, 0), a2, 0, o2);
            PG8_WAIT_V(8); PG8_WAIT_L(0); PG8_BAR; PG8_MMA(1, 0, At, B0); PG8_MMA(1, 1, At, B1); PG8_BAR; PG8_SCHED;
            PG8_LDB(B0, 1, 0); PG8_LDB(B1, 1, 1); PG8_SCHED; PG8_LDA(At, 1, 0); PG8_STAGE_A(PG8_SA(0, 1), a2, 1, o2);
            PG8_WAIT_V(8); PG8_WAIT_L(0); PG8_BAR; PG8_MMA(0, 0, At, B0); PG8_MMA(0, 1, At, B1); PG8_BAR; PG8_SCHED;
            PG8_LDA(At, 1, 1); PG8_STAGE(PG8_SB(1, 0), b3, voffB); PG8_STAGE(PG8_SB(1, 1), b3 + hstepB, voffB); PG8_STAGE_A(PG8_SA(1, 0), a3, 0, o2);
            PG8_WAIT_V(8); PG8_WAIT_L(0); PG8_BAR; PG8_MMA(1, 0, At, B0); PG8_MMA(1, 1, At, B1); PG8_BAR; PG8_SCHED;
        }
        if (wr == 0) PG8_BAR;
        if (do_epi) { const int l2 = lane_id(); E(acc, cur, wr, wc, l2 & 15, l2 >> 4); }
        if (!has_next) break;
#pragma unroll
        for (int a = 0; a < 2; ++a)
#pragma unroll
            for (int b = 0; b < 2; ++b)
#pragma unroll
                for (int m = 0; m < 4; ++m)
#pragma unroll
                    for (int n = 0; n < 2; ++n) acc[a][b][m][n] = (f32x4){0.f, 0.f, 0.f, 0.f};
        cur = nxt; cB = nB; cA = nA; ++ui;
        if constexpr (GATHER) {
#pragma unroll
        for (int h = 0; h < 2; ++h)
#pragma unroll
            for (int i = 0; i < 2; ++i) voC[h][i] = voN[h][i]; }
        if (wr == 1) PG8_BAR;
    }
    PG8_WAIT_V(0);
    PG8_BAR;
#undef PG8_SA
#undef PG8_SB
#undef PG8_STAGE
#undef PG8_LDA
#undef PG8_LDB
#undef PG8_MMA
#undef PG8_CAT8
#undef PG8_WAIT_V
#undef PG8_WAIT_L
#undef PG8_BAR
#undef PG8_SCHED
#undef PG8_SETVO
#undef PG8_STAGE_A
}

__device__ __forceinline__ unsigned pk4_fp8(f32x4 v) { unsigned w = 0; w = __builtin_amdgcn_cvt_pk_fp8_f32(v[0], v[1], w, false); w = __builtin_amdgcn_cvt_pk_fp8_f32(v[2], v[3], w, true); return w; }
__device__ __forceinline__ float sq4(f32x4 v) { return (v[0] * v[0] + v[1] * v[1]) + (v[2] * v[2] + v[3] * v[3]); }
__device__ __forceinline__ float red_fq(float s) { s += __shfl_xor(s, 16); s += __shfl_xor(s, 32); return s; }
__device__ __forceinline__ u32x4 pack8(f32x4 a, f32x4 b) { u32x4 w; w.x = cvt_pk_bf16(a[0], a[1]); w.y = cvt_pk_bf16(a[2], a[3]); w.z = cvt_pk_bf16(b[0], b[1]); w.w = cvt_pk_bf16(b[2], b[3]); return w; }
template <int MODE> struct EpiBf16Stats {
    static constexpr bool PERM = true; static constexpr int MIDK = 0;
    bf16_t* O; int ldc; float* ssq; const float* rsx;
    __device__ __forceinline__ void operator()(const Acc& acc, const Unit& u, int wr, int wc, int fr, int fq) const {
        const int row0 = u.pm * BM + wr * 64 + fr, col0 = u.pn * BM + wc * 32 + 8 * fq;
        float rv[2][4];
#pragma unroll
        for (int ai = 0; ai < 2; ++ai)
#pragma unroll
            for (int m = 0; m < 4; ++m) rv[ai][m] = rsx ? rsx[row0 + ai * HALF + m * 16] : 1.f;
        asm volatile("" ::: "memory");
#pragma unroll
        for (int ai = 0; ai < 2; ++ai)
#pragma unroll
            for (int m = 0; m < 4; ++m) { const int row = row0 + ai * HALF + m * 16; bf16_t* rowp = O + (size_t)row * ldc + col0; const float rs = rv[ai][m];
                const f32x4 a00 = acc[ai][0][m][0] * rs, a01 = acc[ai][0][m][1] * rs, a10 = acc[ai][1][m][0] * rs, a11 = acc[ai][1][m][1] * rs;
                *(u32x4*)(rowp) = pack8(a00, a01); *(u32x4*)(rowp + HALF) = pack8(a10, a11);
                if (MODE == 1) { float s = (sq4(a00) + sq4(a01)) + (sq4(a10) + sq4(a11)); s = red_fq(s); if (fq == 0) ssq[(size_t)row * 16 + u.pn * 4 + wc] = s; }
                else if (u.pn == 0) { float s = (sq4(a00) + sq4(a01)) + (sq4(a10) + sq4(a11)); s = red_fq(s); if (fq == 0) ssq[(size_t)row * 8 + wc] = s; }
                else if (u.pn == 1) { float s = sq4(a00) + sq4(a01); s = red_fq(s); if (fq == 0) ssq[(size_t)row * 8 + 4 + wc] = s; } }
    }
};
struct EpiQ {
    static constexpr bool PERM = true; static constexpr int MIDK = 0;
    bf16_t* Q; const float* ssq; const float* cs;
    __device__ __forceinline__ void operator()(const Acc& acc, const Unit& u, int wr, int wc, int fr, int fq) const {
        const int row0 = u.pm * BM + wr * 64 + fr;
#pragma unroll
        for (int ai = 0; ai < 2; ++ai)
#pragma unroll
            for (int m = 0; m < 4; ++m) { const int row = row0 + ai * HALF + m * 16; const f32x4 sv = *(const f32x4*)(ssq + (size_t)row * 8);
                const float rs = rsqrtf(((sv[0] + sv[1]) + (sv[2] + sv[3])) * (1.f / QL) + EPS); const int b = row / SEQ, s = row % SEQ;
#pragma unroll
                for (int bj = 0; bj < 2; ++bj) { const int cv = u.pn * BM + bj * HALF + wc * 32 + 8 * fq; const int h = cv / DQK, d = cv % DQK;
                    f32x4 v0 = acc[ai][bj][m][0] * rs, v1 = acc[ai][bj][m][1] * rs;
                    if (d >= DN) { const int i0 = (d - DN) >> 1; const f32x4 c = *(const f32x4*)(cs + (size_t)row * 64 + i0), sn = *(const f32x4*)(cs + (size_t)row * 64 + 32 + i0);
                        const f32x4 r0 = {v0[0] * c[0] - v0[1] * sn[0], v0[0] * sn[0] + v0[1] * c[0], v0[2] * c[1] - v0[3] * sn[1], v0[2] * sn[1] + v0[3] * c[1]};
                        const f32x4 r1 = {v1[0] * c[2] - v1[1] * sn[2], v1[0] * sn[2] + v1[1] * c[2], v1[2] * c[3] - v1[3] * sn[3], v1[2] * sn[3] + v1[3] * c[3]};
                        v0 = r0; v1 = r1; }
                    *(u32x4*)(Q + ((size_t)(b * NH + h) * SEQ + s) * DQK + d) = pack8(v0, v1); } }
    }
};
struct EpiKV {
    static constexpr bool PERM = true; static constexpr int MIDK = 0;
    bf16_t* Kc; bf16_t* Vc; const float* ssq;
    __device__ __forceinline__ void operator()(const Acc& acc, const Unit& u, int wr, int wc, int fr, int fq) const {
        const int row0 = u.pm * BM + wr * 64 + fr, d = wc * 32 + 8 * fq, h = u.pn;
#pragma unroll
        for (int ai = 0; ai < 2; ++ai)
#pragma unroll
            for (int m = 0; m < 4; ++m) { const int row = row0 + ai * HALF + m * 16; const f32x4 sv = *(const f32x4*)(ssq + (size_t)row * 8 + 4);
                const float rs = rsqrtf(((sv[0] + sv[1]) + (sv[2] + sv[3])) * (1.f / KVL) + EPS); const int b = row / SEQ, s = row % SEQ; const size_t t = (size_t)(b * NH + h) * SEQ + s;
                *(u32x4*)(Kc + t * DQK + d) = pack8(acc[ai][0][m][0] * rs, acc[ai][0][m][1] * rs);
                *(u32x4*)(Vc + t * DV + d) = pack8(acc[ai][1][m][0] * rs, acc[ai][1][m][1] * rs); }
    }
};
struct EpiWo {
    static constexpr bool PERM = true; static constexpr int MIDK = 8;
    const bf16_t* x; bf16_t* HBF; unsigned char* X8; const float* assq; float* ssq1; const float* gmoe;
    __device__ __forceinline__ void mid(Acc& acc, const Unit& u, int wr, int wc, int fr, int fq) const {
        const int row0 = u.pm * BM + wr * 64 + fr;
#pragma unroll
        for (int ai = 0; ai < 2; ++ai)
#pragma unroll
            for (int m = 0; m < 4; ++m) { const f32x4 sv = *(const f32x4*)(assq + (size_t)(row0 + ai * HALF + m * 16) * 4);
                const float rs = rsqrtf(((sv[0] + sv[1]) + (sv[2] + sv[3])) * (1.f / 512.f) + EPS);
#pragma unroll
                for (int bj = 0; bj < 2; ++bj)
#pragma unroll
                    for (int n = 0; n < 2; ++n) acc[ai][bj][m][n] = acc[ai][bj][m][n] * rs; }
    }
    __device__ __forceinline__ void operator()(const Acc& acc, const Unit& u, int wr, int wc, int fr, int fq) const {
        const int row0 = u.pm * BM + wr * 64 + fr, col0 = u.pn * BM + wc * 32 + 8 * fq;
        f32x4 gn[2][2];
#pragma unroll
        for (int bj = 0; bj < 2; ++bj) { gn[bj][0] = *(const f32x4*)(gmoe + col0 + bj * HALF); gn[bj][1] = *(const f32x4*)(gmoe + col0 + bj * HALF + 4); }
#pragma unroll
        for (int ai = 0; ai < 2; ++ai) { u32x4 xv[4][2];
#pragma unroll
            for (int m = 0; m < 4; ++m) { const size_t off = (size_t)(row0 + ai * HALF + m * 16) * DM + col0;
#pragma unroll
                for (int bj = 0; bj < 2; ++bj) xv[m][bj] = *(const u32x4*)(x + off + bj * HALF); }
            asm volatile("" ::: "memory");
#pragma unroll
            for (int m = 0; m < 4; ++m) { const int row = row0 + ai * HALF + m * 16; const size_t off = (size_t)row * DM + col0; float ss = 0.f;
#pragma unroll
                for (int bj = 0; bj < 2; ++bj) { const u32x4 xq = xv[m][bj]; const f32x4 h0 = (f32x4){blo(xq.x), bhi(xq.x), blo(xq.y), bhi(xq.y)} + acc[ai][bj][m][0], h1 = (f32x4){blo(xq.z), bhi(xq.z), blo(xq.w), bhi(xq.w)} + acc[ai][bj][m][1];
                    *(u32x4*)(HBF + off + bj * HALF) = pack8(h0, h1); *(u32x2*)(X8 + off + bj * HALF) = (u32x2){pk4_fp8(h0 * gn[bj][0]), pk4_fp8(h1 * gn[bj][1])}; ss += sq4(h0) + sq4(h1); }
                ss = red_fq(ss); if (fq == 0) ssq1[(size_t)row * 16 + u.pn * 4 + wc] = ss; }
            asm volatile("" ::: "memory"); }
    }
};
__device__ __forceinline__ f32x4 sigmoid4(f32x4 a) { const f32x4 t = a * -1.44269504f; f32x4 e; e[0] = __builtin_amdgcn_exp2f(t[0]); e[1] = __builtin_amdgcn_exp2f(t[1]); e[2] = __builtin_amdgcn_exp2f(t[2]); e[3] = __builtin_amdgcn_exp2f(t[3]);
    const f32x4 d = e + 1.0f; f32x4 r; r[0] = __builtin_amdgcn_rcpf(d[0]); r[1] = __builtin_amdgcn_rcpf(d[1]); r[2] = __builtin_amdgcn_rcpf(d[2]); r[3] = __builtin_amdgcn_rcpf(d[3]); return r; }
__device__ __forceinline__ f32x2 swiglu2(f32x2 g, f32x2 u) {
    g.x = fminf(g.x, 7.f); g.y = fminf(g.y, 7.f); u.x = __builtin_amdgcn_fmed3f(u.x, -7.f, 7.f); u.y = __builtin_amdgcn_fmed3f(u.y, -7.f, 7.f);
    const f32x2 t = g * -2.45546696f; f32x2 e; e.x = __builtin_amdgcn_exp2f(t.x); e.y = __builtin_amdgcn_exp2f(t.y); const f32x2 d = e + 1.0f; f32x2 r; r.x = __builtin_amdgcn_rcpf(d.x); r.y = __builtin_amdgcn_rcpf(d.y);
    const f32x2 gs = g * r; return u * gs + gs; }
__device__ __forceinline__ float swiglu_f(float g, float u) { g = fminf(g, 7.f); u = __builtin_amdgcn_fmed3f(u, -7.f, 7.f); const float gs = g * __builtin_amdgcn_rcpf(1.f + __builtin_amdgcn_exp2f(g * -2.45546696f)); return fmaf(u, gs, gs); }
constexpr float WSCALE = 64.f, WINV = 1.f / 64.f;
struct EpiMoe1 {
    static constexpr bool PERM = true; static constexpr int MIDK = 0;
    unsigned char* HB; const float* b1; const float* rowrs;
    __device__ __forceinline__ void operator()(const Acc& acc, const Unit& u, int wr, int wc, int fr, int fq) const {
        const int row0 = u.pm * BM + wr * 64 + fr, j0 = u.pn * HALF + wc * 32 + 8 * fq; const float* bg = b1 + (size_t)u.e * 2048 + j0;
        const f32x4 g0 = *(const f32x4*)bg, g1 = *(const f32x4*)(bg + 4), u0 = *(const f32x4*)(bg + 1024), u1 = *(const f32x4*)(bg + 1028);
        float rsv[2][4];
#pragma unroll
        for (int ai = 0; ai < 2; ++ai)
#pragma unroll
            for (int m = 0; m < 4; ++m) rsv[ai][m] = rowrs[row0 + ai * HALF + m * 16];
        asm volatile("" ::: "memory");
#pragma unroll
        for (int ai = 0; ai < 2; ++ai)
#pragma unroll
            for (int m = 0; m < 4; ++m) { const float rs = rsv[ai][m] * WINV;
                const f32x4 a0 = acc[ai][0][m][0] * rs + g0, a1 = acc[ai][0][m][1] * rs + g1, c0 = acc[ai][1][m][0] * rs + u0, c1 = acc[ai][1][m][1] * rs + u1; f32x4 r0, r1;
#pragma unroll
                for (int j = 0; j < 4; j += 2) { const f32x2 s0 = swiglu2((f32x2){a0[j], a0[j + 1]}, (f32x2){c0[j], c0[j + 1]}), s1 = swiglu2((f32x2){a1[j], a1[j + 1]}, (f32x2){c1[j], c1[j + 1]}); r0[j] = s0.x; r0[j + 1] = s0.y; r1[j] = s1.x; r1[j + 1] = s1.y; }
                *(u32x2*)(HB + (size_t)(row0 + ai * HALF + m * 16) * DE + j0) = (u32x2){pk4_fp8(r0), pk4_fp8(r1)}; }
    }
};
struct EpiMoe2 {
    static constexpr bool PERM = true; static constexpr int MIDK = 0;
    unsigned char* Y; const float* b2; const int* rowslot; const float* rowgate;
    __device__ __forceinline__ void operator()(const Acc& acc, const Unit& u, int wr, int wc, int fr, int fq) const {
        const int row0 = u.pm * BM + wr * 64 + fr, col0 = u.pn * BM + wc * 64 + 16 * fq; const float* bb = b2 + (size_t)u.e * DM + col0;
        f32x4 bv[2][2];
#pragma unroll
        for (int bj = 0; bj < 2; ++bj)
#pragma unroll
            for (int n = 0; n < 2; ++n) bv[bj][n] = *(const f32x4*)(bb + bj * 8 + 4 * n);
        float gtv[2][4]; int slv[2][4];
#pragma unroll
        for (int ai = 0; ai < 2; ++ai)
#pragma unroll
            for (int m = 0; m < 4; ++m) { const int r = row0 + ai * HALF + m * 16; gtv[ai][m] = rowgate[r]; slv[ai][m] = rowslot[r]; }
        asm volatile("" ::: "memory");
#pragma unroll
        for (int ai = 0; ai < 2; ++ai)
#pragma unroll
            for (int m = 0; m < 4; ++m) { const float gt = gtv[ai][m]; unsigned char* yp = Y + (size_t)slv[ai][m] * DM + col0;
                *(u32x4*)yp = (u32x4){pk4_fp8((acc[ai][0][m][0] * WINV + bv[0][0]) * gt), pk4_fp8((acc[ai][0][m][1] * WINV + bv[0][1]) * gt), pk4_fp8((acc[ai][1][m][0] * WINV + bv[1][0]) * gt), pk4_fp8((acc[ai][1][m][1] * WINV + bv[1][1]) * gt)}; }
    }
};
struct EpiPle {
    static constexpr bool PERM = true; static constexpr int MIDK = 0;
    const bf16_t* H2; bf16_t* H3; const bf16_t* pler; const float* rpv; const float* rs2; const float* pg; float* fssq;
    __device__ __forceinline__ void operator()(const Acc& acc, const Unit& u, int wr, int wc, int fr, int fq) const {
        const int row0 = u.pm * BM + wr * 64 + fr, col0 = u.pn * BM + wc * 32 + 8 * fq;
        f32x4 gv[2][2];
#pragma unroll
        for (int bj = 0; bj < 2; ++bj)
#pragma unroll
            for (int n = 0; n < 2; ++n) gv[bj][n] = *(const f32x4*)(pg + col0 + bj * HALF + n * 4);
#pragma unroll
        for (int am = 0; am < 4; ++am) { const int ai = am >> 1; u32x4 hq[2][2], pq[2][2]; float r2v[2], rpq[2];
#pragma unroll
            for (int mm = 0; mm < 2; ++mm) { const int row = row0 + ai * HALF + ((am & 1) * 2 + mm) * 16; const size_t off = (size_t)row * DM + col0; r2v[mm] = rs2[row]; rpq[mm] = rpv[row];
#pragma unroll
                for (int bj = 0; bj < 2; ++bj) { hq[mm][bj] = *(const u32x4*)(H2 + off + bj * HALF); pq[mm][bj] = *(const u32x4*)(pler + off + bj * HALF); } }
            asm volatile("" ::: "memory");
#pragma unroll
            for (int mm = 0; mm < 2; ++mm) { const int m = (am & 1) * 2 + mm; const int row = row0 + ai * HALF + m * 16; const size_t off = (size_t)row * DM + col0; const float r2 = r2v[mm], rp = rpq[mm]; float ss = 0.f;
#pragma unroll
                for (int bj = 0; bj < 2; ++bj) { const size_t o = off + bj * HALF; const u32x4 hv = hq[mm][bj], pr = pq[mm][bj];
                    const f32x4 h0 = {blo(hv.x), bhi(hv.x), blo(hv.y), bhi(hv.y)}, h1 = {blo(hv.z), bhi(hv.z), blo(hv.w), bhi(hv.w)};
                    const f32x4 q0 = {blo(pr.x), bhi(pr.x), blo(pr.y), bhi(pr.y)}, q1 = {blo(pr.z), bhi(pr.z), blo(pr.w), bhi(pr.w)};
                    const f32x4 r0 = h0 + sigmoid4(acc[ai][bj][m][0] * r2) * (q0 * (gv[bj][0] * rp)), r1 = h1 + sigmoid4(acc[ai][bj][m][1] * r2) * (q1 * (gv[bj][1] * rp));
                    *(u32x4*)(H3 + o) = pack8(r0, r1); ss += sq4(r0) + sq4(r1); }
                ss = red_fq(ss); if (fq == 0) fssq[(size_t)row * 16 + u.pn * 4 + wc] = ss; }
            asm volatile("" ::: "memory"); }
    }
};
struct EpiPleFinal {
    static constexpr bool PERM = true; static constexpr int MIDK = 0;
    const bf16_t* H2; float* out; const bf16_t* pler; const float* rpv; const float* rs2; const float* pg; const float* gf; float* xs; unsigned* cnt; unsigned* tmo; LAS unsigned char* lds;
    __device__ __forceinline__ void operator()(Acc& acc, const Unit& u, int wr, int wc, int fr, int fq) const {
        const int row0 = u.pm * BM + wr * 64 + fr, col0 = u.pn * BM + wc * 32 + 8 * fq;
        LAS float* P = (LAS float*)(lds + STG_OFF); LAS float* S = P + 1024; const int tid = (wr * 4 + wc) * 64 + fq * 16 + fr;
#define PF_BAR() asm volatile("s_waitcnt lgkmcnt(0)\n\ts_barrier" ::: "memory")
        { f32x4 gv[2][2];
#pragma unroll
          for (int bj = 0; bj < 2; ++bj)
#pragma unroll
            for (int n = 0; n < 2; ++n) gv[bj][n] = *(const f32x4*)(pg + col0 + bj * HALF + n * 4);
#pragma unroll
          for (int am = 0; am < 4; ++am) { const int ai = am >> 1; u32x4 hq[2][2], pq[2][2]; float r2v[2], rpq[2];
#pragma unroll
            for (int mm = 0; mm < 2; ++mm) { const int row = row0 + ai * HALF + ((am & 1) * 2 + mm) * 16; const size_t off = (size_t)row * DM + col0; r2v[mm] = rs2[row]; rpq[mm] = rpv[row];
#pragma unroll
                for (int bj = 0; bj < 2; ++bj) { hq[mm][bj] = *(const u32x4*)(H2 + off + bj * HALF); pq[mm][bj] = *(const u32x4*)(pler + off + bj * HALF); } }
            asm volatile("" ::: "memory");
#pragma unroll
            for (int mm = 0; mm < 2; ++mm) { const int m = (am & 1) * 2 + mm; const float r2 = r2v[mm], rp = rpq[mm]; float ss = 0.f;
#pragma unroll
                for (int bj = 0; bj < 2; ++bj) { const u32x4 hv = hq[mm][bj], pr = pq[mm][bj];
                    const f32x4 h0 = {blo(hv.x), bhi(hv.x), blo(hv.y), bhi(hv.y)}, h1 = {blo(hv.z), bhi(hv.z), blo(hv.w), bhi(hv.w)};
                    const f32x4 q0 = {blo(pr.x), bhi(pr.x), blo(pr.y), bhi(pr.y)}, q1 = {blo(pr.z), bhi(pr.z), blo(pr.w), bhi(pr.w)};
                    const f32x4 r0 = h0 + sigmoid4(acc[ai][bj][m][0] * r2) * (q0 * (gv[bj][0] * rp)), r1 = h1 + sigmoid4(acc[ai][bj][m][1] * r2) * (q1 * (gv[bj][1] * rp));
                    acc[ai][bj][m][0] = r0; acc[ai][bj][m][1] = r1; ss += sq4(r0) + sq4(r1); }
                ss = red_fq(ss); if (fq == 0) P[(ai * HALF + wr * 64 + m * 16 + fr) * 4 + wc] = ss; }
            asm volatile("" ::: "memory"); } }
        PF_BAR();
        if (tid < 256) { const f32x4 p4 = *(const LAS f32x4*)(P + tid * 4); __hip_atomic_store(xs + (size_t)(u.pm * 4 + u.pn) * 256 + tid, (p4[0] + p4[1]) + (p4[2] + p4[3]), __ATOMIC_RELAXED, __HIP_MEMORY_SCOPE_AGENT); }
        asm volatile("s_waitcnt vmcnt(0)" ::: "memory");
        PF_BAR();
        if (tid < 64) {
            if (tid == 0) (void)__hip_atomic_fetch_add(cnt + 64 * u.pm, 1u, __ATOMIC_RELAXED, __HIP_MEMORY_SCOPE_AGENT);
            unsigned sp = 0;
            while ((unsigned)__builtin_amdgcn_readfirstlane(__hip_atomic_load(cnt + 64 * u.pm, __ATOMIC_RELAXED, __HIP_MEMORY_SCOPE_AGENT)) < 4u) {
                __builtin_amdgcn_s_sleep(2); if (++sp > (1u << 22)) { if (tid == 0) __hip_atomic_store(tmo, 1u, __ATOMIC_RELAXED, __HIP_MEMORY_SCOPE_AGENT); break; } }
            __builtin_amdgcn_fence(__ATOMIC_ACQUIRE, "agent");
            asm volatile("s_waitcnt vmcnt(0)" ::: "memory"); }
        PF_BAR();
        if (tid < 256) { float t = 0.f;
#pragma unroll
            for (int q = 0; q < 4; ++q) t += __hip_atomic_load(xs + (size_t)(u.pm * 4 + q) * 256 + tid, __ATOMIC_RELAXED, __HIP_MEMORY_SCOPE_AGENT);
            S[tid] = rsqrtf(t * (1.f / DM) + EPS); }
        PF_BAR();
        { f32x4 gq[2][2];
#pragma unroll
          for (int bj = 0; bj < 2; ++bj)
#pragma unroll
            for (int n = 0; n < 2; ++n) gq[bj][n] = *(const f32x4*)(gf + col0 + bj * HALF + n * 4);
#pragma unroll
          for (int ai = 0; ai < 2; ++ai)
#pragma unroll
            for (int m = 0; m < 4; ++m) { const float rs = S[ai * HALF + wr * 64 + m * 16 + fr]; float* op = out + (size_t)(row0 + ai * HALF + m * 16) * DM + col0;
#pragma unroll
                for (int bj = 0; bj < 2; ++bj) { *(f32x4*)(op + bj * HALF) = acc[ai][bj][m][0] * rs * gq[bj][0]; *(f32x4*)(op + bj * HALF + 4) = acc[ai][bj][m][1] * rs * gq[bj][1]; } } }
        PF_BAR();
#undef PF_BAR
    }
};
}

namespace att {
typedef float f32x16 __attribute__((ext_vector_type(16)));
typedef short s16x4 __attribute__((ext_vector_type(4)));
constexpr int QBLK = 32, KVBLK = 64, QB = 256;
constexpr int SHM_K = KVBLK * DQK * 2, SHM_V = KVBLK * DV * 2;
constexpr int L_V = 0, L_K = 2 * SHM_V, L_WS = L_K + 2 * SHM_K, L_END = L_WS + NWAVES * 256;
constexpr float THR = 8.f;
#define KSWZ(row, colB) ((row) * 384 + ((colB) ^ (((row) & 7) << 4)))
#define SBAR() __builtin_amdgcn_sched_barrier(0)
__device__ __forceinline__ int v_st(int k, int c) { const int kk = (k & ~0xC) | ((k & 4) << 1) | ((k & 8) >> 1); return ((kk >> 3) * 4 + (c >> 5)) * 512 + ((kk & 7) * 32 + (c & 31)) * 2; }
__device__ __forceinline__ int v_rd_base(int lane) { return ((lane & 3) << 3) | (((lane >> 2) & 3) << 6) | (((lane >> 4) & 1) << 5) | (((lane >> 5) & 1) << 8); }
constexpr int v_rd_off(int d0, int ks, int half) { return d0 * 512 + ks * 4096 + half * 2048; }
__device__ __forceinline__ int crow(int r, int hi) { return (r & 3) + 8 * (r >> 2) + 4 * hi; }
typedef __bf16 bf16x2_t __attribute__((ext_vector_type(2)));
__device__ __forceinline__ unsigned cvtpk(float lo, float hi) { f32x2 v = {lo, hi}; bf16x2_t b = __builtin_convertvector(v, bf16x2_t); return __builtin_bit_cast(unsigned, b); }

__device__ __forceinline__ void qkt(f32x16& p0, f32x16& p1, const LAS unsigned char* Kbuf, int r32, int hi, const bf16x8* qr) {
    p0 = f32x16{}; p1 = f32x16{};
    const LAS unsigned char* kb[4];
#pragma unroll
    for (int dd = 0; dd < 4; ++dd) kb[dd] = Kbuf + KSWZ(r32, (dd * 16 + hi * 8) * 2);
#pragma unroll
    for (int d0 = 0; d0 < 12; ++d0) { const LAS unsigned char* a = kb[d0 & 3] + (d0 >> 2) * 128;
        const bf16x8 b0 = *(const LAS bf16x8*)a; const bf16x8 b1 = *(const LAS bf16x8*)(a + 32 * 384);
        p0 = __builtin_amdgcn_mfma_f32_32x32x16_bf16(b0, qr[d0], p0, 0, 0, 0);
        p1 = __builtin_amdgcn_mfma_f32_32x32x16_bf16(b1, qr[d0], p1, 0, 0, 0); }
}
template <int VB>
__device__ __forceinline__ void pv_tile(f32x16* o, int vb0, bf16x8 pa0, bf16x8 pa1, bf16x8 pa2, bf16x8 pa3) {
#define TRRD(dst, off) asm volatile("ds_read_b64_tr_b16 %0, %1 offset:%2" : "=&v"(dst) : "v"(vb0), "i"(off) : "memory")
#define PV_D0(d0) do { s16x4 l0, l1, l2, l3, h0, h1, h2, h3; constexpr int b_ = VB * SHM_V + v_rd_off(d0, 0, 0); \
        TRRD(l0, b_); TRRD(h0, b_ + 2048); TRRD(l1, b_ + 4096); TRRD(h1, b_ + 6144); TRRD(l2, b_ + 8192); TRRD(h2, b_ + 10240); TRRD(l3, b_ + 12288); TRRD(h3, b_ + 14336); \
        asm volatile("s_waitcnt lgkmcnt(0)" ::: "memory"); SBAR(); \
        o[d0] = __builtin_amdgcn_mfma_f32_32x32x16_bf16(pa0, (bf16x8){l0[0], l0[1], l0[2], l0[3], h0[0], h0[1], h0[2], h0[3]}, o[d0], 0, 0, 0); \
        o[d0] = __builtin_amdgcn_mfma_f32_32x32x16_bf16(pa1, (bf16x8){l1[0], l1[1], l1[2], l1[3], h1[0], h1[1], h1[2], h1[3]}, o[d0], 0, 0, 0); \
        o[d0] = __builtin_amdgcn_mfma_f32_32x32x16_bf16(pa2, (bf16x8){l2[0], l2[1], l2[2], l2[3], h2[0], h2[1], h2[2], h2[3]}, o[d0], 0, 0, 0); \
        o[d0] = __builtin_amdgcn_mfma_f32_32x32x16_bf16(pa3, (bf16x8){l3[0], l3[1], l3[2], l3[3], h3[0], h3[1], h3[2], h3[3]}, o[d0], 0, 0, 0); } while (0)
    PV_D0(0); PV_D0(1); PV_D0(2); PV_D0(3);
#undef PV_D0
#undef TRRD
}
struct ConvJob { const float* w1; const float* w2; const float* gain; unsigned char* W1T; unsigned char* W2T; int gw, ngw; };
constexpr int CV_N1 = NE * 32 * 64, CV_N2 = NE * 32 * 32, CV_TOTAL = CV_N1 + CV_N2;
__device__ __forceinline__ int cv_cmap2(int n) { const int t = n & ~255, v = n & 255; return t + 64 * ((v >> 5) & 3) + 16 * ((v >> 3) & 3) + 8 * (v >> 7) + (v & 7); }
__device__ __forceinline__ int cv_cmap1(int n) { const int pn = n >> 8, half = (n >> 7) & 1, jj = n & 127; return half * 1024 + pn * 128 + jj; }
#define CV_DECODE(idx) \
    const bool cv_on = (idx) < CV_TOTAL; const bool cv_is1 = (idx) < CV_N1; const int cv_r = cv_is1 ? (idx) : (idx) - CV_N1; \
    const int cv_nblk = cv_is1 ? 64 : 32, cv_ld = cv_is1 ? 2048 : 1024; const int cv_e = cv_r / (32 * cv_nblk), cv_q = cv_r % (32 * cv_nblk), cv_k0 = 32 * (cv_q / cv_nblk), cv_n0 = 32 * (cv_q % cv_nblk); \
    const float* cv_src = (cv_is1 ? cj.w1 + (size_t)cv_e * 1024 * 2048 : cj.w2 + (size_t)cv_e * 1024 * 1024); \
    const int cv_c = cv_is1 ? cv_cmap1(cv_n0 + (lane & 31)) : cv_cmap2(cv_n0 + (lane & 31));
#define CV_LOAD() do { if (cv_on) { _Pragma("unroll") for (int i = 0; i < 16; ++i) cvw[i] = cv_src[(size_t)(cv_k0 + 2 * i + hi) * cv_ld + cv_c]; } } while (0)
#define CV_STORE() do { if (cv_on) { LAS float* scr = (LAS float*)(lds + L_END) + wid * (32 * 33); \
        _Pragma("unroll") for (int i = 0; i < 16; ++i) { const int kk = 2 * i + hi; scr[kk * 33 + (lane & 31)] = cvw[i] * 64.f; } \
        asm volatile("s_waitcnt lgkmcnt(0)" ::: "memory"); \
        { const int n = lane >> 1, cc = lane & 1; const LAS float* s = scr + (16 * cc) * 33 + n; u32x4 o; \
          o.x = pg8::pk4_fp8((f32x4){s[0 * 33], s[1 * 33], s[2 * 33], s[3 * 33]}); o.y = pg8::pk4_fp8((f32x4){s[4 * 33], s[5 * 33], s[6 * 33], s[7 * 33]}); \
          o.z = pg8::pk4_fp8((f32x4){s[8 * 33], s[9 * 33], s[10 * 33], s[11 * 33]}); o.w = pg8::pk4_fp8((f32x4){s[12 * 33], s[13 * 33], s[14 * 33], s[15 * 33]}); \
          unsigned char* dst = (cv_is1 ? cj.W1T + (size_t)cv_e * 2048 * 1024 : cj.W2T + (size_t)cv_e * 1024 * 1024) + (size_t)(cv_n0 + n) * 1024 + cv_k0 + 16 * cc; *(u32x4*)dst = o; } \
        asm volatile("s_waitcnt lgkmcnt(0)" ::: "memory"); } } while (0)
__device__ __forceinline__ void attn_block(int bh, int qb, const bf16_t* __restrict__ Q, const bf16_t* __restrict__ K, const bf16_t* __restrict__ V, bf16_t* __restrict__ MIX, float* __restrict__ ASSQ, LAS unsigned char* lds, const int wid, const ConvJob& cj, int& tseq) {
    const int lane = lane_id(), r32 = lane & 31, hi = lane >> 5;
    const int b = bh / NH, h = bh % NH;
    const bf16_t* Qw = Q + ((size_t)bh * SEQ + qb * QB + wid * QBLK + r32) * DQK;
    const bf16_t* Kh = K + (size_t)bh * SEQ * DQK; const bf16_t* Vh = V + (size_t)bh * SEQ * DV;
    bf16x8 qr[12];
#pragma unroll
    for (int d0 = 0; d0 < 12; ++d0) qr[d0] = *(const bf16x8*)(Qw + d0 * 16 + hi * 8);
    const int NT = 4 * qb + 4, qlo = qb * QB + wid * QBLK, qm = qlo + r32 - 4 * hi;
    LAS unsigned char* V_lds = lds + L_V; LAS unsigned char* K_lds = lds + L_K;
    LAS float* wsf = (LAS float*)(lds + L_WS) + wid * 64; LAS float* li_l = wsf; LAS float* al_l = wsf + 32;
    unsigned ksrc[3], vsrc[2];
#pragma unroll
    for (int i = 0; i < 3; ++i) { const int off = ((wid + 8 * i) * 64 + lane) * 16, row = off / 384, wb = off % 384, seg = wb >> 7, cpos = (wb & 127) >> 4; ksrc[i] = (unsigned)(row * 384 + seg * 128 + ((cpos ^ (row & 7)) << 4)); }
#pragma unroll
    for (int i = 0; i < 2; ++i) { const int off = ((wid + 8 * i) * 64 + lane) * 16, st = off >> 9, o_ = off & 511, kk = (st >> 2) * 8 + (o_ >> 6), c = (st & 3) * 32 + ((o_ & 63) >> 1);
        const int k = (kk & ~0xC) | ((kk & 4) << 1) | ((kk & 8) >> 1); vsrc[i] = (unsigned)(k * 256 + c * 2); }
    const int vb0 = (int)(unsigned)(uintptr_t)V_lds + v_rd_base(lane);
#define ADMA(t, bf) do { const char* kp = (const char*)(Kh + (size_t)(t) * KVBLK * DQK); const char* vp = (const char*)(Vh + (size_t)(t) * KVBLK * DV); \
        _Pragma("unroll") for (int i = 0; i < 3; ++i) __builtin_amdgcn_global_load_lds((const unsigned*)(kp + ksrc[i]), (LAS unsigned*)(K_lds + (bf) * SHM_K + (wid + 8 * i) * 1024), 16, 0, 0); \
        _Pragma("unroll") for (int i = 0; i < 2; ++i) __builtin_amdgcn_global_load_lds((const unsigned*)(vp + vsrc[i]), (LAS unsigned*)(V_lds + (bf) * SHM_V + (wid + 8 * i) * 1024), 16, 0, 0); } while (0)
    float m_reg = -1e30f, l_reg = 0.f; f32x16 o[4] = {}; float cvw[16]; int cv_pend = -1;
    ADMA(0, 0);
#define TILE(t, BF) do { \
        asm volatile("s_waitcnt vmcnt(0)" ::: "memory"); __syncthreads(); \
        if ((t) + 1 < NT) ADMA((t) + 1, (BF) ^ 1); \
        if (cv_pend >= 0) { CV_DECODE(cv_pend) CV_STORE(); }     \
        { const int cv_idx = tseq * cj.ngw + cj.gw; ++tseq; CV_DECODE(cv_idx) CV_LOAD(); cv_pend = cv_on ? cv_idx : -1; } SBAR(); \
        const int kb_ = (t) * KVBLK; \
        if (kb_ <= qlo + QBLK - 1) { \
            f32x16 p0, p1; SBAR(); qkt(p0, p1, K_lds + (BF) * SHM_K, r32, hi, qr); \
            if (kb_ + KVBLK - 1 > qlo) { const int dq = qm - kb_; const float NEG = -__builtin_inff(); \
                _Pragma("unroll") for (int r = 0; r < 16; ++r) { const int c = (r & 3) + 8 * (r >> 2); if (c > dq) p0[r] = NEG; if (c + 32 > dq) p1[r] = NEG; } } \
            float pmax = p0[0]; _Pragma("unroll") for (int r = 1; r < 16; ++r) pmax = fmaxf(pmax, p0[r]); _Pragma("unroll") for (int r = 0; r < 16; ++r) pmax = fmaxf(pmax, p1[r]); \
            { auto rr = __builtin_amdgcn_permlane32_swap(__float_as_uint(pmax), __float_as_uint(pmax), false, false); pmax = fmaxf(__uint_as_float(rr[0]), __uint_as_float(rr[1])); } \
            if (!__all(pmax - m_reg <= THR)) { const float mn = fmaxf(m_reg, pmax); const float alpha = __builtin_amdgcn_exp2f(m_reg - mn); m_reg = mn; l_reg *= alpha; \
                if (hi == 0) al_l[r32] = alpha; asm volatile("s_waitcnt lgkmcnt(0)" ::: "memory"); \
                _Pragma("unroll") for (int d_ = 0; d_ < 4; ++d_) _Pragma("unroll") for (int r = 0; r < 16; ++r) o[d_][r] *= al_l[crow(r, hi)]; } \
            float ps = 0.f; \
            _Pragma("unroll") for (int r = 0; r < 16; ++r) { p0[r] = __builtin_amdgcn_exp2f(p0[r] - m_reg); p1[r] = __builtin_amdgcn_exp2f(p1[r] - m_reg); } \
            _Pragma("unroll") for (int r = 0; r < 16; ++r) ps += p0[r] + p1[r]; \
            { auto rr = __builtin_amdgcn_permlane32_swap(__float_as_uint(ps), __float_as_uint(ps), false, false); ps = __uint_as_float(rr[0]) + __uint_as_float(rr[1]); } \
            l_reg += ps; \
            bf16x8 pa0, pa1, pa2, pa3; \
            PK4(p0, 0, pa0); PK4(p0, 8, pa1); PK4(p1, 0, pa2); PK4(p1, 8, pa3); \
            SBAR(); pv_tile<BF>(o, vb0, pa0, pa1, pa2, pa3); } \
        } while (0)
#define PK4(P, B_, OUT) do { unsigned a0 = cvtpk(P[B_ + 0], P[B_ + 1]), a1 = cvtpk(P[B_ + 2], P[B_ + 3]); \
        unsigned b0 = cvtpk(P[B_ + 4], P[B_ + 5]), b1 = cvtpk(P[B_ + 6], P[B_ + 7]); \
        auto r0 = __builtin_amdgcn_permlane32_swap(a0, b0, false, false); auto r1 = __builtin_amdgcn_permlane32_swap(a1, b1, false, false); \
        u32x4 w = {r0[0], r1[0], r0[1], r1[1]}; OUT = __builtin_bit_cast(bf16x8, w); } while (0)
    for (int t = 0; t < NT; t += 2) { TILE(t, 0); TILE(t + 1, 1); }
#undef PK4
#undef TILE
#undef ADMA
    if (cv_pend >= 0) { asm volatile("s_waitcnt vmcnt(0)" ::: "memory"); CV_DECODE(cv_pend) CV_STORE(); }
    if (hi == 0) li_l[r32] = l_reg;
    asm volatile("s_waitcnt vmcnt(0) lgkmcnt(0)" ::: "memory");
    float rli[16];
#pragma unroll
    for (int r = 0; r < 16; ++r) rli[r] = __builtin_amdgcn_rcpf(li_l[crow(r, hi)]);
    __syncthreads();
    LAS bf16_t* stg = (LAS bf16_t*)(lds + wid * 8192);
#pragma unroll
    for (int r = 0; r < 16; ++r) { const int orow = crow(r, hi);
#pragma unroll
        for (int d0 = 0; d0 < 4; ++d0) stg[orow * 128 + d0 * 32 + r32] = f2bf(o[d0][r] * rli[r]); }
    asm volatile("s_waitcnt lgkmcnt(0)" ::: "memory");
    const size_t row0 = (size_t)b * SEQ + qb * QB + wid * QBLK;
#pragma unroll
    for (int i = 0; i < 8; ++i) { const int row = i * 4 + (lane >> 4), ch = lane & 15; const u32x4 v = *(const LAS u32x4*)(stg + row * 128 + ch * 8);
        float ss = (blo(v.x) * blo(v.x) + bhi(v.x) * bhi(v.x)) + (blo(v.y) * blo(v.y) + bhi(v.y) * bhi(v.y)) + (blo(v.z) * blo(v.z) + bhi(v.z) * bhi(v.z)) + (blo(v.w) * blo(v.w) + bhi(v.w) * bhi(v.w));
        ss += __shfl_xor(ss, 1); ss += __shfl_xor(ss, 2); ss += __shfl_xor(ss, 4); ss += __shfl_xor(ss, 8);
        *(u32x4*)(MIX + (row0 + row) * DM + h * DV + ch * 8) = v;
        if (ch == 0) ASSQ[(row0 + row) * 4 + h] = ss; }
    __syncthreads();
}
#undef KSWZ
#undef SBAR
}

struct Args { const void* in[25]; float* out; unsigned char* ws; int ph_lo, ph_hi, li, skip; };
enum { PH_PREP = 0, PH_INPROJ, PH_TOKLOCAL, PH_ATTN, PH_WO, PH_ROUTER, PH_ROUTE, PH_MOE1, PH_MOE2, PH_COMBINE, PH_PLE, PH_FINAL, PH_COUNT };

template <int MODE> __device__ __forceinline__ int cmap_col(int n) {
    if (MODE == 1) { const int pn = n >> 8, half = (n >> 7) & 1, jj = n & 127; return half * 1024 + pn * 128 + jj; }
    if (MODE == 2) { const int h = n / DQK, d = n % DQK; if (d < DN) return n; const int t = d - DN; return h * DQK + DN + (t & 1) * 32 + (t >> 1); }
    return n;
}
template <int MODE> __device__ __forceinline__ void transpose_item_fp8(const float* __restrict__ W, int ldsrc, int nblk, unsigned char* __restrict__ WT, int ldd, const float* __restrict__ gain, float scale,
                                                                      LAS float* scr, int item, int lane) {
    const int kb = item / nblk, nb = item % nblk, k0 = 64 * kb, n0 = 32 * nb; const int c = cmap_col<MODE>(n0 + (lane & 31));
    float wv[32];
#pragma unroll
    for (int i = 0; i < 32; ++i) wv[i] = W[(size_t)(k0 + 2 * i + (lane >> 5)) * ldsrc + c];
#pragma unroll
    for (int i = 0; i < 32; ++i) { const int kk = 2 * i + (lane >> 5), k = k0 + kk; float gk = scale; if (gain) gk *= gain[k]; scr[kk * 33 + (lane & 31)] = wv[i] * gk; }
    asm volatile("s_waitcnt lgkmcnt(0)" ::: "memory");
    const int cc = lane & 3;
#pragma unroll
    for (int j = 0; j < 2; ++j) { const int n = (lane >> 2) + 16 * j; const LAS float* s = scr + (16 * cc) * 33 + n; u32x4 o;
        o.x = pg8::pk4_fp8((f32x4){s[0 * 33], s[1 * 33], s[2 * 33], s[3 * 33]}); o.y = pg8::pk4_fp8((f32x4){s[4 * 33], s[5 * 33], s[6 * 33], s[7 * 33]});
        o.z = pg8::pk4_fp8((f32x4){s[8 * 33], s[9 * 33], s[10 * 33], s[11 * 33]}); o.w = pg8::pk4_fp8((f32x4){s[12 * 33], s[13 * 33], s[14 * 33], s[15 * 33]});
        *(u32x4*)(WT + (size_t)(n0 + n) * ldd + k0 + 16 * cc) = o; }
    asm volatile("s_waitcnt lgkmcnt(0)" ::: "memory");
}
template <int MODE> __device__ __forceinline__ void transpose_item(const float* __restrict__ W, int ldsrc, int nblk, bf16_t* __restrict__ WT, int ldd, const float* __restrict__ gain, const float* __restrict__ gain2, float scale,
                                                                  LAS float* scr, int item, int lane) {
    const int kb = item / nblk, nb = item % nblk, k0 = 64 * kb, n0 = 32 * nb; const int c = cmap_col<MODE>(n0 + (lane & 31));
    float wv[32], gq[32];
#pragma unroll
    for (int i = 0; i < 32; ++i) wv[i] = W[(size_t)(k0 + 2 * i + (lane >> 5)) * ldsrc + c];
#pragma unroll
    for (int i = 0; i < 32; ++i) { const int k = k0 + 2 * i + (lane >> 5); gq[i] = gain ? ((gain2 && k >= 512) ? gain2[k - 512] : gain[k]) : 1.f; }
    asm volatile("" ::: "memory");
#pragma unroll
    for (int i = 0; i < 32; ++i) { const int kk = 2 * i + (lane >> 5); scr[kk * 33 + (lane & 31)] = wv[i] * (gq[i] * scale); }
    asm volatile("s_waitcnt lgkmcnt(0)" ::: "memory");
    const int cc = lane & 7;
#pragma unroll
    for (int j = 0; j < 4; ++j) { const int n = (lane >> 3) + 8 * j; const LAS float* s = scr + (8 * cc) * 33 + n;
        u32x4 o; o.x = pk2(s[0 * 33], s[1 * 33]); o.y = pk2(s[2 * 33], s[3 * 33]); o.z = pk2(s[4 * 33], s[5 * 33]); o.w = pk2(s[6 * 33], s[7 * 33]);
        *(u32x4*)(WT + (size_t)(n0 + n) * ldd + k0 + 8 * cc) = o; }
    asm volatile("s_waitcnt lgkmcnt(0)" ::: "memory");
}

__global__ void __launch_bounds__(NTHREADS, 2) fwd(Args args) {
    extern __shared__ __attribute__((aligned(16))) unsigned char lds_raw[];
    LAS unsigned char* lds = (LAS unsigned char*)lds_raw;
    volatile LAS unsigned* MISC = (volatile LAS unsigned*)(lds + MISC_OFF);
    const int wave = __builtin_amdgcn_readfirstlane(threadIdx.x >> 6);
    const int G = gridDim.x, bx = blockIdx.x;
#define PHASE_LANE const int lane = lane_id(); const int tid = wave * 64 + lane; (void)tid
    const int gw = bx * NWAVES + wave, NGW = G * NWAVES;
    unsigned char* ws = args.ws; int* ctl = (int*)(ws + WS_CTL); float* H = args.out;
    const float* x = (const float*)args.in[0]; const float* p = (const float*)args.in[1]; const int* pos = (const int*)args.in[2];
    const float *mix_norm = (const float*)args.in[3], *w_in = (const float*)args.in[4], *q_norm = (const float*)args.in[5], *w_uq = (const float*)args.in[6], *kv_norm = (const float*)args.in[7],
                *w_ukv = (const float*)args.in[8], *attn_out_norm = (const float*)args.in[10], *conv_out_norm = (const float*)args.in[11], *w_o = (const float*)args.in[12],
                *moe_norm = (const float*)args.in[13], *w_router = (const float*)args.in[14], *w1 = (const float*)args.in[16], *b1 = (const float*)args.in[17],
                *w2 = (const float*)args.in[18], *b2 = (const float*)args.in[19], *ple_norm = (const float*)args.in[20], *w_ple_gate = (const float*)args.in[21], *w_ple_proj = (const float*)args.in[22],
                *ple_post_norm = (const float*)args.in[23], *conv_w = (const float*)args.in[9], *b_router = (const float*)args.in[15], *final_norm = (const float*)args.in[24];
    int* TOPI = (int*)(ws + WS_TOPI); float* TOPG = (float*)(ws + WS_TOPG);
    bf16_t *HBF = (bf16_t*)(ws + WS_HBF), *H3 = (bf16_t*)(ws + WS_H3), *WRHL = (bf16_t*)(ws + WS_WRHL); unsigned char* X8 = (unsigned char*)(ws + WS_K);
    float* RSX = (float*)(ws + WS_RSX);
    float *SSQ1 = (float*)(ws + WS_SSQ1), *RS1 = (float*)(ws + WS_RS1), *RS2 = (float*)(ws + WS_RS2), *ROWRS = (float*)(ws + WS_ROWRS);
    bf16_t *WIN = (bf16_t*)(ws + WS_WIN), *WUQ = (bf16_t*)(ws + WS_WUQ), *WUKV = (bf16_t*)(ws + WS_WUKV), *WO = (bf16_t*)(ws + WS_WO), *WG = (bf16_t*)(ws + WS_WG), *WP = (bf16_t*)(ws + WS_WP);
    bf16_t *W1T = (bf16_t*)(ws + WS_W1), *W2T = (bf16_t*)(ws + WS_W2), *XN = (bf16_t*)(ws + WS_XN), *MIX = (bf16_t*)(ws + WS_MIX), *PLER = (bf16_t*)(ws + WS_PLER);
    bf16_t *Z = (bf16_t*)(ws + WS_Z), *Qb = (bf16_t*)(ws + WS_Q), *Kb = (bf16_t*)(ws + WS_K), *Vb = (bf16_t*)(ws + WS_V), *HB = (bf16_t*)(ws + WS_HB), *Y = (bf16_t*)(ws + WS_Y), *P16 = (bf16_t*)(ws + WS_P16);
    float *WR = (float*)(ws + WS_WR), *CS = (float*)(ws + WS_CS), *SSQ = (float*)(ws + WS_SSQ), *ASSQ = (float*)(ws + WS_ASSQ), *PSSQ = (float*)(ws + WS_PSSQ), *FSSQ = (float*)(ws + WS_FSSQ);
    int *ROWTOK = (int*)(ws + WS_ROWTOK), *ROWSLOT = (int*)(ws + WS_ROWSLOT); float* ROWGATE = (float*)(ws + WS_ROWGATE);

    { PHASE_LANE; for (int u = tid; u < (LDS_BYTES - MISC_OFF) / 4; u += NTHREADS) ((LAS unsigned*)(lds + MISC_OFF))[u] = 0u; }
    __syncthreads();
    const int lo = args.ph_lo, hi = args.ph_hi;
    XcdBarrier bar; bar.bar = (unsigned*)ctl + CW_BAR + args.li * XCD_BAR_WORDS; bar.x = 0; bar.st = MISC + 8;
    if (hi - lo > 1) bar = xcd_barrier_post((unsigned*)ctl + CW_BAR + args.li * XCD_BAR_WORDS, MISC + 8, wave);
#define IN(k) (lo <= (k) && (k) < hi)
#define NREP(k) ((PROBE_PH == (k)) ? PROBE_REP : 1)
#define REPLOOP(k) for (int rep = 0; rep < NREP(k); ++rep)
#define LASTREP(k) (rep == NREP(k) - 1)
#ifdef PROBE_TIME_PH
#define STAMP(k) do { if (bx == 0 && wave == 0) MISC[32 + (k)] = (unsigned)__builtin_amdgcn_s_memrealtime(); } while (0)
#else
#define STAMP(k) do { } while (0)
#endif
#define SEAM(k) do { if (IN(k) && IN((k) + 1)) xcd_barrier(bar, wave); STAMP((k) + 1); } while (0)
    STAMP(0);

    if (IN(PH_PREP)) REPLOOP(PH_PREP) {
        PHASE_LANE;
        LAS float* scr = (LAS float*)(lds + wave * 16384);
        constexpr int I_IN = (DM / 64) * (INW / 32), I_UQ = (QL / 64) * (768 / 32), I_UKV = (KVL / 64) * (1024 / 32), I_O = (DM / 64) * (DM / 32), I_G = I_O, I_P = (PLE / 64) * (DM / 32);
        constexpr int I_1 = (DM / 64) * (2048 / 32), I_2 = (DE / 64) * (DM / 32);
        constexpr int NITEMS = I_IN + I_UQ + I_UKV + I_O + I_G + I_P;
        for (int it = gw; it < NITEMS; it += NGW) {
            int r = it;
            if (r < I_IN) { transpose_item<0>(w_in, INW, INW / 32, WIN, DM, mix_norm, nullptr, 1.f, scr, r, lane); continue; } r -= I_IN;
            if (r < I_UQ) { transpose_item<2>(w_uq, 768, 768 / 32, WUQ, QL, q_norm, nullptr, QSCALE, scr, r, lane); continue; } r -= I_UQ;
            if (r < I_UKV) { transpose_item<0>(w_ukv, 1024, 1024 / 32, WUKV, 256, kv_norm, nullptr, 1.f, scr, r, lane); continue; } r -= I_UKV;
            if (r < I_O) { transpose_item<0>(w_o, DM, DM / 32, WO, DM, attn_out_norm, conv_out_norm, 1.f, scr, r, lane); continue; } r -= I_O;
            if (r < I_G) { transpose_item<0>(w_ple_gate, DM, DM / 32, WG, DM, ple_norm, nullptr, 1.f, scr, r, lane); continue; } r -= I_G;
            transpose_item<0>(w_ple_proj, DM, DM / 32, WP, PLE, nullptr, nullptr, 1.f, scr, r, lane);
        }
        for (int i = bx * NTHREADS + tid; i < 1024 * 16; i += G * NTHREADS) *(u32x4*)(WUKV + (size_t)(i >> 4) * 256 + 128 + (i & 15) * 8) = (u32x4){0u, 0u, 0u, 0u};
        for (int i = bx * NTHREADS + tid; i < DM * NE; i += G * NTHREADS) { const int e = i >> 10, k = i & 1023; const float w = w_router[k * NE + e] * moe_norm[k]; const bf16_t whi = f2bf(w);
            WRHL[i] = whi; WRHL[DM * NE + i] = f2bf(w - bf2f(whi)); }
        for (int i = bx * NTHREADS + tid; i < NTOK * 32; i += G * NTHREADS) { const int t = i >> 5, j = i & 31; const float inv = powf(10000.f, -(float)j / 32.f); const float a = (float)pos[t] * inv; float sn, c; sincosf(a, &sn, &c);
            CS[(size_t)t * 64 + j] = c; CS[(size_t)t * 64 + 32 + j] = sn; }
        for (int i = bx * NTHREADS + tid; i < NTOK * PLE / 4; i += 4 * G * NTHREADS) { f32x4 v[4];
#pragma unroll
            for (int q = 0; q < 4; ++q) { const int ii = i + q * G * NTHREADS; v[q] = ii < NTOK * PLE / 4 ? ((const f32x4*)p)[ii] : (f32x4){0.f, 0.f, 0.f, 0.f}; }
#pragma unroll
            for (int q = 0; q < 4; ++q) { const int ii = i + q * G * NTHREADS; if (ii < NTOK * PLE / 4) ((u32x2*)P16)[ii] = (u32x2){pk2(v[q][0], v[q][1]), pk2(v[q][2], v[q][3])}; } }
        for (int row = gw * 4; row < NTOK; row += NGW * 4) {
            f32x4 v[4][4]; float ss[4];
#pragma unroll
            for (int q = 0; q < 4; ++q) { const f32x4* s = (const f32x4*)(x + (size_t)(row + q) * DM);
#pragma unroll
                for (int j = 0; j < 4; ++j) v[q][j] = s[lane + 64 * j]; }
#pragma unroll
            for (int q = 0; q < 4; ++q) { ss[q] = 0.f;
#pragma unroll
                for (int j = 0; j < 4; ++j) ss[q] += pg8::sq4(v[q][j]); }
#pragma unroll
            for (int q = 0; q < 4; ++q) { const float rstd = rsqrtf(wave_sum(ss[q]) * (1.f / DM) + EPS); u32x2* d = (u32x2*)(XN + (size_t)(row + q) * DM); if (lane == 0) RSX[row + q] = rstd;
#pragma unroll
                for (int j = 0; j < 4; ++j) d[lane + 64 * j] = (u32x2){pk2(v[q][j][0], v[q][j][1]), pk2(v[q][j][2], v[q][j][3])}; }
        }
    }
    SEAM(PH_PREP);
    if (IN(PH_INPROJ)) REPLOOP(PH_INPROJ) {
        { pg8::Gemm g{XN, WIN, DM, DM, DM, nullptr, 0}; pg8::StaticOrder S; S.init(NTOK / 256, INWP / 256, G, bx, nullptr);
          pg8::EpiBf16Stats<0> E{Z, INWP, SSQ, RSX}; pg8::gemm_phase<pg8::EpiBf16Stats<0>, false>(lds, g, S, E, wave); }
        { pg8::Gemm g{P16, WP, PLE, PLE, PLE, nullptr, 0}; pg8::StaticOrder S; S.init(NTOK / 256, DM / 256, G, bx, nullptr);
          pg8::EpiBf16Stats<1> E{PLER, DM, PSSQ, nullptr}; pg8::gemm_phase<pg8::EpiBf16Stats<1>, false>(lds, g, S, E, wave); }
    }
    SEAM(PH_INPROJ);
    if (IN(PH_TOKLOCAL)) REPLOOP(PH_TOKLOCAL) {
        PHASE_LANE;
        if (!(args.skip & 1)) for (int r0 = gw * 16; r0 < NTOK; r0 += NGW * 16) {
            const int c8 = lane * 8; f32x4 w0[2], w1[2], w2[2];
#pragma unroll
            for (int q = 0; q < 2; ++q) { w0[q] = *(const f32x4*)(conv_w + c8 + 4 * q); w1[q] = *(const f32x4*)(conv_w + 512 + c8 + 4 * q); w2[q] = *(const f32x4*)(conv_w + 1024 + c8 + 4 * q); }
            f32x4 u1[2] = {}, u2[2] = {};
            if ((r0 % SEQ) != 0) {
#pragma unroll
                for (int p = 1; p <= 2; ++p) { const bf16_t* zp = Z + (size_t)(r0 - p) * INWP; const u32x4 cg = *(const u32x4*)(zp + 960 + c8), vv = *(const u32x4*)(zp + 1472 + c8);
                    const f32x4 a = (f32x4){blo(cg.x), bhi(cg.x), blo(cg.y), bhi(cg.y)} * (f32x4){blo(vv.x), bhi(vv.x), blo(vv.y), bhi(vv.y)}, b = (f32x4){blo(cg.z), bhi(cg.z), blo(cg.w), bhi(cg.w)} * (f32x4){blo(vv.z), bhi(vv.z), blo(vv.w), bhi(vv.w)};
                    if (p == 1) { u1[0] = a; u1[1] = b; } else { u2[0] = a; u2[1] = b; } } }
#pragma unroll 4
            for (int rr = 0; rr < 16; ++rr) { const int row = r0 + rr; const bf16_t* z = Z + (size_t)row * INWP; const int s = row % SEQ, b = row / SEQ;
                const u32x4 bg = *(const u32x4*)(z + 448 + c8), cg = *(const u32x4*)(z + 960 + c8), vv = *(const u32x4*)(z + 1472 + c8);
                if (lane < 32) { const float x1 = bf2f(z[384 + lane]), x2 = bf2f(z[416 + lane]); const float c = CS[(size_t)row * 64 + lane], sn = CS[(size_t)row * 64 + 32 + lane];
                    const unsigned o = pk2(x1 * c - x2 * sn, x1 * sn + x2 * c);
#pragma unroll
                    for (int h = 0; h < NH; ++h) *(unsigned*)(Kb + ((size_t)(b * NH + h) * SEQ + s) * DQK + DN + 2 * lane) = o; }
                f32x4 u0[2]; u0[0] = (f32x4){blo(cg.x), bhi(cg.x), blo(cg.y), bhi(cg.y)} * (f32x4){blo(vv.x), bhi(vv.x), blo(vv.y), bhi(vv.y)}; u0[1] = (f32x4){blo(cg.z), bhi(cg.z), blo(cg.w), bhi(cg.w)} * (f32x4){blo(vv.z), bhi(vv.z), blo(vv.w), bhi(vv.w)};
                f32x4 y[2]; y[0] = (f32x4){blo(bg.x), bhi(bg.x), blo(bg.y), bhi(bg.y)} * (w0[0] * u2[0] + w1[0] * u1[0] + w2[0] * u0[0]); y[1] = (f32x4){blo(bg.z), bhi(bg.z), blo(bg.w), bhi(bg.w)} * (w0[1] * u2[1] + w1[1] * u1[1] + w2[1] * u0[1]);
                const float rstd = rsqrtf(wave_sum(pg8::sq4(y[0]) + pg8::sq4(y[1])) * (1.f / 512.f) + EPS);
                *(u32x4*)(MIX + (size_t)row * DM + 512 + c8) = pg8::pack8(y[0] * rstd, y[1] * rstd);
                u2[0] = u1[0]; u2[1] = u1[1]; u1[0] = u0[0]; u1[1] = u0[1]; }
        }
        { pg8::Gemm g{Z, WUQ, QL, INWP, QL, nullptr, 0}; pg8::StaticOrder S; S.init(NTOK / 256, 768 / 256, G, bx, nullptr);
          pg8::EpiQ E{Qb, SSQ, CS}; pg8::gemm_phase<pg8::EpiQ, false>(lds, g, S, E, wave); }
        { pg8::Gemm g{Z + 256, WUKV, 256, INWP, 256, nullptr, 0}; pg8::StaticOrder S; S.init(NTOK / 256, 1024 / 256, G, bx, nullptr);
          pg8::EpiKV E{Kb, Vb, SSQ}; pg8::gemm_phase<pg8::EpiKV, false>(lds, g, S, E, wave); }
    }
    SEAM(PH_TOKLOCAL);
    if (IN(PH_ATTN)) REPLOOP(PH_ATTN) {
        const int vcu = (G % 8 == 0) ? (bx % 8) * (G / 8) + bx / 8 : bx;
        using att::L_END; using att::cv_cmap1; using att::cv_cmap2; using att::CV_N1; using att::CV_TOTAL;
        const att::ConvJob cj{w1, w2, moe_norm, (unsigned char*)W1T, (unsigned char*)W2T, gw, NGW}; int tseq = LASTREP(PH_ATTN) ? 0 : (1 << 20);
        for (int it = vcu; it < NB * NH * 8; it += G) { const int bh = it >> 3, pr = it & 7;
            for (int pass = 0; pass < 2; ++pass) att::attn_block(bh, pass ? pr : 15 - pr, Qb, Kb, Vb, MIX, ASSQ, lds, wave, cj, tseq); }
        if (LASTREP(PH_ATTN)) { const int lane = lane_id(), hi = lane >> 5, wid = wave; __syncthreads();
            for (int cv_idx = tseq * NGW + gw; cv_idx < att::CV_TOTAL; cv_idx += NGW) { CV_DECODE(cv_idx) float cvw[16]; CV_LOAD(); CV_STORE(); } }
    }
    SEAM(PH_ATTN);
    if (IN(PH_WO)) REPLOOP(PH_WO) {
        pg8::Gemm g{MIX, WO, DM, DM, DM, nullptr, 0}; pg8::StaticOrder S; S.init(NTOK / 256, DM / 256, G, bx, nullptr);
        pg8::EpiWo E{XN, HBF, X8, ASSQ, SSQ1, moe_norm}; pg8::gemm_phase<pg8::EpiWo, false>(lds, g, S, E, wave, LASTREP(PH_WO));
    }
    SEAM(PH_WO);
    if (IN(PH_ROUTER)) REPLOOP(PH_ROUTER) {
        PHASE_LANE;
        typedef float f32x16 __attribute__((ext_vector_type(16)));
        LAS int* hist = (LAS int*)(lds + HIST_OFF); LAS f32x16* xch = (LAS f32x16*)(lds + HIST_OFF + 256);
        for (int i = tid; i < 2 * NE * 128; i += NTHREADS) { const int pe = i >> 7, kc = i & 127, e = pe & 31; *(LAS u32x4*)(lds + pe * 2048 + ((kc ^ (e & 15)) << 4)) = ((const u32x4*)WRHL)[i]; }
        if (tid < NE) hist[tid] = 0;
        __syncthreads();
        for (int chunk = bx; chunk < NTOK / 128; chunk += G) {
            const int base = chunk * 128, wq = wave & 3, kh = wave >> 2;
            const int j = lane & 31, half = lane >> 5, tok = base + wq * 32 + j;
            const bf16_t* xr = HBF + (size_t)tok * DM + kh * 512 + 8 * half; const LAS unsigned char* wrow = lds + j * 2048;
            f32x16 acc = {};
#pragma unroll 8
            for (int s = 0; s < 32; ++s) { const bf16x8 xb = *(const bf16x8*)(xr + 16 * s); const int kc = ((kh * 64 + 2 * s + half) ^ (j & 15)) << 4;
                const bf16x8 ah = *(const LAS bf16x8*)(wrow + kc), al = *(const LAS bf16x8*)(wrow + 65536 + kc);
                acc = __builtin_amdgcn_mfma_f32_32x32x16_bf16(ah, xb, acc, 0, 0, 0); acc = __builtin_amdgcn_mfma_f32_32x32x16_bf16(al, xb, acc, 0, 0, 0); }
            if (kh == 1) xch[wq * 64 + lane] = acc;
            __syncthreads();
            if (kh == 0) {
                const f32x16 other = xch[wq * 64 + lane];
                const f32x4 s0 = *(const f32x4*)(SSQ1 + (size_t)tok * 16 + 8 * half), s1 = *(const f32x4*)(SSQ1 + (size_t)tok * 16 + 8 * half + 4);
                float ss = ((s0[0] + s0[1]) + (s0[2] + s0[3])) + ((s1[0] + s1[1]) + (s1[2] + s1[3])); ss += __shfl_xor(ss, 32); const float rstd = rsqrtf(ss * (1.f / DM) + EPS);
                float v[16];
#pragma unroll
                for (int r = 0; r < 16; ++r) v[r] = (acc[r] + other[r]) * rstd + b_router[(r & 3) + 8 * (r >> 2) + 4 * half];
                float lv[4]; int li[4];
#pragma unroll
                for (int t = 0; t < 4; ++t) { float best = -__builtin_inff(); int bi = 0;
#pragma unroll
                    for (int r = 0; r < 16; ++r) if (v[r] > best) { best = v[r]; bi = (r & 3) + 8 * (r >> 2) + 4 * half; }
                    const auto rv = __builtin_amdgcn_permlane32_swap(__float_as_uint(best), __float_as_uint(best), false, false); const auto ri = __builtin_amdgcn_permlane32_swap((unsigned)bi, (unsigned)bi, false, false);
                    const float b0 = __uint_as_float(rv[0]), b1 = __uint_as_float(rv[1]); const int i0 = (int)ri[0], i1 = (int)ri[1];
                    const bool t0 = (b0 > b1) || (b0 == b1 && i0 < i1); const float gb = t0 ? b0 : b1; const int gi = t0 ? i0 : i1; lv[t] = gb; li[t] = gi;
#pragma unroll
                    for (int r = 0; r < 16; ++r) if ((r & 3) + 8 * (r >> 2) + 4 * half == gi) v[r] = -__builtin_inff(); }
                if (half == 0) { const float e1 = __expf(lv[1] - lv[0]), e2 = __expf(lv[2] - lv[0]), e3 = __expf(lv[3] - lv[0]); const float inv = 1.f / (1.f + e1 + e2 + e3);
                    *(int4*)(TOPI + (size_t)tok * 4) = make_int4(li[0], li[1], li[2], li[3]); *(f32x4*)(TOPG + (size_t)tok * 4) = (f32x4){inv, e1 * inv, e2 * inv, e3 * inv}; RS1[tok] = rstd;
#pragma unroll
                    for (int t = 0; t < 4; ++t) (void)__hip_atomic_fetch_add(hist + li[t], 1, __ATOMIC_RELAXED, __HIP_MEMORY_SCOPE_WORKGROUP); }
            }
            __syncthreads();
        }
        if (tid < NE && LASTREP(PH_ROUTER)) atomicAdd(ctl + CW_CNT + tid, hist[tid]);
        __syncthreads();
    }
    SEAM(PH_ROUTER);
    if (IN(PH_ROUTE)) {
        PHASE_LANE;
        LAS int* sh = (LAS int*)lds;
        if (tid == 0) { int ps = 0, nt = 0;
            for (int e = 0; e < NE; ++e) { sh[e] = ps; const int t = (ctl[CW_CNT + e] + 255) >> 8; if (bx == 0) for (int q = 0; q < t; ++q) ctl[CW_TILE_E + nt + q] = e; nt += t; ps += t * 256; }
            sh[NE] = ps; if (bx == 0) ctl[CW_NTILES] = nt; }
        __syncthreads();
        for (int chunk = bx; chunk < MROWS / NTHREADS; chunk += G) {
            if (tid < NE) sh[64 + tid] = 0;
            __syncthreads();
            const int idx = chunk * NTHREADS + tid, e = TOPI[idx]; const int r = __hip_atomic_fetch_add(sh + 64 + e, 1, __ATOMIC_RELAXED, __HIP_MEMORY_SCOPE_WORKGROUP);
            __syncthreads();
            if (tid < NE) sh[128 + tid] = atomicAdd(ctl + CW_CURSOR + tid, sh[64 + tid]);
            __syncthreads();
            const int dest = sh[e] + sh[128 + e] + r; ROWTOK[dest] = idx >> 2; ROWSLOT[dest] = idx; ROWGATE[dest] = TOPG[idx]; ROWRS[dest] = RS1[idx >> 2];
            __syncthreads();
        }
        for (int e = bx; e < NE; e += G) { const int plo = sh[e] + ctl[CW_CNT + e], phi = sh[e + 1];
            for (int r = plo + tid; r < phi; r += NTHREADS) { ROWTOK[r] = 0; ROWSLOT[r] = MROWS; ROWGATE[r] = 0.f; ROWRS[r] = 0.f; } }
        __syncthreads();
    }
    SEAM(PH_ROUTE);
    if (IN(PH_MOE1)) REPLOOP(PH_MOE1) {
        pg8::Gemm g{X8, W1T, DM, DM, DM, ROWTOK, (size_t)2048 * DM}; pg8::StaticOrder S; S.init(ctl[CW_NTILES], 2048 / 256, G, bx, ctl + CW_TILE_E);
        pg8::EpiMoe1 E{(unsigned char*)HB, b1, ROWRS}; pg8::gemm_phase<pg8::EpiMoe1, true, true>(lds, g, S, E, wave, LASTREP(PH_MOE1));
    }
    SEAM(PH_MOE1);
    if (IN(PH_MOE2)) REPLOOP(PH_MOE2) {
        pg8::Gemm g{HB, W2T, DE, DE, DE, nullptr, (size_t)DM * DE}; pg8::StaticOrder S; S.init(ctl[CW_NTILES], DM / 256, G, bx, ctl + CW_TILE_E);
        pg8::EpiMoe2 E{(unsigned char*)Y, b2, ROWSLOT, ROWGATE}; pg8::gemm_phase<pg8::EpiMoe2, false, true>(lds, g, S, E, wave, LASTREP(PH_MOE2));
    }
    SEAM(PH_MOE2);
    if (IN(PH_COMBINE)) REPLOOP(PH_COMBINE) {
        PHASE_LANE;
        for (int row = gw * 2; row < NTOK; row += NGW * 2) {
            u32x4 hv[2][2]; u32x2 yv[2][4][2]; const unsigned char* Y8 = (const unsigned char*)Y;
#pragma unroll
            for (int q = 0; q < 2; ++q)
#pragma unroll
                for (int j = 0; j < 2; ++j) { hv[q][j] = *(const u32x4*)(HBF + (size_t)(row + q) * DM + (lane + 64 * j) * 8);
#pragma unroll
                    for (int k = 0; k < 4; ++k) yv[q][k][j] = *(const u32x2*)(Y8 + ((size_t)(row + q) * 4 + k) * DM + (lane + 64 * j) * 8); }
#pragma unroll
            for (int q = 0; q < 2; ++q) { float ss = 0.f; u32x4 ov[2];
#pragma unroll
                for (int j = 0; j < 2; ++j) { f32x4 a = {blo(hv[q][j].x), bhi(hv[q][j].x), blo(hv[q][j].y), bhi(hv[q][j].y)}, b = {blo(hv[q][j].z), bhi(hv[q][j].z), blo(hv[q][j].w), bhi(hv[q][j].w)};
#pragma unroll
                    for (int k = 0; k < 4; ++k) { const u32x2 y = yv[q][k][j]; const f32x2 y0 = __builtin_amdgcn_cvt_pk_f32_fp8(y.x, false), y1 = __builtin_amdgcn_cvt_pk_f32_fp8(y.x, true), y2 = __builtin_amdgcn_cvt_pk_f32_fp8(y.y, false), y3 = __builtin_amdgcn_cvt_pk_f32_fp8(y.y, true);
                        a += (f32x4){y0[0], y0[1], y1[0], y1[1]}; b += (f32x4){y2[0], y2[1], y3[0], y3[1]}; }
                    ss += pg8::sq4(a) + pg8::sq4(b); ov[j] = pg8::pack8(a, b); }
                ss = wave_sum(ss);
                bf16_t* ho = LASTREP(PH_COMBINE) ? HBF : (bf16_t*)(ws + WS_HB);
#pragma unroll
                for (int j = 0; j < 2; ++j) *(u32x4*)(ho + (size_t)(row + q) * DM + (lane + 64 * j) * 8) = ov[j];
                float ps = lane < 16 ? PSSQ[(size_t)(row + q) * 16 + lane] : 0.f; ps += __shfl_xor(ps, 1); ps += __shfl_xor(ps, 2); ps += __shfl_xor(ps, 4); ps += __shfl_xor(ps, 8);
                if (lane == 0) { RS2[row + q] = rsqrtf(ss * (1.f / DM) + EPS); RS2[NTOK + row + q] = rsqrtf(ps * (1.f / DM) + EPS); } }
        }
    }
    SEAM(PH_COMBINE);
    if (IN(PH_PLE)) REPLOOP(PH_PLE) {
        pg8::Gemm g{HBF, WG, DM, DM, DM, nullptr, 0}; pg8::StaticOrder S; S.init(NTOK / 256, DM / 256, G, bx, nullptr);
        if (G == 256 && LASTREP(PH_PLE)) { pg8::EpiPleFinal E{HBF, H, PLER, RS2 + NTOK, RS2, ple_post_norm, final_norm, FSSQ, (unsigned*)ctl + CW_PANEL, (unsigned*)ctl + CW_PANEL - 64, lds}; pg8::gemm_phase<pg8::EpiPleFinal, false>(lds, g, S, E, wave); }
        else { pg8::EpiPle E{HBF, H3, PLER, RS2 + NTOK, RS2, ple_post_norm, FSSQ}; pg8::gemm_phase<pg8::EpiPle, false>(lds, g, S, E, wave); }
    }
    if (G != 256) SEAM(PH_PLE);
    if (IN(PH_FINAL) && G != 256) REPLOOP(PH_FINAL) {
        PHASE_LANE;
        for (int row = gw * 4; row < NTOK; row += NGW * 4) {
            u32x4 hv[4][2]; float sp[4];
#pragma unroll
            for (int q = 0; q < 4; ++q) { sp[q] = lane < 16 ? FSSQ[(size_t)(row + q) * 16 + lane] : 0.f;
#pragma unroll
                for (int j = 0; j < 2; ++j) hv[q][j] = *(const u32x4*)(H3 + (size_t)(row + q) * DM + (lane + 64 * j) * 8); }
#pragma unroll
            for (int q = 0; q < 4; ++q) { float s = sp[q]; s += __shfl_xor(s, 1); s += __shfl_xor(s, 2); s += __shfl_xor(s, 4); s += __shfl_xor(s, 8);
                const float rstd = rsqrtf(__shfl(s, 0) * (1.f / DM) + EPS); float* ho = (LASTREP(PH_FINAL) ? H : (float*)(ws + WS_HB)) + (size_t)(row + q) * DM;
#pragma unroll
                for (int j = 0; j < 2; ++j) { const int c = (lane + 64 * j) * 8; const f32x4 g0 = *(const f32x4*)(final_norm + c), g1 = *(const f32x4*)(final_norm + c + 4); const u32x4 v = hv[q][j];
                    *(f32x4*)(ho + c) = (f32x4){blo(v.x), bhi(v.x), blo(v.y), bhi(v.y)} * rstd * g0; *(f32x4*)(ho + c + 4) = (f32x4){blo(v.z), bhi(v.z), blo(v.w), bhi(v.w)} * rstd * g1; } }
        }
    }
#ifdef PROBE_TIME_PH
    STAMP(PH_COUNT);
    if (bx == 0 && wave == 0) { const unsigned dt = MISC[32 + PROBE_TIME_PH + 1] - MISC[32 + PROBE_TIME_PH]; const unsigned long long t0 = __builtin_amdgcn_s_memrealtime(); while (__builtin_amdgcn_s_memrealtime() - t0 < (unsigned long long)dt) __builtin_amdgcn_s_sleep(8); }
#endif
#ifdef PROBE_BARS
    if (hi - lo > 1) for (int i = 0; i < PROBE_BARS; ++i) xcd_barrier(bar, wave);
#endif
#undef IN
#undef NREP
#undef REPLOOP
#undef LASTREP
#undef SEAM
}
static int g_grid = 0;
extern "C" void kernel_launch(void* const* d_in, const int* in_sizes, int n_in, void* d_out, int out_size, void* d_ws, size_t ws_size, hipStream_t stream) {
    if (n_in != 25 || in_sizes[0] != NTOK * DM || out_size != NTOK * DM || ws_size < WS_END) {
        fprintf(stderr, "kernel_launch: unexpected shapes (n_in %d, in0 %d, out %d, ws %zu need %zu)\n", n_in, n_in > 0 ? in_sizes[0] : -1, out_size, ws_size, (size_t)WS_END); return; }
    if (g_grid == 0) {
        int dev = 0, cus = 0, per_cu = 0; (void)hipGetDevice(&dev); (void)hipDeviceGetAttribute(&cus, hipDeviceAttributeMultiprocessorCount, dev);
        if (hipFuncSetAttribute((const void*)fwd, hipFuncAttributeMaxDynamicSharedMemorySize, LDS_BYTES) != hipSuccess) fprintf(stderr, "hipFuncSetAttribute failed\n");
        if (hipOccupancyMaxActiveBlocksPerMultiprocessor(&per_cu, (const void*)fwd, NTHREADS, LDS_BYTES) != hipSuccess || per_cu < 1) { fprintf(stderr, "occupancy query: %d\n", per_cu); per_cu = 1; }
        (void)hipGetLastError();
        g_grid = cus > 0 ? cus : 256;
    }
    (void)hipMemsetAsync((unsigned char*)d_ws + WS_CTL, 0, 64 * 1024, stream);
    Args a{}; for (int i = 0; i < 25; ++i) a.in[i] = d_in[i]; a.out = (float*)d_out; a.ws = (unsigned char*)d_ws;
    a.ph_lo = 0; a.ph_hi = PH_COUNT; a.li = 0; a.skip = 0;
    void* p[] = {&a};
    const hipError_t e = hipLaunchCooperativeKernel((const void*)fwd, dim3(g_grid), dim3(NTHREADS), p, LDS_BYTES, stream);
    if (e != hipSuccess) fprintf(stderr, "cooperative launch failed: %s (grid %d)\n", hipGetErrorString(e), g_grid);
}
```

```cpp
#include <hip/hip_runtime.h>
#include <cstdint>
#include <cstdio>
#include <cmath>

typedef unsigned short bf16_t;

constexpr int NB = 8, SEQ = 4096, DM = 1024, NTOK = NB * SEQ;
constexpr int PLE = 256, NH = 4, DN = 128, DR = 64, DV = 128, QL = 256, KVL = 128, DQK = DN + DR;
constexpr int INW = 1984, INWP = 1536;
constexpr int NE = 32, TOPK = 4, DE = 1024;
constexpr int MROWS = NTOK * TOPK;
constexpr int MAXTILES = MROWS / 256 + NE;
constexpr int PROWS = MAXTILES * 256;
constexpr float EPS = 1e-6f;
constexpr float QSCALE = 0.07216878364870322f * 1.4426950408889634f;

constexpr size_t MiB = 1u << 20;
constexpr size_t WS_CTL = 0;
constexpr size_t WS_WIN = 1 * MiB, WS_WUQ = 5 * MiB, WS_WUKV = 5 * MiB + 512 * 1024, WS_WO = 6 * MiB, WS_WG = 8 * MiB, WS_WP = 10 * MiB;
constexpr size_t WS_WR = 10 * MiB + 512 * 1024;
constexpr size_t WS_CS = 11 * MiB;
constexpr size_t WS_SSQ = 19 * MiB, WS_ASSQ = 20 * MiB, WS_PSSQ = 21 * MiB, WS_FSSQ = 23 * MiB;
constexpr size_t WS_TOPI = 25 * MiB, WS_TOPG = 25 * MiB + 512 * 1024;
constexpr size_t WS_ROWTOK = 26 * MiB, WS_ROWSLOT = 27 * MiB, WS_ROWGATE = 28 * MiB;
constexpr size_t WS_P16 = 29 * MiB;
constexpr size_t WS_SSQ1 = 45 * MiB, WS_RS1 = 47 * MiB, WS_RS2 = 47 * MiB + 128 * 1024, WS_ROWRS = 47 * MiB + 384 * 1024;
constexpr size_t WS_RSX = 10 * MiB + 512 * 1024;
constexpr size_t WS_WRHL = 10 * MiB + 768 * 1024;
constexpr size_t WS_HBF = 112 * MiB;
constexpr size_t WS_H3 = 304 * MiB;
constexpr size_t WS_W1 = 48 * MiB, WS_W2 = 176 * MiB, WS_XN = 240 * MiB, WS_MIX = 304 * MiB, WS_PLER = 368 * MiB;
constexpr size_t WS_Z = 432 * MiB, WS_Q = 560 * MiB, WS_K = 608 * MiB, WS_V = 656 * MiB;
constexpr size_t WS_HB = 432 * MiB;
constexpr size_t WS_Y = 704 * MiB;
constexpr size_t WS_END = WS_Y + (size_t)(MROWS + 256) * DM * 2;
constexpr int CW_CNT = 0, CW_CURSOR = 64, CW_PADSTART = 128, CW_NTILES = 192, CW_TILE_E = 256;

__device__ __forceinline__ float bf2f(bf16_t v) { return __uint_as_float((unsigned)v << 16); }
__device__ __forceinline__ float blo(unsigned u) { return __uint_as_float(u << 16); }
__device__ __forceinline__ float bhi(unsigned u) { return __uint_as_float(u & 0xffff0000u); }
__device__ __forceinline__ bf16_t f2bf(float f) { unsigned u = __float_as_uint(f); return (bf16_t)((u + 0x7fffu + ((u >> 16) & 1u)) >> 16); }
__device__ __forceinline__ unsigned pk2(float lo, float hi) { return (unsigned)f2bf(lo) | ((unsigned)f2bf(hi) << 16); }
__device__ __forceinline__ float wave_sum(float v) {
#pragma unroll
    for (int o = 1; o < 64; o <<= 1) v += __shfl_xor(v, o);
    return v;
}
__device__ __forceinline__ float wave_max(float v) {
#pragma unroll
    for (int o = 1; o < 64; o <<= 1) v = fmaxf(v, __shfl_xor(v, o));
    return v;
}
__device__ __forceinline__ float dot8(uint4 x, uint4 y) {
    return blo(x.x) * blo(y.x) + bhi(x.x) * bhi(y.x) + blo(x.y) * blo(y.y) + bhi(x.y) * bhi(y.y) +
           blo(x.z) * blo(y.z) + bhi(x.z) * bhi(y.z) + blo(x.w) * blo(y.w) + bhi(x.w) * bhi(y.w);
}
__device__ __forceinline__ float dot_bf16(const bf16_t* a, const bf16_t* b, int K) {
    const uint4* a4 = (const uint4*)a; const uint4* b4 = (const uint4*)b; float acc = 0.f;
    for (int i = 0; i < K / 8; ++i) acc += dot8(a4[i], b4[i]);
    return acc;
}

#define LAS __attribute__((address_space(3)))
#define GAS __attribute__((address_space(1)))
typedef short bf16x8 __attribute__((ext_vector_type(8)));
typedef float f32x4 __attribute__((ext_vector_type(4)));
typedef float f32x2 __attribute__((ext_vector_type(2)));
typedef unsigned u32x4 __attribute__((ext_vector_type(4)));
typedef unsigned u32x2 __attribute__((ext_vector_type(2)));
#ifndef PROBE_PH
#define PROBE_PH (-1)
#define PROBE_REP 1
#endif
#ifndef MOE2_DELAY_TICKS
#define MOE2_DELAY_TICKS 700ull
#endif
constexpr int NWAVES = 8, NTHREADS = 512;
constexpr int RING_BYTES = 131072, MISC_OFF = RING_BYTES, HIST_OFF = MISC_OFF + 256, STG_OFF = RING_BYTES + 1024, LDS_BYTES = 163840;
constexpr int CW_PANEL = 8192;
constexpr int CW_BAR = 4096;
__device__ __forceinline__ unsigned cvt_pk_bf16(float lo, float hi) { unsigned r; asm volatile("v_cvt_pk_bf16_f32 %0, %1, %2" : "=v"(r) : "v"(lo), "v"(hi)); return r; }
__device__ __forceinline__ int lane_id() { int l = (int)__builtin_amdgcn_mbcnt_hi(~0u, __builtin_amdgcn_mbcnt_lo(~0u, 0u)); asm volatile("" : "+v"(l)); return l; }
__device__ __forceinline__ float fast_sigmoid(float a) { return __builtin_amdgcn_rcpf(1.f + __expf(-a)); }

#define XB_TMO      128
#define XB_XCNT(j)  (256  + 64 * (j))
#define XB_XSUB(j)  (1280 + 64 * (j))
#define XB_XGEN(j)  (2304 + 64 * (j))
#define XB_TOP      3328
#define XB_TOPGEN   3392
#define XCD_BAR_WORDS 3456
#define XB_SPIN_CAP (1u << 20)
__device__ __forceinline__ unsigned xb_ld(unsigned* p)              { return __hip_atomic_load(p, __ATOMIC_RELAXED, __HIP_MEMORY_SCOPE_AGENT); }
__device__ __forceinline__ unsigned xb_add(unsigned* p, unsigned v) { return __hip_atomic_fetch_add(p, v, __ATOMIC_RELAXED, __HIP_MEMORY_SCOPE_AGENT); }
__device__ __forceinline__ unsigned xb_xcc_id() { return (unsigned)__builtin_amdgcn_s_getreg((3 << 11) | 20) & 0xFu; }
#define XB_SPIN(cond, bar) do { unsigned _sp = 0; while (cond) { __builtin_amdgcn_s_sleep(1); \
    if ((++_sp & 255u) == 0u) { if (xb_ld(&(bar)[XB_TMO])) break; if (_sp > XB_SPIN_CAP) { atomicAdd(&(bar)[XB_TMO], 1u); break; } } } } while (0)
struct XcdBarrier { unsigned* bar; unsigned x; volatile LAS unsigned* st; };
__device__ __forceinline__ XcdBarrier xcd_barrier_post(unsigned* bar, volatile LAS unsigned* st, int wave) {
    XcdBarrier b; b.bar = bar; b.x = xb_xcc_id(); b.st = st;
    if (wave == 0 && lane_id() == 0) (void)xb_add(&bar[XB_XCNT(b.x)], 1u);
    return b;
}
__device__ __forceinline__ void xcd_barrier_complete(unsigned* bar, unsigned x, unsigned& nloc, unsigned& nx) {
    const unsigned G = gridDim.x * gridDim.y * gridDim.z;
    unsigned sum, cnt, mine, sp = 0u;
    for (;;) {
        sum = 0u; cnt = 0u; mine = 0u;
#pragma unroll
        for (unsigned j = 0; j < 16; ++j) { const unsigned c = xb_ld(&bar[XB_XCNT(j)]); sum += c; cnt += (c > 0u) ? 1u : 0u; mine = (j == x) ? c : mine; }
        if (sum == G) break;
        __builtin_amdgcn_s_sleep(1);
        if ((++sp & 255u) == 0u) { if (xb_ld(&bar[XB_TMO])) break; if (sp > XB_SPIN_CAP) { atomicAdd(&bar[XB_TMO], 1u); break; } }
    }
    nloc = mine > 0u ? mine : 1u; nx = cnt > 0u ? cnt : 1u;
}
__device__ __forceinline__ void xcd_barrier(const XcdBarrier& b, int wave) {
    asm volatile("s_waitcnt vmcnt(0)" ::: "memory");
    __syncthreads();
    if (wave == 0 && lane_id() == 0) {
        unsigned* bar = b.bar;
        __builtin_amdgcn_s_waitcnt(0);
        unsigned nloc = b.st[0], nx = b.st[1];
        if (nloc == 0u) { xcd_barrier_complete(bar, b.x, nloc, nx); b.st[0] = nloc; b.st[1] = nx; }
        const unsigned old = xb_add(&bar[XB_XSUB(b.x)], 1u);
        const unsigned gen = old / nloc;
        if (old + 1u == (gen + 1u) * nloc) {
            __builtin_amdgcn_fence(__ATOMIC_RELEASE, "agent");
            asm volatile("s_waitcnt vmcnt(0)" ::: "memory");
            const unsigned og = xb_add(&bar[XB_TOP], 1u);
            const unsigned tg = og / nx;
            if (og + 1u == (tg + 1u) * nx) xb_add(&bar[XB_TOPGEN], 1u);
            else XB_SPIN(xb_ld(&bar[XB_TOPGEN]) == tg, bar);
            __builtin_amdgcn_fence(__ATOMIC_ACQUIRE, "agent");
            xb_add(&bar[XB_XGEN(b.x)], 1u);
            asm volatile("s_waitcnt vmcnt(0)" ::: "memory");
        } else {
            XB_SPIN(xb_ld(&bar[XB_XGEN(b.x)]) == gen, bar);
            __builtin_amdgcn_fence(__ATOMIC_ACQUIRE, "agent");
            asm volatile("s_waitcnt vmcnt(0)" ::: "memory");
        }
    }
    __syncthreads();
}

namespace pg8 {
constexpr int BM = 256, BK = 64, HALF = 128, HTB = HALF * BK * 2, STAGE_BYTES = 8 * HTB, NXCD = 8, WGM = 8;
__host__ __device__ __forceinline__ int lds_byte(int r, int c) { const int st = (r >> 4) * 2 + (c >> 5), rr = r & 15, cc = c & 31, ob = rr * 64 + cc * 2; return st * 1024 + (ob ^ (((ob >> 9) & 1) << 5)); }
__host__ __device__ __forceinline__ void stage_rc(int b, int& R, int& C) { const int st = b / 1024, sb = b % 1024, swz = sb ^ (((sb >> 9) & 1) << 5); R = (st >> 1) * 16 + swz / 64; C = (st & 1) * 32 + (swz % 64) / 2; }
__host__ __device__ __forceinline__ int perm32(int rho) { const int n = rho >> 4, i = rho & 15; return 8 * (i >> 2) + 4 * n + (i & 3); }
struct Unit { int pm, pn, e; };
struct Gemm { const void* A; const void* Bt; int K, lda, ldb; const int* rowidx; size_t bstride; };
struct StaticOrder {
    int nM, nN, nwg, G, c; const int* tile_e;
    __device__ void init(int nM_, int nN_, int G_, int c_, const int* te) { nM = nM_; nN = nN_; nwg = nM * nN; G = G_; c = c_; tile_e = te; }
    __device__ bool next(int i, Unit& u) const {
        const long L = (long)i * G + c; if (L >= nwg) return false;
        int wgid = (int)L; { const int q = nwg / NXCD, r = nwg % NXCD, xcd = wgid % NXCD, off = wgid / NXCD; wgid = (xcd < r ? xcd * (q + 1) : r * (q + 1) + (xcd - r) * q) + off; }
        const int nig = WGM * nN, gid = wgid / nig, fm = gid * WGM, gsz = (nM - fm) < WGM ? (nM - fm) : WGM;
        u.pm = fm + ((wgid % nig) % gsz); u.pn = (wgid % nig) / gsz; u.e = tile_e ? tile_e[u.pm] : 0; return true;
    }
};
typedef f32x4 Acc[2][2][4][2];
typedef int v8i_t __attribute__((ext_vector_type(8)));
typedef int v4i_t __attribute__((ext_vector_type(4)));
template <class Epi, bool GATHER, bool FP8 = false>
__device__ __forceinline__ void gemm_phase(LAS unsigned char* lds, const Gemm g, const StaticOrder& S, const Epi& E, const int wid, const bool do_epi = true) {
    const int lane = lane_id(), tid = wid * 64 + lane, wr = wid >> 2, wc = wid & 3, fr = lane & 15, fq = lane >> 4;
    constexpr int ES = FP8 ? 1 : 2;
    const int K = g.K, nt = K * ES / 128;
    int RA[2], CA[2]; unsigned voffB[2], voffA[2];
#pragma unroll
    for (int i = 0; i < 2; ++i) { int R, C; stage_rc(tid * 16 + i * 8192, R, C); const int Rb = Epi::PERM ? ((R & ~31) + perm32(R & 31)) : R;
        RA[i] = R; CA[i] = C; voffB[i] = (unsigned)(Rb * g.ldb * ES + C * 2); voffA[i] = (unsigned)(R * g.lda * ES + C * 2); }
    const size_t hstepA = GATHER ? 0 : (size_t)HALF * g.lda * ES;
    const size_t kstep = (size_t)(BK * 2);
    const size_t hstepB = (size_t)HALF * g.ldb * ES;
    const unsigned ldsw = (unsigned)wid * 1024u;
    const int aoff = lds_byte(wr * 64 + fr, fq * 8), boff = lds_byte(wc * 32 + fr, fq * 8);
#define PG8_SA(b, h) (((b) * 2 + (h)) * HTB)
#define PG8_SB(b, h) ((4 + (b) * 2 + (h)) * HTB)
#define PG8_STAGE(bufoff, gbase, voff) do { _Pragma("unroll") for (int _i = 0; _i < 2; ++_i) \
        __builtin_amdgcn_global_load_lds((const unsigned*)((const char*)(gbase) + (voff)[_i]), (LAS unsigned*)(lds + (bufoff) + ldsw + _i * 8192), 16, 0, 0); } while (0)
#define PG8_LDA(dst, b, h) do { _Pragma("unroll") for (int m = 0; m < 4; ++m) _Pragma("unroll") for (int k = 0; k < 2; ++k) dst[m][k] = *(const LAS bf16x8*)(lds + PG8_SA(b, h) + aoff + m * 2048 + k * 1024); } while (0)
#define PG8_LDB(dst, b, h) do { _Pragma("unroll") for (int n = 0; n < 2; ++n) _Pragma("unroll") for (int k = 0; k < 2; ++k) dst[n][k] = *(const LAS bf16x8*)(lds + PG8_SB(b, h) + boff + n * 2048 + k * 1024); } while (0)
#define PG8_CAT8(x) __builtin_shufflevector(__builtin_bit_cast(v4i_t, (x)[0]), __builtin_bit_cast(v4i_t, (x)[1]), 0, 1, 2, 3, 4, 5, 6, 7)
#define PG8_MMA(ai, bj, At, Bt) do { __builtin_amdgcn_s_setprio(1); if constexpr (FP8) { _Pragma("unroll") for (int m = 0; m < 4; ++m) _Pragma("unroll") for (int n = 0; n < 2; ++n) \
        acc[ai][bj][m][n] = __builtin_amdgcn_mfma_scale_f32_16x16x128_f8f6f4(PG8_CAT8(Bt[n]), PG8_CAT8(At[m]), acc[ai][bj][m][n], 0, 0, 0, 0x7f7f7f7f, 0, 0x7f7f7f7f); \
        _Pragma("unroll") for (int m = 0; m < 4; ++m) _Pragma("unroll") for (int n = 0; n < 2; ++n) asm volatile("" : "+v"(acc[ai][bj][m][n]));   } else { \
        _Pragma("unroll") for (int m = 0; m < 4; ++m) _Pragma("unroll") for (int n = 0; n < 2; ++n) _Pragma("unroll") for (int k = 0; k < 2; ++k) \
        acc[ai][bj][m][n] = __builtin_amdgcn_mfma_f32_16x16x32_bf16(Bt[n][k], At[m][k], acc[ai][bj][m][n], 0, 0, 0); } __builtin_amdgcn_s_setprio(0); } while (0)
#define PG8_WAIT_V(n) asm volatile("s_waitcnt vmcnt(" #n ")" ::: "memory")
#define PG8_WAIT_L(n) asm volatile("s_waitcnt lgkmcnt(" #n ")" ::: "memory")
#define PG8_BAR __builtin_amdgcn_s_barrier()
#define PG8_SCHED __builtin_amdgcn_sched_barrier(0)
#define PG8_SETVO(vo, u) do { if constexpr (GATHER) { _Pragma("unroll") for (int _h = 0; _h < 2; ++_h) _Pragma("unroll") for (int _i = 0; _i < 2; ++_i) { \
        const int _row = g.rowidx[(u).pm * BM + _h * HALF + RA[_i]]; (vo)[_h][_i] = (unsigned)_row * (unsigned)(g.lda * ES) + (unsigned)CA[_i] * 2u; } } } while (0)
#define PG8_STAGE_A(bufoff, base, h, vog) do { if constexpr (GATHER) { PG8_STAGE(bufoff, base, (vog)[h]); } else { PG8_STAGE(bufoff, (base) + (h) * hstepA, voffA); } } while (0)
    Unit cur, nxt; int ui = 0;
    if (!S.next(0, cur)) return;
    Acc acc;
#pragma unroll
    for (int a = 0; a < 2; ++a)
#pragma unroll
        for (int b = 0; b < 2; ++b)
#pragma unroll
            for (int m = 0; m < 4; ++m)
#pragma unroll
                for (int n = 0; n < 2; ++n) acc[a][b][m][n] = (f32x4){0.f, 0.f, 0.f, 0.f};
    bf16x8 At[4][2], B0[2][2], B1[2][2];
    unsigned voC[2][2], voN[2][2];
    PG8_SETVO(voC, cur);
    const char* const Ab = (const char*)g.A;
    const char* cA = GATHER ? Ab : Ab + (size_t)cur.pm * 2 * hstepA;
    const char* cB = (const char*)g.Bt + (size_t)cur.e * g.bstride + (size_t)cur.pn * 2 * hstepB;
    PG8_STAGE(PG8_SB(0, 0), cB, voffB); PG8_STAGE(PG8_SB(0, 1), cB + hstepB, voffB); PG8_STAGE_A(PG8_SA(0, 0), cA, 0, voC); PG8_STAGE_A(PG8_SA(0, 1), cA, 1, voC);
    if (wr == 1) PG8_BAR;
    PG8_WAIT_V(2); PG8_BAR;
    PG8_STAGE(PG8_SB(1, 0), cB + kstep, voffB); PG8_STAGE_A(PG8_SA(1, 0), cA + kstep, 0, voC); PG8_STAGE(PG8_SB(1, 1), cB + hstepB + kstep, voffB);
    PG8_WAIT_V(6); PG8_BAR;
    for (;;) {
        const bool has_next = S.next(ui + 1, nxt);
        const char* nB = has_next ? (const char*)g.Bt + (size_t)nxt.e * g.bstride + (size_t)nxt.pn * 2 * hstepB : cB;
        const char* nA = (has_next && !GATHER) ? Ab + (size_t)nxt.pm * 2 * hstepA : cA;
        if constexpr (GATHER) { if (has_next) { PG8_SETVO(voN, nxt); } else {
#pragma unroll
            for (int h = 0; h < 2; ++h)
#pragma unroll
                for (int i = 0; i < 2; ++i) voN[h][i] = voC[h][i]; } }
        for (int t = 0; t < nt; t += 2) {
            const bool last = (t == nt - 2);
            if constexpr (Epi::MIDK > 0) { if (t == Epi::MIDK) { const int l2 = lane_id(); E.mid(acc, cur, wr, wc, l2 & 15, l2 >> 4); } }
            const char* a1 = cA + (size_t)(t + 1) * kstep;
            const char* a2 = last ? nA : cA + (size_t)(t + 2) * kstep; const char* b2 = last ? nB : cB + (size_t)(t + 2) * kstep;
            const char* a3 = a2 + kstep; const char* b3 = b2 + kstep;
            unsigned o2[2][2];
            if constexpr (GATHER) {
#pragma unroll
            for (int h = 0; h < 2; ++h)
#pragma unroll
                for (int i = 0; i < 2; ++i) o2[h][i] = last ? voN[h][i] : voC[h][i]; }
            PG8_LDB(B0, 0, 0); PG8_LDB(B1, 0, 1); PG8_SCHED; PG8_LDA(At, 0, 0); PG8_STAGE_A(PG8_SA(1, 1), a1, 1, voC);
            PG8_WAIT_V(8); PG8_WAIT_L(0); PG8_BAR; PG8_MMA(0, 0, At, B0); PG8_MMA(0, 1, At, B1); PG8_BAR; PG8_SCHED;
            PG8_LDA(At, 0, 1); PG8_STAGE(PG8_SB(0, 0), b2, voffB); PG8_STAGE(PG8_SB(0, 1), b2 + hstepB, voffB); PG8_STAGE_A(PG8_SA(0, 0), a2, 0, o2);
            PG8_WAIT_V(8); PG8_WAIT_L(0); PG8_BAR; PG8_MMA(1, 0, At, B0); PG8_MMA(1, 1, At, B1); PG8_BAR; PG8_SCHED;
            PG8_LDB(B0, 1, 0); PG8_LDB(B1, 1, 1); PG8_SCHED; PG8_LDA(At, 1, 0); PG8_STAGE_A(PG8_SA(0, 1), a2, 1, o2);
            PG8_WAIT_V(8); PG8_WAIT_L(0); PG8_BAR; PG8_MMA(0, 0, At, B0); PG8_MMA(0, 1, At, B1); PG8_BAR; PG8_SCHED;
            PG8_LDA(At, 1, 1); PG8_STAGE(PG8_SB(1, 0), b3, voffB); PG8_STAGE(PG8_SB(1, 1), b3 + hstepB, voffB); PG8_STAGE_A(PG8_SA(1, 0), a3, 0, o2);
            PG8_WAIT_V(8); PG8_WAIT_L(0); PG8_BAR; PG8_MMA(1, 0, At, B0); PG8_MMA(1, 1, At, B1); PG8_BAR; PG8_SCHED;
        }
        if (wr == 0) PG8_BAR;
        if (do_epi) { const int l2 = lane_id(); E(acc, cur, wr, wc, l2 & 15, l2 >> 4); }
        if (!has_next) break;
#pragma unroll
        for (int a = 0; a < 2; ++a)
#pragma unroll
            for (int b = 0; b < 2; ++b)
#pragma unroll
                for (int m = 0; m < 4; ++m)
#pragma unroll
                    for (int n = 0; n < 2; ++n) acc[a][b][m][n] = (f32x4){0.f, 0.f, 0.f, 0.f};
        cur = nxt; cB = nB; cA = nA; ++ui;
        if constexpr (GATHER) {
#pragma unroll
        for (int h = 0; h < 2; ++h)
#pragma unroll
            for (int i = 0; i < 2; ++i) voC[h][i] = voN[h][i]; }
        if (wr == 1) PG8_BAR;
    }
    PG8_WAIT_V(0);
    PG8_BAR;
#undef PG8_SA
#undef PG8_SB
#undef PG8_STAGE
#undef PG8_LDA
#undef PG8_LDB
#undef PG8_MMA
#undef PG8_CAT8
#undef PG8_WAIT_V
#undef PG8_WAIT_L
#undef PG8_BAR
#undef PG8_SCHED
#undef PG8_SETVO
#undef PG8_STAGE_A
}

__device__ __forceinline__ unsigned pk4_fp8(f32x4 v) { unsigned w = 0; w = __builtin_amdgcn_cvt_pk_fp8_f32(v[0], v[1], w, false); w = __builtin_amdgcn_cvt_pk_fp8_f32(v[2], v[3], w, true); return w; }
__device__ __forceinline__ float sq4(f32x4 v) { return (v[0] * v[0] + v[1] * v[1]) + (v[2] * v[2] + v[3] * v[3]); }
__device__ __forceinline__ float red_fq(float s) { s += __shfl_xor(s, 16); s += __shfl_xor(s, 32); return s; }
__device__ __forceinline__ u32x4 pack8(f32x4 a, f32x4 b) { u32x4 w; w.x = cvt_pk_bf16(a[0], a[1]); w.y = cvt_pk_bf16(a[2], a[3]); w.z = cvt_pk_bf16(b[0], b[1]); w.w = cvt_pk_bf16(b[2], b[3]); return w; }
template <int MODE> struct EpiBf16Stats {
    static constexpr bool PERM = true; static constexpr int MIDK = 0;
    bf16_t* O; int ldc; float* ssq; const float* rsx;
    __device__ __forceinline__ void operator()(const Acc& acc, const Unit& u, int wr, int wc, int fr, int fq) const {
        const int row0 = u.pm * BM + wr * 64 + fr, col0 = u.pn * BM + wc * 32 + 8 * fq;
        float rv[2][4];
#pragma unroll
        for (int ai = 0; ai < 2; ++ai)
#pragma unroll
            for (int m = 0; m < 4; ++m) rv[ai][m] = rsx ? rsx[row0 + ai * HALF + m * 16] : 1.f;
        asm volatile("" ::: "memory");
#pragma unroll
        for (int ai = 0; ai < 2; ++ai)
#pragma unroll
            for (int m = 0; m < 4; ++m) { const int row = row0 + ai * HALF + m * 16; bf16_t* rowp = O + (size_t)row * ldc + col0; const float rs = rv[ai][m];
                const f32x4 a00 = acc[ai][0][m][0] * rs, a01 = acc[ai][0][m][1] * rs, a10 = acc[ai][1][m][0] * rs, a11 = acc[ai][1][m][1] * rs;
                if (MODE == 0 && u.pn >= 4) { *(u32x4*)(O + (size_t)row * ldc + 960 + (u.pn - 4) * HALF + wc * 32 + 8 * fq) = pack8(a00 * a10, a01 * a11); continue; }
                *(u32x4*)(rowp) = pack8(a00, a01); if (!(MODE == 0 && u.pn == 3 && wc >= 2)) *(u32x4*)(rowp + HALF) = pack8(a10, a11);
                if (MODE == 1) { float s = (sq4(a00) + sq4(a01)) + (sq4(a10) + sq4(a11)); s = red_fq(s); if (fq == 0) ssq[(size_t)row * 16 + u.pn * 4 + wc] = s; }
                else if (u.pn == 0) { float s = (sq4(a00) + sq4(a01)) + (sq4(a10) + sq4(a11)); s = red_fq(s); if (fq == 0) ssq[(size_t)row * 8 + wc] = s; }
                else if (u.pn == 1) { float s = sq4(a00) + sq4(a01); s = red_fq(s); if (fq == 0) ssq[(size_t)row * 8 + 4 + wc] = s; } }
    }
};
struct EpiQ {
    static constexpr bool PERM = true; static constexpr int MIDK = 0;
    bf16_t* Q; const float* ssq; const float* cs;
    __device__ __forceinline__ void operator()(const Acc& acc, const Unit& u, int wr, int wc, int fr, int fq) const {
        const int row0 = u.pm * BM + wr * 64 + fr;
#pragma unroll
        for (int ai = 0; ai < 2; ++ai)
#pragma unroll
            for (int m = 0; m < 4; ++m) { const int row = row0 + ai * HALF + m * 16; const f32x4 sv = *(const f32x4*)(ssq + (size_t)row * 8);
                const float rs = rsqrtf(((sv[0] + sv[1]) + (sv[2] + sv[3])) * (1.f / QL) + EPS); const int b = row / SEQ, s = row % SEQ;
#pragma unroll
                for (int bj = 0; bj < 2; ++bj) { const int cv = u.pn * BM + bj * HALF + wc * 32 + 8 * fq; const int h = cv / DQK, d = cv % DQK;
                    f32x4 v0 = acc[ai][bj][m][0] * rs, v1 = acc[ai][bj][m][1] * rs;
                    if (d >= DN) { const int i0 = (d - DN) >> 1; const f32x4 c = *(const f32x4*)(cs + (size_t)row * 64 + i0), sn = *(const f32x4*)(cs + (size_t)row * 64 + 32 + i0);
                        const f32x4 r0 = {v0[0] * c[0] - v0[1] * sn[0], v0[0] * sn[0] + v0[1] * c[0], v0[2] * c[1] - v0[3] * sn[1], v0[2] * sn[1] + v0[3] * c[1]};
                        const f32x4 r1 = {v1[0] * c[2] - v1[1] * sn[2], v1[0] * sn[2] + v1[1] * c[2], v1[2] * c[3] - v1[3] * sn[3], v1[2] * sn[3] + v1[3] * c[3]};
                        v0 = r0; v1 = r1; }
                    *(u32x4*)(Q + ((size_t)(b * NH + h) * SEQ + s) * DQK + d) = pack8(v0, v1); } }
    }
};
struct EpiKV {
    static constexpr bool PERM = true; static constexpr int MIDK = 0;
    bf16_t* Kc; bf16_t* Vc; const float* ssq;
    __device__ __forceinline__ void operator()(const Acc& acc, const Unit& u, int wr, int wc, int fr, int fq) const {
        const int row0 = u.pm * BM + wr * 64 + fr, d = wc * 32 + 8 * fq, h = u.pn;
#pragma unroll
        for (int ai = 0; ai < 2; ++ai)
#pragma unroll
            for (int m = 0; m < 4; ++m) { const int row = row0 + ai * HALF + m * 16; const f32x4 sv = *(const f32x4*)(ssq + (size_t)row * 8 + 4);
                const float rs = rsqrtf(((sv[0] + sv[1]) + (sv[2] + sv[3])) * (1.f / KVL) + EPS); const int b = row / SEQ, s = row % SEQ; const size_t t = (size_t)(b * NH + h) * SEQ + s;
                *(u32x4*)(Kc + t * DQK + d) = pack8(acc[ai][0][m][0] * rs, acc[ai][0][m][1] * rs);
                *(u32x4*)(Vc + t * DV + d) = pack8(acc[ai][1][m][0] * rs, acc[ai][1][m][1] * rs); }
    }
};
struct EpiWo {
    static constexpr bool PERM = true; static constexpr int MIDK = 8;
    const bf16_t* x; bf16_t* HBF; unsigned char* X8; const float* assq; float* ssq1; const float* gmoe;
    __device__ __forceinline__ void mid(Acc& acc, const Unit& u, int wr, int wc, int fr, int fq) const {
        const int row0 = u.pm * BM + wr * 64 + fr;
#pragma unroll
        for (int ai = 0; ai < 2; ++ai)
#pragma unroll
            for (int m = 0; m < 4; ++m) { const f32x4 sv = *(const f32x4*)(assq + (size_t)(row0 + ai * HALF + m * 16) * 4);
                const float rs = rsqrtf(((sv[0] + sv[1]) + (sv[2] + sv[3])) * (1.f / 512.f) + EPS);
#pragma unroll
                for (int bj = 0; bj < 2; ++bj)
#pragma unroll
                    for (int n = 0; n < 2; ++n) acc[ai][bj][m][n] = acc[ai][bj][m][n] * rs; }
    }
    __device__ __forceinline__ void operator()(const Acc& acc, const Unit& u, int wr, int wc, int fr, int fq) const {
        const int row0 = u.pm * BM + wr * 64 + fr, col0 = u.pn * BM + wc * 32 + 8 * fq;
        f32x4 gn[2][2];
#pragma unroll
        for (int bj = 0; bj < 2; ++bj) { gn[bj][0] = *(const f32x4*)(gmoe + col0 + bj * HALF); gn[bj][1] = *(const f32x4*)(gmoe + col0 + bj * HALF + 4); }
#pragma unroll
        for (int ai = 0; ai < 2; ++ai) { u32x4 xv[4][2];
#pragma unroll
            for (int m = 0; m < 4; ++m) { const size_t off = (size_t)(row0 + ai * HALF + m * 16) * DM + col0;
#pragma unroll
                for (int bj = 0; bj < 2; ++bj) xv[m][bj] = *(const u32x4*)(x + off + bj * HALF); }
            asm volatile("" ::: "memory");
#pragma unroll
            for (int m = 0; m < 4; ++m) { const int row = row0 + ai * HALF + m * 16; const size_t off = (size_t)row * DM + col0; float ss = 0.f;
#pragma unroll
                for (int bj = 0; bj < 2; ++bj) { const u32x4 xq = xv[m][bj]; const f32x4 h0 = (f32x4){blo(xq.x), bhi(xq.x), blo(xq.y), bhi(xq.y)} + acc[ai][bj][m][0], h1 = (f32x4){blo(xq.z), bhi(xq.z), blo(xq.w), bhi(xq.w)} + acc[ai][bj][m][1];
                    *(u32x4*)(HBF + off + bj * HALF) = pack8(h0, h1); *(u32x2*)(X8 + off + bj * HALF) = (u32x2){pk4_fp8(h0 * gn[bj][0]), pk4_fp8(h1 * gn[bj][1])}; ss += sq4(h0) + sq4(h1); }
                ss = red_fq(ss); if (fq == 0) ssq1[(size_t)row * 16 + u.pn * 4 + wc] = ss; }
            asm volatile("" ::: "memory"); }
    }
};
__device__ __forceinline__ f32x4 sigmoid4(f32x4 a) { const f32x4 t = a * -1.44269504f; f32x4 e; e[0] = __builtin_amdgcn_exp2f(t[0]); e[1] = __builtin_amdgcn_exp2f(t[1]); e[2] = __builtin_amdgcn_exp2f(t[2]); e[3] = __builtin_amdgcn_exp2f(t[3]);
    const f32x4 d = e + 1.0f; f32x4 r; r[0] = __builtin_amdgcn_rcpf(d[0]); r[1] = __builtin_amdgcn_rcpf(d[1]); r[2] = __builtin_amdgcn_rcpf(d[2]); r[3] = __builtin_amdgcn_rcpf(d[3]); return r; }
__device__ __forceinline__ f32x2 swiglu2(f32x2 g, f32x2 u) {
    g.x = fminf(g.x, 7.f); g.y = fminf(g.y, 7.f); u.x = __builtin_amdgcn_fmed3f(u.x, -7.f, 7.f); u.y = __builtin_amdgcn_fmed3f(u.y, -7.f, 7.f);
    const f32x2 t = g * -2.45546696f; f32x2 e; e.x = __builtin_amdgcn_exp2f(t.x); e.y = __builtin_amdgcn_exp2f(t.y); const f32x2 d = e + 1.0f; f32x2 r; r.x = __builtin_amdgcn_rcpf(d.x); r.y = __builtin_amdgcn_rcpf(d.y);
    const f32x2 gs = g * r; return u * gs + gs; }
__device__ __forceinline__ float swiglu_f(float g, float u) { g = fminf(g, 7.f); u = __builtin_amdgcn_fmed3f(u, -7.f, 7.f); const float gs = g * __builtin_amdgcn_rcpf(1.f + __builtin_amdgcn_exp2f(g * -2.45546696f)); return fmaf(u, gs, gs); }
constexpr float WSCALE = 64.f, WINV = 1.f / 64.f;
struct EpiMoe1 {
    static constexpr bool PERM = true; static constexpr int MIDK = 0;
    unsigned char* HB; const float* b1; const float* rowrs;
    __device__ __forceinline__ void operator()(const Acc& acc, const Unit& u, int wr, int wc, int fr, int fq) const {
        const int row0 = u.pm * BM + wr * 64 + fr, j0 = u.pn * HALF + wc * 32 + 8 * fq; const float* bg = b1 + (size_t)u.e * 2048 + j0;
        const f32x4 g0 = *(const f32x4*)bg, g1 = *(const f32x4*)(bg + 4), u0 = *(const f32x4*)(bg + 1024), u1 = *(const f32x4*)(bg + 1028);
        float rsv[2][4];
#pragma unroll
        for (int ai = 0; ai < 2; ++ai)
#pragma unroll
            for (int m = 0; m < 4; ++m) rsv[ai][m] = rowrs[row0 + ai * HALF + m * 16];
        asm volatile("" ::: "memory");
#pragma unroll
        for (int ai = 0; ai < 2; ++ai)
#pragma unroll
            for (int m = 0; m < 4; ++m) { const float rs = rsv[ai][m] * WINV;
                const f32x4 a0 = acc[ai][0][m][0] * rs + g0, a1 = acc[ai][0][m][1] * rs + g1, c0 = acc[ai][1][m][0] * rs + u0, c1 = acc[ai][1][m][1] * rs + u1; f32x4 r0, r1;
#pragma unroll
                for (int j = 0; j < 4; j += 2) { const f32x2 s0 = swiglu2((f32x2){a0[j], a0[j + 1]}, (f32x2){c0[j], c0[j + 1]}), s1 = swiglu2((f32x2){a1[j], a1[j + 1]}, (f32x2){c1[j], c1[j + 1]}); r0[j] = s0.x; r0[j + 1] = s0.y; r1[j] = s1.x; r1[j + 1] = s1.y; }
                *(u32x2*)(HB + (size_t)(row0 + ai * HALF + m * 16) * DE + j0) = (u32x2){pk4_fp8(r0), pk4_fp8(r1)}; }
    }
};
struct EpiMoe2 {
    static constexpr bool PERM = true; static constexpr int MIDK = 0;
    unsigned char* Y; const float* b2; const int* rowslot; const float* rowgate;
    __device__ __forceinline__ void operator()(const Acc& acc, const Unit& u, int wr, int wc, int fr, int fq) const {
        const int row0 = u.pm * BM + wr * 64 + fr, col0 = u.pn * BM + wc * 64 + 16 * fq; const float* bb = b2 + (size_t)u.e * DM + col0;
        f32x4 bv[2][2];
#pragma unroll
        for (int bj = 0; bj < 2; ++bj)
#pragma unroll
            for (int n = 0; n < 2; ++n) bv[bj][n] = *(const f32x4*)(bb + bj * 8 + 4 * n);
        float gtv[2][4]; int slv[2][4];
#pragma unroll
        for (int ai = 0; ai < 2; ++ai)
#pragma unroll
            for (int m = 0; m < 4; ++m) { const int r = row0 + ai * HALF + m * 16; gtv[ai][m] = rowgate[r]; slv[ai][m] = rowslot[r]; }
        asm volatile("" ::: "memory");
#pragma unroll
        for (int ai = 0; ai < 2; ++ai)
#pragma unroll
            for (int m = 0; m < 4; ++m) { const float gt = gtv[ai][m]; unsigned char* yp = Y + (size_t)slv[ai][m] * DM + col0;
                *(u32x4*)yp = (u32x4){pk4_fp8((acc[ai][0][m][0] * WINV + bv[0][0]) * gt), pk4_fp8((acc[ai][0][m][1] * WINV + bv[0][1]) * gt), pk4_fp8((acc[ai][1][m][0] * WINV + bv[1][0]) * gt), pk4_fp8((acc[ai][1][m][1] * WINV + bv[1][1]) * gt)}; }
    }
};
struct EpiPle {
    static constexpr bool PERM = true; static constexpr int MIDK = 0;
    const bf16_t* H2; bf16_t* H3; const bf16_t* pler; const float* rpv; const float* rs2; const float* pg; float* fssq;
    __device__ __forceinline__ void operator()(const Acc& acc, const Unit& u, int wr, int wc, int fr, int fq) const {
        const int row0 = u.pm * BM + wr * 64 + fr, col0 = u.pn * BM + wc * 32 + 8 * fq;
        f32x4 gv[2][2];
#pragma unroll
        for (int bj = 0; bj < 2; ++bj)
#pragma unroll
            for (int n = 0; n < 2; ++n) gv[bj][n] = *(const f32x4*)(pg + col0 + bj * HALF + n * 4);
#pragma unroll
        for (int am = 0; am < 4; ++am) { const int ai = am >> 1; u32x4 hq[2][2], pq[2][2]; float r2v[2], rpq[2];
#pragma unroll
            for (int mm = 0; mm < 2; ++mm) { const int row = row0 + ai * HALF + ((am & 1) * 2 + mm) * 16; const size_t off = (size_t)row * DM + col0; r2v[mm] = rs2[row]; rpq[mm] = rpv[row];
#pragma unroll
                for (int bj = 0; bj < 2; ++bj) { hq[mm][bj] = *(const u32x4*)(H2 + off + bj * HALF); pq[mm][bj] = *(const u32x4*)(pler + off + bj * HALF); } }
            asm volatile("" ::: "memory");
#pragma unroll
            for (int mm = 0; mm < 2; ++mm) { const int m = (am & 1) * 2 + mm; const int row = row0 + ai * HALF + m * 16; const size_t off = (size_t)row * DM + col0; const float r2 = r2v[mm], rp = rpq[mm]; float ss = 0.f;
#pragma unroll
                for (int bj = 0; bj < 2; ++bj) { const size_t o = off + bj * HALF; const u32x4 hv = hq[mm][bj], pr = pq[mm][bj];
                    const f32x4 h0 = {blo(hv.x), bhi(hv.x), blo(hv.y), bhi(hv.y)}, h1 = {blo(hv.z), bhi(hv.z), blo(hv.w), bhi(hv.w)};
                    const f32x4 q0 = {blo(pr.x), bhi(pr.x), blo(pr.y), bhi(pr.y)}, q1 = {blo(pr.z), bhi(pr.z), blo(pr.w), bhi(pr.w)};
                    const f32x4 r0 = h0 + sigmoid4(acc[ai][bj][m][0] * r2) * (q0 * (gv[bj][0] * rp)), r1 = h1 + sigmoid4(acc[ai][bj][m][1] * r2) * (q1 * (gv[bj][1] * rp));
                    *(u32x4*)(H3 + o) = pack8(r0, r1); ss += sq4(r0) + sq4(r1); }
                ss = red_fq(ss); if (fq == 0) fssq[(size_t)row * 16 + u.pn * 4 + wc] = ss; }
            asm volatile("" ::: "memory"); }
    }
};
struct EpiPleFinal {
    static constexpr bool PERM = true; static constexpr int MIDK = 0;
    const bf16_t* H2; float* out; const bf16_t* pler; const float* rpv; const float* rs2; const float* pg; const float* gf; float* xs; unsigned* cnt; unsigned* tmo; LAS unsigned char* lds;
    __device__ __forceinline__ void operator()(Acc& acc, const Unit& u, int wr, int wc, int fr, int fq) const {
        const int row0 = u.pm * BM + wr * 64 + fr, col0 = u.pn * BM + wc * 32 + 8 * fq;
        LAS float* P = (LAS float*)(lds + STG_OFF); LAS float* S = P + 1024; const int tid = (wr * 4 + wc) * 64 + fq * 16 + fr;
#define PF_BAR() asm volatile("s_waitcnt lgkmcnt(0)\n\ts_barrier" ::: "memory")
        { f32x4 gv[2][2];
#pragma unroll
          for (int bj = 0; bj < 2; ++bj)
#pragma unroll
            for (int n = 0; n < 2; ++n) gv[bj][n] = *(const f32x4*)(pg + col0 + bj * HALF + n * 4);
#pragma unroll
          for (int am = 0; am < 4; ++am) { const int ai = am >> 1; u32x4 hq[2][2], pq[2][2]; float r2v[2], rpq[2];
#pragma unroll
            for (int mm = 0; mm < 2; ++mm) { const int row = row0 + ai * HALF + ((am & 1) * 2 + mm) * 16; const size_t off = (size_t)row * DM + col0; r2v[mm] = rs2[row]; rpq[mm] = rpv[row];
#pragma unroll
                for (int bj = 0; bj < 2; ++bj) { hq[mm][bj] = *(const u32x4*)(H2 + off + bj * HALF); pq[mm][bj] = *(const u32x4*)(pler + off + bj * HALF); } }
            asm volatile("" ::: "memory");
#pragma unroll
            for (int mm = 0; mm < 2; ++mm) { const int m = (am & 1) * 2 + mm; const float r2 = r2v[mm], rp = rpq[mm]; float ss = 0.f;
#pragma unroll
                for (int bj = 0; bj < 2; ++bj) { const u32x4 hv = hq[mm][bj], pr = pq[mm][bj];
                    const f32x4 h0 = {blo(hv.x), bhi(hv.x), blo(hv.y), bhi(hv.y)}, h1 = {blo(hv.z), bhi(hv.z), blo(hv.w), bhi(hv.w)};
                    const f32x4 q0 = {blo(pr.x), bhi(pr.x), blo(pr.y), bhi(pr.y)}, q1 = {blo(pr.z), bhi(pr.z), blo(pr.w), bhi(pr.w)};
                    const f32x4 r0 = h0 + sigmoid4(acc[ai][bj][m][0] * r2) * (q0 * (gv[bj][0] * rp)), r1 = h1 + sigmoid4(acc[ai][bj][m][1] * r2) * (q1 * (gv[bj][1] * rp));
                    acc[ai][bj][m][0] = r0; acc[ai][bj][m][1] = r1; ss += sq4(r0) + sq4(r1); }
                ss = red_fq(ss); if (fq == 0) P[(ai * HALF + wr * 64 + m * 16 + fr) * 4 + wc] = ss; }
            asm volatile("" ::: "memory"); } }
        PF_BAR();
        if (tid < 256) { const f32x4 p4 = *(const LAS f32x4*)(P + tid * 4); __hip_atomic_store(xs + (size_t)(u.pm * 4 + u.pn) * 256 + tid, (p4[0] + p4[1]) + (p4[2] + p4[3]), __ATOMIC_RELAXED, __HIP_MEMORY_SCOPE_AGENT); }
        asm volatile("s_waitcnt vmcnt(0)" ::: "memory");
        PF_BAR();
        if (tid < 64) {
            if (tid == 0) (void)__hip_atomic_fetch_add(cnt + 64 * u.pm, 1u, __ATOMIC_RELAXED, __HIP_MEMORY_SCOPE_AGENT);
            unsigned sp = 0;
            while ((unsigned)__builtin_amdgcn_readfirstlane(__hip_atomic_load(cnt + 64 * u.pm, __ATOMIC_RELAXED, __HIP_MEMORY_SCOPE_AGENT)) < 4u) {
                __builtin_amdgcn_s_sleep(2); if (++sp > (1u << 22)) { if (tid == 0) __hip_atomic_store(tmo, 1u, __ATOMIC_RELAXED, __HIP_MEMORY_SCOPE_AGENT); break; } }
            __builtin_amdgcn_fence(__ATOMIC_ACQUIRE, "agent");
            asm volatile("s_waitcnt vmcnt(0)" ::: "memory"); }
        PF_BAR();
        if (tid < 256) { float t = 0.f;
#pragma unroll
            for (int q = 0; q < 4; ++q) t += __hip_atomic_load(xs + (size_t)(u.pm * 4 + q) * 256 + tid, __ATOMIC_RELAXED, __HIP_MEMORY_SCOPE_AGENT);
            S[tid] = rsqrtf(t * (1.f / DM) + EPS); }
        PF_BAR();
        { f32x4 gq[2][2];
#pragma unroll
          for (int bj = 0; bj < 2; ++bj)
#pragma unroll
            for (int n = 0; n < 2; ++n) gq[bj][n] = *(const f32x4*)(gf + col0 + bj * HALF + n * 4);
#pragma unroll
          for (int ai = 0; ai < 2; ++ai)
#pragma unroll
            for (int m = 0; m < 4; ++m) { const float rs = S[ai * HALF + wr * 64 + m * 16 + fr]; float* op = out + (size_t)(row0 + ai * HALF + m * 16) * DM + col0;
#pragma unroll
                for (int bj = 0; bj < 2; ++bj) { *(f32x4*)(op + bj * HALF) = acc[ai][bj][m][0] * rs * gq[bj][0]; *(f32x4*)(op + bj * HALF + 4) = acc[ai][bj][m][1] * rs * gq[bj][1]; } } }
        PF_BAR();
#undef PF_BAR
    }
};
}

namespace att {
typedef float f32x16 __attribute__((ext_vector_type(16)));
typedef short s16x4 __attribute__((ext_vector_type(4)));
constexpr int QBLK = 32, KVBLK = 64, QB = 256;
constexpr int SHM_K = KVBLK * DQK * 2, SHM_V = KVBLK * DV * 2;
constexpr int L_V = 0, L_K = 2 * SHM_V, L_WS = L_K + 2 * SHM_K, L_END = L_WS + NWAVES * 256;
constexpr float THR = 8.f;
#define KSWZ(row, colB) ((row) * 384 + ((colB) ^ (((row) & 7) << 4)))
#define SBAR() __builtin_amdgcn_sched_barrier(0)
__device__ __forceinline__ int v_st(int k, int c) { const int kk = (k & ~0xC) | ((k & 4) << 1) | ((k & 8) >> 1); return ((kk >> 3) * 4 + (c >> 5)) * 512 + ((kk & 7) * 32 + (c & 31)) * 2; }
__device__ __forceinline__ int v_rd_base(int lane) { return ((lane & 3) << 3) | (((lane >> 2) & 3) << 6) | (((lane >> 4) & 1) << 5) | (((lane >> 5) & 1) << 8); }
constexpr int v_rd_off(int d0, int ks, int half) { return d0 * 512 + ks * 4096 + half * 2048; }
__device__ __forceinline__ int crow(int r, int hi) { return (r & 3) + 8 * (r >> 2) + 4 * hi; }
typedef __bf16 bf16x2_t __attribute__((ext_vector_type(2)));
__device__ __forceinline__ unsigned cvtpk(float lo, float hi) { f32x2 v = {lo, hi}; bf16x2_t b = __builtin_convertvector(v, bf16x2_t); return __builtin_bit_cast(unsigned, b); }

__device__ __forceinline__ void qkt(f32x16& p0, f32x16& p1, const LAS unsigned char* Kbuf, int r32, int hi, const bf16x8* qr) {
    p0 = f32x16{}; p1 = f32x16{};
    const LAS unsigned char* kb[4];
#pragma unroll
    for (int dd = 0; dd < 4; ++dd) kb[dd] = Kbuf + KSWZ(r32, (dd * 16 + hi * 8) * 2);
#pragma unroll
    for (int d0 = 0; d0 < 12; ++d0) { const LAS unsigned char* a = kb[d0 & 3] + (d0 >> 2) * 128;
        const bf16x8 b0 = *(const LAS bf16x8*)a; const bf16x8 b1 = *(const LAS bf16x8*)(a + 32 * 384);
        p0 = __builtin_amdgcn_mfma_f32_32x32x16_bf16(b0, qr[d0], p0, 0, 0, 0);
        p1 = __builtin_amdgcn_mfma_f32_32x32x16_bf16(b1, qr[d0], p1, 0, 0, 0); }
}
template <int VB>
__device__ __forceinline__ void pv_tile(f32x16* o, int vb0, bf16x8 pa0, bf16x8 pa1, bf16x8 pa2, bf16x8 pa3) {
#define TRRD(dst, off) asm volatile("ds_read_b64_tr_b16 %0, %1 offset:%2" : "=&v"(dst) : "v"(vb0), "i"(off) : "memory")
#define PV_D0(d0) do { s16x4 l0, l1, l2, l3, h0, h1, h2, h3; constexpr int b_ = VB * SHM_V + v_rd_off(d0, 0, 0); \
        TRRD(l0, b_); TRRD(h0, b_ + 2048); TRRD(l1, b_ + 4096); TRRD(h1, b_ + 6144); TRRD(l2, b_ + 8192); TRRD(h2, b_ + 10240); TRRD(l3, b_ + 12288); TRRD(h3, b_ + 14336); \
        asm volatile("s_waitcnt lgkmcnt(0)" ::: "memory"); SBAR(); \
        o[d0] = __builtin_amdgcn_mfma_f32_32x32x16_bf16(pa0, (bf16x8){l0[0], l0[1], l0[2], l0[3], h0[0], h0[1], h0[2], h0[3]}, o[d0], 0, 0, 0); \
        o[d0] = __builtin_amdgcn_mfma_f32_32x32x16_bf16(pa1, (bf16x8){l1[0], l1[1], l1[2], l1[3], h1[0], h1[1], h1[2], h1[3]}, o[d0], 0, 0, 0); \
        o[d0] = __builtin_amdgcn_mfma_f32_32x32x16_bf16(pa2, (bf16x8){l2[0], l2[1], l2[2], l2[3], h2[0], h2[1], h2[2], h2[3]}, o[d0], 0, 0, 0); \
        o[d0] = __builtin_amdgcn_mfma_f32_32x32x16_bf16(pa3, (bf16x8){l3[0], l3[1], l3[2], l3[3], h3[0], h3[1], h3[2], h3[3]}, o[d0], 0, 0, 0); } while (0)
    PV_D0(0); PV_D0(1); PV_D0(2); PV_D0(3);
#undef PV_D0
#undef TRRD
}
struct ConvJob { const float* w1; const float* w2; const float* gain; unsigned char* W1T; unsigned char* W2T; int gw, ngw; };
constexpr int CV_N1 = NE * 32 * 64, CV_N2 = NE * 32 * 32, CV_TOTAL = CV_N1 + CV_N2;
__device__ __forceinline__ int cv_cmap2(int n) { const int t = n & ~255, v = n & 255; return t + 64 * ((v >> 5) & 3) + 16 * ((v >> 3) & 3) + 8 * (v >> 7) + (v & 7); }
__device__ __forceinline__ int cv_cmap1(int n) { const int pn = n >> 8, half = (n >> 7) & 1, jj = n & 127; return half * 1024 + pn * 128 + jj; }
#define CV_DECODE(idx) \
    const bool cv_on = (idx) < CV_TOTAL; const bool cv_is1 = (idx) < CV_N1; const int cv_r = cv_is1 ? (idx) : (idx) - CV_N1; \
    const int cv_nblk = cv_is1 ? 64 : 32, cv_ld = cv_is1 ? 2048 : 1024; const int cv_e = cv_r / (32 * cv_nblk), cv_q = cv_r % (32 * cv_nblk), cv_k0 = 32 * (cv_q / cv_nblk), cv_n0 = 32 * (cv_q % cv_nblk); \
    const float* cv_src = (cv_is1 ? cj.w1 + (size_t)cv_e * 1024 * 2048 : cj.w2 + (size_t)cv_e * 1024 * 1024); \
    const int cv_c = cv_is1 ? cv_cmap1(cv_n0 + (lane & 31)) : cv_cmap2(cv_n0 + (lane & 31));
#define CV_LOAD() do { if (cv_on) { _Pragma("unroll") for (int i = 0; i < 16; ++i) cvw[i] = cv_src[(size_t)(cv_k0 + 2 * i + hi) * cv_ld + cv_c]; } } while (0)
#define CV_STORE() do { if (cv_on) { LAS float* scr = (LAS float*)(lds + L_END) + wid * (32 * 33); \
        _Pragma("unroll") for (int i = 0; i < 16; ++i) { const int kk = 2 * i + hi; scr[kk * 33 + (lane & 31)] = cvw[i] * 64.f; } \
        asm volatile("s_waitcnt lgkmcnt(0)" ::: "memory"); \
        { const int n = lane >> 1, cc = lane & 1; const LAS float* s = scr + (16 * cc) * 33 + n; u32x4 o; \
          o.x = pg8::pk4_fp8((f32x4){s[0 * 33], s[1 * 33], s[2 * 33], s[3 * 33]}); o.y = pg8::pk4_fp8((f32x4){s[4 * 33], s[5 * 33], s[6 * 33], s[7 * 33]}); \
          o.z = pg8::pk4_fp8((f32x4){s[8 * 33], s[9 * 33], s[10 * 33], s[11 * 33]}); o.w = pg8::pk4_fp8((f32x4){s[12 * 33], s[13 * 33], s[14 * 33], s[15 * 33]}); \
          unsigned char* dst = (cv_is1 ? cj.W1T + (size_t)cv_e * 2048 * 1024 : cj.W2T + (size_t)cv_e * 1024 * 1024) + (size_t)(cv_n0 + n) * 1024 + cv_k0 + 16 * cc; *(u32x4*)dst = o; } \
        asm volatile("s_waitcnt lgkmcnt(0)" ::: "memory"); } } while (0)
__device__ __forceinline__ void attn_block(int bh, int qb, const bf16_t* __restrict__ Q, const bf16_t* __restrict__ K, const bf16_t* __restrict__ V, bf16_t* __restrict__ MIX, float* __restrict__ ASSQ, LAS unsigned char* lds, const int wid, const ConvJob& cj, int& tseq) {
    const int lane = lane_id(), r32 = lane & 31, hi = lane >> 5;
    const int b = bh / NH, h = bh % NH;
    const bf16_t* Qw = Q + ((size_t)bh * SEQ + qb * QB + wid * QBLK + r32) * DQK;
    const bf16_t* Kh = K + (size_t)bh * SEQ * DQK; const bf16_t* Vh = V + (size_t)bh * SEQ * DV;
    bf16x8 qr[12];
#pragma unroll
    for (int d0 = 0; d0 < 12; ++d0) qr[d0] = *(const bf16x8*)(Qw + d0 * 16 + hi * 8);
    const int NT = 4 * qb + 4, qlo = qb * QB + wid * QBLK, qm = qlo + r32 - 4 * hi;
    LAS unsigned char* V_lds = lds + L_V; LAS unsigned char* K_lds = lds + L_K;
    LAS float* wsf = (LAS float*)(lds + L_WS) + wid * 64; LAS float* li_l = wsf; LAS float* al_l = wsf + 32;
    unsigned ksrc[3], vsrc[2];
#pragma unroll
    for (int i = 0; i < 3; ++i) { const int off = ((wid + 8 * i) * 64 + lane) * 16, row = off / 384, wb = off % 384, seg = wb >> 7, cpos = (wb & 127) >> 4; ksrc[i] = (unsigned)(row * 384 + seg * 128 + ((cpos ^ (row & 7)) << 4)); }
#pragma unroll
    for (int i = 0; i < 2; ++i) { const int off = ((wid + 8 * i) * 64 + lane) * 16, st = off >> 9, o_ = off & 511, kk = (st >> 2) * 8 + (o_ >> 6), c = (st & 3) * 32 + ((o_ & 63) >> 1);
        const int k = (kk & ~0xC) | ((kk & 4) << 1) | ((kk & 8) >> 1); vsrc[i] = (unsigned)(k * 256 + c * 2); }
    const int vb0 = (int)(unsigned)(uintptr_t)V_lds + v_rd_base(lane);
#define ADMA(t, bf) do { const char* kp = (const char*)(Kh + (size_t)(t) * KVBLK * DQK); const char* vp = (const char*)(Vh + (size_t)(t) * KVBLK * DV); \
        _Pragma("unroll") for (int i = 0; i < 3; ++i) __builtin_amdgcn_global_load_lds((const unsigned*)(kp + ksrc[i]), (LAS unsigned*)(K_lds + (bf) * SHM_K + (wid + 8 * i) * 1024), 16, 0, 0); \
        _Pragma("unroll") for (int i = 0; i < 2; ++i) __builtin_amdgcn_global_load_lds((const unsigned*)(vp + vsrc[i]), (LAS unsigned*)(V_lds + (bf) * SHM_V + (wid + 8 * i) * 1024), 16, 0, 0); } while (0)
    float m_reg = -1e30f, l_reg = 0.f; f32x16 o[4] = {}; float cvw[16]; int cv_pend = -1;
    ADMA(0, 0);
#define TILE(t, BF) do { \
        asm volatile("s_waitcnt vmcnt(0)" ::: "memory"); __syncthreads(); \
        if ((t) + 1 < NT) ADMA((t) + 1, (BF) ^ 1); \
        if (cv_pend >= 0) { CV_DECODE(cv_pend) CV_STORE(); }     \
        { const int cv_idx = tseq * cj.ngw + cj.gw; ++tseq; CV_DECODE(cv_idx) CV_LOAD(); cv_pend = cv_on ? cv_idx : -1; } SBAR(); \
        const int kb_ = (t) * KVBLK; \
        if (kb_ <= qlo + QBLK - 1) { \
            f32x16 p0, p1; SBAR(); qkt(p0, p1, K_lds + (BF) * SHM_K, r32, hi, qr); \
            if (kb_ + KVBLK - 1 > qlo) { const int dq = qm - kb_; const float NEG = -__builtin_inff(); \
                _Pragma("unroll") for (int r = 0; r < 16; ++r) { const int c = (r & 3) + 8 * (r >> 2); if (c > dq) p0[r] = NEG; if (c + 32 > dq) p1[r] = NEG; } } \
            float pmax = p0[0]; _Pragma("unroll") for (int r = 1; r < 16; ++r) pmax = fmaxf(pmax, p0[r]); _Pragma("unroll") for (int r = 0; r < 16; ++r) pmax = fmaxf(pmax, p1[r]); \
            { auto rr = __builtin_amdgcn_permlane32_swap(__float_as_uint(pmax), __float_as_uint(pmax), false, false); pmax = fmaxf(__uint_as_float(rr[0]), __uint_as_float(rr[1])); } \
            if (!__all(pmax - m_reg <= THR)) { const float mn = fmaxf(m_reg, pmax); const float alpha = __builtin_amdgcn_exp2f(m_reg - mn); m_reg = mn; l_reg *= alpha; \
                if (hi == 0) al_l[r32] = alpha; asm volatile("s_waitcnt lgkmcnt(0)" ::: "memory"); \
                _Pragma("unroll") for (int d_ = 0; d_ < 4; ++d_) _Pragma("unroll") for (int r = 0; r < 16; ++r) o[d_][r] *= al_l[crow(r, hi)]; } \
            float ps = 0.f; \
            _Pragma("unroll") for (int r = 0; r < 16; ++r) { p0[r] = __builtin_amdgcn_exp2f(p0[r] - m_reg); p1[r] = __builtin_amdgcn_exp2f(p1[r] - m_reg); } \
            _Pragma("unroll") for (int r = 0; r < 16; ++r) ps += p0[r] + p1[r]; \
            { auto rr = __builtin_amdgcn_permlane32_swap(__float_as_uint(ps), __float_as_uint(ps), false, false); ps = __uint_as_float(rr[0]) + __uint_as_float(rr[1]); } \
            l_reg += ps; \
            bf16x8 pa0, pa1, pa2, pa3; \
            PK4(p0, 0, pa0); PK4(p0, 8, pa1); PK4(p1, 0, pa2); PK4(p1, 8, pa3); \
            SBAR(); pv_tile<BF>(o, vb0, pa0, pa1, pa2, pa3); } \
        } while (0)
#define PK4(P, B_, OUT) do { unsigned a0 = cvtpk(P[B_ + 0], P[B_ + 1]), a1 = cvtpk(P[B_ + 2], P[B_ + 3]); \
        unsigned b0 = cvtpk(P[B_ + 4], P[B_ + 5]), b1 = cvtpk(P[B_ + 6], P[B_ + 7]); \
        auto r0 = __builtin_amdgcn_permlane32_swap(a0, b0, false, false); auto r1 = __builtin_amdgcn_permlane32_swap(a1, b1, false, false); \
        u32x4 w = {r0[0], r1[0], r0[1], r1[1]}; OUT = __builtin_bit_cast(bf16x8, w); } while (0)
    for (int t = 0; t < NT; t += 2) { TILE(t, 0); TILE(t + 1, 1); }
#undef PK4
#undef TILE
#undef ADMA
    if (cv_pend >= 0) { asm volatile("s_waitcnt vmcnt(0)" ::: "memory"); CV_DECODE(cv_pend) CV_STORE(); }
    if (hi == 0) li_l[r32] = l_reg;
    asm volatile("s_waitcnt vmcnt(0) lgkmcnt(0)" ::: "memory");
    float rli[16];
#pragma unroll
    for (int r = 0; r < 16; ++r) rli[r] = __builtin_amdgcn_rcpf(li_l[crow(r, hi)]);
    __syncthreads();
    LAS bf16_t* stg = (LAS bf16_t*)(lds + wid * 8192);
#pragma unroll
    for (int r = 0; r < 16; ++r) { const int orow = crow(r, hi);
#pragma unroll
        for (int d0 = 0; d0 < 4; ++d0) stg[orow * 128 + d0 * 32 + r32] = f2bf(o[d0][r] * rli[r]); }
    asm volatile("s_waitcnt lgkmcnt(0)" ::: "memory");
    const size_t row0 = (size_t)b * SEQ + qb * QB + wid * QBLK;
#pragma unroll
    for (int i = 0; i < 8; ++i) { const int row = i * 4 + (lane >> 4), ch = lane & 15; const u32x4 v = *(const LAS u32x4*)(stg + row * 128 + ch * 8);
        float ss = (blo(v.x) * blo(v.x) + bhi(v.x) * bhi(v.x)) + (blo(v.y) * blo(v.y) + bhi(v.y) * bhi(v.y)) + (blo(v.z) * blo(v.z) + bhi(v.z) * bhi(v.z)) + (blo(v.w) * blo(v.w) + bhi(v.w) * bhi(v.w));
        ss += __shfl_xor(ss, 1); ss += __shfl_xor(ss, 2); ss += __shfl_xor(ss, 4); ss += __shfl_xor(ss, 8);
        *(u32x4*)(MIX + (row0 + row) * DM + h * DV + ch * 8) = v;
        if (ch == 0) ASSQ[(row0 + row) * 4 + h] = ss; }
    __syncthreads();
}
#undef KSWZ
#undef SBAR
}

struct Args { const void* in[25]; float* out; unsigned char* ws; int ph_lo, ph_hi, li, skip; };
enum { PH_PREP = 0, PH_INPROJ, PH_TOKLOCAL, PH_ATTN, PH_WO, PH_ROUTER, PH_ROUTE, PH_MOE1, PH_MOE2, PH_COMBINE, PH_PLE, PH_FINAL, PH_COUNT };

template <int MODE> __device__ __forceinline__ int cmap_col(int n) {
    if (MODE == 1) { const int pn = n >> 8, half = (n >> 7) & 1, jj = n & 127; return half * 1024 + pn * 128 + jj; }
    if (MODE == 4) { if (n < 1024) return n < 960 ? n : INW; const int v = n - 1024, j = v >> 8, hf = (v >> 7) & 1, cc = v & 127; return (hf ? 1472 : 960) + 128 * j + cc; }
    if (MODE == 2) { const int h = n / DQK, d = n % DQK; if (d < DN) return n; const int t = d - DN; return h * DQK + DN + (t & 1) * 32 + (t >> 1); }
    return n;
}
template <int MODE> __device__ __forceinline__ void transpose_item_fp8(const float* __restrict__ W, int ldsrc, int nblk, unsigned char* __restrict__ WT, int ldd, const float* __restrict__ gain, float scale,
                                                                      LAS float* scr, int item, int lane) {
    const int kb = item / nblk, nb = item % nblk, k0 = 64 * kb, n0 = 32 * nb; const int c = cmap_col<MODE>(n0 + (lane & 31));
    float wv[32];
#pragma unroll
    for (int i = 0; i < 32; ++i) wv[i] = W[(size_t)(k0 + 2 * i + (lane >> 5)) * ldsrc + c];
#pragma unroll
    for (int i = 0; i < 32; ++i) { const int kk = 2 * i + (lane >> 5), k = k0 + kk; float gk = scale; if (gain) gk *= gain[k]; scr[kk * 33 + (lane & 31)] = wv[i] * gk; }
    asm volatile("s_waitcnt lgkmcnt(0)" ::: "memory");
    const int cc = lane & 3;
#pragma unroll
    for (int j = 0; j < 2; ++j) { const int n = (lane >> 2) + 16 * j; const LAS float* s = scr + (16 * cc) * 33 + n; u32x4 o;
        o.x = pg8::pk4_fp8((f32x4){s[0 * 33], s[1 * 33], s[2 * 33], s[3 * 33]}); o.y = pg8::pk4_fp8((f32x4){s[4 * 33], s[5 * 33], s[6 * 33], s[7 * 33]});
        o.z = pg8::pk4_fp8((f32x4){s[8 * 33], s[9 * 33], s[10 * 33], s[11 * 33]}); o.w = pg8::pk4_fp8((f32x4){s[12 * 33], s[13 * 33], s[14 * 33], s[15 * 33]});
        *(u32x4*)(WT + (size_t)(n0 + n) * ldd + k0 + 16 * cc) = o; }
    asm volatile("s_waitcnt lgkmcnt(0)" ::: "memory");
}
template <int MODE> __device__ __forceinline__ void transpose_item(const float* __restrict__ W, int ldsrc, int nblk, bf16_t* __restrict__ WT, int ldd, const float* __restrict__ gain, const float* __restrict__ gain2, float scale,
                                                                  LAS float* scr, int item, int lane) {
    const int kb = item / nblk, nb = item % nblk, k0 = 64 * kb, n0 = 32 * nb; const int c = cmap_col<MODE>(n0 + (lane & 31));
    float wv[32], gq[32];
#pragma unroll
    for (int i = 0; i < 32; ++i) wv[i] = W[(size_t)(k0 + 2 * i + (lane >> 5)) * ldsrc + c];
#pragma unroll
    for (int i = 0; i < 32; ++i) { const int k = k0 + 2 * i + (lane >> 5); gq[i] = gain ? ((gain2 && k >= 512) ? gain2[k - 512] : gain[k]) : 1.f; }
    asm volatile("" ::: "memory");
#pragma unroll
    for (int i = 0; i < 32; ++i) { const int kk = 2 * i + (lane >> 5); scr[kk * 33 + (lane & 31)] = wv[i] * (gq[i] * scale); }
    asm volatile("s_waitcnt lgkmcnt(0)" ::: "memory");
    const int cc = lane & 7;
#pragma unroll
    for (int j = 0; j < 4; ++j) { const int n = (lane >> 3) + 8 * j; const LAS float* s = scr + (8 * cc) * 33 + n;
        u32x4 o; o.x = pk2(s[0 * 33], s[1 * 33]); o.y = pk2(s[2 * 33], s[3 * 33]); o.z = pk2(s[4 * 33], s[5 * 33]); o.w = pk2(s[6 * 33], s[7 * 33]);
        *(u32x4*)(WT + (size_t)(n0 + n) * ldd + k0 + 8 * cc) = o; }
    asm volatile("s_waitcnt lgkmcnt(0)" ::: "memory");
}

__global__ void __launch_bounds__(NTHREADS, 2) fwd(Args args) {
    extern __shared__ __attribute__((aligned(16))) unsigned char lds_raw[];
    LAS unsigned char* lds = (LAS unsigned char*)lds_raw;
    volatile LAS unsigned* MISC = (volatile LAS unsigned*)(lds + MISC_OFF);
    const int wave = __builtin_amdgcn_readfirstlane(threadIdx.x >> 6);
    const int G = gridDim.x, bx = blockIdx.x;
#define PHASE_LANE const int lane = lane_id(); const int tid = wave * 64 + lane; (void)tid
    const int gw = bx * NWAVES + wave, NGW = G * NWAVES;
    unsigned char* ws = args.ws; int* ctl = (int*)(ws + WS_CTL); float* H = args.out;
    const float* x = (const float*)args.in[0]; const float* p = (const float*)args.in[1]; const int* pos = (const int*)args.in[2];
    const float *mix_norm = (const float*)args.in[3], *w_in = (const float*)args.in[4], *q_norm = (const float*)args.in[5], *w_uq = (const float*)args.in[6], *kv_norm = (const float*)args.in[7],
                *w_ukv = (const float*)args.in[8], *attn_out_norm = (const float*)args.in[10], *conv_out_norm = (const float*)args.in[11], *w_o = (const float*)args.in[12],
                *moe_norm = (const float*)args.in[13], *w_router = (const float*)args.in[14], *w1 = (const float*)args.in[16], *b1 = (const float*)args.in[17],
                *w2 = (const float*)args.in[18], *b2 = (const float*)args.in[19], *ple_norm = (const float*)args.in[20], *w_ple_gate = (const float*)args.in[21], *w_ple_proj = (const float*)args.in[22],
                *ple_post_norm = (const float*)args.in[23], *conv_w = (const float*)args.in[9], *b_router = (const float*)args.in[15], *final_norm = (const float*)args.in[24];
    int* TOPI = (int*)(ws + WS_TOPI); float* TOPG = (float*)(ws + WS_TOPG);
    bf16_t *HBF = (bf16_t*)(ws + WS_HBF), *H3 = (bf16_t*)(ws + WS_H3), *WRHL = (bf16_t*)(ws + WS_WRHL); unsigned char* X8 = (unsigned char*)(ws + WS_K);
    float* RSX = (float*)(ws + WS_RSX);
    float *SSQ1 = (float*)(ws + WS_SSQ1), *RS1 = (float*)(ws + WS_RS1), *RS2 = (float*)(ws + WS_RS2), *ROWRS = (float*)(ws + WS_ROWRS);
    bf16_t *WIN = (bf16_t*)(ws + WS_WIN), *WUQ = (bf16_t*)(ws + WS_WUQ), *WUKV = (bf16_t*)(ws + WS_WUKV), *WO = (bf16_t*)(ws + WS_WO), *WG = (bf16_t*)(ws + WS_WG), *WP = (bf16_t*)(ws + WS_WP);
    bf16_t *W1T = (bf16_t*)(ws + WS_W1), *W2T = (bf16_t*)(ws + WS_W2), *XN = (bf16_t*)(ws + WS_XN), *MIX = (bf16_t*)(ws + WS_MIX), *PLER = (bf16_t*)(ws + WS_PLER);
    bf16_t *Z = (bf16_t*)(ws + WS_Z), *Qb = (bf16_t*)(ws + WS_Q), *Kb = (bf16_t*)(ws + WS_K), *Vb = (bf16_t*)(ws + WS_V), *HB = (bf16_t*)(ws + WS_HB), *Y = (bf16_t*)(ws + WS_Y), *P16 = (bf16_t*)(ws + WS_P16);
    float *WR = (float*)(ws + WS_WR), *CS = (float*)(ws + WS_CS), *SSQ = (float*)(ws + WS_SSQ), *ASSQ = (float*)(ws + WS_ASSQ), *PSSQ = (float*)(ws + WS_PSSQ), *FSSQ = (float*)(ws + WS_FSSQ);
    int *ROWTOK = (int*)(ws + WS_ROWTOK), *ROWSLOT = (int*)(ws + WS_ROWSLOT); float* ROWGATE = (float*)(ws + WS_ROWGATE);

    { PHASE_LANE; for (int u = tid; u < (LDS_BYTES - MISC_OFF) / 4; u += NTHREADS) ((LAS unsigned*)(lds + MISC_OFF))[u] = 0u; }
    __syncthreads();
    const int lo = args.ph_lo, hi = args.ph_hi;
    XcdBarrier bar; bar.bar = (unsigned*)ctl + CW_BAR + args.li * XCD_BAR_WORDS; bar.x = 0; bar.st = MISC + 8;
    if (hi - lo > 1) bar = xcd_barrier_post((unsigned*)ctl + CW_BAR + args.li * XCD_BAR_WORDS, MISC + 8, wave);
#define IN(k) (lo <= (k) && (k) < hi)
#define NREP(k) ((PROBE_PH == (k)) ? PROBE_REP : 1)
#define REPLOOP(k) for (int rep = 0; rep < NREP(k); ++rep)
#define LASTREP(k) (rep == NREP(k) - 1)
#ifdef PROBE_TIME_PH
#define STAMP(k) do { if (bx == 0 && wave == 0) MISC[32 + (k)] = (unsigned)__builtin_amdgcn_s_memrealtime(); } while (0)
#else
#define STAMP(k) do { } while (0)
#endif
#define SEAM(k) do { if (IN(k) && IN((k) + 1)) xcd_barrier(bar, wave); STAMP((k) + 1); } while (0)
    STAMP(0);

    if (IN(PH_PREP)) REPLOOP(PH_PREP) {
        PHASE_LANE;
        LAS float* scr = (LAS float*)(lds + wave * 16384);
        constexpr int I_IN = (DM / 64) * 64, I_UQ = (QL / 64) * (768 / 32), I_UKV = (KVL / 64) * (1024 / 32), I_O = (DM / 64) * (DM / 32), I_G = I_O, I_P = (PLE / 64) * (DM / 32);
        constexpr int I_1 = (DM / 64) * (2048 / 32), I_2 = (DE / 64) * (DM / 32);
        constexpr int NITEMS = I_IN + I_UQ + I_UKV + I_O + I_G + I_P;
        for (int it = gw; it < NITEMS; it += NGW) {
            int r = it;
            if (r < I_IN) { if ((r & 63) != 30 && (r & 63) != 31) transpose_item<4>(w_in, INW, 64, WIN, DM, mix_norm, nullptr, 1.f, scr, r, lane); continue; } r -= I_IN;
            if (r < I_UQ) { transpose_item<2>(w_uq, 768, 768 / 32, WUQ, QL, q_norm, nullptr, QSCALE, scr, r, lane); continue; } r -= I_UQ;
            if (r < I_UKV) { transpose_item<0>(w_ukv, 1024, 1024 / 32, WUKV, 256, kv_norm, nullptr, 1.f, scr, r, lane); continue; } r -= I_UKV;
            if (r < I_O) { transpose_item<0>(w_o, DM, DM / 32, WO, DM, attn_out_norm, conv_out_norm, 1.f, scr, r, lane); continue; } r -= I_O;
            if (r < I_G) { transpose_item<0>(w_ple_gate, DM, DM / 32, WG, DM, ple_norm, nullptr, 1.f, scr, r, lane); continue; } r -= I_G;
            transpose_item<0>(w_ple_proj, DM, DM / 32, WP, PLE, nullptr, nullptr, 1.f, scr, r, lane);
        }
        for (int i = bx * NTHREADS + tid; i < 1024 * 16; i += G * NTHREADS) *(u32x4*)(WUKV + (size_t)(i >> 4) * 256 + 128 + (i & 15) * 8) = (u32x4){0u, 0u, 0u, 0u};
        for (int i = bx * NTHREADS + tid; i < DM * NE; i += G * NTHREADS) { const int e = i >> 10, k = i & 1023; const float w = w_router[k * NE + e] * moe_norm[k]; const bf16_t whi = f2bf(w);
            WRHL[i] = whi; WRHL[DM * NE + i] = f2bf(w - bf2f(whi)); }
        for (int i = bx * NTHREADS + tid; i < NTOK * 32; i += G * NTHREADS) { const int t = i >> 5, j = i & 31; const float inv = powf(10000.f, -(float)j / 32.f); const float a = (float)pos[t] * inv; float sn, c; sincosf(a, &sn, &c);
            CS[(size_t)t * 64 + j] = c; CS[(size_t)t * 64 + 32 + j] = sn; }
        for (int i = bx * NTHREADS + tid; i < NTOK * PLE / 4; i += 4 * G * NTHREADS) { f32x4 v[4];
#pragma unroll
            for (int q = 0; q < 4; ++q) { const int ii = i + q * G * NTHREADS; v[q] = ii < NTOK * PLE / 4 ? ((const f32x4*)p)[ii] : (f32x4){0.f, 0.f, 0.f, 0.f}; }
#pragma unroll
            for (int q = 0; q < 4; ++q) { const int ii = i + q * G * NTHREADS; if (ii < NTOK * PLE / 4) ((u32x2*)P16)[ii] = (u32x2){pk2(v[q][0], v[q][1]), pk2(v[q][2], v[q][3])}; } }
        for (int row = gw * 4; row < NTOK; row += NGW * 4) {
            f32x4 v[4][4]; float ss[4];
#pragma unroll
            for (int q = 0; q < 4; ++q) { const f32x4* s = (const f32x4*)(x + (size_t)(row + q) * DM);
#pragma unroll
                for (int j = 0; j < 4; ++j) v[q][j] = s[lane + 64 * j]; }
#pragma unroll
            for (int q = 0; q < 4; ++q) { ss[q] = 0.f;
#pragma unroll
                for (int j = 0; j < 4; ++j) ss[q] += pg8::sq4(v[q][j]); }
#pragma unroll
            for (int q = 0; q < 4; ++q) { const float rstd = rsqrtf(wave_sum(ss[q]) * (1.f / DM) + EPS); u32x2* d = (u32x2*)(XN + (size_t)(row + q) * DM); if (lane == 0) RSX[row + q] = rstd;
#pragma unroll
                for (int j = 0; j < 4; ++j) d[lane + 64 * j] = (u32x2){pk2(v[q][j][0], v[q][j][1]), pk2(v[q][j][2], v[q][j][3])}; }
        }
    }
    SEAM(PH_PREP);
    if (IN(PH_INPROJ)) REPLOOP(PH_INPROJ) {
        { pg8::Gemm g{XN, WIN, DM, DM, DM, nullptr, 0}; pg8::StaticOrder S; S.init(NTOK / 256, 8, G, bx, nullptr);
          pg8::EpiBf16Stats<0> E{Z, INWP, SSQ, RSX}; pg8::gemm_phase<pg8::EpiBf16Stats<0>, false>(lds, g, S, E, wave); }
        { pg8::Gemm g{P16, WP, PLE, PLE, PLE, nullptr, 0}; pg8::StaticOrder S; S.init(NTOK / 256, DM / 256, G, bx, nullptr);
          pg8::EpiBf16Stats<1> E{PLER, DM, PSSQ, nullptr}; pg8::gemm_phase<pg8::EpiBf16Stats<1>, false>(lds, g, S, E, wave); }
    }
    SEAM(PH_INPROJ);
    if (IN(PH_TOKLOCAL)) REPLOOP(PH_TOKLOCAL) {
        PHASE_LANE;
        if (!(args.skip & 1)) for (int r0 = gw * 16; r0 < NTOK; r0 += NGW * 16) {
            const int c8 = lane * 8; f32x4 w0[2], w1[2], w2[2];
#pragma unroll
            for (int q = 0; q < 2; ++q) { w0[q] = *(const f32x4*)(conv_w + c8 + 4 * q); w1[q] = *(const f32x4*)(conv_w + 512 + c8 + 4 * q); w2[q] = *(const f32x4*)(conv_w + 1024 + c8 + 4 * q); }
            f32x4 u1[2] = {}, u2[2] = {};
            if ((r0 % SEQ) != 0) {
#pragma unroll
                for (int p = 1; p <= 2; ++p) { const u32x4 uu = *(const u32x4*)(Z + (size_t)(r0 - p) * INWP + 960 + c8);
                    const f32x4 a = {blo(uu.x), bhi(uu.x), blo(uu.y), bhi(uu.y)}, b = {blo(uu.z), bhi(uu.z), blo(uu.w), bhi(uu.w)};
                    if (p == 1) { u1[0] = a; u1[1] = b; } else { u2[0] = a; u2[1] = b; } } }
#pragma unroll 4
            for (int rr = 0; rr < 16; ++rr) { const int row = r0 + rr; const bf16_t* z = Z + (size_t)row * INWP; const int s = row % SEQ, b = row / SEQ;
                const u32x4 bg = *(const u32x4*)(z + 448 + c8), uu = *(const u32x4*)(z + 960 + c8);
                if (lane < 32) { const float x1 = bf2f(z[384 + lane]), x2 = bf2f(z[416 + lane]); const float c = CS[(size_t)row * 64 + lane], sn = CS[(size_t)row * 64 + 32 + lane];
                    const unsigned o = pk2(x1 * c - x2 * sn, x1 * sn + x2 * c);
#pragma unroll
                    for (int h = 0; h < NH; ++h) *(unsigned*)(Kb + ((size_t)(b * NH + h) * SEQ + s) * DQK + DN + 2 * lane) = o; }
                f32x4 u0[2]; u0[0] = (f32x4){blo(uu.x), bhi(uu.x), blo(uu.y), bhi(uu.y)}; u0[1] = (f32x4){blo(uu.z), bhi(uu.z), blo(uu.w), bhi(uu.w)};
                f32x4 y[2]; y[0] = (f32x4){blo(bg.x), bhi(bg.x), blo(bg.y), bhi(bg.y)} * (w0[0] * u2[0] + w1[0] * u1[0] + w2[0] * u0[0]); y[1] = (f32x4){blo(bg.z), bhi(bg.z), blo(bg.w), bhi(bg.w)} * (w0[1] * u2[1] + w1[1] * u1[1] + w2[1] * u0[1]);
                const float rstd = rsqrtf(wave_sum(pg8::sq4(y[0]) + pg8::sq4(y[1])) * (1.f / 512.f) + EPS);
                *(u32x4*)(MIX + (size_t)row * DM + 512 + c8) = pg8::pack8(y[0] * rstd, y[1] * rstd);
                u2[0] = u1[0]; u2[1] = u1[1]; u1[0] = u0[0]; u1[1] = u0[1]; }
        }
        { pg8::Gemm g{Z, WUQ, QL, INWP, QL, nullptr, 0}; pg8::StaticOrder S; S.init(NTOK / 256, 768 / 256, G, bx, nullptr);
          pg8::EpiQ E{Qb, SSQ, CS}; pg8::gemm_phase<pg8::EpiQ, false>(lds, g, S, E, wave); }
        { pg8::Gemm g{Z + 256, WUKV, 256, INWP, 256, nullptr, 0}; pg8::StaticOrder S; S.init(NTOK / 256, 1024 / 256, G, bx, nullptr);
          pg8::EpiKV E{Kb, Vb, SSQ}; pg8::gemm_phase<pg8::EpiKV, false>(lds, g, S, E, wave); }
    }
    SEAM(PH_TOKLOCAL);
    if (IN(PH_ATTN)) REPLOOP(PH_ATTN) {
        const int vcu = (G % 8 == 0) ? (bx % 8) * (G / 8) + bx / 8 : bx;
        using att::L_END; using att::cv_cmap1; using att::cv_cmap2; using att::CV_N1; using att::CV_TOTAL;
        const att::ConvJob cj{w1, w2, moe_norm, (unsigned char*)W1T, (unsigned char*)W2T, gw, NGW}; int tseq = LASTREP(PH_ATTN) ? 0 : (1 << 20);
        for (int it = vcu; it < NB * NH * 8; it += G) { const int bh = it >> 3, pr = it & 7;
            for (int pass = 0; pass < 2; ++pass) att::attn_block(bh, pass ? pr : 15 - pr, Qb, Kb, Vb, MIX, ASSQ, lds, wave, cj, tseq); }
        if (LASTREP(PH_ATTN)) { const int lane = lane_id(), hi = lane >> 5, wid = wave; __syncthreads();
            for (int cv_idx = tseq * NGW + gw; cv_idx < att::CV_TOTAL; cv_idx += NGW) { CV_DECODE(cv_idx) float cvw[16]; CV_LOAD(); CV_STORE(); } }
    }
    SEAM(PH_ATTN);
    if (IN(PH_WO)) REPLOOP(PH_WO) {
        pg8::Gemm g{MIX, WO, DM, DM, DM, nullptr, 0}; pg8::StaticOrder S; S.init(NTOK / 256, DM / 256, G, bx, nullptr);
        pg8::EpiWo E{XN, HBF, X8, ASSQ, SSQ1, moe_norm}; pg8::gemm_phase<pg8::EpiWo, false>(lds, g, S, E, wave, LASTREP(PH_WO));
    }
    SEAM(PH_WO);
    if (IN(PH_ROUTER)) REPLOOP(PH_ROUTER) {
        PHASE_LANE;
        typedef float f32x16 __attribute__((ext_vector_type(16)));
        LAS int* hist = (LAS int*)(lds + HIST_OFF); LAS f32x16* xch = (LAS f32x16*)(lds + HIST_OFF + 256);
        for (int i = tid; i < 2 * NE * 128; i += NTHREADS) { const int pe = i >> 7, kc = i & 127, e = pe & 31; *(LAS u32x4*)(lds + pe * 2048 + ((kc ^ (e & 15)) << 4)) = ((const u32x4*)WRHL)[i]; }
        if (tid < NE) hist[tid] = 0;
        __syncthreads();
        for (int chunk = bx; chunk < NTOK / 128; chunk += G) {
            const int base = chunk * 128, wq = wave & 3, kh = wave >> 2;
            const int j = lane & 31, half = lane >> 5, tok = base + wq * 32 + j;
            const bf16_t* xr = HBF + (size_t)tok * DM + kh * 512 + 8 * half; const LAS unsigned char* wrow = lds + j * 2048;
            f32x16 acc = {};
#pragma unroll 8
            for (int s = 0; s < 32; ++s) { const bf16x8 xb = *(const bf16x8*)(xr + 16 * s); const int kc = ((kh * 64 + 2 * s + half) ^ (j & 15)) << 4;
                const bf16x8 ah = *(const LAS bf16x8*)(wrow + kc), al = *(const LAS bf16x8*)(wrow + 65536 + kc);
                acc = __builtin_amdgcn_mfma_f32_32x32x16_bf16(ah, xb, acc, 0, 0, 0); acc = __builtin_amdgcn_mfma_f32_32x32x16_bf16(al, xb, acc, 0, 0, 0); }
            if (kh == 1) xch[wq * 64 + lane] = acc;
            __syncthreads();
            if (kh == 0) {
                const f32x16 other = xch[wq * 64 + lane];
                const f32x4 s0 = *(const f32x4*)(SSQ1 + (size_t)tok * 16 + 8 * half), s1 = *(const f32x4*)(SSQ1 + (size_t)tok * 16 + 8 * half + 4);
                float ss = ((s0[0] + s0[1]) + (s0[2] + s0[3])) + ((s1[0] + s1[1]) + (s1[2] + s1[3])); ss += __shfl_xor(ss, 32); const float rstd = rsqrtf(ss * (1.f / DM) + EPS);
                float v[16];
#pragma unroll
                for (int r = 0; r < 16; ++r) v[r] = (acc[r] + other[r]) * rstd + b_router[(r & 3) + 8 * (r >> 2) + 4 * half];
                float lv[4]; int li[4];
#pragma unroll
                for (int t = 0; t < 4; ++t) { float best = -__builtin_inff(); int bi = 0;
#pragma unroll
                    for (int r = 0; r < 16; ++r) if (v[r] > best) { best = v[r]; bi = (r & 3) + 8 * (r >> 2) + 4 * half; }
                    const auto rv = __builtin_amdgcn_permlane32_swap(__float_as_uint(best), __float_as_uint(best), false, false); const auto ri = __builtin_amdgcn_permlane32_swap((unsigned)bi, (unsigned)bi, false, false);
                    const float b0 = __uint_as_float(rv[0]), b1 = __uint_as_float(rv[1]); const int i0 = (int)ri[0], i1 = (int)ri[1];
                    const bool t0 = (b0 > b1) || (b0 == b1 && i0 < i1); const float gb = t0 ? b0 : b1; const int gi = t0 ? i0 : i1; lv[t] = gb; li[t] = gi;
#pragma unroll
                    for (int r = 0; r < 16; ++r) if ((r & 3) + 8 * (r >> 2) + 4 * half == gi) v[r] = -__builtin_inff(); }
                if (half == 0) { const float e1 = __expf(lv[1] - lv[0]), e2 = __expf(lv[2] - lv[0]), e3 = __expf(lv[3] - lv[0]); const float inv = 1.f / (1.f + e1 + e2 + e3);
                    *(int4*)(TOPI + (size_t)tok * 4) = make_int4(li[0], li[1], li[2], li[3]); *(f32x4*)(TOPG + (size_t)tok * 4) = (f32x4){inv, e1 * inv, e2 * inv, e3 * inv}; RS1[tok] = rstd;
#pragma unroll
                    for (int t = 0; t < 4; ++t) (void)__hip_atomic_fetch_add(hist + li[t], 1, __ATOMIC_RELAXED, __HIP_MEMORY_SCOPE_WORKGROUP); }
            }
            __syncthreads();
        }
        if (tid < NE && LASTREP(PH_ROUTER)) atomicAdd(ctl + CW_CNT + tid, hist[tid]);
        __syncthreads();
    }
    SEAM(PH_ROUTER);
    if (IN(PH_ROUTE)) {
        PHASE_LANE;
        LAS int* sh = (LAS int*)lds;
        if (tid == 0) { int ps = 0, nt = 0;
            for (int e = 0; e < NE; ++e) { sh[e] = ps; const int t = (ctl[CW_CNT + e] + 255) >> 8; if (bx == 0) for (int q = 0; q < t; ++q) ctl[CW_TILE_E + nt + q] = e; nt += t; ps += t * 256; }
            sh[NE] = ps; if (bx == 0) ctl[CW_NTILES] = nt; }
        __syncthreads();
        for (int chunk = bx; chunk < MROWS / NTHREADS; chunk += G) {
            if (tid < NE) sh[64 + tid] = 0;
            __syncthreads();
            const int idx = chunk * NTHREADS + tid, e = TOPI[idx]; const int r = __hip_atomic_fetch_add(sh + 64 + e, 1, __ATOMIC_RELAXED, __HIP_MEMORY_SCOPE_WORKGROUP);
            __syncthreads();
            if (tid < NE) sh[128 + tid] = atomicAdd(ctl + CW_CURSOR + tid, sh[64 + tid]);
            __syncthreads();
            const int dest = sh[e] + sh[128 + e] + r; ROWTOK[dest] = idx >> 2; ROWSLOT[dest] = idx; ROWGATE[dest] = TOPG[idx]; ROWRS[dest] = RS1[idx >> 2];
            __syncthreads();
        }
        for (int e = bx; e < NE; e += G) { const int plo = sh[e] + ctl[CW_CNT + e], phi = sh[e + 1];
            for (int r = plo + tid; r < phi; r += NTHREADS) { ROWTOK[r] = 0; ROWSLOT[r] = MROWS; ROWGATE[r] = 0.f; ROWRS[r] = 0.f; } }
        __syncthreads();
    }
    SEAM(PH_ROUTE);
    if (IN(PH_MOE1)) REPLOOP(PH_MOE1) {
        pg8::Gemm g{X8, W1T, DM, DM, DM, ROWTOK, (size_t)2048 * DM}; pg8::StaticOrder S; S.init(ctl[CW_NTILES], 2048 / 256, G, bx, ctl + CW_TILE_E);
        pg8::EpiMoe1 E{(unsigned char*)HB, b1, ROWRS}; pg8::gemm_phase<pg8::EpiMoe1, true, true>(lds, g, S, E, wave, LASTREP(PH_MOE1));
    }
    SEAM(PH_MOE1);
    if (IN(PH_MOE2)) REPLOOP(PH_MOE2) {
        pg8::Gemm g{HB, W2T, DE, DE, DE, nullptr, (size_t)DM * DE}; pg8::StaticOrder S; S.init(ctl[CW_NTILES], DM / 256, G, bx, ctl + CW_TILE_E);
        pg8::EpiMoe2 E{(unsigned char*)Y, b2, ROWSLOT, ROWGATE}; pg8::gemm_phase<pg8::EpiMoe2, false, true>(lds, g, S, E, wave, LASTREP(PH_MOE2));
    }
    SEAM(PH_MOE2);
    if (IN(PH_COMBINE)) REPLOOP(PH_COMBINE) {
        PHASE_LANE;
        for (int row = gw * 2; row < NTOK; row += NGW * 2) {
            u32x4 hv[2][2]; u32x2 yv[2][4][2]; const unsigned char* Y8 = (const unsigned char*)Y;
#pragma unroll
            for (int q = 0; q < 2; ++q)
#pragma unroll
                for (int j = 0; j < 2; ++j) { hv[q][j] = *(const u32x4*)(HBF + (size_t)(row + q) * DM + (lane + 64 * j) * 8);
#pragma unroll
                    for (int k = 0; k < 4; ++k) yv[q][k][j] = *(const u32x2*)(Y8 + ((size_t)(row + q) * 4 + k) * DM + (lane + 64 * j) * 8); }
#pragma unroll
            for (int q = 0; q < 2; ++q) { float ss = 0.f; u32x4 ov[2];
#pragma unroll
                for (int j = 0; j < 2; ++j) { f32x4 a = {blo(hv[q][j].x), bhi(hv[q][j].x), blo(hv[q][j].y), bhi(hv[q][j].y)}, b = {blo(hv[q][j].z), bhi(hv[q][j].z), blo(hv[q][j].w), bhi(hv[q][j].w)};
#pragma unroll
                    for (int k = 0; k < 4; ++k) { const u32x2 y = yv[q][k][j]; const f32x2 y0 = __builtin_amdgcn_cvt_pk_f32_fp8(y.x, false), y1 = __builtin_amdgcn_cvt_pk_f32_fp8(y.x, true), y2 = __builtin_amdgcn_cvt_pk_f32_fp8(y.y, false), y3 = __builtin_amdgcn_cvt_pk_f32_fp8(y.y, true);
                        a += (f32x4){y0[0], y0[1], y1[0], y1[1]}; b += (f32x4){y2[0], y2[1], y3[0], y3[1]}; }
                    ss += pg8::sq4(a) + pg8::sq4(b); ov[j] = pg8::pack8(a, b); }
                ss = wave_sum(ss);
                bf16_t* ho = LASTREP(PH_COMBINE) ? HBF : (bf16_t*)(ws + WS_HB);
#pragma unroll
                for (int j = 0; j < 2; ++j) *(u32x4*)(ho + (size_t)(row + q) * DM + (lane + 64 * j) * 8) = ov[j];
                float ps = lane < 16 ? PSSQ[(size_t)(row + q) * 16 + lane] : 0.f; ps += __shfl_xor(ps, 1); ps += __shfl_xor(ps, 2); ps += __shfl_xor(ps, 4); ps += __shfl_xor(ps, 8);
                if (lane == 0) { RS2[row + q] = rsqrtf(ss * (1.f / DM) + EPS); RS2[NTOK + row + q] = rsqrtf(ps * (1.f / DM) + EPS); } }
        }
    }
    SEAM(PH_COMBINE);
    if (IN(PH_PLE)) REPLOOP(PH_PLE) {
        pg8::Gemm g{HBF, WG, DM, DM, DM, nullptr, 0}; pg8::StaticOrder S; S.init(NTOK / 256, DM / 256, G, bx, nullptr);
        if (G == 256 && LASTREP(PH_PLE)) { pg8::EpiPleFinal E{HBF, H, PLER, RS2 + NTOK, RS2, ple_post_norm, final_norm, FSSQ, (unsigned*)ctl + CW_PANEL, (unsigned*)ctl + CW_PANEL - 64, lds}; pg8::gemm_phase<pg8::EpiPleFinal, false>(lds, g, S, E, wave); }
        else { pg8::EpiPle E{HBF, H3, PLER, RS2 + NTOK, RS2, ple_post_norm, FSSQ}; pg8::gemm_phase<pg8::EpiPle, false>(lds, g, S, E, wave); }
    }
    if (G != 256) SEAM(PH_PLE);
    if (IN(PH_FINAL) && G != 256) REPLOOP(PH_FINAL) {
        PHASE_LANE;
        for (int row = gw * 4; row < NTOK; row += NGW * 4) {
            u32x4 hv[4][2]; float sp[4];
#pragma unroll
            for (int q = 0; q < 4; ++q) { sp[q] = lane < 16 ? FSSQ[(size_t)(row + q) * 16 + lane] : 0.f;
#pragma unroll
                for (int j = 0; j < 2; ++j) hv[q][j] = *(const u32x4*)(H3 + (size_t)(row + q) * DM + (lane + 64 * j) * 8); }
#pragma unroll
            for (int q = 0; q < 4; ++q) { float s = sp[q]; s += __shfl_xor(s, 1); s += __shfl_xor(s, 2); s += __shfl_xor(s, 4); s += __shfl_xor(s, 8);
                const float rstd = rsqrtf(__shfl(s, 0) * (1.f / DM) + EPS); float* ho = (LASTREP(PH_FINAL) ? H : (float*)(ws + WS_HB)) + (size_t)(row + q) * DM;
#pragma unroll
                for (int j = 0; j < 2; ++j) { const int c = (lane + 64 * j) * 8; const f32x4 g0 = *(const f32x4*)(final_norm + c), g1 = *(const f32x4*)(final_norm + c + 4); const u32x4 v = hv[q][j];
                    *(f32x4*)(ho + c) = (f32x4){blo(v.x), bhi(v.x), blo(v.y), bhi(v.y)} * rstd * g0; *(f32x4*)(ho + c + 4) = (f32x4){blo(v.z), bhi(v.z), blo(v.w), bhi(v.w)} * rstd * g1; } }
        }
    }
#ifdef PROBE_TIME_PH
    STAMP(PH_COUNT);
    if (bx == 0 && wave == 0) { const unsigned dt = MISC[32 + PROBE_TIME_PH + 1] - MISC[32 + PROBE_TIME_PH]; const unsigned long long t0 = __builtin_amdgcn_s_memrealtime(); while (__builtin_amdgcn_s_memrealtime() - t0 < (unsigned long long)dt) __builtin_amdgcn_s_sleep(8); }
#endif
#ifdef PROBE_BARS
    if (hi - lo > 1) for (int i = 0; i < PROBE_BARS; ++i) xcd_barrier(bar, wave);
#endif
#undef IN
#undef NREP
#undef REPLOOP
#undef LASTREP
#undef SEAM
}
static int g_grid = 0;
extern "C" void kernel_launch(void* const* d_in, const int* in_sizes, int n_in, void* d_out, int out_size, void* d_ws, size_t ws_size, hipStream_t stream) {
    if (n_in != 25 || in_sizes[0] != NTOK * DM || out_size != NTOK * DM || ws_size < WS_END) {
        fprintf(stderr, "kernel_launch: unexpected shapes (n_in %d, in0 %d, out %d, ws %zu need %zu)\n", n_in, n_in > 0 ? in_sizes[0] : -1, out_size, ws_size, (size_t)WS_END); return; }
    if (g_grid == 0) {
        int dev = 0, cus = 0, per_cu = 0; (void)hipGetDevice(&dev); (void)hipDeviceGetAttribute(&cus, hipDeviceAttributeMultiprocessorCount, dev);
        if (hipFuncSetAttribute((const void*)fwd, hipFuncAttributeMaxDynamicSharedMemorySize, LDS_BYTES) != hipSuccess) fprintf(stderr, "hipFuncSetAttribute failed\n");
        if (hipOccupancyMaxActiveBlocksPerMultiprocessor(&per_cu, (const void*)fwd, NTHREADS, LDS_BYTES) != hipSuccess || per_cu < 1) { fprintf(stderr, "occupancy query: %d\n", per_cu); per_cu = 1; }
        (void)hipGetLastError();
        g_grid = cus > 0 ? cus : 256;
    }
    (void)hipMemsetAsync((unsigned char*)d_ws + WS_CTL, 0, 64 * 1024, stream);
    Args a{}; for (int i = 0; i < 25; ++i) a.in[i] = d_in[i]; a.out = (float*)d_out; a.ws = (unsigned char*)d_ws;
    a.ph_lo = 0; a.ph_hi = PH_COUNT; a.li = 0; a.skip = 0;
    void* p[] = {&a};
    const hipError_t e = hipLaunchCooperativeKernel((const void*)fwd, dim3(g_grid), dim3(NTHREADS), p, LDS_BYTES, stream);
    if (e != hipSuccess) fprintf(stderr, "cooperative launch failed: %s (grid %d)\n", hipGetErrorString(e), g_grid);
}
```

```cpp
#include <hip/hip_runtime.h>
#include <cstdint>
#include <cstdio>
#include <cmath>

typedef unsigned short bf16_t;

constexpr int NB = 8, SEQ = 4096, DM = 1024, NTOK = NB * SEQ;
constexpr int PLE = 256, NH = 4, DN = 128, DR = 64, DV = 128, QL = 256, KVL = 128, DQK = DN + DR;
constexpr int INW = 1984, INWP = 1536;
constexpr int NE = 32, TOPK = 4, DE = 1024;
constexpr int MROWS = NTOK * TOPK;
constexpr int MAXTILES = MROWS / 256 + NE;
constexpr int PROWS = MAXTILES * 256;
constexpr float EPS = 1e-6f;
constexpr float QSCALE = 0.07216878364870322f * 1.4426950408889634f;

constexpr size_t MiB = 1u << 20;
constexpr size_t WS_CTL = 0;
constexpr size_t WS_WIN = 1 * MiB, WS_WUQ = 5 * MiB, WS_WUKV = 5 * MiB + 512 * 1024, WS_WO = 6 * MiB, WS_WG = 8 * MiB, WS_WP = 10 * MiB;
constexpr size_t WS_WR = 10 * MiB + 512 * 1024;
constexpr size_t WS_CS = 11 * MiB;
constexpr size_t WS_SSQ = 19 * MiB, WS_ASSQ = 20 * MiB, WS_PSSQ = 21 * MiB, WS_FSSQ = 23 * MiB;
constexpr size_t WS_TOPI = 25 * MiB, WS_TOPG = 25 * MiB + 512 * 1024;
constexpr size_t WS_ROWTOK = 26 * MiB, WS_ROWSLOT = 27 * MiB, WS_ROWGATE = 28 * MiB;
constexpr size_t WS_P16 = 29 * MiB;
constexpr size_t WS_SSQ1 = 45 * MiB, WS_RS1 = 47 * MiB, WS_RS2 = 47 * MiB + 128 * 1024, WS_ROWRS = 47 * MiB + 384 * 1024;
constexpr size_t WS_RSX = 10 * MiB + 512 * 1024;
constexpr size_t WS_WRHL = 10 * MiB + 768 * 1024;
constexpr size_t WS_HBF = 112 * MiB;
constexpr size_t WS_H3 = 304 * MiB;
constexpr size_t WS_W1 = 48 * MiB, WS_W2 = 176 * MiB, WS_XN = 240 * MiB, WS_MIX = 304 * MiB, WS_PLER = 368 * MiB;
constexpr size_t WS_Z = 432 * MiB, WS_Q = 560 * MiB, WS_K = 608 * MiB, WS_V = 656 * MiB;
constexpr size_t WS_HB = 432 * MiB;
constexpr size_t WS_Y = 704 * MiB;
constexpr size_t WS_END = WS_Y + (size_t)(MROWS + 256) * DM * 2;
constexpr int CW_CNT = 0, CW_CURSOR = 64, CW_PADSTART = 128, CW_NTILES = 192, CW_TICKET = 200, CW_READY = 224, CW_TILE_E = 256;

__device__ __forceinline__ float bf2f(bf16_t v) { return __uint_as_float((unsigned)v << 16); }
__device__ __forceinline__ float blo(unsigned u) { return __uint_as_float(u << 16); }
__device__ __forceinline__ float bhi(unsigned u) { return __uint_as_float(u & 0xffff0000u); }
__device__ __forceinline__ bf16_t f2bf(float f) { unsigned u = __float_as_uint(f); return (bf16_t)((u + 0x7fffu + ((u >> 16) & 1u)) >> 16); }
__device__ __forceinline__ unsigned pk2(float lo, float hi) { return (unsigned)f2bf(lo) | ((unsigned)f2bf(hi) << 16); }
__device__ __forceinline__ float wave_sum(float v) {
#pragma unroll
    for (int o = 1; o < 64; o <<= 1) v += __shfl_xor(v, o);
    return v;
}
__device__ __forceinline__ float wave_max(float v) {
#pragma unroll
    for (int o = 1; o < 64; o <<= 1) v = fmaxf(v, __shfl_xor(v, o));
    return v;
}
__device__ __forceinline__ float dot8(uint4 x, uint4 y) {
    return blo(x.x) * blo(y.x) + bhi(x.x) * bhi(y.x) + blo(x.y) * blo(y.y) + bhi(x.y) * bhi(y.y) +
           blo(x.z) * blo(y.z) + bhi(x.z) * bhi(y.z) + blo(x.w) * blo(y.w) + bhi(x.w) * bhi(y.w);
}
__device__ __forceinline__ float dot_bf16(const bf16_t* a, const bf16_t* b, int K) {
    const uint4* a4 = (const uint4*)a; const uint4* b4 = (const uint4*)b; float acc = 0.f;
    for (int i = 0; i < K / 8; ++i) acc += dot8(a4[i], b4[i]);
    return acc;
}

#define LAS __attribute__((address_space(3)))
#define GAS __attribute__((address_space(1)))
typedef short bf16x8 __attribute__((ext_vector_type(8)));
typedef float f32x4 __attribute__((ext_vector_type(4)));
typedef float f32x2 __attribute__((ext_vector_type(2)));
typedef unsigned u32x4 __attribute__((ext_vector_type(4)));
typedef unsigned u32x2 __attribute__((ext_vector_type(2)));
#ifndef PROBE_PH
#define PROBE_PH (-1)
#define PROBE_REP 1
#endif
#ifndef MOE2_DELAY_TICKS
#define MOE2_DELAY_TICKS 700ull
#endif
constexpr int NWAVES = 8, NTHREADS = 512;
constexpr int RING_BYTES = 131072, MISC_OFF = RING_BYTES, HIST_OFF = MISC_OFF + 256, STG_OFF = RING_BYTES + 1024, LT_OFF = HIST_OFF + 256 + 16384, LDS_BYTES = 163840;
constexpr int CW_PANEL = 8192;
constexpr int CW_BAR = 4096;
__device__ __forceinline__ unsigned cvt_pk_bf16(float lo, float hi) { unsigned r; asm volatile("v_cvt_pk_bf16_f32 %0, %1, %2" : "=v"(r) : "v"(lo), "v"(hi)); return r; }
__device__ __forceinline__ int lane_id() { int l = (int)__builtin_amdgcn_mbcnt_hi(~0u, __builtin_amdgcn_mbcnt_lo(~0u, 0u)); asm volatile("" : "+v"(l)); return l; }
__device__ __forceinline__ float fast_sigmoid(float a) { return __builtin_amdgcn_rcpf(1.f + __expf(-a)); }

#define XB_TMO      128
#define XB_XCNT(j)  (256  + 64 * (j))
#define XB_XSUB(j)  (1280 + 64 * (j))
#define XB_XGEN(j)  (2304 + 64 * (j))
#define XB_TOP      3328
#define XB_TOPGEN   3392
#define XCD_BAR_WORDS 3456
#define XB_SPIN_CAP (1u << 20)
__device__ __forceinline__ unsigned xb_ld(unsigned* p)              { return __hip_atomic_load(p, __ATOMIC_RELAXED, __HIP_MEMORY_SCOPE_AGENT); }
__device__ __forceinline__ unsigned xb_add(unsigned* p, unsigned v) { return __hip_atomic_fetch_add(p, v, __ATOMIC_RELAXED, __HIP_MEMORY_SCOPE_AGENT); }
__device__ __forceinline__ unsigned xb_xcc_id() { return (unsigned)__builtin_amdgcn_s_getreg((3 << 11) | 20) & 0xFu; }
#define XB_SPIN(cond, bar) do { unsigned _sp = 0; while (cond) { __builtin_amdgcn_s_sleep(1); \
    if ((++_sp & 255u) == 0u) { if (xb_ld(&(bar)[XB_TMO])) break; if (_sp > XB_SPIN_CAP) { atomicAdd(&(bar)[XB_TMO], 1u); break; } } } } while (0)
struct XcdBarrier { unsigned* bar; unsigned x; volatile LAS unsigned* st; };
__device__ __forceinline__ XcdBarrier xcd_barrier_post(unsigned* bar, volatile LAS unsigned* st, int wave) {
    XcdBarrier b; b.bar = bar; b.x = xb_xcc_id(); b.st = st;
    if (wave == 0 && lane_id() == 0) (void)xb_add(&bar[XB_XCNT(b.x)], 1u);
    return b;
}
__device__ __forceinline__ void xcd_barrier_complete(unsigned* bar, unsigned x, unsigned& nloc, unsigned& nx) {
    const unsigned G = gridDim.x * gridDim.y * gridDim.z;
    unsigned sum, cnt, mine, sp = 0u;
    for (;;) {
        sum = 0u; cnt = 0u; mine = 0u;
#pragma unroll
        for (unsigned j = 0; j < 16; ++j) { const unsigned c = xb_ld(&bar[XB_XCNT(j)]); sum += c; cnt += (c > 0u) ? 1u : 0u; mine = (j == x) ? c : mine; }
        if (sum == G) break;
        __builtin_amdgcn_s_sleep(1);
        if ((++sp & 255u) == 0u) { if (xb_ld(&bar[XB_TMO])) break; if (sp > XB_SPIN_CAP) { atomicAdd(&bar[XB_TMO], 1u); break; } }
    }
    nloc = mine > 0u ? mine : 1u; nx = cnt > 0u ? cnt : 1u;
}
__device__ __forceinline__ void xcd_barrier(const XcdBarrier& b, int wave) {
    asm volatile("s_waitcnt vmcnt(0)" ::: "memory");
    __syncthreads();
    if (wave == 0 && lane_id() == 0) {
        unsigned* bar = b.bar;
        __builtin_amdgcn_s_waitcnt(0);
        unsigned nloc = b.st[0], nx = b.st[1];
        if (nloc == 0u) { xcd_barrier_complete(bar, b.x, nloc, nx); b.st[0] = nloc; b.st[1] = nx; }
        const unsigned old = xb_add(&bar[XB_XSUB(b.x)], 1u);
        const unsigned gen = old / nloc;
        if (old + 1u == (gen + 1u) * nloc) {
            __builtin_amdgcn_fence(__ATOMIC_RELEASE, "agent");
            asm volatile("s_waitcnt vmcnt(0)" ::: "memory");
            const unsigned og = xb_add(&bar[XB_TOP], 1u);
            const unsigned tg = og / nx;
            if (og + 1u == (tg + 1u) * nx) xb_add(&bar[XB_TOPGEN], 1u);
            else XB_SPIN(xb_ld(&bar[XB_TOPGEN]) == tg, bar);
            __builtin_amdgcn_fence(__ATOMIC_ACQUIRE, "agent");
            xb_add(&bar[XB_XGEN(b.x)], 1u);
            asm volatile("s_waitcnt vmcnt(0)" ::: "memory");
        } else {
            XB_SPIN(xb_ld(&bar[XB_XGEN(b.x)]) == gen, bar);
            __builtin_amdgcn_fence(__ATOMIC_ACQUIRE, "agent");
            asm volatile("s_waitcnt vmcnt(0)" ::: "memory");
        }
    }
    __syncthreads();
}

namespace pg8 {
constexpr int BM = 256, BK = 64, HALF = 128, HTB = HALF * BK * 2, STAGE_BYTES = 8 * HTB, NXCD = 8, WGM = 8;
__host__ __device__ __forceinline__ int lds_byte(int r, int c) { const int st = (r >> 4) * 2 + (c >> 5), rr = r & 15, cc = c & 31, ob = rr * 64 + cc * 2; return st * 1024 + (ob ^ (((ob >> 9) & 1) << 5)); }
__host__ __device__ __forceinline__ void stage_rc(int b, int& R, int& C) { const int st = b / 1024, sb = b % 1024, swz = sb ^ (((sb >> 9) & 1) << 5); R = (st >> 1) * 16 + swz / 64; C = (st & 1) * 32 + (swz % 64) / 2; }
__host__ __device__ __forceinline__ int perm32(int rho) { const int n = rho >> 4, i = rho & 15; return 8 * (i >> 2) + 4 * n + (i & 3); }
struct Unit { int pm, pn, e; };
struct Gemm { const void* A; const void* Bt; int K, lda, ldb; const int* rowidx; size_t bstride; };
struct StaticOrder {
    int nM, nN, nwg, G, c; const int* tile_e;
    __device__ void init(int nM_, int nN_, int G_, int c_, const int* te) { nM = nM_; nN = nN_; nwg = nM * nN; G = G_; c = c_; tile_e = te; }
    __device__ bool next(int i, Unit& u) const {
        const long L = (long)i * G + c; if (L >= nwg) return false;
        int wgid = (int)L; { const int q = nwg / NXCD, r = nwg % NXCD, xcd = wgid % NXCD, off = wgid / NXCD; wgid = (xcd < r ? xcd * (q + 1) : r * (q + 1) + (xcd - r) * q) + off; }
        const int nig = WGM * nN, gid = wgid / nig, fm = gid * WGM, gsz = (nM - fm) < WGM ? (nM - fm) : WGM;
        u.pm = fm + ((wgid % nig) % gsz); u.pn = (wgid % nig) / gsz; u.e = tile_e ? tile_e[u.pm] : 0; return true;
    }
};
typedef f32x4 Acc[2][2][4][2];
typedef int v8i_t __attribute__((ext_vector_type(8)));
typedef int v4i_t __attribute__((ext_vector_type(4)));
template <class Epi, bool GATHER, bool FP8 = false>
__device__ __forceinline__ void gemm_phase(LAS unsigned char* lds, const Gemm g, const StaticOrder& S, const Epi& E, const int wid, const bool do_epi = true) {
    const int lane = lane_id(), tid = wid * 64 + lane, wr = wid >> 2, wc = wid & 3, fr = lane & 15, fq = lane >> 4;
    constexpr int ES = FP8 ? 1 : 2;
    const int K = g.K, nt = K * ES / 128;
    int RA[2], CA[2]; unsigned voffB[2], voffA[2];
#pragma unroll
    for (int i = 0; i < 2; ++i) { int R, C; stage_rc(tid * 16 + i * 8192, R, C); const int Rb = Epi::PERM ? ((R & ~31) + perm32(R & 31)) : R;
        RA[i] = R; CA[i] = C; voffB[i] = (unsigned)(Rb * g.ldb * ES + C * 2); voffA[i] = (unsigned)(R * g.lda * ES + C * 2); }
    const size_t hstepA = GATHER ? 0 : (size_t)HALF * g.lda * ES;
    const size_t kstep = (size_t)(BK * 2);
    const size_t hstepB = (size_t)HALF * g.ldb * ES;
    const unsigned ldsw = (unsigned)wid * 1024u;
    const int aoff = lds_byte(wr * 64 + fr, fq * 8), boff = lds_byte(wc * 32 + fr, fq * 8);
#define PG8_SA(b, h) (((b) * 2 + (h)) * HTB)
#define PG8_SB(b, h) ((4 + (b) * 2 + (h)) * HTB)
#define PG8_STAGE(bufoff, gbase, voff) do { _Pragma("unroll") for (int _i = 0; _i < 2; ++_i) \
        __builtin_amdgcn_global_load_lds((const unsigned*)((const char*)(gbase) + (voff)[_i]), (LAS unsigned*)(lds + (bufoff) + ldsw + _i * 8192), 16, 0, 0); } while (0)
#define PG8_LDA(dst, b, h) do { _Pragma("unroll") for (int m = 0; m < 4; ++m) _Pragma("unroll") for (int k = 0; k < 2; ++k) dst[m][k] = *(const LAS bf16x8*)(lds + PG8_SA(b, h) + aoff + m * 2048 + k * 1024); } while (0)
#define PG8_LDB(dst, b, h) do { _Pragma("unroll") for (int n = 0; n < 2; ++n) _Pragma("unroll") for (int k = 0; k < 2; ++k) dst[n][k] = *(const LAS bf16x8*)(lds + PG8_SB(b, h) + boff + n * 2048 + k * 1024); } while (0)
#define PG8_CAT8(x) __builtin_shufflevector(__builtin_bit_cast(v4i_t, (x)[0]), __builtin_bit_cast(v4i_t, (x)[1]), 0, 1, 2, 3, 4, 5, 6, 7)
#define PG8_MMA(ai, bj, At, Bt) do { __builtin_amdgcn_s_setprio(1); if constexpr (FP8) { _Pragma("unroll") for (int m = 0; m < 4; ++m) _Pragma("unroll") for (int n = 0; n < 2; ++n) \
        acc[ai][bj][m][n] = __builtin_amdgcn_mfma_scale_f32_16x16x128_f8f6f4(PG8_CAT8(Bt[n]), PG8_CAT8(At[m]), acc[ai][bj][m][n], 0, 0, 0, 0x7f7f7f7f, 0, 0x7f7f7f7f); \
        _Pragma("unroll") for (int m = 0; m < 4; ++m) _Pragma("unroll") for (int n = 0; n < 2; ++n) asm volatile("" : "+v"(acc[ai][bj][m][n]));   } else { \
        _Pragma("unroll") for (int m = 0; m < 4; ++m) _Pragma("unroll") for (int n = 0; n < 2; ++n) _Pragma("unroll") for (int k = 0; k < 2; ++k) \
        acc[ai][bj][m][n] = __builtin_amdgcn_mfma_f32_16x16x32_bf16(Bt[n][k], At[m][k], acc[ai][bj][m][n], 0, 0, 0); } __builtin_amdgcn_s_setprio(0); } while (0)
#define PG8_WAIT_V(n) asm volatile("s_waitcnt vmcnt(" #n ")" ::: "memory")
#define PG8_WAIT_L(n) asm volatile("s_waitcnt lgkmcnt(" #n ")" ::: "memory")
#define PG8_BAR __builtin_amdgcn_s_barrier()
#define PG8_SCHED __builtin_amdgcn_sched_barrier(0)
#define PG8_SETVO(vo, u) do { if constexpr (GATHER) { _Pragma("unroll") for (int _h = 0; _h < 2; ++_h) _Pragma("unroll") for (int _i = 0; _i < 2; ++_i) { \
        const int _row = g.rowidx[(u).pm * BM + _h * HALF + RA[_i]]; (vo)[_h][_i] = (unsigned)_row * (unsigned)(g.lda * ES) + (unsigned)CA[_i] * 2u; } } } while (0)
#define PG8_STAGE_A(bufoff, base, h, vog) do { if constexpr (GATHER) { PG8_STAGE(bufoff, base, (vog)[h]); } else { PG8_STAGE(bufoff, (base) + (h) * hstepA, voffA); } } while (0)
    Unit cur, nxt; int ui = 0;
    if (!S.next(0, cur)) return;
    Acc acc;
#pragma unroll
    for (int a = 0; a < 2; ++a)
#pragma unroll
        for (int b = 0; b < 2; ++b)
#pragma unroll
            for (int m = 0; m < 4; ++m)
#pragma unroll
                for (int n = 0; n < 2; ++n) acc[a][b][m][n] = (f32x4){0.f, 0.f, 0.f, 0.f};
    bf16x8 At[4][2], B0[2][2], B1[2][2];
    unsigned voC[2][2], voN[2][2];
    PG8_SETVO(voC, cur);
    const char* const Ab = (const char*)g.A;
    const char* cA = GATHER ? Ab : Ab + (size_t)cur.pm * 2 * hstepA;
    const char* cB = (const char*)g.Bt + (size_t)cur.e * g.bstride + (size_t)cur.pn * 2 * hstepB;
    PG8_STAGE(PG8_SB(0, 0), cB, voffB); PG8_STAGE(PG8_SB(0, 1), cB + hstepB, voffB); PG8_STAGE_A(PG8_SA(0, 0), cA, 0, voC); PG8_STAGE_A(PG8_SA(0, 1), cA, 1, voC);
    if (wr == 1) PG8_BAR;
    PG8_WAIT_V(2); PG8_BAR;
    PG8_STAGE(PG8_SB(1, 0), cB + kstep, voffB); PG8_STAGE_A(PG8_SA(1, 0), cA + kstep, 0, voC); PG8_STAGE(PG8_SB(1, 1), cB + hstepB + kstep, voffB);
    PG8_WAIT_V(6); PG8_BAR;
    for (;;) {
        const bool has_next = S.next(ui + 1, nxt);
        const char* nB = has_next ? (const char*)g.Bt + (size_t)nxt.e * g.bstride + (size_t)nxt.pn * 2 * hstepB : cB;
        const char* nA = (has_next && !GATHER) ? Ab + (size_t)nxt.pm * 2 * hstepA : cA;
        if constexpr (GATHER) { if (has_next) { PG8_SETVO(voN, nxt); } else {
#pragma unroll
            for (int h = 0; h < 2; ++h)
#pragma unroll
                for (int i = 0; i < 2; ++i) voN[h][i] = voC[h][i]; } }
        for (int t = 0; t < nt; t += 2) {
            const bool last = (t == nt - 2);
            if constexpr (Epi::MIDK > 0) { if (t == Epi::MIDK) { const int l2 = lane_id(); E.mid(acc, cur, wr, wc, l2 & 15, l2 >> 4); } }
            const char* a1 = cA + (size_t)(t + 1) * kstep;
            const char* a2 = last ? nA : cA + (size_t)(t + 2) * kstep; const char* b2 = last ? nB : cB + (size_t)(t + 2) * kstep;
            const char* a3 = a2 + kstep; const char* b3 = b2 + kstep;
            unsigned o2[2][2];
            if constexpr (GATHER) {
#pragma unroll
            for (int h = 0; h < 2; ++h)
#pragma unroll
                for (int i = 0; i < 2; ++i) o2[h][i] = last ? voN[h][i] : voC[h][i]; }
            PG8_LDB(B0, 0, 0); PG8_LDB(B1, 0, 1); PG8_SCHED; PG8_LDA(At, 0, 0); PG8_STAGE_A(PG8_SA(1, 1), a1, 1, voC);
            PG8_WAIT_V(8); PG8_WAIT_L(0); PG8_BAR; PG8_MMA(0, 0, At, B0); PG8_MMA(0, 1, At, B1); PG8_BAR; PG8_SCHED;
            PG8_LDA(At, 0, 1); PG8_STAGE(PG8_SB(0, 0), b2, voffB); PG8_STAGE(PG8_SB(0, 1), b2 + hstepB, voffB); PG8_STAGE_A(PG8_SA(0, 0), a2, 0, o2);
            PG8_WAIT_V(8); PG8_WAIT_L(0); PG8_BAR; PG8_MMA(1, 0, At, B0); PG8_MMA(1, 1, At, B1); PG8_BAR; PG8_SCHED;
            PG8_LDB(B0, 1, 0); PG8_LDB(B1, 1, 1); PG8_SCHED; PG8_LDA(At, 1, 0); PG8_STAGE_A(PG8_SA(0, 1), a2, 1, o2);
            PG8_WAIT_V(8); PG8_WAIT_L(0); PG8_BAR; PG8_MMA(0, 0, At, B0); PG8_MMA(0, 1, At, B1); PG8_BAR; PG8_SCHED;
            PG8_LDA(At, 1, 1); PG8_STAGE(PG8_SB(1, 0), b3, voffB); PG8_STAGE(PG8_SB(1, 1), b3 + hstepB, voffB); PG8_STAGE_A(PG8_SA(1, 0), a3, 0, o2);
            PG8_WAIT_V(8); PG8_WAIT_L(0); PG8_BAR; PG8_MMA(1, 0, At, B0); PG8_MMA(1, 1, At, B1); PG8_BAR; PG8_SCHED;
        }
        if (wr == 0) PG8_BAR;
        if (do_epi) { const int l2 = lane_id(); E(acc, cur, wr, wc, l2 & 15, l2 >> 4); }
        if (!has_next) break;
#pragma unroll
        for (int a = 0; a < 2; ++a)
#pragma unroll
            for (int b = 0; b < 2; ++b)
#pragma unroll
                for (int m = 0; m < 4; ++m)
#pragma unroll
                    for (int n = 0; n < 2; ++n) acc[a][b][m][n] = (f32x4){0.f, 0.f, 0.f, 0.f};
        cur = nxt; cB = nB; cA = nA; ++ui;
        if constexpr (GATHER) {
#pragma unroll
        for (int h = 0; h < 2; ++h)
#pragma unroll
            for (int i = 0; i < 2; ++i) voC[h][i] = voN[h][i]; }
        if (wr == 1) PG8_BAR;
    }
    PG8_WAIT_V(0);
    PG8_BAR;
#undef PG8_SA
#undef PG8_SB
#undef PG8_STAGE
#undef PG8_LDA
#undef PG8_LDB
#undef PG8_MMA
#undef PG8_CAT8
#undef PG8_WAIT_V
#undef PG8_WAIT_L
#undef PG8_BAR
#undef PG8_SCHED
#undef PG8_SETVO
#undef PG8_STAGE_A
}

__device__ __forceinline__ unsigned pk4_fp8(f32x4 v) { unsigned w = 0; w = __builtin_amdgcn_cvt_pk_fp8_f32(v[0], v[1], w, false); w = __builtin_amdgcn_cvt_pk_fp8_f32(v[2], v[3], w, true); return w; }
__device__ __forceinline__ float sq4(f32x4 v) { return (v[0] * v[0] + v[1] * v[1]) + (v[2] * v[2] + v[3] * v[3]); }
__device__ __forceinline__ float red_fq(float s) { s += __shfl_xor(s, 16); s += __shfl_xor(s, 32); return s; }
__device__ __forceinline__ u32x4 pack8(f32x4 a, f32x4 b) { u32x4 w; w.x = cvt_pk_bf16(a[0], a[1]); w.y = cvt_pk_bf16(a[2], a[3]); w.z = cvt_pk_bf16(b[0], b[1]); w.w = cvt_pk_bf16(b[2], b[3]); return w; }
template <int MODE> struct EpiBf16Stats {
    static constexpr bool PERM = true; static constexpr int MIDK = 0;
    bf16_t* O; int ldc; float* ssq; const float* rsx;
    __device__ __forceinline__ void operator()(const Acc& acc, const Unit& u, int wr, int wc, int fr, int fq) const {
        const int row0 = u.pm * BM + wr * 64 + fr, col0 = u.pn * BM + wc * 32 + 8 * fq;
        float rv[2][4];
#pragma unroll
        for (int ai = 0; ai < 2; ++ai)
#pragma unroll
            for (int m = 0; m < 4; ++m) rv[ai][m] = rsx ? rsx[row0 + ai * HALF + m * 16] : 1.f;
        asm volatile("" ::: "memory");
#pragma unroll
        for (int ai = 0; ai < 2; ++ai)
#pragma unroll
            for (int m = 0; m < 4; ++m) { const int row = row0 + ai * HALF + m * 16; bf16_t* rowp = O + (size_t)row * ldc + col0; const float rs = rv[ai][m];
                const f32x4 a00 = acc[ai][0][m][0] * rs, a01 = acc[ai][0][m][1] * rs, a10 = acc[ai][1][m][0] * rs, a11 = acc[ai][1][m][1] * rs;
                if (MODE == 0 && u.pn >= 4) { *(u32x4*)(O + (size_t)row * ldc + 960 + (u.pn - 4) * HALF + wc * 32 + 8 * fq) = pack8(a00 * a10, a01 * a11); continue; }
                *(u32x4*)(rowp) = pack8(a00, a01); if (!(MODE == 0 && u.pn == 3 && wc >= 2)) *(u32x4*)(rowp + HALF) = pack8(a10, a11);
                if (MODE == 1) { float s = (sq4(a00) + sq4(a01)) + (sq4(a10) + sq4(a11)); s = red_fq(s); if (fq == 0) ssq[(size_t)row * 16 + u.pn * 4 + wc] = s; }
                else if (u.pn == 0) { float s = (sq4(a00) + sq4(a01)) + (sq4(a10) + sq4(a11)); s = red_fq(s); if (fq == 0) ssq[(size_t)row * 8 + wc] = s; }
                else if (u.pn == 1) { float s = sq4(a00) + sq4(a01); s = red_fq(s); if (fq == 0) ssq[(size_t)row * 8 + 4 + wc] = s; } }
    }
};
struct EpiQ {
    static constexpr bool PERM = true; static constexpr int MIDK = 0;
    bf16_t* Q; const float* ssq; const float* cs;
    __device__ __forceinline__ void operator()(const Acc& acc, const Unit& u, int wr, int wc, int fr, int fq) const {
        const int row0 = u.pm * BM + wr * 64 + fr;
#pragma unroll
        for (int ai = 0; ai < 2; ++ai)
#pragma unroll
            for (int m = 0; m < 4; ++m) { const int row = row0 + ai * HALF + m * 16; const f32x4 sv = *(const f32x4*)(ssq + (size_t)row * 8);
                const float rs = rsqrtf(((sv[0] + sv[1]) + (sv[2] + sv[3])) * (1.f / QL) + EPS); const int b = row / SEQ, s = row % SEQ;
#pragma unroll
                for (int bj = 0; bj < 2; ++bj) { const int cv = u.pn * BM + bj * HALF + wc * 32 + 8 * fq; const int h = cv / DQK, d = cv % DQK;
                    f32x4 v0 = acc[ai][bj][m][0] * rs, v1 = acc[ai][bj][m][1] * rs;
                    if (d >= DN) { const int i0 = (d - DN) >> 1; const f32x4 c = *(const f32x4*)(cs + (size_t)row * 64 + i0), sn = *(const f32x4*)(cs + (size_t)row * 64 + 32 + i0);
                        const f32x4 r0 = {v0[0] * c[0] - v0[1] * sn[0], v0[0] * sn[0] + v0[1] * c[0], v0[2] * c[1] - v0[3] * sn[1], v0[2] * sn[1] + v0[3] * c[1]};
                        const f32x4 r1 = {v1[0] * c[2] - v1[1] * sn[2], v1[0] * sn[2] + v1[1] * c[2], v1[2] * c[3] - v1[3] * sn[3], v1[2] * sn[3] + v1[3] * c[3]};
                        v0 = r0; v1 = r1; }
                    *(u32x4*)(Q + ((size_t)(b * NH + h) * SEQ + s) * DQK + d) = pack8(v0, v1); } }
    }
};
struct EpiKV {
    static constexpr bool PERM = true; static constexpr int MIDK = 0;
    bf16_t* Kc; bf16_t* Vc; const float* ssq;
    __device__ __forceinline__ void operator()(const Acc& acc, const Unit& u, int wr, int wc, int fr, int fq) const {
        const int row0 = u.pm * BM + wr * 64 + fr, d = wc * 32 + 8 * fq, h = u.pn;
#pragma unroll
        for (int ai = 0; ai < 2; ++ai)
#pragma unroll
            for (int m = 0; m < 4; ++m) { const int row = row0 + ai * HALF + m * 16; const f32x4 sv = *(const f32x4*)(ssq + (size_t)row * 8 + 4);
                const float rs = rsqrtf(((sv[0] + sv[1]) + (sv[2] + sv[3])) * (1.f / KVL) + EPS); const int b = row / SEQ, s = row % SEQ; const size_t t = (size_t)(b * NH + h) * SEQ + s;
                *(u32x4*)(Kc + t * DQK + d) = pack8(acc[ai][0][m][0] * rs, acc[ai][0][m][1] * rs);
                *(u32x4*)(Vc + t * DV + d) = pack8(acc[ai][1][m][0] * rs, acc[ai][1][m][1] * rs); }
    }
};
struct EpiWo {
    static constexpr bool PERM = true; static constexpr int MIDK = 8;
    const bf16_t* x; bf16_t* HBF; unsigned char* X8; const float* assq; float* ssq1; const float* gmoe;
    __device__ __forceinline__ void mid(Acc& acc, const Unit& u, int wr, int wc, int fr, int fq) const {
        const int row0 = u.pm * BM + wr * 64 + fr;
#pragma unroll
        for (int ai = 0; ai < 2; ++ai)
#pragma unroll
            for (int m = 0; m < 4; ++m) { const f32x4 sv = *(const f32x4*)(assq + (size_t)(row0 + ai * HALF + m * 16) * 4);
                const float rs = rsqrtf(((sv[0] + sv[1]) + (sv[2] + sv[3])) * (1.f / 512.f) + EPS);
#pragma unroll
                for (int bj = 0; bj < 2; ++bj)
#pragma unroll
                    for (int n = 0; n < 2; ++n) acc[ai][bj][m][n] = acc[ai][bj][m][n] * rs; }
    }
    __device__ __forceinline__ void operator()(const Acc& acc, const Unit& u, int wr, int wc, int fr, int fq) const {
        const int row0 = u.pm * BM + wr * 64 + fr, col0 = u.pn * BM + wc * 32 + 8 * fq;
        f32x4 gn[2][2];
#pragma unroll
        for (int bj = 0; bj < 2; ++bj) { gn[bj][0] = *(const f32x4*)(gmoe + col0 + bj * HALF); gn[bj][1] = *(const f32x4*)(gmoe + col0 + bj * HALF + 4); }
#pragma unroll
        for (int ai = 0; ai < 2; ++ai) { u32x4 xv[4][2];
#pragma unroll
            for (int m = 0; m < 4; ++m) { const size_t off = (size_t)(row0 + ai * HALF + m * 16) * DM + col0;
#pragma unroll
                for (int bj = 0; bj < 2; ++bj) xv[m][bj] = *(const u32x4*)(x + off + bj * HALF); }
            asm volatile("" ::: "memory");
#pragma unroll
            for (int m = 0; m < 4; ++m) { const int row = row0 + ai * HALF + m * 16; const size_t off = (size_t)row * DM + col0; float ss = 0.f;
#pragma unroll
                for (int bj = 0; bj < 2; ++bj) { const u32x4 xq = xv[m][bj]; const f32x4 h0 = (f32x4){blo(xq.x), bhi(xq.x), blo(xq.y), bhi(xq.y)} + acc[ai][bj][m][0], h1 = (f32x4){blo(xq.z), bhi(xq.z), blo(xq.w), bhi(xq.w)} + acc[ai][bj][m][1];
                    *(u32x4*)(HBF + off + bj * HALF) = pack8(h0, h1); *(u32x2*)(X8 + off + bj * HALF) = (u32x2){pk4_fp8(h0 * gn[bj][0]), pk4_fp8(h1 * gn[bj][1])}; ss += sq4(h0) + sq4(h1); }
                ss = red_fq(ss); if (fq == 0) ssq1[(size_t)row * 16 + u.pn * 4 + wc] = ss; }
            asm volatile("" ::: "memory"); }
    }
};
__device__ __forceinline__ f32x4 sigmoid4(f32x4 a) { const f32x4 t = a * -1.44269504f; f32x4 e; e[0] = __builtin_amdgcn_exp2f(t[0]); e[1] = __builtin_amdgcn_exp2f(t[1]); e[2] = __builtin_amdgcn_exp2f(t[2]); e[3] = __builtin_amdgcn_exp2f(t[3]);
    const f32x4 d = e + 1.0f; f32x4 r; r[0] = __builtin_amdgcn_rcpf(d[0]); r[1] = __builtin_amdgcn_rcpf(d[1]); r[2] = __builtin_amdgcn_rcpf(d[2]); r[3] = __builtin_amdgcn_rcpf(d[3]); return r; }
__device__ __forceinline__ f32x2 swiglu2(f32x2 g, f32x2 u) {
    g.x = fminf(g.x, 7.f); g.y = fminf(g.y, 7.f); u.x = __builtin_amdgcn_fmed3f(u.x, -7.f, 7.f); u.y = __builtin_amdgcn_fmed3f(u.y, -7.f, 7.f);
    const f32x2 t = g * -2.45546696f; f32x2 e; e.x = __builtin_amdgcn_exp2f(t.x); e.y = __builtin_amdgcn_exp2f(t.y); const f32x2 d = e + 1.0f; f32x2 r; r.x = __builtin_amdgcn_rcpf(d.x); r.y = __builtin_amdgcn_rcpf(d.y);
    const f32x2 gs = g * r; return u * gs + gs; }
__device__ __forceinline__ float swiglu_f(float g, float u) { g = fminf(g, 7.f); u = __builtin_amdgcn_fmed3f(u, -7.f, 7.f); const float gs = g * __builtin_amdgcn_rcpf(1.f + __builtin_amdgcn_exp2f(g * -2.45546696f)); return fmaf(u, gs, gs); }
constexpr float WSCALE = 64.f, WINV = 1.f / 64.f;
struct EpiMoe1 {
    static constexpr bool PERM = true; static constexpr int MIDK = 0;
    unsigned char* HB; const float* b1; const float* rowrs;
    __device__ __forceinline__ void operator()(const Acc& acc, const Unit& u, int wr, int wc, int fr, int fq) const {
        const int row0 = u.pm * BM + wr * 64 + fr, j0 = u.pn * HALF + wc * 32 + 8 * fq; const float* bg = b1 + (size_t)u.e * 2048 + j0;
        const f32x4 g0 = *(const f32x4*)bg, g1 = *(const f32x4*)(bg + 4), u0 = *(const f32x4*)(bg + 1024), u1 = *(const f32x4*)(bg + 1028);
        float rsv[2][4];
#pragma unroll
        for (int ai = 0; ai < 2; ++ai)
#pragma unroll
            for (int m = 0; m < 4; ++m) rsv[ai][m] = rowrs[row0 + ai * HALF + m * 16];
        asm volatile("" ::: "memory");
#pragma unroll
        for (int ai = 0; ai < 2; ++ai)
#pragma unroll
            for (int m = 0; m < 4; ++m) { const float rs = rsv[ai][m] * WINV;
                const f32x4 a0 = acc[ai][0][m][0] * rs + g0, a1 = acc[ai][0][m][1] * rs + g1, c0 = acc[ai][1][m][0] * rs + u0, c1 = acc[ai][1][m][1] * rs + u1; f32x4 r0, r1;
#pragma unroll
                for (int j = 0; j < 4; j += 2) { const f32x2 s0 = swiglu2((f32x2){a0[j], a0[j + 1]}, (f32x2){c0[j], c0[j + 1]}), s1 = swiglu2((f32x2){a1[j], a1[j + 1]}, (f32x2){c1[j], c1[j + 1]}); r0[j] = s0.x; r0[j + 1] = s0.y; r1[j] = s1.x; r1[j + 1] = s1.y; }
                *(u32x2*)(HB + (size_t)(row0 + ai * HALF + m * 16) * DE + j0) = (u32x2){pk4_fp8(r0), pk4_fp8(r1)}; }
    }
};
struct EpiMoe2 {
    static constexpr bool PERM = true; static constexpr int MIDK = 0;
    unsigned char* Y; const float* b2; const int* rowslot; const float* rowgate;
    __device__ __forceinline__ void operator()(const Acc& acc, const Unit& u, int wr, int wc, int fr, int fq) const {
        const int row0 = u.pm * BM + wr * 64 + fr, col0 = u.pn * BM + wc * 64 + 16 * fq; const float* bb = b2 + (size_t)u.e * DM + col0;
        f32x4 bv[2][2];
#pragma unroll
        for (int bj = 0; bj < 2; ++bj)
#pragma unroll
            for (int n = 0; n < 2; ++n) bv[bj][n] = *(const f32x4*)(bb + bj * 8 + 4 * n);
        float gtv[2][4]; int slv[2][4];
#pragma unroll
        for (int ai = 0; ai < 2; ++ai)
#pragma unroll
            for (int m = 0; m < 4; ++m) { const int r = row0 + ai * HALF + m * 16; gtv[ai][m] = rowgate[r]; slv[ai][m] = rowslot[r]; }
        asm volatile("" ::: "memory");
#pragma unroll
        for (int ai = 0; ai < 2; ++ai)
#pragma unroll
            for (int m = 0; m < 4; ++m) { const float gt = gtv[ai][m]; unsigned char* yp = Y + (size_t)slv[ai][m] * DM + col0;
                *(u32x4*)yp = (u32x4){pk4_fp8((acc[ai][0][m][0] * WINV + bv[0][0]) * gt), pk4_fp8((acc[ai][0][m][1] * WINV + bv[0][1]) * gt), pk4_fp8((acc[ai][1][m][0] * WINV + bv[1][0]) * gt), pk4_fp8((acc[ai][1][m][1] * WINV + bv[1][1]) * gt)}; }
    }
};
struct EpiPle {
    static constexpr bool PERM = true; static constexpr int MIDK = 0;
    const bf16_t* H2; bf16_t* H3; const bf16_t* pler; const float* rpv; const float* rs2; const float* pg; float* fssq;
    __device__ __forceinline__ void operator()(const Acc& acc, const Unit& u, int wr, int wc, int fr, int fq) const {
        const int row0 = u.pm * BM + wr * 64 + fr, col0 = u.pn * BM + wc * 32 + 8 * fq;
        f32x4 gv[2][2];
#pragma unroll
        for (int bj = 0; bj < 2; ++bj)
#pragma unroll
            for (int n = 0; n < 2; ++n) gv[bj][n] = *(const f32x4*)(pg + col0 + bj * HALF + n * 4);
#pragma unroll
        for (int am = 0; am < 4; ++am) { const int ai = am >> 1; u32x4 hq[2][2], pq[2][2]; float r2v[2], rpq[2];
#pragma unroll
            for (int mm = 0; mm < 2; ++mm) { const int row = row0 + ai * HALF + ((am & 1) * 2 + mm) * 16; const size_t off = (size_t)row * DM + col0; r2v[mm] = rs2[row]; rpq[mm] = rpv[row];
#pragma unroll
                for (int bj = 0; bj < 2; ++bj) { hq[mm][bj] = *(const u32x4*)(H2 + off + bj * HALF); pq[mm][bj] = *(const u32x4*)(pler + off + bj * HALF); } }
            asm volatile("" ::: "memory");
#pragma unroll
            for (int mm = 0; mm < 2; ++mm) { const int m = (am & 1) * 2 + mm; const int row = row0 + ai * HALF + m * 16; const size_t off = (size_t)row * DM + col0; const float r2 = r2v[mm], rp = rpq[mm]; float ss = 0.f;
#pragma unroll
                for (int bj = 0; bj < 2; ++bj) { const size_t o = off + bj * HALF; const u32x4 hv = hq[mm][bj], pr = pq[mm][bj];
                    const f32x4 h0 = {blo(hv.x), bhi(hv.x), blo(hv.y), bhi(hv.y)}, h1 = {blo(hv.z), bhi(hv.z), blo(hv.w), bhi(hv.w)};
                    const f32x4 q0 = {blo(pr.x), bhi(pr.x), blo(pr.y), bhi(pr.y)}, q1 = {blo(pr.z), bhi(pr.z), blo(pr.w), bhi(pr.w)};
                    const f32x4 r0 = h0 + sigmoid4(acc[ai][bj][m][0] * r2) * (q0 * (gv[bj][0] * rp)), r1 = h1 + sigmoid4(acc[ai][bj][m][1] * r2) * (q1 * (gv[bj][1] * rp));
                    *(u32x4*)(H3 + o) = pack8(r0, r1); ss += sq4(r0) + sq4(r1); }
                ss = red_fq(ss); if (fq == 0) fssq[(size_t)row * 16 + u.pn * 4 + wc] = ss; }
            asm volatile("" ::: "memory"); }
    }
};
struct EpiPleFinal {
    static constexpr bool PERM = true; static constexpr int MIDK = 0;
    const bf16_t* H2; float* out; const bf16_t* pler; const float* rpv; const float* rs2; const float* pg; const float* gf; float* xs; unsigned* cnt; unsigned* tmo; LAS unsigned char* lds;
    __device__ __forceinline__ void operator()(Acc& acc, const Unit& u, int wr, int wc, int fr, int fq) const {
        const int row0 = u.pm * BM + wr * 64 + fr, col0 = u.pn * BM + wc * 32 + 8 * fq;
        LAS float* P = (LAS float*)(lds + STG_OFF); LAS float* S = P + 1024; const int tid = (wr * 4 + wc) * 64 + fq * 16 + fr;
#define PF_BAR() asm volatile("s_waitcnt lgkmcnt(0)\n\ts_barrier" ::: "memory")
        { f32x4 gv[2][2];
#pragma unroll
          for (int bj = 0; bj < 2; ++bj)
#pragma unroll
            for (int n = 0; n < 2; ++n) gv[bj][n] = *(const f32x4*)(pg + col0 + bj * HALF + n * 4);
#pragma unroll
          for (int am = 0; am < 4; ++am) { const int ai = am >> 1; u32x4 hq[2][2], pq[2][2]; float r2v[2], rpq[2];
#pragma unroll
            for (int mm = 0; mm < 2; ++mm) { const int row = row0 + ai * HALF + ((am & 1) * 2 + mm) * 16; const size_t off = (size_t)row * DM + col0; r2v[mm] = rs2[row]; rpq[mm] = rpv[row];
#pragma unroll
                for (int bj = 0; bj < 2; ++bj) { hq[mm][bj] = *(const u32x4*)(H2 + off + bj * HALF); pq[mm][bj] = *(const u32x4*)(pler + off + bj * HALF); } }
            asm volatile("" ::: "memory");
#pragma unroll
            for (int mm = 0; mm < 2; ++mm) { const int m = (am & 1) * 2 + mm; const float r2 = r2v[mm], rp = rpq[mm]; float ss = 0.f;
#pragma unroll
                for (int bj = 0; bj < 2; ++bj) { const u32x4 hv = hq[mm][bj], pr = pq[mm][bj];
                    const f32x4 h0 = {blo(hv.x), bhi(hv.x), blo(hv.y), bhi(hv.y)}, h1 = {blo(hv.z), bhi(hv.z), blo(hv.w), bhi(hv.w)};
                    const f32x4 q0 = {blo(pr.x), bhi(pr.x), blo(pr.y), bhi(pr.y)}, q1 = {blo(pr.z), bhi(pr.z), blo(pr.w), bhi(pr.w)};
                    const f32x4 r0 = h0 + sigmoid4(acc[ai][bj][m][0] * r2) * (q0 * (gv[bj][0] * rp)), r1 = h1 + sigmoid4(acc[ai][bj][m][1] * r2) * (q1 * (gv[bj][1] * rp));
                    acc[ai][bj][m][0] = r0; acc[ai][bj][m][1] = r1; ss += sq4(r0) + sq4(r1); }
                ss = red_fq(ss); if (fq == 0) P[(ai * HALF + wr * 64 + m * 16 + fr) * 4 + wc] = ss; }
            asm volatile("" ::: "memory"); } }
        PF_BAR();
        if (tid < 256) { const f32x4 p4 = *(const LAS f32x4*)(P + tid * 4); __hip_atomic_store(xs + (size_t)(u.pm * 4 + u.pn) * 256 + tid, (p4[0] + p4[1]) + (p4[2] + p4[3]), __ATOMIC_RELAXED, __HIP_MEMORY_SCOPE_AGENT); }
        asm volatile("s_waitcnt vmcnt(0)" ::: "memory");
        PF_BAR();
        if (tid < 64) {
            if (tid == 0) (void)__hip_atomic_fetch_add(cnt + 64 * u.pm, 1u, __ATOMIC_RELAXED, __HIP_MEMORY_SCOPE_AGENT);
            unsigned sp = 0;
            while ((unsigned)__builtin_amdgcn_readfirstlane(__hip_atomic_load(cnt + 64 * u.pm, __ATOMIC_RELAXED, __HIP_MEMORY_SCOPE_AGENT)) < 4u) {
                __builtin_amdgcn_s_sleep(2); if (++sp > (1u << 22)) { if (tid == 0) __hip_atomic_store(tmo, 1u, __ATOMIC_RELAXED, __HIP_MEMORY_SCOPE_AGENT); break; } }
            __builtin_amdgcn_fence(__ATOMIC_ACQUIRE, "agent");
            asm volatile("s_waitcnt vmcnt(0)" ::: "memory"); }
        PF_BAR();
        if (tid < 256) { float t = 0.f;
#pragma unroll
            for (int q = 0; q < 4; ++q) t += __hip_atomic_load(xs + (size_t)(u.pm * 4 + q) * 256 + tid, __ATOMIC_RELAXED, __HIP_MEMORY_SCOPE_AGENT);
            S[tid] = rsqrtf(t * (1.f / DM) + EPS); }
        PF_BAR();
        { f32x4 gq[2][2];
#pragma unroll
          for (int bj = 0; bj < 2; ++bj)
#pragma unroll
            for (int n = 0; n < 2; ++n) gq[bj][n] = *(const f32x4*)(gf + col0 + bj * HALF + n * 4);
#pragma unroll
          for (int ai = 0; ai < 2; ++ai)
#pragma unroll
            for (int m = 0; m < 4; ++m) { const float rs = S[ai * HALF + wr * 64 + m * 16 + fr]; float* op = out + (size_t)(row0 + ai * HALF + m * 16) * DM + col0;
#pragma unroll
                for (int bj = 0; bj < 2; ++bj) { *(f32x4*)(op + bj * HALF) = acc[ai][bj][m][0] * rs * gq[bj][0]; *(f32x4*)(op + bj * HALF + 4) = acc[ai][bj][m][1] * rs * gq[bj][1]; } } }
        PF_BAR();
#undef PF_BAR
    }
};
}

namespace att {
typedef float f32x16 __attribute__((ext_vector_type(16)));
typedef short s16x4 __attribute__((ext_vector_type(4)));
constexpr int QBLK = 32, KVBLK = 64, QB = 256;
constexpr int SHM_K = KVBLK * DQK * 2, SHM_V = KVBLK * DV * 2;
constexpr int L_V = 0, L_K = 2 * SHM_V, L_WS = L_K + 2 * SHM_K, L_END = L_WS + NWAVES * 256;
constexpr float THR = 8.f;
#define KSWZ(row, colB) ((row) * 384 + ((colB) ^ (((row) & 7) << 4)))
#define SBAR() __builtin_amdgcn_sched_barrier(0)
__device__ __forceinline__ int v_st(int k, int c) { const int kk = (k & ~0xC) | ((k & 4) << 1) | ((k & 8) >> 1); return ((kk >> 3) * 4 + (c >> 5)) * 512 + ((kk & 7) * 32 + (c & 31)) * 2; }
__device__ __forceinline__ int v_rd_base(int lane) { return ((lane & 3) << 3) | (((lane >> 2) & 3) << 6) | (((lane >> 4) & 1) << 5) | (((lane >> 5) & 1) << 8); }
constexpr int v_rd_off(int d0, int ks, int half) { return d0 * 512 + ks * 4096 + half * 2048; }
__device__ __forceinline__ int crow(int r, int hi) { return (r & 3) + 8 * (r >> 2) + 4 * hi; }
typedef __bf16 bf16x2_t __attribute__((ext_vector_type(2)));
__device__ __forceinline__ unsigned cvtpk(float lo, float hi) { f32x2 v = {lo, hi}; bf16x2_t b = __builtin_convertvector(v, bf16x2_t); return __builtin_bit_cast(unsigned, b); }

__device__ __forceinline__ void qkt(f32x16& p0, f32x16& p1, const LAS unsigned char* Kbuf, int r32, int hi, const bf16x8* qr) {
    p0 = f32x16{}; p1 = f32x16{};
    const LAS unsigned char* kb[4];
#pragma unroll
    for (int dd = 0; dd < 4; ++dd) kb[dd] = Kbuf + KSWZ(r32, (dd * 16 + hi * 8) * 2);
#pragma unroll
    for (int d0 = 0; d0 < 12; ++d0) { const LAS unsigned char* a = kb[d0 & 3] + (d0 >> 2) * 128;
        const bf16x8 b0 = *(const LAS bf16x8*)a; const bf16x8 b1 = *(const LAS bf16x8*)(a + 32 * 384);
        p0 = __builtin_amdgcn_mfma_f32_32x32x16_bf16(b0, qr[d0], p0, 0, 0, 0);
        p1 = __builtin_amdgcn_mfma_f32_32x32x16_bf16(b1, qr[d0], p1, 0, 0, 0); }
}
template <int VB>
__device__ __forceinline__ void pv_tile(f32x16* o, int vb0, bf16x8 pa0, bf16x8 pa1, bf16x8 pa2, bf16x8 pa3) {
#define TRRD(dst, off) asm volatile("ds_read_b64_tr_b16 %0, %1 offset:%2" : "=&v"(dst) : "v"(vb0), "i"(off) : "memory")
#define PV_D0(d0) do { s16x4 l0, l1, l2, l3, h0, h1, h2, h3; constexpr int b_ = VB * SHM_V + v_rd_off(d0, 0, 0); \
        TRRD(l0, b_); TRRD(h0, b_ + 2048); TRRD(l1, b_ + 4096); TRRD(h1, b_ + 6144); TRRD(l2, b_ + 8192); TRRD(h2, b_ + 10240); TRRD(l3, b_ + 12288); TRRD(h3, b_ + 14336); \
        asm volatile("s_waitcnt lgkmcnt(0)" ::: "memory"); SBAR(); \
        o[d0] = __builtin_amdgcn_mfma_f32_32x32x16_bf16(pa0, (bf16x8){l0[0], l0[1], l0[2], l0[3], h0[0], h0[1], h0[2], h0[3]}, o[d0], 0, 0, 0); \
        o[d0] = __builtin_amdgcn_mfma_f32_32x32x16_bf16(pa1, (bf16x8){l1[0], l1[1], l1[2], l1[3], h1[0], h1[1], h1[2], h1[3]}, o[d0], 0, 0, 0); \
        o[d0] = __builtin_amdgcn_mfma_f32_32x32x16_bf16(pa2, (bf16x8){l2[0], l2[1], l2[2], l2[3], h2[0], h2[1], h2[2], h2[3]}, o[d0], 0, 0, 0); \
        o[d0] = __builtin_amdgcn_mfma_f32_32x32x16_bf16(pa3, (bf16x8){l3[0], l3[1], l3[2], l3[3], h3[0], h3[1], h3[2], h3[3]}, o[d0], 0, 0, 0); } while (0)
    PV_D0(0); PV_D0(1); PV_D0(2); PV_D0(3);
#undef PV_D0
#undef TRRD
}
struct ConvJob { const float* w1; const float* w2; const float* gain; unsigned char* W1T; unsigned char* W2T; int gw, ngw; };
constexpr int CV_N1 = NE * 32 * 64, CV_N2 = NE * 32 * 32, CV_TOTAL = CV_N1 + CV_N2;
__device__ __forceinline__ int cv_cmap2(int n) { const int t = n & ~255, v = n & 255; return t + 64 * ((v >> 5) & 3) + 16 * ((v >> 3) & 3) + 8 * (v >> 7) + (v & 7); }
__device__ __forceinline__ int cv_cmap1(int n) { const int pn = n >> 8, half = (n >> 7) & 1, jj = n & 127; return half * 1024 + pn * 128 + jj; }
#define CV_DECODE(idx) \
    const bool cv_on = (idx) < CV_TOTAL; const bool cv_is1 = (idx) < CV_N1; const int cv_r = cv_is1 ? (idx) : (idx) - CV_N1; \
    const int cv_nblk = cv_is1 ? 64 : 32, cv_ld = cv_is1 ? 2048 : 1024; const int cv_e = cv_r / (32 * cv_nblk), cv_q = cv_r % (32 * cv_nblk), cv_k0 = 32 * (cv_q / cv_nblk), cv_n0 = 32 * (cv_q % cv_nblk); \
    const float* cv_src = (cv_is1 ? cj.w1 + (size_t)cv_e * 1024 * 2048 : cj.w2 + (size_t)cv_e * 1024 * 1024); \
    const int cv_c = cv_is1 ? cv_cmap1(cv_n0 + (lane & 31)) : cv_cmap2(cv_n0 + (lane & 31));
#define CV_LOAD() do { if (cv_on) { _Pragma("unroll") for (int i = 0; i < 16; ++i) cvw[i] = cv_src[(size_t)(cv_k0 + 2 * i + hi) * cv_ld + cv_c]; } } while (0)
#define CV_STORE() do { if (cv_on) { LAS float* scr = (LAS float*)(lds + L_END) + wid * (32 * 33); \
        _Pragma("unroll") for (int i = 0; i < 16; ++i) { const int kk = 2 * i + hi; scr[kk * 33 + (lane & 31)] = cvw[i] * 64.f; } \
        asm volatile("s_waitcnt lgkmcnt(0)" ::: "memory"); \
        { const int n = lane >> 1, cc = lane & 1; const LAS float* s = scr + (16 * cc) * 33 + n; u32x4 o; \
          o.x = pg8::pk4_fp8((f32x4){s[0 * 33], s[1 * 33], s[2 * 33], s[3 * 33]}); o.y = pg8::pk4_fp8((f32x4){s[4 * 33], s[5 * 33], s[6 * 33], s[7 * 33]}); \
          o.z = pg8::pk4_fp8((f32x4){s[8 * 33], s[9 * 33], s[10 * 33], s[11 * 33]}); o.w = pg8::pk4_fp8((f32x4){s[12 * 33], s[13 * 33], s[14 * 33], s[15 * 33]}); \
          unsigned char* dst = (cv_is1 ? cj.W1T + (size_t)cv_e * 2048 * 1024 : cj.W2T + (size_t)cv_e * 1024 * 1024) + (size_t)(cv_n0 + n) * 1024 + cv_k0 + 16 * cc; *(u32x4*)dst = o; } \
        asm volatile("s_waitcnt lgkmcnt(0)" ::: "memory"); } } while (0)
__device__ __forceinline__ void attn_block(int bh, int qb, const bf16_t* __restrict__ Q, const bf16_t* __restrict__ K, const bf16_t* __restrict__ V, bf16_t* __restrict__ MIX, float* __restrict__ ASSQ, LAS unsigned char* lds, const int wid, const ConvJob& cj, int& tseq) {
    const int lane = lane_id(), r32 = lane & 31, hi = lane >> 5;
    const int b = bh / NH, h = bh % NH;
    const bf16_t* Qw = Q + ((size_t)bh * SEQ + qb * QB + wid * QBLK + r32) * DQK;
    const bf16_t* Kh = K + (size_t)bh * SEQ * DQK; const bf16_t* Vh = V + (size_t)bh * SEQ * DV;
    bf16x8 qr[12];
#pragma unroll
    for (int d0 = 0; d0 < 12; ++d0) qr[d0] = *(const bf16x8*)(Qw + d0 * 16 + hi * 8);
    const int NT = 4 * qb + 4, qlo = qb * QB + wid * QBLK, qm = qlo + r32 - 4 * hi;
    LAS unsigned char* V_lds = lds + L_V; LAS unsigned char* K_lds = lds + L_K;
    LAS float* wsf = (LAS float*)(lds + L_WS) + wid * 64; LAS float* li_l = wsf; LAS float* al_l = wsf + 32;
    unsigned ksrc[3], vsrc[2];
#pragma unroll
    for (int i = 0; i < 3; ++i) { const int off = ((wid + 8 * i) * 64 + lane) * 16, row = off / 384, wb = off % 384, seg = wb >> 7, cpos = (wb & 127) >> 4; ksrc[i] = (unsigned)(row * 384 + seg * 128 + ((cpos ^ (row & 7)) << 4)); }
#pragma unroll
    for (int i = 0; i < 2; ++i) { const int off = ((wid + 8 * i) * 64 + lane) * 16, st = off >> 9, o_ = off & 511, kk = (st >> 2) * 8 + (o_ >> 6), c = (st & 3) * 32 + ((o_ & 63) >> 1);
        const int k = (kk & ~0xC) | ((kk & 4) << 1) | ((kk & 8) >> 1); vsrc[i] = (unsigned)(k * 256 + c * 2); }
    const int vb0 = (int)(unsigned)(uintptr_t)V_lds + v_rd_base(lane);
#define ADMA(t, bf) do { const char* kp = (const char*)(Kh + (size_t)(t) * KVBLK * DQK); const char* vp = (const char*)(Vh + (size_t)(t) * KVBLK * DV); \
        _Pragma("unroll") for (int i = 0; i < 3; ++i) __builtin_amdgcn_global_load_lds((const unsigned*)(kp + ksrc[i]), (LAS unsigned*)(K_lds + (bf) * SHM_K + (wid + 8 * i) * 1024), 16, 0, 0); \
        _Pragma("unroll") for (int i = 0; i < 2; ++i) __builtin_amdgcn_global_load_lds((const unsigned*)(vp + vsrc[i]), (LAS unsigned*)(V_lds + (bf) * SHM_V + (wid + 8 * i) * 1024), 16, 0, 0); } while (0)
    float m_reg = -1e30f, l_reg = 0.f; f32x16 o[4] = {}; float cvw[16]; int cv_pend = -1;
    ADMA(0, 0);
#define TILE(t, BF) do { \
        asm volatile("s_waitcnt vmcnt(0)" ::: "memory"); __syncthreads(); \
        if ((t) + 1 < NT) ADMA((t) + 1, (BF) ^ 1); \
        if (cv_pend >= 0) { CV_DECODE(cv_pend) CV_STORE(); }     \
        { const int cv_idx = tseq * cj.ngw + cj.gw; ++tseq; CV_DECODE(cv_idx) CV_LOAD(); cv_pend = cv_on ? cv_idx : -1; } SBAR(); \
        const int kb_ = (t) * KVBLK; \
        if (kb_ <= qlo + QBLK - 1) { \
            f32x16 p0, p1; SBAR(); qkt(p0, p1, K_lds + (BF) * SHM_K, r32, hi, qr); \
            if (kb_ + KVBLK - 1 > qlo) { const int dq = qm - kb_; const float NEG = -__builtin_inff(); \
                _Pragma("unroll") for (int r = 0; r < 16; ++r) { const int c = (r & 3) + 8 * (r >> 2); if (c > dq) p0[r] = NEG; if (c + 32 > dq) p1[r] = NEG; } } \
            float pmax = p0[0]; _Pragma("unroll") for (int r = 1; r < 16; ++r) pmax = fmaxf(pmax, p0[r]); _Pragma("unroll") for (int r = 0; r < 16; ++r) pmax = fmaxf(pmax, p1[r]); \
            { auto rr = __builtin_amdgcn_permlane32_swap(__float_as_uint(pmax), __float_as_uint(pmax), false, false); pmax = fmaxf(__uint_as_float(rr[0]), __uint_as_float(rr[1])); } \
            if (!__all(pmax - m_reg <= THR)) { const float mn = fmaxf(m_reg, pmax); const float alpha = __builtin_amdgcn_exp2f(m_reg - mn); m_reg = mn; l_reg *= alpha; \
                if (hi == 0) al_l[r32] = alpha; asm volatile("s_waitcnt lgkmcnt(0)" ::: "memory"); \
                _Pragma("unroll") for (int d_ = 0; d_ < 4; ++d_) _Pragma("unroll") for (int r = 0; r < 16; ++r) o[d_][r] *= al_l[crow(r, hi)]; } \
            float ps = 0.f; \
            _Pragma("unroll") for (int r = 0; r < 16; ++r) { p0[r] = __builtin_amdgcn_exp2f(p0[r] - m_reg); p1[r] = __builtin_amdgcn_exp2f(p1[r] - m_reg); } \
            _Pragma("unroll") for (int r = 0; r < 16; ++r) ps += p0[r] + p1[r]; \
            { auto rr = __builtin_amdgcn_permlane32_swap(__float_as_uint(ps), __float_as_uint(ps), false, false); ps = __uint_as_float(rr[0]) + __uint_as_float(rr[1]); } \
            l_reg += ps; \
            bf16x8 pa0, pa1, pa2, pa3; \
            PK4(p0, 0, pa0); PK4(p0, 8, pa1); PK4(p1, 0, pa2); PK4(p1, 8, pa3); \
            SBAR(); pv_tile<BF>(o, vb0, pa0, pa1, pa2, pa3); } \
        } while (0)
#define PK4(P, B_, OUT) do { unsigned a0 = cvtpk(P[B_ + 0], P[B_ + 1]), a1 = cvtpk(P[B_ + 2], P[B_ + 3]); \
        unsigned b0 = cvtpk(P[B_ + 4], P[B_ + 5]), b1 = cvtpk(P[B_ + 6], P[B_ + 7]); \
        auto r0 = __builtin_amdgcn_permlane32_swap(a0, b0, false, false); auto r1 = __builtin_amdgcn_permlane32_swap(a1, b1, false, false); \
        u32x4 w = {r0[0], r1[0], r0[1], r1[1]}; OUT = __builtin_bit_cast(bf16x8, w); } while (0)
    for (int t = 0; t < NT; t += 2) { TILE(t, 0); TILE(t + 1, 1); }
#undef PK4
#undef TILE
#undef ADMA
    if (cv_pend >= 0) { asm volatile("s_waitcnt vmcnt(0)" ::: "memory"); CV_DECODE(cv_pend) CV_STORE(); }
    if (hi == 0) li_l[r32] = l_reg;
    asm volatile("s_waitcnt vmcnt(0) lgkmcnt(0)" ::: "memory");
    float rli[16];
#pragma unroll
    for (int r = 0; r < 16; ++r) rli[r] = __builtin_amdgcn_rcpf(li_l[crow(r, hi)]);
    __syncthreads();
    LAS bf16_t* stg = (LAS bf16_t*)(lds + wid * 8192);
#pragma unroll
    for (int r = 0; r < 16; ++r) { const int orow = crow(r, hi);
#pragma unroll
        for (int d0 = 0; d0 < 4; ++d0) stg[orow * 128 + d0 * 32 + r32] = f2bf(o[d0][r] * rli[r]); }
    asm volatile("s_waitcnt lgkmcnt(0)" ::: "memory");
    const size_t row0 = (size_t)b * SEQ + qb * QB + wid * QBLK;
#pragma unroll
    for (int i = 0; i < 8; ++i) { const int row = i * 4 + (lane >> 4), ch = lane & 15; const u32x4 v = *(const LAS u32x4*)(stg + row * 128 + ch * 8);
        float ss = (blo(v.x) * blo(v.x) + bhi(v.x) * bhi(v.x)) + (blo(v.y) * blo(v.y) + bhi(v.y) * bhi(v.y)) + (blo(v.z) * blo(v.z) + bhi(v.z) * bhi(v.z)) + (blo(v.w) * blo(v.w) + bhi(v.w) * bhi(v.w));
        ss += __shfl_xor(ss, 1); ss += __shfl_xor(ss, 2); ss += __shfl_xor(ss, 4); ss += __shfl_xor(ss, 8);
        *(u32x4*)(MIX + (row0 + row) * DM + h * DV + ch * 8) = v;
        if (ch == 0) ASSQ[(row0 + row) * 4 + h] = ss; }
    __syncthreads();
}
#undef KSWZ
#undef SBAR
}

struct Args { const void* in[25]; float* out; unsigned char* ws; int ph_lo, ph_hi, li, skip; };
enum { PH_PREP = 0, PH_INPROJ, PH_TOKLOCAL, PH_ATTN, PH_WO, PH_ROUTER, PH_ROUTE, PH_MOE1, PH_MOE2, PH_COMBINE, PH_PLE, PH_FINAL, PH_COUNT };

template <int MODE> __device__ __forceinline__ int cmap_col(int n) {
    if (MODE == 1) { const int pn = n >> 8, half = (n >> 7) & 1, jj = n & 127; return half * 1024 + pn * 128 + jj; }
    if (MODE == 4) { if (n < 1024) return n < 960 ? n : INW; const int v = n - 1024, j = v >> 8, hf = (v >> 7) & 1, cc = v & 127; return (hf ? 1472 : 960) + 128 * j + cc; }
    if (MODE == 2) { const int h = n / DQK, d = n % DQK; if (d < DN) return n; const int t = d - DN; return h * DQK + DN + (t & 1) * 32 + (t >> 1); }
    return n;
}
template <int MODE> __device__ __forceinline__ void transpose_item_fp8(const float* __restrict__ W, int ldsrc, int nblk, unsigned char* __restrict__ WT, int ldd, const float* __restrict__ gain, float scale,
                                                                      LAS float* scr, int item, int lane) {
    const int kb = item / nblk, nb = item % nblk, k0 = 64 * kb, n0 = 32 * nb; const int c = cmap_col<MODE>(n0 + (lane & 31));
    float wv[32];
#pragma unroll
    for (int i = 0; i < 32; ++i) wv[i] = W[(size_t)(k0 + 2 * i + (lane >> 5)) * ldsrc + c];
#pragma unroll
    for (int i = 0; i < 32; ++i) { const int kk = 2 * i + (lane >> 5), k = k0 + kk; float gk = scale; if (gain) gk *= gain[k]; scr[kk * 33 + (lane & 31)] = wv[i] * gk; }
    asm volatile("s_waitcnt lgkmcnt(0)" ::: "memory");
    const int cc = lane & 3;
#pragma unroll
    for (int j = 0; j < 2; ++j) { const int n = (lane >> 2) + 16 * j; const LAS float* s = scr + (16 * cc) * 33 + n; u32x4 o;
        o.x = pg8::pk4_fp8((f32x4){s[0 * 33], s[1 * 33], s[2 * 33], s[3 * 33]}); o.y = pg8::pk4_fp8((f32x4){s[4 * 33], s[5 * 33], s[6 * 33], s[7 * 33]});
        o.z = pg8::pk4_fp8((f32x4){s[8 * 33], s[9 * 33], s[10 * 33], s[11 * 33]}); o.w = pg8::pk4_fp8((f32x4){s[12 * 33], s[13 * 33], s[14 * 33], s[15 * 33]});
        *(u32x4*)(WT + (size_t)(n0 + n) * ldd + k0 + 16 * cc) = o; }
    asm volatile("s_waitcnt lgkmcnt(0)" ::: "memory");
}
template <int MODE> __device__ __forceinline__ void transpose_item(const float* __restrict__ W, int ldsrc, int nblk, bf16_t* __restrict__ WT, int ldd, const float* __restrict__ gain, const float* __restrict__ gain2, float scale,
                                                                  LAS float* scr, int item, int lane) {
    const int kb = item / nblk, nb = item % nblk, k0 = 64 * kb, n0 = 32 * nb; const int c = cmap_col<MODE>(n0 + (lane & 31));
    float wv[32], gq[32];
#pragma unroll
    for (int i = 0; i < 32; ++i) wv[i] = W[(size_t)(k0 + 2 * i + (lane >> 5)) * ldsrc + c];
#pragma unroll
    for (int i = 0; i < 32; ++i) { const int k = k0 + 2 * i + (lane >> 5); gq[i] = gain ? ((gain2 && k >= 512) ? gain2[k - 512] : gain[k]) : 1.f; }
    asm volatile("" ::: "memory");
#pragma unroll
    for (int i = 0; i < 32; ++i) { const int kk = 2 * i + (lane >> 5); scr[kk * 33 + (lane & 31)] = wv[i] * (gq[i] * scale); }
    asm volatile("s_waitcnt lgkmcnt(0)" ::: "memory");
    const int cc = lane & 7;
#pragma unroll
    for (int j = 0; j < 4; ++j) { const int n = (lane >> 3) + 8 * j; const LAS float* s = scr + (8 * cc) * 33 + n;
        u32x4 o; o.x = pk2(s[0 * 33], s[1 * 33]); o.y = pk2(s[2 * 33], s[3 * 33]); o.z = pk2(s[4 * 33], s[5 * 33]); o.w = pk2(s[6 * 33], s[7 * 33]);
        *(u32x4*)(WT + (size_t)(n0 + n) * ldd + k0 + 8 * cc) = o; }
    asm volatile("s_waitcnt lgkmcnt(0)" ::: "memory");
}

__global__ void __launch_bounds__(NTHREADS, 2) fwd(Args args) {
    extern __shared__ __attribute__((aligned(16))) unsigned char lds_raw[];
    LAS unsigned char* lds = (LAS unsigned char*)lds_raw;
    volatile LAS unsigned* MISC = (volatile LAS unsigned*)(lds + MISC_OFF);
    const int wave = __builtin_amdgcn_readfirstlane(threadIdx.x >> 6);
    const int G = gridDim.x, bx = blockIdx.x;
#define PHASE_LANE const int lane = lane_id(); const int tid = wave * 64 + lane; (void)tid
    const int gw = bx * NWAVES + wave, NGW = G * NWAVES;
    unsigned char* ws = args.ws; int* ctl = (int*)(ws + WS_CTL); float* H = args.out;
    const float* x = (const float*)args.in[0]; const float* p = (const float*)args.in[1]; const int* pos = (const int*)args.in[2];
    const float *mix_norm = (const float*)args.in[3], *w_in = (const float*)args.in[4], *q_norm = (const float*)args.in[5], *w_uq = (const float*)args.in[6], *kv_norm = (const float*)args.in[7],
                *w_ukv = (const float*)args.in[8], *attn_out_norm = (const float*)args.in[10], *conv_out_norm = (const float*)args.in[11], *w_o = (const float*)args.in[12],
                *moe_norm = (const float*)args.in[13], *w_router = (const float*)args.in[14], *w1 = (const float*)args.in[16], *b1 = (const float*)args.in[17],
                *w2 = (const float*)args.in[18], *b2 = (const float*)args.in[19], *ple_norm = (const float*)args.in[20], *w_ple_gate = (const float*)args.in[21], *w_ple_proj = (const float*)args.in[22],
                *ple_post_norm = (const float*)args.in[23], *conv_w = (const float*)args.in[9], *b_router = (const float*)args.in[15], *final_norm = (const float*)args.in[24];
    int* TOPI = (int*)(ws + WS_TOPI); float* TOPG = (float*)(ws + WS_TOPG);
    bf16_t *HBF = (bf16_t*)(ws + WS_HBF), *H3 = (bf16_t*)(ws + WS_H3), *WRHL = (bf16_t*)(ws + WS_WRHL); unsigned char* X8 = (unsigned char*)(ws + WS_K);
    float* RSX = (float*)(ws + WS_RSX);
    float *SSQ1 = (float*)(ws + WS_SSQ1), *RS1 = (float*)(ws + WS_RS1), *RS2 = (float*)(ws + WS_RS2), *ROWRS = (float*)(ws + WS_ROWRS);
    bf16_t *WIN = (bf16_t*)(ws + WS_WIN), *WUQ = (bf16_t*)(ws + WS_WUQ), *WUKV = (bf16_t*)(ws + WS_WUKV), *WO = (bf16_t*)(ws + WS_WO), *WG = (bf16_t*)(ws + WS_WG), *WP = (bf16_t*)(ws + WS_WP);
    bf16_t *W1T = (bf16_t*)(ws + WS_W1), *W2T = (bf16_t*)(ws + WS_W2), *XN = (bf16_t*)(ws + WS_XN), *MIX = (bf16_t*)(ws + WS_MIX), *PLER = (bf16_t*)(ws + WS_PLER);
    bf16_t *Z = (bf16_t*)(ws + WS_Z), *Qb = (bf16_t*)(ws + WS_Q), *Kb = (bf16_t*)(ws + WS_K), *Vb = (bf16_t*)(ws + WS_V), *HB = (bf16_t*)(ws + WS_HB), *Y = (bf16_t*)(ws + WS_Y), *P16 = (bf16_t*)(ws + WS_P16);
    float *WR = (float*)(ws + WS_WR), *CS = (float*)(ws + WS_CS), *SSQ = (float*)(ws + WS_SSQ), *ASSQ = (float*)(ws + WS_ASSQ), *PSSQ = (float*)(ws + WS_PSSQ), *FSSQ = (float*)(ws + WS_FSSQ);
    int *ROWTOK = (int*)(ws + WS_ROWTOK), *ROWSLOT = (int*)(ws + WS_ROWSLOT); float* ROWGATE = (float*)(ws + WS_ROWGATE);

    { PHASE_LANE; for (int u = tid; u < (LDS_BYTES - MISC_OFF) / 4; u += NTHREADS) ((LAS unsigned*)(lds + MISC_OFF))[u] = 0u; }
    __syncthreads();
    const int lo = args.ph_lo, hi = args.ph_hi;
    XcdBarrier bar; bar.bar = (unsigned*)ctl + CW_BAR + args.li * XCD_BAR_WORDS; bar.x = 0; bar.st = MISC + 8;
    if (hi - lo > 1) bar = xcd_barrier_post((unsigned*)ctl + CW_BAR + args.li * XCD_BAR_WORDS, MISC + 8, wave);
#define IN(k) (lo <= (k) && (k) < hi)
#define NREP(k) ((PROBE_PH == (k)) ? PROBE_REP : 1)
#define REPLOOP(k) for (int rep = 0; rep < NREP(k); ++rep)
#define LASTREP(k) (rep == NREP(k) - 1)
#ifdef PROBE_TIME_PH
#define STAMP(k) do { if (bx == 0 && wave == 0) MISC[32 + (k)] = (unsigned)__builtin_amdgcn_s_memrealtime(); } while (0)
#else
#define STAMP(k) do { } while (0)
#endif
#define SEAM(k) do { if (IN(k) && IN((k) + 1)) xcd_barrier(bar, wave); STAMP((k) + 1); } while (0)
    STAMP(0);

    if (IN(PH_PREP)) REPLOOP(PH_PREP) {
        PHASE_LANE;
        LAS float* scr = (LAS float*)(lds + wave * 16384);
        constexpr int I_IN = (DM / 64) * 64, I_UQ = (QL / 64) * (768 / 32), I_UKV = (KVL / 64) * (1024 / 32), I_O = (DM / 64) * (DM / 32), I_G = I_O, I_P = (PLE / 64) * (DM / 32);
        constexpr int I_1 = (DM / 64) * (2048 / 32), I_2 = (DE / 64) * (DM / 32);
        constexpr int NITEMS = I_IN + I_UQ + I_UKV + I_O + I_G + I_P;
        for (int it = gw; it < NITEMS; it += NGW) {
            int r = it;
            if (r < I_IN) { if ((r & 63) != 30 && (r & 63) != 31) transpose_item<4>(w_in, INW, 64, WIN, DM, mix_norm, nullptr, 1.f, scr, r, lane); continue; } r -= I_IN;
            if (r < I_UQ) { transpose_item<2>(w_uq, 768, 768 / 32, WUQ, QL, q_norm, nullptr, QSCALE, scr, r, lane); continue; } r -= I_UQ;
            if (r < I_UKV) { transpose_item<0>(w_ukv, 1024, 1024 / 32, WUKV, 256, kv_norm, nullptr, 1.f, scr, r, lane); continue; } r -= I_UKV;
            if (r < I_O) { transpose_item<0>(w_o, DM, DM / 32, WO, DM, attn_out_norm, conv_out_norm, 1.f, scr, r, lane); continue; } r -= I_O;
            if (r < I_G) { transpose_item<0>(w_ple_gate, DM, DM / 32, WG, DM, ple_norm, nullptr, 1.f, scr, r, lane); continue; } r -= I_G;
            transpose_item<0>(w_ple_proj, DM, DM / 32, WP, PLE, nullptr, nullptr, 1.f, scr, r, lane);
        }
        for (int i = bx * NTHREADS + tid; i < 1024 * 16; i += G * NTHREADS) *(u32x4*)(WUKV + (size_t)(i >> 4) * 256 + 128 + (i & 15) * 8) = (u32x4){0u, 0u, 0u, 0u};
        for (int i = bx * NTHREADS + tid; i < DM * NE; i += G * NTHREADS) { const int e = i >> 10, k = i & 1023; const float w = w_router[k * NE + e] * moe_norm[k]; const bf16_t whi = f2bf(w);
            WRHL[i] = whi; WRHL[DM * NE + i] = f2bf(w - bf2f(whi)); }
        for (int i = bx * NTHREADS + tid; i < NTOK * 32; i += G * NTHREADS) { const int t = i >> 5, j = i & 31; const float inv = powf(10000.f, -(float)j / 32.f); const float a = (float)pos[t] * inv; float sn, c; sincosf(a, &sn, &c);
            CS[(size_t)t * 64 + j] = c; CS[(size_t)t * 64 + 32 + j] = sn; }
        for (int i = bx * NTHREADS + tid; i < NTOK * PLE / 4; i += 4 * G * NTHREADS) { f32x4 v[4];
#pragma unroll
            for (int q = 0; q < 4; ++q) { const int ii = i + q * G * NTHREADS; v[q] = ii < NTOK * PLE / 4 ? ((const f32x4*)p)[ii] : (f32x4){0.f, 0.f, 0.f, 0.f}; }
#pragma unroll
            for (int q = 0; q < 4; ++q) { const int ii = i + q * G * NTHREADS; if (ii < NTOK * PLE / 4) ((u32x2*)P16)[ii] = (u32x2){pk2(v[q][0], v[q][1]), pk2(v[q][2], v[q][3])}; } }
        for (int row = gw * 4; row < NTOK; row += NGW * 4) {
            f32x4 v[4][4]; float ss[4];
#pragma unroll
            for (int q = 0; q < 4; ++q) { const f32x4* s = (const f32x4*)(x + (size_t)(row + q) * DM);
#pragma unroll
                for (int j = 0; j < 4; ++j) v[q][j] = s[lane + 64 * j]; }
#pragma unroll
            for (int q = 0; q < 4; ++q) { ss[q] = 0.f;
#pragma unroll
                for (int j = 0; j < 4; ++j) ss[q] += pg8::sq4(v[q][j]); }
#pragma unroll
            for (int q = 0; q < 4; ++q) { const float rstd = rsqrtf(wave_sum(ss[q]) * (1.f / DM) + EPS); u32x2* d = (u32x2*)(XN + (size_t)(row + q) * DM); if (lane == 0) RSX[row + q] = rstd;
#pragma unroll
                for (int j = 0; j < 4; ++j) d[lane + 64 * j] = (u32x2){pk2(v[q][j][0], v[q][j][1]), pk2(v[q][j][2], v[q][j][3])}; }
        }
    }
    SEAM(PH_PREP);
    if (IN(PH_INPROJ)) REPLOOP(PH_INPROJ) {
        { pg8::Gemm g{XN, WIN, DM, DM, DM, nullptr, 0}; pg8::StaticOrder S; S.init(NTOK / 256, 8, G, bx, nullptr);
          pg8::EpiBf16Stats<0> E{Z, INWP, SSQ, RSX}; pg8::gemm_phase<pg8::EpiBf16Stats<0>, false>(lds, g, S, E, wave); }
        { pg8::Gemm g{P16, WP, PLE, PLE, PLE, nullptr, 0}; pg8::StaticOrder S; S.init(NTOK / 256, DM / 256, G, bx, nullptr);
          pg8::EpiBf16Stats<1> E{PLER, DM, PSSQ, nullptr}; pg8::gemm_phase<pg8::EpiBf16Stats<1>, false>(lds, g, S, E, wave); }
    }
    SEAM(PH_INPROJ);
    if (IN(PH_TOKLOCAL)) REPLOOP(PH_TOKLOCAL) {
        PHASE_LANE;
        if (!(args.skip & 1)) for (int r0 = gw * 16; r0 < NTOK; r0 += NGW * 16) {
            const int c8 = lane * 8; f32x4 w0[2], w1[2], w2[2];
#pragma unroll
            for (int q = 0; q < 2; ++q) { w0[q] = *(const f32x4*)(conv_w + c8 + 4 * q); w1[q] = *(const f32x4*)(conv_w + 512 + c8 + 4 * q); w2[q] = *(const f32x4*)(conv_w + 1024 + c8 + 4 * q); }
            f32x4 u1[2] = {}, u2[2] = {};
            if ((r0 % SEQ) != 0) {
#pragma unroll
                for (int p = 1; p <= 2; ++p) { const u32x4 uu = *(const u32x4*)(Z + (size_t)(r0 - p) * INWP + 960 + c8);
                    const f32x4 a = {blo(uu.x), bhi(uu.x), blo(uu.y), bhi(uu.y)}, b = {blo(uu.z), bhi(uu.z), blo(uu.w), bhi(uu.w)};
                    if (p == 1) { u1[0] = a; u1[1] = b; } else { u2[0] = a; u2[1] = b; } } }
#pragma unroll 4
            for (int rr = 0; rr < 16; ++rr) { const int row = r0 + rr; const bf16_t* z = Z + (size_t)row * INWP; const int s = row % SEQ, b = row / SEQ;
                const u32x4 bg = *(const u32x4*)(z + 448 + c8), uu = *(const u32x4*)(z + 960 + c8);
                if (lane < 32) { const float x1 = bf2f(z[384 + lane]), x2 = bf2f(z[416 + lane]); const float c = CS[(size_t)row * 64 + lane], sn = CS[(size_t)row * 64 + 32 + lane];
                    const unsigned o = pk2(x1 * c - x2 * sn, x1 * sn + x2 * c);
#pragma unroll
                    for (int h = 0; h < NH; ++h) *(unsigned*)(Kb + ((size_t)(b * NH + h) * SEQ + s) * DQK + DN + 2 * lane) = o; }
                f32x4 u0[2]; u0[0] = (f32x4){blo(uu.x), bhi(uu.x), blo(uu.y), bhi(uu.y)}; u0[1] = (f32x4){blo(uu.z), bhi(uu.z), blo(uu.w), bhi(uu.w)};
                f32x4 y[2]; y[0] = (f32x4){blo(bg.x), bhi(bg.x), blo(bg.y), bhi(bg.y)} * (w0[0] * u2[0] + w1[0] * u1[0] + w2[0] * u0[0]); y[1] = (f32x4){blo(bg.z), bhi(bg.z), blo(bg.w), bhi(bg.w)} * (w0[1] * u2[1] + w1[1] * u1[1] + w2[1] * u0[1]);
                const float rstd = rsqrtf(wave_sum(pg8::sq4(y[0]) + pg8::sq4(y[1])) * (1.f / 512.f) + EPS);
                *(u32x4*)(MIX + (size_t)row * DM + 512 + c8) = pg8::pack8(y[0] * rstd, y[1] * rstd);
                u2[0] = u1[0]; u2[1] = u1[1]; u1[0] = u0[0]; u1[1] = u0[1]; }
        }
        { pg8::Gemm g{Z, WUQ, QL, INWP, QL, nullptr, 0}; pg8::StaticOrder S; S.init(NTOK / 256, 768 / 256, G, bx, nullptr);
          pg8::EpiQ E{Qb, SSQ, CS}; pg8::gemm_phase<pg8::EpiQ, false>(lds, g, S, E, wave); }
        { pg8::Gemm g{Z + 256, WUKV, 256, INWP, 256, nullptr, 0}; pg8::StaticOrder S; S.init(NTOK / 256, 1024 / 256, G, bx, nullptr);
          pg8::EpiKV E{Kb, Vb, SSQ}; pg8::gemm_phase<pg8::EpiKV, false>(lds, g, S, E, wave); }
    }
    SEAM(PH_TOKLOCAL);
    if (IN(PH_ATTN)) REPLOOP(PH_ATTN) {
        const int vcu = (G % 8 == 0) ? (bx % 8) * (G / 8) + bx / 8 : bx;
        using att::L_END; using att::cv_cmap1; using att::cv_cmap2; using att::CV_N1; using att::CV_TOTAL;
        const att::ConvJob cj{w1, w2, moe_norm, (unsigned char*)W1T, (unsigned char*)W2T, gw, NGW}; int tseq = LASTREP(PH_ATTN) ? 0 : (1 << 20);
        for (int it = vcu; it < NB * NH * 8; it += G) { const int bh = it >> 3, pr = it & 7;
            for (int pass = 0; pass < 2; ++pass) att::attn_block(bh, pass ? pr : 15 - pr, Qb, Kb, Vb, MIX, ASSQ, lds, wave, cj, tseq); }
        if (LASTREP(PH_ATTN)) { const int lane = lane_id(), hi = lane >> 5, wid = wave; __syncthreads();
            for (int cv_idx = tseq * NGW + gw; cv_idx < att::CV_TOTAL; cv_idx += NGW) { CV_DECODE(cv_idx) float cvw[16]; CV_LOAD(); CV_STORE(); } }
    }
    SEAM(PH_ATTN);
    if (IN(PH_WO)) REPLOOP(PH_WO) {
        pg8::Gemm g{MIX, WO, DM, DM, DM, nullptr, 0}; pg8::StaticOrder S; S.init(NTOK / 256, DM / 256, G, bx, nullptr);
        pg8::EpiWo E{XN, HBF, X8, ASSQ, SSQ1, moe_norm}; pg8::gemm_phase<pg8::EpiWo, false>(lds, g, S, E, wave, LASTREP(PH_WO));
    }
    SEAM(PH_WO);
    if (IN(PH_ROUTER)) REPLOOP(PH_ROUTER) {
        PHASE_LANE;
        typedef float f32x16 __attribute__((ext_vector_type(16)));
        const bool fusedR = (G == 256);
        LAS int* hist = (LAS int*)(lds + HIST_OFF); LAS f32x16* xch = (LAS f32x16*)(lds + HIST_OFF + 256);
        for (int i = tid; i < 2 * NE * 128; i += NTHREADS) { const int pe = i >> 7, kc = i & 127, e = pe & 31; *(LAS u32x4*)(lds + pe * 2048 + ((kc ^ (e & 15)) << 4)) = ((const u32x4*)WRHL)[i]; }
        if (tid < NE) hist[tid] = 0;
        __syncthreads();
        for (int chunk = bx; chunk < NTOK / 128; chunk += G) {
            const int base = chunk * 128, wq = wave & 3, kh = wave >> 2;
            const int j = lane & 31, half = lane >> 5, tok = base + wq * 32 + j;
            const bf16_t* xr = HBF + (size_t)tok * DM + kh * 512 + 8 * half; const LAS unsigned char* wrow = lds + j * 2048;
            f32x16 acc = {};
#pragma unroll 8
            for (int s = 0; s < 32; ++s) { const bf16x8 xb = *(const bf16x8*)(xr + 16 * s); const int kc = ((kh * 64 + 2 * s + half) ^ (j & 15)) << 4;
                const bf16x8 ah = *(const LAS bf16x8*)(wrow + kc), al = *(const LAS bf16x8*)(wrow + 65536 + kc);
                acc = __builtin_amdgcn_mfma_f32_32x32x16_bf16(ah, xb, acc, 0, 0, 0); acc = __builtin_amdgcn_mfma_f32_32x32x16_bf16(al, xb, acc, 0, 0, 0); }
            if (kh == 1) xch[wq * 64 + lane] = acc;
            __syncthreads();
            if (kh == 0) {
                const f32x16 other = xch[wq * 64 + lane];
                const f32x4 s0 = *(const f32x4*)(SSQ1 + (size_t)tok * 16 + 8 * half), s1 = *(const f32x4*)(SSQ1 + (size_t)tok * 16 + 8 * half + 4);
                float ss = ((s0[0] + s0[1]) + (s0[2] + s0[3])) + ((s1[0] + s1[1]) + (s1[2] + s1[3])); ss += __shfl_xor(ss, 32); const float rstd = rsqrtf(ss * (1.f / DM) + EPS);
                float v[16];
#pragma unroll
                for (int r = 0; r < 16; ++r) v[r] = (acc[r] + other[r]) * rstd + b_router[(r & 3) + 8 * (r >> 2) + 4 * half];
                float lv[4]; int li[4];
#pragma unroll
                for (int t = 0; t < 4; ++t) { float best = -__builtin_inff(); int bi = 0;
#pragma unroll
                    for (int r = 0; r < 16; ++r) if (v[r] > best) { best = v[r]; bi = (r & 3) + 8 * (r >> 2) + 4 * half; }
                    const auto rv = __builtin_amdgcn_permlane32_swap(__float_as_uint(best), __float_as_uint(best), false, false); const auto ri = __builtin_amdgcn_permlane32_swap((unsigned)bi, (unsigned)bi, false, false);
                    const float b0 = __uint_as_float(rv[0]), b1 = __uint_as_float(rv[1]); const int i0 = (int)ri[0], i1 = (int)ri[1];
                    const bool t0 = (b0 > b1) || (b0 == b1 && i0 < i1); const float gb = t0 ? b0 : b1; const int gi = t0 ? i0 : i1; lv[t] = gb; li[t] = gi;
#pragma unroll
                    for (int r = 0; r < 16; ++r) if ((r & 3) + 8 * (r >> 2) + 4 * half == gi) v[r] = -__builtin_inff(); }
                if (half == 0) { const float e1 = __expf(lv[1] - lv[0]), e2 = __expf(lv[2] - lv[0]), e3 = __expf(lv[3] - lv[0]); const float inv = 1.f / (1.f + e1 + e2 + e3);
                    if (fusedR) { const int tl = wq * 32 + j; *(LAS u32x4*)(lds + LT_OFF + tl * 16) = (u32x4){(unsigned)li[0], (unsigned)li[1], (unsigned)li[2], (unsigned)li[3]}; *(LAS f32x4*)(lds + LT_OFF + 2048 + tl * 16) = (f32x4){inv, e1 * inv, e2 * inv, e3 * inv}; *(LAS float*)(lds + LT_OFF + 4096 + tl * 4) = rstd; }
                    else { *(int4*)(TOPI + (size_t)tok * 4) = make_int4(li[0], li[1], li[2], li[3]); *(f32x4*)(TOPG + (size_t)tok * 4) = (f32x4){inv, e1 * inv, e2 * inv, e3 * inv}; RS1[tok] = rstd; }
#pragma unroll
                    for (int t = 0; t < 4; ++t) (void)__hip_atomic_fetch_add(hist + li[t], 1, __ATOMIC_RELAXED, __HIP_MEMORY_SCOPE_WORKGROUP); }
            }
            __syncthreads();
        }
        if (!fusedR) { if (tid < NE && LASTREP(PH_ROUTER)) atomicAdd(ctl + CW_CNT + tid, hist[tid]); __syncthreads(); }
        else {
            LAS int* S = (LAS int*)lds; LAS int* T = (LAS int*)(lds + 32768);
            LAS int* shf = (LAS int*)(lds + LT_OFF + 4608); LAS int* sh2 = shf + 64;
            int* BH = (int*)(ws + WS_FSSQ + 1 * MiB); int* BB = BH + 256 * NE;
            if (tid < NE) __hip_atomic_store(BH + bx * NE + tid, hist[tid], __ATOMIC_RELAXED, __HIP_MEMORY_SCOPE_AGENT);
            asm volatile("s_waitcnt vmcnt(0)" ::: "memory");
            __syncthreads();
            if (tid == 0) shf[0] = (__hip_atomic_fetch_add(ctl + CW_TICKET, 1, __ATOMIC_RELAXED, __HIP_MEMORY_SCOPE_AGENT) == G - 1) ? 1 : 0;
            __syncthreads();
            if (shf[0]) {
                if (wave == 0) __builtin_amdgcn_fence(__ATOMIC_ACQUIRE, "agent");
                __syncthreads();
                { u32x4 hv4[4];
#pragma unroll
                  for (int q = 0; q < 4; ++q) hv4[q] = *(const u32x4*)(BH + (tid + q * NTHREADS) * 4);
#pragma unroll
                  for (int q = 0; q < 4; ++q) *(LAS u32x4*)(S + (tid + q * NTHREADS) * 4) = hv4[q]; }
                __syncthreads();
                if (lane < NE) { int run = 0; for (int b = wave * 32; b < wave * 32 + 32; ++b) { const int v = S[b * NE + lane]; S[b * NE + lane] = run; run += v; } T[wave * NE + lane] = run; }
                __syncthreads();
                if (tid < NE) { int run = 0; for (int w = 0; w < 8; ++w) { const int v = T[w * NE + tid]; T[w * NE + tid] = run; run += v; } T[256 + tid] = run; }
                __syncthreads();
#pragma unroll
                for (int q = 0; q < 4; ++q) { const int i = (tid + q * NTHREADS) * 4; u32x4 v = *(const LAS u32x4*)(S + i); const u32x4 tb = *(const LAS u32x4*)(T + (i >> 10) * NE + (i & 31));
                    v += tb; asm volatile("global_store_dwordx4 %0, %1, off sc0 sc1" :: "v"(BB + i), "v"(v) : "memory"); }
                if (wave == 0) { const int c = lane < NE ? T[256 + (lane & 31)] : 0, t = (c + 255) >> 8; int incl = t;
#pragma unroll
                    for (int d = 1; d < 64; d <<= 1) { const int o = __shfl_up(incl, d); if (lane >= d) incl += o; }
                    const int excl = incl - t;
                    if (lane < NE) { __hip_atomic_store(ctl + CW_PADSTART + lane, excl * 256, __ATOMIC_RELAXED, __HIP_MEMORY_SCOPE_AGENT); __hip_atomic_store(ctl + CW_CNT + lane, c, __ATOMIC_RELAXED, __HIP_MEMORY_SCOPE_AGENT);
                        for (int q = 0; q < t; ++q) __hip_atomic_store(ctl + CW_TILE_E + excl + q, lane, __ATOMIC_RELAXED, __HIP_MEMORY_SCOPE_AGENT); }
                    if (lane == NE) { __hip_atomic_store(ctl + CW_PADSTART + NE, excl * 256, __ATOMIC_RELAXED, __HIP_MEMORY_SCOPE_AGENT); __hip_atomic_store(ctl + CW_NTILES, excl, __ATOMIC_RELAXED, __HIP_MEMORY_SCOPE_AGENT); } }
                asm volatile("s_waitcnt vmcnt(0)" ::: "memory");
                __syncthreads();
                if (tid == 0) __hip_atomic_store(ctl + CW_READY, 1, __ATOMIC_RELAXED, __HIP_MEMORY_SCOPE_AGENT);
            }
            if (wave == 0) { unsigned sp = 0;
                while (__builtin_amdgcn_readfirstlane(__hip_atomic_load(ctl + CW_READY, __ATOMIC_RELAXED, __HIP_MEMORY_SCOPE_AGENT)) == 0) { __builtin_amdgcn_s_sleep(24); if (++sp > (1u << 19)) break; }
                __builtin_amdgcn_fence(__ATOMIC_ACQUIRE, "agent"); }
            __syncthreads();
            if (tid < NE) { sh2[tid] = BB[bx * NE + tid] + ctl[CW_PADSTART + tid]; sh2[64 + tid] = 0; }
            __syncthreads();
            { const int e = *(const LAS int*)(lds + LT_OFF + tid * 4); const int r = __hip_atomic_fetch_add(sh2 + 64 + e, 1, __ATOMIC_RELAXED, __HIP_MEMORY_SCOPE_WORKGROUP);
              const int dest = sh2[e] + r, idx = bx * NTHREADS + tid;
              ROWTOK[dest] = idx >> 2; ROWSLOT[dest] = idx; ROWGATE[dest] = *(const LAS float*)(lds + LT_OFF + 2048 + tid * 4); ROWRS[dest] = *(const LAS float*)(lds + LT_OFF + 4096 + (tid >> 2) * 4); }
            if (bx < NE) { const int plo = ctl[CW_PADSTART + bx] + ctl[CW_CNT + bx], phi = ctl[CW_PADSTART + bx + 1];
                for (int r = plo + tid; r < phi; r += NTHREADS) { ROWTOK[r] = 0; ROWSLOT[r] = MROWS; ROWGATE[r] = 0.f; ROWRS[r] = 0.f; } }
            __syncthreads();
        }
    }
    if (G != 256) SEAM(PH_ROUTER);
    if (IN(PH_ROUTE) && G != 256) {
        PHASE_LANE;
        LAS int* sh = (LAS int*)lds;
        if (tid == 0) { int ps = 0, nt = 0;
            for (int e = 0; e < NE; ++e) { sh[e] = ps; const int t = (ctl[CW_CNT + e] + 255) >> 8; if (bx == 0) for (int q = 0; q < t; ++q) ctl[CW_TILE_E + nt + q] = e; nt += t; ps += t * 256; }
            sh[NE] = ps; if (bx == 0) ctl[CW_NTILES] = nt; }
        __syncthreads();
        for (int chunk = bx; chunk < MROWS / NTHREADS; chunk += G) {
            if (tid < NE) sh[64 + tid] = 0;
            __syncthreads();
            const int idx = chunk * NTHREADS + tid, e = TOPI[idx]; const int r = __hip_atomic_fetch_add(sh + 64 + e, 1, __ATOMIC_RELAXED, __HIP_MEMORY_SCOPE_WORKGROUP);
            __syncthreads();
            if (tid < NE) sh[128 + tid] = atomicAdd(ctl + CW_CURSOR + tid, sh[64 + tid]);
            __syncthreads();
            const int dest = sh[e] + sh[128 + e] + r; ROWTOK[dest] = idx >> 2; ROWSLOT[dest] = idx; ROWGATE[dest] = TOPG[idx]; ROWRS[dest] = RS1[idx >> 2];
            __syncthreads();
        }
        for (int e = bx; e < NE; e += G) { const int plo = sh[e] + ctl[CW_CNT + e], phi = sh[e + 1];
            for (int r = plo + tid; r < phi; r += NTHREADS) { ROWTOK[r] = 0; ROWSLOT[r] = MROWS; ROWGATE[r] = 0.f; ROWRS[r] = 0.f; } }
        __syncthreads();
    }
    SEAM(PH_ROUTE);
    if (IN(PH_MOE1)) REPLOOP(PH_MOE1) {
        pg8::Gemm g{X8, W1T, DM, DM, DM, ROWTOK, (size_t)2048 * DM}; pg8::StaticOrder S; S.init(ctl[CW_NTILES], 2048 / 256, G, bx, ctl + CW_TILE_E);
        pg8::EpiMoe1 E{(unsigned char*)HB, b1, ROWRS}; pg8::gemm_phase<pg8::EpiMoe1, true, true>(lds, g, S, E, wave, LASTREP(PH_MOE1));
    }
    SEAM(PH_MOE1);
    if (IN(PH_MOE2)) REPLOOP(PH_MOE2) {
        pg8::Gemm g{HB, W2T, DE, DE, DE, nullptr, (size_t)DM * DE}; pg8::StaticOrder S; S.init(ctl[CW_NTILES], DM / 256, G, bx, ctl + CW_TILE_E);
        pg8::EpiMoe2 E{(unsigned char*)Y, b2, ROWSLOT, ROWGATE}; pg8::gemm_phase<pg8::EpiMoe2, false, true>(lds, g, S, E, wave, LASTREP(PH_MOE2));
    }
    SEAM(PH_MOE2);
    if (IN(PH_COMBINE)) REPLOOP(PH_COMBINE) {
        PHASE_LANE;
        for (int row = gw * 2; row < NTOK; row += NGW * 2) {
            u32x4 hv[2][2]; u32x2 yv[2][4][2]; const unsigned char* Y8 = (const unsigned char*)Y;
#pragma unroll
            for (int q = 0; q < 2; ++q)
#pragma unroll
                for (int j = 0; j < 2; ++j) { hv[q][j] = *(const u32x4*)(HBF + (size_t)(row + q) * DM + (lane + 64 * j) * 8);
#pragma unroll
                    for (int k = 0; k < 4; ++k) yv[q][k][j] = *(const u32x2*)(Y8 + ((size_t)(row + q) * 4 + k) * DM + (lane + 64 * j) * 8); }
#pragma unroll
            for (int q = 0; q < 2; ++q) { float ss = 0.f; u32x4 ov[2];
#pragma unroll
                for (int j = 0; j < 2; ++j) { f32x4 a = {blo(hv[q][j].x), bhi(hv[q][j].x), blo(hv[q][j].y), bhi(hv[q][j].y)}, b = {blo(hv[q][j].z), bhi(hv[q][j].z), blo(hv[q][j].w), bhi(hv[q][j].w)};
#pragma unroll
                    for (int k = 0; k < 4; ++k) { const u32x2 y = yv[q][k][j]; const f32x2 y0 = __builtin_amdgcn_cvt_pk_f32_fp8(y.x, false), y1 = __builtin_amdgcn_cvt_pk_f32_fp8(y.x, true), y2 = __builtin_amdgcn_cvt_pk_f32_fp8(y.y, false), y3 = __builtin_amdgcn_cvt_pk_f32_fp8(y.y, true);
                        a += (f32x4){y0[0], y0[1], y1[0], y1[1]}; b += (f32x4){y2[0], y2[1], y3[0], y3[1]}; }
                    ss += pg8::sq4(a) + pg8::sq4(b); ov[j] = pg8::pack8(a, b); }
                ss = wave_sum(ss);
                bf16_t* ho = LASTREP(PH_COMBINE) ? HBF : (bf16_t*)(ws + WS_HB);
#pragma unroll
                for (int j = 0; j < 2; ++j) *(u32x4*)(ho + (size_t)(row + q) * DM + (lane + 64 * j) * 8) = ov[j];
                float ps = lane < 16 ? PSSQ[(size_t)(row + q) * 16 + lane] : 0.f; ps += __shfl_xor(ps, 1); ps += __shfl_xor(ps, 2); ps += __shfl_xor(ps, 4); ps += __shfl_xor(ps, 8);
                if (lane == 0) { RS2[row + q] = rsqrtf(ss * (1.f / DM) + EPS); RS2[NTOK + row + q] = rsqrtf(ps * (1.f / DM) + EPS); } }
        }
    }
    SEAM(PH_COMBINE);
    if (IN(PH_PLE)) REPLOOP(PH_PLE) {
        pg8::Gemm g{HBF, WG, DM, DM, DM, nullptr, 0}; pg8::StaticOrder S; S.init(NTOK / 256, DM / 256, G, bx, nullptr);
        if (G == 256 && LASTREP(PH_PLE)) { pg8::EpiPleFinal E{HBF, H, PLER, RS2 + NTOK, RS2, ple_post_norm, final_norm, FSSQ, (unsigned*)ctl + CW_PANEL, (unsigned*)ctl + CW_PANEL - 64, lds}; pg8::gemm_phase<pg8::EpiPleFinal, false>(lds, g, S, E, wave); }
        else { pg8::EpiPle E{HBF, H3, PLER, RS2 + NTOK, RS2, ple_post_norm, FSSQ}; pg8::gemm_phase<pg8::EpiPle, false>(lds, g, S, E, wave); }
    }
    if (G != 256) SEAM(PH_PLE);
    if (IN(PH_FINAL) && G != 256) REPLOOP(PH_FINAL) {
        PHASE_LANE;
        for (int row = gw * 4; row < NTOK; row += NGW * 4) {
            u32x4 hv[4][2]; float sp[4];
#pragma unroll
            for (int q = 0; q < 4; ++q) { sp[q] = lane < 16 ? FSSQ[(size_t)(row + q) * 16 + lane] : 0.f;
#pragma unroll
                for (int j = 0; j < 2; ++j) hv[q][j] = *(const u32x4*)(H3 + (size_t)(row + q) * DM + (lane + 64 * j) * 8); }
#pragma unroll
            for (int q = 0; q < 4; ++q) { float s = sp[q]; s += __shfl_xor(s, 1); s += __shfl_xor(s, 2); s += __shfl_xor(s, 4); s += __shfl_xor(s, 8);
                const float rstd = rsqrtf(__shfl(s, 0) * (1.f / DM) + EPS); float* ho = (LASTREP(PH_FINAL) ? H : (float*)(ws + WS_HB)) + (size_t)(row + q) * DM;
#pragma unroll
                for (int j = 0; j < 2; ++j) { const int c = (lane + 64 * j) * 8; const f32x4 g0 = *(const f32x4*)(final_norm + c), g1 = *(const f32x4*)(final_norm + c + 4); const u32x4 v = hv[q][j];
                    *(f32x4*)(ho + c) = (f32x4){blo(v.x), bhi(v.x), blo(v.y), bhi(v.y)} * rstd * g0; *(f32x4*)(ho + c + 4) = (f32x4){blo(v.z), bhi(v.z), blo(v.w), bhi(v.w)} * rstd * g1; } }
        }
    }
#ifdef PROBE_TIME_PH
    STAMP(PH_COUNT);
    if (bx == 0 && wave == 0) {
#ifndef PROBE_TIME_END
#define PROBE_TIME_END (PROBE_TIME_PH + 1)
#endif
        const unsigned dt = MISC[32 + PROBE_TIME_END] - MISC[32 + PROBE_TIME_PH]; const unsigned long long t0 = __builtin_amdgcn_s_memrealtime(); while (__builtin_amdgcn_s_memrealtime() - t0 < (unsigned long long)dt) __builtin_amdgcn_s_sleep(8); }
#endif
#ifdef PROBE_BARS
    if (hi - lo > 1) for (int i = 0; i < PROBE_BARS; ++i) xcd_barrier(bar, wave);
#endif
#undef IN
#undef NREP
#undef REPLOOP
#undef LASTREP
#undef SEAM
}
static int g_grid = 0;
extern "C" void kernel_launch(void* const* d_in, const int* in_sizes, int n_in, void* d_out, int out_size, void* d_ws, size_t ws_size, hipStream_t stream) {
    if (n_in != 25 || in_sizes[0] != NTOK * DM || out_size != NTOK * DM || ws_size < WS_END) {
        fprintf(stderr, "kernel_launch: unexpected shapes (n_in %d, in0 %d, out %d, ws %zu need %zu)\n", n_in, n_in > 0 ? in_sizes[0] : -1, out_size, ws_size, (size_t)WS_END); return; }
    if (g_grid == 0) {
        int dev = 0, cus = 0, per_cu = 0; (void)hipGetDevice(&dev); (void)hipDeviceGetAttribute(&cus, hipDeviceAttributeMultiprocessorCount, dev);
        if (hipFuncSetAttribute((const void*)fwd, hipFuncAttributeMaxDynamicSharedMemorySize, LDS_BYTES) != hipSuccess) fprintf(stderr, "hipFuncSetAttribute failed\n");
        if (hipOccupancyMaxActiveBlocksPerMultiprocessor(&per_cu, (const void*)fwd, NTHREADS, LDS_BYTES) != hipSuccess || per_cu < 1) { fprintf(stderr, "occupancy query: %d\n", per_cu); per_cu = 1; }
        (void)hipGetLastError();
        g_grid = cus > 0 ? cus : 256;
    }
    (void)hipMemsetAsync((unsigned char*)d_ws + WS_CTL, 0, 64 * 1024, stream);
    Args a{}; for (int i = 0; i < 25; ++i) a.in[i] = d_in[i]; a.out = (float*)d_out; a.ws = (unsigned char*)d_ws;
    a.ph_lo = 0; a.ph_hi = PH_COUNT; a.li = 0; a.skip = 0;
    void* p[] = {&a};
    const hipError_t e = hipLaunchCooperativeKernel((const void*)fwd, dim3(g_grid), dim3(NTHREADS), p, LDS_BYTES, stream);
    if (e != hipSuccess) fprintf(stderr, "cooperative launch failed: %s (grid %d)\n", hipGetErrorString(e), g_grid);
}
```

```cpp
#include <hip/hip_runtime.h>
#include <cstdint>
#include <cstdio>
#include <cmath>

typedef unsigned short bf16_t;

constexpr int NB = 8, SEQ = 4096, DM = 1024, NTOK = NB * SEQ;
constexpr int PLE = 256, NH = 4, DN = 128, DR = 64, DV = 128, QL = 256, KVL = 128, DQK = DN + DR;
constexpr int INW = 1984, INWP = 1536;
constexpr int NE = 32, TOPK = 4, DE = 1024;
constexpr int MROWS = NTOK * TOPK;
constexpr int MAXTILES = MROWS / 256 + NE;
constexpr int PROWS = MAXTILES * 256;
constexpr float EPS = 1e-6f;
constexpr float QSCALE = 0.07216878364870322f * 1.4426950408889634f;

constexpr size_t MiB = 1u << 20;
constexpr size_t WS_CTL = 0;
constexpr size_t WS_WIN = 1 * MiB, WS_WUQ = 5 * MiB, WS_WUKV = 5 * MiB + 512 * 1024, WS_WO = 6 * MiB, WS_WG = 8 * MiB, WS_WP = 10 * MiB;
constexpr size_t WS_WR = 10 * MiB + 512 * 1024;
constexpr size_t WS_CS = 11 * MiB;
constexpr size_t WS_SSQ = 19 * MiB, WS_ASSQ = 20 * MiB, WS_PSSQ = 21 * MiB, WS_FSSQ = 23 * MiB;
constexpr size_t WS_TOPI = 25 * MiB, WS_TOPG = 25 * MiB + 512 * 1024;
constexpr size_t WS_ROWTOK = 26 * MiB, WS_ROWSLOT = 27 * MiB, WS_ROWGATE = 28 * MiB;
constexpr size_t WS_P16 = 29 * MiB;
constexpr size_t WS_SSQ1 = 45 * MiB, WS_RS1 = 47 * MiB, WS_RS2 = 47 * MiB + 128 * 1024, WS_ROWRS = 47 * MiB + 384 * 1024;
constexpr size_t WS_RSX = 10 * MiB + 512 * 1024;
constexpr size_t WS_WRHL = 10 * MiB + 768 * 1024;
constexpr size_t WS_HBF = 112 * MiB;
constexpr size_t WS_H3 = 304 * MiB;
constexpr size_t WS_W1 = 48 * MiB, WS_W2 = 176 * MiB, WS_XN = 240 * MiB, WS_MIX = 304 * MiB, WS_PLER = 368 * MiB;
constexpr size_t WS_Z = 432 * MiB, WS_Q = 560 * MiB, WS_K = 608 * MiB, WS_V = 656 * MiB;
constexpr size_t WS_HB = 432 * MiB;
constexpr size_t WS_Y = 704 * MiB;
constexpr size_t WS_END = WS_Y + (size_t)(MROWS + 256) * DM * 2;
constexpr int CW_CNT = 0, CW_CURSOR = 64, CW_PADSTART = 128, CW_NTILES = 192, CW_TICKET = 200, CW_READY = 224, CW_TILE_E = 256;

__device__ __forceinline__ float bf2f(bf16_t v) { return __uint_as_float((unsigned)v << 16); }
__device__ __forceinline__ float blo(unsigned u) { return __uint_as_float(u << 16); }
__device__ __forceinline__ float bhi(unsigned u) { return __uint_as_float(u & 0xffff0000u); }
__device__ __forceinline__ bf16_t f2bf(float f) { unsigned u = __float_as_uint(f); return (bf16_t)((u + 0x7fffu + ((u >> 16) & 1u)) >> 16); }
__device__ __forceinline__ unsigned pk2(float lo, float hi) { return (unsigned)f2bf(lo) | ((unsigned)f2bf(hi) << 16); }
__device__ __forceinline__ float wave_sum(float v) {
#pragma unroll
    for (int o = 1; o < 64; o <<= 1) v += __shfl_xor(v, o);
    return v;
}
__device__ __forceinline__ float wave_max(float v) {
#pragma unroll
    for (int o = 1; o < 64; o <<= 1) v = fmaxf(v, __shfl_xor(v, o));
    return v;
}
__device__ __forceinline__ float dot8(uint4 x, uint4 y) {
    return blo(x.x) * blo(y.x) + bhi(x.x) * bhi(y.x) + blo(x.y) * blo(y.y) + bhi(x.y) * bhi(y.y) +
           blo(x.z) * blo(y.z) + bhi(x.z) * bhi(y.z) + blo(x.w) * blo(y.w) + bhi(x.w) * bhi(y.w);
}
__device__ __forceinline__ float dot_bf16(const bf16_t* a, const bf16_t* b, int K) {
    const uint4* a4 = (const uint4*)a; const uint4* b4 = (const uint4*)b; float acc = 0.f;
    for (int i = 0; i < K / 8; ++i) acc += dot8(a4[i], b4[i]);
    return acc;
}

#define LAS __attribute__((address_space(3)))
#define GAS __attribute__((address_space(1)))
typedef short bf16x8 __attribute__((ext_vector_type(8)));
typedef float f32x4 __attribute__((ext_vector_type(4)));
typedef float f32x2 __attribute__((ext_vector_type(2)));
typedef unsigned u32x4 __attribute__((ext_vector_type(4)));
typedef unsigned u32x2 __attribute__((ext_vector_type(2)));
#ifndef PROBE_PH
#define PROBE_PH (-1)
#define PROBE_REP 1
#endif
#ifndef MOE2_DELAY_TICKS
#define MOE2_DELAY_TICKS 700ull
#endif
constexpr int NWAVES = 8, NTHREADS = 512;
constexpr int RING_BYTES = 131072, MISC_OFF = RING_BYTES, HIST_OFF = MISC_OFF + 256, STG_OFF = RING_BYTES + 1024, LT_OFF = HIST_OFF + 256 + 16384, LDS_BYTES = 163840;
constexpr int CW_PANEL = 8192;
constexpr int CW_BAR = 4096;
__device__ __forceinline__ unsigned cvt_pk_bf16(float lo, float hi) { unsigned r; asm volatile("v_cvt_pk_bf16_f32 %0, %1, %2" : "=v"(r) : "v"(lo), "v"(hi)); return r; }
__device__ __forceinline__ int lane_id() { int l = (int)__builtin_amdgcn_mbcnt_hi(~0u, __builtin_amdgcn_mbcnt_lo(~0u, 0u)); asm volatile("" : "+v"(l)); return l; }
__device__ __forceinline__ float fast_sigmoid(float a) { return __builtin_amdgcn_rcpf(1.f + __expf(-a)); }

#define XB_TMO      128
#define XB_XCNT(j)  (256  + 64 * (j))
#define XB_XSUB(j)  (1280 + 64 * (j))
#define XB_XGEN(j)  (2304 + 64 * (j))
#define XB_TOP      3328
#define XB_TOPGEN   3392
#define XCD_BAR_WORDS 3456
#define XB_SPIN_CAP (1u << 20)
__device__ __forceinline__ unsigned xb_ld(unsigned* p)              { return __hip_atomic_load(p, __ATOMIC_RELAXED, __HIP_MEMORY_SCOPE_AGENT); }
__device__ __forceinline__ unsigned xb_add(unsigned* p, unsigned v) { return __hip_atomic_fetch_add(p, v, __ATOMIC_RELAXED, __HIP_MEMORY_SCOPE_AGENT); }
__device__ __forceinline__ unsigned xb_xcc_id() { return (unsigned)__builtin_amdgcn_s_getreg((3 << 11) | 20) & 0xFu; }
#define XB_SPIN(cond, bar) do { unsigned _sp = 0; while (cond) { __builtin_amdgcn_s_sleep(1); \
    if ((++_sp & 255u) == 0u) { if (xb_ld(&(bar)[XB_TMO])) break; if (_sp > XB_SPIN_CAP) { atomicAdd(&(bar)[XB_TMO], 1u); break; } } } } while (0)
struct XcdBarrier { unsigned* bar; unsigned x; volatile LAS unsigned* st; };
__device__ __forceinline__ XcdBarrier xcd_barrier_post(unsigned* bar, volatile LAS unsigned* st, int wave) {
    XcdBarrier b; b.bar = bar; b.x = xb_xcc_id(); b.st = st;
    if (wave == 0 && lane_id() == 0) (void)xb_add(&bar[XB_XCNT(b.x)], 1u);
    return b;
}
__device__ __forceinline__ void xcd_barrier_complete(unsigned* bar, unsigned x, unsigned& nloc, unsigned& nx) {
    const unsigned G = gridDim.x * gridDim.y * gridDim.z;
    unsigned sum, cnt, mine, sp = 0u;
    for (;;) {
        sum = 0u; cnt = 0u; mine = 0u;
#pragma unroll
        for (unsigned j = 0; j < 16; ++j) { const unsigned c = xb_ld(&bar[XB_XCNT(j)]); sum += c; cnt += (c > 0u) ? 1u : 0u; mine = (j == x) ? c : mine; }
        if (sum == G) break;
        __builtin_amdgcn_s_sleep(1);
        if ((++sp & 255u) == 0u) { if (xb_ld(&bar[XB_TMO])) break; if (sp > XB_SPIN_CAP) { atomicAdd(&bar[XB_TMO], 1u); break; } }
    }
    nloc = mine > 0u ? mine : 1u; nx = cnt > 0u ? cnt : 1u;
}
__device__ __forceinline__ void xcd_barrier(const XcdBarrier& b, int wave) {
    asm volatile("s_waitcnt vmcnt(0)" ::: "memory");
    __syncthreads();
    if (wave == 0 && lane_id() == 0) {
        unsigned* bar = b.bar;
        __builtin_amdgcn_s_waitcnt(0);
        unsigned nloc = b.st[0], nx = b.st[1];
        if (nloc == 0u) { xcd_barrier_complete(bar, b.x, nloc, nx); b.st[0] = nloc; b.st[1] = nx; }
        const unsigned old = xb_add(&bar[XB_XSUB(b.x)], 1u);
        const unsigned gen = old / nloc;
        if (old + 1u == (gen + 1u) * nloc) {
            __builtin_amdgcn_fence(__ATOMIC_RELEASE, "agent");
            asm volatile("s_waitcnt vmcnt(0)" ::: "memory");
            const unsigned og = xb_add(&bar[XB_TOP], 1u);
            const unsigned tg = og / nx;
            if (og + 1u == (tg + 1u) * nx) xb_add(&bar[XB_TOPGEN], 1u);
            else XB_SPIN(xb_ld(&bar[XB_TOPGEN]) == tg, bar);
            __builtin_amdgcn_fence(__ATOMIC_ACQUIRE, "agent");
            xb_add(&bar[XB_XGEN(b.x)], 1u);
            asm volatile("s_waitcnt vmcnt(0)" ::: "memory");
        } else {
            XB_SPIN(xb_ld(&bar[XB_XGEN(b.x)]) == gen, bar);
            __builtin_amdgcn_fence(__ATOMIC_ACQUIRE, "agent");
            asm volatile("s_waitcnt vmcnt(0)" ::: "memory");
        }
    }
    __syncthreads();
}

namespace pg8 {
constexpr int BM = 256, BK = 64, HALF = 128, HTB = HALF * BK * 2, STAGE_BYTES = 8 * HTB, NXCD = 8, WGM = 8;
__host__ __device__ __forceinline__ int lds_byte(int r, int c) { const int st = (r >> 4) * 2 + (c >> 5), rr = r & 15, cc = c & 31, ob = rr * 64 + cc * 2; return st * 1024 + (ob ^ (((ob >> 9) & 1) << 5)); }
__host__ __device__ __forceinline__ void stage_rc(int b, int& R, int& C) { const int st = b / 1024, sb = b % 1024, swz = sb ^ (((sb >> 9) & 1) << 5); R = (st >> 1) * 16 + swz / 64; C = (st & 1) * 32 + (swz % 64) / 2; }
__host__ __device__ __forceinline__ int perm32(int rho) { const int n = rho >> 4, i = rho & 15; return 8 * (i >> 2) + 4 * n + (i & 3); }
struct Unit { int pm, pn, e; };
struct Gemm { const void* A; const void* Bt; int K, lda, ldb; const int* rowidx; size_t bstride; };
struct StaticOrder {
    int nM, nN, nwg, G, c; const int* tile_e;
    __device__ void init(int nM_, int nN_, int G_, int c_, const int* te) { nM = nM_; nN = nN_; nwg = nM * nN; G = G_; c = c_; tile_e = te; }
    __device__ bool next(int i, Unit& u) const {
        const long L = (long)i * G + c; if (L >= nwg) return false;
        int wgid = (int)L; { const int q = nwg / NXCD, r = nwg % NXCD, xcd = wgid % NXCD, off = wgid / NXCD; wgid = (xcd < r ? xcd * (q + 1) : r * (q + 1) + (xcd - r) * q) + off; }
        const int nig = WGM * nN, gid = wgid / nig, fm = gid * WGM, gsz = (nM - fm) < WGM ? (nM - fm) : WGM;
        u.pm = fm + ((wgid % nig) % gsz); u.pn = (wgid % nig) / gsz; u.e = tile_e ? tile_e[u.pm] : 0; return true;
    }
};
typedef f32x4 Acc[2][2][4][2];
typedef int v8i_t __attribute__((ext_vector_type(8)));
typedef int v4i_t __attribute__((ext_vector_type(4)));
template <class Epi, bool GATHER, bool FP8 = false>
__device__ __forceinline__ void gemm_phase(LAS unsigned char* lds, const Gemm g, const StaticOrder& S, const Epi& E, const int wid, const bool do_epi = true) {
    const int lane = lane_id(), tid = wid * 64 + lane, wr = wid >> 2, wc = wid & 3, fr = lane & 15, fq = lane >> 4;
    constexpr int ES = FP8 ? 1 : 2;
    const int K = g.K, nt = K * ES / 128;
    int RA[2], CA[2]; unsigned voffB[2], voffA[2];
#pragma unroll
    for (int i = 0; i < 2; ++i) { int R, C; stage_rc(tid * 16 + i * 8192, R, C); const int Rb = Epi::PERM ? ((R & ~31) + perm32(R & 31)) : R;
        RA[i] = R; CA[i] = C; voffB[i] = (unsigned)(Rb * g.ldb * ES + C * 2); voffA[i] = (unsigned)(R * g.lda * ES + C * 2); }
    const size_t hstepA = GATHER ? 0 : (size_t)HALF * g.lda * ES;
    const size_t kstep = (size_t)(BK * 2);
    const size_t hstepB = (size_t)HALF * g.ldb * ES;
    const unsigned ldsw = (unsigned)wid * 1024u;
    const int aoff = lds_byte(wr * 64 + fr, fq * 8), boff = lds_byte(wc * 32 + fr, fq * 8);
#define PG8_SA(b, h) (((b) * 2 + (h)) * HTB)
#define PG8_SB(b, h) ((4 + (b) * 2 + (h)) * HTB)
#define PG8_STAGE(bufoff, gbase, voff) do { _Pragma("unroll") for (int _i = 0; _i < 2; ++_i) \
        __builtin_amdgcn_global_load_lds((const unsigned*)((const char*)(gbase) + (voff)[_i]), (LAS unsigned*)(lds + (bufoff) + ldsw + _i * 8192), 16, 0, 0); } while (0)
#define PG8_LDA(dst, b, h) do { _Pragma("unroll") for (int m = 0; m < 4; ++m) _Pragma("unroll") for (int k = 0; k < 2; ++k) dst[m][k] = *(const LAS bf16x8*)(lds + PG8_SA(b, h) + aoff + m * 2048 + k * 1024); } while (0)
#define PG8_LDB(dst, b, h) do { _Pragma("unroll") for (int n = 0; n < 2; ++n) _Pragma("unroll") for (int k = 0; k < 2; ++k) dst[n][k] = *(const LAS bf16x8*)(lds + PG8_SB(b, h) + boff + n * 2048 + k * 1024); } while (0)
#define PG8_CAT8(x) __builtin_shufflevector(__builtin_bit_cast(v4i_t, (x)[0]), __builtin_bit_cast(v4i_t, (x)[1]), 0, 1, 2, 3, 4, 5, 6, 7)
#define PG8_MMA(ai, bj, At, Bt) do { __builtin_amdgcn_s_setprio(1); if constexpr (FP8) { _Pragma("unroll") for (int m = 0; m < 4; ++m) _Pragma("unroll") for (int n = 0; n < 2; ++n) \
        acc[ai][bj][m][n] = __builtin_amdgcn_mfma_scale_f32_16x16x128_f8f6f4(PG8_CAT8(Bt[n]), PG8_CAT8(At[m]), acc[ai][bj][m][n], 0, 0, 0, 0x7f7f7f7f, 0, 0x7f7f7f7f); \
        _Pragma("unroll") for (int m = 0; m < 4; ++m) _Pragma("unroll") for (int n = 0; n < 2; ++n) asm volatile("" : "+v"(acc[ai][bj][m][n]));   } else { \
        _Pragma("unroll") for (int m = 0; m < 4; ++m) _Pragma("unroll") for (int n = 0; n < 2; ++n) _Pragma("unroll") for (int k = 0; k < 2; ++k) \
        acc[ai][bj][m][n] = __builtin_amdgcn_mfma_f32_16x16x32_bf16(Bt[n][k], At[m][k], acc[ai][bj][m][n], 0, 0, 0); } __builtin_amdgcn_s_setprio(0); } while (0)
#define PG8_WAIT_V(n) asm volatile("s_waitcnt vmcnt(" #n ")" ::: "memory")
#define PG8_WAIT_L(n) asm volatile("s_waitcnt lgkmcnt(" #n ")" ::: "memory")
#define PG8_BAR __builtin_amdgcn_s_barrier()
#define PG8_SCHED __builtin_amdgcn_sched_barrier(0)
#define PG8_SETVO(vo, u) do { if constexpr (GATHER) { _Pragma("unroll") for (int _h = 0; _h < 2; ++_h) _Pragma("unroll") for (int _i = 0; _i < 2; ++_i) { \
        const int _row = g.rowidx[(u).pm * BM + _h * HALF + RA[_i]]; (vo)[_h][_i] = (unsigned)_row * (unsigned)(g.lda * ES) + (unsigned)CA[_i] * 2u; } } } while (0)
#define PG8_STAGE_A(bufoff, base, h, vog) do { if constexpr (GATHER) { PG8_STAGE(bufoff, base, (vog)[h]); } else { PG8_STAGE(bufoff, (base) + (h) * hstepA, voffA); } } while (0)
    Unit cur, nxt; int ui = 0;
    if (!S.next(0, cur)) return;
    Acc acc;
#pragma unroll
    for (int a = 0; a < 2; ++a)
#pragma unroll
        for (int b = 0; b < 2; ++b)
#pragma unroll
            for (int m = 0; m < 4; ++m)
#pragma unroll
                for (int n = 0; n < 2; ++n) acc[a][b][m][n] = (f32x4){0.f, 0.f, 0.f, 0.f};
    bf16x8 At[4][2], B0[2][2], B1[2][2];
    unsigned voC[2][2], voN[2][2];
    PG8_SETVO(voC, cur);
    const char* const Ab = (const char*)g.A;
    const char* cA = GATHER ? Ab : Ab + (size_t)cur.pm * 2 * hstepA;
    const char* cB = (const char*)g.Bt + (size_t)cur.e * g.bstride + (size_t)cur.pn * 2 * hstepB;
    PG8_STAGE(PG8_SB(0, 0), cB, voffB); PG8_STAGE(PG8_SB(0, 1), cB + hstepB, voffB); PG8_STAGE_A(PG8_SA(0, 0), cA, 0, voC); PG8_STAGE_A(PG8_SA(0, 1), cA, 1, voC);
    if (wr == 1) PG8_BAR;
    PG8_WAIT_V(2); PG8_BAR;
    PG8_STAGE(PG8_SB(1, 0), cB + kstep, voffB); PG8_STAGE_A(PG8_SA(1, 0), cA + kstep, 0, voC); PG8_STAGE(PG8_SB(1, 1), cB + hstepB + kstep, voffB);
    PG8_WAIT_V(6); PG8_BAR;
    for (;;) {
        const bool has_next = S.next(ui + 1, nxt);
        const char* nB = has_next ? (const char*)g.Bt + (size_t)nxt.e * g.bstride + (size_t)nxt.pn * 2 * hstepB : cB;
        const char* nA = (has_next && !GATHER) ? Ab + (size_t)nxt.pm * 2 * hstepA : cA;
        if constexpr (GATHER) { if (has_next) { PG8_SETVO(voN, nxt); } else {
#pragma unroll
            for (int h = 0; h < 2; ++h)
#pragma unroll
                for (int i = 0; i < 2; ++i) voN[h][i] = voC[h][i]; } }
        for (int t = 0; t < nt; t += 2) {
            const bool last = (t == nt - 2);
            if constexpr (Epi::MIDK > 0) { if (t == Epi::MIDK) { const int l2 = lane_id(); E.mid(acc, cur, wr, wc, l2 & 15, l2 >> 4); } }
            const char* a1 = cA + (size_t)(t + 1) * kstep;
            const char* a2 = last ? nA : cA + (size_t)(t + 2) * kstep; const char* b2 = last ? nB : cB + (size_t)(t + 2) * kstep;
            const char* a3 = a2 + kstep; const char* b3 = b2 + kstep;
            unsigned o2[2][2];
            if constexpr (GATHER) {
#pragma unroll
            for (int h = 0; h < 2; ++h)
#pragma unroll
                for (int i = 0; i < 2; ++i) o2[h][i] = last ? voN[h][i] : voC[h][i]; }
            PG8_LDB(B0, 0, 0); PG8_LDB(B1, 0, 1); PG8_SCHED; PG8_LDA(At, 0, 0); PG8_STAGE_A(PG8_SA(1, 1), a1, 1, voC);
            PG8_WAIT_V(8); PG8_WAIT_L(0); PG8_BAR; PG8_MMA(0, 0, At, B0); PG8_MMA(0, 1, At, B1); PG8_BAR; PG8_SCHED;
            PG8_LDA(At, 0, 1); PG8_STAGE(PG8_SB(0, 0), b2, voffB); PG8_STAGE(PG8_SB(0, 1), b2 + hstepB, voffB); PG8_STAGE_A(PG8_SA(0, 0), a2, 0, o2);
            PG8_WAIT_V(8); PG8_WAIT_L(0); PG8_BAR; PG8_MMA(1, 0, At, B0); PG8_MMA(1, 1, At, B1); PG8_BAR; PG8_SCHED;
            PG8_LDB(B0, 1, 0); PG8_LDB(B1, 1, 1); PG8_SCHED; PG8_LDA(At, 1, 0); PG8_STAGE_A(PG8_SA(0, 1), a2, 1, o2);
            PG8_WAIT_V(8); PG8_WAIT_L(0); PG8_BAR; PG8_MMA(0, 0, At, B0); PG8_MMA(0, 1, At, B1); PG8_BAR; PG8_SCHED;
            PG8_LDA(At, 1, 1); PG8_STAGE(PG8_SB(1, 0), b3, voffB); PG8_STAGE(PG8_SB(1, 1), b3 + hstepB, voffB); PG8_STAGE_A(PG8_SA(1, 0), a3, 0, o2);
            PG8_WAIT_V(8); PG8_WAIT_L(0); PG8_BAR; PG8_MMA(1, 0, At, B0); PG8_MMA(1, 1, At, B1); PG8_BAR; PG8_SCHED;
        }
        if (wr == 0) PG8_BAR;
        if (do_epi) { const int l2 = lane_id(); E(acc, cur, wr, wc, l2 & 15, l2 >> 4); }
        if (!has_next) break;
#pragma unroll
        for (int a = 0; a < 2; ++a)
#pragma unroll
            for (int b = 0; b < 2; ++b)
#pragma unroll
                for (int m = 0; m < 4; ++m)
#pragma unroll
                    for (int n = 0; n < 2; ++n) acc[a][b][m][n] = (f32x4){0.f, 0.f, 0.f, 0.f};
        cur = nxt; cB = nB; cA = nA; ++ui;
        if constexpr (GATHER) {
#pragma unroll
        for (int h = 0; h < 2; ++h)
#pragma unroll
            for (int i = 0; i < 2; ++i) voC[h][i] = voN[h][i]; }
        if (wr == 1) PG8_BAR;
    }
    PG8_WAIT_V(0);
    PG8_BAR;
#undef PG8_SA
#undef PG8_SB
#undef PG8_STAGE
#undef PG8_LDA
#undef PG8_LDB
#undef PG8_MMA
#undef PG8_CAT8
#undef PG8_WAIT_V
#undef PG8_WAIT_L
#undef PG8_BAR
#undef PG8_SCHED
#undef PG8_SETVO
#undef PG8_STAGE_A
}

__device__ __forceinline__ unsigned pk4_fp8(f32x4 v) { unsigned w = 0; w = __builtin_amdgcn_cvt_pk_fp8_f32(v[0], v[1], w, false); w = __builtin_amdgcn_cvt_pk_fp8_f32(v[2], v[3], w, true); return w; }
__device__ __forceinline__ float sq4(f32x4 v) { return (v[0] * v[0] + v[1] * v[1]) + (v[2] * v[2] + v[3] * v[3]); }
__device__ __forceinline__ float red_fq(float s) { s += __shfl_xor(s, 16); s += __shfl_xor(s, 32); return s; }
__device__ __forceinline__ u32x4 pack8(f32x4 a, f32x4 b) { u32x4 w; w.x = cvt_pk_bf16(a[0], a[1]); w.y = cvt_pk_bf16(a[2], a[3]); w.z = cvt_pk_bf16(b[0], b[1]); w.w = cvt_pk_bf16(b[2], b[3]); return w; }
template <int MODE> struct EpiBf16Stats {
    static constexpr bool PERM = true; static constexpr int MIDK = 0;
    bf16_t* O; int ldc; float* ssq; const float* rsx;
    __device__ __forceinline__ void operator()(const Acc& acc, const Unit& u, int wr, int wc, int fr, int fq) const {
        const int row0 = u.pm * BM + wr * 64 + fr, col0 = u.pn * BM + wc * 32 + 8 * fq;
        float rv[2][4];
#pragma unroll
        for (int ai = 0; ai < 2; ++ai)
#pragma unroll
            for (int m = 0; m < 4; ++m) rv[ai][m] = rsx ? rsx[row0 + ai * HALF + m * 16] : 1.f;
        asm volatile("" ::: "memory");
#pragma unroll
        for (int ai = 0; ai < 2; ++ai)
#pragma unroll
            for (int m = 0; m < 4; ++m) { const int row = row0 + ai * HALF + m * 16; bf16_t* rowp = O + (size_t)row * ldc + col0; const float rs = rv[ai][m];
                const f32x4 a00 = acc[ai][0][m][0] * rs, a01 = acc[ai][0][m][1] * rs, a10 = acc[ai][1][m][0] * rs, a11 = acc[ai][1][m][1] * rs;
                if (MODE == 0 && u.pn >= 4) { *(u32x4*)(O + (size_t)row * ldc + 960 + (u.pn - 4) * HALF + wc * 32 + 8 * fq) = pack8(a00 * a10, a01 * a11); continue; }
                *(u32x4*)(rowp) = pack8(a00, a01); if (!(MODE == 0 && u.pn == 3 && wc >= 2)) *(u32x4*)(rowp + HALF) = pack8(a10, a11);
                if (MODE == 1) { float s = (sq4(a00) + sq4(a01)) + (sq4(a10) + sq4(a11)); s = red_fq(s); if (fq == 0) ssq[(size_t)row * 16 + u.pn * 4 + wc] = s; }
                else if (u.pn == 0) { float s = (sq4(a00) + sq4(a01)) + (sq4(a10) + sq4(a11)); s = red_fq(s); if (fq == 0) ssq[(size_t)row * 8 + wc] = s; }
                else if (u.pn == 1) { float s = sq4(a00) + sq4(a01); s = red_fq(s); if (fq == 0) ssq[(size_t)row * 8 + 4 + wc] = s; } }
    }
};
struct EpiQ {
    static constexpr bool PERM = true; static constexpr int MIDK = 0;
    bf16_t* Q; const float* ssq; const float* cs;
    __device__ __forceinline__ void operator()(const Acc& acc, const Unit& u, int wr, int wc, int fr, int fq) const {
        const int row0 = u.pm * BM + wr * 64 + fr;
#pragma unroll
        for (int ai = 0; ai < 2; ++ai)
#pragma unroll
            for (int m = 0; m < 4; ++m) { const int row = row0 + ai * HALF + m * 16; const f32x4 sv = *(const f32x4*)(ssq + (size_t)row * 8);
                const float rs = rsqrtf(((sv[0] + sv[1]) + (sv[2] + sv[3])) * (1.f / QL) + EPS); const int b = row / SEQ, s = row % SEQ;
#pragma unroll
                for (int bj = 0; bj < 2; ++bj) { const int cv = u.pn * BM + bj * HALF + wc * 32 + 8 * fq; const int h = cv / DQK, d = cv % DQK;
                    f32x4 v0 = acc[ai][bj][m][0] * rs, v1 = acc[ai][bj][m][1] * rs;
                    if (d >= DN) { const int i0 = (d - DN) >> 1; const f32x4 c = *(const f32x4*)(cs + (size_t)row * 64 + i0), sn = *(const f32x4*)(cs + (size_t)row * 64 + 32 + i0);
                        const f32x4 r0 = {v0[0] * c[0] - v0[1] * sn[0], v0[0] * sn[0] + v0[1] * c[0], v0[2] * c[1] - v0[3] * sn[1], v0[2] * sn[1] + v0[3] * c[1]};
                        const f32x4 r1 = {v1[0] * c[2] - v1[1] * sn[2], v1[0] * sn[2] + v1[1] * c[2], v1[2] * c[3] - v1[3] * sn[3], v1[2] * sn[3] + v1[3] * c[3]};
                        v0 = r0; v1 = r1; }
                    *(u32x4*)(Q + ((size_t)(b * NH + h) * SEQ + s) * DQK + d) = pack8(v0, v1); } }
    }
};
struct EpiKV {
    static constexpr bool PERM = true; static constexpr int MIDK = 0;
    bf16_t* Kc; bf16_t* Vc; const float* ssq;
    __device__ __forceinline__ void operator()(const Acc& acc, const Unit& u, int wr, int wc, int fr, int fq) const {
        const int row0 = u.pm * BM + wr * 64 + fr, d = wc * 32 + 8 * fq, h = u.pn;
#pragma unroll
        for (int ai = 0; ai < 2; ++ai)
#pragma unroll
            for (int m = 0; m < 4; ++m) { const int row = row0 + ai * HALF + m * 16; const f32x4 sv = *(const f32x4*)(ssq + (size_t)row * 8 + 4);
                const float rs = rsqrtf(((sv[0] + sv[1]) + (sv[2] + sv[3])) * (1.f / KVL) + EPS); const int b = row / SEQ, s = row % SEQ; const size_t t = (size_t)(b * NH + h) * SEQ + s;
                *(u32x4*)(Kc + t * DQK + d) = pack8(acc[ai][0][m][0] * rs, acc[ai][0][m][1] * rs);
                *(u32x4*)(Vc + t * DV + d) = pack8(acc[ai][1][m][0] * rs, acc[ai][1][m][1] * rs); }
    }
};
struct EpiWo {
    static constexpr bool PERM = true; static constexpr int MIDK = 8;
    const bf16_t* x; bf16_t* HBF; unsigned char* X8; const float* assq; float* ssq1; const float* gmoe;
    __device__ __forceinline__ void mid(Acc& acc, const Unit& u, int wr, int wc, int fr, int fq) const {
        const int row0 = u.pm * BM + wr * 64 + fr;
#pragma unroll
        for (int ai = 0; ai < 2; ++ai)
#pragma unroll
            for (int m = 0; m < 4; ++m) { const f32x4 sv = *(const f32x4*)(assq + (size_t)(row0 + ai * HALF + m * 16) * 4);
                const float rs = rsqrtf(((sv[0] + sv[1]) + (sv[2] + sv[3])) * (1.f / 512.f) + EPS);
#pragma unroll
                for (int bj = 0; bj < 2; ++bj)
#pragma unroll
                    for (int n = 0; n < 2; ++n) acc[ai][bj][m][n] = acc[ai][bj][m][n] * rs; }
    }
    __device__ __forceinline__ void operator()(const Acc& acc, const Unit& u, int wr, int wc, int fr, int fq) const {
        const int row0 = u.pm * BM + wr * 64 + fr, col0 = u.pn * BM + wc * 32 + 8 * fq;
        f32x4 gn[2][2];
#pragma unroll
        for (int bj = 0; bj < 2; ++bj) { gn[bj][0] = *(const f32x4*)(gmoe + col0 + bj * HALF); gn[bj][1] = *(const f32x4*)(gmoe + col0 + bj * HALF + 4); }
#pragma unroll
        for (int ai = 0; ai < 2; ++ai) { u32x4 xv[4][2];
#pragma unroll
            for (int m = 0; m < 4; ++m) { const size_t off = (size_t)(row0 + ai * HALF + m * 16) * DM + col0;
#pragma unroll
                for (int bj = 0; bj < 2; ++bj) xv[m][bj] = *(const u32x4*)(x + off + bj * HALF); }
            asm volatile("" ::: "memory");
#pragma unroll
            for (int m = 0; m < 4; ++m) { const int row = row0 + ai * HALF + m * 16; const size_t off = (size_t)row * DM + col0; float ss = 0.f;
#pragma unroll
                for (int bj = 0; bj < 2; ++bj) { const u32x4 xq = xv[m][bj]; const f32x4 h0 = (f32x4){blo(xq.x), bhi(xq.x), blo(xq.y), bhi(xq.y)} + acc[ai][bj][m][0], h1 = (f32x4){blo(xq.z), bhi(xq.z), blo(xq.w), bhi(xq.w)} + acc[ai][bj][m][1];
                    *(u32x4*)(HBF + off + bj * HALF) = pack8(h0, h1); *(u32x2*)(X8 + off + bj * HALF) = (u32x2){pk4_fp8(h0 * gn[bj][0]), pk4_fp8(h1 * gn[bj][1])}; ss += sq4(h0) + sq4(h1); }
                ss = red_fq(ss); if (fq == 0) ssq1[(size_t)row * 16 + u.pn * 4 + wc] = ss; }
            asm volatile("" ::: "memory"); }
    }
};
__device__ __forceinline__ f32x4 sigmoid4(f32x4 a) { const f32x4 t = a * -1.44269504f; f32x4 e; e[0] = __builtin_amdgcn_exp2f(t[0]); e[1] = __builtin_amdgcn_exp2f(t[1]); e[2] = __builtin_amdgcn_exp2f(t[2]); e[3] = __builtin_amdgcn_exp2f(t[3]);
    const f32x4 d = e + 1.0f; f32x4 r; r[0] = __builtin_amdgcn_rcpf(d[0]); r[1] = __builtin_amdgcn_rcpf(d[1]); r[2] = __builtin_amdgcn_rcpf(d[2]); r[3] = __builtin_amdgcn_rcpf(d[3]); return r; }
__device__ __forceinline__ f32x2 swiglu2(f32x2 g, f32x2 u) {
    g.x = fminf(g.x, 7.f); g.y = fminf(g.y, 7.f); u.x = __builtin_amdgcn_fmed3f(u.x, -7.f, 7.f); u.y = __builtin_amdgcn_fmed3f(u.y, -7.f, 7.f);
    const f32x2 t = g * -2.45546696f; f32x2 e; e.x = __builtin_amdgcn_exp2f(t.x); e.y = __builtin_amdgcn_exp2f(t.y); const f32x2 d = e + 1.0f; f32x2 r; r.x = __builtin_amdgcn_rcpf(d.x); r.y = __builtin_amdgcn_rcpf(d.y);
    const f32x2 gs = g * r; return u * gs + gs; }
__device__ __forceinline__ float swiglu_f(float g, float u) { g = fminf(g, 7.f); u = __builtin_amdgcn_fmed3f(u, -7.f, 7.f); const float gs = g * __builtin_amdgcn_rcpf(1.f + __builtin_amdgcn_exp2f(g * -2.45546696f)); return fmaf(u, gs, gs); }
constexpr float WSCALE = 64.f, WINV = 1.f / 64.f;
struct EpiMoe1 {
    static constexpr bool PERM = true; static constexpr int MIDK = 0;
    unsigned char* HB; const float* b1; const float* rowrs;
    __device__ __forceinline__ void operator()(const Acc& acc, const Unit& u, int wr, int wc, int fr, int fq) const {
        const int row0 = u.pm * BM + wr * 64 + fr, j0 = u.pn * HALF + wc * 32 + 8 * fq; const float* bg = b1 + (size_t)u.e * 2048 + j0;
        const f32x4 g0 = *(const f32x4*)bg, g1 = *(const f32x4*)(bg + 4), u0 = *(const f32x4*)(bg + 1024), u1 = *(const f32x4*)(bg + 1028);
        float rsv[2][4];
#pragma unroll
        for (int ai = 0; ai < 2; ++ai)
#pragma unroll
            for (int m = 0; m < 4; ++m) rsv[ai][m] = rowrs[row0 + ai * HALF + m * 16];
        asm volatile("" ::: "memory");
#pragma unroll
        for (int ai = 0; ai < 2; ++ai)
#pragma unroll
            for (int m = 0; m < 4; ++m) { const float rs = rsv[ai][m] * WINV;
                const f32x4 a0 = acc[ai][0][m][0] * rs + g0, a1 = acc[ai][0][m][1] * rs + g1, c0 = acc[ai][1][m][0] * rs + u0, c1 = acc[ai][1][m][1] * rs + u1; f32x4 r0, r1;
#pragma unroll
                for (int j = 0; j < 4; j += 2) { const f32x2 s0 = swiglu2((f32x2){a0[j], a0[j + 1]}, (f32x2){c0[j], c0[j + 1]}), s1 = swiglu2((f32x2){a1[j], a1[j + 1]}, (f32x2){c1[j], c1[j + 1]}); r0[j] = s0.x; r0[j + 1] = s0.y; r1[j] = s1.x; r1[j + 1] = s1.y; }
                *(u32x2*)(HB + (size_t)(row0 + ai * HALF + m * 16) * DE + j0) = (u32x2){pk4_fp8(r0), pk4_fp8(r1)}; }
    }
};
struct EpiMoe2 {
    static constexpr bool PERM = true; static constexpr int MIDK = 0;
    unsigned char* Y; const float* b2; const int* rowslot; const float* rowgate;
    __device__ __forceinline__ void operator()(const Acc& acc, const Unit& u, int wr, int wc, int fr, int fq) const {
        const int row0 = u.pm * BM + wr * 64 + fr, col0 = u.pn * BM + wc * 64 + 16 * fq; const float* bb = b2 + (size_t)u.e * DM + col0;
        f32x4 bv[2][2];
#pragma unroll
        for (int bj = 0; bj < 2; ++bj)
#pragma unroll
            for (int n = 0; n < 2; ++n) bv[bj][n] = *(const f32x4*)(bb + bj * 8 + 4 * n);
        float gtv[2][4]; int slv[2][4];
#pragma unroll
        for (int ai = 0; ai < 2; ++ai)
#pragma unroll
            for (int m = 0; m < 4; ++m) { const int r = row0 + ai * HALF + m * 16; gtv[ai][m] = rowgate[r]; slv[ai][m] = rowslot[r]; }
        asm volatile("" ::: "memory");
#pragma unroll
        for (int ai = 0; ai < 2; ++ai)
#pragma unroll
            for (int m = 0; m < 4; ++m) { const float gt = gtv[ai][m]; unsigned char* yp = Y + (size_t)slv[ai][m] * DM + col0;
                *(u32x4*)yp = (u32x4){pk4_fp8((acc[ai][0][m][0] * WINV + bv[0][0]) * gt), pk4_fp8((acc[ai][0][m][1] * WINV + bv[0][1]) * gt), pk4_fp8((acc[ai][1][m][0] * WINV + bv[1][0]) * gt), pk4_fp8((acc[ai][1][m][1] * WINV + bv[1][1]) * gt)}; }
    }
};
struct EpiPle {
    static constexpr bool PERM = true; static constexpr int MIDK = 0;
    const bf16_t* H2; bf16_t* H3; const bf16_t* pler; const float* rpv; const float* rs2; const float* pg; float* fssq;
    __device__ __forceinline__ void operator()(const Acc& acc, const Unit& u, int wr, int wc, int fr, int fq) const {
        const int row0 = u.pm * BM + wr * 64 + fr, col0 = u.pn * BM + wc * 32 + 8 * fq;
        f32x4 gv[2][2];
#pragma unroll
        for (int bj = 0; bj < 2; ++bj)
#pragma unroll
            for (int n = 0; n < 2; ++n) gv[bj][n] = *(const f32x4*)(pg + col0 + bj * HALF + n * 4);
#pragma unroll
        for (int am = 0; am < 4; ++am) { const int ai = am >> 1; u32x4 hq[2][2], pq[2][2]; float r2v[2], rpq[2];
#pragma unroll
            for (int mm = 0; mm < 2; ++mm) { const int row = row0 + ai * HALF + ((am & 1) * 2 + mm) * 16; const size_t off = (size_t)row * DM + col0; r2v[mm] = rs2[row]; rpq[mm] = rpv[row];
#pragma unroll
                for (int bj = 0; bj < 2; ++bj) { hq[mm][bj] = *(const u32x4*)(H2 + off + bj * HALF); pq[mm][bj] = *(const u32x4*)(pler + off + bj * HALF); } }
            asm volatile("" ::: "memory");
#pragma unroll
            for (int mm = 0; mm < 2; ++mm) { const int m = (am & 1) * 2 + mm; const int row = row0 + ai * HALF + m * 16; const size_t off = (size_t)row * DM + col0; const float r2 = r2v[mm], rp = rpq[mm]; float ss = 0.f;
#pragma unroll
                for (int bj = 0; bj < 2; ++bj) { const size_t o = off + bj * HALF; const u32x4 hv = hq[mm][bj], pr = pq[mm][bj];
                    const f32x4 h0 = {blo(hv.x), bhi(hv.x), blo(hv.y), bhi(hv.y)}, h1 = {blo(hv.z), bhi(hv.z), blo(hv.w), bhi(hv.w)};
                    const f32x4 q0 = {blo(pr.x), bhi(pr.x), blo(pr.y), bhi(pr.y)}, q1 = {blo(pr.z), bhi(pr.z), blo(pr.w), bhi(pr.w)};
                    const f32x4 r0 = h0 + sigmoid4(acc[ai][bj][m][0] * r2) * (q0 * (gv[bj][0] * rp)), r1 = h1 + sigmoid4(acc[ai][bj][m][1] * r2) * (q1 * (gv[bj][1] * rp));
                    *(u32x4*)(H3 + o) = pack8(r0, r1); ss += sq4(r0) + sq4(r1); }
                ss = red_fq(ss); if (fq == 0) fssq[(size_t)row * 16 + u.pn * 4 + wc] = ss; }
            asm volatile("" ::: "memory"); }
    }
};
struct EpiPleFinal {
    static constexpr bool PERM = true; static constexpr int MIDK = 0;
    const bf16_t* H2; float* out; const bf16_t* pler; const float* rpv; const float* rs2; const float* pg; const float* gf; float* xs; unsigned* cnt; unsigned* tmo; LAS unsigned char* lds;
    __device__ __forceinline__ void operator()(Acc& acc, const Unit& u, int wr, int wc, int fr, int fq) const {
        const int row0 = u.pm * BM + wr * 64 + fr, col0 = u.pn * BM + wc * 32 + 8 * fq;
        LAS float* P = (LAS float*)(lds + STG_OFF); LAS float* S = P + 1024; const int tid = (wr * 4 + wc) * 64 + fq * 16 + fr;
#define PF_BAR() asm volatile("s_waitcnt lgkmcnt(0)\n\ts_barrier" ::: "memory")
        { f32x4 gv[2][2];
#pragma unroll
          for (int bj = 0; bj < 2; ++bj)
#pragma unroll
            for (int n = 0; n < 2; ++n) gv[bj][n] = *(const f32x4*)(pg + col0 + bj * HALF + n * 4);
#pragma unroll
          for (int am = 0; am < 4; ++am) { const int ai = am >> 1; u32x4 hq[2][2], pq[2][2]; float r2v[2], rpq[2];
#pragma unroll
            for (int mm = 0; mm < 2; ++mm) { const int row = row0 + ai * HALF + ((am & 1) * 2 + mm) * 16; const size_t off = (size_t)row * DM + col0; r2v[mm] = rs2[row]; rpq[mm] = rpv[row];
#pragma unroll
                for (int bj = 0; bj < 2; ++bj) { hq[mm][bj] = *(const u32x4*)(H2 + off + bj * HALF); pq[mm][bj] = *(const u32x4*)(pler + off + bj * HALF); } }
            asm volatile("" ::: "memory");
#pragma unroll
            for (int mm = 0; mm < 2; ++mm) { const int m = (am & 1) * 2 + mm; const float r2 = r2v[mm], rp = rpq[mm]; float ss = 0.f;
#pragma unroll
                for (int bj = 0; bj < 2; ++bj) { const u32x4 hv = hq[mm][bj], pr = pq[mm][bj];
                    const f32x4 h0 = {blo(hv.x), bhi(hv.x), blo(hv.y), bhi(hv.y)}, h1 = {blo(hv.z), bhi(hv.z), blo(hv.w), bhi(hv.w)};
                    const f32x4 q0 = {blo(pr.x), bhi(pr.x), blo(pr.y), bhi(pr.y)}, q1 = {blo(pr.z), bhi(pr.z), blo(pr.w), bhi(pr.w)};
                    const f32x4 r0 = h0 + sigmoid4(acc[ai][bj][m][0] * r2) * (q0 * (gv[bj][0] * rp)), r1 = h1 + sigmoid4(acc[ai][bj][m][1] * r2) * (q1 * (gv[bj][1] * rp));
                    acc[ai][bj][m][0] = r0; acc[ai][bj][m][1] = r1; ss += sq4(r0) + sq4(r1); }
                ss = red_fq(ss); if (fq == 0) P[(ai * HALF + wr * 64 + m * 16 + fr) * 4 + wc] = ss; }
            asm volatile("" ::: "memory"); } }
        PF_BAR();
        if (tid < 256) { const f32x4 p4 = *(const LAS f32x4*)(P + tid * 4); __hip_atomic_store(xs + (size_t)(u.pm * 4 + u.pn) * 256 + tid, (p4[0] + p4[1]) + (p4[2] + p4[3]), __ATOMIC_RELAXED, __HIP_MEMORY_SCOPE_AGENT); }
        asm volatile("s_waitcnt vmcnt(0)" ::: "memory");
        PF_BAR();
        if (tid < 64) {
            if (tid == 0) (void)__hip_atomic_fetch_add(cnt + 64 * u.pm, 1u, __ATOMIC_RELAXED, __HIP_MEMORY_SCOPE_AGENT);
            unsigned sp = 0;
            while ((unsigned)__builtin_amdgcn_readfirstlane(__hip_atomic_load(cnt + 64 * u.pm, __ATOMIC_RELAXED, __HIP_MEMORY_SCOPE_AGENT)) < 4u) {
                __builtin_amdgcn_s_sleep(2); if (++sp > (1u << 22)) { if (tid == 0) __hip_atomic_store(tmo, 1u, __ATOMIC_RELAXED, __HIP_MEMORY_SCOPE_AGENT); break; } }
            __builtin_amdgcn_fence(__ATOMIC_ACQUIRE, "agent");
            asm volatile("s_waitcnt vmcnt(0)" ::: "memory"); }
        PF_BAR();
        if (tid < 256) { float t = 0.f;
#pragma unroll
            for (int q = 0; q < 4; ++q) t += __hip_atomic_load(xs + (size_t)(u.pm * 4 + q) * 256 + tid, __ATOMIC_RELAXED, __HIP_MEMORY_SCOPE_AGENT);
            S[tid] = rsqrtf(t * (1.f / DM) + EPS); }
        PF_BAR();
        { f32x4 gq[2][2];
#pragma unroll
          for (int bj = 0; bj < 2; ++bj)
#pragma unroll
            for (int n = 0; n < 2; ++n) gq[bj][n] = *(const f32x4*)(gf + col0 + bj * HALF + n * 4);
#pragma unroll
          for (int ai = 0; ai < 2; ++ai)
#pragma unroll
            for (int m = 0; m < 4; ++m) { const float rs = S[ai * HALF + wr * 64 + m * 16 + fr]; float* op = out + (size_t)(row0 + ai * HALF + m * 16) * DM + col0;
#pragma unroll
                for (int bj = 0; bj < 2; ++bj) { *(f32x4*)(op + bj * HALF) = acc[ai][bj][m][0] * rs * gq[bj][0]; *(f32x4*)(op + bj * HALF + 4) = acc[ai][bj][m][1] * rs * gq[bj][1]; } } }
        PF_BAR();
#undef PF_BAR
    }
};
}

namespace att {
typedef float f32x16 __attribute__((ext_vector_type(16)));
typedef short s16x4 __attribute__((ext_vector_type(4)));
constexpr int QBLK = 32, KVBLK = 64, QB = 256;
constexpr int SHM_K = KVBLK * DQK * 2, SHM_V = KVBLK * DV * 2;
constexpr int L_V = 0, L_K = 2 * SHM_V, L_WS = L_K + 2 * SHM_K, L_END = L_WS + NWAVES * 256;
constexpr float THR = 8.f;
#define KSWZ(row, colB) ((row) * 384 + ((colB) ^ (((row) & 7) << 4)))
#define SBAR() __builtin_amdgcn_sched_barrier(0)
__device__ __forceinline__ int v_st(int k, int c) { const int kk = (k & ~0xC) | ((k & 4) << 1) | ((k & 8) >> 1); return ((kk >> 3) * 4 + (c >> 5)) * 512 + ((kk & 7) * 32 + (c & 31)) * 2; }
__device__ __forceinline__ int v_rd_base(int lane) { return ((lane & 3) << 3) | (((lane >> 2) & 3) << 6) | (((lane >> 4) & 1) << 5) | (((lane >> 5) & 1) << 8); }
constexpr int v_rd_off(int d0, int ks, int half) { return d0 * 512 + ks * 4096 + half * 2048; }
__device__ __forceinline__ int crow(int r, int hi) { return (r & 3) + 8 * (r >> 2) + 4 * hi; }
typedef __bf16 bf16x2_t __attribute__((ext_vector_type(2)));
__device__ __forceinline__ unsigned cvtpk(float lo, float hi) { f32x2 v = {lo, hi}; bf16x2_t b = __builtin_convertvector(v, bf16x2_t); return __builtin_bit_cast(unsigned, b); }

__device__ __forceinline__ void qkt(f32x16& p0, f32x16& p1, const LAS unsigned char* Kbuf, int r32, int hi, const bf16x8* qr) {
    p0 = f32x16{}; p1 = f32x16{};
    const LAS unsigned char* kb[4];
#pragma unroll
    for (int dd = 0; dd < 4; ++dd) kb[dd] = Kbuf + KSWZ(r32, (dd * 16 + hi * 8) * 2);
    bf16x8 kf[2][2];
#define KLD(d) do { const LAS unsigned char* a = kb[(d) & 3] + ((d) >> 2) * 128; kf[(d) & 1][0] = *(const LAS bf16x8*)a; kf[(d) & 1][1] = *(const LAS bf16x8*)(a + 32 * 384); } while (0)
    KLD(0);
#pragma unroll
    for (int d0 = 0; d0 < 12; ++d0) { if (d0 + 1 < 12) KLD(d0 + 1);
        p0 = __builtin_amdgcn_mfma_f32_32x32x16_bf16(kf[d0 & 1][0], qr[d0], p0, 0, 0, 0);
        p1 = __builtin_amdgcn_mfma_f32_32x32x16_bf16(kf[d0 & 1][1], qr[d0], p1, 0, 0, 0); }
#undef KLD
    __builtin_amdgcn_sched_group_barrier(0x100, 2, 0);
#pragma unroll
    for (int d0 = 0; d0 < 11; ++d0) { __builtin_amdgcn_sched_group_barrier(0x100, 2, 0); __builtin_amdgcn_sched_group_barrier(0x008, 2, 0); }
    __builtin_amdgcn_sched_group_barrier(0x008, 2, 0);
}
__device__ __forceinline__ void pv_tile(f32x16* o, int vb0, bf16x8 pa0, bf16x8 pa1, bf16x8 pa2, bf16x8 pa3) {
#define TRRD(dst, off) asm volatile("ds_read_b64_tr_b16 %0, %1 offset:%2" : "=&v"(dst) : "v"(vb0), "i"(off) : "memory")
#define PV_RD(S_, d0) do { constexpr int b_ = v_rd_off(d0, 0, 0); \
        TRRD(S_[0], b_); TRRD(S_[1], b_ + 2048); TRRD(S_[2], b_ + 4096); TRRD(S_[3], b_ + 6144); TRRD(S_[4], b_ + 8192); TRRD(S_[5], b_ + 10240); TRRD(S_[6], b_ + 12288); TRRD(S_[7], b_ + 14336); } while (0)
#define PV_MM(S_, d0) do { \
        o[d0] = __builtin_amdgcn_mfma_f32_32x32x16_bf16(pa0, (bf16x8){S_[0][0], S_[0][1], S_[0][2], S_[0][3], S_[1][0], S_[1][1], S_[1][2], S_[1][3]}, o[d0], 0, 0, 0); \
        o[d0] = __builtin_amdgcn_mfma_f32_32x32x16_bf16(pa1, (bf16x8){S_[2][0], S_[2][1], S_[2][2], S_[2][3], S_[3][0], S_[3][1], S_[3][2], S_[3][3]}, o[d0], 0, 0, 0); \
        o[d0] = __builtin_amdgcn_mfma_f32_32x32x16_bf16(pa2, (bf16x8){S_[4][0], S_[4][1], S_[4][2], S_[4][3], S_[5][0], S_[5][1], S_[5][2], S_[5][3]}, o[d0], 0, 0, 0); \
        o[d0] = __builtin_amdgcn_mfma_f32_32x32x16_bf16(pa3, (bf16x8){S_[6][0], S_[6][1], S_[6][2], S_[6][3], S_[7][0], S_[7][1], S_[7][2], S_[7][3]}, o[d0], 0, 0, 0); } while (0)
    s16x4 A_[8], B_[8];
    PV_RD(A_, 0);
    PV_RD(B_, 1); asm volatile("s_waitcnt lgkmcnt(8)" ::: "memory"); SBAR(); PV_MM(A_, 0); SBAR();
    PV_RD(A_, 2); asm volatile("s_waitcnt lgkmcnt(8)" ::: "memory"); SBAR(); PV_MM(B_, 1); SBAR();
    PV_RD(B_, 3); asm volatile("s_waitcnt lgkmcnt(8)" ::: "memory"); SBAR(); PV_MM(A_, 2); SBAR();
    asm volatile("s_waitcnt lgkmcnt(0)" ::: "memory"); SBAR(); PV_MM(B_, 3);
#undef PV_RD
#undef PV_MM
#undef TRRD
}
struct ConvJob { const float* w1; const float* w2; const float* gain; unsigned char* W1T; unsigned char* W2T; int gw, ngw; };
constexpr int CV_N1 = NE * 32 * 64, CV_N2 = NE * 32 * 32, CV_TOTAL = CV_N1 + CV_N2;
__device__ __forceinline__ int cv_cmap2(int n) { const int t = n & ~255, v = n & 255; return t + 64 * ((v >> 5) & 3) + 16 * ((v >> 3) & 3) + 8 * (v >> 7) + (v & 7); }
__device__ __forceinline__ int cv_cmap1(int n) { const int pn = n >> 8, half = (n >> 7) & 1, jj = n & 127; return half * 1024 + pn * 128 + jj; }
#define CV_DECODE(idx) \
    const bool cv_on = (idx) < CV_TOTAL; const bool cv_is1 = (idx) < CV_N1; const int cv_r = cv_is1 ? (idx) : (idx) - CV_N1; \
    const int cv_nblk = cv_is1 ? 64 : 32, cv_ld = cv_is1 ? 2048 : 1024; const int cv_e = cv_r / (32 * cv_nblk), cv_q = cv_r % (32 * cv_nblk), cv_k0 = 32 * (cv_q / cv_nblk), cv_n0 = 32 * (cv_q % cv_nblk); \
    const float* cv_src = (cv_is1 ? cj.w1 + (size_t)cv_e * 1024 * 2048 : cj.w2 + (size_t)cv_e * 1024 * 1024); \
    const int cv_c = cv_is1 ? cv_cmap1(cv_n0 + 4 * (lane & 7)) : cv_cmap2(cv_n0 + 4 * (lane & 7));
#define CV_LOAD() do { if (cv_on) { const char* cvb = (const char*)(cv_src + (size_t)cv_k0 * cv_ld); const unsigned cvo = (unsigned)(((lane >> 3) * cv_ld + cv_c) * 4);     \
        LAS unsigned char* scrb = lds + L_END + wid * 4224;     \
        _Pragma("unroll") for (int i = 0; i < 4; ++i) __builtin_amdgcn_global_load_lds((const unsigned*)(cvb + (size_t)(8 * i) * cv_ld * 4 + cvo), (LAS unsigned*)(scrb + i * 1056), 16, 0, 0); } } while (0)
#define CV_SV(j) (s[(2 * cc + ((j) >> 3)) * 264 + ((j) & 7) * 32] * 64.f)
#define CV_STORE() do { if (cv_on) { const LAS float* scr = (const LAS float*)(lds + L_END + wid * 4224); \
        { const int n = lane >> 1, cc = lane & 1; const LAS float* s = scr + n; u32x4 o; \
          o.x = pg8::pk4_fp8((f32x4){CV_SV(0), CV_SV(1), CV_SV(2), CV_SV(3)}); o.y = pg8::pk4_fp8((f32x4){CV_SV(4), CV_SV(5), CV_SV(6), CV_SV(7)}); \
          o.z = pg8::pk4_fp8((f32x4){CV_SV(8), CV_SV(9), CV_SV(10), CV_SV(11)}); o.w = pg8::pk4_fp8((f32x4){CV_SV(12), CV_SV(13), CV_SV(14), CV_SV(15)}); \
          unsigned char* dst = (cv_is1 ? cj.W1T + (size_t)cv_e * 2048 * 1024 : cj.W2T + (size_t)cv_e * 1024 * 1024) + (size_t)(cv_n0 + n) * 1024 + cv_k0 + 16 * cc; *(u32x4*)dst = o; } \
        asm volatile("s_waitcnt lgkmcnt(0)" ::: "memory"); } } while (0)
__device__ __forceinline__ void attn_block(int bh, int qb, const bf16_t* __restrict__ Q, const bf16_t* __restrict__ K, const bf16_t* __restrict__ V, bf16_t* __restrict__ MIX, float* __restrict__ ASSQ, LAS unsigned char* lds, const int wid, const ConvJob& cj, int& tseq) {
    const int lane = lane_id(), r32 = lane & 31, hi = lane >> 5;
    const int b = bh / NH, h = bh % NH;
    const bf16_t* Qw = Q + ((size_t)bh * SEQ + qb * QB + wid * QBLK + r32) * DQK;
    const bf16_t* Kh = K + (size_t)bh * SEQ * DQK; const bf16_t* Vh = V + (size_t)bh * SEQ * DV;
    bf16x8 qr[12];
#pragma unroll
    for (int d0 = 0; d0 < 12; ++d0) qr[d0] = *(const bf16x8*)(Qw + d0 * 16 + hi * 8);
    const int NT = 4 * qb + 4, qlo = qb * QB + wid * QBLK, qm = qlo + r32 - 4 * hi;
    LAS unsigned char* V_lds = lds + L_V; LAS unsigned char* K_lds = lds + L_K;
    LAS float* wsf = (LAS float*)(lds + L_WS) + wid * 64; LAS float* li_l = wsf; LAS float* al_l = wsf + 32;
    unsigned ksrc[3], vsrc[2];
#pragma unroll
    for (int i = 0; i < 3; ++i) { const int off = ((wid + 8 * i) * 64 + lane) * 16, row = off / 384, wb = off % 384, seg = wb >> 7, cpos = (wb & 127) >> 4; ksrc[i] = (unsigned)(row * 384 + seg * 128 + ((cpos ^ (row & 7)) << 4)); }
#pragma unroll
    for (int i = 0; i < 2; ++i) { const int off = ((wid + 8 * i) * 64 + lane) * 16, st = off >> 9, o_ = off & 511, kk = (st >> 2) * 8 + (o_ >> 6), c = (st & 3) * 32 + ((o_ & 63) >> 1);
        const int k = (kk & ~0xC) | ((kk & 4) << 1) | ((kk & 8) >> 1); vsrc[i] = (unsigned)(k * 256 + c * 2); }
    const int vb0 = (int)(unsigned)(uintptr_t)V_lds + v_rd_base(lane);
#define ADMA_K(t, bf) do { const char* kp = (const char*)(Kh + (size_t)(t) * KVBLK * DQK); \
        _Pragma("unroll") for (int i = 0; i < 3; ++i) __builtin_amdgcn_global_load_lds((const unsigned*)(kp + ksrc[i]), (LAS unsigned*)(K_lds + (bf) * SHM_K + (wid + 8 * i) * 1024), 16, 0, 0); } while (0)
#define ADMA_V(t, bf) do { const char* vp = (const char*)(Vh + (size_t)(t) * KVBLK * DV); \
        _Pragma("unroll") for (int i = 0; i < 2; ++i) __builtin_amdgcn_global_load_lds((const unsigned*)(vp + vsrc[i]), (LAS unsigned*)(V_lds + (bf) * SHM_V + (wid + 8 * i) * 1024), 16, 0, 0); } while (0)
#define PK4(P, B_, OUT) do { unsigned a0 = cvtpk(P[B_ + 0], P[B_ + 1]), a1 = cvtpk(P[B_ + 2], P[B_ + 3]); \
        unsigned b0 = cvtpk(P[B_ + 4], P[B_ + 5]), b1 = cvtpk(P[B_ + 6], P[B_ + 7]); \
        auto r0 = __builtin_amdgcn_permlane32_swap(a0, b0, false, false); auto r1 = __builtin_amdgcn_permlane32_swap(a1, b1, false, false); \
        u32x4 w = {r0[0], r1[0], r0[1], r1[1]}; OUT = __builtin_bit_cast(bf16x8, w); } while (0)
    float m_reg = -1e30f, l_reg = 0.f; f32x16 o[4] = {}; int cv_pend = -1;
    const int ph = wid >> 2;
#define STAGE_SLOT(t) do { const int tk = (t) + 2, tv = (t) + 1; \
        if (tk < NT) ADMA_K(tk, tk & 1); \
        if (tv < NT) ADMA_V(tv, tv & 1); \
        if (cv_pend >= 0) { CV_DECODE(cv_pend) CV_STORE(); cv_pend = -1; } \
        if (tv < NT) { const int cv_idx = __builtin_amdgcn_readfirstlane(tseq * cj.ngw + cj.gw); ++tseq; CV_DECODE(cv_idx) CV_LOAD(); cv_pend = cv_on ? cv_idx : -1; } \
        SBAR(); } while (0)
#define PV_PART(t) do { if ((t) * KVBLK <= qlo + QBLK - 1) { SBAR(); pv_tile(o, vb0 + ((t) & 1) * SHM_V, pa0, pa1, pa2, pa3); SBAR(); } } while (0)
#define QK_PART(t) do { if ((t) < NT && (t) * KVBLK <= qlo + QBLK - 1) { SBAR(); qkt(p0, p1, K_lds + ((t) & 1) * SHM_K, r32, hi, qr); SBAR(); } } while (0)
#define VALU_SLOT(t) do { const int kb_ = (t) * KVBLK; \
        if (kb_ <= qlo + QBLK - 1) { \
            if (kb_ + KVBLK - 1 > qlo) { asm volatile("" ::: "memory"); const int dq = qm - kb_; const float NEG = -__builtin_inff(); \
                _Pragma("unroll") for (int r = 0; r < 16; ++r) { const int c = (r & 3) + 8 * (r >> 2); if (c > dq) p0[r] = NEG; if (c + 32 > dq) p1[r] = NEG; } } \
            float pmax = p0[0]; _Pragma("unroll") for (int r = 1; r < 16; ++r) pmax = fmaxf(pmax, p0[r]); _Pragma("unroll") for (int r = 0; r < 16; ++r) pmax = fmaxf(pmax, p1[r]); \
            { auto rr = __builtin_amdgcn_permlane32_swap(__float_as_uint(pmax), __float_as_uint(pmax), false, false); pmax = fmaxf(__uint_as_float(rr[0]), __uint_as_float(rr[1])); } \
            if (!__all(pmax - m_reg <= THR)) { const float mn = fmaxf(m_reg, pmax); const float alpha = __builtin_amdgcn_exp2f(m_reg - mn); m_reg = mn; l_reg *= alpha; \
                if (hi == 0) al_l[r32] = alpha; asm volatile("s_waitcnt lgkmcnt(0)" ::: "memory"); \
                _Pragma("unroll") for (int d_ = 0; d_ < 4; ++d_) _Pragma("unroll") for (int r = 0; r < 16; ++r) o[d_][r] *= al_l[crow(r, hi)]; } \
            float ps = 0.f; \
            _Pragma("unroll") for (int r = 0; r < 16; ++r) { p0[r] = __builtin_amdgcn_exp2f(p0[r] - m_reg); p1[r] = __builtin_amdgcn_exp2f(p1[r] - m_reg); } \
            _Pragma("unroll") for (int r = 0; r < 16; ++r) ps += p0[r] + p1[r]; \
            { auto rr = __builtin_amdgcn_permlane32_swap(__float_as_uint(ps), __float_as_uint(ps), false, false); ps = __uint_as_float(rr[0]) + __uint_as_float(rr[1]); } \
            l_reg += ps; \
            PK4(p0, 0, pa0); PK4(p0, 8, pa1); PK4(p1, 0, pa2); PK4(p1, 8, pa3); } } while (0)
#define SLOT_END_EVEN() asm volatile("s_waitcnt vmcnt(0)\n\ts_barrier" ::: "memory")
#define SLOT_END_ODD() asm volatile("s_barrier" ::: "memory")
    ADMA_K(0, 0);
    asm volatile("s_waitcnt vmcnt(0)" ::: "memory"); __syncthreads();
    if (ph == 0) {
        f32x16 p0, p1;
        STAGE_SLOT(-1); QK_PART(0); SLOT_END_ODD();
        for (int t = 0; t < NT; ++t) { bf16x8 pa0 = {}, pa1 = {}, pa2 = {}, pa3 = {};
            VALU_SLOT(t); SLOT_END_EVEN();
            STAGE_SLOT(t); PV_PART(t); QK_PART(t + 1); SLOT_END_ODD(); }
    } else {
        bf16x8 pa0 = {}, pa1 = {}, pa2 = {}, pa3 = {};
        STAGE_SLOT(-1); SLOT_END_ODD();
        for (int t = 0; t < NT; ++t) { f32x16 p0 = {}, p1 = {};
            if (t > 0) PV_PART(t - 1);
            QK_PART(t); SLOT_END_EVEN();
            STAGE_SLOT(t); VALU_SLOT(t); SLOT_END_ODD(); }
        PV_PART(NT - 1);
    }
#undef STAGE_SLOT
#undef PV_PART
#undef QK_PART
#undef VALU_SLOT
#undef SLOT_END_EVEN
#undef SLOT_END_ODD
#undef PK4
#undef ADMA_K
#undef ADMA_V
    if (cv_pend >= 0) { asm volatile("s_waitcnt vmcnt(0)" ::: "memory"); CV_DECODE(cv_pend) CV_STORE(); }
    if (hi == 0) li_l[r32] = l_reg;
    asm volatile("s_waitcnt vmcnt(0) lgkmcnt(0)" ::: "memory");
    float rli[16];
#pragma unroll
    for (int r = 0; r < 16; ++r) rli[r] = __builtin_amdgcn_rcpf(li_l[crow(r, hi)]);
    __syncthreads();
    LAS bf16_t* stg = (LAS bf16_t*)(lds + wid * 8192);
#pragma unroll
    for (int r = 0; r < 16; ++r) { const int orow = crow(r, hi);
#pragma unroll
        for (int d0 = 0; d0 < 4; ++d0) stg[orow * 128 + d0 * 32 + r32] = f2bf(o[d0][r] * rli[r]); }
    asm volatile("s_waitcnt lgkmcnt(0)" ::: "memory");
    const size_t row0 = (size_t)b * SEQ + qb * QB + wid * QBLK;
#pragma unroll
    for (int i = 0; i < 8; ++i) { const int row = i * 4 + (lane >> 4), ch = lane & 15; const u32x4 v = *(const LAS u32x4*)(stg + row * 128 + ch * 8);
        float ss = (blo(v.x) * blo(v.x) + bhi(v.x) * bhi(v.x)) + (blo(v.y) * blo(v.y) + bhi(v.y) * bhi(v.y)) + (blo(v.z) * blo(v.z) + bhi(v.z) * bhi(v.z)) + (blo(v.w) * blo(v.w) + bhi(v.w) * bhi(v.w));
        ss += __shfl_xor(ss, 1); ss += __shfl_xor(ss, 2); ss += __shfl_xor(ss, 4); ss += __shfl_xor(ss, 8);
        *(u32x4*)(MIX + (row0 + row) * DM + h * DV + ch * 8) = v;
        if (ch == 0) ASSQ[(row0 + row) * 4 + h] = ss; }
    __syncthreads();
}
#undef KSWZ
#undef SBAR
}

struct Args { const void* in[25]; float* out; unsigned char* ws; int ph_lo, ph_hi, li, skip; };
enum { PH_PREP = 0, PH_INPROJ, PH_TOKLOCAL, PH_ATTN, PH_WO, PH_ROUTER, PH_ROUTE, PH_MOE1, PH_MOE2, PH_COMBINE, PH_PLE, PH_FINAL, PH_COUNT };

template <int MODE> __device__ __forceinline__ int cmap_col(int n) {
    if (MODE == 1) { const int pn = n >> 8, half = (n >> 7) & 1, jj = n & 127; return half * 1024 + pn * 128 + jj; }
    if (MODE == 4) { if (n < 1024) return n < 960 ? n : INW; const int v = n - 1024, j = v >> 8, hf = (v >> 7) & 1, cc = v & 127; return (hf ? 1472 : 960) + 128 * j + cc; }
    if (MODE == 2) { const int h = n / DQK, d = n % DQK; if (d < DN) return n; const int t = d - DN; return h * DQK + DN + (t & 1) * 32 + (t >> 1); }
    return n;
}
template <int MODE> __device__ __forceinline__ void transpose_item_fp8(const float* __restrict__ W, int ldsrc, int nblk, unsigned char* __restrict__ WT, int ldd, const float* __restrict__ gain, float scale,
                                                                      LAS float* scr, int item, int lane) {
    const int kb = item / nblk, nb = item % nblk, k0 = 64 * kb, n0 = 32 * nb; const int c = cmap_col<MODE>(n0 + (lane & 31));
    float wv[32];
#pragma unroll
    for (int i = 0; i < 32; ++i) wv[i] = W[(size_t)(k0 + 2 * i + (lane >> 5)) * ldsrc + c];
#pragma unroll
    for (int i = 0; i < 32; ++i) { const int kk = 2 * i + (lane >> 5), k = k0 + kk; float gk = scale; if (gain) gk *= gain[k]; scr[kk * 33 + (lane & 31)] = wv[i] * gk; }
    asm volatile("s_waitcnt lgkmcnt(0)" ::: "memory");
    const int cc = lane & 3;
#pragma unroll
    for (int j = 0; j < 2; ++j) { const int n = (lane >> 2) + 16 * j; const LAS float* s = scr + (16 * cc) * 33 + n; u32x4 o;
        o.x = pg8::pk4_fp8((f32x4){s[0 * 33], s[1 * 33], s[2 * 33], s[3 * 33]}); o.y = pg8::pk4_fp8((f32x4){s[4 * 33], s[5 * 33], s[6 * 33], s[7 * 33]});
        o.z = pg8::pk4_fp8((f32x4){s[8 * 33], s[9 * 33], s[10 * 33], s[11 * 33]}); o.w = pg8::pk4_fp8((f32x4){s[12 * 33], s[13 * 33], s[14 * 33], s[15 * 33]});
        *(u32x4*)(WT + (size_t)(n0 + n) * ldd + k0 + 16 * cc) = o; }
    asm volatile("s_waitcnt lgkmcnt(0)" ::: "memory");
}
template <int MODE> __device__ __forceinline__ void transpose_item(const float* __restrict__ W, int ldsrc, int nblk, bf16_t* __restrict__ WT, int ldd, const float* __restrict__ gain, const float* __restrict__ gain2, float scale,
                                                                  LAS float* scr, int item, int lane) {
    const int kb = item / nblk, nb = item % nblk, k0 = 64 * kb, n0 = 32 * nb; const int c = cmap_col<MODE>(n0 + (lane & 31));
    float wv[32], gq[32];
#pragma unroll
    for (int i = 0; i < 32; ++i) wv[i] = W[(size_t)(k0 + 2 * i + (lane >> 5)) * ldsrc + c];
#pragma unroll
    for (int i = 0; i < 32; ++i) { const int k = k0 + 2 * i + (lane >> 5); gq[i] = gain ? ((gain2 && k >= 512) ? gain2[k - 512] : gain[k]) : 1.f; }
    asm volatile("" ::: "memory");
#pragma unroll
    for (int i = 0; i < 32; ++i) { const int kk = 2 * i + (lane >> 5); scr[kk * 33 + (lane & 31)] = wv[i] * (gq[i] * scale); }
    asm volatile("s_waitcnt lgkmcnt(0)" ::: "memory");
    const int cc = lane & 7;
#pragma unroll
    for (int j = 0; j < 4; ++j) { const int n = (lane >> 3) + 8 * j; const LAS float* s = scr + (8 * cc) * 33 + n;
        u32x4 o; o.x = pk2(s[0 * 33], s[1 * 33]); o.y = pk2(s[2 * 33], s[3 * 33]); o.z = pk2(s[4 * 33], s[5 * 33]); o.w = pk2(s[6 * 33], s[7 * 33]);
        *(u32x4*)(WT + (size_t)(n0 + n) * ldd + k0 + 8 * cc) = o; }
    asm volatile("s_waitcnt lgkmcnt(0)" ::: "memory");
}

__global__ void __launch_bounds__(NTHREADS, 2) fwd(Args args) {
    extern __shared__ __attribute__((aligned(16))) unsigned char lds_raw[];
    LAS unsigned char* lds = (LAS unsigned char*)lds_raw;
    volatile LAS unsigned* MISC = (volatile LAS unsigned*)(lds + MISC_OFF);
    const int wave = __builtin_amdgcn_readfirstlane(threadIdx.x >> 6);
    const int G = gridDim.x, bx = blockIdx.x;
#define PHASE_LANE const int lane = lane_id(); const int tid = wave * 64 + lane; (void)tid
    const int gw = bx * NWAVES + wave, NGW = G * NWAVES;
    unsigned char* ws = args.ws; int* ctl = (int*)(ws + WS_CTL); float* H = args.out;
    const float* x = (const float*)args.in[0]; const float* p = (const float*)args.in[1]; const int* pos = (const int*)args.in[2];
    const float *mix_norm = (const float*)args.in[3], *w_in = (const float*)args.in[4], *q_norm = (const float*)args.in[5], *w_uq = (const float*)args.in[6], *kv_norm = (const float*)args.in[7],
                *w_ukv = (const float*)args.in[8], *attn_out_norm = (const float*)args.in[10], *conv_out_norm = (const float*)args.in[11], *w_o = (const float*)args.in[12],
                *moe_norm = (const float*)args.in[13], *w_router = (const float*)args.in[14], *w1 = (const float*)args.in[16], *b1 = (const float*)args.in[17],
                *w2 = (const float*)args.in[18], *b2 = (const float*)args.in[19], *ple_norm = (const float*)args.in[20], *w_ple_gate = (const float*)args.in[21], *w_ple_proj = (const float*)args.in[22],
                *ple_post_norm = (const float*)args.in[23], *conv_w = (const float*)args.in[9], *b_router = (const float*)args.in[15], *final_norm = (const float*)args.in[24];
    int* TOPI = (int*)(ws + WS_TOPI); float* TOPG = (float*)(ws + WS_TOPG);
    bf16_t *HBF = (bf16_t*)(ws + WS_HBF), *H3 = (bf16_t*)(ws + WS_H3), *WRHL = (bf16_t*)(ws + WS_WRHL); unsigned char* X8 = (unsigned char*)(ws + WS_K);
    float* RSX = (float*)(ws + WS_RSX);
    float *SSQ1 = (float*)(ws + WS_SSQ1), *RS1 = (float*)(ws + WS_RS1), *RS2 = (float*)(ws + WS_RS2), *ROWRS = (float*)(ws + WS_ROWRS);
    bf16_t *WIN = (bf16_t*)(ws + WS_WIN), *WUQ = (bf16_t*)(ws + WS_WUQ), *WUKV = (bf16_t*)(ws + WS_WUKV), *WO = (bf16_t*)(ws + WS_WO), *WG = (bf16_t*)(ws + WS_WG), *WP = (bf16_t*)(ws + WS_WP);
    bf16_t *W1T = (bf16_t*)(ws + WS_W1), *W2T = (bf16_t*)(ws + WS_W2), *XN = (bf16_t*)(ws + WS_XN), *MIX = (bf16_t*)(ws + WS_MIX), *PLER = (bf16_t*)(ws + WS_PLER);
    bf16_t *Z = (bf16_t*)(ws + WS_Z), *Qb = (bf16_t*)(ws + WS_Q), *Kb = (bf16_t*)(ws + WS_K), *Vb = (bf16_t*)(ws + WS_V), *HB = (bf16_t*)(ws + WS_HB), *Y = (bf16_t*)(ws + WS_Y), *P16 = (bf16_t*)(ws + WS_P16);
    float *WR = (float*)(ws + WS_WR), *CS = (float*)(ws + WS_CS), *SSQ = (float*)(ws + WS_SSQ), *ASSQ = (float*)(ws + WS_ASSQ), *PSSQ = (float*)(ws + WS_PSSQ), *FSSQ = (float*)(ws + WS_FSSQ);
    int *ROWTOK = (int*)(ws + WS_ROWTOK), *ROWSLOT = (int*)(ws + WS_ROWSLOT); float* ROWGATE = (float*)(ws + WS_ROWGATE);

    { PHASE_LANE; for (int u = tid; u < (LDS_BYTES - MISC_OFF) / 4; u += NTHREADS) ((LAS unsigned*)(lds + MISC_OFF))[u] = 0u; }
    __syncthreads();
    const int lo = args.ph_lo, hi = args.ph_hi;
    XcdBarrier bar; bar.bar = (unsigned*)ctl + CW_BAR + args.li * XCD_BAR_WORDS; bar.x = 0; bar.st = MISC + 8;
    if (hi - lo > 1) bar = xcd_barrier_post((unsigned*)ctl + CW_BAR + args.li * XCD_BAR_WORDS, MISC + 8, wave);
#define IN(k) (lo <= (k) && (k) < hi)
#define NREP(k) ((PROBE_PH == (k)) ? PROBE_REP : 1)
#define REPLOOP(k) for (int rep = 0; rep < NREP(k); ++rep)
#define LASTREP(k) (rep == NREP(k) - 1)
#ifdef PROBE_TIME_PH
#define STAMP(k) do { if (bx == 0 && wave == 0) MISC[32 + (k)] = (unsigned)__builtin_amdgcn_s_memrealtime(); } while (0)
#else
#define STAMP(k) do { } while (0)
#endif
#define SEAM(k) do { if (IN(k) && IN((k) + 1)) xcd_barrier(bar, wave); STAMP((k) + 1); } while (0)
    STAMP(0);

    if (IN(PH_PREP)) REPLOOP(PH_PREP) {
        PHASE_LANE;
        LAS float* scr = (LAS float*)(lds + wave * 16384);
        constexpr int I_IN = (DM / 64) * 64, I_UQ = (QL / 64) * (768 / 32), I_UKV = (KVL / 64) * (1024 / 32), I_O = (DM / 64) * (DM / 32), I_G = I_O, I_P = (PLE / 64) * (DM / 32);
        constexpr int I_1 = (DM / 64) * (2048 / 32), I_2 = (DE / 64) * (DM / 32);
        constexpr int NITEMS = I_IN + I_UQ + I_UKV + I_O + I_G + I_P;
        for (int it = gw; it < NITEMS; it += NGW) {
            int r = it;
            if (r < I_IN) { if ((r & 63) != 30 && (r & 63) != 31) transpose_item<4>(w_in, INW, 64, WIN, DM, mix_norm, nullptr, 1.f, scr, r, lane); continue; } r -= I_IN;
            if (r < I_UQ) { transpose_item<2>(w_uq, 768, 768 / 32, WUQ, QL, q_norm, nullptr, QSCALE, scr, r, lane); continue; } r -= I_UQ;
            if (r < I_UKV) { transpose_item<0>(w_ukv, 1024, 1024 / 32, WUKV, 256, kv_norm, nullptr, 1.f, scr, r, lane); continue; } r -= I_UKV;
            if (r < I_O) { transpose_item<0>(w_o, DM, DM / 32, WO, DM, attn_out_norm, conv_out_norm, 1.f, scr, r, lane); continue; } r -= I_O;
            if (r < I_G) { transpose_item<0>(w_ple_gate, DM, DM / 32, WG, DM, ple_norm, nullptr, 1.f, scr, r, lane); continue; } r -= I_G;
            transpose_item<0>(w_ple_proj, DM, DM / 32, WP, PLE, nullptr, nullptr, 1.f, scr, r, lane);
        }
        for (int i = bx * NTHREADS + tid; i < 1024 * 16; i += G * NTHREADS) *(u32x4*)(WUKV + (size_t)(i >> 4) * 256 + 128 + (i & 15) * 8) = (u32x4){0u, 0u, 0u, 0u};
        for (int i = bx * NTHREADS + tid; i < DM * NE; i += G * NTHREADS) { const int e = i >> 10, k = i & 1023; const float w = w_router[k * NE + e] * moe_norm[k]; const bf16_t whi = f2bf(w);
            WRHL[i] = whi; WRHL[DM * NE + i] = f2bf(w - bf2f(whi)); }
        for (int i = bx * NTHREADS + tid; i < NTOK * 32; i += G * NTHREADS) { const int t = i >> 5, j = i & 31; const float inv = powf(10000.f, -(float)j / 32.f); const float a = (float)pos[t] * inv; float sn, c; sincosf(a, &sn, &c);
            CS[(size_t)t * 64 + j] = c; CS[(size_t)t * 64 + 32 + j] = sn; }
        for (int i = bx * NTHREADS + tid; i < NTOK * PLE / 4; i += 4 * G * NTHREADS) { f32x4 v[4];
#pragma unroll
            for (int q = 0; q < 4; ++q) { const int ii = i + q * G * NTHREADS; v[q] = ii < NTOK * PLE / 4 ? ((const f32x4*)p)[ii] : (f32x4){0.f, 0.f, 0.f, 0.f}; }
#pragma unroll
            for (int q = 0; q < 4; ++q) { const int ii = i + q * G * NTHREADS; if (ii < NTOK * PLE / 4) ((u32x2*)P16)[ii] = (u32x2){pk2(v[q][0], v[q][1]), pk2(v[q][2], v[q][3])}; } }
        for (int row = gw * 4; row < NTOK; row += NGW * 4) {
            f32x4 v[4][4]; float ss[4];
#pragma unroll
            for (int q = 0; q < 4; ++q) { const f32x4* s = (const f32x4*)(x + (size_t)(row + q) * DM);
#pragma unroll
                for (int j = 0; j < 4; ++j) v[q][j] = s[lane + 64 * j]; }
#pragma unroll
            for (int q = 0; q < 4; ++q) { ss[q] = 0.f;
#pragma unroll
                for (int j = 0; j < 4; ++j) ss[q] += pg8::sq4(v[q][j]); }
#pragma unroll
            for (int q = 0; q < 4; ++q) { const float rstd = rsqrtf(wave_sum(ss[q]) * (1.f / DM) + EPS); u32x2* d = (u32x2*)(XN + (size_t)(row + q) * DM); if (lane == 0) RSX[row + q] = rstd;
#pragma unroll
                for (int j = 0; j < 4; ++j) d[lane + 64 * j] = (u32x2){pk2(v[q][j][0], v[q][j][1]), pk2(v[q][j][2], v[q][j][3])}; }
        }
    }
    SEAM(PH_PREP);
    if (IN(PH_INPROJ)) REPLOOP(PH_INPROJ) {
        { pg8::Gemm g{XN, WIN, DM, DM, DM, nullptr, 0}; pg8::StaticOrder S; S.init(NTOK / 256, 8, G, bx, nullptr);
          pg8::EpiBf16Stats<0> E{Z, INWP, SSQ, RSX}; pg8::gemm_phase<pg8::EpiBf16Stats<0>, false>(lds, g, S, E, wave); }
        { pg8::Gemm g{P16, WP, PLE, PLE, PLE, nullptr, 0}; pg8::StaticOrder S; S.init(NTOK / 256, DM / 256, G, bx, nullptr);
          pg8::EpiBf16Stats<1> E{PLER, DM, PSSQ, nullptr}; pg8::gemm_phase<pg8::EpiBf16Stats<1>, false>(lds, g, S, E, wave); }
    }
    SEAM(PH_INPROJ);
    if (IN(PH_TOKLOCAL)) REPLOOP(PH_TOKLOCAL) {
        PHASE_LANE;
        if (!(args.skip & 1)) for (int r0 = gw * 16; r0 < NTOK; r0 += NGW * 16) {
            const int c8 = lane * 8; f32x4 w0[2], w1[2], w2[2];
#pragma unroll
            for (int q = 0; q < 2; ++q) { w0[q] = *(const f32x4*)(conv_w + c8 + 4 * q); w1[q] = *(const f32x4*)(conv_w + 512 + c8 + 4 * q); w2[q] = *(const f32x4*)(conv_w + 1024 + c8 + 4 * q); }
            f32x4 u1[2] = {}, u2[2] = {};
            if ((r0 % SEQ) != 0) {
#pragma unroll
                for (int p = 1; p <= 2; ++p) { const u32x4 uu = *(const u32x4*)(Z + (size_t)(r0 - p) * INWP + 960 + c8);
                    const f32x4 a = {blo(uu.x), bhi(uu.x), blo(uu.y), bhi(uu.y)}, b = {blo(uu.z), bhi(uu.z), blo(uu.w), bhi(uu.w)};
                    if (p == 1) { u1[0] = a; u1[1] = b; } else { u2[0] = a; u2[1] = b; } } }
#pragma unroll 4
            for (int rr = 0; rr < 16; ++rr) { const int row = r0 + rr; const bf16_t* z = Z + (size_t)row * INWP; const int s = row % SEQ, b = row / SEQ;
                const u32x4 bg = *(const u32x4*)(z + 448 + c8), uu = *(const u32x4*)(z + 960 + c8);
                if (lane < 32) { const float x1 = bf2f(z[384 + lane]), x2 = bf2f(z[416 + lane]); const float c = CS[(size_t)row * 64 + lane], sn = CS[(size_t)row * 64 + 32 + lane];
                    const unsigned o = pk2(x1 * c - x2 * sn, x1 * sn + x2 * c);
#pragma unroll
                    for (int h = 0; h < NH; ++h) *(unsigned*)(Kb + ((size_t)(b * NH + h) * SEQ + s) * DQK + DN + 2 * lane) = o; }
                f32x4 u0[2]; u0[0] = (f32x4){blo(uu.x), bhi(uu.x), blo(uu.y), bhi(uu.y)}; u0[1] = (f32x4){blo(uu.z), bhi(uu.z), blo(uu.w), bhi(uu.w)};
                f32x4 y[2]; y[0] = (f32x4){blo(bg.x), bhi(bg.x), blo(bg.y), bhi(bg.y)} * (w0[0] * u2[0] + w1[0] * u1[0] + w2[0] * u0[0]); y[1] = (f32x4){blo(bg.z), bhi(bg.z), blo(bg.w), bhi(bg.w)} * (w0[1] * u2[1] + w1[1] * u1[1] + w2[1] * u0[1]);
                const float rstd = rsqrtf(wave_sum(pg8::sq4(y[0]) + pg8::sq4(y[1])) * (1.f / 512.f) + EPS);
                *(u32x4*)(MIX + (size_t)row * DM + 512 + c8) = pg8::pack8(y[0] * rstd, y[1] * rstd);
                u2[0] = u1[0]; u2[1] = u1[1]; u1[0] = u0[0]; u1[1] = u0[1]; }
        }
        { pg8::Gemm g{Z, WUQ, QL, INWP, QL, nullptr, 0}; pg8::StaticOrder S; S.init(NTOK / 256, 768 / 256, G, bx, nullptr);
          pg8::EpiQ E{Qb, SSQ, CS}; pg8::gemm_phase<pg8::EpiQ, false>(lds, g, S, E, wave); }
        { pg8::Gemm g{Z + 256, WUKV, 256, INWP, 256, nullptr, 0}; pg8::StaticOrder S; S.init(NTOK / 256, 1024 / 256, G, bx, nullptr);
          pg8::EpiKV E{Kb, Vb, SSQ}; pg8::gemm_phase<pg8::EpiKV, false>(lds, g, S, E, wave); }
    }
    SEAM(PH_TOKLOCAL);
    if (IN(PH_ATTN)) REPLOOP(PH_ATTN) {
        const int vcu = (G % 8 == 0) ? (bx % 8) * (G / 8) + bx / 8 : bx;
        using att::L_END; using att::cv_cmap1; using att::cv_cmap2; using att::CV_N1; using att::CV_TOTAL;
        const att::ConvJob cj{w1, w2, moe_norm, (unsigned char*)W1T, (unsigned char*)W2T, gw, NGW}; int tseq = LASTREP(PH_ATTN) ? 0 : (1 << 20);
        for (int it = vcu; it < NB * NH * 8; it += G) { const int bh = it >> 3, pr = it & 7;
            for (int pass = 0; pass < 2; ++pass) att::attn_block(bh, pass ? pr : 15 - pr, Qb, Kb, Vb, MIX, ASSQ, lds, wave, cj, tseq); }
        if (LASTREP(PH_ATTN)) { const int lane = lane_id(), hi = lane >> 5, wid = wave; __syncthreads();
            for (int cv_idx = tseq * NGW + gw; cv_idx < att::CV_TOTAL; cv_idx += NGW) { CV_DECODE(cv_idx) CV_LOAD(); asm volatile("s_waitcnt vmcnt(0)" ::: "memory"); CV_STORE(); } }
    }
    SEAM(PH_ATTN);
    if (IN(PH_WO)) REPLOOP(PH_WO) {
        pg8::Gemm g{MIX, WO, DM, DM, DM, nullptr, 0}; pg8::StaticOrder S; S.init(NTOK / 256, DM / 256, G, bx, nullptr);
        pg8::EpiWo E{XN, HBF, X8, ASSQ, SSQ1, moe_norm}; pg8::gemm_phase<pg8::EpiWo, false>(lds, g, S, E, wave, LASTREP(PH_WO));
    }
    SEAM(PH_WO);
    if (IN(PH_ROUTER)) REPLOOP(PH_ROUTER) {
        PHASE_LANE;
        typedef float f32x16 __attribute__((ext_vector_type(16)));
        const bool fusedR = (G == 256);
        LAS int* hist = (LAS int*)(lds + HIST_OFF); LAS f32x16* xch = (LAS f32x16*)(lds + HIST_OFF + 256);
        for (int i = tid; i < 2 * NE * 128; i += NTHREADS) { const int pe = i >> 7, kc = i & 127, e = pe & 31; *(LAS u32x4*)(lds + pe * 2048 + ((kc ^ (e & 15)) << 4)) = ((const u32x4*)WRHL)[i]; }
        if (tid < NE) hist[tid] = 0;
        __syncthreads();
        for (int chunk = bx; chunk < NTOK / 128; chunk += G) {
            const int base = chunk * 128, wq = wave & 3, kh = wave >> 2;
            const int j = lane & 31, half = lane >> 5, tok = base + wq * 32 + j;
            const bf16_t* xr = HBF + (size_t)tok * DM + kh * 512 + 8 * half; const LAS unsigned char* wrow = lds + j * 2048;
            f32x16 acc = {};
#pragma unroll 8
            for (int s = 0; s < 32; ++s) { const bf16x8 xb = *(const bf16x8*)(xr + 16 * s); const int kc = ((kh * 64 + 2 * s + half) ^ (j & 15)) << 4;
                const bf16x8 ah = *(const LAS bf16x8*)(wrow + kc), al = *(const LAS bf16x8*)(wrow + 65536 + kc);
                acc = __builtin_amdgcn_mfma_f32_32x32x16_bf16(ah, xb, acc, 0, 0, 0); acc = __builtin_amdgcn_mfma_f32_32x32x16_bf16(al, xb, acc, 0, 0, 0); }
            if (kh == 1) xch[wq * 64 + lane] = acc;
            __syncthreads();
            if (kh == 0) {
                const f32x16 other = xch[wq * 64 + lane];
                const f32x4 s0 = *(const f32x4*)(SSQ1 + (size_t)tok * 16 + 8 * half), s1 = *(const f32x4*)(SSQ1 + (size_t)tok * 16 + 8 * half + 4);
                float ss = ((s0[0] + s0[1]) + (s0[2] + s0[3])) + ((s1[0] + s1[1]) + (s1[2] + s1[3])); ss += __shfl_xor(ss, 32); const float rstd = rsqrtf(ss * (1.f / DM) + EPS);
                float v[16];
#pragma unroll
                for (int r = 0; r < 16; ++r) v[r] = (acc[r] + other[r]) * rstd + b_router[(r & 3) + 8 * (r >> 2) + 4 * half];
                float lv[4]; int li[4];
#pragma unroll
                for (int t = 0; t < 4; ++t) { float best = -__builtin_inff(); int bi = 0;
#pragma unroll
                    for (int r = 0; r < 16; ++r) if (v[r] > best) { best = v[r]; bi = (r & 3) + 8 * (r >> 2) + 4 * half; }
                    const auto rv = __builtin_amdgcn_permlane32_swap(__float_as_uint(best), __float_as_uint(best), false, false); const auto ri = __builtin_amdgcn_permlane32_swap((unsigned)bi, (unsigned)bi, false, false);
                    const float b0 = __uint_as_float(rv[0]), b1 = __uint_as_float(rv[1]); const int i0 = (int)ri[0], i1 = (int)ri[1];
                    const bool t0 = (b0 > b1) || (b0 == b1 && i0 < i1); const float gb = t0 ? b0 : b1; const int gi = t0 ? i0 : i1; lv[t] = gb; li[t] = gi;
#pragma unroll
                    for (int r = 0; r < 16; ++r) if ((r & 3) + 8 * (r >> 2) + 4 * half == gi) v[r] = -__builtin_inff(); }
                if (half == 0) { const float e1 = __expf(lv[1] - lv[0]), e2 = __expf(lv[2] - lv[0]), e3 = __expf(lv[3] - lv[0]); const float inv = 1.f / (1.f + e1 + e2 + e3);
                    if (fusedR) { const int tl = wq * 32 + j; *(LAS u32x4*)(lds + LT_OFF + tl * 16) = (u32x4){(unsigned)li[0], (unsigned)li[1], (unsigned)li[2], (unsigned)li[3]}; *(LAS f32x4*)(lds + LT_OFF + 2048 + tl * 16) = (f32x4){inv, e1 * inv, e2 * inv, e3 * inv}; *(LAS float*)(lds + LT_OFF + 4096 + tl * 4) = rstd; }
                    else { *(int4*)(TOPI + (size_t)tok * 4) = make_int4(li[0], li[1], li[2], li[3]); *(f32x4*)(TOPG + (size_t)tok * 4) = (f32x4){inv, e1 * inv, e2 * inv, e3 * inv}; RS1[tok] = rstd; }
#pragma unroll
                    for (int t = 0; t < 4; ++t) (void)__hip_atomic_fetch_add(hist + li[t], 1, __ATOMIC_RELAXED, __HIP_MEMORY_SCOPE_WORKGROUP); }
            }
            __syncthreads();
        }
        if (!fusedR) { if (tid < NE && LASTREP(PH_ROUTER)) atomicAdd(ctl + CW_CNT + tid, hist[tid]); __syncthreads(); }
        else {
            LAS int* S = (LAS int*)lds; LAS int* T = (LAS int*)(lds + 32768);
            LAS int* shf = (LAS int*)(lds + LT_OFF + 4608); LAS int* sh2 = shf + 64;
            int* BH = (int*)(ws + WS_FSSQ + 1 * MiB); int* BB = BH + 256 * NE;
            if (tid < NE) __hip_atomic_store(BH + bx * NE + tid, hist[tid], __ATOMIC_RELAXED, __HIP_MEMORY_SCOPE_AGENT);
            asm volatile("s_waitcnt vmcnt(0)" ::: "memory");
            __syncthreads();
            if (tid == 0) shf[0] = (__hip_atomic_fetch_add(ctl + CW_TICKET, 1, __ATOMIC_RELAXED, __HIP_MEMORY_SCOPE_AGENT) == G - 1) ? 1 : 0;
            __syncthreads();
            if (shf[0]) {
                if (wave == 0) __builtin_amdgcn_fence(__ATOMIC_ACQUIRE, "agent");
                __syncthreads();
                { u32x4 hv4[4];
#pragma unroll
                  for (int q = 0; q < 4; ++q) hv4[q] = *(const u32x4*)(BH + (tid + q * NTHREADS) * 4);
#pragma unroll
                  for (int q = 0; q < 4; ++q) *(LAS u32x4*)(S + (tid + q * NTHREADS) * 4) = hv4[q]; }
                __syncthreads();
                if (lane < NE) { int run = 0; for (int b = wave * 32; b < wave * 32 + 32; ++b) { const int v = S[b * NE + lane]; S[b * NE + lane] = run; run += v; } T[wave * NE + lane] = run; }
                __syncthreads();
                if (tid < NE) { int run = 0; for (int w = 0; w < 8; ++w) { const int v = T[w * NE + tid]; T[w * NE + tid] = run; run += v; } T[256 + tid] = run; }
                __syncthreads();
#pragma unroll
                for (int q = 0; q < 4; ++q) { const int i = (tid + q * NTHREADS) * 4; u32x4 v = *(const LAS u32x4*)(S + i); const u32x4 tb = *(const LAS u32x4*)(T + (i >> 10) * NE + (i & 31));
                    v += tb; asm volatile("global_store_dwordx4 %0, %1, off sc0 sc1" :: "v"(BB + i), "v"(v) : "memory"); }
                if (wave == 0) { const int c = lane < NE ? T[256 + (lane & 31)] : 0, t = (c + 255) >> 8; int incl = t;
#pragma unroll
                    for (int d = 1; d < 64; d <<= 1) { const int o = __shfl_up(incl, d); if (lane >= d) incl += o; }
                    const int excl = incl - t;
                    if (lane < NE) { __hip_atomic_store(ctl + CW_PADSTART + lane, excl * 256, __ATOMIC_RELAXED, __HIP_MEMORY_SCOPE_AGENT); __hip_atomic_store(ctl + CW_CNT + lane, c, __ATOMIC_RELAXED, __HIP_MEMORY_SCOPE_AGENT);
                        for (int q = 0; q < t; ++q) __hip_atomic_store(ctl + CW_TILE_E + excl + q, lane, __ATOMIC_RELAXED, __HIP_MEMORY_SCOPE_AGENT); }
                    if (lane == NE) { __hip_atomic_store(ctl + CW_PADSTART + NE, excl * 256, __ATOMIC_RELAXED, __HIP_MEMORY_SCOPE_AGENT); __hip_atomic_store(ctl + CW_NTILES, excl, __ATOMIC_RELAXED, __HIP_MEMORY_SCOPE_AGENT); } }
                asm volatile("s_waitcnt vmcnt(0)" ::: "memory");
                __syncthreads();
                if (tid == 0) __hip_atomic_store(ctl + CW_READY, 1, __ATOMIC_RELAXED, __HIP_MEMORY_SCOPE_AGENT);
            }
            if (wave == 0) { unsigned sp = 0;
                while (__builtin_amdgcn_readfirstlane(__hip_atomic_load(ctl + CW_READY, __ATOMIC_RELAXED, __HIP_MEMORY_SCOPE_AGENT)) == 0) { __builtin_amdgcn_s_sleep(24); if (++sp > (1u << 19)) break; }
                __builtin_amdgcn_fence(__ATOMIC_ACQUIRE, "agent"); }
            __syncthreads();
            if (tid < NE) { sh2[tid] = BB[bx * NE + tid] + ctl[CW_PADSTART + tid]; sh2[64 + tid] = 0; }
            __syncthreads();
            { const int e = *(const LAS int*)(lds + LT_OFF + tid * 4); const int r = __hip_atomic_fetch_add(sh2 + 64 + e, 1, __ATOMIC_RELAXED, __HIP_MEMORY_SCOPE_WORKGROUP);
              const int dest = sh2[e] + r, idx = bx * NTHREADS + tid;
              ROWTOK[dest] = idx >> 2; ROWSLOT[dest] = idx; ROWGATE[dest] = *(const LAS float*)(lds + LT_OFF + 2048 + tid * 4); ROWRS[dest] = *(const LAS float*)(lds + LT_OFF + 4096 + (tid >> 2) * 4); }
            if (bx < NE) { const int plo = ctl[CW_PADSTART + bx] + ctl[CW_CNT + bx], phi = ctl[CW_PADSTART + bx + 1];
                for (int r = plo + tid; r < phi; r += NTHREADS) { ROWTOK[r] = 0; ROWSLOT[r] = MROWS; ROWGATE[r] = 0.f; ROWRS[r] = 0.f; } }
            __syncthreads();
        }
    }
    if (G != 256) SEAM(PH_ROUTER);
    if (IN(PH_ROUTE) && G != 256) {
        PHASE_LANE;
        LAS int* sh = (LAS int*)lds;
        if (tid == 0) { int ps = 0, nt = 0;
            for (int e = 0; e < NE; ++e) { sh[e] = ps; const int t = (ctl[CW_CNT + e] + 255) >> 8; if (bx == 0) for (int q = 0; q < t; ++q) ctl[CW_TILE_E + nt + q] = e; nt += t; ps += t * 256; }
            sh[NE] = ps; if (bx == 0) ctl[CW_NTILES] = nt; }
        __syncthreads();
        for (int chunk = bx; chunk < MROWS / NTHREADS; chunk += G) {
            if (tid < NE) sh[64 + tid] = 0;
            __syncthreads();
            const int idx = chunk * NTHREADS + tid, e = TOPI[idx]; const int r = __hip_atomic_fetch_add(sh + 64 + e, 1, __ATOMIC_RELAXED, __HIP_MEMORY_SCOPE_WORKGROUP);
            __syncthreads();
            if (tid < NE) sh[128 + tid] = atomicAdd(ctl + CW_CURSOR + tid, sh[64 + tid]);
            __syncthreads();
            const int dest = sh[e] + sh[128 + e] + r; ROWTOK[dest] = idx >> 2; ROWSLOT[dest] = idx; ROWGATE[dest] = TOPG[idx]; ROWRS[dest] = RS1[idx >> 2];
            __syncthreads();
        }
        for (int e = bx; e < NE; e += G) { const int plo = sh[e] + ctl[CW_CNT + e], phi = sh[e + 1];
            for (int r = plo + tid; r < phi; r += NTHREADS) { ROWTOK[r] = 0; ROWSLOT[r] = MROWS; ROWGATE[r] = 0.f; ROWRS[r] = 0.f; } }
        __syncthreads();
    }
    SEAM(PH_ROUTE);
    if (IN(PH_MOE1)) REPLOOP(PH_MOE1) {
        pg8::Gemm g{X8, W1T, DM, DM, DM, ROWTOK, (size_t)2048 * DM}; pg8::StaticOrder S; S.init(ctl[CW_NTILES], 2048 / 256, G, bx, ctl + CW_TILE_E);
        pg8::EpiMoe1 E{(unsigned char*)HB, b1, ROWRS}; pg8::gemm_phase<pg8::EpiMoe1, true, true>(lds, g, S, E, wave, LASTREP(PH_MOE1));
    }
    SEAM(PH_MOE1);
    if (IN(PH_MOE2)) REPLOOP(PH_MOE2) {
        pg8::Gemm g{HB, W2T, DE, DE, DE, nullptr, (size_t)DM * DE}; pg8::StaticOrder S; S.init(ctl[CW_NTILES], DM / 256, G, bx, ctl + CW_TILE_E);
        pg8::EpiMoe2 E{(unsigned char*)Y, b2, ROWSLOT, ROWGATE}; pg8::gemm_phase<pg8::EpiMoe2, false, true>(lds, g, S, E, wave, LASTREP(PH_MOE2));
    }
    SEAM(PH_MOE2);
    if (IN(PH_COMBINE)) REPLOOP(PH_COMBINE) {
        PHASE_LANE;
        for (int row = gw * 2; row < NTOK; row += NGW * 2) {
            u32x4 hv[2][2]; u32x2 yv[2][4][2]; const unsigned char* Y8 = (const unsigned char*)Y;
#pragma unroll
            for (int q = 0; q < 2; ++q)
#pragma unroll
                for (int j = 0; j < 2; ++j) { hv[q][j] = *(const u32x4*)(HBF + (size_t)(row + q) * DM + (lane + 64 * j) * 8);
#pragma unroll
                    for (int k = 0; k < 4; ++k) yv[q][k][j] = *(const u32x2*)(Y8 + ((size_t)(row + q) * 4 + k) * DM + (lane + 64 * j) * 8); }
#pragma unroll
            for (int q = 0; q < 2; ++q) { float ss = 0.f; u32x4 ov[2];
#pragma unroll
                for (int j = 0; j < 2; ++j) { f32x4 a = {blo(hv[q][j].x), bhi(hv[q][j].x), blo(hv[q][j].y), bhi(hv[q][j].y)}, b = {blo(hv[q][j].z), bhi(hv[q][j].z), blo(hv[q][j].w), bhi(hv[q][j].w)};
#pragma unroll
                    for (int k = 0; k < 4; ++k) { const u32x2 y = yv[q][k][j]; const f32x2 y0 = __builtin_amdgcn_cvt_pk_f32_fp8(y.x, false), y1 = __builtin_amdgcn_cvt_pk_f32_fp8(y.x, true), y2 = __builtin_amdgcn_cvt_pk_f32_fp8(y.y, false), y3 = __builtin_amdgcn_cvt_pk_f32_fp8(y.y, true);
                        a += (f32x4){y0[0], y0[1], y1[0], y1[1]}; b += (f32x4){y2[0], y2[1], y3[0], y3[1]}; }
                    ss += pg8::sq4(a) + pg8::sq4(b); ov[j] = pg8::pack8(a, b); }
                ss = wave_sum(ss);
                bf16_t* ho = LASTREP(PH_COMBINE) ? HBF : (bf16_t*)(ws + WS_HB);
#pragma unroll
                for (int j = 0; j < 2; ++j) *(u32x4*)(ho + (size_t)(row + q) * DM + (lane + 64 * j) * 8) = ov[j];
                float ps = lane < 16 ? PSSQ[(size_t)(row + q) * 16 + lane] : 0.f; ps += __shfl_xor(ps, 1); ps += __shfl_xor(ps, 2); ps += __shfl_xor(ps, 4); ps += __shfl_xor(ps, 8);
                if (lane == 0) { RS2[row + q] = rsqrtf(ss * (1.f / DM) + EPS); RS2[NTOK + row + q] = rsqrtf(ps * (1.f / DM) + EPS); } }
        }
    }
    SEAM(PH_COMBINE);
    if (IN(PH_PLE)) REPLOOP(PH_PLE) {
        pg8::Gemm g{HBF, WG, DM, DM, DM, nullptr, 0}; pg8::StaticOrder S; S.init(NTOK / 256, DM / 256, G, bx, nullptr);
        if (G == 256 && LASTREP(PH_PLE)) { pg8::EpiPleFinal E{HBF, H, PLER, RS2 + NTOK, RS2, ple_post_norm, final_norm, FSSQ, (unsigned*)ctl + CW_PANEL, (unsigned*)ctl + CW_PANEL - 64, lds}; pg8::gemm_phase<pg8::EpiPleFinal, false>(lds, g, S, E, wave); }
        else { pg8::EpiPle E{HBF, H3, PLER, RS2 + NTOK, RS2, ple_post_norm, FSSQ}; pg8::gemm_phase<pg8::EpiPle, false>(lds, g, S, E, wave); }
    }
    if (G != 256) SEAM(PH_PLE);
    if (IN(PH_FINAL) && G != 256) REPLOOP(PH_FINAL) {
        PHASE_LANE;
        for (int row = gw * 4; row < NTOK; row += NGW * 4) {
            u32x4 hv[4][2]; float sp[4];
#pragma unroll
            for (int q = 0; q < 4; ++q) { sp[q] = lane < 16 ? FSSQ[(size_t)(row + q) * 16 + lane] : 0.f;
#pragma unroll
                for (int j = 0; j < 2; ++j) hv[q][j] = *(const u32x4*)(H3 + (size_t)(row + q) * DM + (lane + 64 * j) * 8); }
#pragma unroll
            for (int q = 0; q < 4; ++q) { float s = sp[q]; s += __shfl_xor(s, 1); s += __shfl_xor(s, 2); s += __shfl_xor(s, 4); s += __shfl_xor(s, 8);
                const float rstd = rsqrtf(__shfl(s, 0) * (1.f / DM) + EPS); float* ho = (LASTREP(PH_FINAL) ? H : (float*)(ws + WS_HB)) + (size_t)(row + q) * DM;
#pragma unroll
                for (int j = 0; j < 2; ++j) { const int c = (lane + 64 * j) * 8; const f32x4 g0 = *(const f32x4*)(final_norm + c), g1 = *(const f32x4*)(final_norm + c + 4); const u32x4 v = hv[q][j];
                    *(f32x4*)(ho + c) = (f32x4){blo(v.x), bhi(v.x), blo(v.y), bhi(v.y)} * rstd * g0; *(f32x4*)(ho + c + 4) = (f32x4){blo(v.z), bhi(v.z), blo(v.w), bhi(v.w)} * rstd * g1; } }
        }
    }
#ifdef PROBE_TIME_PH
    STAMP(PH_COUNT);
    if (bx == 0 && wave == 0) {
#ifndef PROBE_TIME_END
#define PROBE_TIME_END (PROBE_TIME_PH + 1)
#endif
        const unsigned dt = MISC[32 + PROBE_TIME_END] - MISC[32 + PROBE_TIME_PH]; const unsigned long long t0 = __builtin_amdgcn_s_memrealtime(); while (__builtin_amdgcn_s_memrealtime() - t0 < (unsigned long long)dt) __builtin_amdgcn_s_sleep(8); }
#endif
#ifdef PROBE_BARS
    if (hi - lo > 1) for (int i = 0; i < PROBE_BARS; ++i) xcd_barrier(bar, wave);
#endif
#undef IN
#undef NREP
#undef REPLOOP
#undef LASTREP
#undef SEAM
}
static int g_grid = 0;
extern "C" void kernel_launch(void* const* d_in, const int* in_sizes, int n_in, void* d_out, int out_size, void* d_ws, size_t ws_size, hipStream_t stream) {
    if (n_in != 25 || in_sizes[0] != NTOK * DM || out_size != NTOK * DM || ws_size < WS_END) {
        fprintf(stderr, "kernel_launch: unexpected shapes (n_in %d, in0 %d, out %d, ws %zu need %zu)\n", n_in, n_in > 0 ? in_sizes[0] : -1, out_size, ws_size, (size_t)WS_END); return; }
    if (g_grid == 0) {
        int dev = 0, cus = 0, per_cu = 0; (void)hipGetDevice(&dev); (void)hipDeviceGetAttribute(&cus, hipDeviceAttributeMultiprocessorCount, dev);
        if (hipFuncSetAttribute((const void*)fwd, hipFuncAttributeMaxDynamicSharedMemorySize, LDS_BYTES) != hipSuccess) fprintf(stderr, "hipFuncSetAttribute failed\n");
        if (hipOccupancyMaxActiveBlocksPerMultiprocessor(&per_cu, (const void*)fwd, NTHREADS, LDS_BYTES) != hipSuccess || per_cu < 1) { fprintf(stderr, "occupancy query: %d\n", per_cu); per_cu = 1; }
        (void)hipGetLastError();
        g_grid = cus > 0 ? cus : 256;
    }
    (void)hipMemsetAsync((unsigned char*)d_ws + WS_CTL, 0, 64 * 1024, stream);
    Args a{}; for (int i = 0; i < 25; ++i) a.in[i] = d_in[i]; a.out = (float*)d_out; a.ws = (unsigned char*)d_ws;
    a.ph_lo = 0; a.ph_hi = PH_COUNT; a.li = 0; a.skip = 0;
    void* p[] = {&a};
    const hipError_t e = hipLaunchCooperativeKernel((const void*)fwd, dim3(g_grid), dim3(NTHREADS), p, LDS_BYTES, stream);
    if (e != hipSuccess) fprintf(stderr, "cooperative launch failed: %s (grid %d)\n", hipGetErrorString(e), g_grid);
}
```

```cpp
#include <hip/hip_runtime.h>
#include <cstdint>
#include <cstdio>
#include <cmath>

typedef unsigned short bf16_t;

constexpr int NB = 8, SEQ = 4096, DM = 1024, NTOK = NB * SEQ;
constexpr int PLE = 256, NH = 4, DN = 128, DR = 64, DV = 128, QL = 256, KVL = 128, DQK = DN + DR;
constexpr int INW = 1984, INWP = 1536;
constexpr int NE = 32, TOPK = 4, DE = 1024;
constexpr int MROWS = NTOK * TOPK;
constexpr int MAXTILES = MROWS / 256 + NE;
constexpr int PROWS = MAXTILES * 256;
constexpr float EPS = 1e-6f;
constexpr float QSCALE = 0.07216878364870322f * 1.4426950408889634f;

constexpr size_t MiB = 1u << 20;
constexpr size_t WS_CTL = 0;
constexpr size_t WS_WIN = 1 * MiB, WS_WUQ = 5 * MiB, WS_WUKV = 5 * MiB + 512 * 1024, WS_WO = 6 * MiB, WS_WG = 8 * MiB, WS_WP = 10 * MiB;
constexpr size_t WS_WR = 10 * MiB + 512 * 1024;
constexpr size_t WS_CS = 11 * MiB;
constexpr size_t WS_SSQ = 19 * MiB, WS_ASSQ = 20 * MiB, WS_PSSQ = 21 * MiB, WS_FSSQ = 23 * MiB;
constexpr size_t WS_TOPI = 25 * MiB, WS_TOPG = 25 * MiB + 512 * 1024;
constexpr size_t WS_ROWTOK = 26 * MiB, WS_ROWSLOT = 27 * MiB, WS_ROWGATE = 28 * MiB;
constexpr size_t WS_P16 = 29 * MiB;
constexpr size_t WS_SSQ1 = 45 * MiB, WS_RS1 = 47 * MiB, WS_RS2 = 47 * MiB + 128 * 1024, WS_ROWRS = 47 * MiB + 384 * 1024;
constexpr size_t WS_RSX = 10 * MiB + 512 * 1024;
constexpr size_t WS_WRHL = 10 * MiB + 768 * 1024;
constexpr size_t WS_HBF = 112 * MiB;
constexpr size_t WS_H3 = 304 * MiB;
constexpr size_t WS_W1 = 48 * MiB, WS_W2 = 176 * MiB, WS_XN = 240 * MiB, WS_MIX = 304 * MiB, WS_PLER = 368 * MiB;
constexpr size_t WS_Z = 432 * MiB, WS_Q = 560 * MiB, WS_K = 608 * MiB, WS_V = 656 * MiB;
constexpr size_t WS_HB = 432 * MiB;
constexpr size_t WS_Y = 704 * MiB;
constexpr size_t WS_END = WS_Y + (size_t)(MROWS + 256) * DM * 2;
constexpr int CW_CNT = 0, CW_CURSOR = 64, CW_PADSTART = 128, CW_NTILES = 192, CW_TICKET = 200, CW_READY = 224, CW_TILE_E = 256;

__device__ __forceinline__ float bf2f(bf16_t v) { return __uint_as_float((unsigned)v << 16); }
__device__ __forceinline__ float blo(unsigned u) { return __uint_as_float(u << 16); }
__device__ __forceinline__ float bhi(unsigned u) { return __uint_as_float(u & 0xffff0000u); }
__device__ __forceinline__ bf16_t f2bf(float f) { unsigned u = __float_as_uint(f); return (bf16_t)((u + 0x7fffu + ((u >> 16) & 1u)) >> 16); }
__device__ __forceinline__ unsigned pk2(float lo, float hi) { return (unsigned)f2bf(lo) | ((unsigned)f2bf(hi) << 16); }
__device__ __forceinline__ float wave_sum(float v) {
#pragma unroll
    for (int o = 1; o < 64; o <<= 1) v += __shfl_xor(v, o);
    return v;
}
__device__ __forceinline__ float wave_max(float v) {
#pragma unroll
    for (int o = 1; o < 64; o <<= 1) v = fmaxf(v, __shfl_xor(v, o));
    return v;
}
__device__ __forceinline__ float dot8(uint4 x, uint4 y) {
    return blo(x.x) * blo(y.x) + bhi(x.x) * bhi(y.x) + blo(x.y) * blo(y.y) + bhi(x.y) * bhi(y.y) +
           blo(x.z) * blo(y.z) + bhi(x.z) * bhi(y.z) + blo(x.w) * blo(y.w) + bhi(x.w) * bhi(y.w);
}
__device__ __forceinline__ float dot_bf16(const bf16_t* a, const bf16_t* b, int K) {
    const uint4* a4 = (const uint4*)a; const uint4* b4 = (const uint4*)b; float acc = 0.f;
    for (int i = 0; i < K / 8; ++i) acc += dot8(a4[i], b4[i]);
    return acc;
}

#define LAS __attribute__((address_space(3)))
#define GAS __attribute__((address_space(1)))
typedef short bf16x8 __attribute__((ext_vector_type(8)));
typedef float f32x4 __attribute__((ext_vector_type(4)));
typedef float f32x2 __attribute__((ext_vector_type(2)));
typedef unsigned u32x4 __attribute__((ext_vector_type(4)));
typedef unsigned u32x2 __attribute__((ext_vector_type(2)));
#ifndef PROBE_PH
#define PROBE_PH (-1)
#define PROBE_REP 1
#endif
#ifndef MOE2_DELAY_TICKS
#define MOE2_DELAY_TICKS 700ull
#endif
constexpr int NWAVES = 8, NTHREADS = 512;
constexpr int RING_BYTES = 131072, MISC_OFF = RING_BYTES, HIST_OFF = MISC_OFF + 256, STG_OFF = RING_BYTES + 1024, LT_OFF = HIST_OFF + 256 + 16384, LDS_BYTES = 163840;
constexpr int CW_PANEL = 8192;
constexpr int CW_BAR = 4096;
__device__ __forceinline__ unsigned cvt_pk_bf16(float lo, float hi) { unsigned r; asm volatile("v_cvt_pk_bf16_f32 %0, %1, %2" : "=v"(r) : "v"(lo), "v"(hi)); return r; }
__device__ __forceinline__ int lane_id() { int l = (int)__builtin_amdgcn_mbcnt_hi(~0u, __builtin_amdgcn_mbcnt_lo(~0u, 0u)); asm volatile("" : "+v"(l)); return l; }
__device__ __forceinline__ float fast_sigmoid(float a) { return __builtin_amdgcn_rcpf(1.f + __expf(-a)); }

#define XB_TMO      128
#define XB_XCNT(j)  (256  + 64 * (j))
#define XB_XSUB(j)  (1280 + 64 * (j))
#define XB_XGEN(j)  (2304 + 64 * (j))
#define XB_TOP      3328
#define XB_TOPGEN   3392
#define XCD_BAR_WORDS 3456
#define XB_SPIN_CAP (1u << 20)
__device__ __forceinline__ unsigned xb_ld(unsigned* p)              { return __hip_atomic_load(p, __ATOMIC_RELAXED, __HIP_MEMORY_SCOPE_AGENT); }
__device__ __forceinline__ unsigned xb_add(unsigned* p, unsigned v) { return __hip_atomic_fetch_add(p, v, __ATOMIC_RELAXED, __HIP_MEMORY_SCOPE_AGENT); }
__device__ __forceinline__ unsigned xb_xcc_id() { return (unsigned)__builtin_amdgcn_s_getreg((3 << 11) | 20) & 0xFu; }
#define XB_SPIN(cond, bar) do { unsigned _sp = 0; while (cond) { __builtin_amdgcn_s_sleep(1); \
    if ((++_sp & 255u) == 0u) { if (xb_ld(&(bar)[XB_TMO])) break; if (_sp > XB_SPIN_CAP) { atomicAdd(&(bar)[XB_TMO], 1u); break; } } } } while (0)
struct XcdBarrier { unsigned* bar; unsigned x; volatile LAS unsigned* st; };
__device__ __forceinline__ XcdBarrier xcd_barrier_post(unsigned* bar, volatile LAS unsigned* st, int wave) {
    XcdBarrier b; b.bar = bar; b.x = xb_xcc_id(); b.st = st;
    if (wave == 0 && lane_id() == 0) (void)xb_add(&bar[XB_XCNT(b.x)], 1u);
    return b;
}
__device__ __forceinline__ void xcd_barrier_complete(unsigned* bar, unsigned x, unsigned& nloc, unsigned& nx) {
    const unsigned G = gridDim.x * gridDim.y * gridDim.z;
    unsigned sum, cnt, mine, sp = 0u;
    for (;;) {
        sum = 0u; cnt = 0u; mine = 0u;
#pragma unroll
        for (unsigned j = 0; j < 16; ++j) { const unsigned c = xb_ld(&bar[XB_XCNT(j)]); sum += c; cnt += (c > 0u) ? 1u : 0u; mine = (j == x) ? c : mine; }
        if (sum == G) break;
        __builtin_amdgcn_s_sleep(1);
        if ((++sp & 255u) == 0u) { if (xb_ld(&bar[XB_TMO])) break; if (sp > XB_SPIN_CAP) { atomicAdd(&bar[XB_TMO], 1u); break; } }
    }
    nloc = mine > 0u ? mine : 1u; nx = cnt > 0u ? cnt : 1u;
}
__device__ __forceinline__ void xcd_barrier(const XcdBarrier& b, int wave) {
    asm volatile("s_waitcnt vmcnt(0)" ::: "memory");
    __syncthreads();
    if (wave == 0 && lane_id() == 0) {
        unsigned* bar = b.bar;
        __builtin_amdgcn_s_waitcnt(0);
        unsigned nloc = b.st[0], nx = b.st[1];
        if (nloc == 0u) { xcd_barrier_complete(bar, b.x, nloc, nx); b.st[0] = nloc; b.st[1] = nx; }
        const unsigned old = xb_add(&bar[XB_XSUB(b.x)], 1u);
        const unsigned gen = old / nloc;
        if (old + 1u == (gen + 1u) * nloc) {
            __builtin_amdgcn_fence(__ATOMIC_RELEASE, "agent");
            asm volatile("s_waitcnt vmcnt(0)" ::: "memory");
            const unsigned og = xb_add(&bar[XB_TOP], 1u);
            const unsigned tg = og / nx;
            if (og + 1u == (tg + 1u) * nx) xb_add(&bar[XB_TOPGEN], 1u);
            else XB_SPIN(xb_ld(&bar[XB_TOPGEN]) == tg, bar);
            __builtin_amdgcn_fence(__ATOMIC_ACQUIRE, "agent");
            xb_add(&bar[XB_XGEN(b.x)], 1u);
            asm volatile("s_waitcnt vmcnt(0)" ::: "memory");
        } else {
            XB_SPIN(xb_ld(&bar[XB_XGEN(b.x)]) == gen, bar);
            __builtin_amdgcn_fence(__ATOMIC_ACQUIRE, "agent");
            asm volatile("s_waitcnt vmcnt(0)" ::: "memory");
        }
    }
    __syncthreads();
}

namespace pg8 {
constexpr int BM = 256, BK = 64, HALF = 128, HTB = HALF * BK * 2, STAGE_BYTES = 8 * HTB, NXCD = 8, WGM = 8;
__host__ __device__ __forceinline__ int lds_byte(int r, int c) { const int st = (r >> 4) * 2 + (c >> 5), rr = r & 15, cc = c & 31, ob = rr * 64 + cc * 2; return st * 1024 + (ob ^ (((ob >> 9) & 1) << 5)); }
__host__ __device__ __forceinline__ void stage_rc(int b, int& R, int& C) { const int st = b / 1024, sb = b % 1024, swz = sb ^ (((sb >> 9) & 1) << 5); R = (st >> 1) * 16 + swz / 64; C = (st & 1) * 32 + (swz % 64) / 2; }
__host__ __device__ __forceinline__ int perm32(int rho) { const int n = rho >> 4, i = rho & 15; return 8 * (i >> 2) + 4 * n + (i & 3); }
struct Unit { int pm, pn, e; };
struct Gemm { const void* A; const void* Bt; int K, lda, ldb; const int* rowidx; size_t bstride; };
struct StaticOrder {
    int nM, nN, nwg, G, c; const int* tile_e;
    __device__ void init(int nM_, int nN_, int G_, int c_, const int* te) { nM = nM_; nN = nN_; nwg = nM * nN; G = G_; c = c_; tile_e = te; }
    __device__ bool next(int i, Unit& u) const {
        const long L = (long)i * G + c; if (L >= nwg) return false;
        int wgid = (int)L; { const int q = nwg / NXCD, r = nwg % NXCD, xcd = wgid % NXCD, off = wgid / NXCD; wgid = (xcd < r ? xcd * (q + 1) : r * (q + 1) + (xcd - r) * q) + off; }
        const int nig = WGM * nN, gid = wgid / nig, fm = gid * WGM, gsz = (nM - fm) < WGM ? (nM - fm) : WGM;
        u.pm = fm + ((wgid % nig) % gsz); u.pn = (wgid % nig) / gsz; u.e = tile_e ? tile_e[u.pm] : 0; return true;
    }
};
typedef f32x4 Acc[2][2][4][2];
typedef int v8i_t __attribute__((ext_vector_type(8)));
typedef int v4i_t __attribute__((ext_vector_type(4)));
template <class Epi, bool GATHER, bool FP8 = false>
__device__ __forceinline__ void gemm_phase(LAS unsigned char* lds, const Gemm g, const StaticOrder& S, const Epi& E, const int wid, const bool do_epi = true) {
    const int lane = lane_id(), tid = wid * 64 + lane, wr = wid >> 2, wc = wid & 3, fr = lane & 15, fq = lane >> 4;
    constexpr int ES = FP8 ? 1 : 2;
    const int K = g.K, nt = K * ES / 128;
    int RA[2], CA[2]; unsigned voffB[2], voffA[2];
#pragma unroll
    for (int i = 0; i < 2; ++i) { int R, C; stage_rc(tid * 16 + i * 8192, R, C); const int Rb = Epi::PERM ? ((R & ~31) + perm32(R & 31)) : R;
        RA[i] = R; CA[i] = C; voffB[i] = (unsigned)(Rb * g.ldb * ES + C * 2); voffA[i] = (unsigned)(R * g.lda * ES + C * 2); }
    const size_t hstepA = GATHER ? 0 : (size_t)HALF * g.lda * ES;
    const size_t kstep = (size_t)(BK * 2);
    const size_t hstepB = (size_t)HALF * g.ldb * ES;
    const unsigned ldsw = (unsigned)wid * 1024u;
    const int aoff = lds_byte(wr * 64 + fr, fq * 8), boff = lds_byte(wc * 32 + fr, fq * 8);
#define PG8_SA(b, h) (((b) * 2 + (h)) * HTB)
#define PG8_SB(b, h) ((4 + (b) * 2 + (h)) * HTB)
#define PG8_STAGE(bufoff, gbase, voff) do { _Pragma("unroll") for (int _i = 0; _i < 2; ++_i) \
        __builtin_amdgcn_global_load_lds((const unsigned*)((const char*)(gbase) + (voff)[_i]), (LAS unsigned*)(lds + (bufoff) + ldsw + _i * 8192), 16, 0, 0); } while (0)
#define PG8_LDA(dst, b, h) do { _Pragma("unroll") for (int m = 0; m < 4; ++m) _Pragma("unroll") for (int k = 0; k < 2; ++k) dst[m][k] = *(const LAS bf16x8*)(lds + PG8_SA(b, h) + aoff + m * 2048 + k * 1024); } while (0)
#define PG8_LDB(dst, b, h) do { _Pragma("unroll") for (int n = 0; n < 2; ++n) _Pragma("unroll") for (int k = 0; k < 2; ++k) dst[n][k] = *(const LAS bf16x8*)(lds + PG8_SB(b, h) + boff + n * 2048 + k * 1024); } while (0)
#define PG8_CAT8(x) __builtin_shufflevector(__builtin_bit_cast(v4i_t, (x)[0]), __builtin_bit_cast(v4i_t, (x)[1]), 0, 1, 2, 3, 4, 5, 6, 7)
#define PG8_MMA(ai, bj, At, Bt) do { __builtin_amdgcn_s_setprio(1); if constexpr (FP8) { _Pragma("unroll") for (int m = 0; m < 4; ++m) _Pragma("unroll") for (int n = 0; n < 2; ++n) \
        acc[ai][bj][m][n] = __builtin_amdgcn_mfma_scale_f32_16x16x128_f8f6f4(PG8_CAT8(Bt[n]), PG8_CAT8(At[m]), acc[ai][bj][m][n], 0, 0, 0, 0x7f7f7f7f, 0, 0x7f7f7f7f); \
        _Pragma("unroll") for (int m = 0; m < 4; ++m) _Pragma("unroll") for (int n = 0; n < 2; ++n) asm volatile("" : "+v"(acc[ai][bj][m][n]));   } else { \
        _Pragma("unroll") for (int m = 0; m < 4; ++m) _Pragma("unroll") for (int n = 0; n < 2; ++n) _Pragma("unroll") for (int k = 0; k < 2; ++k) \
        acc[ai][bj][m][n] = __builtin_amdgcn_mfma_f32_16x16x32_bf16(Bt[n][k], At[m][k], acc[ai][bj][m][n], 0, 0, 0); } __builtin_amdgcn_s_setprio(0); } while (0)
#define PG8_WAIT_V(n) asm volatile("s_waitcnt vmcnt(" #n ")" ::: "memory")
#define PG8_WAIT_L(n) asm volatile("s_waitcnt lgkmcnt(" #n ")" ::: "memory")
#define PG8_BAR __builtin_amdgcn_s_barrier()
#define PG8_SCHED __builtin_amdgcn_sched_barrier(0)
#define PG8_SETVO(vo, u) do { if constexpr (GATHER) { _Pragma("unroll") for (int _h = 0; _h < 2; ++_h) _Pragma("unroll") for (int _i = 0; _i < 2; ++_i) { \
        const int _row = g.rowidx[(u).pm * BM + _h * HALF + RA[_i]]; (vo)[_h][_i] = (unsigned)_row * (unsigned)(g.lda * ES) + (unsigned)CA[_i] * 2u; } } } while (0)
#define PG8_STAGE_A(bufoff, base, h, vog) do { if constexpr (GATHER) { PG8_STAGE(bufoff, base, (vog)[h]); } else { PG8_STAGE(bufoff, (base) + (h) * hstepA, voffA); } } while (0)
    Unit cur, nxt; int ui = 0;
    if (!S.next(0, cur)) return;
    Acc acc;
#pragma unroll
    for (int a = 0; a < 2; ++a)
#pragma unroll
        for (int b = 0; b < 2; ++b)
#pragma unroll
            for (int m = 0; m < 4; ++m)
#pragma unroll
                for (int n = 0; n < 2; ++n) acc[a][b][m][n] = (f32x4){0.f, 0.f, 0.f, 0.f};
    bf16x8 At[4][2], B0[2][2], B1[2][2];
    unsigned voC[2][2], voN[2][2];
    PG8_SETVO(voC, cur);
    const char* const Ab = (const char*)g.A;
    const char* cA = GATHER ? Ab : Ab + (size_t)cur.pm * 2 * hstepA;
    const char* cB = (const char*)g.Bt + (size_t)cur.e * g.bstride + (size_t)cur.pn * 2 * hstepB;
    PG8_STAGE(PG8_SB(0, 0), cB, voffB); PG8_STAGE(PG8_SB(0, 1), cB + hstepB, voffB); PG8_STAGE_A(PG8_SA(0, 0), cA, 0, voC); PG8_STAGE_A(PG8_SA(0, 1), cA, 1, voC);
    if (wr == 1) PG8_BAR;
    PG8_WAIT_V(2); PG8_BAR;
    PG8_STAGE(PG8_SB(1, 0), cB + kstep, voffB); PG8_STAGE_A(PG8_SA(1, 0), cA + kstep, 0, voC); PG8_STAGE(PG8_SB(1, 1), cB + hstepB + kstep, voffB);
    PG8_WAIT_V(6); PG8_BAR;
    for (;;) {
        const bool has_next = S.next(ui + 1, nxt);
        const char* nB = has_next ? (const char*)g.Bt + (size_t)nxt.e * g.bstride + (size_t)nxt.pn * 2 * hstepB : cB;
        const char* nA = (has_next && !GATHER) ? Ab + (size_t)nxt.pm * 2 * hstepA : cA;
        if constexpr (GATHER) { if (has_next) { PG8_SETVO(voN, nxt); } else {
#pragma unroll
            for (int h = 0; h < 2; ++h)
#pragma unroll
                for (int i = 0; i < 2; ++i) voN[h][i] = voC[h][i]; } }
        for (int t = 0; t < nt; t += 2) {
            const bool last = (t == nt - 2);
            if constexpr (Epi::MIDK > 0) { if (t == Epi::MIDK) { const int l2 = lane_id(); E.mid(acc, cur, wr, wc, l2 & 15, l2 >> 4); } }
            const char* a1 = cA + (size_t)(t + 1) * kstep;
            const char* a2 = last ? nA : cA + (size_t)(t + 2) * kstep; const char* b2 = last ? nB : cB + (size_t)(t + 2) * kstep;
            const char* a3 = a2 + kstep; const char* b3 = b2 + kstep;
            unsigned o2[2][2];
            if constexpr (GATHER) {
#pragma unroll
            for (int h = 0; h < 2; ++h)
#pragma unroll
                for (int i = 0; i < 2; ++i) o2[h][i] = last ? voN[h][i] : voC[h][i]; }
            PG8_LDB(B0, 0, 0); PG8_LDB(B1, 0, 1); PG8_SCHED; PG8_LDA(At, 0, 0); PG8_STAGE_A(PG8_SA(1, 1), a1, 1, voC);
            PG8_WAIT_V(8); PG8_WAIT_L(0); PG8_BAR; PG8_MMA(0, 0, At, B0); PG8_MMA(0, 1, At, B1); PG8_BAR; PG8_SCHED;
            PG8_LDA(At, 0, 1); PG8_STAGE(PG8_SB(0, 0), b2, voffB); PG8_STAGE(PG8_SB(0, 1), b2 + hstepB, voffB); PG8_STAGE_A(PG8_SA(0, 0), a2, 0, o2);
            PG8_WAIT_V(8); PG8_WAIT_L(0); PG8_BAR; PG8_MMA(1, 0, At, B0); PG8_MMA(1, 1, At, B1); PG8_BAR; PG8_SCHED;
            PG8_LDB(B0, 1, 0); PG8_LDB(B1, 1, 1); PG8_SCHED; PG8_LDA(At, 1, 0); PG8_STAGE_A(PG8_SA(0, 1), a2, 1, o2);
            PG8_WAIT_V(8); PG8_WAIT_L(0); PG8_BAR; PG8_MMA(0, 0, At, B0); PG8_MMA(0, 1, At, B1); PG8_BAR; PG8_SCHED;
            PG8_LDA(At, 1, 1); PG8_STAGE(PG8_SB(1, 0), b3, voffB); PG8_STAGE(PG8_SB(1, 1), b3 + hstepB, voffB); PG8_STAGE_A(PG8_SA(1, 0), a3, 0, o2);
            PG8_WAIT_V(8); PG8_WAIT_L(0); PG8_BAR; PG8_MMA(1, 0, At, B0); PG8_MMA(1, 1, At, B1); PG8_BAR; PG8_SCHED;
        }
        if (wr == 0) PG8_BAR;
        if (do_epi) { const int l2 = lane_id(); E(acc, cur, wr, wc, l2 & 15, l2 >> 4); }
        if (!has_next) break;
#pragma unroll
        for (int a = 0; a < 2; ++a)
#pragma unroll
            for (int b = 0; b < 2; ++b)
#pragma unroll
                for (int m = 0; m < 4; ++m)
#pragma unroll
                    for (int n = 0; n < 2; ++n) acc[a][b][m][n] = (f32x4){0.f, 0.f, 0.f, 0.f};
        cur = nxt; cB = nB; cA = nA; ++ui;
        if constexpr (GATHER) {
#pragma unroll
        for (int h = 0; h < 2; ++h)
#pragma unroll
            for (int i = 0; i < 2; ++i) voC[h][i] = voN[h][i]; }
        if (wr == 1) PG8_BAR;
    }
    PG8_WAIT_V(0);
    PG8_BAR;
#undef PG8_SA
#undef PG8_SB
#undef PG8_STAGE
#undef PG8_LDA
#undef PG8_LDB
#undef PG8_MMA
#undef PG8_CAT8
#undef PG8_WAIT_V
#undef PG8_WAIT_L
#undef PG8_BAR
#undef PG8_SCHED
#undef PG8_SETVO
#undef PG8_STAGE_A
}

__device__ __forceinline__ unsigned pk4_fp8(f32x4 v) { unsigned w = 0; w = __builtin_amdgcn_cvt_pk_fp8_f32(v[0], v[1], w, false); w = __builtin_amdgcn_cvt_pk_fp8_f32(v[2], v[3], w, true); return w; }
__device__ __forceinline__ float sq4(f32x4 v) { return (v[0] * v[0] + v[1] * v[1]) + (v[2] * v[2] + v[3] * v[3]); }
__device__ __forceinline__ float red_fq(float s) { s += __shfl_xor(s, 16); s += __shfl_xor(s, 32); return s; }
__device__ __forceinline__ u32x4 pack8(f32x4 a, f32x4 b) { u32x4 w; w.x = cvt_pk_bf16(a[0], a[1]); w.y = cvt_pk_bf16(a[2], a[3]); w.z = cvt_pk_bf16(b[0], b[1]); w.w = cvt_pk_bf16(b[2], b[3]); return w; }
template <int MODE> struct EpiBf16Stats {
    static constexpr bool PERM = true; static constexpr int MIDK = 0;
    bf16_t* O; int ldc; float* ssq; const float* rsx;
    __device__ __forceinline__ void operator()(const Acc& acc, const Unit& u, int wr, int wc, int fr, int fq) const {
        const int row0 = u.pm * BM + wr * 64 + fr, col0 = u.pn * BM + wc * 32 + 8 * fq;
        float rv[2][4];
#pragma unroll
        for (int ai = 0; ai < 2; ++ai)
#pragma unroll
            for (int m = 0; m < 4; ++m) rv[ai][m] = rsx ? rsx[row0 + ai * HALF + m * 16] : 1.f;
        asm volatile("" ::: "memory");
#pragma unroll
        for (int ai = 0; ai < 2; ++ai)
#pragma unroll
            for (int m = 0; m < 4; ++m) { const int row = row0 + ai * HALF + m * 16; bf16_t* rowp = O + (size_t)row * ldc + col0; const float rs = rv[ai][m];
                const f32x4 a00 = acc[ai][0][m][0] * rs, a01 = acc[ai][0][m][1] * rs, a10 = acc[ai][1][m][0] * rs, a11 = acc[ai][1][m][1] * rs;
                if (MODE == 0 && u.pn >= 4) { *(u32x4*)(O + (size_t)row * ldc + 960 + (u.pn - 4) * HALF + wc * 32 + 8 * fq) = pack8(a00 * a10, a01 * a11); continue; }
                *(u32x4*)(rowp) = pack8(a00, a01); if (!(MODE == 0 && u.pn == 3 && wc >= 2)) *(u32x4*)(rowp + HALF) = pack8(a10, a11);
                if (MODE == 1) { float s = (sq4(a00) + sq4(a01)) + (sq4(a10) + sq4(a11)); s = red_fq(s); if (fq == 0) ssq[(size_t)row * 16 + u.pn * 4 + wc] = s; }
                else if (u.pn == 0) { float s = (sq4(a00) + sq4(a01)) + (sq4(a10) + sq4(a11)); s = red_fq(s); if (fq == 0) ssq[(size_t)row * 8 + wc] = s; }
                else if (u.pn == 1) { float s = sq4(a00) + sq4(a01); s = red_fq(s); if (fq == 0) ssq[(size_t)row * 8 + 4 + wc] = s; } }
    }
};
struct EpiQ {
    static constexpr bool PERM = true; static constexpr int MIDK = 0;
    bf16_t* Q; const float* ssq; const float* cs;
    __device__ __forceinline__ void operator()(const Acc& acc, const Unit& u, int wr, int wc, int fr, int fq) const {
        const int row0 = u.pm * BM + wr * 64 + fr;
#pragma unroll
        for (int ai = 0; ai < 2; ++ai)
#pragma unroll
            for (int m = 0; m < 4; ++m) { const int row = row0 + ai * HALF + m * 16; const f32x4 sv = *(const f32x4*)(ssq + (size_t)row * 8);
                const float rs = rsqrtf(((sv[0] + sv[1]) + (sv[2] + sv[3])) * (1.f / QL) + EPS); const int b = row / SEQ, s = row % SEQ;
#pragma unroll
                for (int bj = 0; bj < 2; ++bj) { const int cv = u.pn * BM + bj * HALF + wc * 32 + 8 * fq; const int h = cv / DQK, d = cv % DQK;
                    f32x4 v0 = acc[ai][bj][m][0] * rs, v1 = acc[ai][bj][m][1] * rs;
                    if (d >= DN) { const int i0 = (d - DN) >> 1; const f32x4 c = *(const f32x4*)(cs + (size_t)row * 64 + i0), sn = *(const f32x4*)(cs + (size_t)row * 64 + 32 + i0);
                        const f32x4 r0 = {v0[0] * c[0] - v0[1] * sn[0], v0[0] * sn[0] + v0[1] * c[0], v0[2] * c[1] - v0[3] * sn[1], v0[2] * sn[1] + v0[3] * c[1]};
                        const f32x4 r1 = {v1[0] * c[2] - v1[1] * sn[2], v1[0] * sn[2] + v1[1] * c[2], v1[2] * c[3] - v1[3] * sn[3], v1[2] * sn[3] + v1[3] * c[3]};
                        v0 = r0; v1 = r1; }
                    *(u32x4*)(Q + ((size_t)(b * NH + h) * SEQ + s) * DQK + d) = pack8(v0, v1); } }
    }
};
struct EpiKV {
    static constexpr bool PERM = true; static constexpr int MIDK = 0;
    bf16_t* Kc; bf16_t* Vc; const float* ssq;
    __device__ __forceinline__ void operator()(const Acc& acc, const Unit& u, int wr, int wc, int fr, int fq) const {
        const int row0 = u.pm * BM + wr * 64 + fr, d = wc * 32 + 8 * fq, h = u.pn;
#pragma unroll
        for (int ai = 0; ai < 2; ++ai)
#pragma unroll
            for (int m = 0; m < 4; ++m) { const int row = row0 + ai * HALF + m * 16; const f32x4 sv = *(const f32x4*)(ssq + (size_t)row * 8 + 4);
                const float rs = rsqrtf(((sv[0] + sv[1]) + (sv[2] + sv[3])) * (1.f / KVL) + EPS); const int b = row / SEQ, s = row % SEQ; const size_t t = (size_t)(b * NH + h) * SEQ + s;
                *(u32x4*)(Kc + t * DQK + d) = pack8(acc[ai][0][m][0] * rs, acc[ai][0][m][1] * rs);
                *(u32x4*)(Vc + t * DV + d) = pack8(acc[ai][1][m][0] * rs, acc[ai][1][m][1] * rs); }
    }
};
struct EpiWo {
    static constexpr bool PERM = true; static constexpr int MIDK = 8;
    const bf16_t* x; bf16_t* HBF; unsigned char* X8; const float* assq; float* ssq1; const float* gmoe;
    __device__ __forceinline__ void mid(Acc& acc, const Unit& u, int wr, int wc, int fr, int fq) const {
        const int row0 = u.pm * BM + wr * 64 + fr;
#pragma unroll
        for (int ai = 0; ai < 2; ++ai)
#pragma unroll
            for (int m = 0; m < 4; ++m) { const f32x4 sv = *(const f32x4*)(assq + (size_t)(row0 + ai * HALF + m * 16) * 4);
                const float rs = rsqrtf(((sv[0] + sv[1]) + (sv[2] + sv[3])) * (1.f / 512.f) + EPS);
#pragma unroll
                for (int bj = 0; bj < 2; ++bj)
#pragma unroll
                    for (int n = 0; n < 2; ++n) acc[ai][bj][m][n] = acc[ai][bj][m][n] * rs; }
    }
    __device__ __forceinline__ void operator()(const Acc& acc, const Unit& u, int wr, int wc, int fr, int fq) const {
        const int row0 = u.pm * BM + wr * 64 + fr, col0 = u.pn * BM + wc * 32 + 8 * fq;
        f32x4 gn[2][2];
#pragma unroll
        for (int bj = 0; bj < 2; ++bj) { gn[bj][0] = *(const f32x4*)(gmoe + col0 + bj * HALF); gn[bj][1] = *(const f32x4*)(gmoe + col0 + bj * HALF + 4); }
#pragma unroll
        for (int ai = 0; ai < 2; ++ai) { u32x4 xv[4][2];
#pragma unroll
            for (int m = 0; m < 4; ++m) { const size_t off = (size_t)(row0 + ai * HALF + m * 16) * DM + col0;
#pragma unroll
                for (int bj = 0; bj < 2; ++bj) xv[m][bj] = *(const u32x4*)(x + off + bj * HALF); }
            asm volatile("" ::: "memory");
#pragma unroll
            for (int m = 0; m < 4; ++m) { const int row = row0 + ai * HALF + m * 16; const size_t off = (size_t)row * DM + col0; float ss = 0.f;
#pragma unroll
                for (int bj = 0; bj < 2; ++bj) { const u32x4 xq = xv[m][bj]; const f32x4 h0 = (f32x4){blo(xq.x), bhi(xq.x), blo(xq.y), bhi(xq.y)} + acc[ai][bj][m][0], h1 = (f32x4){blo(xq.z), bhi(xq.z), blo(xq.w), bhi(xq.w)} + acc[ai][bj][m][1];
                    *(u32x4*)(HBF + off + bj * HALF) = pack8(h0, h1); *(u32x2*)(X8 + off + bj * HALF) = (u32x2){pk4_fp8(h0 * gn[bj][0]), pk4_fp8(h1 * gn[bj][1])}; ss += sq4(h0) + sq4(h1); }
                ss = red_fq(ss); if (fq == 0) ssq1[(size_t)row * 16 + u.pn * 4 + wc] = ss; }
            asm volatile("" ::: "memory"); }
    }
};
__device__ __forceinline__ f32x4 sigmoid4(f32x4 a) { const f32x4 t = a * -1.44269504f; f32x4 e; e[0] = __builtin_amdgcn_exp2f(t[0]); e[1] = __builtin_amdgcn_exp2f(t[1]); e[2] = __builtin_amdgcn_exp2f(t[2]); e[3] = __builtin_amdgcn_exp2f(t[3]);
    const f32x4 d = e + 1.0f; f32x4 r; r[0] = __builtin_amdgcn_rcpf(d[0]); r[1] = __builtin_amdgcn_rcpf(d[1]); r[2] = __builtin_amdgcn_rcpf(d[2]); r[3] = __builtin_amdgcn_rcpf(d[3]); return r; }
__device__ __forceinline__ f32x2 swiglu2(f32x2 g, f32x2 u) {
    g.x = fminf(g.x, 7.f); g.y = fminf(g.y, 7.f); u.x = __builtin_amdgcn_fmed3f(u.x, -7.f, 7.f); u.y = __builtin_amdgcn_fmed3f(u.y, -7.f, 7.f);
    const f32x2 t = g * -2.45546696f; f32x2 e; e.x = __builtin_amdgcn_exp2f(t.x); e.y = __builtin_amdgcn_exp2f(t.y); const f32x2 d = e + 1.0f; f32x2 r; r.x = __builtin_amdgcn_rcpf(d.x); r.y = __builtin_amdgcn_rcpf(d.y);
    const f32x2 gs = g * r; return u * gs + gs; }
__device__ __forceinline__ float swiglu_f(float g, float u) { g = fminf(g, 7.f); u = __builtin_amdgcn_fmed3f(u, -7.f, 7.f); const float gs = g * __builtin_amdgcn_rcpf(1.f + __builtin_amdgcn_exp2f(g * -2.45546696f)); return fmaf(u, gs, gs); }
constexpr float WSCALE = 64.f, WINV = 1.f / 64.f;
struct EpiMoe1 {
    static constexpr bool PERM = true; static constexpr int MIDK = 0;
    unsigned char* HB; const float* b1; const float* rowrs;
    __device__ __forceinline__ void operator()(const Acc& acc, const Unit& u, int wr, int wc, int fr, int fq) const {
        const int row0 = u.pm * BM + wr * 64 + fr, j0 = u.pn * HALF + wc * 32 + 8 * fq; const float* bg = b1 + (size_t)u.e * 2048 + j0;
        const f32x4 g0 = *(const f32x4*)bg, g1 = *(const f32x4*)(bg + 4), u0 = *(const f32x4*)(bg + 1024), u1 = *(const f32x4*)(bg + 1028);
        float rsv[2][4];
#pragma unroll
        for (int ai = 0; ai < 2; ++ai)
#pragma unroll
            for (int m = 0; m < 4; ++m) rsv[ai][m] = rowrs[row0 + ai * HALF + m * 16];
        asm volatile("" ::: "memory");
#pragma unroll
        for (int ai = 0; ai < 2; ++ai)
#pragma unroll
            for (int m = 0; m < 4; ++m) { const float rs = rsv[ai][m] * WINV;
                const f32x4 a0 = acc[ai][0][m][0] * rs + g0, a1 = acc[ai][0][m][1] * rs + g1, c0 = acc[ai][1][m][0] * rs + u0, c1 = acc[ai][1][m][1] * rs + u1; f32x4 r0, r1;
#pragma unroll
                for (int j = 0; j < 4; j += 2) { const f32x2 s0 = swiglu2((f32x2){a0[j], a0[j + 1]}, (f32x2){c0[j], c0[j + 1]}), s1 = swiglu2((f32x2){a1[j], a1[j + 1]}, (f32x2){c1[j], c1[j + 1]}); r0[j] = s0.x; r0[j + 1] = s0.y; r1[j] = s1.x; r1[j + 1] = s1.y; }
                *(u32x2*)(HB + (size_t)(row0 + ai * HALF + m * 16) * DE + j0) = (u32x2){pk4_fp8(r0), pk4_fp8(r1)}; }
    }
};
struct EpiMoe2 {
    static constexpr bool PERM = true; static constexpr int MIDK = 0;
    unsigned char* Y; const float* b2; const int* rowslot; const float* rowgate;
    __device__ __forceinline__ void operator()(const Acc& acc, const Unit& u, int wr, int wc, int fr, int fq) const {
        const int row0 = u.pm * BM + wr * 64 + fr, col0 = u.pn * BM + wc * 64 + 16 * fq; const float* bb = b2 + (size_t)u.e * DM + col0;
        f32x4 bv[2][2];
#pragma unroll
        for (int bj = 0; bj < 2; ++bj)
#pragma unroll
            for (int n = 0; n < 2; ++n) bv[bj][n] = *(const f32x4*)(bb + bj * 8 + 4 * n);
        float gtv[2][4]; int slv[2][4];
#pragma unroll
        for (int ai = 0; ai < 2; ++ai)
#pragma unroll
            for (int m = 0; m < 4; ++m) { const int r = row0 + ai * HALF + m * 16; gtv[ai][m] = rowgate[r]; slv[ai][m] = rowslot[r]; }
        asm volatile("" ::: "memory");
#pragma unroll
        for (int ai = 0; ai < 2; ++ai)
#pragma unroll
            for (int m = 0; m < 4; ++m) { const float gt = gtv[ai][m]; unsigned char* yp = Y + (size_t)slv[ai][m] * DM + col0;
                *(u32x4*)yp = (u32x4){pk4_fp8((acc[ai][0][m][0] * WINV + bv[0][0]) * gt), pk4_fp8((acc[ai][0][m][1] * WINV + bv[0][1]) * gt), pk4_fp8((acc[ai][1][m][0] * WINV + bv[1][0]) * gt), pk4_fp8((acc[ai][1][m][1] * WINV + bv[1][1]) * gt)}; }
    }
};
struct EpiPle {
    static constexpr bool PERM = true; static constexpr int MIDK = 0;
    const bf16_t* H2; bf16_t* H3; const bf16_t* pler; const float* rpv; const float* rs2; const float* pg; float* fssq;
    __device__ __forceinline__ void operator()(const Acc& acc, const Unit& u, int wr, int wc, int fr, int fq) const {
        const int row0 = u.pm * BM + wr * 64 + fr, col0 = u.pn * BM + wc * 32 + 8 * fq;
        f32x4 gv[2][2];
#pragma unroll
        for (int bj = 0; bj < 2; ++bj)
#pragma unroll
            for (int n = 0; n < 2; ++n) gv[bj][n] = *(const f32x4*)(pg + col0 + bj * HALF + n * 4);
#pragma unroll
        for (int am = 0; am < 4; ++am) { const int ai = am >> 1; u32x4 hq[2][2], pq[2][2]; float r2v[2], rpq[2];
#pragma unroll
            for (int mm = 0; mm < 2; ++mm) { const int row = row0 + ai * HALF + ((am & 1) * 2 + mm) * 16; const size_t off = (size_t)row * DM + col0; r2v[mm] = rs2[row]; rpq[mm] = rpv[row];
#pragma unroll
                for (int bj = 0; bj < 2; ++bj) { hq[mm][bj] = *(const u32x4*)(H2 + off + bj * HALF); pq[mm][bj] = *(const u32x4*)(pler + off + bj * HALF); } }
            asm volatile("" ::: "memory");
#pragma unroll
            for (int mm = 0; mm < 2; ++mm) { const int m = (am & 1) * 2 + mm; const int row = row0 + ai * HALF + m * 16; const size_t off = (size_t)row * DM + col0; const float r2 = r2v[mm], rp = rpq[mm]; float ss = 0.f;
#pragma unroll
                for (int bj = 0; bj < 2; ++bj) { const size_t o = off + bj * HALF; const u32x4 hv = hq[mm][bj], pr = pq[mm][bj];
                    const f32x4 h0 = {blo(hv.x), bhi(hv.x), blo(hv.y), bhi(hv.y)}, h1 = {blo(hv.z), bhi(hv.z), blo(hv.w), bhi(hv.w)};
                    const f32x4 q0 = {blo(pr.x), bhi(pr.x), blo(pr.y), bhi(pr.y)}, q1 = {blo(pr.z), bhi(pr.z), blo(pr.w), bhi(pr.w)};
                    const f32x4 r0 = h0 + sigmoid4(acc[ai][bj][m][0] * r2) * (q0 * (gv[bj][0] * rp)), r1 = h1 + sigmoid4(acc[ai][bj][m][1] * r2) * (q1 * (gv[bj][1] * rp));
                    *(u32x4*)(H3 + o) = pack8(r0, r1); ss += sq4(r0) + sq4(r1); }
                ss = red_fq(ss); if (fq == 0) fssq[(size_t)row * 16 + u.pn * 4 + wc] = ss; }
            asm volatile("" ::: "memory"); }
    }
};
struct EpiPleFinal {
    static constexpr bool PERM = true; static constexpr int MIDK = 0;
    const bf16_t* H2; float* out; const bf16_t* pler; const float* rpv; const float* rs2; const float* pg; const float* gf; float* xs; unsigned* cnt; unsigned* tmo; LAS unsigned char* lds;
    __device__ __forceinline__ void operator()(Acc& acc, const Unit& u, int wr, int wc, int fr, int fq) const {
        const int row0 = u.pm * BM + wr * 64 + fr, col0 = u.pn * BM + wc * 32 + 8 * fq;
        LAS float* P = (LAS float*)(lds + STG_OFF); LAS float* S = P + 1024; const int tid = (wr * 4 + wc) * 64 + fq * 16 + fr;
#define PF_BAR() asm volatile("s_waitcnt lgkmcnt(0)\n\ts_barrier" ::: "memory")
        { f32x4 gv[2][2];
#pragma unroll
          for (int bj = 0; bj < 2; ++bj)
#pragma unroll
            for (int n = 0; n < 2; ++n) gv[bj][n] = *(const f32x4*)(pg + col0 + bj * HALF + n * 4);
#pragma unroll
          for (int am = 0; am < 4; ++am) { const int ai = am >> 1; u32x4 hq[2][2], pq[2][2]; float r2v[2], rpq[2];
#pragma unroll
            for (int mm = 0; mm < 2; ++mm) { const int row = row0 + ai * HALF + ((am & 1) * 2 + mm) * 16; const size_t off = (size_t)row * DM + col0; r2v[mm] = rs2[row]; rpq[mm] = rpv[row];
#pragma unroll
                for (int bj = 0; bj < 2; ++bj) { hq[mm][bj] = *(const u32x4*)(H2 + off + bj * HALF); pq[mm][bj] = *(const u32x4*)(pler + off + bj * HALF); } }
            asm volatile("" ::: "memory");
#pragma unroll
            for (int mm = 0; mm < 2; ++mm) { const int m = (am & 1) * 2 + mm; const float r2 = r2v[mm], rp = rpq[mm]; float ss = 0.f;
#pragma unroll
                for (int bj = 0; bj < 2; ++bj) { const u32x4 hv = hq[mm][bj], pr = pq[mm][bj];
                    const f32x4 h0 = {blo(hv.x), bhi(hv.x), blo(hv.y), bhi(hv.y)}, h1 = {blo(hv.z), bhi(hv.z), blo(hv.w), bhi(hv.w)};
                    const f32x4 q0 = {blo(pr.x), bhi(pr.x), blo(pr.y), bhi(pr.y)}, q1 = {blo(pr.z), bhi(pr.z), blo(pr.w), bhi(pr.w)};
                    const f32x4 r0 = h0 + sigmoid4(acc[ai][bj][m][0] * r2) * (q0 * (gv[bj][0] * rp)), r1 = h1 + sigmoid4(acc[ai][bj][m][1] * r2) * (q1 * (gv[bj][1] * rp));
                    acc[ai][bj][m][0] = r0; acc[ai][bj][m][1] = r1; ss += sq4(r0) + sq4(r1); }
                ss = red_fq(ss); if (fq == 0) P[(ai * HALF + wr * 64 + m * 16 + fr) * 4 + wc] = ss; }
            asm volatile("" ::: "memory"); } }
        PF_BAR();
        if (tid < 256) { const f32x4 p4 = *(const LAS f32x4*)(P + tid * 4); __hip_atomic_store(xs + (size_t)(u.pm * 4 + u.pn) * 256 + tid, (p4[0] + p4[1]) + (p4[2] + p4[3]), __ATOMIC_RELAXED, __HIP_MEMORY_SCOPE_AGENT); }
        asm volatile("s_waitcnt vmcnt(0)" ::: "memory");
        PF_BAR();
        if (tid < 64) {
            if (tid == 0) (void)__hip_atomic_fetch_add(cnt + 64 * u.pm, 1u, __ATOMIC_RELAXED, __HIP_MEMORY_SCOPE_AGENT);
            unsigned sp = 0;
            while ((unsigned)__builtin_amdgcn_readfirstlane(__hip_atomic_load(cnt + 64 * u.pm, __ATOMIC_RELAXED, __HIP_MEMORY_SCOPE_AGENT)) < 4u) {
                __builtin_amdgcn_s_sleep(2); if (++sp > (1u << 22)) { if (tid == 0) __hip_atomic_store(tmo, 1u, __ATOMIC_RELAXED, __HIP_MEMORY_SCOPE_AGENT); break; } }
            __builtin_amdgcn_fence(__ATOMIC_ACQUIRE, "agent");
            asm volatile("s_waitcnt vmcnt(0)" ::: "memory"); }
        PF_BAR();
        if (tid < 256) { float t = 0.f;
#pragma unroll
            for (int q = 0; q < 4; ++q) t += __hip_atomic_load(xs + (size_t)(u.pm * 4 + q) * 256 + tid, __ATOMIC_RELAXED, __HIP_MEMORY_SCOPE_AGENT);
            S[tid] = rsqrtf(t * (1.f / DM) + EPS); }
        PF_BAR();
        { f32x4 gq[2][2];
#pragma unroll
          for (int bj = 0; bj < 2; ++bj)
#pragma unroll
            for (int n = 0; n < 2; ++n) gq[bj][n] = *(const f32x4*)(gf + col0 + bj * HALF + n * 4);
#pragma unroll
          for (int ai = 0; ai < 2; ++ai)
#pragma unroll
            for (int m = 0; m < 4; ++m) { const float rs = S[ai * HALF + wr * 64 + m * 16 + fr]; float* op = out + (size_t)(row0 + ai * HALF + m * 16) * DM + col0;
#pragma unroll
                for (int bj = 0; bj < 2; ++bj) { *(f32x4*)(op + bj * HALF) = acc[ai][bj][m][0] * rs * gq[bj][0]; *(f32x4*)(op + bj * HALF + 4) = acc[ai][bj][m][1] * rs * gq[bj][1]; } } }
        PF_BAR();
#undef PF_BAR
    }
};
}

namespace att {
typedef float f32x16 __attribute__((ext_vector_type(16)));
typedef short s16x4 __attribute__((ext_vector_type(4)));
constexpr int QBLK = 32, KVBLK = 64, QB = 256;
constexpr int SHM_K = KVBLK * DQK * 2, SHM_V = KVBLK * DV * 2;
constexpr int L_V = 0, L_K = 2 * SHM_V, L_WS = L_K + 2 * SHM_K, L_END = L_WS + NWAVES * 256;
constexpr float THR = 8.f;
#define KSWZ(row, colB) ((row) * 384 + ((colB) ^ (((row) & 7) << 4)))
#define SBAR() __builtin_amdgcn_sched_barrier(0)
__device__ __forceinline__ int v_st(int k, int c) { const int kk = (k & ~0xC) | ((k & 4) << 1) | ((k & 8) >> 1); return ((kk >> 3) * 4 + (c >> 5)) * 512 + ((kk & 7) * 32 + (c & 31)) * 2; }
__device__ __forceinline__ int v_rd_base(int lane) { return ((lane & 3) << 3) | (((lane >> 2) & 3) << 6) | (((lane >> 4) & 1) << 5) | (((lane >> 5) & 1) << 8); }
constexpr int v_rd_off(int d0, int ks, int half) { return d0 * 512 + ks * 4096 + half * 2048; }
__device__ __forceinline__ int crow(int r, int hi) { return (r & 3) + 8 * (r >> 2) + 4 * hi; }
typedef __bf16 bf16x2_t __attribute__((ext_vector_type(2)));
__device__ __forceinline__ unsigned cvtpk(float lo, float hi) { f32x2 v = {lo, hi}; bf16x2_t b = __builtin_convertvector(v, bf16x2_t); return __builtin_bit_cast(unsigned, b); }

__device__ __forceinline__ void qkt(f32x16& p0, f32x16& p1, const LAS unsigned char* Kbuf, int r32, int hi, const bf16x8* qr) {
    p0 = f32x16{}; p1 = f32x16{};
    const LAS unsigned char* kb[4];
#pragma unroll
    for (int dd = 0; dd < 4; ++dd) kb[dd] = Kbuf + KSWZ(r32, (dd * 16 + hi * 8) * 2);
    bf16x8 kf[2][2];
#define KLD(d) do { const LAS unsigned char* a = kb[(d) & 3] + ((d) >> 2) * 128; kf[(d) & 1][0] = *(const LAS bf16x8*)a; kf[(d) & 1][1] = *(const LAS bf16x8*)(a + 32 * 384); } while (0)
    KLD(0);
#pragma unroll
    for (int d0 = 0; d0 < 12; ++d0) { if (d0 + 1 < 12) KLD(d0 + 1);
        p0 = __builtin_amdgcn_mfma_f32_32x32x16_bf16(kf[d0 & 1][0], qr[d0], p0, 0, 0, 0);
        p1 = __builtin_amdgcn_mfma_f32_32x32x16_bf16(kf[d0 & 1][1], qr[d0], p1, 0, 0, 0); }
#undef KLD
    __builtin_amdgcn_sched_group_barrier(0x100, 2, 0);
#pragma unroll
    for (int d0 = 0; d0 < 11; ++d0) { __builtin_amdgcn_sched_group_barrier(0x100, 2, 0); __builtin_amdgcn_sched_group_barrier(0x008, 2, 0); }
    __builtin_amdgcn_sched_group_barrier(0x008, 2, 0);
}
__device__ __forceinline__ void pv_tile(f32x16* o, int vb0, bf16x8 pa0, bf16x8 pa1, bf16x8 pa2, bf16x8 pa3) {
#define TRRD(dst, off) asm volatile("ds_read_b64_tr_b16 %0, %1 offset:%2" : "=&v"(dst) : "v"(vb0), "i"(off) : "memory")
#define PV_RD(S_, d0) do { constexpr int b_ = v_rd_off(d0, 0, 0); \
        TRRD(S_[0], b_); TRRD(S_[1], b_ + 2048); TRRD(S_[2], b_ + 4096); TRRD(S_[3], b_ + 6144); TRRD(S_[4], b_ + 8192); TRRD(S_[5], b_ + 10240); TRRD(S_[6], b_ + 12288); TRRD(S_[7], b_ + 14336); } while (0)
#define PV_MM(S_, d0) do { \
        o[d0] = __builtin_amdgcn_mfma_f32_32x32x16_bf16(pa0, (bf16x8){S_[0][0], S_[0][1], S_[0][2], S_[0][3], S_[1][0], S_[1][1], S_[1][2], S_[1][3]}, o[d0], 0, 0, 0); \
        o[d0] = __builtin_amdgcn_mfma_f32_32x32x16_bf16(pa1, (bf16x8){S_[2][0], S_[2][1], S_[2][2], S_[2][3], S_[3][0], S_[3][1], S_[3][2], S_[3][3]}, o[d0], 0, 0, 0); \
        o[d0] = __builtin_amdgcn_mfma_f32_32x32x16_bf16(pa2, (bf16x8){S_[4][0], S_[4][1], S_[4][2], S_[4][3], S_[5][0], S_[5][1], S_[5][2], S_[5][3]}, o[d0], 0, 0, 0); \
        o[d0] = __builtin_amdgcn_mfma_f32_32x32x16_bf16(pa3, (bf16x8){S_[6][0], S_[6][1], S_[6][2], S_[6][3], S_[7][0], S_[7][1], S_[7][2], S_[7][3]}, o[d0], 0, 0, 0); } while (0)
    s16x4 A_[8], B_[8];
    PV_RD(A_, 0);
    PV_RD(B_, 1); asm volatile("s_waitcnt lgkmcnt(8)" ::: "memory"); SBAR(); PV_MM(A_, 0); SBAR();
    PV_RD(A_, 2); asm volatile("s_waitcnt lgkmcnt(8)" ::: "memory"); SBAR(); PV_MM(B_, 1); SBAR();
    PV_RD(B_, 3); asm volatile("s_waitcnt lgkmcnt(8)" ::: "memory"); SBAR(); PV_MM(A_, 2); SBAR();
    asm volatile("s_waitcnt lgkmcnt(0)" ::: "memory"); SBAR(); PV_MM(B_, 3);
#undef PV_RD
#undef PV_MM
#undef TRRD
}
struct ConvJob { const float* w1; const float* w2; const float* gain; unsigned char* W1T; unsigned char* W2T; int gw, ngw; };
constexpr int CV_N1 = NE * 32 * 64, CV_N2 = NE * 32 * 32, CV_TOTAL = CV_N1 + CV_N2;
__device__ __forceinline__ int cv_cmap2(int n) { const int t = n & ~255, v = n & 255; return t + 64 * ((v >> 5) & 3) + 16 * ((v >> 3) & 3) + 8 * (v >> 7) + (v & 7); }
__device__ __forceinline__ int cv_cmap1(int n) { const int pn = n >> 8, half = (n >> 7) & 1, jj = n & 127; return half * 1024 + pn * 128 + jj; }
#define CV_DECODE(idx) \
    const bool cv_on = (idx) < CV_TOTAL; const bool cv_is1 = (idx) < CV_N1; const int cv_r = cv_is1 ? (idx) : (idx) - CV_N1; \
    const int cv_nblk = cv_is1 ? 64 : 32, cv_ld = cv_is1 ? 2048 : 1024; const int cv_e = cv_r / (32 * cv_nblk), cv_q = cv_r % (32 * cv_nblk), cv_k0 = 32 * (cv_q / cv_nblk), cv_n0 = 32 * (cv_q % cv_nblk); \
    const float* cv_src = (cv_is1 ? cj.w1 + (size_t)cv_e * 1024 * 2048 : cj.w2 + (size_t)cv_e * 1024 * 1024); \
    const int cv_c = cv_is1 ? cv_cmap1(cv_n0 + 4 * (lane & 7)) : cv_cmap2(cv_n0 + 4 * (lane & 7));
#define CV_LOAD() do { if (cv_on) { const char* cvb = (const char*)(cv_src + (size_t)cv_k0 * cv_ld); const unsigned cvo = (unsigned)(((lane >> 3) * cv_ld + cv_c) * 4);     \
        LAS unsigned char* scrb = lds + L_END + wid * 4224;     \
        _Pragma("unroll") for (int i = 0; i < 4; ++i) __builtin_amdgcn_global_load_lds((const unsigned*)(cvb + (size_t)(8 * i) * cv_ld * 4 + cvo), (LAS unsigned*)(scrb + i * 1056), 16, 0, 0); } } while (0)
#define CV_SV(j) (s[(2 * cc + ((j) >> 3)) * 264 + ((j) & 7) * 32] * 64.f)
#define CV_STORE() do { if (cv_on) { const LAS float* scr = (const LAS float*)(lds + L_END + wid * 4224); \
        { const int n = lane >> 1, cc = lane & 1; const LAS float* s = scr + n; u32x4 o; \
          o.x = pg8::pk4_fp8((f32x4){CV_SV(0), CV_SV(1), CV_SV(2), CV_SV(3)}); o.y = pg8::pk4_fp8((f32x4){CV_SV(4), CV_SV(5), CV_SV(6), CV_SV(7)}); \
          o.z = pg8::pk4_fp8((f32x4){CV_SV(8), CV_SV(9), CV_SV(10), CV_SV(11)}); o.w = pg8::pk4_fp8((f32x4){CV_SV(12), CV_SV(13), CV_SV(14), CV_SV(15)}); \
          unsigned char* dst = (cv_is1 ? cj.W1T + (size_t)cv_e * 2048 * 1024 : cj.W2T + (size_t)cv_e * 1024 * 1024) + (size_t)(cv_n0 + n) * 1024 + cv_k0 + 16 * cc; *(u32x4*)dst = o; } \
        asm volatile("s_waitcnt lgkmcnt(0)" ::: "memory"); } } while (0)
__device__ __forceinline__ void attn_block(int bh, int qb, const bf16_t* __restrict__ Q, const bf16_t* __restrict__ K, const bf16_t* __restrict__ V, bf16_t* __restrict__ MIX, float* __restrict__ ASSQ, LAS unsigned char* lds, const int wid, const ConvJob& cj, int& tseq) {
    const int lane = lane_id(), r32 = lane & 31, hi = lane >> 5;
    const int b = bh / NH, h = bh % NH;
    const bf16_t* Qw = Q + ((size_t)bh * SEQ + qb * QB + wid * QBLK + r32) * DQK;
    const bf16_t* Kh = K + (size_t)bh * SEQ * DQK; const bf16_t* Vh = V + (size_t)bh * SEQ * DV;
    bf16x8 qr[12];
#pragma unroll
    for (int d0 = 0; d0 < 12; ++d0) qr[d0] = *(const bf16x8*)(Qw + d0 * 16 + hi * 8);
    const int NT = 4 * qb + 4, qlo = qb * QB + wid * QBLK, qm = qlo + r32 - 4 * hi;
    LAS unsigned char* V_lds = lds + L_V; LAS unsigned char* K_lds = lds + L_K;
    LAS float* wsf = (LAS float*)(lds + L_WS) + wid * 64; LAS float* li_l = wsf; LAS float* al_l = wsf + 32;
    unsigned ksrc[3], vsrc[2];
#pragma unroll
    for (int i = 0; i < 3; ++i) { const int off = ((wid + 8 * i) * 64 + lane) * 16, row = off / 384, wb = off % 384, seg = wb >> 7, cpos = (wb & 127) >> 4; ksrc[i] = (unsigned)(row * 384 + seg * 128 + ((cpos ^ (row & 7)) << 4)); }
#pragma unroll
    for (int i = 0; i < 2; ++i) { const int off = ((wid + 8 * i) * 64 + lane) * 16, st = off >> 9, o_ = off & 511, kk = (st >> 2) * 8 + (o_ >> 6), c = (st & 3) * 32 + ((o_ & 63) >> 1);
        const int k = (kk & ~0xC) | ((kk & 4) << 1) | ((kk & 8) >> 1); vsrc[i] = (unsigned)(k * 256 + c * 2); }
    const int vb0 = (int)(unsigned)(uintptr_t)V_lds + v_rd_base(lane);
#define ADMA_K(t, bf) do { const char* kp = (const char*)(Kh + (size_t)(t) * KVBLK * DQK); \
        _Pragma("unroll") for (int i = 0; i < 3; ++i) __builtin_amdgcn_global_load_lds((const unsigned*)(kp + ksrc[i]), (LAS unsigned*)(K_lds + (bf) * SHM_K + (wid + 8 * i) * 1024), 16, 0, 0); } while (0)
#define ADMA_V(t, bf) do { const char* vp = (const char*)(Vh + (size_t)(t) * KVBLK * DV); \
        _Pragma("unroll") for (int i = 0; i < 2; ++i) __builtin_amdgcn_global_load_lds((const unsigned*)(vp + vsrc[i]), (LAS unsigned*)(V_lds + (bf) * SHM_V + (wid + 8 * i) * 1024), 16, 0, 0); } while (0)
#define PK4(P, B_, OUT) do { unsigned a0 = cvtpk(P[B_ + 0], P[B_ + 1]), a1 = cvtpk(P[B_ + 2], P[B_ + 3]); \
        unsigned b0 = cvtpk(P[B_ + 4], P[B_ + 5]), b1 = cvtpk(P[B_ + 6], P[B_ + 7]); \
        auto r0 = __builtin_amdgcn_permlane32_swap(a0, b0, false, false); auto r1 = __builtin_amdgcn_permlane32_swap(a1, b1, false, false); \
        u32x4 w = {r0[0], r1[0], r0[1], r1[1]}; OUT = __builtin_bit_cast(bf16x8, w); } while (0)
    float m_reg = -1e30f, l_reg = 0.f; f32x16 o[4] = {}; int cv_pend = -1;
    const int ph = wid >> 2; bool st_steady = false, st_had = false;
#define STAGE_SLOT(t) do { const int tk = (t) + 2, tv = (t) + 1; const bool kv_full = tk < NT;     \
        if (tk < NT) ADMA_K(tk, tk & 1); \
        if (tv < NT) ADMA_V(tv, tv & 1); \
        const bool had_pend = cv_pend >= 0; \
        if (had_pend) { if (kv_full) asm volatile("s_waitcnt vmcnt(5)" ::: "memory"); else asm volatile("s_waitcnt vmcnt(0)" ::: "memory");     \
            CV_DECODE(cv_pend) CV_STORE(); cv_pend = -1; } \
        st_had = had_pend; SBAR(); } while (0)
#define STAGE_TAIL(t) do { SBAR(); if ((t) + 1 < NT) { const int cv_idx = __builtin_amdgcn_readfirstlane(tseq * cj.ngw + cj.gw); ++tseq; CV_DECODE(cv_idx) CV_LOAD(); cv_pend = cv_on ? cv_idx : -1; } \
        st_steady = st_had && cv_pend >= 0;                                    \
        SBAR(); } while (0)
#define PV_PART(t) do { if ((t) * KVBLK <= qlo + QBLK - 1) { SBAR(); pv_tile(o, vb0 + ((t) & 1) * SHM_V, pa0, pa1, pa2, pa3); SBAR(); } } while (0)
#define QK_PART(t) do { if ((t) < NT && (t) * KVBLK <= qlo + QBLK - 1) { SBAR(); qkt(p0, p1, K_lds + ((t) & 1) * SHM_K, r32, hi, qr); SBAR(); } } while (0)
#define VALU_SLOT(t) do { const int kb_ = (t) * KVBLK; \
        if (kb_ <= qlo + QBLK - 1) { \
            if (kb_ + KVBLK - 1 > qlo) { asm volatile("" ::: "memory"); const int dq = qm - kb_; const float NEG = -__builtin_inff(); \
                _Pragma("unroll") for (int r = 0; r < 16; ++r) { const int c = (r & 3) + 8 * (r >> 2); if (c > dq) p0[r] = NEG; if (c + 32 > dq) p1[r] = NEG; } } \
            float pmax = p0[0]; _Pragma("unroll") for (int r = 1; r < 16; ++r) pmax = fmaxf(pmax, p0[r]); _Pragma("unroll") for (int r = 0; r < 16; ++r) pmax = fmaxf(pmax, p1[r]); \
            { auto rr = __builtin_amdgcn_permlane32_swap(__float_as_uint(pmax), __float_as_uint(pmax), false, false); pmax = fmaxf(__uint_as_float(rr[0]), __uint_as_float(rr[1])); } \
            if (!__all(pmax - m_reg <= THR)) { const float mn = fmaxf(m_reg, pmax); const float alpha = __builtin_amdgcn_exp2f(m_reg - mn); m_reg = mn; l_reg *= alpha; \
                if (hi == 0) al_l[r32] = alpha; asm volatile("s_waitcnt lgkmcnt(0)" ::: "memory"); \
                _Pragma("unroll") for (int d_ = 0; d_ < 4; ++d_) _Pragma("unroll") for (int r = 0; r < 16; ++r) o[d_][r] *= al_l[crow(r, hi)]; } \
            float ps = 0.f; \
            _Pragma("unroll") for (int r = 0; r < 16; ++r) { p0[r] = __builtin_amdgcn_exp2f(p0[r] - m_reg); p1[r] = __builtin_amdgcn_exp2f(p1[r] - m_reg); } \
            _Pragma("unroll") for (int r = 0; r < 16; ++r) ps += p0[r] + p1[r]; \
            { auto rr = __builtin_amdgcn_permlane32_swap(__float_as_uint(ps), __float_as_uint(ps), false, false); ps = __uint_as_float(rr[0]) + __uint_as_float(rr[1]); } \
            l_reg += ps; \
            PK4(p0, 0, pa0); PK4(p0, 8, pa1); PK4(p1, 0, pa2); PK4(p1, 8, pa3); } } while (0)
#define SLOT_END_EVEN() do { if (st_steady) asm volatile("s_waitcnt vmcnt(4)\n\ts_barrier" ::: "memory");     \
        else asm volatile("s_waitcnt vmcnt(0)\n\ts_barrier" ::: "memory"); } while (0)
#define SLOT_END_ODD() asm volatile("s_barrier" ::: "memory")
    ADMA_K(0, 0);
    asm volatile("s_waitcnt vmcnt(0)" ::: "memory"); __syncthreads();
    if (ph == 0) {
        f32x16 p0, p1;
        STAGE_SLOT(-1); QK_PART(0); STAGE_TAIL(-1); SLOT_END_ODD();
        for (int t = 0; t < NT; ++t) { bf16x8 pa0 = {}, pa1 = {}, pa2 = {}, pa3 = {};
            VALU_SLOT(t); SLOT_END_EVEN();
            STAGE_SLOT(t); PV_PART(t); QK_PART(t + 1); STAGE_TAIL(t); SLOT_END_ODD(); }
    } else {
        bf16x8 pa0 = {}, pa1 = {}, pa2 = {}, pa3 = {};
        STAGE_SLOT(-1); STAGE_TAIL(-1); SLOT_END_ODD();
        for (int t = 0; t < NT; ++t) { f32x16 p0 = {}, p1 = {};
            if (t > 0) PV_PART(t - 1);
            QK_PART(t); SLOT_END_EVEN();
            STAGE_SLOT(t); VALU_SLOT(t); STAGE_TAIL(t); SLOT_END_ODD(); }
        PV_PART(NT - 1);
    }
#undef STAGE_SLOT
#undef STAGE_TAIL
#undef PV_PART
#undef QK_PART
#undef VALU_SLOT
#undef SLOT_END_EVEN
#undef SLOT_END_ODD
#undef PK4
#undef ADMA_K
#undef ADMA_V
    if (cv_pend >= 0) { asm volatile("s_waitcnt vmcnt(0)" ::: "memory"); CV_DECODE(cv_pend) CV_STORE(); }
    if (hi == 0) li_l[r32] = l_reg;
    asm volatile("s_waitcnt vmcnt(0) lgkmcnt(0)" ::: "memory");
    float rli[16];
#pragma unroll
    for (int r = 0; r < 16; ++r) rli[r] = __builtin_amdgcn_rcpf(li_l[crow(r, hi)]);
    __syncthreads();
    LAS bf16_t* stg = (LAS bf16_t*)(lds + wid * 8192);
#pragma unroll
    for (int r = 0; r < 16; ++r) { const int orow = crow(r, hi);
#pragma unroll
        for (int d0 = 0; d0 < 4; ++d0) stg[orow * 128 + d0 * 32 + r32] = f2bf(o[d0][r] * rli[r]); }
    asm volatile("s_waitcnt lgkmcnt(0)" ::: "memory");
    const size_t row0 = (size_t)b * SEQ + qb * QB + wid * QBLK;
#pragma unroll
    for (int i = 0; i < 8; ++i) { const int row = i * 4 + (lane >> 4), ch = lane & 15; const u32x4 v = *(const LAS u32x4*)(stg + row * 128 + ch * 8);
        float ss = (blo(v.x) * blo(v.x) + bhi(v.x) * bhi(v.x)) + (blo(v.y) * blo(v.y) + bhi(v.y) * bhi(v.y)) + (blo(v.z) * blo(v.z) + bhi(v.z) * bhi(v.z)) + (blo(v.w) * blo(v.w) + bhi(v.w) * bhi(v.w));
        ss += __shfl_xor(ss, 1); ss += __shfl_xor(ss, 2); ss += __shfl_xor(ss, 4); ss += __shfl_xor(ss, 8);
        *(u32x4*)(MIX + (row0 + row) * DM + h * DV + ch * 8) = v;
        if (ch == 0) ASSQ[(row0 + row) * 4 + h] = ss; }
    __syncthreads();
}
#undef KSWZ
#undef SBAR
}

struct Args { const void* in[25]; float* out; unsigned char* ws; int ph_lo, ph_hi, li, skip; };
enum { PH_PREP = 0, PH_INPROJ, PH_TOKLOCAL, PH_ATTN, PH_WO, PH_ROUTER, PH_ROUTE, PH_MOE1, PH_MOE2, PH_COMBINE, PH_PLE, PH_FINAL, PH_COUNT };

template <int MODE> __device__ __forceinline__ int cmap_col(int n) {
    if (MODE == 1) { const int pn = n >> 8, half = (n >> 7) & 1, jj = n & 127; return half * 1024 + pn * 128 + jj; }
    if (MODE == 4) { if (n < 1024) return n < 960 ? n : INW; const int v = n - 1024, j = v >> 8, hf = (v >> 7) & 1, cc = v & 127; return (hf ? 1472 : 960) + 128 * j + cc; }
    if (MODE == 2) { const int h = n / DQK, d = n % DQK; if (d < DN) return n; const int t = d - DN; return h * DQK + DN + (t & 1) * 32 + (t >> 1); }
    return n;
}
template <int MODE> __device__ __forceinline__ void transpose_item_fp8(const float* __restrict__ W, int ldsrc, int nblk, unsigned char* __restrict__ WT, int ldd, const float* __restrict__ gain, float scale,
                                                                      LAS float* scr, int item, int lane) {
    const int kb = item / nblk, nb = item % nblk, k0 = 64 * kb, n0 = 32 * nb; const int c = cmap_col<MODE>(n0 + (lane & 31));
    float wv[32];
#pragma unroll
    for (int i = 0; i < 32; ++i) wv[i] = W[(size_t)(k0 + 2 * i + (lane >> 5)) * ldsrc + c];
#pragma unroll
    for (int i = 0; i < 32; ++i) { const int kk = 2 * i + (lane >> 5), k = k0 + kk; float gk = scale; if (gain) gk *= gain[k]; scr[kk * 33 + (lane & 31)] = wv[i] * gk; }
    asm volatile("s_waitcnt lgkmcnt(0)" ::: "memory");
    const int cc = lane & 3;
#pragma unroll
    for (int j = 0; j < 2; ++j) { const int n = (lane >> 2) + 16 * j; const LAS float* s = scr + (16 * cc) * 33 + n; u32x4 o;
        o.x = pg8::pk4_fp8((f32x4){s[0 * 33], s[1 * 33], s[2 * 33], s[3 * 33]}); o.y = pg8::pk4_fp8((f32x4){s[4 * 33], s[5 * 33], s[6 * 33], s[7 * 33]});
        o.z = pg8::pk4_fp8((f32x4){s[8 * 33], s[9 * 33], s[10 * 33], s[11 * 33]}); o.w = pg8::pk4_fp8((f32x4){s[12 * 33], s[13 * 33], s[14 * 33], s[15 * 33]});
        *(u32x4*)(WT + (size_t)(n0 + n) * ldd + k0 + 16 * cc) = o; }
    asm volatile("s_waitcnt lgkmcnt(0)" ::: "memory");
}
template <int MODE> __device__ __forceinline__ void transpose_item(const float* __restrict__ W, int ldsrc, int nblk, bf16_t* __restrict__ WT, int ldd, const float* __restrict__ gain, const float* __restrict__ gain2, float scale,
                                                                  LAS float* scr, int item, int lane) {
    const int kb = item / nblk, nb = item % nblk, k0 = 64 * kb, n0 = 32 * nb; const int c = cmap_col<MODE>(n0 + (lane & 31));
    float wv[32], gq[32];
#pragma unroll
    for (int i = 0; i < 32; ++i) wv[i] = W[(size_t)(k0 + 2 * i + (lane >> 5)) * ldsrc + c];
#pragma unroll
    for (int i = 0; i < 32; ++i) { const int k = k0 + 2 * i + (lane >> 5); gq[i] = gain ? ((gain2 && k >= 512) ? gain2[k - 512] : gain[k]) : 1.f; }
    asm volatile("" ::: "memory");
#pragma unroll
    for (int i = 0; i < 32; ++i) { const int kk = 2 * i + (lane >> 5); scr[kk * 33 + (lane & 31)] = wv[i] * (gq[i] * scale); }
    asm volatile("s_waitcnt lgkmcnt(0)" ::: "memory");
    const int cc = lane & 7;
#pragma unroll
    for (int j = 0; j < 4; ++j) { const int n = (lane >> 3) + 8 * j; const LAS float* s = scr + (8 * cc) * 33 + n;
        u32x4 o; o.x = pk2(s[0 * 33], s[1 * 33]); o.y = pk2(s[2 * 33], s[3 * 33]); o.z = pk2(s[4 * 33], s[5 * 33]); o.w = pk2(s[6 * 33], s[7 * 33]);
        *(u32x4*)(WT + (size_t)(n0 + n) * ldd + k0 + 8 * cc) = o; }
    asm volatile("s_waitcnt lgkmcnt(0)" ::: "memory");
}

__global__ void __launch_bounds__(NTHREADS, 2) fwd(Args args) {
    extern __shared__ __attribute__((aligned(16))) unsigned char lds_raw[];
    LAS unsigned char* lds = (LAS unsigned char*)lds_raw;
    volatile LAS unsigned* MISC = (volatile LAS unsigned*)(lds + MISC_OFF);
    const int wave = __builtin_amdgcn_readfirstlane(threadIdx.x >> 6);
    const int G = gridDim.x, bx = blockIdx.x;
#define PHASE_LANE const int lane = lane_id(); const int tid = wave * 64 + lane; (void)tid
    const int gw = bx * NWAVES + wave, NGW = G * NWAVES;
    unsigned char* ws = args.ws; int* ctl = (int*)(ws + WS_CTL); float* H = args.out;
    const float* x = (const float*)args.in[0]; const float* p = (const float*)args.in[1]; const int* pos = (const int*)args.in[2];
    const float *mix_norm = (const float*)args.in[3], *w_in = (const float*)args.in[4], *q_norm = (const float*)args.in[5], *w_uq = (const float*)args.in[6], *kv_norm = (const float*)args.in[7],
                *w_ukv = (const float*)args.in[8], *attn_out_norm = (const float*)args.in[10], *conv_out_norm = (const float*)args.in[11], *w_o = (const float*)args.in[12],
                *moe_norm = (const float*)args.in[13], *w_router = (const float*)args.in[14], *w1 = (const float*)args.in[16], *b1 = (const float*)args.in[17],
                *w2 = (const float*)args.in[18], *b2 = (const float*)args.in[19], *ple_norm = (const float*)args.in[20], *w_ple_gate = (const float*)args.in[21], *w_ple_proj = (const float*)args.in[22],
                *ple_post_norm = (const float*)args.in[23], *conv_w = (const float*)args.in[9], *b_router = (const float*)args.in[15], *final_norm = (const float*)args.in[24];
    int* TOPI = (int*)(ws + WS_TOPI); float* TOPG = (float*)(ws + WS_TOPG);
    bf16_t *HBF = (bf16_t*)(ws + WS_HBF), *H3 = (bf16_t*)(ws + WS_H3), *WRHL = (bf16_t*)(ws + WS_WRHL); unsigned char* X8 = (unsigned char*)(ws + WS_K);
    float* RSX = (float*)(ws + WS_RSX);
    float *SSQ1 = (float*)(ws + WS_SSQ1), *RS1 = (float*)(ws + WS_RS1), *RS2 = (float*)(ws + WS_RS2), *ROWRS = (float*)(ws + WS_ROWRS);
    bf16_t *WIN = (bf16_t*)(ws + WS_WIN), *WUQ = (bf16_t*)(ws + WS_WUQ), *WUKV = (bf16_t*)(ws + WS_WUKV), *WO = (bf16_t*)(ws + WS_WO), *WG = (bf16_t*)(ws + WS_WG), *WP = (bf16_t*)(ws + WS_WP);
    bf16_t *W1T = (bf16_t*)(ws + WS_W1), *W2T = (bf16_t*)(ws + WS_W2), *XN = (bf16_t*)(ws + WS_XN), *MIX = (bf16_t*)(ws + WS_MIX), *PLER = (bf16_t*)(ws + WS_PLER);
    bf16_t *Z = (bf16_t*)(ws + WS_Z), *Qb = (bf16_t*)(ws + WS_Q), *Kb = (bf16_t*)(ws + WS_K), *Vb = (bf16_t*)(ws + WS_V), *HB = (bf16_t*)(ws + WS_HB), *Y = (bf16_t*)(ws + WS_Y), *P16 = (bf16_t*)(ws + WS_P16);
    float *WR = (float*)(ws + WS_WR), *CS = (float*)(ws + WS_CS), *SSQ = (float*)(ws + WS_SSQ), *ASSQ = (float*)(ws + WS_ASSQ), *PSSQ = (float*)(ws + WS_PSSQ), *FSSQ = (float*)(ws + WS_FSSQ);
    int *ROWTOK = (int*)(ws + WS_ROWTOK), *ROWSLOT = (int*)(ws + WS_ROWSLOT); float* ROWGATE = (float*)(ws + WS_ROWGATE);

    { PHASE_LANE; for (int u = tid; u < (LDS_BYTES - MISC_OFF) / 4; u += NTHREADS) ((LAS unsigned*)(lds + MISC_OFF))[u] = 0u; }
    __syncthreads();
    const int lo = args.ph_lo, hi = args.ph_hi;
    XcdBarrier bar; bar.bar = (unsigned*)ctl + CW_BAR + args.li * XCD_BAR_WORDS; bar.x = 0; bar.st = MISC + 8;
    if (hi - lo > 1) bar = xcd_barrier_post((unsigned*)ctl + CW_BAR + args.li * XCD_BAR_WORDS, MISC + 8, wave);
#define IN(k) (lo <= (k) && (k) < hi)
#define NREP(k) ((PROBE_PH == (k)) ? PROBE_REP : 1)
#define REPLOOP(k) for (int rep = 0; rep < NREP(k); ++rep)
#define LASTREP(k) (rep == NREP(k) - 1)
#ifdef PROBE_TIME_PH
#define STAMP(k) do { if (bx == 0 && wave == 0) MISC[32 + (k)] = (unsigned)__builtin_amdgcn_s_memrealtime(); } while (0)
#else
#define STAMP(k) do { } while (0)
#endif
#define SEAM(k) do { if (IN(k) && IN((k) + 1)) xcd_barrier(bar, wave); STAMP((k) + 1); } while (0)
    STAMP(0);

    if (IN(PH_PREP)) REPLOOP(PH_PREP) {
        PHASE_LANE;
        LAS float* scr = (LAS float*)(lds + wave * 16384);
        constexpr int I_IN = (DM / 64) * 64, I_UQ = (QL / 64) * (768 / 32), I_UKV = (KVL / 64) * (1024 / 32), I_O = (DM / 64) * (DM / 32), I_G = I_O, I_P = (PLE / 64) * (DM / 32);
        constexpr int I_1 = (DM / 64) * (2048 / 32), I_2 = (DE / 64) * (DM / 32);
        constexpr int NITEMS = I_IN + I_UQ + I_UKV + I_O + I_G + I_P;
        for (int it = gw; it < NITEMS; it += NGW) {
            int r = it;
            if (r < I_IN) { if ((r & 63) != 30 && (r & 63) != 31) transpose_item<4>(w_in, INW, 64, WIN, DM, mix_norm, nullptr, 1.f, scr, r, lane); continue; } r -= I_IN;
            if (r < I_UQ) { transpose_item<2>(w_uq, 768, 768 / 32, WUQ, QL, q_norm, nullptr, QSCALE, scr, r, lane); continue; } r -= I_UQ;
            if (r < I_UKV) { transpose_item<0>(w_ukv, 1024, 1024 / 32, WUKV, 256, kv_norm, nullptr, 1.f, scr, r, lane); continue; } r -= I_UKV;
            if (r < I_O) { transpose_item<0>(w_o, DM, DM / 32, WO, DM, attn_out_norm, conv_out_norm, 1.f, scr, r, lane); continue; } r -= I_O;
            if (r < I_G) { transpose_item<0>(w_ple_gate, DM, DM / 32, WG, DM, ple_norm, nullptr, 1.f, scr, r, lane); continue; } r -= I_G;
            transpose_item<0>(w_ple_proj, DM, DM / 32, WP, PLE, nullptr, nullptr, 1.f, scr, r, lane);
        }
        for (int i = bx * NTHREADS + tid; i < 1024 * 16; i += G * NTHREADS) *(u32x4*)(WUKV + (size_t)(i >> 4) * 256 + 128 + (i & 15) * 8) = (u32x4){0u, 0u, 0u, 0u};
        for (int i = bx * NTHREADS + tid; i < DM * NE; i += G * NTHREADS) { const int e = i >> 10, k = i & 1023; const float w = w_router[k * NE + e] * moe_norm[k]; const bf16_t whi = f2bf(w);
            WRHL[i] = whi; WRHL[DM * NE + i] = f2bf(w - bf2f(whi)); }
        for (int i = bx * NTHREADS + tid; i < NTOK * 32; i += G * NTHREADS) { const int t = i >> 5, j = i & 31; const float inv = powf(10000.f, -(float)j / 32.f); const float a = (float)pos[t] * inv; float sn, c; sincosf(a, &sn, &c);
            CS[(size_t)t * 64 + j] = c; CS[(size_t)t * 64 + 32 + j] = sn; }
        for (int i = bx * NTHREADS + tid; i < NTOK * PLE / 4; i += 4 * G * NTHREADS) { f32x4 v[4];
#pragma unroll
            for (int q = 0; q < 4; ++q) { const int ii = i + q * G * NTHREADS; v[q] = ii < NTOK * PLE / 4 ? ((const f32x4*)p)[ii] : (f32x4){0.f, 0.f, 0.f, 0.f}; }
#pragma unroll
            for (int q = 0; q < 4; ++q) { const int ii = i + q * G * NTHREADS; if (ii < NTOK * PLE / 4) ((u32x2*)P16)[ii] = (u32x2){pk2(v[q][0], v[q][1]), pk2(v[q][2], v[q][3])}; } }
        for (int row = gw * 4; row < NTOK; row += NGW * 4) {
            f32x4 v[4][4]; float ss[4];
#pragma unroll
            for (int q = 0; q < 4; ++q) { const f32x4* s = (const f32x4*)(x + (size_t)(row + q) * DM);
#pragma unroll
                for (int j = 0; j < 4; ++j) v[q][j] = s[lane + 64 * j]; }
#pragma unroll
            for (int q = 0; q < 4; ++q) { ss[q] = 0.f;
#pragma unroll
                for (int j = 0; j < 4; ++j) ss[q] += pg8::sq4(v[q][j]); }
#pragma unroll
            for (int q = 0; q < 4; ++q) { const float rstd = rsqrtf(wave_sum(ss[q]) * (1.f / DM) + EPS); u32x2* d = (u32x2*)(XN + (size_t)(row + q) * DM); if (lane == 0) RSX[row + q] = rstd;
#pragma unroll
                for (int j = 0; j < 4; ++j) d[lane + 64 * j] = (u32x2){pk2(v[q][j][0], v[q][j][1]), pk2(v[q][j][2], v[q][j][3])}; }
        }
    }
    SEAM(PH_PREP);
    if (IN(PH_INPROJ)) REPLOOP(PH_INPROJ) {
        { pg8::Gemm g{XN, WIN, DM, DM, DM, nullptr, 0}; pg8::StaticOrder S; S.init(NTOK / 256, 8, G, bx, nullptr);
          pg8::EpiBf16Stats<0> E{Z, INWP, SSQ, RSX}; pg8::gemm_phase<pg8::EpiBf16Stats<0>, false>(lds, g, S, E, wave); }
        { pg8::Gemm g{P16, WP, PLE, PLE, PLE, nullptr, 0}; pg8::StaticOrder S; S.init(NTOK / 256, DM / 256, G, bx, nullptr);
          pg8::EpiBf16Stats<1> E{PLER, DM, PSSQ, nullptr}; pg8::gemm_phase<pg8::EpiBf16Stats<1>, false>(lds, g, S, E, wave); }
    }
    SEAM(PH_INPROJ);
    if (IN(PH_TOKLOCAL)) REPLOOP(PH_TOKLOCAL) {
        PHASE_LANE;
        if (!(args.skip & 1)) for (int r0 = gw * 16; r0 < NTOK; r0 += NGW * 16) {
            const int c8 = lane * 8; f32x4 w0[2], w1[2], w2[2];
#pragma unroll
            for (int q = 0; q < 2; ++q) { w0[q] = *(const f32x4*)(conv_w + c8 + 4 * q); w1[q] = *(const f32x4*)(conv_w + 512 + c8 + 4 * q); w2[q] = *(const f32x4*)(conv_w + 1024 + c8 + 4 * q); }
            f32x4 u1[2] = {}, u2[2] = {};
            if ((r0 % SEQ) != 0) {
#pragma unroll
                for (int p = 1; p <= 2; ++p) { const u32x4 uu = *(const u32x4*)(Z + (size_t)(r0 - p) * INWP + 960 + c8);
                    const f32x4 a = {blo(uu.x), bhi(uu.x), blo(uu.y), bhi(uu.y)}, b = {blo(uu.z), bhi(uu.z), blo(uu.w), bhi(uu.w)};
                    if (p == 1) { u1[0] = a; u1[1] = b; } else { u2[0] = a; u2[1] = b; } } }
#pragma unroll 4
            for (int rr = 0; rr < 16; ++rr) { const int row = r0 + rr; const bf16_t* z = Z + (size_t)row * INWP; const int s = row % SEQ, b = row / SEQ;
                const u32x4 bg = *(const u32x4*)(z + 448 + c8), uu = *(const u32x4*)(z + 960 + c8);
                if (lane < 32) { const float x1 = bf2f(z[384 + lane]), x2 = bf2f(z[416 + lane]); const float c = CS[(size_t)row * 64 + lane], sn = CS[(size_t)row * 64 + 32 + lane];
                    const unsigned o = pk2(x1 * c - x2 * sn, x1 * sn + x2 * c);
#pragma unroll
                    for (int h = 0; h < NH; ++h) *(unsigned*)(Kb + ((size_t)(b * NH + h) * SEQ + s) * DQK + DN + 2 * lane) = o; }
                f32x4 u0[2]; u0[0] = (f32x4){blo(uu.x), bhi(uu.x), blo(uu.y), bhi(uu.y)}; u0[1] = (f32x4){blo(uu.z), bhi(uu.z), blo(uu.w), bhi(uu.w)};
                f32x4 y[2]; y[0] = (f32x4){blo(bg.x), bhi(bg.x), blo(bg.y), bhi(bg.y)} * (w0[0] * u2[0] + w1[0] * u1[0] + w2[0] * u0[0]); y[1] = (f32x4){blo(bg.z), bhi(bg.z), blo(bg.w), bhi(bg.w)} * (w0[1] * u2[1] + w1[1] * u1[1] + w2[1] * u0[1]);
                const float rstd = rsqrtf(wave_sum(pg8::sq4(y[0]) + pg8::sq4(y[1])) * (1.f / 512.f) + EPS);
                *(u32x4*)(MIX + (size_t)row * DM + 512 + c8) = pg8::pack8(y[0] * rstd, y[1] * rstd);
                u2[0] = u1[0]; u2[1] = u1[1]; u1[0] = u0[0]; u1[1] = u0[1]; }
        }
        { pg8::Gemm g{Z, WUQ, QL, INWP, QL, nullptr, 0}; pg8::StaticOrder S; S.init(NTOK / 256, 768 / 256, G, bx, nullptr);
          pg8::EpiQ E{Qb, SSQ, CS}; pg8::gemm_phase<pg8::EpiQ, false>(lds, g, S, E, wave); }
        { pg8::Gemm g{Z + 256, WUKV, 256, INWP, 256, nullptr, 0}; pg8::StaticOrder S; S.init(NTOK / 256, 1024 / 256, G, bx, nullptr);
          pg8::EpiKV E{Kb, Vb, SSQ}; pg8::gemm_phase<pg8::EpiKV, false>(lds, g, S, E, wave); }
    }
    SEAM(PH_TOKLOCAL);
    if (IN(PH_ATTN)) REPLOOP(PH_ATTN) {
        const int vcu = (G % 8 == 0) ? (bx % 8) * (G / 8) + bx / 8 : bx;
        using att::L_END; using att::cv_cmap1; using att::cv_cmap2; using att::CV_N1; using att::CV_TOTAL;
        const att::ConvJob cj{w1, w2, moe_norm, (unsigned char*)W1T, (unsigned char*)W2T, gw, NGW}; int tseq = LASTREP(PH_ATTN) ? 0 : (1 << 20);
        for (int it = vcu; it < NB * NH * 8; it += G) { const int bh = it >> 3, pr = it & 7;
            for (int pass = 0; pass < 2; ++pass) att::attn_block(bh, pass ? pr : 15 - pr, Qb, Kb, Vb, MIX, ASSQ, lds, wave, cj, tseq); }
        if (LASTREP(PH_ATTN)) { const int lane = lane_id(), hi = lane >> 5, wid = wave; __syncthreads();
            for (int cv_idx = tseq * NGW + gw; cv_idx < att::CV_TOTAL; cv_idx += NGW) { CV_DECODE(cv_idx) CV_LOAD(); asm volatile("s_waitcnt vmcnt(0)" ::: "memory"); CV_STORE(); } }
    }
    SEAM(PH_ATTN);
    if (IN(PH_WO)) REPLOOP(PH_WO) {
        pg8::Gemm g{MIX, WO, DM, DM, DM, nullptr, 0}; pg8::StaticOrder S; S.init(NTOK / 256, DM / 256, G, bx, nullptr);
        pg8::EpiWo E{XN, HBF, X8, ASSQ, SSQ1, moe_norm}; pg8::gemm_phase<pg8::EpiWo, false>(lds, g, S, E, wave, LASTREP(PH_WO));
    }
    SEAM(PH_WO);
    if (IN(PH_ROUTER)) REPLOOP(PH_ROUTER) {
        PHASE_LANE;
        typedef float f32x16 __attribute__((ext_vector_type(16)));
        const bool fusedR = (G == 256);
        LAS int* hist = (LAS int*)(lds + HIST_OFF); LAS f32x16* xch = (LAS f32x16*)(lds + HIST_OFF + 256);
        for (int i = tid; i < 2 * NE * 128; i += NTHREADS) { const int pe = i >> 7, kc = i & 127, e = pe & 31; *(LAS u32x4*)(lds + pe * 2048 + ((kc ^ (e & 15)) << 4)) = ((const u32x4*)WRHL)[i]; }
        if (tid < NE) hist[tid] = 0;
        __syncthreads();
        for (int chunk = bx; chunk < NTOK / 128; chunk += G) {
            const int base = chunk * 128, wq = wave & 3, kh = wave >> 2;
            const int j = lane & 31, half = lane >> 5, tok = base + wq * 32 + j;
            const bf16_t* xr = HBF + (size_t)tok * DM + kh * 512 + 8 * half; const LAS unsigned char* wrow = lds + j * 2048;
            f32x16 acc = {};
#pragma unroll 8
            for (int s = 0; s < 32; ++s) { const bf16x8 xb = *(const bf16x8*)(xr + 16 * s); const int kc = ((kh * 64 + 2 * s + half) ^ (j & 15)) << 4;
                const bf16x8 ah = *(const LAS bf16x8*)(wrow + kc), al = *(const LAS bf16x8*)(wrow + 65536 + kc);
                acc = __builtin_amdgcn_mfma_f32_32x32x16_bf16(ah, xb, acc, 0, 0, 0); acc = __builtin_amdgcn_mfma_f32_32x32x16_bf16(al, xb, acc, 0, 0, 0); }
            if (kh == 1) xch[wq * 64 + lane] = acc;
            __syncthreads();
            if (kh == 0) {
                const f32x16 other = xch[wq * 64 + lane];
                const f32x4 s0 = *(const f32x4*)(SSQ1 + (size_t)tok * 16 + 8 * half), s1 = *(const f32x4*)(SSQ1 + (size_t)tok * 16 + 8 * half + 4);
                float ss = ((s0[0] + s0[1]) + (s0[2] + s0[3])) + ((s1[0] + s1[1]) + (s1[2] + s1[3])); ss += __shfl_xor(ss, 32); const float rstd = rsqrtf(ss * (1.f / DM) + EPS);
                float v[16];
#pragma unroll
                for (int r = 0; r < 16; ++r) v[r] = (acc[r] + other[r]) * rstd + b_router[(r & 3) + 8 * (r >> 2) + 4 * half];
                float lv[4]; int li[4];
#pragma unroll
                for (int t = 0; t < 4; ++t) { float best = -__builtin_inff(); int bi = 0;
#pragma unroll
                    for (int r = 0; r < 16; ++r) if (v[r] > best) { best = v[r]; bi = (r & 3) + 8 * (r >> 2) + 4 * half; }
                    const auto rv = __builtin_amdgcn_permlane32_swap(__float_as_uint(best), __float_as_uint(best), false, false); const auto ri = __builtin_amdgcn_permlane32_swap((unsigned)bi, (unsigned)bi, false, false);
                    const float b0 = __uint_as_float(rv[0]), b1 = __uint_as_float(rv[1]); const int i0 = (int)ri[0], i1 = (int)ri[1];
                    const bool t0 = (b0 > b1) || (b0 == b1 && i0 < i1); const float gb = t0 ? b0 : b1; const int gi = t0 ? i0 : i1; lv[t] = gb; li[t] = gi;
#pragma unroll
                    for (int r = 0; r < 16; ++r) if ((r & 3) + 8 * (r >> 2) + 4 * half == gi) v[r] = -__builtin_inff(); }
                if (half == 0) { const float e1 = __expf(lv[1] - lv[0]), e2 = __expf(lv[2] - lv[0]), e3 = __expf(lv[3] - lv[0]); const float inv = 1.f / (1.f + e1 + e2 + e3);
                    if (fusedR) { const int tl = wq * 32 + j; *(LAS u32x4*)(lds + LT_OFF + tl * 16) = (u32x4){(unsigned)li[0], (unsigned)li[1], (unsigned)li[2], (unsigned)li[3]}; *(LAS f32x4*)(lds + LT_OFF + 2048 + tl * 16) = (f32x4){inv, e1 * inv, e2 * inv, e3 * inv}; *(LAS float*)(lds + LT_OFF + 4096 + tl * 4) = rstd; }
                    else { *(int4*)(TOPI + (size_t)tok * 4) = make_int4(li[0], li[1], li[2], li[3]); *(f32x4*)(TOPG + (size_t)tok * 4) = (f32x4){inv, e1 * inv, e2 * inv, e3 * inv}; RS1[tok] = rstd; }
#pragma unroll
                    for (int t = 0; t < 4; ++t) (void)__hip_atomic_fetch_add(hist + li[t], 1, __ATOMIC_RELAXED, __HIP_MEMORY_SCOPE_WORKGROUP); }
            }
            __syncthreads();
        }
        if (!fusedR) { if (tid < NE && LASTREP(PH_ROUTER)) atomicAdd(ctl + CW_CNT + tid, hist[tid]); __syncthreads(); }
        else {
            LAS int* S = (LAS int*)lds; LAS int* T = (LAS int*)(lds + 32768);
            LAS int* shf = (LAS int*)(lds + LT_OFF + 4608); LAS int* sh2 = shf + 64;
            int* BH = (int*)(ws + WS_FSSQ + 1 * MiB); int* BB = BH + 256 * NE;
            if (tid < NE) __hip_atomic_store(BH + bx * NE + tid, hist[tid], __ATOMIC_RELAXED, __HIP_MEMORY_SCOPE_AGENT);
            asm volatile("s_waitcnt vmcnt(0)" ::: "memory");
            __syncthreads();
            if (tid == 0) shf[0] = (__hip_atomic_fetch_add(ctl + CW_TICKET, 1, __ATOMIC_RELAXED, __HIP_MEMORY_SCOPE_AGENT) == G - 1) ? 1 : 0;
            __syncthreads();
            if (shf[0]) {
                if (wave == 0) __builtin_amdgcn_fence(__ATOMIC_ACQUIRE, "agent");
                __syncthreads();
                { u32x4 hv4[4];
#pragma unroll
                  for (int q = 0; q < 4; ++q) hv4[q] = *(const u32x4*)(BH + (tid + q * NTHREADS) * 4);
#pragma unroll
                  for (int q = 0; q < 4; ++q) *(LAS u32x4*)(S + (tid + q * NTHREADS) * 4) = hv4[q]; }
                __syncthreads();
                if (lane < NE) { int run = 0; for (int b = wave * 32; b < wave * 32 + 32; ++b) { const int v = S[b * NE + lane]; S[b * NE + lane] = run; run += v; } T[wave * NE + lane] = run; }
                __syncthreads();
                if (tid < NE) { int run = 0; for (int w = 0; w < 8; ++w) { const int v = T[w * NE + tid]; T[w * NE + tid] = run; run += v; } T[256 + tid] = run; }
                __syncthreads();
#pragma unroll
                for (int q = 0; q < 4; ++q) { const int i = (tid + q * NTHREADS) * 4; u32x4 v = *(const LAS u32x4*)(S + i); const u32x4 tb = *(const LAS u32x4*)(T + (i >> 10) * NE + (i & 31));
                    v += tb; asm volatile("global_store_dwordx4 %0, %1, off sc0 sc1" :: "v"(BB + i), "v"(v) : "memory"); }
                if (wave == 0) { const int c = lane < NE ? T[256 + (lane & 31)] : 0, t = (c + 255) >> 8; int incl = t;
#pragma unroll
                    for (int d = 1; d < 64; d <<= 1) { const int o = __shfl_up(incl, d); if (lane >= d) incl += o; }
                    const int excl = incl - t;
                    if (lane < NE) { __hip_atomic_store(ctl + CW_PADSTART + lane, excl * 256, __ATOMIC_RELAXED, __HIP_MEMORY_SCOPE_AGENT); __hip_atomic_store(ctl + CW_CNT + lane, c, __ATOMIC_RELAXED, __HIP_MEMORY_SCOPE_AGENT);
                        for (int q = 0; q < t; ++q) __hip_atomic_store(ctl + CW_TILE_E + excl + q, lane, __ATOMIC_RELAXED, __HIP_MEMORY_SCOPE_AGENT); }
                    if (lane == NE) { __hip_atomic_store(ctl + CW_PADSTART + NE, excl * 256, __ATOMIC_RELAXED, __HIP_MEMORY_SCOPE_AGENT); __hip_atomic_store(ctl + CW_NTILES, excl, __ATOMIC_RELAXED, __HIP_MEMORY_SCOPE_AGENT); } }
                asm volatile("s_waitcnt vmcnt(0)" ::: "memory");
                __syncthreads();
                if (tid == 0) __hip_atomic_store(ctl + CW_READY, 1, __ATOMIC_RELAXED, __HIP_MEMORY_SCOPE_AGENT);
            }
            if (wave == 0) { unsigned sp = 0;
                while (__builtin_amdgcn_readfirstlane(__hip_atomic_load(ctl + CW_READY, __ATOMIC_RELAXED, __HIP_MEMORY_SCOPE_AGENT)) == 0) { __builtin_amdgcn_s_sleep(24); if (++sp > (1u << 19)) break; }
                __builtin_amdgcn_fence(__ATOMIC_ACQUIRE, "agent"); }
            __syncthreads();
            if (tid < NE) { sh2[tid] = BB[bx * NE + tid] + ctl[CW_PADSTART + tid]; sh2[64 + tid] = 0; }
            __syncthreads();
            { const int e = *(const LAS int*)(lds + LT_OFF + tid * 4); const int r = __hip_atomic_fetch_add(sh2 + 64 + e, 1, __ATOMIC_RELAXED, __HIP_MEMORY_SCOPE_WORKGROUP);
              const int dest = sh2[e] + r, idx = bx * NTHREADS + tid;
              ROWTOK[dest] = idx >> 2; ROWSLOT[dest] = idx; ROWGATE[dest] = *(const LAS float*)(lds + LT_OFF + 2048 + tid * 4); ROWRS[dest] = *(const LAS float*)(lds + LT_OFF + 4096 + (tid >> 2) * 4); }
            if (bx < NE) { const int plo = ctl[CW_PADSTART + bx] + ctl[CW_CNT + bx], phi = ctl[CW_PADSTART + bx + 1];
                for (int r = plo + tid; r < phi; r += NTHREADS) { ROWTOK[r] = 0; ROWSLOT[r] = MROWS; ROWGATE[r] = 0.f; ROWRS[r] = 0.f; } }
            __syncthreads();
        }
    }
    if (G != 256) SEAM(PH_ROUTER);
    if (IN(PH_ROUTE) && G != 256) {
        PHASE_LANE;
        LAS int* sh = (LAS int*)lds;
        if (tid == 0) { int ps = 0, nt = 0;
            for (int e = 0; e < NE; ++e) { sh[e] = ps; const int t = (ctl[CW_CNT + e] + 255) >> 8; if (bx == 0) for (int q = 0; q < t; ++q) ctl[CW_TILE_E + nt + q] = e; nt += t; ps += t * 256; }
            sh[NE] = ps; if (bx == 0) ctl[CW_NTILES] = nt; }
        __syncthreads();
        for (int chunk = bx; chunk < MROWS / NTHREADS; chunk += G) {
            if (tid < NE) sh[64 + tid] = 0;
            __syncthreads();
            const int idx = chunk * NTHREADS + tid, e = TOPI[idx]; const int r = __hip_atomic_fetch_add(sh + 64 + e, 1, __ATOMIC_RELAXED, __HIP_MEMORY_SCOPE_WORKGROUP);
            __syncthreads();
            if (tid < NE) sh[128 + tid] = atomicAdd(ctl + CW_CURSOR + tid, sh[64 + tid]);
            __syncthreads();
            const int dest = sh[e] + sh[128 + e] + r; ROWTOK[dest] = idx >> 2; ROWSLOT[dest] = idx; ROWGATE[dest] = TOPG[idx]; ROWRS[dest] = RS1[idx >> 2];
            __syncthreads();
        }
        for (int e = bx; e < NE; e += G) { const int plo = sh[e] + ctl[CW_CNT + e], phi = sh[e + 1];
            for (int r = plo + tid; r < phi; r += NTHREADS) { ROWTOK[r] = 0; ROWSLOT[r] = MROWS; ROWGATE[r] = 0.f; ROWRS[r] = 0.f; } }
        __syncthreads();
    }
    SEAM(PH_ROUTE);
    if (IN(PH_MOE1)) REPLOOP(PH_MOE1) {
        pg8::Gemm g{X8, W1T, DM, DM, DM, ROWTOK, (size_t)2048 * DM}; pg8::StaticOrder S; S.init(ctl[CW_NTILES], 2048 / 256, G, bx, ctl + CW_TILE_E);
        pg8::EpiMoe1 E{(unsigned char*)HB, b1, ROWRS}; pg8::gemm_phase<pg8::EpiMoe1, true, true>(lds, g, S, E, wave, LASTREP(PH_MOE1));
    }
    SEAM(PH_MOE1);
    if (IN(PH_MOE2)) REPLOOP(PH_MOE2) {
        pg8::Gemm g{HB, W2T, DE, DE, DE, nullptr, (size_t)DM * DE}; pg8::StaticOrder S; S.init(ctl[CW_NTILES], DM / 256, G, bx, ctl + CW_TILE_E);
        pg8::EpiMoe2 E{(unsigned char*)Y, b2, ROWSLOT, ROWGATE}; pg8::gemm_phase<pg8::EpiMoe2, false, true>(lds, g, S, E, wave, LASTREP(PH_MOE2));
    }
    SEAM(PH_MOE2);
    if (IN(PH_COMBINE)) REPLOOP(PH_COMBINE) {
        PHASE_LANE;
        for (int row = gw * 2; row < NTOK; row += NGW * 2) {
            u32x4 hv[2][2]; u32x2 yv[2][4][2]; const unsigned char* Y8 = (const unsigned char*)Y;
#pragma unroll
            for (int q = 0; q < 2; ++q)
#pragma unroll
                for (int j = 0; j < 2; ++j) { hv[q][j] = *(const u32x4*)(HBF + (size_t)(row + q) * DM + (lane + 64 * j) * 8);
#pragma unroll
                    for (int k = 0; k < 4; ++k) yv[q][k][j] = *(const u32x2*)(Y8 + ((size_t)(row + q) * 4 + k) * DM + (lane + 64 * j) * 8); }
#pragma unroll
            for (int q = 0; q < 2; ++q) { float ss = 0.f; u32x4 ov[2];
#pragma unroll
                for (int j = 0; j < 2; ++j) { f32x4 a = {blo(hv[q][j].x), bhi(hv[q][j].x), blo(hv[q][j].y), bhi(hv[q][j].y)}, b = {blo(hv[q][j].z), bhi(hv[q][j].z), blo(hv[q][j].w), bhi(hv[q][j].w)};
#pragma unroll
                    for (int k = 0; k < 4; ++k) { const u32x2 y = yv[q][k][j]; const f32x2 y0 = __builtin_amdgcn_cvt_pk_f32_fp8(y.x, false), y1 = __builtin_amdgcn_cvt_pk_f32_fp8(y.x, true), y2 = __builtin_amdgcn_cvt_pk_f32_fp8(y.y, false), y3 = __builtin_amdgcn_cvt_pk_f32_fp8(y.y, true);
                        a += (f32x4){y0[0], y0[1], y1[0], y1[1]}; b += (f32x4){y2[0], y2[1], y3[0], y3[1]}; }
                    ss += pg8::sq4(a) + pg8::sq4(b); ov[j] = pg8::pack8(a, b); }
                ss = wave_sum(ss);
                bf16_t* ho = LASTREP(PH_COMBINE) ? HBF : (bf16_t*)(ws + WS_HB);
#pragma unroll
                for (int j = 0; j < 2; ++j) *(u32x4*)(ho + (size_t)(row + q) * DM + (lane + 64 * j) * 8) = ov[j];
                float ps = lane < 16 ? PSSQ[(size_t)(row + q) * 16 + lane] : 0.f; ps += __shfl_xor(ps, 1); ps += __shfl_xor(ps, 2); ps += __shfl_xor(ps, 4); ps += __shfl_xor(ps, 8);
                if (lane == 0) { RS2[row + q] = rsqrtf(ss * (1.f / DM) + EPS); RS2[NTOK + row + q] = rsqrtf(ps * (1.f / DM) + EPS); } }
        }
    }
    SEAM(PH_COMBINE);
    if (IN(PH_PLE)) REPLOOP(PH_PLE) {
        pg8::Gemm g{HBF, WG, DM, DM, DM, nullptr, 0}; pg8::StaticOrder S; S.init(NTOK / 256, DM / 256, G, bx, nullptr);
        if (G == 256 && LASTREP(PH_PLE)) { pg8::EpiPleFinal E{HBF, H, PLER, RS2 + NTOK, RS2, ple_post_norm, final_norm, FSSQ, (unsigned*)ctl + CW_PANEL, (unsigned*)ctl + CW_PANEL - 64, lds}; pg8::gemm_phase<pg8::EpiPleFinal, false>(lds, g, S, E, wave); }
        else { pg8::EpiPle E{HBF, H3, PLER, RS2 + NTOK, RS2, ple_post_norm, FSSQ}; pg8::gemm_phase<pg8::EpiPle, false>(lds, g, S, E, wave); }
    }
    if (G != 256) SEAM(PH_PLE);
    if (IN(PH_FINAL) && G != 256) REPLOOP(PH_FINAL) {
        PHASE_LANE;
        for (int row = gw * 4; row < NTOK; row += NGW * 4) {
            u32x4 hv[4][2]; float sp[4];
#pragma unroll
            for (int q = 0; q < 4; ++q) { sp[q] = lane < 16 ? FSSQ[(size_t)(row + q) * 16 + lane] : 0.f;
#pragma unroll
                for (int j = 0; j < 2; ++j) hv[q][j] = *(const u32x4*)(H3 + (size_t)(row + q) * DM + (lane + 64 * j) * 8); }
#pragma unroll
            for (int q = 0; q < 4; ++q) { float s = sp[q]; s += __shfl_xor(s, 1); s += __shfl_xor(s, 2); s += __shfl_xor(s, 4); s += __shfl_xor(s, 8);
                const float rstd = rsqrtf(__shfl(s, 0) * (1.f / DM) + EPS); float* ho = (LASTREP(PH_FINAL) ? H : (float*)(ws + WS_HB)) + (size_t)(row + q) * DM;
#pragma unroll
                for (int j = 0; j < 2; ++j) { const int c = (lane + 64 * j) * 8; const f32x4 g0 = *(const f32x4*)(final_norm + c), g1 = *(const f32x4*)(final_norm + c + 4); const u32x4 v = hv[q][j];
                    *(f32x4*)(ho + c) = (f32x4){blo(v.x), bhi(v.x), blo(v.y), bhi(v.y)} * rstd * g0; *(f32x4*)(ho + c + 4) = (f32x4){blo(v.z), bhi(v.z), blo(v.w), bhi(v.w)} * rstd * g1; } }
        }
    }
#ifdef PROBE_TIME_PH
    STAMP(PH_COUNT);
    if (bx == 0 && wave == 0) {
#ifndef PROBE_TIME_END
#define PROBE_TIME_END (PROBE_TIME_PH + 1)
#endif
        const unsigned dt = MISC[32 + PROBE_TIME_END] - MISC[32 + PROBE_TIME_PH]; const unsigned long long t0 = __builtin_amdgcn_s_memrealtime(); while (__builtin_amdgcn_s_memrealtime() - t0 < (unsigned long long)dt) __builtin_amdgcn_s_sleep(8); }
#endif
#ifdef PROBE_BARS
    if (hi - lo > 1) for (int i = 0; i < PROBE_BARS; ++i) xcd_barrier(bar, wave);
#endif
#undef IN
#undef NREP
#undef REPLOOP
#undef LASTREP
#undef SEAM
}
static int g_grid = 0;
extern "C" void kernel_launch(void* const* d_in, const int* in_sizes, int n_in, void* d_out, int out_size, void* d_ws, size_t ws_size, hipStream_t stream) {
    if (n_in != 25 || in_sizes[0] != NTOK * DM || out_size != NTOK * DM || ws_size < WS_END) {
        fprintf(stderr, "kernel_launch: unexpected shapes (n_in %d, in0 %d, out %d, ws %zu need %zu)\n", n_in, n_in > 0 ? in_sizes[0] : -1, out_size, ws_size, (size_t)WS_END); return; }
    if (g_grid == 0) {
        int dev = 0, cus = 0, per_cu = 0; (void)hipGetDevice(&dev); (void)hipDeviceGetAttribute(&cus, hipDeviceAttributeMultiprocessorCount, dev);
        if (hipFuncSetAttribute((const void*)fwd, hipFuncAttributeMaxDynamicSharedMemorySize, LDS_BYTES) != hipSuccess) fprintf(stderr, "hipFuncSetAttribute failed\n");
        if (hipOccupancyMaxActiveBlocksPerMultiprocessor(&per_cu, (const void*)fwd, NTHREADS, LDS_BYTES) != hipSuccess || per_cu < 1) { fprintf(stderr, "occupancy query: %d\n", per_cu); per_cu = 1; }
        (void)hipGetLastError();
        g_grid = cus > 0 ? cus : 256;
    }
    (void)hipMemsetAsync((unsigned char*)d_ws + WS_CTL, 0, 64 * 1024, stream);
    Args a{}; for (int i = 0; i < 25; ++i) a.in[i] = d_in[i]; a.out = (float*)d_out; a.ws = (unsigned char*)d_ws;
    a.ph_lo = 0; a.ph_hi = PH_COUNT; a.li = 0; a.skip = 0;
    void* p[] = {&a};
    const hipError_t e = hipLaunchCooperativeKernel((const void*)fwd, dim3(g_grid), dim3(NTHREADS), p, LDS_BYTES, stream);
    if (e != hipSuccess) fprintf(stderr, "cooperative launch failed: %s (grid %d)\n", hipGetErrorString(e), g_grid);
}
```

```cpp
#include <hip/hip_runtime.h>
#include <cstdint>
#include <cstdio>
#include <cmath>

typedef unsigned short bf16_t;

constexpr int NB = 8, SEQ = 4096, DM = 1024, NTOK = NB * SEQ;
constexpr int PLE = 256, NH = 4, DN = 128, DR = 64, DV = 128, QL = 256, KVL = 128, DQK = DN + DR;
constexpr int INW = 1984, INWP = 1536;
constexpr int NE = 32, TOPK = 4, DE = 1024;
constexpr int MROWS = NTOK * TOPK;
constexpr int MAXTILES = MROWS / 256 + NE;
constexpr int PROWS = MAXTILES * 256;
constexpr float EPS = 1e-6f;
constexpr float QSCALE = 0.07216878364870322f * 1.4426950408889634f;

constexpr size_t MiB = 1u << 20;
constexpr size_t WS_CTL = 0;
constexpr size_t WS_WIN = 1 * MiB, WS_WUQ = 5 * MiB, WS_WUKV = 5 * MiB + 512 * 1024, WS_WO = 6 * MiB, WS_WG = 8 * MiB, WS_WP = 10 * MiB;
constexpr size_t WS_WR = 10 * MiB + 512 * 1024;
constexpr size_t WS_CS = 11 * MiB;
constexpr size_t WS_SSQ = 19 * MiB, WS_ASSQ = 20 * MiB, WS_PSSQ = 21 * MiB, WS_FSSQ = 23 * MiB;
constexpr size_t WS_TOPI = 25 * MiB, WS_TOPG = 25 * MiB + 512 * 1024;
constexpr size_t WS_ROWTOK = 26 * MiB, WS_ROWSLOT = 27 * MiB, WS_ROWGATE = 28 * MiB;
constexpr size_t WS_P16 = 29 * MiB;
constexpr size_t WS_SSQ1 = 45 * MiB, WS_RS1 = 47 * MiB, WS_RS2 = 47 * MiB + 128 * 1024, WS_ROWRS = 47 * MiB + 384 * 1024;
constexpr size_t WS_RSX = 10 * MiB + 512 * 1024;
constexpr size_t WS_WRHL = 10 * MiB + 768 * 1024;
constexpr size_t WS_HBF = 112 * MiB;
constexpr size_t WS_H3 = 304 * MiB;
constexpr size_t WS_W1 = 48 * MiB, WS_W2 = 176 * MiB, WS_XN = 240 * MiB, WS_MIX = 304 * MiB, WS_PLER = 368 * MiB;
constexpr size_t WS_Z = 432 * MiB, WS_Q = 560 * MiB, WS_K = 608 * MiB, WS_V = 656 * MiB;
constexpr size_t WS_HB = 432 * MiB;
constexpr size_t WS_Y = 704 * MiB;
constexpr size_t WS_END = WS_Y + (size_t)(MROWS + 256) * DM * 2;
constexpr int CW_CNT = 0, CW_CURSOR = 64, CW_PADSTART = 128, CW_NTILES = 192, CW_TICKET = 200, CW_READY = 224, CW_TILE_E = 256;

__device__ __forceinline__ float bf2f(bf16_t v) { return __uint_as_float((unsigned)v << 16); }
__device__ __forceinline__ float blo(unsigned u) { return __uint_as_float(u << 16); }
__device__ __forceinline__ float bhi(unsigned u) { return __uint_as_float(u & 0xffff0000u); }
__device__ __forceinline__ bf16_t f2bf(float f) { unsigned u = __float_as_uint(f); return (bf16_t)((u + 0x7fffu + ((u >> 16) & 1u)) >> 16); }
__device__ __forceinline__ unsigned pk2(float lo, float hi) { return (unsigned)f2bf(lo) | ((unsigned)f2bf(hi) << 16); }
__device__ __forceinline__ float wave_sum(float v) {
#pragma unroll
    for (int o = 1; o < 64; o <<= 1) v += __shfl_xor(v, o);
    return v;
}
__device__ __forceinline__ float wave_max(float v) {
#pragma unroll
    for (int o = 1; o < 64; o <<= 1) v = fmaxf(v, __shfl_xor(v, o));
    return v;
}
__device__ __forceinline__ float dot8(uint4 x, uint4 y) {
    return blo(x.x) * blo(y.x) + bhi(x.x) * bhi(y.x) + blo(x.y) * blo(y.y) + bhi(x.y) * bhi(y.y) +
           blo(x.z) * blo(y.z) + bhi(x.z) * bhi(y.z) + blo(x.w) * blo(y.w) + bhi(x.w) * bhi(y.w);
}
__device__ __forceinline__ float dot_bf16(const bf16_t* a, const bf16_t* b, int K) {
    const uint4* a4 = (const uint4*)a; const uint4* b4 = (const uint4*)b; float acc = 0.f;
    for (int i = 0; i < K / 8; ++i) acc += dot8(a4[i], b4[i]);
    return acc;
}

#define LAS __attribute__((address_space(3)))
#define GAS __attribute__((address_space(1)))
typedef short bf16x8 __attribute__((ext_vector_type(8)));
typedef float f32x4 __attribute__((ext_vector_type(4)));
typedef float f32x2 __attribute__((ext_vector_type(2)));
typedef unsigned u32x4 __attribute__((ext_vector_type(4)));
typedef unsigned u32x2 __attribute__((ext_vector_type(2)));
#ifndef PROBE_PH
#define PROBE_PH (-1)
#define PROBE_REP 1
#endif
#ifndef MOE2_DELAY_TICKS
#define MOE2_DELAY_TICKS 700ull
#endif
constexpr int NWAVES = 8, NTHREADS = 512;
constexpr int RING_BYTES = 131072, MISC_OFF = RING_BYTES, HIST_OFF = MISC_OFF + 256, STG_OFF = RING_BYTES + 1024, LT_OFF = HIST_OFF + 256 + 16384, LDS_BYTES = 163840;
constexpr int CW_PANEL = 8192;
constexpr int CW_BAR = 4096;
__device__ __forceinline__ unsigned cvt_pk_bf16(float lo, float hi) { unsigned r; asm volatile("v_cvt_pk_bf16_f32 %0, %1, %2" : "=v"(r) : "v"(lo), "v"(hi)); return r; }
__device__ __forceinline__ int lane_id() { int l = (int)__builtin_amdgcn_mbcnt_hi(~0u, __builtin_amdgcn_mbcnt_lo(~0u, 0u)); asm volatile("" : "+v"(l)); return l; }
__device__ __forceinline__ float fast_sigmoid(float a) { return __builtin_amdgcn_rcpf(1.f + __expf(-a)); }

#define XB_TMO      128
#define XB_XCNT(j)  (256  + 64 * (j))
#define XB_XSUB(j)  (1280 + 64 * (j))
#define XB_XGEN(j)  (2304 + 64 * (j))
#define XB_TOP      3328
#define XB_TOPGEN   3392
#define XCD_BAR_WORDS 3456
#define XB_SPIN_CAP (1u << 20)
__device__ __forceinline__ unsigned xb_ld(unsigned* p)              { return __hip_atomic_load(p, __ATOMIC_RELAXED, __HIP_MEMORY_SCOPE_AGENT); }
__device__ __forceinline__ unsigned xb_add(unsigned* p, unsigned v) { return __hip_atomic_fetch_add(p, v, __ATOMIC_RELAXED, __HIP_MEMORY_SCOPE_AGENT); }
__device__ __forceinline__ unsigned xb_xcc_id() { return (unsigned)__builtin_amdgcn_s_getreg((3 << 11) | 20) & 0xFu; }
#define XB_SPIN(cond, bar) do { unsigned _sp = 0; while (cond) { __builtin_amdgcn_s_sleep(1); \
    if ((++_sp & 255u) == 0u) { if (xb_ld(&(bar)[XB_TMO])) break; if (_sp > XB_SPIN_CAP) { atomicAdd(&(bar)[XB_TMO], 1u); break; } } } } while (0)
struct XcdBarrier { unsigned* bar; unsigned x; volatile LAS unsigned* st; };
__device__ __forceinline__ XcdBarrier xcd_barrier_post(unsigned* bar, volatile LAS unsigned* st, int wave) {
    XcdBarrier b; b.bar = bar; b.x = xb_xcc_id(); b.st = st;
    if (wave == 0 && lane_id() == 0) (void)xb_add(&bar[XB_XCNT(b.x)], 1u);
    return b;
}
__device__ __forceinline__ void xcd_barrier_complete(unsigned* bar, unsigned x, unsigned& nloc, unsigned& nx) {
    const unsigned G = gridDim.x * gridDim.y * gridDim.z;
    unsigned sum, cnt, mine, sp = 0u;
    for (;;) {
        sum = 0u; cnt = 0u; mine = 0u;
#pragma unroll
        for (unsigned j = 0; j < 16; ++j) { const unsigned c = xb_ld(&bar[XB_XCNT(j)]); sum += c; cnt += (c > 0u) ? 1u : 0u; mine = (j == x) ? c : mine; }
        if (sum == G) break;
        __builtin_amdgcn_s_sleep(1);
        if ((++sp & 255u) == 0u) { if (xb_ld(&bar[XB_TMO])) break; if (sp > XB_SPIN_CAP) { atomicAdd(&bar[XB_TMO], 1u); break; } }
    }
    nloc = mine > 0u ? mine : 1u; nx = cnt > 0u ? cnt : 1u;
}
__device__ __forceinline__ void xcd_barrier(const XcdBarrier& b, int wave) {
    asm volatile("s_waitcnt vmcnt(0)" ::: "memory");
    __syncthreads();
    if (wave == 0 && lane_id() == 0) {
        unsigned* bar = b.bar;
        __builtin_amdgcn_s_waitcnt(0);
        unsigned nloc = b.st[0], nx = b.st[1];
        if (nloc == 0u) { xcd_barrier_complete(bar, b.x, nloc, nx); b.st[0] = nloc; b.st[1] = nx; }
        const unsigned old = xb_add(&bar[XB_XSUB(b.x)], 1u);
        const unsigned gen = old / nloc;
        if (old + 1u == (gen + 1u) * nloc) {
            __builtin_amdgcn_fence(__ATOMIC_RELEASE, "agent");
            asm volatile("s_waitcnt vmcnt(0)" ::: "memory");
            const unsigned og = xb_add(&bar[XB_TOP], 1u);
            const unsigned tg = og / nx;
            if (og + 1u == (tg + 1u) * nx) xb_add(&bar[XB_TOPGEN], 1u);
            else XB_SPIN(xb_ld(&bar[XB_TOPGEN]) == tg, bar);
            __builtin_amdgcn_fence(__ATOMIC_ACQUIRE, "agent");
            xb_add(&bar[XB_XGEN(b.x)], 1u);
            asm volatile("s_waitcnt vmcnt(0)" ::: "memory");
        } else {
            XB_SPIN(xb_ld(&bar[XB_XGEN(b.x)]) == gen, bar);
            __builtin_amdgcn_fence(__ATOMIC_ACQUIRE, "agent");
            asm volatile("s_waitcnt vmcnt(0)" ::: "memory");
        }
    }
    __syncthreads();
}

namespace pg8 {
constexpr int BM = 256, BK = 64, HALF = 128, HTB = HALF * BK * 2, STAGE_BYTES = 8 * HTB, NXCD = 8, WGM = 8;
__host__ __device__ __forceinline__ int lds_byte(int r, int c) { const int st = (r >> 4) * 2 + (c >> 5), rr = r & 15, cc = c & 31, ob = rr * 64 + cc * 2; return st * 1024 + (ob ^ (((ob >> 9) & 1) << 5)); }
__host__ __device__ __forceinline__ void stage_rc(int b, int& R, int& C) { const int st = b / 1024, sb = b % 1024, swz = sb ^ (((sb >> 9) & 1) << 5); R = (st >> 1) * 16 + swz / 64; C = (st & 1) * 32 + (swz % 64) / 2; }
__host__ __device__ __forceinline__ int perm32(int rho) { const int n = rho >> 4, i = rho & 15; return 8 * (i >> 2) + 4 * n + (i & 3); }
struct Unit { int pm, pn, e; };
struct Gemm { const void* A; const void* Bt; int K, lda, ldb; const int* rowidx; size_t bstride; };
struct StaticOrder {
    int nM, nN, nwg, G, c; const int* tile_e;
    __device__ void init(int nM_, int nN_, int G_, int c_, const int* te) { nM = nM_; nN = nN_; nwg = nM * nN; G = G_; c = c_; tile_e = te; }
    __device__ bool next(int i, Unit& u) const {
        const long L = (long)i * G + c; if (L >= nwg) return false;
        int wgid = (int)L; { const int q = nwg / NXCD, r = nwg % NXCD, xcd = wgid % NXCD, off = wgid / NXCD; wgid = (xcd < r ? xcd * (q + 1) : r * (q + 1) + (xcd - r) * q) + off; }
        const int nig = WGM * nN, gid = wgid / nig, fm = gid * WGM, gsz = (nM - fm) < WGM ? (nM - fm) : WGM;
        u.pm = fm + ((wgid % nig) % gsz); u.pn = (wgid % nig) / gsz; u.e = tile_e ? tile_e[u.pm] : 0; return true;
    }
};
typedef f32x4 Acc[2][2][4][2];
typedef int v8i_t __attribute__((ext_vector_type(8)));
typedef int v4i_t __attribute__((ext_vector_type(4)));
template <class Epi, bool GATHER, bool FP8 = false>
__device__ __forceinline__ void gemm_phase(LAS unsigned char* lds, const Gemm g, const StaticOrder& S, const Epi& E, const int wid, const bool do_epi = true) {
    const int lane = lane_id(), tid = wid * 64 + lane, wr = wid >> 2, wc = wid & 3, fr = lane & 15, fq = lane >> 4;
    constexpr int ES = FP8 ? 1 : 2;
    const int K = g.K, nt = K * ES / 128;
    int RA[2], CA[2]; unsigned voffB[2], voffA[2];
#pragma unroll
    for (int i = 0; i < 2; ++i) { int R, C; stage_rc(tid * 16 + i * 8192, R, C); const int Rb = Epi::PERM ? ((R & ~31) + perm32(R & 31)) : R;
        RA[i] = R; CA[i] = C; voffB[i] = (unsigned)(Rb * g.ldb * ES + C * 2); voffA[i] = (unsigned)(R * g.lda * ES + C * 2); }
    const size_t hstepA = GATHER ? 0 : (size_t)HALF * g.lda * ES;
    const size_t kstep = (size_t)(BK * 2);
    const size_t hstepB = (size_t)HALF * g.ldb * ES;
    const unsigned ldsw = (unsigned)wid * 1024u;
    const int aoff = lds_byte(wr * 64 + fr, fq * 8), boff = lds_byte(wc * 32 + fr, fq * 8);
#define PG8_SA(b, h) (((b) * 2 + (h)) * HTB)
#define PG8_SB(b, h) ((4 + (b) * 2 + (h)) * HTB)
#define PG8_STAGE(bufoff, gbase, voff) do { _Pragma("unroll") for (int _i = 0; _i < 2; ++_i) \
        __builtin_amdgcn_global_load_lds((const unsigned*)((const char*)(gbase) + (voff)[_i]), (LAS unsigned*)(lds + (bufoff) + ldsw + _i * 8192), 16, 0, 0); } while (0)
#define PG8_LDA(dst, b, h) do { _Pragma("unroll") for (int m = 0; m < 4; ++m) _Pragma("unroll") for (int k = 0; k < 2; ++k) dst[m][k] = *(const LAS bf16x8*)(lds + PG8_SA(b, h) + aoff + m * 2048 + k * 1024); } while (0)
#define PG8_LDB(dst, b, h) do { _Pragma("unroll") for (int n = 0; n < 2; ++n) _Pragma("unroll") for (int k = 0; k < 2; ++k) dst[n][k] = *(const LAS bf16x8*)(lds + PG8_SB(b, h) + boff + n * 2048 + k * 1024); } while (0)
#define PG8_CAT8(x) __builtin_shufflevector(__builtin_bit_cast(v4i_t, (x)[0]), __builtin_bit_cast(v4i_t, (x)[1]), 0, 1, 2, 3, 4, 5, 6, 7)
#define PG8_MMA(ai, bj, At, Bt) do { __builtin_amdgcn_s_setprio(1); if constexpr (FP8) { _Pragma("unroll") for (int m = 0; m < 4; ++m) _Pragma("unroll") for (int n = 0; n < 2; ++n) \
        acc[ai][bj][m][n] = __builtin_amdgcn_mfma_scale_f32_16x16x128_f8f6f4(PG8_CAT8(Bt[n]), PG8_CAT8(At[m]), acc[ai][bj][m][n], 0, 0, 0, 0x7f7f7f7f, 0, 0x7f7f7f7f); \
        _Pragma("unroll") for (int m = 0; m < 4; ++m) _Pragma("unroll") for (int n = 0; n < 2; ++n) asm volatile("" : "+v"(acc[ai][bj][m][n]));   } else { \
        _Pragma("unroll") for (int m = 0; m < 4; ++m) _Pragma("unroll") for (int n = 0; n < 2; ++n) _Pragma("unroll") for (int k = 0; k < 2; ++k) \
        acc[ai][bj][m][n] = __builtin_amdgcn_mfma_f32_16x16x32_bf16(Bt[n][k], At[m][k], acc[ai][bj][m][n], 0, 0, 0); } __builtin_amdgcn_s_setprio(0); } while (0)
#define PG8_WAIT_V(n) asm volatile("s_waitcnt vmcnt(" #n ")" ::: "memory")
#define PG8_WAIT_L(n) asm volatile("s_waitcnt lgkmcnt(" #n ")" ::: "memory")
#define PG8_BAR __builtin_amdgcn_s_barrier()
#define PG8_SCHED __builtin_amdgcn_sched_barrier(0)
#define PG8_SETVO(vo, u) do { if constexpr (GATHER) { _Pragma("unroll") for (int _h = 0; _h < 2; ++_h) _Pragma("unroll") for (int _i = 0; _i < 2; ++_i) { \
        const int _row = g.rowidx[(u).pm * BM + _h * HALF + RA[_i]]; (vo)[_h][_i] = (unsigned)_row * (unsigned)(g.lda * ES) + (unsigned)CA[_i] * 2u; } } } while (0)
#define PG8_STAGE_A(bufoff, base, h, vog) do { if constexpr (GATHER) { PG8_STAGE(bufoff, base, (vog)[h]); } else { PG8_STAGE(bufoff, (base) + (h) * hstepA, voffA); } } while (0)
    Unit cur, nxt; int ui = 0;
    if (!S.next(0, cur)) return;
    Acc acc;
#pragma unroll
    for (int a = 0; a < 2; ++a)
#pragma unroll
        for (int b = 0; b < 2; ++b)
#pragma unroll
            for (int m = 0; m < 4; ++m)
#pragma unroll
                for (int n = 0; n < 2; ++n) acc[a][b][m][n] = (f32x4){0.f, 0.f, 0.f, 0.f};
    bf16x8 At[4][2], B0[2][2], B1[2][2];
    unsigned voC[2][2], voN[2][2];
    PG8_SETVO(voC, cur);
    const char* const Ab = (const char*)g.A;
    const char* cA = GATHER ? Ab : Ab + (size_t)cur.pm * 2 * hstepA;
    const char* cB = (const char*)g.Bt + (size_t)cur.e * g.bstride + (size_t)cur.pn * 2 * hstepB;
    PG8_STAGE(PG8_SB(0, 0), cB, voffB); PG8_STAGE(PG8_SB(0, 1), cB + hstepB, voffB); PG8_STAGE_A(PG8_SA(0, 0), cA, 0, voC); PG8_STAGE_A(PG8_SA(0, 1), cA, 1, voC);
    if (wr == 1) PG8_BAR;
    PG8_WAIT_V(2); PG8_BAR;
    PG8_STAGE(PG8_SB(1, 0), cB + kstep, voffB); PG8_STAGE_A(PG8_SA(1, 0), cA + kstep, 0, voC); PG8_STAGE(PG8_SB(1, 1), cB + hstepB + kstep, voffB);
    PG8_WAIT_V(6); PG8_BAR;
    for (;;) {
        const bool has_next = S.next(ui + 1, nxt);
        const char* nB = has_next ? (const char*)g.Bt + (size_t)nxt.e * g.bstride + (size_t)nxt.pn * 2 * hstepB : cB;
        const char* nA = (has_next && !GATHER) ? Ab + (size_t)nxt.pm * 2 * hstepA : cA;
        if constexpr (GATHER) { if (has_next) { PG8_SETVO(voN, nxt); } else {
#pragma unroll
            for (int h = 0; h < 2; ++h)
#pragma unroll
                for (int i = 0; i < 2; ++i) voN[h][i] = voC[h][i]; } }
        for (int t = 0; t < nt; t += 2) {
            const bool last = (t == nt - 2);
            if constexpr (Epi::MIDK > 0) { if (t == Epi::MIDK) { const int l2 = lane_id(); E.mid(acc, cur, wr, wc, l2 & 15, l2 >> 4); } }
            const char* a1 = cA + (size_t)(t + 1) * kstep;
            const char* a2 = last ? nA : cA + (size_t)(t + 2) * kstep; const char* b2 = last ? nB : cB + (size_t)(t + 2) * kstep;
            const char* a3 = a2 + kstep; const char* b3 = b2 + kstep;
            unsigned o2[2][2];
            if constexpr (GATHER) {
#pragma unroll
            for (int h = 0; h < 2; ++h)
#pragma unroll
                for (int i = 0; i < 2; ++i) o2[h][i] = last ? voN[h][i] : voC[h][i]; }
            PG8_LDB(B0, 0, 0); PG8_LDB(B1, 0, 1); PG8_SCHED; PG8_LDA(At, 0, 0); PG8_STAGE_A(PG8_SA(1, 1), a1, 1, voC);
            PG8_WAIT_V(8); PG8_WAIT_L(0); PG8_BAR; PG8_MMA(0, 0, At, B0); PG8_MMA(0, 1, At, B1); PG8_BAR; PG8_SCHED;
            PG8_LDA(At, 0, 1); PG8_STAGE(PG8_SB(0, 0), b2, voffB); PG8_STAGE(PG8_SB(0, 1), b2 + hstepB, voffB); PG8_STAGE_A(PG8_SA(0, 0), a2, 0, o2);
            PG8_WAIT_V(8); PG8_WAIT_L(0); PG8_BAR; PG8_MMA(1, 0, At, B0); PG8_MMA(1, 1, At, B1); PG8_BAR; PG8_SCHED;
            PG8_LDB(B0, 1, 0); PG8_LDB(B1, 1, 1); PG8_SCHED; PG8_LDA(At, 1, 0); PG8_STAGE_A(PG8_SA(0, 1), a2, 1, o2);
            PG8_WAIT_V(8); PG8_WAIT_L(0); PG8_BAR; PG8_MMA(0, 0, At, B0); PG8_MMA(0, 1, At, B1); PG8_BAR; PG8_SCHED;
            PG8_LDA(At, 1, 1); PG8_STAGE(PG8_SB(1, 0), b3, voffB); PG8_STAGE(PG8_SB(1, 1), b3 + hstepB, voffB); PG8_STAGE_A(PG8_SA(1, 0), a3, 0, o2);
            PG8_WAIT_V(8); PG8_WAIT_L(0); PG8_BAR; PG8_MMA(1, 0, At, B0); PG8_MMA(1, 1, At, B1); PG8_BAR; PG8_SCHED;
        }
        if (wr == 0) PG8_BAR;
        if (do_epi) { const int l2 = lane_id(); E(acc, cur, wr, wc, l2 & 15, l2 >> 4); }
        if (!has_next) break;
#pragma unroll
        for (int a = 0; a < 2; ++a)
#pragma unroll
            for (int b = 0; b < 2; ++b)
#pragma unroll
                for (int m = 0; m < 4; ++m)
#pragma unroll
                    for (int n = 0; n < 2; ++n) acc[a][b][m][n] = (f32x4){0.f, 0.f, 0.f, 0.f};
        cur = nxt; cB = nB; cA = nA; ++ui;
        if constexpr (GATHER) {
#pragma unroll
        for (int h = 0; h < 2; ++h)
#pragma unroll
            for (int i = 0; i < 2; ++i) voC[h][i] = voN[h][i]; }
        if (wr == 1) PG8_BAR;
    }
    PG8_WAIT_V(0);
    PG8_BAR;
#undef PG8_SA
#undef PG8_SB
#undef PG8_STAGE
#undef PG8_LDA
#undef PG8_LDB
#undef PG8_MMA
#undef PG8_CAT8
#undef PG8_WAIT_V
#undef PG8_WAIT_L
#undef PG8_BAR
#undef PG8_SCHED
#undef PG8_SETVO
#undef PG8_STAGE_A
}

__device__ __forceinline__ unsigned pk4_fp8(f32x4 v) { unsigned w = 0; w = __builtin_amdgcn_cvt_pk_fp8_f32(v[0], v[1], w, false); w = __builtin_amdgcn_cvt_pk_fp8_f32(v[2], v[3], w, true); return w; }
__device__ __forceinline__ float sq4(f32x4 v) { return (v[0] * v[0] + v[1] * v[1]) + (v[2] * v[2] + v[3] * v[3]); }
__device__ __forceinline__ float red_fq(float s) { s += __shfl_xor(s, 16); s += __shfl_xor(s, 32); return s; }
__device__ __forceinline__ u32x4 pack8(f32x4 a, f32x4 b) { u32x4 w; w.x = cvt_pk_bf16(a[0], a[1]); w.y = cvt_pk_bf16(a[2], a[3]); w.z = cvt_pk_bf16(b[0], b[1]); w.w = cvt_pk_bf16(b[2], b[3]); return w; }
template <int MODE> struct EpiBf16Stats {
    static constexpr bool PERM = true; static constexpr int MIDK = 0;
    bf16_t* O; int ldc; float* ssq; const float* rsx;
    __device__ __forceinline__ void operator()(const Acc& acc, const Unit& u, int wr, int wc, int fr, int fq) const {
        const int row0 = u.pm * BM + wr * 64 + fr, col0 = u.pn * BM + wc * 32 + 8 * fq;
        float rv[2][4];
#pragma unroll
        for (int ai = 0; ai < 2; ++ai)
#pragma unroll
            for (int m = 0; m < 4; ++m) rv[ai][m] = rsx ? rsx[row0 + ai * HALF + m * 16] : 1.f;
        asm volatile("" ::: "memory");
#pragma unroll
        for (int ai = 0; ai < 2; ++ai)
#pragma unroll
            for (int m = 0; m < 4; ++m) { const int row = row0 + ai * HALF + m * 16; bf16_t* rowp = O + (size_t)row * ldc + col0; const float rs = rv[ai][m];
                const f32x4 a00 = acc[ai][0][m][0] * rs, a01 = acc[ai][0][m][1] * rs, a10 = acc[ai][1][m][0] * rs, a11 = acc[ai][1][m][1] * rs;
                if (MODE == 0 && u.pn >= 4) { *(u32x4*)(O + (size_t)row * ldc + 960 + (u.pn - 4) * HALF + wc * 32 + 8 * fq) = pack8(a00 * a10, a01 * a11); continue; }
                *(u32x4*)(rowp) = pack8(a00, a01); if (!(MODE == 0 && u.pn == 3 && wc >= 2)) *(u32x4*)(rowp + HALF) = pack8(a10, a11);
                if (MODE == 1) { float s = (sq4(a00) + sq4(a01)) + (sq4(a10) + sq4(a11)); s = red_fq(s); if (fq == 0) ssq[(size_t)row * 16 + u.pn * 4 + wc] = s; }
                else if (u.pn == 0) { float s = (sq4(a00) + sq4(a01)) + (sq4(a10) + sq4(a11)); s = red_fq(s); if (fq == 0) ssq[(size_t)row * 8 + wc] = s; }
                else if (u.pn == 1) { float s = sq4(a00) + sq4(a01); s = red_fq(s); if (fq == 0) ssq[(size_t)row * 8 + 4 + wc] = s; } }
    }
};
struct EpiQ {
    static constexpr bool PERM = true; static constexpr int MIDK = 0;
    bf16_t* Q; const float* ssq; const float* cs;
    __device__ __forceinline__ void operator()(const Acc& acc, const Unit& u, int wr, int wc, int fr, int fq) const {
        const int row0 = u.pm * BM + wr * 64 + fr;
#pragma unroll
        for (int ai = 0; ai < 2; ++ai)
#pragma unroll
            for (int m = 0; m < 4; ++m) { const int row = row0 + ai * HALF + m * 16; const f32x4 sv = *(const f32x4*)(ssq + (size_t)row * 8);
                const float rs = rsqrtf(((sv[0] + sv[1]) + (sv[2] + sv[3])) * (1.f / QL) + EPS); const int b = row / SEQ, s = row % SEQ;
#pragma unroll
                for (int bj = 0; bj < 2; ++bj) { const int cv = u.pn * BM + bj * HALF + wc * 32 + 8 * fq; const int h = cv / DQK, d = cv % DQK;
                    f32x4 v0 = acc[ai][bj][m][0] * rs, v1 = acc[ai][bj][m][1] * rs;
                    if (d >= DN) { const int i0 = (d - DN) >> 1; const f32x4 c = *(const f32x4*)(cs + (size_t)row * 64 + i0), sn = *(const f32x4*)(cs + (size_t)row * 64 + 32 + i0);
                        const f32x4 r0 = {v0[0] * c[0] - v0[1] * sn[0], v0[0] * sn[0] + v0[1] * c[0], v0[2] * c[1] - v0[3] * sn[1], v0[2] * sn[1] + v0[3] * c[1]};
                        const f32x4 r1 = {v1[0] * c[2] - v1[1] * sn[2], v1[0] * sn[2] + v1[1] * c[2], v1[2] * c[3] - v1[3] * sn[3], v1[2] * sn[3] + v1[3] * c[3]};
                        v0 = r0; v1 = r1; }
                    *(u32x4*)(Q + ((size_t)(b * NH + h) * SEQ + s) * DQK + d) = pack8(v0, v1); } }
    }
};
struct EpiKV {
    static constexpr bool PERM = true; static constexpr int MIDK = 0;
    bf16_t* Kc; bf16_t* Vc; const float* ssq;
    __device__ __forceinline__ void operator()(const Acc& acc, const Unit& u, int wr, int wc, int fr, int fq) const {
        const int row0 = u.pm * BM + wr * 64 + fr, d = wc * 32 + 8 * fq, h = u.pn;
#pragma unroll
        for (int ai = 0; ai < 2; ++ai)
#pragma unroll
            for (int m = 0; m < 4; ++m) { const int row = row0 + ai * HALF + m * 16; const f32x4 sv = *(const f32x4*)(ssq + (size_t)row * 8 + 4);
                const float rs = rsqrtf(((sv[0] + sv[1]) + (sv[2] + sv[3])) * (1.f / KVL) + EPS); const int b = row / SEQ, s = row % SEQ; const size_t t = (size_t)(b * NH + h) * SEQ + s;
                *(u32x4*)(Kc + t * DQK + d) = pack8(acc[ai][0][m][0] * rs, acc[ai][0][m][1] * rs);
                *(u32x4*)(Vc + t * DV + d) = pack8(acc[ai][1][m][0] * rs, acc[ai][1][m][1] * rs); }
    }
};
struct EpiWo {
    static constexpr bool PERM = true; static constexpr int MIDK = 8;
    const bf16_t* x; bf16_t* HBF; unsigned char* X8; const float* assq; float* ssq1; const float* gmoe;
    __device__ __forceinline__ void mid(Acc& acc, const Unit& u, int wr, int wc, int fr, int fq) const {
        const int row0 = u.pm * BM + wr * 64 + fr;
#pragma unroll
        for (int ai = 0; ai < 2; ++ai)
#pragma unroll
            for (int m = 0; m < 4; ++m) { const f32x4 sv = *(const f32x4*)(assq + (size_t)(row0 + ai * HALF + m * 16) * 4);
                const float rs = rsqrtf(((sv[0] + sv[1]) + (sv[2] + sv[3])) * (1.f / 512.f) + EPS);
#pragma unroll
                for (int bj = 0; bj < 2; ++bj)
#pragma unroll
                    for (int n = 0; n < 2; ++n) acc[ai][bj][m][n] = acc[ai][bj][m][n] * rs; }
    }
    __device__ __forceinline__ void operator()(const Acc& acc, const Unit& u, int wr, int wc, int fr, int fq) const {
        const int row0 = u.pm * BM + wr * 64 + fr, col0 = u.pn * BM + wc * 32 + 8 * fq;
        f32x4 gn[2][2];
#pragma unroll
        for (int bj = 0; bj < 2; ++bj) { gn[bj][0] = *(const f32x4*)(gmoe + col0 + bj * HALF); gn[bj][1] = *(const f32x4*)(gmoe + col0 + bj * HALF + 4); }
#pragma unroll
        for (int ai = 0; ai < 2; ++ai) { u32x4 xv[4][2];
#pragma unroll
            for (int m = 0; m < 4; ++m) { const size_t off = (size_t)(row0 + ai * HALF + m * 16) * DM + col0;
#pragma unroll
                for (int bj = 0; bj < 2; ++bj) xv[m][bj] = *(const u32x4*)(x + off + bj * HALF); }
            asm volatile("" ::: "memory");
#pragma unroll
            for (int m = 0; m < 4; ++m) { const int row = row0 + ai * HALF + m * 16; const size_t off = (size_t)row * DM + col0; float ss = 0.f;
#pragma unroll
                for (int bj = 0; bj < 2; ++bj) { const u32x4 xq = xv[m][bj]; const f32x4 h0 = (f32x4){blo(xq.x), bhi(xq.x), blo(xq.y), bhi(xq.y)} + acc[ai][bj][m][0], h1 = (f32x4){blo(xq.z), bhi(xq.z), blo(xq.w), bhi(xq.w)} + acc[ai][bj][m][1];
                    *(u32x4*)(HBF + off + bj * HALF) = pack8(h0, h1); *(u32x2*)(X8 + off + bj * HALF) = (u32x2){pk4_fp8(h0 * gn[bj][0]), pk4_fp8(h1 * gn[bj][1])}; ss += sq4(h0) + sq4(h1); }
                ss = red_fq(ss); if (fq == 0) ssq1[(size_t)row * 16 + u.pn * 4 + wc] = ss; }
            asm volatile("" ::: "memory"); }
    }
};
__device__ __forceinline__ f32x4 sigmoid4(f32x4 a) { const f32x4 t = a * -1.44269504f; f32x4 e; e[0] = __builtin_amdgcn_exp2f(t[0]); e[1] = __builtin_amdgcn_exp2f(t[1]); e[2] = __builtin_amdgcn_exp2f(t[2]); e[3] = __builtin_amdgcn_exp2f(t[3]);
    const f32x4 d = e + 1.0f; f32x4 r; r[0] = __builtin_amdgcn_rcpf(d[0]); r[1] = __builtin_amdgcn_rcpf(d[1]); r[2] = __builtin_amdgcn_rcpf(d[2]); r[3] = __builtin_amdgcn_rcpf(d[3]); return r; }
__device__ __forceinline__ f32x2 swiglu2(f32x2 g, f32x2 u) {
    g.x = fminf(g.x, 7.f); g.y = fminf(g.y, 7.f); u.x = __builtin_amdgcn_fmed3f(u.x, -7.f, 7.f); u.y = __builtin_amdgcn_fmed3f(u.y, -7.f, 7.f);
    const f32x2 t = g * -2.45546696f; f32x2 e; e.x = __builtin_amdgcn_exp2f(t.x); e.y = __builtin_amdgcn_exp2f(t.y); const f32x2 d = e + 1.0f; f32x2 r; r.x = __builtin_amdgcn_rcpf(d.x); r.y = __builtin_amdgcn_rcpf(d.y);
    const f32x2 gs = g * r; return u * gs + gs; }
__device__ __forceinline__ float swiglu_f(float g, float u) { g = fminf(g, 7.f); u = __builtin_amdgcn_fmed3f(u, -7.f, 7.f); const float gs = g * __builtin_amdgcn_rcpf(1.f + __builtin_amdgcn_exp2f(g * -2.45546696f)); return fmaf(u, gs, gs); }
constexpr float WSCALE = 64.f, WINV = 1.f / 64.f;
struct EpiMoe1 {
    static constexpr bool PERM = true; static constexpr int MIDK = 0;
    unsigned char* HB; const float* b1; const float* rowrs;
    __device__ __forceinline__ void operator()(const Acc& acc, const Unit& u, int wr, int wc, int fr, int fq) const {
        const int row0 = u.pm * BM + wr * 64 + fr, j0 = u.pn * HALF + wc * 32 + 8 * fq; const float* bg = b1 + (size_t)u.e * 2048 + j0;
        const f32x4 g0 = *(const f32x4*)bg, g1 = *(const f32x4*)(bg + 4), u0 = *(const f32x4*)(bg + 1024), u1 = *(const f32x4*)(bg + 1028);
        float rsv[2][4];
#pragma unroll
        for (int ai = 0; ai < 2; ++ai)
#pragma unroll
            for (int m = 0; m < 4; ++m) rsv[ai][m] = rowrs[row0 + ai * HALF + m * 16];
        asm volatile("" ::: "memory");
#pragma unroll
        for (int ai = 0; ai < 2; ++ai)
#pragma unroll
            for (int m = 0; m < 4; ++m) { const float rs = rsv[ai][m] * WINV;
                const f32x4 a0 = acc[ai][0][m][0] * rs + g0, a1 = acc[ai][0][m][1] * rs + g1, c0 = acc[ai][1][m][0] * rs + u0, c1 = acc[ai][1][m][1] * rs + u1; f32x4 r0, r1;
#pragma unroll
                for (int j = 0; j < 4; j += 2) { const f32x2 s0 = swiglu2((f32x2){a0[j], a0[j + 1]}, (f32x2){c0[j], c0[j + 1]}), s1 = swiglu2((f32x2){a1[j], a1[j + 1]}, (f32x2){c1[j], c1[j + 1]}); r0[j] = s0.x; r0[j + 1] = s0.y; r1[j] = s1.x; r1[j + 1] = s1.y; }
                *(u32x2*)(HB + (size_t)(row0 + ai * HALF + m * 16) * DE + j0) = (u32x2){pk4_fp8(r0), pk4_fp8(r1)}; }
    }
};
struct EpiMoe2 {
    static constexpr bool PERM = true; static constexpr int MIDK = 0;
    unsigned char* Y; const float* b2; const int* rowslot; const float* rowgate;
    __device__ __forceinline__ void operator()(const Acc& acc, const Unit& u, int wr, int wc, int fr, int fq) const {
        const int row0 = u.pm * BM + wr * 64 + fr, col0 = u.pn * BM + wc * 64 + 16 * fq; const float* bb = b2 + (size_t)u.e * DM + col0;
        f32x4 bv[2][2];
#pragma unroll
        for (int bj = 0; bj < 2; ++bj)
#pragma unroll
            for (int n = 0; n < 2; ++n) bv[bj][n] = *(const f32x4*)(bb + bj * 8 + 4 * n);
        float gtv[2][4]; int slv[2][4];
#pragma unroll
        for (int ai = 0; ai < 2; ++ai)
#pragma unroll
            for (int m = 0; m < 4; ++m) { const int r = row0 + ai * HALF + m * 16; gtv[ai][m] = rowgate[r]; slv[ai][m] = rowslot[r]; }
        asm volatile("" ::: "memory");
#pragma unroll
        for (int ai = 0; ai < 2; ++ai)
#pragma unroll
            for (int m = 0; m < 4; ++m) { const float gt = gtv[ai][m]; unsigned char* yp = Y + (size_t)slv[ai][m] * DM + col0;
                *(u32x4*)yp = (u32x4){pk4_fp8((acc[ai][0][m][0] * WINV + bv[0][0]) * gt), pk4_fp8((acc[ai][0][m][1] * WINV + bv[0][1]) * gt), pk4_fp8((acc[ai][1][m][0] * WINV + bv[1][0]) * gt), pk4_fp8((acc[ai][1][m][1] * WINV + bv[1][1]) * gt)}; }
    }
};
struct EpiPle {
    static constexpr bool PERM = true; static constexpr int MIDK = 0;
    const bf16_t* H2; bf16_t* H3; const bf16_t* pler; const float* rpv; const float* rs2; const float* pg; float* fssq;
    __device__ __forceinline__ void operator()(const Acc& acc, const Unit& u, int wr, int wc, int fr, int fq) const {
        const int row0 = u.pm * BM + wr * 64 + fr, col0 = u.pn * BM + wc * 32 + 8 * fq;
        f32x4 gv[2][2];
#pragma unroll
        for (int bj = 0; bj < 2; ++bj)
#pragma unroll
            for (int n = 0; n < 2; ++n) gv[bj][n] = *(const f32x4*)(pg + col0 + bj * HALF + n * 4);
#pragma unroll
        for (int am = 0; am < 4; ++am) { const int ai = am >> 1; u32x4 hq[2][2], pq[2][2]; float r2v[2], rpq[2];
#pragma unroll
            for (int mm = 0; mm < 2; ++mm) { const int row = row0 + ai * HALF + ((am & 1) * 2 + mm) * 16; const size_t off = (size_t)row * DM + col0; r2v[mm] = rs2[row]; rpq[mm] = rpv[row];
#pragma unroll
                for (int bj = 0; bj < 2; ++bj) { hq[mm][bj] = *(const u32x4*)(H2 + off + bj * HALF); pq[mm][bj] = *(const u32x4*)(pler + off + bj * HALF); } }
            asm volatile("" ::: "memory");
#pragma unroll
            for (int mm = 0; mm < 2; ++mm) { const int m = (am & 1) * 2 + mm; const int row = row0 + ai * HALF + m * 16; const size_t off = (size_t)row * DM + col0; const float r2 = r2v[mm], rp = rpq[mm]; float ss = 0.f;
#pragma unroll
                for (int bj = 0; bj < 2; ++bj) { const size_t o = off + bj * HALF; const u32x4 hv = hq[mm][bj], pr = pq[mm][bj];
                    const f32x4 h0 = {blo(hv.x), bhi(hv.x), blo(hv.y), bhi(hv.y)}, h1 = {blo(hv.z), bhi(hv.z), blo(hv.w), bhi(hv.w)};
                    const f32x4 q0 = {blo(pr.x), bhi(pr.x), blo(pr.y), bhi(pr.y)}, q1 = {blo(pr.z), bhi(pr.z), blo(pr.w), bhi(pr.w)};
                    const f32x4 r0 = h0 + sigmoid4(acc[ai][bj][m][0] * r2) * (q0 * (gv[bj][0] * rp)), r1 = h1 + sigmoid4(acc[ai][bj][m][1] * r2) * (q1 * (gv[bj][1] * rp));
                    *(u32x4*)(H3 + o) = pack8(r0, r1); ss += sq4(r0) + sq4(r1); }
                ss = red_fq(ss); if (fq == 0) fssq[(size_t)row * 16 + u.pn * 4 + wc] = ss; }
            asm volatile("" ::: "memory"); }
    }
};
struct EpiPleFinal {
    static constexpr bool PERM = true; static constexpr int MIDK = 0;
    const bf16_t* H2; float* out; const bf16_t* pler; const float* rpv; const float* rs2; const float* pg; const float* gf; float* xs; unsigned* cnt; unsigned* tmo; LAS unsigned char* lds;
    __device__ __forceinline__ void operator()(Acc& acc, const Unit& u, int wr, int wc, int fr, int fq) const {
        const int row0 = u.pm * BM + wr * 64 + fr, col0 = u.pn * BM + wc * 32 + 8 * fq;
        LAS float* P = (LAS float*)(lds + STG_OFF); LAS float* S = P + 1024; const int tid = (wr * 4 + wc) * 64 + fq * 16 + fr;
#define PF_BAR() asm volatile("s_waitcnt lgkmcnt(0)\n\ts_barrier" ::: "memory")
        { f32x4 gv[2][2];
#pragma unroll
          for (int bj = 0; bj < 2; ++bj)
#pragma unroll
            for (int n = 0; n < 2; ++n) gv[bj][n] = *(const f32x4*)(pg + col0 + bj * HALF + n * 4);
#pragma unroll
          for (int am = 0; am < 4; ++am) { const int ai = am >> 1; u32x4 hq[2][2], pq[2][2]; float r2v[2], rpq[2];
#pragma unroll
            for (int mm = 0; mm < 2; ++mm) { const int row = row0 + ai * HALF + ((am & 1) * 2 + mm) * 16; const size_t off = (size_t)row * DM + col0; r2v[mm] = rs2[row]; rpq[mm] = rpv[row];
#pragma unroll
                for (int bj = 0; bj < 2; ++bj) { hq[mm][bj] = *(const u32x4*)(H2 + off + bj * HALF); pq[mm][bj] = *(const u32x4*)(pler + off + bj * HALF); } }
            asm volatile("" ::: "memory");
#pragma unroll
            for (int mm = 0; mm < 2; ++mm) { const int m = (am & 1) * 2 + mm; const float r2 = r2v[mm], rp = rpq[mm]; float ss = 0.f;
#pragma unroll
                for (int bj = 0; bj < 2; ++bj) { const u32x4 hv = hq[mm][bj], pr = pq[mm][bj];
                    const f32x4 h0 = {blo(hv.x), bhi(hv.x), blo(hv.y), bhi(hv.y)}, h1 = {blo(hv.z), bhi(hv.z), blo(hv.w), bhi(hv.w)};
                    const f32x4 q0 = {blo(pr.x), bhi(pr.x), blo(pr.y), bhi(pr.y)}, q1 = {blo(pr.z), bhi(pr.z), blo(pr.w), bhi(pr.w)};
                    const f32x4 r0 = h0 + sigmoid4(acc[ai][bj][m][0] * r2) * (q0 * (gv[bj][0] * rp)), r1 = h1 + sigmoid4(acc[ai][bj][m][1] * r2) * (q1 * (gv[bj][1] * rp));
                    acc[ai][bj][m][0] = r0; acc[ai][bj][m][1] = r1; ss += sq4(r0) + sq4(r1); }
                ss = red_fq(ss); if (fq == 0) P[(ai * HALF + wr * 64 + m * 16 + fr) * 4 + wc] = ss; }
            asm volatile("" ::: "memory"); } }
        PF_BAR();
        if (tid < 256) { const f32x4 p4 = *(const LAS f32x4*)(P + tid * 4); __hip_atomic_store(xs + (size_t)(u.pm * 4 + u.pn) * 256 + tid, (p4[0] + p4[1]) + (p4[2] + p4[3]), __ATOMIC_RELAXED, __HIP_MEMORY_SCOPE_AGENT); }
        asm volatile("s_waitcnt vmcnt(0)" ::: "memory");
        PF_BAR();
        if (tid < 64) {
            if (tid == 0) (void)__hip_atomic_fetch_add(cnt + 64 * u.pm, 1u, __ATOMIC_RELAXED, __HIP_MEMORY_SCOPE_AGENT);
            unsigned sp = 0;
            while ((unsigned)__builtin_amdgcn_readfirstlane(__hip_atomic_load(cnt + 64 * u.pm, __ATOMIC_RELAXED, __HIP_MEMORY_SCOPE_AGENT)) < 4u) {
                __builtin_amdgcn_s_sleep(2); if (++sp > (1u << 22)) { if (tid == 0) __hip_atomic_store(tmo, 1u, __ATOMIC_RELAXED, __HIP_MEMORY_SCOPE_AGENT); break; } }
            __builtin_amdgcn_fence(__ATOMIC_ACQUIRE, "agent");
            asm volatile("s_waitcnt vmcnt(0)" ::: "memory"); }
        PF_BAR();
        if (tid < 256) { float t = 0.f;
#pragma unroll
            for (int q = 0; q < 4; ++q) t += __hip_atomic_load(xs + (size_t)(u.pm * 4 + q) * 256 + tid, __ATOMIC_RELAXED, __HIP_MEMORY_SCOPE_AGENT);
            S[tid] = rsqrtf(t * (1.f / DM) + EPS); }
        PF_BAR();
        { f32x4 gq[2][2];
#pragma unroll
          for (int bj = 0; bj < 2; ++bj)
#pragma unroll
            for (int n = 0; n < 2; ++n) gq[bj][n] = *(const f32x4*)(gf + col0 + bj * HALF + n * 4);
#pragma unroll
          for (int ai = 0; ai < 2; ++ai)
#pragma unroll
            for (int m = 0; m < 4; ++m) { const float rs = S[ai * HALF + wr * 64 + m * 16 + fr]; float* op = out + (size_t)(row0 + ai * HALF + m * 16) * DM + col0;
#pragma unroll
                for (int bj = 0; bj < 2; ++bj) { *(f32x4*)(op + bj * HALF) = acc[ai][bj][m][0] * rs * gq[bj][0]; *(f32x4*)(op + bj * HALF + 4) = acc[ai][bj][m][1] * rs * gq[bj][1]; } } }
        PF_BAR();
#undef PF_BAR
    }
};
}

namespace att {
typedef float f32x16 __attribute__((ext_vector_type(16)));
typedef short s16x4 __attribute__((ext_vector_type(4)));
constexpr int QBLK = 32, KVBLK = 64, QB = 256;
constexpr int SHM_K = KVBLK * DQK * 2, SHM_V = KVBLK * DV * 2;
constexpr int L_V = 0, L_K = 2 * SHM_V, L_WS = L_K + 2 * SHM_K, L_END = L_WS + NWAVES * 256;
constexpr float THR = 8.f;
#define KSWZ(row, colB) ((row) * 384 + ((colB) ^ (((row) & 7) << 4)))
#define SBAR() __builtin_amdgcn_sched_barrier(0)
__device__ __forceinline__ int v_st(int k, int c) { const int kk = (k & ~0xC) | ((k & 4) << 1) | ((k & 8) >> 1); return ((kk >> 3) * 4 + (c >> 5)) * 512 + ((kk & 7) * 32 + (c & 31)) * 2; }
__device__ __forceinline__ int v_rd_base(int lane) { return ((lane & 3) << 3) | (((lane >> 2) & 3) << 6) | (((lane >> 4) & 1) << 5) | (((lane >> 5) & 1) << 8); }
constexpr int v_rd_off(int d0, int ks, int half) { return d0 * 512 + ks * 4096 + half * 2048; }
__device__ __forceinline__ int crow(int r, int hi) { return (r & 3) + 8 * (r >> 2) + 4 * hi; }
typedef __bf16 bf16x2_t __attribute__((ext_vector_type(2)));
__device__ __forceinline__ unsigned cvtpk(float lo, float hi) { f32x2 v = {lo, hi}; bf16x2_t b = __builtin_convertvector(v, bf16x2_t); return __builtin_bit_cast(unsigned, b); }

__device__ __forceinline__ void qkt(f32x16& p0, f32x16& p1, const LAS unsigned char* Kbuf, int r32, int hi, const bf16x8* qr) {
    p0 = f32x16{}; p1 = f32x16{};
    const LAS unsigned char* kb[4];
#pragma unroll
    for (int dd = 0; dd < 4; ++dd) kb[dd] = Kbuf + KSWZ(r32, (dd * 16 + hi * 8) * 2);
    bf16x8 kf[2][2];
#define KLD(d) do { const LAS unsigned char* a = kb[(d) & 3] + ((d) >> 2) * 128; kf[(d) & 1][0] = *(const LAS bf16x8*)a; kf[(d) & 1][1] = *(const LAS bf16x8*)(a + 32 * 384); } while (0)
    KLD(0);
#pragma unroll
    for (int d0 = 0; d0 < 12; ++d0) { if (d0 + 1 < 12) KLD(d0 + 1);
        p0 = __builtin_amdgcn_mfma_f32_32x32x16_bf16(kf[d0 & 1][0], qr[d0], p0, 0, 0, 0);
        p1 = __builtin_amdgcn_mfma_f32_32x32x16_bf16(kf[d0 & 1][1], qr[d0], p1, 0, 0, 0); }
#undef KLD
    __builtin_amdgcn_sched_group_barrier(0x100, 2, 0);
#pragma unroll
    for (int d0 = 0; d0 < 11; ++d0) { __builtin_amdgcn_sched_group_barrier(0x100, 2, 0); __builtin_amdgcn_sched_group_barrier(0x008, 2, 0); }
    __builtin_amdgcn_sched_group_barrier(0x008, 2, 0);
}
__device__ __forceinline__ void pv_tile(f32x16* o, int vb0, bf16x8 pa0, bf16x8 pa1, bf16x8 pa2, bf16x8 pa3) {
#define TRRD(dst, off) asm volatile("ds_read_b64_tr_b16 %0, %1 offset:%2" : "=&v"(dst) : "v"(vb0), "i"(off) : "memory")
#define PV_RD(S_, d0) do { constexpr int b_ = v_rd_off(d0, 0, 0); \
        TRRD(S_[0], b_); TRRD(S_[1], b_ + 2048); TRRD(S_[2], b_ + 4096); TRRD(S_[3], b_ + 6144); TRRD(S_[4], b_ + 8192); TRRD(S_[5], b_ + 10240); TRRD(S_[6], b_ + 12288); TRRD(S_[7], b_ + 14336); } while (0)
#define PV_MM(S_, d0) do { \
        o[d0] = __builtin_amdgcn_mfma_f32_32x32x16_bf16(pa0, (bf16x8){S_[0][0], S_[0][1], S_[0][2], S_[0][3], S_[1][0], S_[1][1], S_[1][2], S_[1][3]}, o[d0], 0, 0, 0); \
        o[d0] = __builtin_amdgcn_mfma_f32_32x32x16_bf16(pa1, (bf16x8){S_[2][0], S_[2][1], S_[2][2], S_[2][3], S_[3][0], S_[3][1], S_[3][2], S_[3][3]}, o[d0], 0, 0, 0); \
        o[d0] = __builtin_amdgcn_mfma_f32_32x32x16_bf16(pa2, (bf16x8){S_[4][0], S_[4][1], S_[4][2], S_[4][3], S_[5][0], S_[5][1], S_[5][2], S_[5][3]}, o[d0], 0, 0, 0); \
        o[d0] = __builtin_amdgcn_mfma_f32_32x32x16_bf16(pa3, (bf16x8){S_[6][0], S_[6][1], S_[6][2], S_[6][3], S_[7][0], S_[7][1], S_[7][2], S_[7][3]}, o[d0], 0, 0, 0); } while (0)
    s16x4 A_[8], B_[8];
    PV_RD(A_, 0);
    PV_RD(B_, 1); asm volatile("s_waitcnt lgkmcnt(8)" ::: "memory"); SBAR(); PV_MM(A_, 0); SBAR();
    PV_RD(A_, 2); asm volatile("s_waitcnt lgkmcnt(8)" ::: "memory"); SBAR(); PV_MM(B_, 1); SBAR();
    PV_RD(B_, 3); asm volatile("s_waitcnt lgkmcnt(8)" ::: "memory"); SBAR(); PV_MM(A_, 2); SBAR();
    asm volatile("s_waitcnt lgkmcnt(0)" ::: "memory"); SBAR(); PV_MM(B_, 3);
#undef PV_RD
#undef PV_MM
#undef TRRD
}
struct ConvJob { const float* w1; const float* w2; const float* gain; unsigned char* W1T; unsigned char* W2T; int gw, ngw; };
constexpr int CV_N1 = NE * 32 * 64, CV_N2 = NE * 32 * 32, CV_TOTAL = CV_N1 + CV_N2;
__device__ __forceinline__ int cv_cmap2(int n) { const int t = n & ~255, v = n & 255; return t + 64 * ((v >> 5) & 3) + 16 * ((v >> 3) & 3) + 8 * (v >> 7) + (v & 7); }
__device__ __forceinline__ int cv_cmap1(int n) { const int pn = n >> 8, half = (n >> 7) & 1, jj = n & 127; return half * 1024 + pn * 128 + jj; }
#define CV_DECODE(idx) \
    const bool cv_on = (idx) < CV_TOTAL; const bool cv_is1 = (idx) < CV_N1; const int cv_r = cv_is1 ? (idx) : (idx) - CV_N1; \
    const int cv_sh = cv_is1 ? 6 : 5, cv_ld = cv_is1 ? 2048 : 1024; const int cv_e = cv_r >> (cv_sh + 5), cv_q = cv_r & ((32 << cv_sh) - 1), cv_k0 = 32 * (cv_q >> cv_sh), cv_n0 = 32 * (cv_q & ((1 << cv_sh) - 1)); \
    const float* cv_src = (cv_is1 ? cj.w1 + (size_t)cv_e * 1024 * 2048 : cj.w2 + (size_t)cv_e * 1024 * 1024); \
    const int cv_c = cv_is1 ? cv_cmap1(cv_n0 + 4 * (lane & 7)) : cv_cmap2(cv_n0 + 4 * (lane & 7));
#define CV_LOAD() do { if (cv_on) { const char* cvb = (const char*)(cv_src + (size_t)cv_k0 * cv_ld); const unsigned cvo = (unsigned)(((lane >> 3) * cv_ld + cv_c) * 4);     \
        LAS unsigned char* scrb = lds + L_END + wid * 4224;     \
        _Pragma("unroll") for (int i = 0; i < 4; ++i) __builtin_amdgcn_global_load_lds((const unsigned*)(cvb + (size_t)(8 * i) * cv_ld * 4 + cvo), (LAS unsigned*)(scrb + i * 1056), 16, 0, 0); } } while (0)
#define CV_SV(j) (s[(2 * cc + ((j) >> 3)) * 264 + ((j) & 7) * 32])
#define CV_STORE() do { if (cv_on) { const LAS float* scr = (const LAS float*)(lds + L_END + wid * 4224); \
        { const int n = lane >> 1, cc = lane & 1; const LAS float* s = scr + n; u32x4 o; \
          o.x = pg8::pk4_fp8((f32x4){CV_SV(0), CV_SV(1), CV_SV(2), CV_SV(3)} * 64.f); o.y = pg8::pk4_fp8((f32x4){CV_SV(4), CV_SV(5), CV_SV(6), CV_SV(7)} * 64.f); \
          o.z = pg8::pk4_fp8((f32x4){CV_SV(8), CV_SV(9), CV_SV(10), CV_SV(11)} * 64.f); o.w = pg8::pk4_fp8((f32x4){CV_SV(12), CV_SV(13), CV_SV(14), CV_SV(15)} * 64.f); \
          unsigned char* dst = (cv_is1 ? cj.W1T + (size_t)cv_e * 2048 * 1024 : cj.W2T + (size_t)cv_e * 1024 * 1024) + (size_t)(cv_n0 + n) * 1024 + cv_k0 + 16 * cc; *(u32x4*)dst = o; } \
        asm volatile("s_waitcnt lgkmcnt(0)" ::: "memory"); } } while (0)
__device__ __forceinline__ void attn_block(int bh, int qb, const bf16_t* __restrict__ Q, const bf16_t* __restrict__ K, const bf16_t* __restrict__ V, bf16_t* __restrict__ MIX, float* __restrict__ ASSQ, LAS unsigned char* lds, const int wid, const ConvJob& cj, int& tseq) {
    const int lane = lane_id(), r32 = lane & 31, hi = lane >> 5;
    const int b = bh / NH, h = bh % NH;
    const bf16_t* Qw = Q + ((size_t)bh * SEQ + qb * QB + wid * QBLK + r32) * DQK;
    const bf16_t* Kh = K + (size_t)bh * SEQ * DQK; const bf16_t* Vh = V + (size_t)bh * SEQ * DV;
    bf16x8 qr[12];
#pragma unroll
    for (int d0 = 0; d0 < 12; ++d0) qr[d0] = *(const bf16x8*)(Qw + d0 * 16 + hi * 8);
    const int NT = 4 * qb + 4, qlo = qb * QB + wid * QBLK, qm = qlo + r32 - 4 * hi;
    LAS unsigned char* V_lds = lds + L_V; LAS unsigned char* K_lds = lds + L_K;
    LAS float* wsf = (LAS float*)(lds + L_WS) + wid * 64; LAS float* li_l = wsf; LAS float* al_l = wsf + 32;
    unsigned ksrc[3], vsrc[2];
#pragma unroll
    for (int i = 0; i < 3; ++i) { const int off = ((wid + 8 * i) * 64 + lane) * 16, row = off / 384, wb = off % 384, seg = wb >> 7, cpos = (wb & 127) >> 4; ksrc[i] = (unsigned)(row * 384 + seg * 128 + ((cpos ^ (row & 7)) << 4)); }
#pragma unroll
    for (int i = 0; i < 2; ++i) { const int off = ((wid + 8 * i) * 64 + lane) * 16, st = off >> 9, o_ = off & 511, kk = (st >> 2) * 8 + (o_ >> 6), c = (st & 3) * 32 + ((o_ & 63) >> 1);
        const int k = (kk & ~0xC) | ((kk & 4) << 1) | ((kk & 8) >> 1); vsrc[i] = (unsigned)(k * 256 + c * 2); }
    const int vb0 = (int)(unsigned)(uintptr_t)V_lds + v_rd_base(lane);
#define ADMA_K(t, bf) do { const char* kp = (const char*)(Kh + (size_t)(t) * KVBLK * DQK); \
        _Pragma("unroll") for (int i = 0; i < 3; ++i) __builtin_amdgcn_global_load_lds((const unsigned*)(kp + ksrc[i]), (LAS unsigned*)(K_lds + (bf) * SHM_K + (wid + 8 * i) * 1024), 16, 0, 0); } while (0)
#define ADMA_V(t, bf) do { const char* vp = (const char*)(Vh + (size_t)(t) * KVBLK * DV); \
        _Pragma("unroll") for (int i = 0; i < 2; ++i) __builtin_amdgcn_global_load_lds((const unsigned*)(vp + vsrc[i]), (LAS unsigned*)(V_lds + (bf) * SHM_V + (wid + 8 * i) * 1024), 16, 0, 0); } while (0)
#define PK4(P, B_, OUT) do { unsigned a0 = cvtpk(P[B_ + 0], P[B_ + 1]), a1 = cvtpk(P[B_ + 2], P[B_ + 3]); \
        unsigned b0 = cvtpk(P[B_ + 4], P[B_ + 5]), b1 = cvtpk(P[B_ + 6], P[B_ + 7]); \
        auto r0 = __builtin_amdgcn_permlane32_swap(a0, b0, false, false); auto r1 = __builtin_amdgcn_permlane32_swap(a1, b1, false, false); \
        u32x4 w = {r0[0], r1[0], r0[1], r1[1]}; OUT = __builtin_bit_cast(bf16x8, w); } while (0)
    float m_reg = -1e30f, l_reg = 0.f; f32x16 o[4] = {}; int cv_pend = -1;
    const int ph = wid >> 2; bool st_steady = false, st_had = false;
#define STAGE_SLOT(t) do { const int tk = (t) + 2; const bool kv_full = tk < NT;     \
        if (tk < NT) ADMA_K(tk, tk & 1); \
        const bool had_pend = cv_pend >= 0; \
        if (had_pend) { if (kv_full) asm volatile("s_waitcnt vmcnt(3)" ::: "memory"); else asm volatile("s_waitcnt vmcnt(0)" ::: "memory");     \
            CV_DECODE(cv_pend) CV_STORE(); cv_pend = -1; } \
        st_had = had_pend; SBAR(); } while (0)
#define STAGE_V(t) do { SBAR(); if ((t) + 1 < NT) ADMA_V((t) + 1, ((t) + 1) & 1); SBAR(); } while (0)
#define STAGE_TAIL(t) do { SBAR(); if ((t) + 1 < NT) { const int cv_idx = __builtin_amdgcn_readfirstlane(tseq * cj.ngw + cj.gw); ++tseq; CV_DECODE(cv_idx) CV_LOAD(); cv_pend = cv_on ? cv_idx : -1; } \
        st_steady = st_had && cv_pend >= 0;                                    \
        SBAR(); } while (0)
#define PV_PART(t) do { if ((t) * KVBLK <= qlo + QBLK - 1) { SBAR(); pv_tile(o, vb0 + ((t) & 1) * SHM_V, pa0, pa1, pa2, pa3); SBAR(); } } while (0)
#define QK_PART(t) do { if ((t) < NT && (t) * KVBLK <= qlo + QBLK - 1) { SBAR(); qkt(p0, p1, K_lds + ((t) & 1) * SHM_K, r32, hi, qr); SBAR(); } } while (0)
#define VALU_SLOT(t) VALU_SLOT_H(t, (void)0)
#define VALU_SLOT_H(t, HOOK) do { const int kb_ = (t) * KVBLK; \
        if (!(kb_ <= qlo + QBLK - 1)) { HOOK; } \
        if (kb_ <= qlo + QBLK - 1) { \
            if (kb_ + KVBLK - 1 > qlo) { asm volatile("" ::: "memory"); const int dq = qm - kb_; const float NEG = -__builtin_inff(); \
                _Pragma("unroll") for (int r = 0; r < 16; ++r) { const int c = (r & 3) + 8 * (r >> 2); if (c > dq) p0[r] = NEG; if (c + 32 > dq) p1[r] = NEG; } } \
            float pmax = p0[0]; _Pragma("unroll") for (int r = 1; r < 16; ++r) pmax = fmaxf(pmax, p0[r]); _Pragma("unroll") for (int r = 0; r < 16; ++r) pmax = fmaxf(pmax, p1[r]); \
            { auto rr = __builtin_amdgcn_permlane32_swap(__float_as_uint(pmax), __float_as_uint(pmax), false, false); pmax = fmaxf(__uint_as_float(rr[0]), __uint_as_float(rr[1])); } \
            if (!__all(pmax - m_reg <= THR)) { const float mn = fmaxf(m_reg, pmax); const float alpha = __builtin_amdgcn_exp2f(m_reg - mn); m_reg = mn; l_reg *= alpha; \
                if (hi == 0) al_l[r32] = alpha; asm volatile("s_waitcnt lgkmcnt(0)" ::: "memory"); \
                _Pragma("unroll") for (int d_ = 0; d_ < 4; ++d_) _Pragma("unroll") for (int r = 0; r < 16; ++r) o[d_][r] *= al_l[crow(r, hi)]; } \
            float ps = 0.f; HOOK; \
            _Pragma("unroll") for (int r = 0; r < 16; ++r) { p0[r] = __builtin_amdgcn_exp2f(p0[r] - m_reg); p1[r] = __builtin_amdgcn_exp2f(p1[r] - m_reg); } \
            _Pragma("unroll") for (int r = 0; r < 16; ++r) ps += p0[r] + p1[r]; \
            { auto rr = __builtin_amdgcn_permlane32_swap(__float_as_uint(ps), __float_as_uint(ps), false, false); ps = __uint_as_float(rr[0]) + __uint_as_float(rr[1]); } \
            l_reg += ps; \
            PK4(p0, 0, pa0); PK4(p0, 8, pa1); PK4(p1, 0, pa2); PK4(p1, 8, pa3); } } while (0)
#define SLOT_END_EVEN() do { if (st_steady) asm volatile("s_waitcnt vmcnt(4)\n\ts_barrier" ::: "memory");     \
        else asm volatile("s_waitcnt vmcnt(0)\n\ts_barrier" ::: "memory"); } while (0)
#define SLOT_END_ODD() asm volatile("s_barrier" ::: "memory")
    ADMA_K(0, 0);
    asm volatile("s_waitcnt vmcnt(0)" ::: "memory"); __syncthreads();
    if (ph == 0) {
        f32x16 p0, p1;
        STAGE_SLOT(-1); STAGE_V(-1); QK_PART(0); STAGE_TAIL(-1); SLOT_END_ODD();
        for (int t = 0; t < NT; ++t) { bf16x8 pa0 = {}, pa1 = {}, pa2 = {}, pa3 = {};
            VALU_SLOT(t); SLOT_END_EVEN();
            STAGE_SLOT(t); PV_PART(t); STAGE_V(t); QK_PART(t + 1); STAGE_TAIL(t); SLOT_END_ODD(); }
    } else {
        bf16x8 pa0 = {}, pa1 = {}, pa2 = {}, pa3 = {};
        STAGE_SLOT(-1); STAGE_V(-1); STAGE_TAIL(-1); SLOT_END_ODD();
        for (int t = 0; t < NT; ++t) { f32x16 p0 = {}, p1 = {};
            if (t > 0) PV_PART(t - 1);
            QK_PART(t); SLOT_END_EVEN();
            STAGE_SLOT(t); VALU_SLOT(t); STAGE_V(t); STAGE_TAIL(t); SLOT_END_ODD(); }
        PV_PART(NT - 1);
    }
#undef STAGE_SLOT
#undef STAGE_V
#undef VALU_SLOT_H
#undef STAGE_TAIL
#undef PV_PART
#undef QK_PART
#undef VALU_SLOT
#undef SLOT_END_EVEN
#undef SLOT_END_ODD
#undef PK4
#undef ADMA_K
#undef ADMA_V
    if (cv_pend >= 0) { asm volatile("s_waitcnt vmcnt(0)" ::: "memory"); CV_DECODE(cv_pend) CV_STORE(); }
    if (hi == 0) li_l[r32] = l_reg;
    asm volatile("s_waitcnt vmcnt(0) lgkmcnt(0)" ::: "memory");
    float rli[16];
#pragma unroll
    for (int r = 0; r < 16; ++r) rli[r] = __builtin_amdgcn_rcpf(li_l[crow(r, hi)]);
    __syncthreads();
    LAS bf16_t* stg = (LAS bf16_t*)(lds + wid * 8192);
#pragma unroll
    for (int r = 0; r < 16; ++r) { const int orow = crow(r, hi);
#pragma unroll
        for (int d0 = 0; d0 < 4; ++d0) stg[orow * 128 + d0 * 32 + r32] = f2bf(o[d0][r] * rli[r]); }
    asm volatile("s_waitcnt lgkmcnt(0)" ::: "memory");
    const size_t row0 = (size_t)b * SEQ + qb * QB + wid * QBLK;
#pragma unroll
    for (int i = 0; i < 8; ++i) { const int row = i * 4 + (lane >> 4), ch = lane & 15; const u32x4 v = *(const LAS u32x4*)(stg + row * 128 + ch * 8);
        float ss = (blo(v.x) * blo(v.x) + bhi(v.x) * bhi(v.x)) + (blo(v.y) * blo(v.y) + bhi(v.y) * bhi(v.y)) + (blo(v.z) * blo(v.z) + bhi(v.z) * bhi(v.z)) + (blo(v.w) * blo(v.w) + bhi(v.w) * bhi(v.w));
        ss += __shfl_xor(ss, 1); ss += __shfl_xor(ss, 2); ss += __shfl_xor(ss, 4); ss += __shfl_xor(ss, 8);
        *(u32x4*)(MIX + (row0 + row) * DM + h * DV + ch * 8) = v;
        if (ch == 0) ASSQ[(row0 + row) * 4 + h] = ss; }
    __syncthreads();
}
#undef KSWZ
#undef SBAR
}

struct Args { const void* in[25]; float* out; unsigned char* ws; int ph_lo, ph_hi, li, skip; };
enum { PH_PREP = 0, PH_INPROJ, PH_TOKLOCAL, PH_ATTN, PH_WO, PH_ROUTER, PH_ROUTE, PH_MOE1, PH_MOE2, PH_COMBINE, PH_PLE, PH_FINAL, PH_COUNT };

template <int MODE> __device__ __forceinline__ int cmap_col(int n) {
    if (MODE == 1) { const int pn = n >> 8, half = (n >> 7) & 1, jj = n & 127; return half * 1024 + pn * 128 + jj; }
    if (MODE == 4) { if (n < 1024) return n < 960 ? n : INW; const int v = n - 1024, j = v >> 8, hf = (v >> 7) & 1, cc = v & 127; return (hf ? 1472 : 960) + 128 * j + cc; }
    if (MODE == 2) { const int h = n / DQK, d = n % DQK; if (d < DN) return n; const int t = d - DN; return h * DQK + DN + (t & 1) * 32 + (t >> 1); }
    return n;
}
template <int MODE> __device__ __forceinline__ void transpose_item_fp8(const float* __restrict__ W, int ldsrc, int nblk, unsigned char* __restrict__ WT, int ldd, const float* __restrict__ gain, float scale,
                                                                      LAS float* scr, int item, int lane) {
    const int kb = item / nblk, nb = item % nblk, k0 = 64 * kb, n0 = 32 * nb; const int c = cmap_col<MODE>(n0 + (lane & 31));
    float wv[32];
#pragma unroll
    for (int i = 0; i < 32; ++i) wv[i] = W[(size_t)(k0 + 2 * i + (lane >> 5)) * ldsrc + c];
#pragma unroll
    for (int i = 0; i < 32; ++i) { const int kk = 2 * i + (lane >> 5), k = k0 + kk; float gk = scale; if (gain) gk *= gain[k]; scr[kk * 33 + (lane & 31)] = wv[i] * gk; }
    asm volatile("s_waitcnt lgkmcnt(0)" ::: "memory");
    const int cc = lane & 3;
#pragma unroll
    for (int j = 0; j < 2; ++j) { const int n = (lane >> 2) + 16 * j; const LAS float* s = scr + (16 * cc) * 33 + n; u32x4 o;
        o.x = pg8::pk4_fp8((f32x4){s[0 * 33], s[1 * 33], s[2 * 33], s[3 * 33]}); o.y = pg8::pk4_fp8((f32x4){s[4 * 33], s[5 * 33], s[6 * 33], s[7 * 33]});
        o.z = pg8::pk4_fp8((f32x4){s[8 * 33], s[9 * 33], s[10 * 33], s[11 * 33]}); o.w = pg8::pk4_fp8((f32x4){s[12 * 33], s[13 * 33], s[14 * 33], s[15 * 33]});
        *(u32x4*)(WT + (size_t)(n0 + n) * ldd + k0 + 16 * cc) = o; }
    asm volatile("s_waitcnt lgkmcnt(0)" ::: "memory");
}
template <int MODE> __device__ __forceinline__ void transpose_item(const float* __restrict__ W, int ldsrc, int nblk, bf16_t* __restrict__ WT, int ldd, const float* __restrict__ gain, const float* __restrict__ gain2, float scale,
                                                                  LAS float* scr, int item, int lane) {
    const int kb = item / nblk, nb = item % nblk, k0 = 64 * kb, n0 = 32 * nb; const int c = cmap_col<MODE>(n0 + (lane & 31));
    float wv[32], gq[32];
#pragma unroll
    for (int i = 0; i < 32; ++i) wv[i] = W[(size_t)(k0 + 2 * i + (lane >> 5)) * ldsrc + c];
#pragma unroll
    for (int i = 0; i < 32; ++i) { const int k = k0 + 2 * i + (lane >> 5); gq[i] = gain ? ((gain2 && k >= 512) ? gain2[k - 512] : gain[k]) : 1.f; }
    asm volatile("" ::: "memory");
#pragma unroll
    for (int i = 0; i < 32; ++i) { const int kk = 2 * i + (lane >> 5); scr[kk * 33 + (lane & 31)] = wv[i] * (gq[i] * scale); }
    asm volatile("s_waitcnt lgkmcnt(0)" ::: "memory");
    const int cc = lane & 7;
#pragma unroll
    for (int j = 0; j < 4; ++j) { const int n = (lane >> 3) + 8 * j; const LAS float* s = scr + (8 * cc) * 33 + n;
        u32x4 o; o.x = pk2(s[0 * 33], s[1 * 33]); o.y = pk2(s[2 * 33], s[3 * 33]); o.z = pk2(s[4 * 33], s[5 * 33]); o.w = pk2(s[6 * 33], s[7 * 33]);
        *(u32x4*)(WT + (size_t)(n0 + n) * ldd + k0 + 8 * cc) = o; }
    asm volatile("s_waitcnt lgkmcnt(0)" ::: "memory");
}

__global__ void __launch_bounds__(NTHREADS, 2) fwd(Args args) {
    extern __shared__ __attribute__((aligned(16))) unsigned char lds_raw[];
    LAS unsigned char* lds = (LAS unsigned char*)lds_raw;
    volatile LAS unsigned* MISC = (volatile LAS unsigned*)(lds + MISC_OFF);
    const int wave = __builtin_amdgcn_readfirstlane(threadIdx.x >> 6);
    const int G = gridDim.x, bx = blockIdx.x;
#define PHASE_LANE const int lane = lane_id(); const int tid = wave * 64 + lane; (void)tid
    const int gw = bx * NWAVES + wave, NGW = G * NWAVES;
    unsigned char* ws = args.ws; int* ctl = (int*)(ws + WS_CTL); float* H = args.out;
    const float* x = (const float*)args.in[0]; const float* p = (const float*)args.in[1]; const int* pos = (const int*)args.in[2];
    const float *mix_norm = (const float*)args.in[3], *w_in = (const float*)args.in[4], *q_norm = (const float*)args.in[5], *w_uq = (const float*)args.in[6], *kv_norm = (const float*)args.in[7],
                *w_ukv = (const float*)args.in[8], *attn_out_norm = (const float*)args.in[10], *conv_out_norm = (const float*)args.in[11], *w_o = (const float*)args.in[12],
                *moe_norm = (const float*)args.in[13], *w_router = (const float*)args.in[14], *w1 = (const float*)args.in[16], *b1 = (const float*)args.in[17],
                *w2 = (const float*)args.in[18], *b2 = (const float*)args.in[19], *ple_norm = (const float*)args.in[20], *w_ple_gate = (const float*)args.in[21], *w_ple_proj = (const float*)args.in[22],
                *ple_post_norm = (const float*)args.in[23], *conv_w = (const float*)args.in[9], *b_router = (const float*)args.in[15], *final_norm = (const float*)args.in[24];
    int* TOPI = (int*)(ws + WS_TOPI); float* TOPG = (float*)(ws + WS_TOPG);
    bf16_t *HBF = (bf16_t*)(ws + WS_HBF), *H3 = (bf16_t*)(ws + WS_H3), *WRHL = (bf16_t*)(ws + WS_WRHL); unsigned char* X8 = (unsigned char*)(ws + WS_K);
    float* RSX = (float*)(ws + WS_RSX);
    float *SSQ1 = (float*)(ws + WS_SSQ1), *RS1 = (float*)(ws + WS_RS1), *RS2 = (float*)(ws + WS_RS2), *ROWRS = (float*)(ws + WS_ROWRS);
    bf16_t *WIN = (bf16_t*)(ws + WS_WIN), *WUQ = (bf16_t*)(ws + WS_WUQ), *WUKV = (bf16_t*)(ws + WS_WUKV), *WO = (bf16_t*)(ws + WS_WO), *WG = (bf16_t*)(ws + WS_WG), *WP = (bf16_t*)(ws + WS_WP);
    bf16_t *W1T = (bf16_t*)(ws + WS_W1), *W2T = (bf16_t*)(ws + WS_W2), *XN = (bf16_t*)(ws + WS_XN), *MIX = (bf16_t*)(ws + WS_MIX), *PLER = (bf16_t*)(ws + WS_PLER);
    bf16_t *Z = (bf16_t*)(ws + WS_Z), *Qb = (bf16_t*)(ws + WS_Q), *Kb = (bf16_t*)(ws + WS_K), *Vb = (bf16_t*)(ws + WS_V), *HB = (bf16_t*)(ws + WS_HB), *Y = (bf16_t*)(ws + WS_Y), *P16 = (bf16_t*)(ws + WS_P16);
    float *WR = (float*)(ws + WS_WR), *CS = (float*)(ws + WS_CS), *SSQ = (float*)(ws + WS_SSQ), *ASSQ = (float*)(ws + WS_ASSQ), *PSSQ = (float*)(ws + WS_PSSQ), *FSSQ = (float*)(ws + WS_FSSQ);
    int *ROWTOK = (int*)(ws + WS_ROWTOK), *ROWSLOT = (int*)(ws + WS_ROWSLOT); float* ROWGATE = (float*)(ws + WS_ROWGATE);

    { PHASE_LANE; for (int u = tid; u < (LDS_BYTES - MISC_OFF) / 4; u += NTHREADS) ((LAS unsigned*)(lds + MISC_OFF))[u] = 0u; }
    __syncthreads();
    const int lo = args.ph_lo, hi = args.ph_hi;
    XcdBarrier bar; bar.bar = (unsigned*)ctl + CW_BAR + args.li * XCD_BAR_WORDS; bar.x = 0; bar.st = MISC + 8;
    if (hi - lo > 1) bar = xcd_barrier_post((unsigned*)ctl + CW_BAR + args.li * XCD_BAR_WORDS, MISC + 8, wave);
#define IN(k) (lo <= (k) && (k) < hi)
#define NREP(k) ((PROBE_PH == (k)) ? PROBE_REP : 1)
#define REPLOOP(k) for (int rep = 0; rep < NREP(k); ++rep)
#define LASTREP(k) (rep == NREP(k) - 1)
#ifdef PROBE_TIME_PH
#define STAMP(k) do { if (bx == 0 && wave == 0) MISC[32 + (k)] = (unsigned)__builtin_amdgcn_s_memrealtime(); } while (0)
#else
#define STAMP(k) do { } while (0)
#endif
#define SEAM(k) do { if (IN(k) && IN((k) + 1)) xcd_barrier(bar, wave); STAMP((k) + 1); } while (0)
    STAMP(0);

    if (IN(PH_PREP)) REPLOOP(PH_PREP) {
        PHASE_LANE;
        LAS float* scr = (LAS float*)(lds + wave * 16384);
        constexpr int I_IN = (DM / 64) * 64, I_UQ = (QL / 64) * (768 / 32), I_UKV = (KVL / 64) * (1024 / 32), I_O = (DM / 64) * (DM / 32), I_G = I_O, I_P = (PLE / 64) * (DM / 32);
        constexpr int I_1 = (DM / 64) * (2048 / 32), I_2 = (DE / 64) * (DM / 32);
        constexpr int NITEMS = I_IN + I_UQ + I_UKV + I_O + I_G + I_P;
        for (int it = gw; it < NITEMS; it += NGW) {
            int r = it;
            if (r < I_IN) { if ((r & 63) != 30 && (r & 63) != 31) transpose_item<4>(w_in, INW, 64, WIN, DM, mix_norm, nullptr, 1.f, scr, r, lane); continue; } r -= I_IN;
            if (r < I_UQ) { transpose_item<2>(w_uq, 768, 768 / 32, WUQ, QL, q_norm, nullptr, QSCALE, scr, r, lane); continue; } r -= I_UQ;
            if (r < I_UKV) { transpose_item<0>(w_ukv, 1024, 1024 / 32, WUKV, 256, kv_norm, nullptr, 1.f, scr, r, lane); continue; } r -= I_UKV;
            if (r < I_O) { transpose_item<0>(w_o, DM, DM / 32, WO, DM, attn_out_norm, conv_out_norm, 1.f, scr, r, lane); continue; } r -= I_O;
            if (r < I_G) { transpose_item<0>(w_ple_gate, DM, DM / 32, WG, DM, ple_norm, nullptr, 1.f, scr, r, lane); continue; } r -= I_G;
            transpose_item<0>(w_ple_proj, DM, DM / 32, WP, PLE, nullptr, nullptr, 1.f, scr, r, lane);
        }
        for (int i = bx * NTHREADS + tid; i < 1024 * 16; i += G * NTHREADS) *(u32x4*)(WUKV + (size_t)(i >> 4) * 256 + 128 + (i & 15) * 8) = (u32x4){0u, 0u, 0u, 0u};
        for (int i = bx * NTHREADS + tid; i < DM * NE; i += G * NTHREADS) { const int e = i >> 10, k = i & 1023; const float w = w_router[k * NE + e] * moe_norm[k]; const bf16_t whi = f2bf(w);
            WRHL[i] = whi; WRHL[DM * NE + i] = f2bf(w - bf2f(whi)); }
        for (int i = bx * NTHREADS + tid; i < NTOK * 32; i += G * NTHREADS) { const int t = i >> 5, j = i & 31; const float inv = powf(10000.f, -(float)j / 32.f); const float a = (float)pos[t] * inv; float sn, c; sincosf(a, &sn, &c);
            CS[(size_t)t * 64 + j] = c; CS[(size_t)t * 64 + 32 + j] = sn; }
        for (int i = bx * NTHREADS + tid; i < NTOK * PLE / 4; i += 4 * G * NTHREADS) { f32x4 v[4];
#pragma unroll
            for (int q = 0; q < 4; ++q) { const int ii = i + q * G * NTHREADS; v[q] = ii < NTOK * PLE / 4 ? ((const f32x4*)p)[ii] : (f32x4){0.f, 0.f, 0.f, 0.f}; }
#pragma unroll
            for (int q = 0; q < 4; ++q) { const int ii = i + q * G * NTHREADS; if (ii < NTOK * PLE / 4) ((u32x2*)P16)[ii] = (u32x2){pk2(v[q][0], v[q][1]), pk2(v[q][2], v[q][3])}; } }
        for (int row = gw * 4; row < NTOK; row += NGW * 4) {
            f32x4 v[4][4]; float ss[4];
#pragma unroll
            for (int q = 0; q < 4; ++q) { const f32x4* s = (const f32x4*)(x + (size_t)(row + q) * DM);
#pragma unroll
                for (int j = 0; j < 4; ++j) v[q][j] = s[lane + 64 * j]; }
#pragma unroll
            for (int q = 0; q < 4; ++q) { ss[q] = 0.f;
#pragma unroll
                for (int j = 0; j < 4; ++j) ss[q] += pg8::sq4(v[q][j]); }
#pragma unroll
            for (int q = 0; q < 4; ++q) { const float rstd = rsqrtf(wave_sum(ss[q]) * (1.f / DM) + EPS); u32x2* d = (u32x2*)(XN + (size_t)(row + q) * DM); if (lane == 0) RSX[row + q] = rstd;
#pragma unroll
                for (int j = 0; j < 4; ++j) d[lane + 64 * j] = (u32x2){pk2(v[q][j][0], v[q][j][1]), pk2(v[q][j][2], v[q][j][3])}; }
        }
    }
    SEAM(PH_PREP);
    if (IN(PH_INPROJ)) REPLOOP(PH_INPROJ) {
        { pg8::Gemm g{XN, WIN, DM, DM, DM, nullptr, 0}; pg8::StaticOrder S; S.init(NTOK / 256, 8, G, bx, nullptr);
          pg8::EpiBf16Stats<0> E{Z, INWP, SSQ, RSX}; pg8::gemm_phase<pg8::EpiBf16Stats<0>, false>(lds, g, S, E, wave); }
        { pg8::Gemm g{P16, WP, PLE, PLE, PLE, nullptr, 0}; pg8::StaticOrder S; S.init(NTOK / 256, DM / 256, G, bx, nullptr);
          pg8::EpiBf16Stats<1> E{PLER, DM, PSSQ, nullptr}; pg8::gemm_phase<pg8::EpiBf16Stats<1>, false>(lds, g, S, E, wave); }
    }
    SEAM(PH_INPROJ);
    if (IN(PH_TOKLOCAL)) REPLOOP(PH_TOKLOCAL) {
        PHASE_LANE;
        if (!(args.skip & 1)) for (int r0 = gw * 16; r0 < NTOK; r0 += NGW * 16) {
            const int c8 = lane * 8; f32x4 w0[2], w1[2], w2[2];
#pragma unroll
            for (int q = 0; q < 2; ++q) { w0[q] = *(const f32x4*)(conv_w + c8 + 4 * q); w1[q] = *(const f32x4*)(conv_w + 512 + c8 + 4 * q); w2[q] = *(const f32x4*)(conv_w + 1024 + c8 + 4 * q); }
            f32x4 u1[2] = {}, u2[2] = {};
            if ((r0 % SEQ) != 0) {
#pragma unroll
                for (int p = 1; p <= 2; ++p) { const u32x4 uu = *(const u32x4*)(Z + (size_t)(r0 - p) * INWP + 960 + c8);
                    const f32x4 a = {blo(uu.x), bhi(uu.x), blo(uu.y), bhi(uu.y)}, b = {blo(uu.z), bhi(uu.z), blo(uu.w), bhi(uu.w)};
                    if (p == 1) { u1[0] = a; u1[1] = b; } else { u2[0] = a; u2[1] = b; } } }
#pragma unroll 4
            for (int rr = 0; rr < 16; ++rr) { const int row = r0 + rr; const bf16_t* z = Z + (size_t)row * INWP; const int s = row % SEQ, b = row / SEQ;
                const u32x4 bg = *(const u32x4*)(z + 448 + c8), uu = *(const u32x4*)(z + 960 + c8);
                if (lane < 32) { const float x1 = bf2f(z[384 + lane]), x2 = bf2f(z[416 + lane]); const float c = CS[(size_t)row * 64 + lane], sn = CS[(size_t)row * 64 + 32 + lane];
                    const unsigned o = pk2(x1 * c - x2 * sn, x1 * sn + x2 * c);
#pragma unroll
                    for (int h = 0; h < NH; ++h) *(unsigned*)(Kb + ((size_t)(b * NH + h) * SEQ + s) * DQK + DN + 2 * lane) = o; }
                f32x4 u0[2]; u0[0] = (f32x4){blo(uu.x), bhi(uu.x), blo(uu.y), bhi(uu.y)}; u0[1] = (f32x4){blo(uu.z), bhi(uu.z), blo(uu.w), bhi(uu.w)};
                f32x4 y[2]; y[0] = (f32x4){blo(bg.x), bhi(bg.x), blo(bg.y), bhi(bg.y)} * (w0[0] * u2[0] + w1[0] * u1[0] + w2[0] * u0[0]); y[1] = (f32x4){blo(bg.z), bhi(bg.z), blo(bg.w), bhi(bg.w)} * (w0[1] * u2[1] + w1[1] * u1[1] + w2[1] * u0[1]);
                const float rstd = rsqrtf(wave_sum(pg8::sq4(y[0]) + pg8::sq4(y[1])) * (1.f / 512.f) + EPS);
                *(u32x4*)(MIX + (size_t)row * DM + 512 + c8) = pg8::pack8(y[0] * rstd, y[1] * rstd);
                u2[0] = u1[0]; u2[1] = u1[1]; u1[0] = u0[0]; u1[1] = u0[1]; }
        }
        { pg8::Gemm g{Z, WUQ, QL, INWP, QL, nullptr, 0}; pg8::StaticOrder S; S.init(NTOK / 256, 768 / 256, G, bx, nullptr);
          pg8::EpiQ E{Qb, SSQ, CS}; pg8::gemm_phase<pg8::EpiQ, false>(lds, g, S, E, wave); }
        { pg8::Gemm g{Z + 256, WUKV, 256, INWP, 256, nullptr, 0}; pg8::StaticOrder S; S.init(NTOK / 256, 1024 / 256, G, bx, nullptr);
          pg8::EpiKV E{Kb, Vb, SSQ}; pg8::gemm_phase<pg8::EpiKV, false>(lds, g, S, E, wave); }
    }
    SEAM(PH_TOKLOCAL);
    if (IN(PH_ATTN)) REPLOOP(PH_ATTN) {
        const int vcu = (G % 8 == 0) ? (bx % 8) * (G / 8) + bx / 8 : bx;
        using att::L_END; using att::cv_cmap1; using att::cv_cmap2; using att::CV_N1; using att::CV_TOTAL;
        const att::ConvJob cj{w1, w2, moe_norm, (unsigned char*)W1T, (unsigned char*)W2T, gw, NGW}; int tseq = LASTREP(PH_ATTN) ? 0 : (1 << 20);
        for (int it = vcu; it < NB * NH * 8; it += G) { const int bh = it >> 3, pr = it & 7;
            for (int pass = 0; pass < 2; ++pass) att::attn_block(bh, pass ? pr : 15 - pr, Qb, Kb, Vb, MIX, ASSQ, lds, wave, cj, tseq); }
        if (LASTREP(PH_ATTN)) { const int lane = lane_id(), hi = lane >> 5, wid = wave; __syncthreads();
            for (int cv_idx = tseq * NGW + gw; cv_idx < att::CV_TOTAL; cv_idx += NGW) { CV_DECODE(cv_idx) CV_LOAD(); asm volatile("s_waitcnt vmcnt(0)" ::: "memory"); CV_STORE(); } }
    }
    SEAM(PH_ATTN);
    if (IN(PH_WO)) REPLOOP(PH_WO) {
        pg8::Gemm g{MIX, WO, DM, DM, DM, nullptr, 0}; pg8::StaticOrder S; S.init(NTOK / 256, DM / 256, G, bx, nullptr);
        pg8::EpiWo E{XN, HBF, X8, ASSQ, SSQ1, moe_norm}; pg8::gemm_phase<pg8::EpiWo, false>(lds, g, S, E, wave, LASTREP(PH_WO));
    }
    SEAM(PH_WO);
    if (IN(PH_ROUTER)) REPLOOP(PH_ROUTER) {
        PHASE_LANE;
        typedef float f32x16 __attribute__((ext_vector_type(16)));
        const bool fusedR = (G == 256);
        LAS int* hist = (LAS int*)(lds + HIST_OFF); LAS f32x16* xch = (LAS f32x16*)(lds + HIST_OFF + 256);
        for (int i = tid; i < 2 * NE * 128; i += NTHREADS) { const int pe = i >> 7, kc = i & 127, e = pe & 31; *(LAS u32x4*)(lds + pe * 2048 + ((kc ^ (e & 15)) << 4)) = ((const u32x4*)WRHL)[i]; }
        if (tid < NE) hist[tid] = 0;
        __syncthreads();
        for (int chunk = bx; chunk < NTOK / 128; chunk += G) {
            const int base = chunk * 128, wq = wave & 3, kh = wave >> 2;
            const int j = lane & 31, half = lane >> 5, tok = base + wq * 32 + j;
            const bf16_t* xr = HBF + (size_t)tok * DM + kh * 512 + 8 * half; const LAS unsigned char* wrow = lds + j * 2048;
            f32x16 acc = {};
#pragma unroll 8
            for (int s = 0; s < 32; ++s) { const bf16x8 xb = *(const bf16x8*)(xr + 16 * s); const int kc = ((kh * 64 + 2 * s + half) ^ (j & 15)) << 4;
                const bf16x8 ah = *(const LAS bf16x8*)(wrow + kc), al = *(const LAS bf16x8*)(wrow + 65536 + kc);
                acc = __builtin_amdgcn_mfma_f32_32x32x16_bf16(ah, xb, acc, 0, 0, 0); acc = __builtin_amdgcn_mfma_f32_32x32x16_bf16(al, xb, acc, 0, 0, 0); }
            if (kh == 1) xch[wq * 64 + lane] = acc;
            __syncthreads();
            if (kh == 0) {
                const f32x16 other = xch[wq * 64 + lane];
                const f32x4 s0 = *(const f32x4*)(SSQ1 + (size_t)tok * 16 + 8 * half), s1 = *(const f32x4*)(SSQ1 + (size_t)tok * 16 + 8 * half + 4);
                float ss = ((s0[0] + s0[1]) + (s0[2] + s0[3])) + ((s1[0] + s1[1]) + (s1[2] + s1[3])); ss += __shfl_xor(ss, 32); const float rstd = rsqrtf(ss * (1.f / DM) + EPS);
                float v[16];
#pragma unroll
                for (int r = 0; r < 16; ++r) v[r] = (acc[r] + other[r]) * rstd + b_router[(r & 3) + 8 * (r >> 2) + 4 * half];
                float lv[4]; int li[4];
#pragma unroll
                for (int t = 0; t < 4; ++t) { float best = -__builtin_inff(); int bi = 0;
#pragma unroll
                    for (int r = 0; r < 16; ++r) if (v[r] > best) { best = v[r]; bi = (r & 3) + 8 * (r >> 2) + 4 * half; }
                    const auto rv = __builtin_amdgcn_permlane32_swap(__float_as_uint(best), __float_as_uint(best), false, false); const auto ri = __builtin_amdgcn_permlane32_swap((unsigned)bi, (unsigned)bi, false, false);
                    const float b0 = __uint_as_float(rv[0]), b1 = __uint_as_float(rv[1]); const int i0 = (int)ri[0], i1 = (int)ri[1];
                    const bool t0 = (b0 > b1) || (b0 == b1 && i0 < i1); const float gb = t0 ? b0 : b1; const int gi = t0 ? i0 : i1; lv[t] = gb; li[t] = gi;
#pragma unroll
                    for (int r = 0; r < 16; ++r) if ((r & 3) + 8 * (r >> 2) + 4 * half == gi) v[r] = -__builtin_inff(); }
                if (half == 0) { const float e1 = __expf(lv[1] - lv[0]), e2 = __expf(lv[2] - lv[0]), e3 = __expf(lv[3] - lv[0]); const float inv = 1.f / (1.f + e1 + e2 + e3);
                    if (fusedR) { const int tl = wq * 32 + j; *(LAS u32x4*)(lds + LT_OFF + tl * 16) = (u32x4){(unsigned)li[0], (unsigned)li[1], (unsigned)li[2], (unsigned)li[3]}; *(LAS f32x4*)(lds + LT_OFF + 2048 + tl * 16) = (f32x4){inv, e1 * inv, e2 * inv, e3 * inv}; *(LAS float*)(lds + LT_OFF + 4096 + tl * 4) = rstd; }
                    else { *(int4*)(TOPI + (size_t)tok * 4) = make_int4(li[0], li[1], li[2], li[3]); *(f32x4*)(TOPG + (size_t)tok * 4) = (f32x4){inv, e1 * inv, e2 * inv, e3 * inv}; RS1[tok] = rstd; }
#pragma unroll
                    for (int t = 0; t < 4; ++t) (void)__hip_atomic_fetch_add(hist + li[t], 1, __ATOMIC_RELAXED, __HIP_MEMORY_SCOPE_WORKGROUP); }
            }
            __syncthreads();
        }
        if (!fusedR) { if (tid < NE && LASTREP(PH_ROUTER)) atomicAdd(ctl + CW_CNT + tid, hist[tid]); __syncthreads(); }
        else {
            LAS int* S = (LAS int*)lds; LAS int* T = (LAS int*)(lds + 32768);
            LAS int* shf = (LAS int*)(lds + LT_OFF + 4608); LAS int* sh2 = shf + 64;
            int* BH = (int*)(ws + WS_FSSQ + 1 * MiB); int* BB = BH + 256 * NE;
            if (tid < NE) __hip_atomic_store(BH + bx * NE + tid, hist[tid], __ATOMIC_RELAXED, __HIP_MEMORY_SCOPE_AGENT);
            asm volatile("s_waitcnt vmcnt(0)" ::: "memory");
            __syncthreads();
            if (tid == 0) shf[0] = (__hip_atomic_fetch_add(ctl + CW_TICKET, 1, __ATOMIC_RELAXED, __HIP_MEMORY_SCOPE_AGENT) == G - 1) ? 1 : 0;
            __syncthreads();
            if (shf[0]) {
                if (wave == 0) __builtin_amdgcn_fence(__ATOMIC_ACQUIRE, "agent");
                __syncthreads();
                { u32x4 hv4[4];
#pragma unroll
                  for (int q = 0; q < 4; ++q) hv4[q] = *(const u32x4*)(BH + (tid + q * NTHREADS) * 4);
#pragma unroll
                  for (int q = 0; q < 4; ++q) *(LAS u32x4*)(S + (tid + q * NTHREADS) * 4) = hv4[q]; }
                __syncthreads();
                if (lane < NE) { int run = 0; for (int b = wave * 32; b < wave * 32 + 32; ++b) { const int v = S[b * NE + lane]; S[b * NE + lane] = run; run += v; } T[wave * NE + lane] = run; }
                __syncthreads();
                if (tid < NE) { int run = 0; for (int w = 0; w < 8; ++w) { const int v = T[w * NE + tid]; T[w * NE + tid] = run; run += v; } T[256 + tid] = run; }
                __syncthreads();
#pragma unroll
                for (int q = 0; q < 4; ++q) { const int i = (tid + q * NTHREADS) * 4; u32x4 v = *(const LAS u32x4*)(S + i); const u32x4 tb = *(const LAS u32x4*)(T + (i >> 10) * NE + (i & 31));
                    v += tb; asm volatile("global_store_dwordx4 %0, %1, off sc0 sc1" :: "v"(BB + i), "v"(v) : "memory"); }
                if (wave == 0) { const int c = lane < NE ? T[256 + (lane & 31)] : 0, t = (c + 255) >> 8; int incl = t;
#pragma unroll
                    for (int d = 1; d < 64; d <<= 1) { const int o = __shfl_up(incl, d); if (lane >= d) incl += o; }
                    const int excl = incl - t;
                    if (lane < NE) { __hip_atomic_store(ctl + CW_PADSTART + lane, excl * 256, __ATOMIC_RELAXED, __HIP_MEMORY_SCOPE_AGENT); __hip_atomic_store(ctl + CW_CNT + lane, c, __ATOMIC_RELAXED, __HIP_MEMORY_SCOPE_AGENT);
                        for (int q = 0; q < t; ++q) __hip_atomic_store(ctl + CW_TILE_E + excl + q, lane, __ATOMIC_RELAXED, __HIP_MEMORY_SCOPE_AGENT); }
                    if (lane == NE) { __hip_atomic_store(ctl + CW_PADSTART + NE, excl * 256, __ATOMIC_RELAXED, __HIP_MEMORY_SCOPE_AGENT); __hip_atomic_store(ctl + CW_NTILES, excl, __ATOMIC_RELAXED, __HIP_MEMORY_SCOPE_AGENT); } }
                asm volatile("s_waitcnt vmcnt(0)" ::: "memory");
                __syncthreads();
                if (tid == 0) __hip_atomic_store(ctl + CW_READY, 1, __ATOMIC_RELAXED, __HIP_MEMORY_SCOPE_AGENT);
            }
            if (wave == 0) { unsigned sp = 0;
                while (__builtin_amdgcn_readfirstlane(__hip_atomic_load(ctl + CW_READY, __ATOMIC_RELAXED, __HIP_MEMORY_SCOPE_AGENT)) == 0) { __builtin_amdgcn_s_sleep(24); if (++sp > (1u << 19)) break; }
                __builtin_amdgcn_fence(__ATOMIC_ACQUIRE, "agent"); }
            __syncthreads();
            if (tid < NE) { sh2[tid] = BB[bx * NE + tid] + ctl[CW_PADSTART + tid]; sh2[64 + tid] = 0; }
            __syncthreads();
            { const int e = *(const LAS int*)(lds + LT_OFF + tid * 4); const int r = __hip_atomic_fetch_add(sh2 + 64 + e, 1, __ATOMIC_RELAXED, __HIP_MEMORY_SCOPE_WORKGROUP);
              const int dest = sh2[e] + r, idx = bx * NTHREADS + tid;
              ROWTOK[dest] = idx >> 2; ROWSLOT[dest] = idx; ROWGATE[dest] = *(const LAS float*)(lds + LT_OFF + 2048 + tid * 4); ROWRS[dest] = *(const LAS float*)(lds + LT_OFF + 4096 + (tid >> 2) * 4); }
            if (bx < NE) { const int plo = ctl[CW_PADSTART + bx] + ctl[CW_CNT + bx], phi = ctl[CW_PADSTART + bx + 1];
                for (int r = plo + tid; r < phi; r += NTHREADS) { ROWTOK[r] = 0; ROWSLOT[r] = MROWS; ROWGATE[r] = 0.f; ROWRS[r] = 0.f; } }
            __syncthreads();
        }
    }
    if (G != 256) SEAM(PH_ROUTER);
    if (IN(PH_ROUTE) && G != 256) {
        PHASE_LANE;
        LAS int* sh = (LAS int*)lds;
        if (tid == 0) { int ps = 0, nt = 0;
            for (int e = 0; e < NE; ++e) { sh[e] = ps; const int t = (ctl[CW_CNT + e] + 255) >> 8; if (bx == 0) for (int q = 0; q < t; ++q) ctl[CW_TILE_E + nt + q] = e; nt += t; ps += t * 256; }
            sh[NE] = ps; if (bx == 0) ctl[CW_NTILES] = nt; }
        __syncthreads();
        for (int chunk = bx; chunk < MROWS / NTHREADS; chunk += G) {
            if (tid < NE) sh[64 + tid] = 0;
            __syncthreads();
            const int idx = chunk * NTHREADS + tid, e = TOPI[idx]; const int r = __hip_atomic_fetch_add(sh + 64 + e, 1, __ATOMIC_RELAXED, __HIP_MEMORY_SCOPE_WORKGROUP);
            __syncthreads();
            if (tid < NE) sh[128 + tid] = atomicAdd(ctl + CW_CURSOR + tid, sh[64 + tid]);
            __syncthreads();
            const int dest = sh[e] + sh[128 + e] + r; ROWTOK[dest] = idx >> 2; ROWSLOT[dest] = idx; ROWGATE[dest] = TOPG[idx]; ROWRS[dest] = RS1[idx >> 2];
            __syncthreads();
        }
        for (int e = bx; e < NE; e += G) { const int plo = sh[e] + ctl[CW_CNT + e], phi = sh[e + 1];
            for (int r = plo + tid; r < phi; r += NTHREADS) { ROWTOK[r] = 0; ROWSLOT[r] = MROWS; ROWGATE[r] = 0.f; ROWRS[r] = 0.f; } }
        __syncthreads();
    }
    SEAM(PH_ROUTE);
    if (IN(PH_MOE1)) REPLOOP(PH_MOE1) {
        pg8::Gemm g{X8, W1T, DM, DM, DM, ROWTOK, (size_t)2048 * DM}; pg8::StaticOrder S; S.init(ctl[CW_NTILES], 2048 / 256, G, bx, ctl + CW_TILE_E);
        pg8::EpiMoe1 E{(unsigned char*)HB, b1, ROWRS}; pg8::gemm_phase<pg8::EpiMoe1, true, true>(lds, g, S, E, wave, LASTREP(PH_MOE1));
    }
    SEAM(PH_MOE1);
    if (IN(PH_MOE2)) REPLOOP(PH_MOE2) {
        pg8::Gemm g{HB, W2T, DE, DE, DE, nullptr, (size_t)DM * DE}; pg8::StaticOrder S; S.init(ctl[CW_NTILES], DM / 256, G, bx, ctl + CW_TILE_E);
        pg8::EpiMoe2 E{(unsigned char*)Y, b2, ROWSLOT, ROWGATE}; pg8::gemm_phase<pg8::EpiMoe2, false, true>(lds, g, S, E, wave, LASTREP(PH_MOE2));
    }
    SEAM(PH_MOE2);
    if (IN(PH_COMBINE)) REPLOOP(PH_COMBINE) {
        PHASE_LANE;
        for (int row = gw * 2; row < NTOK; row += NGW * 2) {
            u32x4 hv[2][2]; u32x2 yv[2][4][2]; const unsigned char* Y8 = (const unsigned char*)Y;
#pragma unroll
            for (int q = 0; q < 2; ++q)
#pragma unroll
                for (int j = 0; j < 2; ++j) { hv[q][j] = *(const u32x4*)(HBF + (size_t)(row + q) * DM + (lane + 64 * j) * 8);
#pragma unroll
                    for (int k = 0; k < 4; ++k) yv[q][k][j] = *(const u32x2*)(Y8 + ((size_t)(row + q) * 4 + k) * DM + (lane + 64 * j) * 8); }
#pragma unroll
            for (int q = 0; q < 2; ++q) { float ss = 0.f; u32x4 ov[2];
#pragma unroll
                for (int j = 0; j < 2; ++j) { f32x4 a = {blo(hv[q][j].x), bhi(hv[q][j].x), blo(hv[q][j].y), bhi(hv[q][j].y)}, b = {blo(hv[q][j].z), bhi(hv[q][j].z), blo(hv[q][j].w), bhi(hv[q][j].w)};
#pragma unroll
                    for (int k = 0; k < 4; ++k) { const u32x2 y = yv[q][k][j]; const f32x2 y0 = __builtin_amdgcn_cvt_pk_f32_fp8(y.x, false), y1 = __builtin_amdgcn_cvt_pk_f32_fp8(y.x, true), y2 = __builtin_amdgcn_cvt_pk_f32_fp8(y.y, false), y3 = __builtin_amdgcn_cvt_pk_f32_fp8(y.y, true);
                        a += (f32x4){y0[0], y0[1], y1[0], y1[1]}; b += (f32x4){y2[0], y2[1], y3[0], y3[1]}; }
                    ss += pg8::sq4(a) + pg8::sq4(b); ov[j] = pg8::pack8(a, b); }
                ss = wave_sum(ss);
                bf16_t* ho = LASTREP(PH_COMBINE) ? HBF : (bf16_t*)(ws + WS_HB);
#pragma unroll
                for (int j = 0; j < 2; ++j) *(u32x4*)(ho + (size_t)(row + q) * DM + (lane + 64 * j) * 8) = ov[j];
                float ps = lane < 16 ? PSSQ[(size_t)(row + q) * 16 + lane] : 0.f; ps += __shfl_xor(ps, 1); ps += __shfl_xor(ps, 2); ps += __shfl_xor(ps, 4); ps += __shfl_xor(ps, 8);
                if (lane == 0) { RS2[row + q] = rsqrtf(ss * (1.f / DM) + EPS); RS2[NTOK + row + q] = rsqrtf(ps * (1.f / DM) + EPS); } }
        }
    }
    SEAM(PH_COMBINE);
    if (IN(PH_PLE)) REPLOOP(PH_PLE) {
        pg8::Gemm g{HBF, WG, DM, DM, DM, nullptr, 0}; pg8::StaticOrder S; S.init(NTOK / 256, DM / 256, G, bx, nullptr);
        if (G == 256 && LASTREP(PH_PLE)) { pg8::EpiPleFinal E{HBF, H, PLER, RS2 + NTOK, RS2, ple_post_norm, final_norm, FSSQ, (unsigned*)ctl + CW_PANEL, (unsigned*)ctl + CW_PANEL - 64, lds}; pg8::gemm_phase<pg8::EpiPleFinal, false>(lds, g, S, E, wave); }
        else { pg8::EpiPle E{HBF, H3, PLER, RS2 + NTOK, RS2, ple_post_norm, FSSQ}; pg8::gemm_phase<pg8::EpiPle, false>(lds, g, S, E, wave); }
    }
    if (G != 256) SEAM(PH_PLE);
    if (IN(PH_FINAL) && G != 256) REPLOOP(PH_FINAL) {
        PHASE_LANE;
        for (int row = gw * 4; row < NTOK; row += NGW * 4) {
            u32x4 hv[4][2]; float sp[4];
#pragma unroll
            for (int q = 0; q < 4; ++q) { sp[q] = lane < 16 ? FSSQ[(size_t)(row + q) * 16 + lane] : 0.f;
#pragma unroll
                for (int j = 0; j < 2; ++j) hv[q][j] = *(const u32x4*)(H3 + (size_t)(row + q) * DM + (lane + 64 * j) * 8); }
#pragma unroll
            for (int q = 0; q < 4; ++q) { float s = sp[q]; s += __shfl_xor(s, 1); s += __shfl_xor(s, 2); s += __shfl_xor(s, 4); s += __shfl_xor(s, 8);
                const float rstd = rsqrtf(__shfl(s, 0) * (1.f / DM) + EPS); float* ho = (LASTREP(PH_FINAL) ? H : (float*)(ws + WS_HB)) + (size_t)(row + q) * DM;
#pragma unroll
                for (int j = 0; j < 2; ++j) { const int c = (lane + 64 * j) * 8; const f32x4 g0 = *(const f32x4*)(final_norm + c), g1 = *(const f32x4*)(final_norm + c + 4); const u32x4 v = hv[q][j];
                    *(f32x4*)(ho + c) = (f32x4){blo(v.x), bhi(v.x), blo(v.y), bhi(v.y)} * rstd * g0; *(f32x4*)(ho + c + 4) = (f32x4){blo(v.z), bhi(v.z), blo(v.w), bhi(v.w)} * rstd * g1; } }
        }
    }
#ifdef PROBE_TIME_PH
    STAMP(PH_COUNT);
    if (bx == 0 && wave == 0) {
#ifndef PROBE_TIME_END
#define PROBE_TIME_END (PROBE_TIME_PH + 1)
#endif
        const unsigned dt = MISC[32 + PROBE_TIME_END] - MISC[32 + PROBE_TIME_PH]; const unsigned long long t0 = __builtin_amdgcn_s_memrealtime(); while (__builtin_amdgcn_s_memrealtime() - t0 < (unsigned long long)dt) __builtin_amdgcn_s_sleep(8); }
#endif
#ifdef PROBE_BARS
    if (hi - lo > 1) for (int i = 0; i < PROBE_BARS; ++i) xcd_barrier(bar, wave);
#endif
#undef IN
#undef NREP
#undef REPLOOP
#undef LASTREP
#undef SEAM
}
static int g_grid = 0;
extern "C" void kernel_launch(void* const* d_in, const int* in_sizes, int n_in, void* d_out, int out_size, void* d_ws, size_t ws_size, hipStream_t stream) {
    if (n_in != 25 || in_sizes[0] != NTOK * DM || out_size != NTOK * DM || ws_size < WS_END) {
        fprintf(stderr, "kernel_launch: unexpected shapes (n_in %d, in0 %d, out %d, ws %zu need %zu)\n", n_in, n_in > 0 ? in_sizes[0] : -1, out_size, ws_size, (size_t)WS_END); return; }
    if (g_grid == 0) {
        int dev = 0, cus = 0, per_cu = 0; (void)hipGetDevice(&dev); (void)hipDeviceGetAttribute(&cus, hipDeviceAttributeMultiprocessorCount, dev);
        if (hipFuncSetAttribute((const void*)fwd, hipFuncAttributeMaxDynamicSharedMemorySize, LDS_BYTES) != hipSuccess) fprintf(stderr, "hipFuncSetAttribute failed\n");
        if (hipOccupancyMaxActiveBlocksPerMultiprocessor(&per_cu, (const void*)fwd, NTHREADS, LDS_BYTES) != hipSuccess || per_cu < 1) { fprintf(stderr, "occupancy query: %d\n", per_cu); per_cu = 1; }
        (void)hipGetLastError();
        g_grid = cus > 0 ? cus : 256;
    }
    (void)hipMemsetAsync((unsigned char*)d_ws + WS_CTL, 0, 64 * 1024, stream);
    Args a{}; for (int i = 0; i < 25; ++i) a.in[i] = d_in[i]; a.out = (float*)d_out; a.ws = (unsigned char*)d_ws;
    a.ph_lo = 0; a.ph_hi = PH_COUNT; a.li = 0; a.skip = 0;
    void* p[] = {&a};
    const hipError_t e = hipLaunchCooperativeKernel((const void*)fwd, dim3(g_grid), dim3(NTHREADS), p, LDS_BYTES, stream);
    if (e != hipSuccess) fprintf(stderr, "cooperative launch failed: %s (grid %d)\n", hipGetErrorString(e), g_grid);
}
```

```cpp
#include <hip/hip_runtime.h>
#include <cstdint>
#include <cstdio>
#include <cmath>

typedef unsigned short bf16_t;

constexpr int NB = 8, SEQ = 4096, DM = 1024, NTOK = NB * SEQ;
constexpr int PLE = 256, NH = 4, DN = 128, DR = 64, DV = 128, QL = 256, KVL = 128, DQK = DN + DR;
constexpr int INW = 1984, INWP = 1536;
constexpr int NE = 32, TOPK = 4, DE = 1024;
constexpr int MROWS = NTOK * TOPK;
constexpr int MAXTILES = MROWS / 256 + NE;
constexpr int PROWS = MAXTILES * 256;
constexpr float EPS = 1e-6f;
constexpr float QSCALE = 0.07216878364870322f * 1.4426950408889634f;

constexpr size_t MiB = 1u << 20;
constexpr size_t WS_CTL = 0;
constexpr size_t WS_WIN = 1 * MiB, WS_WUQ = 5 * MiB, WS_WUKV = 5 * MiB + 512 * 1024, WS_WO = 6 * MiB, WS_WG = 8 * MiB, WS_WP = 10 * MiB;
constexpr size_t WS_WR = 10 * MiB + 512 * 1024;
constexpr size_t WS_CS = 11 * MiB;
constexpr size_t WS_SSQ = 19 * MiB, WS_ASSQ = 20 * MiB, WS_PSSQ = 21 * MiB, WS_FSSQ = 23 * MiB;
constexpr size_t WS_TOPI = 25 * MiB, WS_TOPG = 25 * MiB + 512 * 1024;
constexpr size_t WS_ROWTOK = 26 * MiB, WS_ROWSLOT = 27 * MiB, WS_ROWGATE = 28 * MiB;
constexpr size_t WS_P16 = 29 * MiB;
constexpr size_t WS_SSQ1 = 45 * MiB, WS_RS1 = 47 * MiB, WS_RS2 = 47 * MiB + 128 * 1024, WS_ROWRS = 47 * MiB + 384 * 1024;
constexpr size_t WS_RSX = 10 * MiB + 512 * 1024;
constexpr size_t WS_WRHL = 10 * MiB + 768 * 1024;
constexpr size_t WS_HBF = 112 * MiB;
constexpr size_t WS_H3 = 304 * MiB;
constexpr size_t WS_W1 = 48 * MiB, WS_W2 = 176 * MiB, WS_XN = 240 * MiB, WS_MIX = 304 * MiB, WS_PLER = 368 * MiB;
constexpr size_t WS_Z = 432 * MiB, WS_Q = 560 * MiB, WS_K = 608 * MiB, WS_V = 656 * MiB;
constexpr size_t WS_HB = 432 * MiB;
constexpr size_t WS_Y = 704 * MiB;
constexpr size_t WS_END = WS_Y + (size_t)(MROWS + 256) * DM * 2;
constexpr int CW_CNT = 0, CW_CURSOR = 64, CW_PADSTART = 128, CW_NTILES = 192, CW_TICKET = 200, CW_READY = 224, CW_TILE_E = 256;

__device__ __forceinline__ float bf2f(bf16_t v) { return __uint_as_float((unsigned)v << 16); }
__device__ __forceinline__ float blo(unsigned u) { return __uint_as_float(u << 16); }
__device__ __forceinline__ float bhi(unsigned u) { return __uint_as_float(u & 0xffff0000u); }
__device__ __forceinline__ bf16_t f2bf(float f) { unsigned u = __float_as_uint(f); return (bf16_t)((u + 0x7fffu + ((u >> 16) & 1u)) >> 16); }
__device__ __forceinline__ unsigned pk2(float lo, float hi) { return (unsigned)f2bf(lo) | ((unsigned)f2bf(hi) << 16); }
__device__ __forceinline__ float wave_sum(float v) {
#pragma unroll
    for (int o = 1; o < 64; o <<= 1) v += __shfl_xor(v, o);
    return v;
}
__device__ __forceinline__ float wave_max(float v) {
#pragma unroll
    for (int o = 1; o < 64; o <<= 1) v = fmaxf(v, __shfl_xor(v, o));
    return v;
}
__device__ __forceinline__ float dot8(uint4 x, uint4 y) {
    return blo(x.x) * blo(y.x) + bhi(x.x) * bhi(y.x) + blo(x.y) * blo(y.y) + bhi(x.y) * bhi(y.y) +
           blo(x.z) * blo(y.z) + bhi(x.z) * bhi(y.z) + blo(x.w) * blo(y.w) + bhi(x.w) * bhi(y.w);
}
__device__ __forceinline__ float dot_bf16(const bf16_t* a, const bf16_t* b, int K) {
    const uint4* a4 = (const uint4*)a; const uint4* b4 = (const uint4*)b; float acc = 0.f;
    for (int i = 0; i < K / 8; ++i) acc += dot8(a4[i], b4[i]);
    return acc;
}

#define LAS __attribute__((address_space(3)))
#define GAS __attribute__((address_space(1)))
typedef short bf16x8 __attribute__((ext_vector_type(8)));
typedef float f32x4 __attribute__((ext_vector_type(4)));
typedef float f32x2 __attribute__((ext_vector_type(2)));
typedef unsigned u32x4 __attribute__((ext_vector_type(4)));
typedef unsigned u32x2 __attribute__((ext_vector_type(2)));
#ifndef PROBE_PH
#define PROBE_PH (-1)
#define PROBE_REP 1
#endif
#ifndef MOE2_DELAY_TICKS
#define MOE2_DELAY_TICKS 700ull
#endif
constexpr int NWAVES = 8, NTHREADS = 512;
constexpr int RING_BYTES = 131072, MISC_OFF = RING_BYTES, HIST_OFF = MISC_OFF + 256, STG_OFF = RING_BYTES + 1024, LT_OFF = HIST_OFF + 256 + 16384, LDS_BYTES = 163840;
constexpr int CW_PANEL = 8192;
constexpr int CW_BAR = 4096;
__device__ __forceinline__ unsigned cvt_pk_bf16(float lo, float hi) { unsigned r; asm volatile("v_cvt_pk_bf16_f32 %0, %1, %2" : "=v"(r) : "v"(lo), "v"(hi)); return r; }
__device__ __forceinline__ int lane_id() { int l = (int)__builtin_amdgcn_mbcnt_hi(~0u, __builtin_amdgcn_mbcnt_lo(~0u, 0u)); asm volatile("" : "+v"(l)); return l; }
__device__ __forceinline__ float fast_sigmoid(float a) { return __builtin_amdgcn_rcpf(1.f + __expf(-a)); }

#define XB_TMO      128
#define XB_XCNT(j)  (256  + 64 * (j))
#define XB_XSUB(j)  (1280 + 64 * (j))
#define XB_XGEN(j)  (2304 + 64 * (j))
#define XB_TOP      3328
#define XB_TOPGEN   3392
#define XCD_BAR_WORDS 3456
#define XB_SPIN_CAP (1u << 20)
__device__ __forceinline__ unsigned xb_ld(unsigned* p)              { return __hip_atomic_load(p, __ATOMIC_RELAXED, __HIP_MEMORY_SCOPE_AGENT); }
__device__ __forceinline__ unsigned xb_add(unsigned* p, unsigned v) { return __hip_atomic_fetch_add(p, v, __ATOMIC_RELAXED, __HIP_MEMORY_SCOPE_AGENT); }
__device__ __forceinline__ unsigned xb_xcc_id() { return (unsigned)__builtin_amdgcn_s_getreg((3 << 11) | 20) & 0xFu; }
#define XB_SPIN(cond, bar) do { unsigned _sp = 0; while (cond) { __builtin_amdgcn_s_sleep(1); \
    if ((++_sp & 255u) == 0u) { if (xb_ld(&(bar)[XB_TMO])) break; if (_sp > XB_SPIN_CAP) { atomicAdd(&(bar)[XB_TMO], 1u); break; } } } } while (0)
struct XcdBarrier { unsigned* bar; unsigned x; volatile LAS unsigned* st; };
__device__ __forceinline__ XcdBarrier xcd_barrier_post(unsigned* bar, volatile LAS unsigned* st, int wave) {
    XcdBarrier b; b.bar = bar; b.x = xb_xcc_id(); b.st = st;
    if (wave == 0 && lane_id() == 0) (void)xb_add(&bar[XB_XCNT(b.x)], 1u);
    return b;
}
__device__ __forceinline__ void xcd_barrier_complete(unsigned* bar, unsigned x, unsigned& nloc, unsigned& nx) {
    const unsigned G = gridDim.x * gridDim.y * gridDim.z;
    unsigned sum, cnt, mine, sp = 0u;
    for (;;) {
        sum = 0u; cnt = 0u; mine = 0u;
#pragma unroll
        for (unsigned j = 0; j < 16; ++j) { const unsigned c = xb_ld(&bar[XB_XCNT(j)]); sum += c; cnt += (c > 0u) ? 1u : 0u; mine = (j == x) ? c : mine; }
        if (sum == G) break;
        __builtin_amdgcn_s_sleep(1);
        if ((++sp & 255u) == 0u) { if (xb_ld(&bar[XB_TMO])) break; if (sp > XB_SPIN_CAP) { atomicAdd(&bar[XB_TMO], 1u); break; } }
    }
    nloc = mine > 0u ? mine : 1u; nx = cnt > 0u ? cnt : 1u;
}
__device__ __forceinline__ void xcd_barrier(const XcdBarrier& b, int wave) {
    asm volatile("s_waitcnt vmcnt(0)" ::: "memory");
    __syncthreads();
    if (wave == 0 && lane_id() == 0) {
        unsigned* bar = b.bar;
        __builtin_amdgcn_s_waitcnt(0);
        unsigned nloc = b.st[0], nx = b.st[1];
        if (nloc == 0u) { xcd_barrier_complete(bar, b.x, nloc, nx); b.st[0] = nloc; b.st[1] = nx; }
        const unsigned old = xb_add(&bar[XB_XSUB(b.x)], 1u);
        const unsigned gen = old / nloc;
        if (old + 1u == (gen + 1u) * nloc) {
            __builtin_amdgcn_fence(__ATOMIC_RELEASE, "agent");
            asm volatile("s_waitcnt vmcnt(0)" ::: "memory");
            const unsigned og = xb_add(&bar[XB_TOP], 1u);
            const unsigned tg = og / nx;
            if (og + 1u == (tg + 1u) * nx) xb_add(&bar[XB_TOPGEN], 1u);
            else XB_SPIN(xb_ld(&bar[XB_TOPGEN]) == tg, bar);
            __builtin_amdgcn_fence(__ATOMIC_ACQUIRE, "agent");
            xb_add(&bar[XB_XGEN(b.x)], 1u);
            asm volatile("s_waitcnt vmcnt(0)" ::: "memory");
        } else {
            XB_SPIN(xb_ld(&bar[XB_XGEN(b.x)]) == gen, bar);
            __builtin_amdgcn_fence(__ATOMIC_ACQUIRE, "agent");
            asm volatile("s_waitcnt vmcnt(0)" ::: "memory");
        }
    }
    __syncthreads();
}

namespace pg8 {
constexpr int BM = 256, BK = 64, HALF = 128, HTB = HALF * BK * 2, STAGE_BYTES = 8 * HTB, NXCD = 8, WGM = 8;
__host__ __device__ __forceinline__ int lds_byte(int r, int c) { const int st = (r >> 4) * 2 + (c >> 5), rr = r & 15, cc = c & 31, ob = rr * 64 + cc * 2; return st * 1024 + (ob ^ (((ob >> 9) & 1) << 5)); }
__host__ __device__ __forceinline__ void stage_rc(int b, int& R, int& C) { const int st = b / 1024, sb = b % 1024, swz = sb ^ (((sb >> 9) & 1) << 5); R = (st >> 1) * 16 + swz / 64; C = (st & 1) * 32 + (swz % 64) / 2; }
__host__ __device__ __forceinline__ int perm32(int rho) { const int n = rho >> 4, i = rho & 15; return 8 * (i >> 2) + 4 * n + (i & 3); }
struct Unit { int pm, pn, e; };
struct Gemm { const void* A; const void* Bt; int K, lda, ldb; const int* rowidx; size_t bstride; const LAS int* ridx_lds = nullptr; };
struct StaticOrder {
    int nM, nN, nwg, G, c; const int* tile_e; const LAS int* e_lds = nullptr;
    __device__ __forceinline__ void init(int nM_, int nN_, int G_, int c_, const int* te) { nM = nM_; nN = nN_; nwg = nM * nN; G = G_; c = c_; tile_e = te; }
    __device__ __forceinline__ bool next(int i, Unit& u) const {
        const long L = (long)i * G + c; if (L >= nwg) return false;
        int wgid = (int)L; { const int q = nwg / NXCD, r = nwg % NXCD, xcd = wgid % NXCD, off = wgid / NXCD; wgid = (xcd < r ? xcd * (q + 1) : r * (q + 1) + (xcd - r) * q) + off; }
        const int nig = WGM * nN, gid = wgid / nig, fm = gid * WGM, gsz = (nM - fm) < WGM ? (nM - fm) : WGM;
        u.pm = fm + ((wgid % nig) % gsz); u.pn = (wgid % nig) / gsz; u.e = e_lds ? e_lds[i] : (tile_e ? tile_e[u.pm] : 0); return true;
    }
};
typedef f32x4 Acc[2][2][4][2];
typedef int v8i_t __attribute__((ext_vector_type(8)));
typedef int v4i_t __attribute__((ext_vector_type(4)));
template <class Epi, bool GATHER, bool FP8 = false, bool LDSIDX = false>
__device__ __forceinline__ void gemm_phase(LAS unsigned char* lds, const Gemm g, const StaticOrder& S, const Epi& E, const int wid, const bool do_epi = true) {
    const int lane = lane_id(), tid = wid * 64 + lane, wr = wid >> 2, wc = wid & 3, fr = lane & 15, fq = lane >> 4;
    constexpr int ES = FP8 ? 1 : 2;
    const int K = g.K, nt = K * ES / 128;
    int RA[2], CA[2]; unsigned voffB[2], voffA[2];
#pragma unroll
    for (int i = 0; i < 2; ++i) { int R, C; stage_rc(tid * 16 + i * 8192, R, C); const int Rb = Epi::PERM ? ((R & ~31) + perm32(R & 31)) : R;
        RA[i] = R; CA[i] = C; voffB[i] = (unsigned)(Rb * g.ldb * ES + C * 2); voffA[i] = (unsigned)(R * g.lda * ES + C * 2); }
    const size_t hstepA = GATHER ? 0 : (size_t)HALF * g.lda * ES;
    const size_t kstep = (size_t)(BK * 2);
    const size_t hstepB = (size_t)HALF * g.ldb * ES;
    const unsigned ldsw = (unsigned)wid * 1024u;
    const int aoff = lds_byte(wr * 64 + fr, fq * 8), boff = lds_byte(wc * 32 + fr, fq * 8);
#define PG8_SA(b, h) (((b) * 2 + (h)) * HTB)
#define PG8_SB(b, h) ((4 + (b) * 2 + (h)) * HTB)
#define PG8_STAGE(bufoff, gbase, voff) do { _Pragma("unroll") for (int _i = 0; _i < 2; ++_i) \
        __builtin_amdgcn_global_load_lds((const unsigned*)((const char*)(gbase) + (voff)[_i]), (LAS unsigned*)(lds + (bufoff) + ldsw + _i * 8192), 16, 0, 0); } while (0)
#define PG8_LDA(dst, b, h) do { _Pragma("unroll") for (int m = 0; m < 4; ++m) _Pragma("unroll") for (int k = 0; k < 2; ++k) dst[m][k] = *(const LAS bf16x8*)(lds + PG8_SA(b, h) + aoff + m * 2048 + k * 1024); } while (0)
#define PG8_LDB(dst, b, h) do { _Pragma("unroll") for (int n = 0; n < 2; ++n) _Pragma("unroll") for (int k = 0; k < 2; ++k) dst[n][k] = *(const LAS bf16x8*)(lds + PG8_SB(b, h) + boff + n * 2048 + k * 1024); } while (0)
#define PG8_CAT8(x) __builtin_shufflevector(__builtin_bit_cast(v4i_t, (x)[0]), __builtin_bit_cast(v4i_t, (x)[1]), 0, 1, 2, 3, 4, 5, 6, 7)
#define PG8_MMA(ai, bj, At, Bt) do { __builtin_amdgcn_s_setprio(1); if constexpr (FP8) { _Pragma("unroll") for (int m = 0; m < 4; ++m) _Pragma("unroll") for (int n = 0; n < 2; ++n) \
        acc[ai][bj][m][n] = __builtin_amdgcn_mfma_scale_f32_16x16x128_f8f6f4(PG8_CAT8(Bt[n]), PG8_CAT8(At[m]), acc[ai][bj][m][n], 0, 0, 0, 0x7f7f7f7f, 0, 0x7f7f7f7f); \
        _Pragma("unroll") for (int m = 0; m < 4; ++m) _Pragma("unroll") for (int n = 0; n < 2; ++n) asm volatile("" : "+v"(acc[ai][bj][m][n]));   } else { \
        _Pragma("unroll") for (int m = 0; m < 4; ++m) _Pragma("unroll") for (int n = 0; n < 2; ++n) _Pragma("unroll") for (int k = 0; k < 2; ++k) \
        acc[ai][bj][m][n] = __builtin_amdgcn_mfma_f32_16x16x32_bf16(Bt[n][k], At[m][k], acc[ai][bj][m][n], 0, 0, 0); } __builtin_amdgcn_s_setprio(0); } while (0)
#define PG8_WAIT_V(n) asm volatile("s_waitcnt vmcnt(" #n ")" ::: "memory")
#define PG8_WAIT_L(n) asm volatile("s_waitcnt lgkmcnt(" #n ")" ::: "memory")
#define PG8_BAR __builtin_amdgcn_s_barrier()
#define PG8_SCHED __builtin_amdgcn_sched_barrier(0)
#define PG8_SETVO(vo, u, ord) do { if constexpr (GATHER) { _Pragma("unroll") for (int _h = 0; _h < 2; ++_h) _Pragma("unroll") for (int _i = 0; _i < 2; ++_i) { \
        int _row; if constexpr (LDSIDX) _row = g.ridx_lds[(ord) * BM + _h * HALF + RA[_i]]; else _row = g.rowidx[(u).pm * BM + _h * HALF + RA[_i]]; (vo)[_h][_i] = (unsigned)_row * (unsigned)(g.lda * ES) + (unsigned)CA[_i] * 2u; } } } while (0)
#define PG8_STAGE_A(bufoff, base, h, vog) do { if constexpr (GATHER) { PG8_STAGE(bufoff, base, (vog)[h]); } else { PG8_STAGE(bufoff, (base) + (h) * hstepA, voffA); } } while (0)
    Unit cur, nxt; int ui = 0;
    if (!S.next(0, cur)) return;
    Acc acc;
#pragma unroll
    for (int a = 0; a < 2; ++a)
#pragma unroll
        for (int b = 0; b < 2; ++b)
#pragma unroll
            for (int m = 0; m < 4; ++m)
#pragma unroll
                for (int n = 0; n < 2; ++n) acc[a][b][m][n] = (f32x4){0.f, 0.f, 0.f, 0.f};
    bf16x8 At[4][2], B0[2][2], B1[2][2];
    unsigned voC[2][2], voN[2][2];
    PG8_SETVO(voC, cur, 0);
    const char* const Ab = (const char*)g.A;
    const char* cA = GATHER ? Ab : Ab + (size_t)cur.pm * 2 * hstepA;
    const char* cB = (const char*)g.Bt + (size_t)cur.e * g.bstride + (size_t)cur.pn * 2 * hstepB;
    PG8_STAGE(PG8_SB(0, 0), cB, voffB); PG8_STAGE(PG8_SB(0, 1), cB + hstepB, voffB); PG8_STAGE_A(PG8_SA(0, 0), cA, 0, voC); PG8_STAGE_A(PG8_SA(0, 1), cA, 1, voC);
    if (wr == 1) PG8_BAR;
    PG8_WAIT_V(2); PG8_BAR;
    PG8_STAGE(PG8_SB(1, 0), cB + kstep, voffB); PG8_STAGE_A(PG8_SA(1, 0), cA + kstep, 0, voC); PG8_STAGE(PG8_SB(1, 1), cB + hstepB + kstep, voffB);
    PG8_WAIT_V(6); PG8_BAR;
    for (;;) {
        const bool has_next = S.next(ui + 1, nxt);
        const char* nB = has_next ? (const char*)g.Bt + (size_t)nxt.e * g.bstride + (size_t)nxt.pn * 2 * hstepB : cB;
        const char* nA = (has_next && !GATHER) ? Ab + (size_t)nxt.pm * 2 * hstepA : cA;
        if constexpr (GATHER) { if (has_next) { PG8_SETVO(voN, nxt, ui + 1); } else {
#pragma unroll
            for (int h = 0; h < 2; ++h)
#pragma unroll
                for (int i = 0; i < 2; ++i) voN[h][i] = voC[h][i]; } }
        for (int t = 0; t < nt; t += 2) {
            const bool last = (t == nt - 2);
            if constexpr (Epi::MIDK > 0) { if (t == Epi::MIDK) { const int l2 = lane_id(); E.mid(acc, cur, wr, wc, l2 & 15, l2 >> 4); } }
            const char* a1 = cA + (size_t)(t + 1) * kstep;
            const char* a2 = last ? nA : cA + (size_t)(t + 2) * kstep; const char* b2 = last ? nB : cB + (size_t)(t + 2) * kstep;
            const char* a3 = a2 + kstep; const char* b3 = b2 + kstep;
            unsigned o2[2][2];
            if constexpr (GATHER) {
#pragma unroll
            for (int h = 0; h < 2; ++h)
#pragma unroll
                for (int i = 0; i < 2; ++i) o2[h][i] = last ? voN[h][i] : voC[h][i]; }
            PG8_LDB(B0, 0, 0); PG8_LDB(B1, 0, 1); PG8_SCHED; PG8_LDA(At, 0, 0); PG8_STAGE_A(PG8_SA(1, 1), a1, 1, voC);
            PG8_WAIT_V(8); PG8_WAIT_L(0); PG8_BAR; PG8_MMA(0, 0, At, B0); PG8_MMA(0, 1, At, B1); PG8_BAR; PG8_SCHED;
            PG8_LDA(At, 0, 1); PG8_STAGE(PG8_SB(0, 0), b2, voffB); PG8_STAGE(PG8_SB(0, 1), b2 + hstepB, voffB); PG8_STAGE_A(PG8_SA(0, 0), a2, 0, o2);
            PG8_WAIT_V(8); PG8_WAIT_L(0); PG8_BAR; PG8_MMA(1, 0, At, B0); PG8_MMA(1, 1, At, B1); PG8_BAR; PG8_SCHED;
            PG8_LDB(B0, 1, 0); PG8_LDB(B1, 1, 1); PG8_SCHED; PG8_LDA(At, 1, 0); PG8_STAGE_A(PG8_SA(0, 1), a2, 1, o2);
            PG8_WAIT_V(8); PG8_WAIT_L(0); PG8_BAR; PG8_MMA(0, 0, At, B0); PG8_MMA(0, 1, At, B1); PG8_BAR; PG8_SCHED;
            PG8_LDA(At, 1, 1); PG8_STAGE(PG8_SB(1, 0), b3, voffB); PG8_STAGE(PG8_SB(1, 1), b3 + hstepB, voffB); PG8_STAGE_A(PG8_SA(1, 0), a3, 0, o2);
            PG8_WAIT_V(8); PG8_WAIT_L(0); PG8_BAR; PG8_MMA(1, 0, At, B0); PG8_MMA(1, 1, At, B1); PG8_BAR; PG8_SCHED;
        }
        if (wr == 0) PG8_BAR;
#ifdef PROBE_EPI
        const unsigned te0_ = (unsigned)__builtin_amdgcn_s_memrealtime();
#endif
        if (do_epi) { const int l2 = lane_id(); E(acc, cur, wr, wc, l2 & 15, l2 >> 4); }
#ifdef PROBE_EPI
        asm volatile("s_waitcnt vmcnt(0)" ::: "memory");
        if (blockIdx.x == 0 && wid == 0 && lane_id() == 0) { LAS unsigned* M_ = (LAS unsigned*)(lds + 131072); M_[62] += (unsigned)__builtin_amdgcn_s_memrealtime() - te0_; }
#endif
        if (!has_next) break;
#pragma unroll
        for (int a = 0; a < 2; ++a)
#pragma unroll
            for (int b = 0; b < 2; ++b)
#pragma unroll
                for (int m = 0; m < 4; ++m)
#pragma unroll
                    for (int n = 0; n < 2; ++n) acc[a][b][m][n] = (f32x4){0.f, 0.f, 0.f, 0.f};
        cur = nxt; cB = nB; cA = nA; ++ui;
        if constexpr (GATHER) {
#pragma unroll
        for (int h = 0; h < 2; ++h)
#pragma unroll
            for (int i = 0; i < 2; ++i) voC[h][i] = voN[h][i]; }
        if (wr == 1) PG8_BAR;
    }
    PG8_WAIT_V(0);
    PG8_BAR;
#undef PG8_SA
#undef PG8_SB
#undef PG8_STAGE
#undef PG8_LDA
#undef PG8_LDB
#undef PG8_MMA
#undef PG8_CAT8
#undef PG8_WAIT_V
#undef PG8_WAIT_L
#undef PG8_BAR
#undef PG8_SCHED
#undef PG8_SETVO
#undef PG8_STAGE_A
}

__device__ __forceinline__ unsigned pk4_fp8(f32x4 v) { unsigned w = 0; w = __builtin_amdgcn_cvt_pk_fp8_f32(v[0], v[1], w, false); w = __builtin_amdgcn_cvt_pk_fp8_f32(v[2], v[3], w, true); return w; }
__device__ __forceinline__ float sq4(f32x4 v) { return (v[0] * v[0] + v[1] * v[1]) + (v[2] * v[2] + v[3] * v[3]); }
__device__ __forceinline__ float red_fq(float s) { s += __shfl_xor(s, 16); s += __shfl_xor(s, 32); return s; }
__device__ __forceinline__ u32x4 pack8(f32x4 a, f32x4 b) { u32x4 w; w.x = cvt_pk_bf16(a[0], a[1]); w.y = cvt_pk_bf16(a[2], a[3]); w.z = cvt_pk_bf16(b[0], b[1]); w.w = cvt_pk_bf16(b[2], b[3]); return w; }
template <int MODE> struct EpiBf16Stats {
    static constexpr bool PERM = true; static constexpr int MIDK = 0;
    bf16_t* O; int ldc; float* ssq; const float* rsx;
    __device__ __forceinline__ void operator()(const Acc& acc, const Unit& u, int wr, int wc, int fr, int fq) const {
        const int row0 = u.pm * BM + wr * 64 + fr, col0 = u.pn * BM + wc * 32 + 8 * fq;
        float rv[2][4];
#pragma unroll
        for (int ai = 0; ai < 2; ++ai)
#pragma unroll
            for (int m = 0; m < 4; ++m) rv[ai][m] = rsx ? rsx[row0 + ai * HALF + m * 16] : 1.f;
        asm volatile("" ::: "memory");
#pragma unroll
        for (int ai = 0; ai < 2; ++ai)
#pragma unroll
            for (int m = 0; m < 4; ++m) { const int row = row0 + ai * HALF + m * 16; bf16_t* rowp = O + (size_t)row * ldc + col0; const float rs = rv[ai][m];
                const f32x4 a00 = acc[ai][0][m][0] * rs, a01 = acc[ai][0][m][1] * rs, a10 = acc[ai][1][m][0] * rs, a11 = acc[ai][1][m][1] * rs;
                if (MODE == 0 && u.pn >= 4) { *(u32x4*)(O + (size_t)row * ldc + 960 + (u.pn - 4) * HALF + wc * 32 + 8 * fq) = pack8(a00 * a10, a01 * a11); continue; }
                if (MODE == 1) *(u32x4*)((unsigned char*)O + (size_t)row * ldc + u.pn * BM + 64 * wc + 16 * fq) = (u32x4){pk4_fp8(a00), pk4_fp8(a01), pk4_fp8(a10), pk4_fp8(a11)};
                else { *(u32x4*)(rowp) = pack8(a00, a01); if (!(MODE == 0 && u.pn == 3 && wc >= 2)) *(u32x4*)(rowp + HALF) = pack8(a10, a11); }
                if (MODE == 1) { float s = (sq4(a00) + sq4(a01)) + (sq4(a10) + sq4(a11)); s = red_fq(s); if (fq == 0) ssq[(size_t)row * 16 + u.pn * 4 + wc] = s; }
                else if (u.pn == 0) { float s = (sq4(a00) + sq4(a01)) + (sq4(a10) + sq4(a11)); s = red_fq(s); if (fq == 0) ssq[(size_t)row * 8 + wc] = s; }
                else if (u.pn == 1) { float s = sq4(a00) + sq4(a01); s = red_fq(s); if (fq == 0) ssq[(size_t)row * 8 + 4 + wc] = s; } }
    }
};
struct EpiQ {
    static constexpr bool PERM = true; static constexpr int MIDK = 0;
    bf16_t* Q; const float* ssq; const float* cs;
    __device__ __forceinline__ void operator()(const Acc& acc, const Unit& u, int wr, int wc, int fr, int fq) const {
        const int row0 = u.pm * BM + wr * 64 + fr;
#pragma unroll
        for (int ai = 0; ai < 2; ++ai)
#pragma unroll
            for (int m = 0; m < 4; ++m) { const int row = row0 + ai * HALF + m * 16; const f32x4 sv = *(const f32x4*)(ssq + (size_t)row * 8);
                const float rs = rsqrtf(((sv[0] + sv[1]) + (sv[2] + sv[3])) * (1.f / QL) + EPS); const int b = row / SEQ, s = row % SEQ;
#pragma unroll
                for (int bj = 0; bj < 2; ++bj) { const int cv = u.pn * BM + bj * HALF + wc * 32 + 8 * fq; const int h = cv / DQK, d = cv % DQK;
                    f32x4 v0 = acc[ai][bj][m][0] * rs, v1 = acc[ai][bj][m][1] * rs;
                    if (d >= DN) { const int i0 = (d - DN) >> 1; const f32x4 c = *(const f32x4*)(cs + (size_t)row * 64 + i0), sn = *(const f32x4*)(cs + (size_t)row * 64 + 32 + i0);
                        const f32x4 r0 = {v0[0] * c[0] - v0[1] * sn[0], v0[0] * sn[0] + v0[1] * c[0], v0[2] * c[1] - v0[3] * sn[1], v0[2] * sn[1] + v0[3] * c[1]};
                        const f32x4 r1 = {v1[0] * c[2] - v1[1] * sn[2], v1[0] * sn[2] + v1[1] * c[2], v1[2] * c[3] - v1[3] * sn[3], v1[2] * sn[3] + v1[3] * c[3]};
                        v0 = r0; v1 = r1; }
                    *(u32x4*)(Q + ((size_t)(b * NH + h) * SEQ + s) * DQK + d) = pack8(v0, v1); } }
    }
};
struct EpiKV {
    static constexpr bool PERM = true; static constexpr int MIDK = 0;
    bf16_t* Kc; bf16_t* Vc; const float* ssq;
    __device__ __forceinline__ void operator()(const Acc& acc, const Unit& u, int wr, int wc, int fr, int fq) const {
        const int row0 = u.pm * BM + wr * 64 + fr, d = wc * 32 + 8 * fq, h = u.pn;
#pragma unroll
        for (int ai = 0; ai < 2; ++ai)
#pragma unroll
            for (int m = 0; m < 4; ++m) { const int row = row0 + ai * HALF + m * 16; const f32x4 sv = *(const f32x4*)(ssq + (size_t)row * 8 + 4);
                const float rs = rsqrtf(((sv[0] + sv[1]) + (sv[2] + sv[3])) * (1.f / KVL) + EPS); const int b = row / SEQ, s = row % SEQ; const size_t t = (size_t)(b * NH + h) * SEQ + s;
                *(u32x4*)(Kc + t * DQK + d) = pack8(acc[ai][0][m][0] * rs, acc[ai][0][m][1] * rs);
                *(u32x4*)(Vc + t * DV + d) = pack8(acc[ai][1][m][0] * rs, acc[ai][1][m][1] * rs); }
    }
};
struct EpiWo {
    static constexpr bool PERM = true; static constexpr int MIDK = 8;
    const bf16_t* x; bf16_t* HBF; unsigned char* X8; const float* assq; float* ssq1; const float* gmoe;
    __device__ __forceinline__ void mid(Acc& acc, const Unit& u, int wr, int wc, int fr, int fq) const {
        const int row0 = u.pm * BM + wr * 64 + fr;
#pragma unroll
        for (int ai = 0; ai < 2; ++ai)
#pragma unroll
            for (int m = 0; m < 4; ++m) { const f32x4 sv = *(const f32x4*)(assq + (size_t)(row0 + ai * HALF + m * 16) * 4);
                const float rs = rsqrtf(((sv[0] + sv[1]) + (sv[2] + sv[3])) * (1.f / 512.f) + EPS);
#pragma unroll
                for (int bj = 0; bj < 2; ++bj)
#pragma unroll
                    for (int n = 0; n < 2; ++n) acc[ai][bj][m][n] = acc[ai][bj][m][n] * rs; }
    }
    __device__ __forceinline__ void operator()(const Acc& acc, const Unit& u, int wr, int wc, int fr, int fq) const {
        const int row0 = u.pm * BM + wr * 64 + fr, col0 = u.pn * BM + wc * 32 + 8 * fq;
        f32x4 gn[2][2];
#pragma unroll
        for (int bj = 0; bj < 2; ++bj) { gn[bj][0] = *(const f32x4*)(gmoe + col0 + bj * HALF); gn[bj][1] = *(const f32x4*)(gmoe + col0 + bj * HALF + 4); }
#pragma unroll
        for (int ai = 0; ai < 2; ++ai) { u32x4 xv[4][2];
#pragma unroll
            for (int m = 0; m < 4; ++m) { const size_t off = (size_t)(row0 + ai * HALF + m * 16) * DM + col0;
#pragma unroll
                for (int bj = 0; bj < 2; ++bj) xv[m][bj] = *(const u32x4*)(x + off + bj * HALF); }
            asm volatile("" ::: "memory");
#pragma unroll
            for (int m = 0; m < 4; ++m) { const int row = row0 + ai * HALF + m * 16; const size_t off = (size_t)row * DM + col0; float ss = 0.f;
#pragma unroll
                for (int bj = 0; bj < 2; ++bj) { const u32x4 xq = xv[m][bj]; const f32x4 h0 = (f32x4){blo(xq.x), bhi(xq.x), blo(xq.y), bhi(xq.y)} + acc[ai][bj][m][0], h1 = (f32x4){blo(xq.z), bhi(xq.z), blo(xq.w), bhi(xq.w)} + acc[ai][bj][m][1];
                    *(u32x4*)(HBF + off + bj * HALF) = pack8(h0, h1); *(u32x2*)(X8 + off + bj * HALF) = (u32x2){pk4_fp8(h0 * gn[bj][0]), pk4_fp8(h1 * gn[bj][1])}; ss += sq4(h0) + sq4(h1); }
                ss = red_fq(ss); if (fq == 0) ssq1[(size_t)row * 16 + u.pn * 4 + wc] = ss; }
            asm volatile("" ::: "memory"); }
    }
};
__device__ __forceinline__ f32x4 sigmoid4(f32x4 a) { const f32x4 t = a * -1.44269504f; f32x4 e; e[0] = __builtin_amdgcn_exp2f(t[0]); e[1] = __builtin_amdgcn_exp2f(t[1]); e[2] = __builtin_amdgcn_exp2f(t[2]); e[3] = __builtin_amdgcn_exp2f(t[3]);
    const f32x4 d = e + 1.0f; f32x4 r; r[0] = __builtin_amdgcn_rcpf(d[0]); r[1] = __builtin_amdgcn_rcpf(d[1]); r[2] = __builtin_amdgcn_rcpf(d[2]); r[3] = __builtin_amdgcn_rcpf(d[3]); return r; }
__device__ __forceinline__ f32x2 swiglu2(f32x2 g, f32x2 u) {
    g.x = fminf(g.x, 7.f); g.y = fminf(g.y, 7.f); u.x = __builtin_amdgcn_fmed3f(u.x, -7.f, 7.f); u.y = __builtin_amdgcn_fmed3f(u.y, -7.f, 7.f);
    const f32x2 t = g * -2.45546696f; f32x2 e; e.x = __builtin_amdgcn_exp2f(t.x); e.y = __builtin_amdgcn_exp2f(t.y); const f32x2 d = e + 1.0f; f32x2 r; r.x = __builtin_amdgcn_rcpf(d.x); r.y = __builtin_amdgcn_rcpf(d.y);
    const f32x2 gs = g * r; return u * gs + gs; }
__device__ __forceinline__ float swiglu_f(float g, float u) { g = fminf(g, 7.f); u = __builtin_amdgcn_fmed3f(u, -7.f, 7.f); const float gs = g * __builtin_amdgcn_rcpf(1.f + __builtin_amdgcn_exp2f(g * -2.45546696f)); return fmaf(u, gs, gs); }
constexpr float WSCALE = 64.f, WINV = 1.f / 64.f;
struct EpiMoe1 {
    static constexpr bool PERM = true; static constexpr int MIDK = 0;
    unsigned char* HB; const float* b1; const float* rowrs;
    __device__ __forceinline__ void operator()(const Acc& acc, const Unit& u, int wr, int wc, int fr, int fq) const {
        const int row0 = u.pm * BM + wr * 64 + fr, j0 = u.pn * HALF + wc * 32 + 8 * fq; const float* bg = b1 + (size_t)u.e * 2048 + j0;
        const f32x4 g0 = *(const f32x4*)bg, g1 = *(const f32x4*)(bg + 4), u0 = *(const f32x4*)(bg + 1024), u1 = *(const f32x4*)(bg + 1028);
        float rsv[2][4];
#pragma unroll
        for (int ai = 0; ai < 2; ++ai)
#pragma unroll
            for (int m = 0; m < 4; ++m) rsv[ai][m] = rowrs[row0 + ai * HALF + m * 16];
        asm volatile("" ::: "memory");
#pragma unroll
        for (int ai = 0; ai < 2; ++ai)
#pragma unroll
            for (int m = 0; m < 4; ++m) { const float rs = rsv[ai][m] * WINV;
                const f32x4 a0 = acc[ai][0][m][0] * rs + g0, a1 = acc[ai][0][m][1] * rs + g1, c0 = acc[ai][1][m][0] * rs + u0, c1 = acc[ai][1][m][1] * rs + u1; f32x4 r0, r1;
#pragma unroll
                for (int j = 0; j < 4; j += 2) { const f32x2 s0 = swiglu2((f32x2){a0[j], a0[j + 1]}, (f32x2){c0[j], c0[j + 1]}), s1 = swiglu2((f32x2){a1[j], a1[j + 1]}, (f32x2){c1[j], c1[j + 1]}); r0[j] = s0.x; r0[j + 1] = s0.y; r1[j] = s1.x; r1[j + 1] = s1.y; }
                *(u32x2*)(HB + (size_t)(row0 + ai * HALF + m * 16) * DE + j0) = (u32x2){pk4_fp8(r0), pk4_fp8(r1)}; }
    }
};
struct EpiMoe2 {
    static constexpr bool PERM = true; static constexpr int MIDK = 0;
    unsigned char* Y; const float* b2; const int* rowslot; const float* rowgate;
    __device__ __forceinline__ void operator()(const Acc& acc, const Unit& u, int wr, int wc, int fr, int fq) const {
        const int row0 = u.pm * BM + wr * 64 + fr, col0 = u.pn * BM + wc * 64 + 16 * fq; const float* bb = b2 + (size_t)u.e * DM + col0;
        f32x4 bv[2][2];
#pragma unroll
        for (int bj = 0; bj < 2; ++bj)
#pragma unroll
            for (int n = 0; n < 2; ++n) bv[bj][n] = *(const f32x4*)(bb + bj * 8 + 4 * n);
        float gtv[2][4]; int slv[2][4];
#pragma unroll
        for (int ai = 0; ai < 2; ++ai)
#pragma unroll
            for (int m = 0; m < 4; ++m) { const int r = row0 + ai * HALF + m * 16; gtv[ai][m] = rowgate[r]; slv[ai][m] = rowslot[r]; }
        asm volatile("" ::: "memory");
#pragma unroll
        for (int ai = 0; ai < 2; ++ai)
#pragma unroll
            for (int m = 0; m < 4; ++m) { const float gt = gtv[ai][m]; unsigned char* yp = Y + (size_t)slv[ai][m] * DM + col0;
                *(u32x4*)yp = (u32x4){pk4_fp8((acc[ai][0][m][0] * WINV + bv[0][0]) * gt), pk4_fp8((acc[ai][0][m][1] * WINV + bv[0][1]) * gt), pk4_fp8((acc[ai][1][m][0] * WINV + bv[1][0]) * gt), pk4_fp8((acc[ai][1][m][1] * WINV + bv[1][1]) * gt)}; }
    }
};
struct EpiPle {
    static constexpr bool PERM = true; static constexpr int MIDK = 0;
    const bf16_t* H2; bf16_t* H3; const bf16_t* pler; const float* rpv; const float* rs2; const float* pg; float* fssq;
    __device__ __forceinline__ void operator()(const Acc& acc, const Unit& u, int wr, int wc, int fr, int fq) const {
        const int row0 = u.pm * BM + wr * 64 + fr, col0 = u.pn * BM + wc * 32 + 8 * fq;
        f32x4 gv[2][2];
#pragma unroll
        for (int bj = 0; bj < 2; ++bj)
#pragma unroll
            for (int n = 0; n < 2; ++n) gv[bj][n] = *(const f32x4*)(pg + col0 + bj * HALF + n * 4);
#pragma unroll
        for (int am = 0; am < 4; ++am) { const int ai = am >> 1; u32x4 hq[2][2]; u32x2 pq[2][2]; float r2v[2], rpq[2];
#pragma unroll
            for (int mm = 0; mm < 2; ++mm) { const int row = row0 + ai * HALF + ((am & 1) * 2 + mm) * 16; const size_t off = (size_t)row * DM + col0; r2v[mm] = rs2[row]; rpq[mm] = rpv[row];
#pragma unroll
                for (int bj = 0; bj < 2; ++bj) { hq[mm][bj] = *(const u32x4*)(H2 + off + bj * HALF); pq[mm][bj] = *(const u32x2*)((const unsigned char*)pler + off + bj * HALF); } }
            asm volatile("" ::: "memory");
#pragma unroll
            for (int mm = 0; mm < 2; ++mm) { const int m = (am & 1) * 2 + mm; const int row = row0 + ai * HALF + m * 16; const size_t off = (size_t)row * DM + col0; const float r2 = r2v[mm], rp = rpq[mm]; float ss = 0.f;
#pragma unroll
                for (int bj = 0; bj < 2; ++bj) { const size_t o = off + bj * HALF; const u32x4 hv = hq[mm][bj]; const u32x2 pr = pq[mm][bj];
                    const f32x4 h0 = {blo(hv.x), bhi(hv.x), blo(hv.y), bhi(hv.y)}, h1 = {blo(hv.z), bhi(hv.z), blo(hv.w), bhi(hv.w)};
                    const f32x2 qa = __builtin_amdgcn_cvt_pk_f32_fp8(pr.x, false), qb = __builtin_amdgcn_cvt_pk_f32_fp8(pr.x, true), qc = __builtin_amdgcn_cvt_pk_f32_fp8(pr.y, false), qd = __builtin_amdgcn_cvt_pk_f32_fp8(pr.y, true);
                    const f32x4 q0 = {qa[0], qa[1], qb[0], qb[1]}, q1 = {qc[0], qc[1], qd[0], qd[1]};
                    const f32x4 r0 = h0 + sigmoid4(acc[ai][bj][m][0] * r2) * (q0 * (gv[bj][0] * rp)), r1 = h1 + sigmoid4(acc[ai][bj][m][1] * r2) * (q1 * (gv[bj][1] * rp));
                    *(u32x4*)(H3 + o) = pack8(r0, r1); ss += sq4(r0) + sq4(r1); }
                ss = red_fq(ss); if (fq == 0) fssq[(size_t)row * 16 + u.pn * 4 + wc] = ss; }
            asm volatile("" ::: "memory"); }
    }
};
struct EpiPleFinal {
    static constexpr bool PERM = true; static constexpr int MIDK = 0;
    const bf16_t* H2; float* out; const bf16_t* pler; const float* rpv; const float* rs2; const float* pg; const float* gf; float* xs; unsigned* cnt; unsigned* tmo; LAS unsigned char* lds;
    __device__ __forceinline__ void operator()(Acc& acc, const Unit& u, int wr, int wc, int fr, int fq) const {
        const int row0 = u.pm * BM + wr * 64 + fr, col0 = u.pn * BM + wc * 32 + 8 * fq;
        LAS float* P = (LAS float*)(lds + STG_OFF); LAS float* S = P + 1024; const int tid = (wr * 4 + wc) * 64 + fq * 16 + fr;
#define PF_BAR() asm volatile("s_waitcnt lgkmcnt(0)\n\ts_barrier" ::: "memory")
        { f32x4 gv[2][2];
#pragma unroll
          for (int bj = 0; bj < 2; ++bj)
#pragma unroll
            for (int n = 0; n < 2; ++n) gv[bj][n] = *(const f32x4*)(pg + col0 + bj * HALF + n * 4);
#pragma unroll
          for (int am = 0; am < 4; ++am) { const int ai = am >> 1; u32x4 hq[2][2]; u32x2 pq[2][2]; float r2v[2], rpq[2];
#pragma unroll
            for (int mm = 0; mm < 2; ++mm) { const int row = row0 + ai * HALF + ((am & 1) * 2 + mm) * 16; const size_t off = (size_t)row * DM + col0; r2v[mm] = rs2[row]; rpq[mm] = rpv[row];
#pragma unroll
                for (int bj = 0; bj < 2; ++bj) { hq[mm][bj] = *(const u32x4*)(H2 + off + bj * HALF); pq[mm][bj] = *(const u32x2*)((const unsigned char*)pler + off + bj * HALF); } }
            asm volatile("" ::: "memory");
#pragma unroll
            for (int mm = 0; mm < 2; ++mm) { const int m = (am & 1) * 2 + mm; const float r2 = r2v[mm], rp = rpq[mm]; float ss = 0.f;
#pragma unroll
                for (int bj = 0; bj < 2; ++bj) { const u32x4 hv = hq[mm][bj]; const u32x2 pr = pq[mm][bj];
                    const f32x4 h0 = {blo(hv.x), bhi(hv.x), blo(hv.y), bhi(hv.y)}, h1 = {blo(hv.z), bhi(hv.z), blo(hv.w), bhi(hv.w)};
                    const f32x2 qa = __builtin_amdgcn_cvt_pk_f32_fp8(pr.x, false), qb = __builtin_amdgcn_cvt_pk_f32_fp8(pr.x, true), qc = __builtin_amdgcn_cvt_pk_f32_fp8(pr.y, false), qd = __builtin_amdgcn_cvt_pk_f32_fp8(pr.y, true);
                    const f32x4 q0 = {qa[0], qa[1], qb[0], qb[1]}, q1 = {qc[0], qc[1], qd[0], qd[1]};
                    const f32x4 r0 = h0 + sigmoid4(acc[ai][bj][m][0] * r2) * (q0 * (gv[bj][0] * rp)), r1 = h1 + sigmoid4(acc[ai][bj][m][1] * r2) * (q1 * (gv[bj][1] * rp));
                    acc[ai][bj][m][0] = r0; acc[ai][bj][m][1] = r1; ss += sq4(r0) + sq4(r1); }
                ss = red_fq(ss); if (fq == 0) P[(ai * HALF + wr * 64 + m * 16 + fr) * 4 + wc] = ss; }
            asm volatile("" ::: "memory"); } }
        PF_BAR();
        if (tid < 256) { const f32x4 p4 = *(const LAS f32x4*)(P + tid * 4); __hip_atomic_store(xs + (size_t)(u.pm * 4 + u.pn) * 256 + tid, (p4[0] + p4[1]) + (p4[2] + p4[3]), __ATOMIC_RELAXED, __HIP_MEMORY_SCOPE_AGENT); }
        asm volatile("s_waitcnt vmcnt(0)" ::: "memory");
        PF_BAR();
        if (tid < 64) {
            if (tid == 0) (void)__hip_atomic_fetch_add(cnt + 64 * u.pm, 1u, __ATOMIC_RELAXED, __HIP_MEMORY_SCOPE_AGENT);
            unsigned sp = 0;
            while ((unsigned)__builtin_amdgcn_readfirstlane(__hip_atomic_load(cnt + 64 * u.pm, __ATOMIC_RELAXED, __HIP_MEMORY_SCOPE_AGENT)) < 4u) {
                __builtin_amdgcn_s_sleep(2); if (++sp > (1u << 22)) { if (tid == 0) __hip_atomic_store(tmo, 1u, __ATOMIC_RELAXED, __HIP_MEMORY_SCOPE_AGENT); break; } }
            __builtin_amdgcn_fence(__ATOMIC_ACQUIRE, "agent");
            asm volatile("s_waitcnt vmcnt(0)" ::: "memory"); }
        PF_BAR();
        if (tid < 256) { float t = 0.f;
#pragma unroll
            for (int q = 0; q < 4; ++q) t += __hip_atomic_load(xs + (size_t)(u.pm * 4 + q) * 256 + tid, __ATOMIC_RELAXED, __HIP_MEMORY_SCOPE_AGENT);
            S[tid] = rsqrtf(t * (1.f / DM) + EPS); }
        PF_BAR();
        { f32x4 gq[2][2];
#pragma unroll
          for (int bj = 0; bj < 2; ++bj)
#pragma unroll
            for (int n = 0; n < 2; ++n) gq[bj][n] = *(const f32x4*)(gf + col0 + bj * HALF + n * 4);
#pragma unroll
          for (int ai = 0; ai < 2; ++ai)
#pragma unroll
            for (int m = 0; m < 4; ++m) { const float rs = S[ai * HALF + wr * 64 + m * 16 + fr]; float* op = out + (size_t)(row0 + ai * HALF + m * 16) * DM + col0;
#pragma unroll
                for (int bj = 0; bj < 2; ++bj) { *(f32x4*)(op + bj * HALF) = acc[ai][bj][m][0] * rs * gq[bj][0]; *(f32x4*)(op + bj * HALF + 4) = acc[ai][bj][m][1] * rs * gq[bj][1]; } } }
        PF_BAR();
#undef PF_BAR
    }
};
}

namespace att {
typedef float f32x16 __attribute__((ext_vector_type(16)));
typedef short s16x4 __attribute__((ext_vector_type(4)));
constexpr int QBLK = 32, KVBLK = 64, QB = 256;
constexpr int SHM_K = KVBLK * DQK * 2, SHM_V = KVBLK * DV * 2;
constexpr int L_V = 0, L_K = 2 * SHM_V, L_WS = L_K + 2 * SHM_K, L_END = L_WS + NWAVES * 256;
constexpr float THR = 8.f;
#define KSWZ(row, colB) ((row) * 384 + ((colB) ^ (((row) & 7) << 4)))
#define SBAR() __builtin_amdgcn_sched_barrier(0)
__device__ __forceinline__ int v_st(int k, int c) { const int kk = (k & ~0xC) | ((k & 4) << 1) | ((k & 8) >> 1); return ((kk >> 3) * 4 + (c >> 5)) * 512 + ((kk & 7) * 32 + (c & 31)) * 2; }
__device__ __forceinline__ int v_rd_base(int lane) { return ((lane & 3) << 3) | (((lane >> 2) & 3) << 6) | (((lane >> 4) & 1) << 5) | (((lane >> 5) & 1) << 8); }
constexpr int v_rd_off(int d0, int ks, int half) { return d0 * 512 + ks * 4096 + half * 2048; }
__device__ __forceinline__ int crow(int r, int hi) { return (r & 3) + 8 * (r >> 2) + 4 * hi; }
typedef __bf16 bf16x2_t __attribute__((ext_vector_type(2)));
__device__ __forceinline__ unsigned cvtpk(float lo, float hi) { f32x2 v = {lo, hi}; bf16x2_t b = __builtin_convertvector(v, bf16x2_t); return __builtin_bit_cast(unsigned, b); }

__device__ __forceinline__ void qkt(f32x16& p0, f32x16& p1, const LAS unsigned char* Kbuf, int r32, int hi, const bf16x8* qr) {
    p0 = f32x16{}; p1 = f32x16{};
    const LAS unsigned char* kb[4];
#pragma unroll
    for (int dd = 0; dd < 4; ++dd) kb[dd] = Kbuf + KSWZ(r32, (dd * 16 + hi * 8) * 2);
    bf16x8 kf[2][2];
#define KLD(d) do { const LAS unsigned char* a = kb[(d) & 3] + ((d) >> 2) * 128; kf[(d) & 1][0] = *(const LAS bf16x8*)a; kf[(d) & 1][1] = *(const LAS bf16x8*)(a + 32 * 384); } while (0)
    KLD(0);
#pragma unroll
    for (int d0 = 0; d0 < 12; ++d0) { if (d0 + 1 < 12) KLD(d0 + 1);
        p0 = __builtin_amdgcn_mfma_f32_32x32x16_bf16(kf[d0 & 1][0], qr[d0], p0, 0, 0, 0);
        p1 = __builtin_amdgcn_mfma_f32_32x32x16_bf16(kf[d0 & 1][1], qr[d0], p1, 0, 0, 0); }
#undef KLD
    __builtin_amdgcn_sched_group_barrier(0x100, 2, 0);
#pragma unroll
    for (int d0 = 0; d0 < 11; ++d0) { __builtin_amdgcn_sched_group_barrier(0x100, 2, 0); __builtin_amdgcn_sched_group_barrier(0x008, 2, 0); }
    __builtin_amdgcn_sched_group_barrier(0x008, 2, 0);
}
__device__ __forceinline__ void pv_tile(f32x16* o, int vb0, bf16x8 pa0, bf16x8 pa1, bf16x8 pa2, bf16x8 pa3) {
#define TRRD(dst, off) asm volatile("ds_read_b64_tr_b16 %0, %1 offset:%2" : "=&v"(dst) : "v"(vb0), "i"(off) : "memory")
#define PV_RD(S_, d0) do { constexpr int b_ = v_rd_off(d0, 0, 0); \
        TRRD(S_[0], b_); TRRD(S_[1], b_ + 2048); TRRD(S_[2], b_ + 4096); TRRD(S_[3], b_ + 6144); TRRD(S_[4], b_ + 8192); TRRD(S_[5], b_ + 10240); TRRD(S_[6], b_ + 12288); TRRD(S_[7], b_ + 14336); } while (0)
#define PV_MM(S_, d0) do { \
        o[d0] = __builtin_amdgcn_mfma_f32_32x32x16_bf16(pa0, (bf16x8){S_[0][0], S_[0][1], S_[0][2], S_[0][3], S_[1][0], S_[1][1], S_[1][2], S_[1][3]}, o[d0], 0, 0, 0); \
        o[d0] = __builtin_amdgcn_mfma_f32_32x32x16_bf16(pa1, (bf16x8){S_[2][0], S_[2][1], S_[2][2], S_[2][3], S_[3][0], S_[3][1], S_[3][2], S_[3][3]}, o[d0], 0, 0, 0); \
        o[d0] = __builtin_amdgcn_mfma_f32_32x32x16_bf16(pa2, (bf16x8){S_[4][0], S_[4][1], S_[4][2], S_[4][3], S_[5][0], S_[5][1], S_[5][2], S_[5][3]}, o[d0], 0, 0, 0); \
        o[d0] = __builtin_amdgcn_mfma_f32_32x32x16_bf16(pa3, (bf16x8){S_[6][0], S_[6][1], S_[6][2], S_[6][3], S_[7][0], S_[7][1], S_[7][2], S_[7][3]}, o[d0], 0, 0, 0); } while (0)
    s16x4 A_[8], B_[8];
    PV_RD(A_, 0);
    PV_RD(B_, 1); asm volatile("s_waitcnt lgkmcnt(8)" ::: "memory"); SBAR(); PV_MM(A_, 0); SBAR();
    PV_RD(A_, 2); asm volatile("s_waitcnt lgkmcnt(8)" ::: "memory"); SBAR(); PV_MM(B_, 1); SBAR();
    PV_RD(B_, 3); asm volatile("s_waitcnt lgkmcnt(8)" ::: "memory"); SBAR(); PV_MM(A_, 2); SBAR();
    asm volatile("s_waitcnt lgkmcnt(0)" ::: "memory"); SBAR(); PV_MM(B_, 3);
#undef PV_RD
#undef PV_MM
#undef TRRD
}
struct ConvJob { const float* w1; const float* w2; const float* gain; unsigned char* W1T; unsigned char* W2T; int gw, ngw; };
constexpr int CV_N1 = NE * 32 * 64, CV_N2 = NE * 32 * 32, CV_TOTAL = CV_N1 + CV_N2;
__device__ __forceinline__ int cv_cmap2(int n) { const int t = n & ~255, v = n & 255; return t + 64 * ((v >> 5) & 3) + 16 * ((v >> 3) & 3) + 8 * (v >> 7) + (v & 7); }
__device__ __forceinline__ int cv_cmap1(int n) { const int pn = n >> 8, half = (n >> 7) & 1, jj = n & 127; return half * 1024 + pn * 128 + jj; }
#define CV_DECODE(idx) \
    const bool cv_on = (idx) < CV_TOTAL; const bool cv_is1 = (idx) < CV_N1; const int cv_r = cv_is1 ? (idx) : (idx) - CV_N1; \
    const int cv_sh = cv_is1 ? 6 : 5, cv_ld = cv_is1 ? 2048 : 1024; const int cv_e = cv_r >> (cv_sh + 5), cv_q = cv_r & ((32 << cv_sh) - 1), cv_k0 = 32 * (cv_q >> cv_sh), cv_n0 = 32 * (cv_q & ((1 << cv_sh) - 1)); \
    const float* cv_src = (cv_is1 ? cj.w1 + (size_t)cv_e * 1024 * 2048 : cj.w2 + (size_t)cv_e * 1024 * 1024); \
    const int cv_c = cv_is1 ? cv_cmap1(cv_n0 + 4 * (lane & 7)) : cv_cmap2(cv_n0 + 4 * (lane & 7));
#define CV_LOAD() do { if (cv_on) { const char* cvb = (const char*)(cv_src + (size_t)cv_k0 * cv_ld); const unsigned cvo = (unsigned)(((lane >> 3) * cv_ld + cv_c) * 4);     \
        LAS unsigned char* scrb = lds + L_END + wid * 4224;     \
        _Pragma("unroll") for (int i = 0; i < 4; ++i) __builtin_amdgcn_global_load_lds((const unsigned*)(cvb + (size_t)(8 * i) * cv_ld * 4 + cvo), (LAS unsigned*)(scrb + i * 1056), 16, 0, 0); } } while (0)
#define CV_SV(j) (s[(2 * cc + ((j) >> 3)) * 264 + ((j) & 7) * 32])
#define CV_STORE() do { if (cv_on) { const LAS float* scr = (const LAS float*)(lds + L_END + wid * 4224); \
        { const int n = lane >> 1, cc = lane & 1; const LAS float* s = scr + n; u32x4 o; \
          o.x = pg8::pk4_fp8((f32x4){CV_SV(0), CV_SV(1), CV_SV(2), CV_SV(3)} * 64.f); o.y = pg8::pk4_fp8((f32x4){CV_SV(4), CV_SV(5), CV_SV(6), CV_SV(7)} * 64.f); \
          o.z = pg8::pk4_fp8((f32x4){CV_SV(8), CV_SV(9), CV_SV(10), CV_SV(11)} * 64.f); o.w = pg8::pk4_fp8((f32x4){CV_SV(12), CV_SV(13), CV_SV(14), CV_SV(15)} * 64.f); \
          unsigned char* dst = (cv_is1 ? cj.W1T + (size_t)cv_e * 2048 * 1024 : cj.W2T + (size_t)cv_e * 1024 * 1024) + (size_t)(cv_n0 + n) * 1024 + cv_k0 + 16 * cc; *(u32x4*)dst = o; } \
        asm volatile("s_waitcnt lgkmcnt(0)" ::: "memory"); } } while (0)
__device__ __forceinline__ void attn_block(int bh, int qb, const bf16_t* __restrict__ Q, const bf16_t* __restrict__ K, const bf16_t* __restrict__ V, bf16_t* __restrict__ MIX, float* __restrict__ ASSQ, LAS unsigned char* lds, const int wid, const ConvJob& cj, int& tseq) {
    const int lane = lane_id(), r32 = lane & 31, hi = lane >> 5;
    const int b = bh / NH, h = bh % NH;
    const bf16_t* Qw = Q + ((size_t)bh * SEQ + qb * QB + wid * QBLK + r32) * DQK;
    const bf16_t* Kh = K + (size_t)bh * SEQ * DQK; const bf16_t* Vh = V + (size_t)bh * SEQ * DV;
    bf16x8 qr[12];
#pragma unroll
    for (int d0 = 0; d0 < 12; ++d0) qr[d0] = *(const bf16x8*)(Qw + d0 * 16 + hi * 8);
    const int NT = 4 * qb + 4, qlo = qb * QB + wid * QBLK, qm = qlo + r32 - 4 * hi;
    LAS unsigned char* V_lds = lds + L_V; LAS unsigned char* K_lds = lds + L_K;
    LAS float* wsf = (LAS float*)(lds + L_WS) + wid * 64; LAS float* li_l = wsf; LAS float* al_l = wsf + 32;
    unsigned ksrc[3], vsrc[2];
#pragma unroll
    for (int i = 0; i < 3; ++i) { const int off = ((wid + 8 * i) * 64 + lane) * 16, row = off / 384, wb = off % 384, seg = wb >> 7, cpos = (wb & 127) >> 4; ksrc[i] = (unsigned)(row * 384 + seg * 128 + ((cpos ^ (row & 7)) << 4)); }
#pragma unroll
    for (int i = 0; i < 2; ++i) { const int off = ((wid + 8 * i) * 64 + lane) * 16, st = off >> 9, o_ = off & 511, kk = (st >> 2) * 8 + (o_ >> 6), c = (st & 3) * 32 + ((o_ & 63) >> 1);
        const int k = (kk & ~0xC) | ((kk & 4) << 1) | ((kk & 8) >> 1); vsrc[i] = (unsigned)(k * 256 + c * 2); }
    const int vb0 = (int)(unsigned)(uintptr_t)V_lds + v_rd_base(lane);
#define ADMA_K(t, bf) do { const char* kp = (const char*)(Kh + (size_t)(t) * KVBLK * DQK); \
        _Pragma("unroll") for (int i = 0; i < 3; ++i) __builtin_amdgcn_global_load_lds((const unsigned*)(kp + ksrc[i]), (LAS unsigned*)(K_lds + (bf) * SHM_K + (wid + 8 * i) * 1024), 16, 0, 0); } while (0)
#define ADMA_V(t, bf) do { const char* vp = (const char*)(Vh + (size_t)(t) * KVBLK * DV); \
        _Pragma("unroll") for (int i = 0; i < 2; ++i) __builtin_amdgcn_global_load_lds((const unsigned*)(vp + vsrc[i]), (LAS unsigned*)(V_lds + (bf) * SHM_V + (wid + 8 * i) * 1024), 16, 0, 0); } while (0)
#define PK4(P, B_, OUT) do { unsigned a0 = cvtpk(P[B_ + 0], P[B_ + 1]), a1 = cvtpk(P[B_ + 2], P[B_ + 3]); \
        unsigned b0 = cvtpk(P[B_ + 4], P[B_ + 5]), b1 = cvtpk(P[B_ + 6], P[B_ + 7]); \
        auto r0 = __builtin_amdgcn_permlane32_swap(a0, b0, false, false); auto r1 = __builtin_amdgcn_permlane32_swap(a1, b1, false, false); \
        u32x4 w = {r0[0], r1[0], r0[1], r1[1]}; OUT = __builtin_bit_cast(bf16x8, w); } while (0)
    float m_reg = -1e30f, l_reg = 0.f; f32x16 o[4] = {}; int cv_pend = -1;
    const int ph = wid >> 2; bool st_steady = false, st_had = false;
#define STAGE_SLOT(t) do { const int tk = (t) + 2; const bool kv_full = tk < NT;     \
        if (tk < NT) ADMA_K(tk, tk & 1); \
        const bool had_pend = cv_pend >= 0; \
        if (had_pend) { if (kv_full) asm volatile("s_waitcnt vmcnt(3)" ::: "memory"); else asm volatile("s_waitcnt vmcnt(0)" ::: "memory");     \
            CV_DECODE(cv_pend) CV_STORE(); cv_pend = -1; } \
        st_had = had_pend; SBAR(); } while (0)
#define STAGE_V(t) do { SBAR(); if ((t) + 1 < NT) ADMA_V((t) + 1, ((t) + 1) & 1); SBAR(); } while (0)
#define STAGE_TAIL(t) do { SBAR(); if ((t) + 1 < NT) { const int cv_idx = __builtin_amdgcn_readfirstlane(tseq * cj.ngw + cj.gw); ++tseq; CV_DECODE(cv_idx) CV_LOAD(); cv_pend = cv_on ? cv_idx : -1; } \
        st_steady = st_had && cv_pend >= 0;                                    \
        SBAR(); } while (0)
#define PV_PART(t) do { if ((t) * KVBLK <= qlo + QBLK - 1) { SBAR(); pv_tile(o, vb0 + ((t) & 1) * SHM_V, pa0, pa1, pa2, pa3); SBAR(); } } while (0)
#define QK_PART(t) do { if ((t) < NT && (t) * KVBLK <= qlo + QBLK - 1) { SBAR(); qkt(p0, p1, K_lds + ((t) & 1) * SHM_K, r32, hi, qr); SBAR(); } } while (0)
#define VALU_SLOT(t) VALU_SLOT_H(t, (void)0)
#define VALU_SLOT_H(t, HOOK) do { const int kb_ = (t) * KVBLK; \
        if (!(kb_ <= qlo + QBLK - 1)) { HOOK; } \
        if (kb_ <= qlo + QBLK - 1) { \
            if (kb_ + KVBLK - 1 > qlo) { asm volatile("" ::: "memory"); const int dq = qm - kb_; const float NEG = -__builtin_inff(); \
                _Pragma("unroll") for (int r = 0; r < 16; ++r) { const int c = (r & 3) + 8 * (r >> 2); if (c > dq) p0[r] = NEG; if (c + 32 > dq) p1[r] = NEG; } } \
            float pmax = p0[0]; _Pragma("unroll") for (int r = 1; r < 16; ++r) pmax = fmaxf(pmax, p0[r]); _Pragma("unroll") for (int r = 0; r < 16; ++r) pmax = fmaxf(pmax, p1[r]); \
            { auto rr = __builtin_amdgcn_permlane32_swap(__float_as_uint(pmax), __float_as_uint(pmax), false, false); pmax = fmaxf(__uint_as_float(rr[0]), __uint_as_float(rr[1])); } \
            if (!__all(pmax - m_reg <= THR)) { const float mn = fmaxf(m_reg, pmax); const float alpha = __builtin_amdgcn_exp2f(m_reg - mn); m_reg = mn; l_reg *= alpha; \
                if (hi == 0) al_l[r32] = alpha; asm volatile("s_waitcnt lgkmcnt(0)" ::: "memory"); \
                _Pragma("unroll") for (int d_ = 0; d_ < 4; ++d_) _Pragma("unroll") for (int r = 0; r < 16; ++r) o[d_][r] *= al_l[crow(r, hi)]; } \
            float ps = 0.f; HOOK; \
            _Pragma("unroll") for (int r = 0; r < 16; ++r) { p0[r] = __builtin_amdgcn_exp2f(p0[r] - m_reg); p1[r] = __builtin_amdgcn_exp2f(p1[r] - m_reg); } \
            _Pragma("unroll") for (int r = 0; r < 16; ++r) ps += p0[r] + p1[r]; \
            { auto rr = __builtin_amdgcn_permlane32_swap(__float_as_uint(ps), __float_as_uint(ps), false, false); ps = __uint_as_float(rr[0]) + __uint_as_float(rr[1]); } \
            l_reg += ps; \
            PK4(p0, 0, pa0); PK4(p0, 8, pa1); PK4(p1, 0, pa2); PK4(p1, 8, pa3); } } while (0)
#define SLOT_END_EVEN() do { if (st_steady) asm volatile("s_waitcnt vmcnt(4)\n\ts_barrier" ::: "memory");     \
        else asm volatile("s_waitcnt vmcnt(0)\n\ts_barrier" ::: "memory"); } while (0)
#define SLOT_END_ODD() asm volatile("s_barrier" ::: "memory")
    ADMA_K(0, 0);
    asm volatile("s_waitcnt vmcnt(0)" ::: "memory"); __syncthreads();
    if (ph == 0) {
        f32x16 p0, p1;
        STAGE_SLOT(-1); STAGE_V(-1); QK_PART(0); STAGE_TAIL(-1); SLOT_END_ODD();
        for (int t = 0; t < NT; ++t) { bf16x8 pa0 = {}, pa1 = {}, pa2 = {}, pa3 = {};
            VALU_SLOT(t); SLOT_END_EVEN();
            STAGE_SLOT(t); PV_PART(t); STAGE_V(t); QK_PART(t + 1); STAGE_TAIL(t); SLOT_END_ODD(); }
    } else {
        bf16x8 pa0 = {}, pa1 = {}, pa2 = {}, pa3 = {};
        STAGE_SLOT(-1); STAGE_V(-1); STAGE_TAIL(-1); SLOT_END_ODD();
        for (int t = 0; t < NT; ++t) { f32x16 p0 = {}, p1 = {};
            if (t > 0) PV_PART(t - 1);
            QK_PART(t); SLOT_END_EVEN();
            STAGE_SLOT(t); VALU_SLOT(t); STAGE_V(t); STAGE_TAIL(t); SLOT_END_ODD(); }
        PV_PART(NT - 1);
    }
#undef STAGE_SLOT
#undef STAGE_V
#undef VALU_SLOT_H
#undef STAGE_TAIL
#undef PV_PART
#undef QK_PART
#undef VALU_SLOT
#undef SLOT_END_EVEN
#undef SLOT_END_ODD
#undef PK4
#undef ADMA_K
#undef ADMA_V
    if (cv_pend >= 0) { asm volatile("s_waitcnt vmcnt(0)" ::: "memory"); CV_DECODE(cv_pend) CV_STORE(); }
    if (hi == 0) li_l[r32] = l_reg;
    asm volatile("s_waitcnt vmcnt(0) lgkmcnt(0)" ::: "memory");
    float rli[16];
#pragma unroll
    for (int r = 0; r < 16; ++r) rli[r] = __builtin_amdgcn_rcpf(li_l[crow(r, hi)]);
    __syncthreads();
    LAS bf16_t* stg = (LAS bf16_t*)(lds + wid * 8192);
#pragma unroll
    for (int r = 0; r < 16; ++r) { const int orow = crow(r, hi);
#pragma unroll
        for (int d0 = 0; d0 < 4; ++d0) stg[orow * 128 + d0 * 32 + r32] = f2bf(o[d0][r] * rli[r]); }
    asm volatile("s_waitcnt lgkmcnt(0)" ::: "memory");
    const size_t row0 = (size_t)b * SEQ + qb * QB + wid * QBLK;
#pragma unroll
    for (int i = 0; i < 8; ++i) { const int row = i * 4 + (lane >> 4), ch = lane & 15; const u32x4 v = *(const LAS u32x4*)(stg + row * 128 + ch * 8);
        float ss = (blo(v.x) * blo(v.x) + bhi(v.x) * bhi(v.x)) + (blo(v.y) * blo(v.y) + bhi(v.y) * bhi(v.y)) + (blo(v.z) * blo(v.z) + bhi(v.z) * bhi(v.z)) + (blo(v.w) * blo(v.w) + bhi(v.w) * bhi(v.w));
        ss += __shfl_xor(ss, 1); ss += __shfl_xor(ss, 2); ss += __shfl_xor(ss, 4); ss += __shfl_xor(ss, 8);
        *(u32x4*)(MIX + (row0 + row) * DM + h * DV + ch * 8) = v;
        if (ch == 0) ASSQ[(row0 + row) * 4 + h] = ss; }
    __syncthreads();
}
#undef KSWZ
#undef SBAR
}

struct Args { const void* in[25]; float* out; unsigned char* ws; int ph_lo, ph_hi, li, skip; };
enum { PH_PREP = 0, PH_INPROJ, PH_TOKLOCAL, PH_ATTN, PH_WO, PH_ROUTER, PH_ROUTE, PH_MOE1, PH_MOE2, PH_COMBINE, PH_PLE, PH_FINAL, PH_COUNT };

template <int MODE> __device__ __forceinline__ int cmap_col(int n) {
    if (MODE == 1) { const int pn = n >> 8, half = (n >> 7) & 1, jj = n & 127; return half * 1024 + pn * 128 + jj; }
    if (MODE == 4) { if (n < 1024) return n < 960 ? n : INW; const int v = n - 1024, j = v >> 8, hf = (v >> 7) & 1, cc = v & 127; return (hf ? 1472 : 960) + 128 * j + cc; }
    if (MODE == 5) { const int t = n & ~255, v = n & 255; return t + 64 * ((v >> 5) & 3) + 16 * ((v >> 3) & 3) + 8 * (v >> 7) + (v & 7); }
    if (MODE == 2) { const int h = n / DQK, d = n % DQK; if (d < DN) return n; const int t = d - DN; return h * DQK + DN + (t & 1) * 32 + (t >> 1); }
    return n;
}
template <int MODE> __device__ __forceinline__ void transpose_item_fp8(const float* __restrict__ W, int ldsrc, int nblk, unsigned char* __restrict__ WT, int ldd, const float* __restrict__ gain, float scale,
                                                                      LAS float* scr, int item, int lane) {
    const int kb = item / nblk, nb = item % nblk, k0 = 64 * kb, n0 = 32 * nb; const int c = cmap_col<MODE>(n0 + (lane & 31));
    float wv[32];
#pragma unroll
    for (int i = 0; i < 32; ++i) wv[i] = W[(size_t)(k0 + 2 * i + (lane >> 5)) * ldsrc + c];
#pragma unroll
    for (int i = 0; i < 32; ++i) { const int kk = 2 * i + (lane >> 5), k = k0 + kk; float gk = scale; if (gain) gk *= gain[k]; scr[kk * 33 + (lane & 31)] = wv[i] * gk; }
    asm volatile("s_waitcnt lgkmcnt(0)" ::: "memory");
    const int cc = lane & 3;
#pragma unroll
    for (int j = 0; j < 2; ++j) { const int n = (lane >> 2) + 16 * j; const LAS float* s = scr + (16 * cc) * 33 + n; u32x4 o;
        o.x = pg8::pk4_fp8((f32x4){s[0 * 33], s[1 * 33], s[2 * 33], s[3 * 33]}); o.y = pg8::pk4_fp8((f32x4){s[4 * 33], s[5 * 33], s[6 * 33], s[7 * 33]});
        o.z = pg8::pk4_fp8((f32x4){s[8 * 33], s[9 * 33], s[10 * 33], s[11 * 33]}); o.w = pg8::pk4_fp8((f32x4){s[12 * 33], s[13 * 33], s[14 * 33], s[15 * 33]});
        *(u32x4*)(WT + (size_t)(n0 + n) * ldd + k0 + 16 * cc) = o; }
    asm volatile("s_waitcnt lgkmcnt(0)" ::: "memory");
}
template <int MODE> __device__ __forceinline__ void transpose_item(const float* __restrict__ W, int ldsrc, int nblk, bf16_t* __restrict__ WT, int ldd, const float* __restrict__ gain, const float* __restrict__ gain2, float scale,
                                                                  LAS float* scr, int item, int lane) {
    const int kb = item / nblk, nb = item % nblk, k0 = 64 * kb, n0 = 32 * nb; const int c = cmap_col<MODE>(n0 + (lane & 31));
    float wv[32], gq[32];
#pragma unroll
    for (int i = 0; i < 32; ++i) wv[i] = W[(size_t)(k0 + 2 * i + (lane >> 5)) * ldsrc + c];
#pragma unroll
    for (int i = 0; i < 32; ++i) { const int k = k0 + 2 * i + (lane >> 5); gq[i] = gain ? ((gain2 && k >= 512) ? gain2[k - 512] : gain[k]) : 1.f; }
    asm volatile("" ::: "memory");
#pragma unroll
    for (int i = 0; i < 32; ++i) { const int kk = 2 * i + (lane >> 5); scr[kk * 33 + (lane & 31)] = wv[i] * (gq[i] * scale); }
    asm volatile("s_waitcnt lgkmcnt(0)" ::: "memory");
    const int cc = lane & 7;
#pragma unroll
    for (int j = 0; j < 4; ++j) { const int n = (lane >> 3) + 8 * j; const LAS float* s = scr + (8 * cc) * 33 + n;
        u32x4 o; o.x = pk2(s[0 * 33], s[1 * 33]); o.y = pk2(s[2 * 33], s[3 * 33]); o.z = pk2(s[4 * 33], s[5 * 33]); o.w = pk2(s[6 * 33], s[7 * 33]);
        *(u32x4*)(WT + (size_t)(n0 + n) * ldd + k0 + 8 * cc) = o; }
    asm volatile("s_waitcnt lgkmcnt(0)" ::: "memory");
}

__global__ void __launch_bounds__(NTHREADS, 2) fwd(Args args) {
    extern __shared__ __attribute__((aligned(16))) unsigned char lds_raw[];
    LAS unsigned char* lds = (LAS unsigned char*)lds_raw;
    volatile LAS unsigned* MISC = (volatile LAS unsigned*)(lds + MISC_OFF);
    const int wave = __builtin_amdgcn_readfirstlane(threadIdx.x >> 6);
    const int G = gridDim.x, bx = blockIdx.x;
#define PHASE_LANE const int lane = lane_id(); const int tid = wave * 64 + lane; (void)tid
    const int gw = bx * NWAVES + wave, NGW = G * NWAVES;
    unsigned char* ws = args.ws; int* ctl = (int*)(ws + WS_CTL); float* H = args.out;
    const float* x = (const float*)args.in[0]; const float* p = (const float*)args.in[1]; const int* pos = (const int*)args.in[2];
    const float *mix_norm = (const float*)args.in[3], *w_in = (const float*)args.in[4], *q_norm = (const float*)args.in[5], *w_uq = (const float*)args.in[6], *kv_norm = (const float*)args.in[7],
                *w_ukv = (const float*)args.in[8], *attn_out_norm = (const float*)args.in[10], *conv_out_norm = (const float*)args.in[11], *w_o = (const float*)args.in[12],
                *moe_norm = (const float*)args.in[13], *w_router = (const float*)args.in[14], *w1 = (const float*)args.in[16], *b1 = (const float*)args.in[17],
                *w2 = (const float*)args.in[18], *b2 = (const float*)args.in[19], *ple_norm = (const float*)args.in[20], *w_ple_gate = (const float*)args.in[21], *w_ple_proj = (const float*)args.in[22],
                *ple_post_norm = (const float*)args.in[23], *conv_w = (const float*)args.in[9], *b_router = (const float*)args.in[15], *final_norm = (const float*)args.in[24];
    int* TOPI = (int*)(ws + WS_TOPI); float* TOPG = (float*)(ws + WS_TOPG);
    bf16_t *HBF = (bf16_t*)(ws + WS_HBF), *H3 = (bf16_t*)(ws + WS_H3), *WRHL = (bf16_t*)(ws + WS_WRHL); unsigned char* X8 = (unsigned char*)(ws + WS_K);
    float* RSX = (float*)(ws + WS_RSX);
    float *SSQ1 = (float*)(ws + WS_SSQ1), *RS1 = (float*)(ws + WS_RS1), *RS2 = (float*)(ws + WS_RS2), *ROWRS = (float*)(ws + WS_ROWRS);
    bf16_t *WIN = (bf16_t*)(ws + WS_WIN), *WUQ = (bf16_t*)(ws + WS_WUQ), *WUKV = (bf16_t*)(ws + WS_WUKV), *WO = (bf16_t*)(ws + WS_WO), *WG = (bf16_t*)(ws + WS_WG), *WP = (bf16_t*)(ws + WS_WP);
    bf16_t *W1T = (bf16_t*)(ws + WS_W1), *W2T = (bf16_t*)(ws + WS_W2), *XN = (bf16_t*)(ws + WS_XN), *MIX = (bf16_t*)(ws + WS_MIX), *PLER = (bf16_t*)(ws + WS_PLER);
    bf16_t *Z = (bf16_t*)(ws + WS_Z), *Qb = (bf16_t*)(ws + WS_Q), *Kb = (bf16_t*)(ws + WS_K), *Vb = (bf16_t*)(ws + WS_V), *HB = (bf16_t*)(ws + WS_HB), *Y = (bf16_t*)(ws + WS_Y), *P16 = (bf16_t*)(ws + WS_P16);
    float *WR = (float*)(ws + WS_WR), *CS = (float*)(ws + WS_CS), *SSQ = (float*)(ws + WS_SSQ), *ASSQ = (float*)(ws + WS_ASSQ), *PSSQ = (float*)(ws + WS_PSSQ), *FSSQ = (float*)(ws + WS_FSSQ);
    int *ROWTOK = (int*)(ws + WS_ROWTOK), *ROWSLOT = (int*)(ws + WS_ROWSLOT); float* ROWGATE = (float*)(ws + WS_ROWGATE);

    { PHASE_LANE; for (int u = tid; u < (LDS_BYTES - MISC_OFF) / 4; u += NTHREADS) ((LAS unsigned*)(lds + MISC_OFF))[u] = 0u; }
    __syncthreads();
    const int lo = args.ph_lo, hi = args.ph_hi;
    XcdBarrier bar; bar.bar = (unsigned*)ctl + CW_BAR + args.li * XCD_BAR_WORDS; bar.x = 0; bar.st = MISC + 8;
    if (hi - lo > 1) bar = xcd_barrier_post((unsigned*)ctl + CW_BAR + args.li * XCD_BAR_WORDS, MISC + 8, wave);
#define IN(k) (lo <= (k) && (k) < hi)
#define NREP(k) ((PROBE_PH == (k)) ? PROBE_REP : 1)
#define REPLOOP(k) for (int rep = 0; rep < NREP(k); ++rep)
#define LASTREP(k) (rep == NREP(k) - 1)
#ifdef PROBE_TIME_PH
#define STAMP(k) do { if (bx == 0 && wave == 0) MISC[32 + (k)] = (unsigned)__builtin_amdgcn_s_memrealtime(); } while (0)
#else
#define STAMP(k) do { } while (0)
#endif
#ifdef PROBE_EPI
#define SEAM(k) do { if ((k) == PROBE_EPI && bx == 0 && threadIdx.x == 0) MISC[63] = MISC[62]; if (IN(k) && IN((k) + 1)) xcd_barrier(bar, wave); STAMP((k) + 1); if ((k) + 1 == PROBE_EPI && bx == 0 && threadIdx.x == 0) MISC[62] = 0; } while (0)
#else
#define SEAM(k) do { if (IN(k) && IN((k) + 1)) xcd_barrier(bar, wave); STAMP((k) + 1); } while (0)
#endif
    STAMP(0);

    if (IN(PH_PREP)) REPLOOP(PH_PREP) {
        PHASE_LANE;
        LAS float* scr = (LAS float*)(lds + wave * 16384);
        constexpr int I_IN = (DM / 64) * 64, I_UQ = (QL / 64) * (768 / 32), I_UKV = (KVL / 64) * (1024 / 32), I_O = (DM / 64) * (DM / 32), I_G = I_O, I_P = (PLE / 64) * (DM / 32);
        constexpr int I_1 = (DM / 64) * (2048 / 32), I_2 = (DE / 64) * (DM / 32);
        constexpr int NITEMS = I_IN + I_UQ + I_UKV + I_O + I_G + I_P;
        for (int it = gw; it < NITEMS; it += NGW) {
            int r = it;
            if (r < I_IN) { if ((r & 63) != 30 && (r & 63) != 31) transpose_item<4>(w_in, INW, 64, WIN, DM, mix_norm, nullptr, 1.f, scr, r, lane); continue; } r -= I_IN;
            if (r < I_UQ) { transpose_item<2>(w_uq, 768, 768 / 32, WUQ, QL, q_norm, nullptr, QSCALE, scr, r, lane); continue; } r -= I_UQ;
            if (r < I_UKV) { transpose_item<0>(w_ukv, 1024, 1024 / 32, WUKV, 256, kv_norm, nullptr, 1.f, scr, r, lane); continue; } r -= I_UKV;
            if (r < I_O) { transpose_item<0>(w_o, DM, DM / 32, WO, DM, attn_out_norm, conv_out_norm, 1.f, scr, r, lane); continue; } r -= I_O;
            if (r < I_G) { transpose_item<0>(w_ple_gate, DM, DM / 32, WG, DM, ple_norm, nullptr, 1.f, scr, r, lane); continue; } r -= I_G;
            transpose_item<5>(w_ple_proj, DM, DM / 32, WP, PLE, nullptr, nullptr, 1.f, scr, r, lane);
        }
        for (int i = bx * NTHREADS + tid; i < 1024 * 16; i += G * NTHREADS) *(u32x4*)(WUKV + (size_t)(i >> 4) * 256 + 128 + (i & 15) * 8) = (u32x4){0u, 0u, 0u, 0u};
        for (int i = bx * NTHREADS + tid; i < DM * NE; i += G * NTHREADS) { const int e = i >> 10, k = i & 1023; const float w = w_router[k * NE + e] * moe_norm[k]; const bf16_t whi = f2bf(w);
            WRHL[i] = whi; WRHL[DM * NE + i] = f2bf(w - bf2f(whi)); }
        for (int i = bx * NTHREADS + tid; i < NTOK * 32; i += G * NTHREADS) { const int t = i >> 5, j = i & 31; const float inv = powf(10000.f, -(float)j / 32.f); const float a = (float)pos[t] * inv; float sn, c; sincosf(a, &sn, &c);
            CS[(size_t)t * 64 + j] = c; CS[(size_t)t * 64 + 32 + j] = sn; }
        for (int i = bx * NTHREADS + tid; i < NTOK * PLE / 4; i += 4 * G * NTHREADS) { f32x4 v[4];
#pragma unroll
            for (int q = 0; q < 4; ++q) { const int ii = i + q * G * NTHREADS; v[q] = ii < NTOK * PLE / 4 ? ((const f32x4*)p)[ii] : (f32x4){0.f, 0.f, 0.f, 0.f}; }
#pragma unroll
            for (int q = 0; q < 4; ++q) { const int ii = i + q * G * NTHREADS; if (ii < NTOK * PLE / 4) ((u32x2*)P16)[ii] = (u32x2){pk2(v[q][0], v[q][1]), pk2(v[q][2], v[q][3])}; } }
        for (int row = gw * 4; row < NTOK; row += NGW * 4) {
            f32x4 v[4][4]; float ss[4];
#pragma unroll
            for (int q = 0; q < 4; ++q) { const f32x4* s = (const f32x4*)(x + (size_t)(row + q) * DM);
#pragma unroll
                for (int j = 0; j < 4; ++j) v[q][j] = s[lane + 64 * j]; }
#pragma unroll
            for (int q = 0; q < 4; ++q) { ss[q] = 0.f;
#pragma unroll
                for (int j = 0; j < 4; ++j) ss[q] += pg8::sq4(v[q][j]); }
#pragma unroll
            for (int q = 0; q < 4; ++q) { const float rstd = rsqrtf(wave_sum(ss[q]) * (1.f / DM) + EPS); u32x2* d = (u32x2*)(XN + (size_t)(row + q) * DM); if (lane == 0) RSX[row + q] = rstd;
#pragma unroll
                for (int j = 0; j < 4; ++j) d[lane + 64 * j] = (u32x2){pk2(v[q][j][0], v[q][j][1]), pk2(v[q][j][2], v[q][j][3])}; }
        }
    }
    SEAM(PH_PREP);
    if (IN(PH_INPROJ)) REPLOOP(PH_INPROJ) {
        { pg8::Gemm g{XN, WIN, DM, DM, DM, nullptr, 0}; pg8::StaticOrder S; S.init(NTOK / 256, 8, G, bx, nullptr);
          pg8::EpiBf16Stats<0> E{Z, INWP, SSQ, RSX}; pg8::gemm_phase<pg8::EpiBf16Stats<0>, false>(lds, g, S, E, wave); }
        { pg8::Gemm g{P16, WP, PLE, PLE, PLE, nullptr, 0}; pg8::StaticOrder S; S.init(NTOK / 256, DM / 256, G, bx, nullptr);
          pg8::EpiBf16Stats<1> E{PLER, DM, PSSQ, nullptr}; pg8::gemm_phase<pg8::EpiBf16Stats<1>, false>(lds, g, S, E, wave); }
    }
    SEAM(PH_INPROJ);
    if (IN(PH_TOKLOCAL)) REPLOOP(PH_TOKLOCAL) {
        PHASE_LANE;
        if (!(args.skip & 1)) for (int r0 = gw * 16; r0 < NTOK; r0 += NGW * 16) {
            const int c8 = lane * 8; f32x4 w0[2], w1[2], w2[2];
#pragma unroll
            for (int q = 0; q < 2; ++q) { w0[q] = *(const f32x4*)(conv_w + c8 + 4 * q); w1[q] = *(const f32x4*)(conv_w + 512 + c8 + 4 * q); w2[q] = *(const f32x4*)(conv_w + 1024 + c8 + 4 * q); }
            f32x4 u1[2] = {}, u2[2] = {};
            if ((r0 % SEQ) != 0) {
#pragma unroll
                for (int p = 1; p <= 2; ++p) { const u32x4 uu = *(const u32x4*)(Z + (size_t)(r0 - p) * INWP + 960 + c8);
                    const f32x4 a = {blo(uu.x), bhi(uu.x), blo(uu.y), bhi(uu.y)}, b = {blo(uu.z), bhi(uu.z), blo(uu.w), bhi(uu.w)};
                    if (p == 1) { u1[0] = a; u1[1] = b; } else { u2[0] = a; u2[1] = b; } } }
#pragma unroll 4
            for (int rr = 0; rr < 16; ++rr) { const int row = r0 + rr; const bf16_t* z = Z + (size_t)row * INWP; const int s = row % SEQ, b = row / SEQ;
                const u32x4 bg = *(const u32x4*)(z + 448 + c8), uu = *(const u32x4*)(z + 960 + c8);
                if (lane < 32) { const float x1 = bf2f(z[384 + lane]), x2 = bf2f(z[416 + lane]); const float c = CS[(size_t)row * 64 + lane], sn = CS[(size_t)row * 64 + 32 + lane];
                    const unsigned o = pk2(x1 * c - x2 * sn, x1 * sn + x2 * c);
#pragma unroll
                    for (int h = 0; h < NH; ++h) *(unsigned*)(Kb + ((size_t)(b * NH + h) * SEQ + s) * DQK + DN + 2 * lane) = o; }
                f32x4 u0[2]; u0[0] = (f32x4){blo(uu.x), bhi(uu.x), blo(uu.y), bhi(uu.y)}; u0[1] = (f32x4){blo(uu.z), bhi(uu.z), blo(uu.w), bhi(uu.w)};
                f32x4 y[2]; y[0] = (f32x4){blo(bg.x), bhi(bg.x), blo(bg.y), bhi(bg.y)} * (w0[0] * u2[0] + w1[0] * u1[0] + w2[0] * u0[0]); y[1] = (f32x4){blo(bg.z), bhi(bg.z), blo(bg.w), bhi(bg.w)} * (w0[1] * u2[1] + w1[1] * u1[1] + w2[1] * u0[1]);
                const float rstd = rsqrtf(wave_sum(pg8::sq4(y[0]) + pg8::sq4(y[1])) * (1.f / 512.f) + EPS);
                *(u32x4*)(MIX + (size_t)row * DM + 512 + c8) = pg8::pack8(y[0] * rstd, y[1] * rstd);
                u2[0] = u1[0]; u2[1] = u1[1]; u1[0] = u0[0]; u1[1] = u0[1]; }
        }
        { pg8::Gemm g{Z, WUQ, QL, INWP, QL, nullptr, 0}; pg8::StaticOrder S; S.init(NTOK / 256, 768 / 256, G, bx, nullptr);
          pg8::EpiQ E{Qb, SSQ, CS}; pg8::gemm_phase<pg8::EpiQ, false>(lds, g, S, E, wave); }
        { pg8::Gemm g{Z + 256, WUKV, 256, INWP, 256, nullptr, 0}; pg8::StaticOrder S; S.init(NTOK / 256, 1024 / 256, G, bx, nullptr);
          pg8::EpiKV E{Kb, Vb, SSQ}; pg8::gemm_phase<pg8::EpiKV, false>(lds, g, S, E, wave); }
    }
    SEAM(PH_TOKLOCAL);
    if (IN(PH_ATTN)) REPLOOP(PH_ATTN) {
        const int vcu = (G % 8 == 0) ? (bx % 8) * (G / 8) + bx / 8 : bx;
        using att::L_END; using att::cv_cmap1; using att::cv_cmap2; using att::CV_N1; using att::CV_TOTAL;
        const att::ConvJob cj{w1, w2, moe_norm, (unsigned char*)W1T, (unsigned char*)W2T, gw, NGW}; int tseq = LASTREP(PH_ATTN) ? 0 : (1 << 20);
        for (int it = vcu; it < NB * NH * 8; it += G) { const int bh = it >> 3, pr = it & 7;
            for (int pass = 0; pass < 2; ++pass) att::attn_block(bh, pass ? pr : 15 - pr, Qb, Kb, Vb, MIX, ASSQ, lds, wave, cj, tseq); }
        if (LASTREP(PH_ATTN)) { const int lane = lane_id(), hi = lane >> 5, wid = wave; __syncthreads();
            for (int cv_idx = tseq * NGW + gw; cv_idx < att::CV_TOTAL; cv_idx += NGW) { CV_DECODE(cv_idx) CV_LOAD(); asm volatile("s_waitcnt vmcnt(0)" ::: "memory"); CV_STORE(); } }
    }
    SEAM(PH_ATTN);
    if (IN(PH_WO)) REPLOOP(PH_WO) {
        pg8::Gemm g{MIX, WO, DM, DM, DM, nullptr, 0}; pg8::StaticOrder S; S.init(NTOK / 256, DM / 256, G, bx, nullptr);
        pg8::EpiWo E{XN, HBF, X8, ASSQ, SSQ1, moe_norm}; pg8::gemm_phase<pg8::EpiWo, false>(lds, g, S, E, wave, LASTREP(PH_WO));
    }
    SEAM(PH_WO);
    if (IN(PH_ROUTER)) REPLOOP(PH_ROUTER) {
        PHASE_LANE;
        typedef float f32x16 __attribute__((ext_vector_type(16)));
        const bool fusedR = (G == 256);
        LAS int* hist = (LAS int*)(lds + HIST_OFF); LAS f32x16* xch = (LAS f32x16*)(lds + HIST_OFF + 256);
        for (int i = tid; i < 2 * NE * 128; i += NTHREADS) { const int pe = i >> 7, kc = i & 127, e = pe & 31; *(LAS u32x4*)(lds + pe * 2048 + ((kc ^ (e & 15)) << 4)) = ((const u32x4*)WRHL)[i]; }
        if (tid < NE) hist[tid] = 0;
        __syncthreads();
        for (int chunk = bx; chunk < NTOK / 128; chunk += G) {
            const int base = chunk * 128, wq = wave & 3, kh = wave >> 2;
            const int j = lane & 31, half = lane >> 5, tok = base + wq * 32 + j;
            const bf16_t* xr = HBF + (size_t)tok * DM + kh * 512 + 8 * half; const LAS unsigned char* wrow = lds + j * 2048;
            f32x16 acc = {};
#pragma unroll 8
            for (int s = 0; s < 32; ++s) { const bf16x8 xb = *(const bf16x8*)(xr + 16 * s); const int kc = ((kh * 64 + 2 * s + half) ^ (j & 15)) << 4;
                const bf16x8 ah = *(const LAS bf16x8*)(wrow + kc), al = *(const LAS bf16x8*)(wrow + 65536 + kc);
                acc = __builtin_amdgcn_mfma_f32_32x32x16_bf16(ah, xb, acc, 0, 0, 0); acc = __builtin_amdgcn_mfma_f32_32x32x16_bf16(al, xb, acc, 0, 0, 0); }
            if (kh == 1) xch[wq * 64 + lane] = acc;
            __syncthreads();
            if (kh == 0) {
                const f32x16 other = xch[wq * 64 + lane];
                const f32x4 s0 = *(const f32x4*)(SSQ1 + (size_t)tok * 16 + 8 * half), s1 = *(const f32x4*)(SSQ1 + (size_t)tok * 16 + 8 * half + 4);
                float ss = ((s0[0] + s0[1]) + (s0[2] + s0[3])) + ((s1[0] + s1[1]) + (s1[2] + s1[3])); ss += __shfl_xor(ss, 32); const float rstd = rsqrtf(ss * (1.f / DM) + EPS);
                float v[16];
#pragma unroll
                for (int r = 0; r < 16; ++r) v[r] = (acc[r] + other[r]) * rstd + b_router[(r & 3) + 8 * (r >> 2) + 4 * half];
                float lv[4]; int li[4];
#pragma unroll
                for (int t = 0; t < 4; ++t) { float best = -__builtin_inff(); int bi = 0;
#pragma unroll
                    for (int r = 0; r < 16; ++r) if (v[r] > best) { best = v[r]; bi = (r & 3) + 8 * (r >> 2) + 4 * half; }
                    const auto rv = __builtin_amdgcn_permlane32_swap(__float_as_uint(best), __float_as_uint(best), false, false); const auto ri = __builtin_amdgcn_permlane32_swap((unsigned)bi, (unsigned)bi, false, false);
                    const float b0 = __uint_as_float(rv[0]), b1 = __uint_as_float(rv[1]); const int i0 = (int)ri[0], i1 = (int)ri[1];
                    const bool t0 = (b0 > b1) || (b0 == b1 && i0 < i1); const float gb = t0 ? b0 : b1; const int gi = t0 ? i0 : i1; lv[t] = gb; li[t] = gi;
#pragma unroll
                    for (int r = 0; r < 16; ++r) if ((r & 3) + 8 * (r >> 2) + 4 * half == gi) v[r] = -__builtin_inff(); }
                if (half == 0) { const float e1 = __expf(lv[1] - lv[0]), e2 = __expf(lv[2] - lv[0]), e3 = __expf(lv[3] - lv[0]); const float inv = 1.f / (1.f + e1 + e2 + e3);
                    if (fusedR) { const int tl = wq * 32 + j; *(LAS u32x4*)(lds + LT_OFF + tl * 16) = (u32x4){(unsigned)li[0], (unsigned)li[1], (unsigned)li[2], (unsigned)li[3]}; *(LAS f32x4*)(lds + LT_OFF + 2048 + tl * 16) = (f32x4){inv, e1 * inv, e2 * inv, e3 * inv}; *(LAS float*)(lds + LT_OFF + 4096 + tl * 4) = rstd; }
                    else { *(int4*)(TOPI + (size_t)tok * 4) = make_int4(li[0], li[1], li[2], li[3]); *(f32x4*)(TOPG + (size_t)tok * 4) = (f32x4){inv, e1 * inv, e2 * inv, e3 * inv}; RS1[tok] = rstd; }
#pragma unroll
                    for (int t = 0; t < 4; ++t) (void)__hip_atomic_fetch_add(hist + li[t], 1, __ATOMIC_RELAXED, __HIP_MEMORY_SCOPE_WORKGROUP); }
            }
            __syncthreads();
        }
        if (!fusedR) { if (tid < NE && LASTREP(PH_ROUTER)) atomicAdd(ctl + CW_CNT + tid, hist[tid]); __syncthreads(); }
        else {
            LAS int* S = (LAS int*)lds; LAS int* T = (LAS int*)(lds + 32768);
            LAS int* shf = (LAS int*)(lds + LT_OFF + 4608); LAS int* sh2 = shf + 64;
            int* BH = (int*)(ws + WS_FSSQ + 1 * MiB); int* BB = BH + 256 * NE;
            if (tid < NE) __hip_atomic_store(BH + bx * NE + tid, hist[tid], __ATOMIC_RELAXED, __HIP_MEMORY_SCOPE_AGENT);
            asm volatile("s_waitcnt vmcnt(0)" ::: "memory");
            __syncthreads();
            if (tid == 0) shf[0] = (__hip_atomic_fetch_add(ctl + CW_TICKET, 1, __ATOMIC_RELAXED, __HIP_MEMORY_SCOPE_AGENT) == G - 1) ? 1 : 0;
            __syncthreads();
            if (shf[0]) {
                if (wave == 0) __builtin_amdgcn_fence(__ATOMIC_ACQUIRE, "agent");
                __syncthreads();
                { u32x4 hv4[4];
#pragma unroll
                  for (int q = 0; q < 4; ++q) hv4[q] = *(const u32x4*)(BH + (tid + q * NTHREADS) * 4);
#pragma unroll
                  for (int q = 0; q < 4; ++q) *(LAS u32x4*)(S + (tid + q * NTHREADS) * 4) = hv4[q]; }
                __syncthreads();
                if (lane < NE) { int run = 0; for (int b = wave * 32; b < wave * 32 + 32; ++b) { const int v = S[b * NE + lane]; S[b * NE + lane] = run; run += v; } T[wave * NE + lane] = run; }
                __syncthreads();
                if (tid < NE) { int run = 0; for (int w = 0; w < 8; ++w) { const int v = T[w * NE + tid]; T[w * NE + tid] = run; run += v; } T[256 + tid] = run; }
                __syncthreads();
#pragma unroll
                for (int q = 0; q < 4; ++q) { const int i = (tid + q * NTHREADS) * 4; u32x4 v = *(const LAS u32x4*)(S + i); const u32x4 tb = *(const LAS u32x4*)(T + (i >> 10) * NE + (i & 31));
                    v += tb; asm volatile("global_store_dwordx4 %0, %1, off sc0 sc1" :: "v"(BB + i), "v"(v) : "memory"); }
                if (wave == 0) { const int c = lane < NE ? T[256 + (lane & 31)] : 0, t = (c + 255) >> 8; int incl = t;
#pragma unroll
                    for (int d = 1; d < 64; d <<= 1) { const int o = __shfl_up(incl, d); if (lane >= d) incl += o; }
                    const int excl = incl - t;
                    if (lane < NE) { __hip_atomic_store(ctl + CW_PADSTART + lane, excl * 256, __ATOMIC_RELAXED, __HIP_MEMORY_SCOPE_AGENT); __hip_atomic_store(ctl + CW_CNT + lane, c, __ATOMIC_RELAXED, __HIP_MEMORY_SCOPE_AGENT);
                        for (int q = 0; q < t; ++q) __hip_atomic_store(ctl + CW_TILE_E + excl + q, lane, __ATOMIC_RELAXED, __HIP_MEMORY_SCOPE_AGENT); }
                    if (lane == NE) { __hip_atomic_store(ctl + CW_PADSTART + NE, excl * 256, __ATOMIC_RELAXED, __HIP_MEMORY_SCOPE_AGENT); __hip_atomic_store(ctl + CW_NTILES, excl, __ATOMIC_RELAXED, __HIP_MEMORY_SCOPE_AGENT); } }
                asm volatile("s_waitcnt vmcnt(0)" ::: "memory");
                __syncthreads();
                if (tid == 0) __hip_atomic_store(ctl + CW_READY, 1, __ATOMIC_RELAXED, __HIP_MEMORY_SCOPE_AGENT);
            }
            if (wave == 0) { unsigned sp = 0;
                while (__builtin_amdgcn_readfirstlane(__hip_atomic_load(ctl + CW_READY, __ATOMIC_RELAXED, __HIP_MEMORY_SCOPE_AGENT)) == 0) { __builtin_amdgcn_s_sleep(24); if (++sp > (1u << 19)) break; }
                __builtin_amdgcn_fence(__ATOMIC_ACQUIRE, "agent"); }
            __syncthreads();
            if (tid < NE) { sh2[tid] = BB[bx * NE + tid] + ctl[CW_PADSTART + tid]; sh2[64 + tid] = 0; }
            __syncthreads();
            { const int e = *(const LAS int*)(lds + LT_OFF + tid * 4); const int r = __hip_atomic_fetch_add(sh2 + 64 + e, 1, __ATOMIC_RELAXED, __HIP_MEMORY_SCOPE_WORKGROUP);
              const int dest = sh2[e] + r, idx = bx * NTHREADS + tid;
              ROWTOK[dest] = idx >> 2; ROWSLOT[dest] = idx; ROWGATE[dest] = *(const LAS float*)(lds + LT_OFF + 2048 + tid * 4); ROWRS[dest] = *(const LAS float*)(lds + LT_OFF + 4096 + (tid >> 2) * 4); }
            if (bx < NE) { const int plo = ctl[CW_PADSTART + bx] + ctl[CW_CNT + bx], phi = ctl[CW_PADSTART + bx + 1];
                for (int r = plo + tid; r < phi; r += NTHREADS) { ROWTOK[r] = 0; ROWSLOT[r] = MROWS; ROWGATE[r] = 0.f; ROWRS[r] = 0.f; } }
            __syncthreads();
        }
    }
    if (G != 256) SEAM(PH_ROUTER);
    if (IN(PH_ROUTE) && G != 256) {
        PHASE_LANE;
        LAS int* sh = (LAS int*)lds;
        if (tid == 0) { int ps = 0, nt = 0;
            for (int e = 0; e < NE; ++e) { sh[e] = ps; const int t = (ctl[CW_CNT + e] + 255) >> 8; if (bx == 0) for (int q = 0; q < t; ++q) ctl[CW_TILE_E + nt + q] = e; nt += t; ps += t * 256; }
            sh[NE] = ps; if (bx == 0) ctl[CW_NTILES] = nt; }
        __syncthreads();
        for (int chunk = bx; chunk < MROWS / NTHREADS; chunk += G) {
            if (tid < NE) sh[64 + tid] = 0;
            __syncthreads();
            const int idx = chunk * NTHREADS + tid, e = TOPI[idx]; const int r = __hip_atomic_fetch_add(sh + 64 + e, 1, __ATOMIC_RELAXED, __HIP_MEMORY_SCOPE_WORKGROUP);
            __syncthreads();
            if (tid < NE) sh[128 + tid] = atomicAdd(ctl + CW_CURSOR + tid, sh[64 + tid]);
            __syncthreads();
            const int dest = sh[e] + sh[128 + e] + r; ROWTOK[dest] = idx >> 2; ROWSLOT[dest] = idx; ROWGATE[dest] = TOPG[idx]; ROWRS[dest] = RS1[idx >> 2];
            __syncthreads();
        }
        for (int e = bx; e < NE; e += G) { const int plo = sh[e] + ctl[CW_CNT + e], phi = sh[e + 1];
            for (int r = plo + tid; r < phi; r += NTHREADS) { ROWTOK[r] = 0; ROWSLOT[r] = MROWS; ROWGATE[r] = 0.f; ROWRS[r] = 0.f; } }
        __syncthreads();
    }
    SEAM(PH_ROUTE);
    if (IN(PH_MOE1)) REPLOOP(PH_MOE1) {
        pg8::Gemm g{X8, W1T, DM, DM, DM, ROWTOK, (size_t)2048 * DM}; pg8::StaticOrder S; S.init(ctl[CW_NTILES], 2048 / 256, G, bx, ctl + CW_TILE_E);
        { PHASE_LANE; constexpr int MAXU = 24; LAS int* UIDX = (LAS int*)(lds + STG_OFF); LAS int* UE = UIDX + MAXU * 256;
          const int nunits = bx < S.nwg ? (S.nwg - bx + G - 1) / G : 0;
          if (nunits <= MAXU) { pg8::Unit u; for (int i = 0; i < nunits; ++i) { S.next(i, u); if (tid < 256) UIDX[i * 256 + tid] = ROWTOK[u.pm * 256 + tid]; if (tid == 0) UE[i] = u.e; }
              __syncthreads(); g.ridx_lds = UIDX; S.e_lds = UE; } }
        pg8::EpiMoe1 E{(unsigned char*)HB, b1, ROWRS};
        if (g.ridx_lds) pg8::gemm_phase<pg8::EpiMoe1, true, true, true>(lds, g, S, E, wave, LASTREP(PH_MOE1));
        else pg8::gemm_phase<pg8::EpiMoe1, true, true>(lds, g, S, E, wave, LASTREP(PH_MOE1));
    }
    SEAM(PH_MOE1);
    if (IN(PH_MOE2)) REPLOOP(PH_MOE2) {
        pg8::Gemm g{HB, W2T, DE, DE, DE, nullptr, (size_t)DM * DE}; pg8::StaticOrder S; S.init(ctl[CW_NTILES], DM / 256, G, bx, ctl + CW_TILE_E);
        { PHASE_LANE; constexpr int MAXU = 64; LAS int* UE = (LAS int*)(lds + STG_OFF); const int nunits = bx < S.nwg ? (S.nwg - bx + G - 1) / G : 0;
          if (nunits <= MAXU) { pg8::Unit u; for (int i = 0; i < nunits; ++i) { S.next(i, u); if (tid == 0) UE[i] = u.e; } __syncthreads(); S.e_lds = UE; } }
        pg8::EpiMoe2 E{(unsigned char*)Y, b2, ROWSLOT, ROWGATE}; pg8::gemm_phase<pg8::EpiMoe2, false, true>(lds, g, S, E, wave, LASTREP(PH_MOE2));
    }
    SEAM(PH_MOE2);
    if (IN(PH_COMBINE)) REPLOOP(PH_COMBINE) {
        PHASE_LANE;
        for (int row = gw * 2; row < NTOK; row += NGW * 2) {
            u32x4 hv[2][2]; u32x2 yv[2][4][2]; const unsigned char* Y8 = (const unsigned char*)Y;
#pragma unroll
            for (int q = 0; q < 2; ++q)
#pragma unroll
                for (int j = 0; j < 2; ++j) { hv[q][j] = *(const u32x4*)(HBF + (size_t)(row + q) * DM + (lane + 64 * j) * 8);
#pragma unroll
                    for (int k = 0; k < 4; ++k) yv[q][k][j] = *(const u32x2*)(Y8 + ((size_t)(row + q) * 4 + k) * DM + (lane + 64 * j) * 8); }
#pragma unroll
            for (int q = 0; q < 2; ++q) { float ss = 0.f; u32x4 ov[2];
#pragma unroll
                for (int j = 0; j < 2; ++j) { f32x4 a = {blo(hv[q][j].x), bhi(hv[q][j].x), blo(hv[q][j].y), bhi(hv[q][j].y)}, b = {blo(hv[q][j].z), bhi(hv[q][j].z), blo(hv[q][j].w), bhi(hv[q][j].w)};
#pragma unroll
                    for (int k = 0; k < 4; ++k) { const u32x2 y = yv[q][k][j]; const f32x2 y0 = __builtin_amdgcn_cvt_pk_f32_fp8(y.x, false), y1 = __builtin_amdgcn_cvt_pk_f32_fp8(y.x, true), y2 = __builtin_amdgcn_cvt_pk_f32_fp8(y.y, false), y3 = __builtin_amdgcn_cvt_pk_f32_fp8(y.y, true);
                        a += (f32x4){y0[0], y0[1], y1[0], y1[1]}; b += (f32x4){y2[0], y2[1], y3[0], y3[1]}; }
                    ss += pg8::sq4(a) + pg8::sq4(b); ov[j] = pg8::pack8(a, b); }
                ss = wave_sum(ss);
                bf16_t* ho = LASTREP(PH_COMBINE) ? HBF : (bf16_t*)(ws + WS_HB);
#pragma unroll
                for (int j = 0; j < 2; ++j) *(u32x4*)(ho + (size_t)(row + q) * DM + (lane + 64 * j) * 8) = ov[j];
                float ps = lane < 16 ? PSSQ[(size_t)(row + q) * 16 + lane] : 0.f; ps += __shfl_xor(ps, 1); ps += __shfl_xor(ps, 2); ps += __shfl_xor(ps, 4); ps += __shfl_xor(ps, 8);
                if (lane == 0) { RS2[row + q] = rsqrtf(ss * (1.f / DM) + EPS); RS2[NTOK + row + q] = rsqrtf(ps * (1.f / DM) + EPS); } }
        }
    }
    SEAM(PH_COMBINE);
    if (IN(PH_PLE)) REPLOOP(PH_PLE) {
        pg8::Gemm g{HBF, WG, DM, DM, DM, nullptr, 0}; pg8::StaticOrder S; S.init(NTOK / 256, DM / 256, G, bx, nullptr);
        if (G == 256 && LASTREP(PH_PLE)) { pg8::EpiPleFinal E{HBF, H, PLER, RS2 + NTOK, RS2, ple_post_norm, final_norm, FSSQ, (unsigned*)ctl + CW_PANEL, (unsigned*)ctl + CW_PANEL - 64, lds}; pg8::gemm_phase<pg8::EpiPleFinal, false>(lds, g, S, E, wave); }
        else { pg8::EpiPle E{HBF, H3, PLER, RS2 + NTOK, RS2, ple_post_norm, FSSQ}; pg8::gemm_phase<pg8::EpiPle, false>(lds, g, S, E, wave); }
    }
    if (G != 256) SEAM(PH_PLE);
    if (IN(PH_FINAL) && G != 256) REPLOOP(PH_FINAL) {
        PHASE_LANE;
        for (int row = gw * 4; row < NTOK; row += NGW * 4) {
            u32x4 hv[4][2]; float sp[4];
#pragma unroll
            for (int q = 0; q < 4; ++q) { sp[q] = lane < 16 ? FSSQ[(size_t)(row + q) * 16 + lane] : 0.f;
#pragma unroll
                for (int j = 0; j < 2; ++j) hv[q][j] = *(const u32x4*)(H3 + (size_t)(row + q) * DM + (lane + 64 * j) * 8); }
#pragma unroll
            for (int q = 0; q < 4; ++q) { float s = sp[q]; s += __shfl_xor(s, 1); s += __shfl_xor(s, 2); s += __shfl_xor(s, 4); s += __shfl_xor(s, 8);
                const float rstd = rsqrtf(__shfl(s, 0) * (1.f / DM) + EPS); float* ho = (LASTREP(PH_FINAL) ? H : (float*)(ws + WS_HB)) + (size_t)(row + q) * DM;
#pragma unroll
                for (int j = 0; j < 2; ++j) { const int c = (lane + 64 * j) * 8; const f32x4 g0 = *(const f32x4*)(final_norm + c), g1 = *(const f32x4*)(final_norm + c + 4); const u32x4 v = hv[q][j];
                    *(f32x4*)(ho + c) = (f32x4){blo(v.x), bhi(v.x), blo(v.y), bhi(v.y)} * rstd * g0; *(f32x4*)(ho + c + 4) = (f32x4){blo(v.z), bhi(v.z), blo(v.w), bhi(v.w)} * rstd * g1; } }
        }
    }
#ifdef PROBE_EPI
    if (bx == 0 && wave == 0) { const unsigned dt = MISC[63]; const unsigned long long t0 = __builtin_amdgcn_s_memrealtime(); while (__builtin_amdgcn_s_memrealtime() - t0 < (unsigned long long)dt) __builtin_amdgcn_s_sleep(8); }
#endif
#ifdef PROBE_TIME_PH
    STAMP(PH_COUNT);
    if (bx == 0 && wave == 0) {
#ifndef PROBE_TIME_END
#define PROBE_TIME_END (PROBE_TIME_PH + 1)
#endif
        const unsigned dt = MISC[32 + PROBE_TIME_END] - MISC[32 + PROBE_TIME_PH]; const unsigned long long t0 = __builtin_amdgcn_s_memrealtime(); while (__builtin_amdgcn_s_memrealtime() - t0 < (unsigned long long)dt) __builtin_amdgcn_s_sleep(8); }
#endif
#ifdef PROBE_BARS
    if (hi - lo > 1) for (int i = 0; i < PROBE_BARS; ++i) xcd_barrier(bar, wave);
#endif
#undef IN
#undef NREP
#undef REPLOOP
#undef LASTREP
#undef SEAM
}
static int g_grid = 0;
extern "C" void kernel_launch(void* const* d_in, const int* in_sizes, int n_in, void* d_out, int out_size, void* d_ws, size_t ws_size, hipStream_t stream) {
    if (n_in != 25 || in_sizes[0] != NTOK * DM || out_size != NTOK * DM || ws_size < WS_END) {
        fprintf(stderr, "kernel_launch: unexpected shapes (n_in %d, in0 %d, out %d, ws %zu need %zu)\n", n_in, n_in > 0 ? in_sizes[0] : -1, out_size, ws_size, (size_t)WS_END); return; }
    if (g_grid == 0) {
        int dev = 0, cus = 0, per_cu = 0; (void)hipGetDevice(&dev); (void)hipDeviceGetAttribute(&cus, hipDeviceAttributeMultiprocessorCount, dev);
        if (hipFuncSetAttribute((const void*)fwd, hipFuncAttributeMaxDynamicSharedMemorySize, LDS_BYTES) != hipSuccess) fprintf(stderr, "hipFuncSetAttribute failed\n");
        if (hipOccupancyMaxActiveBlocksPerMultiprocessor(&per_cu, (const void*)fwd, NTHREADS, LDS_BYTES) != hipSuccess || per_cu < 1) { fprintf(stderr, "occupancy query: %d\n", per_cu); per_cu = 1; }
        (void)hipGetLastError();
        g_grid = cus > 0 ? cus : 256;
    }
    (void)hipMemsetAsync((unsigned char*)d_ws + WS_CTL, 0, 64 * 1024, stream);
    Args a{}; for (int i = 0; i < 25; ++i) a.in[i] = d_in[i]; a.out = (float*)d_out; a.ws = (unsigned char*)d_ws;
    a.ph_lo = 0; a.ph_hi = PH_COUNT; a.li = 0; a.skip = 0;
    void* p[] = {&a};
    const hipError_t e = hipLaunchCooperativeKernel((const void*)fwd, dim3(g_grid), dim3(NTHREADS), p, LDS_BYTES, stream);
    if (e != hipSuccess) fprintf(stderr, "cooperative launch failed: %s (grid %d)\n", hipGetErrorString(e), g_grid);
}
```

```cpp
#include <hip/hip_runtime.h>
#include <cstdint>
#include <cstdio>
#include <cmath>

typedef unsigned short bf16_t;

constexpr int NB = 8, SEQ = 4096, DM = 1024, NTOK = NB * SEQ;
constexpr int PLE = 256, NH = 4, DN = 128, DR = 64, DV = 128, QL = 256, KVL = 128, DQK = DN + DR;
constexpr int INW = 1984, INWP = 1536;
constexpr int NE = 32, TOPK = 4, DE = 1024;
constexpr int MROWS = NTOK * TOPK;
constexpr int MAXTILES = MROWS / 256 + NE;
constexpr int PROWS = MAXTILES * 256;
constexpr float EPS = 1e-6f;
constexpr float QSCALE = 0.07216878364870322f * 1.4426950408889634f;

constexpr size_t MiB = 1u << 20;
constexpr size_t WS_CTL = 0;
constexpr size_t WS_WIN = 1 * MiB, WS_WUQ = 5 * MiB, WS_WUKV = 5 * MiB + 512 * 1024, WS_WO = 6 * MiB, WS_WG = 8 * MiB, WS_WP = 10 * MiB;
constexpr size_t WS_WR = 10 * MiB + 512 * 1024;
constexpr size_t WS_CS = 11 * MiB;
constexpr size_t WS_SSQ = 19 * MiB, WS_ASSQ = 20 * MiB, WS_PSSQ = 21 * MiB, WS_FSSQ = 23 * MiB;
constexpr size_t WS_TOPI = 25 * MiB, WS_TOPG = 25 * MiB + 512 * 1024;
constexpr size_t WS_ROWTOK = 26 * MiB, WS_ROWSLOT = 27 * MiB, WS_ROWGATE = 28 * MiB;
constexpr size_t WS_P16 = 29 * MiB;
constexpr size_t WS_SSQ1 = 45 * MiB, WS_RS1 = 47 * MiB, WS_RS2 = 47 * MiB + 128 * 1024, WS_ROWRS = 47 * MiB + 384 * 1024;
constexpr size_t WS_RSX = 10 * MiB + 512 * 1024;
constexpr size_t WS_WRHL = 10 * MiB + 768 * 1024;
constexpr size_t WS_HBF = 112 * MiB;
constexpr size_t WS_H3 = 304 * MiB;
constexpr size_t WS_W1 = 48 * MiB, WS_W2 = 176 * MiB, WS_XN = 240 * MiB, WS_MIX = 304 * MiB, WS_PLER = 368 * MiB;
constexpr size_t WS_Z = 432 * MiB, WS_Q = 560 * MiB, WS_K = 608 * MiB, WS_V = 656 * MiB;
constexpr size_t WS_HB = 432 * MiB;
constexpr size_t WS_Y = 704 * MiB;
constexpr size_t WS_END = WS_Y + (size_t)(MROWS + 256) * DM * 2;
constexpr int CW_CNT = 0, CW_CURSOR = 64, CW_PADSTART = 128, CW_NTILES = 192, CW_TICKET = 200, CW_READY = 224, CW_TILE_E = 256;

__device__ __forceinline__ float bf2f(bf16_t v) { return __uint_as_float((unsigned)v << 16); }
__device__ __forceinline__ float blo(unsigned u) { return __uint_as_float(u << 16); }
__device__ __forceinline__ float bhi(unsigned u) { return __uint_as_float(u & 0xffff0000u); }
__device__ __forceinline__ bf16_t f2bf(float f) { unsigned u = __float_as_uint(f); return (bf16_t)((u + 0x7fffu + ((u >> 16) & 1u)) >> 16); }
__device__ __forceinline__ unsigned pk2(float lo, float hi) { return (unsigned)f2bf(lo) | ((unsigned)f2bf(hi) << 16); }
template <int CTRL> __device__ __forceinline__ float dpp_f(float v) { return __builtin_bit_cast(float, __builtin_amdgcn_update_dpp(0, __builtin_bit_cast(int, v), CTRL, 0xF, 0xF, true)); }
#define DPP_XOR1 0xB1
#define DPP_XOR2 0x4E
#define DPP_HMIR 0x141
#define DPP_MIR  0x140
__device__ __forceinline__ float row16_sum(float v) { v += dpp_f<DPP_XOR1>(v); v += dpp_f<DPP_XOR2>(v); v += dpp_f<DPP_HMIR>(v); v += dpp_f<DPP_MIR>(v); return v; }
__device__ __forceinline__ float row16_max(float v) { v = fmaxf(v, dpp_f<DPP_XOR1>(v)); v = fmaxf(v, dpp_f<DPP_XOR2>(v)); v = fmaxf(v, dpp_f<DPP_HMIR>(v)); v = fmaxf(v, dpp_f<DPP_MIR>(v)); return v; }
__device__ __forceinline__ float xsum16(float v) { const auto r = __builtin_amdgcn_permlane16_swap(__float_as_uint(v), __float_as_uint(v), false, false); return __uint_as_float(r[0]) + __uint_as_float(r[1]); }
__device__ __forceinline__ float xsum32(float v) { const auto r = __builtin_amdgcn_permlane32_swap(__float_as_uint(v), __float_as_uint(v), false, false); return __uint_as_float(r[0]) + __uint_as_float(r[1]); }
__device__ __forceinline__ float wave_sum(float v) { return xsum32(xsum16(row16_sum(v))); }
__device__ __forceinline__ float wave_max(float v) { v = row16_max(v);
    { const auto r = __builtin_amdgcn_permlane16_swap(__float_as_uint(v), __float_as_uint(v), false, false); v = fmaxf(__uint_as_float(r[0]), __uint_as_float(r[1])); }
    { const auto r = __builtin_amdgcn_permlane32_swap(__float_as_uint(v), __float_as_uint(v), false, false); v = fmaxf(__uint_as_float(r[0]), __uint_as_float(r[1])); }
    return v; }
__device__ __forceinline__ float dot8(uint4 x, uint4 y) {
    return blo(x.x) * blo(y.x) + bhi(x.x) * bhi(y.x) + blo(x.y) * blo(y.y) + bhi(x.y) * bhi(y.y) +
           blo(x.z) * blo(y.z) + bhi(x.z) * bhi(y.z) + blo(x.w) * blo(y.w) + bhi(x.w) * bhi(y.w);
}
__device__ __forceinline__ float dot_bf16(const bf16_t* a, const bf16_t* b, int K) {
    const uint4* a4 = (const uint4*)a; const uint4* b4 = (const uint4*)b; float acc = 0.f;
    for (int i = 0; i < K / 8; ++i) acc += dot8(a4[i], b4[i]);
    return acc;
}

#define LAS __attribute__((address_space(3)))
#define GAS __attribute__((address_space(1)))
typedef short bf16x8 __attribute__((ext_vector_type(8)));
typedef float f32x4 __attribute__((ext_vector_type(4)));
typedef float f32x2 __attribute__((ext_vector_type(2)));
typedef unsigned u32x4 __attribute__((ext_vector_type(4)));
typedef unsigned u32x2 __attribute__((ext_vector_type(2)));
#ifndef PROBE_PH
#define PROBE_PH (-1)
#define PROBE_REP 1
#endif
#ifndef MOE2_DELAY_TICKS
#define MOE2_DELAY_TICKS 700ull
#endif
constexpr int NWAVES = 8, NTHREADS = 512;
constexpr int RING_BYTES = 131072, MISC_OFF = RING_BYTES, HIST_OFF = MISC_OFF + 256, STG_OFF = RING_BYTES + 1024, LT_OFF = HIST_OFF + 256 + 16384, PRE_OFF = 157696, LDS_BYTES = 163840;
constexpr int CW_PANEL = 8192;
constexpr int CW_BAR = 4096;
__device__ __forceinline__ unsigned cvt_pk_bf16(float lo, float hi) { unsigned r; asm volatile("v_cvt_pk_bf16_f32 %0, %1, %2" : "=v"(r) : "v"(lo), "v"(hi)); return r; }
__device__ __forceinline__ int lane_id() { int l = (int)__builtin_amdgcn_mbcnt_hi(~0u, __builtin_amdgcn_mbcnt_lo(~0u, 0u)); asm volatile("" : "+v"(l)); return l; }
__device__ __forceinline__ float fast_sigmoid(float a) { return __builtin_amdgcn_rcpf(1.f + __expf(-a)); }

#define XB_TMO      128
#define XB_XCNT(j)  (256  + 64 * (j))
#define XB_XSUB(j)  (1280 + 64 * (j))
#define XB_XGEN(j)  (2304 + 64 * (j))
#define XB_TOP      3328
#define XB_TOPGEN   3392
#define XCD_BAR_WORDS 3456
#define XB_SPIN_CAP (1u << 20)
__device__ __forceinline__ unsigned xb_ld(unsigned* p)              { return __hip_atomic_load(p, __ATOMIC_RELAXED, __HIP_MEMORY_SCOPE_AGENT); }
__device__ __forceinline__ unsigned xb_add(unsigned* p, unsigned v) { return __hip_atomic_fetch_add(p, v, __ATOMIC_RELAXED, __HIP_MEMORY_SCOPE_AGENT); }
__device__ __forceinline__ unsigned xb_xcc_id() { return (unsigned)__builtin_amdgcn_s_getreg((3 << 11) | 20) & 0xFu; }
#define XB_SPIN(cond, bar) do { unsigned _sp = 0; while (cond) { __builtin_amdgcn_s_sleep(1); \
    if ((++_sp & 255u) == 0u) { if (xb_ld(&(bar)[XB_TMO])) break; if (_sp > XB_SPIN_CAP) { atomicAdd(&(bar)[XB_TMO], 1u); break; } } } } while (0)
struct XcdBarrier { unsigned* bar; unsigned x; volatile LAS unsigned* st; };
__device__ __forceinline__ XcdBarrier xcd_barrier_post(unsigned* bar, volatile LAS unsigned* st, int wave) {
    XcdBarrier b; b.bar = bar; b.x = xb_xcc_id(); b.st = st;
    if (wave == 0 && lane_id() == 0) (void)xb_add(&bar[XB_XCNT(b.x)], 1u);
    return b;
}
__device__ __forceinline__ void xcd_barrier_complete(unsigned* bar, unsigned x, unsigned& nloc, unsigned& nx) {
    const unsigned G = gridDim.x * gridDim.y * gridDim.z;
    unsigned sum, cnt, mine, sp = 0u;
    for (;;) {
        sum = 0u; cnt = 0u; mine = 0u;
#pragma unroll
        for (unsigned j = 0; j < 16; ++j) { const unsigned c = xb_ld(&bar[XB_XCNT(j)]); sum += c; cnt += (c > 0u) ? 1u : 0u; mine = (j == x) ? c : mine; }
        if (sum == G) break;
        __builtin_amdgcn_s_sleep(1);
        if ((++sp & 255u) == 0u) { if (xb_ld(&bar[XB_TMO])) break; if (sp > XB_SPIN_CAP) { atomicAdd(&bar[XB_TMO], 1u); break; } }
    }
    nloc = mine > 0u ? mine : 1u; nx = cnt > 0u ? cnt : 1u;
}
__device__ __forceinline__ void xcd_barrier(const XcdBarrier& b, int wave) {
    asm volatile("s_waitcnt vmcnt(0)" ::: "memory");
    __syncthreads();
    if (wave == 0 && lane_id() == 0) {
        unsigned* bar = b.bar;
        __builtin_amdgcn_s_waitcnt(0);
        unsigned nloc = b.st[0], nx = b.st[1];
        if (nloc == 0u) { xcd_barrier_complete(bar, b.x, nloc, nx); b.st[0] = nloc; b.st[1] = nx; }
        const unsigned old = xb_add(&bar[XB_XSUB(b.x)], 1u);
        const unsigned gen = old / nloc;
        if (old + 1u == (gen + 1u) * nloc) {
            __builtin_amdgcn_fence(__ATOMIC_RELEASE, "agent");
            asm volatile("s_waitcnt vmcnt(0)" ::: "memory");
            const unsigned og = xb_add(&bar[XB_TOP], 1u);
            const unsigned tg = og / nx;
            if (og + 1u == (tg + 1u) * nx) xb_add(&bar[XB_TOPGEN], 1u);
            else XB_SPIN(xb_ld(&bar[XB_TOPGEN]) == tg, bar);
            __builtin_amdgcn_fence(__ATOMIC_ACQUIRE, "agent");
            xb_add(&bar[XB_XGEN(b.x)], 1u);
            asm volatile("s_waitcnt vmcnt(0)" ::: "memory");
        } else {
            XB_SPIN(xb_ld(&bar[XB_XGEN(b.x)]) == gen, bar);
            __builtin_amdgcn_fence(__ATOMIC_ACQUIRE, "agent");
            asm volatile("s_waitcnt vmcnt(0)" ::: "memory");
        }
    }
    __syncthreads();
}

namespace pg8 {
constexpr int BM = 256, BK = 64, HALF = 128, HTB = HALF * BK * 2, STAGE_BYTES = 8 * HTB, NXCD = 8, WGM = 8;
__host__ __device__ __forceinline__ int lds_byte(int r, int c) { const int st = (r >> 4) * 2 + (c >> 5), rr = r & 15, cc = c & 31, ob = rr * 64 + cc * 2; return st * 1024 + (ob ^ (((ob >> 9) & 1) << 5)); }
__host__ __device__ __forceinline__ void stage_rc(int b, int& R, int& C) { const int st = b / 1024, sb = b % 1024, swz = sb ^ (((sb >> 9) & 1) << 5); R = (st >> 1) * 16 + swz / 64; C = (st & 1) * 32 + (swz % 64) / 2; }
__host__ __device__ __forceinline__ int perm32(int rho) { const int n = rho >> 4, i = rho & 15; return 8 * (i >> 2) + 4 * n + (i & 3); }
struct Unit { int pm, pn, e; };
struct Gemm { const void* A; const void* Bt; int K, lda, ldb; const int* rowidx; size_t bstride; const LAS int* ridx_lds = nullptr; };
struct StaticOrder {
    int nM, nN, nwg, G, c; const int* tile_e; const LAS int* e_lds = nullptr; int wgm = WGM;
    int seg = 0, nA = 0, baseA = 0, GA = 1, cA = 0, baseB = 0, limB = 0;
    __device__ __forceinline__ void init(int nM_, int nN_, int G_, int c_, const int* te) { nM = nM_; nN = nN_; nwg = nM * nN; G = G_; c = c_; tile_e = te; }
    __device__ __forceinline__ bool next(int i, Unit& u) const {
        long L;
        if (seg) { if (i < nA) L = (long)baseA + cA + (long)i * GA; else { L = (long)baseB + c + (long)(i - nA) * G; if (L >= limB) return false; } }
        else { L = (long)i * G + c; if (L >= nwg) return false; }
        int wgid = (int)L; { const int q = nwg / NXCD, r = nwg % NXCD, xcd = wgid % NXCD, off = wgid / NXCD; wgid = (xcd < r ? xcd * (q + 1) : r * (q + 1) + (xcd - r) * q) + off; }
        const int nig = wgm * nN, gid = wgid / nig, fm = gid * wgm, gsz = (nM - fm) < wgm ? (nM - fm) : wgm;
        u.pm = fm + ((wgid % nig) % gsz); u.pn = (wgid % nig) / gsz; u.e = e_lds ? e_lds[i] : (tile_e ? tile_e[u.pm] : 0); return true;
    }
};
typedef f32x4 Acc[2][2][4][2];
typedef int v8i_t __attribute__((ext_vector_type(8)));
typedef int v4i_t __attribute__((ext_vector_type(4)));
template <class Epi, bool GATHER, bool FP8 = false, bool LDSIDX = false>
__device__ __forceinline__ void gemm_phase(LAS unsigned char* lds, const Gemm g, const StaticOrder& S, const Epi& E, const int wid, const bool do_epi = true) {
    const int lane = lane_id(), tid = wid * 64 + lane, wr = wid >> 2, wc = wid & 3, fr = lane & 15, fq = lane >> 4;
    constexpr int ES = FP8 ? 1 : 2;
    const int K = g.K, nt = K * ES / 128;
    int RA[2], CA[2]; unsigned voffB[2], voffA[2];
#pragma unroll
    for (int i = 0; i < 2; ++i) { int R, C; stage_rc(tid * 16 + i * 8192, R, C); const int Rb = Epi::PERM ? ((R & ~31) + perm32(R & 31)) : R;
        RA[i] = R; CA[i] = C; voffB[i] = (unsigned)(Rb * g.ldb * ES + C * 2); voffA[i] = (unsigned)(R * g.lda * ES + C * 2); }
    const size_t hstepA = GATHER ? 0 : (size_t)HALF * g.lda * ES;
    const size_t kstep = (size_t)(BK * 2);
    const size_t hstepB = (size_t)HALF * g.ldb * ES;
    const unsigned ldsw = (unsigned)wid * 1024u;
    const int aoff = lds_byte(wr * 64 + fr, fq * 8), boff = lds_byte(wc * 32 + fr, fq * 8);
#define PG8_SA(b, h) (((b) * 2 + (h)) * HTB)
#define PG8_SB(b, h) ((4 + (b) * 2 + (h)) * HTB)
#define PG8_STAGE(bufoff, gbase, voff) do { _Pragma("unroll") for (int _i = 0; _i < 2; ++_i) \
        __builtin_amdgcn_global_load_lds((const unsigned*)((const char*)(gbase) + (voff)[_i]), (LAS unsigned*)(lds + (bufoff) + ldsw + _i * 8192), 16, 0, 0); } while (0)
#define PG8_LDA(dst, b, h) do { _Pragma("unroll") for (int m = 0; m < 4; ++m) _Pragma("unroll") for (int k = 0; k < 2; ++k) dst[m][k] = *(const LAS bf16x8*)(lds + PG8_SA(b, h) + aoff + m * 2048 + k * 1024); } while (0)
#define PG8_LDB(dst, b, h) do { _Pragma("unroll") for (int n = 0; n < 2; ++n) _Pragma("unroll") for (int k = 0; k < 2; ++k) dst[n][k] = *(const LAS bf16x8*)(lds + PG8_SB(b, h) + boff + n * 2048 + k * 1024); } while (0)
#define PG8_CAT8(x) __builtin_shufflevector(__builtin_bit_cast(v4i_t, (x)[0]), __builtin_bit_cast(v4i_t, (x)[1]), 0, 1, 2, 3, 4, 5, 6, 7)
#define PG8_MMA(ai, bj, At, Bt) do { __builtin_amdgcn_s_setprio(1); if constexpr (FP8) { _Pragma("unroll") for (int m = 0; m < 4; ++m) _Pragma("unroll") for (int n = 0; n < 2; ++n) \
        acc[ai][bj][m][n] = __builtin_amdgcn_mfma_scale_f32_16x16x128_f8f6f4(PG8_CAT8(Bt[n]), PG8_CAT8(At[m]), acc[ai][bj][m][n], 0, 0, 0, 0x7f7f7f7f, 0, 0x7f7f7f7f); \
        _Pragma("unroll") for (int m = 0; m < 4; ++m) _Pragma("unroll") for (int n = 0; n < 2; ++n) asm volatile("" : "+v"(acc[ai][bj][m][n]));   } else { \
        _Pragma("unroll") for (int m = 0; m < 4; ++m) _Pragma("unroll") for (int n = 0; n < 2; ++n) _Pragma("unroll") for (int k = 0; k < 2; ++k) \
        acc[ai][bj][m][n] = __builtin_amdgcn_mfma_f32_16x16x32_bf16(Bt[n][k], At[m][k], acc[ai][bj][m][n], 0, 0, 0); } __builtin_amdgcn_s_setprio(0); } while (0)
#define PG8_WAIT_V(n) asm volatile("s_waitcnt vmcnt(" #n ")" ::: "memory")
#define PG8_WAIT_L(n) asm volatile("s_waitcnt lgkmcnt(" #n ")" ::: "memory")
#define PG8_BAR __builtin_amdgcn_s_barrier()
#define PG8_SCHED __builtin_amdgcn_sched_barrier(0)
#define PG8_SETVO(vo, u, ord) do { if constexpr (GATHER) { _Pragma("unroll") for (int _h = 0; _h < 2; ++_h) _Pragma("unroll") for (int _i = 0; _i < 2; ++_i) { \
        int _row; if constexpr (LDSIDX) _row = g.ridx_lds[(ord) * BM + _h * HALF + RA[_i]]; else _row = g.rowidx[(u).pm * BM + _h * HALF + RA[_i]]; (vo)[_h][_i] = (unsigned)_row * (unsigned)(g.lda * ES) + (unsigned)CA[_i] * 2u; } } } while (0)
#define PG8_STAGE_A(bufoff, base, h, vog) do { if constexpr (GATHER) { PG8_STAGE(bufoff, base, (vog)[h]); } else { PG8_STAGE(bufoff, (base) + (h) * hstepA, voffA); } } while (0)
    Unit cur, nxt; int ui = 0;
    if (!S.next(0, cur)) return;
    Acc acc;
#pragma unroll
    for (int a = 0; a < 2; ++a)
#pragma unroll
        for (int b = 0; b < 2; ++b)
#pragma unroll
            for (int m = 0; m < 4; ++m)
#pragma unroll
                for (int n = 0; n < 2; ++n) acc[a][b][m][n] = (f32x4){0.f, 0.f, 0.f, 0.f};
    bf16x8 At[4][2], B0[2][2], B1[2][2];
    unsigned voC[2][2], voN[2][2];
    PG8_SETVO(voC, cur, 0);
    const char* const Ab = (const char*)g.A;
    const char* cA = GATHER ? Ab : Ab + (size_t)cur.pm * 2 * hstepA;
    const char* cB = (const char*)g.Bt + (size_t)cur.e * g.bstride + (size_t)cur.pn * 2 * hstepB;
    PG8_STAGE(PG8_SB(0, 0), cB, voffB); PG8_STAGE(PG8_SB(0, 1), cB + hstepB, voffB); PG8_STAGE_A(PG8_SA(0, 0), cA, 0, voC); PG8_STAGE_A(PG8_SA(0, 1), cA, 1, voC);
    if (wr == 1) PG8_BAR;
    PG8_WAIT_V(2); PG8_BAR;
    PG8_STAGE(PG8_SB(1, 0), cB + kstep, voffB); PG8_STAGE_A(PG8_SA(1, 0), cA + kstep, 0, voC); PG8_STAGE(PG8_SB(1, 1), cB + hstepB + kstep, voffB);
    PG8_WAIT_V(6); PG8_BAR;
    for (;;) {
        const bool has_next = S.next(ui + 1, nxt);
        const char* nB = has_next ? (const char*)g.Bt + (size_t)nxt.e * g.bstride + (size_t)nxt.pn * 2 * hstepB : cB;
        const char* nA = (has_next && !GATHER) ? Ab + (size_t)nxt.pm * 2 * hstepA : cA;
        if constexpr (GATHER) { if (has_next) { PG8_SETVO(voN, nxt, ui + 1); } else {
#pragma unroll
            for (int h = 0; h < 2; ++h)
#pragma unroll
                for (int i = 0; i < 2; ++i) voN[h][i] = voC[h][i]; } }
        for (int t = 0; t < nt; t += 2) {
            const bool last = (t == nt - 2);
            if constexpr (Epi::MIDK > 0) { if (t == Epi::MIDK) { const int l2 = lane_id(); E.mid(acc, cur, wr, wc, l2 & 15, l2 >> 4, (const LAS unsigned char*)(lds + Epi::PRE_BASE + (ui & 1) * Epi::NPRE * 1024)); } }
            if constexpr (Epi::NPRE > 0) { if (t == 0 && wid < Epi::NPRE) {
                __builtin_amdgcn_global_load_lds((const unsigned*)E.pre_src(cur, wid, lane_id()), (LAS unsigned*)(lds + Epi::PRE_BASE + ((ui & 1) * Epi::NPRE + wid) * 1024), 16, 0, 0); } }
            const char* a1 = cA + (size_t)(t + 1) * kstep;
            const char* a2 = last ? nA : cA + (size_t)(t + 2) * kstep; const char* b2 = last ? nB : cB + (size_t)(t + 2) * kstep;
            const char* a3 = a2 + kstep; const char* b3 = b2 + kstep;
            unsigned o2[2][2];
            if constexpr (GATHER) {
#pragma unroll
            for (int h = 0; h < 2; ++h)
#pragma unroll
                for (int i = 0; i < 2; ++i) o2[h][i] = last ? voN[h][i] : voC[h][i]; }
            PG8_LDB(B0, 0, 0); PG8_LDB(B1, 0, 1); PG8_SCHED; PG8_LDA(At, 0, 0); PG8_STAGE_A(PG8_SA(1, 1), a1, 1, voC);
            PG8_WAIT_V(8); PG8_WAIT_L(0); PG8_BAR; PG8_MMA(0, 0, At, B0); PG8_MMA(0, 1, At, B1); PG8_BAR; PG8_SCHED;
            PG8_LDA(At, 0, 1); PG8_STAGE(PG8_SB(0, 0), b2, voffB); PG8_STAGE(PG8_SB(0, 1), b2 + hstepB, voffB); PG8_STAGE_A(PG8_SA(0, 0), a2, 0, o2);
            PG8_WAIT_V(8); PG8_WAIT_L(0); PG8_BAR; PG8_MMA(1, 0, At, B0); PG8_MMA(1, 1, At, B1); PG8_BAR; PG8_SCHED;
            PG8_LDB(B0, 1, 0); PG8_LDB(B1, 1, 1); PG8_SCHED; PG8_LDA(At, 1, 0); PG8_STAGE_A(PG8_SA(0, 1), a2, 1, o2);
            PG8_WAIT_V(8); PG8_WAIT_L(0); PG8_BAR; PG8_MMA(0, 0, At, B0); PG8_MMA(0, 1, At, B1); PG8_BAR; PG8_SCHED;
            PG8_LDA(At, 1, 1); PG8_STAGE(PG8_SB(1, 0), b3, voffB); PG8_STAGE(PG8_SB(1, 1), b3 + hstepB, voffB); PG8_STAGE_A(PG8_SA(1, 0), a3, 0, o2);
            PG8_WAIT_V(8); PG8_WAIT_L(0); PG8_BAR; PG8_MMA(1, 0, At, B0); PG8_MMA(1, 1, At, B1); PG8_BAR; PG8_SCHED;
        }
        if (wr == 0) PG8_BAR;
#ifdef PROBE_EPI
        const unsigned te0_ = (unsigned)__builtin_amdgcn_s_memrealtime();
#endif
        if (do_epi) { const int l2 = lane_id();
            if constexpr (Epi::NPRE > 0) E(acc, cur, wr, wc, l2 & 15, l2 >> 4, (const LAS unsigned char*)(lds + Epi::PRE_BASE + (ui & 1) * Epi::NPRE * 1024)); else E(acc, cur, wr, wc, l2 & 15, l2 >> 4); }
#ifdef PROBE_EPI
        asm volatile("s_waitcnt vmcnt(0)" ::: "memory");
        if (blockIdx.x == 0 && wid == 0 && lane_id() == 0) { LAS unsigned* M_ = (LAS unsigned*)(lds + 131072); M_[62] += (unsigned)__builtin_amdgcn_s_memrealtime() - te0_; }
#endif
        if (!has_next) break;
#pragma unroll
        for (int a = 0; a < 2; ++a)
#pragma unroll
            for (int b = 0; b < 2; ++b)
#pragma unroll
                for (int m = 0; m < 4; ++m)
#pragma unroll
                    for (int n = 0; n < 2; ++n) acc[a][b][m][n] = (f32x4){0.f, 0.f, 0.f, 0.f};
        cur = nxt; cB = nB; cA = nA; ++ui;
        if constexpr (GATHER) {
#pragma unroll
        for (int h = 0; h < 2; ++h)
#pragma unroll
            for (int i = 0; i < 2; ++i) voC[h][i] = voN[h][i]; }
        if (wr == 1) PG8_BAR;
    }
    PG8_WAIT_V(0);
    PG8_BAR;
#undef PG8_SA
#undef PG8_SB
#undef PG8_STAGE
#undef PG8_LDA
#undef PG8_LDB
#undef PG8_MMA
#undef PG8_CAT8
#undef PG8_WAIT_V
#undef PG8_WAIT_L
#undef PG8_BAR
#undef PG8_SCHED
#undef PG8_SETVO
#undef PG8_STAGE_A
}

__device__ __forceinline__ unsigned pk4_fp8(f32x4 v) { unsigned w = 0; w = __builtin_amdgcn_cvt_pk_fp8_f32(v[0], v[1], w, false); w = __builtin_amdgcn_cvt_pk_fp8_f32(v[2], v[3], w, true); return w; }
__device__ __forceinline__ float sq4(f32x4 v) { return (v[0] * v[0] + v[1] * v[1]) + (v[2] * v[2] + v[3] * v[3]); }
__device__ __forceinline__ float red_fq(float s) { return xsum32(xsum16(s)); }
__device__ __forceinline__ u32x4 pack8(f32x4 a, f32x4 b) { u32x4 w; w.x = cvt_pk_bf16(a[0], a[1]); w.y = cvt_pk_bf16(a[2], a[3]); w.z = cvt_pk_bf16(b[0], b[1]); w.w = cvt_pk_bf16(b[2], b[3]); return w; }
template <int MODE> struct EpiBf16Stats {
    static constexpr bool PERM = true; static constexpr int MIDK = 0; static constexpr int NPRE = MODE == 0 ? 1 : 0, PRE_BASE = 138240;
    __device__ __forceinline__ const char* pre_src(const Unit& u, int piece, int lane) const { return (const char*)(rsx + (size_t)u.pm * BM) + lane * 16; }
    bf16_t* O; int ldc; float* ssq; const float* rsx;
    __device__ __forceinline__ void operator()(const Acc& acc, const Unit& u, int wr, int wc, int fr, int fq, const LAS unsigned char* pre = nullptr) const {
        const int row0 = u.pm * BM + wr * 64 + fr, col0 = u.pn * BM + wc * 32 + 8 * fq;
        float rv[2][4]; f32x4 gpl[4] = {};
        if (MODE == 1) {
#pragma unroll
            for (int q = 0; q < 4; ++q) gpl[q] = *(const f32x4*)(rsx + u.pn * BM + 64 * wc + 16 * fq + 4 * q); }
#pragma unroll
        for (int ai = 0; ai < 2; ++ai)
#pragma unroll
            for (int m = 0; m < 4; ++m) rv[ai][m] = (MODE == 0) ? ((const LAS float*)pre)[wr * 64 + fr + ai * HALF + m * 16] : 1.f;
        asm volatile("" ::: "memory");
#pragma unroll
        for (int ai = 0; ai < 2; ++ai)
#pragma unroll
            for (int m = 0; m < 4; ++m) { const int row = row0 + ai * HALF + m * 16; bf16_t* rowp = O + (size_t)row * ldc + col0; const float rs = rv[ai][m];
                const f32x4 a00 = acc[ai][0][m][0] * rs, a01 = acc[ai][0][m][1] * rs, a10 = acc[ai][1][m][0] * rs, a11 = acc[ai][1][m][1] * rs;
                if (MODE == 0 && u.pn >= 4) { *(u32x4*)(O + (size_t)row * ldc + 960 + (u.pn - 4) * HALF + wc * 32 + 8 * fq) = pack8(a00 * a10, a01 * a11); continue; }
                if (MODE == 1) *(u32x4*)((unsigned char*)O + (size_t)row * ldc + u.pn * BM + 64 * wc + 16 * fq) = (u32x4){pk4_fp8(a00 * gpl[0]), pk4_fp8(a01 * gpl[1]), pk4_fp8(a10 * gpl[2]), pk4_fp8(a11 * gpl[3])};
                else { *(u32x4*)(rowp) = pack8(a00, a01); if (!(MODE == 0 && u.pn == 3 && wc >= 2)) *(u32x4*)(rowp + HALF) = pack8(a10, a11); }
                if (MODE == 1) { float s = (sq4(a00) + sq4(a01)) + (sq4(a10) + sq4(a11)); s = red_fq(s); if (fq == 0) ssq[(size_t)row * 16 + u.pn * 4 + wc] = s; }
                else if (u.pn == 0) { float s = (sq4(a00) + sq4(a01)) + (sq4(a10) + sq4(a11)); s = red_fq(s); if (fq == 0) ssq[(size_t)row * 8 + wc] = s; }
                else if (u.pn == 1) { float s = sq4(a00) + sq4(a01); s = red_fq(s); if (fq == 0) ssq[(size_t)row * 8 + 4 + wc] = s; } }
    }
};
struct EpiQ {
    static constexpr bool PERM = true; static constexpr int MIDK = 0; static constexpr int NPRE = 8, PRE_BASE = 138240;
    bf16_t* Q; const float* ssq; const float* cs;
    __device__ __forceinline__ const char* pre_src(const Unit& u, int piece, int lane) const { return (const char*)(ssq + ((size_t)u.pm * BM + piece * 32) * 8) + lane * 16; }
    __device__ __forceinline__ void operator()(const Acc& acc, const Unit& u, int wr, int wc, int fr, int fq, const LAS unsigned char* pre) const {
        const int row0 = u.pm * BM + wr * 64 + fr;
#pragma unroll
        for (int ai = 0; ai < 2; ++ai)
#pragma unroll
            for (int m = 0; m < 4; ++m) { const int row = row0 + ai * HALF + m * 16; const f32x4 sv = *(const LAS f32x4*)(pre + (wr * 64 + fr + ai * HALF + m * 16) * 32);
                const float rs = rsqrtf(((sv[0] + sv[1]) + (sv[2] + sv[3])) * (1.f / QL) + EPS); const int b = row / SEQ, s = row % SEQ;
#pragma unroll
                for (int bj = 0; bj < 2; ++bj) { const int cv = u.pn * BM + bj * HALF + wc * 32 + 8 * fq; const int h = cv / DQK, d = cv % DQK;
                    f32x4 v0 = acc[ai][bj][m][0] * rs, v1 = acc[ai][bj][m][1] * rs;
                    if (d >= DN) { const int i0 = (d - DN) >> 1; const f32x4 c = *(const f32x4*)(cs + (size_t)row * 64 + i0), sn = *(const f32x4*)(cs + (size_t)row * 64 + 32 + i0);
                        const f32x4 r0 = {v0[0] * c[0] - v0[1] * sn[0], v0[0] * sn[0] + v0[1] * c[0], v0[2] * c[1] - v0[3] * sn[1], v0[2] * sn[1] + v0[3] * c[1]};
                        const f32x4 r1 = {v1[0] * c[2] - v1[1] * sn[2], v1[0] * sn[2] + v1[1] * c[2], v1[2] * c[3] - v1[3] * sn[3], v1[2] * sn[3] + v1[3] * c[3]};
                        v0 = r0; v1 = r1; }
                    *(u32x4*)(Q + ((size_t)(b * NH + h) * SEQ + s) * DQK + d) = pack8(v0, v1); } }
    }
};
struct EpiKV {
    static constexpr bool PERM = true; static constexpr int MIDK = 0; static constexpr int NPRE = 8, PRE_BASE = 138240;
    bf16_t* Kc; bf16_t* Vc; const float* ssq;
    __device__ __forceinline__ const char* pre_src(const Unit& u, int piece, int lane) const { return (const char*)(ssq + ((size_t)u.pm * BM + piece * 32) * 8) + lane * 16; }
    __device__ __forceinline__ void operator()(const Acc& acc, const Unit& u, int wr, int wc, int fr, int fq, const LAS unsigned char* pre) const {
        const int row0 = u.pm * BM + wr * 64 + fr, d = wc * 32 + 8 * fq, h = u.pn;
#pragma unroll
        for (int ai = 0; ai < 2; ++ai)
#pragma unroll
            for (int m = 0; m < 4; ++m) { const int row = row0 + ai * HALF + m * 16; const f32x4 sv = *(const LAS f32x4*)(pre + (wr * 64 + fr + ai * HALF + m * 16) * 32 + 16);
                const float rs = rsqrtf(((sv[0] + sv[1]) + (sv[2] + sv[3])) * (1.f / KVL) + EPS); const int b = row / SEQ, s = row % SEQ; const size_t t = (size_t)(b * NH + h) * SEQ + s;
                *(u32x4*)(Kc + t * DQK + d) = pack8(acc[ai][0][m][0] * rs, acc[ai][0][m][1] * rs);
                *(u32x4*)(Vc + t * DV + d) = pack8(acc[ai][1][m][0] * rs, acc[ai][1][m][1] * rs); }
    }
};
struct EpiWo {
    static constexpr bool PERM = true; static constexpr int MIDK = 4; static constexpr int NPRE = 5, PRE_BASE = 138240;
    const bf16_t* x; bf16_t* HBF; unsigned char* X8; const float* assq; float* ssq1; const float* gmoe;
    __device__ __forceinline__ const char* pre_src(const Unit& u, int piece, int lane) const {
        if (piece < 4) return (const char*)(assq + ((size_t)u.pm * BM + piece * 64) * 4) + lane * 16;
        return (const char*)(gmoe + u.pn * BM) + lane * 16; }
    __device__ __forceinline__ void mid(Acc& acc, const Unit& u, int wr, int wc, int fr, int fq, const LAS unsigned char* pre) const {
        const LAS unsigned char* pa = pre + (wr * 64 + fr) * 16;
#pragma unroll
        for (int ai = 0; ai < 2; ++ai)
#pragma unroll
            for (int m = 0; m < 4; ++m) { const f32x4 sv = *(const LAS f32x4*)(pa + (ai * HALF + m * 16) * 16);
                const float rs = rsqrtf(((sv[0] + sv[1]) + (sv[2] + sv[3])) * (1.f / 512.f) + EPS) * (1.f / 32.f);
#pragma unroll
                for (int bj = 0; bj < 2; ++bj)
#pragma unroll
                    for (int n = 0; n < 2; ++n) acc[ai][bj][m][n] = acc[ai][bj][m][n] * rs; }
    }
    __device__ __forceinline__ void operator()(const Acc& acc, const Unit& u, int wr, int wc, int fr, int fq, const LAS unsigned char* pre) const {
        const int row0 = u.pm * BM + wr * 64 + fr, col0 = u.pn * BM + wc * 32 + 8 * fq; const LAS float* pg_ = (const LAS float*)(pre + 4096) + wc * 32 + 8 * fq;
        f32x4 gn[2][2];
#pragma unroll
        for (int bj = 0; bj < 2; ++bj) { gn[bj][0] = *(const LAS f32x4*)(pg_ + bj * HALF); gn[bj][1] = *(const LAS f32x4*)(pg_ + bj * HALF + 4); }
#pragma unroll
        for (int ai = 0; ai < 2; ++ai) { u32x4 xv[4][2];
#pragma unroll
            for (int m = 0; m < 4; ++m) { const size_t off = (size_t)(row0 + ai * HALF + m * 16) * DM + col0;
#pragma unroll
                for (int bj = 0; bj < 2; ++bj) xv[m][bj] = *(const u32x4*)(x + off + bj * HALF); }
            asm volatile("" ::: "memory");
#pragma unroll
            for (int m = 0; m < 4; ++m) { const int row = row0 + ai * HALF + m * 16; const size_t off = (size_t)row * DM + col0; float ss = 0.f;
#pragma unroll
                for (int bj = 0; bj < 2; ++bj) { const u32x4 xq = xv[m][bj]; const f32x4 h0 = (f32x4){blo(xq.x), bhi(xq.x), blo(xq.y), bhi(xq.y)} + acc[ai][bj][m][0] * (1.f / 64.f), h1 = (f32x4){blo(xq.z), bhi(xq.z), blo(xq.w), bhi(xq.w)} + acc[ai][bj][m][1] * (1.f / 64.f);
                    *(u32x4*)(HBF + off + bj * HALF) = pack8(h0, h1); *(u32x2*)(X8 + off + bj * HALF) = (u32x2){pk4_fp8(h0 * gn[bj][0]), pk4_fp8(h1 * gn[bj][1])}; ss += sq4(h0) + sq4(h1); }
                ss = red_fq(ss); if (fq == 0) ssq1[(size_t)row * 16 + u.pn * 4 + wc] = ss; }
            asm volatile("" ::: "memory"); }
    }
};
__device__ __forceinline__ f32x4 sigmoid4(f32x4 a) { const f32x4 t = a * -1.44269504f; f32x4 e; e[0] = __builtin_amdgcn_exp2f(t[0]); e[1] = __builtin_amdgcn_exp2f(t[1]); e[2] = __builtin_amdgcn_exp2f(t[2]); e[3] = __builtin_amdgcn_exp2f(t[3]);
    const f32x4 d = e + 1.0f; f32x4 r; r[0] = __builtin_amdgcn_rcpf(d[0]); r[1] = __builtin_amdgcn_rcpf(d[1]); r[2] = __builtin_amdgcn_rcpf(d[2]); r[3] = __builtin_amdgcn_rcpf(d[3]); return r; }
__device__ __forceinline__ f32x2 swiglu2(f32x2 g, f32x2 u) {
    g.x = fminf(g.x, 7.f); g.y = fminf(g.y, 7.f); u.x = __builtin_amdgcn_fmed3f(u.x, -7.f, 7.f); u.y = __builtin_amdgcn_fmed3f(u.y, -7.f, 7.f);
    const f32x2 t = g * -2.45546696f; f32x2 e; e.x = __builtin_amdgcn_exp2f(t.x); e.y = __builtin_amdgcn_exp2f(t.y); const f32x2 d = e + 1.0f; f32x2 r; r.x = __builtin_amdgcn_rcpf(d.x); r.y = __builtin_amdgcn_rcpf(d.y);
    const f32x2 gs = g * r; return u * gs + gs; }
__device__ __forceinline__ float swiglu_f(float g, float u) { g = fminf(g, 7.f); u = __builtin_amdgcn_fmed3f(u, -7.f, 7.f); const float gs = g * __builtin_amdgcn_rcpf(1.f + __builtin_amdgcn_exp2f(g * -2.45546696f)); return fmaf(u, gs, gs); }
constexpr float WSCALE = 64.f, WINV = 1.f / 64.f;
struct EpiMoe1 {
    static constexpr bool PERM = true; static constexpr int MIDK = 0; static constexpr int NPRE = 2, PRE_BASE = 157696;
    unsigned char* HB; const float* b1; const float* rowrs;
    __device__ __forceinline__ const char* pre_src(const Unit& u, int piece, int lane) const {
        if (piece == 0) return (const char*)(rowrs + (size_t)u.pm * BM) + lane * 16;
        return (const char*)(b1 + (size_t)u.e * 2048 + (lane >> 5) * 1024 + u.pn * HALF) + (lane & 31) * 16; }
    __device__ __forceinline__ void operator()(const Acc& acc, const Unit& u, int wr, int wc, int fr, int fq, const LAS unsigned char* pre) const {
        const int row0 = u.pm * BM + wr * 64 + fr, j0 = u.pn * HALF + wc * 32 + 8 * fq; const LAS float* prs = (const LAS float*)pre + wr * 64 + fr; const LAS float* pbs = (const LAS float*)(pre + 1024) + wc * 32 + 8 * fq;
        const f32x4 g0 = *(const LAS f32x4*)pbs, g1 = *(const LAS f32x4*)(pbs + 4), u0 = *(const LAS f32x4*)(pbs + 128), u1 = *(const LAS f32x4*)(pbs + 132);
        float rsv[2][4];
#pragma unroll
        for (int ai = 0; ai < 2; ++ai)
#pragma unroll
            for (int m = 0; m < 4; ++m) rsv[ai][m] = prs[ai * HALF + m * 16];
        asm volatile("" ::: "memory");
#pragma unroll
        for (int ai = 0; ai < 2; ++ai)
#pragma unroll
            for (int m = 0; m < 4; ++m) { const float rs = rsv[ai][m] * WINV;
                const f32x4 a0 = acc[ai][0][m][0] * rs + g0, a1 = acc[ai][0][m][1] * rs + g1, c0 = acc[ai][1][m][0] * rs + u0, c1 = acc[ai][1][m][1] * rs + u1; f32x4 r0, r1;
#pragma unroll
                for (int j = 0; j < 4; j += 2) { const f32x2 s0 = swiglu2((f32x2){a0[j], a0[j + 1]}, (f32x2){c0[j], c0[j + 1]}), s1 = swiglu2((f32x2){a1[j], a1[j + 1]}, (f32x2){c1[j], c1[j + 1]}); r0[j] = s0.x; r0[j + 1] = s0.y; r1[j] = s1.x; r1[j + 1] = s1.y; }
                *(u32x2*)(HB + (size_t)(row0 + ai * HALF + m * 16) * DE + j0) = (u32x2){pk4_fp8(r0), pk4_fp8(r1)}; }
    }
};
struct EpiMoe2 {
    static constexpr bool PERM = true; static constexpr int MIDK = 0; static constexpr int NPRE = 3, PRE_BASE = 157696;
    unsigned char* Y; const float* b2; const int* rowslot; const float* rowgate;
    __device__ __forceinline__ const char* pre_src(const Unit& u, int piece, int lane) const {
        if (piece == 0) return (const char*)(rowslot + (size_t)u.pm * BM) + lane * 16;
        if (piece == 1) return (const char*)(rowgate + (size_t)u.pm * BM) + lane * 16;
        return (const char*)(b2 + (size_t)u.e * DM + u.pn * BM) + lane * 16; }
    __device__ __forceinline__ void operator()(const Acc& acc, const Unit& u, int wr, int wc, int fr, int fq, const LAS unsigned char* pre) const {
        const int col0 = u.pn * BM + wc * 64 + 16 * fq; const LAS float* bb = (const LAS float*)(pre + 2048) + wc * 64 + 16 * fq;
        const LAS int* psl = (const LAS int*)pre + wr * 64 + fr; const LAS float* pgt = (const LAS float*)(pre + 1024) + wr * 64 + fr;
        f32x4 bv[2][2];
#pragma unroll
        for (int bj = 0; bj < 2; ++bj)
#pragma unroll
            for (int n = 0; n < 2; ++n) bv[bj][n] = *(const LAS f32x4*)(bb + bj * 8 + 4 * n);
        float gtv[2][4]; int slv[2][4];
#pragma unroll
        for (int ai = 0; ai < 2; ++ai)
#pragma unroll
            for (int m = 0; m < 4; ++m) { gtv[ai][m] = pgt[ai * HALF + m * 16]; slv[ai][m] = psl[ai * HALF + m * 16]; }
        asm volatile("" ::: "memory");
#pragma unroll
        for (int ai = 0; ai < 2; ++ai)
#pragma unroll
            for (int m = 0; m < 4; ++m) { const float gt = gtv[ai][m]; unsigned char* yp = Y + (size_t)slv[ai][m] * DM + col0;
                *(u32x4*)yp = (u32x4){pk4_fp8((acc[ai][0][m][0] * WINV + bv[0][0]) * gt), pk4_fp8((acc[ai][0][m][1] * WINV + bv[0][1]) * gt), pk4_fp8((acc[ai][1][m][0] * WINV + bv[1][0]) * gt), pk4_fp8((acc[ai][1][m][1] * WINV + bv[1][1]) * gt)}; }
    }
};
struct EpiPle {
    static constexpr bool PERM = true; static constexpr int MIDK = 0; static constexpr int NPRE = 0;
    const bf16_t* H2; bf16_t* H3; const bf16_t* pler; const float* rpv; const float* rs2; const float* pg; float* fssq;
    __device__ __forceinline__ void operator()(const Acc& acc, const Unit& u, int wr, int wc, int fr, int fq) const {
        const int row0 = u.pm * BM + wr * 64 + fr, col0 = u.pn * BM + wc * 32 + 8 * fq;
        f32x4 gv[2][2];
#pragma unroll
        for (int bj = 0; bj < 2; ++bj)
#pragma unroll
            for (int n = 0; n < 2; ++n) gv[bj][n] = *(const f32x4*)(pg + col0 + bj * HALF + n * 4);
#pragma unroll
        for (int am = 0; am < 4; ++am) { const int ai = am >> 1; u32x4 hq[2][2]; u32x2 pq[2][2]; float r2v[2], rpq[2];
#pragma unroll
            for (int mm = 0; mm < 2; ++mm) { const int row = row0 + ai * HALF + ((am & 1) * 2 + mm) * 16; const size_t off = (size_t)row * DM + col0; r2v[mm] = rs2[row] * WINV; rpq[mm] = rpv[row];
#pragma unroll
                for (int bj = 0; bj < 2; ++bj) { hq[mm][bj] = *(const u32x4*)(H2 + off + bj * HALF); pq[mm][bj] = *(const u32x2*)((const unsigned char*)pler + off + bj * HALF); } }
            asm volatile("" ::: "memory");
#pragma unroll
            for (int mm = 0; mm < 2; ++mm) { const int m = (am & 1) * 2 + mm; const int row = row0 + ai * HALF + m * 16; const size_t off = (size_t)row * DM + col0; const float r2 = r2v[mm], rp = rpq[mm]; float ss = 0.f;
#pragma unroll
                for (int bj = 0; bj < 2; ++bj) { const size_t o = off + bj * HALF; const u32x4 hv = hq[mm][bj]; const u32x2 pr = pq[mm][bj];
                    const f32x4 h0 = {blo(hv.x), bhi(hv.x), blo(hv.y), bhi(hv.y)}, h1 = {blo(hv.z), bhi(hv.z), blo(hv.w), bhi(hv.w)};
                    const f32x2 qa = __builtin_amdgcn_cvt_pk_f32_fp8(pr.x, false), qb = __builtin_amdgcn_cvt_pk_f32_fp8(pr.x, true), qc = __builtin_amdgcn_cvt_pk_f32_fp8(pr.y, false), qd = __builtin_amdgcn_cvt_pk_f32_fp8(pr.y, true);
                    const f32x4 q0 = {qa[0], qa[1], qb[0], qb[1]}, q1 = {qc[0], qc[1], qd[0], qd[1]};
                    const f32x4 r0 = h0 + sigmoid4(acc[ai][bj][m][0] * r2) * (q0 * rp), r1 = h1 + sigmoid4(acc[ai][bj][m][1] * r2) * (q1 * rp);
                    *(u32x4*)(H3 + o) = pack8(r0, r1); ss += sq4(r0) + sq4(r1); }
                ss = red_fq(ss); if (fq == 0) fssq[(size_t)row * 16 + u.pn * 4 + wc] = ss; }
            asm volatile("" ::: "memory"); }
    }
};
struct EpiPleFinal {
    static constexpr bool PERM = true; static constexpr int MIDK = 0; static constexpr int NPRE = 0;
    const bf16_t* H2; float* out; const bf16_t* pler; const float* rpv; const float* rs2; const float* pg; const float* gf; float* xs; unsigned* cnt; unsigned* tmo; LAS unsigned char* lds;
    __device__ __forceinline__ void operator()(Acc& acc, const Unit& u, int wr, int wc, int fr, int fq) const {
        const int row0 = u.pm * BM + wr * 64 + fr, col0 = u.pn * BM + wc * 32 + 8 * fq;
        LAS float* P = (LAS float*)(lds + STG_OFF); LAS float* S = P + 1024; const int tid = (wr * 4 + wc) * 64 + fq * 16 + fr;
#define PF_BAR() asm volatile("s_waitcnt lgkmcnt(0)\n\ts_barrier" ::: "memory")
        {
          u32x4 hqA[2][2], hqB[2][2]; u32x2 pqA[2][2], pqB[2][2]; float r2A[2], rpA[2], r2B[2], rpB[2];
#define PF_LOAD(HQ, PQ, R2, RP, am) do { _Pragma("unroll") for (int mm = 0; mm < 2; ++mm) { const int row = row0 + ((am) >> 1) * HALF + (((am) & 1) * 2 + mm) * 16; const size_t off = (size_t)row * DM + col0; R2[mm] = rs2[row] * WINV; RP[mm] = rpv[row]; \
              _Pragma("unroll") for (int bj = 0; bj < 2; ++bj) { HQ[mm][bj] = *(const u32x4*)(H2 + off + bj * HALF); PQ[mm][bj] = *(const u32x2*)((const unsigned char*)pler + off + bj * HALF); } } asm volatile("" ::: "memory"); } while (0)
#define PF_COMP(HQ, PQ, R2, RP, am) do { constexpr int ai = (am) >> 1; _Pragma("unroll") for (int mm = 0; mm < 2; ++mm) { const int m = ((am) & 1) * 2 + mm; const float r2 = R2[mm], rp = RP[mm]; float ss = 0.f; \
              _Pragma("unroll") for (int bj = 0; bj < 2; ++bj) { const u32x4 hv = HQ[mm][bj]; const u32x2 pr = PQ[mm][bj]; \
                  const f32x4 h0 = {blo(hv.x), bhi(hv.x), blo(hv.y), bhi(hv.y)}, h1 = {blo(hv.z), bhi(hv.z), blo(hv.w), bhi(hv.w)}; \
                  const f32x2 qa = __builtin_amdgcn_cvt_pk_f32_fp8(pr.x, false), qb = __builtin_amdgcn_cvt_pk_f32_fp8(pr.x, true), qc = __builtin_amdgcn_cvt_pk_f32_fp8(pr.y, false), qd = __builtin_amdgcn_cvt_pk_f32_fp8(pr.y, true); \
                  const f32x4 q0 = {qa[0], qa[1], qb[0], qb[1]}, q1 = {qc[0], qc[1], qd[0], qd[1]}; \
                  const f32x4 r0 = h0 + sigmoid4(acc[ai][bj][m][0] * r2) * (q0 * rp), r1 = h1 + sigmoid4(acc[ai][bj][m][1] * r2) * (q1 * rp); \
                  acc[ai][bj][m][0] = r0; acc[ai][bj][m][1] = r1; ss += sq4(r0) + sq4(r1); } \
              ss = red_fq(ss); if (fq == 0) P[(ai * HALF + wr * 64 + m * 16 + fr) * 4 + wc] = ss; } asm volatile("" ::: "memory"); } while (0)
          PF_LOAD(hqA, pqA, r2A, rpA, 0);
          PF_LOAD(hqB, pqB, r2B, rpB, 1); PF_COMP(hqA, pqA, r2A, rpA, 0);
          PF_LOAD(hqA, pqA, r2A, rpA, 2); PF_COMP(hqB, pqB, r2B, rpB, 1);
          PF_LOAD(hqB, pqB, r2B, rpB, 3); PF_COMP(hqA, pqA, r2A, rpA, 2);
          PF_COMP(hqB, pqB, r2B, rpB, 3);
#undef PF_LOAD
#undef PF_COMP
        }
        PF_BAR();
        if (tid < 256) { const f32x4 p4 = *(const LAS f32x4*)(P + tid * 4); __hip_atomic_store(xs + (size_t)(u.pm * 4 + u.pn) * 256 + tid, (p4[0] + p4[1]) + (p4[2] + p4[3]), __ATOMIC_RELAXED, __HIP_MEMORY_SCOPE_AGENT); }
        asm volatile("s_waitcnt vmcnt(0)" ::: "memory");
        PF_BAR();
        if (tid < 64) {
            if (tid == 0) (void)__hip_atomic_fetch_add(cnt + 64 * u.pm, 1u, __ATOMIC_RELAXED, __HIP_MEMORY_SCOPE_AGENT);
            unsigned sp = 0;
            while ((unsigned)__builtin_amdgcn_readfirstlane(__hip_atomic_load(cnt + 64 * u.pm, __ATOMIC_RELAXED, __HIP_MEMORY_SCOPE_AGENT)) < 4u) {
                __builtin_amdgcn_s_sleep(2); if (++sp > (1u << 22)) { if (tid == 0) __hip_atomic_store(tmo, 1u, __ATOMIC_RELAXED, __HIP_MEMORY_SCOPE_AGENT); break; } }
            __builtin_amdgcn_fence(__ATOMIC_ACQUIRE, "agent");
            asm volatile("s_waitcnt vmcnt(0)" ::: "memory"); }
        PF_BAR();
        if (tid < 256) { float t = 0.f;
#pragma unroll
            for (int q = 0; q < 4; ++q) t += __hip_atomic_load(xs + (size_t)(u.pm * 4 + q) * 256 + tid, __ATOMIC_RELAXED, __HIP_MEMORY_SCOPE_AGENT);
            S[tid] = rsqrtf(t * (1.f / DM) + EPS); }
        PF_BAR();
        { f32x4 gq[2][2];
#pragma unroll
          for (int bj = 0; bj < 2; ++bj)
#pragma unroll
            for (int n = 0; n < 2; ++n) gq[bj][n] = *(const f32x4*)(gf + col0 + bj * HALF + n * 4);
#pragma unroll
          for (int ai = 0; ai < 2; ++ai)
#pragma unroll
            for (int m = 0; m < 4; ++m) { const float rs = S[ai * HALF + wr * 64 + m * 16 + fr]; float* op = out + (size_t)(row0 + ai * HALF + m * 16) * DM + col0;
#pragma unroll
                for (int bj = 0; bj < 2; ++bj) { *(f32x4*)(op + bj * HALF) = acc[ai][bj][m][0] * rs * gq[bj][0]; *(f32x4*)(op + bj * HALF + 4) = acc[ai][bj][m][1] * rs * gq[bj][1]; } } }
        PF_BAR();
#undef PF_BAR
    }
};
}

namespace att {
typedef float f32x16 __attribute__((ext_vector_type(16)));
typedef short s16x4 __attribute__((ext_vector_type(4)));
constexpr int QBLK = 32, KVBLK = 64, QB = 256;
constexpr int SHM_K = KVBLK * DQK * 2, SHM_V = KVBLK * DV * 2;
constexpr int L_V = 0, L_K = 2 * SHM_V, L_WS = L_K + 2 * SHM_K, L_END = L_WS + NWAVES * 256;
constexpr float THR = 8.f;
#define KSWZ(row, colB) ((row) * 384 + ((colB) ^ (((row) & 7) << 4)))
#define SBAR() __builtin_amdgcn_sched_barrier(0)
__device__ __forceinline__ int v_st(int k, int c) { const int kk = (k & ~0xC) | ((k & 4) << 1) | ((k & 8) >> 1); return ((kk >> 3) * 4 + (c >> 5)) * 512 + ((kk & 7) * 32 + (c & 31)) * 2; }
__device__ __forceinline__ int v_rd_base(int lane) { return ((lane & 3) << 3) | (((lane >> 2) & 3) << 6) | (((lane >> 4) & 1) << 5) | (((lane >> 5) & 1) << 8); }
constexpr int v_rd_off(int d0, int ks, int half) { return d0 * 512 + ks * 4096 + half * 2048; }
__device__ __forceinline__ int crow(int r, int hi) { return (r & 3) + 8 * (r >> 2) + 4 * hi; }
typedef __bf16 bf16x2_t __attribute__((ext_vector_type(2)));
__device__ __forceinline__ unsigned cvtpk(float lo, float hi) { f32x2 v = {lo, hi}; bf16x2_t b = __builtin_convertvector(v, bf16x2_t); return __builtin_bit_cast(unsigned, b); }

__device__ __forceinline__ void qkt(f32x16& p0, f32x16& p1, const LAS unsigned char* Kbuf, int r32, int hi, const bf16x8* qr) {
    p0 = f32x16{}; p1 = f32x16{};
    const LAS unsigned char* kb[4];
#pragma unroll
    for (int dd = 0; dd < 4; ++dd) kb[dd] = Kbuf + KSWZ(r32, (dd * 16 + hi * 8) * 2);
    bf16x8 kf[2][2];
#define KLD(d) do { const LAS unsigned char* a = kb[(d) & 3] + ((d) >> 2) * 128; kf[(d) & 1][0] = *(const LAS bf16x8*)a; kf[(d) & 1][1] = *(const LAS bf16x8*)(a + 32 * 384); } while (0)
    KLD(0);
#pragma unroll
    for (int d0 = 0; d0 < 12; ++d0) { if (d0 + 1 < 12) KLD(d0 + 1);
        p0 = __builtin_amdgcn_mfma_f32_32x32x16_bf16(kf[d0 & 1][0], qr[d0], p0, 0, 0, 0);
        p1 = __builtin_amdgcn_mfma_f32_32x32x16_bf16(kf[d0 & 1][1], qr[d0], p1, 0, 0, 0); }
#undef KLD
    __builtin_amdgcn_sched_group_barrier(0x100, 2, 0);
#pragma unroll
    for (int d0 = 0; d0 < 11; ++d0) { __builtin_amdgcn_sched_group_barrier(0x100, 2, 0); __builtin_amdgcn_sched_group_barrier(0x008, 2, 0); }
    __builtin_amdgcn_sched_group_barrier(0x008, 2, 0);
}
__device__ __forceinline__ void pv_tile(f32x16* o, int vb0, bf16x8 pa0, bf16x8 pa1, bf16x8 pa2, bf16x8 pa3) {
#define TRRD(dst, off) asm volatile("ds_read_b64_tr_b16 %0, %1 offset:%2" : "=&v"(dst) : "v"(vb0), "i"(off) : "memory")
#define PV_RD(S_, d0) do { constexpr int b_ = v_rd_off(d0, 0, 0); \
        TRRD(S_[0], b_); TRRD(S_[1], b_ + 2048); TRRD(S_[2], b_ + 4096); TRRD(S_[3], b_ + 6144); TRRD(S_[4], b_ + 8192); TRRD(S_[5], b_ + 10240); TRRD(S_[6], b_ + 12288); TRRD(S_[7], b_ + 14336); } while (0)
#define PV_MM(S_, d0) do { \
        o[d0] = __builtin_amdgcn_mfma_f32_32x32x16_bf16(pa0, (bf16x8){S_[0][0], S_[0][1], S_[0][2], S_[0][3], S_[1][0], S_[1][1], S_[1][2], S_[1][3]}, o[d0], 0, 0, 0); \
        o[d0] = __builtin_amdgcn_mfma_f32_32x32x16_bf16(pa1, (bf16x8){S_[2][0], S_[2][1], S_[2][2], S_[2][3], S_[3][0], S_[3][1], S_[3][2], S_[3][3]}, o[d0], 0, 0, 0); \
        o[d0] = __builtin_amdgcn_mfma_f32_32x32x16_bf16(pa2, (bf16x8){S_[4][0], S_[4][1], S_[4][2], S_[4][3], S_[5][0], S_[5][1], S_[5][2], S_[5][3]}, o[d0], 0, 0, 0); \
        o[d0] = __builtin_amdgcn_mfma_f32_32x32x16_bf16(pa3, (bf16x8){S_[6][0], S_[6][1], S_[6][2], S_[6][3], S_[7][0], S_[7][1], S_[7][2], S_[7][3]}, o[d0], 0, 0, 0); } while (0)
    s16x4 A_[8], B_[8];
    PV_RD(A_, 0);
    PV_RD(B_, 1); asm volatile("s_waitcnt lgkmcnt(8)" ::: "memory"); SBAR(); PV_MM(A_, 0); SBAR();
    PV_RD(A_, 2); asm volatile("s_waitcnt lgkmcnt(8)" ::: "memory"); SBAR(); PV_MM(B_, 1); SBAR();
    PV_RD(B_, 3); asm volatile("s_waitcnt lgkmcnt(8)" ::: "memory"); SBAR(); PV_MM(A_, 2); SBAR();
    asm volatile("s_waitcnt lgkmcnt(0)" ::: "memory"); SBAR(); PV_MM(B_, 3);
#undef PV_RD
#undef PV_MM
#undef TRRD
}
struct ConvJob { const float* w1; const float* w2; const float* gain; unsigned char* W1T; unsigned char* W2T; int gw, ngw; };
constexpr int CV_N1 = NE * 32 * 64, CV_N2 = NE * 32 * 32, CV_TOTAL = CV_N1 + CV_N2;
__device__ __forceinline__ int cv_cmap2(int n) { const int t = n & ~255, v = n & 255; return t + 64 * ((v >> 5) & 3) + 16 * ((v >> 3) & 3) + 8 * (v >> 7) + (v & 7); }
__device__ __forceinline__ int cv_cmap1(int n) { const int pn = n >> 8, half = (n >> 7) & 1, jj = n & 127; return half * 1024 + pn * 128 + jj; }
#define CV_DECODE(idx) \
    const bool cv_on = (idx) < CV_TOTAL; const bool cv_is1 = (idx) < CV_N1; const int cv_r = cv_is1 ? (idx) : (idx) - CV_N1; \
    const int cv_sh = cv_is1 ? 6 : 5, cv_ld = cv_is1 ? 2048 : 1024; const int cv_e = cv_r >> (cv_sh + 5), cv_q = cv_r & ((32 << cv_sh) - 1), cv_k0 = 32 * (cv_q >> cv_sh), cv_n0 = 32 * (cv_q & ((1 << cv_sh) - 1)); \
    const float* cv_src = (cv_is1 ? cj.w1 + (size_t)cv_e * 1024 * 2048 : cj.w2 + (size_t)cv_e * 1024 * 1024); \
    const int cv_c = cv_is1 ? cv_cmap1(cv_n0 + 4 * (lane & 7)) : cv_cmap2(cv_n0 + 4 * (lane & 7));
#define CV_LOAD() do { if (cv_on) { const char* cvb = (const char*)(cv_src + (size_t)cv_k0 * cv_ld); const unsigned cvo = (unsigned)(((lane >> 3) * cv_ld + cv_c) * 4);     \
        LAS unsigned char* scrb = lds + L_END + wid * 4224;     \
        _Pragma("unroll") for (int i = 0; i < 4; ++i) __builtin_amdgcn_global_load_lds((const unsigned*)(cvb + (size_t)(8 * i) * cv_ld * 4 + cvo), (LAS unsigned*)(scrb + i * 1056), 16, 0, 0); } } while (0)
#define CV_SV(j) (s[(2 * cc + ((j) >> 3)) * 264 + ((j) & 7) * 32])
#define CV_STORE() do { if (cv_on) { const LAS float* scr = (const LAS float*)(lds + L_END + wid * 4224); \
        { const int n = lane >> 1, cc = lane & 1; const LAS float* s = scr + n; u32x4 o; \
          o.x = pg8::pk4_fp8((f32x4){CV_SV(0), CV_SV(1), CV_SV(2), CV_SV(3)} * 64.f); o.y = pg8::pk4_fp8((f32x4){CV_SV(4), CV_SV(5), CV_SV(6), CV_SV(7)} * 64.f); \
          o.z = pg8::pk4_fp8((f32x4){CV_SV(8), CV_SV(9), CV_SV(10), CV_SV(11)} * 64.f); o.w = pg8::pk4_fp8((f32x4){CV_SV(12), CV_SV(13), CV_SV(14), CV_SV(15)} * 64.f); \
          unsigned char* dst = (cv_is1 ? cj.W1T + (size_t)cv_e * 2048 * 1024 : cj.W2T + (size_t)cv_e * 1024 * 1024) + (size_t)(cv_n0 + n) * 1024 + cv_k0 + 16 * cc; *(u32x4*)dst = o; } \
        asm volatile("s_waitcnt lgkmcnt(0)" ::: "memory"); } } while (0)
__device__ __forceinline__ void attn_block(int bh, int qb, const bf16_t* __restrict__ Q, const bf16_t* __restrict__ K, const bf16_t* __restrict__ V, bf16_t* __restrict__ MIX, float* __restrict__ ASSQ, LAS unsigned char* lds, const int wid, const ConvJob& cj, int& tseq) {
    const int lane = lane_id(), r32 = lane & 31, hi = lane >> 5;
    const int b = bh / NH, h = bh % NH;
    const bf16_t* Qw = Q + ((size_t)bh * SEQ + qb * QB + wid * QBLK + r32) * DQK;
    const bf16_t* Kh = K + (size_t)bh * SEQ * DQK; const bf16_t* Vh = V + (size_t)bh * SEQ * DV;
    bf16x8 qr[12];
#pragma unroll
    for (int d0 = 0; d0 < 12; ++d0) qr[d0] = *(const bf16x8*)(Qw + d0 * 16 + hi * 8);
    const int NT = 4 * qb + 4, qlo = qb * QB + wid * QBLK, qm = qlo + r32 - 4 * hi;
    LAS unsigned char* V_lds = lds + L_V; LAS unsigned char* K_lds = lds + L_K;
    LAS float* wsf = (LAS float*)(lds + L_WS) + wid * 64; LAS float* li_l = wsf; LAS float* al_l = wsf + 32;
    unsigned ksrc[3], vsrc[2];
#pragma unroll
    for (int i = 0; i < 3; ++i) { const int off = ((wid + 8 * i) * 64 + lane) * 16, row = off / 384, wb = off % 384, seg = wb >> 7, cpos = (wb & 127) >> 4; ksrc[i] = (unsigned)(row * 384 + seg * 128 + ((cpos ^ (row & 7)) << 4)); }
#pragma unroll
    for (int i = 0; i < 2; ++i) { const int off = ((wid + 8 * i) * 64 + lane) * 16, st = off >> 9, o_ = off & 511, kk = (st >> 2) * 8 + (o_ >> 6), c = (st & 3) * 32 + ((o_ & 63) >> 1);
        const int k = (kk & ~0xC) | ((kk & 4) << 1) | ((kk & 8) >> 1); vsrc[i] = (unsigned)(k * 256 + c * 2); }
    const int vb0 = (int)(unsigned)(uintptr_t)V_lds + v_rd_base(lane);
#define ADMA_K(t, bf) do { const char* kp = (const char*)(Kh + (size_t)(t) * KVBLK * DQK); \
        _Pragma("unroll") for (int i = 0; i < 3; ++i) __builtin_amdgcn_global_load_lds((const unsigned*)(kp + ksrc[i]), (LAS unsigned*)(K_lds + (bf) * SHM_K + (wid + 8 * i) * 1024), 16, 0, 0); } while (0)
#define ADMA_V(t, bf) do { const char* vp = (const char*)(Vh + (size_t)(t) * KVBLK * DV); \
        _Pragma("unroll") for (int i = 0; i < 2; ++i) __builtin_amdgcn_global_load_lds((const unsigned*)(vp + vsrc[i]), (LAS unsigned*)(V_lds + (bf) * SHM_V + (wid + 8 * i) * 1024), 16, 0, 0); } while (0)
#define PK4(P, B_, OUT) do { unsigned a0 = cvtpk(P[B_ + 0], P[B_ + 1]), a1 = cvtpk(P[B_ + 2], P[B_ + 3]); \
        unsigned b0 = cvtpk(P[B_ + 4], P[B_ + 5]), b1 = cvtpk(P[B_ + 6], P[B_ + 7]); \
        auto r0 = __builtin_amdgcn_permlane32_swap(a0, b0, false, false); auto r1 = __builtin_amdgcn_permlane32_swap(a1, b1, false, false); \
        u32x4 w = {r0[0], r1[0], r0[1], r1[1]}; OUT = __builtin_bit_cast(bf16x8, w); } while (0)
    float m_reg = -1e30f, l_reg = 0.f; f32x16 o[4] = {}; int cv_pend = -1;
    const int ph = wid >> 2; bool st_steady = false, st_had = false;
#define STAGE_SLOT(t) do { const int tk = (t) + 2; const bool kv_full = tk < NT;     \
        if (tk < NT) ADMA_K(tk, tk & 1); \
        const bool had_pend = cv_pend >= 0; \
        if (had_pend) { if (kv_full) asm volatile("s_waitcnt vmcnt(3)" ::: "memory"); else asm volatile("s_waitcnt vmcnt(0)" ::: "memory");     \
            CV_DECODE(cv_pend) CV_STORE(); cv_pend = -1; } \
        st_had = had_pend; SBAR(); } while (0)
#define STAGE_V(t) do { SBAR(); if ((t) + 1 < NT) ADMA_V((t) + 1, ((t) + 1) & 1); SBAR(); } while (0)
#define STAGE_TAIL(t) do { SBAR(); if ((t) + 1 < NT) { const int cv_idx = __builtin_amdgcn_readfirstlane(tseq * cj.ngw + cj.gw); ++tseq; CV_DECODE(cv_idx) CV_LOAD(); cv_pend = cv_on ? cv_idx : -1; } \
        st_steady = st_had && cv_pend >= 0;                                    \
        SBAR(); } while (0)
#define PV_PART(t) do { if ((t) * KVBLK <= qlo + QBLK - 1) { SBAR(); pv_tile(o, vb0 + ((t) & 1) * SHM_V, pa0, pa1, pa2, pa3); SBAR(); } } while (0)
#define QK_PART(t) do { if ((t) < NT && (t) * KVBLK <= qlo + QBLK - 1) { SBAR(); qkt(p0, p1, K_lds + ((t) & 1) * SHM_K, r32, hi, qr); SBAR(); } } while (0)
#define VALU_SLOT(t) VALU_SLOT_H(t, (void)0)
#define VALU_SLOT_H(t, HOOK) do { const int kb_ = (t) * KVBLK; \
        if (!(kb_ <= qlo + QBLK - 1)) { HOOK; } \
        if (kb_ <= qlo + QBLK - 1) { \
            if (kb_ + KVBLK - 1 > qlo) { asm volatile("" ::: "memory"); const int dq = qm - kb_; const float NEG = -__builtin_inff(); \
                _Pragma("unroll") for (int r = 0; r < 16; ++r) { const int c = (r & 3) + 8 * (r >> 2); if (c > dq) p0[r] = NEG; if (c + 32 > dq) p1[r] = NEG; } } \
            float pmax = p0[0]; _Pragma("unroll") for (int r = 1; r < 16; ++r) pmax = fmaxf(pmax, p0[r]); _Pragma("unroll") for (int r = 0; r < 16; ++r) pmax = fmaxf(pmax, p1[r]); \
            { auto rr = __builtin_amdgcn_permlane32_swap(__float_as_uint(pmax), __float_as_uint(pmax), false, false); pmax = fmaxf(__uint_as_float(rr[0]), __uint_as_float(rr[1])); } \
            if (!__all(pmax - m_reg <= THR)) { const float mn = fmaxf(m_reg, pmax); const float alpha = __builtin_amdgcn_exp2f(m_reg - mn); m_reg = mn; l_reg *= alpha; \
                if (hi == 0) al_l[r32] = alpha; asm volatile("s_waitcnt lgkmcnt(0)" ::: "memory"); \
                _Pragma("unroll") for (int d_ = 0; d_ < 4; ++d_) _Pragma("unroll") for (int r = 0; r < 16; ++r) o[d_][r] *= al_l[crow(r, hi)]; } \
            float ps = 0.f; HOOK; \
            _Pragma("unroll") for (int r = 0; r < 16; ++r) { p0[r] = __builtin_amdgcn_exp2f(p0[r] - m_reg); p1[r] = __builtin_amdgcn_exp2f(p1[r] - m_reg); } \
            _Pragma("unroll") for (int r = 0; r < 16; ++r) ps += p0[r] + p1[r]; \
            { auto rr = __builtin_amdgcn_permlane32_swap(__float_as_uint(ps), __float_as_uint(ps), false, false); ps = __uint_as_float(rr[0]) + __uint_as_float(rr[1]); } \
            l_reg += ps; \
            PK4(p0, 0, pa0); PK4(p0, 8, pa1); PK4(p1, 0, pa2); PK4(p1, 8, pa3); } } while (0)
#define SLOT_END_EVEN() do { if (st_steady) asm volatile("s_waitcnt vmcnt(4)\n\ts_barrier" ::: "memory");     \
        else asm volatile("s_waitcnt vmcnt(0)\n\ts_barrier" ::: "memory"); } while (0)
#define SLOT_END_ODD() asm volatile("s_barrier" ::: "memory")
    ADMA_K(0, 0);
    asm volatile("s_waitcnt vmcnt(0)" ::: "memory"); __syncthreads();
    if (ph == 0) {
        f32x16 p0, p1;
        STAGE_SLOT(-1); STAGE_V(-1); QK_PART(0); STAGE_TAIL(-1); SLOT_END_ODD();
        for (int t = 0; t < NT; ++t) { bf16x8 pa0 = {}, pa1 = {}, pa2 = {}, pa3 = {};
            VALU_SLOT(t); SLOT_END_EVEN();
            STAGE_SLOT(t); PV_PART(t); STAGE_V(t); QK_PART(t + 1); STAGE_TAIL(t); SLOT_END_ODD(); }
    } else {
        bf16x8 pa0 = {}, pa1 = {}, pa2 = {}, pa3 = {};
        STAGE_SLOT(-1); STAGE_V(-1); STAGE_TAIL(-1); SLOT_END_ODD();
        for (int t = 0; t < NT; ++t) { f32x16 p0 = {}, p1 = {};
            if (t > 0) PV_PART(t - 1);
            QK_PART(t); SLOT_END_EVEN();
            STAGE_SLOT(t); VALU_SLOT(t); STAGE_V(t); STAGE_TAIL(t); SLOT_END_ODD(); }
        PV_PART(NT - 1);
    }
#undef STAGE_SLOT
#undef STAGE_V
#undef VALU_SLOT_H
#undef STAGE_TAIL
#undef PV_PART
#undef QK_PART
#undef VALU_SLOT
#undef SLOT_END_EVEN
#undef SLOT_END_ODD
#undef PK4
#undef ADMA_K
#undef ADMA_V
    if (cv_pend >= 0) { asm volatile("s_waitcnt vmcnt(0)" ::: "memory"); CV_DECODE(cv_pend) CV_STORE(); }
    if (hi == 0) li_l[r32] = l_reg;
    asm volatile("s_waitcnt vmcnt(0) lgkmcnt(0)" ::: "memory");
    float rli[16];
#pragma unroll
    for (int r = 0; r < 16; ++r) rli[r] = __builtin_amdgcn_rcpf(li_l[crow(r, hi)]);
    __syncthreads();
    LAS bf16_t* stg = (LAS bf16_t*)(lds + wid * 8192);
#pragma unroll
    for (int r = 0; r < 16; ++r) { const int orow = crow(r, hi);
#pragma unroll
        for (int d0 = 0; d0 < 4; ++d0) stg[orow * 128 + d0 * 32 + r32] = f2bf(o[d0][r] * rli[r]); }
    asm volatile("s_waitcnt lgkmcnt(0)" ::: "memory");
    const size_t row0 = (size_t)b * SEQ + qb * QB + wid * QBLK;
#pragma unroll
    for (int i = 0; i < 8; ++i) { const int row = i * 4 + (lane >> 4), ch = lane & 15; const u32x4 v = *(const LAS u32x4*)(stg + row * 128 + ch * 8);
        float ss = (blo(v.x) * blo(v.x) + bhi(v.x) * bhi(v.x)) + (blo(v.y) * blo(v.y) + bhi(v.y) * bhi(v.y)) + (blo(v.z) * blo(v.z) + bhi(v.z) * bhi(v.z)) + (blo(v.w) * blo(v.w) + bhi(v.w) * bhi(v.w));
        ss = row16_sum(ss);
        *(u32x2*)((unsigned char*)MIX + (row0 + row) * DM + h * DV + ch * 8) = (u32x2){pg8::pk4_fp8((f32x4){blo(v.x), bhi(v.x), blo(v.y), bhi(v.y)} * 32.f), pg8::pk4_fp8((f32x4){blo(v.z), bhi(v.z), blo(v.w), bhi(v.w)} * 32.f)};
        if (ch == 0) ASSQ[(row0 + row) * 4 + h] = ss; }
    __syncthreads();
}
#undef KSWZ
#undef SBAR
}

struct Args { const void* in[25]; float* out; unsigned char* ws; int ph_lo, ph_hi, li, skip; };
enum { PH_PREP = 0, PH_INPROJ, PH_TOKLOCAL, PH_ATTN, PH_WO, PH_ROUTER, PH_ROUTE, PH_MOE1, PH_MOE2, PH_COMBINE, PH_PLE, PH_FINAL, PH_COUNT };

template <int MODE> __device__ __forceinline__ int cmap_col(int n) {
    if (MODE == 1) { const int pn = n >> 8, half = (n >> 7) & 1, jj = n & 127; return half * 1024 + pn * 128 + jj; }
    if (MODE == 4) { if (n < 1024) return n < 960 ? n : INW; const int v = n - 1024, j = v >> 8, hf = (v >> 7) & 1, cc = v & 127; return (hf ? 1472 : 960) + 128 * j + cc; }
    if (MODE == 5) { const int t = n & ~255, v = n & 255; return t + 64 * ((v >> 5) & 3) + 16 * ((v >> 3) & 3) + 8 * (v >> 7) + (v & 7); }
    if (MODE == 2) { const int h = n / DQK, d = n % DQK; if (d < DN) return n; const int t = d - DN; return h * DQK + DN + (t & 1) * 32 + (t >> 1); }
    return n;
}
template <int MODE> __device__ __forceinline__ void transpose_item_fp8(const float* __restrict__ W, int ldsrc, int nblk, unsigned char* __restrict__ WT, int ldd, const float* __restrict__ gain, float scale,
                                                                      LAS float* scr, int item, int lane, const float* __restrict__ gain2 = nullptr) {
    const int kb = item / nblk, nb = item % nblk, k0 = 64 * kb, n0 = 32 * nb; const int c = cmap_col<MODE>(n0 + (lane & 31));
    float wv[32];
#pragma unroll
    for (int i = 0; i < 32; ++i) wv[i] = W[(size_t)(k0 + 2 * i + (lane >> 5)) * ldsrc + c];
#pragma unroll
    for (int i = 0; i < 32; ++i) { const int kk = 2 * i + (lane >> 5), k = k0 + kk; float gk = scale; if (gain) gk *= (gain2 && k >= 512) ? gain2[k - 512] : gain[k]; scr[kk * 33 + (lane & 31)] = wv[i] * gk; }
    asm volatile("s_waitcnt lgkmcnt(0)" ::: "memory");
    const int cc = lane & 3;
#pragma unroll
    for (int j = 0; j < 2; ++j) { const int n = (lane >> 2) + 16 * j; const LAS float* s = scr + (16 * cc) * 33 + n; u32x4 o;
        o.x = pg8::pk4_fp8((f32x4){s[0 * 33], s[1 * 33], s[2 * 33], s[3 * 33]}); o.y = pg8::pk4_fp8((f32x4){s[4 * 33], s[5 * 33], s[6 * 33], s[7 * 33]});
        o.z = pg8::pk4_fp8((f32x4){s[8 * 33], s[9 * 33], s[10 * 33], s[11 * 33]}); o.w = pg8::pk4_fp8((f32x4){s[12 * 33], s[13 * 33], s[14 * 33], s[15 * 33]});
        *(u32x4*)(WT + (size_t)(n0 + n) * ldd + k0 + 16 * cc) = o; }
    asm volatile("s_waitcnt lgkmcnt(0)" ::: "memory");
}
template <int MODE> __device__ __forceinline__ void transpose_item(const float* __restrict__ W, int ldsrc, int nblk, bf16_t* __restrict__ WT, int ldd, const float* __restrict__ gain, const float* __restrict__ gain2, float scale,
                                                                  LAS float* scr, int item, int lane) {
    const int kb = item / nblk, nb = item % nblk, k0 = 64 * kb, n0 = 32 * nb; const int c = cmap_col<MODE>(n0 + (lane & 31));
    float wv[32], gq[32];
#pragma unroll
    for (int i = 0; i < 32; ++i) wv[i] = W[(size_t)(k0 + 2 * i + (lane >> 5)) * ldsrc + c];
#pragma unroll
    for (int i = 0; i < 32; ++i) { const int k = k0 + 2 * i + (lane >> 5); gq[i] = gain ? ((gain2 && k >= 512) ? gain2[k - 512] : gain[k]) : 1.f; }
    asm volatile("" ::: "memory");
#pragma unroll
    for (int i = 0; i < 32; ++i) { const int kk = 2 * i + (lane >> 5); scr[kk * 33 + (lane & 31)] = wv[i] * (gq[i] * scale); }
    asm volatile("s_waitcnt lgkmcnt(0)" ::: "memory");
    const int cc = lane & 7;
#pragma unroll
    for (int j = 0; j < 4; ++j) { const int n = (lane >> 3) + 8 * j; const LAS float* s = scr + (8 * cc) * 33 + n;
        u32x4 o; o.x = pk2(s[0 * 33], s[1 * 33]); o.y = pk2(s[2 * 33], s[3 * 33]); o.z = pk2(s[4 * 33], s[5 * 33]); o.w = pk2(s[6 * 33], s[7 * 33]);
        *(u32x4*)(WT + (size_t)(n0 + n) * ldd + k0 + 8 * cc) = o; }
    asm volatile("s_waitcnt lgkmcnt(0)" ::: "memory");
}

__global__ void __launch_bounds__(NTHREADS, 2) fwd(Args args) {
    extern __shared__ __attribute__((aligned(16))) unsigned char lds_raw[];
    LAS unsigned char* lds = (LAS unsigned char*)lds_raw;
    volatile LAS unsigned* MISC = (volatile LAS unsigned*)(lds + MISC_OFF);
    const int wave = __builtin_amdgcn_readfirstlane(threadIdx.x >> 6);
    const int G = gridDim.x, bx = blockIdx.x;
#define PHASE_LANE const int lane = lane_id(); const int tid = wave * 64 + lane; (void)tid
    const int gw = bx * NWAVES + wave, NGW = G * NWAVES;
    unsigned char* ws = args.ws; int* ctl = (int*)(ws + WS_CTL); float* H = args.out;
    const float* x = (const float*)args.in[0]; const float* p = (const float*)args.in[1]; const int* pos = (const int*)args.in[2];
    const float *mix_norm = (const float*)args.in[3], *w_in = (const float*)args.in[4], *q_norm = (const float*)args.in[5], *w_uq = (const float*)args.in[6], *kv_norm = (const float*)args.in[7],
                *w_ukv = (const float*)args.in[8], *attn_out_norm = (const float*)args.in[10], *conv_out_norm = (const float*)args.in[11], *w_o = (const float*)args.in[12],
                *moe_norm = (const float*)args.in[13], *w_router = (const float*)args.in[14], *w1 = (const float*)args.in[16], *b1 = (const float*)args.in[17],
                *w2 = (const float*)args.in[18], *b2 = (const float*)args.in[19], *ple_norm = (const float*)args.in[20], *w_ple_gate = (const float*)args.in[21], *w_ple_proj = (const float*)args.in[22],
                *ple_post_norm = (const float*)args.in[23], *conv_w = (const float*)args.in[9], *b_router = (const float*)args.in[15], *final_norm = (const float*)args.in[24];
    int* TOPI = (int*)(ws + WS_TOPI); float* TOPG = (float*)(ws + WS_TOPG);
    bf16_t *HBF = (bf16_t*)(ws + WS_HBF), *H3 = (bf16_t*)(ws + WS_H3), *WRHL = (bf16_t*)(ws + WS_WRHL); unsigned char* X8 = (unsigned char*)(ws + WS_K);
    float* RSX = (float*)(ws + WS_RSX);
    float *SSQ1 = (float*)(ws + WS_SSQ1), *RS1 = (float*)(ws + WS_RS1), *RS2 = (float*)(ws + WS_RS2), *ROWRS = (float*)(ws + WS_ROWRS);
    unsigned char* H8 = ws + WS_K;
    bf16_t *WIN = (bf16_t*)(ws + WS_WIN), *WUQ = (bf16_t*)(ws + WS_WUQ), *WUKV = (bf16_t*)(ws + WS_WUKV), *WO = (bf16_t*)(ws + WS_WO), *WG = (bf16_t*)(ws + WS_WG), *WP = (bf16_t*)(ws + WS_WP);
    bf16_t *W1T = (bf16_t*)(ws + WS_W1), *W2T = (bf16_t*)(ws + WS_W2), *XN = (bf16_t*)(ws + WS_XN), *MIX = (bf16_t*)(ws + WS_MIX), *PLER = (bf16_t*)(ws + WS_PLER);
    bf16_t *Z = (bf16_t*)(ws + WS_Z), *Qb = (bf16_t*)(ws + WS_Q), *Kb = (bf16_t*)(ws + WS_K), *Vb = (bf16_t*)(ws + WS_V), *HB = (bf16_t*)(ws + WS_HB), *Y = (bf16_t*)(ws + WS_Y), *P16 = (bf16_t*)(ws + WS_P16);
    float *WR = (float*)(ws + WS_WR), *CS = (float*)(ws + WS_CS), *SSQ = (float*)(ws + WS_SSQ), *ASSQ = (float*)(ws + WS_ASSQ), *PSSQ = (float*)(ws + WS_PSSQ), *FSSQ = (float*)(ws + WS_FSSQ);
    int *ROWTOK = (int*)(ws + WS_ROWTOK), *ROWSLOT = (int*)(ws + WS_ROWSLOT); float* ROWGATE = (float*)(ws + WS_ROWGATE);

    { PHASE_LANE; for (int u = tid; u < (LDS_BYTES - MISC_OFF) / 4; u += NTHREADS) ((LAS unsigned*)(lds + MISC_OFF))[u] = 0u; }
    __syncthreads();
    const int lo = args.ph_lo, hi = args.ph_hi;
    XcdBarrier bar; bar.bar = (unsigned*)ctl + CW_BAR + args.li * XCD_BAR_WORDS; bar.x = 0; bar.st = MISC + 8;
    if (hi - lo > 1) bar = xcd_barrier_post((unsigned*)ctl + CW_BAR + args.li * XCD_BAR_WORDS, MISC + 8, wave);
#define IN(k) (lo <= (k) && (k) < hi)
#define NREP(k) ((PROBE_PH == (k)) ? PROBE_REP : 1)
#define REPLOOP(k) for (int rep = 0; rep < NREP(k); ++rep)
#define LASTREP(k) (rep == NREP(k) - 1)
#ifdef PROBE_TIME_PH
#define STAMP(k) do { if (bx == 0 && wave == 0) MISC[32 + (k)] = (unsigned)__builtin_amdgcn_s_memrealtime(); } while (0)
#else
#define STAMP(k) do { } while (0)
#endif
#ifdef PROBE_EPI
#define SEAM(k) do { if ((k) == PROBE_EPI && bx == 0 && threadIdx.x == 0) MISC[63] = MISC[62]; if (IN(k) && IN((k) + 1)) xcd_barrier(bar, wave); STAMP((k) + 1); if ((k) + 1 == PROBE_EPI && bx == 0 && threadIdx.x == 0) MISC[62] = 0; } while (0)
#else
#define SEAM(k) do { if (IN(k) && IN((k) + 1)) xcd_barrier(bar, wave); STAMP((k) + 1); } while (0)
#endif
    STAMP(0);

    if (IN(PH_PREP)) REPLOOP(PH_PREP) {
        PHASE_LANE;
        LAS float* scr = (LAS float*)(lds + wave * 16384);
        constexpr int I_IN = (DM / 64) * 64, I_UQ = (QL / 64) * (768 / 32), I_UKV = (KVL / 64) * (1024 / 32), I_O = (DM / 64) * (DM / 32), I_G = I_O, I_P = (PLE / 64) * (DM / 32);
        constexpr int I_1 = (DM / 64) * (2048 / 32), I_2 = (DE / 64) * (DM / 32);
        constexpr int NITEMS = I_IN + I_UQ + I_UKV + I_O + I_G + I_P;
        for (int half_ = 0; half_ < 2; ++half_) {
        if ((half_ ^ (bx & 1)) == 0) {
        for (int it = gw; it < NITEMS; it += NGW) {
            int r = it;
            if (r < I_IN) { if ((r & 63) != 30 && (r & 63) != 31) transpose_item<4>(w_in, INW, 64, WIN, DM, mix_norm, nullptr, 1.f, scr, r, lane); continue; } r -= I_IN;
            if (r < I_UQ) { transpose_item<2>(w_uq, 768, 768 / 32, WUQ, QL, q_norm, nullptr, QSCALE, scr, r, lane); continue; } r -= I_UQ;
            if (r < I_UKV) { transpose_item<0>(w_ukv, 1024, 1024 / 32, WUKV, 256, kv_norm, nullptr, 1.f, scr, r, lane); continue; } r -= I_UKV;
            if (r < I_O) { transpose_item_fp8<0>(w_o, DM, DM / 32, (unsigned char*)WO, DM, attn_out_norm, 64.f, scr, r, lane, conv_out_norm); continue; } r -= I_O;
            if (r < I_G) { transpose_item_fp8<0>(w_ple_gate, DM, DM / 32, (unsigned char*)WG, DM, ple_norm, 64.f, scr, r, lane); continue; } r -= I_G;
            transpose_item<5>(w_ple_proj, DM, DM / 32, WP, PLE, nullptr, nullptr, 1.f, scr, r, lane);
        }
        for (int i = bx * NTHREADS + tid; i < 1024 * 16; i += G * NTHREADS) *(u32x4*)(WUKV + (size_t)(i >> 4) * 256 + 128 + (i & 15) * 8) = (u32x4){0u, 0u, 0u, 0u};
        for (int i = bx * NTHREADS + tid; i < DM * NE; i += G * NTHREADS) { const int e = i >> 10, k = i & 1023; const float w = w_router[k * NE + e] * moe_norm[k]; const bf16_t whi = f2bf(w);
            WRHL[i] = whi; WRHL[DM * NE + i] = f2bf(w - bf2f(whi)); }
        { const float inv = powf(10000.f, -(float)(tid & 31) / 32.f);
        for (int i = bx * NTHREADS + tid; i < NTOK * 32; i += G * NTHREADS) { const int t = i >> 5, j = i & 31; const float a = (float)pos[t] * inv; float sn, c; sincosf(a, &sn, &c);
            CS[(size_t)t * 64 + j] = c; CS[(size_t)t * 64 + 32 + j] = sn; } }
        } else {
        for (int i = bx * NTHREADS + tid; i < NTOK * PLE / 4; i += 4 * G * NTHREADS) { f32x4 v[4];
#pragma unroll
            for (int q = 0; q < 4; ++q) { const int ii = i + q * G * NTHREADS; v[q] = ii < NTOK * PLE / 4 ? ((const f32x4*)p)[ii] : (f32x4){0.f, 0.f, 0.f, 0.f}; }
#pragma unroll
            for (int q = 0; q < 4; ++q) { const int ii = i + q * G * NTHREADS; if (ii < NTOK * PLE / 4) ((u32x2*)P16)[ii] = (u32x2){pk2(v[q][0], v[q][1]), pk2(v[q][2], v[q][3])}; } }
        for (int row = gw * 4; row < NTOK; row += NGW * 4) {
            f32x4 v[4][4]; float ss[4];
#pragma unroll
            for (int q = 0; q < 4; ++q) { const f32x4* s = (const f32x4*)(x + (size_t)(row + q) * DM);
#pragma unroll
                for (int j = 0; j < 4; ++j) v[q][j] = s[lane + 64 * j]; }
#pragma unroll
            for (int q = 0; q < 4; ++q) { ss[q] = 0.f;
#pragma unroll
                for (int j = 0; j < 4; ++j) ss[q] += pg8::sq4(v[q][j]); }
#pragma unroll
            for (int q = 0; q < 4; ++q) { const float rstd = rsqrtf(wave_sum(ss[q]) * (1.f / DM) + EPS); u32x2* d = (u32x2*)(XN + (size_t)(row + q) * DM); if (lane == 0) RSX[row + q] = rstd;
#pragma unroll
                for (int j = 0; j < 4; ++j) d[lane + 64 * j] = (u32x2){pk2(v[q][j][0], v[q][j][1]), pk2(v[q][j][2], v[q][j][3])}; }
        }
        } }
    }
    SEAM(PH_PREP);
    if (IN(PH_INPROJ)) REPLOOP(PH_INPROJ) {
        { pg8::Gemm g{XN, WIN, DM, DM, DM, nullptr, 0}; pg8::StaticOrder S; S.init(NTOK / 256, 8, G, bx, nullptr);
          pg8::EpiBf16Stats<0> E{Z, INWP, SSQ, RSX}; pg8::gemm_phase<pg8::EpiBf16Stats<0>, false>(lds, g, S, E, wave); }
    }
    SEAM(PH_INPROJ);
    if (IN(PH_TOKLOCAL)) REPLOOP(PH_TOKLOCAL) {
        PHASE_LANE;
#ifdef PROBE_Z
        const unsigned tz0_ = (unsigned)__builtin_amdgcn_s_memrealtime();
#endif
        if (!(args.skip & 1)) for (int r0 = gw * 16; r0 < NTOK; r0 += NGW * 16) {
            const int c8 = lane * 8; f32x4 w0[2], w1[2], w2[2];
#pragma unroll
            for (int q = 0; q < 2; ++q) { w0[q] = *(const f32x4*)(conv_w + c8 + 4 * q); w1[q] = *(const f32x4*)(conv_w + 512 + c8 + 4 * q); w2[q] = *(const f32x4*)(conv_w + 1024 + c8 + 4 * q); }
            f32x4 u1[2] = {}, u2[2] = {};
            if ((r0 % SEQ) != 0) {
#pragma unroll
                for (int p = 1; p <= 2; ++p) { const u32x4 uu = *(const u32x4*)(Z + (size_t)(r0 - p) * INWP + 960 + c8);
                    const f32x4 a = {blo(uu.x), bhi(uu.x), blo(uu.y), bhi(uu.y)}, b = {blo(uu.z), bhi(uu.z), blo(uu.w), bhi(uu.w)};
                    if (p == 1) { u1[0] = a; u1[1] = b; } else { u2[0] = a; u2[1] = b; } } }
            u32x4 bgA[4], uuA[4], bgB[4], uuB[4]; float kxA[4][4], kxB[4][4]; const int li = lane & 31, hh = lane >> 5;
#define ZR_LOAD(BG, UU, KX, base) do { _Pragma("unroll") for (int q = 0; q < 4; ++q) { const int row_ = r0 + (base) + q; const bf16_t* z_ = Z + (size_t)row_ * INWP; \
                BG[q] = *(const u32x4*)(z_ + 448 + c8); UU[q] = *(const u32x4*)(z_ + 960 + c8); \
                KX[q][0] = bf2f(z_[384 + li]); KX[q][1] = bf2f(z_[416 + li]); KX[q][2] = CS[(size_t)row_ * 64 + li]; KX[q][3] = CS[(size_t)row_ * 64 + 32 + li]; } \
                asm volatile("" ::: "memory"); } while (0)
#define ZR_COMP(BG, UU, KX, base) do { _Pragma("unroll") for (int q = 0; q < 4; ++q) { const int row = r0 + (base) + q; const int s_ = row % SEQ, b_ = row / SEQ; const u32x4 bg = BG[q], uu = UU[q]; \
                { const float x1 = KX[q][0], x2 = KX[q][1], c = KX[q][2], sn = KX[q][3]; const unsigned o = pk2(x1 * c - x2 * sn, x1 * sn + x2 * c); \
                    _Pragma("unroll") for (int h2 = 0; h2 < NH / 2; ++h2) *(unsigned*)(Kb + ((size_t)(b_ * NH + 2 * hh + h2) * SEQ + s_) * DQK + DN + 2 * li) = o; } \
                f32x4 u0[2]; u0[0] = (f32x4){blo(uu.x), bhi(uu.x), blo(uu.y), bhi(uu.y)}; u0[1] = (f32x4){blo(uu.z), bhi(uu.z), blo(uu.w), bhi(uu.w)}; \
                f32x4 y[2]; y[0] = (f32x4){blo(bg.x), bhi(bg.x), blo(bg.y), bhi(bg.y)} * (w0[0] * u2[0] + w1[0] * u1[0] + w2[0] * u0[0]); y[1] = (f32x4){blo(bg.z), bhi(bg.z), blo(bg.w), bhi(bg.w)} * (w0[1] * u2[1] + w1[1] * u1[1] + w2[1] * u0[1]); \
                const float rstd = rsqrtf(wave_sum(pg8::sq4(y[0]) + pg8::sq4(y[1])) * (1.f / 512.f) + EPS); \
                *(u32x2*)((unsigned char*)MIX + (size_t)row * DM + 512 + c8) = (u32x2){pg8::pk4_fp8(y[0] * rstd), pg8::pk4_fp8(y[1] * rstd)}; \
                u2[0] = u1[0]; u2[1] = u1[1]; u1[0] = u0[0]; u1[1] = u0[1]; } } while (0)
            ZR_LOAD(bgA, uuA, kxA, 0);
            ZR_LOAD(bgB, uuB, kxB, 4); ZR_COMP(bgA, uuA, kxA, 0);
            ZR_LOAD(bgA, uuA, kxA, 8); ZR_COMP(bgB, uuB, kxB, 4);
            ZR_LOAD(bgB, uuB, kxB, 12); ZR_COMP(bgA, uuA, kxA, 8);
            ZR_COMP(bgB, uuB, kxB, 12);
#undef ZR_LOAD
#undef ZR_COMP
        }
#ifdef PROBE_Z
        asm volatile("s_waitcnt vmcnt(0)" ::: "memory");
        if (bx == 0 && wave == PROBE_Z && lane_id() == 0) MISC[63] = (unsigned)__builtin_amdgcn_s_memrealtime() - tz0_;
#endif
        { pg8::Gemm g{Z, WUQ, QL, INWP, QL, nullptr, 0}; pg8::StaticOrder S; S.init(NTOK / 256, 768 / 256, G, bx, nullptr);
          pg8::EpiQ E{Qb, SSQ, CS}; pg8::gemm_phase<pg8::EpiQ, false>(lds, g, S, E, wave); }
        { pg8::Gemm g{Z + 256, WUKV, 256, INWP, 256, nullptr, 0}; pg8::StaticOrder S; S.init(NTOK / 256, 1024 / 256, G, bx, nullptr);
          pg8::EpiKV E{Kb, Vb, SSQ}; pg8::gemm_phase<pg8::EpiKV, false>(lds, g, S, E, wave); }
    }
    SEAM(PH_TOKLOCAL);
    if (IN(PH_ATTN)) REPLOOP(PH_ATTN) {
        const int vcu = (G % 8 == 0) ? (bx % 8) * (G / 8) + bx / 8 : bx;
        using att::L_END; using att::cv_cmap1; using att::cv_cmap2; using att::CV_N1; using att::CV_TOTAL;
        const att::ConvJob cj{w1, w2, moe_norm, (unsigned char*)W1T, (unsigned char*)W2T, gw, NGW}; int tseq = LASTREP(PH_ATTN) ? 0 : (1 << 20);
        for (int it = vcu; it < NB * NH * 8; it += G) { const int bh = it >> 3, pr = it & 7;
            for (int pass = 0; pass < 2; ++pass) att::attn_block(bh, pass ? pr : 15 - pr, Qb, Kb, Vb, MIX, ASSQ, lds, wave, cj, tseq); }
        if (LASTREP(PH_ATTN)) { const int lane = lane_id(), hi = lane >> 5, wid = wave; __syncthreads();
            for (int cv_idx = tseq * NGW + gw; cv_idx < att::CV_TOTAL; cv_idx += NGW) { CV_DECODE(cv_idx) CV_LOAD(); asm volatile("s_waitcnt vmcnt(0)" ::: "memory"); CV_STORE(); } }
    }
    SEAM(PH_ATTN);
    if (IN(PH_WO)) REPLOOP(PH_WO) {
        pg8::Gemm g{MIX, WO, DM, DM, DM, nullptr, 0}; pg8::StaticOrder S; S.init(NTOK / 256, DM / 256, G, bx, nullptr);
        pg8::EpiWo E{XN, HBF, X8, ASSQ, SSQ1, moe_norm}; pg8::gemm_phase<pg8::EpiWo, false, true>(lds, g, S, E, wave, LASTREP(PH_WO));
    }
    SEAM(PH_WO);
    if (IN(PH_ROUTER)) REPLOOP(PH_ROUTER) {
        PHASE_LANE;
        typedef float f32x16 __attribute__((ext_vector_type(16)));
        const bool fusedR = (G == 256);
        LAS int* hist = (LAS int*)(lds + HIST_OFF); LAS f32x16* xch = (LAS f32x16*)(lds + HIST_OFF + 256);
        for (int pc = wave; pc < 2 * NE * 2; pc += NWAVES) { const int pe = pc >> 1, hf = pc & 1, kc = (hf * 64 + lane) ^ (pe & 15);
            __builtin_amdgcn_global_load_lds((const unsigned*)((const char*)WRHL + ((size_t)pe * 128 + kc) * 16), (LAS unsigned*)(lds + pe * 2048 + hf * 1024), 16, 0, 0); }
        asm volatile("s_waitcnt vmcnt(0)" ::: "memory");
        if (tid < NE) hist[tid] = 0;
        __syncthreads();
        for (int chunk = bx; chunk < NTOK / 128; chunk += G) {
            const int base = chunk * 128, wq = wave & 3, kh = wave >> 2;
            const int j = lane & 31, half = lane >> 5, tok = base + wq * 32 + j;
            const bf16_t* xr = HBF + (size_t)tok * DM + kh * 512 + 8 * half; const LAS unsigned char* wrow = lds + j * 2048;
            f32x16 acc = {};
#pragma unroll 8
            for (int s = 0; s < 32; ++s) { const bf16x8 xb = *(const bf16x8*)(xr + 16 * s); const int kc = ((kh * 64 + 2 * s + half) ^ (j & 15)) << 4;
                const bf16x8 ah = *(const LAS bf16x8*)(wrow + kc), al = *(const LAS bf16x8*)(wrow + 65536 + kc);
                acc = __builtin_amdgcn_mfma_f32_32x32x16_bf16(ah, xb, acc, 0, 0, 0); acc = __builtin_amdgcn_mfma_f32_32x32x16_bf16(al, xb, acc, 0, 0, 0); }
            if (kh == 1) xch[wq * 64 + lane] = acc;
            __syncthreads();
            if (kh == 0) {
                const f32x16 other = xch[wq * 64 + lane];
                const f32x4 s0 = *(const f32x4*)(SSQ1 + (size_t)tok * 16 + 8 * half), s1 = *(const f32x4*)(SSQ1 + (size_t)tok * 16 + 8 * half + 4);
                float ss = ((s0[0] + s0[1]) + (s0[2] + s0[3])) + ((s1[0] + s1[1]) + (s1[2] + s1[3])); ss = xsum32(ss); const float rstd = rsqrtf(ss * (1.f / DM) + EPS);
                float v[16];
#pragma unroll
                for (int r = 0; r < 16; ++r) v[r] = (acc[r] + other[r]) * rstd + b_router[(r & 3) + 8 * (r >> 2) + 4 * half];
                float lv[4]; int li[4];
#pragma unroll
                for (int t = 0; t < 4; ++t) { float best = -__builtin_inff(); int bi = 0;
#pragma unroll
                    for (int r = 0; r < 16; ++r) if (v[r] > best) { best = v[r]; bi = (r & 3) + 8 * (r >> 2) + 4 * half; }
                    const auto rv = __builtin_amdgcn_permlane32_swap(__float_as_uint(best), __float_as_uint(best), false, false); const auto ri = __builtin_amdgcn_permlane32_swap((unsigned)bi, (unsigned)bi, false, false);
                    const float b0 = __uint_as_float(rv[0]), b1 = __uint_as_float(rv[1]); const int i0 = (int)ri[0], i1 = (int)ri[1];
                    const bool t0 = (b0 > b1) || (b0 == b1 && i0 < i1); const float gb = t0 ? b0 : b1; const int gi = t0 ? i0 : i1; lv[t] = gb; li[t] = gi;
#pragma unroll
                    for (int r = 0; r < 16; ++r) if ((r & 3) + 8 * (r >> 2) + 4 * half == gi) v[r] = -__builtin_inff(); }
                if (half == 0) { const float e1 = __expf(lv[1] - lv[0]), e2 = __expf(lv[2] - lv[0]), e3 = __expf(lv[3] - lv[0]); const float inv = 1.f / (1.f + e1 + e2 + e3);
                    if (fusedR) { const int tl = wq * 32 + j; *(LAS u32x4*)(lds + LT_OFF + tl * 16) = (u32x4){(unsigned)li[0], (unsigned)li[1], (unsigned)li[2], (unsigned)li[3]}; *(LAS f32x4*)(lds + LT_OFF + 2048 + tl * 16) = (f32x4){inv, e1 * inv, e2 * inv, e3 * inv}; *(LAS float*)(lds + LT_OFF + 4096 + tl * 4) = rstd; }
                    else { *(int4*)(TOPI + (size_t)tok * 4) = make_int4(li[0], li[1], li[2], li[3]); *(f32x4*)(TOPG + (size_t)tok * 4) = (f32x4){inv, e1 * inv, e2 * inv, e3 * inv}; RS1[tok] = rstd; }
#pragma unroll
                    for (int t = 0; t < 4; ++t) (void)__hip_atomic_fetch_add(hist + li[t], 1, __ATOMIC_RELAXED, __HIP_MEMORY_SCOPE_WORKGROUP); }
            }
            __syncthreads();
        }
        if (!fusedR) { if (tid < NE && LASTREP(PH_ROUTER)) atomicAdd(ctl + CW_CNT + tid, hist[tid]); __syncthreads(); }
        else {
            LAS int* S = (LAS int*)lds; LAS int* T = (LAS int*)(lds + 32768);
            LAS int* shf = (LAS int*)(lds + LT_OFF + 4608); LAS int* sh2 = shf + 64;
            int* BH = (int*)(ws + WS_FSSQ + 1 * MiB); int* BB = BH + 256 * NE;
            if (tid < NE) __hip_atomic_store(BH + bx * NE + tid, hist[tid], __ATOMIC_RELAXED, __HIP_MEMORY_SCOPE_AGENT);
            asm volatile("s_waitcnt vmcnt(0)" ::: "memory");
            __syncthreads();
            if (tid == 0) shf[0] = (__hip_atomic_fetch_add(ctl + CW_TICKET, 1, __ATOMIC_RELAXED, __HIP_MEMORY_SCOPE_AGENT) == G - 1) ? 1 : 0;
            __syncthreads();
            if (shf[0]) {
                if (wave == 0) __builtin_amdgcn_fence(__ATOMIC_ACQUIRE, "agent");
                __syncthreads();
                { u32x4 hv4[4];
#pragma unroll
                  for (int q = 0; q < 4; ++q) hv4[q] = *(const u32x4*)(BH + (tid + q * NTHREADS) * 4);
#pragma unroll
                  for (int q = 0; q < 4; ++q) *(LAS u32x4*)(S + (tid + q * NTHREADS) * 4) = hv4[q]; }
                __syncthreads();
                if (lane < NE) { int run = 0; for (int b = wave * 32; b < wave * 32 + 32; ++b) { const int v = S[b * NE + lane]; S[b * NE + lane] = run; run += v; } T[wave * NE + lane] = run; }
                __syncthreads();
                if (tid < NE) { int run = 0; for (int w = 0; w < 8; ++w) { const int v = T[w * NE + tid]; T[w * NE + tid] = run; run += v; } T[256 + tid] = run; }
                __syncthreads();
#pragma unroll
                for (int q = 0; q < 4; ++q) { const int i = (tid + q * NTHREADS) * 4; u32x4 v = *(const LAS u32x4*)(S + i); const u32x4 tb = *(const LAS u32x4*)(T + (i >> 10) * NE + (i & 31));
                    v += tb; asm volatile("global_store_dwordx4 %0, %1, off sc0 sc1" :: "v"(BB + i), "v"(v) : "memory"); }
                if (wave == 0) { const int c = lane < NE ? T[256 + (lane & 31)] : 0, t = (c + 255) >> 8; int incl = t;
#pragma unroll
                    for (int d = 1; d < 64; d <<= 1) { const int o = __shfl_up(incl, d); if (lane >= d) incl += o; }
                    const int excl = incl - t;
                    if (lane < NE) { __hip_atomic_store(ctl + CW_PADSTART + lane, excl * 256, __ATOMIC_RELAXED, __HIP_MEMORY_SCOPE_AGENT); __hip_atomic_store(ctl + CW_CNT + lane, c, __ATOMIC_RELAXED, __HIP_MEMORY_SCOPE_AGENT);
                        for (int q = 0; q < t; ++q) __hip_atomic_store(ctl + CW_TILE_E + excl + q, lane, __ATOMIC_RELAXED, __HIP_MEMORY_SCOPE_AGENT); }
                    if (lane == NE) { __hip_atomic_store(ctl + CW_PADSTART + NE, excl * 256, __ATOMIC_RELAXED, __HIP_MEMORY_SCOPE_AGENT); __hip_atomic_store(ctl + CW_NTILES, excl, __ATOMIC_RELAXED, __HIP_MEMORY_SCOPE_AGENT); } }
                asm volatile("s_waitcnt vmcnt(0)" ::: "memory");
                __syncthreads();
                if (tid == 0) __hip_atomic_store(ctl + CW_READY, 1, __ATOMIC_RELAXED, __HIP_MEMORY_SCOPE_AGENT);
            }
            if (wave == 0) { unsigned sp = 0;
                while (__builtin_amdgcn_readfirstlane(__hip_atomic_load(ctl + CW_READY, __ATOMIC_RELAXED, __HIP_MEMORY_SCOPE_AGENT)) == 0) { __builtin_amdgcn_s_sleep(24); if (++sp > (1u << 19)) break; }
                __builtin_amdgcn_fence(__ATOMIC_ACQUIRE, "agent"); }
            __syncthreads();
            if (tid < NE) { sh2[tid] = BB[bx * NE + tid] + ctl[CW_PADSTART + tid]; sh2[64 + tid] = 0; }
            __syncthreads();
            { const int e = *(const LAS int*)(lds + LT_OFF + tid * 4); const int r = __hip_atomic_fetch_add(sh2 + 64 + e, 1, __ATOMIC_RELAXED, __HIP_MEMORY_SCOPE_WORKGROUP);
              const int dest = sh2[e] + r, idx = bx * NTHREADS + tid;
              ROWTOK[dest] = idx >> 2; ROWSLOT[dest] = idx; ROWGATE[dest] = *(const LAS float*)(lds + LT_OFF + 2048 + tid * 4); ROWRS[dest] = *(const LAS float*)(lds + LT_OFF + 4096 + (tid >> 2) * 4); }
            if (bx < NE) { const int plo = ctl[CW_PADSTART + bx] + ctl[CW_CNT + bx], phi = ctl[CW_PADSTART + bx + 1];
                for (int r = plo + tid; r < phi; r += NTHREADS) { ROWTOK[r] = 0; ROWSLOT[r] = MROWS; ROWGATE[r] = 0.f; ROWRS[r] = 0.f; } }
            __syncthreads();
        }
    }
    if (G != 256) SEAM(PH_ROUTER);
    if (IN(PH_ROUTE) && G != 256) {
        PHASE_LANE;
        LAS int* sh = (LAS int*)lds;
        if (tid == 0) { int ps = 0, nt = 0;
            for (int e = 0; e < NE; ++e) { sh[e] = ps; const int t = (ctl[CW_CNT + e] + 255) >> 8; if (bx == 0) for (int q = 0; q < t; ++q) ctl[CW_TILE_E + nt + q] = e; nt += t; ps += t * 256; }
            sh[NE] = ps; if (bx == 0) ctl[CW_NTILES] = nt; }
        __syncthreads();
        for (int chunk = bx; chunk < MROWS / NTHREADS; chunk += G) {
            if (tid < NE) sh[64 + tid] = 0;
            __syncthreads();
            const int idx = chunk * NTHREADS + tid, e = TOPI[idx]; const int r = __hip_atomic_fetch_add(sh + 64 + e, 1, __ATOMIC_RELAXED, __HIP_MEMORY_SCOPE_WORKGROUP);
            __syncthreads();
            if (tid < NE) sh[128 + tid] = atomicAdd(ctl + CW_CURSOR + tid, sh[64 + tid]);
            __syncthreads();
            const int dest = sh[e] + sh[128 + e] + r; ROWTOK[dest] = idx >> 2; ROWSLOT[dest] = idx; ROWGATE[dest] = TOPG[idx]; ROWRS[dest] = RS1[idx >> 2];
            __syncthreads();
        }
        for (int e = bx; e < NE; e += G) { const int plo = sh[e] + ctl[CW_CNT + e], phi = sh[e + 1];
            for (int r = plo + tid; r < phi; r += NTHREADS) { ROWTOK[r] = 0; ROWSLOT[r] = MROWS; ROWGATE[r] = 0.f; ROWRS[r] = 0.f; } }
        __syncthreads();
    }
    SEAM(PH_ROUTE);
    constexpr int NPR = (NTOK / 256) * (DM / 256);
#define PLER_PLAN() const int nt_ = ctl[CW_NTILES]; const int rem1_ = (nt_ * 8) % G, rem2_ = (nt_ * 4) % G; const int S1_ = rem1_ ? G - rem1_ : 0, S2_ = rem2_ ? G - rem2_ : 0; \
        const int F2_ = NPR < 2 * S2_ ? NPR : 2 * S2_; const int F1_ = (NPR - F2_) < 2 * S1_ ? (NPR - F2_) : 2 * S1_;
#define PLER_FILL(bA, lA, SA, rkA, bB, lB) do { pg8::Gemm gp{P16, WP, PLE, PLE, PLE, nullptr, 0}; pg8::StaticOrder Sp; Sp.init(NTOK / 256, DM / 256, G, bx, nullptr); Sp.seg = 1; \
        Sp.baseA = (bA); Sp.GA = (SA) > 0 ? (SA) : 1; Sp.cA = (rkA); Sp.nA = ((SA) > 0 && (rkA) >= 0 && (bA) + (rkA) < (lA)) ? ((lA) - (bA) - (rkA) + (SA) - 1) / (SA) : 0; Sp.baseB = (bB); Sp.limB = (lB); \
        pg8::EpiBf16Stats<1> Ep{PLER, DM, PSSQ, ple_post_norm}; pg8::gemm_phase<pg8::EpiBf16Stats<1>, false>(lds, gp, Sp, Ep, wave); } while (0)
    if (IN(PH_MOE1)) REPLOOP(PH_MOE1) {
        pg8::Gemm g{X8, W1T, DM, DM, DM, ROWTOK, (size_t)2048 * DM}; pg8::StaticOrder S; S.init(ctl[CW_NTILES], 2048 / 256, G, bx, ctl + CW_TILE_E); S.wgm = 4;
        { PHASE_LANE; constexpr int MAXU = 24; LAS int* UIDX = (LAS int*)(lds + STG_OFF); LAS int* UE = UIDX + MAXU * 256;
          const int nunits = bx < S.nwg ? (S.nwg - bx + G - 1) / G : 0;
          if (nunits <= MAXU) { const int* te = S.tile_e; S.tile_e = nullptr;
              if (tid < nunits) { pg8::Unit u; S.next(tid, u); UE[tid] = te[u.pm]; }
              for (int i0 = 0; i0 < nunits; i0 += 12) { int v[12];
#pragma unroll
                  for (int q = 0; q < 12; ++q) { pg8::Unit u; u.pm = 0; const bool ok = i0 + q < nunits; if (ok) S.next(i0 + q, u); v[q] = (ok && tid < 256) ? ROWTOK[u.pm * 256 + tid] : 0; }
#pragma unroll
                  for (int q = 0; q < 12; ++q) if (i0 + q < nunits && tid < 256) UIDX[(i0 + q) * 256 + tid] = v[q]; }
              S.tile_e = te; __syncthreads(); g.ridx_lds = UIDX; S.e_lds = UE; } }
        pg8::EpiMoe1 E{(unsigned char*)HB, b1, ROWRS};
        if (g.ridx_lds) pg8::gemm_phase<pg8::EpiMoe1, true, true, true>(lds, g, S, E, wave, LASTREP(PH_MOE1));
        else pg8::gemm_phase<pg8::EpiMoe1, true, true>(lds, g, S, E, wave, LASTREP(PH_MOE1));
        if (LASTREP(PH_MOE1)) { PLER_PLAN() PLER_FILL(0, F1_, S1_, bx - rem1_, 0, 0); }
    }
    SEAM(PH_MOE1);
    if (IN(PH_MOE2)) REPLOOP(PH_MOE2) {
        pg8::Gemm g{HB, W2T, DE, DE, DE, nullptr, (size_t)DM * DE}; pg8::StaticOrder S; S.init(ctl[CW_NTILES], DM / 256, G, bx, ctl + CW_TILE_E); S.wgm = 4;
        { PHASE_LANE; constexpr int MAXU = 64; LAS int* UE = (LAS int*)(lds + STG_OFF); const int nunits = bx < S.nwg ? (S.nwg - bx + G - 1) / G : 0;
          if (nunits <= MAXU) { const int* te = S.tile_e; S.tile_e = nullptr; if (tid < nunits) { pg8::Unit u; S.next(tid, u); UE[tid] = te[u.pm]; } S.tile_e = te; __syncthreads(); S.e_lds = UE; } }
        pg8::EpiMoe2 E{(unsigned char*)Y, b2, ROWSLOT, ROWGATE}; pg8::gemm_phase<pg8::EpiMoe2, false, true>(lds, g, S, E, wave, LASTREP(PH_MOE2));
        if (LASTREP(PH_MOE2)) { PLER_PLAN() PLER_FILL(F1_, F1_ + F2_, S2_, bx - rem2_, F1_ + F2_, NPR); }
    }
    SEAM(PH_MOE2);
    if (IN(PH_COMBINE)) REPLOOP(PH_COMBINE) {
        PHASE_LANE;
        for (int row = gw * 2; row < NTOK; row += NGW * 2) {
            u32x4 hv[2][2]; u32x2 yv[2][4][2]; const unsigned char* Y8 = (const unsigned char*)Y;
#pragma unroll
            for (int q = 0; q < 2; ++q)
#pragma unroll
                for (int j = 0; j < 2; ++j) { hv[q][j] = *(const u32x4*)(HBF + (size_t)(row + q) * DM + (lane + 64 * j) * 8);
#pragma unroll
                    for (int k = 0; k < 4; ++k) yv[q][k][j] = *(const u32x2*)(Y8 + ((size_t)(row + q) * 4 + k) * DM + (lane + 64 * j) * 8); }
#pragma unroll
            for (int q = 0; q < 2; ++q) { float ss = 0.f; u32x4 ov[2]; u32x2 o8[2];
#pragma unroll
                for (int j = 0; j < 2; ++j) { f32x4 a = {blo(hv[q][j].x), bhi(hv[q][j].x), blo(hv[q][j].y), bhi(hv[q][j].y)}, b = {blo(hv[q][j].z), bhi(hv[q][j].z), blo(hv[q][j].w), bhi(hv[q][j].w)};
#pragma unroll
                    for (int k = 0; k < 4; ++k) { const u32x2 y = yv[q][k][j]; const f32x2 y0 = __builtin_amdgcn_cvt_pk_f32_fp8(y.x, false), y1 = __builtin_amdgcn_cvt_pk_f32_fp8(y.x, true), y2 = __builtin_amdgcn_cvt_pk_f32_fp8(y.y, false), y3 = __builtin_amdgcn_cvt_pk_f32_fp8(y.y, true);
                        a += (f32x4){y0[0], y0[1], y1[0], y1[1]}; b += (f32x4){y2[0], y2[1], y3[0], y3[1]}; }
                    ss += pg8::sq4(a) + pg8::sq4(b); ov[j] = pg8::pack8(a, b); o8[j] = (u32x2){pg8::pk4_fp8(a), pg8::pk4_fp8(b)}; }
                ss = wave_sum(ss);
                bf16_t* ho = LASTREP(PH_COMBINE) ? HBF : (bf16_t*)(ws + WS_HB);
#pragma unroll
                for (int j = 0; j < 2; ++j) { *(u32x4*)(ho + (size_t)(row + q) * DM + (lane + 64 * j) * 8) = ov[j]; *(u32x2*)(H8 + (size_t)(row + q) * DM + (lane + 64 * j) * 8) = o8[j]; }
                float ps = lane < 16 ? PSSQ[(size_t)(row + q) * 16 + lane] : 0.f; ps = row16_sum(ps);
                if (lane == 0) { RS2[row + q] = rsqrtf(ss * (1.f / DM) + EPS); RS2[NTOK + row + q] = rsqrtf(ps * (1.f / DM) + EPS); } }
        }
    }
    SEAM(PH_COMBINE);
    if (IN(PH_PLE)) REPLOOP(PH_PLE) {
        pg8::Gemm g{H8, WG, DM, DM, DM, nullptr, 0}; pg8::StaticOrder S; S.init(NTOK / 256, DM / 256, G, bx, nullptr);
        if (G == 256 && LASTREP(PH_PLE)) { pg8::EpiPleFinal E{HBF, H, PLER, RS2 + NTOK, RS2, ple_post_norm, final_norm, FSSQ, (unsigned*)ctl + CW_PANEL, (unsigned*)ctl + CW_PANEL - 64, lds}; pg8::gemm_phase<pg8::EpiPleFinal, false, true>(lds, g, S, E, wave); }
        else { pg8::EpiPle E{HBF, H3, PLER, RS2 + NTOK, RS2, ple_post_norm, FSSQ}; pg8::gemm_phase<pg8::EpiPle, false, true>(lds, g, S, E, wave); }
    }
    if (G != 256) SEAM(PH_PLE);
    if (IN(PH_FINAL) && G != 256) REPLOOP(PH_FINAL) {
        PHASE_LANE;
        for (int row = gw * 4; row < NTOK; row += NGW * 4) {
            u32x4 hv[4][2]; float sp[4];
#pragma unroll
            for (int q = 0; q < 4; ++q) { sp[q] = lane < 16 ? FSSQ[(size_t)(row + q) * 16 + lane] : 0.f;
#pragma unroll
                for (int j = 0; j < 2; ++j) hv[q][j] = *(const u32x4*)(H3 + (size_t)(row + q) * DM + (lane + 64 * j) * 8); }
#pragma unroll
            for (int q = 0; q < 4; ++q) { float s = row16_sum(sp[q]);
                const float rstd = rsqrtf(__shfl(s, 0) * (1.f / DM) + EPS); float* ho = (LASTREP(PH_FINAL) ? H : (float*)(ws + WS_HB)) + (size_t)(row + q) * DM;
#pragma unroll
                for (int j = 0; j < 2; ++j) { const int c = (lane + 64 * j) * 8; const f32x4 g0 = *(const f32x4*)(final_norm + c), g1 = *(const f32x4*)(final_norm + c + 4); const u32x4 v = hv[q][j];
                    *(f32x4*)(ho + c) = (f32x4){blo(v.x), bhi(v.x), blo(v.y), bhi(v.y)} * rstd * g0; *(f32x4*)(ho + c + 4) = (f32x4){blo(v.z), bhi(v.z), blo(v.w), bhi(v.w)} * rstd * g1; } }
        }
    }
#ifdef PROBE_EPI
    if (bx == 0 && wave == 0) { const unsigned dt = MISC[63]; const unsigned long long t0 = __builtin_amdgcn_s_memrealtime(); while (__builtin_amdgcn_s_memrealtime() - t0 < (unsigned long long)dt) __builtin_amdgcn_s_sleep(8); }
#endif
#ifdef PROBE_Z
    if (bx == 0 && wave == 0) { const unsigned dt = MISC[63]; const unsigned long long t0 = __builtin_amdgcn_s_memrealtime(); while (__builtin_amdgcn_s_memrealtime() - t0 < (unsigned long long)dt) __builtin_amdgcn_s_sleep(8); }
#endif
#ifdef PROBE_TIME_PH
    STAMP(PH_COUNT);
    if (bx == 0 && wave == 0) {
#ifndef PROBE_TIME_END
#define PROBE_TIME_END (PROBE_TIME_PH + 1)
#endif
        const unsigned dt = MISC[32 + PROBE_TIME_END] - MISC[32 + PROBE_TIME_PH]; const unsigned long long t0 = __builtin_amdgcn_s_memrealtime(); while (__builtin_amdgcn_s_memrealtime() - t0 < (unsigned long long)dt) __builtin_amdgcn_s_sleep(8); }
#endif
#ifdef PROBE_BARS
    if (hi - lo > 1) for (int i = 0; i < PROBE_BARS; ++i) xcd_barrier(bar, wave);
#endif
#undef IN
#undef NREP
#undef REPLOOP
#undef LASTREP
#undef SEAM
}
static int g_grid = 0;
extern "C" void kernel_launch(void* const* d_in, const int* in_sizes, int n_in, void* d_out, int out_size, void* d_ws, size_t ws_size, hipStream_t stream) {
    if (n_in != 25 || in_sizes[0] != NTOK * DM || out_size != NTOK * DM || ws_size < WS_END) {
        fprintf(stderr, "kernel_launch: unexpected shapes (n_in %d, in0 %d, out %d, ws %zu need %zu)\n", n_in, n_in > 0 ? in_sizes[0] : -1, out_size, ws_size, (size_t)WS_END); return; }
    if (g_grid == 0) {
        int dev = 0, cus = 0, per_cu = 0; (void)hipGetDevice(&dev); (void)hipDeviceGetAttribute(&cus, hipDeviceAttributeMultiprocessorCount, dev);
        if (hipFuncSetAttribute((const void*)fwd, hipFuncAttributeMaxDynamicSharedMemorySize, LDS_BYTES) != hipSuccess) fprintf(stderr, "hipFuncSetAttribute failed\n");
        if (hipOccupancyMaxActiveBlocksPerMultiprocessor(&per_cu, (const void*)fwd, NTHREADS, LDS_BYTES) != hipSuccess || per_cu < 1) { fprintf(stderr, "occupancy query: %d\n", per_cu); per_cu = 1; }
        (void)hipGetLastError();
        g_grid = cus > 0 ? cus : 256;
    }
    (void)hipMemsetAsync((unsigned char*)d_ws + WS_CTL, 0, 64 * 1024, stream);
    Args a{}; for (int i = 0; i < 25; ++i) a.in[i] = d_in[i]; a.out = (float*)d_out; a.ws = (unsigned char*)d_ws;
    a.ph_lo = 0; a.ph_hi = PH_COUNT; a.li = 0; a.skip = 0;
    void* p[] = {&a};
    const hipError_t e = hipLaunchCooperativeKernel((const void*)fwd, dim3(g_grid), dim3(NTHREADS), p, LDS_BYTES, stream);
    if (e != hipSuccess) fprintf(stderr, "cooperative launch failed: %s (grid %d)\n", hipGetErrorString(e), g_grid);
}
```
